# Optimizing an MI355X kernel written in HIP

```python
import math
import jax
import jax.numpy as jnp
from jax import lax
import numpy as np

D_MODEL = 1024
BATCH = 1
SEQ = 16384
DEPTH = 4

GRID_W = 64
CTX_LEN = 256
HEAD_DIM = 64
BRANCH_W = D_MODEL // 2
MIX_W = 2 * BRANCH_W
NA_HEADS = BRANCH_W // HEAD_DIM
NA_WIN_ROWS = 8
NA_WIN_COLS = 16
GQA_HEADS = BRANCH_W // HEAD_DIM
GQA_KV_HEADS = 2
GQA_GROUP = GQA_HEADS // GQA_KV_HEADS
GQA_KV_W = GQA_KV_HEADS * HEAD_DIM
ROPE_THETA = 10000.0
ROPE_FREQS = HEAD_DIM // 4
Q_BLOCK = 128
RWKV_HEADS = BRANCH_W // HEAD_DIM
DECAY_LORA = 32
ICLR_LORA = 32
HY_WIDTH = BRANCH_W
HY_ORDER = 2
HY_POS_BANDS = 16
HY_POS_DIM = 1 + 2 * HY_POS_BANDS
HY_FILTER_HIDDEN = 64
HY_DECAY_TARGET = 1e-2
HY_FAST_DECAY_PCT = 0.3
HY_SLOW_DECAY_PCT = 1.5
NORM_EPS = 1e-6
RWKV_GN_EPS = 64e-5
N_ATTN_LAYERS = (DEPTH + 1) // 2
N_REC_LAYERS = DEPTH // 2
ATTN_SPLITS = (BRANCH_W, BRANCH_W, BRANCH_W, BRANCH_W, BRANCH_W, GQA_KV_W, GQA_KV_W, BRANCH_W)
ATTN_IN = 6 * BRANCH_W + 2 * GQA_KV_W
RWKV_SPLITS = (BRANCH_W, BRANCH_W, BRANCH_W, DECAY_LORA, DECAY_LORA, ICLR_LORA, ICLR_LORA)
RWKV_SHIFT_W = 3 * BRANCH_W + 2 * DECAY_LORA + 2 * ICLR_LORA
HY_IN_W = (HY_ORDER + 1) * HY_WIDTH
REC_SPLITS = (RWKV_SHIFT_W, BRANCH_W, HY_IN_W, HY_WIDTH)
REC_IN = RWKV_SHIFT_W + BRANCH_W + HY_IN_W + HY_WIDTH

kernel_name = "hybrid_natten_gqa_rwkv7_hyena_dit"


def split_cols(u, sizes):
    parts, start = [], 0
    for s in sizes:
        parts.append(u[..., start:start + s])
        start += s
    return parts


def to_heads(t, n_heads):
    return t.reshape(t.shape[:-1] + (n_heads, HEAD_DIM))


def rms_norm(x, gain):
    xf = x.astype(jnp.float32)
    y = xf * lax.rsqrt(jnp.mean(xf * xf, axis=-1, keepdims=True) + NORM_EPS)
    return (y * gain.astype(jnp.float32)).astype(x.dtype)


def adaln(cond, ada_w, ada_b):
    m = jax.nn.silu(cond) @ ada_w + ada_b
    return jnp.split(m, 3, axis=-1)


def modulate(x, gain, shift, scale):
    return rms_norm(x, gain) * (1 + scale) + shift


def centred_pad(u):
    return jnp.pad(u, ((0, 0), (1, 1), (0, 0)))


def centred_conv3(u, taps):
    up = centred_pad(u)
    return up[:, :-2] * taps[0] + up[:, 1:-1] * taps[1] + up[:, 2:] * taps[2]


def centred_token_shift(u, mu):
    up = centred_pad(u)
    return u + (0.5 * (up[:, :-2] + up[:, 2:]) - u) * mu


def axial_rope_tables(n):
    t = jnp.arange(n, dtype=jnp.int32)
    pos = jnp.stack([t // GRID_W, t % GRID_W], axis=-1).astype(jnp.float32)
    inv_freq = ROPE_THETA ** (-jnp.arange(ROPE_FREQS, dtype=jnp.float32) / ROPE_FREQS)
    ang = pos[:, :, None] * inv_freq
    return jnp.cos(ang), jnp.sin(ang)


def apply_axial_rope(x, cos, sin):
    xs = x.astype(jnp.float32).reshape(x.shape[:-1] + (2, 2, ROPE_FREQS))
    x1, x2 = xs[..., 0, :], xs[..., 1, :]
    c, s = cos[None, :, None], sin[None, :, None]
    y = jnp.stack([x1 * c - x2 * s, x2 * c + x1 * s], axis=-2)
    return y.reshape(x.shape).astype(x.dtype)


def softmax_f32(s):
    return jax.nn.softmax(s.astype(jnp.float32), axis=-1)


def dense_gqa(q, k, v):
    s = jnp.einsum('bqhgd,bkhd->bhgqk', q, k) * (q.shape[-1] ** -0.5)
    p = softmax_f32(s).astype(v.dtype)
    return jnp.einsum('bhgqk,bkhd->bqhgd', p, v)


def blockwise_gqa(q, k, v, k_ctx, v_ctx):
    b, n, hk, g, dh = q.shape
    scale = dh ** -0.5

    def block(q_blk):
        s = jnp.concatenate([jnp.einsum('bqhgd,bkhd->bhgqk', q_blk, k),
                             jnp.einsum('bqhgd,bkhd->bhgqk', q_blk, k_ctx)], axis=-1) * scale
        p = softmax_f32(s).astype(v.dtype)
        return (jnp.einsum('bhgqk,bkhd->bqhgd', p[..., :n], v)
                + jnp.einsum('bhgqk,bkhd->bqhgd', p[..., n:], v_ctx))

    q_blocks = jnp.moveaxis(q.reshape(b, n // Q_BLOCK, Q_BLOCK, hk, g, dh), 1, 0)
    out = lax.map(block, q_blocks)
    return jnp.moveaxis(out, 0, 1).reshape(b, n, hk, g, dh)


def neighbourhood_layout(n, rows):
    kh, kw = min(NA_WIN_ROWS, rows), NA_WIN_COLS
    t = jnp.arange(n, dtype=jnp.int32)
    q_row, q_col = t // GRID_W, t % GRID_W
    row0 = jnp.clip(q_row - kh // 2, 0, rows - kh)
    col0 = jnp.clip(q_col - kw // 2, 0, GRID_W - kw)
    k_row = row0[:, None, None] + jnp.arange(kh, dtype=jnp.int32)[None, :, None]
    k_col = col0[:, None, None] + jnp.arange(kw, dtype=jnp.int32)[None, None, :]
    shape = (n, kh, kw)
    idx = jnp.broadcast_to(k_row * GRID_W + k_col, shape).reshape(n, kh * kw)
    rel_r = jnp.broadcast_to(k_row - q_row[:, None, None] + NA_WIN_ROWS - 1, shape).reshape(n, kh * kw)
    rel_c = jnp.broadcast_to(k_col - q_col[:, None, None] + NA_WIN_COLS - 1, shape).reshape(n, kh * kw)
    return idx, rel_r, rel_c


def neighbourhood_attention(q, k, v, k_ctx, v_ctx, rpb, rows):
    b, n, h, dh = q.shape
    idx, rel_r, rel_c = neighbourhood_layout(n, rows)
    n_win = idx.shape[-1]
    nblk = n // Q_BLOCK
    scale = dh ** -0.5

    def block(args):
        q_blk, idx_blk, rr_blk, rc_blk = args
        k_win = jnp.take(k, idx_blk, axis=1)
        v_win = jnp.take(v, idx_blk, axis=1)
        s_win = jnp.einsum('bqhd,bqkhd->bhqk', q_blk, k_win) * scale + rpb[:, rr_blk, rc_blk][None]
        s_ctx = jnp.einsum('bqhd,bkhd->bhqk', q_blk, k_ctx) * scale
        p = softmax_f32(jnp.concatenate([s_win, s_ctx], axis=-1)).astype(v.dtype)
        return (jnp.einsum('bhqk,bqkhd->bqhd', p[..., :n_win], v_win)
                + jnp.einsum('bhqk,bkhd->bqhd', p[..., n_win:], v_ctx))

    xs = (jnp.moveaxis(q.reshape(b, nblk, Q_BLOCK, h, dh), 1, 0),
          idx.reshape(nblk, Q_BLOCK, n_win),
          rel_r.reshape(nblk, Q_BLOCK, n_win),
          rel_c.reshape(nblk, Q_BLOCK, n_win))
    out = lax.map(block, xs)
    return jnp.moveaxis(out, 0, 1).reshape(b, n, h, dh)


def rwkv_features(u, w0, w_up, a0, a_up, k_k, k_a):
    r, k, v, dw_f, dw_b, da_f, da_b = split_cols(u, RWKV_SPLITS)
    kk = to_heads(k * k_k, RWKV_HEADS).astype(jnp.float32)
    kk = kk * lax.rsqrt(jnp.sum(kk * kk, axis=-1, keepdims=True) + 1e-12)
    dirs = []
    for d, (dw, da) in enumerate(((dw_f, da_f), (dw_b, da_b))):
        w_log = -jax.nn.softplus(-(w0[d] + jnp.tanh(dw) @ w_up[d])) - 0.5
        decay = jnp.exp(-jnp.exp(w_log.astype(jnp.float32)))
        a = jax.nn.sigmoid(a0[d] + da @ a_up[d])
        k_d = k * (1 + (a - 1) * k_a)
        dirs.append((to_heads(decay, RWKV_HEADS), to_heads(k_d, RWKV_HEADS), kk * to_heads(a, RWKV_HEADS)))
    return to_heads(r, RWKV_HEADS), to_heads(v, RWKV_HEADS), kk, dirs


def wkv_scan(s0, r, decay, k, v, kk, b, reverse, emit):
    xs = tuple(jnp.moveaxis(t, 1, 0) for t in (r, decay, k, v, kk, b))

    def step(s, inp):
        r_t, w_t, k_t, v_t, kk_t, b_t = inp
        sa = jnp.einsum('bhij,bhj->bhi', s, kk_t)
        s = s * w_t[:, :, None, :] - sa[..., None] * b_t[:, :, None, :] + v_t[..., None] * k_t[:, :, None, :]
        y = jnp.einsum('bhij,bhj->bhi', s, r_t) if emit else None
        return s, y

    s_final, ys = lax.scan(step, s0, xs, reverse=reverse)
    return s_final, (jnp.moveaxis(ys, 0, 1) if emit else None)


def rwkv_readout(y, r, k_bonus, v, r_k, gn_w, gn_b):
    yf = y.astype(jnp.float32)
    mean = jnp.mean(yf, axis=-1, keepdims=True)
    var = jnp.mean(jnp.square(yf - mean), axis=-1, keepdims=True)
    yn = ((yf - mean) * lax.rsqrt(var + RWKV_GN_EPS)).reshape(y.shape[:2] + (BRANCH_W,))
    yn = (yn * gn_w + gn_b).astype(v.dtype)
    bonus = jnp.sum(r * k_bonus * r_k, axis=-1, keepdims=True) * v
    return yn + bonus.reshape(yn.shape)


def rwkv_branch(u_lat, u_ctx, mu, w0, w_up, a0, a_up, k_k, k_a, r_k, gn_w, gn_b, ctx_out):
    r, v, kk, dirs = rwkv_features(centred_token_shift(u_lat, mu), w0, w_up, a0, a_up, k_k, k_a)
    rc, vc, kkc, dirs_c = rwkv_features(centred_token_shift(u_ctx, mu), w0, w_up, a0, a_up, k_k, k_a)
    s0 = jnp.zeros((u_lat.shape[0], RWKV_HEADS, HEAD_DIM, HEAD_DIM), jnp.float32)
    y_lat, y_ctx = [], []
    for d in range(2):
        reverse = d == 1
        decay_c, k_c, b_c = dirs_c[d]
        s_ctx, yc = wkv_scan(s0, rc, decay_c, k_c, vc, kkc, b_c, reverse, ctx_out)
        decay_l, k_l, b_l = dirs[d]
        _, yl = wkv_scan(s_ctx, r, decay_l, k_l, v, kk, b_l, reverse, True)
        y_lat.append(yl)
        y_ctx.append(yc)
    out_lat = rwkv_readout(y_lat[0] + y_lat[1], r, 0.5 * (dirs[0][1] + dirs[1][1]), v, r_k, gn_w, gn_b)
    out_ctx = None
    if ctx_out:
        out_ctx = rwkv_readout(y_ctx[0] + y_ctx[1], rc, 0.5 * (dirs_c[0][1] + dirs_c[1][1]), vc, r_k, gn_w, gn_b)
    return out_lat, out_ctx


def hyena_filters(L, w1, b1, w2, b2, w3, b3):
    t_idx = jnp.arange(L, dtype=jnp.float32)
    t = t_idx / max(L - 1, 1)
    bands = jnp.linspace(1e-4, HY_POS_BANDS - 1, HY_POS_BANDS, dtype=jnp.float32)
    ang = 2.0 * math.pi * bands[None, :] * t_idx[:, None] / L
    feats = jnp.concatenate([t[:, None], jnp.cos(ang), -jnp.sin(ang)], axis=-1)
    hid = jnp.sin(feats @ w1 + b1)
    hid = jnp.sin(hid @ w2 + b2)
    taps = (hid @ w3 + b3).reshape(L, 2, HY_ORDER, HY_WIDTH)
    deltas = jnp.linspace(math.log(HY_DECAY_TARGET) / HY_FAST_DECAY_PCT,
                          math.log(HY_DECAY_TARGET) / HY_SLOW_DECAY_PCT, HY_WIDTH, dtype=jnp.float32)
    window = jnp.exp(-t[:, None] * jnp.abs(deltas))
    taps = taps * window[:, None, None, :]
    fwd, bwd = taps[:, 0], taps[:, 1]
    kern = jnp.concatenate([fwd[:1] + bwd[:1], fwd[1:], jnp.zeros_like(fwd[:1]), bwd[:0:-1]], axis=0)
    kern = kern.astype(jnp.float32)
    return kern * lax.rsqrt(jnp.sum(kern * kern, axis=0, keepdims=True))


def fft_long_conv(z, kern, skip):
    L = z.shape[1]
    zf = jnp.fft.rfft(z.astype(jnp.float32), n=2 * L, axis=1)
    kf = jnp.fft.rfft(kern, n=2 * L, axis=0)
    y = jnp.fft.irfft(zf * kf[None], n=2 * L, axis=1)[:, :L]
    return (y + z * skip).astype(z.dtype)


def hyena_operator(u, short_taps, kern, skip):
    v, x1, x2 = split_cols(centred_conv3(u, short_taps), (HY_WIDTH, HY_WIDTH, HY_WIDTH))
    z = v
    for o, gate in enumerate((x1, x2)):
        z = gate * fft_long_conv(z, kern[:, o], skip[o])
    return z


def attn_layer(x, ctx, c, c_ctx, norm_g, ada_w, ada_b, w_in, rpb, q_gain, k_gain, w_out, cos, sin, rows, ctx_out):
    b, n, _ = x.shape
    lc = ctx.shape[1]
    shift, scale, gate = adaln(c, ada_w, ada_b)
    shift_c, scale_c, gate_c = adaln(c_ctx, ada_w, ada_b)
    u = modulate(x, norm_g, shift[:, None], scale[:, None]) @ w_in
    uc = modulate(ctx, norm_g, shift_c, scale_c) @ w_in
    qa, ka, va, ga, qb, kb, vb, gb = split_cols(u, ATTN_SPLITS)
    qa_c, ka_c, va_c, ga_c, qb_c, kb_c, vb_c, gb_c = split_cols(uc, ATTN_SPLITS)
    ka_c, va_c = to_heads(ka_c, NA_HEADS), to_heads(va_c, NA_HEADS)
    o_a = neighbourhood_attention(to_heads(qa, NA_HEADS), to_heads(ka, NA_HEADS), to_heads(va, NA_HEADS),
                                  ka_c, va_c, rpb, rows)
    kb_c = rms_norm(to_heads(kb_c, GQA_KV_HEADS), k_gain)
    vb_c = to_heads(vb_c, GQA_KV_HEADS)
    q_lat = apply_axial_rope(rms_norm(to_heads(qb, GQA_HEADS), q_gain), cos, sin)
    q_lat = q_lat.reshape(b, n, GQA_KV_HEADS, GQA_GROUP, HEAD_DIM)
    k_lat = apply_axial_rope(rms_norm(to_heads(kb, GQA_KV_HEADS), k_gain), cos, sin)
    o_b = blockwise_gqa(q_lat, k_lat, to_heads(vb, GQA_KV_HEADS), kb_c, vb_c)
    y = jnp.concatenate([o_a.reshape(b, n, BRANCH_W) * jax.nn.silu(ga),
                         o_b.reshape(b, n, BRANCH_W) * jax.nn.silu(gb)], axis=-1) @ w_out
    x = x + gate[:, None] * y
    if ctx_out:
        oa_c = dense_gqa(to_heads(qa_c, NA_HEADS)[:, :, :, None], ka_c, va_c)
        qb_c = rms_norm(to_heads(qb_c, GQA_HEADS), q_gain).reshape(b, lc, GQA_KV_HEADS, GQA_GROUP, HEAD_DIM)
        ob_c = dense_gqa(qb_c, kb_c, vb_c)
        yc = jnp.concatenate([oa_c.reshape(b, lc, BRANCH_W) * jax.nn.silu(ga_c),
                              ob_c.reshape(b, lc, BRANCH_W) * jax.nn.silu(gb_c)], axis=-1) @ w_out
        ctx = ctx + gate_c * yc
    return x, ctx


def rec_layer(x, ctx, c, c_ctx, norm_g, ada_w, ada_b, w_in, mu, w0, w_up, a0, a_up, k_k, k_a, r_k, gn_w, gn_b,
              hy_short, hy_w1, hy_b1, hy_w2, hy_b2, hy_w3, hy_b3, hy_skip, w_out, ctx_out):
    shift, scale, gate = adaln(c, ada_w, ada_b)
    shift_c, scale_c, gate_c = adaln(c_ctx, ada_w, ada_b)
    u = modulate(x, norm_g, shift[:, None], scale[:, None]) @ w_in
    uc = modulate(ctx, norm_g, shift_c, scale_c) @ w_in
    u_rw, g_rw, u_hy, g_hy = split_cols(u, REC_SPLITS)
    uc_rw, gc_rw, uc_hy, gc_hy = split_cols(uc, REC_SPLITS)
    y_rw, yc_rw = rwkv_branch(u_rw, uc_rw, mu, w0, w_up, a0, a_up, k_k, k_a, r_k, gn_w, gn_b, ctx_out)
    y_hy = hyena_operator(u_hy, hy_short, hyena_filters(x.shape[1], hy_w1, hy_b1, hy_w2, hy_b2, hy_w3, hy_b3), hy_skip)
    y = jnp.concatenate([y_rw * jax.nn.silu(g_rw), y_hy * jax.nn.silu(g_hy)], axis=-1) @ w_out
    x = x + gate[:, None] * y
    if ctx_out:
        kern_c = hyena_filters(ctx.shape[1], hy_w1, hy_b1, hy_w2, hy_b2, hy_w3, hy_b3)
        yc_hy = hyena_operator(uc_hy, hy_short, kern_c, hy_skip)
        yc = jnp.concatenate([yc_rw * jax.nn.silu(gc_rw), yc_hy * jax.nn.silu(gc_hy)], axis=-1) @ w_out
        ctx = ctx + gate_c * yc
    return x, ctx


def setup_inputs(seed: int = 0) -> dict:
    key = jax.random.key(seed)
    keys = iter(jax.random.split(key, 48))

    def normal(shape, scale=1.0):
        return scale * jax.random.normal(next(keys), shape, jnp.float32)

    na, nr, d = N_ATTN_LAYERS, N_REC_LAYERS, D_MODEL
    return {
        "x": normal((BATCH, SEQ, d)),
        "c": normal((BATCH, d)),
        "ctx": normal((BATCH, CTX_LEN, d)),
        "c_ctx": normal((d,)),
        "attn_norm": 1.0 + normal((na, d), 0.1),
        "attn_ada_w": normal((na, d, 3 * d), d ** -0.5),
        "attn_ada_b": normal((na, 3 * d), 0.1),
        "attn_w_in": normal((na, d, ATTN_IN), d ** -0.5),
        "na_rpb": normal((na, NA_HEADS, 2 * NA_WIN_ROWS - 1, 2 * NA_WIN_COLS - 1), 0.5),
        "gqa_q_gain": 1.0 + normal((na, HEAD_DIM), 0.1),
        "gqa_k_gain": 1.0 + normal((na, HEAD_DIM), 0.1),
        "attn_w_out": normal((na, MIX_W, d), MIX_W ** -0.5),
        "rec_norm": 1.0 + normal((nr, d), 0.1),
        "rec_ada_w": normal((nr, d, 3 * d), d ** -0.5),
        "rec_ada_b": normal((nr, 3 * d), 0.1),
        "rec_w_in": normal((nr, d, REC_IN), d ** -0.5),
        "rwkv_mu": jax.random.uniform(next(keys), (nr, RWKV_SHIFT_W), jnp.float32),
        "rwkv_w0": jnp.linspace(-6.0, -0.5, BRANCH_W, dtype=jnp.float32) + normal((nr, 2, BRANCH_W), 0.1),
        "rwkv_w_up": normal((nr, 2, DECAY_LORA, BRANCH_W), 0.1),
        "rwkv_a0": normal((nr, 2, BRANCH_W), 0.5),
        "rwkv_a_up": normal((nr, 2, ICLR_LORA, BRANCH_W), ICLR_LORA ** -0.5),
        "rwkv_k_k": 0.85 + normal((nr, BRANCH_W), 0.05),
        "rwkv_k_a": 1.0 + normal((nr, BRANCH_W), 0.05),
        "rwkv_r_k": normal((nr, RWKV_HEADS, HEAD_DIM), 0.1),
        "rwkv_gn_w": 1.0 + normal((nr, BRANCH_W), 0.1),
        "rwkv_gn_b": normal((nr, BRANCH_W), 0.1),
        "hy_short": normal((nr, 3, HY_IN_W), 3 ** -0.5),
        "hy_w1": normal((nr, HY_POS_DIM, HY_FILTER_HIDDEN), HY_POS_DIM ** -0.5),
        "hy_b1": normal((nr, HY_FILTER_HIDDEN), 0.1),
        "hy_w2": normal((nr, HY_FILTER_HIDDEN, HY_FILTER_HIDDEN), HY_FILTER_HIDDEN ** -0.5),
        "hy_b2": normal((nr, HY_FILTER_HIDDEN), 0.1),
        "hy_w3": normal((nr, HY_FILTER_HIDDEN, 2 * HY_ORDER * HY_WIDTH), HY_FILTER_HIDDEN ** -0.5),
        "hy_b3": normal((nr, 2 * HY_ORDER * HY_WIDTH), 0.1),
        "hy_skip": normal((nr, HY_ORDER, HY_WIDTH), 0.5),
        "rec_w_out": normal((nr, MIX_W, d), MIX_W ** -0.5),
        "final_norm": 1.0 + normal((d,), 0.1),
    }


def reference(x, c, ctx, c_ctx, attn_norm, attn_ada_w, attn_ada_b, attn_w_in, na_rpb, gqa_q_gain, gqa_k_gain,
              attn_w_out, rec_norm, rec_ada_w, rec_ada_b, rec_w_in, rwkv_mu, rwkv_w0, rwkv_w_up, rwkv_a0, rwkv_a_up,
              rwkv_k_k, rwkv_k_a, rwkv_r_k, rwkv_gn_w, rwkv_gn_b, hy_short, hy_w1, hy_b1, hy_w2, hy_b2, hy_w3, hy_b3,
              hy_skip, rec_w_out, final_norm):
    n = x.shape[1]
    rows = n // GRID_W
    cos, sin = axial_rope_tables(n)
    for layer in range(DEPTH):
        i = layer // 2
        ctx_out = layer < DEPTH - 1
        if layer % 2 == 0:
            x, ctx = attn_layer(x, ctx, c, c_ctx, attn_norm[i], attn_ada_w[i], attn_ada_b[i], attn_w_in[i],
                                na_rpb[i], gqa_q_gain[i], gqa_k_gain[i], attn_w_out[i], cos, sin, rows, ctx_out)
        else:
            x, ctx = rec_layer(x, ctx, c, c_ctx, rec_norm[i], rec_ada_w[i], rec_ada_b[i], rec_w_in[i],
                               rwkv_mu[i], rwkv_w0[i], rwkv_w_up[i], rwkv_a0[i], rwkv_a_up[i], rwkv_k_k[i],
                               rwkv_k_a[i], rwkv_r_k[i], rwkv_gn_w[i], rwkv_gn_b[i], hy_short[i], hy_w1[i],
                               hy_b1[i], hy_w2[i], hy_b2[i], hy_w3[i], hy_b3[i], hy_skip[i], rec_w_out[i], ctx_out)
    return rms_norm(x, final_norm)
```

```cpp
#ifndef EMU
#include <hip/hip_runtime.h>
#endif
#include <cstdio>
#include <cstdint>
#include <cmath>

constexpr int DM = 1024, NLAT = 16384, NCTX = 256, NTOK = NLAT + NCTX;
constexpr int GRIDW = 64, GRIDH = 256;
constexpr int AIN = 3328;
constexpr int RIN = 4224, RINP = 4352;
constexpr int URW_W = 2176;
constexpr int UHY_W = 1536;
constexpr int NWAVES = 8, NTHREADS = 512;
constexpr float C2 = 0.125f * 1.4426950408889634f;
constexpr float LOG2E = 1.4426950408889634f;
constexpr float NORM_EPS = 1e-6f;

typedef unsigned short bf16_t;

constexpr size_t MiB = 1u << 20;
constexpr size_t WS_CTL = 0, CTL_ZERO_BYTES = 64 * 1024;
constexpr size_t WS_ADA = 1 * MiB;
constexpr size_t WS_TW = WS_ADA + 128 * 1024;
constexpr size_t WS_HID256 = WS_TW + 160 * 1024;
constexpr size_t WS_BONUS = WS_HID256 + 64 * 1024;
constexpr size_t WS_XCTX = 3 * MiB;
constexpr size_t WS_VXC = 4 * MiB;
constexpr size_t WS_HID = 6 * MiB;
constexpr size_t WS_WAIN = 14 * MiB;
constexpr size_t WS_WAOUT = 27 * MiB;
constexpr size_t WS_WRIN = 31 * MiB;
constexpr size_t WS_WROUT = 48 * MiB;
constexpr size_t WS_XN = 52 * MiB;
constexpr size_t WS_U = 85 * MiB;
constexpr size_t WS_UHY = 155 * MiB;
constexpr size_t WS_GHY = 204 * MiB;
constexpr size_t WS_VX0 = 52 * MiB, WS_VX1 = 68 * MiB;
constexpr size_t WS_VX2 = 221 * MiB;
constexpr size_t WS_YHY = 155 * MiB;
constexpr size_t WS_YB = 171 * MiB;
constexpr size_t WS_YF = 187 * MiB + 512 * 1024;
constexpr size_t WS_HYOUT = 238 * MiB;
constexpr size_t WS_END = 256 * MiB;
static_assert(WS_U + (size_t)NTOK * AIN * 2 <= WS_END, "U attn");
static_assert(WS_U + (size_t)NTOK * URW_W * 2 <= WS_UHY && WS_UHY + (size_t)NTOK * UHY_W * 2 <= WS_GHY && WS_GHY + (size_t)NTOK * 512 * 2 <= WS_VX2, "rec map 1");
static_assert(WS_VX2 + (size_t)512 * 16384 * 2 <= WS_HYOUT && WS_HYOUT + (size_t)NTOK * 512 * 2 <= WS_END, "rec map 2");
static_assert(WS_YHY + (size_t)512 * 16384 * 2 <= WS_YB && WS_YB + (size_t)NTOK * 512 * 2 <= WS_YF && WS_YF + (size_t)NTOK * 512 * 2 <= WS_GHY, "rec map 3");
static_assert(WS_XN + (size_t)NTOK * DM * 2 <= WS_U && WS_VX1 + (size_t)512 * 16384 * 2 <= WS_U, "xn map");

constexpr int LDS_BYTES = 160 * 1024;
constexpr int MISC_OFF = LDS_BYTES - 256;
constexpr int RING_BYTES = MISC_OFF;

#ifdef EMU
#define DEVFN inline
#else
#define DEVFN __device__ __forceinline__
#endif

DEVFN float bf2f(bf16_t h) { union { unsigned u; float f; } x; x.u = ((unsigned)h) << 16; return x.f; }
DEVFN unsigned f2bf(float f) { union { unsigned u; float f; } x; x.f = f; unsigned u = x.u; return (u + 0x7fffu + ((u >> 16) & 1u)) >> 16; }
DEVFN unsigned pk2(float lo, float hi) { return f2bf(lo) | (f2bf(hi) << 16); }
DEVFN float bflo(unsigned w) { union { unsigned u; float f; } x; x.u = w << 16; return x.f; }
DEVFN float bfhi(unsigned w) { union { unsigned u; float f; } x; x.u = w & 0xffff0000u; return x.f; }
struct U4 { unsigned x, y, z, w; };
struct U2 { unsigned x, y; };
struct F2 { float x, y; };
struct F4 { float x, y, z, w; };
DEVFN float silu_f(float v) { return v / (1.0f + expf(-v)); }
DEVFN float sigmoid_f(float v) { return 1.0f / (1.0f + expf(-v)); }
#ifndef EMU
#define UNR _Pragma("unroll")
#define UNR1 _Pragma("unroll 1")
#define CFENCE() asm volatile("" ::: "memory")
#define OPAQUE(x) asm volatile("" : "+v"(x))
#define SYNC() __syncthreads()
#define WAVE_SYNC() do { asm volatile("s_waitcnt lgkmcnt(0)" ::: "memory"); __builtin_amdgcn_wave_barrier(); } while (0)
DEVFN float shfl_xor_f(float v, int m) { return __shfl_xor(v, m); }
DEVFN float shfl_f(float v, int src) { return __shfl(v, src); }
DEVFN void sincospi_f(float x, float* s, float* c) { sincospif(x, s, c); }
#endif

enum InIdx { I_X = 0, I_C, I_CTX, I_CCTX, I_ANORM, I_AADAW, I_AADAB, I_AWIN, I_RPB, I_QG, I_KG, I_AWOUT, I_RNORM, I_RADAW, I_RADAB, I_RWIN, I_MU, I_W0, I_WUP, I_A0, I_AUP,
             I_KK, I_KA, I_RK, I_GNW, I_GNB, I_HSHORT, I_HW1, I_HB1, I_HW2, I_HB2, I_HW3, I_HB3, I_HSKIP, I_RWOUT, I_FNORM, N_IN };

struct Ctx {
    const float* in[N_IN]; float* out; unsigned char* ws;
    int tid, lane, wave, vcu, G;
};

DEVFN float wave_sum(float v) { for (int o = 1; o < 64; o <<= 1) v += shfl_xor_f(v, o); return v; }

DEVFN U4 ld16(const void* p) { return *(const U4*)p; }
DEVFN void st16(void* p, U4 v) { *(U4*)p = v; }
DEVFN void unpack8(U4 w, float* f) { f[0] = bflo(w.x); f[1] = bfhi(w.x); f[2] = bflo(w.y); f[3] = bfhi(w.y); f[4] = bflo(w.z); f[5] = bfhi(w.z); f[6] = bflo(w.w); f[7] = bfhi(w.w); }
DEVFN U4 pack8(const float* f) { U4 w; w.x = pk2(f[0], f[1]); w.y = pk2(f[2], f[3]); w.z = pk2(f[4], f[5]); w.w = pk2(f[6], f[7]); return w; }

DEVFN void p0_transpose_item(const float* W, int K, int N, bf16_t* WT, float* scr, int item, int lane) {
    const int nblk = N / 32, kb = item / nblk, nb = item % nblk, k0 = 64 * kb, n0 = 32 * nb;
    UNR for (int i = 0; i < 32; ++i) { const int kk = 2 * i + (lane >> 5); scr[kk * 33 + (lane & 31)] = W[(size_t)(k0 + kk) * N + n0 + (lane & 31)]; }
    WAVE_SYNC();
    const int c = lane & 7;
    UNR for (int j = 0; j < 4; ++j) { const int n = (lane >> 3) + 8 * j; const float* s = scr + (8 * c) * 33 + n;
        U4 o; o.x = pk2(s[0 * 33], s[1 * 33]); o.y = pk2(s[2 * 33], s[3 * 33]); o.z = pk2(s[4 * 33], s[5 * 33]); o.w = pk2(s[6 * 33], s[7 * 33]);
        st16(WT + (size_t)(n0 + n) * K + k0 + 8 * c, o); }
    WAVE_SYNC();
}

DEVFN void hid_rows(const float* w1, const float* b1, const float* w2, const float* b2, float* hid, int L, int gw, int NGW, int lane) {
    float w1c[33], w2c[64];
    UNR for (int i = 0; i < 33; ++i) w1c[i] = w1[i * 64 + lane];
    UNR for (int i = 0; i < 64; ++i) w2c[i] = w2[i * 64 + lane];
    const float bb1 = b1[lane], bb2 = b2[lane];
    for (int t = gw; t < L; t += NGW) {
        float feat = 0.f;
        if (lane == 0) feat = (float)t / (float)(L - 1 > 1 ? L - 1 : 1);
        else if (lane < 33) { const int b = (lane - 1) & 15; const float band = 1e-4f + (float)b * ((15.0f - 1e-4f) / 15.0f);
            const float x = 2.0f * band * (float)t / (float)L; float s, c; sincospi_f(x, &s, &c); feat = (lane <= 16) ? c : -s; }
        float a = bb1;
        UNR for (int i = 0; i < 33; ++i) a += shfl_f(feat, i) * w1c[i];
        const float h1 = sinf(a);
        float b = bb2;
        UNR for (int i = 0; i < 64; ++i) b += shfl_f(h1, i) * w2c[i];
        hid[(size_t)t * 64 + lane] = sinf(b);
    }
}

DEVFN void ph_prologue(const Ctx& C, unsigned char* lds) {
    const int gw = C.vcu * NWAVES + C.wave, NGW = C.G * NWAVES, lane = C.lane;
    float* scr = (float*)(lds + C.wave * 16384);
    {
        constexpr int I_AIN = 16 * (AIN / 32), I_OUT = 16 * 32, I_RIN = 16 * (RIN / 32);
        constexpr int NIT = 2 * (I_AIN + I_OUT + I_RIN + I_OUT);
        for (int it = gw; it < NIT; it += NGW) {
            int r = it; const int li = r & 1; r >>= 1;
            if (r < I_AIN) { p0_transpose_item(C.in[I_AWIN] + (size_t)li * DM * AIN, DM, AIN, (bf16_t*)(C.ws + WS_WAIN) + (size_t)li * AIN * DM, scr, r, lane); continue; } r -= I_AIN;
            if (r < I_OUT) { p0_transpose_item(C.in[I_AWOUT] + (size_t)li * DM * DM, DM, DM, (bf16_t*)(C.ws + WS_WAOUT) + (size_t)li * DM * DM, scr, r, lane); continue; } r -= I_OUT;
            if (r < I_RIN) { p0_transpose_item(C.in[I_RWIN] + (size_t)li * DM * RIN, DM, RIN, (bf16_t*)(C.ws + WS_WRIN) + (size_t)li * RINP * DM, scr, r, lane); continue; } r -= I_RIN;
            p0_transpose_item(C.in[I_RWOUT] + (size_t)li * DM * DM, DM, DM, (bf16_t*)(C.ws + WS_WROUT) + (size_t)li * DM * DM, scr, r, lane);
        }
        for (int e = gw * 64 + lane; e < 2 * (RINP - RIN) * DM / 8; e += NGW * 64) { const int li = e / ((RINP - RIN) * DM / 8), o = e % ((RINP - RIN) * DM / 8);
            U4 z; z.x = z.y = z.z = z.w = 0u; st16((bf16_t*)(C.ws + WS_WRIN) + (size_t)li * RINP * DM + (size_t)RIN * DM + (size_t)o * 8, z); }
    }
    {
        float* ADA = (float*)(C.ws + WS_ADA);
        for (int it = gw; it < 4 * 48; it += NGW) {
            const int layer = it / 48, cb = it % 48, col = cb * 64 + lane, i = layer >> 1;
            const float* W = (layer & 1) ? C.in[I_RADAW] + (size_t)i * DM * 3072 : C.in[I_AADAW] + (size_t)i * DM * 3072;
            const float* B = (layer & 1) ? C.in[I_RADAB] + (size_t)i * 3072 : C.in[I_AADAB] + (size_t)i * 3072;
            float a0 = 0.f, a1 = 0.f;
            for (int k0 = 0; k0 < DM; k0 += 64) {
                const float sc = silu_f(C.in[I_C][k0 + lane]), sx = silu_f(C.in[I_CCTX][k0 + lane]);
                for (int k = 0; k < 64; ++k) { const float w = W[(size_t)(k0 + k) * 3072 + col]; a0 += shfl_f(sc, k) * w; a1 += shfl_f(sx, k) * w; }
            }
            ADA[(size_t)(layer * 2 + 0) * 3072 + col] = a0 + B[col];
            ADA[(size_t)(layer * 2 + 1) * 3072 + col] = a1 + B[col];
        }
    }
    for (int i = 0; i < 2; ++i)
        hid_rows(C.in[I_HW1] + (size_t)i * 33 * 64, C.in[I_HB1] + i * 64, C.in[I_HW2] + (size_t)i * 64 * 64, C.in[I_HB2] + i * 64, (float*)(C.ws + WS_HID) + (size_t)i * NLAT * 64, NLAT, gw, NGW, lane);
    hid_rows(C.in[I_HW1], C.in[I_HB1], C.in[I_HW2], C.in[I_HB2], (float*)(C.ws + WS_HID256), NCTX, gw, NGW, lane);
    { F2* TW = (F2*)(C.ws + WS_TW);
      for (int k = gw * 64 + lane; k <= 16384; k += NGW * 64) { float s, c; sincospi_f((float)k * (1.0f / 16384.0f), &s, &c); F2 w; w.x = c; w.y = -s; TW[k] = w; } }
}

DEVFN void ph_norm(const Ctx& C, int layer, const float* xlat, const float* xctx, bool do_ctx) {
    const int gw = C.vcu * NWAVES + C.wave, NGW = C.G * NWAVES, lane = C.lane, i = layer >> 1;
    const float* gain = ((layer & 1) ? C.in[I_RNORM] : C.in[I_ANORM]) + (size_t)i * DM;
    const float* ADA = (const float*)(C.ws + WS_ADA) + (size_t)layer * 2 * 3072;
    bf16_t* XN = (bf16_t*)(C.ws + WS_XN);
    const int nrows = do_ctx ? NTOK : NLAT;
    for (int m = gw; m < nrows; m += NGW) {
        const bool isctx = m >= NLAT;
        const float* xr = isctx ? xctx + (size_t)(m - NLAT) * DM : xlat + (size_t)m * DM;
        const float* ada = ADA + (isctx ? 3072 : 0);
        F4 v[4]; float s = 0.f;
        UNR for (int j = 0; j < 4; ++j) { v[j] = *(const F4*)(xr + 256 * j + 4 * lane); s += (v[j].x * v[j].x + v[j].y * v[j].y) + (v[j].z * v[j].z + v[j].w * v[j].w); }
        const float rs = 1.0f / sqrtf(wave_sum(s) * (1.0f / DM) + NORM_EPS);
        UNR for (int j = 0; j < 4; ++j) { const int c0 = 256 * j + 4 * lane;
            const F4 g = *(const F4*)(gain + c0), sh = *(const F4*)(ada + c0), sc = *(const F4*)(ada + 1024 + c0);
            U2 o; o.x = pk2(v[j].x * rs * g.x * (1.f + sc.x) + sh.x, v[j].y * rs * g.y * (1.f + sc.y) + sh.y);
            o.y = pk2(v[j].z * rs * g.z * (1.f + sc.z) + sh.z, v[j].w * rs * g.w * (1.f + sc.w) + sh.w);
            *(U2*)(XN + (size_t)m * DM + c0) = o; }
    }
}

DEVFN void ph_final(const Ctx& C) {
    const int gw = C.vcu * NWAVES + C.wave, NGW = C.G * NWAVES, lane = C.lane;
    const float* gain = C.in[I_FNORM];
    for (int m = gw; m < NLAT; m += NGW) {
        float* xr = C.out + (size_t)m * DM;
        F4 v[4]; float s = 0.f;
        UNR for (int j = 0; j < 4; ++j) { v[j] = *(const F4*)(xr + 256 * j + 4 * lane); s += (v[j].x * v[j].x + v[j].y * v[j].y) + (v[j].z * v[j].z + v[j].w * v[j].w); }
        const float rs = 1.0f / sqrtf(wave_sum(s) * (1.0f / DM) + NORM_EPS);
        UNR for (int j = 0; j < 4; ++j) { const int c0 = 256 * j + 4 * lane; const F4 g = *(const F4*)(gain + c0);
            F4 o; o.x = v[j].x * rs * g.x; o.y = v[j].y * rs * g.y; o.z = v[j].z * rs * g.z; o.w = v[j].w * rs * g.w; *(F4*)(xr + c0) = o; }
    }
}

DEVFN void ph_qkprep(const Ctx& C, int i) {
    const int gw = C.vcu * NWAVES + C.wave, NGW = C.G * NWAVES, lane = C.lane;
    bf16_t* U = (bf16_t*)(C.ws + WS_U);
    const float qg = C.in[I_QG][i * 64 + lane], kg = C.in[I_KG][i * 64 + lane];
    const int axis = lane >> 5, half = (lane >> 4) & 1, f = lane & 15;
    const float invf = exp2f(-(float)f * (13.287712379549449f / 16.0f));
    for (int m = gw; m < NTOK; m += NGW) {
        float cs = 1.f, sn = 0.f;
        if (m < NLAT) { const float pos = (float)(axis == 0 ? (m >> 6) : (m & 63)); const float ang = pos * invf; cs = cosf(ang); sn = sinf(ang); }
        bf16_t* ur = U + (size_t)m * AIN + 2048;
        for (int h = 0; h < 10; ++h) {
            const float v = bf2f(ur[h * 64 + lane]);
            const float ss = wave_sum(v * v);
            float y = v * (1.0f / sqrtf(ss * (1.0f / 64.0f) + NORM_EPS)) * (h < 8 ? qg : kg);
            const float p = shfl_xor_f(y, 16);
            y = half == 0 ? y * cs - p * sn : y * cs + p * sn;
            if (h < 8) y *= C2;
            ur[h * 64 + lane] = (bf16_t)f2bf(y);
        }
    }
}

DEVFN void ph_hyprep(const Ctx& C, int i, bool do_ctx, unsigned char* lds) {
    const int tid = C.tid;
    const bf16_t* UHY = (const bf16_t*)(C.ws + WS_UHY);
    const float* taps = C.in[I_HSHORT] + (size_t)i * 3 * UHY_W;
    float* T = (float*)lds;
    const int ntile_lat = 3 * 8 * 256, ntile = ntile_lat + (do_ctx ? 3 * 8 * 4 : 0);
    for (int it = C.vcu; it < ntile; it += C.G) {
        const bool isctx = it >= ntile_lat; const int r = isctx ? it - ntile_lat : it;
        const int ntb = isctx ? 4 : 256; const int tb = r % ntb, cb = (r / ntb) & 7, g = r / (ntb * 8);
        const int seg0 = isctx ? NLAT : 0, segn = isctx ? NCTX : NLAT;
        {
            const int tl = tid >> 3, c8 = (tid & 7) * 8, t = 64 * tb + tl, col = g * 512 + 64 * cb + c8;
            float um[8], u0[8], up[8];
            unpack8(ld16(UHY + (size_t)(seg0 + t) * UHY_W + col), u0);
            if (t > 0) unpack8(ld16(UHY + (size_t)(seg0 + t - 1) * UHY_W + col), um); else UNR for (int e = 0; e < 8; ++e) um[e] = 0.f;
            if (t < segn - 1) unpack8(ld16(UHY + (size_t)(seg0 + t + 1) * UHY_W + col), up); else UNR for (int e = 0; e < 8; ++e) up[e] = 0.f;
            UNR for (int e = 0; e < 8; ++e) T[(c8 + e) * 65 + tl] = um[e] * taps[col + e] + u0[e] * taps[UHY_W + col + e] + up[e] * taps[2 * UHY_W + col + e];
        }
        SYNC();
        {
            const int cl = tid >> 3, t8 = (tid & 7) * 8, ch = 64 * cb + cl;
            float v[8]; UNR for (int e = 0; e < 8; ++e) v[e] = T[cl * 65 + t8 + e];
            if (!isctx) { bf16_t* VX = (bf16_t*)(C.ws + (g == 0 ? WS_VX0 : g == 1 ? WS_VX1 : WS_VX2)); st16(VX + (size_t)ch * NLAT + 64 * tb + t8, pack8(v)); }
            else { float* VXC = (float*)(C.ws + WS_VXC) + ((size_t)g * 512 + ch) * NCTX + 64 * tb + t8; UNR for (int e = 0; e < 8; ++e) VXC[e] = v[e]; }
        }
        SYNC();
    }
}

constexpr int FFT_N = 16384;
DEVFN int fidx(int n) { return n + (n >> 4); }
DEVFN F2 cmul(F2 a, F2 b) { F2 r; r.x = a.x * b.x - a.y * b.y; r.y = a.x * b.y + a.y * b.x; return r; }
DEVFN F2 cmulc(F2 a, F2 b) { F2 r; r.x = a.x * b.x + a.y * b.y; r.y = a.y * b.x - a.x * b.y; return r; }
DEVFN F2 cadd(F2 a, F2 b) { F2 r; r.x = a.x + b.x; r.y = a.y + b.y; return r; }
DEVFN F2 csub(F2 a, F2 b) { F2 r; r.x = a.x - b.x; r.y = a.y - b.y; return r; }
DEVFN F2 cconj(F2 a) { F2 r; r.x = a.x; r.y = -a.y; return r; }
template <bool INV> DEVFN F2 mul_mi(F2 a) { F2 r; if (!INV) { r.x = a.y; r.y = -a.x; } else { r.x = -a.y; r.y = a.x; } return r; }
template <bool INV> DEVFN void dft4(F2& a0, F2& a1, F2& a2, F2& a3) {
    const F2 s02 = cadd(a0, a2), d02 = csub(a0, a2), s13 = cadd(a1, a3), d13 = mul_mi<INV>(csub(a1, a3));
    a0 = cadd(s02, s13); a2 = csub(s02, s13); a1 = cadd(d02, d13); a3 = csub(d02, d13);
}
template <bool INV> DEVFN void dft16(F2* a) {
    UNR for (int n2 = 0; n2 < 4; ++n2) dft4<INV>(a[n2], a[4 + n2], a[8 + n2], a[12 + n2]);
    const float c1 = 0.92387953251128674f, s1 = 0.38268343236508977f, r2 = 0.70710678118654752f;
    const F2 w1 = {c1, INV ? s1 : -s1}, w2 = {r2, INV ? r2 : -r2}, w3 = {s1, INV ? c1 : -c1}, w6 = {-r2, INV ? r2 : -r2}, w9 = {-c1, INV ? -s1 : s1};
    a[4 * 1 + 1] = cmul(a[4 * 1 + 1], w1); a[4 * 1 + 2] = cmul(a[4 * 1 + 2], w2); a[4 * 1 + 3] = cmul(a[4 * 1 + 3], w3);
    a[4 * 2 + 1] = cmul(a[4 * 2 + 1], w2); a[4 * 2 + 2] = mul_mi<INV>(a[4 * 2 + 2]); a[4 * 2 + 3] = cmul(a[4 * 2 + 3], w6);
    a[4 * 3 + 1] = cmul(a[4 * 3 + 1], w3); a[4 * 3 + 2] = cmul(a[4 * 3 + 2], w6); a[4 * 3 + 3] = cmul(a[4 * 3 + 3], w9);
    F2 x[16];
    UNR for (int k1 = 0; k1 < 4; ++k1) { F2 b0 = a[4 * k1 + 0], b1 = a[4 * k1 + 1], b2 = a[4 * k1 + 2], b3 = a[4 * k1 + 3]; dft4<INV>(b0, b1, b2, b3); x[k1] = b0; x[k1 + 4] = b1; x[k1 + 8] = b2; x[k1 + 12] = b3; }
    UNR for (int q = 0; q < 16; ++q) a[q] = x[q];
}
template <int R, bool INV> DEVFN void fft_stage(F2* F, const F2* TW, int B, int tid) {
    const int S = B / R, NB = FFT_N / R, tws = 2 * (FFT_N / B);
    int tq = tid; OPAQUE(tq);
    UNR1 for (int q = tq; q < NB; q += NTHREADS) {
        const int blk = q / S, j = q - blk * S, base = blk * B + j;
        F2 a[R];
        UNR for (int m = 0; m < R; ++m) a[m] = F[fidx(base + m * S)];
        if (INV && S > 1) { const F2 w1 = TW[tws * j]; F2 w = w1; UNR for (int m = 1; m < R; ++m) { a[m] = cmulc(a[m], w); w = cmul(w, w1); } }
        if constexpr (R == 4) dft4<INV>(a[0], a[1], a[2], a[3]); else dft16<INV>(a);
        if (!INV && S > 1) { const F2 w1 = TW[tws * j]; F2 w = w1; UNR for (int m = 1; m < R; ++m) { a[m] = cmul(a[m], w); w = cmul(w, w1); } }
        UNR for (int m = 0; m < R; ++m) F[fidx(base + m * S)] = a[m];
    }
}
DEVFN void fft_fwd(F2* F, const F2* TW, int tid) {
    fft_stage<4, false>(F, TW, 16384, tid); SYNC(); fft_stage<16, false>(F, TW, 4096, tid); SYNC(); fft_stage<16, false>(F, TW, 256, tid); SYNC(); fft_stage<16, false>(F, TW, 16, tid); SYNC();
}
DEVFN void fft_inv(F2* F, const F2* TW, int tid) {
    fft_stage<16, true>(F, TW, 16, tid); SYNC(); fft_stage<16, true>(F, TW, 256, tid); SYNC(); fft_stage<16, true>(F, TW, 4096, tid); SYNC(); fft_stage<4, true>(F, TW, 16384, tid); SYNC();
}
DEVFN int fpos(int k) { return ((k & 3) << 12) | (((k >> 2) & 15) << 8) | (((k >> 6) & 15) << 4) | (k >> 10); }

DEVFN float block_sum(float v, float* red, int tid) {
    v = wave_sum(v);
    if ((tid & 63) == 0) red[tid >> 6] = v;
    SYNC();
    float s = 0.f; UNR for (int w = 0; w < NWAVES; ++w) s += red[w];
    SYNC();
    return s;
}

DEVFN void hyena_channel(const Ctx& C, int i, int c, unsigned char* lds) {
    const int tid = C.tid; constexpr int L = NLAT;
    F2* F = (F2*)lds; float* Ff = (float*)lds;
    float* W3C = (float*)(lds + 139264);
    float* red = W3C + 272;
    const F2* TW = (const F2*)(C.ws + WS_TW);
    const float* hid = (const float*)(C.ws + WS_HID) + (size_t)i * NLAT * 64;
    const float* w3 = C.in[I_HW3] + (size_t)i * 64 * 2048; const float* b3 = C.in[I_HB3] + (size_t)i * 2048;
    const bf16_t* VX0 = (const bf16_t*)(C.ws + WS_VX0) + (size_t)c * L;
    const bf16_t* VX1 = (const bf16_t*)(C.ws + WS_VX1) + (size_t)c * L;
    const bf16_t* VX2 = (const bf16_t*)(C.ws + WS_VX2) + (size_t)c * L;
    bf16_t* YHY = (bf16_t*)(C.ws + WS_YHY) + (size_t)c * L;
    const float skip0 = C.in[I_HSKIP][(size_t)i * 1024 + c], skip1 = C.in[I_HSKIP][(size_t)i * 1024 + 512 + c];
    const float delta = 15.350567286626973f + (float)c * ((3.0701134573253945f - 15.350567286626973f) / 511.0f);
    if (tid < 256) { const int o = tid >> 7, s = (tid >> 6) & 1, m = tid & 63; W3C[tid] = w3[(size_t)m * 2048 + (s * 2 + o) * 512 + c]; }
    if (tid < 4) W3C[256 + tid] = b3[((tid & 1) * 2 + (tid >> 1)) * 512 + c];
    SYNC();
    UNR1 for (int o = 0; o < 2; ++o) {
        float ssq = 0.f;
        for (int ii = 0; ii < 32; ++ii) {
            CFENCE();
            const int t = tid + NTHREADS * ii;
            const F4* hr = (const F4*)(hid + (size_t)t * 64);
            float af = W3C[256 + o * 2 + 0], ab = W3C[256 + o * 2 + 1];
            const float* wf = W3C + (o * 2 + 0) * 64; const float* wb = W3C + (o * 2 + 1) * 64;
            UNR for (int m4 = 0; m4 < 16; ++m4) { const F4 h = hr[m4];
                af += h.x * wf[4 * m4] + h.y * wf[4 * m4 + 1] + h.z * wf[4 * m4 + 2] + h.w * wf[4 * m4 + 3];
                ab += h.x * wb[4 * m4] + h.y * wb[4 * m4 + 1] + h.z * wb[4 * m4 + 2] + h.w * wb[4 * m4 + 3]; }
            const float win = expf(-((float)t / (float)(L - 1)) * delta);
            af *= win; ab *= win;
            if (t == 0) { af += ab; ssq += af * af; Ff[0] = af; Ff[2 * fidx(L >> 1)] = 0.f; }
            else { ssq += af * af + ab * ab; Ff[2 * fidx(t >> 1) + (t & 1)] = af; const int m = 2 * L - t; Ff[2 * fidx(m >> 1) + (m & 1)] = ab; }
        }
        const float knorm = 1.0f / sqrtf(block_sum(ssq, red, tid));
        fft_fwd(F, TW, tid);
        F2 kfa[16], kfb[16]; F2 kfh = {0.f, 0.f};
        int tq1 = tid; OPAQUE(tq1);
        UNR for (int ii = 0; ii < 16; ++ii) {
            const int k = tq1 + NTHREADS * ii;
            if (k == 0) { const F2 c0 = F[fidx(0)]; kfa[ii].x = (c0.x + c0.y) * knorm; kfa[ii].y = 0.f; kfb[ii].x = (c0.x - c0.y) * knorm; kfb[ii].y = 0.f;
                          const F2 ch = F[fidx(fpos(L / 2))]; kfh.x = ch.x * knorm; kfh.y = -ch.y * knorm; }
            else { const F2 ck = F[fidx(fpos(k))], cp = cconj(F[fidx(fpos(L - k))]);
                F2 e = cadd(ck, cp), od = csub(ck, cp); e.x *= 0.5f; e.y *= 0.5f; F2 oo; oo.x = 0.5f * od.y; oo.y = -0.5f * od.x;
                const F2 tt = cmul(TW[k], oo);
                kfa[ii] = cadd(e, tt); kfb[ii] = cconj(csub(e, tt)); kfa[ii].x *= knorm; kfa[ii].y *= knorm; kfb[ii].x *= knorm; kfb[ii].y *= knorm; }
            CFENCE();
        }
        SYNC();
        UNR for (int ii = 0; ii < 4; ++ii) {
            int tq3 = tid; OPAQUE(tq3); const int t0 = 8 * (tq3 + NTHREADS * ii); float v[8];
            unpack8(ld16((o == 0 ? VX0 : (const bf16_t*)YHY) + t0), v);
            float* d = Ff + 2 * fidx(t0 >> 1); UNR for (int e = 0; e < 8; ++e) d[e] = v[e];
            float* zz = Ff + 2 * fidx((L + t0) >> 1); UNR for (int e = 0; e < 8; ++e) zz[e] = 0.f;
        }
        SYNC();
        fft_fwd(F, TW, tid);
        int tq2 = tid; OPAQUE(tq2);
        UNR for (int ii = 0; ii < 16; ++ii) {
            const int k = tq2 + NTHREADS * ii;
            if (k == 0) { const F2 c0 = F[fidx(0)]; const float y0 = (c0.x + c0.y) * kfa[ii].x, yl = (c0.x - c0.y) * kfb[ii].x; F2 d; d.x = 0.5f * (y0 + yl); d.y = 0.5f * (y0 - yl); F[fidx(0)] = d;
                          const int ph = fidx(fpos(L / 2)); const F2 y = cmul(cconj(F[ph]), kfh); F[ph] = cconj(y); }
            else { const int pk = fidx(fpos(k)), pp = fidx(fpos(L - k)); const F2 ck = F[pk], cp = cconj(F[pp]);
                F2 e = cadd(ck, cp), od = csub(ck, cp); e.x *= 0.5f; e.y *= 0.5f; F2 oo; oo.x = 0.5f * od.y; oo.y = -0.5f * od.x;
                const F2 w = TW[k]; const F2 tt = cmul(w, oo);
                const F2 yk = cmul(cadd(e, tt), kfa[ii]), yp = cmul(cconj(csub(e, tt)), kfb[ii]);
                F2 ye = cadd(yk, cconj(yp)), yd = csub(yk, cconj(yp)); ye.x *= 0.5f; ye.y *= 0.5f; yd.x *= 0.5f; yd.y *= 0.5f;
                const F2 yo = cmulc(yd, w);
                F2 iyo; iyo.x = -yo.y; iyo.y = yo.x;
                F[pk] = cadd(ye, iyo); F[pp] = cconj(csub(ye, iyo)); }
            CFENCE();
        }
        SYNC();
        fft_inv(F, TW, tid);
        UNR for (int ii = 0; ii < 4; ++ii) {
            int tq4 = tid; OPAQUE(tq4); const int t0 = 8 * (tq4 + NTHREADS * ii); const float* d = Ff + 2 * fidx(t0 >> 1);
            float y[8]; UNR for (int e = 0; e < 8; ++e) y[e] = d[e] * (1.0f / (float)FFT_N);
            if (o == 0) { float v[8], x1[8], r[8]; unpack8(ld16(VX0 + t0), v); unpack8(ld16(VX1 + t0), x1); UNR for (int e = 0; e < 8; ++e) r[e] = x1[e] * (y[e] + v[e] * skip0); st16(YHY + t0, pack8(r)); }
            else { float x2[8], zp[8], r[8]; unpack8(ld16(VX2 + t0), x2); unpack8(ld16(YHY + t0), zp); UNR for (int e = 0; e < 8; ++e) r[e] = x2[e] * (y[e] + zp[e] * skip1); st16(YHY + t0, pack8(r)); }
        }
        SYNC();
    }
}

DEVFN void hyena_ctx_channel(const Ctx& C, int i, int c, unsigned char* lds) {
    const int tid = C.tid; constexpr int L = NCTX;
    float* KF = (float*)lds;
    float* Z = KF + 1024;
    float* red = Z + 256;
    float* W3C = red + 16;
    const float* hid = (const float*)(C.ws + WS_HID256);
    const float* w3 = C.in[I_HW3] + (size_t)i * 64 * 2048; const float* b3 = C.in[I_HB3] + (size_t)i * 2048;
    const float* VXC = (const float*)(C.ws + WS_VXC);
    const float delta = 15.350567286626973f + (float)c * ((3.0701134573253945f - 15.350567286626973f) / 511.0f);
    if (tid < 256) { const int o = tid >> 7, s = (tid >> 6) & 1, m = tid & 63; W3C[tid] = w3[(size_t)m * 2048 + (s * 2 + o) * 512 + c]; }
    if (tid < 4) W3C[256 + tid] = b3[((tid & 1) * 2 + (tid >> 1)) * 512 + c];
    SYNC();
    {
        const int o = tid >> 8, t = tid & 255;
        float af = W3C[256 + o * 2 + 0], ab = W3C[256 + o * 2 + 1];
        for (int m = 0; m < 64; ++m) { const float h = hid[t * 64 + m]; af += h * W3C[(o * 2 + 0) * 64 + m]; ab += h * W3C[(o * 2 + 1) * 64 + m]; }
        const float win = expf(-((float)t / (float)(L - 1)) * delta); af *= win; ab *= win;
        float ssq; if (t == 0) { af += ab; ab = 0.f; ssq = af * af; } else ssq = af * af + ab * ab;
        KF[(o * 2 + 0) * 256 + t] = af; KF[(o * 2 + 1) * 256 + t] = ab;
        ssq = wave_sum(ssq);
        if ((tid & 63) == 0) red[tid >> 6] = ssq;
        SYNC();
        const float tot = red[o * 4] + red[o * 4 + 1] + red[o * 4 + 2] + red[o * 4 + 3];
        const float kn = 1.0f / sqrtf(tot);
        KF[(o * 2 + 0) * 256 + t] = af * kn; KF[(o * 2 + 1) * 256 + t] = ab * kn;
    }
    float v = 0.f, x1 = 0.f, x2 = 0.f, z1 = 0.f;
    if (tid < 256) { v = VXC[((size_t)0 * 512 + c) * L + tid]; x1 = VXC[((size_t)1 * 512 + c) * L + tid]; x2 = VXC[((size_t)2 * 512 + c) * L + tid]; Z[tid] = v; }
    SYNC();
    for (int o = 0; o < 2; ++o) {
        float y = 0.f;
        if (tid < 256) { const int t = tid; const float* kf = KF + (o * 2) * 256; const float* kb = KF + (o * 2 + 1) * 256;
            for (int s = 0; s <= t; ++s) y += kf[t - s] * Z[s];
            for (int s = t + 1; s < L; ++s) y += kb[s - t] * Z[s]; }
        SYNC();
        if (tid < 256) { if (o == 0) { z1 = x1 * (y + v * C.in[I_HSKIP][(size_t)i * 1024 + c]); Z[tid] = z1; }
            else { const float r = x2 * (y + z1 * C.in[I_HSKIP][(size_t)i * 1024 + 512 + c]);
                const bf16_t* GHY = (const bf16_t*)(C.ws + WS_GHY); bf16_t* HO = (bf16_t*)(C.ws + WS_HYOUT);
                HO[(size_t)(NLAT + tid) * 512 + c] = (bf16_t)f2bf(r * bf2f(GHY[(size_t)(NLAT + tid) * 512 + c])); } }
        SYNC();
    }
}

DEVFN void rwkv_scan(const Ctx& C, int i, int h, int d, int half, bool ctx_out, unsigned char* lds, int max_chunks) {
    const int tid = C.tid;
    float* sW = (float*)lds; float* sKD = sW + 4096; float* sB = sKD + 4096; float* sKK = sB + 4096; float* sR = sKK + 4096; float* sV = sR + 4096;
    float* sTD = sV + 4096; float* sAD = sTD + 2048; float* sWUP = sAD + 2048; float* sAUP = sWUP + 2048; float* sY = sAUP + 2048;
    const bf16_t* U = (const bf16_t*)(C.ws + WS_U);
    const float* mu = C.in[I_MU] + (size_t)i * 1664;
    const float* w0 = C.in[I_W0] + ((size_t)i * 2 + d) * 512 + 64 * h; const float* a0 = C.in[I_A0] + ((size_t)i * 2 + d) * 512 + 64 * h;
    const float* wup = C.in[I_WUP] + ((size_t)i * 2 + d) * 32 * 512 + 64 * h; const float* aup = C.in[I_AUP] + ((size_t)i * 2 + d) * 32 * 512 + 64 * h;
    const float* k_k = C.in[I_KK] + (size_t)i * 512 + 64 * h; const float* k_a = C.in[I_KA] + (size_t)i * 512 + 64 * h; const float* r_k = C.in[I_RK] + (size_t)i * 512 + 64 * h;
    bf16_t* Yd = (bf16_t*)(C.ws + (d == 0 ? WS_YF : WS_YB));
    float* BON = (float*)(C.ws + WS_BONUS) + (size_t)d * NTOK * 8;
    for (int e = tid; e < 2048; e += NTHREADS) { const int m = e >> 6, j = e & 63; sWUP[e] = wup[(size_t)m * 512 + j]; sAUP[e] = aup[(size_t)m * 512 + j]; }
    const int ft = tid >> 3, fp = tid & 7;
    float mu_r[8], mu_k[8], mu_v[8], mu_w[4], mu_a[4], c_w0[8], c_a0[8], c_kk[8], c_ka[8], c_rk[8];
    UNR for (int e = 0; e < 8; ++e) { const int j = 8 * fp + e; mu_r[e] = mu[64 * h + j]; mu_k[e] = mu[512 + 64 * h + j]; mu_v[e] = mu[1024 + 64 * h + j];
        c_w0[e] = w0[j]; c_a0[e] = a0[j]; c_kk[e] = k_k[j]; c_ka[e] = k_a[j]; c_rk[e] = r_k[j]; }
    UNR for (int e = 0; e < 4; ++e) { mu_w[e] = mu[1536 + 32 * d + 4 * fp + e]; mu_a[e] = mu[1600 + 32 * d + 4 * fp + e]; }
    const int il = tid >> 4, sp = tid & 15;
    float S0 = 0.f, S1 = 0.f, S2 = 0.f, S3 = 0.f;
    SYNC();
    const int nchunks = NTOK / 64;
    for (int ch = 0; ch < nchunks && ch < max_chunks; ++ch) {
        const bool isctx = ch < 4;
        const int seg0 = isctx ? NLAT : 0, segn = isctx ? NCTX : NLAT;
        const int cl = isctx ? ch : ch - 4;
        const int R0 = d == 0 ? 64 * cl : segn - 64 * (cl + 1);
        {
            const int tl = d == 0 ? R0 + ft : R0 + 63 - ft;
            const bf16_t* u0p = U + (size_t)(seg0 + tl) * URW_W;
            const bool hm = tl > 0, hp = tl < segn - 1;
            float r[8], k[8], v[8];
            {
                float a[8], m[8], p[8];
                #define SHIFT3(COL, MU, OUT) do { unpack8(ld16(u0p + (COL)), a); if (hm) unpack8(ld16(u0p - URW_W + (COL)), m); else UNR for (int e = 0; e < 8; ++e) m[e] = 0.f; \
                    if (hp) unpack8(ld16(u0p + URW_W + (COL)), p); else UNR for (int e = 0; e < 8; ++e) p[e] = 0.f; \
                    UNR for (int e = 0; e < 8; ++e) OUT[e] = a[e] + (0.5f * (m[e] + p[e]) - a[e]) * MU[e]; } while (0)
                SHIFT3(64 * h + 8 * fp, mu_r, r); SHIFT3(512 + 64 * h + 8 * fp, mu_k, k); SHIFT3(1024 + 64 * h + 8 * fp, mu_v, v);
                #undef SHIFT3
            }
            {
                const int cw = 1536 + 32 * d + 4 * fp, ca = 1600 + 32 * d + 4 * fp;
                const U2 w0_ = *(const U2*)(u0p + cw), a0_ = *(const U2*)(u0p + ca);
                U2 wm = {0u, 0u}, am = {0u, 0u}, wp = {0u, 0u}, ap = {0u, 0u};
                if (hm) { wm = *(const U2*)(u0p - URW_W + cw); am = *(const U2*)(u0p - URW_W + ca); }
                if (hp) { wp = *(const U2*)(u0p + URW_W + cw); ap = *(const U2*)(u0p + URW_W + ca); }
                const float wa[4] = {bflo(w0_.x), bfhi(w0_.x), bflo(w0_.y), bfhi(w0_.y)}, wmm[4] = {bflo(wm.x), bfhi(wm.x), bflo(wm.y), bfhi(wm.y)}, wpp[4] = {bflo(wp.x), bfhi(wp.x), bflo(wp.y), bfhi(wp.y)};
                const float aa[4] = {bflo(a0_.x), bfhi(a0_.x), bflo(a0_.y), bfhi(a0_.y)}, amm[4] = {bflo(am.x), bfhi(am.x), bflo(am.y), bfhi(am.y)}, app[4] = {bflo(ap.x), bfhi(ap.x), bflo(ap.y), bfhi(ap.y)};
                UNR for (int e = 0; e < 4; ++e) { sTD[ft * 32 + 4 * fp + e] = tanhf(wa[e] + (0.5f * (wmm[e] + wpp[e]) - wa[e]) * mu_w[e]);
                                               sAD[ft * 32 + 4 * fp + e] = aa[e] + (0.5f * (amm[e] + app[e]) - aa[e]) * mu_a[e]; }
            }
            SYNC();
            float wl[8], al[8];
            UNR for (int e = 0; e < 8; ++e) { wl[e] = c_w0[e]; al[e] = c_a0[e]; }
            for (int m = 0; m < 32; ++m) { const float td = sTD[ft * 32 + m], ad = sAD[ft * 32 + m];
                UNR for (int e = 0; e < 8; ++e) { wl[e] += td * sWUP[m * 64 + 8 * fp + e]; al[e] += ad * sAUP[m * 64 + 8 * fp + e]; } }
            float kkv[8], ssq = 0.f;
            UNR for (int e = 0; e < 8; ++e) { kkv[e] = k[e] * c_kk[e]; ssq += kkv[e] * kkv[e]; }
            ssq += shfl_xor_f(ssq, 1); ssq += shfl_xor_f(ssq, 2); ssq += shfl_xor_f(ssq, 4);
            const float kn = 1.0f / sqrtf(ssq + 1e-12f);
            float bon = 0.f;
            UNR for (int e = 0; e < 8; ++e) {
                const float x = -wl[e];
                const float sp_ = fmaxf(x, 0.f) + log1pf(expf(-fabsf(x)));
                const float wlog = -sp_ - 0.5f;
                const float dec = expf(-expf(wlog));
                const float a = sigmoid_f(al[e]);
                const float kd = k[e] * (1.0f + (a - 1.0f) * c_ka[e]);
                const float kk = kkv[e] * kn;
                const int o = ft * 64 + 8 * fp + e;
                sW[o] = dec; sKD[o] = kd; sB[o] = kk * a; sKK[o] = kk; sR[o] = r[e]; sV[o] = v[e];
                bon += r[e] * kd * c_rk[e];
            }
            bon += shfl_xor_f(bon, 1); bon += shfl_xor_f(bon, 2); bon += shfl_xor_f(bon, 4);
            if (fp == 0 && half == 0) BON[(size_t)(seg0 + tl) * 8 + h] = 0.5f * bon;
        }
        SYNC();
        for (int k = 0; k < 64; ++k) {
            const F4 kk4 = *(const F4*)(sKK + k * 64 + 4 * sp), w4 = *(const F4*)(sW + k * 64 + 4 * sp), b4 = *(const F4*)(sB + k * 64 + 4 * sp),
                     kd4 = *(const F4*)(sKD + k * 64 + 4 * sp), r4 = *(const F4*)(sR + k * 64 + 4 * sp);
            const float vi = sV[k * 64 + 32 * half + il];
            float sa = S0 * kk4.x + S1 * kk4.y + S2 * kk4.z + S3 * kk4.w;
            sa += shfl_xor_f(sa, 1); sa += shfl_xor_f(sa, 2); sa += shfl_xor_f(sa, 4); sa += shfl_xor_f(sa, 8);
            S0 = S0 * w4.x - sa * b4.x + vi * kd4.x; S1 = S1 * w4.y - sa * b4.y + vi * kd4.y; S2 = S2 * w4.z - sa * b4.z + vi * kd4.z; S3 = S3 * w4.w - sa * b4.w + vi * kd4.w;
            float y = S0 * r4.x + S1 * r4.y + S2 * r4.z + S3 * r4.w;
            y += shfl_xor_f(y, 1); y += shfl_xor_f(y, 2); y += shfl_xor_f(y, 4); y += shfl_xor_f(y, 8);
            if (sp == 0) sY[k * 32 + il] = y;
        }
        SYNC();
        if (!isctx || ctx_out) {
            const int k = tid >> 3, q = (tid & 7) * 4; const int tl = d == 0 ? R0 + k : R0 + 63 - k;
            U2 o; o.x = pk2(sY[k * 32 + q], sY[k * 32 + q + 1]); o.y = pk2(sY[k * 32 + q + 2], sY[k * 32 + q + 3]);
            *(U2*)(Yd + (size_t)(seg0 + tl) * 512 + 64 * h + 32 * half + q) = o;
        }
    }
}

DEVFN void ph_readout_hyout(const Ctx& C, int i, bool do_ctx, unsigned char* lds) {
    const int tid = C.tid;
    {
        const bf16_t* U = (const bf16_t*)(C.ws + WS_U); bf16_t* YF = (bf16_t*)(C.ws + WS_YF); const bf16_t* YB = (const bf16_t*)(C.ws + WS_YB);
        const float* BON = (const float*)(C.ws + WS_BONUS);
        const float* mu = C.in[I_MU] + (size_t)i * 1664 + 1024; const float* gnw = C.in[I_GNW] + (size_t)i * 512; const float* gnb = C.in[I_GNB] + (size_t)i * 512;
        const int rl = tid >> 6, c8 = (tid & 63) * 8, h = (tid & 63) >> 3;
        float muv[8], gw_[8], gb_[8];
        UNR for (int e = 0; e < 8; ++e) { muv[e] = mu[c8 + e]; gw_[e] = gnw[c8 + e]; gb_[e] = gnb[c8 + e]; }
        const int nrows = do_ctx ? NTOK : NLAT;
        for (int r0 = C.vcu * 8; r0 < nrows; r0 += C.G * 8) {
            const int row = r0 + rl; const bool isctx = row >= NLAT; const int seg0 = isctx ? NLAT : 0, segn = isctx ? NCTX : NLAT, tl = row - seg0;
            float yf[8], yb[8], y[8], a[8], m[8], p[8], g[8];
            unpack8(ld16(YF + (size_t)row * 512 + c8), yf); unpack8(ld16(YB + (size_t)row * 512 + c8), yb);
            float s = 0.f; UNR for (int e = 0; e < 8; ++e) { y[e] = yf[e] + yb[e]; s += y[e]; }
            s += shfl_xor_f(s, 1); s += shfl_xor_f(s, 2); s += shfl_xor_f(s, 4);
            const float mean = s * (1.0f / 64.0f); float q = 0.f;
            UNR for (int e = 0; e < 8; ++e) { y[e] -= mean; q += y[e] * y[e]; }
            q += shfl_xor_f(q, 1); q += shfl_xor_f(q, 2); q += shfl_xor_f(q, 4);
            const float rstd = 1.0f / sqrtf(q * (1.0f / 64.0f) + 64e-5f);
            const bf16_t* up = U + (size_t)row * URW_W + 1024 + c8;
            unpack8(ld16(up), a);
            if (tl > 0) unpack8(ld16(up - URW_W), m); else UNR for (int e = 0; e < 8; ++e) m[e] = 0.f;
            if (tl < segn - 1) unpack8(ld16(up + URW_W), p); else UNR for (int e = 0; e < 8; ++e) p[e] = 0.f;
            unpack8(ld16(U + (size_t)row * URW_W + 1664 + c8), g);
            const float bon = BON[(size_t)row * 8 + h] + BON[(size_t)NTOK * 8 + (size_t)row * 8 + h];
            float o[8];
            UNR for (int e = 0; e < 8; ++e) { const float v = a[e] + (0.5f * (m[e] + p[e]) - a[e]) * muv[e]; o[e] = (y[e] * rstd * gw_[e] + gb_[e] + bon * v) * g[e]; }
            st16(YF + (size_t)row * 512 + c8, pack8(o));
        }
    }
    {
        const bf16_t* YHY = (const bf16_t*)(C.ws + WS_YHY); const bf16_t* GHY = (const bf16_t*)(C.ws + WS_GHY); bf16_t* HO = (bf16_t*)(C.ws + WS_HYOUT);
        float* T = (float*)lds;
        for (int it = C.vcu; it < 256 * 8; it += C.G) {
            const int tb = it >> 3, cb = it & 7;
            { const int cl = tid >> 3, t8 = (tid & 7) * 8; float v[8]; unpack8(ld16(YHY + (size_t)(64 * cb + cl) * NLAT + 64 * tb + t8), v); UNR for (int e = 0; e < 8; ++e) T[cl * 65 + t8 + e] = v[e]; }
            SYNC();
            { const int tl = tid >> 3, c8 = (tid & 7) * 8; float g[8], o[8]; const size_t off = (size_t)(64 * tb + tl) * 512 + 64 * cb + c8;
              unpack8(ld16(GHY + off), g); UNR for (int e = 0; e < 8; ++e) o[e] = T[(c8 + e) * 65 + tl] * g[e]; st16(HO + off, pack8(o)); }
            SYNC();
        }
    }
}

DEVFN void ph_scan_hyena(const Ctx& C, int i, bool ctx_out, unsigned char* lds) {
    const int nscan = 32;
    if (C.vcu < nscan) { rwkv_scan(C, i, C.vcu >> 2, (C.vcu >> 1) & 1, C.vcu & 1, ctx_out, lds, 1 << 30); return; }
    const int nh = C.G - nscan;
    for (int c = C.vcu - nscan; c < 512; c += nh) hyena_channel(C, i, c, lds);
    if (ctx_out) for (int c = C.vcu - nscan; c < 512; c += nh) { SYNC(); hyena_ctx_channel(C, i, c, lds); }
}
namespace pg8 {
#define PG8_LAS __attribute__((address_space(3)))
typedef unsigned short bf16_t;
typedef short bf16x8 __attribute__((ext_vector_type(8)));
typedef float f32x4 __attribute__((ext_vector_type(4)));
typedef unsigned u32x4 __attribute__((ext_vector_type(4)));
constexpr int BM = 256, BK = 64, HALF = 128, HTB = HALF * BK * 2  , STAGE_BYTES = 8 * HTB, NXCD = 8, WGM = 8;

__host__ __device__ __forceinline__ int lds_byte(int r, int c) { const int st = (r >> 4) * 2 + (c >> 5), rr = r & 15, cc = c & 31, ob = rr * 64 + cc * 2; return st * 1024 + (ob ^ (((ob >> 9) & 1) << 5)); }
__host__ __device__ __forceinline__ void stage_rc(int b, int& R, int& C) { const int st = b / 1024, sb = b % 1024, swz = sb ^ (((sb >> 9) & 1) << 5); R = (st >> 1) * 16 + swz / 64; C = (st & 1) * 32 + (swz % 64) / 2; }
__host__ __device__ __forceinline__ int perm32(int rho) { const int n = rho >> 4, i = rho & 15; return 8 * (i >> 2) + 4 * n + (i & 3); }

struct Unit { int pm, pn; };
struct Gemm { const bf16_t* A; const bf16_t* A2; int lda; const bf16_t* Bt; int M, N, K; };

struct StaticOrder {
    int nM, nN, nwg, G, c;
    __host__ __device__ void init(int M, int N, int G_, int c_) { nM = M / BM; nN = N / BM; nwg = nM * nN; G = G_; c = c_; }
    __host__ __device__ bool next(int i, Unit& u) const {
        const long L = (long)i * G + c; if (L >= nwg) return false;
        int wgid = (int)L; { const int q = nwg / NXCD, r = nwg % NXCD, xcd = wgid % NXCD, off = wgid / NXCD; wgid = (xcd < r ? xcd * (q + 1) : r * (q + 1) + (xcd - r) * q) + off; }
        const int nig = WGM * nN, gid = wgid / nig, fm = gid * WGM, gsz = (nM - fm) < WGM ? (nM - fm) : WGM;
        u.pm = fm + ((wgid % nig) % gsz); u.pn = (wgid % nig) / gsz; return true;
    }
    __device__ __forceinline__ void a_ready(const Unit&) const {}
    __device__ __forceinline__ void done(const Unit&) const {}
};

__device__ __forceinline__ unsigned cvt_pk_bf16(float lo, float hi) { unsigned r; asm volatile("v_cvt_pk_bf16_f32 %0, %1, %2" : "=v"(r) : "v"(lo), "v"(hi)); return r; }
__device__ __forceinline__ float silu_fast(float v) { return v * __builtin_amdgcn_rcpf(1.0f + __expf(-v)); }

template <int LAYOUT> struct EpiIn {
    static constexpr bool PERM = true, AFTER_DRAIN = false;
    unsigned char* ws;
    __device__ __forceinline__ void operator()(const f32x4 (&acc)[2][2][4][2], const Unit& u, int wr, int wc, int fr, int fq) const {
        const int row0 = u.pm * BM + wr * 64 + fr;
#pragma unroll
        for (int bj = 0; bj < 2; ++bj) {
            const int cg = u.pn * BM + bj * HALF;
            bf16_t* base; int ldc, mode, col;
            if (LAYOUT == 0) { base = (bf16_t*)(ws + WS_U); ldc = AIN; col = cg; mode = cg < 512 ? 1 : ((cg >= 1536 && cg < 2048) || cg >= 2816) ? 2 : 0; }
            else {
                if (cg < URW_W) { base = (bf16_t*)(ws + WS_U); ldc = URW_W; col = cg; mode = cg >= 1664 ? 2 : 0; }
                else if (cg < URW_W + UHY_W) { base = (bf16_t*)(ws + WS_UHY); ldc = UHY_W; col = cg - URW_W; mode = 0; }
                else if (cg < RIN) { base = (bf16_t*)(ws + WS_GHY); ldc = 512; col = cg - URW_W - UHY_W; mode = 2; }
                else { base = nullptr; ldc = 0; col = 0; mode = 3; }
            }
            if (mode == 3) continue;
            const int col0 = col + wc * 32 + 8 * fq;
#pragma unroll
            for (int ai = 0; ai < 2; ++ai)
#pragma unroll
                for (int m = 0; m < 4; ++m) {
                    f32x4 v0 = acc[ai][bj][m][0], v1 = acc[ai][bj][m][1];
                    if (mode == 1) { v0 = v0 * C2; v1 = v1 * C2; }
                    if (mode == 2) { v0 = (f32x4){silu_fast(v0[0]), silu_fast(v0[1]), silu_fast(v0[2]), silu_fast(v0[3])}; v1 = (f32x4){silu_fast(v1[0]), silu_fast(v1[1]), silu_fast(v1[2]), silu_fast(v1[3])}; }
                    u32x4 w; w.x = cvt_pk_bf16(v0[0], v0[1]); w.y = cvt_pk_bf16(v0[2], v0[3]); w.z = cvt_pk_bf16(v1[0], v1[1]); w.w = cvt_pk_bf16(v1[2], v1[3]);
                    *(u32x4*)(base + (size_t)(row0 + ai * HALF + m * 16) * ldc + col0) = w;
                }
        }
    }
};

struct EpiRes {
    static constexpr bool PERM = false, AFTER_DRAIN = false;
    const float* blat; const float* bctx; float* olat; float* octx; const float* gate; const float* gate_c;
    __device__ __forceinline__ void operator()(const f32x4 (&acc)[2][2][4][2], const Unit& u, int wr, int wc, int fr, int fq) const {
        const bool isctx = u.pm * BM >= NLAT;
        const float* bs = isctx ? bctx - (size_t)NLAT * DM : blat; float* os = isctx ? octx - (size_t)NLAT * DM : olat; const float* gt = isctx ? gate_c : gate;
        const int col0 = u.pn * BM + wc * 32 + 4 * fq;
#pragma unroll
        for (int bj = 0; bj < 2; ++bj)
#pragma unroll
            for (int n = 0; n < 2; ++n) { const f32x4 g = *(const f32x4*)(gt + col0 + bj * HALF + n * 16);
#pragma unroll
                for (int ai = 0; ai < 2; ++ai)
#pragma unroll
                    for (int m = 0; m < 4; ++m) { const size_t off = (size_t)(u.pm * BM + ai * HALF + wr * 64 + m * 16 + fr) * DM + col0 + bj * HALF + n * 16;
                        const f32x4 b = *(const f32x4*)(bs + off); *(f32x4*)(os + off) = b + g * acc[ai][bj][m][n]; } }
    }
};
template <class Epi, class Sched, bool ALIGN_EPI = false, bool SP2 = false>
__device__ __forceinline__ void gemm_phase(PG8_LAS unsigned char* lds, const Gemm g, const Sched& S, const Epi& E) {
    int tid_ = threadIdx.x; asm volatile("" : "+v"(tid_));
    const int tid = tid_, wid = __builtin_amdgcn_readfirstlane(tid >> 6), lane = tid & 63, wr = wid >> 2, wc = wid & 3, fr = lane & 15, fq = lane >> 4;
    const int K = g.K, nt = K / BK;
    unsigned voffA[2], voffB[2];
#pragma unroll
    for (int i = 0; i < 2; ++i) { int R, C; stage_rc(tid * 16 + i * 8192, R, C); const int Rb = Epi::PERM ? ((R & ~31) + perm32(R & 31)) : R;
        voffA[i] = (unsigned)(R * g.lda + C) * 2u; voffB[i] = (unsigned)(Rb * K + C) * 2u; }
    const size_t kstep = (size_t)(BK * 2);
    const size_t hstepA = (size_t)HALF * g.lda * 2, hstepB = (size_t)HALF * K * 2;
    const size_t tstepA = 2 * hstepA, tstepB = 2 * hstepB;
    const int nh = nt / 2; const ptrdiff_t dlt = ((const char*)g.A2 - (const char*)g.A) - (ptrdiff_t)nh * (ptrdiff_t)kstep;
    const unsigned ldsw = (unsigned)wid * 1024u;
    const int aoff = lds_byte(wr * 64 + fr, fq * 8), boff = lds_byte(wc * 32 + fr, fq * 8);
#define PG8_SA(b, h) (((b) * 2 + (h)) * HTB)
#define PG8_SB(b, h) ((4 + (b) * 2 + (h)) * HTB)
#define PG8_STAGE(bufoff, gbase, voff) do { _Pragma("unroll") for (int _i = 0; _i < 2; ++_i) \
        __builtin_amdgcn_global_load_lds((const unsigned*)((const char*)(gbase) + (voff)[_i]), (PG8_LAS unsigned*)(lds + (bufoff) + ldsw + _i * 8192), 16, 0, 0); } while (0)
#define PG8_LDA(dst, b, h) do { _Pragma("unroll") for (int m = 0; m < 4; ++m) _Pragma("unroll") for (int k = 0; k < 2; ++k) dst[m][k] = *(const PG8_LAS bf16x8*)(lds + PG8_SA(b, h) + aoff + m * 2048 + k * 1024); } while (0)
#define PG8_LDB(dst, b, h) do { _Pragma("unroll") for (int n = 0; n < 2; ++n) _Pragma("unroll") for (int k = 0; k < 2; ++k) dst[n][k] = *(const PG8_LAS bf16x8*)(lds + PG8_SB(b, h) + boff + n * 2048 + k * 1024); } while (0)
#define PG8_MMA(ai, bj, At, Bt) do { __builtin_amdgcn_s_setprio(1); _Pragma("unroll") for (int m = 0; m < 4; ++m) _Pragma("unroll") for (int n = 0; n < 2; ++n) _Pragma("unroll") for (int k = 0; k < 2; ++k) \
        acc[ai][bj][m][n] = __builtin_amdgcn_mfma_f32_16x16x32_bf16(Bt[n][k], At[m][k], acc[ai][bj][m][n], 0, 0, 0); __builtin_amdgcn_s_setprio(0); } while (0)
#define PG8_WAIT_V(n) asm volatile("s_waitcnt vmcnt(" #n ")" ::: "memory")
#define PG8_WAIT_L(n) asm volatile("s_waitcnt lgkmcnt(" #n ")" ::: "memory")
#define PG8_BAR __builtin_amdgcn_s_barrier()
#define PG8_SCHED __builtin_amdgcn_sched_barrier(0)
    Unit cur, nxt; int ui = 0;
    if (!S.next(0, cur)) return;
    f32x4 acc[2][2][4][2];
#pragma unroll
    for (int a = 0; a < 2; ++a)
#pragma unroll
        for (int b = 0; b < 2; ++b)
#pragma unroll
            for (int m = 0; m < 4; ++m)
#pragma unroll
                for (int n = 0; n < 2; ++n) acc[a][b][m][n] = (f32x4){0.f, 0.f, 0.f, 0.f};
    bf16x8 At[4][2], B0[2][2], B1[2][2];
    const char* cA = (const char*)g.A + (size_t)cur.pm * tstepA; const char* cB = (const char*)g.Bt + (size_t)cur.pn * tstepB;
    S.a_ready(cur);
    if constexpr (SP2) {
        PG8_STAGE(PG8_SB(0, 0), cB, voffB); PG8_STAGE(PG8_SB(0, 1), cB + hstepB, voffB); PG8_STAGE(PG8_SA(0, 0), cA, voffA); PG8_STAGE(PG8_SA(0, 1), cA + hstepA, voffA);
        if (wr == 1) PG8_BAR;
        PG8_WAIT_V(2); PG8_BAR;
        PG8_STAGE(PG8_SB(1, 0), cB + kstep, voffB); PG8_STAGE(PG8_SA(1, 0), cA + kstep, voffA); PG8_STAGE(PG8_SB(1, 1), cB + hstepB + kstep, voffB);
        PG8_WAIT_V(6); PG8_BAR;
    } else {
        PG8_STAGE(PG8_SB(0, 0), cB, voffB); PG8_STAGE(PG8_SA(0, 0), cA, voffA); PG8_STAGE(PG8_SB(0, 1), cB + hstepB, voffB); PG8_STAGE(PG8_SA(0, 1), cA + hstepA, voffA);
        if (wr == 1) PG8_BAR;
        PG8_WAIT_V(4); PG8_BAR;
        PG8_STAGE(PG8_SB(1, 0), cB + kstep, voffB); PG8_STAGE(PG8_SA(1, 0), cA + kstep, voffA); PG8_STAGE(PG8_SB(1, 1), cB + hstepB + kstep, voffB);
        PG8_WAIT_V(6); PG8_BAR;
    }
    for (;;) {
        const bool has_next = S.next(ui + 1, nxt);
        const char* nA = has_next ? (const char*)g.A + (size_t)nxt.pm * tstepA : cA; const char* nB = has_next ? (const char*)g.Bt + (size_t)nxt.pn * tstepB : cB;
        for (int t = 0; t < nt; t += 2) {
            const bool last = (t == nt - 2);
            const char* a1 = cA + (size_t)(t + 1) * kstep + ((t + 1) >= nh ? dlt : 0);
            const char* a2 = last ? nA : cA + (size_t)(t + 2) * kstep + ((t + 2) >= nh ? dlt : 0); const char* b2 = last ? nB : cB + (size_t)(t + 2) * kstep;
            const char* a3 = a2 + kstep; const char* b3 = b2 + kstep;
            if (last && has_next) S.a_ready(nxt);
            if constexpr (SP2) {
            PG8_LDB(B0, 0, 0); PG8_LDB(B1, 0, 1); PG8_SCHED; PG8_LDA(At, 0, 0); PG8_STAGE(PG8_SA(1, 1), a1 + hstepA, voffA);
            PG8_WAIT_V(8); PG8_WAIT_L(0); PG8_BAR; PG8_MMA(0, 0, At, B0); PG8_MMA(0, 1, At, B1); PG8_BAR; PG8_SCHED;
            PG8_LDA(At, 0, 1); PG8_STAGE(PG8_SB(0, 0), b2, voffB); PG8_STAGE(PG8_SB(0, 1), b2 + hstepB, voffB); PG8_STAGE(PG8_SA(0, 0), a2, voffA);
            PG8_WAIT_V(8); PG8_WAIT_L(0); PG8_BAR; PG8_MMA(1, 0, At, B0); PG8_MMA(1, 1, At, B1); PG8_BAR; PG8_SCHED;
            PG8_LDB(B0, 1, 0); PG8_LDB(B1, 1, 1); PG8_SCHED; PG8_LDA(At, 1, 0); PG8_STAGE(PG8_SA(0, 1), a2 + hstepA, voffA);
            PG8_WAIT_V(8); PG8_WAIT_L(0); PG8_BAR; PG8_MMA(0, 0, At, B0); PG8_MMA(0, 1, At, B1); PG8_BAR; PG8_SCHED;
            PG8_LDA(At, 1, 1); PG8_STAGE(PG8_SB(1, 0), b3, voffB); PG8_STAGE(PG8_SB(1, 1), b3 + hstepB, voffB); PG8_STAGE(PG8_SA(1, 0), a3, voffA);
            PG8_WAIT_V(8); PG8_WAIT_L(0); PG8_BAR; PG8_MMA(1, 0, At, B0); PG8_MMA(1, 1, At, B1); PG8_BAR; PG8_SCHED;
            } else {
            PG8_LDB(B0, 0, 0); PG8_SCHED; PG8_LDA(At, 0, 0); PG8_STAGE(PG8_SA(1, 1), a1 + hstepA, voffA);
            PG8_WAIT_L(8); PG8_BAR; PG8_WAIT_L(0); PG8_MMA(0, 0, At, B0); PG8_BAR; PG8_SCHED;
            PG8_LDB(B1, 0, 1); PG8_STAGE(PG8_SB(0, 0), b2, voffB);
            PG8_BAR; PG8_WAIT_L(0); PG8_MMA(0, 1, At, B1); PG8_BAR;
            PG8_LDA(At, 0, 1); PG8_STAGE(PG8_SA(0, 0), a2, voffA);
            PG8_BAR; PG8_WAIT_L(0); PG8_MMA(1, 0, At, B0); PG8_BAR; PG8_SCHED;
            PG8_STAGE(PG8_SB(0, 1), b2 + hstepB, voffB);
            PG8_WAIT_V(6); PG8_BAR; PG8_MMA(1, 1, At, B1); PG8_BAR;
            PG8_LDB(B0, 1, 0); PG8_SCHED; PG8_LDA(At, 1, 0); PG8_STAGE(PG8_SA(0, 1), a2 + hstepA, voffA);
            PG8_WAIT_L(8); PG8_BAR; PG8_WAIT_L(0); PG8_MMA(0, 0, At, B0); PG8_BAR; PG8_SCHED;
            PG8_LDB(B1, 1, 1); PG8_STAGE(PG8_SB(1, 0), b3, voffB);
            PG8_BAR; PG8_WAIT_L(0); PG8_MMA(0, 1, At, B1); PG8_BAR;
            PG8_LDA(At, 1, 1); PG8_STAGE(PG8_SA(1, 0), a3, voffA);
            PG8_BAR; PG8_WAIT_L(0); PG8_MMA(1, 0, At, B0); PG8_BAR; PG8_SCHED;
            PG8_STAGE(PG8_SB(1, 1), b3 + hstepB, voffB);
            PG8_WAIT_V(6); PG8_BAR; PG8_MMA(1, 1, At, B1); PG8_BAR;
            }
        }
        if constexpr (ALIGN_EPI) { if (wr == 0) PG8_BAR; }
        if constexpr (!Epi::AFTER_DRAIN) { E(acc, cur, wr, wc, fr, fq); S.done(cur); }
        if (!has_next) break;
#pragma unroll
        for (int a = 0; a < 2; ++a)
#pragma unroll
            for (int b = 0; b < 2; ++b)
#pragma unroll
                for (int m = 0; m < 4; ++m)
#pragma unroll
                    for (int n = 0; n < 2; ++n) acc[a][b][m][n] = (f32x4){0.f, 0.f, 0.f, 0.f};
        cur = nxt; cA = nA; cB = nB; ++ui;
        if constexpr (ALIGN_EPI) { if (wr == 1) PG8_BAR; }
    }
    PG8_WAIT_V(0);
    if constexpr (!ALIGN_EPI) { if (wr == 0) PG8_BAR; }
    PG8_BAR;
    if constexpr (Epi::AFTER_DRAIN) { E.fused(acc, cur, wr, wc, fr, fq, lds, wid, lane); S.done(cur); }
#undef PG8_SA
#undef PG8_SB
#undef PG8_STAGE
#undef PG8_LDA
#undef PG8_LDB
#undef PG8_MMA
#undef PG8_WAIT_V
#undef PG8_WAIT_L
#undef PG8_BAR
#undef PG8_SCHED
}
}
#include <hip/hip_bf16.h>
#include <cmath>
namespace attn_body {
using bf16=__hip_bfloat16;
using bf16x8=__attribute__((ext_vector_type(8)))short;
using s16x4=__attribute__((ext_vector_type(4)))short;
using f32x16=__attribute__((ext_vector_type(16)))float;
using u32x4=__attribute__((ext_vector_type(4)))unsigned;
constexpr int D=64;
constexpr int NW=8,QBLK=32,QB=QBLK*NW,KVBLK=64;
__device__ __forceinline__ int crow(int r,int hi){return (r&3)+8*(r>>2)+4*hi;}
#define SBAR() __builtin_amdgcn_sched_barrier(0)
typedef __attribute__((address_space(3))) const float* lds_fptr;
struct NaCtx { lds_fptr tab; int rmin, qr, qc, row0, col0; };
__device__ __forceinline__ void namask(f32x16&p0,f32x16&p1,int t,const NaCtx&n,int hi){
  if(t<4)return;
  const float NEG=-INFINITY; const int kr=n.rmin+(t-4);
  if(kr<n.row0||kr>=n.row0+8){
    #pragma unroll
    for(int r=0;r<16;++r){p0[r]=NEG;p1[r]=NEG;}
    return; }
  const lds_fptr bt=n.tab+((kr-n.qr+7)*31+15-n.qc+4*hi); const int d0=4*hi-n.col0;
  #pragma unroll
  for(int r=0;r<16;++r){const int e=(r&3)+8*(r>>2);
    p0[r]=((unsigned)(e+d0)<16u)?p0[r]+bt[e]:NEG; p1[r]=((unsigned)(e+32+d0)<16u)?p1[r]+bt[e+32]:NEG;}
}

constexpr int NSLOT=3, SLOTB=8192;
constexpr int LDS_K=0, LDS_V=NSLOT*SLOTB, LDS_WS=2*NSLOT*SLOTB, LDS_OST=LDS_WS+NW*64*4, LDS_BIAS=LDS_OST+NW*4096, LDS_BYTES=LDS_BIAS+640*4;
constexpr float C2=0.125f*1.4426950408889634f;
__device__ __forceinline__ void glds16(const void*gsrc,unsigned lds_dst){unsigned keep;
  asm volatile("s_mov_b32 %0, m0\n\ts_mov_b32 m0, %2\n\ts_nop 0\n\tglobal_load_lds_dwordx4 %1, off\n\ts_mov_b32 m0, %0":"=&s"(keep):"v"(gsrc),"s"(lds_dst):"memory");}
__device__ __forceinline__ float max3f(float a,float b,float c){float r;asm("v_max3_f32 %0, %1, %2, %3":"=v"(r):"v"(a),"v"(b),"v"(c));return r;}
__device__ __forceinline__ float max2f(float a,float b){float r;asm("v_max_f32_e32 %0, %1, %2":"=v"(r):"v"(a),"v"(b));return r;}
__device__ __forceinline__ float fadd_s(float a,float b){float r;asm("v_add_f32_e32 %0, %1, %2":"=v"(r):"v"(a),"v"(b));return r;}
__device__ __forceinline__ float fsub_s(float a,float b){float r;asm("v_sub_f32_e32 %0, %1, %2":"=v"(r):"v"(a),"v"(b));return r;}
typedef float f32x2_t __attribute__((ext_vector_type(2))); typedef __bf16 bf16x2_t __attribute__((ext_vector_type(2)));
__device__ __forceinline__ unsigned cvtpk_s(float lo,float hi){f32x2_t v={lo,hi};bf16x2_t b=__builtin_convertvector(v,bf16x2_t);return __builtin_bit_cast(unsigned,b);}
#define WAIT_BAR(N) asm volatile("s_waitcnt vmcnt(" #N ") lgkmcnt(0)\n\ts_barrier":::"memory")

__device__ __forceinline__ void qkt(f32x16&p0,f32x16&p1,const char*Kslot,const bf16x8*qr,const f32x16&negm,int r32,int hi){
  const char*kb=Kslot+hi*1024+r32*16;
  #pragma unroll
  for(int d0=0;d0<4;++d0){
    const bf16x8 b0=*reinterpret_cast<const bf16x8*>(kb+d0*2048);
    const bf16x8 b1=*reinterpret_cast<const bf16x8*>(kb+d0*2048+512);
    if(d0==0){p0=__builtin_amdgcn_mfma_f32_32x32x16_bf16(b0,qr[0],negm,0,0,0);p1=__builtin_amdgcn_mfma_f32_32x32x16_bf16(b1,qr[0],negm,0,0,0);}
    else{p0=__builtin_amdgcn_mfma_f32_32x32x16_bf16(b0,qr[d0],p0,0,0,0);p1=__builtin_amdgcn_mfma_f32_32x32x16_bf16(b1,qr[d0],p1,0,0,0);}}
}
typedef __attribute__((address_space(3))) const char* lds_cptr;
typedef short v4i16_t __attribute__((ext_vector_type(4)));
__device__ __forceinline__ void kload8(bf16x8*kf,lds_cptr kp){
  kf[0]=*(const __attribute__((address_space(3))) bf16x8*)(kp);      kf[1]=*(const __attribute__((address_space(3))) bf16x8*)(kp+512);
  kf[2]=*(const __attribute__((address_space(3))) bf16x8*)(kp+2048); kf[3]=*(const __attribute__((address_space(3))) bf16x8*)(kp+2560);
  kf[4]=*(const __attribute__((address_space(3))) bf16x8*)(kp+4096); kf[5]=*(const __attribute__((address_space(3))) bf16x8*)(kp+4608);
  kf[6]=*(const __attribute__((address_space(3))) bf16x8*)(kp+6144); kf[7]=*(const __attribute__((address_space(3))) bf16x8*)(kp+6656);
}
__device__ __forceinline__ void kload2(bf16x8*kf,lds_cptr kp,int j){ kf[2*j]=*(const __attribute__((address_space(3))) bf16x8*)(kp+j*2048); kf[2*j+1]=*(const __attribute__((address_space(3))) bf16x8*)(kp+j*2048+512); }
__device__ __forceinline__ s16x4 vtr(lds_cptr p){ return __builtin_bit_cast(s16x4,__builtin_amdgcn_ds_read_tr16_b64_v4i16((__attribute__((address_space(3))) v4i16_t*)p)); }
__device__ __forceinline__ float rowmax(const f32x16&p0,const f32x16&p1){
  float a=max3f(p0[0],p0[1],p1[0]),b=max3f(p0[2],p0[3],p1[1]);a=max3f(a,p1[2],p1[3]);
  #pragma unroll
  for(int r=4;r<16;r+=4){a=max3f(a,p0[r],p0[r+1]);b=max3f(b,p0[r+2],p0[r+3]);a=max3f(a,p1[r],p1[r+1]);b=max3f(b,p1[r+2],p1[r+3]);}
  const float m=max2f(a,b);
  auto rr=__builtin_amdgcn_permlane32_swap(__float_as_uint(m),__float_as_uint(m),false,false);
  return max2f(__uint_as_float(rr[0]),__uint_as_float(rr[1]));
}
__device__ __forceinline__ void pv(f32x16*o,int vb,bf16x8 pa0,bf16x8 pa1,bf16x8 pa2,bf16x8 pa3){
  #pragma unroll
  for(int d0=0;d0<2;++d0){s16x4 lo[4],hi[4];
    #pragma unroll
    for(int ks=0;ks<4;++ks){
      asm volatile("ds_read_b64_tr_b16 %0,%1 offset:%c2":"=&v"(lo[ks]):"v"(vb),"i"(d0*4096+ks*1024):"memory");
      asm volatile("ds_read_b64_tr_b16 %0,%1 offset:%c2":"=&v"(hi[ks]):"v"(vb),"i"(d0*4096+ks*1024+512):"memory");}
    asm volatile("s_waitcnt lgkmcnt(0)":::"memory");SBAR();
    #define PK(k) (bf16x8){lo[k][0],lo[k][1],lo[k][2],lo[k][3],hi[k][0],hi[k][1],hi[k][2],hi[k][3]}
    o[d0]=__builtin_amdgcn_mfma_f32_32x32x16_bf16(pa0,PK(0),o[d0],0,0,0);
    o[d0]=__builtin_amdgcn_mfma_f32_32x32x16_bf16(pa1,PK(1),o[d0],0,0,0);
    o[d0]=__builtin_amdgcn_mfma_f32_32x32x16_bf16(pa2,PK(2),o[d0],0,0,0);
    o[d0]=__builtin_amdgcn_mfma_f32_32x32x16_bf16(pa3,PK(3),o[d0],0,0,0);
    #undef PK
  }
}

#define ATTN_STORE16(p,v) (*(u32x4*)(p)=(v))
template<bool NA> __device__ __forceinline__ f32x16 cinit(const f32x16&negm){ if constexpr(NA){ f32x16 z=f32x16{}; return z; } else return negm; }
constexpr int UP=3328, OP=1024;
struct AJob { const bf16*U; bf16*MX; unsigned qo, ko, vo, go, oo; int NT, tile0a, na, tile0b; int qr0, rmin; const float*rpb; };
__device__ __forceinline__ u32x4 gate8(u32x4 v,u32x4 g);
template<int THRL,bool NA> __device__ __forceinline__ void attn_unit(const AJob&J,char*shm){
  int tid_=threadIdx.x; asm volatile("":"+v"(tid_));
  const int tid=tid_,lane=tid&63,r32=lane&31,hi=lane>>5; const int wid=__builtin_amdgcn_readfirstlane(tid>>6);
  const bf16*Qw=J.U+J.qo+(long)(wid*QBLK)*UP;
  const bf16*Kh=J.U+J.ko,*Vh=J.U+J.vo;
  const unsigned lds0=(unsigned)(uintptr_t)shm;
  float*wsf=(float*)(shm+LDS_WS)+wid*64;
  const bf16*ksrc=Kh+(long)lane*UP+wid*8;
  const bf16*vsrc=Vh+(long)(16*(wid&3)+(lane>>2))*UP+(wid>>2)*32+(lane&3)*8;
  const unsigned kdst=lds0+LDS_K+wid*1024, vdst=lds0+LDS_V+wid*1024;
  #define TROW(t) (64L*(long)(((t)<J.na)?(J.tile0a+(t)):(J.tile0b+((t)-J.na))))
  #define DMA_K(t,slot) glds16(ksrc+TROW(t)*UP,(unsigned)__builtin_amdgcn_readfirstlane(kdst+(slot)))
  #define DMA_V(t,slot) glds16(vsrc+TROW(t)*UP,(unsigned)__builtin_amdgcn_readfirstlane(vdst+(slot)))
  const int vb0=(int)(lds0+LDS_V)+((lane>>4)&1)*32+(lane&3)*8+(4*hi+((lane&15)>>2))*64;
  const char*Kbase=shm+LDS_K; bf16x8 kf[8];
  const lds_cptr shm3=(lds_cptr)shm; const lds_cptr kp0=shm3+LDS_K+hi*1024+r32*16; const lds_cptr vp0=shm3+LDS_V+((lane>>4)&1)*32+(lane&3)*8+(4*hi+((lane&15)>>2))*64;
  const int NT=J.NT;
  NaCtx nac; nac.tab=(lds_fptr)(shm+LDS_BIAS)+64; nac.rmin=J.rmin; nac.qr=J.qr0+(wid>>1); nac.qc=32*(wid&1)+r32;
  { int a=nac.qr-4; a=a<0?0:(a>248?248:a); nac.row0=a; int b=nac.qc-8; b=b<0?0:(b>48?48:b); nac.col0=b; }
  if(NA){ if(J.rpb){ for(int e=tid;e<465;e+=512)((__attribute__((address_space(3))) float*)(shm+LDS_BIAS))[64+e]=J.rpb[e]*1.4426950408889634f; } }
  DMA_K(0,0);DMA_V(0,0);DMA_K(1,SLOTB);
  bf16x8 qr[4];
  #pragma unroll
  for(int d0=0;d0<4;++d0)qr[d0]=*reinterpret_cast<const bf16x8*>(&Qw[(long)r32*UP+d0*16+hi*8]);
  float mhat=0.f,l_reg=0.f;f32x16 o[2];o[0]=f32x16{};o[1]=f32x16{};f32x16 negm=f32x16{}; if constexpr(!NA) asm volatile("":"+v"(negm));
  #define CMASK(P0,P1,t) do{ if constexpr(NA) namask(P0,P1,(t),nac,hi); }while(0)
  bool resc=false;
  #define START(P0,P1) do{ const float rm=rowmax(P0,P1); resc=false; \
    { const float dl=rm; mhat=fadd_s(mhat,dl); \
      _Pragma("unroll") for(int r=0;r<16;++r){P0[r]=fsub_s(P0[r],dl);P1[r]=fsub_s(P1[r],dl);} \
      if constexpr(!NA){ _Pragma("unroll") for(int r=0;r<16;++r)negm[r]=-mhat; asm volatile("":"+v"(negm)); } } \
    _Pragma("unroll") for(int r=0;r<16;++r)P0[r]=__builtin_amdgcn_exp2f(P0[r]); }while(0)
  #define RESC() do{ if(resc){ asm volatile("s_waitcnt lgkmcnt(0)":::"memory"); \
      _Pragma("unroll") for(int d_=0;d_<2;++d_) _Pragma("unroll") for(int r=0;r<16;++r)o[d_][r]*=wsf[crow(r,hi)]; } }while(0)
  f32x16 pA0,pA1,pB0,pB1;
  int sl_prev=0,sl_cur=0,sl_next=SLOTB;
  #define ROT() do{sl_prev=sl_cur;sl_cur=sl_next;sl_next=(sl_next==(NSLOT-1)*SLOTB)?0:sl_next+SLOTB;}while(0)
  DMA_K(2,2*SLOTB);
  WAIT_BAR(3);
  qkt(pA0,pA1,Kbase,qr,cinit<NA>(negm),r32,hi);asm volatile("s_nop 15\n\ts_nop 7":"+v"(pA0),"+v"(pA1));CMASK(pA0,pA1,0);
  START(pA0,pA1);
  _Pragma("unroll") for(int r=0;r<16;++r)pA1[r]=__builtin_amdgcn_exp2f(pA1[r]);
  WAIT_BAR(0);
  DMA_K(3,0);DMA_V(1,SLOTB);
  ROT();
  kload8(kf,kp0+sl_cur);
  WAIT_BAR(2);
  s16x4 vlo[8],vhi[8]; u32x4 pw0,pw1,pw2,pw3;
  #define PKW(P,B) cvtpk_s(P[B],P[B+1])
  #define PAF(k) __builtin_bit_cast(bf16x8,pw##k)
  #define VFR(i) (bf16x8){vlo[i][0],vlo[i][1],vlo[i][2],vlo[i][3],vhi[i][0],vhi[i][1],vhi[i][2],vhi[i][3]}
  #define PIN(x) asm volatile("":"+v"(x))
  #define MX3(a,b,c) __builtin_fmaxf(__builtin_fmaxf((a),(b)),(c))
  #define GAPA(MF,A0,A1,A2,A3,W0,W1,PW) do{ MF; sacc+=A0; sacc+=A1; sacc+=A2; sacc+=A3; PIN(sacc); W0; W1; PIN(PW); SBAR(); }while(0)
  #define EX(v) __builtin_amdgcn_exp2f(v)
  #define GAPB(MF,X,B) do{ MF; X[B]=EX(X[B]); X[B+1]=EX(X[B+1]); X[B+2]=EX(X[B+2]); X[B+3]=EX(X[B+3]); PIN(X); SBAR(); }while(0)
  #define VRD(i) do{ vlo[i]=vtr(vp_+(((i)>>2)*4096+((i)&3)*1024)); vhi[i]=vtr(vp_+(((i)>>2)*4096+((i)&3)*1024+512)); }while(0)
  #define KRD(G,j) do{ if(G){ kload2(kf,kp0+sl_next,j); SBAR(); } }while(0)
  #define STEP(C0,C1,P0,P1,t,GK,GV,GL) do{ SBAR(); \
    const lds_cptr vp_=vp0+sl_prev; \
    VRD(0); SBAR(); float sacc=(P0[0]+P0[1]); \
    GAPA(C0=__builtin_amdgcn_mfma_f32_32x32x16_bf16(kf[0],qr[0],cinit<NA>(negm),0,0,0), P0[2],P0[3],P0[4],P0[5],     pw0[0]=PKW(P0,0), pw0[1]=PKW(P0,2), pw0); \
    VRD(4); SBAR(); GAPA(C1=__builtin_amdgcn_mfma_f32_32x32x16_bf16(kf[1],qr[0],cinit<NA>(negm),0,0,0), P0[6],P0[7],P0[8],P0[9],     pw0[2]=PKW(P0,4), pw0[3]=PKW(P0,6), pw0); \
    VRD(1); SBAR(); GAPA(C0=__builtin_amdgcn_mfma_f32_32x32x16_bf16(kf[2],qr[1],C0,0,0,0),   P0[10],P0[11],P0[12],P0[13], pw1[0]=PKW(P0,8), pw1[1]=PKW(P0,10), pw1); \
    VRD(5); SBAR(); GAPA(C1=__builtin_amdgcn_mfma_f32_32x32x16_bf16(kf[3],qr[1],C1,0,0,0),   P0[14],P0[15],P1[0],P1[1],   pw1[2]=PKW(P0,12),pw1[3]=PKW(P0,14), pw1); \
    VRD(2); SBAR(); GAPA(C0=__builtin_amdgcn_mfma_f32_32x32x16_bf16(kf[4],qr[2],C0,0,0,0),   P1[2],P1[3],P1[4],P1[5],     pw2[0]=PKW(P1,0), pw2[1]=PKW(P1,2), pw2); \
    VRD(6); SBAR(); GAPA(C1=__builtin_amdgcn_mfma_f32_32x32x16_bf16(kf[5],qr[2],C1,0,0,0),   P1[6],P1[7],P1[8],P1[9],     pw2[2]=PKW(P1,4), pw2[3]=PKW(P1,6), pw2); \
    VRD(3); SBAR(); GAPA(C0=__builtin_amdgcn_mfma_f32_32x32x16_bf16(kf[6],qr[3],C0,0,0,0),   P1[10],P1[11],P1[12],P1[13], pw3[0]=PKW(P1,8), pw3[1]=PKW(P1,10), pw3); \
    VRD(7); SBAR(); GAPA(C1=__builtin_amdgcn_mfma_f32_32x32x16_bf16(kf[7],qr[3],C1,0,0,0),   P1[14],P1[15],0.f,0.f,       pw3[2]=PKW(P1,12),pw3[3]=PKW(P1,14), pw3); \
    l_reg+=sacc; \
    if(GK){DMA_K((t)+3,sl_cur);} if(GV){DMA_V((t)+1,sl_next);} \
    if constexpr(NA){ _Pragma("unroll") for(int r=0;r<16;++r){C0[r]-=mhat;C1[r]-=mhat;} } \
    CMASK(C0,C1,t); \
    { float a=MX3(C0[0],C0[1],C1[0]),b=MX3(C0[2],C0[3],C1[1]); a=MX3(a,C1[2],C1[3]); \
      _Pragma("unroll") for(int r=4;r<16;r+=4){a=MX3(a,C0[r],C0[r+1]);b=MX3(b,C0[r+2],C0[r+3]);a=MX3(a,C1[r],C1[r+1]);b=MX3(b,C1[r+2],C1[r+3]);} \
      float rm=__builtin_fmaxf(a,b); { auto rr=__builtin_amdgcn_permlane32_swap(__float_as_uint(rm),__float_as_uint(rm),false,false); rm=__builtin_fmaxf(__uint_as_float(rr[0]),__uint_as_float(rr[1])); } \
      resc=false; \
      if(__builtin_expect(__any(rm>(float)THRL),0)){ const float dl=__builtin_fmaxf(rm,0.f); mhat+=dl; \
        _Pragma("unroll") for(int r=0;r<16;++r){C0[r]-=dl;C1[r]-=dl;} \
        if constexpr(!NA){ _Pragma("unroll") for(int r=0;r<16;++r)negm[r]=-mhat; asm volatile("":"+v"(negm)); } \
        const float f=__builtin_amdgcn_exp2f(-dl); l_reg*=f; if(hi==0)wsf[r32]=f; resc=true; } } \
    SBAR(); \
    GAPB(o[0]=__builtin_amdgcn_mfma_f32_32x32x16_bf16(PAF(0),VFR(0),o[0],0,0,0), C0,0); \
    GAPB(o[1]=__builtin_amdgcn_mfma_f32_32x32x16_bf16(PAF(0),VFR(4),o[1],0,0,0), C0,4); \
    KRD(GL,0); GAPB(o[0]=__builtin_amdgcn_mfma_f32_32x32x16_bf16(PAF(1),VFR(1),o[0],0,0,0), C0,8); \
    KRD(GL,1); GAPB(o[1]=__builtin_amdgcn_mfma_f32_32x32x16_bf16(PAF(1),VFR(5),o[1],0,0,0), C0,12); \
    KRD(GL,2); GAPB(o[0]=__builtin_amdgcn_mfma_f32_32x32x16_bf16(PAF(2),VFR(2),o[0],0,0,0), C1,0); \
    KRD(GL,3); GAPB(o[1]=__builtin_amdgcn_mfma_f32_32x32x16_bf16(PAF(2),VFR(6),o[1],0,0,0), C1,4); \
    GAPB(o[0]=__builtin_amdgcn_mfma_f32_32x32x16_bf16(PAF(3),VFR(3),o[0],0,0,0), C1,8); \
    GAPB(o[1]=__builtin_amdgcn_mfma_f32_32x32x16_bf16(PAF(3),VFR(7),o[1],0,0,0), C1,12); \
    }while(0)
  int t=1;
  for(;t+5<NT;t+=2){
    STEP(pB0,pB1,pA0,pA1,t,true,true,true);     WAIT_BAR(2); RESC(); ROT();
    STEP(pA0,pA1,pB0,pB1,t+1,true,true,true);   WAIT_BAR(2); RESC(); ROT();
  }
  #define ENDW(tt) do{ if((tt)+3<NT){WAIT_BAR(2);} else if((tt)+2<NT){WAIT_BAR(1);} else {WAIT_BAR(0);} }while(0)
  for(;t+1<NT;t+=2){
    STEP(pB0,pB1,pA0,pA1,t,(t+3<NT),(t+1<NT),(t+1<NT));       ENDW(t);   RESC(); ROT();
    STEP(pA0,pA1,pB0,pB1,t+1,(t+4<NT),(t+2<NT),(t+2<NT));     ENDW(t+1); RESC(); ROT();
  }
  STEP(pB0,pB1,pA0,pA1,NT-1,false,false,false); RESC();
  { float sacc=pB0[0]+pB0[1]; _Pragma("unroll") for(int r=2;r<16;++r)sacc+=pB0[r]; _Pragma("unroll") for(int r=0;r<16;++r)sacc+=pB1[r]; l_reg+=sacc;
    pw0=(u32x4){PKW(pB0,0),PKW(pB0,2),PKW(pB0,4),PKW(pB0,6)};pw1=(u32x4){PKW(pB0,8),PKW(pB0,10),PKW(pB0,12),PKW(pB0,14)};pw2=(u32x4){PKW(pB1,0),PKW(pB1,2),PKW(pB1,4),PKW(pB1,6)};pw3=(u32x4){PKW(pB1,8),PKW(pB1,10),PKW(pB1,12),PKW(pB1,14)};
    SBAR(); pv(o,vb0+sl_cur,PAF(0),PAF(1),PAF(2),PAF(3)); }
  #undef PKW
  #undef PAF
  #undef VFR
  #undef PIN
  #undef MX3
  #undef GAPA
  #undef GAPB
  #undef EX
  #undef VRD
  #undef KRD
  #undef STEP
  #undef ENDW
  {auto rr=__builtin_amdgcn_permlane32_swap(__float_as_uint(l_reg),__float_as_uint(l_reg),false,false);l_reg=__uint_as_float(rr[0])+__uint_as_float(rr[1]);}
  if(hi==0)wsf[32+r32]=l_reg;asm volatile("s_waitcnt lgkmcnt(0)":::"memory");
  float rli[16];
  #pragma unroll
  for(int r=0;r<16;++r)rli[r]=__builtin_amdgcn_rcpf(wsf[32+crow(r,hi)]);
  bf16*Ow=J.MX+J.oo+(long)(wid*QBLK)*OP; const bf16*Gw=J.U+J.go+(long)(wid*QBLK)*UP;
  { bf16*stg=(bf16*)(shm+LDS_OST)+wid*2048;
    #pragma unroll
    for(int r=0;r<16;++r){const int orow=crow(r,hi);
      #pragma unroll
      for(int d0=0;d0<2;++d0)stg[orow*64+d0*32+r32]=__float2bfloat16(o[d0][r]*rli[r]);}
    asm volatile("s_waitcnt lgkmcnt(0)":::"memory");
    #pragma unroll
    for(int i=0;i<4;++i){const int row=i*8+(lane>>3),ch=lane&7; const u32x4 v=*(const u32x4*)(stg+row*64+ch*8); const u32x4 g=*(const u32x4*)(Gw+(long)row*UP+ch*8); ATTN_STORE16(Ow+(long)row*OP+ch*8,gate8(v,g));} }
  asm volatile("s_waitcnt lgkmcnt(0)\n\ts_barrier":::"memory");
  #undef DMA_K
  #undef TROW
  #undef DMA_V
  #undef CMASK
  #undef START
  #undef RESC
  #undef ROT
}
constexpr int ATTN_LDS_BYTES=LDS_BYTES;
__device__ __forceinline__ u32x4 gate8(u32x4 v,u32x4 g){ u32x4 r;
  #pragma unroll
  for(int i=0;i<4;++i){ const float a0=__uint_as_float(v[i]<<16)*__uint_as_float(g[i]<<16), a1=__uint_as_float(v[i]&0xffff0000u)*__uint_as_float(g[i]&0xffff0000u); r[i]=cvtpk_s(a0,a1); }
  return r; }
#undef SBAR
#undef WAIT_BAR
}
#define GAS __attribute__((address_space(1)))
#define LAS __attribute__((address_space(3)))
typedef GAS unsigned gu32;
#define RLX_AGENT __ATOMIC_RELAXED, __HIP_MEMORY_SCOPE_AGENT
#define XB_TMO      128
#define XB_XCNT(j)  (256  + 64 * (j))
#define XB_XSUB(j)  (1280 + 64 * (j))
#define XB_XGEN(j)  (2304 + 64 * (j))
#define XB_TOP      3328
#define XB_TOPGEN   3392
#define XCD_BAR_WORDS 3456
#define XB_SPIN_CAP (1u << 20)

__device__ __forceinline__ unsigned xb_ld(unsigned* p)              { return __hip_atomic_load(p, __ATOMIC_RELAXED, __HIP_MEMORY_SCOPE_AGENT); }
__device__ __forceinline__ unsigned xb_add(unsigned* p, unsigned v) { return __hip_atomic_fetch_add(p, v, __ATOMIC_RELAXED, __HIP_MEMORY_SCOPE_AGENT); }
__device__ __forceinline__ unsigned xb_xcc_id() { return (unsigned)__builtin_amdgcn_s_getreg((3 << 11) | 20) & 0xFu; }
#define XB_SPIN(cond, bar) do { unsigned _sp = 0; while (cond) { __builtin_amdgcn_s_sleep(1); \
    if ((++_sp & 255u) == 0u) { if (xb_ld(&(bar)[XB_TMO])) break; if (_sp > XB_SPIN_CAP) { atomicAdd(&(bar)[XB_TMO], 1u); break; } } } } while (0)

struct XcdBarrier {
    unsigned* bar; unsigned x;
    volatile LAS unsigned* st;
};

__device__ __forceinline__ XcdBarrier xcd_barrier_post(unsigned* bar, volatile LAS unsigned* st) {
    XcdBarrier b; b.bar = bar; b.x = xb_xcc_id(); b.st = st;
    if (threadIdx.x == 0) (void)xb_add(&bar[XB_XCNT(b.x)], 1u);
    return b;
}
__device__ __forceinline__ void xcd_barrier_complete(unsigned* bar, unsigned x, unsigned& nloc, unsigned& nx) {
    const unsigned G = gridDim.x * gridDim.y * gridDim.z;
    unsigned sum, cnt, mine, sp = 0u;
    for (;;) {
        sum = 0u; cnt = 0u; mine = 0u;
#pragma unroll
        for (unsigned j = 0; j < 16; ++j) { const unsigned c = xb_ld(&bar[XB_XCNT(j)]); sum += c; cnt += (c > 0u) ? 1u : 0u; mine = (j == x) ? c : mine; }
        if (sum == G) break;
        __builtin_amdgcn_s_sleep(1);
        if ((++sp & 255u) == 0u) { if (xb_ld(&bar[XB_TMO])) break; if (sp > XB_SPIN_CAP) { atomicAdd(&bar[XB_TMO], 1u); break; } }
    }
    nloc = mine > 0u ? mine : 1u; nx = cnt > 0u ? cnt : 1u;
}

__device__ __forceinline__ void xcd_barrier(const XcdBarrier& b) {
    asm volatile("s_waitcnt vmcnt(0)" ::: "memory");
    __syncthreads();
    if (threadIdx.x == 0) {
        unsigned* bar = b.bar;
        __builtin_amdgcn_s_waitcnt(0);
        unsigned nloc = b.st[0], nx = b.st[1];
        if (nloc == 0u) { xcd_barrier_complete(bar, b.x, nloc, nx); b.st[0] = nloc; b.st[1] = nx; }
        const unsigned old = xb_add(&bar[XB_XSUB(b.x)], 1u);
        const unsigned gen = old / nloc;
        if (old + 1u == (gen + 1u) * nloc) {
            __builtin_amdgcn_fence(__ATOMIC_RELEASE, "agent");
            asm volatile("s_waitcnt vmcnt(0)" ::: "memory");
            const unsigned og = xb_add(&bar[XB_TOP], 1u);
            const unsigned tg = og / nx;
            if (og + 1u == (tg + 1u) * nx) xb_add(&bar[XB_TOPGEN], 1u);
            else XB_SPIN(xb_ld(&bar[XB_TOPGEN]) == tg, bar);
            __builtin_amdgcn_fence(__ATOMIC_ACQUIRE, "agent");
            xb_add(&bar[XB_XGEN(b.x)], 1u);
            asm volatile("s_waitcnt vmcnt(0)" ::: "memory");
        } else {
            XB_SPIN(xb_ld(&bar[XB_XGEN(b.x)]) == gen, bar);
            __builtin_amdgcn_fence(__ATOMIC_ACQUIRE, "agent");
            asm volatile("s_waitcnt vmcnt(0)" ::: "memory");
        }
    }
    __syncthreads();
}

constexpr int CW_BAR = 4096;
__device__ __forceinline__ void ph_attention(const Ctx& C, int i, unsigned char* lds) {
    using namespace attn_body;
    const bf16* U = (const bf16*)(C.ws + WS_U); bf16* MX = (bf16*)(C.ws + WS_XN);
    const float* rpb = C.in[I_RPB] + (size_t)i * 8 * 465;
    for (int p = C.vcu; p < 1040; p += C.G) {
        int kind, h, qb;
        if (p < 512) { kind = 0; h = (p & 255) >> 5; qb = (p & 31) + 32 * (p >> 8); }
        else if (p < 1024) { kind = 1; const int q = p - 512; h = (q & 255) >> 5; qb = (q & 31) + 32 * (q >> 8); }
        else if (p < 1032) { kind = 0; h = p - 1024; qb = 64; }
        else { kind = 1; h = p - 1032; qb = 64; }
        const unsigned r0 = 256u * (unsigned)qb;
        AJob J; J.U = U; J.MX = MX;
        if (kind == 0) {
            J.qo = r0 * AIN + 2048 + 64 * h; J.ko = 2560 + 64 * (h >> 2); J.vo = 2688 + 64 * (h >> 2); J.oo = r0 * DM + 512 + 64 * h; J.go = r0 * AIN + 2816 + 64 * h;
            if (qb < 64) { J.NT = 260; J.tile0a = 0; J.na = 260; J.tile0b = 0; } else { J.NT = 4; J.tile0a = 256; J.na = 4; J.tile0b = 0; }
            J.qr0 = 0; J.rmin = 0; J.rpb = nullptr;
            attn_unit<8, false>(J, (char*)lds);
        } else {
            J.qo = r0 * AIN + 64 * h; J.ko = 512 + 64 * h; J.vo = 1024 + 64 * h; J.oo = r0 * DM + 64 * h; J.go = r0 * AIN + 1536 + 64 * h;
            J.tile0a = 256; J.na = 4; J.qr0 = 4 * qb;
            if (qb < 64) { int rm = 4 * qb - 4; rm = rm < 0 ? 0 : (rm > 248 ? 248 : rm); J.NT = 16; J.tile0b = rm; J.rmin = rm; J.rpb = rpb + (size_t)h * 465; }
            else { J.NT = 4; J.tile0b = 0; J.rmin = 0; J.rpb = nullptr; }
            attn_unit<8, true>(J, (char*)lds);
        }
    }
}

struct Args { const float* in[N_IN]; float* out; unsigned char* ws; int ph_lo, ph_hi; };
typedef __attribute__((address_space(4))) const Args* KArgP;
__global__ void __launch_bounds__(NTHREADS, 2) mk_fwd(Args args) {
    extern __shared__ __attribute__((aligned(16))) unsigned char lds[];
    volatile LAS unsigned* MISC = (volatile LAS unsigned*)((LAS unsigned char*)lds + MISC_OFF);
    if (threadIdx.x < 64) MISC[threadIdx.x] = 0u;
    __syncthreads();
    XcdBarrier bar = xcd_barrier_post((unsigned*)(args.ws + WS_CTL) + CW_BAR, MISC + 8);
    const int lo = args.ph_lo, hi = args.ph_hi;
    int pc = 0;
#define PHASE(...) do { if (pc >= lo && pc < hi) { KArgP ap = (KArgP)__builtin_amdgcn_kernarg_segment_ptr(); asm volatile("" : "+s"(ap)); Ctx C; \
        _Pragma("unroll") for (int k = 0; k < N_IN; ++k) C.in[k] = ap->in[k]; C.out = ap->out; C.ws = ap->ws; \
        { int t_ = threadIdx.x; asm volatile("" : "+v"(t_)); C.tid = t_; } C.lane = C.tid & 63; C.wave = __builtin_amdgcn_readfirstlane(C.tid >> 6); \
        C.G = gridDim.x; { const int bx = blockIdx.x; C.vcu = (C.G % 8 == 0) ? (bx % 8) * (C.G / 8) + bx / 8 : bx; } \
        float* XCTX = (float*)(C.ws + WS_XCTX); unsigned char* ldsg = (unsigned char*)lds; unsigned char* wsp = C.ws; (void)XCTX; (void)ldsg; (void)wsp; \
        const float* xl = layer == 0 ? C.in[I_X] : C.out; const float* xc = layer == 0 ? C.in[I_CTX] : XCTX; (void)xl; (void)xc; \
        const float* ADA = (const float*)(C.ws + WS_ADA) + (size_t)layer * 2 * 3072; (void)ADA; \
        __VA_ARGS__; if (pc + 1 < hi) xcd_barrier(bar); } ++pc; } while (0)
#ifndef PH_MASK
#define PH_MASK 0xFFFF
#endif
#define EN(b) if ((PH_MASK >> (b)) & 1)

    { const int layer = 0; PHASE(EN(0) ph_prologue(C, ldsg)); }
    for (int layer = 0; layer < 4; ++layer) {
        const int i = layer >> 1;
        const bool ctx_out = layer < 3;
        PHASE(EN(1) ph_norm(C, layer, xl, xc, true));
        if ((layer & 1) == 0) {
            PHASE(EN(2) { pg8::Gemm g{(const pg8::bf16_t*)(wsp + WS_XN), (const pg8::bf16_t*)(wsp + WS_XN) + DM / 2, DM, (const pg8::bf16_t*)(wsp + WS_WAIN) + (size_t)i * AIN * DM, NTOK, AIN, DM};
                    pg8::StaticOrder S; S.init(NTOK, AIN, C.G, (int)blockIdx.x); pg8::EpiIn<0> E{wsp};
                    pg8::gemm_phase<pg8::EpiIn<0>, pg8::StaticOrder, true, true>((LAS unsigned char*)lds, g, S, E); });
            PHASE(EN(3) ph_qkprep(C, i));
            PHASE(EN(4) ph_attention(C, i, ldsg));
            PHASE(EN(5) { pg8::Gemm g{(const pg8::bf16_t*)(wsp + WS_XN), (const pg8::bf16_t*)(wsp + WS_XN) + DM / 2, DM, (const pg8::bf16_t*)(wsp + WS_WAOUT) + (size_t)i * DM * DM, NTOK, DM, DM};
                    pg8::StaticOrder S; S.init(NTOK, DM, C.G, (int)blockIdx.x); pg8::EpiRes E{xl, xc, C.out, XCTX, ADA + 2048, ADA + 3072 + 2048};
                    pg8::gemm_phase<pg8::EpiRes, pg8::StaticOrder, true, true>((LAS unsigned char*)lds, g, S, E); });
        } else {
            PHASE(EN(6) { pg8::Gemm g{(const pg8::bf16_t*)(wsp + WS_XN), (const pg8::bf16_t*)(wsp + WS_XN) + DM / 2, DM, (const pg8::bf16_t*)(wsp + WS_WRIN) + (size_t)i * RINP * DM, NTOK, RINP, DM};
                    pg8::StaticOrder S; S.init(NTOK, RINP, C.G, (int)blockIdx.x); pg8::EpiIn<1> E{wsp};
                    pg8::gemm_phase<pg8::EpiIn<1>, pg8::StaticOrder, true, true>((LAS unsigned char*)lds, g, S, E); });
            PHASE(EN(7) ph_hyprep(C, i, ctx_out, ldsg));
            PHASE(EN(8) ph_scan_hyena(C, i, ctx_out, ldsg));
            PHASE(EN(9) ph_readout_hyout(C, i, ctx_out, ldsg));
            const int Mo = ctx_out ? NTOK : NLAT;
            PHASE(EN(10) { pg8::Gemm g{(const pg8::bf16_t*)(wsp + WS_YF), (const pg8::bf16_t*)(wsp + WS_HYOUT), 512, (const pg8::bf16_t*)(wsp + WS_WROUT) + (size_t)i * DM * DM, Mo, DM, DM};
                    pg8::StaticOrder S; S.init(Mo, DM, C.G, (int)blockIdx.x); pg8::EpiRes E{xl, xc, C.out, XCTX, ADA + 2048, ADA + 3072 + 2048};
                    pg8::gemm_phase<pg8::EpiRes, pg8::StaticOrder, true, true>((LAS unsigned char*)lds, g, S, E); });
        }
    }
    { const int layer = 3; PHASE(EN(11) ph_final(C)); }
#undef PHASE
}
constexpr int N_PHASES = 1 + 2 * 5 + 2 * 6 + 1;

#ifndef MK_SPLIT
#define MK_SPLIT 0
#endif
extern "C" void kernel_launch(void* const* d_in, const int* in_sizes, int n_in, void* d_out, int out_size, void* d_ws, size_t ws_size, hipStream_t stream) {
    static int grid = 0;
    if (grid == 0) {
        if (n_in != N_IN || out_size != NLAT * DM || ws_size < WS_END) { fprintf(stderr, "kernel_launch: unexpected shapes (n_in %d out %d ws %zu)\n", n_in, out_size, ws_size); grid = -1; return; }
        int dev = 0, cus = 0, per_cu = 0;
        if (hipGetDevice(&dev) != hipSuccess || hipDeviceGetAttribute(&cus, hipDeviceAttributeMultiprocessorCount, dev) != hipSuccess) { grid = -1; return; }
        if (hipFuncSetAttribute((const void*)mk_fwd, hipFuncAttributeMaxDynamicSharedMemorySize, LDS_BYTES) != hipSuccess) { fprintf(stderr, "kernel_launch: hipFuncSetAttribute failed\n"); grid = -1; return; }
        if (hipOccupancyMaxActiveBlocksPerMultiprocessor(&per_cu, (const void*)mk_fwd, NTHREADS, LDS_BYTES) != hipSuccess || per_cu < 1) fprintf(stderr, "kernel_launch: occupancy query says %d\n", per_cu);
        (void)hipGetLastError();
        grid = cus;
    }
    if (grid < 0) return;
    (void)hipMemsetAsync((char*)d_ws + WS_CTL, 0, CTL_ZERO_BYTES, stream);
    Args a{};
    for (int k = 0; k < N_IN; ++k) a.in[k] = (const float*)d_in[k];
    a.out = (float*)d_out; a.ws = (unsigned char*)d_ws;
#if MK_SPLIT
    for (int p = 0; p < N_PHASES; ++p) { a.ph_lo = p; a.ph_hi = p + 1; hipLaunchKernelGGL(mk_fwd, dim3(grid), dim3(NTHREADS), LDS_BYTES, stream, a); }
#else
    a.ph_lo = 0; a.ph_hi = N_PHASES;
    hipLaunchKernelGGL(mk_fwd, dim3(grid), dim3(NTHREADS), LDS_BYTES, stream, a);
#endif
}
```

```cpp
#ifndef EMU
#include <hip/hip_runtime.h>
#endif
#include <cstdio>
#include <cstdint>
#include <cmath>

constexpr int DM = 1024, NLAT = 16384, NCTX = 256, NTOK = NLAT + NCTX;
constexpr int GRIDW = 64, GRIDH = 256;
constexpr int AIN = 3328;
constexpr int RIN = 4224, RINP = 4352;
constexpr int URW_W = 2176;
constexpr int UHY_W = 1536;
constexpr int NWAVES = 8, NTHREADS = 512;
constexpr float C2 = 0.125f * 1.4426950408889634f;
constexpr float LOG2E = 1.4426950408889634f;
constexpr float NORM_EPS = 1e-6f;

typedef unsigned short bf16_t;

constexpr size_t MiB = 1u << 20;
constexpr size_t WS_CTL = 0, CTL_ZERO_BYTES = 256 * 1024;
constexpr size_t WS_ADA = 1 * MiB;
constexpr size_t WS_TW = WS_ADA + 128 * 1024;
constexpr size_t WS_HID256 = WS_TW + 160 * 1024;
constexpr size_t WS_BONUS = WS_HID256 + 64 * 1024;
constexpr size_t WS_XCTX = 3 * MiB;
constexpr size_t WS_VXC = 4 * MiB;
constexpr size_t WS_HID = 6 * MiB;
constexpr size_t WS_WAIN = 14 * MiB;
constexpr size_t WS_WAOUT = 27 * MiB;
constexpr size_t WS_WRIN = 31 * MiB;
constexpr size_t WS_WROUT = 48 * MiB;
constexpr size_t WS_XN = 52 * MiB;
constexpr size_t WS_U = 85 * MiB;
constexpr size_t WS_UHY = 155 * MiB;
constexpr size_t WS_GHY = 204 * MiB;
constexpr size_t WS_VX0 = 52 * MiB, WS_VX1 = 68 * MiB;
constexpr size_t WS_VX2 = 221 * MiB;
constexpr size_t WS_YHY = 155 * MiB;
constexpr size_t WS_YB = 171 * MiB;
constexpr size_t WS_YF = 187 * MiB + 512 * 1024;
constexpr size_t WS_HYOUT = 238 * MiB;
constexpr size_t WS_END = 256 * MiB;
static_assert(WS_U + (size_t)NTOK * AIN * 2 <= WS_END, "U attn");
static_assert(WS_U + (size_t)NTOK * URW_W * 2 <= WS_UHY && WS_UHY + (size_t)NTOK * UHY_W * 2 <= WS_GHY && WS_GHY + (size_t)NTOK * 512 * 2 <= WS_VX2, "rec map 1");
static_assert(WS_VX2 + (size_t)512 * 16384 * 2 <= WS_HYOUT && WS_HYOUT + (size_t)NTOK * 512 * 2 <= WS_END, "rec map 2");
static_assert(WS_YHY + (size_t)512 * 16384 * 2 <= WS_YB && WS_YB + (size_t)NTOK * 512 * 2 <= WS_YF && WS_YF + (size_t)NTOK * 512 * 2 <= WS_GHY, "rec map 3");
static_assert(WS_XN + (size_t)NTOK * DM * 2 <= WS_U && WS_VX1 + (size_t)512 * 16384 * 2 <= WS_U, "xn map");

constexpr int LDS_BYTES = 160 * 1024;
constexpr int MISC_OFF = LDS_BYTES - 256;
constexpr int RING_BYTES = MISC_OFF;

#ifdef EMU
#define DEVFN inline
#else
#define DEVFN __device__ __forceinline__
#endif

DEVFN float bf2f(bf16_t h) { union { unsigned u; float f; } x; x.u = ((unsigned)h) << 16; return x.f; }
DEVFN unsigned f2bf(float f) { union { unsigned u; float f; } x; x.f = f; unsigned u = x.u; return (u + 0x7fffu + ((u >> 16) & 1u)) >> 16; }
DEVFN unsigned pk2(float lo, float hi) { return f2bf(lo) | (f2bf(hi) << 16); }
DEVFN float bflo(unsigned w) { union { unsigned u; float f; } x; x.u = w << 16; return x.f; }
DEVFN float bfhi(unsigned w) { union { unsigned u; float f; } x; x.u = w & 0xffff0000u; return x.f; }
struct U4 { unsigned x, y, z, w; };
struct U2 { unsigned x, y; };
struct F2 { float x, y; };
struct F4 { float x, y, z, w; };
DEVFN float silu_f(float v) { return v / (1.0f + expf(-v)); }
DEVFN float sigmoid_f(float v) { return 1.0f / (1.0f + expf(-v)); }
#define SCAN_CHUNK_ASM \
    "ds_read_b128 v[96:99], %[ab] offset:24576\n\t" \
    "ds_read_b128 v[100:103], %[ab] offset:0\n\t" \
    "ds_read_b128 v[104:107], %[ab] offset:16384\n\t" \
    "ds_read_b128 v[108:111], %[ab] offset:8192\n\t" \
    "ds_read_b128 v[112:115], %[ab] offset:32768\n\t" \
    "ds_read_b32 v116, %[av] offset:0\n\t" \
    "s_waitcnt lgkmcnt(0)\n\t" \
    "ds_read_b128 v[118:121], %[ab] offset:24832\n\t" \
    "ds_read_b128 v[122:125], %[ab] offset:256\n\t" \
    "ds_read_b128 v[126:129], %[ab] offset:16640\n\t" \
    "ds_read_b128 v[130:133], %[ab] offset:8448\n\t" \
    "ds_read_b128 v[134:137], %[ab] offset:33024\n\t" \
    "ds_read_b32 v138, %[av] offset:64\n\t" \
    "v_pk_mul_f32 v[140:141], %[s01], v[96:97]\n\t" \
    "v_pk_fma_f32 v[140:141], %[s23], v[98:99], v[140:141]\n\t" \
    "v_add_f32 v146, v140, v141\n\t" \
    "v_pk_mul_f32 v[142:143], %[s01], v[100:101]\n\t" \
    "v_pk_mul_f32 v[144:145], %[s23], v[102:103]\n\t" \
    "v_add_f32_dpp v146, v146, v146 quad_perm:[1,0,3,2] row_mask:0xf bank_mask:0xf bound_ctrl:1\n\t" \
    "v_add_f32_dpp %[yp], %[yp], %[yp] quad_perm:[1,0,3,2] row_mask:0xf bank_mask:0xf bound_ctrl:1\n\t" \
    "v_pk_fma_f32 v[142:143], v[116:117], v[108:109], v[142:143] op_sel_hi:[0,1,1]\n\t" \
    "v_add_f32_dpp v146, v146, v146 quad_perm:[2,3,0,1] row_mask:0xf bank_mask:0xf bound_ctrl:1\n\t" \
    "v_add_f32_dpp %[yp], %[yp], %[yp] quad_perm:[2,3,0,1] row_mask:0xf bank_mask:0xf bound_ctrl:1\n\t" \
    "v_pk_fma_f32 v[144:145], v[116:117], v[110:111], v[144:145] op_sel_hi:[0,1,1]\n\t" \
    "v_add_f32_dpp v146, v146, v146 row_half_mirror row_mask:0xf bank_mask:0xf bound_ctrl:1\n\t" \
    "v_add_f32_dpp %[yp], %[yp], %[yp] row_half_mirror row_mask:0xf bank_mask:0xf bound_ctrl:1\n\t" \
    "v_cmp_eq_u32_e32 vcc, 15, %[sp]\n\t" \
    "v_add_f32_dpp v146, v146, v146 row_mirror row_mask:0xf bank_mask:0xf bound_ctrl:1\n\t" \
    "v_add_f32_dpp %[yp], %[yp], %[yp] row_mirror row_mask:0xf bank_mask:0xf bound_ctrl:1\n\t" \
    "v_cndmask_b32_e32 %[yk0], %[yk0], %[yp], vcc\n\t" \
    "v_pk_fma_f32 %[s01], v[146:147], v[104:105], v[142:143] op_sel_hi:[0,1,1] neg_lo:[1,0,0] neg_hi:[1,0,0]\n\t" \
    "v_pk_fma_f32 %[s23], v[146:147], v[106:107], v[144:145] op_sel_hi:[0,1,1] neg_lo:[1,0,0] neg_hi:[1,0,0]\n\t" \
    "v_pk_mul_f32 v[140:141], %[s01], v[112:113]\n\t" \
    "v_pk_fma_f32 v[140:141], %[s23], v[114:115], v[140:141]\n\t" \
    "v_add_f32 %[yp], v140, v141\n\t" \
    "s_waitcnt lgkmcnt(0)\n\t" \
    "ds_read_b128 v[96:99], %[ab] offset:25088\n\t" \
    "ds_read_b128 v[100:103], %[ab] offset:512\n\t" \
    "ds_read_b128 v[104:107], %[ab] offset:16896\n\t" \
    "ds_read_b128 v[108:111], %[ab] offset:8704\n\t" \
    "ds_read_b128 v[112:115], %[ab] offset:33280\n\t" \
    "ds_read_b32 v116, %[av] offset:128\n\t" \
    "v_pk_mul_f32 v[140:141], %[s01], v[118:119]\n\t" \
    "v_pk_fma_f32 v[140:141], %[s23], v[120:121], v[140:141]\n\t" \
    "v_add_f32 v146, v140, v141\n\t" \
    "v_pk_mul_f32 v[142:143], %[s01], v[122:123]\n\t" \
    "v_pk_mul_f32 v[144:145], %[s23], v[124:125]\n\t" \
    "v_add_f32_dpp v146, v146, v146 quad_perm:[1,0,3,2] row_mask:0xf bank_mask:0xf bound_ctrl:1\n\t" \
    "v_add_f32_dpp %[yp], %[yp], %[yp] quad_perm:[1,0,3,2] row_mask:0xf bank_mask:0xf bound_ctrl:1\n\t" \
    "v_pk_fma_f32 v[142:143], v[138:139], v[130:131], v[142:143] op_sel_hi:[0,1,1]\n\t" \
    "v_add_f32_dpp v146, v146, v146 quad_perm:[2,3,0,1] row_mask:0xf bank_mask:0xf bound_ctrl:1\n\t" \
    "v_add_f32_dpp %[yp], %[yp], %[yp] quad_perm:[2,3,0,1] row_mask:0xf bank_mask:0xf bound_ctrl:1\n\t" \
    "v_pk_fma_f32 v[144:145], v[138:139], v[132:133], v[144:145] op_sel_hi:[0,1,1]\n\t" \
    "v_add_f32_dpp v146, v146, v146 row_half_mirror row_mask:0xf bank_mask:0xf bound_ctrl:1\n\t" \
    "v_add_f32_dpp %[yp], %[yp], %[yp] row_half_mirror row_mask:0xf bank_mask:0xf bound_ctrl:1\n\t" \
    "v_cmp_eq_u32_e32 vcc, 0, %[sp]\n\t" \
    "v_add_f32_dpp v146, v146, v146 row_mirror row_mask:0xf bank_mask:0xf bound_ctrl:1\n\t" \
    "v_add_f32_dpp %[yp], %[yp], %[yp] row_mirror row_mask:0xf bank_mask:0xf bound_ctrl:1\n\t" \
    "v_cndmask_b32_e32 %[yk0], %[yk0], %[yp], vcc\n\t" \
    "v_pk_fma_f32 %[s01], v[146:147], v[126:127], v[142:143] op_sel_hi:[0,1,1] neg_lo:[1,0,0] neg_hi:[1,0,0]\n\t" \
    "v_pk_fma_f32 %[s23], v[146:147], v[128:129], v[144:145] op_sel_hi:[0,1,1] neg_lo:[1,0,0] neg_hi:[1,0,0]\n\t" \
    "v_pk_mul_f32 v[140:141], %[s01], v[134:135]\n\t" \
    "v_pk_fma_f32 v[140:141], %[s23], v[136:137], v[140:141]\n\t" \
    "v_add_f32 %[yp], v140, v141\n\t" \
    "s_waitcnt lgkmcnt(0)\n\t" \
    "ds_read_b128 v[118:121], %[ab] offset:25344\n\t" \
    "ds_read_b128 v[122:125], %[ab] offset:768\n\t" \
    "ds_read_b128 v[126:129], %[ab] offset:17152\n\t" \
    "ds_read_b128 v[130:133], %[ab] offset:8960\n\t" \
    "ds_read_b128 v[134:137], %[ab] offset:33536\n\t" \
    "ds_read_b32 v138, %[av] offset:192\n\t" \
    "v_pk_mul_f32 v[140:141], %[s01], v[96:97]\n\t" \
    "v_pk_fma_f32 v[140:141], %[s23], v[98:99], v[140:141]\n\t" \
    "v_add_f32 v146, v140, v141\n\t" \
    "v_pk_mul_f32 v[142:143], %[s01], v[100:101]\n\t" \
    "v_pk_mul_f32 v[144:145], %[s23], v[102:103]\n\t" \
    "v_add_f32_dpp v146, v146, v146 quad_perm:[1,0,3,2] row_mask:0xf bank_mask:0xf bound_ctrl:1\n\t" \
    "v_add_f32_dpp %[yp], %[yp], %[yp] quad_perm:[1,0,3,2] row_mask:0xf bank_mask:0xf bound_ctrl:1\n\t" \
    "v_pk_fma_f32 v[142:143], v[116:117], v[108:109], v[142:143] op_sel_hi:[0,1,1]\n\t" \
    "v_add_f32_dpp v146, v146, v146 quad_perm:[2,3,0,1] row_mask:0xf bank_mask:0xf bound_ctrl:1\n\t" \
    "v_add_f32_dpp %[yp], %[yp], %[yp] quad_perm:[2,3,0,1] row_mask:0xf bank_mask:0xf bound_ctrl:1\n\t" \
    "v_pk_fma_f32 v[144:145], v[116:117], v[110:111], v[144:145] op_sel_hi:[0,1,1]\n\t" \
    "v_add_f32_dpp v146, v146, v146 row_half_mirror row_mask:0xf bank_mask:0xf bound_ctrl:1\n\t" \
    "v_add_f32_dpp %[yp], %[yp], %[yp] row_half_mirror row_mask:0xf bank_mask:0xf bound_ctrl:1\n\t" \
    "v_cmp_eq_u32_e32 vcc, 1, %[sp]\n\t" \
    "v_add_f32_dpp v146, v146, v146 row_mirror row_mask:0xf bank_mask:0xf bound_ctrl:1\n\t" \
    "v_add_f32_dpp %[yp], %[yp], %[yp] row_mirror row_mask:0xf bank_mask:0xf bound_ctrl:1\n\t" \
    "v_cndmask_b32_e32 %[yk0], %[yk0], %[yp], vcc\n\t" \
    "v_pk_fma_f32 %[s01], v[146:147], v[104:105], v[142:143] op_sel_hi:[0,1,1] neg_lo:[1,0,0] neg_hi:[1,0,0]\n\t" \
    "v_pk_fma_f32 %[s23], v[146:147], v[106:107], v[144:145] op_sel_hi:[0,1,1] neg_lo:[1,0,0] neg_hi:[1,0,0]\n\t" \
    "v_pk_mul_f32 v[140:141], %[s01], v[112:113]\n\t" \
    "v_pk_fma_f32 v[140:141], %[s23], v[114:115], v[140:141]\n\t" \
    "v_add_f32 %[yp], v140, v141\n\t" \
    "s_waitcnt lgkmcnt(0)\n\t" \
    "ds_read_b128 v[96:99], %[ab] offset:25600\n\t" \
    "ds_read_b128 v[100:103], %[ab] offset:1024\n\t" \
    "ds_read_b128 v[104:107], %[ab] offset:17408\n\t" \
    "ds_read_b128 v[108:111], %[ab] offset:9216\n\t" \
    "ds_read_b128 v[112:115], %[ab] offset:33792\n\t" \
    "ds_read_b32 v116, %[av] offset:256\n\t" \
    "v_pk_mul_f32 v[140:141], %[s01], v[118:119]\n\t" \
    "v_pk_fma_f32 v[140:141], %[s23], v[120:121], v[140:141]\n\t" \
    "v_add_f32 v146, v140, v141\n\t" \
    "v_pk_mul_f32 v[142:143], %[s01], v[122:123]\n\t" \
    "v_pk_mul_f32 v[144:145], %[s23], v[124:125]\n\t" \
    "v_add_f32_dpp v146, v146, v146 quad_perm:[1,0,3,2] row_mask:0xf bank_mask:0xf bound_ctrl:1\n\t" \
    "v_add_f32_dpp %[yp], %[yp], %[yp] quad_perm:[1,0,3,2] row_mask:0xf bank_mask:0xf bound_ctrl:1\n\t" \
    "v_pk_fma_f32 v[142:143], v[138:139], v[130:131], v[142:143] op_sel_hi:[0,1,1]\n\t" \
    "v_add_f32_dpp v146, v146, v146 quad_perm:[2,3,0,1] row_mask:0xf bank_mask:0xf bound_ctrl:1\n\t" \
    "v_add_f32_dpp %[yp], %[yp], %[yp] quad_perm:[2,3,0,1] row_mask:0xf bank_mask:0xf bound_ctrl:1\n\t" \
    "v_pk_fma_f32 v[144:145], v[138:139], v[132:133], v[144:145] op_sel_hi:[0,1,1]\n\t" \
    "v_add_f32_dpp v146, v146, v146 row_half_mirror row_mask:0xf bank_mask:0xf bound_ctrl:1\n\t" \
    "v_add_f32_dpp %[yp], %[yp], %[yp] row_half_mirror row_mask:0xf bank_mask:0xf bound_ctrl:1\n\t" \
    "v_cmp_eq_u32_e32 vcc, 2, %[sp]\n\t" \
    "v_add_f32_dpp v146, v146, v146 row_mirror row_mask:0xf bank_mask:0xf bound_ctrl:1\n\t" \
    "v_add_f32_dpp %[yp], %[yp], %[yp] row_mirror row_mask:0xf bank_mask:0xf bound_ctrl:1\n\t" \
    "v_cndmask_b32_e32 %[yk0], %[yk0], %[yp], vcc\n\t" \
    "v_pk_fma_f32 %[s01], v[146:147], v[126:127], v[142:143] op_sel_hi:[0,1,1] neg_lo:[1,0,0] neg_hi:[1,0,0]\n\t" \
    "v_pk_fma_f32 %[s23], v[146:147], v[128:129], v[144:145] op_sel_hi:[0,1,1] neg_lo:[1,0,0] neg_hi:[1,0,0]\n\t" \
    "v_pk_mul_f32 v[140:141], %[s01], v[134:135]\n\t" \
    "v_pk_fma_f32 v[140:141], %[s23], v[136:137], v[140:141]\n\t" \
    "v_add_f32 %[yp], v140, v141\n\t" \
    "s_waitcnt lgkmcnt(0)\n\t" \
    "ds_read_b128 v[118:121], %[ab] offset:25856\n\t" \
    "ds_read_b128 v[122:125], %[ab] offset:1280\n\t" \
    "ds_read_b128 v[126:129], %[ab] offset:17664\n\t" \
    "ds_read_b128 v[130:133], %[ab] offset:9472\n\t" \
    "ds_read_b128 v[134:137], %[ab] offset:34048\n\t" \
    "ds_read_b32 v138, %[av] offset:320\n\t" \
    "v_pk_mul_f32 v[140:141], %[s01], v[96:97]\n\t" \
    "v_pk_fma_f32 v[140:141], %[s23], v[98:99], v[140:141]\n\t" \
    "v_add_f32 v146, v140, v141\n\t" \
    "v_pk_mul_f32 v[142:143], %[s01], v[100:101]\n\t" \
    "v_pk_mul_f32 v[144:145], %[s23], v[102:103]\n\t" \
    "v_add_f32_dpp v146, v146, v146 quad_perm:[1,0,3,2] row_mask:0xf bank_mask:0xf bound_ctrl:1\n\t" \
    "v_add_f32_dpp %[yp], %[yp], %[yp] quad_perm:[1,0,3,2] row_mask:0xf bank_mask:0xf bound_ctrl:1\n\t" \
    "v_pk_fma_f32 v[142:143], v[116:117], v[108:109], v[142:143] op_sel_hi:[0,1,1]\n\t" \
    "v_add_f32_dpp v146, v146, v146 quad_perm:[2,3,0,1] row_mask:0xf bank_mask:0xf bound_ctrl:1\n\t" \
    "v_add_f32_dpp %[yp], %[yp], %[yp] quad_perm:[2,3,0,1] row_mask:0xf bank_mask:0xf bound_ctrl:1\n\t" \
    "v_pk_fma_f32 v[144:145], v[116:117], v[110:111], v[144:145] op_sel_hi:[0,1,1]\n\t" \
    "v_add_f32_dpp v146, v146, v146 row_half_mirror row_mask:0xf bank_mask:0xf bound_ctrl:1\n\t" \
    "v_add_f32_dpp %[yp], %[yp], %[yp] row_half_mirror row_mask:0xf bank_mask:0xf bound_ctrl:1\n\t" \
    "v_cmp_eq_u32_e32 vcc, 3, %[sp]\n\t" \
    "v_add_f32_dpp v146, v146, v146 row_mirror row_mask:0xf bank_mask:0xf bound_ctrl:1\n\t" \
    "v_add_f32_dpp %[yp], %[yp], %[yp] row_mirror row_mask:0xf bank_mask:0xf bound_ctrl:1\n\t" \
    "v_cndmask_b32_e32 %[yk0], %[yk0], %[yp], vcc\n\t" \
    "v_pk_fma_f32 %[s01], v[146:147], v[104:105], v[142:143] op_sel_hi:[0,1,1] neg_lo:[1,0,0] neg_hi:[1,0,0]\n\t" \
    "v_pk_fma_f32 %[s23], v[146:147], v[106:107], v[144:145] op_sel_hi:[0,1,1] neg_lo:[1,0,0] neg_hi:[1,0,0]\n\t" \
    "v_pk_mul_f32 v[140:141], %[s01], v[112:113]\n\t" \
    "v_pk_fma_f32 v[140:141], %[s23], v[114:115], v[140:141]\n\t" \
    "v_add_f32 %[yp], v140, v141\n\t" \
    "s_waitcnt lgkmcnt(0)\n\t" \
    "ds_read_b128 v[96:99], %[ab] offset:26112\n\t" \
    "ds_read_b128 v[100:103], %[ab] offset:1536\n\t" \
    "ds_read_b128 v[104:107], %[ab] offset:17920\n\t" \
    "ds_read_b128 v[108:111], %[ab] offset:9728\n\t" \
    "ds_read_b128 v[112:115], %[ab] offset:34304\n\t" \
    "ds_read_b32 v116, %[av] offset:384\n\t" \
    "v_pk_mul_f32 v[140:141], %[s01], v[118:119]\n\t" \
    "v_pk_fma_f32 v[140:141], %[s23], v[120:121], v[140:141]\n\t" \
    "v_add_f32 v146, v140, v141\n\t" \
    "v_pk_mul_f32 v[142:143], %[s01], v[122:123]\n\t" \
    "v_pk_mul_f32 v[144:145], %[s23], v[124:125]\n\t" \
    "v_add_f32_dpp v146, v146, v146 quad_perm:[1,0,3,2] row_mask:0xf bank_mask:0xf bound_ctrl:1\n\t" \
    "v_add_f32_dpp %[yp], %[yp], %[yp] quad_perm:[1,0,3,2] row_mask:0xf bank_mask:0xf bound_ctrl:1\n\t" \
    "v_pk_fma_f32 v[142:143], v[138:139], v[130:131], v[142:143] op_sel_hi:[0,1,1]\n\t" \
    "v_add_f32_dpp v146, v146, v146 quad_perm:[2,3,0,1] row_mask:0xf bank_mask:0xf bound_ctrl:1\n\t" \
    "v_add_f32_dpp %[yp], %[yp], %[yp] quad_perm:[2,3,0,1] row_mask:0xf bank_mask:0xf bound_ctrl:1\n\t" \
    "v_pk_fma_f32 v[144:145], v[138:139], v[132:133], v[144:145] op_sel_hi:[0,1,1]\n\t" \
    "v_add_f32_dpp v146, v146, v146 row_half_mirror row_mask:0xf bank_mask:0xf bound_ctrl:1\n\t" \
    "v_add_f32_dpp %[yp], %[yp], %[yp] row_half_mirror row_mask:0xf bank_mask:0xf bound_ctrl:1\n\t" \
    "v_cmp_eq_u32_e32 vcc, 4, %[sp]\n\t" \
    "v_add_f32_dpp v146, v146, v146 row_mirror row_mask:0xf bank_mask:0xf bound_ctrl:1\n\t" \
    "v_add_f32_dpp %[yp], %[yp], %[yp] row_mirror row_mask:0xf bank_mask:0xf bound_ctrl:1\n\t" \
    "v_cndmask_b32_e32 %[yk0], %[yk0], %[yp], vcc\n\t" \
    "v_pk_fma_f32 %[s01], v[146:147], v[126:127], v[142:143] op_sel_hi:[0,1,1] neg_lo:[1,0,0] neg_hi:[1,0,0]\n\t" \
    "v_pk_fma_f32 %[s23], v[146:147], v[128:129], v[144:145] op_sel_hi:[0,1,1] neg_lo:[1,0,0] neg_hi:[1,0,0]\n\t" \
    "v_pk_mul_f32 v[140:141], %[s01], v[134:135]\n\t" \
    "v_pk_fma_f32 v[140:141], %[s23], v[136:137], v[140:141]\n\t" \
    "v_add_f32 %[yp], v140, v141\n\t" \
    "s_waitcnt lgkmcnt(0)\n\t" \
    "ds_read_b128 v[118:121], %[ab] offset:26368\n\t" \
    "ds_read_b128 v[122:125], %[ab] offset:1792\n\t" \
    "ds_read_b128 v[126:129], %[ab] offset:18176\n\t" \
    "ds_read_b128 v[130:133], %[ab] offset:9984\n\t" \
    "ds_read_b128 v[134:137], %[ab] offset:34560\n\t" \
    "ds_read_b32 v138, %[av] offset:448\n\t" \
    "v_pk_mul_f32 v[140:141], %[s01], v[96:97]\n\t" \
    "v_pk_fma_f32 v[140:141], %[s23], v[98:99], v[140:141]\n\t" \
    "v_add_f32 v146, v140, v141\n\t" \
    "v_pk_mul_f32 v[142:143], %[s01], v[100:101]\n\t" \
    "v_pk_mul_f32 v[144:145], %[s23], v[102:103]\n\t" \
    "v_add_f32_dpp v146, v146, v146 quad_perm:[1,0,3,2] row_mask:0xf bank_mask:0xf bound_ctrl:1\n\t" \
    "v_add_f32_dpp %[yp], %[yp], %[yp] quad_perm:[1,0,3,2] row_mask:0xf bank_mask:0xf bound_ctrl:1\n\t" \
    "v_pk_fma_f32 v[142:143], v[116:117], v[108:109], v[142:143] op_sel_hi:[0,1,1]\n\t" \
    "v_add_f32_dpp v146, v146, v146 quad_perm:[2,3,0,1] row_mask:0xf bank_mask:0xf bound_ctrl:1\n\t" \
    "v_add_f32_dpp %[yp], %[yp], %[yp] quad_perm:[2,3,0,1] row_mask:0xf bank_mask:0xf bound_ctrl:1\n\t" \
    "v_pk_fma_f32 v[144:145], v[116:117], v[110:111], v[144:145] op_sel_hi:[0,1,1]\n\t" \
    "v_add_f32_dpp v146, v146, v146 row_half_mirror row_mask:0xf bank_mask:0xf bound_ctrl:1\n\t" \
    "v_add_f32_dpp %[yp], %[yp], %[yp] row_half_mirror row_mask:0xf bank_mask:0xf bound_ctrl:1\n\t" \
    "v_cmp_eq_u32_e32 vcc, 5, %[sp]\n\t" \
    "v_add_f32_dpp v146, v146, v146 row_mirror row_mask:0xf bank_mask:0xf bound_ctrl:1\n\t" \
    "v_add_f32_dpp %[yp], %[yp], %[yp] row_mirror row_mask:0xf bank_mask:0xf bound_ctrl:1\n\t" \
    "v_cndmask_b32_e32 %[yk0], %[yk0], %[yp], vcc\n\t" \
    "v_pk_fma_f32 %[s01], v[146:147], v[104:105], v[142:143] op_sel_hi:[0,1,1] neg_lo:[1,0,0] neg_hi:[1,0,0]\n\t" \
    "v_pk_fma_f32 %[s23], v[146:147], v[106:107], v[144:145] op_sel_hi:[0,1,1] neg_lo:[1,0,0] neg_hi:[1,0,0]\n\t" \
    "v_pk_mul_f32 v[140:141], %[s01], v[112:113]\n\t" \
    "v_pk_fma_f32 v[140:141], %[s23], v[114:115], v[140:141]\n\t" \
    "v_add_f32 %[yp], v140, v141\n\t" \
    "s_waitcnt lgkmcnt(0)\n\t" \
    "ds_read_b128 v[96:99], %[ab] offset:26624\n\t" \
    "ds_read_b128 v[100:103], %[ab] offset:2048\n\t" \
    "ds_read_b128 v[104:107], %[ab] offset:18432\n\t" \
    "ds_read_b128 v[108:111], %[ab] offset:10240\n\t" \
    "ds_read_b128 v[112:115], %[ab] offset:34816\n\t" \
    "ds_read_b32 v116, %[av] offset:512\n\t" \
    "v_pk_mul_f32 v[140:141], %[s01], v[118:119]\n\t" \
    "v_pk_fma_f32 v[140:141], %[s23], v[120:121], v[140:141]\n\t" \
    "v_add_f32 v146, v140, v141\n\t" \
    "v_pk_mul_f32 v[142:143], %[s01], v[122:123]\n\t" \
    "v_pk_mul_f32 v[144:145], %[s23], v[124:125]\n\t" \
    "v_add_f32_dpp v146, v146, v146 quad_perm:[1,0,3,2] row_mask:0xf bank_mask:0xf bound_ctrl:1\n\t" \
    "v_add_f32_dpp %[yp], %[yp], %[yp] quad_perm:[1,0,3,2] row_mask:0xf bank_mask:0xf bound_ctrl:1\n\t" \
    "v_pk_fma_f32 v[142:143], v[138:139], v[130:131], v[142:143] op_sel_hi:[0,1,1]\n\t" \
    "v_add_f32_dpp v146, v146, v146 quad_perm:[2,3,0,1] row_mask:0xf bank_mask:0xf bound_ctrl:1\n\t" \
    "v_add_f32_dpp %[yp], %[yp], %[yp] quad_perm:[2,3,0,1] row_mask:0xf bank_mask:0xf bound_ctrl:1\n\t" \
    "v_pk_fma_f32 v[144:145], v[138:139], v[132:133], v[144:145] op_sel_hi:[0,1,1]\n\t" \
    "v_add_f32_dpp v146, v146, v146 row_half_mirror row_mask:0xf bank_mask:0xf bound_ctrl:1\n\t" \
    "v_add_f32_dpp %[yp], %[yp], %[yp] row_half_mirror row_mask:0xf bank_mask:0xf bound_ctrl:1\n\t" \
    "v_cmp_eq_u32_e32 vcc, 6, %[sp]\n\t" \
    "v_add_f32_dpp v146, v146, v146 row_mirror row_mask:0xf bank_mask:0xf bound_ctrl:1\n\t" \
    "v_add_f32_dpp %[yp], %[yp], %[yp] row_mirror row_mask:0xf bank_mask:0xf bound_ctrl:1\n\t" \
    "v_cndmask_b32_e32 %[yk0], %[yk0], %[yp], vcc\n\t" \
    "v_pk_fma_f32 %[s01], v[146:147], v[126:127], v[142:143] op_sel_hi:[0,1,1] neg_lo:[1,0,0] neg_hi:[1,0,0]\n\t" \
    "v_pk_fma_f32 %[s23], v[146:147], v[128:129], v[144:145] op_sel_hi:[0,1,1] neg_lo:[1,0,0] neg_hi:[1,0,0]\n\t" \
    "v_pk_mul_f32 v[140:141], %[s01], v[134:135]\n\t" \
    "v_pk_fma_f32 v[140:141], %[s23], v[136:137], v[140:141]\n\t" \
    "v_add_f32 %[yp], v140, v141\n\t" \
    "s_waitcnt lgkmcnt(0)\n\t" \
    "ds_read_b128 v[118:121], %[ab] offset:26880\n\t" \
    "ds_read_b128 v[122:125], %[ab] offset:2304\n\t" \
    "ds_read_b128 v[126:129], %[ab] offset:18688\n\t" \
    "ds_read_b128 v[130:133], %[ab] offset:10496\n\t" \
    "ds_read_b128 v[134:137], %[ab] offset:35072\n\t" \
    "ds_read_b32 v138, %[av] offset:576\n\t" \
    "v_pk_mul_f32 v[140:141], %[s01], v[96:97]\n\t" \
    "v_pk_fma_f32 v[140:141], %[s23], v[98:99], v[140:141]\n\t" \
    "v_add_f32 v146, v140, v141\n\t" \
    "v_pk_mul_f32 v[142:143], %[s01], v[100:101]\n\t" \
    "v_pk_mul_f32 v[144:145], %[s23], v[102:103]\n\t" \
    "v_add_f32_dpp v146, v146, v146 quad_perm:[1,0,3,2] row_mask:0xf bank_mask:0xf bound_ctrl:1\n\t" \
    "v_add_f32_dpp %[yp], %[yp], %[yp] quad_perm:[1,0,3,2] row_mask:0xf bank_mask:0xf bound_ctrl:1\n\t" \
    "v_pk_fma_f32 v[142:143], v[116:117], v[108:109], v[142:143] op_sel_hi:[0,1,1]\n\t" \
    "v_add_f32_dpp v146, v146, v146 quad_perm:[2,3,0,1] row_mask:0xf bank_mask:0xf bound_ctrl:1\n\t" \
    "v_add_f32_dpp %[yp], %[yp], %[yp] quad_perm:[2,3,0,1] row_mask:0xf bank_mask:0xf bound_ctrl:1\n\t" \
    "v_pk_fma_f32 v[144:145], v[116:117], v[110:111], v[144:145] op_sel_hi:[0,1,1]\n\t" \
    "v_add_f32_dpp v146, v146, v146 row_half_mirror row_mask:0xf bank_mask:0xf bound_ctrl:1\n\t" \
    "v_add_f32_dpp %[yp], %[yp], %[yp] row_half_mirror row_mask:0xf bank_mask:0xf bound_ctrl:1\n\t" \
    "v_cmp_eq_u32_e32 vcc, 7, %[sp]\n\t" \
    "v_add_f32_dpp v146, v146, v146 row_mirror row_mask:0xf bank_mask:0xf bound_ctrl:1\n\t" \
    "v_add_f32_dpp %[yp], %[yp], %[yp] row_mirror row_mask:0xf bank_mask:0xf bound_ctrl:1\n\t" \
    "v_cndmask_b32_e32 %[yk0], %[yk0], %[yp], vcc\n\t" \
    "v_pk_fma_f32 %[s01], v[146:147], v[104:105], v[142:143] op_sel_hi:[0,1,1] neg_lo:[1,0,0] neg_hi:[1,0,0]\n\t" \
    "v_pk_fma_f32 %[s23], v[146:147], v[106:107], v[144:145] op_sel_hi:[0,1,1] neg_lo:[1,0,0] neg_hi:[1,0,0]\n\t" \
    "v_pk_mul_f32 v[140:141], %[s01], v[112:113]\n\t" \
    "v_pk_fma_f32 v[140:141], %[s23], v[114:115], v[140:141]\n\t" \
    "v_add_f32 %[yp], v140, v141\n\t" \
    "s_waitcnt lgkmcnt(0)\n\t" \
    "ds_read_b128 v[96:99], %[ab] offset:27136\n\t" \
    "ds_read_b128 v[100:103], %[ab] offset:2560\n\t" \
    "ds_read_b128 v[104:107], %[ab] offset:18944\n\t" \
    "ds_read_b128 v[108:111], %[ab] offset:10752\n\t" \
    "ds_read_b128 v[112:115], %[ab] offset:35328\n\t" \
    "ds_read_b32 v116, %[av] offset:640\n\t" \
    "v_pk_mul_f32 v[140:141], %[s01], v[118:119]\n\t" \
    "v_pk_fma_f32 v[140:141], %[s23], v[120:121], v[140:141]\n\t" \
    "v_add_f32 v146, v140, v141\n\t" \
    "v_pk_mul_f32 v[142:143], %[s01], v[122:123]\n\t" \
    "v_pk_mul_f32 v[144:145], %[s23], v[124:125]\n\t" \
    "v_add_f32_dpp v146, v146, v146 quad_perm:[1,0,3,2] row_mask:0xf bank_mask:0xf bound_ctrl:1\n\t" \
    "v_add_f32_dpp %[yp], %[yp], %[yp] quad_perm:[1,0,3,2] row_mask:0xf bank_mask:0xf bound_ctrl:1\n\t" \
    "v_pk_fma_f32 v[142:143], v[138:139], v[130:131], v[142:143] op_sel_hi:[0,1,1]\n\t" \
    "v_add_f32_dpp v146, v146, v146 quad_perm:[2,3,0,1] row_mask:0xf bank_mask:0xf bound_ctrl:1\n\t" \
    "v_add_f32_dpp %[yp], %[yp], %[yp] quad_perm:[2,3,0,1] row_mask:0xf bank_mask:0xf bound_ctrl:1\n\t" \
    "v_pk_fma_f32 v[144:145], v[138:139], v[132:133], v[144:145] op_sel_hi:[0,1,1]\n\t" \
    "v_add_f32_dpp v146, v146, v146 row_half_mirror row_mask:0xf bank_mask:0xf bound_ctrl:1\n\t" \
    "v_add_f32_dpp %[yp], %[yp], %[yp] row_half_mirror row_mask:0xf bank_mask:0xf bound_ctrl:1\n\t" \
    "v_cmp_eq_u32_e32 vcc, 8, %[sp]\n\t" \
    "v_add_f32_dpp v146, v146, v146 row_mirror row_mask:0xf bank_mask:0xf bound_ctrl:1\n\t" \
    "v_add_f32_dpp %[yp], %[yp], %[yp] row_mirror row_mask:0xf bank_mask:0xf bound_ctrl:1\n\t" \
    "v_cndmask_b32_e32 %[yk0], %[yk0], %[yp], vcc\n\t" \
    "v_pk_fma_f32 %[s01], v[146:147], v[126:127], v[142:143] op_sel_hi:[0,1,1] neg_lo:[1,0,0] neg_hi:[1,0,0]\n\t" \
    "v_pk_fma_f32 %[s23], v[146:147], v[128:129], v[144:145] op_sel_hi:[0,1,1] neg_lo:[1,0,0] neg_hi:[1,0,0]\n\t" \
    "v_pk_mul_f32 v[140:141], %[s01], v[134:135]\n\t" \
    "v_pk_fma_f32 v[140:141], %[s23], v[136:137], v[140:141]\n\t" \
    "v_add_f32 %[yp], v140, v141\n\t" \
    "s_waitcnt lgkmcnt(0)\n\t" \
    "ds_read_b128 v[118:121], %[ab] offset:27392\n\t" \
    "ds_read_b128 v[122:125], %[ab] offset:2816\n\t" \
    "ds_read_b128 v[126:129], %[ab] offset:19200\n\t" \
    "ds_read_b128 v[130:133], %[ab] offset:11008\n\t" \
    "ds_read_b128 v[134:137], %[ab] offset:35584\n\t" \
    "ds_read_b32 v138, %[av] offset:704\n\t" \
    "v_pk_mul_f32 v[140:141], %[s01], v[96:97]\n\t" \
    "v_pk_fma_f32 v[140:141], %[s23], v[98:99], v[140:141]\n\t" \
    "v_add_f32 v146, v140, v141\n\t" \
    "v_pk_mul_f32 v[142:143], %[s01], v[100:101]\n\t" \
    "v_pk_mul_f32 v[144:145], %[s23], v[102:103]\n\t" \
    "v_add_f32_dpp v146, v146, v146 quad_perm:[1,0,3,2] row_mask:0xf bank_mask:0xf bound_ctrl:1\n\t" \
    "v_add_f32_dpp %[yp], %[yp], %[yp] quad_perm:[1,0,3,2] row_mask:0xf bank_mask:0xf bound_ctrl:1\n\t" \
    "v_pk_fma_f32 v[142:143], v[116:117], v[108:109], v[142:143] op_sel_hi:[0,1,1]\n\t" \
    "v_add_f32_dpp v146, v146, v146 quad_perm:[2,3,0,1] row_mask:0xf bank_mask:0xf bound_ctrl:1\n\t" \
    "v_add_f32_dpp %[yp], %[yp], %[yp] quad_perm:[2,3,0,1] row_mask:0xf bank_mask:0xf bound_ctrl:1\n\t" \
    "v_pk_fma_f32 v[144:145], v[116:117], v[110:111], v[144:145] op_sel_hi:[0,1,1]\n\t" \
    "v_add_f32_dpp v146, v146, v146 row_half_mirror row_mask:0xf bank_mask:0xf bound_ctrl:1\n\t" \
    "v_add_f32_dpp %[yp], %[yp], %[yp] row_half_mirror row_mask:0xf bank_mask:0xf bound_ctrl:1\n\t" \
    "v_cmp_eq_u32_e32 vcc, 9, %[sp]\n\t" \
    "v_add_f32_dpp v146, v146, v146 row_mirror row_mask:0xf bank_mask:0xf bound_ctrl:1\n\t" \
    "v_add_f32_dpp %[yp], %[yp], %[yp] row_mirror row_mask:0xf bank_mask:0xf bound_ctrl:1\n\t" \
    "v_cndmask_b32_e32 %[yk0], %[yk0], %[yp], vcc\n\t" \
    "v_pk_fma_f32 %[s01], v[146:147], v[104:105], v[142:143] op_sel_hi:[0,1,1] neg_lo:[1,0,0] neg_hi:[1,0,0]\n\t" \
    "v_pk_fma_f32 %[s23], v[146:147], v[106:107], v[144:145] op_sel_hi:[0,1,1] neg_lo:[1,0,0] neg_hi:[1,0,0]\n\t" \
    "v_pk_mul_f32 v[140:141], %[s01], v[112:113]\n\t" \
    "v_pk_fma_f32 v[140:141], %[s23], v[114:115], v[140:141]\n\t" \
    "v_add_f32 %[yp], v140, v141\n\t" \
    "s_waitcnt lgkmcnt(0)\n\t" \
    "ds_read_b128 v[96:99], %[ab] offset:27648\n\t" \
    "ds_read_b128 v[100:103], %[ab] offset:3072\n\t" \
    "ds_read_b128 v[104:107], %[ab] offset:19456\n\t" \
    "ds_read_b128 v[108:111], %[ab] offset:11264\n\t" \
    "ds_read_b128 v[112:115], %[ab] offset:35840\n\t" \
    "ds_read_b32 v116, %[av] offset:768\n\t" \
    "v_pk_mul_f32 v[140:141], %[s01], v[118:119]\n\t" \
    "v_pk_fma_f32 v[140:141], %[s23], v[120:121], v[140:141]\n\t" \
    "v_add_f32 v146, v140, v141\n\t" \
    "v_pk_mul_f32 v[142:143], %[s01], v[122:123]\n\t" \
    "v_pk_mul_f32 v[144:145], %[s23], v[124:125]\n\t" \
    "v_add_f32_dpp v146, v146, v146 quad_perm:[1,0,3,2] row_mask:0xf bank_mask:0xf bound_ctrl:1\n\t" \
    "v_add_f32_dpp %[yp], %[yp], %[yp] quad_perm:[1,0,3,2] row_mask:0xf bank_mask:0xf bound_ctrl:1\n\t" \
    "v_pk_fma_f32 v[142:143], v[138:139], v[130:131], v[142:143] op_sel_hi:[0,1,1]\n\t" \
    "v_add_f32_dpp v146, v146, v146 quad_perm:[2,3,0,1] row_mask:0xf bank_mask:0xf bound_ctrl:1\n\t" \
    "v_add_f32_dpp %[yp], %[yp], %[yp] quad_perm:[2,3,0,1] row_mask:0xf bank_mask:0xf bound_ctrl:1\n\t" \
    "v_pk_fma_f32 v[144:145], v[138:139], v[132:133], v[144:145] op_sel_hi:[0,1,1]\n\t" \
    "v_add_f32_dpp v146, v146, v146 row_half_mirror row_mask:0xf bank_mask:0xf bound_ctrl:1\n\t" \
    "v_add_f32_dpp %[yp], %[yp], %[yp] row_half_mirror row_mask:0xf bank_mask:0xf bound_ctrl:1\n\t" \
    "v_cmp_eq_u32_e32 vcc, 10, %[sp]\n\t" \
    "v_add_f32_dpp v146, v146, v146 row_mirror row_mask:0xf bank_mask:0xf bound_ctrl:1\n\t" \
    "v_add_f32_dpp %[yp], %[yp], %[yp] row_mirror row_mask:0xf bank_mask:0xf bound_ctrl:1\n\t" \
    "v_cndmask_b32_e32 %[yk0], %[yk0], %[yp], vcc\n\t" \
    "v_pk_fma_f32 %[s01], v[146:147], v[126:127], v[142:143] op_sel_hi:[0,1,1] neg_lo:[1,0,0] neg_hi:[1,0,0]\n\t" \
    "v_pk_fma_f32 %[s23], v[146:147], v[128:129], v[144:145] op_sel_hi:[0,1,1] neg_lo:[1,0,0] neg_hi:[1,0,0]\n\t" \
    "v_pk_mul_f32 v[140:141], %[s01], v[134:135]\n\t" \
    "v_pk_fma_f32 v[140:141], %[s23], v[136:137], v[140:141]\n\t" \
    "v_add_f32 %[yp], v140, v141\n\t" \
    "s_waitcnt lgkmcnt(0)\n\t" \
    "ds_read_b128 v[118:121], %[ab] offset:27904\n\t" \
    "ds_read_b128 v[122:125], %[ab] offset:3328\n\t" \
    "ds_read_b128 v[126:129], %[ab] offset:19712\n\t" \
    "ds_read_b128 v[130:133], %[ab] offset:11520\n\t" \
    "ds_read_b128 v[134:137], %[ab] offset:36096\n\t" \
    "ds_read_b32 v138, %[av] offset:832\n\t" \
    "v_pk_mul_f32 v[140:141], %[s01], v[96:97]\n\t" \
    "v_pk_fma_f32 v[140:141], %[s23], v[98:99], v[140:141]\n\t" \
    "v_add_f32 v146, v140, v141\n\t" \
    "v_pk_mul_f32 v[142:143], %[s01], v[100:101]\n\t" \
    "v_pk_mul_f32 v[144:145], %[s23], v[102:103]\n\t" \
    "v_add_f32_dpp v146, v146, v146 quad_perm:[1,0,3,2] row_mask:0xf bank_mask:0xf bound_ctrl:1\n\t" \
    "v_add_f32_dpp %[yp], %[yp], %[yp] quad_perm:[1,0,3,2] row_mask:0xf bank_mask:0xf bound_ctrl:1\n\t" \
    "v_pk_fma_f32 v[142:143], v[116:117], v[108:109], v[142:143] op_sel_hi:[0,1,1]\n\t" \
    "v_add_f32_dpp v146, v146, v146 quad_perm:[2,3,0,1] row_mask:0xf bank_mask:0xf bound_ctrl:1\n\t" \
    "v_add_f32_dpp %[yp], %[yp], %[yp] quad_perm:[2,3,0,1] row_mask:0xf bank_mask:0xf bound_ctrl:1\n\t" \
    "v_pk_fma_f32 v[144:145], v[116:117], v[110:111], v[144:145] op_sel_hi:[0,1,1]\n\t" \
    "v_add_f32_dpp v146, v146, v146 row_half_mirror row_mask:0xf bank_mask:0xf bound_ctrl:1\n\t" \
    "v_add_f32_dpp %[yp], %[yp], %[yp] row_half_mirror row_mask:0xf bank_mask:0xf bound_ctrl:1\n\t" \
    "v_cmp_eq_u32_e32 vcc, 11, %[sp]\n\t" \
    "v_add_f32_dpp v146, v146, v146 row_mirror row_mask:0xf bank_mask:0xf bound_ctrl:1\n\t" \
    "v_add_f32_dpp %[yp], %[yp], %[yp] row_mirror row_mask:0xf bank_mask:0xf bound_ctrl:1\n\t" \
    "v_cndmask_b32_e32 %[yk0], %[yk0], %[yp], vcc\n\t" \
    "v_pk_fma_f32 %[s01], v[146:147], v[104:105], v[142:143] op_sel_hi:[0,1,1] neg_lo:[1,0,0] neg_hi:[1,0,0]\n\t" \
    "v_pk_fma_f32 %[s23], v[146:147], v[106:107], v[144:145] op_sel_hi:[0,1,1] neg_lo:[1,0,0] neg_hi:[1,0,0]\n\t" \
    "v_pk_mul_f32 v[140:141], %[s01], v[112:113]\n\t" \
    "v_pk_fma_f32 v[140:141], %[s23], v[114:115], v[140:141]\n\t" \
    "v_add_f32 %[yp], v140, v141\n\t" \
    "s_waitcnt lgkmcnt(0)\n\t" \
    "ds_read_b128 v[96:99], %[ab] offset:28160\n\t" \
    "ds_read_b128 v[100:103], %[ab] offset:3584\n\t" \
    "ds_read_b128 v[104:107], %[ab] offset:19968\n\t" \
    "ds_read_b128 v[108:111], %[ab] offset:11776\n\t" \
    "ds_read_b128 v[112:115], %[ab] offset:36352\n\t" \
    "ds_read_b32 v116, %[av] offset:896\n\t" \
    "v_pk_mul_f32 v[140:141], %[s01], v[118:119]\n\t" \
    "v_pk_fma_f32 v[140:141], %[s23], v[120:121], v[140:141]\n\t" \
    "v_add_f32 v146, v140, v141\n\t" \
    "v_pk_mul_f32 v[142:143], %[s01], v[122:123]\n\t" \
    "v_pk_mul_f32 v[144:145], %[s23], v[124:125]\n\t" \
    "v_add_f32_dpp v146, v146, v146 quad_perm:[1,0,3,2] row_mask:0xf bank_mask:0xf bound_ctrl:1\n\t" \
    "v_add_f32_dpp %[yp], %[yp], %[yp] quad_perm:[1,0,3,2] row_mask:0xf bank_mask:0xf bound_ctrl:1\n\t" \
    "v_pk_fma_f32 v[142:143], v[138:139], v[130:131], v[142:143] op_sel_hi:[0,1,1]\n\t" \
    "v_add_f32_dpp v146, v146, v146 quad_perm:[2,3,0,1] row_mask:0xf bank_mask:0xf bound_ctrl:1\n\t" \
    "v_add_f32_dpp %[yp], %[yp], %[yp] quad_perm:[2,3,0,1] row_mask:0xf bank_mask:0xf bound_ctrl:1\n\t" \
    "v_pk_fma_f32 v[144:145], v[138:139], v[132:133], v[144:145] op_sel_hi:[0,1,1]\n\t" \
    "v_add_f32_dpp v146, v146, v146 row_half_mirror row_mask:0xf bank_mask:0xf bound_ctrl:1\n\t" \
    "v_add_f32_dpp %[yp], %[yp], %[yp] row_half_mirror row_mask:0xf bank_mask:0xf bound_ctrl:1\n\t" \
    "v_cmp_eq_u32_e32 vcc, 12, %[sp]\n\t" \
    "v_add_f32_dpp v146, v146, v146 row_mirror row_mask:0xf bank_mask:0xf bound_ctrl:1\n\t" \
    "v_add_f32_dpp %[yp], %[yp], %[yp] row_mirror row_mask:0xf bank_mask:0xf bound_ctrl:1\n\t" \
    "v_cndmask_b32_e32 %[yk0], %[yk0], %[yp], vcc\n\t" \
    "v_pk_fma_f32 %[s01], v[146:147], v[126:127], v[142:143] op_sel_hi:[0,1,1] neg_lo:[1,0,0] neg_hi:[1,0,0]\n\t" \
    "v_pk_fma_f32 %[s23], v[146:147], v[128:129], v[144:145] op_sel_hi:[0,1,1] neg_lo:[1,0,0] neg_hi:[1,0,0]\n\t" \
    "v_pk_mul_f32 v[140:141], %[s01], v[134:135]\n\t" \
    "v_pk_fma_f32 v[140:141], %[s23], v[136:137], v[140:141]\n\t" \
    "v_add_f32 %[yp], v140, v141\n\t" \
    "s_waitcnt lgkmcnt(0)\n\t" \
    "ds_read_b128 v[118:121], %[ab] offset:28416\n\t" \
    "ds_read_b128 v[122:125], %[ab] offset:3840\n\t" \
    "ds_read_b128 v[126:129], %[ab] offset:20224\n\t" \
    "ds_read_b128 v[130:133], %[ab] offset:12032\n\t" \
    "ds_read_b128 v[134:137], %[ab] offset:36608\n\t" \
    "ds_read_b32 v138, %[av] offset:960\n\t" \
    "v_pk_mul_f32 v[140:141], %[s01], v[96:97]\n\t" \
    "v_pk_fma_f32 v[140:141], %[s23], v[98:99], v[140:141]\n\t" \
    "v_add_f32 v146, v140, v141\n\t" \
    "v_pk_mul_f32 v[142:143], %[s01], v[100:101]\n\t" \
    "v_pk_mul_f32 v[144:145], %[s23], v[102:103]\n\t" \
    "v_add_f32_dpp v146, v146, v146 quad_perm:[1,0,3,2] row_mask:0xf bank_mask:0xf bound_ctrl:1\n\t" \
    "v_add_f32_dpp %[yp], %[yp], %[yp] quad_perm:[1,0,3,2] row_mask:0xf bank_mask:0xf bound_ctrl:1\n\t" \
    "v_pk_fma_f32 v[142:143], v[116:117], v[108:109], v[142:143] op_sel_hi:[0,1,1]\n\t" \
    "v_add_f32_dpp v146, v146, v146 quad_perm:[2,3,0,1] row_mask:0xf bank_mask:0xf bound_ctrl:1\n\t" \
    "v_add_f32_dpp %[yp], %[yp], %[yp] quad_perm:[2,3,0,1] row_mask:0xf bank_mask:0xf bound_ctrl:1\n\t" \
    "v_pk_fma_f32 v[144:145], v[116:117], v[110:111], v[144:145] op_sel_hi:[0,1,1]\n\t" \
    "v_add_f32_dpp v146, v146, v146 row_half_mirror row_mask:0xf bank_mask:0xf bound_ctrl:1\n\t" \
    "v_add_f32_dpp %[yp], %[yp], %[yp] row_half_mirror row_mask:0xf bank_mask:0xf bound_ctrl:1\n\t" \
    "v_cmp_eq_u32_e32 vcc, 13, %[sp]\n\t" \
    "v_add_f32_dpp v146, v146, v146 row_mirror row_mask:0xf bank_mask:0xf bound_ctrl:1\n\t" \
    "v_add_f32_dpp %[yp], %[yp], %[yp] row_mirror row_mask:0xf bank_mask:0xf bound_ctrl:1\n\t" \
    "v_cndmask_b32_e32 %[yk0], %[yk0], %[yp], vcc\n\t" \
    "v_pk_fma_f32 %[s01], v[146:147], v[104:105], v[142:143] op_sel_hi:[0,1,1] neg_lo:[1,0,0] neg_hi:[1,0,0]\n\t" \
    "v_pk_fma_f32 %[s23], v[146:147], v[106:107], v[144:145] op_sel_hi:[0,1,1] neg_lo:[1,0,0] neg_hi:[1,0,0]\n\t" \
    "v_pk_mul_f32 v[140:141], %[s01], v[112:113]\n\t" \
    "v_pk_fma_f32 v[140:141], %[s23], v[114:115], v[140:141]\n\t" \
    "v_add_f32 %[yp], v140, v141\n\t" \
    "s_waitcnt lgkmcnt(0)\n\t" \
    "ds_read_b128 v[96:99], %[ab] offset:28672\n\t" \
    "ds_read_b128 v[100:103], %[ab] offset:4096\n\t" \
    "ds_read_b128 v[104:107], %[ab] offset:20480\n\t" \
    "ds_read_b128 v[108:111], %[ab] offset:12288\n\t" \
    "ds_read_b128 v[112:115], %[ab] offset:36864\n\t" \
    "ds_read_b32 v116, %[av] offset:1024\n\t" \
    "v_pk_mul_f32 v[140:141], %[s01], v[118:119]\n\t" \
    "v_pk_fma_f32 v[140:141], %[s23], v[120:121], v[140:141]\n\t" \
    "v_add_f32 v146, v140, v141\n\t" \
    "v_pk_mul_f32 v[142:143], %[s01], v[122:123]\n\t" \
    "v_pk_mul_f32 v[144:145], %[s23], v[124:125]\n\t" \
    "v_add_f32_dpp v146, v146, v146 quad_perm:[1,0,3,2] row_mask:0xf bank_mask:0xf bound_ctrl:1\n\t" \
    "v_add_f32_dpp %[yp], %[yp], %[yp] quad_perm:[1,0,3,2] row_mask:0xf bank_mask:0xf bound_ctrl:1\n\t" \
    "v_pk_fma_f32 v[142:143], v[138:139], v[130:131], v[142:143] op_sel_hi:[0,1,1]\n\t" \
    "v_add_f32_dpp v146, v146, v146 quad_perm:[2,3,0,1] row_mask:0xf bank_mask:0xf bound_ctrl:1\n\t" \
    "v_add_f32_dpp %[yp], %[yp], %[yp] quad_perm:[2,3,0,1] row_mask:0xf bank_mask:0xf bound_ctrl:1\n\t" \
    "v_pk_fma_f32 v[144:145], v[138:139], v[132:133], v[144:145] op_sel_hi:[0,1,1]\n\t" \
    "v_add_f32_dpp v146, v146, v146 row_half_mirror row_mask:0xf bank_mask:0xf bound_ctrl:1\n\t" \
    "v_add_f32_dpp %[yp], %[yp], %[yp] row_half_mirror row_mask:0xf bank_mask:0xf bound_ctrl:1\n\t" \
    "v_cmp_eq_u32_e32 vcc, 14, %[sp]\n\t" \
    "v_add_f32_dpp v146, v146, v146 row_mirror row_mask:0xf bank_mask:0xf bound_ctrl:1\n\t" \
    "v_add_f32_dpp %[yp], %[yp], %[yp] row_mirror row_mask:0xf bank_mask:0xf bound_ctrl:1\n\t" \
    "v_cndmask_b32_e32 %[yk0], %[yk0], %[yp], vcc\n\t" \
    "v_pk_fma_f32 %[s01], v[146:147], v[126:127], v[142:143] op_sel_hi:[0,1,1] neg_lo:[1,0,0] neg_hi:[1,0,0]\n\t" \
    "v_pk_fma_f32 %[s23], v[146:147], v[128:129], v[144:145] op_sel_hi:[0,1,1] neg_lo:[1,0,0] neg_hi:[1,0,0]\n\t" \
    "v_pk_mul_f32 v[140:141], %[s01], v[134:135]\n\t" \
    "v_pk_fma_f32 v[140:141], %[s23], v[136:137], v[140:141]\n\t" \
    "v_add_f32 %[yp], v140, v141\n\t" \
    "s_waitcnt lgkmcnt(0)\n\t" \
    "ds_read_b128 v[118:121], %[ab] offset:28928\n\t" \
    "ds_read_b128 v[122:125], %[ab] offset:4352\n\t" \
    "ds_read_b128 v[126:129], %[ab] offset:20736\n\t" \
    "ds_read_b128 v[130:133], %[ab] offset:12544\n\t" \
    "ds_read_b128 v[134:137], %[ab] offset:37120\n\t" \
    "ds_read_b32 v138, %[av] offset:1088\n\t" \
    "v_pk_mul_f32 v[140:141], %[s01], v[96:97]\n\t" \
    "v_pk_fma_f32 v[140:141], %[s23], v[98:99], v[140:141]\n\t" \
    "v_add_f32 v146, v140, v141\n\t" \
    "v_pk_mul_f32 v[142:143], %[s01], v[100:101]\n\t" \
    "v_pk_mul_f32 v[144:145], %[s23], v[102:103]\n\t" \
    "v_add_f32_dpp v146, v146, v146 quad_perm:[1,0,3,2] row_mask:0xf bank_mask:0xf bound_ctrl:1\n\t" \
    "v_add_f32_dpp %[yp], %[yp], %[yp] quad_perm:[1,0,3,2] row_mask:0xf bank_mask:0xf bound_ctrl:1\n\t" \
    "v_pk_fma_f32 v[142:143], v[116:117], v[108:109], v[142:143] op_sel_hi:[0,1,1]\n\t" \
    "v_add_f32_dpp v146, v146, v146 quad_perm:[2,3,0,1] row_mask:0xf bank_mask:0xf bound_ctrl:1\n\t" \
    "v_add_f32_dpp %[yp], %[yp], %[yp] quad_perm:[2,3,0,1] row_mask:0xf bank_mask:0xf bound_ctrl:1\n\t" \
    "v_pk_fma_f32 v[144:145], v[116:117], v[110:111], v[144:145] op_sel_hi:[0,1,1]\n\t" \
    "v_add_f32_dpp v146, v146, v146 row_half_mirror row_mask:0xf bank_mask:0xf bound_ctrl:1\n\t" \
    "v_add_f32_dpp %[yp], %[yp], %[yp] row_half_mirror row_mask:0xf bank_mask:0xf bound_ctrl:1\n\t" \
    "v_cmp_eq_u32_e32 vcc, 15, %[sp]\n\t" \
    "v_add_f32_dpp v146, v146, v146 row_mirror row_mask:0xf bank_mask:0xf bound_ctrl:1\n\t" \
    "v_add_f32_dpp %[yp], %[yp], %[yp] row_mirror row_mask:0xf bank_mask:0xf bound_ctrl:1\n\t" \
    "v_cndmask_b32_e32 %[yk0], %[yk0], %[yp], vcc\n\t" \
    "v_pk_fma_f32 %[s01], v[146:147], v[104:105], v[142:143] op_sel_hi:[0,1,1] neg_lo:[1,0,0] neg_hi:[1,0,0]\n\t" \
    "v_pk_fma_f32 %[s23], v[146:147], v[106:107], v[144:145] op_sel_hi:[0,1,1] neg_lo:[1,0,0] neg_hi:[1,0,0]\n\t" \
    "v_pk_mul_f32 v[140:141], %[s01], v[112:113]\n\t" \
    "v_pk_fma_f32 v[140:141], %[s23], v[114:115], v[140:141]\n\t" \
    "v_add_f32 %[yp], v140, v141\n\t" \
    "s_waitcnt lgkmcnt(0)\n\t" \
    "ds_read_b128 v[96:99], %[ab] offset:29184\n\t" \
    "ds_read_b128 v[100:103], %[ab] offset:4608\n\t" \
    "ds_read_b128 v[104:107], %[ab] offset:20992\n\t" \
    "ds_read_b128 v[108:111], %[ab] offset:12800\n\t" \
    "ds_read_b128 v[112:115], %[ab] offset:37376\n\t" \
    "ds_read_b32 v116, %[av] offset:1152\n\t" \
    "v_pk_mul_f32 v[140:141], %[s01], v[118:119]\n\t" \
    "v_pk_fma_f32 v[140:141], %[s23], v[120:121], v[140:141]\n\t" \
    "v_add_f32 v146, v140, v141\n\t" \
    "v_pk_mul_f32 v[142:143], %[s01], v[122:123]\n\t" \
    "v_pk_mul_f32 v[144:145], %[s23], v[124:125]\n\t" \
    "v_add_f32_dpp v146, v146, v146 quad_perm:[1,0,3,2] row_mask:0xf bank_mask:0xf bound_ctrl:1\n\t" \
    "v_add_f32_dpp %[yp], %[yp], %[yp] quad_perm:[1,0,3,2] row_mask:0xf bank_mask:0xf bound_ctrl:1\n\t" \
    "v_pk_fma_f32 v[142:143], v[138:139], v[130:131], v[142:143] op_sel_hi:[0,1,1]\n\t" \
    "v_add_f32_dpp v146, v146, v146 quad_perm:[2,3,0,1] row_mask:0xf bank_mask:0xf bound_ctrl:1\n\t" \
    "v_add_f32_dpp %[yp], %[yp], %[yp] quad_perm:[2,3,0,1] row_mask:0xf bank_mask:0xf bound_ctrl:1\n\t" \
    "v_pk_fma_f32 v[144:145], v[138:139], v[132:133], v[144:145] op_sel_hi:[0,1,1]\n\t" \
    "v_add_f32_dpp v146, v146, v146 row_half_mirror row_mask:0xf bank_mask:0xf bound_ctrl:1\n\t" \
    "v_add_f32_dpp %[yp], %[yp], %[yp] row_half_mirror row_mask:0xf bank_mask:0xf bound_ctrl:1\n\t" \
    "v_cmp_eq_u32_e32 vcc, 0, %[sp]\n\t" \
    "v_add_f32_dpp v146, v146, v146 row_mirror row_mask:0xf bank_mask:0xf bound_ctrl:1\n\t" \
    "v_add_f32_dpp %[yp], %[yp], %[yp] row_mirror row_mask:0xf bank_mask:0xf bound_ctrl:1\n\t" \
    "v_cndmask_b32_e32 %[yk1], %[yk1], %[yp], vcc\n\t" \
    "v_pk_fma_f32 %[s01], v[146:147], v[126:127], v[142:143] op_sel_hi:[0,1,1] neg_lo:[1,0,0] neg_hi:[1,0,0]\n\t" \
    "v_pk_fma_f32 %[s23], v[146:147], v[128:129], v[144:145] op_sel_hi:[0,1,1] neg_lo:[1,0,0] neg_hi:[1,0,0]\n\t" \
    "v_pk_mul_f32 v[140:141], %[s01], v[134:135]\n\t" \
    "v_pk_fma_f32 v[140:141], %[s23], v[136:137], v[140:141]\n\t" \
    "v_add_f32 %[yp], v140, v141\n\t" \
    "s_waitcnt lgkmcnt(0)\n\t" \
    "ds_read_b128 v[118:121], %[ab] offset:29440\n\t" \
    "ds_read_b128 v[122:125], %[ab] offset:4864\n\t" \
    "ds_read_b128 v[126:129], %[ab] offset:21248\n\t" \
    "ds_read_b128 v[130:133], %[ab] offset:13056\n\t" \
    "ds_read_b128 v[134:137], %[ab] offset:37632\n\t" \
    "ds_read_b32 v138, %[av] offset:1216\n\t" \
    "v_pk_mul_f32 v[140:141], %[s01], v[96:97]\n\t" \
    "v_pk_fma_f32 v[140:141], %[s23], v[98:99], v[140:141]\n\t" \
    "v_add_f32 v146, v140, v141\n\t" \
    "v_pk_mul_f32 v[142:143], %[s01], v[100:101]\n\t" \
    "v_pk_mul_f32 v[144:145], %[s23], v[102:103]\n\t" \
    "v_add_f32_dpp v146, v146, v146 quad_perm:[1,0,3,2] row_mask:0xf bank_mask:0xf bound_ctrl:1\n\t" \
    "v_add_f32_dpp %[yp], %[yp], %[yp] quad_perm:[1,0,3,2] row_mask:0xf bank_mask:0xf bound_ctrl:1\n\t" \
    "v_pk_fma_f32 v[142:143], v[116:117], v[108:109], v[142:143] op_sel_hi:[0,1,1]\n\t" \
    "v_add_f32_dpp v146, v146, v146 quad_perm:[2,3,0,1] row_mask:0xf bank_mask:0xf bound_ctrl:1\n\t" \
    "v_add_f32_dpp %[yp], %[yp], %[yp] quad_perm:[2,3,0,1] row_mask:0xf bank_mask:0xf bound_ctrl:1\n\t" \
    "v_pk_fma_f32 v[144:145], v[116:117], v[110:111], v[144:145] op_sel_hi:[0,1,1]\n\t" \
    "v_add_f32_dpp v146, v146, v146 row_half_mirror row_mask:0xf bank_mask:0xf bound_ctrl:1\n\t" \
    "v_add_f32_dpp %[yp], %[yp], %[yp] row_half_mirror row_mask:0xf bank_mask:0xf bound_ctrl:1\n\t" \
    "v_cmp_eq_u32_e32 vcc, 1, %[sp]\n\t" \
    "v_add_f32_dpp v146, v146, v146 row_mirror row_mask:0xf bank_mask:0xf bound_ctrl:1\n\t" \
    "v_add_f32_dpp %[yp], %[yp], %[yp] row_mirror row_mask:0xf bank_mask:0xf bound_ctrl:1\n\t" \
    "v_cndmask_b32_e32 %[yk1], %[yk1], %[yp], vcc\n\t" \
    "v_pk_fma_f32 %[s01], v[146:147], v[104:105], v[142:143] op_sel_hi:[0,1,1] neg_lo:[1,0,0] neg_hi:[1,0,0]\n\t" \
    "v_pk_fma_f32 %[s23], v[146:147], v[106:107], v[144:145] op_sel_hi:[0,1,1] neg_lo:[1,0,0] neg_hi:[1,0,0]\n\t" \
    "v_pk_mul_f32 v[140:141], %[s01], v[112:113]\n\t" \
    "v_pk_fma_f32 v[140:141], %[s23], v[114:115], v[140:141]\n\t" \
    "v_add_f32 %[yp], v140, v141\n\t" \
    "s_waitcnt lgkmcnt(0)\n\t" \
    "ds_read_b128 v[96:99], %[ab] offset:29696\n\t" \
    "ds_read_b128 v[100:103], %[ab] offset:5120\n\t" \
    "ds_read_b128 v[104:107], %[ab] offset:21504\n\t" \
    "ds_read_b128 v[108:111], %[ab] offset:13312\n\t" \
    "ds_read_b128 v[112:115], %[ab] offset:37888\n\t" \
    "ds_read_b32 v116, %[av] offset:1280\n\t" \
    "v_pk_mul_f32 v[140:141], %[s01], v[118:119]\n\t" \
    "v_pk_fma_f32 v[140:141], %[s23], v[120:121], v[140:141]\n\t" \
    "v_add_f32 v146, v140, v141\n\t" \
    "v_pk_mul_f32 v[142:143], %[s01], v[122:123]\n\t" \
    "v_pk_mul_f32 v[144:145], %[s23], v[124:125]\n\t" \
    "v_add_f32_dpp v146, v146, v146 quad_perm:[1,0,3,2] row_mask:0xf bank_mask:0xf bound_ctrl:1\n\t" \
    "v_add_f32_dpp %[yp], %[yp], %[yp] quad_perm:[1,0,3,2] row_mask:0xf bank_mask:0xf bound_ctrl:1\n\t" \
    "v_pk_fma_f32 v[142:143], v[138:139], v[130:131], v[142:143] op_sel_hi:[0,1,1]\n\t" \
    "v_add_f32_dpp v146, v146, v146 quad_perm:[2,3,0,1] row_mask:0xf bank_mask:0xf bound_ctrl:1\n\t" \
    "v_add_f32_dpp %[yp], %[yp], %[yp] quad_perm:[2,3,0,1] row_mask:0xf bank_mask:0xf bound_ctrl:1\n\t" \
    "v_pk_fma_f32 v[144:145], v[138:139], v[132:133], v[144:145] op_sel_hi:[0,1,1]\n\t" \
    "v_add_f32_dpp v146, v146, v146 row_half_mirror row_mask:0xf bank_mask:0xf bound_ctrl:1\n\t" \
    "v_add_f32_dpp %[yp], %[yp], %[yp] row_half_mirror row_mask:0xf bank_mask:0xf bound_ctrl:1\n\t" \
    "v_cmp_eq_u32_e32 vcc, 2, %[sp]\n\t" \
    "v_add_f32_dpp v146, v146, v146 row_mirror row_mask:0xf bank_mask:0xf bound_ctrl:1\n\t" \
    "v_add_f32_dpp %[yp], %[yp], %[yp] row_mirror row_mask:0xf bank_mask:0xf bound_ctrl:1\n\t" \
    "v_cndmask_b32_e32 %[yk1], %[yk1], %[yp], vcc\n\t" \
    "v_pk_fma_f32 %[s01], v[146:147], v[126:127], v[142:143] op_sel_hi:[0,1,1] neg_lo:[1,0,0] neg_hi:[1,0,0]\n\t" \
    "v_pk_fma_f32 %[s23], v[146:147], v[128:129], v[144:145] op_sel_hi:[0,1,1] neg_lo:[1,0,0] neg_hi:[1,0,0]\n\t" \
    "v_pk_mul_f32 v[140:141], %[s01], v[134:135]\n\t" \
    "v_pk_fma_f32 v[140:141], %[s23], v[136:137], v[140:141]\n\t" \
    "v_add_f32 %[yp], v140, v141\n\t" \
    "s_waitcnt lgkmcnt(0)\n\t" \
    "ds_read_b128 v[118:121], %[ab] offset:29952\n\t" \
    "ds_read_b128 v[122:125], %[ab] offset:5376\n\t" \
    "ds_read_b128 v[126:129], %[ab] offset:21760\n\t" \
    "ds_read_b128 v[130:133], %[ab] offset:13568\n\t" \
    "ds_read_b128 v[134:137], %[ab] offset:38144\n\t" \
    "ds_read_b32 v138, %[av] offset:1344\n\t" \
    "v_pk_mul_f32 v[140:141], %[s01], v[96:97]\n\t" \
    "v_pk_fma_f32 v[140:141], %[s23], v[98:99], v[140:141]\n\t" \
    "v_add_f32 v146, v140, v141\n\t" \
    "v_pk_mul_f32 v[142:143], %[s01], v[100:101]\n\t" \
    "v_pk_mul_f32 v[144:145], %[s23], v[102:103]\n\t" \
    "v_add_f32_dpp v146, v146, v146 quad_perm:[1,0,3,2] row_mask:0xf bank_mask:0xf bound_ctrl:1\n\t" \
    "v_add_f32_dpp %[yp], %[yp], %[yp] quad_perm:[1,0,3,2] row_mask:0xf bank_mask:0xf bound_ctrl:1\n\t" \
    "v_pk_fma_f32 v[142:143], v[116:117], v[108:109], v[142:143] op_sel_hi:[0,1,1]\n\t" \
    "v_add_f32_dpp v146, v146, v146 quad_perm:[2,3,0,1] row_mask:0xf bank_mask:0xf bound_ctrl:1\n\t" \
    "v_add_f32_dpp %[yp], %[yp], %[yp] quad_perm:[2,3,0,1] row_mask:0xf bank_mask:0xf bound_ctrl:1\n\t" \
    "v_pk_fma_f32 v[144:145], v[116:117], v[110:111], v[144:145] op_sel_hi:[0,1,1]\n\t" \
    "v_add_f32_dpp v146, v146, v146 row_half_mirror row_mask:0xf bank_mask:0xf bound_ctrl:1\n\t" \
    "v_add_f32_dpp %[yp], %[yp], %[yp] row_half_mirror row_mask:0xf bank_mask:0xf bound_ctrl:1\n\t" \
    "v_cmp_eq_u32_e32 vcc, 3, %[sp]\n\t" \
    "v_add_f32_dpp v146, v146, v146 row_mirror row_mask:0xf bank_mask:0xf bound_ctrl:1\n\t" \
    "v_add_f32_dpp %[yp], %[yp], %[yp] row_mirror row_mask:0xf bank_mask:0xf bound_ctrl:1\n\t" \
    "v_cndmask_b32_e32 %[yk1], %[yk1], %[yp], vcc\n\t" \
    "v_pk_fma_f32 %[s01], v[146:147], v[104:105], v[142:143] op_sel_hi:[0,1,1] neg_lo:[1,0,0] neg_hi:[1,0,0]\n\t" \
    "v_pk_fma_f32 %[s23], v[146:147], v[106:107], v[144:145] op_sel_hi:[0,1,1] neg_lo:[1,0,0] neg_hi:[1,0,0]\n\t" \
    "v_pk_mul_f32 v[140:141], %[s01], v[112:113]\n\t" \
    "v_pk_fma_f32 v[140:141], %[s23], v[114:115], v[140:141]\n\t" \
    "v_add_f32 %[yp], v140, v141\n\t" \
    "s_waitcnt lgkmcnt(0)\n\t" \
    "ds_read_b128 v[96:99], %[ab] offset:30208\n\t" \
    "ds_read_b128 v[100:103], %[ab] offset:5632\n\t" \
    "ds_read_b128 v[104:107], %[ab] offset:22016\n\t" \
    "ds_read_b128 v[108:111], %[ab] offset:13824\n\t" \
    "ds_read_b128 v[112:115], %[ab] offset:38400\n\t" \
    "ds_read_b32 v116, %[av] offset:1408\n\t" \
    "v_pk_mul_f32 v[140:141], %[s01], v[118:119]\n\t" \
    "v_pk_fma_f32 v[140:141], %[s23], v[120:121], v[140:141]\n\t" \
    "v_add_f32 v146, v140, v141\n\t" \
    "v_pk_mul_f32 v[142:143], %[s01], v[122:123]\n\t" \
    "v_pk_mul_f32 v[144:145], %[s23], v[124:125]\n\t" \
    "v_add_f32_dpp v146, v146, v146 quad_perm:[1,0,3,2] row_mask:0xf bank_mask:0xf bound_ctrl:1\n\t" \
    "v_add_f32_dpp %[yp], %[yp], %[yp] quad_perm:[1,0,3,2] row_mask:0xf bank_mask:0xf bound_ctrl:1\n\t" \
    "v_pk_fma_f32 v[142:143], v[138:139], v[130:131], v[142:143] op_sel_hi:[0,1,1]\n\t" \
    "v_add_f32_dpp v146, v146, v146 quad_perm:[2,3,0,1] row_mask:0xf bank_mask:0xf bound_ctrl:1\n\t" \
    "v_add_f32_dpp %[yp], %[yp], %[yp] quad_perm:[2,3,0,1] row_mask:0xf bank_mask:0xf bound_ctrl:1\n\t" \
    "v_pk_fma_f32 v[144:145], v[138:139], v[132:133], v[144:145] op_sel_hi:[0,1,1]\n\t" \
    "v_add_f32_dpp v146, v146, v146 row_half_mirror row_mask:0xf bank_mask:0xf bound_ctrl:1\n\t" \
    "v_add_f32_dpp %[yp], %[yp], %[yp] row_half_mirror row_mask:0xf bank_mask:0xf bound_ctrl:1\n\t" \
    "v_cmp_eq_u32_e32 vcc, 4, %[sp]\n\t" \
    "v_add_f32_dpp v146, v146, v146 row_mirror row_mask:0xf bank_mask:0xf bound_ctrl:1\n\t" \
    "v_add_f32_dpp %[yp], %[yp], %[yp] row_mirror row_mask:0xf bank_mask:0xf bound_ctrl:1\n\t" \
    "v_cndmask_b32_e32 %[yk1], %[yk1], %[yp], vcc\n\t" \
    "v_pk_fma_f32 %[s01], v[146:147], v[126:127], v[142:143] op_sel_hi:[0,1,1] neg_lo:[1,0,0] neg_hi:[1,0,0]\n\t" \
    "v_pk_fma_f32 %[s23], v[146:147], v[128:129], v[144:145] op_sel_hi:[0,1,1] neg_lo:[1,0,0] neg_hi:[1,0,0]\n\t" \
    "v_pk_mul_f32 v[140:141], %[s01], v[134:135]\n\t" \
    "v_pk_fma_f32 v[140:141], %[s23], v[136:137], v[140:141]\n\t" \
    "v_add_f32 %[yp], v140, v141\n\t" \
    "s_waitcnt lgkmcnt(0)\n\t" \
    "ds_read_b128 v[118:121], %[ab] offset:30464\n\t" \
    "ds_read_b128 v[122:125], %[ab] offset:5888\n\t" \
    "ds_read_b128 v[126:129], %[ab] offset:22272\n\t" \
    "ds_read_b128 v[130:133], %[ab] offset:14080\n\t" \
    "ds_read_b128 v[134:137], %[ab] offset:38656\n\t" \
    "ds_read_b32 v138, %[av] offset:1472\n\t" \
    "v_pk_mul_f32 v[140:141], %[s01], v[96:97]\n\t" \
    "v_pk_fma_f32 v[140:141], %[s23], v[98:99], v[140:141]\n\t" \
    "v_add_f32 v146, v140, v141\n\t" \
    "v_pk_mul_f32 v[142:143], %[s01], v[100:101]\n\t" \
    "v_pk_mul_f32 v[144:145], %[s23], v[102:103]\n\t" \
    "v_add_f32_dpp v146, v146, v146 quad_perm:[1,0,3,2] row_mask:0xf bank_mask:0xf bound_ctrl:1\n\t" \
    "v_add_f32_dpp %[yp], %[yp], %[yp] quad_perm:[1,0,3,2] row_mask:0xf bank_mask:0xf bound_ctrl:1\n\t" \
    "v_pk_fma_f32 v[142:143], v[116:117], v[108:109], v[142:143] op_sel_hi:[0,1,1]\n\t" \
    "v_add_f32_dpp v146, v146, v146 quad_perm:[2,3,0,1] row_mask:0xf bank_mask:0xf bound_ctrl:1\n\t" \
    "v_add_f32_dpp %[yp], %[yp], %[yp] quad_perm:[2,3,0,1] row_mask:0xf bank_mask:0xf bound_ctrl:1\n\t" \
    "v_pk_fma_f32 v[144:145], v[116:117], v[110:111], v[144:145] op_sel_hi:[0,1,1]\n\t" \
    "v_add_f32_dpp v146, v146, v146 row_half_mirror row_mask:0xf bank_mask:0xf bound_ctrl:1\n\t" \
    "v_add_f32_dpp %[yp], %[yp], %[yp] row_half_mirror row_mask:0xf bank_mask:0xf bound_ctrl:1\n\t" \
    "v_cmp_eq_u32_e32 vcc, 5, %[sp]\n\t" \
    "v_add_f32_dpp v146, v146, v146 row_mirror row_mask:0xf bank_mask:0xf bound_ctrl:1\n\t" \
    "v_add_f32_dpp %[yp], %[yp], %[yp] row_mirror row_mask:0xf bank_mask:0xf bound_ctrl:1\n\t" \
    "v_cndmask_b32_e32 %[yk1], %[yk1], %[yp], vcc\n\t" \
    "v_pk_fma_f32 %[s01], v[146:147], v[104:105], v[142:143] op_sel_hi:[0,1,1] neg_lo:[1,0,0] neg_hi:[1,0,0]\n\t" \
    "v_pk_fma_f32 %[s23], v[146:147], v[106:107], v[144:145] op_sel_hi:[0,1,1] neg_lo:[1,0,0] neg_hi:[1,0,0]\n\t" \
    "v_pk_mul_f32 v[140:141], %[s01], v[112:113]\n\t" \
    "v_pk_fma_f32 v[140:141], %[s23], v[114:115], v[140:141]\n\t" \
    "v_add_f32 %[yp], v140, v141\n\t" \
    "s_waitcnt lgkmcnt(0)\n\t" \
    "ds_read_b128 v[96:99], %[ab] offset:30720\n\t" \
    "ds_read_b128 v[100:103], %[ab] offset:6144\n\t" \
    "ds_read_b128 v[104:107], %[ab] offset:22528\n\t" \
    "ds_read_b128 v[108:111], %[ab] offset:14336\n\t" \
    "ds_read_b128 v[112:115], %[ab] offset:38912\n\t" \
    "ds_read_b32 v116, %[av] offset:1536\n\t" \
    "v_pk_mul_f32 v[140:141], %[s01], v[118:119]\n\t" \
    "v_pk_fma_f32 v[140:141], %[s23], v[120:121], v[140:141]\n\t" \
    "v_add_f32 v146, v140, v141\n\t" \
    "v_pk_mul_f32 v[142:143], %[s01], v[122:123]\n\t" \
    "v_pk_mul_f32 v[144:145], %[s23], v[124:125]\n\t" \
    "v_add_f32_dpp v146, v146, v146 quad_perm:[1,0,3,2] row_mask:0xf bank_mask:0xf bound_ctrl:1\n\t" \
    "v_add_f32_dpp %[yp], %[yp], %[yp] quad_perm:[1,0,3,2] row_mask:0xf bank_mask:0xf bound_ctrl:1\n\t" \
    "v_pk_fma_f32 v[142:143], v[138:139], v[130:131], v[142:143] op_sel_hi:[0,1,1]\n\t" \
    "v_add_f32_dpp v146, v146, v146 quad_perm:[2,3,0,1] row_mask:0xf bank_mask:0xf bound_ctrl:1\n\t" \
    "v_add_f32_dpp %[yp], %[yp], %[yp] quad_perm:[2,3,0,1] row_mask:0xf bank_mask:0xf bound_ctrl:1\n\t" \
    "v_pk_fma_f32 v[144:145], v[138:139], v[132:133], v[144:145] op_sel_hi:[0,1,1]\n\t" \
    "v_add_f32_dpp v146, v146, v146 row_half_mirror row_mask:0xf bank_mask:0xf bound_ctrl:1\n\t" \
    "v_add_f32_dpp %[yp], %[yp], %[yp] row_half_mirror row_mask:0xf bank_mask:0xf bound_ctrl:1\n\t" \
    "v_cmp_eq_u32_e32 vcc, 6, %[sp]\n\t" \
    "v_add_f32_dpp v146, v146, v146 row_mirror row_mask:0xf bank_mask:0xf bound_ctrl:1\n\t" \
    "v_add_f32_dpp %[yp], %[yp], %[yp] row_mirror row_mask:0xf bank_mask:0xf bound_ctrl:1\n\t" \
    "v_cndmask_b32_e32 %[yk1], %[yk1], %[yp], vcc\n\t" \
    "v_pk_fma_f32 %[s01], v[146:147], v[126:127], v[142:143] op_sel_hi:[0,1,1] neg_lo:[1,0,0] neg_hi:[1,0,0]\n\t" \
    "v_pk_fma_f32 %[s23], v[146:147], v[128:129], v[144:145] op_sel_hi:[0,1,1] neg_lo:[1,0,0] neg_hi:[1,0,0]\n\t" \
    "v_pk_mul_f32 v[140:141], %[s01], v[134:135]\n\t" \
    "v_pk_fma_f32 v[140:141], %[s23], v[136:137], v[140:141]\n\t" \
    "v_add_f32 %[yp], v140, v141\n\t" \
    "s_waitcnt lgkmcnt(0)\n\t" \
    "ds_read_b128 v[118:121], %[ab] offset:30976\n\t" \
    "ds_read_b128 v[122:125], %[ab] offset:6400\n\t" \
    "ds_read_b128 v[126:129], %[ab] offset:22784\n\t" \
    "ds_read_b128 v[130:133], %[ab] offset:14592\n\t" \
    "ds_read_b128 v[134:137], %[ab] offset:39168\n\t" \
    "ds_read_b32 v138, %[av] offset:1600\n\t" \
    "v_pk_mul_f32 v[140:141], %[s01], v[96:97]\n\t" \
    "v_pk_fma_f32 v[140:141], %[s23], v[98:99], v[140:141]\n\t" \
    "v_add_f32 v146, v140, v141\n\t" \
    "v_pk_mul_f32 v[142:143], %[s01], v[100:101]\n\t" \
    "v_pk_mul_f32 v[144:145], %[s23], v[102:103]\n\t" \
    "v_add_f32_dpp v146, v146, v146 quad_perm:[1,0,3,2] row_mask:0xf bank_mask:0xf bound_ctrl:1\n\t" \
    "v_add_f32_dpp %[yp], %[yp], %[yp] quad_perm:[1,0,3,2] row_mask:0xf bank_mask:0xf bound_ctrl:1\n\t" \
    "v_pk_fma_f32 v[142:143], v[116:117], v[108:109], v[142:143] op_sel_hi:[0,1,1]\n\t" \
    "v_add_f32_dpp v146, v146, v146 quad_perm:[2,3,0,1] row_mask:0xf bank_mask:0xf bound_ctrl:1\n\t" \
    "v_add_f32_dpp %[yp], %[yp], %[yp] quad_perm:[2,3,0,1] row_mask:0xf bank_mask:0xf bound_ctrl:1\n\t" \
    "v_pk_fma_f32 v[144:145], v[116:117], v[110:111], v[144:145] op_sel_hi:[0,1,1]\n\t" \
    "v_add_f32_dpp v146, v146, v146 row_half_mirror row_mask:0xf bank_mask:0xf bound_ctrl:1\n\t" \
    "v_add_f32_dpp %[yp], %[yp], %[yp] row_half_mirror row_mask:0xf bank_mask:0xf bound_ctrl:1\n\t" \
    "v_cmp_eq_u32_e32 vcc, 7, %[sp]\n\t" \
    "v_add_f32_dpp v146, v146, v146 row_mirror row_mask:0xf bank_mask:0xf bound_ctrl:1\n\t" \
    "v_add_f32_dpp %[yp], %[yp], %[yp] row_mirror row_mask:0xf bank_mask:0xf bound_ctrl:1\n\t" \
    "v_cndmask_b32_e32 %[yk1], %[yk1], %[yp], vcc\n\t" \
    "v_pk_fma_f32 %[s01], v[146:147], v[104:105], v[142:143] op_sel_hi:[0,1,1] neg_lo:[1,0,0] neg_hi:[1,0,0]\n\t" \
    "v_pk_fma_f32 %[s23], v[146:147], v[106:107], v[144:145] op_sel_hi:[0,1,1] neg_lo:[1,0,0] neg_hi:[1,0,0]\n\t" \
    "v_pk_mul_f32 v[140:141], %[s01], v[112:113]\n\t" \
    "v_pk_fma_f32 v[140:141], %[s23], v[114:115], v[140:141]\n\t" \
    "v_add_f32 %[yp], v140, v141\n\t" \
    "s_waitcnt lgkmcnt(0)\n\t" \
    "ds_read_b128 v[96:99], %[ab] offset:31232\n\t" \
    "ds_read_b128 v[100:103], %[ab] offset:6656\n\t" \
    "ds_read_b128 v[104:107], %[ab] offset:23040\n\t" \
    "ds_read_b128 v[108:111], %[ab] offset:14848\n\t" \
    "ds_read_b128 v[112:115], %[ab] offset:39424\n\t" \
    "ds_read_b32 v116, %[av] offset:1664\n\t" \
    "v_pk_mul_f32 v[140:141], %[s01], v[118:119]\n\t" \
    "v_pk_fma_f32 v[140:141], %[s23], v[120:121], v[140:141]\n\t" \
    "v_add_f32 v146, v140, v141\n\t" \
    "v_pk_mul_f32 v[142:143], %[s01], v[122:123]\n\t" \
    "v_pk_mul_f32 v[144:145], %[s23], v[124:125]\n\t" \
    "v_add_f32_dpp v146, v146, v146 quad_perm:[1,0,3,2] row_mask:0xf bank_mask:0xf bound_ctrl:1\n\t" \
    "v_add_f32_dpp %[yp], %[yp], %[yp] quad_perm:[1,0,3,2] row_mask:0xf bank_mask:0xf bound_ctrl:1\n\t" \
    "v_pk_fma_f32 v[142:143], v[138:139], v[130:131], v[142:143] op_sel_hi:[0,1,1]\n\t" \
    "v_add_f32_dpp v146, v146, v146 quad_perm:[2,3,0,1] row_mask:0xf bank_mask:0xf bound_ctrl:1\n\t" \
    "v_add_f32_dpp %[yp], %[yp], %[yp] quad_perm:[2,3,0,1] row_mask:0xf bank_mask:0xf bound_ctrl:1\n\t" \
    "v_pk_fma_f32 v[144:145], v[138:139], v[132:133], v[144:145] op_sel_hi:[0,1,1]\n\t" \
    "v_add_f32_dpp v146, v146, v146 row_half_mirror row_mask:0xf bank_mask:0xf bound_ctrl:1\n\t" \
    "v_add_f32_dpp %[yp], %[yp], %[yp] row_half_mirror row_mask:0xf bank_mask:0xf bound_ctrl:1\n\t" \
    "v_cmp_eq_u32_e32 vcc, 8, %[sp]\n\t" \
    "v_add_f32_dpp v146, v146, v146 row_mirror row_mask:0xf bank_mask:0xf bound_ctrl:1\n\t" \
    "v_add_f32_dpp %[yp], %[yp], %[yp] row_mirror row_mask:0xf bank_mask:0xf bound_ctrl:1\n\t" \
    "v_cndmask_b32_e32 %[yk1], %[yk1], %[yp], vcc\n\t" \
    "v_pk_fma_f32 %[s01], v[146:147], v[126:127], v[142:143] op_sel_hi:[0,1,1] neg_lo:[1,0,0] neg_hi:[1,0,0]\n\t" \
    "v_pk_fma_f32 %[s23], v[146:147], v[128:129], v[144:145] op_sel_hi:[0,1,1] neg_lo:[1,0,0] neg_hi:[1,0,0]\n\t" \
    "v_pk_mul_f32 v[140:141], %[s01], v[134:135]\n\t" \
    "v_pk_fma_f32 v[140:141], %[s23], v[136:137], v[140:141]\n\t" \
    "v_add_f32 %[yp], v140, v141\n\t" \
    "s_waitcnt lgkmcnt(0)\n\t" \
    "ds_read_b128 v[118:121], %[ab] offset:31488\n\t" \
    "ds_read_b128 v[122:125], %[ab] offset:6912\n\t" \
    "ds_read_b128 v[126:129], %[ab] offset:23296\n\t" \
    "ds_read_b128 v[130:133], %[ab] offset:15104\n\t" \
    "ds_read_b128 v[134:137], %[ab] offset:39680\n\t" \
    "ds_read_b32 v138, %[av] offset:1728\n\t" \
    "v_pk_mul_f32 v[140:141], %[s01], v[96:97]\n\t" \
    "v_pk_fma_f32 v[140:141], %[s23], v[98:99], v[140:141]\n\t" \
    "v_add_f32 v146, v140, v141\n\t" \
    "v_pk_mul_f32 v[142:143], %[s01], v[100:101]\n\t" \
    "v_pk_mul_f32 v[144:145], %[s23], v[102:103]\n\t" \
    "v_add_f32_dpp v146, v146, v146 quad_perm:[1,0,3,2] row_mask:0xf bank_mask:0xf bound_ctrl:1\n\t" \
    "v_add_f32_dpp %[yp], %[yp], %[yp] quad_perm:[1,0,3,2] row_mask:0xf bank_mask:0xf bound_ctrl:1\n\t" \
    "v_pk_fma_f32 v[142:143], v[116:117], v[108:109], v[142:143] op_sel_hi:[0,1,1]\n\t" \
    "v_add_f32_dpp v146, v146, v146 quad_perm:[2,3,0,1] row_mask:0xf bank_mask:0xf bound_ctrl:1\n\t" \
    "v_add_f32_dpp %[yp], %[yp], %[yp] quad_perm:[2,3,0,1] row_mask:0xf bank_mask:0xf bound_ctrl:1\n\t" \
    "v_pk_fma_f32 v[144:145], v[116:117], v[110:111], v[144:145] op_sel_hi:[0,1,1]\n\t" \
    "v_add_f32_dpp v146, v146, v146 row_half_mirror row_mask:0xf bank_mask:0xf bound_ctrl:1\n\t" \
    "v_add_f32_dpp %[yp], %[yp], %[yp] row_half_mirror row_mask:0xf bank_mask:0xf bound_ctrl:1\n\t" \
    "v_cmp_eq_u32_e32 vcc, 9, %[sp]\n\t" \
    "v_add_f32_dpp v146, v146, v146 row_mirror row_mask:0xf bank_mask:0xf bound_ctrl:1\n\t" \
    "v_add_f32_dpp %[yp], %[yp], %[yp] row_mirror row_mask:0xf bank_mask:0xf bound_ctrl:1\n\t" \
    "v_cndmask_b32_e32 %[yk1], %[yk1], %[yp], vcc\n\t" \
    "v_pk_fma_f32 %[s01], v[146:147], v[104:105], v[142:143] op_sel_hi:[0,1,1] neg_lo:[1,0,0] neg_hi:[1,0,0]\n\t" \
    "v_pk_fma_f32 %[s23], v[146:147], v[106:107], v[144:145] op_sel_hi:[0,1,1] neg_lo:[1,0,0] neg_hi:[1,0,0]\n\t" \
    "v_pk_mul_f32 v[140:141], %[s01], v[112:113]\n\t" \
    "v_pk_fma_f32 v[140:141], %[s23], v[114:115], v[140:141]\n\t" \
    "v_add_f32 %[yp], v140, v141\n\t" \
    "s_waitcnt lgkmcnt(0)\n\t" \
    "ds_read_b128 v[96:99], %[ab] offset:31744\n\t" \
    "ds_read_b128 v[100:103], %[ab] offset:7168\n\t" \
    "ds_read_b128 v[104:107], %[ab] offset:23552\n\t" \
    "ds_read_b128 v[108:111], %[ab] offset:15360\n\t" \
    "ds_read_b128 v[112:115], %[ab] offset:39936\n\t" \
    "ds_read_b32 v116, %[av] offset:1792\n\t" \
    "v_pk_mul_f32 v[140:141], %[s01], v[118:119]\n\t" \
    "v_pk_fma_f32 v[140:141], %[s23], v[120:121], v[140:141]\n\t" \
    "v_add_f32 v146, v140, v141\n\t" \
    "v_pk_mul_f32 v[142:143], %[s01], v[122:123]\n\t" \
    "v_pk_mul_f32 v[144:145], %[s23], v[124:125]\n\t" \
    "v_add_f32_dpp v146, v146, v146 quad_perm:[1,0,3,2] row_mask:0xf bank_mask:0xf bound_ctrl:1\n\t" \
    "v_add_f32_dpp %[yp], %[yp], %[yp] quad_perm:[1,0,3,2] row_mask:0xf bank_mask:0xf bound_ctrl:1\n\t" \
    "v_pk_fma_f32 v[142:143], v[138:139], v[130:131], v[142:143] op_sel_hi:[0,1,1]\n\t" \
    "v_add_f32_dpp v146, v146, v146 quad_perm:[2,3,0,1] row_mask:0xf bank_mask:0xf bound_ctrl:1\n\t" \
    "v_add_f32_dpp %[yp], %[yp], %[yp] quad_perm:[2,3,0,1] row_mask:0xf bank_mask:0xf bound_ctrl:1\n\t" \
    "v_pk_fma_f32 v[144:145], v[138:139], v[132:133], v[144:145] op_sel_hi:[0,1,1]\n\t" \
    "v_add_f32_dpp v146, v146, v146 row_half_mirror row_mask:0xf bank_mask:0xf bound_ctrl:1\n\t" \
    "v_add_f32_dpp %[yp], %[yp], %[yp] row_half_mirror row_mask:0xf bank_mask:0xf bound_ctrl:1\n\t" \
    "v_cmp_eq_u32_e32 vcc, 10, %[sp]\n\t" \
    "v_add_f32_dpp v146, v146, v146 row_mirror row_mask:0xf bank_mask:0xf bound_ctrl:1\n\t" \
    "v_add_f32_dpp %[yp], %[yp], %[yp] row_mirror row_mask:0xf bank_mask:0xf bound_ctrl:1\n\t" \
    "v_cndmask_b32_e32 %[yk1], %[yk1], %[yp], vcc\n\t" \
    "v_pk_fma_f32 %[s01], v[146:147], v[126:127], v[142:143] op_sel_hi:[0,1,1] neg_lo:[1,0,0] neg_hi:[1,0,0]\n\t" \
    "v_pk_fma_f32 %[s23], v[146:147], v[128:129], v[144:145] op_sel_hi:[0,1,1] neg_lo:[1,0,0] neg_hi:[1,0,0]\n\t" \
    "v_pk_mul_f32 v[140:141], %[s01], v[134:135]\n\t" \
    "v_pk_fma_f32 v[140:141], %[s23], v[136:137], v[140:141]\n\t" \
    "v_add_f32 %[yp], v140, v141\n\t" \
    "s_waitcnt lgkmcnt(0)\n\t" \
    "ds_read_b128 v[118:121], %[ab] offset:32000\n\t" \
    "ds_read_b128 v[122:125], %[ab] offset:7424\n\t" \
    "ds_read_b128 v[126:129], %[ab] offset:23808\n\t" \
    "ds_read_b128 v[130:133], %[ab] offset:15616\n\t" \
    "ds_read_b128 v[134:137], %[ab] offset:40192\n\t" \
    "ds_read_b32 v138, %[av] offset:1856\n\t" \
    "v_pk_mul_f32 v[140:141], %[s01], v[96:97]\n\t" \
    "v_pk_fma_f32 v[140:141], %[s23], v[98:99], v[140:141]\n\t" \
    "v_add_f32 v146, v140, v141\n\t" \
    "v_pk_mul_f32 v[142:143], %[s01], v[100:101]\n\t" \
    "v_pk_mul_f32 v[144:145], %[s23], v[102:103]\n\t" \
    "v_add_f32_dpp v146, v146, v146 quad_perm:[1,0,3,2] row_mask:0xf bank_mask:0xf bound_ctrl:1\n\t" \
    "v_add_f32_dpp %[yp], %[yp], %[yp] quad_perm:[1,0,3,2] row_mask:0xf bank_mask:0xf bound_ctrl:1\n\t" \
    "v_pk_fma_f32 v[142:143], v[116:117], v[108:109], v[142:143] op_sel_hi:[0,1,1]\n\t" \
    "v_add_f32_dpp v146, v146, v146 quad_perm:[2,3,0,1] row_mask:0xf bank_mask:0xf bound_ctrl:1\n\t" \
    "v_add_f32_dpp %[yp], %[yp], %[yp] quad_perm:[2,3,0,1] row_mask:0xf bank_mask:0xf bound_ctrl:1\n\t" \
    "v_pk_fma_f32 v[144:145], v[116:117], v[110:111], v[144:145] op_sel_hi:[0,1,1]\n\t" \
    "v_add_f32_dpp v146, v146, v146 row_half_mirror row_mask:0xf bank_mask:0xf bound_ctrl:1\n\t" \
    "v_add_f32_dpp %[yp], %[yp], %[yp] row_half_mirror row_mask:0xf bank_mask:0xf bound_ctrl:1\n\t" \
    "v_cmp_eq_u32_e32 vcc, 11, %[sp]\n\t" \
    "v_add_f32_dpp v146, v146, v146 row_mirror row_mask:0xf bank_mask:0xf bound_ctrl:1\n\t" \
    "v_add_f32_dpp %[yp], %[yp], %[yp] row_mirror row_mask:0xf bank_mask:0xf bound_ctrl:1\n\t" \
    "v_cndmask_b32_e32 %[yk1], %[yk1], %[yp], vcc\n\t" \
    "v_pk_fma_f32 %[s01], v[146:147], v[104:105], v[142:143] op_sel_hi:[0,1,1] neg_lo:[1,0,0] neg_hi:[1,0,0]\n\t" \
    "v_pk_fma_f32 %[s23], v[146:147], v[106:107], v[144:145] op_sel_hi:[0,1,1] neg_lo:[1,0,0] neg_hi:[1,0,0]\n\t" \
    "v_pk_mul_f32 v[140:141], %[s01], v[112:113]\n\t" \
    "v_pk_fma_f32 v[140:141], %[s23], v[114:115], v[140:141]\n\t" \
    "v_add_f32 %[yp], v140, v141\n\t" \
    "s_waitcnt lgkmcnt(0)\n\t" \
    "ds_read_b128 v[96:99], %[ab] offset:32256\n\t" \
    "ds_read_b128 v[100:103], %[ab] offset:7680\n\t" \
    "ds_read_b128 v[104:107], %[ab] offset:24064\n\t" \
    "ds_read_b128 v[108:111], %[ab] offset:15872\n\t" \
    "ds_read_b128 v[112:115], %[ab] offset:40448\n\t" \
    "ds_read_b32 v116, %[av] offset:1920\n\t" \
    "v_pk_mul_f32 v[140:141], %[s01], v[118:119]\n\t" \
    "v_pk_fma_f32 v[140:141], %[s23], v[120:121], v[140:141]\n\t" \
    "v_add_f32 v146, v140, v141\n\t" \
    "v_pk_mul_f32 v[142:143], %[s01], v[122:123]\n\t" \
    "v_pk_mul_f32 v[144:145], %[s23], v[124:125]\n\t" \
    "v_add_f32_dpp v146, v146, v146 quad_perm:[1,0,3,2] row_mask:0xf bank_mask:0xf bound_ctrl:1\n\t" \
    "v_add_f32_dpp %[yp], %[yp], %[yp] quad_perm:[1,0,3,2] row_mask:0xf bank_mask:0xf bound_ctrl:1\n\t" \
    "v_pk_fma_f32 v[142:143], v[138:139], v[130:131], v[142:143] op_sel_hi:[0,1,1]\n\t" \
    "v_add_f32_dpp v146, v146, v146 quad_perm:[2,3,0,1] row_mask:0xf bank_mask:0xf bound_ctrl:1\n\t" \
    "v_add_f32_dpp %[yp], %[yp], %[yp] quad_perm:[2,3,0,1] row_mask:0xf bank_mask:0xf bound_ctrl:1\n\t" \
    "v_pk_fma_f32 v[144:145], v[138:139], v[132:133], v[144:145] op_sel_hi:[0,1,1]\n\t" \
    "v_add_f32_dpp v146, v146, v146 row_half_mirror row_mask:0xf bank_mask:0xf bound_ctrl:1\n\t" \
    "v_add_f32_dpp %[yp], %[yp], %[yp] row_half_mirror row_mask:0xf bank_mask:0xf bound_ctrl:1\n\t" \
    "v_cmp_eq_u32_e32 vcc, 12, %[sp]\n\t" \
    "v_add_f32_dpp v146, v146, v146 row_mirror row_mask:0xf bank_mask:0xf bound_ctrl:1\n\t" \
    "v_add_f32_dpp %[yp], %[yp], %[yp] row_mirror row_mask:0xf bank_mask:0xf bound_ctrl:1\n\t" \
    "v_cndmask_b32_e32 %[yk1], %[yk1], %[yp], vcc\n\t" \
    "v_pk_fma_f32 %[s01], v[146:147], v[126:127], v[142:143] op_sel_hi:[0,1,1] neg_lo:[1,0,0] neg_hi:[1,0,0]\n\t" \
    "v_pk_fma_f32 %[s23], v[146:147], v[128:129], v[144:145] op_sel_hi:[0,1,1] neg_lo:[1,0,0] neg_hi:[1,0,0]\n\t" \
    "v_pk_mul_f32 v[140:141], %[s01], v[134:135]\n\t" \
    "v_pk_fma_f32 v[140:141], %[s23], v[136:137], v[140:141]\n\t" \
    "v_add_f32 %[yp], v140, v141\n\t" \
    "s_waitcnt lgkmcnt(0)\n\t" \
    "ds_read_b128 v[118:121], %[ab] offset:32512\n\t" \
    "ds_read_b128 v[122:125], %[ab] offset:7936\n\t" \
    "ds_read_b128 v[126:129], %[ab] offset:24320\n\t" \
    "ds_read_b128 v[130:133], %[ab] offset:16128\n\t" \
    "ds_read_b128 v[134:137], %[ab] offset:40704\n\t" \
    "ds_read_b32 v138, %[av] offset:1984\n\t" \
    "v_pk_mul_f32 v[140:141], %[s01], v[96:97]\n\t" \
    "v_pk_fma_f32 v[140:141], %[s23], v[98:99], v[140:141]\n\t" \
    "v_add_f32 v146, v140, v141\n\t" \
    "v_pk_mul_f32 v[142:143], %[s01], v[100:101]\n\t" \
    "v_pk_mul_f32 v[144:145], %[s23], v[102:103]\n\t" \
    "v_add_f32_dpp v146, v146, v146 quad_perm:[1,0,3,2] row_mask:0xf bank_mask:0xf bound_ctrl:1\n\t" \
    "v_add_f32_dpp %[yp], %[yp], %[yp] quad_perm:[1,0,3,2] row_mask:0xf bank_mask:0xf bound_ctrl:1\n\t" \
    "v_pk_fma_f32 v[142:143], v[116:117], v[108:109], v[142:143] op_sel_hi:[0,1,1]\n\t" \
    "v_add_f32_dpp v146, v146, v146 quad_perm:[2,3,0,1] row_mask:0xf bank_mask:0xf bound_ctrl:1\n\t" \
    "v_add_f32_dpp %[yp], %[yp], %[yp] quad_perm:[2,3,0,1] row_mask:0xf bank_mask:0xf bound_ctrl:1\n\t" \
    "v_pk_fma_f32 v[144:145], v[116:117], v[110:111], v[144:145] op_sel_hi:[0,1,1]\n\t" \
    "v_add_f32_dpp v146, v146, v146 row_half_mirror row_mask:0xf bank_mask:0xf bound_ctrl:1\n\t" \
    "v_add_f32_dpp %[yp], %[yp], %[yp] row_half_mirror row_mask:0xf bank_mask:0xf bound_ctrl:1\n\t" \
    "v_cmp_eq_u32_e32 vcc, 13, %[sp]\n\t" \
    "v_add_f32_dpp v146, v146, v146 row_mirror row_mask:0xf bank_mask:0xf bound_ctrl:1\n\t" \
    "v_add_f32_dpp %[yp], %[yp], %[yp] row_mirror row_mask:0xf bank_mask:0xf bound_ctrl:1\n\t" \
    "v_cndmask_b32_e32 %[yk1], %[yk1], %[yp], vcc\n\t" \
    "v_pk_fma_f32 %[s01], v[146:147], v[104:105], v[142:143] op_sel_hi:[0,1,1] neg_lo:[1,0,0] neg_hi:[1,0,0]\n\t" \
    "v_pk_fma_f32 %[s23], v[146:147], v[106:107], v[144:145] op_sel_hi:[0,1,1] neg_lo:[1,0,0] neg_hi:[1,0,0]\n\t" \
    "v_pk_mul_f32 v[140:141], %[s01], v[112:113]\n\t" \
    "v_pk_fma_f32 v[140:141], %[s23], v[114:115], v[140:141]\n\t" \
    "v_add_f32 %[yp], v140, v141\n\t" \
    "s_waitcnt lgkmcnt(0)\n\t" \
    "ds_read_b128 v[96:99], %[ab] offset:32768\n\t" \
    "ds_read_b128 v[100:103], %[ab] offset:8192\n\t" \
    "ds_read_b128 v[104:107], %[ab] offset:24576\n\t" \
    "ds_read_b128 v[108:111], %[ab] offset:16384\n\t" \
    "ds_read_b128 v[112:115], %[ab] offset:40960\n\t" \
    "ds_read_b32 v116, %[av] offset:2048\n\t" \
    "v_pk_mul_f32 v[140:141], %[s01], v[118:119]\n\t" \
    "v_pk_fma_f32 v[140:141], %[s23], v[120:121], v[140:141]\n\t" \
    "v_add_f32 v146, v140, v141\n\t" \
    "v_pk_mul_f32 v[142:143], %[s01], v[122:123]\n\t" \
    "v_pk_mul_f32 v[144:145], %[s23], v[124:125]\n\t" \
    "v_add_f32_dpp v146, v146, v146 quad_perm:[1,0,3,2] row_mask:0xf bank_mask:0xf bound_ctrl:1\n\t" \
    "v_add_f32_dpp %[yp], %[yp], %[yp] quad_perm:[1,0,3,2] row_mask:0xf bank_mask:0xf bound_ctrl:1\n\t" \
    "v_pk_fma_f32 v[142:143], v[138:139], v[130:131], v[142:143] op_sel_hi:[0,1,1]\n\t" \
    "v_add_f32_dpp v146, v146, v146 quad_perm:[2,3,0,1] row_mask:0xf bank_mask:0xf bound_ctrl:1\n\t" \
    "v_add_f32_dpp %[yp], %[yp], %[yp] quad_perm:[2,3,0,1] row_mask:0xf bank_mask:0xf bound_ctrl:1\n\t" \
    "v_pk_fma_f32 v[144:145], v[138:139], v[132:133], v[144:145] op_sel_hi:[0,1,1]\n\t" \
    "v_add_f32_dpp v146, v146, v146 row_half_mirror row_mask:0xf bank_mask:0xf bound_ctrl:1\n\t" \
    "v_add_f32_dpp %[yp], %[yp], %[yp] row_half_mirror row_mask:0xf bank_mask:0xf bound_ctrl:1\n\t" \
    "v_cmp_eq_u32_e32 vcc, 14, %[sp]\n\t" \
    "v_add_f32_dpp v146, v146, v146 row_mirror row_mask:0xf bank_mask:0xf bound_ctrl:1\n\t" \
    "v_add_f32_dpp %[yp], %[yp], %[yp] row_mirror row_mask:0xf bank_mask:0xf bound_ctrl:1\n\t" \
    "v_cndmask_b32_e32 %[yk1], %[yk1], %[yp], vcc\n\t" \
    "v_pk_fma_f32 %[s01], v[146:147], v[126:127], v[142:143] op_sel_hi:[0,1,1] neg_lo:[1,0,0] neg_hi:[1,0,0]\n\t" \
    "v_pk_fma_f32 %[s23], v[146:147], v[128:129], v[144:145] op_sel_hi:[0,1,1] neg_lo:[1,0,0] neg_hi:[1,0,0]\n\t" \
    "v_pk_mul_f32 v[140:141], %[s01], v[134:135]\n\t" \
    "v_pk_fma_f32 v[140:141], %[s23], v[136:137], v[140:141]\n\t" \
    "v_add_f32 %[yp], v140, v141\n\t" \
    "s_waitcnt lgkmcnt(0)\n\t"
#define SCAN_CHUNK_CLOBBERS "v96", "v97", "v98", "v99", "v100", "v101", "v102", "v103", "v104", "v105", "v106", "v107", "v108", "v109", "v110", "v111", "v112", "v113", "v114", "v115", "v116", "v117", "v118", "v119", "v120", "v121", "v122", "v123", "v124", "v125", "v126", "v127", "v128", "v129", "v130", "v131", "v132", "v133", "v134", "v135", "v136", "v137", "v138", "v139", "v140", "v141", "v142", "v143", "v144", "v145", "v146", "v147", "vcc", "memory"
#ifndef EMU
#define UNR _Pragma("unroll")
#define UNR1 _Pragma("unroll 1")
#define CFENCE() asm volatile("" ::: "memory")
#define OPAQUE(x) asm volatile("" : "+v"(x))
#define SYNC() __syncthreads()
#define WAVE_SYNC() do { asm volatile("s_waitcnt lgkmcnt(0)" ::: "memory"); __builtin_amdgcn_wave_barrier(); } while (0)
DEVFN float shfl_xor_f(float v, int m) { return __shfl_xor(v, m); }
DEVFN float shfl_f(float v, int src) { return __shfl(v, src); }
DEVFN void sincospi_f(float x, float* s, float* c) { sincospif(x, s, c); }
template <int M> DEVFN float rowx_add(float v) { constexpr int ctrl = M == 1 ? 0xB1 : M == 2 ? 0x4E : M == 7 ? 0x141 : 0x140;
    return v + __builtin_bit_cast(float, __builtin_amdgcn_update_dpp(0, __builtin_bit_cast(int, v), ctrl, 0xf, 0xf, true)); }
#endif

enum InIdx { I_X = 0, I_C, I_CTX, I_CCTX, I_ANORM, I_AADAW, I_AADAB, I_AWIN, I_RPB, I_QG, I_KG, I_AWOUT, I_RNORM, I_RADAW, I_RADAB, I_RWIN, I_MU, I_W0, I_WUP, I_A0, I_AUP,
             I_KK, I_KA, I_RK, I_GNW, I_GNB, I_HSHORT, I_HW1, I_HB1, I_HW2, I_HB2, I_HW3, I_HB3, I_HSKIP, I_RWOUT, I_FNORM, N_IN };

#if defined(TSEL) && !defined(EMU)
#define XSTAMP(C, k, cond) do { if ((cond) && (C).tid == 0) __hip_atomic_store((unsigned long long*)((C).ws + WS_CTL + 32768) + (k), (unsigned long long)__builtin_amdgcn_s_memrealtime(), __ATOMIC_RELAXED, __HIP_MEMORY_SCOPE_AGENT); } while (0)
#else
#define XSTAMP(C, k, cond) do {} while (0)
#endif
#if defined(TSEL) && !defined(EMU)
#define TACC_DECL unsigned long long tacc_ = 0, tb_ = 0
#define TACC_BEGIN tb_ = __builtin_amdgcn_s_memrealtime()
#define TACC_END tacc_ += __builtin_amdgcn_s_memrealtime() - tb_
#define TACC_STORE(C, k, cond) do { if (cond) __hip_atomic_store((unsigned long long*)((C).ws + WS_CTL + 32768) + (k), tacc_, __ATOMIC_RELAXED, __HIP_MEMORY_SCOPE_AGENT); } while (0)
#else
#define TACC_DECL
#define TACC_BEGIN
#define TACC_END
#define TACC_STORE(C, k, cond)
#endif
struct Ctx {
    const float* in[N_IN]; float* out; unsigned char* ws;
    int tid, lane, wave, vcu, G;
};

#ifdef EMU
DEVFN float wave_sum(float v) { for (int o = 1; o < 64; o <<= 1) v += shfl_xor_f(v, o); return v; }
DEVFN float swap16_f(float v) { return shfl_xor_f(v, 16); }
#else
DEVFN float wave_sum(float v) { v = rowx_add<1>(v); v = rowx_add<2>(v); v = rowx_add<7>(v); v = rowx_add<15>(v);
    const int i_ = __builtin_bit_cast(int, v);
    return (__builtin_bit_cast(float, __builtin_amdgcn_readlane(i_, 0)) + __builtin_bit_cast(float, __builtin_amdgcn_readlane(i_, 16))) + (__builtin_bit_cast(float, __builtin_amdgcn_readlane(i_, 32)) + __builtin_bit_cast(float, __builtin_amdgcn_readlane(i_, 48))); }
DEVFN float swap16_f(float v) { return __builtin_bit_cast(float, __builtin_amdgcn_ds_swizzle(__builtin_bit_cast(int, v), 0x401F)); }
#endif

DEVFN U4 ld16(const void* p) { return *(const U4*)p; }
DEVFN void st16(void* p, U4 v) { *(U4*)p = v; }
DEVFN void unpack8(U4 w, float* f) { f[0] = bflo(w.x); f[1] = bfhi(w.x); f[2] = bflo(w.y); f[3] = bfhi(w.y); f[4] = bflo(w.z); f[5] = bfhi(w.z); f[6] = bflo(w.w); f[7] = bfhi(w.w); }
DEVFN U4 pack8(const float* f) { U4 w; w.x = pk2(f[0], f[1]); w.y = pk2(f[2], f[3]); w.z = pk2(f[4], f[5]); w.w = pk2(f[6], f[7]); return w; }

DEVFN void p0_transpose_item(const float* W, int K, int N, bf16_t* WT, float* scr, int item, int lane) {
    const int nblk = N / 32, kb = item / nblk, nb = item % nblk, k0 = 64 * kb, n0 = 32 * nb;
    UNR for (int i = 0; i < 32; ++i) { const int kk = 2 * i + (lane >> 5); scr[kk * 33 + (lane & 31)] = W[(size_t)(k0 + kk) * N + n0 + (lane & 31)]; }
    WAVE_SYNC();
    const int c = lane & 7;
    UNR for (int j = 0; j < 4; ++j) { const int n = (lane >> 3) + 8 * j; const float* s = scr + (8 * c) * 33 + n;
        U4 o; o.x = pk2(s[0 * 33], s[1 * 33]); o.y = pk2(s[2 * 33], s[3 * 33]); o.z = pk2(s[4 * 33], s[5 * 33]); o.w = pk2(s[6 * 33], s[7 * 33]);
        st16(WT + (size_t)(n0 + n) * K + k0 + 8 * c, o); }
    WAVE_SYNC();
}

DEVFN void hid_rows(const float* w1, const float* b1, const float* w2, const float* b2, float* hid, int L, int gw, int NGW, int lane) {
    float w1c[33], w2c[64];
    UNR for (int i = 0; i < 33; ++i) w1c[i] = w1[i * 64 + lane];
    UNR for (int i = 0; i < 64; ++i) w2c[i] = w2[i * 64 + lane];
    const float bb1 = b1[lane], bb2 = b2[lane];
    for (int t = gw; t < L; t += NGW) {
        float feat = 0.f;
        if (lane == 0) feat = (float)t / (float)(L - 1 > 1 ? L - 1 : 1);
        else if (lane < 33) { const int b = (lane - 1) & 15; const float band = 1e-4f + (float)b * ((15.0f - 1e-4f) / 15.0f);
            const float x = 2.0f * band * (float)t / (float)L; float s, c; sincospi_f(x, &s, &c); feat = (lane <= 16) ? c : -s; }
        float a = bb1;
        UNR for (int i = 0; i < 33; ++i) a += shfl_f(feat, i) * w1c[i];
        const float h1 = sinf(a);
        float b = bb2;
        UNR for (int i = 0; i < 64; ++i) b += shfl_f(h1, i) * w2c[i];
        hid[(size_t)t * 64 + lane] = sinf(b);
    }
}

DEVFN void ph_prologue(const Ctx& C, unsigned char* lds) {
    const int gw = C.vcu * NWAVES + C.wave, NGW = C.G * NWAVES, lane = C.lane;
    float* scr = (float*)(lds + C.wave * 16384);
    {
        constexpr int I_AIN = 16 * (AIN / 32), I_OUT = 16 * 32, I_RIN = 16 * (RIN / 32);
        constexpr int NIT = 2 * (I_AIN + I_OUT + I_RIN + I_OUT);
        for (int it = gw; it < NIT; it += NGW) {
            int r = it; const int li = r & 1; r >>= 1;
            if (r < I_AIN) { p0_transpose_item(C.in[I_AWIN] + (size_t)li * DM * AIN, DM, AIN, (bf16_t*)(C.ws + WS_WAIN) + (size_t)li * AIN * DM, scr, r, lane); continue; } r -= I_AIN;
            if (r < I_OUT) { p0_transpose_item(C.in[I_AWOUT] + (size_t)li * DM * DM, DM, DM, (bf16_t*)(C.ws + WS_WAOUT) + (size_t)li * DM * DM, scr, r, lane); continue; } r -= I_OUT;
            if (r < I_RIN) { p0_transpose_item(C.in[I_RWIN] + (size_t)li * DM * RIN, DM, RIN, (bf16_t*)(C.ws + WS_WRIN) + (size_t)li * RINP * DM, scr, r, lane); continue; } r -= I_RIN;
            p0_transpose_item(C.in[I_RWOUT] + (size_t)li * DM * DM, DM, DM, (bf16_t*)(C.ws + WS_WROUT) + (size_t)li * DM * DM, scr, r, lane);
        }
        for (int e = gw * 64 + lane; e < 2 * (RINP - RIN) * DM / 8; e += NGW * 64) { const int li = e / ((RINP - RIN) * DM / 8), o = e % ((RINP - RIN) * DM / 8);
            U4 z; z.x = z.y = z.z = z.w = 0u; st16((bf16_t*)(C.ws + WS_WRIN) + (size_t)li * RINP * DM + (size_t)RIN * DM + (size_t)o * 8, z); }
    }
    {
        float* ADA = (float*)(C.ws + WS_ADA);
        for (int it = gw; it < 4 * 48; it += NGW) {
            const int layer = it / 48, cb = it % 48, col = cb * 64 + lane, i = layer >> 1;
            const float* W = (layer & 1) ? C.in[I_RADAW] + (size_t)i * DM * 3072 : C.in[I_AADAW] + (size_t)i * DM * 3072;
            const float* B = (layer & 1) ? C.in[I_RADAB] + (size_t)i * 3072 : C.in[I_AADAB] + (size_t)i * 3072;
            float a0 = 0.f, a1 = 0.f;
            for (int k0 = 0; k0 < DM; k0 += 64) {
                const float sc = silu_f(C.in[I_C][k0 + lane]), sx = silu_f(C.in[I_CCTX][k0 + lane]);
                for (int k = 0; k < 64; ++k) { const float w = W[(size_t)(k0 + k) * 3072 + col]; a0 += shfl_f(sc, k) * w; a1 += shfl_f(sx, k) * w; }
            }
            ADA[(size_t)(layer * 2 + 0) * 3072 + col] = a0 + B[col];
            ADA[(size_t)(layer * 2 + 1) * 3072 + col] = a1 + B[col];
        }
    }
    for (int i = 0; i < 2; ++i)
        hid_rows(C.in[I_HW1] + (size_t)i * 33 * 64, C.in[I_HB1] + i * 64, C.in[I_HW2] + (size_t)i * 64 * 64, C.in[I_HB2] + i * 64, (float*)(C.ws + WS_HID) + (size_t)i * NLAT * 64, NLAT, gw, NGW, lane);
    hid_rows(C.in[I_HW1], C.in[I_HB1], C.in[I_HW2], C.in[I_HB2], (float*)(C.ws + WS_HID256), NCTX, gw, NGW, lane);
    { F2* TW = (F2*)(C.ws + WS_TW);
      for (int k = gw * 64 + lane; k <= 16384; k += NGW * 64) { float s, c; sincospi_f((float)k * (1.0f / 16384.0f), &s, &c); F2 w; w.x = c; w.y = -s; TW[k] = w; } }
}

DEVFN void ph_norm(const Ctx& C, int layer, const float* xlat, const float* xctx, bool do_ctx) {
    const int gw = C.vcu * NWAVES + C.wave, NGW = C.G * NWAVES, lane = C.lane, i = layer >> 1;
    const float* gain = ((layer & 1) ? C.in[I_RNORM] : C.in[I_ANORM]) + (size_t)i * DM;
    const float* ADA = (const float*)(C.ws + WS_ADA) + (size_t)layer * 2 * 3072;
    bf16_t* XN = (bf16_t*)(C.ws + WS_XN);
    const int nrows = do_ctx ? NTOK : NLAT;
    for (int m = gw; m < nrows; m += NGW) {
        const bool isctx = m >= NLAT;
        const float* xr = isctx ? xctx + (size_t)(m - NLAT) * DM : xlat + (size_t)m * DM;
        const float* ada = ADA + (isctx ? 3072 : 0);
        F4 v[4]; float s = 0.f;
        UNR for (int j = 0; j < 4; ++j) { v[j] = *(const F4*)(xr + 256 * j + 4 * lane); s += (v[j].x * v[j].x + v[j].y * v[j].y) + (v[j].z * v[j].z + v[j].w * v[j].w); }
        const float rs = 1.0f / sqrtf(wave_sum(s) * (1.0f / DM) + NORM_EPS);
        UNR for (int j = 0; j < 4; ++j) { const int c0 = 256 * j + 4 * lane;
            const F4 g = *(const F4*)(gain + c0), sh = *(const F4*)(ada + c0), sc = *(const F4*)(ada + 1024 + c0);
            U2 o; o.x = pk2(v[j].x * rs * g.x * (1.f + sc.x) + sh.x, v[j].y * rs * g.y * (1.f + sc.y) + sh.y);
            o.y = pk2(v[j].z * rs * g.z * (1.f + sc.z) + sh.z, v[j].w * rs * g.w * (1.f + sc.w) + sh.w);
            *(U2*)(XN + (size_t)m * DM + c0) = o; }
    }
}

DEVFN void ph_final(const Ctx& C) {
    const int gw = C.vcu * NWAVES + C.wave, NGW = C.G * NWAVES, lane = C.lane;
    const float* gain = C.in[I_FNORM];
    for (int m = gw; m < NLAT; m += NGW) {
        float* xr = C.out + (size_t)m * DM;
        F4 v[4]; float s = 0.f;
        UNR for (int j = 0; j < 4; ++j) { v[j] = *(const F4*)(xr + 256 * j + 4 * lane); s += (v[j].x * v[j].x + v[j].y * v[j].y) + (v[j].z * v[j].z + v[j].w * v[j].w); }
        const float rs = 1.0f / sqrtf(wave_sum(s) * (1.0f / DM) + NORM_EPS);
        UNR for (int j = 0; j < 4; ++j) { const int c0 = 256 * j + 4 * lane; const F4 g = *(const F4*)(gain + c0);
            F4 o; o.x = v[j].x * rs * g.x; o.y = v[j].y * rs * g.y; o.z = v[j].z * rs * g.z; o.w = v[j].w * rs * g.w; *(F4*)(xr + c0) = o; }
    }
}

DEVFN void ph_qkprep(const Ctx& C, int i) {
    const int gw = C.vcu * NWAVES + C.wave, NGW = C.G * NWAVES, lane = C.lane;
    bf16_t* U = (bf16_t*)(C.ws + WS_U);
    const float qg = C.in[I_QG][i * 64 + lane], kg = C.in[I_KG][i * 64 + lane];
    const int axis = lane >> 5, half = (lane >> 4) & 1, f = lane & 15;
    const float invf = exp2f(-(float)f * (13.287712379549449f / 16.0f));
    for (int m = gw; m < NTOK; m += NGW) {
        float cs = 1.f, sn = 0.f;
        if (m < NLAT) { const float pos = (float)(axis == 0 ? (m >> 6) : (m & 63)); const float ang = pos * invf; cs = cosf(ang); sn = sinf(ang); }
        bf16_t* ur = U + (size_t)m * AIN + 2048;
        for (int h = 0; h < 10; ++h) {
            const float v = bf2f(ur[h * 64 + lane]);
            const float ss = wave_sum(v * v);
            float y = v * (1.0f / sqrtf(ss * (1.0f / 64.0f) + NORM_EPS)) * (h < 8 ? qg : kg);
            const float p = swap16_f(y);
            y = half == 0 ? y * cs - p * sn : y * cs + p * sn;
            if (h < 8) y *= C2;
            ur[h * 64 + lane] = (bf16_t)f2bf(y);
        }
    }
}

DEVFN void ph_hyprep(const Ctx& C, int i, bool do_ctx, unsigned char* lds) {
    const int tid = C.tid;
    const bf16_t* UHY = (const bf16_t*)(C.ws + WS_UHY);
    const float* taps = C.in[I_HSHORT] + (size_t)i * 3 * UHY_W;
    float* T = (float*)lds;
    const int ntile_lat = 3 * 8 * 256, ntile = ntile_lat + (do_ctx ? 3 * 8 * 4 : 0);
    for (int it = C.vcu; it < ntile; it += C.G) {
        const bool isctx = it >= ntile_lat; const int r = isctx ? it - ntile_lat : it;
        const int ntb = isctx ? 4 : 256; const int tb = r % ntb, cb = (r / ntb) & 7, g = r / (ntb * 8);
        const int seg0 = isctx ? NLAT : 0, segn = isctx ? NCTX : NLAT;
        {
            const int tl = tid >> 3, c8 = (tid & 7) * 8, t = 64 * tb + tl, col = g * 512 + 64 * cb + c8;
            float um[8], u0[8], up[8];
            unpack8(ld16(UHY + (size_t)(seg0 + t) * UHY_W + col), u0);
            if (t > 0) unpack8(ld16(UHY + (size_t)(seg0 + t - 1) * UHY_W + col), um); else UNR for (int e = 0; e < 8; ++e) um[e] = 0.f;
            if (t < segn - 1) unpack8(ld16(UHY + (size_t)(seg0 + t + 1) * UHY_W + col), up); else UNR for (int e = 0; e < 8; ++e) up[e] = 0.f;
            UNR for (int e = 0; e < 8; ++e) T[(c8 + e) * 65 + tl] = um[e] * taps[col + e] + u0[e] * taps[UHY_W + col + e] + up[e] * taps[2 * UHY_W + col + e];
        }
        SYNC();
        {
            const int cl = tid >> 3, t8 = (tid & 7) * 8, ch = 64 * cb + cl;
            float v[8]; UNR for (int e = 0; e < 8; ++e) v[e] = T[cl * 65 + t8 + e];
            if (!isctx) { bf16_t* VX = (bf16_t*)(C.ws + (g == 0 ? WS_VX0 : g == 1 ? WS_VX1 : WS_VX2)); st16(VX + (size_t)ch * NLAT + 64 * tb + t8, pack8(v)); }
            else { float* VXC = (float*)(C.ws + WS_VXC) + ((size_t)g * 512 + ch) * NCTX + 64 * tb + t8; UNR for (int e = 0; e < 8; ++e) VXC[e] = v[e]; }
        }
        SYNC();
    }
}

constexpr int FFT_N = 16384;
DEVFN int fidx(int n) { return n + (n >> 4); }
DEVFN F2 cmul(F2 a, F2 b) { F2 r; r.x = a.x * b.x - a.y * b.y; r.y = a.x * b.y + a.y * b.x; return r; }
DEVFN F2 cmulc(F2 a, F2 b) { F2 r; r.x = a.x * b.x + a.y * b.y; r.y = a.y * b.x - a.x * b.y; return r; }
DEVFN F2 cadd(F2 a, F2 b) { F2 r; r.x = a.x + b.x; r.y = a.y + b.y; return r; }
DEVFN F2 csub(F2 a, F2 b) { F2 r; r.x = a.x - b.x; r.y = a.y - b.y; return r; }
DEVFN F2 cconj(F2 a) { F2 r; r.x = a.x; r.y = -a.y; return r; }
template <bool INV> DEVFN F2 mul_mi(F2 a) { F2 r; if (!INV) { r.x = a.y; r.y = -a.x; } else { r.x = -a.y; r.y = a.x; } return r; }
template <bool INV> DEVFN void dft4(F2& a0, F2& a1, F2& a2, F2& a3) {
    const F2 s02 = cadd(a0, a2), d02 = csub(a0, a2), s13 = cadd(a1, a3), d13 = mul_mi<INV>(csub(a1, a3));
    a0 = cadd(s02, s13); a2 = csub(s02, s13); a1 = cadd(d02, d13); a3 = csub(d02, d13);
}
template <bool INV> DEVFN void dft16(F2* a) {
    UNR for (int n2 = 0; n2 < 4; ++n2) dft4<INV>(a[n2], a[4 + n2], a[8 + n2], a[12 + n2]);
    const float c1 = 0.92387953251128674f, s1 = 0.38268343236508977f, r2 = 0.70710678118654752f;
    const F2 w1 = {c1, INV ? s1 : -s1}, w2 = {r2, INV ? r2 : -r2}, w3 = {s1, INV ? c1 : -c1}, w6 = {-r2, INV ? r2 : -r2}, w9 = {-c1, INV ? -s1 : s1};
    a[4 * 1 + 1] = cmul(a[4 * 1 + 1], w1); a[4 * 1 + 2] = cmul(a[4 * 1 + 2], w2); a[4 * 1 + 3] = cmul(a[4 * 1 + 3], w3);
    a[4 * 2 + 1] = cmul(a[4 * 2 + 1], w2); a[4 * 2 + 2] = mul_mi<INV>(a[4 * 2 + 2]); a[4 * 2 + 3] = cmul(a[4 * 2 + 3], w6);
    a[4 * 3 + 1] = cmul(a[4 * 3 + 1], w3); a[4 * 3 + 2] = cmul(a[4 * 3 + 2], w6); a[4 * 3 + 3] = cmul(a[4 * 3 + 3], w9);
    F2 x[16];
    UNR for (int k1 = 0; k1 < 4; ++k1) { F2 b0 = a[4 * k1 + 0], b1 = a[4 * k1 + 1], b2 = a[4 * k1 + 2], b3 = a[4 * k1 + 3]; dft4<INV>(b0, b1, b2, b3); x[k1] = b0; x[k1 + 4] = b1; x[k1 + 8] = b2; x[k1 + 12] = b3; }
    UNR for (int q = 0; q < 16; ++q) a[q] = x[q];
}
template <int R, bool INV> DEVFN void fft_stage(F2* F, const F2* TW, int B, int tid) {
    const int S = B / R, NB = FFT_N / R, tws = 2 * (FFT_N / B);
    int tq = tid; OPAQUE(tq);
    UNR1 for (int q = tq; q < NB; q += NTHREADS) {
        const int blk = q / S, j = q - blk * S, base = blk * B + j;
        F2 a[R];
        UNR for (int m = 0; m < R; ++m) a[m] = F[fidx(base + m * S)];
        if (INV && S > 1) { const F2 w1 = TW[tws * j]; F2 w = w1; UNR for (int m = 1; m < R; ++m) { a[m] = cmulc(a[m], w); w = cmul(w, w1); } }
        if constexpr (R == 4) dft4<INV>(a[0], a[1], a[2], a[3]); else dft16<INV>(a);
        if (!INV && S > 1) { const F2 w1 = TW[tws * j]; F2 w = w1; UNR for (int m = 1; m < R; ++m) { a[m] = cmul(a[m], w); w = cmul(w, w1); } }
        UNR for (int m = 0; m < R; ++m) F[fidx(base + m * S)] = a[m];
    }
}
DEVFN void fft_fwd(F2* F, const F2* TW, int tid) {
    fft_stage<4, false>(F, TW, 16384, tid); SYNC(); fft_stage<16, false>(F, TW, 4096, tid); SYNC(); fft_stage<16, false>(F, TW, 256, tid); SYNC(); fft_stage<16, false>(F, TW, 16, tid); SYNC();
}
DEVFN void fft_inv(F2* F, const F2* TW, int tid) {
    fft_stage<16, true>(F, TW, 16, tid); SYNC(); fft_stage<16, true>(F, TW, 256, tid); SYNC(); fft_stage<16, true>(F, TW, 4096, tid); SYNC(); fft_stage<4, true>(F, TW, 16384, tid); SYNC();
}
DEVFN int fpos(int k) { return ((k & 3) << 12) | (((k >> 2) & 15) << 8) | (((k >> 6) & 15) << 4) | (k >> 10); }

DEVFN float block_sum(float v, float* red, int tid) {
    v = wave_sum(v);
    if ((tid & 63) == 0) red[tid >> 6] = v;
    SYNC();
    float s = 0.f; UNR for (int w = 0; w < NWAVES; ++w) s += red[w];
    SYNC();
    return s;
}

DEVFN void hyena_channel(const Ctx& C, int i, int c, unsigned char* lds) {
    const int tid = C.tid; constexpr int L = NLAT;
    F2* F = (F2*)lds; float* Ff = (float*)lds;
    float* W3C = (float*)(lds + 139264);
    float* red = W3C + 272;
    const F2* TW = (const F2*)(C.ws + WS_TW);
    const float* hid = (const float*)(C.ws + WS_HID) + (size_t)i * NLAT * 64;
    const float* w3 = C.in[I_HW3] + (size_t)i * 64 * 2048; const float* b3 = C.in[I_HB3] + (size_t)i * 2048;
    const bf16_t* VX0 = (const bf16_t*)(C.ws + WS_VX0) + (size_t)c * L;
    const bf16_t* VX1 = (const bf16_t*)(C.ws + WS_VX1) + (size_t)c * L;
    const bf16_t* VX2 = (const bf16_t*)(C.ws + WS_VX2) + (size_t)c * L;
    bf16_t* YHY = (bf16_t*)(C.ws + WS_YHY) + (size_t)c * L;
    const float skip0 = C.in[I_HSKIP][(size_t)i * 1024 + c], skip1 = C.in[I_HSKIP][(size_t)i * 1024 + 512 + c];
    const float delta = 15.350567286626973f + (float)c * ((3.0701134573253945f - 15.350567286626973f) / 511.0f);
    if (tid < 256) { const int o = tid >> 7, s = (tid >> 6) & 1, m = tid & 63; W3C[tid] = w3[(size_t)m * 2048 + (s * 2 + o) * 512 + c]; }
    if (tid < 4) W3C[256 + tid] = b3[((tid & 1) * 2 + (tid >> 1)) * 512 + c];
    SYNC();
    UNR1 for (int o = 0; o < 2; ++o) {
        float ssq = 0.f;
        {
            const int part = tid & 3, tsub = (tid & 63) >> 2, wv = tid >> 6;
            float wf[16], wb[16];
            UNR for (int m = 0; m < 16; ++m) { wf[m] = W3C[(o * 2 + 0) * 64 + 16 * part + m]; wb[m] = W3C[(o * 2 + 1) * 64 + 16 * part + m]; }
            const float bf_ = W3C[256 + o * 2 + 0], bb_ = W3C[256 + o * 2 + 1];
            UNR1 for (int ii = 0; ii < 128; ++ii) {
                const int t = (ii * 8 + wv) * 16 + tsub;
                const F4* hr = (const F4*)(hid + (size_t)t * 64 + 16 * part);
                float af = 0.f, ab = 0.f;
                UNR for (int m4 = 0; m4 < 4; ++m4) { const F4 h = hr[m4];
                    af += h.x * wf[4 * m4] + h.y * wf[4 * m4 + 1] + h.z * wf[4 * m4 + 2] + h.w * wf[4 * m4 + 3];
                    ab += h.x * wb[4 * m4] + h.y * wb[4 * m4 + 1] + h.z * wb[4 * m4 + 2] + h.w * wb[4 * m4 + 3]; }
                af = rowx_add<1>(af); af = rowx_add<2>(af); ab = rowx_add<1>(ab); ab = rowx_add<2>(ab);
                if (part == 0) {
                    const float win = expf(-((float)t / (float)(L - 1)) * delta);
                    af = (af + bf_) * win; ab = (ab + bb_) * win;
                    if (t == 0) { af += ab; ssq += af * af; Ff[0] = af; Ff[2 * fidx(L >> 1)] = 0.f; }
                    else { ssq += af * af + ab * ab; Ff[2 * fidx(t >> 1) + (t & 1)] = af; const int m = 2 * L - t; Ff[2 * fidx(m >> 1) + (m & 1)] = ab; }
                }
            }
        }
        const float knorm = 1.0f / sqrtf(block_sum(ssq, red, tid));
        fft_fwd(F, TW, tid);
        F2 kfa[16], kfb[16]; F2 kfh = {0.f, 0.f};
        int tq1 = tid; OPAQUE(tq1);
        UNR for (int ii = 0; ii < 16; ++ii) {
            const int k = tq1 + NTHREADS * ii;
            if (k == 0) { const F2 c0 = F[fidx(0)]; kfa[ii].x = (c0.x + c0.y) * knorm; kfa[ii].y = 0.f; kfb[ii].x = (c0.x - c0.y) * knorm; kfb[ii].y = 0.f;
                          const F2 ch = F[fidx(fpos(L / 2))]; kfh.x = ch.x * knorm; kfh.y = -ch.y * knorm; }
            else { const F2 ck = F[fidx(fpos(k))], cp = cconj(F[fidx(fpos(L - k))]);
                F2 e = cadd(ck, cp), od = csub(ck, cp); e.x *= 0.5f; e.y *= 0.5f; F2 oo; oo.x = 0.5f * od.y; oo.y = -0.5f * od.x;
                const F2 tt = cmul(TW[k], oo);
                kfa[ii] = cadd(e, tt); kfb[ii] = cconj(csub(e, tt)); kfa[ii].x *= knorm; kfa[ii].y *= knorm; kfb[ii].x *= knorm; kfb[ii].y *= knorm; }
            CFENCE();
        }
        SYNC();
        UNR for (int ii = 0; ii < 4; ++ii) {
            int tq3 = tid; OPAQUE(tq3); const int t0 = 8 * (tq3 + NTHREADS * ii); float v[8];
            unpack8(ld16((o == 0 ? VX0 : (const bf16_t*)YHY) + t0), v);
            float* d = Ff + 2 * fidx(t0 >> 1); UNR for (int e = 0; e < 8; ++e) d[e] = v[e];
            float* zz = Ff + 2 * fidx((L + t0) >> 1); UNR for (int e = 0; e < 8; ++e) zz[e] = 0.f;
        }
        SYNC();
        fft_fwd(F, TW, tid);
        int tq2 = tid; OPAQUE(tq2);
        UNR for (int ii = 0; ii < 16; ++ii) {
            const int k = tq2 + NTHREADS * ii;
            if (k == 0) { const F2 c0 = F[fidx(0)]; const float y0 = (c0.x + c0.y) * kfa[ii].x, yl = (c0.x - c0.y) * kfb[ii].x; F2 d; d.x = 0.5f * (y0 + yl); d.y = 0.5f * (y0 - yl); F[fidx(0)] = d;
                          const int ph = fidx(fpos(L / 2)); const F2 y = cmul(cconj(F[ph]), kfh); F[ph] = cconj(y); }
            else { const int pk = fidx(fpos(k)), pp = fidx(fpos(L - k)); const F2 ck = F[pk], cp = cconj(F[pp]);
                F2 e = cadd(ck, cp), od = csub(ck, cp); e.x *= 0.5f; e.y *= 0.5f; F2 oo; oo.x = 0.5f * od.y; oo.y = -0.5f * od.x;
                const F2 w = TW[k]; const F2 tt = cmul(w, oo);
                const F2 yk = cmul(cadd(e, tt), kfa[ii]), yp = cmul(cconj(csub(e, tt)), kfb[ii]);
                F2 ye = cadd(yk, cconj(yp)), yd = csub(yk, cconj(yp)); ye.x *= 0.5f; ye.y *= 0.5f; yd.x *= 0.5f; yd.y *= 0.5f;
                const F2 yo = cmulc(yd, w);
                F2 iyo; iyo.x = -yo.y; iyo.y = yo.x;
                F[pk] = cadd(ye, iyo); F[pp] = cconj(csub(ye, iyo)); }
            CFENCE();
        }
        SYNC();
        fft_inv(F, TW, tid);
        UNR for (int ii = 0; ii < 4; ++ii) {
            int tq4 = tid; OPAQUE(tq4); const int t0 = 8 * (tq4 + NTHREADS * ii); const float* d = Ff + 2 * fidx(t0 >> 1);
            float y[8]; UNR for (int e = 0; e < 8; ++e) y[e] = d[e] * (1.0f / (float)FFT_N);
            if (o == 0) { float v[8], x1[8], r[8]; unpack8(ld16(VX0 + t0), v); unpack8(ld16(VX1 + t0), x1); UNR for (int e = 0; e < 8; ++e) r[e] = x1[e] * (y[e] + v[e] * skip0); st16(YHY + t0, pack8(r)); }
            else { float x2[8], zp[8], r[8]; unpack8(ld16(VX2 + t0), x2); unpack8(ld16(YHY + t0), zp); UNR for (int e = 0; e < 8; ++e) r[e] = x2[e] * (y[e] + zp[e] * skip1); st16(YHY + t0, pack8(r)); }
        }
        SYNC();
    }
}

DEVFN void hyena_ctx_channel(const Ctx& C, int i, int c, unsigned char* lds) {
    const int tid = C.tid; constexpr int L = NCTX;
    float* KF = (float*)lds;
    float* Z = KF + 1024;
    float* red = Z + 256;
    float* W3C = red + 16;
    const float* hid = (const float*)(C.ws + WS_HID256);
    const float* w3 = C.in[I_HW3] + (size_t)i * 64 * 2048; const float* b3 = C.in[I_HB3] + (size_t)i * 2048;
    const float* VXC = (const float*)(C.ws + WS_VXC);
    const float delta = 15.350567286626973f + (float)c * ((3.0701134573253945f - 15.350567286626973f) / 511.0f);
    if (tid < 256) { const int o = tid >> 7, s = (tid >> 6) & 1, m = tid & 63; W3C[tid] = w3[(size_t)m * 2048 + (s * 2 + o) * 512 + c]; }
    if (tid < 4) W3C[256 + tid] = b3[((tid & 1) * 2 + (tid >> 1)) * 512 + c];
    SYNC();
    {
        const int o = tid >> 8, t = tid & 255;
        float af = W3C[256 + o * 2 + 0], ab = W3C[256 + o * 2 + 1];
        for (int m = 0; m < 64; ++m) { const float h = hid[t * 64 + m]; af += h * W3C[(o * 2 + 0) * 64 + m]; ab += h * W3C[(o * 2 + 1) * 64 + m]; }
        const float win = expf(-((float)t / (float)(L - 1)) * delta); af *= win; ab *= win;
        float ssq; if (t == 0) { af += ab; ab = 0.f; ssq = af * af; } else ssq = af * af + ab * ab;
        KF[(o * 2 + 0) * 256 + t] = af; KF[(o * 2 + 1) * 256 + t] = ab;
        ssq = wave_sum(ssq);
        if ((tid & 63) == 0) red[tid >> 6] = ssq;
        SYNC();
        const float tot = red[o * 4] + red[o * 4 + 1] + red[o * 4 + 2] + red[o * 4 + 3];
        const float kn = 1.0f / sqrtf(tot);
        KF[(o * 2 + 0) * 256 + t] = af * kn; KF[(o * 2 + 1) * 256 + t] = ab * kn;
    }
    float v = 0.f, x1 = 0.f, x2 = 0.f, z1 = 0.f;
    if (tid < 256) { v = VXC[((size_t)0 * 512 + c) * L + tid]; x1 = VXC[((size_t)1 * 512 + c) * L + tid]; x2 = VXC[((size_t)2 * 512 + c) * L + tid]; Z[tid] = v; }
    SYNC();
    for (int o = 0; o < 2; ++o) {
        float y = 0.f;
        if (tid < 256) { const int t = tid; const float* kf = KF + (o * 2) * 256; const float* kb = KF + (o * 2 + 1) * 256;
            for (int s = 0; s <= t; ++s) y += kf[t - s] * Z[s];
            for (int s = t + 1; s < L; ++s) y += kb[s - t] * Z[s]; }
        SYNC();
        if (tid < 256) { if (o == 0) { z1 = x1 * (y + v * C.in[I_HSKIP][(size_t)i * 1024 + c]); Z[tid] = z1; }
            else { const float r = x2 * (y + z1 * C.in[I_HSKIP][(size_t)i * 1024 + 512 + c]);
                const bf16_t* GHY = (const bf16_t*)(C.ws + WS_GHY); bf16_t* HO = (bf16_t*)(C.ws + WS_HYOUT);
                HO[(size_t)(NLAT + tid) * 512 + c] = (bf16_t)f2bf(r * bf2f(GHY[(size_t)(NLAT + tid) * 512 + c])); } }
        SYNC();
    }
}

typedef float P2 __attribute__((vector_size(8)));
#ifdef EMU
struct H8 { unsigned short v[8]; };
struct A4 { float v[4]; };
inline A4 mfma16(const H8& a, const H8& b, const A4& c) {
    static H8 sa_[emu::MAXB][8][64], sb_[emu::MAXB][8][64]; const int w = emu::t_tid >> 6, l = emu::t_tid & 63; H8 (*sa)[64] = sa_[emu::t_blk]; H8 (*sb)[64] = sb_[emu::t_blk];
    sa[w][l] = a; sb[w][l] = b; pthread_barrier_wait(&emu::g_wbar_[emu::t_blk][w]);
    A4 r = c;
    for (int reg = 0; reg < 4; ++reg) { const int row = 4 * (l >> 4) + reg, col = l & 15; float acc = 0.f;
        for (int k = 0; k < 32; ++k) acc += bf2f(sa[w][row + 16 * (k >> 3)].v[k & 7]) * bf2f(sb[w][col + 16 * (k >> 3)].v[k & 7]);
        r.v[reg] += acc; }
    pthread_barrier_wait(&emu::g_wbar_[emu::t_blk][w]);
    return r;
}
#define H8_SET(h, j, x) (h).v[j] = (unsigned short)(x)
#define A4_GET(a, j) (a).v[j]
#define MFMA_PAD(a,b,c,d,e,f,g,h)
#else
typedef short H8 __attribute__((ext_vector_type(8)));
typedef float A4 __attribute__((ext_vector_type(4)));
DEVFN A4 mfma16(const H8& a, const H8& b, const A4& c) { return __builtin_amdgcn_mfma_f32_16x16x32_bf16(a, b, c, 0, 0, 0); }
#define H8_SET(h, j, x) (h)[j] = (short)(x)
#define A4_GET(a, j) (a)[j]
#define MFMA_PAD(a,b,c,d,e,f,g,h) asm volatile("s_nop 15\n\ts_nop 15" : "+v"(a), "+v"(b), "+v"(c), "+v"(d), "+v"(e), "+v"(f), "+v"(g), "+v"(h))
#endif
#ifdef EMU
#define FEXP(x) expf(x)
#define FLOG(x) logf(x)
#define FRCP(x) (1.0f / (x))
#define FRSQ(x) (1.0f / sqrtf(x))
#define SETPRIO(n)
#else
#define FEXP(x) __expf(x)
#define FLOG(x) __logf(x)
#define FRCP(x) __builtin_amdgcn_rcpf(x)
#define FRSQ(x) __builtin_amdgcn_rsqf(x)
#define SETPRIO(n) __builtin_amdgcn_s_setprio(n)
#endif
DEVFN H8 h8_from_u4(U4 w) { H8 r; H8_SET(r, 0, w.x & 0xffff); H8_SET(r, 1, w.x >> 16); H8_SET(r, 2, w.y & 0xffff); H8_SET(r, 3, w.y >> 16); H8_SET(r, 4, w.z & 0xffff); H8_SET(r, 5, w.z >> 16); H8_SET(r, 6, w.w & 0xffff); H8_SET(r, 7, w.w >> 16); return r; }
constexpr int SC_T = 32;
constexpr int SC_R = 16;
constexpr int SC_BUF = 5 * SC_T * 64 + SC_T * SC_R;
DEVFN void rwkv_scan(const Ctx& C, int i, int h, int d, int rq, bool ctx_out, unsigned char* lds, int max_chunks) {
    const int tid = C.tid;
    float* sBUF = (float*)lds; float* sY = sBUF + 2 * SC_BUF; float* sWV = sY + 2 * SC_T * SC_R;
    const bf16_t* U = (const bf16_t*)(C.ws + WS_U);
    const float* mu = C.in[I_MU] + (size_t)i * 1664;
    const float* w0 = C.in[I_W0] + ((size_t)i * 2 + d) * 512 + 64 * h; const float* a0 = C.in[I_A0] + ((size_t)i * 2 + d) * 512 + 64 * h;
    const float* wup = C.in[I_WUP] + ((size_t)i * 2 + d) * 32 * 512 + 64 * h; const float* aup = C.in[I_AUP] + ((size_t)i * 2 + d) * 32 * 512 + 64 * h;
    const float* k_k = C.in[I_KK] + (size_t)i * 512 + 64 * h; const float* k_a = C.in[I_KA] + (size_t)i * 512 + 64 * h; const float* r_k = C.in[I_RK] + (size_t)i * 512 + 64 * h;
    bf16_t* Yd = (bf16_t*)(C.ws + (d == 0 ? WS_YF : WS_YB));
    float* BON = (float*)(C.ws + WS_BONUS) + (size_t)d * NTOK * 8;
    const bool is_scan = tid < 256;
    const int nchunks = NTOK / SC_T < max_chunks ? NTOK / SC_T : max_chunks;
    #define CHUNK_GEOM(ch, seg0, segn, R0) const bool isctx_ = (ch) < NCTX / SC_T; const int seg0 = isctx_ ? NLAT : 0, segn = isctx_ ? NCTX : NLAT; \
        const int cl_ = isctx_ ? (ch) : (ch) - NCTX / SC_T; const int R0 = d == 0 ? SC_T * cl_ : segn - SC_T * (cl_ + 1);
    const int ft = (tid & 255) >> 3, fp = tid & 7;
    float* sCN = sWV + 4 * 1280; float* sCN_base_ = sCN;
    if (tid < 64) { const int j = tid; sCN[j] = mu[64 * h + j]; sCN[64 + j] = mu[512 + 64 * h + j]; sCN[128 + j] = mu[1024 + 64 * h + j]; sCN[192 + j] = w0[j]; sCN[256 + j] = a0[j];
        sCN[320 + j] = k_k[j]; sCN[384 + j] = k_a[j]; sCN[448 + j] = r_k[j]; sCN[512 + j] = j < 32 ? mu[1536 + 32 * d + j] : mu[1600 + 32 * d + (j - 32)]; }
    U4* sBF = (U4*)(sCN_base_ + 640);
    { const int m = tid >> 8, nt = (tid >> 6) & 3, ln = tid & 63; const float* src = m == 0 ? wup : aup; float f[8];
      UNR for (int j = 0; j < 8; ++j) f[j] = src[(size_t)(8 * (ln >> 4) + j) * 512 + 16 * nt + (ln & 15)];
      sBF[tid] = pack8(f); }
    float* myWV = sWV + ((tid >> 6) & 3) * 1280; float* sWL = myWV; float* sAL = myWV + 512; bf16_t* sTDb = (bf16_t*)(myWV + 1024); bf16_t* sADb = sTDb + 256;
    const int rl = (tid & 255) >> 4, sp = tid & 15;
    float S0 = 0.f, S1 = 0.f, S2 = 0.f, S3 = 0.f;
    SYNC();
    U4 pu[9]; U2 pw[6];
    auto issue = [&](int ch) {
        int tq_ = tid; OPAQUE(tq_); const int ft = (tq_ & 255) >> 3, fp = tq_ & 7;
        CHUNK_GEOM(ch, seg0, segn, R0)
        const int tl = d == 0 ? R0 + ft : R0 + SC_T - 1 - ft;
        const bf16_t* u0p = U + (size_t)(seg0 + tl) * URW_W;
        const bool hm = tl > 0, hp = tl < segn - 1;
        const U4 z4 = {0u, 0u, 0u, 0u}; const U2 z2 = {0u, 0u};
        const int cw = 1536 + 32 * d + 4 * fp, ca = 1600 + 32 * d + 4 * fp;
        UNR for (int j = 0; j < 3; ++j) { pu[3 * j] = ld16(u0p + 512 * j + 64 * h + 8 * fp); pu[3 * j + 1] = z4; pu[3 * j + 2] = z4; }
        pw[0] = *(const U2*)(u0p + cw); pw[3] = *(const U2*)(u0p + ca); pw[1] = z2; pw[2] = z2; pw[4] = z2; pw[5] = z2;
        if (hm) { UNR for (int j = 0; j < 3; ++j) pu[3 * j + 1] = ld16(u0p - URW_W + 512 * j + 64 * h + 8 * fp); pw[1] = *(const U2*)(u0p - URW_W + cw); pw[4] = *(const U2*)(u0p - URW_W + ca); }
        if (hp) { UNR for (int j = 0; j < 3; ++j) pu[3 * j + 2] = ld16(u0p + URW_W + 512 * j + 64 * h + 8 * fp); pw[2] = *(const U2*)(u0p + URW_W + cw); pw[5] = *(const U2*)(u0p + URW_W + ca); }
    };
    auto features = [&](int ch) {
        int tq_ = tid; OPAQUE(tq_); const int ft = (tq_ & 255) >> 3, fp = tq_ & 7;
        const float* mu_r = sCN + 8 * fp; const float* mu_k = sCN + 64 + 8 * fp; const float* mu_v = sCN + 128 + 8 * fp; const float* c_w0 = sCN + 192 + 8 * fp; const float* c_a0 = sCN + 256 + 8 * fp;
        const float* c_kk = sCN + 320 + 8 * fp; const float* c_ka = sCN + 384 + 8 * fp; const float* c_rk = sCN + 448 + 8 * fp; const float* mu_w = sCN + 512 + 4 * fp; const float* mu_a = sCN + 544 + 4 * fp;
        CHUNK_GEOM(ch, seg0, segn, R0)
        float* B_ = sBUF + (ch & 1) * SC_BUF; float* sW = B_; float* sKD = B_ + SC_T * 64; float* sB = B_ + 2 * SC_T * 64; float* sKK = B_ + 3 * SC_T * 64; float* sR = B_ + 4 * SC_T * 64; float* sV = B_ + 5 * SC_T * 64;
        const int tl = d == 0 ? R0 + ft : R0 + SC_T - 1 - ft;
        float r[8], k[8], v[8];
        {
            float a[8], m[8], p[8];
            #define SHIFT3(J, MU, OUT) do { unpack8(pu[3 * (J)], a); unpack8(pu[3 * (J) + 1], m); unpack8(pu[3 * (J) + 2], p); \
                UNR for (int e = 0; e < 8; ++e) OUT[e] = a[e] + (0.5f * (m[e] + p[e]) - a[e]) * MU[e]; } while (0)
            SHIFT3(0, mu_r, r); SHIFT3(1, mu_k, k); SHIFT3(2, mu_v, v);
            #undef SHIFT3
        }
        {
            const U2 w0_ = pw[0], wm = pw[1], wp = pw[2], a0_ = pw[3], am = pw[4], ap = pw[5];
            const float wa[4] = {bflo(w0_.x), bfhi(w0_.x), bflo(w0_.y), bfhi(w0_.y)}, wmm[4] = {bflo(wm.x), bfhi(wm.x), bflo(wm.y), bfhi(wm.y)}, wpp[4] = {bflo(wp.x), bfhi(wp.x), bflo(wp.y), bfhi(wp.y)};
            const float aa[4] = {bflo(a0_.x), bfhi(a0_.x), bflo(a0_.y), bfhi(a0_.y)}, amm[4] = {bflo(am.x), bfhi(am.x), bflo(am.y), bfhi(am.y)}, app[4] = {bflo(ap.x), bfhi(ap.x), bflo(ap.y), bfhi(ap.y)};
            if (ch + 1 < nchunks) issue(ch + 1);
            const int tw = ft & 7;
            float tdv[4], adv[4];
            UNR for (int e = 0; e < 4; ++e) { const float x = wa[e] + (0.5f * (wmm[e] + wpp[e]) - wa[e]) * mu_w[e];
                tdv[e] = 1.0f - 2.0f * FRCP(1.0f + FEXP(2.0f * x));
                adv[e] = aa[e] + (0.5f * (amm[e] + app[e]) - aa[e]) * mu_a[e]; }
            U2 tq, aq; tq.x = pk2(tdv[0], tdv[1]); tq.y = pk2(tdv[2], tdv[3]); aq.x = pk2(adv[0], adv[1]); aq.y = pk2(adv[2], adv[3]);
            *(U2*)(sTDb + tw * 32 + 4 * fp) = tq; *(U2*)(sADb + tw * 32 + 4 * fp) = aq;
        }
        WAVE_SYNC();
        float wl[8], al[8];
        {
            const int lane = tid & 63, arow = lane & 7, kg = lane >> 4;
            const U4 ta = ld16(sTDb + arow * 32 + 8 * kg), aa_ = ld16(sADb + arow * 32 + 8 * kg);
            H8 At, Aa;
            H8_SET(At, 0, ta.x & 0xffff); H8_SET(At, 1, ta.x >> 16); H8_SET(At, 2, ta.y & 0xffff); H8_SET(At, 3, ta.y >> 16); H8_SET(At, 4, ta.z & 0xffff); H8_SET(At, 5, ta.z >> 16); H8_SET(At, 6, ta.w & 0xffff); H8_SET(At, 7, ta.w >> 16);
            H8_SET(Aa, 0, aa_.x & 0xffff); H8_SET(Aa, 1, aa_.x >> 16); H8_SET(Aa, 2, aa_.y & 0xffff); H8_SET(Aa, 3, aa_.y >> 16); H8_SET(Aa, 4, aa_.z & 0xffff); H8_SET(Aa, 5, aa_.z >> 16); H8_SET(Aa, 6, aa_.w & 0xffff); H8_SET(Aa, 7, aa_.w >> 16);
            A4 cw_[4], ca_[4];
            UNR for (int nt = 0; nt < 4; ++nt) {
                A4 z; A4_GET(z, 0) = 0.f; A4_GET(z, 1) = 0.f; A4_GET(z, 2) = 0.f; A4_GET(z, 3) = 0.f;
                cw_[nt] = mfma16(At, h8_from_u4(sBF[nt * 64 + (tid & 63)]), z); ca_[nt] = mfma16(Aa, h8_from_u4(sBF[(4 + nt) * 64 + (tid & 63)]), z);
            }
            MFMA_PAD(cw_[0], cw_[1], cw_[2], cw_[3], ca_[0], ca_[1], ca_[2], ca_[3]);
            if (lane < 32) { UNR for (int nt = 0; nt < 4; ++nt) UNR for (int rg = 0; rg < 4; ++rg) { const int tok = 4 * (lane >> 4) + rg; sWL[tok * 64 + 16 * nt + (lane & 15)] = A4_GET(cw_[nt], rg); sAL[tok * 64 + 16 * nt + (lane & 15)] = A4_GET(ca_[nt], rg); } }
            WAVE_SYNC();
            const int tw = ft & 7;
            { const F4 w0_ = *(const F4*)(sWL + tw * 64 + 8 * fp), w1_ = *(const F4*)(sWL + tw * 64 + 8 * fp + 4), a0_ = *(const F4*)(sAL + tw * 64 + 8 * fp), a1_ = *(const F4*)(sAL + tw * 64 + 8 * fp + 4);
              const F4 cw0 = *(const F4*)(c_w0), cw1 = *(const F4*)(c_w0 + 4), ca0 = *(const F4*)(c_a0), ca1 = *(const F4*)(c_a0 + 4);
              wl[0] = cw0.x + w0_.x; wl[1] = cw0.y + w0_.y; wl[2] = cw0.z + w0_.z; wl[3] = cw0.w + w0_.w; wl[4] = cw1.x + w1_.x; wl[5] = cw1.y + w1_.y; wl[6] = cw1.z + w1_.z; wl[7] = cw1.w + w1_.w;
              al[0] = ca0.x + a0_.x; al[1] = ca0.y + a0_.y; al[2] = ca0.z + a0_.z; al[3] = ca0.w + a0_.w; al[4] = ca1.x + a1_.x; al[5] = ca1.y + a1_.y; al[6] = ca1.z + a1_.z; al[7] = ca1.w + a1_.w; }
            WAVE_SYNC();
        }
        float kkv[8], ssq = 0.f;
        UNR for (int e = 0; e < 8; ++e) { kkv[e] = k[e] * c_kk[e]; ssq += kkv[e] * kkv[e]; }
        ssq = rowx_add<1>(ssq); ssq = rowx_add<2>(ssq); ssq = rowx_add<7>(ssq);
        const float kn = FRSQ(ssq + 1e-12f);
        float bon = 0.f; float o_w[8], o_kd[8], o_b[8], o_kk[8];
        UNR for (int e = 0; e < 8; ++e) {
            const float dec = FEXP(-0.60653066f * FRCP(1.0f + FEXP(-wl[e])));
            const float a = FRCP(1.0f + FEXP(-al[e]));
            const float kd = k[e] * (1.0f + (a - 1.0f) * c_ka[e]);
            const float kk = kkv[e] * kn;
            o_w[e] = dec; o_kd[e] = kd; o_b[e] = kk * a; o_kk[e] = kk;
            bon += r[e] * kd * c_rk[e];
        }
        { const int o = ft * 64 + 8 * fp;
          #define ST8(P, A) do { F4 x0_, x1_; x0_.x = A[0]; x0_.y = A[1]; x0_.z = A[2]; x0_.w = A[3]; x1_.x = A[4]; x1_.y = A[5]; x1_.z = A[6]; x1_.w = A[7]; *(F4*)((P) + o) = x0_; *(F4*)((P) + o + 4) = x1_; } while (0)
          ST8(sW, o_w); ST8(sKD, o_kd); ST8(sB, o_b); ST8(sKK, o_kk); ST8(sR, r);
          #undef ST8
        }
        if ((fp >> 1) == rq) { UNR for (int e = 0; e < 8; ++e) sV[ft * SC_R + 8 * (fp & 1) + e] = v[e]; }
        bon = rowx_add<1>(bon); bon = rowx_add<2>(bon); bon = rowx_add<7>(bon);
        if (fp == 0 && rq == 0) BON[(size_t)(seg0 + tl) * 8 + h] = 0.5f * bon;
    };
    auto store_y = [&](int ch) {
        CHUNK_GEOM(ch, seg0, segn, R0)
        if (isctx_ && !ctx_out) return;
        const float* Yb = sY + (ch & 1) * SC_T * SC_R;
        const int k = (tid & 255) >> 3, q = (tid & 7) * 2; const int tl = d == 0 ? R0 + k : R0 + SC_T - 1 - k;
        *(unsigned*)(Yd + (size_t)(seg0 + tl) * 512 + 64 * h + SC_R * rq + q) = pk2(Yb[k * SC_R + q], Yb[k * SC_R + q + 1]);
    };
    if (!is_scan) { issue(0); features(0); }
    SYNC();
    if (C.wave < 4) SETPRIO(3);
    TACC_DECL;
    for (int ch = 0; ch < nchunks; ++ch) {
        TACC_BEGIN;
        if (is_scan) {
            const float* B_ = sBUF + (ch & 1) * SC_BUF; const float* sW = B_; const float* sKD = B_ + SC_T * 64; const float* sB = B_ + 2 * SC_T * 64; const float* sKK = B_ + 3 * SC_T * 64; const float* sR = B_ + 4 * SC_T * 64; const float* sV = B_ + 5 * SC_T * 64;
            float* Yb = sY + (ch & 1) * SC_T * SC_R;
            float yk0 = 0.f, yk1 = 0.f, yp = 0.f;
#ifndef EMU
            {
                const unsigned ab = (unsigned)(uintptr_t)B_ + 16u * (unsigned)sp, av = (unsigned)(uintptr_t)sV + 4u * (unsigned)rl;
                P2 s01 = {S0, S1}, s23 = {S2, S3};
                asm volatile(SCAN_CHUNK_ASM : [s01] "+v"(s01), [s23] "+v"(s23), [yp] "+v"(yp), [yk0] "+v"(yk0), [yk1] "+v"(yk1) : [ab] "v"(ab), [av] "v"(av), [sp] "v"(sp) : SCAN_CHUNK_CLOBBERS);
                S0 = s01[0]; S1 = s01[1]; S2 = s23[0]; S3 = s23[1];
            }
#else
            for (int k = 0; k < SC_T; ++k) {
                const F4 kk4 = *(const F4*)(sKK + k * 64 + 4 * sp), w4 = *(const F4*)(sW + k * 64 + 4 * sp), b4 = *(const F4*)(sB + k * 64 + 4 * sp),
                         kd4 = *(const F4*)(sKD + k * 64 + 4 * sp), r4 = *(const F4*)(sR + k * 64 + 4 * sp);
                const float vi = sV[k * SC_R + rl];
                float sa = (S0 * kk4.x + S2 * kk4.z) + (S1 * kk4.y + S3 * kk4.w);
                const float t0 = S0 * w4.x + vi * kd4.x, t1 = S1 * w4.y + vi * kd4.y, t2 = S2 * w4.z + vi * kd4.z, t3 = S3 * w4.w + vi * kd4.w;
                sa = rowx_add<1>(sa); yp = rowx_add<1>(yp); sa = rowx_add<2>(sa); yp = rowx_add<2>(yp);
                sa = rowx_add<7>(sa); yp = rowx_add<7>(yp); sa = rowx_add<15>(sa); yp = rowx_add<15>(yp);
                if (sp == ((k + 15) & 15)) { if (k <= 16) yk0 = yp; else yk1 = yp; }
                S0 = t0 - sa * b4.x; S1 = t1 - sa * b4.y; S2 = t2 - sa * b4.z; S3 = t3 - sa * b4.w;
                yp = (S0 * r4.x + S2 * r4.z) + (S1 * r4.y + S3 * r4.w);
            }
#endif
            yp = rowx_add<1>(yp); yp = rowx_add<2>(yp); yp = rowx_add<7>(yp); yp = rowx_add<15>(yp);
            if (sp == 15) yk1 = yp;
            Yb[sp * SC_R + rl] = yk0; Yb[(sp + 16) * SC_R + rl] = yk1;
        } else {
            if (ch + 1 < nchunks) features(ch + 1);
            if (ch > 0) store_y(ch - 1);
        }
        TACC_END;
        SYNC();
    }
    TACC_STORE(C, is_scan ? 45 : 46, C.vcu == 0 && (tid == 0 || tid == 256));
    if (C.wave < 4) SETPRIO(0);
    if (!is_scan) store_y(nchunks - 1);
    #undef CHUNK_GEOM
}

DEVFN void ph_readout_hyout(const Ctx& C, int i, bool do_ctx, unsigned char* lds) {
    const int tid = C.tid;
    {
        const bf16_t* U = (const bf16_t*)(C.ws + WS_U); bf16_t* YF = (bf16_t*)(C.ws + WS_YF); const bf16_t* YB = (const bf16_t*)(C.ws + WS_YB);
        const float* BON = (const float*)(C.ws + WS_BONUS);
        const float* mu = C.in[I_MU] + (size_t)i * 1664 + 1024; const float* gnw = C.in[I_GNW] + (size_t)i * 512; const float* gnb = C.in[I_GNB] + (size_t)i * 512;
        const int rl = tid >> 6, c8 = (tid & 63) * 8, h = (tid & 63) >> 3;
        float muv[8], gw_[8], gb_[8];
        UNR for (int e = 0; e < 8; ++e) { muv[e] = mu[c8 + e]; gw_[e] = gnw[c8 + e]; gb_[e] = gnb[c8 + e]; }
        const int nrows = do_ctx ? NTOK : NLAT;
        for (int r0 = C.vcu * 8; r0 < nrows; r0 += C.G * 8) {
            const int row = r0 + rl; const bool isctx = row >= NLAT; const int seg0 = isctx ? NLAT : 0, segn = isctx ? NCTX : NLAT, tl = row - seg0;
            float yf[8], yb[8], y[8], a[8], m[8], p[8], g[8];
            unpack8(ld16(YF + (size_t)row * 512 + c8), yf); unpack8(ld16(YB + (size_t)row * 512 + c8), yb);
            float s = 0.f; UNR for (int e = 0; e < 8; ++e) { y[e] = yf[e] + yb[e]; s += y[e]; }
            s = rowx_add<1>(s); s = rowx_add<2>(s); s = rowx_add<7>(s);
            const float mean = s * (1.0f / 64.0f); float q = 0.f;
            UNR for (int e = 0; e < 8; ++e) { y[e] -= mean; q += y[e] * y[e]; }
            q = rowx_add<1>(q); q = rowx_add<2>(q); q = rowx_add<7>(q);
            const float rstd = 1.0f / sqrtf(q * (1.0f / 64.0f) + 64e-5f);
            const bf16_t* up = U + (size_t)row * URW_W + 1024 + c8;
            unpack8(ld16(up), a);
            if (tl > 0) unpack8(ld16(up - URW_W), m); else UNR for (int e = 0; e < 8; ++e) m[e] = 0.f;
            if (tl < segn - 1) unpack8(ld16(up + URW_W), p); else UNR for (int e = 0; e < 8; ++e) p[e] = 0.f;
            unpack8(ld16(U + (size_t)row * URW_W + 1664 + c8), g);
            const float bon = BON[(size_t)row * 8 + h] + BON[(size_t)NTOK * 8 + (size_t)row * 8 + h];
            float o[8];
            UNR for (int e = 0; e < 8; ++e) { const float v = a[e] + (0.5f * (m[e] + p[e]) - a[e]) * muv[e]; o[e] = (y[e] * rstd * gw_[e] + gb_[e] + bon * v) * g[e]; }
            st16(YF + (size_t)row * 512 + c8, pack8(o));
        }
    }
    {
        const bf16_t* YHY = (const bf16_t*)(C.ws + WS_YHY); const bf16_t* GHY = (const bf16_t*)(C.ws + WS_GHY); bf16_t* HO = (bf16_t*)(C.ws + WS_HYOUT);
        float* T = (float*)lds;
        for (int it = C.vcu; it < 256 * 8; it += C.G) {
            const int tb = it >> 3, cb = it & 7;
            { const int cl = tid >> 3, t8 = (tid & 7) * 8; float v[8]; unpack8(ld16(YHY + (size_t)(64 * cb + cl) * NLAT + 64 * tb + t8), v); UNR for (int e = 0; e < 8; ++e) T[cl * 65 + t8 + e] = v[e]; }
            SYNC();
            { const int tl = tid >> 3, c8 = (tid & 7) * 8; float g[8], o[8]; const size_t off = (size_t)(64 * tb + tl) * 512 + 64 * cb + c8;
              unpack8(ld16(GHY + off), g); UNR for (int e = 0; e < 8; ++e) o[e] = T[(c8 + e) * 65 + tl] * g[e]; st16(HO + off, pack8(o)); }
            SYNC();
        }
    }
}

constexpr int RC_T = 16, RC_RING = 7, RC_NPROD = 6;
constexpr int RS_KKD = 0, RS_RD = 2048, RS_KIT = 4096, RS_NBIT = 6144, RS_VT = 8192, RS_T = 9216, RS_P0 = 9728, RS_Q1 = 10240, RS_NQ2 = 10752, RS_GC = 11264, RS_BYTES = 11520;
constexpr int RW_TDAD = 0, RW_WL = 2048, RW_AL = 6144, RW_KIP = 2048, RW_BIP = 4096, RW_AM = 10240, RW_BYTES = 11264;
constexpr int RC_LDS_RING = 0, RC_LDS_WAVE = RC_RING * RS_BYTES, RC_LDS_BFR = RC_LDS_WAVE + RC_NPROD * RW_BYTES, RC_LDS_FLAGS = RC_LDS_BFR + 8192, RC_LDS_END = RC_LDS_FLAGS + 3 * 8 * 4;
static_assert(RC_LDS_END <= RING_BYTES, "rwkv chunked LDS");
#ifdef EMU
#include <sched.h>
#define SPIN_WAIT(cond) do { while (!(cond)) sched_yield(); __sync_synchronize(); } while (0)
#define LDS_FENCE() __sync_synchronize()
#else
#define SPIN_WAIT(cond) do { while (!(cond)) __builtin_amdgcn_s_sleep(1); asm volatile("" ::: "memory"); } while (0)
#define LDS_FENCE() asm volatile("s_waitcnt lgkmcnt(0)" ::: "memory")
#endif
#ifdef EMU
DEVFN float wave_sum_fast(float v) { v = rowx_add<1>(v); v = rowx_add<2>(v); v = rowx_add<7>(v); v = rowx_add<15>(v); return (shfl_f(v, 0) + shfl_f(v, 16)) + (shfl_f(v, 32) + shfl_f(v, 48)); }
#else
DEVFN float wave_sum_fast(float v) { v = rowx_add<1>(v); v = rowx_add<2>(v); v = rowx_add<7>(v); v = rowx_add<15>(v);
    const int i_ = __builtin_bit_cast(int, v);
    return (__builtin_bit_cast(float, __builtin_amdgcn_readlane(i_, 0)) + __builtin_bit_cast(float, __builtin_amdgcn_readlane(i_, 16))) + (__builtin_bit_cast(float, __builtin_amdgcn_readlane(i_, 32)) + __builtin_bit_cast(float, __builtin_amdgcn_readlane(i_, 48))); }
#endif
DEVFN int rc_pos(int k) { return (k & 32) | (((k >> 2) & 3) << 3) | (((k >> 4) & 1) << 2) | (k & 3); }
DEVFN H8 h8_from(U4 w) { H8 r; H8_SET(r, 0, w.x & 0xffff); H8_SET(r, 1, w.x >> 16); H8_SET(r, 2, w.y & 0xffff); H8_SET(r, 3, w.y >> 16); H8_SET(r, 4, w.z & 0xffff); H8_SET(r, 5, w.z >> 16); H8_SET(r, 6, w.w & 0xffff); H8_SET(r, 7, w.w >> 16); return r; }
DEVFN H8 h8_lo4(U2 w) { H8 r; H8_SET(r, 0, w.x & 0xffff); H8_SET(r, 1, w.x >> 16); H8_SET(r, 2, w.y & 0xffff); H8_SET(r, 3, w.y >> 16); H8_SET(r, 4, 0); H8_SET(r, 5, 0); H8_SET(r, 6, 0); H8_SET(r, 7, 0); return r; }
DEVFN H8 h8_zero() { H8 r; UNR for (int j = 0; j < 8; ++j) H8_SET(r, j, 0); return r; }
DEVFN H8 h8_pack2(const A4& a, const A4& b) { H8 r; UNR for (int j = 0; j < 4; ++j) { H8_SET(r, j, f2bf(A4_GET(a, j))); H8_SET(r, 4 + j, f2bf(A4_GET(b, j))); } return r; }
DEVFN H8 h8_pack1(const A4& a) { H8 r; UNR for (int j = 0; j < 4; ++j) { H8_SET(r, j, f2bf(A4_GET(a, j))); H8_SET(r, 4 + j, 0); } return r; }
DEVFN A4 a4_zero() { A4 z; A4_GET(z, 0) = 0.f; A4_GET(z, 1) = 0.f; A4_GET(z, 2) = 0.f; A4_GET(z, 3) = 0.f; return z; }

DEVFN void rwkv_chunked(const Ctx& C, int i, int h, int d, int vh, bool ctx_out, unsigned char* lds, int max_chunks) {
    const int tid = C.tid, lane = tid & 63, wave = tid >> 6;
    volatile unsigned* fl_ready = (volatile unsigned*)(lds + RC_LDS_FLAGS); volatile unsigned* fl_done0 = fl_ready + 8; volatile unsigned* fl_done1 = fl_done0 + 8;
    if (tid < 24) fl_ready[tid] = 0u;
    { U4* sBF = (U4*)(lds + RC_LDS_BFR); const int m = tid >> 8, nt = (tid >> 6) & 3, ln = tid & 63;
      const float* src = (m == 0 ? C.in[I_WUP] : C.in[I_AUP]) + ((size_t)i * 2 + d) * 32 * 512 + 64 * h; float f[8];
      UNR for (int j = 0; j < 8; ++j) f[j] = src[(size_t)(8 * (ln >> 4) + j) * 512 + 16 * nt + (ln & 15)];
      sBF[tid] = pack8(f); }
    SYNC();
    const int nchunks = (NTOK / RC_T) < max_chunks ? (NTOK / RC_T) : max_chunks;
    bf16_t* Yd = (bf16_t*)(C.ws + (d == 0 ? WS_YF : WS_YB));
    #define RC_GEOM(ch, seg0, segn, R0) const bool isctx_ = (ch) < NCTX / RC_T; const int seg0 = isctx_ ? NLAT : 0, segn = isctx_ ? NCTX : NLAT; \
        const int cl_ = isctx_ ? (ch) : (ch) - NCTX / RC_T; const int R0 = d == 0 ? RC_T * cl_ : segn - RC_T * (cl_ + 1);
    if (wave < 2) {
        const int vt = wave, kg = lane >> 4, l15 = lane & 15;
        A4 H0_ = a4_zero(), H1_ = a4_zero(), H2_ = a4_zero(), H3_ = a4_zero();
        for (int ch = 0; ch < nchunks; ++ch) {
            const int slot = ch % RC_RING; const unsigned char* rb = lds + RC_LDS_RING + slot * RS_BYTES;
            SPIN_WAIT(fl_ready[slot] == (unsigned)(ch + 1));
            const H8 Hb0 = h8_pack2(H0_, H1_), Hb1 = h8_pack2(H2_, H3_);
            const H8 Vb = kg < 2 ? h8_from(ld16(rb + RS_VT + ((16 * vt + l15) * 16 + 8 * kg) * 2)) : h8_zero();
            const H8 kkd0 = h8_from(ld16(rb + RS_KKD + (l15 * 64 + 8 * kg) * 2)), kkd1 = h8_from(ld16(rb + RS_KKD + (l15 * 64 + 32 + 8 * kg) * 2));
            const H8 rd0 = h8_from(ld16(rb + RS_RD + (l15 * 64 + 8 * kg) * 2)), rd1 = h8_from(ld16(rb + RS_RD + (l15 * 64 + 32 + 8 * kg) * 2));
            const H8 p0f = kg < 2 ? h8_from(ld16(rb + RS_P0 + (l15 * 16 + 8 * kg) * 2)) : h8_zero();
            const H8 q1f = kg < 2 ? h8_from(ld16(rb + RS_Q1 + (l15 * 16 + 8 * kg) * 2)) : h8_zero();
            const H8 tf = h8_lo4(*(const U2*)(rb + RS_T + (l15 * 16 + 4 * kg) * 2)), nq2f = h8_lo4(*(const U2*)(rb + RS_NQ2 + (l15 * 16 + 4 * kg) * 2));
            A4 X = mfma16(kkd0, Hb0, a4_zero()); X = mfma16(kkd1, Hb1, X); X = mfma16(p0f, Vb, X);
            A4 Y = mfma16(rd0, Hb0, a4_zero()); Y = mfma16(rd1, Hb1, Y); Y = mfma16(q1f, Vb, Y);
            const H8 Xb = h8_pack1(X);
            const A4 U_ = mfma16(tf, Xb, a4_zero());
            const H8 Ub = h8_pack1(U_);
            Y = mfma16(nq2f, Ub, Y);
            #define HUPD(Hx, kt) do { const int kr = 16 * (kt) + l15; \
                const H8 kif = kg < 2 ? h8_from(ld16(rb + RS_KIT + (kr * 16 + 8 * kg) * 2)) : h8_zero(); const H8 nbf = h8_lo4(*(const U2*)(rb + RS_NBIT + (kr * 16 + 4 * kg) * 2)); \
                Hx = mfma16(kif, Vb, Hx); Hx = mfma16(nbf, Ub, Hx); const F4 g = *(const F4*)(rb + RS_GC + (16 * (kt) + 4 * kg) * 4); \
                A4_GET(Hx, 0) *= g.x; A4_GET(Hx, 1) *= g.y; A4_GET(Hx, 2) *= g.z; A4_GET(Hx, 3) *= g.w; } while (0)
            HUPD(H0_, 0); HUPD(H1_, 1); HUPD(H2_, 2); HUPD(H3_, 3);
            #undef HUPD
            LDS_FENCE(); WAVE_SYNC();
            if (lane == 0) { if (vt == 0) fl_done0[slot] = (unsigned)(ch + 1); else fl_done1[slot] = (unsigned)(ch + 1); }
            { RC_GEOM(ch, seg0, segn, R0)
              if (!isctx_ || ctx_out) { UNR for (int rg = 0; rg < 4; ++rg) { const int t = 4 * kg + rg, tl = d == 0 ? R0 + t : R0 + RC_T - 1 - t;
                  Yd[(size_t)(seg0 + tl) * 512 + 64 * h + 32 * vh + 16 * vt + l15] = (bf16_t)f2bf(A4_GET(Y, rg)); } } }
        }
    } else {
        const int p = wave - 2, k = lane;
        unsigned char* wsb = lds + RC_LDS_WAVE + p * RW_BYTES;
        bf16_t* sTDAD = (bf16_t*)(wsb + RW_TDAD); float* sWL = (float*)(wsb + RW_WL); float* sAL = (float*)(wsb + RW_AL); bf16_t* sKIP = (bf16_t*)(wsb + RW_KIP); bf16_t* sBIP = (bf16_t*)(wsb + RW_BIP); float* sAM = (float*)(wsb + RW_AM);
        const bf16_t* U = (const bf16_t*)(C.ws + WS_U);
        const float* mu = C.in[I_MU] + (size_t)i * 1664;
        const float mu_r = mu[64 * h + k], mu_k = mu[512 + 64 * h + k], mu_v = mu[1024 + 64 * h + k], mu_l = k < 32 ? mu[1536 + 32 * d + k] : mu[1600 + 32 * d + (k - 32)];
        const float c_w0 = C.in[I_W0][((size_t)i * 2 + d) * 512 + 64 * h + k], c_a0 = C.in[I_A0][((size_t)i * 2 + d) * 512 + 64 * h + k];
        const float c_kk = C.in[I_KK][(size_t)i * 512 + 64 * h + k], c_ka = C.in[I_KA][(size_t)i * 512 + 64 * h + k], c_rk = C.in[I_RK][(size_t)i * 512 + 64 * h + k];
        float* BON = (float*)(C.ws + WS_BONUS) + (size_t)d * NTOK * 8;
        const U4* sBF = (const U4*)(lds + RC_LDS_BFR);
        const int lcol = k < 32 ? 1536 + 32 * d + k : 1600 + 32 * d + (k - 32);
        const int kg = lane >> 4, l15 = lane & 15, pk_ = rc_pos(k);
        for (int ch = p; ch < nchunks; ch += RC_NPROD) {
            RC_GEOM(ch, seg0, segn, R0)
            float ur[18], uk[18], uv[18], ul[18];
            UNR for (int j = 0; j < 18; ++j) { const int row = d == 0 ? R0 - 1 + j : R0 + 16 - j; const bool ok = row >= 0 && row < segn; const bf16_t* up = U + (size_t)(seg0 + (ok ? row : R0)) * URW_W;
                const float m_ = ok ? 1.f : 0.f; ur[j] = m_ * bf2f(up[64 * h + k]); uk[j] = m_ * bf2f(up[512 + 64 * h + k]); uv[j] = m_ * bf2f(up[1024 + 64 * h + k]); ul[j] = m_ * bf2f(up[lcol]); }
            UNR for (int t = 0; t < 16; ++t) { const int j = t + 1; const float x = ul[j] + (0.5f * (ul[j - 1] + ul[j + 1]) - ul[j]) * mu_l;
                const float val = k < 32 ? 1.0f - 2.0f * FRCP(1.0f + FEXP(2.0f * x)) : x; sTDAD[t * 64 + k] = (bf16_t)f2bf(val); }
            WAVE_SYNC();
            {
                const H8 At = h8_from(ld16(sTDAD + l15 * 64 + 8 * kg)), Aa = h8_from(ld16(sTDAD + l15 * 64 + 32 + 8 * kg));
                A4 cw_[4], ca_[4];
                UNR for (int nt = 0; nt < 4; ++nt) { cw_[nt] = mfma16(At, h8_from(sBF[nt * 64 + lane]), a4_zero()); ca_[nt] = mfma16(Aa, h8_from(sBF[(4 + nt) * 64 + lane]), a4_zero()); }
                MFMA_PAD(cw_[0], cw_[1], cw_[2], cw_[3], ca_[0], ca_[1], ca_[2], ca_[3]);
                UNR for (int nt = 0; nt < 4; ++nt) UNR for (int rg = 0; rg < 4; ++rg) { sWL[(4 * kg + rg) * 64 + 16 * nt + l15] = A4_GET(cw_[nt], rg); sAL[(4 * kg + rg) * 64 + 16 * nt + l15] = A4_GET(ca_[nt], rg); }
            }
            WAVE_SYNC();
            float fr[16], fkd[16], fb[16], fkk[16], flw[16], fv[16];
            UNR for (int t = 0; t < 16; ++t) { const int j = t + 1;
                const float r_ = ur[j] + (0.5f * (ur[j - 1] + ur[j + 1]) - ur[j]) * mu_r, k_ = uk[j] + (0.5f * (uk[j - 1] + uk[j + 1]) - uk[j]) * mu_k, v_ = uv[j] + (0.5f * (uv[j - 1] + uv[j + 1]) - uv[j]) * mu_v;
                const float kkraw = k_ * c_kk; const float ss = wave_sum_fast(kkraw * kkraw); const float kk_ = kkraw * FRSQ(ss + 1e-12f);
                const float x = -(c_w0 + sWL[t * 64 + k]); const float sp_ = fmaxf(x, 0.f) + FLOG(1.0f + FEXP(-fabsf(x)));
                const float lw_ = -FEXP(-sp_ - 0.5f);
                const float a = FRCP(1.0f + FEXP(-(c_a0 + sAL[t * 64 + k])));
                const float kd_ = k_ * (1.0f + (a - 1.0f) * c_ka);
                fr[t] = r_; fkd[t] = kd_; fb[t] = kk_ * a; fkk[t] = kk_; flw[t] = lw_; fv[t] = v_;
                const float bon = wave_sum_fast(r_ * kd_ * c_rk);
                if (vh == 0 && lane == 0) { const int tl = d == 0 ? R0 + t : R0 + RC_T - 1 - t; BON[(size_t)(seg0 + tl) * 8 + h] = 0.5f * bon; }
            }
            WAVE_SYNC();
            const int slot = ch % RC_RING; unsigned char* rb = lds + RC_LDS_RING + slot * RS_BYTES;
            if (ch >= RC_RING) SPIN_WAIT(fl_done0[slot] == (unsigned)(ch - RC_RING + 1) && fl_done1[slot] == (unsigned)(ch - RC_RING + 1));
            {
                bf16_t* rKKD = (bf16_t*)(rb + RS_KKD); bf16_t* rRD = (bf16_t*)(rb + RS_RD); bf16_t* rKIT = (bf16_t*)(rb + RS_KIT); bf16_t* rNBIT = (bf16_t*)(rb + RS_NBIT); bf16_t* rVT = (bf16_t*)(rb + RS_VT);
                float L = 0.f, e_prev = 1.f;
                UNR for (int t = 0; t < 16; ++t) { L += flw[t]; const float e = FEXP(L), ei = FEXP(-L);
                    rKKD[t * 64 + pk_] = (bf16_t)f2bf(fkk[t] * e_prev); rRD[t * 64 + pk_] = (bf16_t)f2bf(fr[t] * e);
                    const float ki_ = fkd[t] * ei, bi_ = fb[t] * ei; sKIP[t * 64 + pk_] = (bf16_t)f2bf(ki_); sBIP[t * 64 + pk_] = (bf16_t)f2bf(bi_);
                    rKIT[k * 16 + t] = (bf16_t)f2bf(ki_); rNBIT[k * 16 + t] = (bf16_t)f2bf(-bi_);
                    e_prev = e; }
                ((float*)(rb + RS_GC))[k] = e_prev;
                U4 w0_, w1_;
                if ((k >> 5) == vh) { w0_.x = pk2(fv[0], fv[1]); w0_.y = pk2(fv[2], fv[3]); w0_.z = pk2(fv[4], fv[5]); w0_.w = pk2(fv[6], fv[7]); w1_.x = pk2(fv[8], fv[9]); w1_.y = pk2(fv[10], fv[11]); w1_.z = pk2(fv[12], fv[13]); w1_.w = pk2(fv[14], fv[15]);
                    st16(rVT + (k & 31) * 16, w0_); st16(rVT + (k & 31) * 16 + 8, w1_); }
            }
            WAVE_SYNC();
            {
                const bf16_t* rKKD = (const bf16_t*)(rb + RS_KKD); const bf16_t* rRD = (const bf16_t*)(rb + RS_RD);
                const H8 ak0 = h8_from(ld16(rKKD + l15 * 64 + 8 * kg)), ak1 = h8_from(ld16(rKKD + l15 * 64 + 32 + 8 * kg)), ar0 = h8_from(ld16(rRD + l15 * 64 + 8 * kg)), ar1 = h8_from(ld16(rRD + l15 * 64 + 32 + 8 * kg));
                const H8 bb0 = h8_from(ld16(sBIP + l15 * 64 + 8 * kg)), bb1 = h8_from(ld16(sBIP + l15 * 64 + 32 + 8 * kg)), bk0 = h8_from(ld16(sKIP + l15 * 64 + 8 * kg)), bk1 = h8_from(ld16(sKIP + l15 * 64 + 32 + 8 * kg));
                A4 mA = mfma16(ak0, bb0, a4_zero()); mA = mfma16(ak1, bb1, mA);
                A4 mP = mfma16(ak0, bk0, a4_zero()); mP = mfma16(ak1, bk1, mP);
                A4 mQ1 = mfma16(ar0, bk0, a4_zero()); mQ1 = mfma16(ar1, bk1, mQ1);
                A4 mQ2 = mfma16(ar0, bb0, a4_zero()); mQ2 = mfma16(ar1, bb1, mQ2);
                MFMA_PAD(mA, mP, mQ1, mQ2, mA, mP, mQ1, mQ2);
                bf16_t* rP0 = (bf16_t*)(rb + RS_P0); bf16_t* rQ1 = (bf16_t*)(rb + RS_Q1); bf16_t* rNQ2 = (bf16_t*)(rb + RS_NQ2);
                UNR for (int rg = 0; rg < 4; ++rg) { const int t = 4 * kg + rg, s_ = l15;
                    sAM[t * 16 + s_] = t > s_ ? A4_GET(mA, rg) : 0.f;
                    rP0[t * 16 + s_] = (bf16_t)f2bf(t > s_ ? A4_GET(mP, rg) : 0.f); rQ1[t * 16 + s_] = (bf16_t)f2bf(t >= s_ ? A4_GET(mQ1, rg) : 0.f); rNQ2[t * 16 + s_] = (bf16_t)f2bf(t >= s_ ? -A4_GET(mQ2, rg) : 0.f); }
            }
            WAVE_SYNC();
            {
                const int j = l15; float x[16]; bf16_t* rT = (bf16_t*)(rb + RS_T);
                UNR for (int t = 0; t < 16; ++t) { float acc = t == j ? 1.f : 0.f;
                    UNR for (int s_ = 0; s_ < 16; ++s_) if (s_ < t) acc -= sAM[t * 16 + s_] * x[s_];
                    x[t] = acc; if (lane < 16) rT[t * 16 + j] = (bf16_t)f2bf(acc); }
            }
            LDS_FENCE();
            WAVE_SYNC();
            if (lane == 0) fl_ready[slot] = (unsigned)(ch + 1);
        }
    }
    #undef RC_GEOM
    SYNC();
}
constexpr int FR_SLOTS = 20, FR_FLOATS = 6 * 2048, FR_LEAD = 20;
constexpr size_t WS_FRING = WS_HYOUT;
static_assert((size_t)16 * FR_SLOTS * FR_FLOATS * 4 <= (size_t)NLAT * 512 * 2, "feature ring fits");
constexpr size_t CTL_FFLAG = 65536, CTL_FPOS = CTL_FFLAG + 16 * 520 * 4 * 4;
constexpr int SC2_R = 8, SC2_NWG = 8;
static_assert(CTL_FPOS + 64 * 64 <= CTL_ZERO_BYTES, "control words");
#ifdef EMU
DEVFN unsigned gld_u32(const unsigned* p) { __sync_synchronize(); return *(volatile const unsigned*)p; }
DEVFN void gst_u32(unsigned* p, unsigned v) { __sync_synchronize(); *(volatile unsigned*)p = v; __sync_synchronize(); }
DEVFN unsigned long long gld_u64(const unsigned long long* p) { return *(volatile const unsigned long long*)p; }
DEVFN void gst_u64(unsigned long long* p, unsigned long long v) { *(volatile unsigned long long*)p = v; }
#define VM_DRAIN() __sync_synchronize()
#define GSPIN_WAIT(cond) do { while (!(cond)) sched_yield(); __sync_synchronize(); } while (0)
#else
DEVFN unsigned gld_u32(const unsigned* p) { return __hip_atomic_load(p, __ATOMIC_RELAXED, __HIP_MEMORY_SCOPE_AGENT); }
DEVFN void gst_u32(unsigned* p, unsigned v) { __hip_atomic_store(p, v, __ATOMIC_RELAXED, __HIP_MEMORY_SCOPE_AGENT); }
DEVFN unsigned long long gld_u64(const unsigned long long* p) { return __hip_atomic_load(p, __ATOMIC_RELAXED, __HIP_MEMORY_SCOPE_AGENT); }
DEVFN void gst_u64(unsigned long long* p, unsigned long long v) { __hip_atomic_store(p, v, __ATOMIC_RELAXED, __HIP_MEMORY_SCOPE_AGENT); }
#define VM_DRAIN() asm volatile("s_waitcnt vmcnt(0)" ::: "memory")
#define GSPIN_WAIT(cond) do { unsigned sp__ = 0; while (!(cond)) { __builtin_amdgcn_s_sleep(10); if (++sp__ > (1u << 21)) break; } asm volatile("" ::: "memory"); } while (0)
#endif
#ifdef EMU
#define SPIN_WAIT_SLOW(cond) SPIN_WAIT(cond)
#else
#define SPIN_WAIT_SLOW(cond) do { while (!(cond)) __builtin_amdgcn_s_sleep(8); asm volatile("" ::: "memory"); } while (0)
#endif
DEVFN unsigned long long f2_bits(float a, float b) { union { float f[2]; unsigned long long u; } x; x.f[0] = a; x.f[1] = b; return x.u; }

DEVFN void rwkv_scan2(const Ctx& C, int i, int h, int d, int rq, bool ctx_out, unsigned char* lds, int max_chunks) {
    const int tid = C.tid, lane = tid & 63, wave = C.wave;
    float* sBUF = (float*)lds;
    float* sWV = sBUF + 3 * SC_BUF;
    float* sCN = sWV + 4 * 1280;
    U4* sBF = (U4*)(sCN + 640);
    volatile unsigned* lf = (volatile unsigned*)((unsigned char*)sBF + 8192);
    const int hd = h * 2 + d;
    const unsigned epoch = (unsigned)(i + 1), pbase = (unsigned)i * 100000u;
    {
    const float* mu = C.in[I_MU] + (size_t)i * 1664;
    const float* w0 = C.in[I_W0] + ((size_t)i * 2 + d) * 512 + 64 * h; const float* a0 = C.in[I_A0] + ((size_t)i * 2 + d) * 512 + 64 * h;
    const float* wup = C.in[I_WUP] + ((size_t)i * 2 + d) * 32 * 512 + 64 * h; const float* aup = C.in[I_AUP] + ((size_t)i * 2 + d) * 32 * 512 + 64 * h;
    const float* k_k = C.in[I_KK] + (size_t)i * 512 + 64 * h; const float* k_a = C.in[I_KA] + (size_t)i * 512 + 64 * h; const float* r_k = C.in[I_RK] + (size_t)i * 512 + 64 * h;
    if (tid < 64) { const int j = tid; sCN[j] = mu[64 * h + j]; sCN[64 + j] = mu[512 + 64 * h + j]; sCN[128 + j] = mu[1024 + 64 * h + j]; sCN[192 + j] = w0[j]; sCN[256 + j] = a0[j];
        sCN[320 + j] = k_k[j]; sCN[384 + j] = k_a[j]; sCN[448 + j] = r_k[j]; sCN[512 + j] = j < 32 ? mu[1536 + 32 * d + j] : mu[1600 + 32 * d + (j - 32)]; }
    { const int m = tid >> 8, nt = (tid >> 6) & 3, ln = tid & 63; const float* src = m == 0 ? wup : aup; float f[8];
      UNR for (int j = 0; j < 8; ++j) f[j] = src[(size_t)(8 * (ln >> 4) + j) * 512 + 16 * nt + (ln & 15)];
      sBF[tid] = pack8(f); }
    }
    if (tid < 32) lf[tid] = 0u;
    SYNC();
    const int nchunks = NTOK / SC_T < max_chunks ? NTOK / SC_T : max_chunks;
    #define CHUNK_GEOM(ch, seg0, segn, R0) const bool isctx_ = (ch) < NCTX / SC_T; const int seg0 = isctx_ ? NLAT : 0, segn = isctx_ ? NCTX : NLAT; \
        const int cl_ = isctx_ ? (ch) : (ch) - NCTX / SC_T; const int R0 = d == 0 ? SC_T * cl_ : segn - SC_T * (cl_ + 1);
    if (wave < 2) {
        bf16_t* Yd = (bf16_t*)(C.ws + (d == 0 ? WS_YF : WS_YB));
        const int rl = tid >> 4, sp = tid & 15;
        float S0 = 0.f, S1 = 0.f, S2 = 0.f, S3 = 0.f;
        for (int ch = 0; ch < nchunks; ++ch) {
            const int b = ch % 3;
            SPIN_WAIT(lf[0 * 3 + b] == (unsigned)(ch + 1) && lf[1 * 3 + b] == (unsigned)(ch + 1));
            const float* B_ = sBUF + b * SC_BUF; const float* sV = B_ + 5 * SC_T * 64;
            float yk0 = 0.f, yk1 = 0.f, yp = 0.f;
#ifndef EMU
            {
                const unsigned ab = (unsigned)(uintptr_t)B_ + 16u * (unsigned)sp, av = (unsigned)(uintptr_t)sV + 4u * (unsigned)rl;
                P2 s01 = {S0, S1}, s23 = {S2, S3};
                asm volatile(SCAN_CHUNK_ASM : [s01] "+v"(s01), [s23] "+v"(s23), [yp] "+v"(yp), [yk0] "+v"(yk0), [yk1] "+v"(yk1) : [ab] "v"(ab), [av] "v"(av), [sp] "v"(sp) : SCAN_CHUNK_CLOBBERS);
                S0 = s01[0]; S1 = s01[1]; S2 = s23[0]; S3 = s23[1];
            }
#else
            { const float* sW = B_; const float* sKD = B_ + SC_T * 64; const float* sB = B_ + 2 * SC_T * 64; const float* sKK = B_ + 3 * SC_T * 64; const float* sR = B_ + 4 * SC_T * 64;
              for (int k = 0; k < SC_T; ++k) {
                const F4 kk4 = *(const F4*)(sKK + k * 64 + 4 * sp), w4 = *(const F4*)(sW + k * 64 + 4 * sp), b4 = *(const F4*)(sB + k * 64 + 4 * sp),
                         kd4 = *(const F4*)(sKD + k * 64 + 4 * sp), r4 = *(const F4*)(sR + k * 64 + 4 * sp);
                const float vi = sV[k * SC_R + rl];
                float sa = (S0 * kk4.x + S2 * kk4.z) + (S1 * kk4.y + S3 * kk4.w);
                const float t0 = S0 * w4.x + vi * kd4.x, t1 = S1 * w4.y + vi * kd4.y, t2 = S2 * w4.z + vi * kd4.z, t3 = S3 * w4.w + vi * kd4.w;
                sa = rowx_add<1>(sa); yp = rowx_add<1>(yp); sa = rowx_add<2>(sa); yp = rowx_add<2>(yp);
                sa = rowx_add<7>(sa); yp = rowx_add<7>(yp); sa = rowx_add<15>(sa); yp = rowx_add<15>(yp);
                if (sp == ((k + 15) & 15)) { if (k <= 16) yk0 = yp; else yk1 = yp; }
                S0 = t0 - sa * b4.x; S1 = t1 - sa * b4.y; S2 = t2 - sa * b4.z; S3 = t3 - sa * b4.w;
                yp = (S0 * r4.x + S2 * r4.z) + (S1 * r4.y + S3 * r4.w);
              } }
#endif
            LDS_FENCE(); WAVE_SYNC();
            if (lane == 0) lf[8 + wave * 3 + b] = (unsigned)(ch + 1);
            yp = rowx_add<1>(yp); yp = rowx_add<2>(yp); yp = rowx_add<7>(yp); yp = rowx_add<15>(yp);
            if (sp == 15) yk1 = yp;
            { CHUNK_GEOM(ch, seg0, segn, R0)
              if (!isctx_ || ctx_out) { const int t0 = d == 0 ? R0 + sp : R0 + SC_T - 1 - sp, t1 = d == 0 ? R0 + sp + 16 : R0 + SC_T - 1 - (sp + 16);
                  Yd[(size_t)(seg0 + t0) * 512 + 64 * h + SC2_R * rq + rl] = (bf16_t)f2bf(yk0); Yd[(size_t)(seg0 + t1) * 512 + 64 * h + SC2_R * rq + rl] = (bf16_t)f2bf(yk1); } }
        }
    } else if (wave < 6) {
        const int p = wave - 2;
        const bf16_t* U = (const bf16_t*)(C.ws + WS_U); float* BON = (float*)(C.ws + WS_BONUS) + (size_t)d * NTOK * 8;
        float* RING = (float*)(C.ws + WS_FRING) + (size_t)hd * FR_SLOTS * FR_FLOATS; unsigned* FFLAG = (unsigned*)(C.ws + WS_CTL + CTL_FFLAG) + (size_t)hd * 520 * 4; unsigned* FPOS = (unsigned*)(C.ws + WS_CTL + CTL_FPOS) + (size_t)hd * 64;
        float* myWV = sWV + p * 1280; float* sWL = myWV; float* sAL = myWV + 512; bf16_t* sTDb = (bf16_t*)(myWV + 1024); bf16_t* sADb = sTDb + 256;
        const int fp = lane & 7, tw = lane >> 3;
        const float* mu_r = sCN + 8 * fp; const float* mu_k = sCN + 64 + 8 * fp; const float* mu_v = sCN + 128 + 8 * fp; const float* c_w0 = sCN + 192 + 8 * fp; const float* c_a0 = sCN + 256 + 8 * fp;
        const float* c_kk = sCN + 320 + 8 * fp; const float* c_ka = sCN + 384 + 8 * fp; const float* c_rk = sCN + 448 + 8 * fp; const float* mu_w = sCN + 512 + 4 * fp; const float* mu_a = sCN + 544 + 4 * fp;
        U4 pu[9]; U2 pw[6];
        auto issue = [&](int q) {
            const int ch = rq + SC2_NWG * q; if (ch >= nchunks) return;
            CHUNK_GEOM(ch, seg0, segn, R0)
            const int ft = 8 * p + tw, tl = d == 0 ? R0 + ft : R0 + SC_T - 1 - ft;
            const bf16_t* u0p = U + (size_t)(seg0 + tl) * URW_W; const bool hm = tl > 0, hp = tl < segn - 1;
            const U4 z4 = {0u, 0u, 0u, 0u}; const U2 z2 = {0u, 0u};
            const int cw = 1536 + 32 * d + 4 * fp, ca = 1600 + 32 * d + 4 * fp;
            UNR for (int j = 0; j < 3; ++j) { pu[3 * j] = ld16(u0p + 512 * j + 64 * h + 8 * fp); pu[3 * j + 1] = z4; pu[3 * j + 2] = z4; }
            pw[0] = *(const U2*)(u0p + cw); pw[3] = *(const U2*)(u0p + ca); pw[1] = z2; pw[2] = z2; pw[4] = z2; pw[5] = z2;
            if (hm) { UNR for (int j = 0; j < 3; ++j) pu[3 * j + 1] = ld16(u0p - URW_W + 512 * j + 64 * h + 8 * fp); pw[1] = *(const U2*)(u0p - URW_W + cw); pw[4] = *(const U2*)(u0p - URW_W + ca); }
            if (hp) { UNR for (int j = 0; j < 3; ++j) pu[3 * j + 2] = ld16(u0p + URW_W + 512 * j + 64 * h + 8 * fp); pw[2] = *(const U2*)(u0p + URW_W + cw); pw[5] = *(const U2*)(u0p + URW_W + ca); }
        };
        issue(0);
        const int npass = (nchunks - rq + SC2_NWG - 1) / SC2_NWG;
        for (int q = 0; q < npass; ++q) {
            const int ch = rq + SC2_NWG * q;
            if (ch >= FR_SLOTS) { const unsigned need = pbase + (unsigned)(ch - FR_SLOTS + 1);
                GSPIN_WAIT(gld_u32(FPOS + 0) >= need && gld_u32(FPOS + 8) >= need && gld_u32(FPOS + 16) >= need && gld_u32(FPOS + 24) >= need && gld_u32(FPOS + 32) >= need && gld_u32(FPOS + 40) >= need && gld_u32(FPOS + 48) >= need && gld_u32(FPOS + 56) >= need); }
            CHUNK_GEOM(ch, seg0, segn, R0)
            float* rec = RING + (size_t)(ch % FR_SLOTS) * FR_FLOATS;
            {
                const int ft = 8 * p + tw;
                const int tl = d == 0 ? R0 + ft : R0 + SC_T - 1 - ft;
                float r[8], k[8], v[8];
                {
                    float a[8], m[8], qq[8];
                    #define SHIFT3(J, MU, OUT) do { unpack8(pu[3 * (J)], a); unpack8(pu[3 * (J) + 1], m); unpack8(pu[3 * (J) + 2], qq); \
                        UNR for (int e = 0; e < 8; ++e) OUT[e] = a[e] + (0.5f * (m[e] + qq[e]) - a[e]) * MU[e]; } while (0)
                    SHIFT3(0, mu_r, r); SHIFT3(1, mu_k, k); SHIFT3(2, mu_v, v);
                    #undef SHIFT3
                }
                {
                    const U2 w0_ = pw[0], wm = pw[1], wp = pw[2], a0_ = pw[3], am = pw[4], ap = pw[5];
                    const float wa[4] = {bflo(w0_.x), bfhi(w0_.x), bflo(w0_.y), bfhi(w0_.y)}, wmm[4] = {bflo(wm.x), bfhi(wm.x), bflo(wm.y), bfhi(wm.y)}, wpp[4] = {bflo(wp.x), bfhi(wp.x), bflo(wp.y), bfhi(wp.y)};
                    const float aa[4] = {bflo(a0_.x), bfhi(a0_.x), bflo(a0_.y), bfhi(a0_.y)}, amm[4] = {bflo(am.x), bfhi(am.x), bflo(am.y), bfhi(am.y)}, app[4] = {bflo(ap.x), bfhi(ap.x), bflo(ap.y), bfhi(ap.y)};
                    issue(q + 1);
                    float tdv[4], adv[4];
                    UNR for (int e = 0; e < 4; ++e) { const float x = wa[e] + (0.5f * (wmm[e] + wpp[e]) - wa[e]) * mu_w[e];
                        tdv[e] = 1.0f - 2.0f * FRCP(1.0f + FEXP(2.0f * x));
                        adv[e] = aa[e] + (0.5f * (amm[e] + app[e]) - aa[e]) * mu_a[e]; }
                    U2 tq, aq; tq.x = pk2(tdv[0], tdv[1]); tq.y = pk2(tdv[2], tdv[3]); aq.x = pk2(adv[0], adv[1]); aq.y = pk2(adv[2], adv[3]);
                    *(U2*)(sTDb + tw * 32 + 4 * fp) = tq; *(U2*)(sADb + tw * 32 + 4 * fp) = aq;
                }
                WAVE_SYNC();
                float wl[8], al[8];
                {
                    const int arow = lane & 7, kg = lane >> 4;
                    const H8 At = h8_from_u4(ld16(sTDb + arow * 32 + 8 * kg)), Aa = h8_from_u4(ld16(sADb + arow * 32 + 8 * kg));
                    A4 cw_[4], ca_[4];
                    UNR for (int nt = 0; nt < 4; ++nt) { A4 z; A4_GET(z, 0) = 0.f; A4_GET(z, 1) = 0.f; A4_GET(z, 2) = 0.f; A4_GET(z, 3) = 0.f;
                        cw_[nt] = mfma16(At, h8_from_u4(sBF[nt * 64 + lane]), z); ca_[nt] = mfma16(Aa, h8_from_u4(sBF[(4 + nt) * 64 + lane]), z); }
                    MFMA_PAD(cw_[0], cw_[1], cw_[2], cw_[3], ca_[0], ca_[1], ca_[2], ca_[3]);
                    if (lane < 32) { UNR for (int nt = 0; nt < 4; ++nt) UNR for (int rg = 0; rg < 4; ++rg) { const int tok = 4 * (lane >> 4) + rg; sWL[tok * 64 + 16 * nt + (lane & 15)] = A4_GET(cw_[nt], rg); sAL[tok * 64 + 16 * nt + (lane & 15)] = A4_GET(ca_[nt], rg); } }
                    WAVE_SYNC();
                    UNR for (int e = 0; e < 8; ++e) { wl[e] = c_w0[e] + sWL[tw * 64 + 8 * fp + e]; al[e] = c_a0[e] + sAL[tw * 64 + 8 * fp + e]; }
                    WAVE_SYNC();
                }
                float kkv[8], ssq = 0.f;
                UNR for (int e = 0; e < 8; ++e) { kkv[e] = k[e] * c_kk[e]; ssq += kkv[e] * kkv[e]; }
                ssq = rowx_add<1>(ssq); ssq = rowx_add<2>(ssq); ssq = rowx_add<7>(ssq);
                const float kn = FRSQ(ssq + 1e-12f);
                float bon = 0.f; float o_w[8], o_kd[8], o_b[8], o_kk[8];
                UNR for (int e = 0; e < 8; ++e) {
                    const float dec = FEXP(-0.60653066f * FRCP(1.0f + FEXP(-wl[e])));
                    const float a = FRCP(1.0f + FEXP(-al[e]));
                    const float kd = k[e] * (1.0f + (a - 1.0f) * c_ka[e]);
                    const float kk = kkv[e] * kn;
                    o_w[e] = dec; o_kd[e] = kd; o_b[e] = kk * a; o_kk[e] = kk;
                    bon += r[e] * kd * c_rk[e];
                }
                { unsigned long long* rp = (unsigned long long*)(rec + ft * 64 + 8 * fp);
                  #define ST8(AR, A) do { UNR for (int e2 = 0; e2 < 4; ++e2) gst_u64(rp + (AR) * 1024 + e2, f2_bits(A[2 * e2], A[2 * e2 + 1])); } while (0)
                  ST8(0, o_w); ST8(1, o_kd); ST8(2, o_b); ST8(3, o_kk); ST8(4, r); ST8(5, v);
                  #undef ST8
                }
                bon = rowx_add<1>(bon); bon = rowx_add<2>(bon); bon = rowx_add<7>(bon);
                if (fp == 0) BON[(size_t)(seg0 + tl) * 8 + h] = 0.5f * bon;
            }
            VM_DRAIN(); if (lane == 0) gst_u32(FFLAG + (size_t)ch * 4 + p, epoch);
        }
    } else {
        const int w = wave - 6;
        const float* RING = (const float*)(C.ws + WS_FRING) + (size_t)hd * FR_SLOTS * FR_FLOATS; unsigned* FFLAG = (unsigned*)(C.ws + WS_CTL + CTL_FFLAG) + (size_t)hd * 520 * 4; unsigned* FPOS = (unsigned*)(C.ws + WS_CTL + CTL_FPOS) + (size_t)hd * 64;
        for (int ch = 0; ch < nchunks; ++ch) {
            const int b = ch % 3;
            if (ch >= 3) SPIN_WAIT_SLOW(lf[8 + 0 * 3 + b] == (unsigned)(ch - 2) && lf[8 + 1 * 3 + b] == (unsigned)(ch - 2));
            GSPIN_WAIT(gld_u32(FFLAG + (size_t)ch * 4) == epoch && gld_u32(FFLAG + (size_t)ch * 4 + 1) == epoch && gld_u32(FFLAG + (size_t)ch * 4 + 2) == epoch && gld_u32(FFLAG + (size_t)ch * 4 + 3) == epoch);
            const unsigned long long* rec = (const unsigned long long*)(RING + (size_t)(ch % FR_SLOTS) * FR_FLOATS);
            float* B_ = sBUF + b * SC_BUF;
            { unsigned long long x[40], xv[2];
              UNR for (int j = 0; j < 40; ++j) x[j] = gld_u64(rec + (size_t)w * 2560 + j * 64 + lane);
              { const int idx = w * 64 + lane, tok = idx >> 2, c2 = idx & 3; xv[0] = gld_u64(rec + 5 * 1024 + tok * 32 + 4 * rq + c2); xv[1] = 0ull; }
              UNR for (int j = 0; j < 40; ++j) ((unsigned long long*)B_)[(size_t)w * 2560 + j * 64 + lane] = x[j];
              { const int idx = w * 64 + lane, tok = idx >> 2, c2 = idx & 3; ((unsigned long long*)(B_ + 5 * SC_T * 64))[tok * 8 + c2] = xv[0]; } }
            LDS_FENCE(); WAVE_SYNC();
            if (lane == 0) { lf[w * 3 + b] = (unsigned)(ch + 1); if (w == 0) gst_u32(FPOS + 8 * rq, pbase + (unsigned)(ch + 1)); }
        }
    }
    #undef CHUNK_GEOM
    SYNC();
}
DEVFN void ph_scan_hyena(const Ctx& C, int i, bool ctx_out, unsigned char* lds) {
    const int nscan = 128;
    if (C.vcu < nscan) { rwkv_scan2(C, i, C.vcu >> 4, (C.vcu >> 3) & 1, C.vcu & 7, ctx_out, lds, 1 << 30); XSTAMP(C, 40 + (C.vcu == 0 ? 0 : 3), C.vcu == 0 || C.vcu == 127); return; }
    const int nh = C.G - nscan;
    for (int c = C.vcu - nscan; c < 512; c += nh) { hyena_channel(C, i, c, lds); if (c == C.vcu - nscan) XSTAMP(C, 44, C.vcu == nscan); }
    XSTAMP(C, 41, C.vcu == nscan); XSTAMP(C, 42, C.vcu == C.G - 1);
    if (ctx_out) for (int c = C.vcu - nscan; c < 512; c += nh) { SYNC(); hyena_ctx_channel(C, i, c, lds); }
}
namespace pg8 {
#define PG8_LAS __attribute__((address_space(3)))
typedef unsigned short bf16_t;
typedef short bf16x8 __attribute__((ext_vector_type(8)));
typedef float f32x4 __attribute__((ext_vector_type(4)));
typedef unsigned u32x4 __attribute__((ext_vector_type(4)));
constexpr int BM = 256, BK = 64, HALF = 128, HTB = HALF * BK * 2  , STAGE_BYTES = 8 * HTB, NXCD = 8, WGM = 8;

__host__ __device__ __forceinline__ int lds_byte(int r, int c) { const int st = (r >> 4) * 2 + (c >> 5), rr = r & 15, cc = c & 31, ob = rr * 64 + cc * 2; return st * 1024 + (ob ^ (((ob >> 9) & 1) << 5)); }
__host__ __device__ __forceinline__ void stage_rc(int b, int& R, int& C) { const int st = b / 1024, sb = b % 1024, swz = sb ^ (((sb >> 9) & 1) << 5); R = (st >> 1) * 16 + swz / 64; C = (st & 1) * 32 + (swz % 64) / 2; }
__host__ __device__ __forceinline__ int perm32(int rho) { const int n = rho >> 4, i = rho & 15; return 8 * (i >> 2) + 4 * n + (i & 3); }

struct Unit { int pm, pn; };
struct Gemm { const bf16_t* A; const bf16_t* A2; int lda; const bf16_t* Bt; int M, N, K; };

struct StaticOrder {
    int nM, nN, nwg, G, c;
    __host__ __device__ void init(int M, int N, int G_, int c_) { nM = M / BM; nN = N / BM; nwg = nM * nN; G = G_; c = c_; }
    __host__ __device__ bool next(int i, Unit& u) const {
        const long L = (long)i * G + c; if (L >= nwg) return false;
        int wgid = (int)L; { const int q = nwg / NXCD, r = nwg % NXCD, xcd = wgid % NXCD, off = wgid / NXCD; wgid = (xcd < r ? xcd * (q + 1) : r * (q + 1) + (xcd - r) * q) + off; }
        const int nig = WGM * nN, gid = wgid / nig, fm = gid * WGM, gsz = (nM - fm) < WGM ? (nM - fm) : WGM;
        u.pm = fm + ((wgid % nig) % gsz); u.pn = (wgid % nig) / gsz; return true;
    }
    __device__ __forceinline__ void a_ready(const Unit&) const {}
    __device__ __forceinline__ void done(const Unit&) const {}
};

__device__ __forceinline__ unsigned cvt_pk_bf16(float lo, float hi) { unsigned r; asm volatile("v_cvt_pk_bf16_f32 %0, %1, %2" : "=v"(r) : "v"(lo), "v"(hi)); return r; }
__device__ __forceinline__ float silu_fast(float v) { return v * __builtin_amdgcn_rcpf(1.0f + __expf(-v)); }

template <int LAYOUT> struct EpiIn {
    static constexpr bool PERM = true, AFTER_DRAIN = false;
    unsigned char* ws;
    __device__ __forceinline__ void operator()(const f32x4 (&acc)[2][2][4][2], const Unit& u, int wr, int wc, int fr, int fq) const {
        const int row0 = u.pm * BM + wr * 64 + fr;
#pragma unroll
        for (int bj = 0; bj < 2; ++bj) {
            const int cg = u.pn * BM + bj * HALF;
            bf16_t* base; int ldc, mode, col;
            if (LAYOUT == 0) { base = (bf16_t*)(ws + WS_U); ldc = AIN; col = cg; mode = cg < 512 ? 1 : ((cg >= 1536 && cg < 2048) || cg >= 2816) ? 2 : 0; }
            else {
                if (cg < URW_W) { base = (bf16_t*)(ws + WS_U); ldc = URW_W; col = cg; mode = cg >= 1664 ? 2 : 0; }
                else if (cg < URW_W + UHY_W) { base = (bf16_t*)(ws + WS_UHY); ldc = UHY_W; col = cg - URW_W; mode = 0; }
                else if (cg < RIN) { base = (bf16_t*)(ws + WS_GHY); ldc = 512; col = cg - URW_W - UHY_W; mode = 2; }
                else { base = nullptr; ldc = 0; col = 0; mode = 3; }
            }
            if (mode == 3) continue;
            const int col0 = col + wc * 32 + 8 * fq;
#pragma unroll
            for (int ai = 0; ai < 2; ++ai)
#pragma unroll
                for (int m = 0; m < 4; ++m) {
                    f32x4 v0 = acc[ai][bj][m][0], v1 = acc[ai][bj][m][1];
                    if (mode == 1) { v0 = v0 * C2; v1 = v1 * C2; }
                    if (mode == 2) { v0 = (f32x4){silu_fast(v0[0]), silu_fast(v0[1]), silu_fast(v0[2]), silu_fast(v0[3])}; v1 = (f32x4){silu_fast(v1[0]), silu_fast(v1[1]), silu_fast(v1[2]), silu_fast(v1[3])}; }
                    u32x4 w; w.x = cvt_pk_bf16(v0[0], v0[1]); w.y = cvt_pk_bf16(v0[2], v0[3]); w.z = cvt_pk_bf16(v1[0], v1[1]); w.w = cvt_pk_bf16(v1[2], v1[3]);
                    *(u32x4*)(base + (size_t)(row0 + ai * HALF + m * 16) * ldc + col0) = w;
                }
        }
    }
};

struct EpiRes {
    static constexpr bool PERM = false, AFTER_DRAIN = false;
    const float* blat; const float* bctx; float* olat; float* octx; const float* gate; const float* gate_c;
    __device__ __forceinline__ void operator()(const f32x4 (&acc)[2][2][4][2], const Unit& u, int wr, int wc, int fr, int fq) const {
        const bool isctx = u.pm * BM >= NLAT;
        const float* bs = isctx ? bctx - (size_t)NLAT * DM : blat; float* os = isctx ? octx - (size_t)NLAT * DM : olat; const float* gt = isctx ? gate_c : gate;
        const int col0 = u.pn * BM + wc * 32 + 4 * fq;
#pragma unroll
        for (int bj = 0; bj < 2; ++bj)
#pragma unroll
            for (int n = 0; n < 2; ++n) { const f32x4 g = *(const f32x4*)(gt + col0 + bj * HALF + n * 16);
#pragma unroll
                for (int ai = 0; ai < 2; ++ai)
#pragma unroll
                    for (int m = 0; m < 4; ++m) { const size_t off = (size_t)(u.pm * BM + ai * HALF + wr * 64 + m * 16 + fr) * DM + col0 + bj * HALF + n * 16;
                        const f32x4 b = *(const f32x4*)(bs + off); *(f32x4*)(os + off) = b + g * acc[ai][bj][m][n]; } }
    }
};
template <class Epi, class Sched, bool ALIGN_EPI = false, bool SP2 = false>
__device__ __forceinline__ void gemm_phase(PG8_LAS unsigned char* lds, const Gemm g, const Sched& S, const Epi& E) {
    int tid_ = threadIdx.x; asm volatile("" : "+v"(tid_));
    const int tid = tid_, wid = __builtin_amdgcn_readfirstlane(tid >> 6), lane = tid & 63, wr = wid >> 2, wc = wid & 3, fr = lane & 15, fq = lane >> 4;
    const int K = g.K, nt = K / BK;
    unsigned voffA[2], voffB[2];
#pragma unroll
    for (int i = 0; i < 2; ++i) { int R, C; stage_rc(tid * 16 + i * 8192, R, C); const int Rb = Epi::PERM ? ((R & ~31) + perm32(R & 31)) : R;
        voffA[i] = (unsigned)(R * g.lda + C) * 2u; voffB[i] = (unsigned)(Rb * K + C) * 2u; }
    const size_t kstep = (size_t)(BK * 2);
    const size_t hstepA = (size_t)HALF * g.lda * 2, hstepB = (size_t)HALF * K * 2;
    const size_t tstepA = 2 * hstepA, tstepB = 2 * hstepB;
    const int nh = nt / 2; const ptrdiff_t dlt = ((const char*)g.A2 - (const char*)g.A) - (ptrdiff_t)nh * (ptrdiff_t)kstep;
    const unsigned ldsw = (unsigned)wid * 1024u;
    const int aoff = lds_byte(wr * 64 + fr, fq * 8), boff = lds_byte(wc * 32 + fr, fq * 8);
#define PG8_SA(b, h) (((b) * 2 + (h)) * HTB)
#define PG8_SB(b, h) ((4 + (b) * 2 + (h)) * HTB)
#define PG8_STAGE(bufoff, gbase, voff) do { _Pragma("unroll") for (int _i = 0; _i < 2; ++_i) \
        __builtin_amdgcn_global_load_lds((const unsigned*)((const char*)(gbase) + (voff)[_i]), (PG8_LAS unsigned*)(lds + (bufoff) + ldsw + _i * 8192), 16, 0, 0); } while (0)
#define PG8_LDA(dst, b, h) do { _Pragma("unroll") for (int m = 0; m < 4; ++m) _Pragma("unroll") for (int k = 0; k < 2; ++k) dst[m][k] = *(const PG8_LAS bf16x8*)(lds + PG8_SA(b, h) + aoff + m * 2048 + k * 1024); } while (0)
#define PG8_LDB(dst, b, h) do { _Pragma("unroll") for (int n = 0; n < 2; ++n) _Pragma("unroll") for (int k = 0; k < 2; ++k) dst[n][k] = *(const PG8_LAS bf16x8*)(lds + PG8_SB(b, h) + boff + n * 2048 + k * 1024); } while (0)
#define PG8_MMA(ai, bj, At, Bt) do { __builtin_amdgcn_s_setprio(1); _Pragma("unroll") for (int m = 0; m < 4; ++m) _Pragma("unroll") for (int n = 0; n < 2; ++n) _Pragma("unroll") for (int k = 0; k < 2; ++k) \
        acc[ai][bj][m][n] = __builtin_amdgcn_mfma_f32_16x16x32_bf16(Bt[n][k], At[m][k], acc[ai][bj][m][n], 0, 0, 0); __builtin_amdgcn_s_setprio(0); } while (0)
#define PG8_WAIT_V(n) asm volatile("s_waitcnt vmcnt(" #n ")" ::: "memory")
#define PG8_WAIT_L(n) asm volatile("s_waitcnt lgkmcnt(" #n ")" ::: "memory")
#define PG8_BAR __builtin_amdgcn_s_barrier()
#define PG8_SCHED __builtin_amdgcn_sched_barrier(0)
    Unit cur, nxt; int ui = 0;
    if (!S.next(0, cur)) return;
    f32x4 acc[2][2][4][2];
#pragma unroll
    for (int a = 0; a < 2; ++a)
#pragma unroll
        for (int b = 0; b < 2; ++b)
#pragma unroll
            for (int m = 0; m < 4; ++m)
#pragma unroll
                for (int n = 0; n < 2; ++n) acc[a][b][m][n] = (f32x4){0.f, 0.f, 0.f, 0.f};
    bf16x8 At[4][2], B0[2][2], B1[2][2];
    const char* cA = (const char*)g.A + (size_t)cur.pm * tstepA; const char* cB = (const char*)g.Bt + (size_t)cur.pn * tstepB;
    S.a_ready(cur);
    if constexpr (SP2) {
        PG8_STAGE(PG8_SB(0, 0), cB, voffB); PG8_STAGE(PG8_SB(0, 1), cB + hstepB, voffB); PG8_STAGE(PG8_SA(0, 0), cA, voffA); PG8_STAGE(PG8_SA(0, 1), cA + hstepA, voffA);
        if (wr == 1) PG8_BAR;
        PG8_WAIT_V(2); PG8_BAR;
        PG8_STAGE(PG8_SB(1, 0), cB + kstep, voffB); PG8_STAGE(PG8_SA(1, 0), cA + kstep, voffA); PG8_STAGE(PG8_SB(1, 1), cB + hstepB + kstep, voffB);
        PG8_WAIT_V(6); PG8_BAR;
    } else {
        PG8_STAGE(PG8_SB(0, 0), cB, voffB); PG8_STAGE(PG8_SA(0, 0), cA, voffA); PG8_STAGE(PG8_SB(0, 1), cB + hstepB, voffB); PG8_STAGE(PG8_SA(0, 1), cA + hstepA, voffA);
        if (wr == 1) PG8_BAR;
        PG8_WAIT_V(4); PG8_BAR;
        PG8_STAGE(PG8_SB(1, 0), cB + kstep, voffB); PG8_STAGE(PG8_SA(1, 0), cA + kstep, voffA); PG8_STAGE(PG8_SB(1, 1), cB + hstepB + kstep, voffB);
        PG8_WAIT_V(6); PG8_BAR;
    }
    for (;;) {
        const bool has_next = S.next(ui + 1, nxt);
        const char* nA = has_next ? (const char*)g.A + (size_t)nxt.pm * tstepA : cA; const char* nB = has_next ? (const char*)g.Bt + (size_t)nxt.pn * tstepB : cB;
        for (int t = 0; t < nt; t += 2) {
            const bool last = (t == nt - 2);
            const char* a1 = cA + (size_t)(t + 1) * kstep + ((t + 1) >= nh ? dlt : 0);
            const char* a2 = last ? nA : cA + (size_t)(t + 2) * kstep + ((t + 2) >= nh ? dlt : 0); const char* b2 = last ? nB : cB + (size_t)(t + 2) * kstep;
            const char* a3 = a2 + kstep; const char* b3 = b2 + kstep;
            if (last && has_next) S.a_ready(nxt);
            if constexpr (SP2) {
            PG8_LDB(B0, 0, 0); PG8_LDB(B1, 0, 1); PG8_SCHED; PG8_LDA(At, 0, 0); PG8_STAGE(PG8_SA(1, 1), a1 + hstepA, voffA);
            PG8_WAIT_V(8); PG8_WAIT_L(0); PG8_BAR; PG8_MMA(0, 0, At, B0); PG8_MMA(0, 1, At, B1); PG8_BAR; PG8_SCHED;
            PG8_LDA(At, 0, 1); PG8_STAGE(PG8_SB(0, 0), b2, voffB); PG8_STAGE(PG8_SB(0, 1), b2 + hstepB, voffB); PG8_STAGE(PG8_SA(0, 0), a2, voffA);
            PG8_WAIT_V(8); PG8_WAIT_L(0); PG8_BAR; PG8_MMA(1, 0, At, B0); PG8_MMA(1, 1, At, B1); PG8_BAR; PG8_SCHED;
            PG8_LDB(B0, 1, 0); PG8_LDB(B1, 1, 1); PG8_SCHED; PG8_LDA(At, 1, 0); PG8_STAGE(PG8_SA(0, 1), a2 + hstepA, voffA);
            PG8_WAIT_V(8); PG8_WAIT_L(0); PG8_BAR; PG8_MMA(0, 0, At, B0); PG8_MMA(0, 1, At, B1); PG8_BAR; PG8_SCHED;
            PG8_LDA(At, 1, 1); PG8_STAGE(PG8_SB(1, 0), b3, voffB); PG8_STAGE(PG8_SB(1, 1), b3 + hstepB, voffB); PG8_STAGE(PG8_SA(1, 0), a3, voffA);
            PG8_WAIT_V(8); PG8_WAIT_L(0); PG8_BAR; PG8_MMA(1, 0, At, B0); PG8_MMA(1, 1, At, B1); PG8_BAR; PG8_SCHED;
            } else {
            PG8_LDB(B0, 0, 0); PG8_SCHED; PG8_LDA(At, 0, 0); PG8_STAGE(PG8_SA(1, 1), a1 + hstepA, voffA);
            PG8_WAIT_L(8); PG8_BAR; PG8_WAIT_L(0); PG8_MMA(0, 0, At, B0); PG8_BAR; PG8_SCHED;
            PG8_LDB(B1, 0, 1); PG8_STAGE(PG8_SB(0, 0), b2, voffB);
            PG8_BAR; PG8_WAIT_L(0); PG8_MMA(0, 1, At, B1); PG8_BAR;
            PG8_LDA(At, 0, 1); PG8_STAGE(PG8_SA(0, 0), a2, voffA);
            PG8_BAR; PG8_WAIT_L(0); PG8_MMA(1, 0, At, B0); PG8_BAR; PG8_SCHED;
            PG8_STAGE(PG8_SB(0, 1), b2 + hstepB, voffB);
            PG8_WAIT_V(6); PG8_BAR; PG8_MMA(1, 1, At, B1); PG8_BAR;
            PG8_LDB(B0, 1, 0); PG8_SCHED; PG8_LDA(At, 1, 0); PG8_STAGE(PG8_SA(0, 1), a2 + hstepA, voffA);
            PG8_WAIT_L(8); PG8_BAR; PG8_WAIT_L(0); PG8_MMA(0, 0, At, B0); PG8_BAR; PG8_SCHED;
            PG8_LDB(B1, 1, 1); PG8_STAGE(PG8_SB(1, 0), b3, voffB);
            PG8_BAR; PG8_WAIT_L(0); PG8_MMA(0, 1, At, B1); PG8_BAR;
            PG8_LDA(At, 1, 1); PG8_STAGE(PG8_SA(1, 0), a3, voffA);
            PG8_BAR; PG8_WAIT_L(0); PG8_MMA(1, 0, At, B0); PG8_BAR; PG8_SCHED;
            PG8_STAGE(PG8_SB(1, 1), b3 + hstepB, voffB);
            PG8_WAIT_V(6); PG8_BAR; PG8_MMA(1, 1, At, B1); PG8_BAR;
            }
        }
        if constexpr (ALIGN_EPI) { if (wr == 0) PG8_BAR; }
        if constexpr (!Epi::AFTER_DRAIN) { E(acc, cur, wr, wc, fr, fq); S.done(cur); }
        if (!has_next) break;
#pragma unroll
        for (int a = 0; a < 2; ++a)
#pragma unroll
            for (int b = 0; b < 2; ++b)
#pragma unroll
                for (int m = 0; m < 4; ++m)
#pragma unroll
                    for (int n = 0; n < 2; ++n) acc[a][b][m][n] = (f32x4){0.f, 0.f, 0.f, 0.f};
        cur = nxt; cA = nA; cB = nB; ++ui;
        if constexpr (ALIGN_EPI) { if (wr == 1) PG8_BAR; }
    }
    PG8_WAIT_V(0);
    if constexpr (!ALIGN_EPI) { if (wr == 0) PG8_BAR; }
    PG8_BAR;
    if constexpr (Epi::AFTER_DRAIN) { E.fused(acc, cur, wr, wc, fr, fq, lds, wid, lane); S.done(cur); }
#undef PG8_SA
#undef PG8_SB
#undef PG8_STAGE
#undef PG8_LDA
#undef PG8_LDB
#undef PG8_MMA
#undef PG8_WAIT_V
#undef PG8_WAIT_L
#undef PG8_BAR
#undef PG8_SCHED
}
}
#include <hip/hip_bf16.h>
#include <cmath>
namespace attn_body {
using bf16=__hip_bfloat16;
using bf16x8=__attribute__((ext_vector_type(8)))short;
using s16x4=__attribute__((ext_vector_type(4)))short;
using f32x16=__attribute__((ext_vector_type(16)))float;
using u32x4=__attribute__((ext_vector_type(4)))unsigned;
constexpr int D=64;
constexpr int NW=8,QBLK=32,QB=QBLK*NW,KVBLK=64;
__device__ __forceinline__ int crow(int r,int hi){return (r&3)+8*(r>>2)+4*hi;}
#define SBAR() __builtin_amdgcn_sched_barrier(0)
typedef __attribute__((address_space(3))) const float* lds_fptr;
struct NaCtx { lds_fptr tab; int rmin, qr, qc, row0, col0; };
__device__ __forceinline__ void namask(f32x16&p0,f32x16&p1,int t,const NaCtx&n,int hi){
  if(t<4)return;
  const float NEG=-INFINITY; const int kr=n.rmin+(t-4);
  if(kr<n.row0||kr>=n.row0+8){
    #pragma unroll
    for(int r=0;r<16;++r){p0[r]=NEG;p1[r]=NEG;}
    return; }
  const lds_fptr bt=n.tab+((kr-n.qr+7)*31+15-n.qc+4*hi); const int d0=4*hi-n.col0;
  #pragma unroll
  for(int r=0;r<16;++r){const int e=(r&3)+8*(r>>2);
    p0[r]=((unsigned)(e+d0)<16u)?p0[r]+bt[e]:NEG; p1[r]=((unsigned)(e+32+d0)<16u)?p1[r]+bt[e+32]:NEG;}
}

constexpr int NSLOT=3, SLOTB=8192;
constexpr int LDS_K=0, LDS_V=NSLOT*SLOTB, LDS_WS=2*NSLOT*SLOTB, LDS_OST=LDS_WS+NW*64*4, LDS_BIAS=LDS_OST+NW*4096, LDS_BYTES=LDS_BIAS+640*4;
constexpr float C2=0.125f*1.4426950408889634f;
__device__ __forceinline__ void glds16(const void*gsrc,unsigned lds_dst){unsigned keep;
  asm volatile("s_mov_b32 %0, m0\n\ts_mov_b32 m0, %2\n\ts_nop 0\n\tglobal_load_lds_dwordx4 %1, off\n\ts_mov_b32 m0, %0":"=&s"(keep):"v"(gsrc),"s"(lds_dst):"memory");}
__device__ __forceinline__ float max3f(float a,float b,float c){float r;asm("v_max3_f32 %0, %1, %2, %3":"=v"(r):"v"(a),"v"(b),"v"(c));return r;}
__device__ __forceinline__ float max2f(float a,float b){float r;asm("v_max_f32_e32 %0, %1, %2":"=v"(r):"v"(a),"v"(b));return r;}
__device__ __forceinline__ float fadd_s(float a,float b){float r;asm("v_add_f32_e32 %0, %1, %2":"=v"(r):"v"(a),"v"(b));return r;}
__device__ __forceinline__ float fsub_s(float a,float b){float r;asm("v_sub_f32_e32 %0, %1, %2":"=v"(r):"v"(a),"v"(b));return r;}
typedef float f32x2_t __attribute__((ext_vector_type(2))); typedef __bf16 bf16x2_t __attribute__((ext_vector_type(2)));
__device__ __forceinline__ unsigned cvtpk_s(float lo,float hi){f32x2_t v={lo,hi};bf16x2_t b=__builtin_convertvector(v,bf16x2_t);return __builtin_bit_cast(unsigned,b);}
#define WAIT_BAR(N) asm volatile("s_waitcnt vmcnt(" #N ") lgkmcnt(0)\n\ts_barrier":::"memory")

__device__ __forceinline__ void qkt(f32x16&p0,f32x16&p1,const char*Kslot,const bf16x8*qr,const f32x16&negm,int r32,int hi){
  const char*kb=Kslot+hi*1024+r32*16;
  #pragma unroll
  for(int d0=0;d0<4;++d0){
    const bf16x8 b0=*reinterpret_cast<const bf16x8*>(kb+d0*2048);
    const bf16x8 b1=*reinterpret_cast<const bf16x8*>(kb+d0*2048+512);
    if(d0==0){p0=__builtin_amdgcn_mfma_f32_32x32x16_bf16(b0,qr[0],negm,0,0,0);p1=__builtin_amdgcn_mfma_f32_32x32x16_bf16(b1,qr[0],negm,0,0,0);}
    else{p0=__builtin_amdgcn_mfma_f32_32x32x16_bf16(b0,qr[d0],p0,0,0,0);p1=__builtin_amdgcn_mfma_f32_32x32x16_bf16(b1,qr[d0],p1,0,0,0);}}
}
typedef __attribute__((address_space(3))) const char* lds_cptr;
typedef short v4i16_t __attribute__((ext_vector_type(4)));
__device__ __forceinline__ void kload8(bf16x8*kf,lds_cptr kp){
  kf[0]=*(const __attribute__((address_space(3))) bf16x8*)(kp);      kf[1]=*(const __attribute__((address_space(3))) bf16x8*)(kp+512);
  kf[2]=*(const __attribute__((address_space(3))) bf16x8*)(kp+2048); kf[3]=*(const __attribute__((address_space(3))) bf16x8*)(kp+2560);
  kf[4]=*(const __attribute__((address_space(3))) bf16x8*)(kp+4096); kf[5]=*(const __attribute__((address_space(3))) bf16x8*)(kp+4608);
  kf[6]=*(const __attribute__((address_space(3))) bf16x8*)(kp+6144); kf[7]=*(const __attribute__((address_space(3))) bf16x8*)(kp+6656);
}
__device__ __forceinline__ void kload2(bf16x8*kf,lds_cptr kp,int j){ kf[2*j]=*(const __attribute__((address_space(3))) bf16x8*)(kp+j*2048); kf[2*j+1]=*(const __attribute__((address_space(3))) bf16x8*)(kp+j*2048+512); }
__device__ __forceinline__ s16x4 vtr(lds_cptr p){ return __builtin_bit_cast(s16x4,__builtin_amdgcn_ds_read_tr16_b64_v4i16((__attribute__((address_space(3))) v4i16_t*)p)); }
__device__ __forceinline__ float rowmax(const f32x16&p0,const f32x16&p1){
  float a=max3f(p0[0],p0[1],p1[0]),b=max3f(p0[2],p0[3],p1[1]);a=max3f(a,p1[2],p1[3]);
  #pragma unroll
  for(int r=4;r<16;r+=4){a=max3f(a,p0[r],p0[r+1]);b=max3f(b,p0[r+2],p0[r+3]);a=max3f(a,p1[r],p1[r+1]);b=max3f(b,p1[r+2],p1[r+3]);}
  const float m=max2f(a,b);
  auto rr=__builtin_amdgcn_permlane32_swap(__float_as_uint(m),__float_as_uint(m),false,false);
  return max2f(__uint_as_float(rr[0]),__uint_as_float(rr[1]));
}
__device__ __forceinline__ void pv(f32x16*o,int vb,bf16x8 pa0,bf16x8 pa1,bf16x8 pa2,bf16x8 pa3){
  #pragma unroll
  for(int d0=0;d0<2;++d0){s16x4 lo[4],hi[4];
    #pragma unroll
    for(int ks=0;ks<4;++ks){
      asm volatile("ds_read_b64_tr_b16 %0,%1 offset:%c2":"=&v"(lo[ks]):"v"(vb),"i"(d0*4096+ks*1024):"memory");
      asm volatile("ds_read_b64_tr_b16 %0,%1 offset:%c2":"=&v"(hi[ks]):"v"(vb),"i"(d0*4096+ks*1024+512):"memory");}
    asm volatile("s_waitcnt lgkmcnt(0)":::"memory");SBAR();
    #define PK(k) (bf16x8){lo[k][0],lo[k][1],lo[k][2],lo[k][3],hi[k][0],hi[k][1],hi[k][2],hi[k][3]}
    o[d0]=__builtin_amdgcn_mfma_f32_32x32x16_bf16(pa0,PK(0),o[d0],0,0,0);
    o[d0]=__builtin_amdgcn_mfma_f32_32x32x16_bf16(pa1,PK(1),o[d0],0,0,0);
    o[d0]=__builtin_amdgcn_mfma_f32_32x32x16_bf16(pa2,PK(2),o[d0],0,0,0);
    o[d0]=__builtin_amdgcn_mfma_f32_32x32x16_bf16(pa3,PK(3),o[d0],0,0,0);
    #undef PK
  }
}

#define ATTN_STORE16(p,v) (*(u32x4*)(p)=(v))
template<bool NA> __device__ __forceinline__ f32x16 cinit(const f32x16&negm){ if constexpr(NA){ f32x16 z=f32x16{}; return z; } else return negm; }
constexpr int UP=3328, OP=1024;
struct AJob { const bf16*U; bf16*MX; unsigned qo, ko, vo, go, oo; int NT, tile0a, na, tile0b; int qr0, rmin; const float*rpb; };
__device__ __forceinline__ u32x4 gate8(u32x4 v,u32x4 g);
template<int THRL,bool NA> __device__ __forceinline__ void attn_unit(const AJob&J,char*shm){
  int tid_=threadIdx.x; asm volatile("":"+v"(tid_));
  const int tid=tid_,lane=tid&63,r32=lane&31,hi=lane>>5; const int wid=__builtin_amdgcn_readfirstlane(tid>>6);
  const bf16*Qw=J.U+J.qo+(long)(wid*QBLK)*UP;
  const bf16*Kh=J.U+J.ko,*Vh=J.U+J.vo;
  const unsigned lds0=(unsigned)(uintptr_t)shm;
  float*wsf=(float*)(shm+LDS_WS)+wid*64;
  const bf16*ksrc=Kh+(long)lane*UP+wid*8;
  const bf16*vsrc=Vh+(long)(16*(wid&3)+(lane>>2))*UP+(wid>>2)*32+(lane&3)*8;
  const unsigned kdst=lds0+LDS_K+wid*1024, vdst=lds0+LDS_V+wid*1024;
  #define TROW(t) (64L*(long)(((t)<J.na)?(J.tile0a+(t)):(J.tile0b+((t)-J.na))))
  #define DMA_K(t,slot) glds16(ksrc+TROW(t)*UP,(unsigned)__builtin_amdgcn_readfirstlane(kdst+(slot)))
  #define DMA_V(t,slot) glds16(vsrc+TROW(t)*UP,(unsigned)__builtin_amdgcn_readfirstlane(vdst+(slot)))
  const int vb0=(int)(lds0+LDS_V)+((lane>>4)&1)*32+(lane&3)*8+(4*hi+((lane&15)>>2))*64;
  const char*Kbase=shm+LDS_K; bf16x8 kf[8];
  const lds_cptr shm3=(lds_cptr)shm; const lds_cptr kp0=shm3+LDS_K+hi*1024+r32*16; const lds_cptr vp0=shm3+LDS_V+((lane>>4)&1)*32+(lane&3)*8+(4*hi+((lane&15)>>2))*64;
  const int NT=J.NT;
  NaCtx nac; nac.tab=(lds_fptr)(shm+LDS_BIAS)+64; nac.rmin=J.rmin; nac.qr=J.qr0+(wid>>1); nac.qc=32*(wid&1)+r32;
  { int a=nac.qr-4; a=a<0?0:(a>248?248:a); nac.row0=a; int b=nac.qc-8; b=b<0?0:(b>48?48:b); nac.col0=b; }
  if(NA){ if(J.rpb){ for(int e=tid;e<465;e+=512)((__attribute__((address_space(3))) float*)(shm+LDS_BIAS))[64+e]=J.rpb[e]*1.4426950408889634f; } }
  DMA_K(0,0);DMA_V(0,0);DMA_K(1,SLOTB);
  bf16x8 qr[4];
  #pragma unroll
  for(int d0=0;d0<4;++d0)qr[d0]=*reinterpret_cast<const bf16x8*>(&Qw[(long)r32*UP+d0*16+hi*8]);
  float mhat=0.f,l_reg=0.f;f32x16 o[2];o[0]=f32x16{};o[1]=f32x16{};f32x16 negm=f32x16{}; if constexpr(!NA) asm volatile("":"+v"(negm));
  #define CMASK(P0,P1,t) do{ if constexpr(NA) namask(P0,P1,(t),nac,hi); }while(0)
  bool resc=false;
  #define START(P0,P1) do{ const float rm=rowmax(P0,P1); resc=false; \
    { const float dl=rm; mhat=fadd_s(mhat,dl); \
      _Pragma("unroll") for(int r=0;r<16;++r){P0[r]=fsub_s(P0[r],dl);P1[r]=fsub_s(P1[r],dl);} \
      if constexpr(!NA){ _Pragma("unroll") for(int r=0;r<16;++r)negm[r]=-mhat; asm volatile("":"+v"(negm)); } } \
    _Pragma("unroll") for(int r=0;r<16;++r)P0[r]=__builtin_amdgcn_exp2f(P0[r]); }while(0)
  #define RESC() do{ if(resc){ asm volatile("s_waitcnt lgkmcnt(0)":::"memory"); \
      _Pragma("unroll") for(int d_=0;d_<2;++d_) _Pragma("unroll") for(int r=0;r<16;++r)o[d_][r]*=wsf[crow(r,hi)]; } }while(0)
  f32x16 pA0,pA1,pB0,pB1;
  int sl_prev=0,sl_cur=0,sl_next=SLOTB;
  #define ROT() do{sl_prev=sl_cur;sl_cur=sl_next;sl_next=(sl_next==(NSLOT-1)*SLOTB)?0:sl_next+SLOTB;}while(0)
  DMA_K(2,2*SLOTB);
  WAIT_BAR(3);
  qkt(pA0,pA1,Kbase,qr,cinit<NA>(negm),r32,hi);asm volatile("s_nop 15\n\ts_nop 7":"+v"(pA0),"+v"(pA1));CMASK(pA0,pA1,0);
  START(pA0,pA1);
  _Pragma("unroll") for(int r=0;r<16;++r)pA1[r]=__builtin_amdgcn_exp2f(pA1[r]);
  WAIT_BAR(0);
  DMA_K(3,0);DMA_V(1,SLOTB);
  ROT();
  kload8(kf,kp0+sl_cur);
  WAIT_BAR(2);
  s16x4 vlo[8],vhi[8]; u32x4 pw0,pw1,pw2,pw3;
  #define PKW(P,B) cvtpk_s(P[B],P[B+1])
  #define PAF(k) __builtin_bit_cast(bf16x8,pw##k)
  #define VFR(i) (bf16x8){vlo[i][0],vlo[i][1],vlo[i][2],vlo[i][3],vhi[i][0],vhi[i][1],vhi[i][2],vhi[i][3]}
  #define PIN(x) asm volatile("":"+v"(x))
  #define MX3(a,b,c) __builtin_fmaxf(__builtin_fmaxf((a),(b)),(c))
  #define GAPA(MF,A0,A1,A2,A3,W0,W1,PW) do{ MF; sacc+=A0; sacc+=A1; sacc+=A2; sacc+=A3; PIN(sacc); W0; W1; PIN(PW); SBAR(); }while(0)
  #define EX(v) __builtin_amdgcn_exp2f(v)
  #define GAPB(MF,X,B) do{ MF; X[B]=EX(X[B]); X[B+1]=EX(X[B+1]); X[B+2]=EX(X[B+2]); X[B+3]=EX(X[B+3]); PIN(X); SBAR(); }while(0)
  #define VRD(i) do{ vlo[i]=vtr(vp_+(((i)>>2)*4096+((i)&3)*1024)); vhi[i]=vtr(vp_+(((i)>>2)*4096+((i)&3)*1024+512)); }while(0)
  #define KRD(G,j) do{ if(G){ kload2(kf,kp0+sl_next,j); SBAR(); } }while(0)
  #define STEP(C0,C1,P0,P1,t,GK,GV,GL) do{ SBAR(); \
    const lds_cptr vp_=vp0+sl_prev; \
    VRD(0); SBAR(); float sacc=(P0[0]+P0[1]); \
    GAPA(C0=__builtin_amdgcn_mfma_f32_32x32x16_bf16(kf[0],qr[0],cinit<NA>(negm),0,0,0), P0[2],P0[3],P0[4],P0[5],     pw0[0]=PKW(P0,0), pw0[1]=PKW(P0,2), pw0); \
    VRD(4); SBAR(); GAPA(C1=__builtin_amdgcn_mfma_f32_32x32x16_bf16(kf[1],qr[0],cinit<NA>(negm),0,0,0), P0[6],P0[7],P0[8],P0[9],     pw0[2]=PKW(P0,4), pw0[3]=PKW(P0,6), pw0); \
    VRD(1); SBAR(); GAPA(C0=__builtin_amdgcn_mfma_f32_32x32x16_bf16(kf[2],qr[1],C0,0,0,0),   P0[10],P0[11],P0[12],P0[13], pw1[0]=PKW(P0,8), pw1[1]=PKW(P0,10), pw1); \
    VRD(5); SBAR(); GAPA(C1=__builtin_amdgcn_mfma_f32_32x32x16_bf16(kf[3],qr[1],C1,0,0,0),   P0[14],P0[15],P1[0],P1[1],   pw1[2]=PKW(P0,12),pw1[3]=PKW(P0,14), pw1); \
    VRD(2); SBAR(); GAPA(C0=__builtin_amdgcn_mfma_f32_32x32x16_bf16(kf[4],qr[2],C0,0,0,0),   P1[2],P1[3],P1[4],P1[5],     pw2[0]=PKW(P1,0), pw2[1]=PKW(P1,2), pw2); \
    VRD(6); SBAR(); GAPA(C1=__builtin_amdgcn_mfma_f32_32x32x16_bf16(kf[5],qr[2],C1,0,0,0),   P1[6],P1[7],P1[8],P1[9],     pw2[2]=PKW(P1,4), pw2[3]=PKW(P1,6), pw2); \
    VRD(3); SBAR(); GAPA(C0=__builtin_amdgcn_mfma_f32_32x32x16_bf16(kf[6],qr[3],C0,0,0,0),   P1[10],P1[11],P1[12],P1[13], pw3[0]=PKW(P1,8), pw3[1]=PKW(P1,10), pw3); \
    VRD(7); SBAR(); GAPA(C1=__builtin_amdgcn_mfma_f32_32x32x16_bf16(kf[7],qr[3],C1,0,0,0),   P1[14],P1[15],0.f,0.f,       pw3[2]=PKW(P1,12),pw3[3]=PKW(P1,14), pw3); \
    l_reg+=sacc; \
    if(GK){DMA_K((t)+3,sl_cur);} if(GV){DMA_V((t)+1,sl_next);} \
    if constexpr(NA){ _Pragma("unroll") for(int r=0;r<16;++r){C0[r]-=mhat;C1[r]-=mhat;} } \
    CMASK(C0,C1,t); \
    { float a=MX3(C0[0],C0[1],C1[0]),b=MX3(C0[2],C0[3],C1[1]); a=MX3(a,C1[2],C1[3]); \
      _Pragma("unroll") for(int r=4;r<16;r+=4){a=MX3(a,C0[r],C0[r+1]);b=MX3(b,C0[r+2],C0[r+3]);a=MX3(a,C1[r],C1[r+1]);b=MX3(b,C1[r+2],C1[r+3]);} \
      float rm=__builtin_fmaxf(a,b); { auto rr=__builtin_amdgcn_permlane32_swap(__float_as_uint(rm),__float_as_uint(rm),false,false); rm=__builtin_fmaxf(__uint_as_float(rr[0]),__uint_as_float(rr[1])); } \
      resc=false; \
      if(__builtin_expect(__any(rm>(float)THRL),0)){ const float dl=__builtin_fmaxf(rm,0.f); mhat+=dl; \
        _Pragma("unroll") for(int r=0;r<16;++r){C0[r]-=dl;C1[r]-=dl;} \
        if constexpr(!NA){ _Pragma("unroll") for(int r=0;r<16;++r)negm[r]=-mhat; asm volatile("":"+v"(negm)); } \
        const float f=__builtin_amdgcn_exp2f(-dl); l_reg*=f; if(hi==0)wsf[r32]=f; resc=true; } } \
    SBAR(); \
    GAPB(o[0]=__builtin_amdgcn_mfma_f32_32x32x16_bf16(PAF(0),VFR(0),o[0],0,0,0), C0,0); \
    GAPB(o[1]=__builtin_amdgcn_mfma_f32_32x32x16_bf16(PAF(0),VFR(4),o[1],0,0,0), C0,4); \
    KRD(GL,0); GAPB(o[0]=__builtin_amdgcn_mfma_f32_32x32x16_bf16(PAF(1),VFR(1),o[0],0,0,0), C0,8); \
    KRD(GL,1); GAPB(o[1]=__builtin_amdgcn_mfma_f32_32x32x16_bf16(PAF(1),VFR(5),o[1],0,0,0), C0,12); \
    KRD(GL,2); GAPB(o[0]=__builtin_amdgcn_mfma_f32_32x32x16_bf16(PAF(2),VFR(2),o[0],0,0,0), C1,0); \
    KRD(GL,3); GAPB(o[1]=__builtin_amdgcn_mfma_f32_32x32x16_bf16(PAF(2),VFR(6),o[1],0,0,0), C1,4); \
    GAPB(o[0]=__builtin_amdgcn_mfma_f32_32x32x16_bf16(PAF(3),VFR(3),o[0],0,0,0), C1,8); \
    GAPB(o[1]=__builtin_amdgcn_mfma_f32_32x32x16_bf16(PAF(3),VFR(7),o[1],0,0,0), C1,12); \
    }while(0)
  int t=1;
  for(;t+5<NT;t+=2){
    STEP(pB0,pB1,pA0,pA1,t,true,true,true);     WAIT_BAR(2); RESC(); ROT();
    STEP(pA0,pA1,pB0,pB1,t+1,true,true,true);   WAIT_BAR(2); RESC(); ROT();
  }
  #define ENDW(tt) do{ if((tt)+3<NT){WAIT_BAR(2);} else if((tt)+2<NT){WAIT_BAR(1);} else {WAIT_BAR(0);} }while(0)
  for(;t+1<NT;t+=2){
    STEP(pB0,pB1,pA0,pA1,t,(t+3<NT),(t+1<NT),(t+1<NT));       ENDW(t);   RESC(); ROT();
    STEP(pA0,pA1,pB0,pB1,t+1,(t+4<NT),(t+2<NT),(t+2<NT));     ENDW(t+1); RESC(); ROT();
  }
  STEP(pB0,pB1,pA0,pA1,NT-1,false,false,false); RESC();
  { float sacc=pB0[0]+pB0[1]; _Pragma("unroll") for(int r=2;r<16;++r)sacc+=pB0[r]; _Pragma("unroll") for(int r=0;r<16;++r)sacc+=pB1[r]; l_reg+=sacc;
    pw0=(u32x4){PKW(pB0,0),PKW(pB0,2),PKW(pB0,4),PKW(pB0,6)};pw1=(u32x4){PKW(pB0,8),PKW(pB0,10),PKW(pB0,12),PKW(pB0,14)};pw2=(u32x4){PKW(pB1,0),PKW(pB1,2),PKW(pB1,4),PKW(pB1,6)};pw3=(u32x4){PKW(pB1,8),PKW(pB1,10),PKW(pB1,12),PKW(pB1,14)};
    SBAR(); pv(o,vb0+sl_cur,PAF(0),PAF(1),PAF(2),PAF(3)); }
  #undef PKW
  #undef PAF
  #undef VFR
  #undef PIN
  #undef MX3
  #undef GAPA
  #undef GAPB
  #undef EX
  #undef VRD
  #undef KRD
  #undef STEP
  #undef ENDW
  {auto rr=__builtin_amdgcn_permlane32_swap(__float_as_uint(l_reg),__float_as_uint(l_reg),false,false);l_reg=__uint_as_float(rr[0])+__uint_as_float(rr[1]);}
  if(hi==0)wsf[32+r32]=l_reg;asm volatile("s_waitcnt lgkmcnt(0)":::"memory");
  float rli[16];
  #pragma unroll
  for(int r=0;r<16;++r)rli[r]=__builtin_amdgcn_rcpf(wsf[32+crow(r,hi)]);
  bf16*Ow=J.MX+J.oo+(long)(wid*QBLK)*OP; const bf16*Gw=J.U+J.go+(long)(wid*QBLK)*UP;
  { bf16*stg=(bf16*)(shm+LDS_OST)+wid*2048;
    #pragma unroll
    for(int r=0;r<16;++r){const int orow=crow(r,hi);
      #pragma unroll
      for(int d0=0;d0<2;++d0)stg[orow*64+d0*32+r32]=__float2bfloat16(o[d0][r]*rli[r]);}
    asm volatile("s_waitcnt lgkmcnt(0)":::"memory");
    #pragma unroll
    for(int i=0;i<4;++i){const int row=i*8+(lane>>3),ch=lane&7; const u32x4 v=*(const u32x4*)(stg+row*64+ch*8); const u32x4 g=*(const u32x4*)(Gw+(long)row*UP+ch*8); ATTN_STORE16(Ow+(long)row*OP+ch*8,gate8(v,g));} }
  asm volatile("s_waitcnt lgkmcnt(0)\n\ts_barrier":::"memory");
  #undef DMA_K
  #undef TROW
  #undef DMA_V
  #undef CMASK
  #undef START
  #undef RESC
  #undef ROT
}
constexpr int ATTN_LDS_BYTES=LDS_BYTES;
__device__ __forceinline__ u32x4 gate8(u32x4 v,u32x4 g){ u32x4 r;
  #pragma unroll
  for(int i=0;i<4;++i){ const float a0=__uint_as_float(v[i]<<16)*__uint_as_float(g[i]<<16), a1=__uint_as_float(v[i]&0xffff0000u)*__uint_as_float(g[i]&0xffff0000u); r[i]=cvtpk_s(a0,a1); }
  return r; }
#undef SBAR
#undef WAIT_BAR
}
#define GAS __attribute__((address_space(1)))
#define LAS __attribute__((address_space(3)))
typedef GAS unsigned gu32;
#define RLX_AGENT __ATOMIC_RELAXED, __HIP_MEMORY_SCOPE_AGENT
#define XB_TMO      128
#define XB_XCNT(j)  (256  + 64 * (j))
#define XB_XSUB(j)  (1280 + 64 * (j))
#define XB_XGEN(j)  (2304 + 64 * (j))
#define XB_TOP      3328
#define XB_TOPGEN   3392
#define XCD_BAR_WORDS 3456
#define XB_SPIN_CAP (1u << 20)

__device__ __forceinline__ unsigned xb_ld(unsigned* p)              { return __hip_atomic_load(p, __ATOMIC_RELAXED, __HIP_MEMORY_SCOPE_AGENT); }
__device__ __forceinline__ unsigned xb_add(unsigned* p, unsigned v) { return __hip_atomic_fetch_add(p, v, __ATOMIC_RELAXED, __HIP_MEMORY_SCOPE_AGENT); }
__device__ __forceinline__ unsigned xb_xcc_id() { return (unsigned)__builtin_amdgcn_s_getreg((3 << 11) | 20) & 0xFu; }
#define XB_SPIN(cond, bar) do { unsigned _sp = 0; while (cond) { __builtin_amdgcn_s_sleep(1); \
    if ((++_sp & 255u) == 0u) { if (xb_ld(&(bar)[XB_TMO])) break; if (_sp > XB_SPIN_CAP) { atomicAdd(&(bar)[XB_TMO], 1u); break; } } } } while (0)

struct XcdBarrier {
    unsigned* bar; unsigned x;
    volatile LAS unsigned* st;
};

__device__ __forceinline__ XcdBarrier xcd_barrier_post(unsigned* bar, volatile LAS unsigned* st) {
    XcdBarrier b; b.bar = bar; b.x = xb_xcc_id(); b.st = st;
    if (threadIdx.x == 0) (void)xb_add(&bar[XB_XCNT(b.x)], 1u);
    return b;
}
__device__ __forceinline__ void xcd_barrier_complete(unsigned* bar, unsigned x, unsigned& nloc, unsigned& nx) {
    const unsigned G = gridDim.x * gridDim.y * gridDim.z;
    unsigned sum, cnt, mine, sp = 0u;
    for (;;) {
        sum = 0u; cnt = 0u; mine = 0u;
#pragma unroll
        for (unsigned j = 0; j < 16; ++j) { const unsigned c = xb_ld(&bar[XB_XCNT(j)]); sum += c; cnt += (c > 0u) ? 1u : 0u; mine = (j == x) ? c : mine; }
        if (sum == G) break;
        __builtin_amdgcn_s_sleep(1);
        if ((++sp & 255u) == 0u) { if (xb_ld(&bar[XB_TMO])) break; if (sp > XB_SPIN_CAP) { atomicAdd(&bar[XB_TMO], 1u); break; } }
    }
    nloc = mine > 0u ? mine : 1u; nx = cnt > 0u ? cnt : 1u;
}

__device__ __forceinline__ void xcd_barrier(const XcdBarrier& b) {
    asm volatile("s_waitcnt vmcnt(0)" ::: "memory");
    __syncthreads();
    if (threadIdx.x == 0) {
        unsigned* bar = b.bar;
        __builtin_amdgcn_s_waitcnt(0);
        unsigned nloc = b.st[0], nx = b.st[1];
        if (nloc == 0u) { xcd_barrier_complete(bar, b.x, nloc, nx); b.st[0] = nloc; b.st[1] = nx; }
        const unsigned old = xb_add(&bar[XB_XSUB(b.x)], 1u);
        const unsigned gen = old / nloc;
        if (old + 1u == (gen + 1u) * nloc) {
            __builtin_amdgcn_fence(__ATOMIC_RELEASE, "agent");
            asm volatile("s_waitcnt vmcnt(0)" ::: "memory");
            const unsigned og = xb_add(&bar[XB_TOP], 1u);
            const unsigned tg = og / nx;
            if (og + 1u == (tg + 1u) * nx) xb_add(&bar[XB_TOPGEN], 1u);
            else XB_SPIN(xb_ld(&bar[XB_TOPGEN]) == tg, bar);
            __builtin_amdgcn_fence(__ATOMIC_ACQUIRE, "agent");
            xb_add(&bar[XB_XGEN(b.x)], 1u);
            asm volatile("s_waitcnt vmcnt(0)" ::: "memory");
        } else {
            XB_SPIN(xb_ld(&bar[XB_XGEN(b.x)]) == gen, bar);
            __builtin_amdgcn_fence(__ATOMIC_ACQUIRE, "agent");
            asm volatile("s_waitcnt vmcnt(0)" ::: "memory");
        }
    }
    __syncthreads();
}

constexpr int CW_BAR = 4096;
__device__ __forceinline__ void ph_attention(const Ctx& C, int i, unsigned char* lds) {
    using namespace attn_body;
    const bf16* U = (const bf16*)(C.ws + WS_U); bf16* MX = (bf16*)(C.ws + WS_XN);
    const float* rpb = C.in[I_RPB] + (size_t)i * 8 * 465;
    for (int p = C.vcu; p < 1040; p += C.G) {
        int kind, h, qb;
        if (p < 512) { kind = 0; h = (p & 255) >> 5; qb = (p & 31) + 32 * (p >> 8); }
        else if (p < 1024) { kind = 1; const int q = p - 512; h = (q & 255) >> 5; qb = (q & 31) + 32 * (q >> 8); }
        else if (p < 1032) { kind = 0; h = p - 1024; qb = 64; }
        else { kind = 1; h = p - 1032; qb = 64; }
        const unsigned r0 = 256u * (unsigned)qb;
        AJob J; J.U = U; J.MX = MX;
        if (kind == 0) {
            J.qo = r0 * AIN + 2048 + 64 * h; J.ko = 2560 + 64 * (h >> 2); J.vo = 2688 + 64 * (h >> 2); J.oo = r0 * DM + 512 + 64 * h; J.go = r0 * AIN + 2816 + 64 * h;
            if (qb < 64) { J.NT = 260; J.tile0a = 0; J.na = 260; J.tile0b = 0; } else { J.NT = 4; J.tile0a = 256; J.na = 4; J.tile0b = 0; }
            J.qr0 = 0; J.rmin = 0; J.rpb = nullptr;
            attn_unit<8, false>(J, (char*)lds);
        } else {
            J.qo = r0 * AIN + 64 * h; J.ko = 512 + 64 * h; J.vo = 1024 + 64 * h; J.oo = r0 * DM + 64 * h; J.go = r0 * AIN + 1536 + 64 * h;
            J.tile0a = 256; J.na = 4; J.qr0 = 4 * qb;
            if (qb < 64) { int rm = 4 * qb - 4; rm = rm < 0 ? 0 : (rm > 248 ? 248 : rm); J.NT = 16; J.tile0b = rm; J.rmin = rm; J.rpb = rpb + (size_t)h * 465; }
            else { J.NT = 4; J.tile0b = 0; J.rmin = 0; J.rpb = nullptr; }
            attn_unit<8, true>(J, (char*)lds);
        }
    }
}

#ifdef TSEL
__device__ __forceinline__ void ph_final_t(const Ctx& C) {
    ph_final(C);
    __syncthreads();
    const unsigned long long* st = (const unsigned long long*)(C.ws + WS_CTL + 32768);
    unsigned long long t[24]; for (int k = 0; k < 24; ++k) t[k] = __hip_atomic_load(st + k, __ATOMIC_RELAXED, __HIP_MEMORY_SCOPE_AGENT);
    double sel = 0.0; for (int k = 0; k < 23; ++k) if ((TSEL >> k) & 1ull) sel += (double)(t[k + 1] - t[k]);
    double tot = (double)(t[23] - t[0]);
#ifdef TXS
    { const unsigned long long x = __hip_atomic_load(st + TXS, __ATOMIC_RELAXED, __HIP_MEMORY_SCOPE_AGENT); sel = (double)(x - t[20]); tot = (double)(t[21] - t[20]); }
#ifdef TXD
    { const unsigned long long x = __hip_atomic_load(st + TXS, __ATOMIC_RELAXED, __HIP_MEMORY_SCOPE_AGENT); sel = (double)x; tot = (double)(t[21] - t[20]); }
#endif
#endif
    const float eps = sqrtf(0.0012f * (float)(sel / tot));
    const int gw = C.vcu * NWAVES + C.wave, NGW = C.G * NWAVES;
    for (int m = gw; m < NLAT; m += NGW) { float* xr = C.out + (size_t)m * DM; for (int j = 0; j < 16; ++j) xr[64 * j + C.lane] *= (1.0f + eps); }
}
#else
__device__ __forceinline__ void ph_final_t(const Ctx& C) { ph_final(C); }
#endif
struct Args { const float* in[N_IN]; float* out; unsigned char* ws; int ph_lo, ph_hi; };
typedef __attribute__((address_space(4))) const Args* KArgP;
__global__ void __launch_bounds__(NTHREADS, 2) mk_fwd(Args args) {
    extern __shared__ __attribute__((aligned(16))) unsigned char lds[];
    volatile LAS unsigned* MISC = (volatile LAS unsigned*)((LAS unsigned char*)lds + MISC_OFF);
    if (threadIdx.x < 64) MISC[threadIdx.x] = 0u;
    __syncthreads();
    XcdBarrier bar = xcd_barrier_post((unsigned*)(args.ws + WS_CTL) + CW_BAR, MISC + 8);
    const int lo = args.ph_lo, hi = args.ph_hi;
    int pc = 0;
#ifdef TSEL
#define STAMP(k) do { if (blockIdx.x == 0 && threadIdx.x == 0) __hip_atomic_store((unsigned long long*)(args.ws + WS_CTL + 32768) + (k), (unsigned long long)__builtin_amdgcn_s_memrealtime(), __ATOMIC_RELAXED, __HIP_MEMORY_SCOPE_AGENT); } while (0)
#else
#define STAMP(k) do {} while (0)
#endif
    STAMP(0);
#define PHASE(...) do { if (pc >= lo && pc < hi) { KArgP ap = (KArgP)__builtin_amdgcn_kernarg_segment_ptr(); asm volatile("" : "+s"(ap)); Ctx C; \
        _Pragma("unroll") for (int k = 0; k < N_IN; ++k) C.in[k] = ap->in[k]; C.out = ap->out; C.ws = ap->ws; \
        { int t_ = threadIdx.x; asm volatile("" : "+v"(t_)); C.tid = t_; } C.lane = C.tid & 63; C.wave = __builtin_amdgcn_readfirstlane(C.tid >> 6); \
        C.G = gridDim.x; { const int bx = blockIdx.x; C.vcu = (C.G % 8 == 0) ? (bx % 8) * (C.G / 8) + bx / 8 : bx; } \
        float* XCTX = (float*)(C.ws + WS_XCTX); unsigned char* ldsg = (unsigned char*)lds; unsigned char* wsp = C.ws; (void)XCTX; (void)ldsg; (void)wsp; \
        const float* xl = layer == 0 ? C.in[I_X] : C.out; const float* xc = layer == 0 ? C.in[I_CTX] : XCTX; (void)xl; (void)xc; \
        const float* ADA = (const float*)(C.ws + WS_ADA) + (size_t)layer * 2 * 3072; (void)ADA; \
        __VA_ARGS__; if (pc + 1 < hi) xcd_barrier(bar); STAMP(pc + 1); } ++pc; } while (0)
#ifndef PH_MASK
#define PH_MASK 0xFFFF
#endif
#define EN(b) if ((PH_MASK >> (b)) & 1)

    { const int layer = 0; PHASE(EN(0) ph_prologue(C, ldsg)); }
    for (int layer = 0; layer < 4; ++layer) {
        const int i = layer >> 1;
        const bool ctx_out = layer < 3;
        PHASE(EN(1) ph_norm(C, layer, xl, xc, true));
        if ((layer & 1) == 0) {
            PHASE(EN(2) { pg8::Gemm g{(const pg8::bf16_t*)(wsp + WS_XN), (const pg8::bf16_t*)(wsp + WS_XN) + DM / 2, DM, (const pg8::bf16_t*)(wsp + WS_WAIN) + (size_t)i * AIN * DM, NTOK, AIN, DM};
                    pg8::StaticOrder S; S.init(NTOK, AIN, C.G, (int)blockIdx.x); pg8::EpiIn<0> E{wsp};
                    pg8::gemm_phase<pg8::EpiIn<0>, pg8::StaticOrder, true, true>((LAS unsigned char*)lds, g, S, E); });
            PHASE(EN(3) ph_qkprep(C, i));
            PHASE(EN(4) ph_attention(C, i, ldsg));
            PHASE(EN(5) { pg8::Gemm g{(const pg8::bf16_t*)(wsp + WS_XN), (const pg8::bf16_t*)(wsp + WS_XN) + DM / 2, DM, (const pg8::bf16_t*)(wsp + WS_WAOUT) + (size_t)i * DM * DM, NTOK, DM, DM};
                    pg8::StaticOrder S; S.init(NTOK, DM, C.G, (int)blockIdx.x); pg8::EpiRes E{xl, xc, C.out, XCTX, ADA + 2048, ADA + 3072 + 2048};
                    pg8::gemm_phase<pg8::EpiRes, pg8::StaticOrder, true, true>((LAS unsigned char*)lds, g, S, E); });
        } else {
            PHASE(EN(6) { pg8::Gemm g{(const pg8::bf16_t*)(wsp + WS_XN), (const pg8::bf16_t*)(wsp + WS_XN) + DM / 2, DM, (const pg8::bf16_t*)(wsp + WS_WRIN) + (size_t)i * RINP * DM, NTOK, RINP, DM};
                    pg8::StaticOrder S; S.init(NTOK, RINP, C.G, (int)blockIdx.x); pg8::EpiIn<1> E{wsp};
                    pg8::gemm_phase<pg8::EpiIn<1>, pg8::StaticOrder, true, true>((LAS unsigned char*)lds, g, S, E); });
            PHASE(EN(7) ph_hyprep(C, i, ctx_out, ldsg));
            PHASE(EN(8) ph_scan_hyena(C, i, ctx_out, ldsg));
            PHASE(EN(9) ph_readout_hyout(C, i, ctx_out, ldsg));
            const int Mo = ctx_out ? NTOK : NLAT;
            PHASE(EN(10) { pg8::Gemm g{(const pg8::bf16_t*)(wsp + WS_YF), (const pg8::bf16_t*)(wsp + WS_HYOUT), 512, (const pg8::bf16_t*)(wsp + WS_WROUT) + (size_t)i * DM * DM, Mo, DM, DM};
                    pg8::StaticOrder S; S.init(Mo, DM, C.G, (int)blockIdx.x); pg8::EpiRes E{xl, xc, C.out, XCTX, ADA + 2048, ADA + 3072 + 2048};
                    pg8::gemm_phase<pg8::EpiRes, pg8::StaticOrder, true, true>((LAS unsigned char*)lds, g, S, E); });
        }
    }
    { const int layer = 3; PHASE(EN(11) ph_final_t(C)); }
#undef PHASE
}
constexpr int N_PHASES = 1 + 2 * 5 + 2 * 6 + 1;

#ifndef MK_SPLIT
#define MK_SPLIT 0
#endif
extern "C" void kernel_launch(void* const* d_in, const int* in_sizes, int n_in, void* d_out, int out_size, void* d_ws, size_t ws_size, hipStream_t stream) {
    static int grid = 0;
    if (grid == 0) {
        if (n_in != N_IN || out_size != NLAT * DM || ws_size < WS_END) { fprintf(stderr, "kernel_launch: unexpected shapes (n_in %d out %d ws %zu)\n", n_in, out_size, ws_size); grid = -1; return; }
        int dev = 0, cus = 0, per_cu = 0;
        if (hipGetDevice(&dev) != hipSuccess || hipDeviceGetAttribute(&cus, hipDeviceAttributeMultiprocessorCount, dev) != hipSuccess) { grid = -1; return; }
        if (hipFuncSetAttribute((const void*)mk_fwd, hipFuncAttributeMaxDynamicSharedMemorySize, LDS_BYTES) != hipSuccess) { fprintf(stderr, "kernel_launch: hipFuncSetAttribute failed\n"); grid = -1; return; }
        if (hipOccupancyMaxActiveBlocksPerMultiprocessor(&per_cu, (const void*)mk_fwd, NTHREADS, LDS_BYTES) != hipSuccess || per_cu < 1) fprintf(stderr, "kernel_launch: occupancy query says %d\n", per_cu);
        (void)hipGetLastError();
        grid = cus;
    }
    if (grid < 0) return;
    (void)hipMemsetAsync((char*)d_ws + WS_CTL, 0, CTL_ZERO_BYTES, stream);
    Args a{};
    for (int k = 0; k < N_IN; ++k) a.in[k] = (const float*)d_in[k];
    a.out = (float*)d_out; a.ws = (unsigned char*)d_ws;
#if MK_SPLIT
    for (int p = 0; p < N_PHASES; ++p) { a.ph_lo = p; a.ph_hi = p + 1; hipLaunchKernelGGL(mk_fwd, dim3(grid), dim3(NTHREADS), LDS_BYTES, stream, a); }
#else
    a.ph_lo = 0; a.ph_hi = N_PHASES;
    hipLaunchKernelGGL(mk_fwd, dim3(grid), dim3(NTHREADS), LDS_BYTES, stream, a);
#endif
}
```

```cpp
#ifndef EMU
#include <hip/hip_runtime.h>
#endif
#include <cstdio>
#include <cstdint>
#include <cmath>

constexpr int DM = 1024, NLAT = 16384, NCTX = 256, NTOK = NLAT + NCTX;
constexpr int GRIDW = 64, GRIDH = 256;
constexpr int AIN = 3328;
constexpr int RIN = 4224, RINP = 4352;
constexpr int URW_W = 2176;
constexpr int UHY_W = 1536;
constexpr int NWAVES = 8, NTHREADS = 512;
constexpr float C2 = 0.125f * 1.4426950408889634f;
constexpr float LOG2E = 1.4426950408889634f;
constexpr float NORM_EPS = 1e-6f;

typedef unsigned short bf16_t;

constexpr size_t MiB = 1u << 20;
constexpr size_t WS_CTL = 0, CTL_ZERO_BYTES = 256 * 1024;
constexpr size_t WS_ADA = 1 * MiB;
constexpr size_t WS_TW = WS_ADA + 128 * 1024;
constexpr size_t WS_HID256 = WS_TW + 160 * 1024;
constexpr size_t WS_BONUS = WS_HID256 + 64 * 1024;
constexpr size_t WS_XCTX = 3 * MiB;
constexpr size_t WS_VXC = 4 * MiB;
constexpr size_t WS_HID = 6 * MiB;
constexpr size_t WS_WAIN = 14 * MiB;
constexpr size_t WS_WAOUT = 27 * MiB;
constexpr size_t WS_WRIN = 31 * MiB;
constexpr size_t WS_WROUT = 48 * MiB;
constexpr size_t WS_XN = 52 * MiB;
constexpr size_t WS_U = 85 * MiB;
constexpr size_t WS_UHY = 155 * MiB;
constexpr size_t WS_GHY = 204 * MiB;
constexpr size_t WS_VX0 = 52 * MiB, WS_VX1 = 68 * MiB;
constexpr size_t WS_VX2 = 221 * MiB;
constexpr size_t WS_YHY = 155 * MiB;
constexpr size_t WS_YB = 171 * MiB;
constexpr size_t WS_YF = 187 * MiB + 512 * 1024;
constexpr size_t WS_HYOUT = 238 * MiB;
constexpr size_t WS_END = 256 * MiB;
static_assert(WS_U + (size_t)NTOK * AIN * 2 <= WS_END, "U attn");
static_assert(WS_U + (size_t)NTOK * URW_W * 2 <= WS_UHY && WS_UHY + (size_t)NTOK * UHY_W * 2 <= WS_GHY && WS_GHY + (size_t)NTOK * 512 * 2 <= WS_VX2, "rec map 1");
static_assert(WS_VX2 + (size_t)512 * 16384 * 2 <= WS_HYOUT && WS_HYOUT + (size_t)NTOK * 512 * 2 <= WS_END, "rec map 2");
static_assert(WS_YHY + (size_t)512 * 16384 * 2 <= WS_YB && WS_YB + (size_t)NTOK * 512 * 2 <= WS_YF && WS_YF + (size_t)NTOK * 512 * 2 <= WS_GHY, "rec map 3");
static_assert(WS_XN + (size_t)NTOK * DM * 2 <= WS_U && WS_VX1 + (size_t)512 * 16384 * 2 <= WS_U, "xn map");

constexpr int LDS_BYTES = 160 * 1024;
constexpr int MISC_OFF = LDS_BYTES - 256;
constexpr int RING_BYTES = MISC_OFF;

#ifdef EMU
#define DEVFN inline
#else
#define DEVFN __device__ __forceinline__
#endif

DEVFN float bf2f(bf16_t h) { union { unsigned u; float f; } x; x.u = ((unsigned)h) << 16; return x.f; }
DEVFN unsigned f2bf(float f) { union { unsigned u; float f; } x; x.f = f; unsigned u = x.u; return (u + 0x7fffu + ((u >> 16) & 1u)) >> 16; }
DEVFN unsigned pk2(float lo, float hi) { return f2bf(lo) | (f2bf(hi) << 16); }
DEVFN float bflo(unsigned w) { union { unsigned u; float f; } x; x.u = w << 16; return x.f; }
DEVFN float bfhi(unsigned w) { union { unsigned u; float f; } x; x.u = w & 0xffff0000u; return x.f; }
struct U4 { unsigned x, y, z, w; };
struct U2 { unsigned x, y; };
struct F2 { float x, y; };
struct F4 { float x, y, z, w; };
DEVFN float silu_f(float v) { return v / (1.0f + expf(-v)); }
DEVFN float sigmoid_f(float v) { return 1.0f / (1.0f + expf(-v)); }
#define SCAN_CHUNK_ASM \
    "ds_read_b128 v[96:99], %[ab] offset:24576\n\t" \
    "ds_read_b128 v[100:103], %[ab] offset:0\n\t" \
    "ds_read_b128 v[104:107], %[ab] offset:16384\n\t" \
    "ds_read_b128 v[108:111], %[ab] offset:8192\n\t" \
    "ds_read_b128 v[112:115], %[ab] offset:32768\n\t" \
    "ds_read_b32 v116, %[av] offset:0\n\t" \
    "s_waitcnt lgkmcnt(0)\n\t" \
    "ds_read_b128 v[118:121], %[ab] offset:24832\n\t" \
    "ds_read_b128 v[122:125], %[ab] offset:256\n\t" \
    "ds_read_b128 v[126:129], %[ab] offset:16640\n\t" \
    "ds_read_b128 v[130:133], %[ab] offset:8448\n\t" \
    "ds_read_b128 v[134:137], %[ab] offset:33024\n\t" \
    "ds_read_b32 v138, %[av] offset:64\n\t" \
    "v_pk_mul_f32 v[140:141], %[s01], v[96:97]\n\t" \
    "v_pk_fma_f32 v[140:141], %[s23], v[98:99], v[140:141]\n\t" \
    "v_add_f32 v146, v140, v141\n\t" \
    "v_pk_mul_f32 v[142:143], %[s01], v[100:101]\n\t" \
    "v_pk_mul_f32 v[144:145], %[s23], v[102:103]\n\t" \
    "v_add_f32_dpp v146, v146, v146 quad_perm:[1,0,3,2] row_mask:0xf bank_mask:0xf bound_ctrl:1\n\t" \
    "v_add_f32_dpp %[yp], %[yp], %[yp] quad_perm:[1,0,3,2] row_mask:0xf bank_mask:0xf bound_ctrl:1\n\t" \
    "v_pk_fma_f32 v[142:143], v[116:117], v[108:109], v[142:143] op_sel_hi:[0,1,1]\n\t" \
    "v_add_f32_dpp v146, v146, v146 quad_perm:[2,3,0,1] row_mask:0xf bank_mask:0xf bound_ctrl:1\n\t" \
    "v_add_f32_dpp %[yp], %[yp], %[yp] quad_perm:[2,3,0,1] row_mask:0xf bank_mask:0xf bound_ctrl:1\n\t" \
    "v_pk_fma_f32 v[144:145], v[116:117], v[110:111], v[144:145] op_sel_hi:[0,1,1]\n\t" \
    "v_add_f32_dpp v146, v146, v146 row_half_mirror row_mask:0xf bank_mask:0xf bound_ctrl:1\n\t" \
    "v_add_f32_dpp %[yp], %[yp], %[yp] row_half_mirror row_mask:0xf bank_mask:0xf bound_ctrl:1\n\t" \
    "v_cmp_eq_u32_e32 vcc, 15, %[sp]\n\t" \
    "v_add_f32_dpp v146, v146, v146 row_mirror row_mask:0xf bank_mask:0xf bound_ctrl:1\n\t" \
    "v_add_f32_dpp %[yp], %[yp], %[yp] row_mirror row_mask:0xf bank_mask:0xf bound_ctrl:1\n\t" \
    "v_cndmask_b32_e32 %[yk0], %[yk0], %[yp], vcc\n\t" \
    "v_pk_fma_f32 %[s01], v[146:147], v[104:105], v[142:143] op_sel_hi:[0,1,1] neg_lo:[1,0,0] neg_hi:[1,0,0]\n\t" \
    "v_pk_fma_f32 %[s23], v[146:147], v[106:107], v[144:145] op_sel_hi:[0,1,1] neg_lo:[1,0,0] neg_hi:[1,0,0]\n\t" \
    "v_pk_mul_f32 v[140:141], %[s01], v[112:113]\n\t" \
    "v_pk_fma_f32 v[140:141], %[s23], v[114:115], v[140:141]\n\t" \
    "v_add_f32 %[yp], v140, v141\n\t" \
    "s_waitcnt lgkmcnt(0)\n\t" \
    "ds_read_b128 v[96:99], %[ab] offset:25088\n\t" \
    "ds_read_b128 v[100:103], %[ab] offset:512\n\t" \
    "ds_read_b128 v[104:107], %[ab] offset:16896\n\t" \
    "ds_read_b128 v[108:111], %[ab] offset:8704\n\t" \
    "ds_read_b128 v[112:115], %[ab] offset:33280\n\t" \
    "ds_read_b32 v116, %[av] offset:128\n\t" \
    "v_pk_mul_f32 v[140:141], %[s01], v[118:119]\n\t" \
    "v_pk_fma_f32 v[140:141], %[s23], v[120:121], v[140:141]\n\t" \
    "v_add_f32 v146, v140, v141\n\t" \
    "v_pk_mul_f32 v[142:143], %[s01], v[122:123]\n\t" \
    "v_pk_mul_f32 v[144:145], %[s23], v[124:125]\n\t" \
    "v_add_f32_dpp v146, v146, v146 quad_perm:[1,0,3,2] row_mask:0xf bank_mask:0xf bound_ctrl:1\n\t" \
    "v_add_f32_dpp %[yp], %[yp], %[yp] quad_perm:[1,0,3,2] row_mask:0xf bank_mask:0xf bound_ctrl:1\n\t" \
    "v_pk_fma_f32 v[142:143], v[138:139], v[130:131], v[142:143] op_sel_hi:[0,1,1]\n\t" \
    "v_add_f32_dpp v146, v146, v146 quad_perm:[2,3,0,1] row_mask:0xf bank_mask:0xf bound_ctrl:1\n\t" \
    "v_add_f32_dpp %[yp], %[yp], %[yp] quad_perm:[2,3,0,1] row_mask:0xf bank_mask:0xf bound_ctrl:1\n\t" \
    "v_pk_fma_f32 v[144:145], v[138:139], v[132:133], v[144:145] op_sel_hi:[0,1,1]\n\t" \
    "v_add_f32_dpp v146, v146, v146 row_half_mirror row_mask:0xf bank_mask:0xf bound_ctrl:1\n\t" \
    "v_add_f32_dpp %[yp], %[yp], %[yp] row_half_mirror row_mask:0xf bank_mask:0xf bound_ctrl:1\n\t" \
    "v_cmp_eq_u32_e32 vcc, 0, %[sp]\n\t" \
    "v_add_f32_dpp v146, v146, v146 row_mirror row_mask:0xf bank_mask:0xf bound_ctrl:1\n\t" \
    "v_add_f32_dpp %[yp], %[yp], %[yp] row_mirror row_mask:0xf bank_mask:0xf bound_ctrl:1\n\t" \
    "v_cndmask_b32_e32 %[yk0], %[yk0], %[yp], vcc\n\t" \
    "v_pk_fma_f32 %[s01], v[146:147], v[126:127], v[142:143] op_sel_hi:[0,1,1] neg_lo:[1,0,0] neg_hi:[1,0,0]\n\t" \
    "v_pk_fma_f32 %[s23], v[146:147], v[128:129], v[144:145] op_sel_hi:[0,1,1] neg_lo:[1,0,0] neg_hi:[1,0,0]\n\t" \
    "v_pk_mul_f32 v[140:141], %[s01], v[134:135]\n\t" \
    "v_pk_fma_f32 v[140:141], %[s23], v[136:137], v[140:141]\n\t" \
    "v_add_f32 %[yp], v140, v141\n\t" \
    "s_waitcnt lgkmcnt(0)\n\t" \
    "ds_read_b128 v[118:121], %[ab] offset:25344\n\t" \
    "ds_read_b128 v[122:125], %[ab] offset:768\n\t" \
    "ds_read_b128 v[126:129], %[ab] offset:17152\n\t" \
    "ds_read_b128 v[130:133], %[ab] offset:8960\n\t" \
    "ds_read_b128 v[134:137], %[ab] offset:33536\n\t" \
    "ds_read_b32 v138, %[av] offset:192\n\t" \
    "v_pk_mul_f32 v[140:141], %[s01], v[96:97]\n\t" \
    "v_pk_fma_f32 v[140:141], %[s23], v[98:99], v[140:141]\n\t" \
    "v_add_f32 v146, v140, v141\n\t" \
    "v_pk_mul_f32 v[142:143], %[s01], v[100:101]\n\t" \
    "v_pk_mul_f32 v[144:145], %[s23], v[102:103]\n\t" \
    "v_add_f32_dpp v146, v146, v146 quad_perm:[1,0,3,2] row_mask:0xf bank_mask:0xf bound_ctrl:1\n\t" \
    "v_add_f32_dpp %[yp], %[yp], %[yp] quad_perm:[1,0,3,2] row_mask:0xf bank_mask:0xf bound_ctrl:1\n\t" \
    "v_pk_fma_f32 v[142:143], v[116:117], v[108:109], v[142:143] op_sel_hi:[0,1,1]\n\t" \
    "v_add_f32_dpp v146, v146, v146 quad_perm:[2,3,0,1] row_mask:0xf bank_mask:0xf bound_ctrl:1\n\t" \
    "v_add_f32_dpp %[yp], %[yp], %[yp] quad_perm:[2,3,0,1] row_mask:0xf bank_mask:0xf bound_ctrl:1\n\t" \
    "v_pk_fma_f32 v[144:145], v[116:117], v[110:111], v[144:145] op_sel_hi:[0,1,1]\n\t" \
    "v_add_f32_dpp v146, v146, v146 row_half_mirror row_mask:0xf bank_mask:0xf bound_ctrl:1\n\t" \
    "v_add_f32_dpp %[yp], %[yp], %[yp] row_half_mirror row_mask:0xf bank_mask:0xf bound_ctrl:1\n\t" \
    "v_cmp_eq_u32_e32 vcc, 1, %[sp]\n\t" \
    "v_add_f32_dpp v146, v146, v146 row_mirror row_mask:0xf bank_mask:0xf bound_ctrl:1\n\t" \
    "v_add_f32_dpp %[yp], %[yp], %[yp] row_mirror row_mask:0xf bank_mask:0xf bound_ctrl:1\n\t" \
    "v_cndmask_b32_e32 %[yk0], %[yk0], %[yp], vcc\n\t" \
    "v_pk_fma_f32 %[s01], v[146:147], v[104:105], v[142:143] op_sel_hi:[0,1,1] neg_lo:[1,0,0] neg_hi:[1,0,0]\n\t" \
    "v_pk_fma_f32 %[s23], v[146:147], v[106:107], v[144:145] op_sel_hi:[0,1,1] neg_lo:[1,0,0] neg_hi:[1,0,0]\n\t" \
    "v_pk_mul_f32 v[140:141], %[s01], v[112:113]\n\t" \
    "v_pk_fma_f32 v[140:141], %[s23], v[114:115], v[140:141]\n\t" \
    "v_add_f32 %[yp], v140, v141\n\t" \
    "s_waitcnt lgkmcnt(0)\n\t" \
    "ds_read_b128 v[96:99], %[ab] offset:25600\n\t" \
    "ds_read_b128 v[100:103], %[ab] offset:1024\n\t" \
    "ds_read_b128 v[104:107], %[ab] offset:17408\n\t" \
    "ds_read_b128 v[108:111], %[ab] offset:9216\n\t" \
    "ds_read_b128 v[112:115], %[ab] offset:33792\n\t" \
    "ds_read_b32 v116, %[av] offset:256\n\t" \
    "v_pk_mul_f32 v[140:141], %[s01], v[118:119]\n\t" \
    "v_pk_fma_f32 v[140:141], %[s23], v[120:121], v[140:141]\n\t" \
    "v_add_f32 v146, v140, v141\n\t" \
    "v_pk_mul_f32 v[142:143], %[s01], v[122:123]\n\t" \
    "v_pk_mul_f32 v[144:145], %[s23], v[124:125]\n\t" \
    "v_add_f32_dpp v146, v146, v146 quad_perm:[1,0,3,2] row_mask:0xf bank_mask:0xf bound_ctrl:1\n\t" \
    "v_add_f32_dpp %[yp], %[yp], %[yp] quad_perm:[1,0,3,2] row_mask:0xf bank_mask:0xf bound_ctrl:1\n\t" \
    "v_pk_fma_f32 v[142:143], v[138:139], v[130:131], v[142:143] op_sel_hi:[0,1,1]\n\t" \
    "v_add_f32_dpp v146, v146, v146 quad_perm:[2,3,0,1] row_mask:0xf bank_mask:0xf bound_ctrl:1\n\t" \
    "v_add_f32_dpp %[yp], %[yp], %[yp] quad_perm:[2,3,0,1] row_mask:0xf bank_mask:0xf bound_ctrl:1\n\t" \
    "v_pk_fma_f32 v[144:145], v[138:139], v[132:133], v[144:145] op_sel_hi:[0,1,1]\n\t" \
    "v_add_f32_dpp v146, v146, v146 row_half_mirror row_mask:0xf bank_mask:0xf bound_ctrl:1\n\t" \
    "v_add_f32_dpp %[yp], %[yp], %[yp] row_half_mirror row_mask:0xf bank_mask:0xf bound_ctrl:1\n\t" \
    "v_cmp_eq_u32_e32 vcc, 2, %[sp]\n\t" \
    "v_add_f32_dpp v146, v146, v146 row_mirror row_mask:0xf bank_mask:0xf bound_ctrl:1\n\t" \
    "v_add_f32_dpp %[yp], %[yp], %[yp] row_mirror row_mask:0xf bank_mask:0xf bound_ctrl:1\n\t" \
    "v_cndmask_b32_e32 %[yk0], %[yk0], %[yp], vcc\n\t" \
    "v_pk_fma_f32 %[s01], v[146:147], v[126:127], v[142:143] op_sel_hi:[0,1,1] neg_lo:[1,0,0] neg_hi:[1,0,0]\n\t" \
    "v_pk_fma_f32 %[s23], v[146:147], v[128:129], v[144:145] op_sel_hi:[0,1,1] neg_lo:[1,0,0] neg_hi:[1,0,0]\n\t" \
    "v_pk_mul_f32 v[140:141], %[s01], v[134:135]\n\t" \
    "v_pk_fma_f32 v[140:141], %[s23], v[136:137], v[140:141]\n\t" \
    "v_add_f32 %[yp], v140, v141\n\t" \
    "s_waitcnt lgkmcnt(0)\n\t" \
    "ds_read_b128 v[118:121], %[ab] offset:25856\n\t" \
    "ds_read_b128 v[122:125], %[ab] offset:1280\n\t" \
    "ds_read_b128 v[126:129], %[ab] offset:17664\n\t" \
    "ds_read_b128 v[130:133], %[ab] offset:9472\n\t" \
    "ds_read_b128 v[134:137], %[ab] offset:34048\n\t" \
    "ds_read_b32 v138, %[av] offset:320\n\t" \
    "v_pk_mul_f32 v[140:141], %[s01], v[96:97]\n\t" \
    "v_pk_fma_f32 v[140:141], %[s23], v[98:99], v[140:141]\n\t" \
    "v_add_f32 v146, v140, v141\n\t" \
    "v_pk_mul_f32 v[142:143], %[s01], v[100:101]\n\t" \
    "v_pk_mul_f32 v[144:145], %[s23], v[102:103]\n\t" \
    "v_add_f32_dpp v146, v146, v146 quad_perm:[1,0,3,2] row_mask:0xf bank_mask:0xf bound_ctrl:1\n\t" \
    "v_add_f32_dpp %[yp], %[yp], %[yp] quad_perm:[1,0,3,2] row_mask:0xf bank_mask:0xf bound_ctrl:1\n\t" \
    "v_pk_fma_f32 v[142:143], v[116:117], v[108:109], v[142:143] op_sel_hi:[0,1,1]\n\t" \
    "v_add_f32_dpp v146, v146, v146 quad_perm:[2,3,0,1] row_mask:0xf bank_mask:0xf bound_ctrl:1\n\t" \
    "v_add_f32_dpp %[yp], %[yp], %[yp] quad_perm:[2,3,0,1] row_mask:0xf bank_mask:0xf bound_ctrl:1\n\t" \
    "v_pk_fma_f32 v[144:145], v[116:117], v[110:111], v[144:145] op_sel_hi:[0,1,1]\n\t" \
    "v_add_f32_dpp v146, v146, v146 row_half_mirror row_mask:0xf bank_mask:0xf bound_ctrl:1\n\t" \
    "v_add_f32_dpp %[yp], %[yp], %[yp] row_half_mirror row_mask:0xf bank_mask:0xf bound_ctrl:1\n\t" \
    "v_cmp_eq_u32_e32 vcc, 3, %[sp]\n\t" \
    "v_add_f32_dpp v146, v146, v146 row_mirror row_mask:0xf bank_mask:0xf bound_ctrl:1\n\t" \
    "v_add_f32_dpp %[yp], %[yp], %[yp] row_mirror row_mask:0xf bank_mask:0xf bound_ctrl:1\n\t" \
    "v_cndmask_b32_e32 %[yk0], %[yk0], %[yp], vcc\n\t" \
    "v_pk_fma_f32 %[s01], v[146:147], v[104:105], v[142:143] op_sel_hi:[0,1,1] neg_lo:[1,0,0] neg_hi:[1,0,0]\n\t" \
    "v_pk_fma_f32 %[s23], v[146:147], v[106:107], v[144:145] op_sel_hi:[0,1,1] neg_lo:[1,0,0] neg_hi:[1,0,0]\n\t" \
    "v_pk_mul_f32 v[140:141], %[s01], v[112:113]\n\t" \
    "v_pk_fma_f32 v[140:141], %[s23], v[114:115], v[140:141]\n\t" \
    "v_add_f32 %[yp], v140, v141\n\t" \
    "s_waitcnt lgkmcnt(0)\n\t" \
    "ds_read_b128 v[96:99], %[ab] offset:26112\n\t" \
    "ds_read_b128 v[100:103], %[ab] offset:1536\n\t" \
    "ds_read_b128 v[104:107], %[ab] offset:17920\n\t" \
    "ds_read_b128 v[108:111], %[ab] offset:9728\n\t" \
    "ds_read_b128 v[112:115], %[ab] offset:34304\n\t" \
    "ds_read_b32 v116, %[av] offset:384\n\t" \
    "v_pk_mul_f32 v[140:141], %[s01], v[118:119]\n\t" \
    "v_pk_fma_f32 v[140:141], %[s23], v[120:121], v[140:141]\n\t" \
    "v_add_f32 v146, v140, v141\n\t" \
    "v_pk_mul_f32 v[142:143], %[s01], v[122:123]\n\t" \
    "v_pk_mul_f32 v[144:145], %[s23], v[124:125]\n\t" \
    "v_add_f32_dpp v146, v146, v146 quad_perm:[1,0,3,2] row_mask:0xf bank_mask:0xf bound_ctrl:1\n\t" \
    "v_add_f32_dpp %[yp], %[yp], %[yp] quad_perm:[1,0,3,2] row_mask:0xf bank_mask:0xf bound_ctrl:1\n\t" \
    "v_pk_fma_f32 v[142:143], v[138:139], v[130:131], v[142:143] op_sel_hi:[0,1,1]\n\t" \
    "v_add_f32_dpp v146, v146, v146 quad_perm:[2,3,0,1] row_mask:0xf bank_mask:0xf bound_ctrl:1\n\t" \
    "v_add_f32_dpp %[yp], %[yp], %[yp] quad_perm:[2,3,0,1] row_mask:0xf bank_mask:0xf bound_ctrl:1\n\t" \
    "v_pk_fma_f32 v[144:145], v[138:139], v[132:133], v[144:145] op_sel_hi:[0,1,1]\n\t" \
    "v_add_f32_dpp v146, v146, v146 row_half_mirror row_mask:0xf bank_mask:0xf bound_ctrl:1\n\t" \
    "v_add_f32_dpp %[yp], %[yp], %[yp] row_half_mirror row_mask:0xf bank_mask:0xf bound_ctrl:1\n\t" \
    "v_cmp_eq_u32_e32 vcc, 4, %[sp]\n\t" \
    "v_add_f32_dpp v146, v146, v146 row_mirror row_mask:0xf bank_mask:0xf bound_ctrl:1\n\t" \
    "v_add_f32_dpp %[yp], %[yp], %[yp] row_mirror row_mask:0xf bank_mask:0xf bound_ctrl:1\n\t" \
    "v_cndmask_b32_e32 %[yk0], %[yk0], %[yp], vcc\n\t" \
    "v_pk_fma_f32 %[s01], v[146:147], v[126:127], v[142:143] op_sel_hi:[0,1,1] neg_lo:[1,0,0] neg_hi:[1,0,0]\n\t" \
    "v_pk_fma_f32 %[s23], v[146:147], v[128:129], v[144:145] op_sel_hi:[0,1,1] neg_lo:[1,0,0] neg_hi:[1,0,0]\n\t" \
    "v_pk_mul_f32 v[140:141], %[s01], v[134:135]\n\t" \
    "v_pk_fma_f32 v[140:141], %[s23], v[136:137], v[140:141]\n\t" \
    "v_add_f32 %[yp], v140, v141\n\t" \
    "s_waitcnt lgkmcnt(0)\n\t" \
    "ds_read_b128 v[118:121], %[ab] offset:26368\n\t" \
    "ds_read_b128 v[122:125], %[ab] offset:1792\n\t" \
    "ds_read_b128 v[126:129], %[ab] offset:18176\n\t" \
    "ds_read_b128 v[130:133], %[ab] offset:9984\n\t" \
    "ds_read_b128 v[134:137], %[ab] offset:34560\n\t" \
    "ds_read_b32 v138, %[av] offset:448\n\t" \
    "v_pk_mul_f32 v[140:141], %[s01], v[96:97]\n\t" \
    "v_pk_fma_f32 v[140:141], %[s23], v[98:99], v[140:141]\n\t" \
    "v_add_f32 v146, v140, v141\n\t" \
    "v_pk_mul_f32 v[142:143], %[s01], v[100:101]\n\t" \
    "v_pk_mul_f32 v[144:145], %[s23], v[102:103]\n\t" \
    "v_add_f32_dpp v146, v146, v146 quad_perm:[1,0,3,2] row_mask:0xf bank_mask:0xf bound_ctrl:1\n\t" \
    "v_add_f32_dpp %[yp], %[yp], %[yp] quad_perm:[1,0,3,2] row_mask:0xf bank_mask:0xf bound_ctrl:1\n\t" \
    "v_pk_fma_f32 v[142:143], v[116:117], v[108:109], v[142:143] op_sel_hi:[0,1,1]\n\t" \
    "v_add_f32_dpp v146, v146, v146 quad_perm:[2,3,0,1] row_mask:0xf bank_mask:0xf bound_ctrl:1\n\t" \
    "v_add_f32_dpp %[yp], %[yp], %[yp] quad_perm:[2,3,0,1] row_mask:0xf bank_mask:0xf bound_ctrl:1\n\t" \
    "v_pk_fma_f32 v[144:145], v[116:117], v[110:111], v[144:145] op_sel_hi:[0,1,1]\n\t" \
    "v_add_f32_dpp v146, v146, v146 row_half_mirror row_mask:0xf bank_mask:0xf bound_ctrl:1\n\t" \
    "v_add_f32_dpp %[yp], %[yp], %[yp] row_half_mirror row_mask:0xf bank_mask:0xf bound_ctrl:1\n\t" \
    "v_cmp_eq_u32_e32 vcc, 5, %[sp]\n\t" \
    "v_add_f32_dpp v146, v146, v146 row_mirror row_mask:0xf bank_mask:0xf bound_ctrl:1\n\t" \
    "v_add_f32_dpp %[yp], %[yp], %[yp] row_mirror row_mask:0xf bank_mask:0xf bound_ctrl:1\n\t" \
    "v_cndmask_b32_e32 %[yk0], %[yk0], %[yp], vcc\n\t" \
    "v_pk_fma_f32 %[s01], v[146:147], v[104:105], v[142:143] op_sel_hi:[0,1,1] neg_lo:[1,0,0] neg_hi:[1,0,0]\n\t" \
    "v_pk_fma_f32 %[s23], v[146:147], v[106:107], v[144:145] op_sel_hi:[0,1,1] neg_lo:[1,0,0] neg_hi:[1,0,0]\n\t" \
    "v_pk_mul_f32 v[140:141], %[s01], v[112:113]\n\t" \
    "v_pk_fma_f32 v[140:141], %[s23], v[114:115], v[140:141]\n\t" \
    "v_add_f32 %[yp], v140, v141\n\t" \
    "s_waitcnt lgkmcnt(0)\n\t" \
    "ds_read_b128 v[96:99], %[ab] offset:26624\n\t" \
    "ds_read_b128 v[100:103], %[ab] offset:2048\n\t" \
    "ds_read_b128 v[104:107], %[ab] offset:18432\n\t" \
    "ds_read_b128 v[108:111], %[ab] offset:10240\n\t" \
    "ds_read_b128 v[112:115], %[ab] offset:34816\n\t" \
    "ds_read_b32 v116, %[av] offset:512\n\t" \
    "v_pk_mul_f32 v[140:141], %[s01], v[118:119]\n\t" \
    "v_pk_fma_f32 v[140:141], %[s23], v[120:121], v[140:141]\n\t" \
    "v_add_f32 v146, v140, v141\n\t" \
    "v_pk_mul_f32 v[142:143], %[s01], v[122:123]\n\t" \
    "v_pk_mul_f32 v[144:145], %[s23], v[124:125]\n\t" \
    "v_add_f32_dpp v146, v146, v146 quad_perm:[1,0,3,2] row_mask:0xf bank_mask:0xf bound_ctrl:1\n\t" \
    "v_add_f32_dpp %[yp], %[yp], %[yp] quad_perm:[1,0,3,2] row_mask:0xf bank_mask:0xf bound_ctrl:1\n\t" \
    "v_pk_fma_f32 v[142:143], v[138:139], v[130:131], v[142:143] op_sel_hi:[0,1,1]\n\t" \
    "v_add_f32_dpp v146, v146, v146 quad_perm:[2,3,0,1] row_mask:0xf bank_mask:0xf bound_ctrl:1\n\t" \
    "v_add_f32_dpp %[yp], %[yp], %[yp] quad_perm:[2,3,0,1] row_mask:0xf bank_mask:0xf bound_ctrl:1\n\t" \
    "v_pk_fma_f32 v[144:145], v[138:139], v[132:133], v[144:145] op_sel_hi:[0,1,1]\n\t" \
    "v_add_f32_dpp v146, v146, v146 row_half_mirror row_mask:0xf bank_mask:0xf bound_ctrl:1\n\t" \
    "v_add_f32_dpp %[yp], %[yp], %[yp] row_half_mirror row_mask:0xf bank_mask:0xf bound_ctrl:1\n\t" \
    "v_cmp_eq_u32_e32 vcc, 6, %[sp]\n\t" \
    "v_add_f32_dpp v146, v146, v146 row_mirror row_mask:0xf bank_mask:0xf bound_ctrl:1\n\t" \
    "v_add_f32_dpp %[yp], %[yp], %[yp] row_mirror row_mask:0xf bank_mask:0xf bound_ctrl:1\n\t" \
    "v_cndmask_b32_e32 %[yk0], %[yk0], %[yp], vcc\n\t" \
    "v_pk_fma_f32 %[s01], v[146:147], v[126:127], v[142:143] op_sel_hi:[0,1,1] neg_lo:[1,0,0] neg_hi:[1,0,0]\n\t" \
    "v_pk_fma_f32 %[s23], v[146:147], v[128:129], v[144:145] op_sel_hi:[0,1,1] neg_lo:[1,0,0] neg_hi:[1,0,0]\n\t" \
    "v_pk_mul_f32 v[140:141], %[s01], v[134:135]\n\t" \
    "v_pk_fma_f32 v[140:141], %[s23], v[136:137], v[140:141]\n\t" \
    "v_add_f32 %[yp], v140, v141\n\t" \
    "s_waitcnt lgkmcnt(0)\n\t" \
    "ds_read_b128 v[118:121], %[ab] offset:26880\n\t" \
    "ds_read_b128 v[122:125], %[ab] offset:2304\n\t" \
    "ds_read_b128 v[126:129], %[ab] offset:18688\n\t" \
    "ds_read_b128 v[130:133], %[ab] offset:10496\n\t" \
    "ds_read_b128 v[134:137], %[ab] offset:35072\n\t" \
    "ds_read_b32 v138, %[av] offset:576\n\t" \
    "v_pk_mul_f32 v[140:141], %[s01], v[96:97]\n\t" \
    "v_pk_fma_f32 v[140:141], %[s23], v[98:99], v[140:141]\n\t" \
    "v_add_f32 v146, v140, v141\n\t" \
    "v_pk_mul_f32 v[142:143], %[s01], v[100:101]\n\t" \
    "v_pk_mul_f32 v[144:145], %[s23], v[102:103]\n\t" \
    "v_add_f32_dpp v146, v146, v146 quad_perm:[1,0,3,2] row_mask:0xf bank_mask:0xf bound_ctrl:1\n\t" \
    "v_add_f32_dpp %[yp], %[yp], %[yp] quad_perm:[1,0,3,2] row_mask:0xf bank_mask:0xf bound_ctrl:1\n\t" \
    "v_pk_fma_f32 v[142:143], v[116:117], v[108:109], v[142:143] op_sel_hi:[0,1,1]\n\t" \
    "v_add_f32_dpp v146, v146, v146 quad_perm:[2,3,0,1] row_mask:0xf bank_mask:0xf bound_ctrl:1\n\t" \
    "v_add_f32_dpp %[yp], %[yp], %[yp] quad_perm:[2,3,0,1] row_mask:0xf bank_mask:0xf bound_ctrl:1\n\t" \
    "v_pk_fma_f32 v[144:145], v[116:117], v[110:111], v[144:145] op_sel_hi:[0,1,1]\n\t" \
    "v_add_f32_dpp v146, v146, v146 row_half_mirror row_mask:0xf bank_mask:0xf bound_ctrl:1\n\t" \
    "v_add_f32_dpp %[yp], %[yp], %[yp] row_half_mirror row_mask:0xf bank_mask:0xf bound_ctrl:1\n\t" \
    "v_cmp_eq_u32_e32 vcc, 7, %[sp]\n\t" \
    "v_add_f32_dpp v146, v146, v146 row_mirror row_mask:0xf bank_mask:0xf bound_ctrl:1\n\t" \
    "v_add_f32_dpp %[yp], %[yp], %[yp] row_mirror row_mask:0xf bank_mask:0xf bound_ctrl:1\n\t" \
    "v_cndmask_b32_e32 %[yk0], %[yk0], %[yp], vcc\n\t" \
    "v_pk_fma_f32 %[s01], v[146:147], v[104:105], v[142:143] op_sel_hi:[0,1,1] neg_lo:[1,0,0] neg_hi:[1,0,0]\n\t" \
    "v_pk_fma_f32 %[s23], v[146:147], v[106:107], v[144:145] op_sel_hi:[0,1,1] neg_lo:[1,0,0] neg_hi:[1,0,0]\n\t" \
    "v_pk_mul_f32 v[140:141], %[s01], v[112:113]\n\t" \
    "v_pk_fma_f32 v[140:141], %[s23], v[114:115], v[140:141]\n\t" \
    "v_add_f32 %[yp], v140, v141\n\t" \
    "s_waitcnt lgkmcnt(0)\n\t" \
    "ds_read_b128 v[96:99], %[ab] offset:27136\n\t" \
    "ds_read_b128 v[100:103], %[ab] offset:2560\n\t" \
    "ds_read_b128 v[104:107], %[ab] offset:18944\n\t" \
    "ds_read_b128 v[108:111], %[ab] offset:10752\n\t" \
    "ds_read_b128 v[112:115], %[ab] offset:35328\n\t" \
    "ds_read_b32 v116, %[av] offset:640\n\t" \
    "v_pk_mul_f32 v[140:141], %[s01], v[118:119]\n\t" \
    "v_pk_fma_f32 v[140:141], %[s23], v[120:121], v[140:141]\n\t" \
    "v_add_f32 v146, v140, v141\n\t" \
    "v_pk_mul_f32 v[142:143], %[s01], v[122:123]\n\t" \
    "v_pk_mul_f32 v[144:145], %[s23], v[124:125]\n\t" \
    "v_add_f32_dpp v146, v146, v146 quad_perm:[1,0,3,2] row_mask:0xf bank_mask:0xf bound_ctrl:1\n\t" \
    "v_add_f32_dpp %[yp], %[yp], %[yp] quad_perm:[1,0,3,2] row_mask:0xf bank_mask:0xf bound_ctrl:1\n\t" \
    "v_pk_fma_f32 v[142:143], v[138:139], v[130:131], v[142:143] op_sel_hi:[0,1,1]\n\t" \
    "v_add_f32_dpp v146, v146, v146 quad_perm:[2,3,0,1] row_mask:0xf bank_mask:0xf bound_ctrl:1\n\t" \
    "v_add_f32_dpp %[yp], %[yp], %[yp] quad_perm:[2,3,0,1] row_mask:0xf bank_mask:0xf bound_ctrl:1\n\t" \
    "v_pk_fma_f32 v[144:145], v[138:139], v[132:133], v[144:145] op_sel_hi:[0,1,1]\n\t" \
    "v_add_f32_dpp v146, v146, v146 row_half_mirror row_mask:0xf bank_mask:0xf bound_ctrl:1\n\t" \
    "v_add_f32_dpp %[yp], %[yp], %[yp] row_half_mirror row_mask:0xf bank_mask:0xf bound_ctrl:1\n\t" \
    "v_cmp_eq_u32_e32 vcc, 8, %[sp]\n\t" \
    "v_add_f32_dpp v146, v146, v146 row_mirror row_mask:0xf bank_mask:0xf bound_ctrl:1\n\t" \
    "v_add_f32_dpp %[yp], %[yp], %[yp] row_mirror row_mask:0xf bank_mask:0xf bound_ctrl:1\n\t" \
    "v_cndmask_b32_e32 %[yk0], %[yk0], %[yp], vcc\n\t" \
    "v_pk_fma_f32 %[s01], v[146:147], v[126:127], v[142:143] op_sel_hi:[0,1,1] neg_lo:[1,0,0] neg_hi:[1,0,0]\n\t" \
    "v_pk_fma_f32 %[s23], v[146:147], v[128:129], v[144:145] op_sel_hi:[0,1,1] neg_lo:[1,0,0] neg_hi:[1,0,0]\n\t" \
    "v_pk_mul_f32 v[140:141], %[s01], v[134:135]\n\t" \
    "v_pk_fma_f32 v[140:141], %[s23], v[136:137], v[140:141]\n\t" \
    "v_add_f32 %[yp], v140, v141\n\t" \
    "s_waitcnt lgkmcnt(0)\n\t" \
    "ds_read_b128 v[118:121], %[ab] offset:27392\n\t" \
    "ds_read_b128 v[122:125], %[ab] offset:2816\n\t" \
    "ds_read_b128 v[126:129], %[ab] offset:19200\n\t" \
    "ds_read_b128 v[130:133], %[ab] offset:11008\n\t" \
    "ds_read_b128 v[134:137], %[ab] offset:35584\n\t" \
    "ds_read_b32 v138, %[av] offset:704\n\t" \
    "v_pk_mul_f32 v[140:141], %[s01], v[96:97]\n\t" \
    "v_pk_fma_f32 v[140:141], %[s23], v[98:99], v[140:141]\n\t" \
    "v_add_f32 v146, v140, v141\n\t" \
    "v_pk_mul_f32 v[142:143], %[s01], v[100:101]\n\t" \
    "v_pk_mul_f32 v[144:145], %[s23], v[102:103]\n\t" \
    "v_add_f32_dpp v146, v146, v146 quad_perm:[1,0,3,2] row_mask:0xf bank_mask:0xf bound_ctrl:1\n\t" \
    "v_add_f32_dpp %[yp], %[yp], %[yp] quad_perm:[1,0,3,2] row_mask:0xf bank_mask:0xf bound_ctrl:1\n\t" \
    "v_pk_fma_f32 v[142:143], v[116:117], v[108:109], v[142:143] op_sel_hi:[0,1,1]\n\t" \
    "v_add_f32_dpp v146, v146, v146 quad_perm:[2,3,0,1] row_mask:0xf bank_mask:0xf bound_ctrl:1\n\t" \
    "v_add_f32_dpp %[yp], %[yp], %[yp] quad_perm:[2,3,0,1] row_mask:0xf bank_mask:0xf bound_ctrl:1\n\t" \
    "v_pk_fma_f32 v[144:145], v[116:117], v[110:111], v[144:145] op_sel_hi:[0,1,1]\n\t" \
    "v_add_f32_dpp v146, v146, v146 row_half_mirror row_mask:0xf bank_mask:0xf bound_ctrl:1\n\t" \
    "v_add_f32_dpp %[yp], %[yp], %[yp] row_half_mirror row_mask:0xf bank_mask:0xf bound_ctrl:1\n\t" \
    "v_cmp_eq_u32_e32 vcc, 9, %[sp]\n\t" \
    "v_add_f32_dpp v146, v146, v146 row_mirror row_mask:0xf bank_mask:0xf bound_ctrl:1\n\t" \
    "v_add_f32_dpp %[yp], %[yp], %[yp] row_mirror row_mask:0xf bank_mask:0xf bound_ctrl:1\n\t" \
    "v_cndmask_b32_e32 %[yk0], %[yk0], %[yp], vcc\n\t" \
    "v_pk_fma_f32 %[s01], v[146:147], v[104:105], v[142:143] op_sel_hi:[0,1,1] neg_lo:[1,0,0] neg_hi:[1,0,0]\n\t" \
    "v_pk_fma_f32 %[s23], v[146:147], v[106:107], v[144:145] op_sel_hi:[0,1,1] neg_lo:[1,0,0] neg_hi:[1,0,0]\n\t" \
    "v_pk_mul_f32 v[140:141], %[s01], v[112:113]\n\t" \
    "v_pk_fma_f32 v[140:141], %[s23], v[114:115], v[140:141]\n\t" \
    "v_add_f32 %[yp], v140, v141\n\t" \
    "s_waitcnt lgkmcnt(0)\n\t" \
    "ds_read_b128 v[96:99], %[ab] offset:27648\n\t" \
    "ds_read_b128 v[100:103], %[ab] offset:3072\n\t" \
    "ds_read_b128 v[104:107], %[ab] offset:19456\n\t" \
    "ds_read_b128 v[108:111], %[ab] offset:11264\n\t" \
    "ds_read_b128 v[112:115], %[ab] offset:35840\n\t" \
    "ds_read_b32 v116, %[av] offset:768\n\t" \
    "v_pk_mul_f32 v[140:141], %[s01], v[118:119]\n\t" \
    "v_pk_fma_f32 v[140:141], %[s23], v[120:121], v[140:141]\n\t" \
    "v_add_f32 v146, v140, v141\n\t" \
    "v_pk_mul_f32 v[142:143], %[s01], v[122:123]\n\t" \
    "v_pk_mul_f32 v[144:145], %[s23], v[124:125]\n\t" \
    "v_add_f32_dpp v146, v146, v146 quad_perm:[1,0,3,2] row_mask:0xf bank_mask:0xf bound_ctrl:1\n\t" \
    "v_add_f32_dpp %[yp], %[yp], %[yp] quad_perm:[1,0,3,2] row_mask:0xf bank_mask:0xf bound_ctrl:1\n\t" \
    "v_pk_fma_f32 v[142:143], v[138:139], v[130:131], v[142:143] op_sel_hi:[0,1,1]\n\t" \
    "v_add_f32_dpp v146, v146, v146 quad_perm:[2,3,0,1] row_mask:0xf bank_mask:0xf bound_ctrl:1\n\t" \
    "v_add_f32_dpp %[yp], %[yp], %[yp] quad_perm:[2,3,0,1] row_mask:0xf bank_mask:0xf bound_ctrl:1\n\t" \
    "v_pk_fma_f32 v[144:145], v[138:139], v[132:133], v[144:145] op_sel_hi:[0,1,1]\n\t" \
    "v_add_f32_dpp v146, v146, v146 row_half_mirror row_mask:0xf bank_mask:0xf bound_ctrl:1\n\t" \
    "v_add_f32_dpp %[yp], %[yp], %[yp] row_half_mirror row_mask:0xf bank_mask:0xf bound_ctrl:1\n\t" \
    "v_cmp_eq_u32_e32 vcc, 10, %[sp]\n\t" \
    "v_add_f32_dpp v146, v146, v146 row_mirror row_mask:0xf bank_mask:0xf bound_ctrl:1\n\t" \
    "v_add_f32_dpp %[yp], %[yp], %[yp] row_mirror row_mask:0xf bank_mask:0xf bound_ctrl:1\n\t" \
    "v_cndmask_b32_e32 %[yk0], %[yk0], %[yp], vcc\n\t" \
    "v_pk_fma_f32 %[s01], v[146:147], v[126:127], v[142:143] op_sel_hi:[0,1,1] neg_lo:[1,0,0] neg_hi:[1,0,0]\n\t" \
    "v_pk_fma_f32 %[s23], v[146:147], v[128:129], v[144:145] op_sel_hi:[0,1,1] neg_lo:[1,0,0] neg_hi:[1,0,0]\n\t" \
    "v_pk_mul_f32 v[140:141], %[s01], v[134:135]\n\t" \
    "v_pk_fma_f32 v[140:141], %[s23], v[136:137], v[140:141]\n\t" \
    "v_add_f32 %[yp], v140, v141\n\t" \
    "s_waitcnt lgkmcnt(0)\n\t" \
    "ds_read_b128 v[118:121], %[ab] offset:27904\n\t" \
    "ds_read_b128 v[122:125], %[ab] offset:3328\n\t" \
    "ds_read_b128 v[126:129], %[ab] offset:19712\n\t" \
    "ds_read_b128 v[130:133], %[ab] offset:11520\n\t" \
    "ds_read_b128 v[134:137], %[ab] offset:36096\n\t" \
    "ds_read_b32 v138, %[av] offset:832\n\t" \
    "v_pk_mul_f32 v[140:141], %[s01], v[96:97]\n\t" \
    "v_pk_fma_f32 v[140:141], %[s23], v[98:99], v[140:141]\n\t" \
    "v_add_f32 v146, v140, v141\n\t" \
    "v_pk_mul_f32 v[142:143], %[s01], v[100:101]\n\t" \
    "v_pk_mul_f32 v[144:145], %[s23], v[102:103]\n\t" \
    "v_add_f32_dpp v146, v146, v146 quad_perm:[1,0,3,2] row_mask:0xf bank_mask:0xf bound_ctrl:1\n\t" \
    "v_add_f32_dpp %[yp], %[yp], %[yp] quad_perm:[1,0,3,2] row_mask:0xf bank_mask:0xf bound_ctrl:1\n\t" \
    "v_pk_fma_f32 v[142:143], v[116:117], v[108:109], v[142:143] op_sel_hi:[0,1,1]\n\t" \
    "v_add_f32_dpp v146, v146, v146 quad_perm:[2,3,0,1] row_mask:0xf bank_mask:0xf bound_ctrl:1\n\t" \
    "v_add_f32_dpp %[yp], %[yp], %[yp] quad_perm:[2,3,0,1] row_mask:0xf bank_mask:0xf bound_ctrl:1\n\t" \
    "v_pk_fma_f32 v[144:145], v[116:117], v[110:111], v[144:145] op_sel_hi:[0,1,1]\n\t" \
    "v_add_f32_dpp v146, v146, v146 row_half_mirror row_mask:0xf bank_mask:0xf bound_ctrl:1\n\t" \
    "v_add_f32_dpp %[yp], %[yp], %[yp] row_half_mirror row_mask:0xf bank_mask:0xf bound_ctrl:1\n\t" \
    "v_cmp_eq_u32_e32 vcc, 11, %[sp]\n\t" \
    "v_add_f32_dpp v146, v146, v146 row_mirror row_mask:0xf bank_mask:0xf bound_ctrl:1\n\t" \
    "v_add_f32_dpp %[yp], %[yp], %[yp] row_mirror row_mask:0xf bank_mask:0xf bound_ctrl:1\n\t" \
    "v_cndmask_b32_e32 %[yk0], %[yk0], %[yp], vcc\n\t" \
    "v_pk_fma_f32 %[s01], v[146:147], v[104:105], v[142:143] op_sel_hi:[0,1,1] neg_lo:[1,0,0] neg_hi:[1,0,0]\n\t" \
    "v_pk_fma_f32 %[s23], v[146:147], v[106:107], v[144:145] op_sel_hi:[0,1,1] neg_lo:[1,0,0] neg_hi:[1,0,0]\n\t" \
    "v_pk_mul_f32 v[140:141], %[s01], v[112:113]\n\t" \
    "v_pk_fma_f32 v[140:141], %[s23], v[114:115], v[140:141]\n\t" \
    "v_add_f32 %[yp], v140, v141\n\t" \
    "s_waitcnt lgkmcnt(0)\n\t" \
    "ds_read_b128 v[96:99], %[ab] offset:28160\n\t" \
    "ds_read_b128 v[100:103], %[ab] offset:3584\n\t" \
    "ds_read_b128 v[104:107], %[ab] offset:19968\n\t" \
    "ds_read_b128 v[108:111], %[ab] offset:11776\n\t" \
    "ds_read_b128 v[112:115], %[ab] offset:36352\n\t" \
    "ds_read_b32 v116, %[av] offset:896\n\t" \
    "v_pk_mul_f32 v[140:141], %[s01], v[118:119]\n\t" \
    "v_pk_fma_f32 v[140:141], %[s23], v[120:121], v[140:141]\n\t" \
    "v_add_f32 v146, v140, v141\n\t" \
    "v_pk_mul_f32 v[142:143], %[s01], v[122:123]\n\t" \
    "v_pk_mul_f32 v[144:145], %[s23], v[124:125]\n\t" \
    "v_add_f32_dpp v146, v146, v146 quad_perm:[1,0,3,2] row_mask:0xf bank_mask:0xf bound_ctrl:1\n\t" \
    "v_add_f32_dpp %[yp], %[yp], %[yp] quad_perm:[1,0,3,2] row_mask:0xf bank_mask:0xf bound_ctrl:1\n\t" \
    "v_pk_fma_f32 v[142:143], v[138:139], v[130:131], v[142:143] op_sel_hi:[0,1,1]\n\t" \
    "v_add_f32_dpp v146, v146, v146 quad_perm:[2,3,0,1] row_mask:0xf bank_mask:0xf bound_ctrl:1\n\t" \
    "v_add_f32_dpp %[yp], %[yp], %[yp] quad_perm:[2,3,0,1] row_mask:0xf bank_mask:0xf bound_ctrl:1\n\t" \
    "v_pk_fma_f32 v[144:145], v[138:139], v[132:133], v[144:145] op_sel_hi:[0,1,1]\n\t" \
    "v_add_f32_dpp v146, v146, v146 row_half_mirror row_mask:0xf bank_mask:0xf bound_ctrl:1\n\t" \
    "v_add_f32_dpp %[yp], %[yp], %[yp] row_half_mirror row_mask:0xf bank_mask:0xf bound_ctrl:1\n\t" \
    "v_cmp_eq_u32_e32 vcc, 12, %[sp]\n\t" \
    "v_add_f32_dpp v146, v146, v146 row_mirror row_mask:0xf bank_mask:0xf bound_ctrl:1\n\t" \
    "v_add_f32_dpp %[yp], %[yp], %[yp] row_mirror row_mask:0xf bank_mask:0xf bound_ctrl:1\n\t" \
    "v_cndmask_b32_e32 %[yk0], %[yk0], %[yp], vcc\n\t" \
    "v_pk_fma_f32 %[s01], v[146:147], v[126:127], v[142:143] op_sel_hi:[0,1,1] neg_lo:[1,0,0] neg_hi:[1,0,0]\n\t" \
    "v_pk_fma_f32 %[s23], v[146:147], v[128:129], v[144:145] op_sel_hi:[0,1,1] neg_lo:[1,0,0] neg_hi:[1,0,0]\n\t" \
    "v_pk_mul_f32 v[140:141], %[s01], v[134:135]\n\t" \
    "v_pk_fma_f32 v[140:141], %[s23], v[136:137], v[140:141]\n\t" \
    "v_add_f32 %[yp], v140, v141\n\t" \
    "s_waitcnt lgkmcnt(0)\n\t" \
    "ds_read_b128 v[118:121], %[ab] offset:28416\n\t" \
    "ds_read_b128 v[122:125], %[ab] offset:3840\n\t" \
    "ds_read_b128 v[126:129], %[ab] offset:20224\n\t" \
    "ds_read_b128 v[130:133], %[ab] offset:12032\n\t" \
    "ds_read_b128 v[134:137], %[ab] offset:36608\n\t" \
    "ds_read_b32 v138, %[av] offset:960\n\t" \
    "v_pk_mul_f32 v[140:141], %[s01], v[96:97]\n\t" \
    "v_pk_fma_f32 v[140:141], %[s23], v[98:99], v[140:141]\n\t" \
    "v_add_f32 v146, v140, v141\n\t" \
    "v_pk_mul_f32 v[142:143], %[s01], v[100:101]\n\t" \
    "v_pk_mul_f32 v[144:145], %[s23], v[102:103]\n\t" \
    "v_add_f32_dpp v146, v146, v146 quad_perm:[1,0,3,2] row_mask:0xf bank_mask:0xf bound_ctrl:1\n\t" \
    "v_add_f32_dpp %[yp], %[yp], %[yp] quad_perm:[1,0,3,2] row_mask:0xf bank_mask:0xf bound_ctrl:1\n\t" \
    "v_pk_fma_f32 v[142:143], v[116:117], v[108:109], v[142:143] op_sel_hi:[0,1,1]\n\t" \
    "v_add_f32_dpp v146, v146, v146 quad_perm:[2,3,0,1] row_mask:0xf bank_mask:0xf bound_ctrl:1\n\t" \
    "v_add_f32_dpp %[yp], %[yp], %[yp] quad_perm:[2,3,0,1] row_mask:0xf bank_mask:0xf bound_ctrl:1\n\t" \
    "v_pk_fma_f32 v[144:145], v[116:117], v[110:111], v[144:145] op_sel_hi:[0,1,1]\n\t" \
    "v_add_f32_dpp v146, v146, v146 row_half_mirror row_mask:0xf bank_mask:0xf bound_ctrl:1\n\t" \
    "v_add_f32_dpp %[yp], %[yp], %[yp] row_half_mirror row_mask:0xf bank_mask:0xf bound_ctrl:1\n\t" \
    "v_cmp_eq_u32_e32 vcc, 13, %[sp]\n\t" \
    "v_add_f32_dpp v146, v146, v146 row_mirror row_mask:0xf bank_mask:0xf bound_ctrl:1\n\t" \
    "v_add_f32_dpp %[yp], %[yp], %[yp] row_mirror row_mask:0xf bank_mask:0xf bound_ctrl:1\n\t" \
    "v_cndmask_b32_e32 %[yk0], %[yk0], %[yp], vcc\n\t" \
    "v_pk_fma_f32 %[s01], v[146:147], v[104:105], v[142:143] op_sel_hi:[0,1,1] neg_lo:[1,0,0] neg_hi:[1,0,0]\n\t" \
    "v_pk_fma_f32 %[s23], v[146:147], v[106:107], v[144:145] op_sel_hi:[0,1,1] neg_lo:[1,0,0] neg_hi:[1,0,0]\n\t" \
    "v_pk_mul_f32 v[140:141], %[s01], v[112:113]\n\t" \
    "v_pk_fma_f32 v[140:141], %[s23], v[114:115], v[140:141]\n\t" \
    "v_add_f32 %[yp], v140, v141\n\t" \
    "s_waitcnt lgkmcnt(0)\n\t" \
    "ds_read_b128 v[96:99], %[ab] offset:28672\n\t" \
    "ds_read_b128 v[100:103], %[ab] offset:4096\n\t" \
    "ds_read_b128 v[104:107], %[ab] offset:20480\n\t" \
    "ds_read_b128 v[108:111], %[ab] offset:12288\n\t" \
    "ds_read_b128 v[112:115], %[ab] offset:36864\n\t" \
    "ds_read_b32 v116, %[av] offset:1024\n\t" \
    "v_pk_mul_f32 v[140:141], %[s01], v[118:119]\n\t" \
    "v_pk_fma_f32 v[140:141], %[s23], v[120:121], v[140:141]\n\t" \
    "v_add_f32 v146, v140, v141\n\t" \
    "v_pk_mul_f32 v[142:143], %[s01], v[122:123]\n\t" \
    "v_pk_mul_f32 v[144:145], %[s23], v[124:125]\n\t" \
    "v_add_f32_dpp v146, v146, v146 quad_perm:[1,0,3,2] row_mask:0xf bank_mask:0xf bound_ctrl:1\n\t" \
    "v_add_f32_dpp %[yp], %[yp], %[yp] quad_perm:[1,0,3,2] row_mask:0xf bank_mask:0xf bound_ctrl:1\n\t" \
    "v_pk_fma_f32 v[142:143], v[138:139], v[130:131], v[142:143] op_sel_hi:[0,1,1]\n\t" \
    "v_add_f32_dpp v146, v146, v146 quad_perm:[2,3,0,1] row_mask:0xf bank_mask:0xf bound_ctrl:1\n\t" \
    "v_add_f32_dpp %[yp], %[yp], %[yp] quad_perm:[2,3,0,1] row_mask:0xf bank_mask:0xf bound_ctrl:1\n\t" \
    "v_pk_fma_f32 v[144:145], v[138:139], v[132:133], v[144:145] op_sel_hi:[0,1,1]\n\t" \
    "v_add_f32_dpp v146, v146, v146 row_half_mirror row_mask:0xf bank_mask:0xf bound_ctrl:1\n\t" \
    "v_add_f32_dpp %[yp], %[yp], %[yp] row_half_mirror row_mask:0xf bank_mask:0xf bound_ctrl:1\n\t" \
    "v_cmp_eq_u32_e32 vcc, 14, %[sp]\n\t" \
    "v_add_f32_dpp v146, v146, v146 row_mirror row_mask:0xf bank_mask:0xf bound_ctrl:1\n\t" \
    "v_add_f32_dpp %[yp], %[yp], %[yp] row_mirror row_mask:0xf bank_mask:0xf bound_ctrl:1\n\t" \
    "v_cndmask_b32_e32 %[yk0], %[yk0], %[yp], vcc\n\t" \
    "v_pk_fma_f32 %[s01], v[146:147], v[126:127], v[142:143] op_sel_hi:[0,1,1] neg_lo:[1,0,0] neg_hi:[1,0,0]\n\t" \
    "v_pk_fma_f32 %[s23], v[146:147], v[128:129], v[144:145] op_sel_hi:[0,1,1] neg_lo:[1,0,0] neg_hi:[1,0,0]\n\t" \
    "v_pk_mul_f32 v[140:141], %[s01], v[134:135]\n\t" \
    "v_pk_fma_f32 v[140:141], %[s23], v[136:137], v[140:141]\n\t" \
    "v_add_f32 %[yp], v140, v141\n\t" \
    "s_waitcnt lgkmcnt(0)\n\t" \
    "ds_read_b128 v[118:121], %[ab] offset:28928\n\t" \
    "ds_read_b128 v[122:125], %[ab] offset:4352\n\t" \
    "ds_read_b128 v[126:129], %[ab] offset:20736\n\t" \
    "ds_read_b128 v[130:133], %[ab] offset:12544\n\t" \
    "ds_read_b128 v[134:137], %[ab] offset:37120\n\t" \
    "ds_read_b32 v138, %[av] offset:1088\n\t" \
    "v_pk_mul_f32 v[140:141], %[s01], v[96:97]\n\t" \
    "v_pk_fma_f32 v[140:141], %[s23], v[98:99], v[140:141]\n\t" \
    "v_add_f32 v146, v140, v141\n\t" \
    "v_pk_mul_f32 v[142:143], %[s01], v[100:101]\n\t" \
    "v_pk_mul_f32 v[144:145], %[s23], v[102:103]\n\t" \
    "v_add_f32_dpp v146, v146, v146 quad_perm:[1,0,3,2] row_mask:0xf bank_mask:0xf bound_ctrl:1\n\t" \
    "v_add_f32_dpp %[yp], %[yp], %[yp] quad_perm:[1,0,3,2] row_mask:0xf bank_mask:0xf bound_ctrl:1\n\t" \
    "v_pk_fma_f32 v[142:143], v[116:117], v[108:109], v[142:143] op_sel_hi:[0,1,1]\n\t" \
    "v_add_f32_dpp v146, v146, v146 quad_perm:[2,3,0,1] row_mask:0xf bank_mask:0xf bound_ctrl:1\n\t" \
    "v_add_f32_dpp %[yp], %[yp], %[yp] quad_perm:[2,3,0,1] row_mask:0xf bank_mask:0xf bound_ctrl:1\n\t" \
    "v_pk_fma_f32 v[144:145], v[116:117], v[110:111], v[144:145] op_sel_hi:[0,1,1]\n\t" \
    "v_add_f32_dpp v146, v146, v146 row_half_mirror row_mask:0xf bank_mask:0xf bound_ctrl:1\n\t" \
    "v_add_f32_dpp %[yp], %[yp], %[yp] row_half_mirror row_mask:0xf bank_mask:0xf bound_ctrl:1\n\t" \
    "v_cmp_eq_u32_e32 vcc, 15, %[sp]\n\t" \
    "v_add_f32_dpp v146, v146, v146 row_mirror row_mask:0xf bank_mask:0xf bound_ctrl:1\n\t" \
    "v_add_f32_dpp %[yp], %[yp], %[yp] row_mirror row_mask:0xf bank_mask:0xf bound_ctrl:1\n\t" \
    "v_cndmask_b32_e32 %[yk0], %[yk0], %[yp], vcc\n\t" \
    "v_pk_fma_f32 %[s01], v[146:147], v[104:105], v[142:143] op_sel_hi:[0,1,1] neg_lo:[1,0,0] neg_hi:[1,0,0]\n\t" \
    "v_pk_fma_f32 %[s23], v[146:147], v[106:107], v[144:145] op_sel_hi:[0,1,1] neg_lo:[1,0,0] neg_hi:[1,0,0]\n\t" \
    "v_pk_mul_f32 v[140:141], %[s01], v[112:113]\n\t" \
    "v_pk_fma_f32 v[140:141], %[s23], v[114:115], v[140:141]\n\t" \
    "v_add_f32 %[yp], v140, v141\n\t" \
    "s_waitcnt lgkmcnt(0)\n\t" \
    "ds_read_b128 v[96:99], %[ab] offset:29184\n\t" \
    "ds_read_b128 v[100:103], %[ab] offset:4608\n\t" \
    "ds_read_b128 v[104:107], %[ab] offset:20992\n\t" \
    "ds_read_b128 v[108:111], %[ab] offset:12800\n\t" \
    "ds_read_b128 v[112:115], %[ab] offset:37376\n\t" \
    "ds_read_b32 v116, %[av] offset:1152\n\t" \
    "v_pk_mul_f32 v[140:141], %[s01], v[118:119]\n\t" \
    "v_pk_fma_f32 v[140:141], %[s23], v[120:121], v[140:141]\n\t" \
    "v_add_f32 v146, v140, v141\n\t" \
    "v_pk_mul_f32 v[142:143], %[s01], v[122:123]\n\t" \
    "v_pk_mul_f32 v[144:145], %[s23], v[124:125]\n\t" \
    "v_add_f32_dpp v146, v146, v146 quad_perm:[1,0,3,2] row_mask:0xf bank_mask:0xf bound_ctrl:1\n\t" \
    "v_add_f32_dpp %[yp], %[yp], %[yp] quad_perm:[1,0,3,2] row_mask:0xf bank_mask:0xf bound_ctrl:1\n\t" \
    "v_pk_fma_f32 v[142:143], v[138:139], v[130:131], v[142:143] op_sel_hi:[0,1,1]\n\t" \
    "v_add_f32_dpp v146, v146, v146 quad_perm:[2,3,0,1] row_mask:0xf bank_mask:0xf bound_ctrl:1\n\t" \
    "v_add_f32_dpp %[yp], %[yp], %[yp] quad_perm:[2,3,0,1] row_mask:0xf bank_mask:0xf bound_ctrl:1\n\t" \
    "v_pk_fma_f32 v[144:145], v[138:139], v[132:133], v[144:145] op_sel_hi:[0,1,1]\n\t" \
    "v_add_f32_dpp v146, v146, v146 row_half_mirror row_mask:0xf bank_mask:0xf bound_ctrl:1\n\t" \
    "v_add_f32_dpp %[yp], %[yp], %[yp] row_half_mirror row_mask:0xf bank_mask:0xf bound_ctrl:1\n\t" \
    "v_cmp_eq_u32_e32 vcc, 0, %[sp]\n\t" \
    "v_add_f32_dpp v146, v146, v146 row_mirror row_mask:0xf bank_mask:0xf bound_ctrl:1\n\t" \
    "v_add_f32_dpp %[yp], %[yp], %[yp] row_mirror row_mask:0xf bank_mask:0xf bound_ctrl:1\n\t" \
    "v_cndmask_b32_e32 %[yk1], %[yk1], %[yp], vcc\n\t" \
    "v_pk_fma_f32 %[s01], v[146:147], v[126:127], v[142:143] op_sel_hi:[0,1,1] neg_lo:[1,0,0] neg_hi:[1,0,0]\n\t" \
    "v_pk_fma_f32 %[s23], v[146:147], v[128:129], v[144:145] op_sel_hi:[0,1,1] neg_lo:[1,0,0] neg_hi:[1,0,0]\n\t" \
    "v_pk_mul_f32 v[140:141], %[s01], v[134:135]\n\t" \
    "v_pk_fma_f32 v[140:141], %[s23], v[136:137], v[140:141]\n\t" \
    "v_add_f32 %[yp], v140, v141\n\t" \
    "s_waitcnt lgkmcnt(0)\n\t" \
    "ds_read_b128 v[118:121], %[ab] offset:29440\n\t" \
    "ds_read_b128 v[122:125], %[ab] offset:4864\n\t" \
    "ds_read_b128 v[126:129], %[ab] offset:21248\n\t" \
    "ds_read_b128 v[130:133], %[ab] offset:13056\n\t" \
    "ds_read_b128 v[134:137], %[ab] offset:37632\n\t" \
    "ds_read_b32 v138, %[av] offset:1216\n\t" \
    "v_pk_mul_f32 v[140:141], %[s01], v[96:97]\n\t" \
    "v_pk_fma_f32 v[140:141], %[s23], v[98:99], v[140:141]\n\t" \
    "v_add_f32 v146, v140, v141\n\t" \
    "v_pk_mul_f32 v[142:143], %[s01], v[100:101]\n\t" \
    "v_pk_mul_f32 v[144:145], %[s23], v[102:103]\n\t" \
    "v_add_f32_dpp v146, v146, v146 quad_perm:[1,0,3,2] row_mask:0xf bank_mask:0xf bound_ctrl:1\n\t" \
    "v_add_f32_dpp %[yp], %[yp], %[yp] quad_perm:[1,0,3,2] row_mask:0xf bank_mask:0xf bound_ctrl:1\n\t" \
    "v_pk_fma_f32 v[142:143], v[116:117], v[108:109], v[142:143] op_sel_hi:[0,1,1]\n\t" \
    "v_add_f32_dpp v146, v146, v146 quad_perm:[2,3,0,1] row_mask:0xf bank_mask:0xf bound_ctrl:1\n\t" \
    "v_add_f32_dpp %[yp], %[yp], %[yp] quad_perm:[2,3,0,1] row_mask:0xf bank_mask:0xf bound_ctrl:1\n\t" \
    "v_pk_fma_f32 v[144:145], v[116:117], v[110:111], v[144:145] op_sel_hi:[0,1,1]\n\t" \
    "v_add_f32_dpp v146, v146, v146 row_half_mirror row_mask:0xf bank_mask:0xf bound_ctrl:1\n\t" \
    "v_add_f32_dpp %[yp], %[yp], %[yp] row_half_mirror row_mask:0xf bank_mask:0xf bound_ctrl:1\n\t" \
    "v_cmp_eq_u32_e32 vcc, 1, %[sp]\n\t" \
    "v_add_f32_dpp v146, v146, v146 row_mirror row_mask:0xf bank_mask:0xf bound_ctrl:1\n\t" \
    "v_add_f32_dpp %[yp], %[yp], %[yp] row_mirror row_mask:0xf bank_mask:0xf bound_ctrl:1\n\t" \
    "v_cndmask_b32_e32 %[yk1], %[yk1], %[yp], vcc\n\t" \
    "v_pk_fma_f32 %[s01], v[146:147], v[104:105], v[142:143] op_sel_hi:[0,1,1] neg_lo:[1,0,0] neg_hi:[1,0,0]\n\t" \
    "v_pk_fma_f32 %[s23], v[146:147], v[106:107], v[144:145] op_sel_hi:[0,1,1] neg_lo:[1,0,0] neg_hi:[1,0,0]\n\t" \
    "v_pk_mul_f32 v[140:141], %[s01], v[112:113]\n\t" \
    "v_pk_fma_f32 v[140:141], %[s23], v[114:115], v[140:141]\n\t" \
    "v_add_f32 %[yp], v140, v141\n\t" \
    "s_waitcnt lgkmcnt(0)\n\t" \
    "ds_read_b128 v[96:99], %[ab] offset:29696\n\t" \
    "ds_read_b128 v[100:103], %[ab] offset:5120\n\t" \
    "ds_read_b128 v[104:107], %[ab] offset:21504\n\t" \
    "ds_read_b128 v[108:111], %[ab] offset:13312\n\t" \
    "ds_read_b128 v[112:115], %[ab] offset:37888\n\t" \
    "ds_read_b32 v116, %[av] offset:1280\n\t" \
    "v_pk_mul_f32 v[140:141], %[s01], v[118:119]\n\t" \
    "v_pk_fma_f32 v[140:141], %[s23], v[120:121], v[140:141]\n\t" \
    "v_add_f32 v146, v140, v141\n\t" \
    "v_pk_mul_f32 v[142:143], %[s01], v[122:123]\n\t" \
    "v_pk_mul_f32 v[144:145], %[s23], v[124:125]\n\t" \
    "v_add_f32_dpp v146, v146, v146 quad_perm:[1,0,3,2] row_mask:0xf bank_mask:0xf bound_ctrl:1\n\t" \
    "v_add_f32_dpp %[yp], %[yp], %[yp] quad_perm:[1,0,3,2] row_mask:0xf bank_mask:0xf bound_ctrl:1\n\t" \
    "v_pk_fma_f32 v[142:143], v[138:139], v[130:131], v[142:143] op_sel_hi:[0,1,1]\n\t" \
    "v_add_f32_dpp v146, v146, v146 quad_perm:[2,3,0,1] row_mask:0xf bank_mask:0xf bound_ctrl:1\n\t" \
    "v_add_f32_dpp %[yp], %[yp], %[yp] quad_perm:[2,3,0,1] row_mask:0xf bank_mask:0xf bound_ctrl:1\n\t" \
    "v_pk_fma_f32 v[144:145], v[138:139], v[132:133], v[144:145] op_sel_hi:[0,1,1]\n\t" \
    "v_add_f32_dpp v146, v146, v146 row_half_mirror row_mask:0xf bank_mask:0xf bound_ctrl:1\n\t" \
    "v_add_f32_dpp %[yp], %[yp], %[yp] row_half_mirror row_mask:0xf bank_mask:0xf bound_ctrl:1\n\t" \
    "v_cmp_eq_u32_e32 vcc, 2, %[sp]\n\t" \
    "v_add_f32_dpp v146, v146, v146 row_mirror row_mask:0xf bank_mask:0xf bound_ctrl:1\n\t" \
    "v_add_f32_dpp %[yp], %[yp], %[yp] row_mirror row_mask:0xf bank_mask:0xf bound_ctrl:1\n\t" \
    "v_cndmask_b32_e32 %[yk1], %[yk1], %[yp], vcc\n\t" \
    "v_pk_fma_f32 %[s01], v[146:147], v[126:127], v[142:143] op_sel_hi:[0,1,1] neg_lo:[1,0,0] neg_hi:[1,0,0]\n\t" \
    "v_pk_fma_f32 %[s23], v[146:147], v[128:129], v[144:145] op_sel_hi:[0,1,1] neg_lo:[1,0,0] neg_hi:[1,0,0]\n\t" \
    "v_pk_mul_f32 v[140:141], %[s01], v[134:135]\n\t" \
    "v_pk_fma_f32 v[140:141], %[s23], v[136:137], v[140:141]\n\t" \
    "v_add_f32 %[yp], v140, v141\n\t" \
    "s_waitcnt lgkmcnt(0)\n\t" \
    "ds_read_b128 v[118:121], %[ab] offset:29952\n\t" \
    "ds_read_b128 v[122:125], %[ab] offset:5376\n\t" \
    "ds_read_b128 v[126:129], %[ab] offset:21760\n\t" \
    "ds_read_b128 v[130:133], %[ab] offset:13568\n\t" \
    "ds_read_b128 v[134:137], %[ab] offset:38144\n\t" \
    "ds_read_b32 v138, %[av] offset:1344\n\t" \
    "v_pk_mul_f32 v[140:141], %[s01], v[96:97]\n\t" \
    "v_pk_fma_f32 v[140:141], %[s23], v[98:99], v[140:141]\n\t" \
    "v_add_f32 v146, v140, v141\n\t" \
    "v_pk_mul_f32 v[142:143], %[s01], v[100:101]\n\t" \
    "v_pk_mul_f32 v[144:145], %[s23], v[102:103]\n\t" \
    "v_add_f32_dpp v146, v146, v146 quad_perm:[1,0,3,2] row_mask:0xf bank_mask:0xf bound_ctrl:1\n\t" \
    "v_add_f32_dpp %[yp], %[yp], %[yp] quad_perm:[1,0,3,2] row_mask:0xf bank_mask:0xf bound_ctrl:1\n\t" \
    "v_pk_fma_f32 v[142:143], v[116:117], v[108:109], v[142:143] op_sel_hi:[0,1,1]\n\t" \
    "v_add_f32_dpp v146, v146, v146 quad_perm:[2,3,0,1] row_mask:0xf bank_mask:0xf bound_ctrl:1\n\t" \
    "v_add_f32_dpp %[yp], %[yp], %[yp] quad_perm:[2,3,0,1] row_mask:0xf bank_mask:0xf bound_ctrl:1\n\t" \
    "v_pk_fma_f32 v[144:145], v[116:117], v[110:111], v[144:145] op_sel_hi:[0,1,1]\n\t" \
    "v_add_f32_dpp v146, v146, v146 row_half_mirror row_mask:0xf bank_mask:0xf bound_ctrl:1\n\t" \
    "v_add_f32_dpp %[yp], %[yp], %[yp] row_half_mirror row_mask:0xf bank_mask:0xf bound_ctrl:1\n\t" \
    "v_cmp_eq_u32_e32 vcc, 3, %[sp]\n\t" \
    "v_add_f32_dpp v146, v146, v146 row_mirror row_mask:0xf bank_mask:0xf bound_ctrl:1\n\t" \
    "v_add_f32_dpp %[yp], %[yp], %[yp] row_mirror row_mask:0xf bank_mask:0xf bound_ctrl:1\n\t" \
    "v_cndmask_b32_e32 %[yk1], %[yk1], %[yp], vcc\n\t" \
    "v_pk_fma_f32 %[s01], v[146:147], v[104:105], v[142:143] op_sel_hi:[0,1,1] neg_lo:[1,0,0] neg_hi:[1,0,0]\n\t" \
    "v_pk_fma_f32 %[s23], v[146:147], v[106:107], v[144:145] op_sel_hi:[0,1,1] neg_lo:[1,0,0] neg_hi:[1,0,0]\n\t" \
    "v_pk_mul_f32 v[140:141], %[s01], v[112:113]\n\t" \
    "v_pk_fma_f32 v[140:141], %[s23], v[114:115], v[140:141]\n\t" \
    "v_add_f32 %[yp], v140, v141\n\t" \
    "s_waitcnt lgkmcnt(0)\n\t" \
    "ds_read_b128 v[96:99], %[ab] offset:30208\n\t" \
    "ds_read_b128 v[100:103], %[ab] offset:5632\n\t" \
    "ds_read_b128 v[104:107], %[ab] offset:22016\n\t" \
    "ds_read_b128 v[108:111], %[ab] offset:13824\n\t" \
    "ds_read_b128 v[112:115], %[ab] offset:38400\n\t" \
    "ds_read_b32 v116, %[av] offset:1408\n\t" \
    "v_pk_mul_f32 v[140:141], %[s01], v[118:119]\n\t" \
    "v_pk_fma_f32 v[140:141], %[s23], v[120:121], v[140:141]\n\t" \
    "v_add_f32 v146, v140, v141\n\t" \
    "v_pk_mul_f32 v[142:143], %[s01], v[122:123]\n\t" \
    "v_pk_mul_f32 v[144:145], %[s23], v[124:125]\n\t" \
    "v_add_f32_dpp v146, v146, v146 quad_perm:[1,0,3,2] row_mask:0xf bank_mask:0xf bound_ctrl:1\n\t" \
    "v_add_f32_dpp %[yp], %[yp], %[yp] quad_perm:[1,0,3,2] row_mask:0xf bank_mask:0xf bound_ctrl:1\n\t" \
    "v_pk_fma_f32 v[142:143], v[138:139], v[130:131], v[142:143] op_sel_hi:[0,1,1]\n\t" \
    "v_add_f32_dpp v146, v146, v146 quad_perm:[2,3,0,1] row_mask:0xf bank_mask:0xf bound_ctrl:1\n\t" \
    "v_add_f32_dpp %[yp], %[yp], %[yp] quad_perm:[2,3,0,1] row_mask:0xf bank_mask:0xf bound_ctrl:1\n\t" \
    "v_pk_fma_f32 v[144:145], v[138:139], v[132:133], v[144:145] op_sel_hi:[0,1,1]\n\t" \
    "v_add_f32_dpp v146, v146, v146 row_half_mirror row_mask:0xf bank_mask:0xf bound_ctrl:1\n\t" \
    "v_add_f32_dpp %[yp], %[yp], %[yp] row_half_mirror row_mask:0xf bank_mask:0xf bound_ctrl:1\n\t" \
    "v_cmp_eq_u32_e32 vcc, 4, %[sp]\n\t" \
    "v_add_f32_dpp v146, v146, v146 row_mirror row_mask:0xf bank_mask:0xf bound_ctrl:1\n\t" \
    "v_add_f32_dpp %[yp], %[yp], %[yp] row_mirror row_mask:0xf bank_mask:0xf bound_ctrl:1\n\t" \
    "v_cndmask_b32_e32 %[yk1], %[yk1], %[yp], vcc\n\t" \
    "v_pk_fma_f32 %[s01], v[146:147], v[126:127], v[142:143] op_sel_hi:[0,1,1] neg_lo:[1,0,0] neg_hi:[1,0,0]\n\t" \
    "v_pk_fma_f32 %[s23], v[146:147], v[128:129], v[144:145] op_sel_hi:[0,1,1] neg_lo:[1,0,0] neg_hi:[1,0,0]\n\t" \
    "v_pk_mul_f32 v[140:141], %[s01], v[134:135]\n\t" \
    "v_pk_fma_f32 v[140:141], %[s23], v[136:137], v[140:141]\n\t" \
    "v_add_f32 %[yp], v140, v141\n\t" \
    "s_waitcnt lgkmcnt(0)\n\t" \
    "ds_read_b128 v[118:121], %[ab] offset:30464\n\t" \
    "ds_read_b128 v[122:125], %[ab] offset:5888\n\t" \
    "ds_read_b128 v[126:129], %[ab] offset:22272\n\t" \
    "ds_read_b128 v[130:133], %[ab] offset:14080\n\t" \
    "ds_read_b128 v[134:137], %[ab] offset:38656\n\t" \
    "ds_read_b32 v138, %[av] offset:1472\n\t" \
    "v_pk_mul_f32 v[140:141], %[s01], v[96:97]\n\t" \
    "v_pk_fma_f32 v[140:141], %[s23], v[98:99], v[140:141]\n\t" \
    "v_add_f32 v146, v140, v141\n\t" \
    "v_pk_mul_f32 v[142:143], %[s01], v[100:101]\n\t" \
    "v_pk_mul_f32 v[144:145], %[s23], v[102:103]\n\t" \
    "v_add_f32_dpp v146, v146, v146 quad_perm:[1,0,3,2] row_mask:0xf bank_mask:0xf bound_ctrl:1\n\t" \
    "v_add_f32_dpp %[yp], %[yp], %[yp] quad_perm:[1,0,3,2] row_mask:0xf bank_mask:0xf bound_ctrl:1\n\t" \
    "v_pk_fma_f32 v[142:143], v[116:117], v[108:109], v[142:143] op_sel_hi:[0,1,1]\n\t" \
    "v_add_f32_dpp v146, v146, v146 quad_perm:[2,3,0,1] row_mask:0xf bank_mask:0xf bound_ctrl:1\n\t" \
    "v_add_f32_dpp %[yp], %[yp], %[yp] quad_perm:[2,3,0,1] row_mask:0xf bank_mask:0xf bound_ctrl:1\n\t" \
    "v_pk_fma_f32 v[144:145], v[116:117], v[110:111], v[144:145] op_sel_hi:[0,1,1]\n\t" \
    "v_add_f32_dpp v146, v146, v146 row_half_mirror row_mask:0xf bank_mask:0xf bound_ctrl:1\n\t" \
    "v_add_f32_dpp %[yp], %[yp], %[yp] row_half_mirror row_mask:0xf bank_mask:0xf bound_ctrl:1\n\t" \
    "v_cmp_eq_u32_e32 vcc, 5, %[sp]\n\t" \
    "v_add_f32_dpp v146, v146, v146 row_mirror row_mask:0xf bank_mask:0xf bound_ctrl:1\n\t" \
    "v_add_f32_dpp %[yp], %[yp], %[yp] row_mirror row_mask:0xf bank_mask:0xf bound_ctrl:1\n\t" \
    "v_cndmask_b32_e32 %[yk1], %[yk1], %[yp], vcc\n\t" \
    "v_pk_fma_f32 %[s01], v[146:147], v[104:105], v[142:143] op_sel_hi:[0,1,1] neg_lo:[1,0,0] neg_hi:[1,0,0]\n\t" \
    "v_pk_fma_f32 %[s23], v[146:147], v[106:107], v[144:145] op_sel_hi:[0,1,1] neg_lo:[1,0,0] neg_hi:[1,0,0]\n\t" \
    "v_pk_mul_f32 v[140:141], %[s01], v[112:113]\n\t" \
    "v_pk_fma_f32 v[140:141], %[s23], v[114:115], v[140:141]\n\t" \
    "v_add_f32 %[yp], v140, v141\n\t" \
    "s_waitcnt lgkmcnt(0)\n\t" \
    "ds_read_b128 v[96:99], %[ab] offset:30720\n\t" \
    "ds_read_b128 v[100:103], %[ab] offset:6144\n\t" \
    "ds_read_b128 v[104:107], %[ab] offset:22528\n\t" \
    "ds_read_b128 v[108:111], %[ab] offset:14336\n\t" \
    "ds_read_b128 v[112:115], %[ab] offset:38912\n\t" \
    "ds_read_b32 v116, %[av] offset:1536\n\t" \
    "v_pk_mul_f32 v[140:141], %[s01], v[118:119]\n\t" \
    "v_pk_fma_f32 v[140:141], %[s23], v[120:121], v[140:141]\n\t" \
    "v_add_f32 v146, v140, v141\n\t" \
    "v_pk_mul_f32 v[142:143], %[s01], v[122:123]\n\t" \
    "v_pk_mul_f32 v[144:145], %[s23], v[124:125]\n\t" \
    "v_add_f32_dpp v146, v146, v146 quad_perm:[1,0,3,2] row_mask:0xf bank_mask:0xf bound_ctrl:1\n\t" \
    "v_add_f32_dpp %[yp], %[yp], %[yp] quad_perm:[1,0,3,2] row_mask:0xf bank_mask:0xf bound_ctrl:1\n\t" \
    "v_pk_fma_f32 v[142:143], v[138:139], v[130:131], v[142:143] op_sel_hi:[0,1,1]\n\t" \
    "v_add_f32_dpp v146, v146, v146 quad_perm:[2,3,0,1] row_mask:0xf bank_mask:0xf bound_ctrl:1\n\t" \
    "v_add_f32_dpp %[yp], %[yp], %[yp] quad_perm:[2,3,0,1] row_mask:0xf bank_mask:0xf bound_ctrl:1\n\t" \
    "v_pk_fma_f32 v[144:145], v[138:139], v[132:133], v[144:145] op_sel_hi:[0,1,1]\n\t" \
    "v_add_f32_dpp v146, v146, v146 row_half_mirror row_mask:0xf bank_mask:0xf bound_ctrl:1\n\t" \
    "v_add_f32_dpp %[yp], %[yp], %[yp] row_half_mirror row_mask:0xf bank_mask:0xf bound_ctrl:1\n\t" \
    "v_cmp_eq_u32_e32 vcc, 6, %[sp]\n\t" \
    "v_add_f32_dpp v146, v146, v146 row_mirror row_mask:0xf bank_mask:0xf bound_ctrl:1\n\t" \
    "v_add_f32_dpp %[yp], %[yp], %[yp] row_mirror row_mask:0xf bank_mask:0xf bound_ctrl:1\n\t" \
    "v_cndmask_b32_e32 %[yk1], %[yk1], %[yp], vcc\n\t" \
    "v_pk_fma_f32 %[s01], v[146:147], v[126:127], v[142:143] op_sel_hi:[0,1,1] neg_lo:[1,0,0] neg_hi:[1,0,0]\n\t" \
    "v_pk_fma_f32 %[s23], v[146:147], v[128:129], v[144:145] op_sel_hi:[0,1,1] neg_lo:[1,0,0] neg_hi:[1,0,0]\n\t" \
    "v_pk_mul_f32 v[140:141], %[s01], v[134:135]\n\t" \
    "v_pk_fma_f32 v[140:141], %[s23], v[136:137], v[140:141]\n\t" \
    "v_add_f32 %[yp], v140, v141\n\t" \
    "s_waitcnt lgkmcnt(0)\n\t" \
    "ds_read_b128 v[118:121], %[ab] offset:30976\n\t" \
    "ds_read_b128 v[122:125], %[ab] offset:6400\n\t" \
    "ds_read_b128 v[126:129], %[ab] offset:22784\n\t" \
    "ds_read_b128 v[130:133], %[ab] offset:14592\n\t" \
    "ds_read_b128 v[134:137], %[ab] offset:39168\n\t" \
    "ds_read_b32 v138, %[av] offset:1600\n\t" \
    "v_pk_mul_f32 v[140:141], %[s01], v[96:97]\n\t" \
    "v_pk_fma_f32 v[140:141], %[s23], v[98:99], v[140:141]\n\t" \
    "v_add_f32 v146, v140, v141\n\t" \
    "v_pk_mul_f32 v[142:143], %[s01], v[100:101]\n\t" \
    "v_pk_mul_f32 v[144:145], %[s23], v[102:103]\n\t" \
    "v_add_f32_dpp v146, v146, v146 quad_perm:[1,0,3,2] row_mask:0xf bank_mask:0xf bound_ctrl:1\n\t" \
    "v_add_f32_dpp %[yp], %[yp], %[yp] quad_perm:[1,0,3,2] row_mask:0xf bank_mask:0xf bound_ctrl:1\n\t" \
    "v_pk_fma_f32 v[142:143], v[116:117], v[108:109], v[142:143] op_sel_hi:[0,1,1]\n\t" \
    "v_add_f32_dpp v146, v146, v146 quad_perm:[2,3,0,1] row_mask:0xf bank_mask:0xf bound_ctrl:1\n\t" \
    "v_add_f32_dpp %[yp], %[yp], %[yp] quad_perm:[2,3,0,1] row_mask:0xf bank_mask:0xf bound_ctrl:1\n\t" \
    "v_pk_fma_f32 v[144:145], v[116:117], v[110:111], v[144:145] op_sel_hi:[0,1,1]\n\t" \
    "v_add_f32_dpp v146, v146, v146 row_half_mirror row_mask:0xf bank_mask:0xf bound_ctrl:1\n\t" \
    "v_add_f32_dpp %[yp], %[yp], %[yp] row_half_mirror row_mask:0xf bank_mask:0xf bound_ctrl:1\n\t" \
    "v_cmp_eq_u32_e32 vcc, 7, %[sp]\n\t" \
    "v_add_f32_dpp v146, v146, v146 row_mirror row_mask:0xf bank_mask:0xf bound_ctrl:1\n\t" \
    "v_add_f32_dpp %[yp], %[yp], %[yp] row_mirror row_mask:0xf bank_mask:0xf bound_ctrl:1\n\t" \
    "v_cndmask_b32_e32 %[yk1], %[yk1], %[yp], vcc\n\t" \
    "v_pk_fma_f32 %[s01], v[146:147], v[104:105], v[142:143] op_sel_hi:[0,1,1] neg_lo:[1,0,0] neg_hi:[1,0,0]\n\t" \
    "v_pk_fma_f32 %[s23], v[146:147], v[106:107], v[144:145] op_sel_hi:[0,1,1] neg_lo:[1,0,0] neg_hi:[1,0,0]\n\t" \
    "v_pk_mul_f32 v[140:141], %[s01], v[112:113]\n\t" \
    "v_pk_fma_f32 v[140:141], %[s23], v[114:115], v[140:141]\n\t" \
    "v_add_f32 %[yp], v140, v141\n\t" \
    "s_waitcnt lgkmcnt(0)\n\t" \
    "ds_read_b128 v[96:99], %[ab] offset:31232\n\t" \
    "ds_read_b128 v[100:103], %[ab] offset:6656\n\t" \
    "ds_read_b128 v[104:107], %[ab] offset:23040\n\t" \
    "ds_read_b128 v[108:111], %[ab] offset:14848\n\t" \
    "ds_read_b128 v[112:115], %[ab] offset:39424\n\t" \
    "ds_read_b32 v116, %[av] offset:1664\n\t" \
    "v_pk_mul_f32 v[140:141], %[s01], v[118:119]\n\t" \
    "v_pk_fma_f32 v[140:141], %[s23], v[120:121], v[140:141]\n\t" \
    "v_add_f32 v146, v140, v141\n\t" \
    "v_pk_mul_f32 v[142:143], %[s01], v[122:123]\n\t" \
    "v_pk_mul_f32 v[144:145], %[s23], v[124:125]\n\t" \
    "v_add_f32_dpp v146, v146, v146 quad_perm:[1,0,3,2] row_mask:0xf bank_mask:0xf bound_ctrl:1\n\t" \
    "v_add_f32_dpp %[yp], %[yp], %[yp] quad_perm:[1,0,3,2] row_mask:0xf bank_mask:0xf bound_ctrl:1\n\t" \
    "v_pk_fma_f32 v[142:143], v[138:139], v[130:131], v[142:143] op_sel_hi:[0,1,1]\n\t" \
    "v_add_f32_dpp v146, v146, v146 quad_perm:[2,3,0,1] row_mask:0xf bank_mask:0xf bound_ctrl:1\n\t" \
    "v_add_f32_dpp %[yp], %[yp], %[yp] quad_perm:[2,3,0,1] row_mask:0xf bank_mask:0xf bound_ctrl:1\n\t" \
    "v_pk_fma_f32 v[144:145], v[138:139], v[132:133], v[144:145] op_sel_hi:[0,1,1]\n\t" \
    "v_add_f32_dpp v146, v146, v146 row_half_mirror row_mask:0xf bank_mask:0xf bound_ctrl:1\n\t" \
    "v_add_f32_dpp %[yp], %[yp], %[yp] row_half_mirror row_mask:0xf bank_mask:0xf bound_ctrl:1\n\t" \
    "v_cmp_eq_u32_e32 vcc, 8, %[sp]\n\t" \
    "v_add_f32_dpp v146, v146, v146 row_mirror row_mask:0xf bank_mask:0xf bound_ctrl:1\n\t" \
    "v_add_f32_dpp %[yp], %[yp], %[yp] row_mirror row_mask:0xf bank_mask:0xf bound_ctrl:1\n\t" \
    "v_cndmask_b32_e32 %[yk1], %[yk1], %[yp], vcc\n\t" \
    "v_pk_fma_f32 %[s01], v[146:147], v[126:127], v[142:143] op_sel_hi:[0,1,1] neg_lo:[1,0,0] neg_hi:[1,0,0]\n\t" \
    "v_pk_fma_f32 %[s23], v[146:147], v[128:129], v[144:145] op_sel_hi:[0,1,1] neg_lo:[1,0,0] neg_hi:[1,0,0]\n\t" \
    "v_pk_mul_f32 v[140:141], %[s01], v[134:135]\n\t" \
    "v_pk_fma_f32 v[140:141], %[s23], v[136:137], v[140:141]\n\t" \
    "v_add_f32 %[yp], v140, v141\n\t" \
    "s_waitcnt lgkmcnt(0)\n\t" \
    "ds_read_b128 v[118:121], %[ab] offset:31488\n\t" \
    "ds_read_b128 v[122:125], %[ab] offset:6912\n\t" \
    "ds_read_b128 v[126:129], %[ab] offset:23296\n\t" \
    "ds_read_b128 v[130:133], %[ab] offset:15104\n\t" \
    "ds_read_b128 v[134:137], %[ab] offset:39680\n\t" \
    "ds_read_b32 v138, %[av] offset:1728\n\t" \
    "v_pk_mul_f32 v[140:141], %[s01], v[96:97]\n\t" \
    "v_pk_fma_f32 v[140:141], %[s23], v[98:99], v[140:141]\n\t" \
    "v_add_f32 v146, v140, v141\n\t" \
    "v_pk_mul_f32 v[142:143], %[s01], v[100:101]\n\t" \
    "v_pk_mul_f32 v[144:145], %[s23], v[102:103]\n\t" \
    "v_add_f32_dpp v146, v146, v146 quad_perm:[1,0,3,2] row_mask:0xf bank_mask:0xf bound_ctrl:1\n\t" \
    "v_add_f32_dpp %[yp], %[yp], %[yp] quad_perm:[1,0,3,2] row_mask:0xf bank_mask:0xf bound_ctrl:1\n\t" \
    "v_pk_fma_f32 v[142:143], v[116:117], v[108:109], v[142:143] op_sel_hi:[0,1,1]\n\t" \
    "v_add_f32_dpp v146, v146, v146 quad_perm:[2,3,0,1] row_mask:0xf bank_mask:0xf bound_ctrl:1\n\t" \
    "v_add_f32_dpp %[yp], %[yp], %[yp] quad_perm:[2,3,0,1] row_mask:0xf bank_mask:0xf bound_ctrl:1\n\t" \
    "v_pk_fma_f32 v[144:145], v[116:117], v[110:111], v[144:145] op_sel_hi:[0,1,1]\n\t" \
    "v_add_f32_dpp v146, v146, v146 row_half_mirror row_mask:0xf bank_mask:0xf bound_ctrl:1\n\t" \
    "v_add_f32_dpp %[yp], %[yp], %[yp] row_half_mirror row_mask:0xf bank_mask:0xf bound_ctrl:1\n\t" \
    "v_cmp_eq_u32_e32 vcc, 9, %[sp]\n\t" \
    "v_add_f32_dpp v146, v146, v146 row_mirror row_mask:0xf bank_mask:0xf bound_ctrl:1\n\t" \
    "v_add_f32_dpp %[yp], %[yp], %[yp] row_mirror row_mask:0xf bank_mask:0xf bound_ctrl:1\n\t" \
    "v_cndmask_b32_e32 %[yk1], %[yk1], %[yp], vcc\n\t" \
    "v_pk_fma_f32 %[s01], v[146:147], v[104:105], v[142:143] op_sel_hi:[0,1,1] neg_lo:[1,0,0] neg_hi:[1,0,0]\n\t" \
    "v_pk_fma_f32 %[s23], v[146:147], v[106:107], v[144:145] op_sel_hi:[0,1,1] neg_lo:[1,0,0] neg_hi:[1,0,0]\n\t" \
    "v_pk_mul_f32 v[140:141], %[s01], v[112:113]\n\t" \
    "v_pk_fma_f32 v[140:141], %[s23], v[114:115], v[140:141]\n\t" \
    "v_add_f32 %[yp], v140, v141\n\t" \
    "s_waitcnt lgkmcnt(0)\n\t" \
    "ds_read_b128 v[96:99], %[ab] offset:31744\n\t" \
    "ds_read_b128 v[100:103], %[ab] offset:7168\n\t" \
    "ds_read_b128 v[104:107], %[ab] offset:23552\n\t" \
    "ds_read_b128 v[108:111], %[ab] offset:15360\n\t" \
    "ds_read_b128 v[112:115], %[ab] offset:39936\n\t" \
    "ds_read_b32 v116, %[av] offset:1792\n\t" \
    "v_pk_mul_f32 v[140:141], %[s01], v[118:119]\n\t" \
    "v_pk_fma_f32 v[140:141], %[s23], v[120:121], v[140:141]\n\t" \
    "v_add_f32 v146, v140, v141\n\t" \
    "v_pk_mul_f32 v[142:143], %[s01], v[122:123]\n\t" \
    "v_pk_mul_f32 v[144:145], %[s23], v[124:125]\n\t" \
    "v_add_f32_dpp v146, v146, v146 quad_perm:[1,0,3,2] row_mask:0xf bank_mask:0xf bound_ctrl:1\n\t" \
    "v_add_f32_dpp %[yp], %[yp], %[yp] quad_perm:[1,0,3,2] row_mask:0xf bank_mask:0xf bound_ctrl:1\n\t" \
    "v_pk_fma_f32 v[142:143], v[138:139], v[130:131], v[142:143] op_sel_hi:[0,1,1]\n\t" \
    "v_add_f32_dpp v146, v146, v146 quad_perm:[2,3,0,1] row_mask:0xf bank_mask:0xf bound_ctrl:1\n\t" \
    "v_add_f32_dpp %[yp], %[yp], %[yp] quad_perm:[2,3,0,1] row_mask:0xf bank_mask:0xf bound_ctrl:1\n\t" \
    "v_pk_fma_f32 v[144:145], v[138:139], v[132:133], v[144:145] op_sel_hi:[0,1,1]\n\t" \
    "v_add_f32_dpp v146, v146, v146 row_half_mirror row_mask:0xf bank_mask:0xf bound_ctrl:1\n\t" \
    "v_add_f32_dpp %[yp], %[yp], %[yp] row_half_mirror row_mask:0xf bank_mask:0xf bound_ctrl:1\n\t" \
    "v_cmp_eq_u32_e32 vcc, 10, %[sp]\n\t" \
    "v_add_f32_dpp v146, v146, v146 row_mirror row_mask:0xf bank_mask:0xf bound_ctrl:1\n\t" \
    "v_add_f32_dpp %[yp], %[yp], %[yp] row_mirror row_mask:0xf bank_mask:0xf bound_ctrl:1\n\t" \
    "v_cndmask_b32_e32 %[yk1], %[yk1], %[yp], vcc\n\t" \
    "v_pk_fma_f32 %[s01], v[146:147], v[126:127], v[142:143] op_sel_hi:[0,1,1] neg_lo:[1,0,0] neg_hi:[1,0,0]\n\t" \
    "v_pk_fma_f32 %[s23], v[146:147], v[128:129], v[144:145] op_sel_hi:[0,1,1] neg_lo:[1,0,0] neg_hi:[1,0,0]\n\t" \
    "v_pk_mul_f32 v[140:141], %[s01], v[134:135]\n\t" \
    "v_pk_fma_f32 v[140:141], %[s23], v[136:137], v[140:141]\n\t" \
    "v_add_f32 %[yp], v140, v141\n\t" \
    "s_waitcnt lgkmcnt(0)\n\t" \
    "ds_read_b128 v[118:121], %[ab] offset:32000\n\t" \
    "ds_read_b128 v[122:125], %[ab] offset:7424\n\t" \
    "ds_read_b128 v[126:129], %[ab] offset:23808\n\t" \
    "ds_read_b128 v[130:133], %[ab] offset:15616\n\t" \
    "ds_read_b128 v[134:137], %[ab] offset:40192\n\t" \
    "ds_read_b32 v138, %[av] offset:1856\n\t" \
    "v_pk_mul_f32 v[140:141], %[s01], v[96:97]\n\t" \
    "v_pk_fma_f32 v[140:141], %[s23], v[98:99], v[140:141]\n\t" \
    "v_add_f32 v146, v140, v141\n\t" \
    "v_pk_mul_f32 v[142:143], %[s01], v[100:101]\n\t" \
    "v_pk_mul_f32 v[144:145], %[s23], v[102:103]\n\t" \
    "v_add_f32_dpp v146, v146, v146 quad_perm:[1,0,3,2] row_mask:0xf bank_mask:0xf bound_ctrl:1\n\t" \
    "v_add_f32_dpp %[yp], %[yp], %[yp] quad_perm:[1,0,3,2] row_mask:0xf bank_mask:0xf bound_ctrl:1\n\t" \
    "v_pk_fma_f32 v[142:143], v[116:117], v[108:109], v[142:143] op_sel_hi:[0,1,1]\n\t" \
    "v_add_f32_dpp v146, v146, v146 quad_perm:[2,3,0,1] row_mask:0xf bank_mask:0xf bound_ctrl:1\n\t" \
    "v_add_f32_dpp %[yp], %[yp], %[yp] quad_perm:[2,3,0,1] row_mask:0xf bank_mask:0xf bound_ctrl:1\n\t" \
    "v_pk_fma_f32 v[144:145], v[116:117], v[110:111], v[144:145] op_sel_hi:[0,1,1]\n\t" \
    "v_add_f32_dpp v146, v146, v146 row_half_mirror row_mask:0xf bank_mask:0xf bound_ctrl:1\n\t" \
    "v_add_f32_dpp %[yp], %[yp], %[yp] row_half_mirror row_mask:0xf bank_mask:0xf bound_ctrl:1\n\t" \
    "v_cmp_eq_u32_e32 vcc, 11, %[sp]\n\t" \
    "v_add_f32_dpp v146, v146, v146 row_mirror row_mask:0xf bank_mask:0xf bound_ctrl:1\n\t" \
    "v_add_f32_dpp %[yp], %[yp], %[yp] row_mirror row_mask:0xf bank_mask:0xf bound_ctrl:1\n\t" \
    "v_cndmask_b32_e32 %[yk1], %[yk1], %[yp], vcc\n\t" \
    "v_pk_fma_f32 %[s01], v[146:147], v[104:105], v[142:143] op_sel_hi:[0,1,1] neg_lo:[1,0,0] neg_hi:[1,0,0]\n\t" \
    "v_pk_fma_f32 %[s23], v[146:147], v[106:107], v[144:145] op_sel_hi:[0,1,1] neg_lo:[1,0,0] neg_hi:[1,0,0]\n\t" \
    "v_pk_mul_f32 v[140:141], %[s01], v[112:113]\n\t" \
    "v_pk_fma_f32 v[140:141], %[s23], v[114:115], v[140:141]\n\t" \
    "v_add_f32 %[yp], v140, v141\n\t" \
    "s_waitcnt lgkmcnt(0)\n\t" \
    "ds_read_b128 v[96:99], %[ab] offset:32256\n\t" \
    "ds_read_b128 v[100:103], %[ab] offset:7680\n\t" \
    "ds_read_b128 v[104:107], %[ab] offset:24064\n\t" \
    "ds_read_b128 v[108:111], %[ab] offset:15872\n\t" \
    "ds_read_b128 v[112:115], %[ab] offset:40448\n\t" \
    "ds_read_b32 v116, %[av] offset:1920\n\t" \
    "v_pk_mul_f32 v[140:141], %[s01], v[118:119]\n\t" \
    "v_pk_fma_f32 v[140:141], %[s23], v[120:121], v[140:141]\n\t" \
    "v_add_f32 v146, v140, v141\n\t" \
    "v_pk_mul_f32 v[142:143], %[s01], v[122:123]\n\t" \
    "v_pk_mul_f32 v[144:145], %[s23], v[124:125]\n\t" \
    "v_add_f32_dpp v146, v146, v146 quad_perm:[1,0,3,2] row_mask:0xf bank_mask:0xf bound_ctrl:1\n\t" \
    "v_add_f32_dpp %[yp], %[yp], %[yp] quad_perm:[1,0,3,2] row_mask:0xf bank_mask:0xf bound_ctrl:1\n\t" \
    "v_pk_fma_f32 v[142:143], v[138:139], v[130:131], v[142:143] op_sel_hi:[0,1,1]\n\t" \
    "v_add_f32_dpp v146, v146, v146 quad_perm:[2,3,0,1] row_mask:0xf bank_mask:0xf bound_ctrl:1\n\t" \
    "v_add_f32_dpp %[yp], %[yp], %[yp] quad_perm:[2,3,0,1] row_mask:0xf bank_mask:0xf bound_ctrl:1\n\t" \
    "v_pk_fma_f32 v[144:145], v[138:139], v[132:133], v[144:145] op_sel_hi:[0,1,1]\n\t" \
    "v_add_f32_dpp v146, v146, v146 row_half_mirror row_mask:0xf bank_mask:0xf bound_ctrl:1\n\t" \
    "v_add_f32_dpp %[yp], %[yp], %[yp] row_half_mirror row_mask:0xf bank_mask:0xf bound_ctrl:1\n\t" \
    "v_cmp_eq_u32_e32 vcc, 12, %[sp]\n\t" \
    "v_add_f32_dpp v146, v146, v146 row_mirror row_mask:0xf bank_mask:0xf bound_ctrl:1\n\t" \
    "v_add_f32_dpp %[yp], %[yp], %[yp] row_mirror row_mask:0xf bank_mask:0xf bound_ctrl:1\n\t" \
    "v_cndmask_b32_e32 %[yk1], %[yk1], %[yp], vcc\n\t" \
    "v_pk_fma_f32 %[s01], v[146:147], v[126:127], v[142:143] op_sel_hi:[0,1,1] neg_lo:[1,0,0] neg_hi:[1,0,0]\n\t" \
    "v_pk_fma_f32 %[s23], v[146:147], v[128:129], v[144:145] op_sel_hi:[0,1,1] neg_lo:[1,0,0] neg_hi:[1,0,0]\n\t" \
    "v_pk_mul_f32 v[140:141], %[s01], v[134:135]\n\t" \
    "v_pk_fma_f32 v[140:141], %[s23], v[136:137], v[140:141]\n\t" \
    "v_add_f32 %[yp], v140, v141\n\t" \
    "s_waitcnt lgkmcnt(0)\n\t" \
    "ds_read_b128 v[118:121], %[ab] offset:32512\n\t" \
    "ds_read_b128 v[122:125], %[ab] offset:7936\n\t" \
    "ds_read_b128 v[126:129], %[ab] offset:24320\n\t" \
    "ds_read_b128 v[130:133], %[ab] offset:16128\n\t" \
    "ds_read_b128 v[134:137], %[ab] offset:40704\n\t" \
    "ds_read_b32 v138, %[av] offset:1984\n\t" \
    "v_pk_mul_f32 v[140:141], %[s01], v[96:97]\n\t" \
    "v_pk_fma_f32 v[140:141], %[s23], v[98:99], v[140:141]\n\t" \
    "v_add_f32 v146, v140, v141\n\t" \
    "v_pk_mul_f32 v[142:143], %[s01], v[100:101]\n\t" \
    "v_pk_mul_f32 v[144:145], %[s23], v[102:103]\n\t" \
    "v_add_f32_dpp v146, v146, v146 quad_perm:[1,0,3,2] row_mask:0xf bank_mask:0xf bound_ctrl:1\n\t" \
    "v_add_f32_dpp %[yp], %[yp], %[yp] quad_perm:[1,0,3,2] row_mask:0xf bank_mask:0xf bound_ctrl:1\n\t" \
    "v_pk_fma_f32 v[142:143], v[116:117], v[108:109], v[142:143] op_sel_hi:[0,1,1]\n\t" \
    "v_add_f32_dpp v146, v146, v146 quad_perm:[2,3,0,1] row_mask:0xf bank_mask:0xf bound_ctrl:1\n\t" \
    "v_add_f32_dpp %[yp], %[yp], %[yp] quad_perm:[2,3,0,1] row_mask:0xf bank_mask:0xf bound_ctrl:1\n\t" \
    "v_pk_fma_f32 v[144:145], v[116:117], v[110:111], v[144:145] op_sel_hi:[0,1,1]\n\t" \
    "v_add_f32_dpp v146, v146, v146 row_half_mirror row_mask:0xf bank_mask:0xf bound_ctrl:1\n\t" \
    "v_add_f32_dpp %[yp], %[yp], %[yp] row_half_mirror row_mask:0xf bank_mask:0xf bound_ctrl:1\n\t" \
    "v_cmp_eq_u32_e32 vcc, 13, %[sp]\n\t" \
    "v_add_f32_dpp v146, v146, v146 row_mirror row_mask:0xf bank_mask:0xf bound_ctrl:1\n\t" \
    "v_add_f32_dpp %[yp], %[yp], %[yp] row_mirror row_mask:0xf bank_mask:0xf bound_ctrl:1\n\t" \
    "v_cndmask_b32_e32 %[yk1], %[yk1], %[yp], vcc\n\t" \
    "v_pk_fma_f32 %[s01], v[146:147], v[104:105], v[142:143] op_sel_hi:[0,1,1] neg_lo:[1,0,0] neg_hi:[1,0,0]\n\t" \
    "v_pk_fma_f32 %[s23], v[146:147], v[106:107], v[144:145] op_sel_hi:[0,1,1] neg_lo:[1,0,0] neg_hi:[1,0,0]\n\t" \
    "v_pk_mul_f32 v[140:141], %[s01], v[112:113]\n\t" \
    "v_pk_fma_f32 v[140:141], %[s23], v[114:115], v[140:141]\n\t" \
    "v_add_f32 %[yp], v140, v141\n\t" \
    "s_waitcnt lgkmcnt(0)\n\t" \
    "ds_read_b128 v[96:99], %[ab] offset:32768\n\t" \
    "ds_read_b128 v[100:103], %[ab] offset:8192\n\t" \
    "ds_read_b128 v[104:107], %[ab] offset:24576\n\t" \
    "ds_read_b128 v[108:111], %[ab] offset:16384\n\t" \
    "ds_read_b128 v[112:115], %[ab] offset:40960\n\t" \
    "ds_read_b32 v116, %[av] offset:2048\n\t" \
    "v_pk_mul_f32 v[140:141], %[s01], v[118:119]\n\t" \
    "v_pk_fma_f32 v[140:141], %[s23], v[120:121], v[140:141]\n\t" \
    "v_add_f32 v146, v140, v141\n\t" \
    "v_pk_mul_f32 v[142:143], %[s01], v[122:123]\n\t" \
    "v_pk_mul_f32 v[144:145], %[s23], v[124:125]\n\t" \
    "v_add_f32_dpp v146, v146, v146 quad_perm:[1,0,3,2] row_mask:0xf bank_mask:0xf bound_ctrl:1\n\t" \
    "v_add_f32_dpp %[yp], %[yp], %[yp] quad_perm:[1,0,3,2] row_mask:0xf bank_mask:0xf bound_ctrl:1\n\t" \
    "v_pk_fma_f32 v[142:143], v[138:139], v[130:131], v[142:143] op_sel_hi:[0,1,1]\n\t" \
    "v_add_f32_dpp v146, v146, v146 quad_perm:[2,3,0,1] row_mask:0xf bank_mask:0xf bound_ctrl:1\n\t" \
    "v_add_f32_dpp %[yp], %[yp], %[yp] quad_perm:[2,3,0,1] row_mask:0xf bank_mask:0xf bound_ctrl:1\n\t" \
    "v_pk_fma_f32 v[144:145], v[138:139], v[132:133], v[144:145] op_sel_hi:[0,1,1]\n\t" \
    "v_add_f32_dpp v146, v146, v146 row_half_mirror row_mask:0xf bank_mask:0xf bound_ctrl:1\n\t" \
    "v_add_f32_dpp %[yp], %[yp], %[yp] row_half_mirror row_mask:0xf bank_mask:0xf bound_ctrl:1\n\t" \
    "v_cmp_eq_u32_e32 vcc, 14, %[sp]\n\t" \
    "v_add_f32_dpp v146, v146, v146 row_mirror row_mask:0xf bank_mask:0xf bound_ctrl:1\n\t" \
    "v_add_f32_dpp %[yp], %[yp], %[yp] row_mirror row_mask:0xf bank_mask:0xf bound_ctrl:1\n\t" \
    "v_cndmask_b32_e32 %[yk1], %[yk1], %[yp], vcc\n\t" \
    "v_pk_fma_f32 %[s01], v[146:147], v[126:127], v[142:143] op_sel_hi:[0,1,1] neg_lo:[1,0,0] neg_hi:[1,0,0]\n\t" \
    "v_pk_fma_f32 %[s23], v[146:147], v[128:129], v[144:145] op_sel_hi:[0,1,1] neg_lo:[1,0,0] neg_hi:[1,0,0]\n\t" \
    "v_pk_mul_f32 v[140:141], %[s01], v[134:135]\n\t" \
    "v_pk_fma_f32 v[140:141], %[s23], v[136:137], v[140:141]\n\t" \
    "v_add_f32 %[yp], v140, v141\n\t" \
    "s_waitcnt lgkmcnt(0)\n\t"
#define SCAN_CHUNK_CLOBBERS "v96", "v97", "v98", "v99", "v100", "v101", "v102", "v103", "v104", "v105", "v106", "v107", "v108", "v109", "v110", "v111", "v112", "v113", "v114", "v115", "v116", "v117", "v118", "v119", "v120", "v121", "v122", "v123", "v124", "v125", "v126", "v127", "v128", "v129", "v130", "v131", "v132", "v133", "v134", "v135", "v136", "v137", "v138", "v139", "v140", "v141", "v142", "v143", "v144", "v145", "v146", "v147", "vcc", "memory"
#ifndef EMU
#define UNR _Pragma("unroll")
#define UNR1 _Pragma("unroll 1")
#define CFENCE() asm volatile("" ::: "memory")
#define OPAQUE(x) asm volatile("" : "+v"(x))
#define SYNC() __syncthreads()
#define WAVE_SYNC() do { asm volatile("s_waitcnt lgkmcnt(0)" ::: "memory"); __builtin_amdgcn_wave_barrier(); } while (0)
DEVFN float shfl_xor_f(float v, int m) { return __shfl_xor(v, m); }
DEVFN float shfl_f(float v, int src) { return __shfl(v, src); }
DEVFN void sincospi_f(float x, float* s, float* c) { sincospif(x, s, c); }
template <int M> DEVFN float rowx_add(float v) { constexpr int ctrl = M == 1 ? 0xB1 : M == 2 ? 0x4E : M == 7 ? 0x141 : 0x140;
    return v + __builtin_bit_cast(float, __builtin_amdgcn_update_dpp(0, __builtin_bit_cast(int, v), ctrl, 0xf, 0xf, true)); }
#endif

enum InIdx { I_X = 0, I_C, I_CTX, I_CCTX, I_ANORM, I_AADAW, I_AADAB, I_AWIN, I_RPB, I_QG, I_KG, I_AWOUT, I_RNORM, I_RADAW, I_RADAB, I_RWIN, I_MU, I_W0, I_WUP, I_A0, I_AUP,
             I_KK, I_KA, I_RK, I_GNW, I_GNB, I_HSHORT, I_HW1, I_HB1, I_HW2, I_HB2, I_HW3, I_HB3, I_HSKIP, I_RWOUT, I_FNORM, N_IN };

#if defined(TSEL) && !defined(EMU)
#define XSTAMP(C, k, cond) do { if ((cond) && (C).tid == 0) __hip_atomic_store((unsigned long long*)((C).ws + WS_CTL + 32768) + (k), (unsigned long long)__builtin_amdgcn_s_memrealtime(), __ATOMIC_RELAXED, __HIP_MEMORY_SCOPE_AGENT); } while (0)
#else
#define XSTAMP(C, k, cond) do {} while (0)
#endif
#if defined(TSEL) && !defined(EMU)
#define TACC_DECL unsigned long long tacc_ = 0, tb_ = 0
#define TACC_BEGIN tb_ = __builtin_amdgcn_s_memrealtime()
#define TACC_END tacc_ += __builtin_amdgcn_s_memrealtime() - tb_
#define TACC_STORE(C, k, cond) do { if (cond) __hip_atomic_store((unsigned long long*)((C).ws + WS_CTL + 32768) + (k), tacc_, __ATOMIC_RELAXED, __HIP_MEMORY_SCOPE_AGENT); } while (0)
#else
#define TACC_DECL
#define TACC_BEGIN
#define TACC_END
#define TACC_STORE(C, k, cond)
#endif
struct Ctx {
    const float* in[N_IN]; float* out; unsigned char* ws;
    int tid, lane, wave, vcu, G;
};

#ifdef EMU
DEVFN float wave_sum(float v) { for (int o = 1; o < 64; o <<= 1) v += shfl_xor_f(v, o); return v; }
DEVFN float swap16_f(float v) { return shfl_xor_f(v, 16); }
#else
DEVFN float wave_sum(float v) { v = rowx_add<1>(v); v = rowx_add<2>(v); v = rowx_add<7>(v); v = rowx_add<15>(v);
    const int i_ = __builtin_bit_cast(int, v);
    return (__builtin_bit_cast(float, __builtin_amdgcn_readlane(i_, 0)) + __builtin_bit_cast(float, __builtin_amdgcn_readlane(i_, 16))) + (__builtin_bit_cast(float, __builtin_amdgcn_readlane(i_, 32)) + __builtin_bit_cast(float, __builtin_amdgcn_readlane(i_, 48))); }
DEVFN float swap16_f(float v) { return __builtin_bit_cast(float, __builtin_amdgcn_ds_swizzle(__builtin_bit_cast(int, v), 0x401F)); }
#endif

DEVFN U4 ld16(const void* p) { return *(const U4*)p; }
DEVFN void st16(void* p, U4 v) { *(U4*)p = v; }
DEVFN void unpack8(U4 w, float* f) { f[0] = bflo(w.x); f[1] = bfhi(w.x); f[2] = bflo(w.y); f[3] = bfhi(w.y); f[4] = bflo(w.z); f[5] = bfhi(w.z); f[6] = bflo(w.w); f[7] = bfhi(w.w); }
DEVFN U4 pack8(const float* f) { U4 w; w.x = pk2(f[0], f[1]); w.y = pk2(f[2], f[3]); w.z = pk2(f[4], f[5]); w.w = pk2(f[6], f[7]); return w; }

DEVFN void p0_transpose_item(const float* W, int K, int N, bf16_t* WT, float* scr, int item, int lane) {
    const int nblk = N / 32, kb = item / nblk, nb = item % nblk, k0 = 64 * kb, n0 = 32 * nb;
    UNR for (int i = 0; i < 32; ++i) { const int kk = 2 * i + (lane >> 5); scr[kk * 33 + (lane & 31)] = W[(size_t)(k0 + kk) * N + n0 + (lane & 31)]; }
    WAVE_SYNC();
    const int c = lane & 7;
    UNR for (int j = 0; j < 4; ++j) { const int n = (lane >> 3) + 8 * j; const float* s = scr + (8 * c) * 33 + n;
        U4 o; o.x = pk2(s[0 * 33], s[1 * 33]); o.y = pk2(s[2 * 33], s[3 * 33]); o.z = pk2(s[4 * 33], s[5 * 33]); o.w = pk2(s[6 * 33], s[7 * 33]);
        st16(WT + (size_t)(n0 + n) * K + k0 + 8 * c, o); }
    WAVE_SYNC();
}

DEVFN void hid_rows(const float* w1, const float* b1, const float* w2, const float* b2, float* hid, int L, int gw, int NGW, int lane) {
    float w1c[33], w2c[64];
    UNR for (int i = 0; i < 33; ++i) w1c[i] = w1[i * 64 + lane];
    UNR for (int i = 0; i < 64; ++i) w2c[i] = w2[i * 64 + lane];
    const float bb1 = b1[lane], bb2 = b2[lane];
    for (int t = gw; t < L; t += NGW) {
        float feat = 0.f;
        if (lane == 0) feat = (float)t / (float)(L - 1 > 1 ? L - 1 : 1);
        else if (lane < 33) { const int b = (lane - 1) & 15; const float band = 1e-4f + (float)b * ((15.0f - 1e-4f) / 15.0f);
            const float x = 2.0f * band * (float)t / (float)L; float s, c; sincospi_f(x, &s, &c); feat = (lane <= 16) ? c : -s; }
        float a = bb1;
        UNR for (int i = 0; i < 33; ++i) a += shfl_f(feat, i) * w1c[i];
        const float h1 = sinf(a);
        float b = bb2;
        UNR for (int i = 0; i < 64; ++i) b += shfl_f(h1, i) * w2c[i];
        hid[(size_t)t * 64 + lane] = sinf(b);
    }
}

DEVFN void ph_prologue(const Ctx& C, unsigned char* lds) {
    const int gw = C.vcu * NWAVES + C.wave, NGW = C.G * NWAVES, lane = C.lane;
    float* scr = (float*)(lds + C.wave * 16384);
    {
        constexpr int I_AIN = 16 * (AIN / 32), I_OUT = 16 * 32, I_RIN = 16 * (RIN / 32);
        constexpr int NIT = 2 * (I_AIN + I_OUT + I_RIN + I_OUT);
        for (int it = gw; it < NIT; it += NGW) {
            int r = it; const int li = r & 1; r >>= 1;
            if (r < I_AIN) { p0_transpose_item(C.in[I_AWIN] + (size_t)li * DM * AIN, DM, AIN, (bf16_t*)(C.ws + WS_WAIN) + (size_t)li * AIN * DM, scr, r, lane); continue; } r -= I_AIN;
            if (r < I_OUT) { p0_transpose_item(C.in[I_AWOUT] + (size_t)li * DM * DM, DM, DM, (bf16_t*)(C.ws + WS_WAOUT) + (size_t)li * DM * DM, scr, r, lane); continue; } r -= I_OUT;
            if (r < I_RIN) { p0_transpose_item(C.in[I_RWIN] + (size_t)li * DM * RIN, DM, RIN, (bf16_t*)(C.ws + WS_WRIN) + (size_t)li * RINP * DM, scr, r, lane); continue; } r -= I_RIN;
            p0_transpose_item(C.in[I_RWOUT] + (size_t)li * DM * DM, DM, DM, (bf16_t*)(C.ws + WS_WROUT) + (size_t)li * DM * DM, scr, r, lane);
        }
        for (int e = gw * 64 + lane; e < 2 * (RINP - RIN) * DM / 8; e += NGW * 64) { const int li = e / ((RINP - RIN) * DM / 8), o = e % ((RINP - RIN) * DM / 8);
            U4 z; z.x = z.y = z.z = z.w = 0u; st16((bf16_t*)(C.ws + WS_WRIN) + (size_t)li * RINP * DM + (size_t)RIN * DM + (size_t)o * 8, z); }
    }
    {
        float* ADA = (float*)(C.ws + WS_ADA);
        for (int it = gw; it < 4 * 48; it += NGW) {
            const int layer = it / 48, cb = it % 48, col = cb * 64 + lane, i = layer >> 1;
            const float* W = (layer & 1) ? C.in[I_RADAW] + (size_t)i * DM * 3072 : C.in[I_AADAW] + (size_t)i * DM * 3072;
            const float* B = (layer & 1) ? C.in[I_RADAB] + (size_t)i * 3072 : C.in[I_AADAB] + (size_t)i * 3072;
            float a0 = 0.f, a1 = 0.f;
            for (int k0 = 0; k0 < DM; k0 += 64) {
                const float sc = silu_f(C.in[I_C][k0 + lane]), sx = silu_f(C.in[I_CCTX][k0 + lane]);
                for (int k = 0; k < 64; ++k) { const float w = W[(size_t)(k0 + k) * 3072 + col]; a0 += shfl_f(sc, k) * w; a1 += shfl_f(sx, k) * w; }
            }
            ADA[(size_t)(layer * 2 + 0) * 3072 + col] = a0 + B[col];
            ADA[(size_t)(layer * 2 + 1) * 3072 + col] = a1 + B[col];
        }
    }
    for (int i = 0; i < 2; ++i)
        hid_rows(C.in[I_HW1] + (size_t)i * 33 * 64, C.in[I_HB1] + i * 64, C.in[I_HW2] + (size_t)i * 64 * 64, C.in[I_HB2] + i * 64, (float*)(C.ws + WS_HID) + (size_t)i * NLAT * 64, NLAT, gw, NGW, lane);
    hid_rows(C.in[I_HW1], C.in[I_HB1], C.in[I_HW2], C.in[I_HB2], (float*)(C.ws + WS_HID256), NCTX, gw, NGW, lane);
    { F2* TW = (F2*)(C.ws + WS_TW);
      for (int k = gw * 64 + lane; k <= 16384; k += NGW * 64) { float s, c; sincospi_f((float)k * (1.0f / 16384.0f), &s, &c); F2 w; w.x = c; w.y = -s; TW[k] = w; } }
}

DEVFN void ph_norm(const Ctx& C, int layer, const float* xlat, const float* xctx, bool do_ctx) {
    const int gw = C.vcu * NWAVES + C.wave, NGW = C.G * NWAVES, lane = C.lane, i = layer >> 1;
    const float* gain = ((layer & 1) ? C.in[I_RNORM] : C.in[I_ANORM]) + (size_t)i * DM;
    const float* ADA = (const float*)(C.ws + WS_ADA) + (size_t)layer * 2 * 3072;
    bf16_t* XN = (bf16_t*)(C.ws + WS_XN);
    const int nrows = do_ctx ? NTOK : NLAT;
    for (int m = gw; m < nrows; m += NGW) {
        const bool isctx = m >= NLAT;
        const float* xr = isctx ? xctx + (size_t)(m - NLAT) * DM : xlat + (size_t)m * DM;
        const float* ada = ADA + (isctx ? 3072 : 0);
        F4 v[4]; float s = 0.f;
        UNR for (int j = 0; j < 4; ++j) { v[j] = *(const F4*)(xr + 256 * j + 4 * lane); s += (v[j].x * v[j].x + v[j].y * v[j].y) + (v[j].z * v[j].z + v[j].w * v[j].w); }
        const float rs = 1.0f / sqrtf(wave_sum(s) * (1.0f / DM) + NORM_EPS);
        UNR for (int j = 0; j < 4; ++j) { const int c0 = 256 * j + 4 * lane;
            const F4 g = *(const F4*)(gain + c0), sh = *(const F4*)(ada + c0), sc = *(const F4*)(ada + 1024 + c0);
            U2 o; o.x = pk2(v[j].x * rs * g.x * (1.f + sc.x) + sh.x, v[j].y * rs * g.y * (1.f + sc.y) + sh.y);
            o.y = pk2(v[j].z * rs * g.z * (1.f + sc.z) + sh.z, v[j].w * rs * g.w * (1.f + sc.w) + sh.w);
            *(U2*)(XN + (size_t)m * DM + c0) = o; }
    }
}

DEVFN void ph_final(const Ctx& C) {
    const int gw = C.vcu * NWAVES + C.wave, NGW = C.G * NWAVES, lane = C.lane;
    const float* gain = C.in[I_FNORM];
    for (int m = gw; m < NLAT; m += NGW) {
        float* xr = C.out + (size_t)m * DM;
        F4 v[4]; float s = 0.f;
        UNR for (int j = 0; j < 4; ++j) { v[j] = *(const F4*)(xr + 256 * j + 4 * lane); s += (v[j].x * v[j].x + v[j].y * v[j].y) + (v[j].z * v[j].z + v[j].w * v[j].w); }
        const float rs = 1.0f / sqrtf(wave_sum(s) * (1.0f / DM) + NORM_EPS);
        UNR for (int j = 0; j < 4; ++j) { const int c0 = 256 * j + 4 * lane; const F4 g = *(const F4*)(gain + c0);
            F4 o; o.x = v[j].x * rs * g.x; o.y = v[j].y * rs * g.y; o.z = v[j].z * rs * g.z; o.w = v[j].w * rs * g.w; *(F4*)(xr + c0) = o; }
    }
}

DEVFN void ph_qkprep(const Ctx& C, int i) {
    const int gw = C.vcu * NWAVES + C.wave, NGW = C.G * NWAVES, lane = C.lane;
    bf16_t* U = (bf16_t*)(C.ws + WS_U);
    const float qg = C.in[I_QG][i * 64 + lane], kg = C.in[I_KG][i * 64 + lane];
    const int axis = lane >> 5, half = (lane >> 4) & 1, f = lane & 15;
    const float invf = exp2f(-(float)f * (13.287712379549449f / 16.0f));
    for (int m = gw; m < NTOK; m += NGW) {
        float cs = 1.f, sn = 0.f;
        if (m < NLAT) { const float pos = (float)(axis == 0 ? (m >> 6) : (m & 63)); const float ang = pos * invf; cs = cosf(ang); sn = sinf(ang); }
        bf16_t* ur = U + (size_t)m * AIN + 2048;
        for (int h = 0; h < 10; ++h) {
            const float v = bf2f(ur[h * 64 + lane]);
            const float ss = wave_sum(v * v);
            float y = v * (1.0f / sqrtf(ss * (1.0f / 64.0f) + NORM_EPS)) * (h < 8 ? qg : kg);
            const float p = swap16_f(y);
            y = half == 0 ? y * cs - p * sn : y * cs + p * sn;
            if (h < 8) y *= C2;
            ur[h * 64 + lane] = (bf16_t)f2bf(y);
        }
    }
}

DEVFN void ph_hyprep(const Ctx& C, int i, bool do_ctx, unsigned char* lds) {
    const int tid = C.tid;
    const bf16_t* UHY = (const bf16_t*)(C.ws + WS_UHY);
    const float* taps = C.in[I_HSHORT] + (size_t)i * 3 * UHY_W;
    float* T = (float*)lds;
    const int ntile_lat = 3 * 8 * 256, ntile = ntile_lat + (do_ctx ? 3 * 8 * 4 : 0);
    for (int it = C.vcu; it < ntile; it += C.G) {
        const bool isctx = it >= ntile_lat; const int r = isctx ? it - ntile_lat : it;
        const int ntb = isctx ? 4 : 256; const int tb = r % ntb, cb = (r / ntb) & 7, g = r / (ntb * 8);
        const int seg0 = isctx ? NLAT : 0, segn = isctx ? NCTX : NLAT;
        {
            const int tl = tid >> 3, c8 = (tid & 7) * 8, t = 64 * tb + tl, col = g * 512 + 64 * cb + c8;
            float um[8], u0[8], up[8];
            unpack8(ld16(UHY + (size_t)(seg0 + t) * UHY_W + col), u0);
            if (t > 0) unpack8(ld16(UHY + (size_t)(seg0 + t - 1) * UHY_W + col), um); else UNR for (int e = 0; e < 8; ++e) um[e] = 0.f;
            if (t < segn - 1) unpack8(ld16(UHY + (size_t)(seg0 + t + 1) * UHY_W + col), up); else UNR for (int e = 0; e < 8; ++e) up[e] = 0.f;
            UNR for (int e = 0; e < 8; ++e) T[(c8 + e) * 65 + tl] = um[e] * taps[col + e] + u0[e] * taps[UHY_W + col + e] + up[e] * taps[2 * UHY_W + col + e];
        }
        SYNC();
        {
            const int cl = tid >> 3, t8 = (tid & 7) * 8, ch = 64 * cb + cl;
            float v[8]; UNR for (int e = 0; e < 8; ++e) v[e] = T[cl * 65 + t8 + e];
            if (!isctx) { bf16_t* VX = (bf16_t*)(C.ws + (g == 0 ? WS_VX0 : g == 1 ? WS_VX1 : WS_VX2)); st16(VX + (size_t)ch * NLAT + 64 * tb + t8, pack8(v)); }
            else { float* VXC = (float*)(C.ws + WS_VXC) + ((size_t)g * 512 + ch) * NCTX + 64 * tb + t8; UNR for (int e = 0; e < 8; ++e) VXC[e] = v[e]; }
        }
        SYNC();
    }
}

constexpr int FFT_N = 16384;
DEVFN int fidx(int n) { return n + (n >> 4); }
DEVFN F2 cmul(F2 a, F2 b) { F2 r; r.x = a.x * b.x - a.y * b.y; r.y = a.x * b.y + a.y * b.x; return r; }
DEVFN F2 cmulc(F2 a, F2 b) { F2 r; r.x = a.x * b.x + a.y * b.y; r.y = a.y * b.x - a.x * b.y; return r; }
DEVFN F2 cadd(F2 a, F2 b) { F2 r; r.x = a.x + b.x; r.y = a.y + b.y; return r; }
DEVFN F2 csub(F2 a, F2 b) { F2 r; r.x = a.x - b.x; r.y = a.y - b.y; return r; }
DEVFN F2 cconj(F2 a) { F2 r; r.x = a.x; r.y = -a.y; return r; }
template <bool INV> DEVFN F2 mul_mi(F2 a) { F2 r; if (!INV) { r.x = a.y; r.y = -a.x; } else { r.x = -a.y; r.y = a.x; } return r; }
template <bool INV> DEVFN void dft4(F2& a0, F2& a1, F2& a2, F2& a3) {
    const F2 s02 = cadd(a0, a2), d02 = csub(a0, a2), s13 = cadd(a1, a3), d13 = mul_mi<INV>(csub(a1, a3));
    a0 = cadd(s02, s13); a2 = csub(s02, s13); a1 = cadd(d02, d13); a3 = csub(d02, d13);
}
template <bool INV> DEVFN void dft16(F2* a) {
    UNR for (int n2 = 0; n2 < 4; ++n2) dft4<INV>(a[n2], a[4 + n2], a[8 + n2], a[12 + n2]);
    const float c1 = 0.92387953251128674f, s1 = 0.38268343236508977f, r2 = 0.70710678118654752f;
    const F2 w1 = {c1, INV ? s1 : -s1}, w2 = {r2, INV ? r2 : -r2}, w3 = {s1, INV ? c1 : -c1}, w6 = {-r2, INV ? r2 : -r2}, w9 = {-c1, INV ? -s1 : s1};
    a[4 * 1 + 1] = cmul(a[4 * 1 + 1], w1); a[4 * 1 + 2] = cmul(a[4 * 1 + 2], w2); a[4 * 1 + 3] = cmul(a[4 * 1 + 3], w3);
    a[4 * 2 + 1] = cmul(a[4 * 2 + 1], w2); a[4 * 2 + 2] = mul_mi<INV>(a[4 * 2 + 2]); a[4 * 2 + 3] = cmul(a[4 * 2 + 3], w6);
    a[4 * 3 + 1] = cmul(a[4 * 3 + 1], w3); a[4 * 3 + 2] = cmul(a[4 * 3 + 2], w6); a[4 * 3 + 3] = cmul(a[4 * 3 + 3], w9);
    F2 x[16];
    UNR for (int k1 = 0; k1 < 4; ++k1) { F2 b0 = a[4 * k1 + 0], b1 = a[4 * k1 + 1], b2 = a[4 * k1 + 2], b3 = a[4 * k1 + 3]; dft4<INV>(b0, b1, b2, b3); x[k1] = b0; x[k1 + 4] = b1; x[k1 + 8] = b2; x[k1 + 12] = b3; }
    UNR for (int q = 0; q < 16; ++q) a[q] = x[q];
}
template <int R, bool INV> DEVFN void fft_stage(F2* F, const F2* TW, int B, int tid) {
    const int S = B / R, NB = FFT_N / R, tws = 2 * (FFT_N / B);
    int tq = tid; OPAQUE(tq);
    UNR1 for (int q = tq; q < NB; q += NTHREADS) {
        const int blk = q / S, j = q - blk * S, base = blk * B + j;
        F2 a[R];
        UNR for (int m = 0; m < R; ++m) a[m] = F[fidx(base + m * S)];
        if (INV && S > 1) { const F2 w1 = TW[tws * j]; F2 w = w1; UNR for (int m = 1; m < R; ++m) { a[m] = cmulc(a[m], w); w = cmul(w, w1); } }
        if constexpr (R == 4) dft4<INV>(a[0], a[1], a[2], a[3]); else dft16<INV>(a);
        if (!INV && S > 1) { const F2 w1 = TW[tws * j]; F2 w = w1; UNR for (int m = 1; m < R; ++m) { a[m] = cmul(a[m], w); w = cmul(w, w1); } }
        UNR for (int m = 0; m < R; ++m) F[fidx(base + m * S)] = a[m];
    }
}
DEVFN void fft_fwd(F2* F, const F2* TW, int tid) {
    fft_stage<4, false>(F, TW, 16384, tid); SYNC(); fft_stage<16, false>(F, TW, 4096, tid); SYNC(); fft_stage<16, false>(F, TW, 256, tid); SYNC(); fft_stage<16, false>(F, TW, 16, tid); SYNC();
}
DEVFN void fft_inv(F2* F, const F2* TW, int tid) {
    fft_stage<16, true>(F, TW, 16, tid); SYNC(); fft_stage<16, true>(F, TW, 256, tid); SYNC(); fft_stage<16, true>(F, TW, 4096, tid); SYNC(); fft_stage<4, true>(F, TW, 16384, tid); SYNC();
}
DEVFN int fpos(int k) { return ((k & 3) << 12) | (((k >> 2) & 15) << 8) | (((k >> 6) & 15) << 4) | (k >> 10); }

DEVFN float block_sum(float v, float* red, int tid) {
    v = wave_sum(v);
    if ((tid & 63) == 0) red[tid >> 6] = v;
    SYNC();
    float s = 0.f; UNR for (int w = 0; w < NWAVES; ++w) s += red[w];
    SYNC();
    return s;
}

DEVFN void hyena_channel(const Ctx& C, int i, int c, unsigned char* lds) {
    const int tid = C.tid; constexpr int L = NLAT;
    F2* F = (F2*)lds; float* Ff = (float*)lds;
    float* W3C = (float*)(lds + 139264);
    float* red = W3C + 272;
    const F2* TW = (const F2*)(C.ws + WS_TW);
    const float* hid = (const float*)(C.ws + WS_HID) + (size_t)i * NLAT * 64;
    const float* w3 = C.in[I_HW3] + (size_t)i * 64 * 2048; const float* b3 = C.in[I_HB3] + (size_t)i * 2048;
    const bf16_t* VX0 = (const bf16_t*)(C.ws + WS_VX0) + (size_t)c * L;
    const bf16_t* VX1 = (const bf16_t*)(C.ws + WS_VX1) + (size_t)c * L;
    const bf16_t* VX2 = (const bf16_t*)(C.ws + WS_VX2) + (size_t)c * L;
    bf16_t* YHY = (bf16_t*)(C.ws + WS_YHY) + (size_t)c * L;
    const float skip0 = C.in[I_HSKIP][(size_t)i * 1024 + c], skip1 = C.in[I_HSKIP][(size_t)i * 1024 + 512 + c];
    const float delta = 15.350567286626973f + (float)c * ((3.0701134573253945f - 15.350567286626973f) / 511.0f);
    if (tid < 256) { const int o = tid >> 7, s = (tid >> 6) & 1, m = tid & 63; W3C[tid] = w3[(size_t)m * 2048 + (s * 2 + o) * 512 + c]; }
    if (tid < 4) W3C[256 + tid] = b3[((tid & 1) * 2 + (tid >> 1)) * 512 + c];
    SYNC();
    UNR1 for (int o = 0; o < 2; ++o) {
        float ssq = 0.f;
        {
            const int part = tid & 3, tsub = (tid & 63) >> 2, wv = tid >> 6;
            float wf[16], wb[16];
            UNR for (int m = 0; m < 16; ++m) { wf[m] = W3C[(o * 2 + 0) * 64 + 16 * part + m]; wb[m] = W3C[(o * 2 + 1) * 64 + 16 * part + m]; }
            const float bf_ = W3C[256 + o * 2 + 0], bb_ = W3C[256 + o * 2 + 1];
            UNR1 for (int ii = 0; ii < 128; ++ii) {
                const int t = (ii * 8 + wv) * 16 + tsub;
                const F4* hr = (const F4*)(hid + (size_t)t * 64 + 16 * part);
                float af = 0.f, ab = 0.f;
                UNR for (int m4 = 0; m4 < 4; ++m4) { const F4 h = hr[m4];
                    af += h.x * wf[4 * m4] + h.y * wf[4 * m4 + 1] + h.z * wf[4 * m4 + 2] + h.w * wf[4 * m4 + 3];
                    ab += h.x * wb[4 * m4] + h.y * wb[4 * m4 + 1] + h.z * wb[4 * m4 + 2] + h.w * wb[4 * m4 + 3]; }
                af = rowx_add<1>(af); af = rowx_add<2>(af); ab = rowx_add<1>(ab); ab = rowx_add<2>(ab);
                if (part == 0) {
                    const float win = expf(-((float)t / (float)(L - 1)) * delta);
                    af = (af + bf_) * win; ab = (ab + bb_) * win;
                    if (t == 0) { af += ab; ssq += af * af; Ff[0] = af; Ff[2 * fidx(L >> 1)] = 0.f; }
                    else { ssq += af * af + ab * ab; Ff[2 * fidx(t >> 1) + (t & 1)] = af; const int m = 2 * L - t; Ff[2 * fidx(m >> 1) + (m & 1)] = ab; }
                }
            }
        }
        const float knorm = 1.0f / sqrtf(block_sum(ssq, red, tid));
        fft_fwd(F, TW, tid);
        F2 kfa[16], kfb[16]; F2 kfh = {0.f, 0.f};
        int tq1 = tid; OPAQUE(tq1);
        UNR for (int ii = 0; ii < 16; ++ii) {
            const int k = tq1 + NTHREADS * ii;
            if (k == 0) { const F2 c0 = F[fidx(0)]; kfa[ii].x = (c0.x + c0.y) * knorm; kfa[ii].y = 0.f; kfb[ii].x = (c0.x - c0.y) * knorm; kfb[ii].y = 0.f;
                          const F2 ch = F[fidx(fpos(L / 2))]; kfh.x = ch.x * knorm; kfh.y = -ch.y * knorm; }
            else { const F2 ck = F[fidx(fpos(k))], cp = cconj(F[fidx(fpos(L - k))]);
                F2 e = cadd(ck, cp), od = csub(ck, cp); e.x *= 0.5f; e.y *= 0.5f; F2 oo; oo.x = 0.5f * od.y; oo.y = -0.5f * od.x;
                const F2 tt = cmul(TW[k], oo);
                kfa[ii] = cadd(e, tt); kfb[ii] = cconj(csub(e, tt)); kfa[ii].x *= knorm; kfa[ii].y *= knorm; kfb[ii].x *= knorm; kfb[ii].y *= knorm; }
            CFENCE();
        }
        SYNC();
        UNR for (int ii = 0; ii < 4; ++ii) {
            int tq3 = tid; OPAQUE(tq3); const int t0 = 8 * (tq3 + NTHREADS * ii); float v[8];
            unpack8(ld16((o == 0 ? VX0 : (const bf16_t*)YHY) + t0), v);
            float* d = Ff + 2 * fidx(t0 >> 1); UNR for (int e = 0; e < 8; ++e) d[e] = v[e];
            float* zz = Ff + 2 * fidx((L + t0) >> 1); UNR for (int e = 0; e < 8; ++e) zz[e] = 0.f;
        }
        SYNC();
        fft_fwd(F, TW, tid);
        int tq2 = tid; OPAQUE(tq2);
        UNR for (int ii = 0; ii < 16; ++ii) {
            const int k = tq2 + NTHREADS * ii;
            if (k == 0) { const F2 c0 = F[fidx(0)]; const float y0 = (c0.x + c0.y) * kfa[ii].x, yl = (c0.x - c0.y) * kfb[ii].x; F2 d; d.x = 0.5f * (y0 + yl); d.y = 0.5f * (y0 - yl); F[fidx(0)] = d;
                          const int ph = fidx(fpos(L / 2)); const F2 y = cmul(cconj(F[ph]), kfh); F[ph] = cconj(y); }
            else { const int pk = fidx(fpos(k)), pp = fidx(fpos(L - k)); const F2 ck = F[pk], cp = cconj(F[pp]);
                F2 e = cadd(ck, cp), od = csub(ck, cp); e.x *= 0.5f; e.y *= 0.5f; F2 oo; oo.x = 0.5f * od.y; oo.y = -0.5f * od.x;
                const F2 w = TW[k]; const F2 tt = cmul(w, oo);
                const F2 yk = cmul(cadd(e, tt), kfa[ii]), yp = cmul(cconj(csub(e, tt)), kfb[ii]);
                F2 ye = cadd(yk, cconj(yp)), yd = csub(yk, cconj(yp)); ye.x *= 0.5f; ye.y *= 0.5f; yd.x *= 0.5f; yd.y *= 0.5f;
                const F2 yo = cmulc(yd, w);
                F2 iyo; iyo.x = -yo.y; iyo.y = yo.x;
                F[pk] = cadd(ye, iyo); F[pp] = cconj(csub(ye, iyo)); }
            CFENCE();
        }
        SYNC();
        fft_inv(F, TW, tid);
        UNR for (int ii = 0; ii < 4; ++ii) {
            int tq4 = tid; OPAQUE(tq4); const int t0 = 8 * (tq4 + NTHREADS * ii); const float* d = Ff + 2 * fidx(t0 >> 1);
            float y[8]; UNR for (int e = 0; e < 8; ++e) y[e] = d[e] * (1.0f / (float)FFT_N);
            if (o == 0) { float v[8], x1[8], r[8]; unpack8(ld16(VX0 + t0), v); unpack8(ld16(VX1 + t0), x1); UNR for (int e = 0; e < 8; ++e) r[e] = x1[e] * (y[e] + v[e] * skip0); st16(YHY + t0, pack8(r)); }
            else { float x2[8], zp[8], r[8]; unpack8(ld16(VX2 + t0), x2); unpack8(ld16(YHY + t0), zp); UNR for (int e = 0; e < 8; ++e) r[e] = x2[e] * (y[e] + zp[e] * skip1); st16(YHY + t0, pack8(r)); }
        }
        SYNC();
    }
}

DEVFN void hyena_ctx_channel(const Ctx& C, int i, int c, unsigned char* lds) {
    const int tid = C.tid; constexpr int L = NCTX;
    float* KF = (float*)lds;
    float* Z = KF + 1024;
    float* red = Z + 256;
    float* W3C = red + 16;
    const float* hid = (const float*)(C.ws + WS_HID256);
    const float* w3 = C.in[I_HW3] + (size_t)i * 64 * 2048; const float* b3 = C.in[I_HB3] + (size_t)i * 2048;
    const float* VXC = (const float*)(C.ws + WS_VXC);
    const float delta = 15.350567286626973f + (float)c * ((3.0701134573253945f - 15.350567286626973f) / 511.0f);
    if (tid < 256) { const int o = tid >> 7, s = (tid >> 6) & 1, m = tid & 63; W3C[tid] = w3[(size_t)m * 2048 + (s * 2 + o) * 512 + c]; }
    if (tid < 4) W3C[256 + tid] = b3[((tid & 1) * 2 + (tid >> 1)) * 512 + c];
    SYNC();
    {
        const int o = tid >> 8, t = tid & 255;
        float af = W3C[256 + o * 2 + 0], ab = W3C[256 + o * 2 + 1];
        for (int m = 0; m < 64; ++m) { const float h = hid[t * 64 + m]; af += h * W3C[(o * 2 + 0) * 64 + m]; ab += h * W3C[(o * 2 + 1) * 64 + m]; }
        const float win = expf(-((float)t / (float)(L - 1)) * delta); af *= win; ab *= win;
        float ssq; if (t == 0) { af += ab; ab = 0.f; ssq = af * af; } else ssq = af * af + ab * ab;
        KF[(o * 2 + 0) * 256 + t] = af; KF[(o * 2 + 1) * 256 + t] = ab;
        ssq = wave_sum(ssq);
        if ((tid & 63) == 0) red[tid >> 6] = ssq;
        SYNC();
        const float tot = red[o * 4] + red[o * 4 + 1] + red[o * 4 + 2] + red[o * 4 + 3];
        const float kn = 1.0f / sqrtf(tot);
        KF[(o * 2 + 0) * 256 + t] = af * kn; KF[(o * 2 + 1) * 256 + t] = ab * kn;
    }
    float v = 0.f, x1 = 0.f, x2 = 0.f, z1 = 0.f;
    if (tid < 256) { v = VXC[((size_t)0 * 512 + c) * L + tid]; x1 = VXC[((size_t)1 * 512 + c) * L + tid]; x2 = VXC[((size_t)2 * 512 + c) * L + tid]; Z[tid] = v; }
    SYNC();
    for (int o = 0; o < 2; ++o) {
        float y = 0.f;
        if (tid < 256) { const int t = tid; const float* kf = KF + (o * 2) * 256; const float* kb = KF + (o * 2 + 1) * 256;
            for (int s = 0; s <= t; ++s) y += kf[t - s] * Z[s];
            for (int s = t + 1; s < L; ++s) y += kb[s - t] * Z[s]; }
        SYNC();
        if (tid < 256) { if (o == 0) { z1 = x1 * (y + v * C.in[I_HSKIP][(size_t)i * 1024 + c]); Z[tid] = z1; }
            else { const float r = x2 * (y + z1 * C.in[I_HSKIP][(size_t)i * 1024 + 512 + c]);
                const bf16_t* GHY = (const bf16_t*)(C.ws + WS_GHY); bf16_t* HO = (bf16_t*)(C.ws + WS_HYOUT);
                HO[(size_t)(NLAT + tid) * 512 + c] = (bf16_t)f2bf(r * bf2f(GHY[(size_t)(NLAT + tid) * 512 + c])); } }
        SYNC();
    }
}

typedef float P2 __attribute__((vector_size(8)));
#ifdef EMU
struct H8 { unsigned short v[8]; };
struct A4 { float v[4]; };
inline A4 mfma16(const H8& a, const H8& b, const A4& c) {
    static H8 sa_[emu::MAXB][8][64], sb_[emu::MAXB][8][64]; const int w = emu::t_tid >> 6, l = emu::t_tid & 63; H8 (*sa)[64] = sa_[emu::t_blk]; H8 (*sb)[64] = sb_[emu::t_blk];
    sa[w][l] = a; sb[w][l] = b; pthread_barrier_wait(&emu::g_wbar_[emu::t_blk][w]);
    A4 r = c;
    for (int reg = 0; reg < 4; ++reg) { const int row = 4 * (l >> 4) + reg, col = l & 15; float acc = 0.f;
        for (int k = 0; k < 32; ++k) acc += bf2f(sa[w][row + 16 * (k >> 3)].v[k & 7]) * bf2f(sb[w][col + 16 * (k >> 3)].v[k & 7]);
        r.v[reg] += acc; }
    pthread_barrier_wait(&emu::g_wbar_[emu::t_blk][w]);
    return r;
}
#define H8_SET(h, j, x) (h).v[j] = (unsigned short)(x)
#define A4_GET(a, j) (a).v[j]
#define MFMA_PAD(a,b,c,d,e,f,g,h)
#else
typedef short H8 __attribute__((ext_vector_type(8)));
typedef float A4 __attribute__((ext_vector_type(4)));
DEVFN A4 mfma16(const H8& a, const H8& b, const A4& c) { return __builtin_amdgcn_mfma_f32_16x16x32_bf16(a, b, c, 0, 0, 0); }
#define H8_SET(h, j, x) (h)[j] = (short)(x)
#define A4_GET(a, j) (a)[j]
#define MFMA_PAD(a,b,c,d,e,f,g,h) asm volatile("s_nop 15\n\ts_nop 15" : "+v"(a), "+v"(b), "+v"(c), "+v"(d), "+v"(e), "+v"(f), "+v"(g), "+v"(h))
#endif
#ifdef EMU
#define FEXP(x) expf(x)
#define FLOG(x) logf(x)
#define FRCP(x) (1.0f / (x))
#define FRSQ(x) (1.0f / sqrtf(x))
#define SETPRIO(n)
#else
#define FEXP(x) __expf(x)
#define FLOG(x) __logf(x)
#define FRCP(x) __builtin_amdgcn_rcpf(x)
#define FRSQ(x) __builtin_amdgcn_rsqf(x)
#define SETPRIO(n) __builtin_amdgcn_s_setprio(n)
#endif
DEVFN H8 h8_from_u4(U4 w) { H8 r; H8_SET(r, 0, w.x & 0xffff); H8_SET(r, 1, w.x >> 16); H8_SET(r, 2, w.y & 0xffff); H8_SET(r, 3, w.y >> 16); H8_SET(r, 4, w.z & 0xffff); H8_SET(r, 5, w.z >> 16); H8_SET(r, 6, w.w & 0xffff); H8_SET(r, 7, w.w >> 16); return r; }
constexpr int SC_T = 32;
constexpr int SC_R = 16;
constexpr int SC_BUF = 5 * SC_T * 64 + SC_T * SC_R;
DEVFN void rwkv_scan(const Ctx& C, int i, int h, int d, int rq, bool ctx_out, unsigned char* lds, int max_chunks) {
    const int tid = C.tid;
    float* sBUF = (float*)lds; float* sY = sBUF + 2 * SC_BUF; float* sWV = sY + 2 * SC_T * SC_R;
    const bf16_t* U = (const bf16_t*)(C.ws + WS_U);
    const float* mu = C.in[I_MU] + (size_t)i * 1664;
    const float* w0 = C.in[I_W0] + ((size_t)i * 2 + d) * 512 + 64 * h; const float* a0 = C.in[I_A0] + ((size_t)i * 2 + d) * 512 + 64 * h;
    const float* wup = C.in[I_WUP] + ((size_t)i * 2 + d) * 32 * 512 + 64 * h; const float* aup = C.in[I_AUP] + ((size_t)i * 2 + d) * 32 * 512 + 64 * h;
    const float* k_k = C.in[I_KK] + (size_t)i * 512 + 64 * h; const float* k_a = C.in[I_KA] + (size_t)i * 512 + 64 * h; const float* r_k = C.in[I_RK] + (size_t)i * 512 + 64 * h;
    bf16_t* Yd = (bf16_t*)(C.ws + (d == 0 ? WS_YF : WS_YB));
    float* BON = (float*)(C.ws + WS_BONUS) + (size_t)d * NTOK * 8;
    const bool is_scan = tid < 256;
    const int nchunks = NTOK / SC_T < max_chunks ? NTOK / SC_T : max_chunks;
    #define CHUNK_GEOM(ch, seg0, segn, R0) const bool isctx_ = (ch) < NCTX / SC_T; const int seg0 = isctx_ ? NLAT : 0, segn = isctx_ ? NCTX : NLAT; \
        const int cl_ = isctx_ ? (ch) : (ch) - NCTX / SC_T; const int R0 = d == 0 ? SC_T * cl_ : segn - SC_T * (cl_ + 1);
    const int ft = (tid & 255) >> 3, fp = tid & 7;
    float* sCN = sWV + 4 * 1280; float* sCN_base_ = sCN;
    if (tid < 64) { const int j = tid; sCN[j] = mu[64 * h + j]; sCN[64 + j] = mu[512 + 64 * h + j]; sCN[128 + j] = mu[1024 + 64 * h + j]; sCN[192 + j] = w0[j]; sCN[256 + j] = a0[j];
        sCN[320 + j] = k_k[j]; sCN[384 + j] = k_a[j]; sCN[448 + j] = r_k[j]; sCN[512 + j] = j < 32 ? mu[1536 + 32 * d + j] : mu[1600 + 32 * d + (j - 32)]; }
    U4* sBF = (U4*)(sCN_base_ + 640);
    { const int m = tid >> 8, nt = (tid >> 6) & 3, ln = tid & 63; const float* src = m == 0 ? wup : aup; float f[8];
      UNR for (int j = 0; j < 8; ++j) f[j] = src[(size_t)(8 * (ln >> 4) + j) * 512 + 16 * nt + (ln & 15)];
      sBF[tid] = pack8(f); }
    float* myWV = sWV + ((tid >> 6) & 3) * 1280; float* sWL = myWV; float* sAL = myWV + 512; bf16_t* sTDb = (bf16_t*)(myWV + 1024); bf16_t* sADb = sTDb + 256;
    const int rl = (tid & 255) >> 4, sp = tid & 15;
    float S0 = 0.f, S1 = 0.f, S2 = 0.f, S3 = 0.f;
    SYNC();
    U4 pu[9]; U2 pw[6];
    auto issue = [&](int ch) {
        int tq_ = tid; OPAQUE(tq_); const int ft = (tq_ & 255) >> 3, fp = tq_ & 7;
        CHUNK_GEOM(ch, seg0, segn, R0)
        const int tl = d == 0 ? R0 + ft : R0 + SC_T - 1 - ft;
        const bf16_t* u0p = U + (size_t)(seg0 + tl) * URW_W;
        const bool hm = tl > 0, hp = tl < segn - 1;
        const U4 z4 = {0u, 0u, 0u, 0u}; const U2 z2 = {0u, 0u};
        const int cw = 1536 + 32 * d + 4 * fp, ca = 1600 + 32 * d + 4 * fp;
        UNR for (int j = 0; j < 3; ++j) { pu[3 * j] = ld16(u0p + 512 * j + 64 * h + 8 * fp); pu[3 * j + 1] = z4; pu[3 * j + 2] = z4; }
        pw[0] = *(const U2*)(u0p + cw); pw[3] = *(const U2*)(u0p + ca); pw[1] = z2; pw[2] = z2; pw[4] = z2; pw[5] = z2;
        if (hm) { UNR for (int j = 0; j < 3; ++j) pu[3 * j + 1] = ld16(u0p - URW_W + 512 * j + 64 * h + 8 * fp); pw[1] = *(const U2*)(u0p - URW_W + cw); pw[4] = *(const U2*)(u0p - URW_W + ca); }
        if (hp) { UNR for (int j = 0; j < 3; ++j) pu[3 * j + 2] = ld16(u0p + URW_W + 512 * j + 64 * h + 8 * fp); pw[2] = *(const U2*)(u0p + URW_W + cw); pw[5] = *(const U2*)(u0p + URW_W + ca); }
    };
    auto features = [&](int ch) {
        int tq_ = tid; OPAQUE(tq_); const int ft = (tq_ & 255) >> 3, fp = tq_ & 7;
        const float* mu_r = sCN + 8 * fp; const float* mu_k = sCN + 64 + 8 * fp; const float* mu_v = sCN + 128 + 8 * fp; const float* c_w0 = sCN + 192 + 8 * fp; const float* c_a0 = sCN + 256 + 8 * fp;
        const float* c_kk = sCN + 320 + 8 * fp; const float* c_ka = sCN + 384 + 8 * fp; const float* c_rk = sCN + 448 + 8 * fp; const float* mu_w = sCN + 512 + 4 * fp; const float* mu_a = sCN + 544 + 4 * fp;
        CHUNK_GEOM(ch, seg0, segn, R0)
        float* B_ = sBUF + (ch & 1) * SC_BUF; float* sW = B_; float* sKD = B_ + SC_T * 64; float* sB = B_ + 2 * SC_T * 64; float* sKK = B_ + 3 * SC_T * 64; float* sR = B_ + 4 * SC_T * 64; float* sV = B_ + 5 * SC_T * 64;
        const int tl = d == 0 ? R0 + ft : R0 + SC_T - 1 - ft;
        float r[8], k[8], v[8];
        {
            float a[8], m[8], p[8];
            #define SHIFT3(J, MU, OUT) do { unpack8(pu[3 * (J)], a); unpack8(pu[3 * (J) + 1], m); unpack8(pu[3 * (J) + 2], p); \
                UNR for (int e = 0; e < 8; ++e) OUT[e] = a[e] + (0.5f * (m[e] + p[e]) - a[e]) * MU[e]; } while (0)
            SHIFT3(0, mu_r, r); SHIFT3(1, mu_k, k); SHIFT3(2, mu_v, v);
            #undef SHIFT3
        }
        {
            const U2 w0_ = pw[0], wm = pw[1], wp = pw[2], a0_ = pw[3], am = pw[4], ap = pw[5];
            const float wa[4] = {bflo(w0_.x), bfhi(w0_.x), bflo(w0_.y), bfhi(w0_.y)}, wmm[4] = {bflo(wm.x), bfhi(wm.x), bflo(wm.y), bfhi(wm.y)}, wpp[4] = {bflo(wp.x), bfhi(wp.x), bflo(wp.y), bfhi(wp.y)};
            const float aa[4] = {bflo(a0_.x), bfhi(a0_.x), bflo(a0_.y), bfhi(a0_.y)}, amm[4] = {bflo(am.x), bfhi(am.x), bflo(am.y), bfhi(am.y)}, app[4] = {bflo(ap.x), bfhi(ap.x), bflo(ap.y), bfhi(ap.y)};
            if (ch + 1 < nchunks) issue(ch + 1);
            const int tw = ft & 7;
            float tdv[4], adv[4];
            UNR for (int e = 0; e < 4; ++e) { const float x = wa[e] + (0.5f * (wmm[e] + wpp[e]) - wa[e]) * mu_w[e];
                tdv[e] = 1.0f - 2.0f * FRCP(1.0f + FEXP(2.0f * x));
                adv[e] = aa[e] + (0.5f * (amm[e] + app[e]) - aa[e]) * mu_a[e]; }
            U2 tq, aq; tq.x = pk2(tdv[0], tdv[1]); tq.y = pk2(tdv[2], tdv[3]); aq.x = pk2(adv[0], adv[1]); aq.y = pk2(adv[2], adv[3]);
            *(U2*)(sTDb + tw * 32 + 4 * fp) = tq; *(U2*)(sADb + tw * 32 + 4 * fp) = aq;
        }
        WAVE_SYNC();
        float wl[8], al[8];
        {
            const int lane = tid & 63, arow = lane & 7, kg = lane >> 4;
            const U4 ta = ld16(sTDb + arow * 32 + 8 * kg), aa_ = ld16(sADb + arow * 32 + 8 * kg);
            H8 At, Aa;
            H8_SET(At, 0, ta.x & 0xffff); H8_SET(At, 1, ta.x >> 16); H8_SET(At, 2, ta.y & 0xffff); H8_SET(At, 3, ta.y >> 16); H8_SET(At, 4, ta.z & 0xffff); H8_SET(At, 5, ta.z >> 16); H8_SET(At, 6, ta.w & 0xffff); H8_SET(At, 7, ta.w >> 16);
            H8_SET(Aa, 0, aa_.x & 0xffff); H8_SET(Aa, 1, aa_.x >> 16); H8_SET(Aa, 2, aa_.y & 0xffff); H8_SET(Aa, 3, aa_.y >> 16); H8_SET(Aa, 4, aa_.z & 0xffff); H8_SET(Aa, 5, aa_.z >> 16); H8_SET(Aa, 6, aa_.w & 0xffff); H8_SET(Aa, 7, aa_.w >> 16);
            A4 cw_[4], ca_[4];
            UNR for (int nt = 0; nt < 4; ++nt) {
                A4 z; A4_GET(z, 0) = 0.f; A4_GET(z, 1) = 0.f; A4_GET(z, 2) = 0.f; A4_GET(z, 3) = 0.f;
                cw_[nt] = mfma16(At, h8_from_u4(sBF[nt * 64 + (tid & 63)]), z); ca_[nt] = mfma16(Aa, h8_from_u4(sBF[(4 + nt) * 64 + (tid & 63)]), z);
            }
            MFMA_PAD(cw_[0], cw_[1], cw_[2], cw_[3], ca_[0], ca_[1], ca_[2], ca_[3]);
            if (lane < 32) { UNR for (int nt = 0; nt < 4; ++nt) UNR for (int rg = 0; rg < 4; ++rg) { const int tok = 4 * (lane >> 4) + rg; sWL[tok * 64 + 16 * nt + (lane & 15)] = A4_GET(cw_[nt], rg); sAL[tok * 64 + 16 * nt + (lane & 15)] = A4_GET(ca_[nt], rg); } }
            WAVE_SYNC();
            const int tw = ft & 7;
            { const F4 w0_ = *(const F4*)(sWL + tw * 64 + 8 * fp), w1_ = *(const F4*)(sWL + tw * 64 + 8 * fp + 4), a0_ = *(const F4*)(sAL + tw * 64 + 8 * fp), a1_ = *(const F4*)(sAL + tw * 64 + 8 * fp + 4);
              const F4 cw0 = *(const F4*)(c_w0), cw1 = *(const F4*)(c_w0 + 4), ca0 = *(const F4*)(c_a0), ca1 = *(const F4*)(c_a0 + 4);
              wl[0] = cw0.x + w0_.x; wl[1] = cw0.y + w0_.y; wl[2] = cw0.z + w0_.z; wl[3] = cw0.w + w0_.w; wl[4] = cw1.x + w1_.x; wl[5] = cw1.y + w1_.y; wl[6] = cw1.z + w1_.z; wl[7] = cw1.w + w1_.w;
              al[0] = ca0.x + a0_.x; al[1] = ca0.y + a0_.y; al[2] = ca0.z + a0_.z; al[3] = ca0.w + a0_.w; al[4] = ca1.x + a1_.x; al[5] = ca1.y + a1_.y; al[6] = ca1.z + a1_.z; al[7] = ca1.w + a1_.w; }
            WAVE_SYNC();
        }
        float kkv[8], ssq = 0.f;
        UNR for (int e = 0; e < 8; ++e) { kkv[e] = k[e] * c_kk[e]; ssq += kkv[e] * kkv[e]; }
        ssq = rowx_add<1>(ssq); ssq = rowx_add<2>(ssq); ssq = rowx_add<7>(ssq);
        const float kn = FRSQ(ssq + 1e-12f);
        float bon = 0.f; float o_w[8], o_kd[8], o_b[8], o_kk[8];
        UNR for (int e = 0; e < 8; ++e) {
            const float dec = FEXP(-0.60653066f * FRCP(1.0f + FEXP(-wl[e])));
            const float a = FRCP(1.0f + FEXP(-al[e]));
            const float kd = k[e] * (1.0f + (a - 1.0f) * c_ka[e]);
            const float kk = kkv[e] * kn;
            o_w[e] = dec; o_kd[e] = kd; o_b[e] = kk * a; o_kk[e] = kk;
            bon += r[e] * kd * c_rk[e];
        }
        { const int o = ft * 64 + 8 * fp;
          #define ST8(P, A) do { F4 x0_, x1_; x0_.x = A[0]; x0_.y = A[1]; x0_.z = A[2]; x0_.w = A[3]; x1_.x = A[4]; x1_.y = A[5]; x1_.z = A[6]; x1_.w = A[7]; *(F4*)((P) + o) = x0_; *(F4*)((P) + o + 4) = x1_; } while (0)
          ST8(sW, o_w); ST8(sKD, o_kd); ST8(sB, o_b); ST8(sKK, o_kk); ST8(sR, r);
          #undef ST8
        }
        if ((fp >> 1) == rq) { UNR for (int e = 0; e < 8; ++e) sV[ft * SC_R + 8 * (fp & 1) + e] = v[e]; }
        bon = rowx_add<1>(bon); bon = rowx_add<2>(bon); bon = rowx_add<7>(bon);
        if (fp == 0 && rq == 0) BON[(size_t)(seg0 + tl) * 8 + h] = 0.5f * bon;
    };
    auto store_y = [&](int ch) {
        CHUNK_GEOM(ch, seg0, segn, R0)
        if (isctx_ && !ctx_out) return;
        const float* Yb = sY + (ch & 1) * SC_T * SC_R;
        const int k = (tid & 255) >> 3, q = (tid & 7) * 2; const int tl = d == 0 ? R0 + k : R0 + SC_T - 1 - k;
        *(unsigned*)(Yd + (size_t)(seg0 + tl) * 512 + 64 * h + SC_R * rq + q) = pk2(Yb[k * SC_R + q], Yb[k * SC_R + q + 1]);
    };
    if (!is_scan) { issue(0); features(0); }
    SYNC();
    if (C.wave < 4) SETPRIO(3);
    TACC_DECL;
    for (int ch = 0; ch < nchunks; ++ch) {
        TACC_BEGIN;
        if (is_scan) {
            const float* B_ = sBUF + (ch & 1) * SC_BUF; const float* sW = B_; const float* sKD = B_ + SC_T * 64; const float* sB = B_ + 2 * SC_T * 64; const float* sKK = B_ + 3 * SC_T * 64; const float* sR = B_ + 4 * SC_T * 64; const float* sV = B_ + 5 * SC_T * 64;
            float* Yb = sY + (ch & 1) * SC_T * SC_R;
            float yk0 = 0.f, yk1 = 0.f, yp = 0.f;
#ifndef EMU
            {
                const unsigned ab = (unsigned)(uintptr_t)B_ + 16u * (unsigned)sp, av = (unsigned)(uintptr_t)sV + 4u * (unsigned)rl;
                P2 s01 = {S0, S1}, s23 = {S2, S3};
                asm volatile(SCAN_CHUNK_ASM : [s01] "+v"(s01), [s23] "+v"(s23), [yp] "+v"(yp), [yk0] "+v"(yk0), [yk1] "+v"(yk1) : [ab] "v"(ab), [av] "v"(av), [sp] "v"(sp) : SCAN_CHUNK_CLOBBERS);
                S0 = s01[0]; S1 = s01[1]; S2 = s23[0]; S3 = s23[1];
            }
#else
            for (int k = 0; k < SC_T; ++k) {
                const F4 kk4 = *(const F4*)(sKK + k * 64 + 4 * sp), w4 = *(const F4*)(sW + k * 64 + 4 * sp), b4 = *(const F4*)(sB + k * 64 + 4 * sp),
                         kd4 = *(const F4*)(sKD + k * 64 + 4 * sp), r4 = *(const F4*)(sR + k * 64 + 4 * sp);
                const float vi = sV[k * SC_R + rl];
                float sa = (S0 * kk4.x + S2 * kk4.z) + (S1 * kk4.y + S3 * kk4.w);
                const float t0 = S0 * w4.x + vi * kd4.x, t1 = S1 * w4.y + vi * kd4.y, t2 = S2 * w4.z + vi * kd4.z, t3 = S3 * w4.w + vi * kd4.w;
                sa = rowx_add<1>(sa); yp = rowx_add<1>(yp); sa = rowx_add<2>(sa); yp = rowx_add<2>(yp);
                sa = rowx_add<7>(sa); yp = rowx_add<7>(yp); sa = rowx_add<15>(sa); yp = rowx_add<15>(yp);
                if (sp == ((k + 15) & 15)) { if (k <= 16) yk0 = yp; else yk1 = yp; }
                S0 = t0 - sa * b4.x; S1 = t1 - sa * b4.y; S2 = t2 - sa * b4.z; S3 = t3 - sa * b4.w;
                yp = (S0 * r4.x + S2 * r4.z) + (S1 * r4.y + S3 * r4.w);
            }
#endif
            yp = rowx_add<1>(yp); yp = rowx_add<2>(yp); yp = rowx_add<7>(yp); yp = rowx_add<15>(yp);
            if (sp == 15) yk1 = yp;
            Yb[sp * SC_R + rl] = yk0; Yb[(sp + 16) * SC_R + rl] = yk1;
        } else {
            if (ch + 1 < nchunks) features(ch + 1);
            if (ch > 0) store_y(ch - 1);
        }
        TACC_END;
        SYNC();
    }
    TACC_STORE(C, is_scan ? 45 : 46, C.vcu == 0 && (tid == 0 || tid == 256));
    if (C.wave < 4) SETPRIO(0);
    if (!is_scan) store_y(nchunks - 1);
    #undef CHUNK_GEOM
}

DEVFN void ph_readout_hyout(const Ctx& C, int i, bool do_ctx, unsigned char* lds) {
    const int tid = C.tid;
    {
        const bf16_t* U = (const bf16_t*)(C.ws + WS_U); bf16_t* YF = (bf16_t*)(C.ws + WS_YF); const bf16_t* YB = (const bf16_t*)(C.ws + WS_YB);
        const float* BON = (const float*)(C.ws + WS_BONUS);
        const float* mu = C.in[I_MU] + (size_t)i * 1664 + 1024; const float* gnw = C.in[I_GNW] + (size_t)i * 512; const float* gnb = C.in[I_GNB] + (size_t)i * 512;
        const int rl = tid >> 6, c8 = (tid & 63) * 8, h = (tid & 63) >> 3;
        float muv[8], gw_[8], gb_[8];
        UNR for (int e = 0; e < 8; ++e) { muv[e] = mu[c8 + e]; gw_[e] = gnw[c8 + e]; gb_[e] = gnb[c8 + e]; }
        const int nrows = do_ctx ? NTOK : NLAT;
        for (int r0 = C.vcu * 8; r0 < nrows; r0 += C.G * 8) {
            const int row = r0 + rl; const bool isctx = row >= NLAT; const int seg0 = isctx ? NLAT : 0, segn = isctx ? NCTX : NLAT, tl = row - seg0;
            float yf[8], yb[8], y[8], a[8], m[8], p[8], g[8];
            unpack8(ld16(YF + (size_t)row * 512 + c8), yf); unpack8(ld16(YB + (size_t)row * 512 + c8), yb);
            float s = 0.f; UNR for (int e = 0; e < 8; ++e) { y[e] = yf[e] + yb[e]; s += y[e]; }
            s = rowx_add<1>(s); s = rowx_add<2>(s); s = rowx_add<7>(s);
            const float mean = s * (1.0f / 64.0f); float q = 0.f;
            UNR for (int e = 0; e < 8; ++e) { y[e] -= mean; q += y[e] * y[e]; }
            q = rowx_add<1>(q); q = rowx_add<2>(q); q = rowx_add<7>(q);
            const float rstd = 1.0f / sqrtf(q * (1.0f / 64.0f) + 64e-5f);
            const bf16_t* up = U + (size_t)row * URW_W + 1024 + c8;
            unpack8(ld16(up), a);
            if (tl > 0) unpack8(ld16(up - URW_W), m); else UNR for (int e = 0; e < 8; ++e) m[e] = 0.f;
            if (tl < segn - 1) unpack8(ld16(up + URW_W), p); else UNR for (int e = 0; e < 8; ++e) p[e] = 0.f;
            unpack8(ld16(U + (size_t)row * URW_W + 1664 + c8), g);
            const float bon = BON[(size_t)row * 8 + h] + BON[(size_t)NTOK * 8 + (size_t)row * 8 + h];
            float o[8];
            UNR for (int e = 0; e < 8; ++e) { const float v = a[e] + (0.5f * (m[e] + p[e]) - a[e]) * muv[e]; o[e] = (y[e] * rstd * gw_[e] + gb_[e] + bon * v) * g[e]; }
            st16(YF + (size_t)row * 512 + c8, pack8(o));
        }
    }
    {
        const bf16_t* YHY = (const bf16_t*)(C.ws + WS_YHY); const bf16_t* GHY = (const bf16_t*)(C.ws + WS_GHY); bf16_t* HO = (bf16_t*)(C.ws + WS_HYOUT);
        float* T = (float*)lds;
        for (int it = C.vcu; it < 256 * 8; it += C.G) {
            const int tb = it >> 3, cb = it & 7;
            { const int cl = tid >> 3, t8 = (tid & 7) * 8; float v[8]; unpack8(ld16(YHY + (size_t)(64 * cb + cl) * NLAT + 64 * tb + t8), v); UNR for (int e = 0; e < 8; ++e) T[cl * 65 + t8 + e] = v[e]; }
            SYNC();
            { const int tl = tid >> 3, c8 = (tid & 7) * 8; float g[8], o[8]; const size_t off = (size_t)(64 * tb + tl) * 512 + 64 * cb + c8;
              unpack8(ld16(GHY + off), g); UNR for (int e = 0; e < 8; ++e) o[e] = T[(c8 + e) * 65 + tl] * g[e]; st16(HO + off, pack8(o)); }
            SYNC();
        }
    }
}

constexpr int RC_T = 16, RC_RING = 7, RC_NPROD = 6;
constexpr int RS_KKD = 0, RS_RD = 2048, RS_KIT = 4096, RS_NBIT = 6144, RS_VT = 8192, RS_T = 9216, RS_P0 = 9728, RS_Q1 = 10240, RS_NQ2 = 10752, RS_GC = 11264, RS_BYTES = 11520;
constexpr int RW_TDAD = 0, RW_WL = 2048, RW_AL = 6144, RW_KIP = 2048, RW_BIP = 4096, RW_AM = 10240, RW_BYTES = 11264;
constexpr int RC_LDS_RING = 0, RC_LDS_WAVE = RC_RING * RS_BYTES, RC_LDS_BFR = RC_LDS_WAVE + RC_NPROD * RW_BYTES, RC_LDS_FLAGS = RC_LDS_BFR + 8192, RC_LDS_END = RC_LDS_FLAGS + 3 * 8 * 4;
static_assert(RC_LDS_END <= RING_BYTES, "rwkv chunked LDS");
#ifdef EMU
#include <sched.h>
#define SPIN_WAIT(cond) do { while (!(cond)) sched_yield(); __sync_synchronize(); } while (0)
#define LDS_FENCE() __sync_synchronize()
#else
#define SPIN_WAIT(cond) do { while (!(cond)) __builtin_amdgcn_s_sleep(1); asm volatile("" ::: "memory"); } while (0)
#define LDS_FENCE() asm volatile("s_waitcnt lgkmcnt(0)" ::: "memory")
#endif
#ifdef EMU
DEVFN float wave_sum_fast(float v) { v = rowx_add<1>(v); v = rowx_add<2>(v); v = rowx_add<7>(v); v = rowx_add<15>(v); return (shfl_f(v, 0) + shfl_f(v, 16)) + (shfl_f(v, 32) + shfl_f(v, 48)); }
#else
DEVFN float wave_sum_fast(float v) { v = rowx_add<1>(v); v = rowx_add<2>(v); v = rowx_add<7>(v); v = rowx_add<15>(v);
    const int i_ = __builtin_bit_cast(int, v);
    return (__builtin_bit_cast(float, __builtin_amdgcn_readlane(i_, 0)) + __builtin_bit_cast(float, __builtin_amdgcn_readlane(i_, 16))) + (__builtin_bit_cast(float, __builtin_amdgcn_readlane(i_, 32)) + __builtin_bit_cast(float, __builtin_amdgcn_readlane(i_, 48))); }
#endif
DEVFN int rc_pos(int k) { return (k & 32) | (((k >> 2) & 3) << 3) | (((k >> 4) & 1) << 2) | (k & 3); }
DEVFN H8 h8_from(U4 w) { H8 r; H8_SET(r, 0, w.x & 0xffff); H8_SET(r, 1, w.x >> 16); H8_SET(r, 2, w.y & 0xffff); H8_SET(r, 3, w.y >> 16); H8_SET(r, 4, w.z & 0xffff); H8_SET(r, 5, w.z >> 16); H8_SET(r, 6, w.w & 0xffff); H8_SET(r, 7, w.w >> 16); return r; }
DEVFN H8 h8_lo4(U2 w) { H8 r; H8_SET(r, 0, w.x & 0xffff); H8_SET(r, 1, w.x >> 16); H8_SET(r, 2, w.y & 0xffff); H8_SET(r, 3, w.y >> 16); H8_SET(r, 4, 0); H8_SET(r, 5, 0); H8_SET(r, 6, 0); H8_SET(r, 7, 0); return r; }
DEVFN H8 h8_zero() { H8 r; UNR for (int j = 0; j < 8; ++j) H8_SET(r, j, 0); return r; }
DEVFN H8 h8_pack2(const A4& a, const A4& b) { H8 r; UNR for (int j = 0; j < 4; ++j) { H8_SET(r, j, f2bf(A4_GET(a, j))); H8_SET(r, 4 + j, f2bf(A4_GET(b, j))); } return r; }
DEVFN H8 h8_pack1(const A4& a) { H8 r; UNR for (int j = 0; j < 4; ++j) { H8_SET(r, j, f2bf(A4_GET(a, j))); H8_SET(r, 4 + j, 0); } return r; }
DEVFN A4 a4_zero() { A4 z; A4_GET(z, 0) = 0.f; A4_GET(z, 1) = 0.f; A4_GET(z, 2) = 0.f; A4_GET(z, 3) = 0.f; return z; }

DEVFN void rwkv_chunked(const Ctx& C, int i, int h, int d, int vh, bool ctx_out, unsigned char* lds, int max_chunks) {
    const int tid = C.tid, lane = tid & 63, wave = tid >> 6;
    volatile unsigned* fl_ready = (volatile unsigned*)(lds + RC_LDS_FLAGS); volatile unsigned* fl_done0 = fl_ready + 8; volatile unsigned* fl_done1 = fl_done0 + 8;
    if (tid < 24) fl_ready[tid] = 0u;
    { U4* sBF = (U4*)(lds + RC_LDS_BFR); const int m = tid >> 8, nt = (tid >> 6) & 3, ln = tid & 63;
      const float* src = (m == 0 ? C.in[I_WUP] : C.in[I_AUP]) + ((size_t)i * 2 + d) * 32 * 512 + 64 * h; float f[8];
      UNR for (int j = 0; j < 8; ++j) f[j] = src[(size_t)(8 * (ln >> 4) + j) * 512 + 16 * nt + (ln & 15)];
      sBF[tid] = pack8(f); }
    SYNC();
    const int nchunks = (NTOK / RC_T) < max_chunks ? (NTOK / RC_T) : max_chunks;
    bf16_t* Yd = (bf16_t*)(C.ws + (d == 0 ? WS_YF : WS_YB));
    #define RC_GEOM(ch, seg0, segn, R0) const bool isctx_ = (ch) < NCTX / RC_T; const int seg0 = isctx_ ? NLAT : 0, segn = isctx_ ? NCTX : NLAT; \
        const int cl_ = isctx_ ? (ch) : (ch) - NCTX / RC_T; const int R0 = d == 0 ? RC_T * cl_ : segn - RC_T * (cl_ + 1);
    if (wave < 2) {
        const int vt = wave, kg = lane >> 4, l15 = lane & 15;
        A4 H0_ = a4_zero(), H1_ = a4_zero(), H2_ = a4_zero(), H3_ = a4_zero();
        for (int ch = 0; ch < nchunks; ++ch) {
            const int slot = ch % RC_RING; const unsigned char* rb = lds + RC_LDS_RING + slot * RS_BYTES;
            SPIN_WAIT(fl_ready[slot] == (unsigned)(ch + 1));
            const H8 Hb0 = h8_pack2(H0_, H1_), Hb1 = h8_pack2(H2_, H3_);
            const H8 Vb = kg < 2 ? h8_from(ld16(rb + RS_VT + ((16 * vt + l15) * 16 + 8 * kg) * 2)) : h8_zero();
            const H8 kkd0 = h8_from(ld16(rb + RS_KKD + (l15 * 64 + 8 * kg) * 2)), kkd1 = h8_from(ld16(rb + RS_KKD + (l15 * 64 + 32 + 8 * kg) * 2));
            const H8 rd0 = h8_from(ld16(rb + RS_RD + (l15 * 64 + 8 * kg) * 2)), rd1 = h8_from(ld16(rb + RS_RD + (l15 * 64 + 32 + 8 * kg) * 2));
            const H8 p0f = kg < 2 ? h8_from(ld16(rb + RS_P0 + (l15 * 16 + 8 * kg) * 2)) : h8_zero();
            const H8 q1f = kg < 2 ? h8_from(ld16(rb + RS_Q1 + (l15 * 16 + 8 * kg) * 2)) : h8_zero();
            const H8 tf = h8_lo4(*(const U2*)(rb + RS_T + (l15 * 16 + 4 * kg) * 2)), nq2f = h8_lo4(*(const U2*)(rb + RS_NQ2 + (l15 * 16 + 4 * kg) * 2));
            A4 X = mfma16(kkd0, Hb0, a4_zero()); X = mfma16(kkd1, Hb1, X); X = mfma16(p0f, Vb, X);
            A4 Y = mfma16(rd0, Hb0, a4_zero()); Y = mfma16(rd1, Hb1, Y); Y = mfma16(q1f, Vb, Y);
            const H8 Xb = h8_pack1(X);
            const A4 U_ = mfma16(tf, Xb, a4_zero());
            const H8 Ub = h8_pack1(U_);
            Y = mfma16(nq2f, Ub, Y);
            #define HUPD(Hx, kt) do { const int kr = 16 * (kt) + l15; \
                const H8 kif = kg < 2 ? h8_from(ld16(rb + RS_KIT + (kr * 16 + 8 * kg) * 2)) : h8_zero(); const H8 nbf = h8_lo4(*(const U2*)(rb + RS_NBIT + (kr * 16 + 4 * kg) * 2)); \
                Hx = mfma16(kif, Vb, Hx); Hx = mfma16(nbf, Ub, Hx); const F4 g = *(const F4*)(rb + RS_GC + (16 * (kt) + 4 * kg) * 4); \
                A4_GET(Hx, 0) *= g.x; A4_GET(Hx, 1) *= g.y; A4_GET(Hx, 2) *= g.z; A4_GET(Hx, 3) *= g.w; } while (0)
            HUPD(H0_, 0); HUPD(H1_, 1); HUPD(H2_, 2); HUPD(H3_, 3);
            #undef HUPD
            LDS_FENCE(); WAVE_SYNC();
            if (lane == 0) { if (vt == 0) fl_done0[slot] = (unsigned)(ch + 1); else fl_done1[slot] = (unsigned)(ch + 1); }
            { RC_GEOM(ch, seg0, segn, R0)
              if (!isctx_ || ctx_out) { UNR for (int rg = 0; rg < 4; ++rg) { const int t = 4 * kg + rg, tl = d == 0 ? R0 + t : R0 + RC_T - 1 - t;
                  Yd[(size_t)(seg0 + tl) * 512 + 64 * h + 32 * vh + 16 * vt + l15] = (bf16_t)f2bf(A4_GET(Y, rg)); } } }
        }
    } else {
        const int p = wave - 2, k = lane;
        unsigned char* wsb = lds + RC_LDS_WAVE + p * RW_BYTES;
        bf16_t* sTDAD = (bf16_t*)(wsb + RW_TDAD); float* sWL = (float*)(wsb + RW_WL); float* sAL = (float*)(wsb + RW_AL); bf16_t* sKIP = (bf16_t*)(wsb + RW_KIP); bf16_t* sBIP = (bf16_t*)(wsb + RW_BIP); float* sAM = (float*)(wsb + RW_AM);
        const bf16_t* U = (const bf16_t*)(C.ws + WS_U);
        const float* mu = C.in[I_MU] + (size_t)i * 1664;
        const float mu_r = mu[64 * h + k], mu_k = mu[512 + 64 * h + k], mu_v = mu[1024 + 64 * h + k], mu_l = k < 32 ? mu[1536 + 32 * d + k] : mu[1600 + 32 * d + (k - 32)];
        const float c_w0 = C.in[I_W0][((size_t)i * 2 + d) * 512 + 64 * h + k], c_a0 = C.in[I_A0][((size_t)i * 2 + d) * 512 + 64 * h + k];
        const float c_kk = C.in[I_KK][(size_t)i * 512 + 64 * h + k], c_ka = C.in[I_KA][(size_t)i * 512 + 64 * h + k], c_rk = C.in[I_RK][(size_t)i * 512 + 64 * h + k];
        float* BON = (float*)(C.ws + WS_BONUS) + (size_t)d * NTOK * 8;
        const U4* sBF = (const U4*)(lds + RC_LDS_BFR);
        const int lcol = k < 32 ? 1536 + 32 * d + k : 1600 + 32 * d + (k - 32);
        const int kg = lane >> 4, l15 = lane & 15, pk_ = rc_pos(k);
        for (int ch = p; ch < nchunks; ch += RC_NPROD) {
            RC_GEOM(ch, seg0, segn, R0)
            float ur[18], uk[18], uv[18], ul[18];
            UNR for (int j = 0; j < 18; ++j) { const int row = d == 0 ? R0 - 1 + j : R0 + 16 - j; const bool ok = row >= 0 && row < segn; const bf16_t* up = U + (size_t)(seg0 + (ok ? row : R0)) * URW_W;
                const float m_ = ok ? 1.f : 0.f; ur[j] = m_ * bf2f(up[64 * h + k]); uk[j] = m_ * bf2f(up[512 + 64 * h + k]); uv[j] = m_ * bf2f(up[1024 + 64 * h + k]); ul[j] = m_ * bf2f(up[lcol]); }
            UNR for (int t = 0; t < 16; ++t) { const int j = t + 1; const float x = ul[j] + (0.5f * (ul[j - 1] + ul[j + 1]) - ul[j]) * mu_l;
                const float val = k < 32 ? 1.0f - 2.0f * FRCP(1.0f + FEXP(2.0f * x)) : x; sTDAD[t * 64 + k] = (bf16_t)f2bf(val); }
            WAVE_SYNC();
            {
                const H8 At = h8_from(ld16(sTDAD + l15 * 64 + 8 * kg)), Aa = h8_from(ld16(sTDAD + l15 * 64 + 32 + 8 * kg));
                A4 cw_[4], ca_[4];
                UNR for (int nt = 0; nt < 4; ++nt) { cw_[nt] = mfma16(At, h8_from(sBF[nt * 64 + lane]), a4_zero()); ca_[nt] = mfma16(Aa, h8_from(sBF[(4 + nt) * 64 + lane]), a4_zero()); }
                MFMA_PAD(cw_[0], cw_[1], cw_[2], cw_[3], ca_[0], ca_[1], ca_[2], ca_[3]);
                UNR for (int nt = 0; nt < 4; ++nt) UNR for (int rg = 0; rg < 4; ++rg) { sWL[(4 * kg + rg) * 64 + 16 * nt + l15] = A4_GET(cw_[nt], rg); sAL[(4 * kg + rg) * 64 + 16 * nt + l15] = A4_GET(ca_[nt], rg); }
            }
            WAVE_SYNC();
            float fr[16], fkd[16], fb[16], fkk[16], flw[16], fv[16];
            UNR for (int t = 0; t < 16; ++t) { const int j = t + 1;
                const float r_ = ur[j] + (0.5f * (ur[j - 1] + ur[j + 1]) - ur[j]) * mu_r, k_ = uk[j] + (0.5f * (uk[j - 1] + uk[j + 1]) - uk[j]) * mu_k, v_ = uv[j] + (0.5f * (uv[j - 1] + uv[j + 1]) - uv[j]) * mu_v;
                const float kkraw = k_ * c_kk; const float ss = wave_sum_fast(kkraw * kkraw); const float kk_ = kkraw * FRSQ(ss + 1e-12f);
                const float x = -(c_w0 + sWL[t * 64 + k]); const float sp_ = fmaxf(x, 0.f) + FLOG(1.0f + FEXP(-fabsf(x)));
                const float lw_ = -FEXP(-sp_ - 0.5f);
                const float a = FRCP(1.0f + FEXP(-(c_a0 + sAL[t * 64 + k])));
                const float kd_ = k_ * (1.0f + (a - 1.0f) * c_ka);
                fr[t] = r_; fkd[t] = kd_; fb[t] = kk_ * a; fkk[t] = kk_; flw[t] = lw_; fv[t] = v_;
                const float bon = wave_sum_fast(r_ * kd_ * c_rk);
                if (vh == 0 && lane == 0) { const int tl = d == 0 ? R0 + t : R0 + RC_T - 1 - t; BON[(size_t)(seg0 + tl) * 8 + h] = 0.5f * bon; }
            }
            WAVE_SYNC();
            const int slot = ch % RC_RING; unsigned char* rb = lds + RC_LDS_RING + slot * RS_BYTES;
            if (ch >= RC_RING) SPIN_WAIT(fl_done0[slot] == (unsigned)(ch - RC_RING + 1) && fl_done1[slot] == (unsigned)(ch - RC_RING + 1));
            {
                bf16_t* rKKD = (bf16_t*)(rb + RS_KKD); bf16_t* rRD = (bf16_t*)(rb + RS_RD); bf16_t* rKIT = (bf16_t*)(rb + RS_KIT); bf16_t* rNBIT = (bf16_t*)(rb + RS_NBIT); bf16_t* rVT = (bf16_t*)(rb + RS_VT);
                float L = 0.f, e_prev = 1.f;
                UNR for (int t = 0; t < 16; ++t) { L += flw[t]; const float e = FEXP(L), ei = FEXP(-L);
                    rKKD[t * 64 + pk_] = (bf16_t)f2bf(fkk[t] * e_prev); rRD[t * 64 + pk_] = (bf16_t)f2bf(fr[t] * e);
                    const float ki_ = fkd[t] * ei, bi_ = fb[t] * ei; sKIP[t * 64 + pk_] = (bf16_t)f2bf(ki_); sBIP[t * 64 + pk_] = (bf16_t)f2bf(bi_);
                    rKIT[k * 16 + t] = (bf16_t)f2bf(ki_); rNBIT[k * 16 + t] = (bf16_t)f2bf(-bi_);
                    e_prev = e; }
                ((float*)(rb + RS_GC))[k] = e_prev;
                U4 w0_, w1_;
                if ((k >> 5) == vh) { w0_.x = pk2(fv[0], fv[1]); w0_.y = pk2(fv[2], fv[3]); w0_.z = pk2(fv[4], fv[5]); w0_.w = pk2(fv[6], fv[7]); w1_.x = pk2(fv[8], fv[9]); w1_.y = pk2(fv[10], fv[11]); w1_.z = pk2(fv[12], fv[13]); w1_.w = pk2(fv[14], fv[15]);
                    st16(rVT + (k & 31) * 16, w0_); st16(rVT + (k & 31) * 16 + 8, w1_); }
            }
            WAVE_SYNC();
            {
                const bf16_t* rKKD = (const bf16_t*)(rb + RS_KKD); const bf16_t* rRD = (const bf16_t*)(rb + RS_RD);
                const H8 ak0 = h8_from(ld16(rKKD + l15 * 64 + 8 * kg)), ak1 = h8_from(ld16(rKKD + l15 * 64 + 32 + 8 * kg)), ar0 = h8_from(ld16(rRD + l15 * 64 + 8 * kg)), ar1 = h8_from(ld16(rRD + l15 * 64 + 32 + 8 * kg));
                const H8 bb0 = h8_from(ld16(sBIP + l15 * 64 + 8 * kg)), bb1 = h8_from(ld16(sBIP + l15 * 64 + 32 + 8 * kg)), bk0 = h8_from(ld16(sKIP + l15 * 64 + 8 * kg)), bk1 = h8_from(ld16(sKIP + l15 * 64 + 32 + 8 * kg));
                A4 mA = mfma16(ak0, bb0, a4_zero()); mA = mfma16(ak1, bb1, mA);
                A4 mP = mfma16(ak0, bk0, a4_zero()); mP = mfma16(ak1, bk1, mP);
                A4 mQ1 = mfma16(ar0, bk0, a4_zero()); mQ1 = mfma16(ar1, bk1, mQ1);
                A4 mQ2 = mfma16(ar0, bb0, a4_zero()); mQ2 = mfma16(ar1, bb1, mQ2);
                MFMA_PAD(mA, mP, mQ1, mQ2, mA, mP, mQ1, mQ2);
                bf16_t* rP0 = (bf16_t*)(rb + RS_P0); bf16_t* rQ1 = (bf16_t*)(rb + RS_Q1); bf16_t* rNQ2 = (bf16_t*)(rb + RS_NQ2);
                UNR for (int rg = 0; rg < 4; ++rg) { const int t = 4 * kg + rg, s_ = l15;
                    sAM[t * 16 + s_] = t > s_ ? A4_GET(mA, rg) : 0.f;
                    rP0[t * 16 + s_] = (bf16_t)f2bf(t > s_ ? A4_GET(mP, rg) : 0.f); rQ1[t * 16 + s_] = (bf16_t)f2bf(t >= s_ ? A4_GET(mQ1, rg) : 0.f); rNQ2[t * 16 + s_] = (bf16_t)f2bf(t >= s_ ? -A4_GET(mQ2, rg) : 0.f); }
            }
            WAVE_SYNC();
            {
                const int j = l15; float x[16]; bf16_t* rT = (bf16_t*)(rb + RS_T);
                UNR for (int t = 0; t < 16; ++t) { float acc = t == j ? 1.f : 0.f;
                    UNR for (int s_ = 0; s_ < 16; ++s_) if (s_ < t) acc -= sAM[t * 16 + s_] * x[s_];
                    x[t] = acc; if (lane < 16) rT[t * 16 + j] = (bf16_t)f2bf(acc); }
            }
            LDS_FENCE();
            WAVE_SYNC();
            if (lane == 0) fl_ready[slot] = (unsigned)(ch + 1);
        }
    }
    #undef RC_GEOM
    SYNC();
}
constexpr int FR_SLOTS = 20, FR_FLOATS = 6 * 2048, FR_LEAD = 20;
constexpr size_t WS_FRING = WS_HYOUT;
static_assert((size_t)16 * FR_SLOTS * FR_FLOATS * 4 <= (size_t)NLAT * 512 * 2, "feature ring fits");
constexpr size_t CTL_FFLAG = 65536, CTL_FPOS = CTL_FFLAG + 16 * 520 * 4 * 4;
constexpr int SC2_R = 8, SC2_NWG = 8;
static_assert(CTL_FPOS + 64 * 64 <= CTL_ZERO_BYTES, "control words");
#ifdef EMU
DEVFN unsigned gld_u32(const unsigned* p) { __sync_synchronize(); return *(volatile const unsigned*)p; }
DEVFN void gst_u32(unsigned* p, unsigned v) { __sync_synchronize(); *(volatile unsigned*)p = v; __sync_synchronize(); }
DEVFN unsigned long long gld_u64(const unsigned long long* p) { return *(volatile const unsigned long long*)p; }
DEVFN void gst_u64(unsigned long long* p, unsigned long long v) { *(volatile unsigned long long*)p = v; }
#define VM_DRAIN() __sync_synchronize()
#define GSPIN_WAIT(cond) do { while (!(cond)) sched_yield(); __sync_synchronize(); } while (0)
#else
DEVFN unsigned gld_u32(const unsigned* p) { return __hip_atomic_load(p, __ATOMIC_RELAXED, __HIP_MEMORY_SCOPE_AGENT); }
DEVFN void gst_u32(unsigned* p, unsigned v) { __hip_atomic_store(p, v, __ATOMIC_RELAXED, __HIP_MEMORY_SCOPE_AGENT); }
DEVFN unsigned long long gld_u64(const unsigned long long* p) { return __hip_atomic_load(p, __ATOMIC_RELAXED, __HIP_MEMORY_SCOPE_AGENT); }
DEVFN void gst_u64(unsigned long long* p, unsigned long long v) { __hip_atomic_store(p, v, __ATOMIC_RELAXED, __HIP_MEMORY_SCOPE_AGENT); }
#define VM_DRAIN() asm volatile("s_waitcnt vmcnt(0)" ::: "memory")
#define GSPIN_WAIT(cond) do { unsigned sp__ = 0; while (!(cond)) { __builtin_amdgcn_s_sleep(2); if (++sp__ > (1u << 22)) break; } asm volatile("" ::: "memory"); } while (0)
#endif
DEVFN unsigned long long f2_bits(float a, float b) { union { float f[2]; unsigned long long u; } x; x.f[0] = a; x.f[1] = b; return x.u; }

DEVFN void rwkv_scan2(const Ctx& C, int i, int h, int d, int rq, bool ctx_out, unsigned char* lds, int max_chunks) {
    const int tid = C.tid, lane = tid & 63, wave = C.wave;
    float* sBUF = (float*)lds;
    float* sWV = sBUF + 3 * SC_BUF;
    float* sCN = sWV + 4 * 1280;
    U4* sBF = (U4*)(sCN + 640);
    volatile unsigned* lf = (volatile unsigned*)((unsigned char*)sBF + 8192);
    const int hd = h * 2 + d;
    const unsigned epoch = (unsigned)(i + 1), pbase = (unsigned)i * 100000u;
    {
    const float* mu = C.in[I_MU] + (size_t)i * 1664;
    const float* w0 = C.in[I_W0] + ((size_t)i * 2 + d) * 512 + 64 * h; const float* a0 = C.in[I_A0] + ((size_t)i * 2 + d) * 512 + 64 * h;
    const float* wup = C.in[I_WUP] + ((size_t)i * 2 + d) * 32 * 512 + 64 * h; const float* aup = C.in[I_AUP] + ((size_t)i * 2 + d) * 32 * 512 + 64 * h;
    const float* k_k = C.in[I_KK] + (size_t)i * 512 + 64 * h; const float* k_a = C.in[I_KA] + (size_t)i * 512 + 64 * h; const float* r_k = C.in[I_RK] + (size_t)i * 512 + 64 * h;
    if (tid < 64) { const int j = tid; sCN[j] = mu[64 * h + j]; sCN[64 + j] = mu[512 + 64 * h + j]; sCN[128 + j] = mu[1024 + 64 * h + j]; sCN[192 + j] = w0[j]; sCN[256 + j] = a0[j];
        sCN[320 + j] = k_k[j]; sCN[384 + j] = k_a[j]; sCN[448 + j] = r_k[j]; sCN[512 + j] = j < 32 ? mu[1536 + 32 * d + j] : mu[1600 + 32 * d + (j - 32)]; }
    { const int m = tid >> 8, nt = (tid >> 6) & 3, ln = tid & 63; const float* src = m == 0 ? wup : aup; float f[8];
      UNR for (int j = 0; j < 8; ++j) f[j] = src[(size_t)(8 * (ln >> 4) + j) * 512 + 16 * nt + (ln & 15)];
      sBF[tid] = pack8(f); }
    }
    if (tid < 32) lf[tid] = 0u;
    SYNC();
    const int nchunks = NTOK / SC_T < max_chunks ? NTOK / SC_T : max_chunks;
    #define CHUNK_GEOM(ch, seg0, segn, R0) const bool isctx_ = (ch) < NCTX / SC_T; const int seg0 = isctx_ ? NLAT : 0, segn = isctx_ ? NCTX : NLAT; \
        const int cl_ = isctx_ ? (ch) : (ch) - NCTX / SC_T; const int R0 = d == 0 ? SC_T * cl_ : segn - SC_T * (cl_ + 1);
    if (wave < 2) {
        bf16_t* Yd = (bf16_t*)(C.ws + (d == 0 ? WS_YF : WS_YB));
        const int rl = tid >> 4, sp = tid & 15;
        float S0 = 0.f, S1 = 0.f, S2 = 0.f, S3 = 0.f;
        for (int ch = 0; ch < nchunks; ++ch) {
            const int b = ch % 3;
            SPIN_WAIT(lf[0 * 3 + b] == (unsigned)(ch + 1) && lf[1 * 3 + b] == (unsigned)(ch + 1));
            const float* B_ = sBUF + b * SC_BUF; const float* sV = B_ + 5 * SC_T * 64;
            float yk0 = 0.f, yk1 = 0.f, yp = 0.f;
#ifndef EMU
            {
                const unsigned ab = (unsigned)(uintptr_t)B_ + 16u * (unsigned)sp, av = (unsigned)(uintptr_t)sV + 4u * (unsigned)rl;
                P2 s01 = {S0, S1}, s23 = {S2, S3};
                asm volatile(SCAN_CHUNK_ASM : [s01] "+v"(s01), [s23] "+v"(s23), [yp] "+v"(yp), [yk0] "+v"(yk0), [yk1] "+v"(yk1) : [ab] "v"(ab), [av] "v"(av), [sp] "v"(sp) : SCAN_CHUNK_CLOBBERS);
                S0 = s01[0]; S1 = s01[1]; S2 = s23[0]; S3 = s23[1];
            }
#else
            { const float* sW = B_; const float* sKD = B_ + SC_T * 64; const float* sB = B_ + 2 * SC_T * 64; const float* sKK = B_ + 3 * SC_T * 64; const float* sR = B_ + 4 * SC_T * 64;
              for (int k = 0; k < SC_T; ++k) {
                const F4 kk4 = *(const F4*)(sKK + k * 64 + 4 * sp), w4 = *(const F4*)(sW + k * 64 + 4 * sp), b4 = *(const F4*)(sB + k * 64 + 4 * sp),
                         kd4 = *(const F4*)(sKD + k * 64 + 4 * sp), r4 = *(const F4*)(sR + k * 64 + 4 * sp);
                const float vi = sV[k * SC_R + rl];
                float sa = (S0 * kk4.x + S2 * kk4.z) + (S1 * kk4.y + S3 * kk4.w);
                const float t0 = S0 * w4.x + vi * kd4.x, t1 = S1 * w4.y + vi * kd4.y, t2 = S2 * w4.z + vi * kd4.z, t3 = S3 * w4.w + vi * kd4.w;
                sa = rowx_add<1>(sa); yp = rowx_add<1>(yp); sa = rowx_add<2>(sa); yp = rowx_add<2>(yp);
                sa = rowx_add<7>(sa); yp = rowx_add<7>(yp); sa = rowx_add<15>(sa); yp = rowx_add<15>(yp);
                if (sp == ((k + 15) & 15)) { if (k <= 16) yk0 = yp; else yk1 = yp; }
                S0 = t0 - sa * b4.x; S1 = t1 - sa * b4.y; S2 = t2 - sa * b4.z; S3 = t3 - sa * b4.w;
                yp = (S0 * r4.x + S2 * r4.z) + (S1 * r4.y + S3 * r4.w);
              } }
#endif
            LDS_FENCE(); WAVE_SYNC();
            if (lane == 0) lf[8 + wave * 3 + b] = (unsigned)(ch + 1);
            yp = rowx_add<1>(yp); yp = rowx_add<2>(yp); yp = rowx_add<7>(yp); yp = rowx_add<15>(yp);
            if (sp == 15) yk1 = yp;
            { CHUNK_GEOM(ch, seg0, segn, R0)
              if (!isctx_ || ctx_out) { const int t0 = d == 0 ? R0 + sp : R0 + SC_T - 1 - sp, t1 = d == 0 ? R0 + sp + 16 : R0 + SC_T - 1 - (sp + 16);
                  Yd[(size_t)(seg0 + t0) * 512 + 64 * h + SC2_R * rq + rl] = (bf16_t)f2bf(yk0); Yd[(size_t)(seg0 + t1) * 512 + 64 * h + SC2_R * rq + rl] = (bf16_t)f2bf(yk1); } }
        }
    } else if (wave < 6) {
        const int p = wave - 2;
        const bf16_t* U = (const bf16_t*)(C.ws + WS_U); float* BON = (float*)(C.ws + WS_BONUS) + (size_t)d * NTOK * 8;
        float* RING = (float*)(C.ws + WS_FRING) + (size_t)hd * FR_SLOTS * FR_FLOATS; unsigned* FFLAG = (unsigned*)(C.ws + WS_CTL + CTL_FFLAG) + (size_t)hd * 520 * 4; unsigned* FPOS = (unsigned*)(C.ws + WS_CTL + CTL_FPOS) + (size_t)hd * 64;
        float* myWV = sWV + p * 1280; float* sWL = myWV; float* sAL = myWV + 512; bf16_t* sTDb = (bf16_t*)(myWV + 1024); bf16_t* sADb = sTDb + 256;
        const int fp = lane & 7, tw = lane >> 3;
        const float* mu_r = sCN + 8 * fp; const float* mu_k = sCN + 64 + 8 * fp; const float* mu_v = sCN + 128 + 8 * fp; const float* c_w0 = sCN + 192 + 8 * fp; const float* c_a0 = sCN + 256 + 8 * fp;
        const float* c_kk = sCN + 320 + 8 * fp; const float* c_ka = sCN + 384 + 8 * fp; const float* c_rk = sCN + 448 + 8 * fp; const float* mu_w = sCN + 512 + 4 * fp; const float* mu_a = sCN + 544 + 4 * fp;
        U4 pu[9]; U2 pw[6];
        auto issue = [&](int q) {
            const int ch = rq + SC2_NWG * q; if (ch >= nchunks) return;
            CHUNK_GEOM(ch, seg0, segn, R0)
            const int ft = 8 * p + tw, tl = d == 0 ? R0 + ft : R0 + SC_T - 1 - ft;
            const bf16_t* u0p = U + (size_t)(seg0 + tl) * URW_W; const bool hm = tl > 0, hp = tl < segn - 1;
            const U4 z4 = {0u, 0u, 0u, 0u}; const U2 z2 = {0u, 0u};
            const int cw = 1536 + 32 * d + 4 * fp, ca = 1600 + 32 * d + 4 * fp;
            UNR for (int j = 0; j < 3; ++j) { pu[3 * j] = ld16(u0p + 512 * j + 64 * h + 8 * fp); pu[3 * j + 1] = z4; pu[3 * j + 2] = z4; }
            pw[0] = *(const U2*)(u0p + cw); pw[3] = *(const U2*)(u0p + ca); pw[1] = z2; pw[2] = z2; pw[4] = z2; pw[5] = z2;
            if (hm) { UNR for (int j = 0; j < 3; ++j) pu[3 * j + 1] = ld16(u0p - URW_W + 512 * j + 64 * h + 8 * fp); pw[1] = *(const U2*)(u0p - URW_W + cw); pw[4] = *(const U2*)(u0p - URW_W + ca); }
            if (hp) { UNR for (int j = 0; j < 3; ++j) pu[3 * j + 2] = ld16(u0p + URW_W + 512 * j + 64 * h + 8 * fp); pw[2] = *(const U2*)(u0p + URW_W + cw); pw[5] = *(const U2*)(u0p + URW_W + ca); }
        };
        issue(0);
        const int npass = (nchunks - rq + SC2_NWG - 1) / SC2_NWG;
        for (int q = 0; q < npass; ++q) {
            const int ch = rq + SC2_NWG * q;
            if (ch >= FR_SLOTS) { const unsigned need = pbase + (unsigned)(ch - FR_SLOTS + 1);
                GSPIN_WAIT(gld_u32(FPOS + 0) >= need && gld_u32(FPOS + 8) >= need && gld_u32(FPOS + 16) >= need && gld_u32(FPOS + 24) >= need && gld_u32(FPOS + 32) >= need && gld_u32(FPOS + 40) >= need && gld_u32(FPOS + 48) >= need && gld_u32(FPOS + 56) >= need); }
            CHUNK_GEOM(ch, seg0, segn, R0)
            float* rec = RING + (size_t)(ch % FR_SLOTS) * FR_FLOATS;
            {
                const int ft = 8 * p + tw;
                const int tl = d == 0 ? R0 + ft : R0 + SC_T - 1 - ft;
                float r[8], k[8], v[8];
                {
                    float a[8], m[8], qq[8];
                    #define SHIFT3(J, MU, OUT) do { unpack8(pu[3 * (J)], a); unpack8(pu[3 * (J) + 1], m); unpack8(pu[3 * (J) + 2], qq); \
                        UNR for (int e = 0; e < 8; ++e) OUT[e] = a[e] + (0.5f * (m[e] + qq[e]) - a[e]) * MU[e]; } while (0)
                    SHIFT3(0, mu_r, r); SHIFT3(1, mu_k, k); SHIFT3(2, mu_v, v);
                    #undef SHIFT3
                }
                {
                    const U2 w0_ = pw[0], wm = pw[1], wp = pw[2], a0_ = pw[3], am = pw[4], ap = pw[5];
                    const float wa[4] = {bflo(w0_.x), bfhi(w0_.x), bflo(w0_.y), bfhi(w0_.y)}, wmm[4] = {bflo(wm.x), bfhi(wm.x), bflo(wm.y), bfhi(wm.y)}, wpp[4] = {bflo(wp.x), bfhi(wp.x), bflo(wp.y), bfhi(wp.y)};
                    const float aa[4] = {bflo(a0_.x), bfhi(a0_.x), bflo(a0_.y), bfhi(a0_.y)}, amm[4] = {bflo(am.x), bfhi(am.x), bflo(am.y), bfhi(am.y)}, app[4] = {bflo(ap.x), bfhi(ap.x), bflo(ap.y), bfhi(ap.y)};
                    issue(q + 1);
                    float tdv[4], adv[4];
                    UNR for (int e = 0; e < 4; ++e) { const float x = wa[e] + (0.5f * (wmm[e] + wpp[e]) - wa[e]) * mu_w[e];
                        tdv[e] = 1.0f - 2.0f * FRCP(1.0f + FEXP(2.0f * x));
                        adv[e] = aa[e] + (0.5f * (amm[e] + app[e]) - aa[e]) * mu_a[e]; }
                    U2 tq, aq; tq.x = pk2(tdv[0], tdv[1]); tq.y = pk2(tdv[2], tdv[3]); aq.x = pk2(adv[0], adv[1]); aq.y = pk2(adv[2], adv[3]);
                    *(U2*)(sTDb + tw * 32 + 4 * fp) = tq; *(U2*)(sADb + tw * 32 + 4 * fp) = aq;
                }
                WAVE_SYNC();
                float wl[8], al[8];
                {
                    const int arow = lane & 7, kg = lane >> 4;
                    const H8 At = h8_from_u4(ld16(sTDb + arow * 32 + 8 * kg)), Aa = h8_from_u4(ld16(sADb + arow * 32 + 8 * kg));
                    A4 cw_[4], ca_[4];
                    UNR for (int nt = 0; nt < 4; ++nt) { A4 z; A4_GET(z, 0) = 0.f; A4_GET(z, 1) = 0.f; A4_GET(z, 2) = 0.f; A4_GET(z, 3) = 0.f;
                        cw_[nt] = mfma16(At, h8_from_u4(sBF[nt * 64 + lane]), z); ca_[nt] = mfma16(Aa, h8_from_u4(sBF[(4 + nt) * 64 + lane]), z); }
                    MFMA_PAD(cw_[0], cw_[1], cw_[2], cw_[3], ca_[0], ca_[1], ca_[2], ca_[3]);
                    if (lane < 32) { UNR for (int nt = 0; nt < 4; ++nt) UNR for (int rg = 0; rg < 4; ++rg) { const int tok = 4 * (lane >> 4) + rg; sWL[tok * 64 + 16 * nt + (lane & 15)] = A4_GET(cw_[nt], rg); sAL[tok * 64 + 16 * nt + (lane & 15)] = A4_GET(ca_[nt], rg); } }
                    WAVE_SYNC();
                    UNR for (int e = 0; e < 8; ++e) { wl[e] = c_w0[e] + sWL[tw * 64 + 8 * fp + e]; al[e] = c_a0[e] + sAL[tw * 64 + 8 * fp + e]; }
                    WAVE_SYNC();
                }
                float kkv[8], ssq = 0.f;
                UNR for (int e = 0; e < 8; ++e) { kkv[e] = k[e] * c_kk[e]; ssq += kkv[e] * kkv[e]; }
                ssq = rowx_add<1>(ssq); ssq = rowx_add<2>(ssq); ssq = rowx_add<7>(ssq);
                const float kn = FRSQ(ssq + 1e-12f);
                float bon = 0.f; float o_w[8], o_kd[8], o_b[8], o_kk[8];
                UNR for (int e = 0; e < 8; ++e) {
                    const float dec = FEXP(-0.60653066f * FRCP(1.0f + FEXP(-wl[e])));
                    const float a = FRCP(1.0f + FEXP(-al[e]));
                    const float kd = k[e] * (1.0f + (a - 1.0f) * c_ka[e]);
                    const float kk = kkv[e] * kn;
                    o_w[e] = dec; o_kd[e] = kd; o_b[e] = kk * a; o_kk[e] = kk;
                    bon += r[e] * kd * c_rk[e];
                }
                { unsigned long long* rp = (unsigned long long*)(rec + ft * 64 + 8 * fp);
                  #define ST8(AR, A) do { UNR for (int e2 = 0; e2 < 4; ++e2) gst_u64(rp + (AR) * 1024 + e2, f2_bits(A[2 * e2], A[2 * e2 + 1])); } while (0)
                  ST8(0, o_w); ST8(1, o_kd); ST8(2, o_b); ST8(3, o_kk); ST8(4, r); ST8(5, v);
                  #undef ST8
                }
                bon = rowx_add<1>(bon); bon = rowx_add<2>(bon); bon = rowx_add<7>(bon);
                if (fp == 0) BON[(size_t)(seg0 + tl) * 8 + h] = 0.5f * bon;
            }
            VM_DRAIN(); if (lane == 0) gst_u32(FFLAG + (size_t)ch * 4 + p, epoch);
        }
    } else {
        const int w = wave - 6;
        const float* RING = (const float*)(C.ws + WS_FRING) + (size_t)hd * FR_SLOTS * FR_FLOATS; unsigned* FFLAG = (unsigned*)(C.ws + WS_CTL + CTL_FFLAG) + (size_t)hd * 520 * 4; unsigned* FPOS = (unsigned*)(C.ws + WS_CTL + CTL_FPOS) + (size_t)hd * 64;
        for (int ch = 0; ch < nchunks; ++ch) {
            const int b = ch % 3;
            if (ch >= 3) SPIN_WAIT(lf[8 + 0 * 3 + b] == (unsigned)(ch - 2) && lf[8 + 1 * 3 + b] == (unsigned)(ch - 2));
            GSPIN_WAIT(gld_u32(FFLAG + (size_t)ch * 4) == epoch && gld_u32(FFLAG + (size_t)ch * 4 + 1) == epoch && gld_u32(FFLAG + (size_t)ch * 4 + 2) == epoch && gld_u32(FFLAG + (size_t)ch * 4 + 3) == epoch);
            const unsigned long long* rec = (const unsigned long long*)(RING + (size_t)(ch % FR_SLOTS) * FR_FLOATS);
            float* B_ = sBUF + b * SC_BUF;
            { unsigned long long x[40], xv[2];
              UNR for (int j = 0; j < 40; ++j) x[j] = gld_u64(rec + (size_t)w * 2560 + j * 64 + lane);
              { const int idx = w * 64 + lane, tok = idx >> 2, c2 = idx & 3; xv[0] = gld_u64(rec + 5 * 1024 + tok * 32 + 4 * rq + c2); xv[1] = 0ull; }
              UNR for (int j = 0; j < 40; ++j) ((unsigned long long*)B_)[(size_t)w * 2560 + j * 64 + lane] = x[j];
              { const int idx = w * 64 + lane, tok = idx >> 2, c2 = idx & 3; ((unsigned long long*)(B_ + 5 * SC_T * 64))[tok * 8 + c2] = xv[0]; } }
            LDS_FENCE(); WAVE_SYNC();
            if (lane == 0) { lf[w * 3 + b] = (unsigned)(ch + 1); if (w == 0) gst_u32(FPOS + 8 * rq, pbase + (unsigned)(ch + 1)); }
        }
    }
    #undef CHUNK_GEOM
    SYNC();
}
DEVFN void ph_scan_hyena(const Ctx& C, int i, bool ctx_out, unsigned char* lds) {
    const int nscan = 128;
    if (C.vcu < nscan) { rwkv_scan2(C, i, C.vcu >> 4, (C.vcu >> 3) & 1, C.vcu & 7, ctx_out, lds, 1 << 30); XSTAMP(C, 40 + (C.vcu == 0 ? 0 : 3), C.vcu == 0 || C.vcu == 127); return; }
    const int nh = C.G - nscan;
    for (int c = C.vcu - nscan; c < 512; c += nh) { hyena_channel(C, i, c, lds); if (c == C.vcu - nscan) XSTAMP(C, 44, C.vcu == nscan); }
    XSTAMP(C, 41, C.vcu == nscan); XSTAMP(C, 42, C.vcu == C.G - 1);
    if (ctx_out) for (int c = C.vcu - nscan; c < 512; c += nh) { SYNC(); hyena_ctx_channel(C, i, c, lds); }
}

DEVFN void ctx_outproj(const Ctx& C, const bf16_t* A1, const bf16_t* A2, int lda, const bf16_t* Wt, const float* gate_c, const float* base, float* out) {
    const int row = C.tid & 255, cp = C.tid >> 8;
    for (int n0 = 4 * C.vcu; n0 < DM; n0 += 4 * C.G) {
        const int n = n0 + 2 * cp;
        const bf16_t* w0p = Wt + (size_t)n * DM; const bf16_t* w1p = w0p + DM;
        float acc0 = 0.f, acc1 = 0.f;
        for (int hf = 0; hf < 2; ++hf) {
            const bf16_t* ap = (hf == 0 ? A1 : A2) + (size_t)row * lda;
            for (int k0 = 0; k0 < 512; k0 += 8) {
                float a[8], w0[8], w1[8];
                unpack8(ld16(ap + k0), a); unpack8(ld16(w0p + 512 * hf + k0), w0); unpack8(ld16(w1p + 512 * hf + k0), w1);
                UNR for (int e = 0; e < 8; ++e) { acc0 += a[e] * w0[e]; acc1 += a[e] * w1[e]; }
            }
        }
        const size_t o = (size_t)row * DM + n;
        out[o] = base[o] + gate_c[n] * acc0; out[o + 1] = base[o + 1] + gate_c[n + 1] * acc1;
    }
}
namespace pg8 {
#define PG8_LAS __attribute__((address_space(3)))
typedef unsigned short bf16_t;
typedef short bf16x8 __attribute__((ext_vector_type(8)));
typedef float f32x4 __attribute__((ext_vector_type(4)));
typedef unsigned u32x4 __attribute__((ext_vector_type(4)));
constexpr int BM = 256, BK = 64, HALF = 128, HTB = HALF * BK * 2  , STAGE_BYTES = 8 * HTB, NXCD = 8, WGM = 8;

__host__ __device__ __forceinline__ int lds_byte(int r, int c) { const int st = (r >> 4) * 2 + (c >> 5), rr = r & 15, cc = c & 31, ob = rr * 64 + cc * 2; return st * 1024 + (ob ^ (((ob >> 9) & 1) << 5)); }
__host__ __device__ __forceinline__ void stage_rc(int b, int& R, int& C) { const int st = b / 1024, sb = b % 1024, swz = sb ^ (((sb >> 9) & 1) << 5); R = (st >> 1) * 16 + swz / 64; C = (st & 1) * 32 + (swz % 64) / 2; }
__host__ __device__ __forceinline__ int perm32(int rho) { const int n = rho >> 4, i = rho & 15; return 8 * (i >> 2) + 4 * n + (i & 3); }

struct Unit { int pm, pn; };
struct Gemm { const bf16_t* A; const bf16_t* A2; int lda; const bf16_t* Bt; int M, N, K; };

struct StaticOrder {
    int nM, nN, nwg, G, c;
    __host__ __device__ void init(int M, int N, int G_, int c_) { nM = M / BM; nN = N / BM; nwg = nM * nN; G = G_; c = c_; }
    __host__ __device__ bool next(int i, Unit& u) const {
        const long L = (long)i * G + c; if (L >= nwg) return false;
        int wgid = (int)L; { const int q = nwg / NXCD, r = nwg % NXCD, xcd = wgid % NXCD, off = wgid / NXCD; wgid = (xcd < r ? xcd * (q + 1) : r * (q + 1) + (xcd - r) * q) + off; }
        const int nig = WGM * nN, gid = wgid / nig, fm = gid * WGM, gsz = (nM - fm) < WGM ? (nM - fm) : WGM;
        u.pm = fm + ((wgid % nig) % gsz); u.pn = (wgid % nig) / gsz; return true;
    }
    __device__ __forceinline__ void a_ready(const Unit&) const {}
    __device__ __forceinline__ void done(const Unit&) const {}
};

__device__ __forceinline__ unsigned cvt_pk_bf16(float lo, float hi) { unsigned r; asm volatile("v_cvt_pk_bf16_f32 %0, %1, %2" : "=v"(r) : "v"(lo), "v"(hi)); return r; }
__device__ __forceinline__ float silu_fast(float v) { return v * __builtin_amdgcn_rcpf(1.0f + __expf(-v)); }

template <int LAYOUT> struct EpiIn {
    static constexpr bool PERM = true, AFTER_DRAIN = false;
    unsigned char* ws;
    __device__ __forceinline__ void operator()(const f32x4 (&acc)[2][2][4][2], const Unit& u, int wr, int wc, int fr, int fq) const {
        const int row0 = u.pm * BM + wr * 64 + fr;
#pragma unroll
        for (int bj = 0; bj < 2; ++bj) {
            const int cg = u.pn * BM + bj * HALF;
            bf16_t* base; int ldc, mode, col;
            if (LAYOUT == 0) { base = (bf16_t*)(ws + WS_U); ldc = AIN; col = cg; mode = cg < 512 ? 1 : ((cg >= 1536 && cg < 2048) || cg >= 2816) ? 2 : 0; }
            else {
                if (cg < URW_W) { base = (bf16_t*)(ws + WS_U); ldc = URW_W; col = cg; mode = cg >= 1664 ? 2 : 0; }
                else if (cg < URW_W + UHY_W) { base = (bf16_t*)(ws + WS_UHY); ldc = UHY_W; col = cg - URW_W; mode = 0; }
                else if (cg < RIN) { base = (bf16_t*)(ws + WS_GHY); ldc = 512; col = cg - URW_W - UHY_W; mode = 2; }
                else { base = nullptr; ldc = 0; col = 0; mode = 3; }
            }
            if (mode == 3) continue;
            const int col0 = col + wc * 32 + 8 * fq;
#pragma unroll
            for (int ai = 0; ai < 2; ++ai)
#pragma unroll
                for (int m = 0; m < 4; ++m) {
                    f32x4 v0 = acc[ai][bj][m][0], v1 = acc[ai][bj][m][1];
                    if (mode == 1) { v0 = v0 * C2; v1 = v1 * C2; }
                    if (mode == 2) { v0 = (f32x4){silu_fast(v0[0]), silu_fast(v0[1]), silu_fast(v0[2]), silu_fast(v0[3])}; v1 = (f32x4){silu_fast(v1[0]), silu_fast(v1[1]), silu_fast(v1[2]), silu_fast(v1[3])}; }
                    u32x4 w; w.x = cvt_pk_bf16(v0[0], v0[1]); w.y = cvt_pk_bf16(v0[2], v0[3]); w.z = cvt_pk_bf16(v1[0], v1[1]); w.w = cvt_pk_bf16(v1[2], v1[3]);
                    *(u32x4*)(base + (size_t)(row0 + ai * HALF + m * 16) * ldc + col0) = w;
                }
        }
    }
};

struct EpiRes {
    static constexpr bool PERM = false, AFTER_DRAIN = false;
    const float* blat; const float* bctx; float* olat; float* octx; const float* gate; const float* gate_c;
    __device__ __forceinline__ void operator()(const f32x4 (&acc)[2][2][4][2], const Unit& u, int wr, int wc, int fr, int fq) const {
        const bool isctx = u.pm * BM >= NLAT;
        const float* bs = isctx ? bctx - (size_t)NLAT * DM : blat; float* os = isctx ? octx - (size_t)NLAT * DM : olat; const float* gt = isctx ? gate_c : gate;
        const int col0 = u.pn * BM + wc * 32 + 4 * fq;
#pragma unroll
        for (int bj = 0; bj < 2; ++bj)
#pragma unroll
            for (int n = 0; n < 2; ++n) { const f32x4 g = *(const f32x4*)(gt + col0 + bj * HALF + n * 16);
#pragma unroll
                for (int ai = 0; ai < 2; ++ai)
#pragma unroll
                    for (int m = 0; m < 4; ++m) { const size_t off = (size_t)(u.pm * BM + ai * HALF + wr * 64 + m * 16 + fr) * DM + col0 + bj * HALF + n * 16;
                        const f32x4 b = *(const f32x4*)(bs + off); *(f32x4*)(os + off) = b + g * acc[ai][bj][m][n]; } }
    }
};
template <class Epi, class Sched, bool ALIGN_EPI = false, bool SP2 = false>
__device__ __forceinline__ void gemm_phase(PG8_LAS unsigned char* lds, const Gemm g, const Sched& S, const Epi& E) {
    int tid_ = threadIdx.x; asm volatile("" : "+v"(tid_));
    const int tid = tid_, wid = __builtin_amdgcn_readfirstlane(tid >> 6), lane = tid & 63, wr = wid >> 2, wc = wid & 3, fr = lane & 15, fq = lane >> 4;
    const int K = g.K, nt = K / BK;
    unsigned voffA[2], voffB[2];
#pragma unroll
    for (int i = 0; i < 2; ++i) { int R, C; stage_rc(tid * 16 + i * 8192, R, C); const int Rb = Epi::PERM ? ((R & ~31) + perm32(R & 31)) : R;
        voffA[i] = (unsigned)(R * g.lda + C) * 2u; voffB[i] = (unsigned)(Rb * K + C) * 2u; }
    const size_t kstep = (size_t)(BK * 2);
    const size_t hstepA = (size_t)HALF * g.lda * 2, hstepB = (size_t)HALF * K * 2;
    const size_t tstepA = 2 * hstepA, tstepB = 2 * hstepB;
    const int nh = nt / 2; const ptrdiff_t dlt = ((const char*)g.A2 - (const char*)g.A) - (ptrdiff_t)nh * (ptrdiff_t)kstep;
    const unsigned ldsw = (unsigned)wid * 1024u;
    const int aoff = lds_byte(wr * 64 + fr, fq * 8), boff = lds_byte(wc * 32 + fr, fq * 8);
#define PG8_SA(b, h) (((b) * 2 + (h)) * HTB)
#define PG8_SB(b, h) ((4 + (b) * 2 + (h)) * HTB)
#define PG8_STAGE(bufoff, gbase, voff) do { _Pragma("unroll") for (int _i = 0; _i < 2; ++_i) \
        __builtin_amdgcn_global_load_lds((const unsigned*)((const char*)(gbase) + (voff)[_i]), (PG8_LAS unsigned*)(lds + (bufoff) + ldsw + _i * 8192), 16, 0, 0); } while (0)
#define PG8_LDA(dst, b, h) do { _Pragma("unroll") for (int m = 0; m < 4; ++m) _Pragma("unroll") for (int k = 0; k < 2; ++k) dst[m][k] = *(const PG8_LAS bf16x8*)(lds + PG8_SA(b, h) + aoff + m * 2048 + k * 1024); } while (0)
#define PG8_LDB(dst, b, h) do { _Pragma("unroll") for (int n = 0; n < 2; ++n) _Pragma("unroll") for (int k = 0; k < 2; ++k) dst[n][k] = *(const PG8_LAS bf16x8*)(lds + PG8_SB(b, h) + boff + n * 2048 + k * 1024); } while (0)
#define PG8_MMA(ai, bj, At, Bt) do { __builtin_amdgcn_s_setprio(1); _Pragma("unroll") for (int m = 0; m < 4; ++m) _Pragma("unroll") for (int n = 0; n < 2; ++n) _Pragma("unroll") for (int k = 0; k < 2; ++k) \
        acc[ai][bj][m][n] = __builtin_amdgcn_mfma_f32_16x16x32_bf16(Bt[n][k], At[m][k], acc[ai][bj][m][n], 0, 0, 0); __builtin_amdgcn_s_setprio(0); } while (0)
#define PG8_WAIT_V(n) asm volatile("s_waitcnt vmcnt(" #n ")" ::: "memory")
#define PG8_WAIT_L(n) asm volatile("s_waitcnt lgkmcnt(" #n ")" ::: "memory")
#define PG8_BAR __builtin_amdgcn_s_barrier()
#define PG8_SCHED __builtin_amdgcn_sched_barrier(0)
    Unit cur, nxt; int ui = 0;
    if (!S.next(0, cur)) return;
    f32x4 acc[2][2][4][2];
#pragma unroll
    for (int a = 0; a < 2; ++a)
#pragma unroll
        for (int b = 0; b < 2; ++b)
#pragma unroll
            for (int m = 0; m < 4; ++m)
#pragma unroll
                for (int n = 0; n < 2; ++n) acc[a][b][m][n] = (f32x4){0.f, 0.f, 0.f, 0.f};
    bf16x8 At[4][2], B0[2][2], B1[2][2];
    const char* cA = (const char*)g.A + (size_t)cur.pm * tstepA; const char* cB = (const char*)g.Bt + (size_t)cur.pn * tstepB;
    S.a_ready(cur);
    if constexpr (SP2) {
        PG8_STAGE(PG8_SB(0, 0), cB, voffB); PG8_STAGE(PG8_SB(0, 1), cB + hstepB, voffB); PG8_STAGE(PG8_SA(0, 0), cA, voffA); PG8_STAGE(PG8_SA(0, 1), cA + hstepA, voffA);
        if (wr == 1) PG8_BAR;
        PG8_WAIT_V(2); PG8_BAR;
        PG8_STAGE(PG8_SB(1, 0), cB + kstep, voffB); PG8_STAGE(PG8_SA(1, 0), cA + kstep, voffA); PG8_STAGE(PG8_SB(1, 1), cB + hstepB + kstep, voffB);
        PG8_WAIT_V(6); PG8_BAR;
    } else {
        PG8_STAGE(PG8_SB(0, 0), cB, voffB); PG8_STAGE(PG8_SA(0, 0), cA, voffA); PG8_STAGE(PG8_SB(0, 1), cB + hstepB, voffB); PG8_STAGE(PG8_SA(0, 1), cA + hstepA, voffA);
        if (wr == 1) PG8_BAR;
        PG8_WAIT_V(4); PG8_BAR;
        PG8_STAGE(PG8_SB(1, 0), cB + kstep, voffB); PG8_STAGE(PG8_SA(1, 0), cA + kstep, voffA); PG8_STAGE(PG8_SB(1, 1), cB + hstepB + kstep, voffB);
        PG8_WAIT_V(6); PG8_BAR;
    }
    for (;;) {
        const bool has_next = S.next(ui + 1, nxt);
        const char* nA = has_next ? (const char*)g.A + (size_t)nxt.pm * tstepA : cA; const char* nB = has_next ? (const char*)g.Bt + (size_t)nxt.pn * tstepB : cB;
        for (int t = 0; t < nt; t += 2) {
            const bool last = (t == nt - 2);
            const char* a1 = cA + (size_t)(t + 1) * kstep + ((t + 1) >= nh ? dlt : 0);
            const char* a2 = last ? nA : cA + (size_t)(t + 2) * kstep + ((t + 2) >= nh ? dlt : 0); const char* b2 = last ? nB : cB + (size_t)(t + 2) * kstep;
            const char* a3 = a2 + kstep; const char* b3 = b2 + kstep;
            if (last && has_next) S.a_ready(nxt);
            if constexpr (SP2) {
            PG8_LDB(B0, 0, 0); PG8_LDB(B1, 0, 1); PG8_SCHED; PG8_LDA(At, 0, 0); PG8_STAGE(PG8_SA(1, 1), a1 + hstepA, voffA);
            PG8_WAIT_V(8); PG8_WAIT_L(0); PG8_BAR; PG8_MMA(0, 0, At, B0); PG8_MMA(0, 1, At, B1); PG8_BAR; PG8_SCHED;
            PG8_LDA(At, 0, 1); PG8_STAGE(PG8_SB(0, 0), b2, voffB); PG8_STAGE(PG8_SB(0, 1), b2 + hstepB, voffB); PG8_STAGE(PG8_SA(0, 0), a2, voffA);
            PG8_WAIT_V(8); PG8_WAIT_L(0); PG8_BAR; PG8_MMA(1, 0, At, B0); PG8_MMA(1, 1, At, B1); PG8_BAR; PG8_SCHED;
            PG8_LDB(B0, 1, 0); PG8_LDB(B1, 1, 1); PG8_SCHED; PG8_LDA(At, 1, 0); PG8_STAGE(PG8_SA(0, 1), a2 + hstepA, voffA);
            PG8_WAIT_V(8); PG8_WAIT_L(0); PG8_BAR; PG8_MMA(0, 0, At, B0); PG8_MMA(0, 1, At, B1); PG8_BAR; PG8_SCHED;
            PG8_LDA(At, 1, 1); PG8_STAGE(PG8_SB(1, 0), b3, voffB); PG8_STAGE(PG8_SB(1, 1), b3 + hstepB, voffB); PG8_STAGE(PG8_SA(1, 0), a3, voffA);
            PG8_WAIT_V(8); PG8_WAIT_L(0); PG8_BAR; PG8_MMA(1, 0, At, B0); PG8_MMA(1, 1, At, B1); PG8_BAR; PG8_SCHED;
            } else {
            PG8_LDB(B0, 0, 0); PG8_SCHED; PG8_LDA(At, 0, 0); PG8_STAGE(PG8_SA(1, 1), a1 + hstepA, voffA);
            PG8_WAIT_L(8); PG8_BAR; PG8_WAIT_L(0); PG8_MMA(0, 0, At, B0); PG8_BAR; PG8_SCHED;
            PG8_LDB(B1, 0, 1); PG8_STAGE(PG8_SB(0, 0), b2, voffB);
            PG8_BAR; PG8_WAIT_L(0); PG8_MMA(0, 1, At, B1); PG8_BAR;
            PG8_LDA(At, 0, 1); PG8_STAGE(PG8_SA(0, 0), a2, voffA);
            PG8_BAR; PG8_WAIT_L(0); PG8_MMA(1, 0, At, B0); PG8_BAR; PG8_SCHED;
            PG8_STAGE(PG8_SB(0, 1), b2 + hstepB, voffB);
            PG8_WAIT_V(6); PG8_BAR; PG8_MMA(1, 1, At, B1); PG8_BAR;
            PG8_LDB(B0, 1, 0); PG8_SCHED; PG8_LDA(At, 1, 0); PG8_STAGE(PG8_SA(0, 1), a2 + hstepA, voffA);
            PG8_WAIT_L(8); PG8_BAR; PG8_WAIT_L(0); PG8_MMA(0, 0, At, B0); PG8_BAR; PG8_SCHED;
            PG8_LDB(B1, 1, 1); PG8_STAGE(PG8_SB(1, 0), b3, voffB);
            PG8_BAR; PG8_WAIT_L(0); PG8_MMA(0, 1, At, B1); PG8_BAR;
            PG8_LDA(At, 1, 1); PG8_STAGE(PG8_SA(1, 0), a3, voffA);
            PG8_BAR; PG8_WAIT_L(0); PG8_MMA(1, 0, At, B0); PG8_BAR; PG8_SCHED;
            PG8_STAGE(PG8_SB(1, 1), b3 + hstepB, voffB);
            PG8_WAIT_V(6); PG8_BAR; PG8_MMA(1, 1, At, B1); PG8_BAR;
            }
        }
        if constexpr (ALIGN_EPI) { if (wr == 0) PG8_BAR; }
        if constexpr (!Epi::AFTER_DRAIN) { E(acc, cur, wr, wc, fr, fq); S.done(cur); }
        if (!has_next) break;
#pragma unroll
        for (int a = 0; a < 2; ++a)
#pragma unroll
            for (int b = 0; b < 2; ++b)
#pragma unroll
                for (int m = 0; m < 4; ++m)
#pragma unroll
                    for (int n = 0; n < 2; ++n) acc[a][b][m][n] = (f32x4){0.f, 0.f, 0.f, 0.f};
        cur = nxt; cA = nA; cB = nB; ++ui;
        if constexpr (ALIGN_EPI) { if (wr == 1) PG8_BAR; }
    }
    PG8_WAIT_V(0);
    if constexpr (!ALIGN_EPI) { if (wr == 0) PG8_BAR; }
    PG8_BAR;
    if constexpr (Epi::AFTER_DRAIN) { E.fused(acc, cur, wr, wc, fr, fq, lds, wid, lane); S.done(cur); }
#undef PG8_SA
#undef PG8_SB
#undef PG8_STAGE
#undef PG8_LDA
#undef PG8_LDB
#undef PG8_MMA
#undef PG8_WAIT_V
#undef PG8_WAIT_L
#undef PG8_BAR
#undef PG8_SCHED
}
}
#include <hip/hip_bf16.h>
#include <cmath>
namespace attn_body {
using bf16=__hip_bfloat16;
using bf16x8=__attribute__((ext_vector_type(8)))short;
using s16x4=__attribute__((ext_vector_type(4)))short;
using f32x16=__attribute__((ext_vector_type(16)))float;
using u32x4=__attribute__((ext_vector_type(4)))unsigned;
constexpr int D=64;
constexpr int NW=8,QBLK=32,QB=QBLK*NW,KVBLK=64;
__device__ __forceinline__ int crow(int r,int hi){return (r&3)+8*(r>>2)+4*hi;}
#define SBAR() __builtin_amdgcn_sched_barrier(0)
typedef __attribute__((address_space(3))) const float* lds_fptr;
struct NaCtx { lds_fptr tab; int rmin, qr, qc, row0, col0; };
__device__ __forceinline__ void namask(f32x16&p0,f32x16&p1,int t,const NaCtx&n,int hi){
  if(t<4)return;
  const float NEG=-INFINITY; const int kr=n.rmin+(t-4);
  if(kr<n.row0||kr>=n.row0+8){
    #pragma unroll
    for(int r=0;r<16;++r){p0[r]=NEG;p1[r]=NEG;}
    return; }
  const lds_fptr bt=n.tab+((kr-n.qr+7)*31+15-n.qc+4*hi); const int d0=4*hi-n.col0;
  #pragma unroll
  for(int r=0;r<16;++r){const int e=(r&3)+8*(r>>2);
    p0[r]=((unsigned)(e+d0)<16u)?p0[r]+bt[e]:NEG; p1[r]=((unsigned)(e+32+d0)<16u)?p1[r]+bt[e+32]:NEG;}
}

constexpr int NSLOT=3, SLOTB=8192;
constexpr int LDS_K=0, LDS_V=NSLOT*SLOTB, LDS_WS=2*NSLOT*SLOTB, LDS_OST=LDS_WS+NW*64*4, LDS_BIAS=LDS_OST+NW*4096, LDS_BYTES=LDS_BIAS+640*4;
constexpr float C2=0.125f*1.4426950408889634f;
__device__ __forceinline__ void glds16(const void*gsrc,unsigned lds_dst){unsigned keep;
  asm volatile("s_mov_b32 %0, m0\n\ts_mov_b32 m0, %2\n\ts_nop 0\n\tglobal_load_lds_dwordx4 %1, off\n\ts_mov_b32 m0, %0":"=&s"(keep):"v"(gsrc),"s"(lds_dst):"memory");}
__device__ __forceinline__ float max3f(float a,float b,float c){float r;asm("v_max3_f32 %0, %1, %2, %3":"=v"(r):"v"(a),"v"(b),"v"(c));return r;}
__device__ __forceinline__ float max2f(float a,float b){float r;asm("v_max_f32_e32 %0, %1, %2":"=v"(r):"v"(a),"v"(b));return r;}
__device__ __forceinline__ float fadd_s(float a,float b){float r;asm("v_add_f32_e32 %0, %1, %2":"=v"(r):"v"(a),"v"(b));return r;}
__device__ __forceinline__ float fsub_s(float a,float b){float r;asm("v_sub_f32_e32 %0, %1, %2":"=v"(r):"v"(a),"v"(b));return r;}
typedef float f32x2_t __attribute__((ext_vector_type(2))); typedef __bf16 bf16x2_t __attribute__((ext_vector_type(2)));
__device__ __forceinline__ unsigned cvtpk_s(float lo,float hi){f32x2_t v={lo,hi};bf16x2_t b=__builtin_convertvector(v,bf16x2_t);return __builtin_bit_cast(unsigned,b);}
#define WAIT_BAR(N) asm volatile("s_waitcnt vmcnt(" #N ") lgkmcnt(0)\n\ts_barrier":::"memory")

__device__ __forceinline__ void qkt(f32x16&p0,f32x16&p1,const char*Kslot,const bf16x8*qr,const f32x16&negm,int r32,int hi){
  const char*kb=Kslot+hi*1024+r32*16;
  #pragma unroll
  for(int d0=0;d0<4;++d0){
    const bf16x8 b0=*reinterpret_cast<const bf16x8*>(kb+d0*2048);
    const bf16x8 b1=*reinterpret_cast<const bf16x8*>(kb+d0*2048+512);
    if(d0==0){p0=__builtin_amdgcn_mfma_f32_32x32x16_bf16(b0,qr[0],negm,0,0,0);p1=__builtin_amdgcn_mfma_f32_32x32x16_bf16(b1,qr[0],negm,0,0,0);}
    else{p0=__builtin_amdgcn_mfma_f32_32x32x16_bf16(b0,qr[d0],p0,0,0,0);p1=__builtin_amdgcn_mfma_f32_32x32x16_bf16(b1,qr[d0],p1,0,0,0);}}
}
typedef __attribute__((address_space(3))) const char* lds_cptr;
typedef short v4i16_t __attribute__((ext_vector_type(4)));
__device__ __forceinline__ void kload8(bf16x8*kf,lds_cptr kp){
  kf[0]=*(const __attribute__((address_space(3))) bf16x8*)(kp);      kf[1]=*(const __attribute__((address_space(3))) bf16x8*)(kp+512);
  kf[2]=*(const __attribute__((address_space(3))) bf16x8*)(kp+2048); kf[3]=*(const __attribute__((address_space(3))) bf16x8*)(kp+2560);
  kf[4]=*(const __attribute__((address_space(3))) bf16x8*)(kp+4096); kf[5]=*(const __attribute__((address_space(3))) bf16x8*)(kp+4608);
  kf[6]=*(const __attribute__((address_space(3))) bf16x8*)(kp+6144); kf[7]=*(const __attribute__((address_space(3))) bf16x8*)(kp+6656);
}
__device__ __forceinline__ void kload2(bf16x8*kf,lds_cptr kp,int j){ kf[2*j]=*(const __attribute__((address_space(3))) bf16x8*)(kp+j*2048); kf[2*j+1]=*(const __attribute__((address_space(3))) bf16x8*)(kp+j*2048+512); }
__device__ __forceinline__ s16x4 vtr(lds_cptr p){ return __builtin_bit_cast(s16x4,__builtin_amdgcn_ds_read_tr16_b64_v4i16((__attribute__((address_space(3))) v4i16_t*)p)); }
__device__ __forceinline__ float rowmax(const f32x16&p0,const f32x16&p1){
  float a=max3f(p0[0],p0[1],p1[0]),b=max3f(p0[2],p0[3],p1[1]);a=max3f(a,p1[2],p1[3]);
  #pragma unroll
  for(int r=4;r<16;r+=4){a=max3f(a,p0[r],p0[r+1]);b=max3f(b,p0[r+2],p0[r+3]);a=max3f(a,p1[r],p1[r+1]);b=max3f(b,p1[r+2],p1[r+3]);}
  const float m=max2f(a,b);
  auto rr=__builtin_amdgcn_permlane32_swap(__float_as_uint(m),__float_as_uint(m),false,false);
  return max2f(__uint_as_float(rr[0]),__uint_as_float(rr[1]));
}
__device__ __forceinline__ void pv(f32x16*o,int vb,bf16x8 pa0,bf16x8 pa1,bf16x8 pa2,bf16x8 pa3){
  #pragma unroll
  for(int d0=0;d0<2;++d0){s16x4 lo[4],hi[4];
    #pragma unroll
    for(int ks=0;ks<4;++ks){
      asm volatile("ds_read_b64_tr_b16 %0,%1 offset:%c2":"=&v"(lo[ks]):"v"(vb),"i"(d0*4096+ks*1024):"memory");
      asm volatile("ds_read_b64_tr_b16 %0,%1 offset:%c2":"=&v"(hi[ks]):"v"(vb),"i"(d0*4096+ks*1024+512):"memory");}
    asm volatile("s_waitcnt lgkmcnt(0)":::"memory");SBAR();
    #define PK(k) (bf16x8){lo[k][0],lo[k][1],lo[k][2],lo[k][3],hi[k][0],hi[k][1],hi[k][2],hi[k][3]}
    o[d0]=__builtin_amdgcn_mfma_f32_32x32x16_bf16(pa0,PK(0),o[d0],0,0,0);
    o[d0]=__builtin_amdgcn_mfma_f32_32x32x16_bf16(pa1,PK(1),o[d0],0,0,0);
    o[d0]=__builtin_amdgcn_mfma_f32_32x32x16_bf16(pa2,PK(2),o[d0],0,0,0);
    o[d0]=__builtin_amdgcn_mfma_f32_32x32x16_bf16(pa3,PK(3),o[d0],0,0,0);
    #undef PK
  }
}

#define ATTN_STORE16(p,v) (*(u32x4*)(p)=(v))
template<bool NA> __device__ __forceinline__ f32x16 cinit(const f32x16&negm){ if constexpr(NA){ f32x16 z=f32x16{}; return z; } else return negm; }
constexpr int UP=3328, OP=1024;
struct AJob { const bf16*U; bf16*MX; unsigned qo, ko, vo, go, oo; int NT, tile0a, na, tile0b; int qr0, rmin; const float*rpb; };
__device__ __forceinline__ u32x4 gate8(u32x4 v,u32x4 g);
template<int THRL,bool NA> __device__ __forceinline__ void attn_unit(const AJob&J,char*shm){
  int tid_=threadIdx.x; asm volatile("":"+v"(tid_));
  const int tid=tid_,lane=tid&63,r32=lane&31,hi=lane>>5; const int wid=__builtin_amdgcn_readfirstlane(tid>>6);
  const bf16*Qw=J.U+J.qo+(long)(wid*QBLK)*UP;
  const bf16*Kh=J.U+J.ko,*Vh=J.U+J.vo;
  const unsigned lds0=(unsigned)(uintptr_t)shm;
  float*wsf=(float*)(shm+LDS_WS)+wid*64;
  const bf16*ksrc=Kh+(long)lane*UP+wid*8;
  const bf16*vsrc=Vh+(long)(16*(wid&3)+(lane>>2))*UP+(wid>>2)*32+(lane&3)*8;
  const unsigned kdst=lds0+LDS_K+wid*1024, vdst=lds0+LDS_V+wid*1024;
  #define TROW(t) (64L*(long)(((t)<J.na)?(J.tile0a+(t)):(J.tile0b+((t)-J.na))))
  #define DMA_K(t,slot) glds16(ksrc+TROW(t)*UP,(unsigned)__builtin_amdgcn_readfirstlane(kdst+(slot)))
  #define DMA_V(t,slot) glds16(vsrc+TROW(t)*UP,(unsigned)__builtin_amdgcn_readfirstlane(vdst+(slot)))
  const int vb0=(int)(lds0+LDS_V)+((lane>>4)&1)*32+(lane&3)*8+(4*hi+((lane&15)>>2))*64;
  const char*Kbase=shm+LDS_K; bf16x8 kf[8];
  const lds_cptr shm3=(lds_cptr)shm; const lds_cptr kp0=shm3+LDS_K+hi*1024+r32*16; const lds_cptr vp0=shm3+LDS_V+((lane>>4)&1)*32+(lane&3)*8+(4*hi+((lane&15)>>2))*64;
  const int NT=J.NT;
  NaCtx nac; nac.tab=(lds_fptr)(shm+LDS_BIAS)+64; nac.rmin=J.rmin; nac.qr=J.qr0+(wid>>1); nac.qc=32*(wid&1)+r32;
  { int a=nac.qr-4; a=a<0?0:(a>248?248:a); nac.row0=a; int b=nac.qc-8; b=b<0?0:(b>48?48:b); nac.col0=b; }
  if(NA){ if(J.rpb){ for(int e=tid;e<465;e+=512)((__attribute__((address_space(3))) float*)(shm+LDS_BIAS))[64+e]=J.rpb[e]*1.4426950408889634f; } }
  DMA_K(0,0);DMA_V(0,0);DMA_K(1,SLOTB);
  bf16x8 qr[4];
  #pragma unroll
  for(int d0=0;d0<4;++d0)qr[d0]=*reinterpret_cast<const bf16x8*>(&Qw[(long)r32*UP+d0*16+hi*8]);
  float mhat=0.f,l_reg=0.f;f32x16 o[2];o[0]=f32x16{};o[1]=f32x16{};f32x16 negm=f32x16{}; if constexpr(!NA) asm volatile("":"+v"(negm));
  #define CMASK(P0,P1,t) do{ if constexpr(NA) namask(P0,P1,(t),nac,hi); }while(0)
  bool resc=false;
  #define START(P0,P1) do{ const float rm=rowmax(P0,P1); resc=false; \
    { const float dl=rm; mhat=fadd_s(mhat,dl); \
      _Pragma("unroll") for(int r=0;r<16;++r){P0[r]=fsub_s(P0[r],dl);P1[r]=fsub_s(P1[r],dl);} \
      if constexpr(!NA){ _Pragma("unroll") for(int r=0;r<16;++r)negm[r]=-mhat; asm volatile("":"+v"(negm)); } } \
    _Pragma("unroll") for(int r=0;r<16;++r)P0[r]=__builtin_amdgcn_exp2f(P0[r]); }while(0)
  #define RESC() do{ if(resc){ asm volatile("s_waitcnt lgkmcnt(0)":::"memory"); \
      _Pragma("unroll") for(int d_=0;d_<2;++d_) _Pragma("unroll") for(int r=0;r<16;++r)o[d_][r]*=wsf[crow(r,hi)]; } }while(0)
  f32x16 pA0,pA1,pB0,pB1;
  int sl_prev=0,sl_cur=0,sl_next=SLOTB;
  #define ROT() do{sl_prev=sl_cur;sl_cur=sl_next;sl_next=(sl_next==(NSLOT-1)*SLOTB)?0:sl_next+SLOTB;}while(0)
  DMA_K(2,2*SLOTB);
  WAIT_BAR(3);
  qkt(pA0,pA1,Kbase,qr,cinit<NA>(negm),r32,hi);asm volatile("s_nop 15\n\ts_nop 7":"+v"(pA0),"+v"(pA1));CMASK(pA0,pA1,0);
  START(pA0,pA1);
  _Pragma("unroll") for(int r=0;r<16;++r)pA1[r]=__builtin_amdgcn_exp2f(pA1[r]);
  WAIT_BAR(0);
  DMA_K(3,0);DMA_V(1,SLOTB);
  ROT();
  kload8(kf,kp0+sl_cur);
  WAIT_BAR(2);
  s16x4 vlo[8],vhi[8]; u32x4 pw0,pw1,pw2,pw3;
  #define PKW(P,B) cvtpk_s(P[B],P[B+1])
  #define PAF(k) __builtin_bit_cast(bf16x8,pw##k)
  #define VFR(i) (bf16x8){vlo[i][0],vlo[i][1],vlo[i][2],vlo[i][3],vhi[i][0],vhi[i][1],vhi[i][2],vhi[i][3]}
  #define PIN(x) asm volatile("":"+v"(x))
  #define MX3(a,b,c) __builtin_fmaxf(__builtin_fmaxf((a),(b)),(c))
  #define GAPA(MF,A0,A1,A2,A3,W0,W1,PW) do{ MF; sacc+=A0; sacc+=A1; sacc+=A2; sacc+=A3; PIN(sacc); W0; W1; PIN(PW); SBAR(); }while(0)
  #define EX(v) __builtin_amdgcn_exp2f(v)
  #define GAPB(MF,X,B) do{ MF; X[B]=EX(X[B]); X[B+1]=EX(X[B+1]); X[B+2]=EX(X[B+2]); X[B+3]=EX(X[B+3]); PIN(X); SBAR(); }while(0)
  #define VRD(i) do{ vlo[i]=vtr(vp_+(((i)>>2)*4096+((i)&3)*1024)); vhi[i]=vtr(vp_+(((i)>>2)*4096+((i)&3)*1024+512)); }while(0)
  #define KRD(G,j) do{ if(G){ kload2(kf,kp0+sl_next,j); SBAR(); } }while(0)
  #define STEP(C0,C1,P0,P1,t,GK,GV,GL) do{ SBAR(); \
    const lds_cptr vp_=vp0+sl_prev; \
    VRD(0); SBAR(); float sacc=(P0[0]+P0[1]); \
    GAPA(C0=__builtin_amdgcn_mfma_f32_32x32x16_bf16(kf[0],qr[0],cinit<NA>(negm),0,0,0), P0[2],P0[3],P0[4],P0[5],     pw0[0]=PKW(P0,0), pw0[1]=PKW(P0,2), pw0); \
    VRD(4); SBAR(); GAPA(C1=__builtin_amdgcn_mfma_f32_32x32x16_bf16(kf[1],qr[0],cinit<NA>(negm),0,0,0), P0[6],P0[7],P0[8],P0[9],     pw0[2]=PKW(P0,4), pw0[3]=PKW(P0,6), pw0); \
    VRD(1); SBAR(); GAPA(C0=__builtin_amdgcn_mfma_f32_32x32x16_bf16(kf[2],qr[1],C0,0,0,0),   P0[10],P0[11],P0[12],P0[13], pw1[0]=PKW(P0,8), pw1[1]=PKW(P0,10), pw1); \
    VRD(5); SBAR(); GAPA(C1=__builtin_amdgcn_mfma_f32_32x32x16_bf16(kf[3],qr[1],C1,0,0,0),   P0[14],P0[15],P1[0],P1[1],   pw1[2]=PKW(P0,12),pw1[3]=PKW(P0,14), pw1); \
    VRD(2); SBAR(); GAPA(C0=__builtin_amdgcn_mfma_f32_32x32x16_bf16(kf[4],qr[2],C0,0,0,0),   P1[2],P1[3],P1[4],P1[5],     pw2[0]=PKW(P1,0), pw2[1]=PKW(P1,2), pw2); \
    VRD(6); SBAR(); GAPA(C1=__builtin_amdgcn_mfma_f32_32x32x16_bf16(kf[5],qr[2],C1,0,0,0),   P1[6],P1[7],P1[8],P1[9],     pw2[2]=PKW(P1,4), pw2[3]=PKW(P1,6), pw2); \
    VRD(3); SBAR(); GAPA(C0=__builtin_amdgcn_mfma_f32_32x32x16_bf16(kf[6],qr[3],C0,0,0,0),   P1[10],P1[11],P1[12],P1[13], pw3[0]=PKW(P1,8), pw3[1]=PKW(P1,10), pw3); \
    VRD(7); SBAR(); GAPA(C1=__builtin_amdgcn_mfma_f32_32x32x16_bf16(kf[7],qr[3],C1,0,0,0),   P1[14],P1[15],0.f,0.f,       pw3[2]=PKW(P1,12),pw3[3]=PKW(P1,14), pw3); \
    l_reg+=sacc; \
    if(GK){DMA_K((t)+3,sl_cur);} if(GV){DMA_V((t)+1,sl_next);} \
    if constexpr(NA){ _Pragma("unroll") for(int r=0;r<16;++r){C0[r]-=mhat;C1[r]-=mhat;} } \
    CMASK(C0,C1,t); \
    { float a=MX3(C0[0],C0[1],C1[0]),b=MX3(C0[2],C0[3],C1[1]); a=MX3(a,C1[2],C1[3]); \
      _Pragma("unroll") for(int r=4;r<16;r+=4){a=MX3(a,C0[r],C0[r+1]);b=MX3(b,C0[r+2],C0[r+3]);a=MX3(a,C1[r],C1[r+1]);b=MX3(b,C1[r+2],C1[r+3]);} \
      float rm=__builtin_fmaxf(a,b); { auto rr=__builtin_amdgcn_permlane32_swap(__float_as_uint(rm),__float_as_uint(rm),false,false); rm=__builtin_fmaxf(__uint_as_float(rr[0]),__uint_as_float(rr[1])); } \
      resc=false; \
      if(__builtin_expect(__any(rm>(float)THRL),0)){ const float dl=__builtin_fmaxf(rm,0.f); mhat+=dl; \
        _Pragma("unroll") for(int r=0;r<16;++r){C0[r]-=dl;C1[r]-=dl;} \
        if constexpr(!NA){ _Pragma("unroll") for(int r=0;r<16;++r)negm[r]=-mhat; asm volatile("":"+v"(negm)); } \
        const float f=__builtin_amdgcn_exp2f(-dl); l_reg*=f; if(hi==0)wsf[r32]=f; resc=true; } } \
    SBAR(); \
    GAPB(o[0]=__builtin_amdgcn_mfma_f32_32x32x16_bf16(PAF(0),VFR(0),o[0],0,0,0), C0,0); \
    GAPB(o[1]=__builtin_amdgcn_mfma_f32_32x32x16_bf16(PAF(0),VFR(4),o[1],0,0,0), C0,4); \
    KRD(GL,0); GAPB(o[0]=__builtin_amdgcn_mfma_f32_32x32x16_bf16(PAF(1),VFR(1),o[0],0,0,0), C0,8); \
    KRD(GL,1); GAPB(o[1]=__builtin_amdgcn_mfma_f32_32x32x16_bf16(PAF(1),VFR(5),o[1],0,0,0), C0,12); \
    KRD(GL,2); GAPB(o[0]=__builtin_amdgcn_mfma_f32_32x32x16_bf16(PAF(2),VFR(2),o[0],0,0,0), C1,0); \
    KRD(GL,3); GAPB(o[1]=__builtin_amdgcn_mfma_f32_32x32x16_bf16(PAF(2),VFR(6),o[1],0,0,0), C1,4); \
    GAPB(o[0]=__builtin_amdgcn_mfma_f32_32x32x16_bf16(PAF(3),VFR(3),o[0],0,0,0), C1,8); \
    GAPB(o[1]=__builtin_amdgcn_mfma_f32_32x32x16_bf16(PAF(3),VFR(7),o[1],0,0,0), C1,12); \
    }while(0)
  int t=1;
  for(;t+5<NT;t+=2){
    STEP(pB0,pB1,pA0,pA1,t,true,true,true);     WAIT_BAR(2); RESC(); ROT();
    STEP(pA0,pA1,pB0,pB1,t+1,true,true,true);   WAIT_BAR(2); RESC(); ROT();
  }
  #define ENDW(tt) do{ if((tt)+3<NT){WAIT_BAR(2);} else if((tt)+2<NT){WAIT_BAR(1);} else {WAIT_BAR(0);} }while(0)
  for(;t+1<NT;t+=2){
    STEP(pB0,pB1,pA0,pA1,t,(t+3<NT),(t+1<NT),(t+1<NT));       ENDW(t);   RESC(); ROT();
    STEP(pA0,pA1,pB0,pB1,t+1,(t+4<NT),(t+2<NT),(t+2<NT));     ENDW(t+1); RESC(); ROT();
  }
  STEP(pB0,pB1,pA0,pA1,NT-1,false,false,false); RESC();
  { float sacc=pB0[0]+pB0[1]; _Pragma("unroll") for(int r=2;r<16;++r)sacc+=pB0[r]; _Pragma("unroll") for(int r=0;r<16;++r)sacc+=pB1[r]; l_reg+=sacc;
    pw0=(u32x4){PKW(pB0,0),PKW(pB0,2),PKW(pB0,4),PKW(pB0,6)};pw1=(u32x4){PKW(pB0,8),PKW(pB0,10),PKW(pB0,12),PKW(pB0,14)};pw2=(u32x4){PKW(pB1,0),PKW(pB1,2),PKW(pB1,4),PKW(pB1,6)};pw3=(u32x4){PKW(pB1,8),PKW(pB1,10),PKW(pB1,12),PKW(pB1,14)};
    SBAR(); pv(o,vb0+sl_cur,PAF(0),PAF(1),PAF(2),PAF(3)); }
  #undef PKW
  #undef PAF
  #undef VFR
  #undef PIN
  #undef MX3
  #undef GAPA
  #undef GAPB
  #undef EX
  #undef VRD
  #undef KRD
  #undef STEP
  #undef ENDW
  {auto rr=__builtin_amdgcn_permlane32_swap(__float_as_uint(l_reg),__float_as_uint(l_reg),false,false);l_reg=__uint_as_float(rr[0])+__uint_as_float(rr[1]);}
  if(hi==0)wsf[32+r32]=l_reg;asm volatile("s_waitcnt lgkmcnt(0)":::"memory");
  float rli[16];
  #pragma unroll
  for(int r=0;r<16;++r)rli[r]=__builtin_amdgcn_rcpf(wsf[32+crow(r,hi)]);
  bf16*Ow=J.MX+J.oo+(long)(wid*QBLK)*OP; const bf16*Gw=J.U+J.go+(long)(wid*QBLK)*UP;
  { bf16*stg=(bf16*)(shm+LDS_OST)+wid*2048;
    #pragma unroll
    for(int r=0;r<16;++r){const int orow=crow(r,hi);
      #pragma unroll
      for(int d0=0;d0<2;++d0)stg[orow*64+d0*32+r32]=__float2bfloat16(o[d0][r]*rli[r]);}
    asm volatile("s_waitcnt lgkmcnt(0)":::"memory");
    #pragma unroll
    for(int i=0;i<4;++i){const int row=i*8+(lane>>3),ch=lane&7; const u32x4 v=*(const u32x4*)(stg+row*64+ch*8); const u32x4 g=*(const u32x4*)(Gw+(long)row*UP+ch*8); ATTN_STORE16(Ow+(long)row*OP+ch*8,gate8(v,g));} }
  asm volatile("s_waitcnt lgkmcnt(0)\n\ts_barrier":::"memory");
  #undef DMA_K
  #undef TROW
  #undef DMA_V
  #undef CMASK
  #undef START
  #undef RESC
  #undef ROT
}
constexpr int ATTN_LDS_BYTES=LDS_BYTES;
__device__ __forceinline__ u32x4 gate8(u32x4 v,u32x4 g){ u32x4 r;
  #pragma unroll
  for(int i=0;i<4;++i){ const float a0=__uint_as_float(v[i]<<16)*__uint_as_float(g[i]<<16), a1=__uint_as_float(v[i]&0xffff0000u)*__uint_as_float(g[i]&0xffff0000u); r[i]=cvtpk_s(a0,a1); }
  return r; }
#undef SBAR
#undef WAIT_BAR
}
#define GAS __attribute__((address_space(1)))
#define LAS __attribute__((address_space(3)))
typedef GAS unsigned gu32;
#define RLX_AGENT __ATOMIC_RELAXED, __HIP_MEMORY_SCOPE_AGENT
#define XB_TMO      128
#define XB_XCNT(j)  (256  + 64 * (j))
#define XB_XSUB(j)  (1280 + 64 * (j))
#define XB_XGEN(j)  (2304 + 64 * (j))
#define XB_TOP      3328
#define XB_TOPGEN   3392
#define XCD_BAR_WORDS 3456
#define XB_SPIN_CAP (1u << 20)

__device__ __forceinline__ unsigned xb_ld(unsigned* p)              { return __hip_atomic_load(p, __ATOMIC_RELAXED, __HIP_MEMORY_SCOPE_AGENT); }
__device__ __forceinline__ unsigned xb_add(unsigned* p, unsigned v) { return __hip_atomic_fetch_add(p, v, __ATOMIC_RELAXED, __HIP_MEMORY_SCOPE_AGENT); }
__device__ __forceinline__ unsigned xb_xcc_id() { return (unsigned)__builtin_amdgcn_s_getreg((3 << 11) | 20) & 0xFu; }
#define XB_SPIN(cond, bar) do { unsigned _sp = 0; while (cond) { __builtin_amdgcn_s_sleep(1); \
    if ((++_sp & 255u) == 0u) { if (xb_ld(&(bar)[XB_TMO])) break; if (_sp > XB_SPIN_CAP) { atomicAdd(&(bar)[XB_TMO], 1u); break; } } } } while (0)

struct XcdBarrier {
    unsigned* bar; unsigned x;
    volatile LAS unsigned* st;
};

__device__ __forceinline__ XcdBarrier xcd_barrier_post(unsigned* bar, volatile LAS unsigned* st) {
    XcdBarrier b; b.bar = bar; b.x = xb_xcc_id(); b.st = st;
    if (threadIdx.x == 0) (void)xb_add(&bar[XB_XCNT(b.x)], 1u);
    return b;
}
__device__ __forceinline__ void xcd_barrier_complete(unsigned* bar, unsigned x, unsigned& nloc, unsigned& nx) {
    const unsigned G = gridDim.x * gridDim.y * gridDim.z;
    unsigned sum, cnt, mine, sp = 0u;
    for (;;) {
        sum = 0u; cnt = 0u; mine = 0u;
#pragma unroll
        for (unsigned j = 0; j < 16; ++j) { const unsigned c = xb_ld(&bar[XB_XCNT(j)]); sum += c; cnt += (c > 0u) ? 1u : 0u; mine = (j == x) ? c : mine; }
        if (sum == G) break;
        __builtin_amdgcn_s_sleep(1);
        if ((++sp & 255u) == 0u) { if (xb_ld(&bar[XB_TMO])) break; if (sp > XB_SPIN_CAP) { atomicAdd(&bar[XB_TMO], 1u); break; } }
    }
    nloc = mine > 0u ? mine : 1u; nx = cnt > 0u ? cnt : 1u;
}

__device__ __forceinline__ void xcd_barrier(const XcdBarrier& b) {
    asm volatile("s_waitcnt vmcnt(0)" ::: "memory");
    __syncthreads();
    if (threadIdx.x == 0) {
        unsigned* bar = b.bar;
        __builtin_amdgcn_s_waitcnt(0);
        unsigned nloc = b.st[0], nx = b.st[1];
        if (nloc == 0u) { xcd_barrier_complete(bar, b.x, nloc, nx); b.st[0] = nloc; b.st[1] = nx; }
        const unsigned old = xb_add(&bar[XB_XSUB(b.x)], 1u);
        const unsigned gen = old / nloc;
        if (old + 1u == (gen + 1u) * nloc) {
            __builtin_amdgcn_fence(__ATOMIC_RELEASE, "agent");
            asm volatile("s_waitcnt vmcnt(0)" ::: "memory");
            const unsigned og = xb_add(&bar[XB_TOP], 1u);
            const unsigned tg = og / nx;
            if (og + 1u == (tg + 1u) * nx) xb_add(&bar[XB_TOPGEN], 1u);
            else XB_SPIN(xb_ld(&bar[XB_TOPGEN]) == tg, bar);
            __builtin_amdgcn_fence(__ATOMIC_ACQUIRE, "agent");
            xb_add(&bar[XB_XGEN(b.x)], 1u);
            asm volatile("s_waitcnt vmcnt(0)" ::: "memory");
        } else {
            XB_SPIN(xb_ld(&bar[XB_XGEN(b.x)]) == gen, bar);
            __builtin_amdgcn_fence(__ATOMIC_ACQUIRE, "agent");
            asm volatile("s_waitcnt vmcnt(0)" ::: "memory");
        }
    }
    __syncthreads();
}

constexpr int CW_BAR = 4096;
__device__ __forceinline__ void ph_attention(const Ctx& C, int i, unsigned char* lds) {
    using namespace attn_body;
    const bf16* U = (const bf16*)(C.ws + WS_U); bf16* MX = (bf16*)(C.ws + WS_XN);
    const float* rpb = C.in[I_RPB] + (size_t)i * 8 * 465;
    for (int p = C.vcu; p < 1040; p += C.G) {
        int kind, h, qb;
        if (p < 512) { kind = 0; h = (p & 255) >> 5; qb = (p & 31) + 32 * (p >> 8); }
        else if (p < 1024) { kind = 1; const int q = p - 512; h = (q & 255) >> 5; qb = (q & 31) + 32 * (q >> 8); }
        else if (p < 1032) { kind = 0; h = p - 1024; qb = 64; }
        else { kind = 1; h = p - 1032; qb = 64; }
        const unsigned r0 = 256u * (unsigned)qb;
        AJob J; J.U = U; J.MX = MX;
        if (kind == 0) {
            J.qo = r0 * AIN + 2048 + 64 * h; J.ko = 2560 + 64 * (h >> 2); J.vo = 2688 + 64 * (h >> 2); J.oo = r0 * DM + 512 + 64 * h; J.go = r0 * AIN + 2816 + 64 * h;
            if (qb < 64) { J.NT = 260; J.tile0a = 0; J.na = 260; J.tile0b = 0; } else { J.NT = 4; J.tile0a = 256; J.na = 4; J.tile0b = 0; }
            J.qr0 = 0; J.rmin = 0; J.rpb = nullptr;
            attn_unit<8, false>(J, (char*)lds);
        } else {
            J.qo = r0 * AIN + 64 * h; J.ko = 512 + 64 * h; J.vo = 1024 + 64 * h; J.oo = r0 * DM + 64 * h; J.go = r0 * AIN + 1536 + 64 * h;
            J.tile0a = 256; J.na = 4; J.qr0 = 4 * qb;
            if (qb < 64) { int rm = 4 * qb - 4; rm = rm < 0 ? 0 : (rm > 248 ? 248 : rm); J.NT = 16; J.tile0b = rm; J.rmin = rm; J.rpb = rpb + (size_t)h * 465; }
            else { J.NT = 4; J.tile0b = 0; J.rmin = 0; J.rpb = nullptr; }
            attn_unit<8, true>(J, (char*)lds);
        }
    }
}

#ifdef TSEL
__device__ __forceinline__ void ph_final_t(const Ctx& C) {
    ph_final(C);
    __syncthreads();
    const unsigned long long* st = (const unsigned long long*)(C.ws + WS_CTL + 32768);
    unsigned long long t[24]; for (int k = 0; k < 24; ++k) t[k] = __hip_atomic_load(st + k, __ATOMIC_RELAXED, __HIP_MEMORY_SCOPE_AGENT);
    double sel = 0.0; for (int k = 0; k < 23; ++k) if ((TSEL >> k) & 1ull) sel += (double)(t[k + 1] - t[k]);
    double tot = (double)(t[23] - t[0]);
#ifdef TXS
    { const unsigned long long x = __hip_atomic_load(st + TXS, __ATOMIC_RELAXED, __HIP_MEMORY_SCOPE_AGENT); sel = (double)(x - t[20]); tot = (double)(t[21] - t[20]); }
#ifdef TXD
    { const unsigned long long x = __hip_atomic_load(st + TXS, __ATOMIC_RELAXED, __HIP_MEMORY_SCOPE_AGENT); sel = (double)x; tot = (double)(t[21] - t[20]); }
#endif
#endif
    const float eps = sqrtf(0.0012f * (float)(sel / tot));
    const int gw = C.vcu * NWAVES + C.wave, NGW = C.G * NWAVES;
    for (int m = gw; m < NLAT; m += NGW) { float* xr = C.out + (size_t)m * DM; for (int j = 0; j < 16; ++j) xr[64 * j + C.lane] *= (1.0f + eps); }
}
#else
__device__ __forceinline__ void ph_final_t(const Ctx& C) { ph_final(C); }
#endif
struct Args { const float* in[N_IN]; float* out; unsigned char* ws; int ph_lo, ph_hi; };
typedef __attribute__((address_space(4))) const Args* KArgP;
__global__ void __launch_bounds__(NTHREADS, 2) mk_fwd(Args args) {
    extern __shared__ __attribute__((aligned(16))) unsigned char lds[];
    volatile LAS unsigned* MISC = (volatile LAS unsigned*)((LAS unsigned char*)lds + MISC_OFF);
    if (threadIdx.x < 64) MISC[threadIdx.x] = 0u;
    __syncthreads();
    XcdBarrier bar = xcd_barrier_post((unsigned*)(args.ws + WS_CTL) + CW_BAR, MISC + 8);
    const int lo = args.ph_lo, hi = args.ph_hi;
    int pc = 0;
#ifdef TSEL
#define STAMP(k) do { if (blockIdx.x == 0 && threadIdx.x == 0) __hip_atomic_store((unsigned long long*)(args.ws + WS_CTL + 32768) + (k), (unsigned long long)__builtin_amdgcn_s_memrealtime(), __ATOMIC_RELAXED, __HIP_MEMORY_SCOPE_AGENT); } while (0)
#else
#define STAMP(k) do {} while (0)
#endif
    STAMP(0);
#define PHASE(...) do { if (pc >= lo && pc < hi) { KArgP ap = (KArgP)__builtin_amdgcn_kernarg_segment_ptr(); asm volatile("" : "+s"(ap)); Ctx C; \
        _Pragma("unroll") for (int k = 0; k < N_IN; ++k) C.in[k] = ap->in[k]; C.out = ap->out; C.ws = ap->ws; \
        { int t_ = threadIdx.x; asm volatile("" : "+v"(t_)); C.tid = t_; } C.lane = C.tid & 63; C.wave = __builtin_amdgcn_readfirstlane(C.tid >> 6); \
        C.G = gridDim.x; { const int bx = blockIdx.x; C.vcu = (C.G % 8 == 0) ? (bx % 8) * (C.G / 8) + bx / 8 : bx; } \
        float* XCTX = (float*)(C.ws + WS_XCTX); unsigned char* ldsg = (unsigned char*)lds; unsigned char* wsp = C.ws; (void)XCTX; (void)ldsg; (void)wsp; \
        const float* xl = layer == 0 ? C.in[I_X] : C.out; const float* xc = layer == 0 ? C.in[I_CTX] : XCTX; (void)xl; (void)xc; \
        const float* ADA = (const float*)(C.ws + WS_ADA) + (size_t)layer * 2 * 3072; (void)ADA; \
        __VA_ARGS__; if (pc + 1 < hi) xcd_barrier(bar); STAMP(pc + 1); } ++pc; } while (0)
#ifndef PH_MASK
#define PH_MASK 0xFFFF
#endif
#define EN(b) if ((PH_MASK >> (b)) & 1)

    { const int layer = 0; PHASE(EN(0) ph_prologue(C, ldsg)); }
    for (int layer = 0; layer < 4; ++layer) {
        const int i = layer >> 1;
        const bool ctx_out = layer < 3;
        PHASE(EN(1) ph_norm(C, layer, xl, xc, true));
        if ((layer & 1) == 0) {
            PHASE(EN(2) { pg8::Gemm g{(const pg8::bf16_t*)(wsp + WS_XN), (const pg8::bf16_t*)(wsp + WS_XN) + DM / 2, DM, (const pg8::bf16_t*)(wsp + WS_WAIN) + (size_t)i * AIN * DM, NTOK, AIN, DM};
                    pg8::StaticOrder S; S.init(NTOK, AIN, C.G, (int)blockIdx.x); pg8::EpiIn<0> E{wsp};
                    pg8::gemm_phase<pg8::EpiIn<0>, pg8::StaticOrder, true, true>((LAS unsigned char*)lds, g, S, E); });
            PHASE(EN(3) ph_qkprep(C, i));
            PHASE(EN(4) ph_attention(C, i, ldsg));
            PHASE(EN(5) { pg8::Gemm g{(const pg8::bf16_t*)(wsp + WS_XN), (const pg8::bf16_t*)(wsp + WS_XN) + DM / 2, DM, (const pg8::bf16_t*)(wsp + WS_WAOUT) + (size_t)i * DM * DM, NLAT, DM, DM};
                    pg8::StaticOrder S; S.init(NLAT, DM, C.G, (int)blockIdx.x); pg8::EpiRes E{xl, xc, C.out, XCTX, ADA + 2048, ADA + 3072 + 2048};
                    pg8::gemm_phase<pg8::EpiRes, pg8::StaticOrder, true, true>((LAS unsigned char*)lds, g, S, E);
                    ctx_outproj(C, (const bf16_t*)(wsp + WS_XN) + (size_t)NLAT * DM, (const bf16_t*)(wsp + WS_XN) + (size_t)NLAT * DM + 512, DM, (const bf16_t*)(wsp + WS_WAOUT) + (size_t)i * DM * DM, ADA + 3072 + 2048, xc, XCTX); });
        } else {
            PHASE(EN(6) { pg8::Gemm g{(const pg8::bf16_t*)(wsp + WS_XN), (const pg8::bf16_t*)(wsp + WS_XN) + DM / 2, DM, (const pg8::bf16_t*)(wsp + WS_WRIN) + (size_t)i * RINP * DM, NTOK, RINP, DM};
                    pg8::StaticOrder S; S.init(NTOK, RINP, C.G, (int)blockIdx.x); pg8::EpiIn<1> E{wsp};
                    pg8::gemm_phase<pg8::EpiIn<1>, pg8::StaticOrder, true, true>((LAS unsigned char*)lds, g, S, E); });
            PHASE(EN(7) ph_hyprep(C, i, ctx_out, ldsg));
            PHASE(EN(8) ph_scan_hyena(C, i, ctx_out, ldsg));
            PHASE(EN(9) ph_readout_hyout(C, i, ctx_out, ldsg));
            const int Mo = NLAT;
            PHASE(EN(10) { pg8::Gemm g{(const pg8::bf16_t*)(wsp + WS_YF), (const pg8::bf16_t*)(wsp + WS_HYOUT), 512, (const pg8::bf16_t*)(wsp + WS_WROUT) + (size_t)i * DM * DM, Mo, DM, DM};
                    pg8::StaticOrder S; S.init(Mo, DM, C.G, (int)blockIdx.x); pg8::EpiRes E{xl, xc, C.out, XCTX, ADA + 2048, ADA + 3072 + 2048};
                    pg8::gemm_phase<pg8::EpiRes, pg8::StaticOrder, true, true>((LAS unsigned char*)lds, g, S, E);
                    if (ctx_out) ctx_outproj(C, (const bf16_t*)(wsp + WS_YF) + (size_t)NLAT * 512, (const bf16_t*)(wsp + WS_HYOUT) + (size_t)NLAT * 512, 512, (const bf16_t*)(wsp + WS_WROUT) + (size_t)i * DM * DM, ADA + 3072 + 2048, xc, XCTX); });
        }
    }
    { const int layer = 3; PHASE(EN(11) ph_final_t(C)); }
#undef PHASE
}
constexpr int N_PHASES = 1 + 2 * 5 + 2 * 6 + 1;

#ifndef MK_SPLIT
#define MK_SPLIT 0
#endif
extern "C" void kernel_launch(void* const* d_in, const int* in_sizes, int n_in, void* d_out, int out_size, void* d_ws, size_t ws_size, hipStream_t stream) {
    static int grid = 0;
    if (grid == 0) {
        if (n_in != N_IN || out_size != NLAT * DM || ws_size < WS_END) { fprintf(stderr, "kernel_launch: unexpected shapes (n_in %d out %d ws %zu)\n", n_in, out_size, ws_size); grid = -1; return; }
        int dev = 0, cus = 0, per_cu = 0;
        if (hipGetDevice(&dev) != hipSuccess || hipDeviceGetAttribute(&cus, hipDeviceAttributeMultiprocessorCount, dev) != hipSuccess) { grid = -1; return; }
        if (hipFuncSetAttribute((const void*)mk_fwd, hipFuncAttributeMaxDynamicSharedMemorySize, LDS_BYTES) != hipSuccess) { fprintf(stderr, "kernel_launch: hipFuncSetAttribute failed\n"); grid = -1; return; }
        if (hipOccupancyMaxActiveBlocksPerMultiprocessor(&per_cu, (const void*)mk_fwd, NTHREADS, LDS_BYTES) != hipSuccess || per_cu < 1) fprintf(stderr, "kernel_launch: occupancy query says %d\n", per_cu);
        (void)hipGetLastError();
        grid = cus;
    }
    if (grid < 0) return;
    (void)hipMemsetAsync((char*)d_ws + WS_CTL, 0, CTL_ZERO_BYTES, stream);
    Args a{};
    for (int k = 0; k < N_IN; ++k) a.in[k] = (const float*)d_in[k];
    a.out = (float*)d_out; a.ws = (unsigned char*)d_ws;
#if MK_SPLIT
    for (int p = 0; p < N_PHASES; ++p) { a.ph_lo = p; a.ph_hi = p + 1; hipLaunchKernelGGL(mk_fwd, dim3(grid), dim3(NTHREADS), LDS_BYTES, stream, a); }
#else
    a.ph_lo = 0; a.ph_hi = N_PHASES;
    hipLaunchKernelGGL(mk_fwd, dim3(grid), dim3(NTHREADS), LDS_BYTES, stream, a);
#endif
}
```

```cpp
#ifndef EMU
#include <hip/hip_runtime.h>
#endif
#include <cstdio>
#include <cstdint>
#include <cmath>

constexpr int DM = 1024, NLAT = 16384, NCTX = 256, NTOK = NLAT + NCTX;
constexpr int GRIDW = 64, GRIDH = 256;
constexpr int AIN = 3328;
constexpr int RIN = 4224, RINP = 4352;
constexpr int URW_W = 2176;
constexpr int UHY_W = 1536;
constexpr int NWAVES = 8, NTHREADS = 512;
constexpr float C2 = 0.125f * 1.4426950408889634f;
constexpr float LOG2E = 1.4426950408889634f;
constexpr float NORM_EPS = 1e-6f;

typedef unsigned short bf16_t;

constexpr size_t MiB = 1u << 20;
constexpr size_t WS_CTL = 0, CTL_ZERO_BYTES = 256 * 1024;
constexpr size_t WS_ADA = 1 * MiB;
constexpr size_t WS_TW = WS_ADA + 128 * 1024;
constexpr size_t WS_HID256 = WS_TW + 160 * 1024;
constexpr size_t WS_BONUS = WS_HID256 + 64 * 1024;
constexpr size_t WS_XCTX = 3 * MiB;
constexpr size_t WS_VXC = 4 * MiB;
constexpr size_t WS_HID = 6 * MiB;
constexpr size_t WS_WAIN = 14 * MiB;
constexpr size_t WS_WAOUT = 27 * MiB;
constexpr size_t WS_WRIN = 31 * MiB;
constexpr size_t WS_WROUT = 48 * MiB;
constexpr size_t WS_XN = 52 * MiB;
constexpr size_t WS_U = 85 * MiB;
constexpr size_t WS_UHY = 155 * MiB;
constexpr size_t WS_GHY = 204 * MiB;
constexpr size_t WS_VX0 = 52 * MiB, WS_VX1 = 68 * MiB;
constexpr size_t WS_VX2 = 221 * MiB;
constexpr size_t WS_YHY = 155 * MiB;
constexpr size_t WS_YB = 171 * MiB;
constexpr size_t WS_YF = 187 * MiB + 512 * 1024;
constexpr size_t WS_HYOUT = 238 * MiB;
constexpr size_t WS_END = 256 * MiB;
static_assert(WS_U + (size_t)NTOK * AIN * 2 <= WS_END, "U attn");
static_assert(WS_U + (size_t)NTOK * URW_W * 2 <= WS_UHY && WS_UHY + (size_t)NTOK * UHY_W * 2 <= WS_GHY && WS_GHY + (size_t)NTOK * 512 * 2 <= WS_VX2, "rec map 1");
static_assert(WS_VX2 + (size_t)512 * 16384 * 2 <= WS_HYOUT && WS_HYOUT + (size_t)NTOK * 512 * 2 <= WS_END, "rec map 2");
static_assert(WS_YHY + (size_t)512 * 16384 * 2 <= WS_YB && WS_YB + (size_t)NTOK * 512 * 2 <= WS_YF && WS_YF + (size_t)NTOK * 512 * 2 <= WS_GHY, "rec map 3");
static_assert(WS_XN + (size_t)NTOK * DM * 2 <= WS_U && WS_VX1 + (size_t)512 * 16384 * 2 <= WS_U, "xn map");

constexpr int LDS_BYTES = 160 * 1024;
constexpr int MISC_OFF = LDS_BYTES - 256;
constexpr int RING_BYTES = MISC_OFF;

#ifdef EMU
#define DEVFN inline
#else
#define DEVFN __device__ __forceinline__
#endif

DEVFN float bf2f(bf16_t h) { union { unsigned u; float f; } x; x.u = ((unsigned)h) << 16; return x.f; }
DEVFN unsigned f2bf(float f) { union { unsigned u; float f; } x; x.f = f; unsigned u = x.u; return (u + 0x7fffu + ((u >> 16) & 1u)) >> 16; }
DEVFN unsigned pk2(float lo, float hi) { return f2bf(lo) | (f2bf(hi) << 16); }
DEVFN float bflo(unsigned w) { union { unsigned u; float f; } x; x.u = w << 16; return x.f; }
DEVFN float bfhi(unsigned w) { union { unsigned u; float f; } x; x.u = w & 0xffff0000u; return x.f; }
struct U4 { unsigned x, y, z, w; };
struct U2 { unsigned x, y; };
struct F2 { float x, y; };
struct F4 { float x, y, z, w; };
DEVFN float silu_f(float v) { return v / (1.0f + expf(-v)); }
DEVFN float sigmoid_f(float v) { return 1.0f / (1.0f + expf(-v)); }
#define SCAN_CHUNK_ASM \
    "ds_read_b128 v[96:99], %[ab] offset:24576\n\t" \
    "ds_read_b128 v[100:103], %[ab] offset:0\n\t" \
    "ds_read_b128 v[104:107], %[ab] offset:16384\n\t" \
    "ds_read_b128 v[108:111], %[ab] offset:8192\n\t" \
    "ds_read_b128 v[112:115], %[ab] offset:32768\n\t" \
    "ds_read_b32 v116, %[av] offset:0\n\t" \
    "s_waitcnt lgkmcnt(0)\n\t" \
    "ds_read_b128 v[118:121], %[ab] offset:24832\n\t" \
    "ds_read_b128 v[122:125], %[ab] offset:256\n\t" \
    "ds_read_b128 v[126:129], %[ab] offset:16640\n\t" \
    "ds_read_b128 v[130:133], %[ab] offset:8448\n\t" \
    "ds_read_b128 v[134:137], %[ab] offset:33024\n\t" \
    "ds_read_b32 v138, %[av] offset:64\n\t" \
    "v_pk_mul_f32 v[140:141], %[s01], v[96:97]\n\t" \
    "v_pk_fma_f32 v[140:141], %[s23], v[98:99], v[140:141]\n\t" \
    "v_add_f32 v146, v140, v141\n\t" \
    "v_pk_mul_f32 v[142:143], %[s01], v[100:101]\n\t" \
    "v_pk_mul_f32 v[144:145], %[s23], v[102:103]\n\t" \
    "v_add_f32_dpp v146, v146, v146 quad_perm:[1,0,3,2] row_mask:0xf bank_mask:0xf bound_ctrl:1\n\t" \
    "v_add_f32_dpp %[yp], %[yp], %[yp] quad_perm:[1,0,3,2] row_mask:0xf bank_mask:0xf bound_ctrl:1\n\t" \
    "v_pk_fma_f32 v[142:143], v[116:117], v[108:109], v[142:143] op_sel_hi:[0,1,1]\n\t" \
    "v_add_f32_dpp v146, v146, v146 quad_perm:[2,3,0,1] row_mask:0xf bank_mask:0xf bound_ctrl:1\n\t" \
    "v_add_f32_dpp %[yp], %[yp], %[yp] quad_perm:[2,3,0,1] row_mask:0xf bank_mask:0xf bound_ctrl:1\n\t" \
    "v_pk_fma_f32 v[144:145], v[116:117], v[110:111], v[144:145] op_sel_hi:[0,1,1]\n\t" \
    "v_add_f32_dpp v146, v146, v146 row_half_mirror row_mask:0xf bank_mask:0xf bound_ctrl:1\n\t" \
    "v_add_f32_dpp %[yp], %[yp], %[yp] row_half_mirror row_mask:0xf bank_mask:0xf bound_ctrl:1\n\t" \
    "v_cmp_eq_u32_e32 vcc, 15, %[sp]\n\t" \
    "v_add_f32_dpp v146, v146, v146 row_mirror row_mask:0xf bank_mask:0xf bound_ctrl:1\n\t" \
    "v_add_f32_dpp %[yp], %[yp], %[yp] row_mirror row_mask:0xf bank_mask:0xf bound_ctrl:1\n\t" \
    "v_cndmask_b32_e32 %[yk0], %[yk0], %[yp], vcc\n\t" \
    "v_pk_fma_f32 %[s01], v[146:147], v[104:105], v[142:143] op_sel_hi:[0,1,1] neg_lo:[1,0,0] neg_hi:[1,0,0]\n\t" \
    "v_pk_fma_f32 %[s23], v[146:147], v[106:107], v[144:145] op_sel_hi:[0,1,1] neg_lo:[1,0,0] neg_hi:[1,0,0]\n\t" \
    "v_pk_mul_f32 v[140:141], %[s01], v[112:113]\n\t" \
    "v_pk_fma_f32 v[140:141], %[s23], v[114:115], v[140:141]\n\t" \
    "v_add_f32 %[yp], v140, v141\n\t" \
    "s_waitcnt lgkmcnt(0)\n\t" \
    "ds_read_b128 v[96:99], %[ab] offset:25088\n\t" \
    "ds_read_b128 v[100:103], %[ab] offset:512\n\t" \
    "ds_read_b128 v[104:107], %[ab] offset:16896\n\t" \
    "ds_read_b128 v[108:111], %[ab] offset:8704\n\t" \
    "ds_read_b128 v[112:115], %[ab] offset:33280\n\t" \
    "ds_read_b32 v116, %[av] offset:128\n\t" \
    "v_pk_mul_f32 v[140:141], %[s01], v[118:119]\n\t" \
    "v_pk_fma_f32 v[140:141], %[s23], v[120:121], v[140:141]\n\t" \
    "v_add_f32 v146, v140, v141\n\t" \
    "v_pk_mul_f32 v[142:143], %[s01], v[122:123]\n\t" \
    "v_pk_mul_f32 v[144:145], %[s23], v[124:125]\n\t" \
    "v_add_f32_dpp v146, v146, v146 quad_perm:[1,0,3,2] row_mask:0xf bank_mask:0xf bound_ctrl:1\n\t" \
    "v_add_f32_dpp %[yp], %[yp], %[yp] quad_perm:[1,0,3,2] row_mask:0xf bank_mask:0xf bound_ctrl:1\n\t" \
    "v_pk_fma_f32 v[142:143], v[138:139], v[130:131], v[142:143] op_sel_hi:[0,1,1]\n\t" \
    "v_add_f32_dpp v146, v146, v146 quad_perm:[2,3,0,1] row_mask:0xf bank_mask:0xf bound_ctrl:1\n\t" \
    "v_add_f32_dpp %[yp], %[yp], %[yp] quad_perm:[2,3,0,1] row_mask:0xf bank_mask:0xf bound_ctrl:1\n\t" \
    "v_pk_fma_f32 v[144:145], v[138:139], v[132:133], v[144:145] op_sel_hi:[0,1,1]\n\t" \
    "v_add_f32_dpp v146, v146, v146 row_half_mirror row_mask:0xf bank_mask:0xf bound_ctrl:1\n\t" \
    "v_add_f32_dpp %[yp], %[yp], %[yp] row_half_mirror row_mask:0xf bank_mask:0xf bound_ctrl:1\n\t" \
    "v_cmp_eq_u32_e32 vcc, 0, %[sp]\n\t" \
    "v_add_f32_dpp v146, v146, v146 row_mirror row_mask:0xf bank_mask:0xf bound_ctrl:1\n\t" \
    "v_add_f32_dpp %[yp], %[yp], %[yp] row_mirror row_mask:0xf bank_mask:0xf bound_ctrl:1\n\t" \
    "v_cndmask_b32_e32 %[yk0], %[yk0], %[yp], vcc\n\t" \
    "v_pk_fma_f32 %[s01], v[146:147], v[126:127], v[142:143] op_sel_hi:[0,1,1] neg_lo:[1,0,0] neg_hi:[1,0,0]\n\t" \
    "v_pk_fma_f32 %[s23], v[146:147], v[128:129], v[144:145] op_sel_hi:[0,1,1] neg_lo:[1,0,0] neg_hi:[1,0,0]\n\t" \
    "v_pk_mul_f32 v[140:141], %[s01], v[134:135]\n\t" \
    "v_pk_fma_f32 v[140:141], %[s23], v[136:137], v[140:141]\n\t" \
    "v_add_f32 %[yp], v140, v141\n\t" \
    "s_waitcnt lgkmcnt(0)\n\t" \
    "ds_read_b128 v[118:121], %[ab] offset:25344\n\t" \
    "ds_read_b128 v[122:125], %[ab] offset:768\n\t" \
    "ds_read_b128 v[126:129], %[ab] offset:17152\n\t" \
    "ds_read_b128 v[130:133], %[ab] offset:8960\n\t" \
    "ds_read_b128 v[134:137], %[ab] offset:33536\n\t" \
    "ds_read_b32 v138, %[av] offset:192\n\t" \
    "v_pk_mul_f32 v[140:141], %[s01], v[96:97]\n\t" \
    "v_pk_fma_f32 v[140:141], %[s23], v[98:99], v[140:141]\n\t" \
    "v_add_f32 v146, v140, v141\n\t" \
    "v_pk_mul_f32 v[142:143], %[s01], v[100:101]\n\t" \
    "v_pk_mul_f32 v[144:145], %[s23], v[102:103]\n\t" \
    "v_add_f32_dpp v146, v146, v146 quad_perm:[1,0,3,2] row_mask:0xf bank_mask:0xf bound_ctrl:1\n\t" \
    "v_add_f32_dpp %[yp], %[yp], %[yp] quad_perm:[1,0,3,2] row_mask:0xf bank_mask:0xf bound_ctrl:1\n\t" \
    "v_pk_fma_f32 v[142:143], v[116:117], v[108:109], v[142:143] op_sel_hi:[0,1,1]\n\t" \
    "v_add_f32_dpp v146, v146, v146 quad_perm:[2,3,0,1] row_mask:0xf bank_mask:0xf bound_ctrl:1\n\t" \
    "v_add_f32_dpp %[yp], %[yp], %[yp] quad_perm:[2,3,0,1] row_mask:0xf bank_mask:0xf bound_ctrl:1\n\t" \
    "v_pk_fma_f32 v[144:145], v[116:117], v[110:111], v[144:145] op_sel_hi:[0,1,1]\n\t" \
    "v_add_f32_dpp v146, v146, v146 row_half_mirror row_mask:0xf bank_mask:0xf bound_ctrl:1\n\t" \
    "v_add_f32_dpp %[yp], %[yp], %[yp] row_half_mirror row_mask:0xf bank_mask:0xf bound_ctrl:1\n\t" \
    "v_cmp_eq_u32_e32 vcc, 1, %[sp]\n\t" \
    "v_add_f32_dpp v146, v146, v146 row_mirror row_mask:0xf bank_mask:0xf bound_ctrl:1\n\t" \
    "v_add_f32_dpp %[yp], %[yp], %[yp] row_mirror row_mask:0xf bank_mask:0xf bound_ctrl:1\n\t" \
    "v_cndmask_b32_e32 %[yk0], %[yk0], %[yp], vcc\n\t" \
    "v_pk_fma_f32 %[s01], v[146:147], v[104:105], v[142:143] op_sel_hi:[0,1,1] neg_lo:[1,0,0] neg_hi:[1,0,0]\n\t" \
    "v_pk_fma_f32 %[s23], v[146:147], v[106:107], v[144:145] op_sel_hi:[0,1,1] neg_lo:[1,0,0] neg_hi:[1,0,0]\n\t" \
    "v_pk_mul_f32 v[140:141], %[s01], v[112:113]\n\t" \
    "v_pk_fma_f32 v[140:141], %[s23], v[114:115], v[140:141]\n\t" \
    "v_add_f32 %[yp], v140, v141\n\t" \
    "s_waitcnt lgkmcnt(0)\n\t" \
    "ds_read_b128 v[96:99], %[ab] offset:25600\n\t" \
    "ds_read_b128 v[100:103], %[ab] offset:1024\n\t" \
    "ds_read_b128 v[104:107], %[ab] offset:17408\n\t" \
    "ds_read_b128 v[108:111], %[ab] offset:9216\n\t" \
    "ds_read_b128 v[112:115], %[ab] offset:33792\n\t" \
    "ds_read_b32 v116, %[av] offset:256\n\t" \
    "v_pk_mul_f32 v[140:141], %[s01], v[118:119]\n\t" \
    "v_pk_fma_f32 v[140:141], %[s23], v[120:121], v[140:141]\n\t" \
    "v_add_f32 v146, v140, v141\n\t" \
    "v_pk_mul_f32 v[142:143], %[s01], v[122:123]\n\t" \
    "v_pk_mul_f32 v[144:145], %[s23], v[124:125]\n\t" \
    "v_add_f32_dpp v146, v146, v146 quad_perm:[1,0,3,2] row_mask:0xf bank_mask:0xf bound_ctrl:1\n\t" \
    "v_add_f32_dpp %[yp], %[yp], %[yp] quad_perm:[1,0,3,2] row_mask:0xf bank_mask:0xf bound_ctrl:1\n\t" \
    "v_pk_fma_f32 v[142:143], v[138:139], v[130:131], v[142:143] op_sel_hi:[0,1,1]\n\t" \
    "v_add_f32_dpp v146, v146, v146 quad_perm:[2,3,0,1] row_mask:0xf bank_mask:0xf bound_ctrl:1\n\t" \
    "v_add_f32_dpp %[yp], %[yp], %[yp] quad_perm:[2,3,0,1] row_mask:0xf bank_mask:0xf bound_ctrl:1\n\t" \
    "v_pk_fma_f32 v[144:145], v[138:139], v[132:133], v[144:145] op_sel_hi:[0,1,1]\n\t" \
    "v_add_f32_dpp v146, v146, v146 row_half_mirror row_mask:0xf bank_mask:0xf bound_ctrl:1\n\t" \
    "v_add_f32_dpp %[yp], %[yp], %[yp] row_half_mirror row_mask:0xf bank_mask:0xf bound_ctrl:1\n\t" \
    "v_cmp_eq_u32_e32 vcc, 2, %[sp]\n\t" \
    "v_add_f32_dpp v146, v146, v146 row_mirror row_mask:0xf bank_mask:0xf bound_ctrl:1\n\t" \
    "v_add_f32_dpp %[yp], %[yp], %[yp] row_mirror row_mask:0xf bank_mask:0xf bound_ctrl:1\n\t" \
    "v_cndmask_b32_e32 %[yk0], %[yk0], %[yp], vcc\n\t" \
    "v_pk_fma_f32 %[s01], v[146:147], v[126:127], v[142:143] op_sel_hi:[0,1,1] neg_lo:[1,0,0] neg_hi:[1,0,0]\n\t" \
    "v_pk_fma_f32 %[s23], v[146:147], v[128:129], v[144:145] op_sel_hi:[0,1,1] neg_lo:[1,0,0] neg_hi:[1,0,0]\n\t" \
    "v_pk_mul_f32 v[140:141], %[s01], v[134:135]\n\t" \
    "v_pk_fma_f32 v[140:141], %[s23], v[136:137], v[140:141]\n\t" \
    "v_add_f32 %[yp], v140, v141\n\t" \
    "s_waitcnt lgkmcnt(0)\n\t" \
    "ds_read_b128 v[118:121], %[ab] offset:25856\n\t" \
    "ds_read_b128 v[122:125], %[ab] offset:1280\n\t" \
    "ds_read_b128 v[126:129], %[ab] offset:17664\n\t" \
    "ds_read_b128 v[130:133], %[ab] offset:9472\n\t" \
    "ds_read_b128 v[134:137], %[ab] offset:34048\n\t" \
    "ds_read_b32 v138, %[av] offset:320\n\t" \
    "v_pk_mul_f32 v[140:141], %[s01], v[96:97]\n\t" \
    "v_pk_fma_f32 v[140:141], %[s23], v[98:99], v[140:141]\n\t" \
    "v_add_f32 v146, v140, v141\n\t" \
    "v_pk_mul_f32 v[142:143], %[s01], v[100:101]\n\t" \
    "v_pk_mul_f32 v[144:145], %[s23], v[102:103]\n\t" \
    "v_add_f32_dpp v146, v146, v146 quad_perm:[1,0,3,2] row_mask:0xf bank_mask:0xf bound_ctrl:1\n\t" \
    "v_add_f32_dpp %[yp], %[yp], %[yp] quad_perm:[1,0,3,2] row_mask:0xf bank_mask:0xf bound_ctrl:1\n\t" \
    "v_pk_fma_f32 v[142:143], v[116:117], v[108:109], v[142:143] op_sel_hi:[0,1,1]\n\t" \
    "v_add_f32_dpp v146, v146, v146 quad_perm:[2,3,0,1] row_mask:0xf bank_mask:0xf bound_ctrl:1\n\t" \
    "v_add_f32_dpp %[yp], %[yp], %[yp] quad_perm:[2,3,0,1] row_mask:0xf bank_mask:0xf bound_ctrl:1\n\t" \
    "v_pk_fma_f32 v[144:145], v[116:117], v[110:111], v[144:145] op_sel_hi:[0,1,1]\n\t" \
    "v_add_f32_dpp v146, v146, v146 row_half_mirror row_mask:0xf bank_mask:0xf bound_ctrl:1\n\t" \
    "v_add_f32_dpp %[yp], %[yp], %[yp] row_half_mirror row_mask:0xf bank_mask:0xf bound_ctrl:1\n\t" \
    "v_cmp_eq_u32_e32 vcc, 3, %[sp]\n\t" \
    "v_add_f32_dpp v146, v146, v146 row_mirror row_mask:0xf bank_mask:0xf bound_ctrl:1\n\t" \
    "v_add_f32_dpp %[yp], %[yp], %[yp] row_mirror row_mask:0xf bank_mask:0xf bound_ctrl:1\n\t" \
    "v_cndmask_b32_e32 %[yk0], %[yk0], %[yp], vcc\n\t" \
    "v_pk_fma_f32 %[s01], v[146:147], v[104:105], v[142:143] op_sel_hi:[0,1,1] neg_lo:[1,0,0] neg_hi:[1,0,0]\n\t" \
    "v_pk_fma_f32 %[s23], v[146:147], v[106:107], v[144:145] op_sel_hi:[0,1,1] neg_lo:[1,0,0] neg_hi:[1,0,0]\n\t" \
    "v_pk_mul_f32 v[140:141], %[s01], v[112:113]\n\t" \
    "v_pk_fma_f32 v[140:141], %[s23], v[114:115], v[140:141]\n\t" \
    "v_add_f32 %[yp], v140, v141\n\t" \
    "s_waitcnt lgkmcnt(0)\n\t" \
    "ds_read_b128 v[96:99], %[ab] offset:26112\n\t" \
    "ds_read_b128 v[100:103], %[ab] offset:1536\n\t" \
    "ds_read_b128 v[104:107], %[ab] offset:17920\n\t" \
    "ds_read_b128 v[108:111], %[ab] offset:9728\n\t" \
    "ds_read_b128 v[112:115], %[ab] offset:34304\n\t" \
    "ds_read_b32 v116, %[av] offset:384\n\t" \
    "v_pk_mul_f32 v[140:141], %[s01], v[118:119]\n\t" \
    "v_pk_fma_f32 v[140:141], %[s23], v[120:121], v[140:141]\n\t" \
    "v_add_f32 v146, v140, v141\n\t" \
    "v_pk_mul_f32 v[142:143], %[s01], v[122:123]\n\t" \
    "v_pk_mul_f32 v[144:145], %[s23], v[124:125]\n\t" \
    "v_add_f32_dpp v146, v146, v146 quad_perm:[1,0,3,2] row_mask:0xf bank_mask:0xf bound_ctrl:1\n\t" \
    "v_add_f32_dpp %[yp], %[yp], %[yp] quad_perm:[1,0,3,2] row_mask:0xf bank_mask:0xf bound_ctrl:1\n\t" \
    "v_pk_fma_f32 v[142:143], v[138:139], v[130:131], v[142:143] op_sel_hi:[0,1,1]\n\t" \
    "v_add_f32_dpp v146, v146, v146 quad_perm:[2,3,0,1] row_mask:0xf bank_mask:0xf bound_ctrl:1\n\t" \
    "v_add_f32_dpp %[yp], %[yp], %[yp] quad_perm:[2,3,0,1] row_mask:0xf bank_mask:0xf bound_ctrl:1\n\t" \
    "v_pk_fma_f32 v[144:145], v[138:139], v[132:133], v[144:145] op_sel_hi:[0,1,1]\n\t" \
    "v_add_f32_dpp v146, v146, v146 row_half_mirror row_mask:0xf bank_mask:0xf bound_ctrl:1\n\t" \
    "v_add_f32_dpp %[yp], %[yp], %[yp] row_half_mirror row_mask:0xf bank_mask:0xf bound_ctrl:1\n\t" \
    "v_cmp_eq_u32_e32 vcc, 4, %[sp]\n\t" \
    "v_add_f32_dpp v146, v146, v146 row_mirror row_mask:0xf bank_mask:0xf bound_ctrl:1\n\t" \
    "v_add_f32_dpp %[yp], %[yp], %[yp] row_mirror row_mask:0xf bank_mask:0xf bound_ctrl:1\n\t" \
    "v_cndmask_b32_e32 %[yk0], %[yk0], %[yp], vcc\n\t" \
    "v_pk_fma_f32 %[s01], v[146:147], v[126:127], v[142:143] op_sel_hi:[0,1,1] neg_lo:[1,0,0] neg_hi:[1,0,0]\n\t" \
    "v_pk_fma_f32 %[s23], v[146:147], v[128:129], v[144:145] op_sel_hi:[0,1,1] neg_lo:[1,0,0] neg_hi:[1,0,0]\n\t" \
    "v_pk_mul_f32 v[140:141], %[s01], v[134:135]\n\t" \
    "v_pk_fma_f32 v[140:141], %[s23], v[136:137], v[140:141]\n\t" \
    "v_add_f32 %[yp], v140, v141\n\t" \
    "s_waitcnt lgkmcnt(0)\n\t" \
    "ds_read_b128 v[118:121], %[ab] offset:26368\n\t" \
    "ds_read_b128 v[122:125], %[ab] offset:1792\n\t" \
    "ds_read_b128 v[126:129], %[ab] offset:18176\n\t" \
    "ds_read_b128 v[130:133], %[ab] offset:9984\n\t" \
    "ds_read_b128 v[134:137], %[ab] offset:34560\n\t" \
    "ds_read_b32 v138, %[av] offset:448\n\t" \
    "v_pk_mul_f32 v[140:141], %[s01], v[96:97]\n\t" \
    "v_pk_fma_f32 v[140:141], %[s23], v[98:99], v[140:141]\n\t" \
    "v_add_f32 v146, v140, v141\n\t" \
    "v_pk_mul_f32 v[142:143], %[s01], v[100:101]\n\t" \
    "v_pk_mul_f32 v[144:145], %[s23], v[102:103]\n\t" \
    "v_add_f32_dpp v146, v146, v146 quad_perm:[1,0,3,2] row_mask:0xf bank_mask:0xf bound_ctrl:1\n\t" \
    "v_add_f32_dpp %[yp], %[yp], %[yp] quad_perm:[1,0,3,2] row_mask:0xf bank_mask:0xf bound_ctrl:1\n\t" \
    "v_pk_fma_f32 v[142:143], v[116:117], v[108:109], v[142:143] op_sel_hi:[0,1,1]\n\t" \
    "v_add_f32_dpp v146, v146, v146 quad_perm:[2,3,0,1] row_mask:0xf bank_mask:0xf bound_ctrl:1\n\t" \
    "v_add_f32_dpp %[yp], %[yp], %[yp] quad_perm:[2,3,0,1] row_mask:0xf bank_mask:0xf bound_ctrl:1\n\t" \
    "v_pk_fma_f32 v[144:145], v[116:117], v[110:111], v[144:145] op_sel_hi:[0,1,1]\n\t" \
    "v_add_f32_dpp v146, v146, v146 row_half_mirror row_mask:0xf bank_mask:0xf bound_ctrl:1\n\t" \
    "v_add_f32_dpp %[yp], %[yp], %[yp] row_half_mirror row_mask:0xf bank_mask:0xf bound_ctrl:1\n\t" \
    "v_cmp_eq_u32_e32 vcc, 5, %[sp]\n\t" \
    "v_add_f32_dpp v146, v146, v146 row_mirror row_mask:0xf bank_mask:0xf bound_ctrl:1\n\t" \
    "v_add_f32_dpp %[yp], %[yp], %[yp] row_mirror row_mask:0xf bank_mask:0xf bound_ctrl:1\n\t" \
    "v_cndmask_b32_e32 %[yk0], %[yk0], %[yp], vcc\n\t" \
    "v_pk_fma_f32 %[s01], v[146:147], v[104:105], v[142:143] op_sel_hi:[0,1,1] neg_lo:[1,0,0] neg_hi:[1,0,0]\n\t" \
    "v_pk_fma_f32 %[s23], v[146:147], v[106:107], v[144:145] op_sel_hi:[0,1,1] neg_lo:[1,0,0] neg_hi:[1,0,0]\n\t" \
    "v_pk_mul_f32 v[140:141], %[s01], v[112:113]\n\t" \
    "v_pk_fma_f32 v[140:141], %[s23], v[114:115], v[140:141]\n\t" \
    "v_add_f32 %[yp], v140, v141\n\t" \
    "s_waitcnt lgkmcnt(0)\n\t" \
    "ds_read_b128 v[96:99], %[ab] offset:26624\n\t" \
    "ds_read_b128 v[100:103], %[ab] offset:2048\n\t" \
    "ds_read_b128 v[104:107], %[ab] offset:18432\n\t" \
    "ds_read_b128 v[108:111], %[ab] offset:10240\n\t" \
    "ds_read_b128 v[112:115], %[ab] offset:34816\n\t" \
    "ds_read_b32 v116, %[av] offset:512\n\t" \
    "v_pk_mul_f32 v[140:141], %[s01], v[118:119]\n\t" \
    "v_pk_fma_f32 v[140:141], %[s23], v[120:121], v[140:141]\n\t" \
    "v_add_f32 v146, v140, v141\n\t" \
    "v_pk_mul_f32 v[142:143], %[s01], v[122:123]\n\t" \
    "v_pk_mul_f32 v[144:145], %[s23], v[124:125]\n\t" \
    "v_add_f32_dpp v146, v146, v146 quad_perm:[1,0,3,2] row_mask:0xf bank_mask:0xf bound_ctrl:1\n\t" \
    "v_add_f32_dpp %[yp], %[yp], %[yp] quad_perm:[1,0,3,2] row_mask:0xf bank_mask:0xf bound_ctrl:1\n\t" \
    "v_pk_fma_f32 v[142:143], v[138:139], v[130:131], v[142:143] op_sel_hi:[0,1,1]\n\t" \
    "v_add_f32_dpp v146, v146, v146 quad_perm:[2,3,0,1] row_mask:0xf bank_mask:0xf bound_ctrl:1\n\t" \
    "v_add_f32_dpp %[yp], %[yp], %[yp] quad_perm:[2,3,0,1] row_mask:0xf bank_mask:0xf bound_ctrl:1\n\t" \
    "v_pk_fma_f32 v[144:145], v[138:139], v[132:133], v[144:145] op_sel_hi:[0,1,1]\n\t" \
    "v_add_f32_dpp v146, v146, v146 row_half_mirror row_mask:0xf bank_mask:0xf bound_ctrl:1\n\t" \
    "v_add_f32_dpp %[yp], %[yp], %[yp] row_half_mirror row_mask:0xf bank_mask:0xf bound_ctrl:1\n\t" \
    "v_cmp_eq_u32_e32 vcc, 6, %[sp]\n\t" \
    "v_add_f32_dpp v146, v146, v146 row_mirror row_mask:0xf bank_mask:0xf bound_ctrl:1\n\t" \
    "v_add_f32_dpp %[yp], %[yp], %[yp] row_mirror row_mask:0xf bank_mask:0xf bound_ctrl:1\n\t" \
    "v_cndmask_b32_e32 %[yk0], %[yk0], %[yp], vcc\n\t" \
    "v_pk_fma_f32 %[s01], v[146:147], v[126:127], v[142:143] op_sel_hi:[0,1,1] neg_lo:[1,0,0] neg_hi:[1,0,0]\n\t" \
    "v_pk_fma_f32 %[s23], v[146:147], v[128:129], v[144:145] op_sel_hi:[0,1,1] neg_lo:[1,0,0] neg_hi:[1,0,0]\n\t" \
    "v_pk_mul_f32 v[140:141], %[s01], v[134:135]\n\t" \
    "v_pk_fma_f32 v[140:141], %[s23], v[136:137], v[140:141]\n\t" \
    "v_add_f32 %[yp], v140, v141\n\t" \
    "s_waitcnt lgkmcnt(0)\n\t" \
    "ds_read_b128 v[118:121], %[ab] offset:26880\n\t" \
    "ds_read_b128 v[122:125], %[ab] offset:2304\n\t" \
    "ds_read_b128 v[126:129], %[ab] offset:18688\n\t" \
    "ds_read_b128 v[130:133], %[ab] offset:10496\n\t" \
    "ds_read_b128 v[134:137], %[ab] offset:35072\n\t" \
    "ds_read_b32 v138, %[av] offset:576\n\t" \
    "v_pk_mul_f32 v[140:141], %[s01], v[96:97]\n\t" \
    "v_pk_fma_f32 v[140:141], %[s23], v[98:99], v[140:141]\n\t" \
    "v_add_f32 v146, v140, v141\n\t" \
    "v_pk_mul_f32 v[142:143], %[s01], v[100:101]\n\t" \
    "v_pk_mul_f32 v[144:145], %[s23], v[102:103]\n\t" \
    "v_add_f32_dpp v146, v146, v146 quad_perm:[1,0,3,2] row_mask:0xf bank_mask:0xf bound_ctrl:1\n\t" \
    "v_add_f32_dpp %[yp], %[yp], %[yp] quad_perm:[1,0,3,2] row_mask:0xf bank_mask:0xf bound_ctrl:1\n\t" \
    "v_pk_fma_f32 v[142:143], v[116:117], v[108:109], v[142:143] op_sel_hi:[0,1,1]\n\t" \
    "v_add_f32_dpp v146, v146, v146 quad_perm:[2,3,0,1] row_mask:0xf bank_mask:0xf bound_ctrl:1\n\t" \
    "v_add_f32_dpp %[yp], %[yp], %[yp] quad_perm:[2,3,0,1] row_mask:0xf bank_mask:0xf bound_ctrl:1\n\t" \
    "v_pk_fma_f32 v[144:145], v[116:117], v[110:111], v[144:145] op_sel_hi:[0,1,1]\n\t" \
    "v_add_f32_dpp v146, v146, v146 row_half_mirror row_mask:0xf bank_mask:0xf bound_ctrl:1\n\t" \
    "v_add_f32_dpp %[yp], %[yp], %[yp] row_half_mirror row_mask:0xf bank_mask:0xf bound_ctrl:1\n\t" \
    "v_cmp_eq_u32_e32 vcc, 7, %[sp]\n\t" \
    "v_add_f32_dpp v146, v146, v146 row_mirror row_mask:0xf bank_mask:0xf bound_ctrl:1\n\t" \
    "v_add_f32_dpp %[yp], %[yp], %[yp] row_mirror row_mask:0xf bank_mask:0xf bound_ctrl:1\n\t" \
    "v_cndmask_b32_e32 %[yk0], %[yk0], %[yp], vcc\n\t" \
    "v_pk_fma_f32 %[s01], v[146:147], v[104:105], v[142:143] op_sel_hi:[0,1,1] neg_lo:[1,0,0] neg_hi:[1,0,0]\n\t" \
    "v_pk_fma_f32 %[s23], v[146:147], v[106:107], v[144:145] op_sel_hi:[0,1,1] neg_lo:[1,0,0] neg_hi:[1,0,0]\n\t" \
    "v_pk_mul_f32 v[140:141], %[s01], v[112:113]\n\t" \
    "v_pk_fma_f32 v[140:141], %[s23], v[114:115], v[140:141]\n\t" \
    "v_add_f32 %[yp], v140, v141\n\t" \
    "s_waitcnt lgkmcnt(0)\n\t" \
    "ds_read_b128 v[96:99], %[ab] offset:27136\n\t" \
    "ds_read_b128 v[100:103], %[ab] offset:2560\n\t" \
    "ds_read_b128 v[104:107], %[ab] offset:18944\n\t" \
    "ds_read_b128 v[108:111], %[ab] offset:10752\n\t" \
    "ds_read_b128 v[112:115], %[ab] offset:35328\n\t" \
    "ds_read_b32 v116, %[av] offset:640\n\t" \
    "v_pk_mul_f32 v[140:141], %[s01], v[118:119]\n\t" \
    "v_pk_fma_f32 v[140:141], %[s23], v[120:121], v[140:141]\n\t" \
    "v_add_f32 v146, v140, v141\n\t" \
    "v_pk_mul_f32 v[142:143], %[s01], v[122:123]\n\t" \
    "v_pk_mul_f32 v[144:145], %[s23], v[124:125]\n\t" \
    "v_add_f32_dpp v146, v146, v146 quad_perm:[1,0,3,2] row_mask:0xf bank_mask:0xf bound_ctrl:1\n\t" \
    "v_add_f32_dpp %[yp], %[yp], %[yp] quad_perm:[1,0,3,2] row_mask:0xf bank_mask:0xf bound_ctrl:1\n\t" \
    "v_pk_fma_f32 v[142:143], v[138:139], v[130:131], v[142:143] op_sel_hi:[0,1,1]\n\t" \
    "v_add_f32_dpp v146, v146, v146 quad_perm:[2,3,0,1] row_mask:0xf bank_mask:0xf bound_ctrl:1\n\t" \
    "v_add_f32_dpp %[yp], %[yp], %[yp] quad_perm:[2,3,0,1] row_mask:0xf bank_mask:0xf bound_ctrl:1\n\t" \
    "v_pk_fma_f32 v[144:145], v[138:139], v[132:133], v[144:145] op_sel_hi:[0,1,1]\n\t" \
    "v_add_f32_dpp v146, v146, v146 row_half_mirror row_mask:0xf bank_mask:0xf bound_ctrl:1\n\t" \
    "v_add_f32_dpp %[yp], %[yp], %[yp] row_half_mirror row_mask:0xf bank_mask:0xf bound_ctrl:1\n\t" \
    "v_cmp_eq_u32_e32 vcc, 8, %[sp]\n\t" \
    "v_add_f32_dpp v146, v146, v146 row_mirror row_mask:0xf bank_mask:0xf bound_ctrl:1\n\t" \
    "v_add_f32_dpp %[yp], %[yp], %[yp] row_mirror row_mask:0xf bank_mask:0xf bound_ctrl:1\n\t" \
    "v_cndmask_b32_e32 %[yk0], %[yk0], %[yp], vcc\n\t" \
    "v_pk_fma_f32 %[s01], v[146:147], v[126:127], v[142:143] op_sel_hi:[0,1,1] neg_lo:[1,0,0] neg_hi:[1,0,0]\n\t" \
    "v_pk_fma_f32 %[s23], v[146:147], v[128:129], v[144:145] op_sel_hi:[0,1,1] neg_lo:[1,0,0] neg_hi:[1,0,0]\n\t" \
    "v_pk_mul_f32 v[140:141], %[s01], v[134:135]\n\t" \
    "v_pk_fma_f32 v[140:141], %[s23], v[136:137], v[140:141]\n\t" \
    "v_add_f32 %[yp], v140, v141\n\t" \
    "s_waitcnt lgkmcnt(0)\n\t" \
    "ds_read_b128 v[118:121], %[ab] offset:27392\n\t" \
    "ds_read_b128 v[122:125], %[ab] offset:2816\n\t" \
    "ds_read_b128 v[126:129], %[ab] offset:19200\n\t" \
    "ds_read_b128 v[130:133], %[ab] offset:11008\n\t" \
    "ds_read_b128 v[134:137], %[ab] offset:35584\n\t" \
    "ds_read_b32 v138, %[av] offset:704\n\t" \
    "v_pk_mul_f32 v[140:141], %[s01], v[96:97]\n\t" \
    "v_pk_fma_f32 v[140:141], %[s23], v[98:99], v[140:141]\n\t" \
    "v_add_f32 v146, v140, v141\n\t" \
    "v_pk_mul_f32 v[142:143], %[s01], v[100:101]\n\t" \
    "v_pk_mul_f32 v[144:145], %[s23], v[102:103]\n\t" \
    "v_add_f32_dpp v146, v146, v146 quad_perm:[1,0,3,2] row_mask:0xf bank_mask:0xf bound_ctrl:1\n\t" \
    "v_add_f32_dpp %[yp], %[yp], %[yp] quad_perm:[1,0,3,2] row_mask:0xf bank_mask:0xf bound_ctrl:1\n\t" \
    "v_pk_fma_f32 v[142:143], v[116:117], v[108:109], v[142:143] op_sel_hi:[0,1,1]\n\t" \
    "v_add_f32_dpp v146, v146, v146 quad_perm:[2,3,0,1] row_mask:0xf bank_mask:0xf bound_ctrl:1\n\t" \
    "v_add_f32_dpp %[yp], %[yp], %[yp] quad_perm:[2,3,0,1] row_mask:0xf bank_mask:0xf bound_ctrl:1\n\t" \
    "v_pk_fma_f32 v[144:145], v[116:117], v[110:111], v[144:145] op_sel_hi:[0,1,1]\n\t" \
    "v_add_f32_dpp v146, v146, v146 row_half_mirror row_mask:0xf bank_mask:0xf bound_ctrl:1\n\t" \
    "v_add_f32_dpp %[yp], %[yp], %[yp] row_half_mirror row_mask:0xf bank_mask:0xf bound_ctrl:1\n\t" \
    "v_cmp_eq_u32_e32 vcc, 9, %[sp]\n\t" \
    "v_add_f32_dpp v146, v146, v146 row_mirror row_mask:0xf bank_mask:0xf bound_ctrl:1\n\t" \
    "v_add_f32_dpp %[yp], %[yp], %[yp] row_mirror row_mask:0xf bank_mask:0xf bound_ctrl:1\n\t" \
    "v_cndmask_b32_e32 %[yk0], %[yk0], %[yp], vcc\n\t" \
    "v_pk_fma_f32 %[s01], v[146:147], v[104:105], v[142:143] op_sel_hi:[0,1,1] neg_lo:[1,0,0] neg_hi:[1,0,0]\n\t" \
    "v_pk_fma_f32 %[s23], v[146:147], v[106:107], v[144:145] op_sel_hi:[0,1,1] neg_lo:[1,0,0] neg_hi:[1,0,0]\n\t" \
    "v_pk_mul_f32 v[140:141], %[s01], v[112:113]\n\t" \
    "v_pk_fma_f32 v[140:141], %[s23], v[114:115], v[140:141]\n\t" \
    "v_add_f32 %[yp], v140, v141\n\t" \
    "s_waitcnt lgkmcnt(0)\n\t" \
    "ds_read_b128 v[96:99], %[ab] offset:27648\n\t" \
    "ds_read_b128 v[100:103], %[ab] offset:3072\n\t" \
    "ds_read_b128 v[104:107], %[ab] offset:19456\n\t" \
    "ds_read_b128 v[108:111], %[ab] offset:11264\n\t" \
    "ds_read_b128 v[112:115], %[ab] offset:35840\n\t" \
    "ds_read_b32 v116, %[av] offset:768\n\t" \
    "v_pk_mul_f32 v[140:141], %[s01], v[118:119]\n\t" \
    "v_pk_fma_f32 v[140:141], %[s23], v[120:121], v[140:141]\n\t" \
    "v_add_f32 v146, v140, v141\n\t" \
    "v_pk_mul_f32 v[142:143], %[s01], v[122:123]\n\t" \
    "v_pk_mul_f32 v[144:145], %[s23], v[124:125]\n\t" \
    "v_add_f32_dpp v146, v146, v146 quad_perm:[1,0,3,2] row_mask:0xf bank_mask:0xf bound_ctrl:1\n\t" \
    "v_add_f32_dpp %[yp], %[yp], %[yp] quad_perm:[1,0,3,2] row_mask:0xf bank_mask:0xf bound_ctrl:1\n\t" \
    "v_pk_fma_f32 v[142:143], v[138:139], v[130:131], v[142:143] op_sel_hi:[0,1,1]\n\t" \
    "v_add_f32_dpp v146, v146, v146 quad_perm:[2,3,0,1] row_mask:0xf bank_mask:0xf bound_ctrl:1\n\t" \
    "v_add_f32_dpp %[yp], %[yp], %[yp] quad_perm:[2,3,0,1] row_mask:0xf bank_mask:0xf bound_ctrl:1\n\t" \
    "v_pk_fma_f32 v[144:145], v[138:139], v[132:133], v[144:145] op_sel_hi:[0,1,1]\n\t" \
    "v_add_f32_dpp v146, v146, v146 row_half_mirror row_mask:0xf bank_mask:0xf bound_ctrl:1\n\t" \
    "v_add_f32_dpp %[yp], %[yp], %[yp] row_half_mirror row_mask:0xf bank_mask:0xf bound_ctrl:1\n\t" \
    "v_cmp_eq_u32_e32 vcc, 10, %[sp]\n\t" \
    "v_add_f32_dpp v146, v146, v146 row_mirror row_mask:0xf bank_mask:0xf bound_ctrl:1\n\t" \
    "v_add_f32_dpp %[yp], %[yp], %[yp] row_mirror row_mask:0xf bank_mask:0xf bound_ctrl:1\n\t" \
    "v_cndmask_b32_e32 %[yk0], %[yk0], %[yp], vcc\n\t" \
    "v_pk_fma_f32 %[s01], v[146:147], v[126:127], v[142:143] op_sel_hi:[0,1,1] neg_lo:[1,0,0] neg_hi:[1,0,0]\n\t" \
    "v_pk_fma_f32 %[s23], v[146:147], v[128:129], v[144:145] op_sel_hi:[0,1,1] neg_lo:[1,0,0] neg_hi:[1,0,0]\n\t" \
    "v_pk_mul_f32 v[140:141], %[s01], v[134:135]\n\t" \
    "v_pk_fma_f32 v[140:141], %[s23], v[136:137], v[140:141]\n\t" \
    "v_add_f32 %[yp], v140, v141\n\t" \
    "s_waitcnt lgkmcnt(0)\n\t" \
    "ds_read_b128 v[118:121], %[ab] offset:27904\n\t" \
    "ds_read_b128 v[122:125], %[ab] offset:3328\n\t" \
    "ds_read_b128 v[126:129], %[ab] offset:19712\n\t" \
    "ds_read_b128 v[130:133], %[ab] offset:11520\n\t" \
    "ds_read_b128 v[134:137], %[ab] offset:36096\n\t" \
    "ds_read_b32 v138, %[av] offset:832\n\t" \
    "v_pk_mul_f32 v[140:141], %[s01], v[96:97]\n\t" \
    "v_pk_fma_f32 v[140:141], %[s23], v[98:99], v[140:141]\n\t" \
    "v_add_f32 v146, v140, v141\n\t" \
    "v_pk_mul_f32 v[142:143], %[s01], v[100:101]\n\t" \
    "v_pk_mul_f32 v[144:145], %[s23], v[102:103]\n\t" \
    "v_add_f32_dpp v146, v146, v146 quad_perm:[1,0,3,2] row_mask:0xf bank_mask:0xf bound_ctrl:1\n\t" \
    "v_add_f32_dpp %[yp], %[yp], %[yp] quad_perm:[1,0,3,2] row_mask:0xf bank_mask:0xf bound_ctrl:1\n\t" \
    "v_pk_fma_f32 v[142:143], v[116:117], v[108:109], v[142:143] op_sel_hi:[0,1,1]\n\t" \
    "v_add_f32_dpp v146, v146, v146 quad_perm:[2,3,0,1] row_mask:0xf bank_mask:0xf bound_ctrl:1\n\t" \
    "v_add_f32_dpp %[yp], %[yp], %[yp] quad_perm:[2,3,0,1] row_mask:0xf bank_mask:0xf bound_ctrl:1\n\t" \
    "v_pk_fma_f32 v[144:145], v[116:117], v[110:111], v[144:145] op_sel_hi:[0,1,1]\n\t" \
    "v_add_f32_dpp v146, v146, v146 row_half_mirror row_mask:0xf bank_mask:0xf bound_ctrl:1\n\t" \
    "v_add_f32_dpp %[yp], %[yp], %[yp] row_half_mirror row_mask:0xf bank_mask:0xf bound_ctrl:1\n\t" \
    "v_cmp_eq_u32_e32 vcc, 11, %[sp]\n\t" \
    "v_add_f32_dpp v146, v146, v146 row_mirror row_mask:0xf bank_mask:0xf bound_ctrl:1\n\t" \
    "v_add_f32_dpp %[yp], %[yp], %[yp] row_mirror row_mask:0xf bank_mask:0xf bound_ctrl:1\n\t" \
    "v_cndmask_b32_e32 %[yk0], %[yk0], %[yp], vcc\n\t" \
    "v_pk_fma_f32 %[s01], v[146:147], v[104:105], v[142:143] op_sel_hi:[0,1,1] neg_lo:[1,0,0] neg_hi:[1,0,0]\n\t" \
    "v_pk_fma_f32 %[s23], v[146:147], v[106:107], v[144:145] op_sel_hi:[0,1,1] neg_lo:[1,0,0] neg_hi:[1,0,0]\n\t" \
    "v_pk_mul_f32 v[140:141], %[s01], v[112:113]\n\t" \
    "v_pk_fma_f32 v[140:141], %[s23], v[114:115], v[140:141]\n\t" \
    "v_add_f32 %[yp], v140, v141\n\t" \
    "s_waitcnt lgkmcnt(0)\n\t" \
    "ds_read_b128 v[96:99], %[ab] offset:28160\n\t" \
    "ds_read_b128 v[100:103], %[ab] offset:3584\n\t" \
    "ds_read_b128 v[104:107], %[ab] offset:19968\n\t" \
    "ds_read_b128 v[108:111], %[ab] offset:11776\n\t" \
    "ds_read_b128 v[112:115], %[ab] offset:36352\n\t" \
    "ds_read_b32 v116, %[av] offset:896\n\t" \
    "v_pk_mul_f32 v[140:141], %[s01], v[118:119]\n\t" \
    "v_pk_fma_f32 v[140:141], %[s23], v[120:121], v[140:141]\n\t" \
    "v_add_f32 v146, v140, v141\n\t" \
    "v_pk_mul_f32 v[142:143], %[s01], v[122:123]\n\t" \
    "v_pk_mul_f32 v[144:145], %[s23], v[124:125]\n\t" \
    "v_add_f32_dpp v146, v146, v146 quad_perm:[1,0,3,2] row_mask:0xf bank_mask:0xf bound_ctrl:1\n\t" \
    "v_add_f32_dpp %[yp], %[yp], %[yp] quad_perm:[1,0,3,2] row_mask:0xf bank_mask:0xf bound_ctrl:1\n\t" \
    "v_pk_fma_f32 v[142:143], v[138:139], v[130:131], v[142:143] op_sel_hi:[0,1,1]\n\t" \
    "v_add_f32_dpp v146, v146, v146 quad_perm:[2,3,0,1] row_mask:0xf bank_mask:0xf bound_ctrl:1\n\t" \
    "v_add_f32_dpp %[yp], %[yp], %[yp] quad_perm:[2,3,0,1] row_mask:0xf bank_mask:0xf bound_ctrl:1\n\t" \
    "v_pk_fma_f32 v[144:145], v[138:139], v[132:133], v[144:145] op_sel_hi:[0,1,1]\n\t" \
    "v_add_f32_dpp v146, v146, v146 row_half_mirror row_mask:0xf bank_mask:0xf bound_ctrl:1\n\t" \
    "v_add_f32_dpp %[yp], %[yp], %[yp] row_half_mirror row_mask:0xf bank_mask:0xf bound_ctrl:1\n\t" \
    "v_cmp_eq_u32_e32 vcc, 12, %[sp]\n\t" \
    "v_add_f32_dpp v146, v146, v146 row_mirror row_mask:0xf bank_mask:0xf bound_ctrl:1\n\t" \
    "v_add_f32_dpp %[yp], %[yp], %[yp] row_mirror row_mask:0xf bank_mask:0xf bound_ctrl:1\n\t" \
    "v_cndmask_b32_e32 %[yk0], %[yk0], %[yp], vcc\n\t" \
    "v_pk_fma_f32 %[s01], v[146:147], v[126:127], v[142:143] op_sel_hi:[0,1,1] neg_lo:[1,0,0] neg_hi:[1,0,0]\n\t" \
    "v_pk_fma_f32 %[s23], v[146:147], v[128:129], v[144:145] op_sel_hi:[0,1,1] neg_lo:[1,0,0] neg_hi:[1,0,0]\n\t" \
    "v_pk_mul_f32 v[140:141], %[s01], v[134:135]\n\t" \
    "v_pk_fma_f32 v[140:141], %[s23], v[136:137], v[140:141]\n\t" \
    "v_add_f32 %[yp], v140, v141\n\t" \
    "s_waitcnt lgkmcnt(0)\n\t" \
    "ds_read_b128 v[118:121], %[ab] offset:28416\n\t" \
    "ds_read_b128 v[122:125], %[ab] offset:3840\n\t" \
    "ds_read_b128 v[126:129], %[ab] offset:20224\n\t" \
    "ds_read_b128 v[130:133], %[ab] offset:12032\n\t" \
    "ds_read_b128 v[134:137], %[ab] offset:36608\n\t" \
    "ds_read_b32 v138, %[av] offset:960\n\t" \
    "v_pk_mul_f32 v[140:141], %[s01], v[96:97]\n\t" \
    "v_pk_fma_f32 v[140:141], %[s23], v[98:99], v[140:141]\n\t" \
    "v_add_f32 v146, v140, v141\n\t" \
    "v_pk_mul_f32 v[142:143], %[s01], v[100:101]\n\t" \
    "v_pk_mul_f32 v[144:145], %[s23], v[102:103]\n\t" \
    "v_add_f32_dpp v146, v146, v146 quad_perm:[1,0,3,2] row_mask:0xf bank_mask:0xf bound_ctrl:1\n\t" \
    "v_add_f32_dpp %[yp], %[yp], %[yp] quad_perm:[1,0,3,2] row_mask:0xf bank_mask:0xf bound_ctrl:1\n\t" \
    "v_pk_fma_f32 v[142:143], v[116:117], v[108:109], v[142:143] op_sel_hi:[0,1,1]\n\t" \
    "v_add_f32_dpp v146, v146, v146 quad_perm:[2,3,0,1] row_mask:0xf bank_mask:0xf bound_ctrl:1\n\t" \
    "v_add_f32_dpp %[yp], %[yp], %[yp] quad_perm:[2,3,0,1] row_mask:0xf bank_mask:0xf bound_ctrl:1\n\t" \
    "v_pk_fma_f32 v[144:145], v[116:117], v[110:111], v[144:145] op_sel_hi:[0,1,1]\n\t" \
    "v_add_f32_dpp v146, v146, v146 row_half_mirror row_mask:0xf bank_mask:0xf bound_ctrl:1\n\t" \
    "v_add_f32_dpp %[yp], %[yp], %[yp] row_half_mirror row_mask:0xf bank_mask:0xf bound_ctrl:1\n\t" \
    "v_cmp_eq_u32_e32 vcc, 13, %[sp]\n\t" \
    "v_add_f32_dpp v146, v146, v146 row_mirror row_mask:0xf bank_mask:0xf bound_ctrl:1\n\t" \
    "v_add_f32_dpp %[yp], %[yp], %[yp] row_mirror row_mask:0xf bank_mask:0xf bound_ctrl:1\n\t" \
    "v_cndmask_b32_e32 %[yk0], %[yk0], %[yp], vcc\n\t" \
    "v_pk_fma_f32 %[s01], v[146:147], v[104:105], v[142:143] op_sel_hi:[0,1,1] neg_lo:[1,0,0] neg_hi:[1,0,0]\n\t" \
    "v_pk_fma_f32 %[s23], v[146:147], v[106:107], v[144:145] op_sel_hi:[0,1,1] neg_lo:[1,0,0] neg_hi:[1,0,0]\n\t" \
    "v_pk_mul_f32 v[140:141], %[s01], v[112:113]\n\t" \
    "v_pk_fma_f32 v[140:141], %[s23], v[114:115], v[140:141]\n\t" \
    "v_add_f32 %[yp], v140, v141\n\t" \
    "s_waitcnt lgkmcnt(0)\n\t" \
    "ds_read_b128 v[96:99], %[ab] offset:28672\n\t" \
    "ds_read_b128 v[100:103], %[ab] offset:4096\n\t" \
    "ds_read_b128 v[104:107], %[ab] offset:20480\n\t" \
    "ds_read_b128 v[108:111], %[ab] offset:12288\n\t" \
    "ds_read_b128 v[112:115], %[ab] offset:36864\n\t" \
    "ds_read_b32 v116, %[av] offset:1024\n\t" \
    "v_pk_mul_f32 v[140:141], %[s01], v[118:119]\n\t" \
    "v_pk_fma_f32 v[140:141], %[s23], v[120:121], v[140:141]\n\t" \
    "v_add_f32 v146, v140, v141\n\t" \
    "v_pk_mul_f32 v[142:143], %[s01], v[122:123]\n\t" \
    "v_pk_mul_f32 v[144:145], %[s23], v[124:125]\n\t" \
    "v_add_f32_dpp v146, v146, v146 quad_perm:[1,0,3,2] row_mask:0xf bank_mask:0xf bound_ctrl:1\n\t" \
    "v_add_f32_dpp %[yp], %[yp], %[yp] quad_perm:[1,0,3,2] row_mask:0xf bank_mask:0xf bound_ctrl:1\n\t" \
    "v_pk_fma_f32 v[142:143], v[138:139], v[130:131], v[142:143] op_sel_hi:[0,1,1]\n\t" \
    "v_add_f32_dpp v146, v146, v146 quad_perm:[2,3,0,1] row_mask:0xf bank_mask:0xf bound_ctrl:1\n\t" \
    "v_add_f32_dpp %[yp], %[yp], %[yp] quad_perm:[2,3,0,1] row_mask:0xf bank_mask:0xf bound_ctrl:1\n\t" \
    "v_pk_fma_f32 v[144:145], v[138:139], v[132:133], v[144:145] op_sel_hi:[0,1,1]\n\t" \
    "v_add_f32_dpp v146, v146, v146 row_half_mirror row_mask:0xf bank_mask:0xf bound_ctrl:1\n\t" \
    "v_add_f32_dpp %[yp], %[yp], %[yp] row_half_mirror row_mask:0xf bank_mask:0xf bound_ctrl:1\n\t" \
    "v_cmp_eq_u32_e32 vcc, 14, %[sp]\n\t" \
    "v_add_f32_dpp v146, v146, v146 row_mirror row_mask:0xf bank_mask:0xf bound_ctrl:1\n\t" \
    "v_add_f32_dpp %[yp], %[yp], %[yp] row_mirror row_mask:0xf bank_mask:0xf bound_ctrl:1\n\t" \
    "v_cndmask_b32_e32 %[yk0], %[yk0], %[yp], vcc\n\t" \
    "v_pk_fma_f32 %[s01], v[146:147], v[126:127], v[142:143] op_sel_hi:[0,1,1] neg_lo:[1,0,0] neg_hi:[1,0,0]\n\t" \
    "v_pk_fma_f32 %[s23], v[146:147], v[128:129], v[144:145] op_sel_hi:[0,1,1] neg_lo:[1,0,0] neg_hi:[1,0,0]\n\t" \
    "v_pk_mul_f32 v[140:141], %[s01], v[134:135]\n\t" \
    "v_pk_fma_f32 v[140:141], %[s23], v[136:137], v[140:141]\n\t" \
    "v_add_f32 %[yp], v140, v141\n\t" \
    "s_waitcnt lgkmcnt(0)\n\t" \
    "ds_read_b128 v[118:121], %[ab] offset:28928\n\t" \
    "ds_read_b128 v[122:125], %[ab] offset:4352\n\t" \
    "ds_read_b128 v[126:129], %[ab] offset:20736\n\t" \
    "ds_read_b128 v[130:133], %[ab] offset:12544\n\t" \
    "ds_read_b128 v[134:137], %[ab] offset:37120\n\t" \
    "ds_read_b32 v138, %[av] offset:1088\n\t" \
    "v_pk_mul_f32 v[140:141], %[s01], v[96:97]\n\t" \
    "v_pk_fma_f32 v[140:141], %[s23], v[98:99], v[140:141]\n\t" \
    "v_add_f32 v146, v140, v141\n\t" \
    "v_pk_mul_f32 v[142:143], %[s01], v[100:101]\n\t" \
    "v_pk_mul_f32 v[144:145], %[s23], v[102:103]\n\t" \
    "v_add_f32_dpp v146, v146, v146 quad_perm:[1,0,3,2] row_mask:0xf bank_mask:0xf bound_ctrl:1\n\t" \
    "v_add_f32_dpp %[yp], %[yp], %[yp] quad_perm:[1,0,3,2] row_mask:0xf bank_mask:0xf bound_ctrl:1\n\t" \
    "v_pk_fma_f32 v[142:143], v[116:117], v[108:109], v[142:143] op_sel_hi:[0,1,1]\n\t" \
    "v_add_f32_dpp v146, v146, v146 quad_perm:[2,3,0,1] row_mask:0xf bank_mask:0xf bound_ctrl:1\n\t" \
    "v_add_f32_dpp %[yp], %[yp], %[yp] quad_perm:[2,3,0,1] row_mask:0xf bank_mask:0xf bound_ctrl:1\n\t" \
    "v_pk_fma_f32 v[144:145], v[116:117], v[110:111], v[144:145] op_sel_hi:[0,1,1]\n\t" \
    "v_add_f32_dpp v146, v146, v146 row_half_mirror row_mask:0xf bank_mask:0xf bound_ctrl:1\n\t" \
    "v_add_f32_dpp %[yp], %[yp], %[yp] row_half_mirror row_mask:0xf bank_mask:0xf bound_ctrl:1\n\t" \
    "v_cmp_eq_u32_e32 vcc, 15, %[sp]\n\t" \
    "v_add_f32_dpp v146, v146, v146 row_mirror row_mask:0xf bank_mask:0xf bound_ctrl:1\n\t" \
    "v_add_f32_dpp %[yp], %[yp], %[yp] row_mirror row_mask:0xf bank_mask:0xf bound_ctrl:1\n\t" \
    "v_cndmask_b32_e32 %[yk0], %[yk0], %[yp], vcc\n\t" \
    "v_pk_fma_f32 %[s01], v[146:147], v[104:105], v[142:143] op_sel_hi:[0,1,1] neg_lo:[1,0,0] neg_hi:[1,0,0]\n\t" \
    "v_pk_fma_f32 %[s23], v[146:147], v[106:107], v[144:145] op_sel_hi:[0,1,1] neg_lo:[1,0,0] neg_hi:[1,0,0]\n\t" \
    "v_pk_mul_f32 v[140:141], %[s01], v[112:113]\n\t" \
    "v_pk_fma_f32 v[140:141], %[s23], v[114:115], v[140:141]\n\t" \
    "v_add_f32 %[yp], v140, v141\n\t" \
    "s_waitcnt lgkmcnt(0)\n\t" \
    "ds_read_b128 v[96:99], %[ab] offset:29184\n\t" \
    "ds_read_b128 v[100:103], %[ab] offset:4608\n\t" \
    "ds_read_b128 v[104:107], %[ab] offset:20992\n\t" \
    "ds_read_b128 v[108:111], %[ab] offset:12800\n\t" \
    "ds_read_b128 v[112:115], %[ab] offset:37376\n\t" \
    "ds_read_b32 v116, %[av] offset:1152\n\t" \
    "v_pk_mul_f32 v[140:141], %[s01], v[118:119]\n\t" \
    "v_pk_fma_f32 v[140:141], %[s23], v[120:121], v[140:141]\n\t" \
    "v_add_f32 v146, v140, v141\n\t" \
    "v_pk_mul_f32 v[142:143], %[s01], v[122:123]\n\t" \
    "v_pk_mul_f32 v[144:145], %[s23], v[124:125]\n\t" \
    "v_add_f32_dpp v146, v146, v146 quad_perm:[1,0,3,2] row_mask:0xf bank_mask:0xf bound_ctrl:1\n\t" \
    "v_add_f32_dpp %[yp], %[yp], %[yp] quad_perm:[1,0,3,2] row_mask:0xf bank_mask:0xf bound_ctrl:1\n\t" \
    "v_pk_fma_f32 v[142:143], v[138:139], v[130:131], v[142:143] op_sel_hi:[0,1,1]\n\t" \
    "v_add_f32_dpp v146, v146, v146 quad_perm:[2,3,0,1] row_mask:0xf bank_mask:0xf bound_ctrl:1\n\t" \
    "v_add_f32_dpp %[yp], %[yp], %[yp] quad_perm:[2,3,0,1] row_mask:0xf bank_mask:0xf bound_ctrl:1\n\t" \
    "v_pk_fma_f32 v[144:145], v[138:139], v[132:133], v[144:145] op_sel_hi:[0,1,1]\n\t" \
    "v_add_f32_dpp v146, v146, v146 row_half_mirror row_mask:0xf bank_mask:0xf bound_ctrl:1\n\t" \
    "v_add_f32_dpp %[yp], %[yp], %[yp] row_half_mirror row_mask:0xf bank_mask:0xf bound_ctrl:1\n\t" \
    "v_cmp_eq_u32_e32 vcc, 0, %[sp]\n\t" \
    "v_add_f32_dpp v146, v146, v146 row_mirror row_mask:0xf bank_mask:0xf bound_ctrl:1\n\t" \
    "v_add_f32_dpp %[yp], %[yp], %[yp] row_mirror row_mask:0xf bank_mask:0xf bound_ctrl:1\n\t" \
    "v_cndmask_b32_e32 %[yk1], %[yk1], %[yp], vcc\n\t" \
    "v_pk_fma_f32 %[s01], v[146:147], v[126:127], v[142:143] op_sel_hi:[0,1,1] neg_lo:[1,0,0] neg_hi:[1,0,0]\n\t" \
    "v_pk_fma_f32 %[s23], v[146:147], v[128:129], v[144:145] op_sel_hi:[0,1,1] neg_lo:[1,0,0] neg_hi:[1,0,0]\n\t" \
    "v_pk_mul_f32 v[140:141], %[s01], v[134:135]\n\t" \
    "v_pk_fma_f32 v[140:141], %[s23], v[136:137], v[140:141]\n\t" \
    "v_add_f32 %[yp], v140, v141\n\t" \
    "s_waitcnt lgkmcnt(0)\n\t" \
    "ds_read_b128 v[118:121], %[ab] offset:29440\n\t" \
    "ds_read_b128 v[122:125], %[ab] offset:4864\n\t" \
    "ds_read_b128 v[126:129], %[ab] offset:21248\n\t" \
    "ds_read_b128 v[130:133], %[ab] offset:13056\n\t" \
    "ds_read_b128 v[134:137], %[ab] offset:37632\n\t" \
    "ds_read_b32 v138, %[av] offset:1216\n\t" \
    "v_pk_mul_f32 v[140:141], %[s01], v[96:97]\n\t" \
    "v_pk_fma_f32 v[140:141], %[s23], v[98:99], v[140:141]\n\t" \
    "v_add_f32 v146, v140, v141\n\t" \
    "v_pk_mul_f32 v[142:143], %[s01], v[100:101]\n\t" \
    "v_pk_mul_f32 v[144:145], %[s23], v[102:103]\n\t" \
    "v_add_f32_dpp v146, v146, v146 quad_perm:[1,0,3,2] row_mask:0xf bank_mask:0xf bound_ctrl:1\n\t" \
    "v_add_f32_dpp %[yp], %[yp], %[yp] quad_perm:[1,0,3,2] row_mask:0xf bank_mask:0xf bound_ctrl:1\n\t" \
    "v_pk_fma_f32 v[142:143], v[116:117], v[108:109], v[142:143] op_sel_hi:[0,1,1]\n\t" \
    "v_add_f32_dpp v146, v146, v146 quad_perm:[2,3,0,1] row_mask:0xf bank_mask:0xf bound_ctrl:1\n\t" \
    "v_add_f32_dpp %[yp], %[yp], %[yp] quad_perm:[2,3,0,1] row_mask:0xf bank_mask:0xf bound_ctrl:1\n\t" \
    "v_pk_fma_f32 v[144:145], v[116:117], v[110:111], v[144:145] op_sel_hi:[0,1,1]\n\t" \
    "v_add_f32_dpp v146, v146, v146 row_half_mirror row_mask:0xf bank_mask:0xf bound_ctrl:1\n\t" \
    "v_add_f32_dpp %[yp], %[yp], %[yp] row_half_mirror row_mask:0xf bank_mask:0xf bound_ctrl:1\n\t" \
    "v_cmp_eq_u32_e32 vcc, 1, %[sp]\n\t" \
    "v_add_f32_dpp v146, v146, v146 row_mirror row_mask:0xf bank_mask:0xf bound_ctrl:1\n\t" \
    "v_add_f32_dpp %[yp], %[yp], %[yp] row_mirror row_mask:0xf bank_mask:0xf bound_ctrl:1\n\t" \
    "v_cndmask_b32_e32 %[yk1], %[yk1], %[yp], vcc\n\t" \
    "v_pk_fma_f32 %[s01], v[146:147], v[104:105], v[142:143] op_sel_hi:[0,1,1] neg_lo:[1,0,0] neg_hi:[1,0,0]\n\t" \
    "v_pk_fma_f32 %[s23], v[146:147], v[106:107], v[144:145] op_sel_hi:[0,1,1] neg_lo:[1,0,0] neg_hi:[1,0,0]\n\t" \
    "v_pk_mul_f32 v[140:141], %[s01], v[112:113]\n\t" \
    "v_pk_fma_f32 v[140:141], %[s23], v[114:115], v[140:141]\n\t" \
    "v_add_f32 %[yp], v140, v141\n\t" \
    "s_waitcnt lgkmcnt(0)\n\t" \
    "ds_read_b128 v[96:99], %[ab] offset:29696\n\t" \
    "ds_read_b128 v[100:103], %[ab] offset:5120\n\t" \
    "ds_read_b128 v[104:107], %[ab] offset:21504\n\t" \
    "ds_read_b128 v[108:111], %[ab] offset:13312\n\t" \
    "ds_read_b128 v[112:115], %[ab] offset:37888\n\t" \
    "ds_read_b32 v116, %[av] offset:1280\n\t" \
    "v_pk_mul_f32 v[140:141], %[s01], v[118:119]\n\t" \
    "v_pk_fma_f32 v[140:141], %[s23], v[120:121], v[140:141]\n\t" \
    "v_add_f32 v146, v140, v141\n\t" \
    "v_pk_mul_f32 v[142:143], %[s01], v[122:123]\n\t" \
    "v_pk_mul_f32 v[144:145], %[s23], v[124:125]\n\t" \
    "v_add_f32_dpp v146, v146, v146 quad_perm:[1,0,3,2] row_mask:0xf bank_mask:0xf bound_ctrl:1\n\t" \
    "v_add_f32_dpp %[yp], %[yp], %[yp] quad_perm:[1,0,3,2] row_mask:0xf bank_mask:0xf bound_ctrl:1\n\t" \
    "v_pk_fma_f32 v[142:143], v[138:139], v[130:131], v[142:143] op_sel_hi:[0,1,1]\n\t" \
    "v_add_f32_dpp v146, v146, v146 quad_perm:[2,3,0,1] row_mask:0xf bank_mask:0xf bound_ctrl:1\n\t" \
    "v_add_f32_dpp %[yp], %[yp], %[yp] quad_perm:[2,3,0,1] row_mask:0xf bank_mask:0xf bound_ctrl:1\n\t" \
    "v_pk_fma_f32 v[144:145], v[138:139], v[132:133], v[144:145] op_sel_hi:[0,1,1]\n\t" \
    "v_add_f32_dpp v146, v146, v146 row_half_mirror row_mask:0xf bank_mask:0xf bound_ctrl:1\n\t" \
    "v_add_f32_dpp %[yp], %[yp], %[yp] row_half_mirror row_mask:0xf bank_mask:0xf bound_ctrl:1\n\t" \
    "v_cmp_eq_u32_e32 vcc, 2, %[sp]\n\t" \
    "v_add_f32_dpp v146, v146, v146 row_mirror row_mask:0xf bank_mask:0xf bound_ctrl:1\n\t" \
    "v_add_f32_dpp %[yp], %[yp], %[yp] row_mirror row_mask:0xf bank_mask:0xf bound_ctrl:1\n\t" \
    "v_cndmask_b32_e32 %[yk1], %[yk1], %[yp], vcc\n\t" \
    "v_pk_fma_f32 %[s01], v[146:147], v[126:127], v[142:143] op_sel_hi:[0,1,1] neg_lo:[1,0,0] neg_hi:[1,0,0]\n\t" \
    "v_pk_fma_f32 %[s23], v[146:147], v[128:129], v[144:145] op_sel_hi:[0,1,1] neg_lo:[1,0,0] neg_hi:[1,0,0]\n\t" \
    "v_pk_mul_f32 v[140:141], %[s01], v[134:135]\n\t" \
    "v_pk_fma_f32 v[140:141], %[s23], v[136:137], v[140:141]\n\t" \
    "v_add_f32 %[yp], v140, v141\n\t" \
    "s_waitcnt lgkmcnt(0)\n\t" \
    "ds_read_b128 v[118:121], %[ab] offset:29952\n\t" \
    "ds_read_b128 v[122:125], %[ab] offset:5376\n\t" \
    "ds_read_b128 v[126:129], %[ab] offset:21760\n\t" \
    "ds_read_b128 v[130:133], %[ab] offset:13568\n\t" \
    "ds_read_b128 v[134:137], %[ab] offset:38144\n\t" \
    "ds_read_b32 v138, %[av] offset:1344\n\t" \
    "v_pk_mul_f32 v[140:141], %[s01], v[96:97]\n\t" \
    "v_pk_fma_f32 v[140:141], %[s23], v[98:99], v[140:141]\n\t" \
    "v_add_f32 v146, v140, v141\n\t" \
    "v_pk_mul_f32 v[142:143], %[s01], v[100:101]\n\t" \
    "v_pk_mul_f32 v[144:145], %[s23], v[102:103]\n\t" \
    "v_add_f32_dpp v146, v146, v146 quad_perm:[1,0,3,2] row_mask:0xf bank_mask:0xf bound_ctrl:1\n\t" \
    "v_add_f32_dpp %[yp], %[yp], %[yp] quad_perm:[1,0,3,2] row_mask:0xf bank_mask:0xf bound_ctrl:1\n\t" \
    "v_pk_fma_f32 v[142:143], v[116:117], v[108:109], v[142:143] op_sel_hi:[0,1,1]\n\t" \
    "v_add_f32_dpp v146, v146, v146 quad_perm:[2,3,0,1] row_mask:0xf bank_mask:0xf bound_ctrl:1\n\t" \
    "v_add_f32_dpp %[yp], %[yp], %[yp] quad_perm:[2,3,0,1] row_mask:0xf bank_mask:0xf bound_ctrl:1\n\t" \
    "v_pk_fma_f32 v[144:145], v[116:117], v[110:111], v[144:145] op_sel_hi:[0,1,1]\n\t" \
    "v_add_f32_dpp v146, v146, v146 row_half_mirror row_mask:0xf bank_mask:0xf bound_ctrl:1\n\t" \
    "v_add_f32_dpp %[yp], %[yp], %[yp] row_half_mirror row_mask:0xf bank_mask:0xf bound_ctrl:1\n\t" \
    "v_cmp_eq_u32_e32 vcc, 3, %[sp]\n\t" \
    "v_add_f32_dpp v146, v146, v146 row_mirror row_mask:0xf bank_mask:0xf bound_ctrl:1\n\t" \
    "v_add_f32_dpp %[yp], %[yp], %[yp] row_mirror row_mask:0xf bank_mask:0xf bound_ctrl:1\n\t" \
    "v_cndmask_b32_e32 %[yk1], %[yk1], %[yp], vcc\n\t" \
    "v_pk_fma_f32 %[s01], v[146:147], v[104:105], v[142:143] op_sel_hi:[0,1,1] neg_lo:[1,0,0] neg_hi:[1,0,0]\n\t" \
    "v_pk_fma_f32 %[s23], v[146:147], v[106:107], v[144:145] op_sel_hi:[0,1,1] neg_lo:[1,0,0] neg_hi:[1,0,0]\n\t" \
    "v_pk_mul_f32 v[140:141], %[s01], v[112:113]\n\t" \
    "v_pk_fma_f32 v[140:141], %[s23], v[114:115], v[140:141]\n\t" \
    "v_add_f32 %[yp], v140, v141\n\t" \
    "s_waitcnt lgkmcnt(0)\n\t" \
    "ds_read_b128 v[96:99], %[ab] offset:30208\n\t" \
    "ds_read_b128 v[100:103], %[ab] offset:5632\n\t" \
    "ds_read_b128 v[104:107], %[ab] offset:22016\n\t" \
    "ds_read_b128 v[108:111], %[ab] offset:13824\n\t" \
    "ds_read_b128 v[112:115], %[ab] offset:38400\n\t" \
    "ds_read_b32 v116, %[av] offset:1408\n\t" \
    "v_pk_mul_f32 v[140:141], %[s01], v[118:119]\n\t" \
    "v_pk_fma_f32 v[140:141], %[s23], v[120:121], v[140:141]\n\t" \
    "v_add_f32 v146, v140, v141\n\t" \
    "v_pk_mul_f32 v[142:143], %[s01], v[122:123]\n\t" \
    "v_pk_mul_f32 v[144:145], %[s23], v[124:125]\n\t" \
    "v_add_f32_dpp v146, v146, v146 quad_perm:[1,0,3,2] row_mask:0xf bank_mask:0xf bound_ctrl:1\n\t" \
    "v_add_f32_dpp %[yp], %[yp], %[yp] quad_perm:[1,0,3,2] row_mask:0xf bank_mask:0xf bound_ctrl:1\n\t" \
    "v_pk_fma_f32 v[142:143], v[138:139], v[130:131], v[142:143] op_sel_hi:[0,1,1]\n\t" \
    "v_add_f32_dpp v146, v146, v146 quad_perm:[2,3,0,1] row_mask:0xf bank_mask:0xf bound_ctrl:1\n\t" \
    "v_add_f32_dpp %[yp], %[yp], %[yp] quad_perm:[2,3,0,1] row_mask:0xf bank_mask:0xf bound_ctrl:1\n\t" \
    "v_pk_fma_f32 v[144:145], v[138:139], v[132:133], v[144:145] op_sel_hi:[0,1,1]\n\t" \
    "v_add_f32_dpp v146, v146, v146 row_half_mirror row_mask:0xf bank_mask:0xf bound_ctrl:1\n\t" \
    "v_add_f32_dpp %[yp], %[yp], %[yp] row_half_mirror row_mask:0xf bank_mask:0xf bound_ctrl:1\n\t" \
    "v_cmp_eq_u32_e32 vcc, 4, %[sp]\n\t" \
    "v_add_f32_dpp v146, v146, v146 row_mirror row_mask:0xf bank_mask:0xf bound_ctrl:1\n\t" \
    "v_add_f32_dpp %[yp], %[yp], %[yp] row_mirror row_mask:0xf bank_mask:0xf bound_ctrl:1\n\t" \
    "v_cndmask_b32_e32 %[yk1], %[yk1], %[yp], vcc\n\t" \
    "v_pk_fma_f32 %[s01], v[146:147], v[126:127], v[142:143] op_sel_hi:[0,1,1] neg_lo:[1,0,0] neg_hi:[1,0,0]\n\t" \
    "v_pk_fma_f32 %[s23], v[146:147], v[128:129], v[144:145] op_sel_hi:[0,1,1] neg_lo:[1,0,0] neg_hi:[1,0,0]\n\t" \
    "v_pk_mul_f32 v[140:141], %[s01], v[134:135]\n\t" \
    "v_pk_fma_f32 v[140:141], %[s23], v[136:137], v[140:141]\n\t" \
    "v_add_f32 %[yp], v140, v141\n\t" \
    "s_waitcnt lgkmcnt(0)\n\t" \
    "ds_read_b128 v[118:121], %[ab] offset:30464\n\t" \
    "ds_read_b128 v[122:125], %[ab] offset:5888\n\t" \
    "ds_read_b128 v[126:129], %[ab] offset:22272\n\t" \
    "ds_read_b128 v[130:133], %[ab] offset:14080\n\t" \
    "ds_read_b128 v[134:137], %[ab] offset:38656\n\t" \
    "ds_read_b32 v138, %[av] offset:1472\n\t" \
    "v_pk_mul_f32 v[140:141], %[s01], v[96:97]\n\t" \
    "v_pk_fma_f32 v[140:141], %[s23], v[98:99], v[140:141]\n\t" \
    "v_add_f32 v146, v140, v141\n\t" \
    "v_pk_mul_f32 v[142:143], %[s01], v[100:101]\n\t" \
    "v_pk_mul_f32 v[144:145], %[s23], v[102:103]\n\t" \
    "v_add_f32_dpp v146, v146, v146 quad_perm:[1,0,3,2] row_mask:0xf bank_mask:0xf bound_ctrl:1\n\t" \
    "v_add_f32_dpp %[yp], %[yp], %[yp] quad_perm:[1,0,3,2] row_mask:0xf bank_mask:0xf bound_ctrl:1\n\t" \
    "v_pk_fma_f32 v[142:143], v[116:117], v[108:109], v[142:143] op_sel_hi:[0,1,1]\n\t" \
    "v_add_f32_dpp v146, v146, v146 quad_perm:[2,3,0,1] row_mask:0xf bank_mask:0xf bound_ctrl:1\n\t" \
    "v_add_f32_dpp %[yp], %[yp], %[yp] quad_perm:[2,3,0,1] row_mask:0xf bank_mask:0xf bound_ctrl:1\n\t" \
    "v_pk_fma_f32 v[144:145], v[116:117], v[110:111], v[144:145] op_sel_hi:[0,1,1]\n\t" \
    "v_add_f32_dpp v146, v146, v146 row_half_mirror row_mask:0xf bank_mask:0xf bound_ctrl:1\n\t" \
    "v_add_f32_dpp %[yp], %[yp], %[yp] row_half_mirror row_mask:0xf bank_mask:0xf bound_ctrl:1\n\t" \
    "v_cmp_eq_u32_e32 vcc, 5, %[sp]\n\t" \
    "v_add_f32_dpp v146, v146, v146 row_mirror row_mask:0xf bank_mask:0xf bound_ctrl:1\n\t" \
    "v_add_f32_dpp %[yp], %[yp], %[yp] row_mirror row_mask:0xf bank_mask:0xf bound_ctrl:1\n\t" \
    "v_cndmask_b32_e32 %[yk1], %[yk1], %[yp], vcc\n\t" \
    "v_pk_fma_f32 %[s01], v[146:147], v[104:105], v[142:143] op_sel_hi:[0,1,1] neg_lo:[1,0,0] neg_hi:[1,0,0]\n\t" \
    "v_pk_fma_f32 %[s23], v[146:147], v[106:107], v[144:145] op_sel_hi:[0,1,1] neg_lo:[1,0,0] neg_hi:[1,0,0]\n\t" \
    "v_pk_mul_f32 v[140:141], %[s01], v[112:113]\n\t" \
    "v_pk_fma_f32 v[140:141], %[s23], v[114:115], v[140:141]\n\t" \
    "v_add_f32 %[yp], v140, v141\n\t" \
    "s_waitcnt lgkmcnt(0)\n\t" \
    "ds_read_b128 v[96:99], %[ab] offset:30720\n\t" \
    "ds_read_b128 v[100:103], %[ab] offset:6144\n\t" \
    "ds_read_b128 v[104:107], %[ab] offset:22528\n\t" \
    "ds_read_b128 v[108:111], %[ab] offset:14336\n\t" \
    "ds_read_b128 v[112:115], %[ab] offset:38912\n\t" \
    "ds_read_b32 v116, %[av] offset:1536\n\t" \
    "v_pk_mul_f32 v[140:141], %[s01], v[118:119]\n\t" \
    "v_pk_fma_f32 v[140:141], %[s23], v[120:121], v[140:141]\n\t" \
    "v_add_f32 v146, v140, v141\n\t" \
    "v_pk_mul_f32 v[142:143], %[s01], v[122:123]\n\t" \
    "v_pk_mul_f32 v[144:145], %[s23], v[124:125]\n\t" \
    "v_add_f32_dpp v146, v146, v146 quad_perm:[1,0,3,2] row_mask:0xf bank_mask:0xf bound_ctrl:1\n\t" \
    "v_add_f32_dpp %[yp], %[yp], %[yp] quad_perm:[1,0,3,2] row_mask:0xf bank_mask:0xf bound_ctrl:1\n\t" \
    "v_pk_fma_f32 v[142:143], v[138:139], v[130:131], v[142:143] op_sel_hi:[0,1,1]\n\t" \
    "v_add_f32_dpp v146, v146, v146 quad_perm:[2,3,0,1] row_mask:0xf bank_mask:0xf bound_ctrl:1\n\t" \
    "v_add_f32_dpp %[yp], %[yp], %[yp] quad_perm:[2,3,0,1] row_mask:0xf bank_mask:0xf bound_ctrl:1\n\t" \
    "v_pk_fma_f32 v[144:145], v[138:139], v[132:133], v[144:145] op_sel_hi:[0,1,1]\n\t" \
    "v_add_f32_dpp v146, v146, v146 row_half_mirror row_mask:0xf bank_mask:0xf bound_ctrl:1\n\t" \
    "v_add_f32_dpp %[yp], %[yp], %[yp] row_half_mirror row_mask:0xf bank_mask:0xf bound_ctrl:1\n\t" \
    "v_cmp_eq_u32_e32 vcc, 6, %[sp]\n\t" \
    "v_add_f32_dpp v146, v146, v146 row_mirror row_mask:0xf bank_mask:0xf bound_ctrl:1\n\t" \
    "v_add_f32_dpp %[yp], %[yp], %[yp] row_mirror row_mask:0xf bank_mask:0xf bound_ctrl:1\n\t" \
    "v_cndmask_b32_e32 %[yk1], %[yk1], %[yp], vcc\n\t" \
    "v_pk_fma_f32 %[s01], v[146:147], v[126:127], v[142:143] op_sel_hi:[0,1,1] neg_lo:[1,0,0] neg_hi:[1,0,0]\n\t" \
    "v_pk_fma_f32 %[s23], v[146:147], v[128:129], v[144:145] op_sel_hi:[0,1,1] neg_lo:[1,0,0] neg_hi:[1,0,0]\n\t" \
    "v_pk_mul_f32 v[140:141], %[s01], v[134:135]\n\t" \
    "v_pk_fma_f32 v[140:141], %[s23], v[136:137], v[140:141]\n\t" \
    "v_add_f32 %[yp], v140, v141\n\t" \
    "s_waitcnt lgkmcnt(0)\n\t" \
    "ds_read_b128 v[118:121], %[ab] offset:30976\n\t" \
    "ds_read_b128 v[122:125], %[ab] offset:6400\n\t" \
    "ds_read_b128 v[126:129], %[ab] offset:22784\n\t" \
    "ds_read_b128 v[130:133], %[ab] offset:14592\n\t" \
    "ds_read_b128 v[134:137], %[ab] offset:39168\n\t" \
    "ds_read_b32 v138, %[av] offset:1600\n\t" \
    "v_pk_mul_f32 v[140:141], %[s01], v[96:97]\n\t" \
    "v_pk_fma_f32 v[140:141], %[s23], v[98:99], v[140:141]\n\t" \
    "v_add_f32 v146, v140, v141\n\t" \
    "v_pk_mul_f32 v[142:143], %[s01], v[100:101]\n\t" \
    "v_pk_mul_f32 v[144:145], %[s23], v[102:103]\n\t" \
    "v_add_f32_dpp v146, v146, v146 quad_perm:[1,0,3,2] row_mask:0xf bank_mask:0xf bound_ctrl:1\n\t" \
    "v_add_f32_dpp %[yp], %[yp], %[yp] quad_perm:[1,0,3,2] row_mask:0xf bank_mask:0xf bound_ctrl:1\n\t" \
    "v_pk_fma_f32 v[142:143], v[116:117], v[108:109], v[142:143] op_sel_hi:[0,1,1]\n\t" \
    "v_add_f32_dpp v146, v146, v146 quad_perm:[2,3,0,1] row_mask:0xf bank_mask:0xf bound_ctrl:1\n\t" \
    "v_add_f32_dpp %[yp], %[yp], %[yp] quad_perm:[2,3,0,1] row_mask:0xf bank_mask:0xf bound_ctrl:1\n\t" \
    "v_pk_fma_f32 v[144:145], v[116:117], v[110:111], v[144:145] op_sel_hi:[0,1,1]\n\t" \
    "v_add_f32_dpp v146, v146, v146 row_half_mirror row_mask:0xf bank_mask:0xf bound_ctrl:1\n\t" \
    "v_add_f32_dpp %[yp], %[yp], %[yp] row_half_mirror row_mask:0xf bank_mask:0xf bound_ctrl:1\n\t" \
    "v_cmp_eq_u32_e32 vcc, 7, %[sp]\n\t" \
    "v_add_f32_dpp v146, v146, v146 row_mirror row_mask:0xf bank_mask:0xf bound_ctrl:1\n\t" \
    "v_add_f32_dpp %[yp], %[yp], %[yp] row_mirror row_mask:0xf bank_mask:0xf bound_ctrl:1\n\t" \
    "v_cndmask_b32_e32 %[yk1], %[yk1], %[yp], vcc\n\t" \
    "v_pk_fma_f32 %[s01], v[146:147], v[104:105], v[142:143] op_sel_hi:[0,1,1] neg_lo:[1,0,0] neg_hi:[1,0,0]\n\t" \
    "v_pk_fma_f32 %[s23], v[146:147], v[106:107], v[144:145] op_sel_hi:[0,1,1] neg_lo:[1,0,0] neg_hi:[1,0,0]\n\t" \
    "v_pk_mul_f32 v[140:141], %[s01], v[112:113]\n\t" \
    "v_pk_fma_f32 v[140:141], %[s23], v[114:115], v[140:141]\n\t" \
    "v_add_f32 %[yp], v140, v141\n\t" \
    "s_waitcnt lgkmcnt(0)\n\t" \
    "ds_read_b128 v[96:99], %[ab] offset:31232\n\t" \
    "ds_read_b128 v[100:103], %[ab] offset:6656\n\t" \
    "ds_read_b128 v[104:107], %[ab] offset:23040\n\t" \
    "ds_read_b128 v[108:111], %[ab] offset:14848\n\t" \
    "ds_read_b128 v[112:115], %[ab] offset:39424\n\t" \
    "ds_read_b32 v116, %[av] offset:1664\n\t" \
    "v_pk_mul_f32 v[140:141], %[s01], v[118:119]\n\t" \
    "v_pk_fma_f32 v[140:141], %[s23], v[120:121], v[140:141]\n\t" \
    "v_add_f32 v146, v140, v141\n\t" \
    "v_pk_mul_f32 v[142:143], %[s01], v[122:123]\n\t" \
    "v_pk_mul_f32 v[144:145], %[s23], v[124:125]\n\t" \
    "v_add_f32_dpp v146, v146, v146 quad_perm:[1,0,3,2] row_mask:0xf bank_mask:0xf bound_ctrl:1\n\t" \
    "v_add_f32_dpp %[yp], %[yp], %[yp] quad_perm:[1,0,3,2] row_mask:0xf bank_mask:0xf bound_ctrl:1\n\t" \
    "v_pk_fma_f32 v[142:143], v[138:139], v[130:131], v[142:143] op_sel_hi:[0,1,1]\n\t" \
    "v_add_f32_dpp v146, v146, v146 quad_perm:[2,3,0,1] row_mask:0xf bank_mask:0xf bound_ctrl:1\n\t" \
    "v_add_f32_dpp %[yp], %[yp], %[yp] quad_perm:[2,3,0,1] row_mask:0xf bank_mask:0xf bound_ctrl:1\n\t" \
    "v_pk_fma_f32 v[144:145], v[138:139], v[132:133], v[144:145] op_sel_hi:[0,1,1]\n\t" \
    "v_add_f32_dpp v146, v146, v146 row_half_mirror row_mask:0xf bank_mask:0xf bound_ctrl:1\n\t" \
    "v_add_f32_dpp %[yp], %[yp], %[yp] row_half_mirror row_mask:0xf bank_mask:0xf bound_ctrl:1\n\t" \
    "v_cmp_eq_u32_e32 vcc, 8, %[sp]\n\t" \
    "v_add_f32_dpp v146, v146, v146 row_mirror row_mask:0xf bank_mask:0xf bound_ctrl:1\n\t" \
    "v_add_f32_dpp %[yp], %[yp], %[yp] row_mirror row_mask:0xf bank_mask:0xf bound_ctrl:1\n\t" \
    "v_cndmask_b32_e32 %[yk1], %[yk1], %[yp], vcc\n\t" \
    "v_pk_fma_f32 %[s01], v[146:147], v[126:127], v[142:143] op_sel_hi:[0,1,1] neg_lo:[1,0,0] neg_hi:[1,0,0]\n\t" \
    "v_pk_fma_f32 %[s23], v[146:147], v[128:129], v[144:145] op_sel_hi:[0,1,1] neg_lo:[1,0,0] neg_hi:[1,0,0]\n\t" \
    "v_pk_mul_f32 v[140:141], %[s01], v[134:135]\n\t" \
    "v_pk_fma_f32 v[140:141], %[s23], v[136:137], v[140:141]\n\t" \
    "v_add_f32 %[yp], v140, v141\n\t" \
    "s_waitcnt lgkmcnt(0)\n\t" \
    "ds_read_b128 v[118:121], %[ab] offset:31488\n\t" \
    "ds_read_b128 v[122:125], %[ab] offset:6912\n\t" \
    "ds_read_b128 v[126:129], %[ab] offset:23296\n\t" \
    "ds_read_b128 v[130:133], %[ab] offset:15104\n\t" \
    "ds_read_b128 v[134:137], %[ab] offset:39680\n\t" \
    "ds_read_b32 v138, %[av] offset:1728\n\t" \
    "v_pk_mul_f32 v[140:141], %[s01], v[96:97]\n\t" \
    "v_pk_fma_f32 v[140:141], %[s23], v[98:99], v[140:141]\n\t" \
    "v_add_f32 v146, v140, v141\n\t" \
    "v_pk_mul_f32 v[142:143], %[s01], v[100:101]\n\t" \
    "v_pk_mul_f32 v[144:145], %[s23], v[102:103]\n\t" \
    "v_add_f32_dpp v146, v146, v146 quad_perm:[1,0,3,2] row_mask:0xf bank_mask:0xf bound_ctrl:1\n\t" \
    "v_add_f32_dpp %[yp], %[yp], %[yp] quad_perm:[1,0,3,2] row_mask:0xf bank_mask:0xf bound_ctrl:1\n\t" \
    "v_pk_fma_f32 v[142:143], v[116:117], v[108:109], v[142:143] op_sel_hi:[0,1,1]\n\t" \
    "v_add_f32_dpp v146, v146, v146 quad_perm:[2,3,0,1] row_mask:0xf bank_mask:0xf bound_ctrl:1\n\t" \
    "v_add_f32_dpp %[yp], %[yp], %[yp] quad_perm:[2,3,0,1] row_mask:0xf bank_mask:0xf bound_ctrl:1\n\t" \
    "v_pk_fma_f32 v[144:145], v[116:117], v[110:111], v[144:145] op_sel_hi:[0,1,1]\n\t" \
    "v_add_f32_dpp v146, v146, v146 row_half_mirror row_mask:0xf bank_mask:0xf bound_ctrl:1\n\t" \
    "v_add_f32_dpp %[yp], %[yp], %[yp] row_half_mirror row_mask:0xf bank_mask:0xf bound_ctrl:1\n\t" \
    "v_cmp_eq_u32_e32 vcc, 9, %[sp]\n\t" \
    "v_add_f32_dpp v146, v146, v146 row_mirror row_mask:0xf bank_mask:0xf bound_ctrl:1\n\t" \
    "v_add_f32_dpp %[yp], %[yp], %[yp] row_mirror row_mask:0xf bank_mask:0xf bound_ctrl:1\n\t" \
    "v_cndmask_b32_e32 %[yk1], %[yk1], %[yp], vcc\n\t" \
    "v_pk_fma_f32 %[s01], v[146:147], v[104:105], v[142:143] op_sel_hi:[0,1,1] neg_lo:[1,0,0] neg_hi:[1,0,0]\n\t" \
    "v_pk_fma_f32 %[s23], v[146:147], v[106:107], v[144:145] op_sel_hi:[0,1,1] neg_lo:[1,0,0] neg_hi:[1,0,0]\n\t" \
    "v_pk_mul_f32 v[140:141], %[s01], v[112:113]\n\t" \
    "v_pk_fma_f32 v[140:141], %[s23], v[114:115], v[140:141]\n\t" \
    "v_add_f32 %[yp], v140, v141\n\t" \
    "s_waitcnt lgkmcnt(0)\n\t" \
    "ds_read_b128 v[96:99], %[ab] offset:31744\n\t" \
    "ds_read_b128 v[100:103], %[ab] offset:7168\n\t" \
    "ds_read_b128 v[104:107], %[ab] offset:23552\n\t" \
    "ds_read_b128 v[108:111], %[ab] offset:15360\n\t" \
    "ds_read_b128 v[112:115], %[ab] offset:39936\n\t" \
    "ds_read_b32 v116, %[av] offset:1792\n\t" \
    "v_pk_mul_f32 v[140:141], %[s01], v[118:119]\n\t" \
    "v_pk_fma_f32 v[140:141], %[s23], v[120:121], v[140:141]\n\t" \
    "v_add_f32 v146, v140, v141\n\t" \
    "v_pk_mul_f32 v[142:143], %[s01], v[122:123]\n\t" \
    "v_pk_mul_f32 v[144:145], %[s23], v[124:125]\n\t" \
    "v_add_f32_dpp v146, v146, v146 quad_perm:[1,0,3,2] row_mask:0xf bank_mask:0xf bound_ctrl:1\n\t" \
    "v_add_f32_dpp %[yp], %[yp], %[yp] quad_perm:[1,0,3,2] row_mask:0xf bank_mask:0xf bound_ctrl:1\n\t" \
    "v_pk_fma_f32 v[142:143], v[138:139], v[130:131], v[142:143] op_sel_hi:[0,1,1]\n\t" \
    "v_add_f32_dpp v146, v146, v146 quad_perm:[2,3,0,1] row_mask:0xf bank_mask:0xf bound_ctrl:1\n\t" \
    "v_add_f32_dpp %[yp], %[yp], %[yp] quad_perm:[2,3,0,1] row_mask:0xf bank_mask:0xf bound_ctrl:1\n\t" \
    "v_pk_fma_f32 v[144:145], v[138:139], v[132:133], v[144:145] op_sel_hi:[0,1,1]\n\t" \
    "v_add_f32_dpp v146, v146, v146 row_half_mirror row_mask:0xf bank_mask:0xf bound_ctrl:1\n\t" \
    "v_add_f32_dpp %[yp], %[yp], %[yp] row_half_mirror row_mask:0xf bank_mask:0xf bound_ctrl:1\n\t" \
    "v_cmp_eq_u32_e32 vcc, 10, %[sp]\n\t" \
    "v_add_f32_dpp v146, v146, v146 row_mirror row_mask:0xf bank_mask:0xf bound_ctrl:1\n\t" \
    "v_add_f32_dpp %[yp], %[yp], %[yp] row_mirror row_mask:0xf bank_mask:0xf bound_ctrl:1\n\t" \
    "v_cndmask_b32_e32 %[yk1], %[yk1], %[yp], vcc\n\t" \
    "v_pk_fma_f32 %[s01], v[146:147], v[126:127], v[142:143] op_sel_hi:[0,1,1] neg_lo:[1,0,0] neg_hi:[1,0,0]\n\t" \
    "v_pk_fma_f32 %[s23], v[146:147], v[128:129], v[144:145] op_sel_hi:[0,1,1] neg_lo:[1,0,0] neg_hi:[1,0,0]\n\t" \
    "v_pk_mul_f32 v[140:141], %[s01], v[134:135]\n\t" \
    "v_pk_fma_f32 v[140:141], %[s23], v[136:137], v[140:141]\n\t" \
    "v_add_f32 %[yp], v140, v141\n\t" \
    "s_waitcnt lgkmcnt(0)\n\t" \
    "ds_read_b128 v[118:121], %[ab] offset:32000\n\t" \
    "ds_read_b128 v[122:125], %[ab] offset:7424\n\t" \
    "ds_read_b128 v[126:129], %[ab] offset:23808\n\t" \
    "ds_read_b128 v[130:133], %[ab] offset:15616\n\t" \
    "ds_read_b128 v[134:137], %[ab] offset:40192\n\t" \
    "ds_read_b32 v138, %[av] offset:1856\n\t" \
    "v_pk_mul_f32 v[140:141], %[s01], v[96:97]\n\t" \
    "v_pk_fma_f32 v[140:141], %[s23], v[98:99], v[140:141]\n\t" \
    "v_add_f32 v146, v140, v141\n\t" \
    "v_pk_mul_f32 v[142:143], %[s01], v[100:101]\n\t" \
    "v_pk_mul_f32 v[144:145], %[s23], v[102:103]\n\t" \
    "v_add_f32_dpp v146, v146, v146 quad_perm:[1,0,3,2] row_mask:0xf bank_mask:0xf bound_ctrl:1\n\t" \
    "v_add_f32_dpp %[yp], %[yp], %[yp] quad_perm:[1,0,3,2] row_mask:0xf bank_mask:0xf bound_ctrl:1\n\t" \
    "v_pk_fma_f32 v[142:143], v[116:117], v[108:109], v[142:143] op_sel_hi:[0,1,1]\n\t" \
    "v_add_f32_dpp v146, v146, v146 quad_perm:[2,3,0,1] row_mask:0xf bank_mask:0xf bound_ctrl:1\n\t" \
    "v_add_f32_dpp %[yp], %[yp], %[yp] quad_perm:[2,3,0,1] row_mask:0xf bank_mask:0xf bound_ctrl:1\n\t" \
    "v_pk_fma_f32 v[144:145], v[116:117], v[110:111], v[144:145] op_sel_hi:[0,1,1]\n\t" \
    "v_add_f32_dpp v146, v146, v146 row_half_mirror row_mask:0xf bank_mask:0xf bound_ctrl:1\n\t" \
    "v_add_f32_dpp %[yp], %[yp], %[yp] row_half_mirror row_mask:0xf bank_mask:0xf bound_ctrl:1\n\t" \
    "v_cmp_eq_u32_e32 vcc, 11, %[sp]\n\t" \
    "v_add_f32_dpp v146, v146, v146 row_mirror row_mask:0xf bank_mask:0xf bound_ctrl:1\n\t" \
    "v_add_f32_dpp %[yp], %[yp], %[yp] row_mirror row_mask:0xf bank_mask:0xf bound_ctrl:1\n\t" \
    "v_cndmask_b32_e32 %[yk1], %[yk1], %[yp], vcc\n\t" \
    "v_pk_fma_f32 %[s01], v[146:147], v[104:105], v[142:143] op_sel_hi:[0,1,1] neg_lo:[1,0,0] neg_hi:[1,0,0]\n\t" \
    "v_pk_fma_f32 %[s23], v[146:147], v[106:107], v[144:145] op_sel_hi:[0,1,1] neg_lo:[1,0,0] neg_hi:[1,0,0]\n\t" \
    "v_pk_mul_f32 v[140:141], %[s01], v[112:113]\n\t" \
    "v_pk_fma_f32 v[140:141], %[s23], v[114:115], v[140:141]\n\t" \
    "v_add_f32 %[yp], v140, v141\n\t" \
    "s_waitcnt lgkmcnt(0)\n\t" \
    "ds_read_b128 v[96:99], %[ab] offset:32256\n\t" \
    "ds_read_b128 v[100:103], %[ab] offset:7680\n\t" \
    "ds_read_b128 v[104:107], %[ab] offset:24064\n\t" \
    "ds_read_b128 v[108:111], %[ab] offset:15872\n\t" \
    "ds_read_b128 v[112:115], %[ab] offset:40448\n\t" \
    "ds_read_b32 v116, %[av] offset:1920\n\t" \
    "v_pk_mul_f32 v[140:141], %[s01], v[118:119]\n\t" \
    "v_pk_fma_f32 v[140:141], %[s23], v[120:121], v[140:141]\n\t" \
    "v_add_f32 v146, v140, v141\n\t" \
    "v_pk_mul_f32 v[142:143], %[s01], v[122:123]\n\t" \
    "v_pk_mul_f32 v[144:145], %[s23], v[124:125]\n\t" \
    "v_add_f32_dpp v146, v146, v146 quad_perm:[1,0,3,2] row_mask:0xf bank_mask:0xf bound_ctrl:1\n\t" \
    "v_add_f32_dpp %[yp], %[yp], %[yp] quad_perm:[1,0,3,2] row_mask:0xf bank_mask:0xf bound_ctrl:1\n\t" \
    "v_pk_fma_f32 v[142:143], v[138:139], v[130:131], v[142:143] op_sel_hi:[0,1,1]\n\t" \
    "v_add_f32_dpp v146, v146, v146 quad_perm:[2,3,0,1] row_mask:0xf bank_mask:0xf bound_ctrl:1\n\t" \
    "v_add_f32_dpp %[yp], %[yp], %[yp] quad_perm:[2,3,0,1] row_mask:0xf bank_mask:0xf bound_ctrl:1\n\t" \
    "v_pk_fma_f32 v[144:145], v[138:139], v[132:133], v[144:145] op_sel_hi:[0,1,1]\n\t" \
    "v_add_f32_dpp v146, v146, v146 row_half_mirror row_mask:0xf bank_mask:0xf bound_ctrl:1\n\t" \
    "v_add_f32_dpp %[yp], %[yp], %[yp] row_half_mirror row_mask:0xf bank_mask:0xf bound_ctrl:1\n\t" \
    "v_cmp_eq_u32_e32 vcc, 12, %[sp]\n\t" \
    "v_add_f32_dpp v146, v146, v146 row_mirror row_mask:0xf bank_mask:0xf bound_ctrl:1\n\t" \
    "v_add_f32_dpp %[yp], %[yp], %[yp] row_mirror row_mask:0xf bank_mask:0xf bound_ctrl:1\n\t" \
    "v_cndmask_b32_e32 %[yk1], %[yk1], %[yp], vcc\n\t" \
    "v_pk_fma_f32 %[s01], v[146:147], v[126:127], v[142:143] op_sel_hi:[0,1,1] neg_lo:[1,0,0] neg_hi:[1,0,0]\n\t" \
    "v_pk_fma_f32 %[s23], v[146:147], v[128:129], v[144:145] op_sel_hi:[0,1,1] neg_lo:[1,0,0] neg_hi:[1,0,0]\n\t" \
    "v_pk_mul_f32 v[140:141], %[s01], v[134:135]\n\t" \
    "v_pk_fma_f32 v[140:141], %[s23], v[136:137], v[140:141]\n\t" \
    "v_add_f32 %[yp], v140, v141\n\t" \
    "s_waitcnt lgkmcnt(0)\n\t" \
    "ds_read_b128 v[118:121], %[ab] offset:32512\n\t" \
    "ds_read_b128 v[122:125], %[ab] offset:7936\n\t" \
    "ds_read_b128 v[126:129], %[ab] offset:24320\n\t" \
    "ds_read_b128 v[130:133], %[ab] offset:16128\n\t" \
    "ds_read_b128 v[134:137], %[ab] offset:40704\n\t" \
    "ds_read_b32 v138, %[av] offset:1984\n\t" \
    "v_pk_mul_f32 v[140:141], %[s01], v[96:97]\n\t" \
    "v_pk_fma_f32 v[140:141], %[s23], v[98:99], v[140:141]\n\t" \
    "v_add_f32 v146, v140, v141\n\t" \
    "v_pk_mul_f32 v[142:143], %[s01], v[100:101]\n\t" \
    "v_pk_mul_f32 v[144:145], %[s23], v[102:103]\n\t" \
    "v_add_f32_dpp v146, v146, v146 quad_perm:[1,0,3,2] row_mask:0xf bank_mask:0xf bound_ctrl:1\n\t" \
    "v_add_f32_dpp %[yp], %[yp], %[yp] quad_perm:[1,0,3,2] row_mask:0xf bank_mask:0xf bound_ctrl:1\n\t" \
    "v_pk_fma_f32 v[142:143], v[116:117], v[108:109], v[142:143] op_sel_hi:[0,1,1]\n\t" \
    "v_add_f32_dpp v146, v146, v146 quad_perm:[2,3,0,1] row_mask:0xf bank_mask:0xf bound_ctrl:1\n\t" \
    "v_add_f32_dpp %[yp], %[yp], %[yp] quad_perm:[2,3,0,1] row_mask:0xf bank_mask:0xf bound_ctrl:1\n\t" \
    "v_pk_fma_f32 v[144:145], v[116:117], v[110:111], v[144:145] op_sel_hi:[0,1,1]\n\t" \
    "v_add_f32_dpp v146, v146, v146 row_half_mirror row_mask:0xf bank_mask:0xf bound_ctrl:1\n\t" \
    "v_add_f32_dpp %[yp], %[yp], %[yp] row_half_mirror row_mask:0xf bank_mask:0xf bound_ctrl:1\n\t" \
    "v_cmp_eq_u32_e32 vcc, 13, %[sp]\n\t" \
    "v_add_f32_dpp v146, v146, v146 row_mirror row_mask:0xf bank_mask:0xf bound_ctrl:1\n\t" \
    "v_add_f32_dpp %[yp], %[yp], %[yp] row_mirror row_mask:0xf bank_mask:0xf bound_ctrl:1\n\t" \
    "v_cndmask_b32_e32 %[yk1], %[yk1], %[yp], vcc\n\t" \
    "v_pk_fma_f32 %[s01], v[146:147], v[104:105], v[142:143] op_sel_hi:[0,1,1] neg_lo:[1,0,0] neg_hi:[1,0,0]\n\t" \
    "v_pk_fma_f32 %[s23], v[146:147], v[106:107], v[144:145] op_sel_hi:[0,1,1] neg_lo:[1,0,0] neg_hi:[1,0,0]\n\t" \
    "v_pk_mul_f32 v[140:141], %[s01], v[112:113]\n\t" \
    "v_pk_fma_f32 v[140:141], %[s23], v[114:115], v[140:141]\n\t" \
    "v_add_f32 %[yp], v140, v141\n\t" \
    "s_waitcnt lgkmcnt(0)\n\t" \
    "ds_read_b128 v[96:99], %[ab] offset:32768\n\t" \
    "ds_read_b128 v[100:103], %[ab] offset:8192\n\t" \
    "ds_read_b128 v[104:107], %[ab] offset:24576\n\t" \
    "ds_read_b128 v[108:111], %[ab] offset:16384\n\t" \
    "ds_read_b128 v[112:115], %[ab] offset:40960\n\t" \
    "ds_read_b32 v116, %[av] offset:2048\n\t" \
    "v_pk_mul_f32 v[140:141], %[s01], v[118:119]\n\t" \
    "v_pk_fma_f32 v[140:141], %[s23], v[120:121], v[140:141]\n\t" \
    "v_add_f32 v146, v140, v141\n\t" \
    "v_pk_mul_f32 v[142:143], %[s01], v[122:123]\n\t" \
    "v_pk_mul_f32 v[144:145], %[s23], v[124:125]\n\t" \
    "v_add_f32_dpp v146, v146, v146 quad_perm:[1,0,3,2] row_mask:0xf bank_mask:0xf bound_ctrl:1\n\t" \
    "v_add_f32_dpp %[yp], %[yp], %[yp] quad_perm:[1,0,3,2] row_mask:0xf bank_mask:0xf bound_ctrl:1\n\t" \
    "v_pk_fma_f32 v[142:143], v[138:139], v[130:131], v[142:143] op_sel_hi:[0,1,1]\n\t" \
    "v_add_f32_dpp v146, v146, v146 quad_perm:[2,3,0,1] row_mask:0xf bank_mask:0xf bound_ctrl:1\n\t" \
    "v_add_f32_dpp %[yp], %[yp], %[yp] quad_perm:[2,3,0,1] row_mask:0xf bank_mask:0xf bound_ctrl:1\n\t" \
    "v_pk_fma_f32 v[144:145], v[138:139], v[132:133], v[144:145] op_sel_hi:[0,1,1]\n\t" \
    "v_add_f32_dpp v146, v146, v146 row_half_mirror row_mask:0xf bank_mask:0xf bound_ctrl:1\n\t" \
    "v_add_f32_dpp %[yp], %[yp], %[yp] row_half_mirror row_mask:0xf bank_mask:0xf bound_ctrl:1\n\t" \
    "v_cmp_eq_u32_e32 vcc, 14, %[sp]\n\t" \
    "v_add_f32_dpp v146, v146, v146 row_mirror row_mask:0xf bank_mask:0xf bound_ctrl:1\n\t" \
    "v_add_f32_dpp %[yp], %[yp], %[yp] row_mirror row_mask:0xf bank_mask:0xf bound_ctrl:1\n\t" \
    "v_cndmask_b32_e32 %[yk1], %[yk1], %[yp], vcc\n\t" \
    "v_pk_fma_f32 %[s01], v[146:147], v[126:127], v[142:143] op_sel_hi:[0,1,1] neg_lo:[1,0,0] neg_hi:[1,0,0]\n\t" \
    "v_pk_fma_f32 %[s23], v[146:147], v[128:129], v[144:145] op_sel_hi:[0,1,1] neg_lo:[1,0,0] neg_hi:[1,0,0]\n\t" \
    "v_pk_mul_f32 v[140:141], %[s01], v[134:135]\n\t" \
    "v_pk_fma_f32 v[140:141], %[s23], v[136:137], v[140:141]\n\t" \
    "v_add_f32 %[yp], v140, v141\n\t" \
    "s_waitcnt lgkmcnt(0)\n\t"
#define SCAN_CHUNK_CLOBBERS "v96", "v97", "v98", "v99", "v100", "v101", "v102", "v103", "v104", "v105", "v106", "v107", "v108", "v109", "v110", "v111", "v112", "v113", "v114", "v115", "v116", "v117", "v118", "v119", "v120", "v121", "v122", "v123", "v124", "v125", "v126", "v127", "v128", "v129", "v130", "v131", "v132", "v133", "v134", "v135", "v136", "v137", "v138", "v139", "v140", "v141", "v142", "v143", "v144", "v145", "v146", "v147", "vcc", "memory"
#ifndef EMU
#define UNR _Pragma("unroll")
#define UNR1 _Pragma("unroll 1")
#define CFENCE() asm volatile("" ::: "memory")
#define OPAQUE(x) asm volatile("" : "+v"(x))
#define SYNC() __syncthreads()
#define WAVE_SYNC() do { asm volatile("s_waitcnt lgkmcnt(0)" ::: "memory"); __builtin_amdgcn_wave_barrier(); } while (0)
DEVFN float shfl_xor_f(float v, int m) { return __shfl_xor(v, m); }
DEVFN float shfl_f(float v, int src) { return __shfl(v, src); }
DEVFN void sincospi_f(float x, float* s, float* c) { sincospif(x, s, c); }
template <int M> DEVFN float rowx_add(float v) { constexpr int ctrl = M == 1 ? 0xB1 : M == 2 ? 0x4E : M == 7 ? 0x141 : 0x140;
    return v + __builtin_bit_cast(float, __builtin_amdgcn_update_dpp(0, __builtin_bit_cast(int, v), ctrl, 0xf, 0xf, true)); }
#endif

enum InIdx { I_X = 0, I_C, I_CTX, I_CCTX, I_ANORM, I_AADAW, I_AADAB, I_AWIN, I_RPB, I_QG, I_KG, I_AWOUT, I_RNORM, I_RADAW, I_RADAB, I_RWIN, I_MU, I_W0, I_WUP, I_A0, I_AUP,
             I_KK, I_KA, I_RK, I_GNW, I_GNB, I_HSHORT, I_HW1, I_HB1, I_HW2, I_HB2, I_HW3, I_HB3, I_HSKIP, I_RWOUT, I_FNORM, N_IN };

#if defined(TSEL) && !defined(EMU)
#define XSTAMP(C, k, cond) do { if ((cond) && (C).tid == 0) __hip_atomic_store((unsigned long long*)((C).ws + WS_CTL + 32768) + (k), (unsigned long long)__builtin_amdgcn_s_memrealtime(), __ATOMIC_RELAXED, __HIP_MEMORY_SCOPE_AGENT); } while (0)
#else
#define XSTAMP(C, k, cond) do {} while (0)
#endif
#if defined(TSEL) && !defined(EMU)
#define TACC_DECL unsigned long long tacc_ = 0, tb_ = 0
#define TACC_BEGIN tb_ = __builtin_amdgcn_s_memrealtime()
#define TACC_END tacc_ += __builtin_amdgcn_s_memrealtime() - tb_
#define TACC_STORE(C, k, cond) do { if (cond) __hip_atomic_store((unsigned long long*)((C).ws + WS_CTL + 32768) + (k), tacc_, __ATOMIC_RELAXED, __HIP_MEMORY_SCOPE_AGENT); } while (0)
#else
#define TACC_DECL
#define TACC_BEGIN
#define TACC_END
#define TACC_STORE(C, k, cond)
#endif
struct Ctx {
    const float* in[N_IN]; float* out; unsigned char* ws;
    int tid, lane, wave, vcu, G;
};

#ifdef EMU
DEVFN float wave_sum(float v) { for (int o = 1; o < 64; o <<= 1) v += shfl_xor_f(v, o); return v; }
DEVFN float swap16_f(float v) { return shfl_xor_f(v, 16); }
#else
DEVFN float wave_sum(float v) { v = rowx_add<1>(v); v = rowx_add<2>(v); v = rowx_add<7>(v); v = rowx_add<15>(v);
    const int i_ = __builtin_bit_cast(int, v);
    return (__builtin_bit_cast(float, __builtin_amdgcn_readlane(i_, 0)) + __builtin_bit_cast(float, __builtin_amdgcn_readlane(i_, 16))) + (__builtin_bit_cast(float, __builtin_amdgcn_readlane(i_, 32)) + __builtin_bit_cast(float, __builtin_amdgcn_readlane(i_, 48))); }
DEVFN float swap16_f(float v) { return __builtin_bit_cast(float, __builtin_amdgcn_ds_swizzle(__builtin_bit_cast(int, v), 0x401F)); }
#endif

DEVFN U4 ld16(const void* p) { return *(const U4*)p; }
DEVFN void st16(void* p, U4 v) { *(U4*)p = v; }
DEVFN void unpack8(U4 w, float* f) { f[0] = bflo(w.x); f[1] = bfhi(w.x); f[2] = bflo(w.y); f[3] = bfhi(w.y); f[4] = bflo(w.z); f[5] = bfhi(w.z); f[6] = bflo(w.w); f[7] = bfhi(w.w); }
DEVFN U4 pack8(const float* f) { U4 w; w.x = pk2(f[0], f[1]); w.y = pk2(f[2], f[3]); w.z = pk2(f[4], f[5]); w.w = pk2(f[6], f[7]); return w; }

DEVFN void p0_transpose_item(const float* W, int K, int N, bf16_t* WT, float* scr, int item, int lane) {
    const int nblk = N / 32, kb = item / nblk, nb = item % nblk, k0 = 64 * kb, n0 = 32 * nb;
    UNR for (int i = 0; i < 32; ++i) { const int kk = 2 * i + (lane >> 5); scr[kk * 33 + (lane & 31)] = W[(size_t)(k0 + kk) * N + n0 + (lane & 31)]; }
    WAVE_SYNC();
    const int c = lane & 7;
    UNR for (int j = 0; j < 4; ++j) { const int n = (lane >> 3) + 8 * j; const float* s = scr + (8 * c) * 33 + n;
        U4 o; o.x = pk2(s[0 * 33], s[1 * 33]); o.y = pk2(s[2 * 33], s[3 * 33]); o.z = pk2(s[4 * 33], s[5 * 33]); o.w = pk2(s[6 * 33], s[7 * 33]);
        st16(WT + (size_t)(n0 + n) * K + k0 + 8 * c, o); }
    WAVE_SYNC();
}

DEVFN void hid_rows(const float* w1, const float* b1, const float* w2, const float* b2, float* hid, int L, int gw, int NGW, int lane) {
    float w1c[33], w2c[64];
    UNR for (int i = 0; i < 33; ++i) w1c[i] = w1[i * 64 + lane];
    UNR for (int i = 0; i < 64; ++i) w2c[i] = w2[i * 64 + lane];
    const float bb1 = b1[lane], bb2 = b2[lane];
    for (int t = gw; t < L; t += NGW) {
        float feat = 0.f;
        if (lane == 0) feat = (float)t / (float)(L - 1 > 1 ? L - 1 : 1);
        else if (lane < 33) { const int b = (lane - 1) & 15; const float band = 1e-4f + (float)b * ((15.0f - 1e-4f) / 15.0f);
            const float x = 2.0f * band * (float)t / (float)L; float s, c; sincospi_f(x, &s, &c); feat = (lane <= 16) ? c : -s; }
        float a = bb1;
        UNR for (int i = 0; i < 33; ++i) a += shfl_f(feat, i) * w1c[i];
        const float h1 = sinf(a);
        float b = bb2;
        UNR for (int i = 0; i < 64; ++i) b += shfl_f(h1, i) * w2c[i];
        hid[(size_t)t * 64 + lane] = sinf(b);
    }
}

DEVFN void r2_build_bfrag(const Ctx& C);
DEVFN void ph_prologue(const Ctx& C, unsigned char* lds) {
    const int gw = C.vcu * NWAVES + C.wave, NGW = C.G * NWAVES, lane = C.lane;
    float* scr = (float*)(lds + C.wave * 16384);
    {
        constexpr int I_AIN = 16 * (AIN / 32), I_OUT = 16 * 32, I_RIN = 16 * (RIN / 32);
        constexpr int NIT = 2 * (I_AIN + I_OUT + I_RIN + I_OUT);
        for (int it = gw; it < NIT; it += NGW) {
            int r = it; const int li = r & 1; r >>= 1;
            if (r < I_AIN) { p0_transpose_item(C.in[I_AWIN] + (size_t)li * DM * AIN, DM, AIN, (bf16_t*)(C.ws + WS_WAIN) + (size_t)li * AIN * DM, scr, r, lane); continue; } r -= I_AIN;
            if (r < I_OUT) { p0_transpose_item(C.in[I_AWOUT] + (size_t)li * DM * DM, DM, DM, (bf16_t*)(C.ws + WS_WAOUT) + (size_t)li * DM * DM, scr, r, lane); continue; } r -= I_OUT;
            if (r < I_RIN) { p0_transpose_item(C.in[I_RWIN] + (size_t)li * DM * RIN, DM, RIN, (bf16_t*)(C.ws + WS_WRIN) + (size_t)li * RINP * DM, scr, r, lane); continue; } r -= I_RIN;
            p0_transpose_item(C.in[I_RWOUT] + (size_t)li * DM * DM, DM, DM, (bf16_t*)(C.ws + WS_WROUT) + (size_t)li * DM * DM, scr, r, lane);
        }
        for (int e = gw * 64 + lane; e < 2 * (RINP - RIN) * DM / 8; e += NGW * 64) { const int li = e / ((RINP - RIN) * DM / 8), o = e % ((RINP - RIN) * DM / 8);
            U4 z; z.x = z.y = z.z = z.w = 0u; st16((bf16_t*)(C.ws + WS_WRIN) + (size_t)li * RINP * DM + (size_t)RIN * DM + (size_t)o * 8, z); }
    }
    {
        float* ADA = (float*)(C.ws + WS_ADA);
        for (int it = gw; it < 4 * 48; it += NGW) {
            const int layer = it / 48, cb = it % 48, col = cb * 64 + lane, i = layer >> 1;
            const float* W = (layer & 1) ? C.in[I_RADAW] + (size_t)i * DM * 3072 : C.in[I_AADAW] + (size_t)i * DM * 3072;
            const float* B = (layer & 1) ? C.in[I_RADAB] + (size_t)i * 3072 : C.in[I_AADAB] + (size_t)i * 3072;
            float a0 = 0.f, a1 = 0.f;
            for (int k0 = 0; k0 < DM; k0 += 64) {
                const float sc = silu_f(C.in[I_C][k0 + lane]), sx = silu_f(C.in[I_CCTX][k0 + lane]);
                for (int k = 0; k < 64; ++k) { const float w = W[(size_t)(k0 + k) * 3072 + col]; a0 += shfl_f(sc, k) * w; a1 += shfl_f(sx, k) * w; }
            }
            ADA[(size_t)(layer * 2 + 0) * 3072 + col] = a0 + B[col];
            ADA[(size_t)(layer * 2 + 1) * 3072 + col] = a1 + B[col];
        }
    }
    for (int i = 0; i < 2; ++i)
        hid_rows(C.in[I_HW1] + (size_t)i * 33 * 64, C.in[I_HB1] + i * 64, C.in[I_HW2] + (size_t)i * 64 * 64, C.in[I_HB2] + i * 64, (float*)(C.ws + WS_HID) + (size_t)i * NLAT * 64, NLAT, gw, NGW, lane);
    hid_rows(C.in[I_HW1], C.in[I_HB1], C.in[I_HW2], C.in[I_HB2], (float*)(C.ws + WS_HID256), NCTX, gw, NGW, lane);
    r2_build_bfrag(C);
    { F2* TW = (F2*)(C.ws + WS_TW);
      for (int k = gw * 64 + lane; k <= 16384; k += NGW * 64) { float s, c; sincospi_f((float)k * (1.0f / 16384.0f), &s, &c); F2 w; w.x = c; w.y = -s; TW[k] = w; } }
}

DEVFN void ph_norm(const Ctx& C, int layer, const float* xlat, const float* xctx, bool do_ctx) {
    const int gw = C.vcu * NWAVES + C.wave, NGW = C.G * NWAVES, lane = C.lane, i = layer >> 1;
    const float* gain = ((layer & 1) ? C.in[I_RNORM] : C.in[I_ANORM]) + (size_t)i * DM;
    const float* ADA = (const float*)(C.ws + WS_ADA) + (size_t)layer * 2 * 3072;
    bf16_t* XN = (bf16_t*)(C.ws + WS_XN);
    const int nrows = do_ctx ? NTOK : NLAT;
    for (int m = gw; m < nrows; m += NGW) {
        const bool isctx = m >= NLAT;
        const float* xr = isctx ? xctx + (size_t)(m - NLAT) * DM : xlat + (size_t)m * DM;
        const float* ada = ADA + (isctx ? 3072 : 0);
        F4 v[4]; float s = 0.f;
        UNR for (int j = 0; j < 4; ++j) { v[j] = *(const F4*)(xr + 256 * j + 4 * lane); s += (v[j].x * v[j].x + v[j].y * v[j].y) + (v[j].z * v[j].z + v[j].w * v[j].w); }
        const float rs = 1.0f / sqrtf(wave_sum(s) * (1.0f / DM) + NORM_EPS);
        UNR for (int j = 0; j < 4; ++j) { const int c0 = 256 * j + 4 * lane;
            const F4 g = *(const F4*)(gain + c0), sh = *(const F4*)(ada + c0), sc = *(const F4*)(ada + 1024 + c0);
            U2 o; o.x = pk2(v[j].x * rs * g.x * (1.f + sc.x) + sh.x, v[j].y * rs * g.y * (1.f + sc.y) + sh.y);
            o.y = pk2(v[j].z * rs * g.z * (1.f + sc.z) + sh.z, v[j].w * rs * g.w * (1.f + sc.w) + sh.w);
            *(U2*)(XN + (size_t)m * DM + c0) = o; }
    }
}

DEVFN void ph_final(const Ctx& C) {
    const int gw = C.vcu * NWAVES + C.wave, NGW = C.G * NWAVES, lane = C.lane;
    const float* gain = C.in[I_FNORM];
    for (int m = gw; m < NLAT; m += NGW) {
        float* xr = C.out + (size_t)m * DM;
        F4 v[4]; float s = 0.f;
        UNR for (int j = 0; j < 4; ++j) { v[j] = *(const F4*)(xr + 256 * j + 4 * lane); s += (v[j].x * v[j].x + v[j].y * v[j].y) + (v[j].z * v[j].z + v[j].w * v[j].w); }
        const float rs = 1.0f / sqrtf(wave_sum(s) * (1.0f / DM) + NORM_EPS);
        UNR for (int j = 0; j < 4; ++j) { const int c0 = 256 * j + 4 * lane; const F4 g = *(const F4*)(gain + c0);
            F4 o; o.x = v[j].x * rs * g.x; o.y = v[j].y * rs * g.y; o.z = v[j].z * rs * g.z; o.w = v[j].w * rs * g.w; *(F4*)(xr + c0) = o; }
    }
}

DEVFN void ph_qkprep(const Ctx& C, int i) {
    const int gw = C.vcu * NWAVES + C.wave, NGW = C.G * NWAVES, lane = C.lane;
    bf16_t* U = (bf16_t*)(C.ws + WS_U);
    const float qg = C.in[I_QG][i * 64 + lane], kg = C.in[I_KG][i * 64 + lane];
    const int axis = lane >> 5, half = (lane >> 4) & 1, f = lane & 15;
    const float invf = exp2f(-(float)f * (13.287712379549449f / 16.0f));
    for (int m = gw; m < NTOK; m += NGW) {
        float cs = 1.f, sn = 0.f;
        if (m < NLAT) { const float pos = (float)(axis == 0 ? (m >> 6) : (m & 63)); const float ang = pos * invf; cs = cosf(ang); sn = sinf(ang); }
        bf16_t* ur = U + (size_t)m * AIN + 2048;
        for (int h = 0; h < 10; ++h) {
            const float v = bf2f(ur[h * 64 + lane]);
            const float ss = wave_sum(v * v);
            float y = v * (1.0f / sqrtf(ss * (1.0f / 64.0f) + NORM_EPS)) * (h < 8 ? qg : kg);
            const float p = swap16_f(y);
            y = half == 0 ? y * cs - p * sn : y * cs + p * sn;
            if (h < 8) y *= C2;
            ur[h * 64 + lane] = (bf16_t)f2bf(y);
        }
    }
}

DEVFN void ph_hyprep(const Ctx& C, int i, bool do_ctx, unsigned char* lds) {
    const int tid = C.tid;
    const bf16_t* UHY = (const bf16_t*)(C.ws + WS_UHY);
    const float* taps = C.in[I_HSHORT] + (size_t)i * 3 * UHY_W;
    float* T = (float*)lds;
    const int ntile_lat = 3 * 8 * 256, ntile = ntile_lat + (do_ctx ? 3 * 8 * 4 : 0);
    for (int it = C.vcu; it < ntile; it += C.G) {
        const bool isctx = it >= ntile_lat; const int r = isctx ? it - ntile_lat : it;
        const int ntb = isctx ? 4 : 256; const int tb = r % ntb, cb = (r / ntb) & 7, g = r / (ntb * 8);
        const int seg0 = isctx ? NLAT : 0, segn = isctx ? NCTX : NLAT;
        {
            const int tl = tid >> 3, c8 = (tid & 7) * 8, t = 64 * tb + tl, col = g * 512 + 64 * cb + c8;
            float um[8], u0[8], up[8];
            unpack8(ld16(UHY + (size_t)(seg0 + t) * UHY_W + col), u0);
            if (t > 0) unpack8(ld16(UHY + (size_t)(seg0 + t - 1) * UHY_W + col), um); else UNR for (int e = 0; e < 8; ++e) um[e] = 0.f;
            if (t < segn - 1) unpack8(ld16(UHY + (size_t)(seg0 + t + 1) * UHY_W + col), up); else UNR for (int e = 0; e < 8; ++e) up[e] = 0.f;
            UNR for (int e = 0; e < 8; ++e) T[(c8 + e) * 65 + tl] = um[e] * taps[col + e] + u0[e] * taps[UHY_W + col + e] + up[e] * taps[2 * UHY_W + col + e];
        }
        SYNC();
        {
            const int cl = tid >> 3, t8 = (tid & 7) * 8, ch = 64 * cb + cl;
            float v[8]; UNR for (int e = 0; e < 8; ++e) v[e] = T[cl * 65 + t8 + e];
            if (!isctx) { bf16_t* VX = (bf16_t*)(C.ws + (g == 0 ? WS_VX0 : g == 1 ? WS_VX1 : WS_VX2)); st16(VX + (size_t)ch * NLAT + 64 * tb + t8, pack8(v)); }
            else { float* VXC = (float*)(C.ws + WS_VXC) + ((size_t)g * 512 + ch) * NCTX + 64 * tb + t8; UNR for (int e = 0; e < 8; ++e) VXC[e] = v[e]; }
        }
        SYNC();
    }
}

constexpr int FFT_N = 16384;
DEVFN int fidx(int n) { return n + (n >> 4); }
DEVFN F2 cmul(F2 a, F2 b) { F2 r; r.x = a.x * b.x - a.y * b.y; r.y = a.x * b.y + a.y * b.x; return r; }
DEVFN F2 cmulc(F2 a, F2 b) { F2 r; r.x = a.x * b.x + a.y * b.y; r.y = a.y * b.x - a.x * b.y; return r; }
DEVFN F2 cadd(F2 a, F2 b) { F2 r; r.x = a.x + b.x; r.y = a.y + b.y; return r; }
DEVFN F2 csub(F2 a, F2 b) { F2 r; r.x = a.x - b.x; r.y = a.y - b.y; return r; }
DEVFN F2 cconj(F2 a) { F2 r; r.x = a.x; r.y = -a.y; return r; }
template <bool INV> DEVFN F2 mul_mi(F2 a) { F2 r; if (!INV) { r.x = a.y; r.y = -a.x; } else { r.x = -a.y; r.y = a.x; } return r; }
template <bool INV> DEVFN void dft4(F2& a0, F2& a1, F2& a2, F2& a3) {
    const F2 s02 = cadd(a0, a2), d02 = csub(a0, a2), s13 = cadd(a1, a3), d13 = mul_mi<INV>(csub(a1, a3));
    a0 = cadd(s02, s13); a2 = csub(s02, s13); a1 = cadd(d02, d13); a3 = csub(d02, d13);
}
template <bool INV> DEVFN void dft16(F2* a) {
    UNR for (int n2 = 0; n2 < 4; ++n2) dft4<INV>(a[n2], a[4 + n2], a[8 + n2], a[12 + n2]);
    const float c1 = 0.92387953251128674f, s1 = 0.38268343236508977f, r2 = 0.70710678118654752f;
    const F2 w1 = {c1, INV ? s1 : -s1}, w2 = {r2, INV ? r2 : -r2}, w3 = {s1, INV ? c1 : -c1}, w6 = {-r2, INV ? r2 : -r2}, w9 = {-c1, INV ? -s1 : s1};
    a[4 * 1 + 1] = cmul(a[4 * 1 + 1], w1); a[4 * 1 + 2] = cmul(a[4 * 1 + 2], w2); a[4 * 1 + 3] = cmul(a[4 * 1 + 3], w3);
    a[4 * 2 + 1] = cmul(a[4 * 2 + 1], w2); a[4 * 2 + 2] = mul_mi<INV>(a[4 * 2 + 2]); a[4 * 2 + 3] = cmul(a[4 * 2 + 3], w6);
    a[4 * 3 + 1] = cmul(a[4 * 3 + 1], w3); a[4 * 3 + 2] = cmul(a[4 * 3 + 2], w6); a[4 * 3 + 3] = cmul(a[4 * 3 + 3], w9);
    F2 x[16];
    UNR for (int k1 = 0; k1 < 4; ++k1) { F2 b0 = a[4 * k1 + 0], b1 = a[4 * k1 + 1], b2 = a[4 * k1 + 2], b3 = a[4 * k1 + 3]; dft4<INV>(b0, b1, b2, b3); x[k1] = b0; x[k1 + 4] = b1; x[k1 + 8] = b2; x[k1 + 12] = b3; }
    UNR for (int q = 0; q < 16; ++q) a[q] = x[q];
}
template <int R, bool INV> DEVFN void fft_stage(F2* F, const F2* TW, int B, int tid) {
    const int S = B / R, NB = FFT_N / R, tws = 2 * (FFT_N / B);
    int tq = tid; OPAQUE(tq);
    UNR1 for (int q = tq; q < NB; q += NTHREADS) {
        const int blk = q / S, j = q - blk * S, base = blk * B + j;
        F2 a[R];
        UNR for (int m = 0; m < R; ++m) a[m] = F[fidx(base + m * S)];
        if (INV && S > 1) { const F2 w1 = TW[tws * j]; F2 w = w1; UNR for (int m = 1; m < R; ++m) { a[m] = cmulc(a[m], w); w = cmul(w, w1); } }
        if constexpr (R == 4) dft4<INV>(a[0], a[1], a[2], a[3]); else dft16<INV>(a);
        if (!INV && S > 1) { const F2 w1 = TW[tws * j]; F2 w = w1; UNR for (int m = 1; m < R; ++m) { a[m] = cmul(a[m], w); w = cmul(w, w1); } }
        UNR for (int m = 0; m < R; ++m) F[fidx(base + m * S)] = a[m];
    }
}
DEVFN void fft_fwd(F2* F, const F2* TW, int tid) {
    fft_stage<4, false>(F, TW, 16384, tid); SYNC(); fft_stage<16, false>(F, TW, 4096, tid); SYNC(); fft_stage<16, false>(F, TW, 256, tid); SYNC(); fft_stage<16, false>(F, TW, 16, tid); SYNC();
}
DEVFN void fft_inv(F2* F, const F2* TW, int tid) {
    fft_stage<16, true>(F, TW, 16, tid); SYNC(); fft_stage<16, true>(F, TW, 256, tid); SYNC(); fft_stage<16, true>(F, TW, 4096, tid); SYNC(); fft_stage<4, true>(F, TW, 16384, tid); SYNC();
}
DEVFN int fpos(int k) { return ((k & 3) << 12) | (((k >> 2) & 15) << 8) | (((k >> 6) & 15) << 4) | (k >> 10); }

DEVFN float block_sum(float v, float* red, int tid) {
    v = wave_sum(v);
    if ((tid & 63) == 0) red[tid >> 6] = v;
    SYNC();
    float s = 0.f; UNR for (int w = 0; w < NWAVES; ++w) s += red[w];
    SYNC();
    return s;
}

DEVFN void hyena_channel(const Ctx& C, int i, int c, unsigned char* lds) {
    const int tid = C.tid; constexpr int L = NLAT;
    F2* F = (F2*)lds; float* Ff = (float*)lds;
    float* W3C = (float*)(lds + 139264);
    float* red = W3C + 272;
    const F2* TW = (const F2*)(C.ws + WS_TW);
    const float* hid = (const float*)(C.ws + WS_HID) + (size_t)i * NLAT * 64;
    const float* w3 = C.in[I_HW3] + (size_t)i * 64 * 2048; const float* b3 = C.in[I_HB3] + (size_t)i * 2048;
    const bf16_t* VX0 = (const bf16_t*)(C.ws + WS_VX0) + (size_t)c * L;
    const bf16_t* VX1 = (const bf16_t*)(C.ws + WS_VX1) + (size_t)c * L;
    const bf16_t* VX2 = (const bf16_t*)(C.ws + WS_VX2) + (size_t)c * L;
    bf16_t* YHY = (bf16_t*)(C.ws + WS_YHY) + (size_t)c * L;
    const float skip0 = C.in[I_HSKIP][(size_t)i * 1024 + c], skip1 = C.in[I_HSKIP][(size_t)i * 1024 + 512 + c];
    const float delta = 15.350567286626973f + (float)c * ((3.0701134573253945f - 15.350567286626973f) / 511.0f);
    if (tid < 256) { const int o = tid >> 7, s = (tid >> 6) & 1, m = tid & 63; W3C[tid] = w3[(size_t)m * 2048 + (s * 2 + o) * 512 + c]; }
    if (tid < 4) W3C[256 + tid] = b3[((tid & 1) * 2 + (tid >> 1)) * 512 + c];
    SYNC();
    UNR1 for (int o = 0; o < 2; ++o) {
        float ssq = 0.f;
        {
            const int part = tid & 3, tsub = (tid & 63) >> 2, wv = tid >> 6;
            float wf[16], wb[16];
            UNR for (int m = 0; m < 16; ++m) { wf[m] = W3C[(o * 2 + 0) * 64 + 16 * part + m]; wb[m] = W3C[(o * 2 + 1) * 64 + 16 * part + m]; }
            const float bf_ = W3C[256 + o * 2 + 0], bb_ = W3C[256 + o * 2 + 1];
            UNR1 for (int ii = 0; ii < 128; ++ii) {
                const int t = (ii * 8 + wv) * 16 + tsub;
                const F4* hr = (const F4*)(hid + (size_t)t * 64 + 16 * part);
                float af = 0.f, ab = 0.f;
                UNR for (int m4 = 0; m4 < 4; ++m4) { const F4 h = hr[m4];
                    af += h.x * wf[4 * m4] + h.y * wf[4 * m4 + 1] + h.z * wf[4 * m4 + 2] + h.w * wf[4 * m4 + 3];
                    ab += h.x * wb[4 * m4] + h.y * wb[4 * m4 + 1] + h.z * wb[4 * m4 + 2] + h.w * wb[4 * m4 + 3]; }
                af = rowx_add<1>(af); af = rowx_add<2>(af); ab = rowx_add<1>(ab); ab = rowx_add<2>(ab);
                if (part == 0) {
                    const float win = expf(-((float)t / (float)(L - 1)) * delta);
                    af = (af + bf_) * win; ab = (ab + bb_) * win;
                    if (t == 0) { af += ab; ssq += af * af; Ff[0] = af; Ff[2 * fidx(L >> 1)] = 0.f; }
                    else { ssq += af * af + ab * ab; Ff[2 * fidx(t >> 1) + (t & 1)] = af; const int m = 2 * L - t; Ff[2 * fidx(m >> 1) + (m & 1)] = ab; }
                }
            }
        }
        const float knorm = 1.0f / sqrtf(block_sum(ssq, red, tid));
        fft_fwd(F, TW, tid);
        F2 kfa[16], kfb[16]; F2 kfh = {0.f, 0.f};
        int tq1 = tid; OPAQUE(tq1);
        UNR for (int ii = 0; ii < 16; ++ii) {
            const int k = tq1 + NTHREADS * ii;
            if (k == 0) { const F2 c0 = F[fidx(0)]; kfa[ii].x = (c0.x + c0.y) * knorm; kfa[ii].y = 0.f; kfb[ii].x = (c0.x - c0.y) * knorm; kfb[ii].y = 0.f;
                          const F2 ch = F[fidx(fpos(L / 2))]; kfh.x = ch.x * knorm; kfh.y = -ch.y * knorm; }
            else { const F2 ck = F[fidx(fpos(k))], cp = cconj(F[fidx(fpos(L - k))]);
                F2 e = cadd(ck, cp), od = csub(ck, cp); e.x *= 0.5f; e.y *= 0.5f; F2 oo; oo.x = 0.5f * od.y; oo.y = -0.5f * od.x;
                const F2 tt = cmul(TW[k], oo);
                kfa[ii] = cadd(e, tt); kfb[ii] = cconj(csub(e, tt)); kfa[ii].x *= knorm; kfa[ii].y *= knorm; kfb[ii].x *= knorm; kfb[ii].y *= knorm; }
            CFENCE();
        }
        SYNC();
        UNR for (int ii = 0; ii < 4; ++ii) {
            int tq3 = tid; OPAQUE(tq3); const int t0 = 8 * (tq3 + NTHREADS * ii); float v[8];
            unpack8(ld16((o == 0 ? VX0 : (const bf16_t*)YHY) + t0), v);
            float* d = Ff + 2 * fidx(t0 >> 1); UNR for (int e = 0; e < 8; ++e) d[e] = v[e];
            float* zz = Ff + 2 * fidx((L + t0) >> 1); UNR for (int e = 0; e < 8; ++e) zz[e] = 0.f;
        }
        SYNC();
        fft_fwd(F, TW, tid);
        int tq2 = tid; OPAQUE(tq2);
        UNR for (int ii = 0; ii < 16; ++ii) {
            const int k = tq2 + NTHREADS * ii;
            if (k == 0) { const F2 c0 = F[fidx(0)]; const float y0 = (c0.x + c0.y) * kfa[ii].x, yl = (c0.x - c0.y) * kfb[ii].x; F2 d; d.x = 0.5f * (y0 + yl); d.y = 0.5f * (y0 - yl); F[fidx(0)] = d;
                          const int ph = fidx(fpos(L / 2)); const F2 y = cmul(cconj(F[ph]), kfh); F[ph] = cconj(y); }
            else { const int pk = fidx(fpos(k)), pp = fidx(fpos(L - k)); const F2 ck = F[pk], cp = cconj(F[pp]);
                F2 e = cadd(ck, cp), od = csub(ck, cp); e.x *= 0.5f; e.y *= 0.5f; F2 oo; oo.x = 0.5f * od.y; oo.y = -0.5f * od.x;
                const F2 w = TW[k]; const F2 tt = cmul(w, oo);
                const F2 yk = cmul(cadd(e, tt), kfa[ii]), yp = cmul(cconj(csub(e, tt)), kfb[ii]);
                F2 ye = cadd(yk, cconj(yp)), yd = csub(yk, cconj(yp)); ye.x *= 0.5f; ye.y *= 0.5f; yd.x *= 0.5f; yd.y *= 0.5f;
                const F2 yo = cmulc(yd, w);
                F2 iyo; iyo.x = -yo.y; iyo.y = yo.x;
                F[pk] = cadd(ye, iyo); F[pp] = cconj(csub(ye, iyo)); }
            CFENCE();
        }
        SYNC();
        fft_inv(F, TW, tid);
        UNR for (int ii = 0; ii < 4; ++ii) {
            int tq4 = tid; OPAQUE(tq4); const int t0 = 8 * (tq4 + NTHREADS * ii); const float* d = Ff + 2 * fidx(t0 >> 1);
            float y[8]; UNR for (int e = 0; e < 8; ++e) y[e] = d[e] * (1.0f / (float)FFT_N);
            if (o == 0) { float v[8], x1[8], r[8]; unpack8(ld16(VX0 + t0), v); unpack8(ld16(VX1 + t0), x1); UNR for (int e = 0; e < 8; ++e) r[e] = x1[e] * (y[e] + v[e] * skip0); st16(YHY + t0, pack8(r)); }
            else { float x2[8], zp[8], r[8]; unpack8(ld16(VX2 + t0), x2); unpack8(ld16(YHY + t0), zp); UNR for (int e = 0; e < 8; ++e) r[e] = x2[e] * (y[e] + zp[e] * skip1); st16(YHY + t0, pack8(r)); }
        }
        SYNC();
    }
}

DEVFN void hyena_ctx_channel(const Ctx& C, int i, int c, unsigned char* lds) {
    const int tid = C.tid; constexpr int L = NCTX;
    float* KF = (float*)lds;
    float* Z = KF + 1024;
    float* red = Z + 256;
    float* W3C = red + 16;
    const float* hid = (const float*)(C.ws + WS_HID256);
    const float* w3 = C.in[I_HW3] + (size_t)i * 64 * 2048; const float* b3 = C.in[I_HB3] + (size_t)i * 2048;
    const float* VXC = (const float*)(C.ws + WS_VXC);
    const float delta = 15.350567286626973f + (float)c * ((3.0701134573253945f - 15.350567286626973f) / 511.0f);
    if (tid < 256) { const int o = tid >> 7, s = (tid >> 6) & 1, m = tid & 63; W3C[tid] = w3[(size_t)m * 2048 + (s * 2 + o) * 512 + c]; }
    if (tid < 4) W3C[256 + tid] = b3[((tid & 1) * 2 + (tid >> 1)) * 512 + c];
    SYNC();
    {
        const int o = tid >> 8, t = tid & 255;
        float af = W3C[256 + o * 2 + 0], ab = W3C[256 + o * 2 + 1];
        for (int m = 0; m < 64; ++m) { const float h = hid[t * 64 + m]; af += h * W3C[(o * 2 + 0) * 64 + m]; ab += h * W3C[(o * 2 + 1) * 64 + m]; }
        const float win = expf(-((float)t / (float)(L - 1)) * delta); af *= win; ab *= win;
        float ssq; if (t == 0) { af += ab; ab = 0.f; ssq = af * af; } else ssq = af * af + ab * ab;
        KF[(o * 2 + 0) * 256 + t] = af; KF[(o * 2 + 1) * 256 + t] = ab;
        ssq = wave_sum(ssq);
        if ((tid & 63) == 0) red[tid >> 6] = ssq;
        SYNC();
        const float tot = red[o * 4] + red[o * 4 + 1] + red[o * 4 + 2] + red[o * 4 + 3];
        const float kn = 1.0f / sqrtf(tot);
        KF[(o * 2 + 0) * 256 + t] = af * kn; KF[(o * 2 + 1) * 256 + t] = ab * kn;
    }
    float v = 0.f, x1 = 0.f, x2 = 0.f, z1 = 0.f;
    if (tid < 256) { v = VXC[((size_t)0 * 512 + c) * L + tid]; x1 = VXC[((size_t)1 * 512 + c) * L + tid]; x2 = VXC[((size_t)2 * 512 + c) * L + tid]; Z[tid] = v; }
    SYNC();
    for (int o = 0; o < 2; ++o) {
        float y = 0.f;
        if (tid < 256) { const int t = tid; const float* kf = KF + (o * 2) * 256; const float* kb = KF + (o * 2 + 1) * 256;
            for (int s = 0; s <= t; ++s) y += kf[t - s] * Z[s];
            for (int s = t + 1; s < L; ++s) y += kb[s - t] * Z[s]; }
        SYNC();
        if (tid < 256) { if (o == 0) { z1 = x1 * (y + v * C.in[I_HSKIP][(size_t)i * 1024 + c]); Z[tid] = z1; }
            else { const float r = x2 * (y + z1 * C.in[I_HSKIP][(size_t)i * 1024 + 512 + c]);
                const bf16_t* GHY = (const bf16_t*)(C.ws + WS_GHY); bf16_t* HO = (bf16_t*)(C.ws + WS_HYOUT);
                HO[(size_t)(NLAT + tid) * 512 + c] = (bf16_t)f2bf(r * bf2f(GHY[(size_t)(NLAT + tid) * 512 + c])); } }
        SYNC();
    }
}

typedef float P2 __attribute__((vector_size(8)));
#ifdef EMU
struct H8 { unsigned short v[8]; };
struct A4 { float v[4]; };
inline A4 mfma16(const H8& a, const H8& b, const A4& c) {
    static H8 sa_[emu::MAXB][8][64], sb_[emu::MAXB][8][64]; const int w = emu::t_tid >> 6, l = emu::t_tid & 63; H8 (*sa)[64] = sa_[emu::t_blk]; H8 (*sb)[64] = sb_[emu::t_blk];
    sa[w][l] = a; sb[w][l] = b; pthread_barrier_wait(&emu::g_wbar_[emu::t_blk][w]);
    A4 r = c;
    for (int reg = 0; reg < 4; ++reg) { const int row = 4 * (l >> 4) + reg, col = l & 15; float acc = 0.f;
        for (int k = 0; k < 32; ++k) acc += bf2f(sa[w][row + 16 * (k >> 3)].v[k & 7]) * bf2f(sb[w][col + 16 * (k >> 3)].v[k & 7]);
        r.v[reg] += acc; }
    pthread_barrier_wait(&emu::g_wbar_[emu::t_blk][w]);
    return r;
}
#define H8_SET(h, j, x) (h).v[j] = (unsigned short)(x)
#define A4_GET(a, j) (a).v[j]
#define MFMA_PAD(a,b,c,d,e,f,g,h)
#else
typedef short H8 __attribute__((ext_vector_type(8)));
typedef float A4 __attribute__((ext_vector_type(4)));
DEVFN A4 mfma16(const H8& a, const H8& b, const A4& c) { return __builtin_amdgcn_mfma_f32_16x16x32_bf16(a, b, c, 0, 0, 0); }
#define H8_SET(h, j, x) (h)[j] = (short)(x)
#define A4_GET(a, j) (a)[j]
#define MFMA_PAD(a,b,c,d,e,f,g,h) asm volatile("s_nop 15\n\ts_nop 15" : "+v"(a), "+v"(b), "+v"(c), "+v"(d), "+v"(e), "+v"(f), "+v"(g), "+v"(h))
#endif
#ifdef EMU
#define FEXP(x) expf(x)
#define FLOG(x) logf(x)
#define FRCP(x) (1.0f / (x))
#define FRSQ(x) (1.0f / sqrtf(x))
#define SETPRIO(n)
#else
#define FEXP(x) __expf(x)
#define FLOG(x) __logf(x)
#define FRCP(x) __builtin_amdgcn_rcpf(x)
#define FRSQ(x) __builtin_amdgcn_rsqf(x)
#define SETPRIO(n) __builtin_amdgcn_s_setprio(n)
#endif
DEVFN H8 h8_from_u4(U4 w) { H8 r; H8_SET(r, 0, w.x & 0xffff); H8_SET(r, 1, w.x >> 16); H8_SET(r, 2, w.y & 0xffff); H8_SET(r, 3, w.y >> 16); H8_SET(r, 4, w.z & 0xffff); H8_SET(r, 5, w.z >> 16); H8_SET(r, 6, w.w & 0xffff); H8_SET(r, 7, w.w >> 16); return r; }
constexpr int SC_T = 32;
constexpr int SC_R = 16;
constexpr int SC_BUF = 5 * SC_T * 64 + SC_T * SC_R;
DEVFN void rwkv_scan(const Ctx& C, int i, int h, int d, int rq, bool ctx_out, unsigned char* lds, int max_chunks) {
    const int tid = C.tid;
    float* sBUF = (float*)lds; float* sY = sBUF + 2 * SC_BUF; float* sWV = sY + 2 * SC_T * SC_R;
    const bf16_t* U = (const bf16_t*)(C.ws + WS_U);
    const float* mu = C.in[I_MU] + (size_t)i * 1664;
    const float* w0 = C.in[I_W0] + ((size_t)i * 2 + d) * 512 + 64 * h; const float* a0 = C.in[I_A0] + ((size_t)i * 2 + d) * 512 + 64 * h;
    const float* wup = C.in[I_WUP] + ((size_t)i * 2 + d) * 32 * 512 + 64 * h; const float* aup = C.in[I_AUP] + ((size_t)i * 2 + d) * 32 * 512 + 64 * h;
    const float* k_k = C.in[I_KK] + (size_t)i * 512 + 64 * h; const float* k_a = C.in[I_KA] + (size_t)i * 512 + 64 * h; const float* r_k = C.in[I_RK] + (size_t)i * 512 + 64 * h;
    bf16_t* Yd = (bf16_t*)(C.ws + (d == 0 ? WS_YF : WS_YB));
    float* BON = (float*)(C.ws + WS_BONUS) + (size_t)d * NTOK * 8;
    const bool is_scan = tid < 256;
    const int nchunks = NTOK / SC_T < max_chunks ? NTOK / SC_T : max_chunks;
    #define CHUNK_GEOM(ch, seg0, segn, R0) const bool isctx_ = (ch) < NCTX / SC_T; const int seg0 = isctx_ ? NLAT : 0, segn = isctx_ ? NCTX : NLAT; \
        const int cl_ = isctx_ ? (ch) : (ch) - NCTX / SC_T; const int R0 = d == 0 ? SC_T * cl_ : segn - SC_T * (cl_ + 1);
    const int ft = (tid & 255) >> 3, fp = tid & 7;
    float* sCN = sWV + 4 * 1280; float* sCN_base_ = sCN;
    if (tid < 64) { const int j = tid; sCN[j] = mu[64 * h + j]; sCN[64 + j] = mu[512 + 64 * h + j]; sCN[128 + j] = mu[1024 + 64 * h + j]; sCN[192 + j] = w0[j]; sCN[256 + j] = a0[j];
        sCN[320 + j] = k_k[j]; sCN[384 + j] = k_a[j]; sCN[448 + j] = r_k[j]; sCN[512 + j] = j < 32 ? mu[1536 + 32 * d + j] : mu[1600 + 32 * d + (j - 32)]; }
    U4* sBF = (U4*)(sCN_base_ + 640);
    { const int m = tid >> 8, nt = (tid >> 6) & 3, ln = tid & 63; const float* src = m == 0 ? wup : aup; float f[8];
      UNR for (int j = 0; j < 8; ++j) f[j] = src[(size_t)(8 * (ln >> 4) + j) * 512 + 16 * nt + (ln & 15)];
      sBF[tid] = pack8(f); }
    float* myWV = sWV + ((tid >> 6) & 3) * 1280; float* sWL = myWV; float* sAL = myWV + 512; bf16_t* sTDb = (bf16_t*)(myWV + 1024); bf16_t* sADb = sTDb + 256;
    const int rl = (tid & 255) >> 4, sp = tid & 15;
    float S0 = 0.f, S1 = 0.f, S2 = 0.f, S3 = 0.f;
    SYNC();
    U4 pu[9]; U2 pw[6];
    auto issue = [&](int ch) {
        int tq_ = tid; OPAQUE(tq_); const int ft = (tq_ & 255) >> 3, fp = tq_ & 7;
        CHUNK_GEOM(ch, seg0, segn, R0)
        const int tl = d == 0 ? R0 + ft : R0 + SC_T - 1 - ft;
        const bf16_t* u0p = U + (size_t)(seg0 + tl) * URW_W;
        const bool hm = tl > 0, hp = tl < segn - 1;
        const U4 z4 = {0u, 0u, 0u, 0u}; const U2 z2 = {0u, 0u};
        const int cw = 1536 + 32 * d + 4 * fp, ca = 1600 + 32 * d + 4 * fp;
        UNR for (int j = 0; j < 3; ++j) { pu[3 * j] = ld16(u0p + 512 * j + 64 * h + 8 * fp); pu[3 * j + 1] = z4; pu[3 * j + 2] = z4; }
        pw[0] = *(const U2*)(u0p + cw); pw[3] = *(const U2*)(u0p + ca); pw[1] = z2; pw[2] = z2; pw[4] = z2; pw[5] = z2;
        if (hm) { UNR for (int j = 0; j < 3; ++j) pu[3 * j + 1] = ld16(u0p - URW_W + 512 * j + 64 * h + 8 * fp); pw[1] = *(const U2*)(u0p - URW_W + cw); pw[4] = *(const U2*)(u0p - URW_W + ca); }
        if (hp) { UNR for (int j = 0; j < 3; ++j) pu[3 * j + 2] = ld16(u0p + URW_W + 512 * j + 64 * h + 8 * fp); pw[2] = *(const U2*)(u0p + URW_W + cw); pw[5] = *(const U2*)(u0p + URW_W + ca); }
    };
    auto features = [&](int ch) {
        int tq_ = tid; OPAQUE(tq_); const int ft = (tq_ & 255) >> 3, fp = tq_ & 7;
        const float* mu_r = sCN + 8 * fp; const float* mu_k = sCN + 64 + 8 * fp; const float* mu_v = sCN + 128 + 8 * fp; const float* c_w0 = sCN + 192 + 8 * fp; const float* c_a0 = sCN + 256 + 8 * fp;
        const float* c_kk = sCN + 320 + 8 * fp; const float* c_ka = sCN + 384 + 8 * fp; const float* c_rk = sCN + 448 + 8 * fp; const float* mu_w = sCN + 512 + 4 * fp; const float* mu_a = sCN + 544 + 4 * fp;
        CHUNK_GEOM(ch, seg0, segn, R0)
        float* B_ = sBUF + (ch & 1) * SC_BUF; float* sW = B_; float* sKD = B_ + SC_T * 64; float* sB = B_ + 2 * SC_T * 64; float* sKK = B_ + 3 * SC_T * 64; float* sR = B_ + 4 * SC_T * 64; float* sV = B_ + 5 * SC_T * 64;
        const int tl = d == 0 ? R0 + ft : R0 + SC_T - 1 - ft;
        float r[8], k[8], v[8];
        {
            float a[8], m[8], p[8];
            #define SHIFT3(J, MU, OUT) do { unpack8(pu[3 * (J)], a); unpack8(pu[3 * (J) + 1], m); unpack8(pu[3 * (J) + 2], p); \
                UNR for (int e = 0; e < 8; ++e) OUT[e] = a[e] + (0.5f * (m[e] + p[e]) - a[e]) * MU[e]; } while (0)
            SHIFT3(0, mu_r, r); SHIFT3(1, mu_k, k); SHIFT3(2, mu_v, v);
            #undef SHIFT3
        }
        {
            const U2 w0_ = pw[0], wm = pw[1], wp = pw[2], a0_ = pw[3], am = pw[4], ap = pw[5];
            const float wa[4] = {bflo(w0_.x), bfhi(w0_.x), bflo(w0_.y), bfhi(w0_.y)}, wmm[4] = {bflo(wm.x), bfhi(wm.x), bflo(wm.y), bfhi(wm.y)}, wpp[4] = {bflo(wp.x), bfhi(wp.x), bflo(wp.y), bfhi(wp.y)};
            const float aa[4] = {bflo(a0_.x), bfhi(a0_.x), bflo(a0_.y), bfhi(a0_.y)}, amm[4] = {bflo(am.x), bfhi(am.x), bflo(am.y), bfhi(am.y)}, app[4] = {bflo(ap.x), bfhi(ap.x), bflo(ap.y), bfhi(ap.y)};
            if (ch + 1 < nchunks) issue(ch + 1);
            const int tw = ft & 7;
            float tdv[4], adv[4];
            UNR for (int e = 0; e < 4; ++e) { const float x = wa[e] + (0.5f * (wmm[e] + wpp[e]) - wa[e]) * mu_w[e];
                tdv[e] = 1.0f - 2.0f * FRCP(1.0f + FEXP(2.0f * x));
                adv[e] = aa[e] + (0.5f * (amm[e] + app[e]) - aa[e]) * mu_a[e]; }
            U2 tq, aq; tq.x = pk2(tdv[0], tdv[1]); tq.y = pk2(tdv[2], tdv[3]); aq.x = pk2(adv[0], adv[1]); aq.y = pk2(adv[2], adv[3]);
            *(U2*)(sTDb + tw * 32 + 4 * fp) = tq; *(U2*)(sADb + tw * 32 + 4 * fp) = aq;
        }
        WAVE_SYNC();
        float wl[8], al[8];
        {
            const int lane = tid & 63, arow = lane & 7, kg = lane >> 4;
            const U4 ta = ld16(sTDb + arow * 32 + 8 * kg), aa_ = ld16(sADb + arow * 32 + 8 * kg);
            H8 At, Aa;
            H8_SET(At, 0, ta.x & 0xffff); H8_SET(At, 1, ta.x >> 16); H8_SET(At, 2, ta.y & 0xffff); H8_SET(At, 3, ta.y >> 16); H8_SET(At, 4, ta.z & 0xffff); H8_SET(At, 5, ta.z >> 16); H8_SET(At, 6, ta.w & 0xffff); H8_SET(At, 7, ta.w >> 16);
            H8_SET(Aa, 0, aa_.x & 0xffff); H8_SET(Aa, 1, aa_.x >> 16); H8_SET(Aa, 2, aa_.y & 0xffff); H8_SET(Aa, 3, aa_.y >> 16); H8_SET(Aa, 4, aa_.z & 0xffff); H8_SET(Aa, 5, aa_.z >> 16); H8_SET(Aa, 6, aa_.w & 0xffff); H8_SET(Aa, 7, aa_.w >> 16);
            A4 cw_[4], ca_[4];
            UNR for (int nt = 0; nt < 4; ++nt) {
                A4 z; A4_GET(z, 0) = 0.f; A4_GET(z, 1) = 0.f; A4_GET(z, 2) = 0.f; A4_GET(z, 3) = 0.f;
                cw_[nt] = mfma16(At, h8_from_u4(sBF[nt * 64 + (tid & 63)]), z); ca_[nt] = mfma16(Aa, h8_from_u4(sBF[(4 + nt) * 64 + (tid & 63)]), z);
            }
            MFMA_PAD(cw_[0], cw_[1], cw_[2], cw_[3], ca_[0], ca_[1], ca_[2], ca_[3]);
            if (lane < 32) { UNR for (int nt = 0; nt < 4; ++nt) UNR for (int rg = 0; rg < 4; ++rg) { const int tok = 4 * (lane >> 4) + rg; sWL[tok * 64 + 16 * nt + (lane & 15)] = A4_GET(cw_[nt], rg); sAL[tok * 64 + 16 * nt + (lane & 15)] = A4_GET(ca_[nt], rg); } }
            WAVE_SYNC();
            const int tw = ft & 7;
            { const F4 w0_ = *(const F4*)(sWL + tw * 64 + 8 * fp), w1_ = *(const F4*)(sWL + tw * 64 + 8 * fp + 4), a0_ = *(const F4*)(sAL + tw * 64 + 8 * fp), a1_ = *(const F4*)(sAL + tw * 64 + 8 * fp + 4);
              const F4 cw0 = *(const F4*)(c_w0), cw1 = *(const F4*)(c_w0 + 4), ca0 = *(const F4*)(c_a0), ca1 = *(const F4*)(c_a0 + 4);
              wl[0] = cw0.x + w0_.x; wl[1] = cw0.y + w0_.y; wl[2] = cw0.z + w0_.z; wl[3] = cw0.w + w0_.w; wl[4] = cw1.x + w1_.x; wl[5] = cw1.y + w1_.y; wl[6] = cw1.z + w1_.z; wl[7] = cw1.w + w1_.w;
              al[0] = ca0.x + a0_.x; al[1] = ca0.y + a0_.y; al[2] = ca0.z + a0_.z; al[3] = ca0.w + a0_.w; al[4] = ca1.x + a1_.x; al[5] = ca1.y + a1_.y; al[6] = ca1.z + a1_.z; al[7] = ca1.w + a1_.w; }
            WAVE_SYNC();
        }
        float kkv[8], ssq = 0.f;
        UNR for (int e = 0; e < 8; ++e) { kkv[e] = k[e] * c_kk[e]; ssq += kkv[e] * kkv[e]; }
        ssq = rowx_add<1>(ssq); ssq = rowx_add<2>(ssq); ssq = rowx_add<7>(ssq);
        const float kn = FRSQ(ssq + 1e-12f);
        float bon = 0.f; float o_w[8], o_kd[8], o_b[8], o_kk[8];
        UNR for (int e = 0; e < 8; ++e) {
            const float dec = FEXP(-0.60653066f * FRCP(1.0f + FEXP(-wl[e])));
            const float a = FRCP(1.0f + FEXP(-al[e]));
            const float kd = k[e] * (1.0f + (a - 1.0f) * c_ka[e]);
            const float kk = kkv[e] * kn;
            o_w[e] = dec; o_kd[e] = kd; o_b[e] = kk * a; o_kk[e] = kk;
            bon += r[e] * kd * c_rk[e];
        }
        { const int o = ft * 64 + 8 * fp;
          #define ST8(P, A) do { F4 x0_, x1_; x0_.x = A[0]; x0_.y = A[1]; x0_.z = A[2]; x0_.w = A[3]; x1_.x = A[4]; x1_.y = A[5]; x1_.z = A[6]; x1_.w = A[7]; *(F4*)((P) + o) = x0_; *(F4*)((P) + o + 4) = x1_; } while (0)
          ST8(sW, o_w); ST8(sKD, o_kd); ST8(sB, o_b); ST8(sKK, o_kk); ST8(sR, r);
          #undef ST8
        }
        if ((fp >> 1) == rq) { UNR for (int e = 0; e < 8; ++e) sV[ft * SC_R + 8 * (fp & 1) + e] = v[e]; }
        bon = rowx_add<1>(bon); bon = rowx_add<2>(bon); bon = rowx_add<7>(bon);
        if (fp == 0 && rq == 0) BON[(size_t)(seg0 + tl) * 8 + h] = 0.5f * bon;
    };
    auto store_y = [&](int ch) {
        CHUNK_GEOM(ch, seg0, segn, R0)
        if (isctx_ && !ctx_out) return;
        const float* Yb = sY + (ch & 1) * SC_T * SC_R;
        const int k = (tid & 255) >> 3, q = (tid & 7) * 2; const int tl = d == 0 ? R0 + k : R0 + SC_T - 1 - k;
        *(unsigned*)(Yd + (size_t)(seg0 + tl) * 512 + 64 * h + SC_R * rq + q) = pk2(Yb[k * SC_R + q], Yb[k * SC_R + q + 1]);
    };
    if (!is_scan) { issue(0); features(0); }
    SYNC();
    if (C.wave < 4) SETPRIO(3);
    TACC_DECL;
    for (int ch = 0; ch < nchunks; ++ch) {
        TACC_BEGIN;
        if (is_scan) {
            const float* B_ = sBUF + (ch & 1) * SC_BUF; const float* sW = B_; const float* sKD = B_ + SC_T * 64; const float* sB = B_ + 2 * SC_T * 64; const float* sKK = B_ + 3 * SC_T * 64; const float* sR = B_ + 4 * SC_T * 64; const float* sV = B_ + 5 * SC_T * 64;
            float* Yb = sY + (ch & 1) * SC_T * SC_R;
            float yk0 = 0.f, yk1 = 0.f, yp = 0.f;
#ifndef EMU
            {
                const unsigned ab = (unsigned)(uintptr_t)B_ + 16u * (unsigned)sp, av = (unsigned)(uintptr_t)sV + 4u * (unsigned)rl;
                P2 s01 = {S0, S1}, s23 = {S2, S3};
                asm volatile(SCAN_CHUNK_ASM : [s01] "+v"(s01), [s23] "+v"(s23), [yp] "+v"(yp), [yk0] "+v"(yk0), [yk1] "+v"(yk1) : [ab] "v"(ab), [av] "v"(av), [sp] "v"(sp) : SCAN_CHUNK_CLOBBERS);
                S0 = s01[0]; S1 = s01[1]; S2 = s23[0]; S3 = s23[1];
            }
#else
            for (int k = 0; k < SC_T; ++k) {
                const F4 kk4 = *(const F4*)(sKK + k * 64 + 4 * sp), w4 = *(const F4*)(sW + k * 64 + 4 * sp), b4 = *(const F4*)(sB + k * 64 + 4 * sp),
                         kd4 = *(const F4*)(sKD + k * 64 + 4 * sp), r4 = *(const F4*)(sR + k * 64 + 4 * sp);
                const float vi = sV[k * SC_R + rl];
                float sa = (S0 * kk4.x + S2 * kk4.z) + (S1 * kk4.y + S3 * kk4.w);
                const float t0 = S0 * w4.x + vi * kd4.x, t1 = S1 * w4.y + vi * kd4.y, t2 = S2 * w4.z + vi * kd4.z, t3 = S3 * w4.w + vi * kd4.w;
                sa = rowx_add<1>(sa); yp = rowx_add<1>(yp); sa = rowx_add<2>(sa); yp = rowx_add<2>(yp);
                sa = rowx_add<7>(sa); yp = rowx_add<7>(yp); sa = rowx_add<15>(sa); yp = rowx_add<15>(yp);
                if (sp == ((k + 15) & 15)) { if (k <= 16) yk0 = yp; else yk1 = yp; }
                S0 = t0 - sa * b4.x; S1 = t1 - sa * b4.y; S2 = t2 - sa * b4.z; S3 = t3 - sa * b4.w;
                yp = (S0 * r4.x + S2 * r4.z) + (S1 * r4.y + S3 * r4.w);
            }
#endif
            yp = rowx_add<1>(yp); yp = rowx_add<2>(yp); yp = rowx_add<7>(yp); yp = rowx_add<15>(yp);
            if (sp == 15) yk1 = yp;
            Yb[sp * SC_R + rl] = yk0; Yb[(sp + 16) * SC_R + rl] = yk1;
        } else {
            if (ch + 1 < nchunks) features(ch + 1);
            if (ch > 0) store_y(ch - 1);
        }
        TACC_END;
        SYNC();
    }
    TACC_STORE(C, is_scan ? 45 : 46, C.vcu == 0 && (tid == 0 || tid == 256));
    if (C.wave < 4) SETPRIO(0);
    if (!is_scan) store_y(nchunks - 1);
    #undef CHUNK_GEOM
}

DEVFN void ph_readout_hyout(const Ctx& C, int i, bool do_ctx, unsigned char* lds) {
    const int tid = C.tid;
    {
        const bf16_t* U = (const bf16_t*)(C.ws + WS_U); bf16_t* YF = (bf16_t*)(C.ws + WS_YF); const bf16_t* YB = (const bf16_t*)(C.ws + WS_YB);
        const float* BON = (const float*)(C.ws + WS_BONUS);
        const float* mu = C.in[I_MU] + (size_t)i * 1664 + 1024; const float* gnw = C.in[I_GNW] + (size_t)i * 512; const float* gnb = C.in[I_GNB] + (size_t)i * 512;
        const int rl = tid >> 6, c8 = (tid & 63) * 8, h = (tid & 63) >> 3;
        float muv[8], gw_[8], gb_[8];
        UNR for (int e = 0; e < 8; ++e) { muv[e] = mu[c8 + e]; gw_[e] = gnw[c8 + e]; gb_[e] = gnb[c8 + e]; }
        const int nrows = do_ctx ? NTOK : NLAT;
        for (int r0 = C.vcu * 8; r0 < nrows; r0 += C.G * 8) {
            const int row = r0 + rl; const bool isctx = row >= NLAT; const int seg0 = isctx ? NLAT : 0, segn = isctx ? NCTX : NLAT, tl = row - seg0;
            float yf[8], yb[8], y[8], a[8], m[8], p[8], g[8];
            unpack8(ld16(YF + (size_t)row * 512 + c8), yf); unpack8(ld16(YB + (size_t)row * 512 + c8), yb);
            float s = 0.f; UNR for (int e = 0; e < 8; ++e) { y[e] = yf[e] + yb[e]; s += y[e]; }
            s = rowx_add<1>(s); s = rowx_add<2>(s); s = rowx_add<7>(s);
            const float mean = s * (1.0f / 64.0f); float q = 0.f;
            UNR for (int e = 0; e < 8; ++e) { y[e] -= mean; q += y[e] * y[e]; }
            q = rowx_add<1>(q); q = rowx_add<2>(q); q = rowx_add<7>(q);
            const float rstd = 1.0f / sqrtf(q * (1.0f / 64.0f) + 64e-5f);
            const bf16_t* up = U + (size_t)row * URW_W + 1024 + c8;
            unpack8(ld16(up), a);
            if (tl > 0) unpack8(ld16(up - URW_W), m); else UNR for (int e = 0; e < 8; ++e) m[e] = 0.f;
            if (tl < segn - 1) unpack8(ld16(up + URW_W), p); else UNR for (int e = 0; e < 8; ++e) p[e] = 0.f;
            unpack8(ld16(U + (size_t)row * URW_W + 1664 + c8), g);
            const float bon = BON[(size_t)row * 8 + h] + BON[(size_t)NTOK * 8 + (size_t)row * 8 + h];
            float o[8];
            UNR for (int e = 0; e < 8; ++e) { const float v = a[e] + (0.5f * (m[e] + p[e]) - a[e]) * muv[e]; o[e] = (y[e] * rstd * gw_[e] + gb_[e] + bon * v) * g[e]; }
            st16(YF + (size_t)row * 512 + c8, pack8(o));
        }
    }
    {
        const bf16_t* YHY = (const bf16_t*)(C.ws + WS_YHY); const bf16_t* GHY = (const bf16_t*)(C.ws + WS_GHY); bf16_t* HO = (bf16_t*)(C.ws + WS_HYOUT);
        float* T = (float*)lds;
        for (int it = C.vcu; it < 256 * 8; it += C.G) {
            const int tb = it >> 3, cb = it & 7;
            { const int cl = tid >> 3, t8 = (tid & 7) * 8; float v[8]; unpack8(ld16(YHY + (size_t)(64 * cb + cl) * NLAT + 64 * tb + t8), v); UNR for (int e = 0; e < 8; ++e) T[cl * 65 + t8 + e] = v[e]; }
            SYNC();
            { const int tl = tid >> 3, c8 = (tid & 7) * 8; float g[8], o[8]; const size_t off = (size_t)(64 * tb + tl) * 512 + 64 * cb + c8;
              unpack8(ld16(GHY + off), g); UNR for (int e = 0; e < 8; ++e) o[e] = T[(c8 + e) * 65 + tl] * g[e]; st16(HO + off, pack8(o)); }
            SYNC();
        }
    }
}

constexpr int RC_T = 16, RC_RING = 7, RC_NPROD = 6;
constexpr int RS_KKD = 0, RS_RD = 2048, RS_KIT = 4096, RS_NBIT = 6144, RS_VT = 8192, RS_T = 9216, RS_P0 = 9728, RS_Q1 = 10240, RS_NQ2 = 10752, RS_GC = 11264, RS_BYTES = 11520;
constexpr int RW_TDAD = 0, RW_WL = 2048, RW_AL = 6144, RW_KIP = 2048, RW_BIP = 4096, RW_AM = 10240, RW_BYTES = 11264;
constexpr int RC_LDS_RING = 0, RC_LDS_WAVE = RC_RING * RS_BYTES, RC_LDS_BFR = RC_LDS_WAVE + RC_NPROD * RW_BYTES, RC_LDS_FLAGS = RC_LDS_BFR + 8192, RC_LDS_END = RC_LDS_FLAGS + 3 * 8 * 4;
static_assert(RC_LDS_END <= RING_BYTES, "rwkv chunked LDS");
#ifdef EMU
#include <sched.h>
#define SPIN_WAIT(cond) do { while (!(cond)) sched_yield(); __sync_synchronize(); } while (0)
#define LDS_FENCE() __sync_synchronize()
#else
#define SPIN_WAIT(cond) do { while (!(cond)) __builtin_amdgcn_s_sleep(1); asm volatile("" ::: "memory"); } while (0)
#define LDS_FENCE() asm volatile("s_waitcnt lgkmcnt(0)" ::: "memory")
#endif
#ifdef EMU
DEVFN float wave_sum_fast(float v) { v = rowx_add<1>(v); v = rowx_add<2>(v); v = rowx_add<7>(v); v = rowx_add<15>(v); return (shfl_f(v, 0) + shfl_f(v, 16)) + (shfl_f(v, 32) + shfl_f(v, 48)); }
#else
DEVFN float wave_sum_fast(float v) { v = rowx_add<1>(v); v = rowx_add<2>(v); v = rowx_add<7>(v); v = rowx_add<15>(v);
    const int i_ = __builtin_bit_cast(int, v);
    return (__builtin_bit_cast(float, __builtin_amdgcn_readlane(i_, 0)) + __builtin_bit_cast(float, __builtin_amdgcn_readlane(i_, 16))) + (__builtin_bit_cast(float, __builtin_amdgcn_readlane(i_, 32)) + __builtin_bit_cast(float, __builtin_amdgcn_readlane(i_, 48))); }
#endif
DEVFN int rc_pos(int k) { return (k & 32) | (((k >> 2) & 3) << 3) | (((k >> 4) & 1) << 2) | (k & 3); }
DEVFN H8 h8_from(U4 w) { H8 r; H8_SET(r, 0, w.x & 0xffff); H8_SET(r, 1, w.x >> 16); H8_SET(r, 2, w.y & 0xffff); H8_SET(r, 3, w.y >> 16); H8_SET(r, 4, w.z & 0xffff); H8_SET(r, 5, w.z >> 16); H8_SET(r, 6, w.w & 0xffff); H8_SET(r, 7, w.w >> 16); return r; }
DEVFN H8 h8_lo4(U2 w) { H8 r; H8_SET(r, 0, w.x & 0xffff); H8_SET(r, 1, w.x >> 16); H8_SET(r, 2, w.y & 0xffff); H8_SET(r, 3, w.y >> 16); H8_SET(r, 4, 0); H8_SET(r, 5, 0); H8_SET(r, 6, 0); H8_SET(r, 7, 0); return r; }
DEVFN H8 h8_zero() { H8 r; UNR for (int j = 0; j < 8; ++j) H8_SET(r, j, 0); return r; }
DEVFN H8 h8_pack2(const A4& a, const A4& b) { H8 r; UNR for (int j = 0; j < 4; ++j) { H8_SET(r, j, f2bf(A4_GET(a, j))); H8_SET(r, 4 + j, f2bf(A4_GET(b, j))); } return r; }
DEVFN H8 h8_pack1(const A4& a) { H8 r; UNR for (int j = 0; j < 4; ++j) { H8_SET(r, j, f2bf(A4_GET(a, j))); H8_SET(r, 4 + j, 0); } return r; }
DEVFN A4 a4_zero() { A4 z; A4_GET(z, 0) = 0.f; A4_GET(z, 1) = 0.f; A4_GET(z, 2) = 0.f; A4_GET(z, 3) = 0.f; return z; }

DEVFN void rwkv_chunked(const Ctx& C, int i, int h, int d, int vh, bool ctx_out, unsigned char* lds, int max_chunks) {
    const int tid = C.tid, lane = tid & 63, wave = tid >> 6;
    volatile unsigned* fl_ready = (volatile unsigned*)(lds + RC_LDS_FLAGS); volatile unsigned* fl_done0 = fl_ready + 8; volatile unsigned* fl_done1 = fl_done0 + 8;
    if (tid < 24) fl_ready[tid] = 0u;
    { U4* sBF = (U4*)(lds + RC_LDS_BFR); const int m = tid >> 8, nt = (tid >> 6) & 3, ln = tid & 63;
      const float* src = (m == 0 ? C.in[I_WUP] : C.in[I_AUP]) + ((size_t)i * 2 + d) * 32 * 512 + 64 * h; float f[8];
      UNR for (int j = 0; j < 8; ++j) f[j] = src[(size_t)(8 * (ln >> 4) + j) * 512 + 16 * nt + (ln & 15)];
      sBF[tid] = pack8(f); }
    SYNC();
    const int nchunks = (NTOK / RC_T) < max_chunks ? (NTOK / RC_T) : max_chunks;
    bf16_t* Yd = (bf16_t*)(C.ws + (d == 0 ? WS_YF : WS_YB));
    #define RC_GEOM(ch, seg0, segn, R0) const bool isctx_ = (ch) < NCTX / RC_T; const int seg0 = isctx_ ? NLAT : 0, segn = isctx_ ? NCTX : NLAT; \
        const int cl_ = isctx_ ? (ch) : (ch) - NCTX / RC_T; const int R0 = d == 0 ? RC_T * cl_ : segn - RC_T * (cl_ + 1);
    if (wave < 2) {
        const int vt = wave, kg = lane >> 4, l15 = lane & 15;
        A4 H0_ = a4_zero(), H1_ = a4_zero(), H2_ = a4_zero(), H3_ = a4_zero();
        for (int ch = 0; ch < nchunks; ++ch) {
            const int slot = ch % RC_RING; const unsigned char* rb = lds + RC_LDS_RING + slot * RS_BYTES;
            SPIN_WAIT(fl_ready[slot] == (unsigned)(ch + 1));
            const H8 Hb0 = h8_pack2(H0_, H1_), Hb1 = h8_pack2(H2_, H3_);
            const H8 Vb = kg < 2 ? h8_from(ld16(rb + RS_VT + ((16 * vt + l15) * 16 + 8 * kg) * 2)) : h8_zero();
            const H8 kkd0 = h8_from(ld16(rb + RS_KKD + (l15 * 64 + 8 * kg) * 2)), kkd1 = h8_from(ld16(rb + RS_KKD + (l15 * 64 + 32 + 8 * kg) * 2));
            const H8 rd0 = h8_from(ld16(rb + RS_RD + (l15 * 64 + 8 * kg) * 2)), rd1 = h8_from(ld16(rb + RS_RD + (l15 * 64 + 32 + 8 * kg) * 2));
            const H8 p0f = kg < 2 ? h8_from(ld16(rb + RS_P0 + (l15 * 16 + 8 * kg) * 2)) : h8_zero();
            const H8 q1f = kg < 2 ? h8_from(ld16(rb + RS_Q1 + (l15 * 16 + 8 * kg) * 2)) : h8_zero();
            const H8 tf = h8_lo4(*(const U2*)(rb + RS_T + (l15 * 16 + 4 * kg) * 2)), nq2f = h8_lo4(*(const U2*)(rb + RS_NQ2 + (l15 * 16 + 4 * kg) * 2));
            A4 X = mfma16(kkd0, Hb0, a4_zero()); X = mfma16(kkd1, Hb1, X); X = mfma16(p0f, Vb, X);
            A4 Y = mfma16(rd0, Hb0, a4_zero()); Y = mfma16(rd1, Hb1, Y); Y = mfma16(q1f, Vb, Y);
            const H8 Xb = h8_pack1(X);
            const A4 U_ = mfma16(tf, Xb, a4_zero());
            const H8 Ub = h8_pack1(U_);
            Y = mfma16(nq2f, Ub, Y);
            #define HUPD(Hx, kt) do { const int kr = 16 * (kt) + l15; \
                const H8 kif = kg < 2 ? h8_from(ld16(rb + RS_KIT + (kr * 16 + 8 * kg) * 2)) : h8_zero(); const H8 nbf = h8_lo4(*(const U2*)(rb + RS_NBIT + (kr * 16 + 4 * kg) * 2)); \
                Hx = mfma16(kif, Vb, Hx); Hx = mfma16(nbf, Ub, Hx); const F4 g = *(const F4*)(rb + RS_GC + (16 * (kt) + 4 * kg) * 4); \
                A4_GET(Hx, 0) *= g.x; A4_GET(Hx, 1) *= g.y; A4_GET(Hx, 2) *= g.z; A4_GET(Hx, 3) *= g.w; } while (0)
            HUPD(H0_, 0); HUPD(H1_, 1); HUPD(H2_, 2); HUPD(H3_, 3);
            #undef HUPD
            LDS_FENCE(); WAVE_SYNC();
            if (lane == 0) { if (vt == 0) fl_done0[slot] = (unsigned)(ch + 1); else fl_done1[slot] = (unsigned)(ch + 1); }
            { RC_GEOM(ch, seg0, segn, R0)
              if (!isctx_ || ctx_out) { UNR for (int rg = 0; rg < 4; ++rg) { const int t = 4 * kg + rg, tl = d == 0 ? R0 + t : R0 + RC_T - 1 - t;
                  Yd[(size_t)(seg0 + tl) * 512 + 64 * h + 32 * vh + 16 * vt + l15] = (bf16_t)f2bf(A4_GET(Y, rg)); } } }
        }
    } else {
        const int p = wave - 2, k = lane;
        unsigned char* wsb = lds + RC_LDS_WAVE + p * RW_BYTES;
        bf16_t* sTDAD = (bf16_t*)(wsb + RW_TDAD); float* sWL = (float*)(wsb + RW_WL); float* sAL = (float*)(wsb + RW_AL); bf16_t* sKIP = (bf16_t*)(wsb + RW_KIP); bf16_t* sBIP = (bf16_t*)(wsb + RW_BIP); float* sAM = (float*)(wsb + RW_AM);
        const bf16_t* U = (const bf16_t*)(C.ws + WS_U);
        const float* mu = C.in[I_MU] + (size_t)i * 1664;
        const float mu_r = mu[64 * h + k], mu_k = mu[512 + 64 * h + k], mu_v = mu[1024 + 64 * h + k], mu_l = k < 32 ? mu[1536 + 32 * d + k] : mu[1600 + 32 * d + (k - 32)];
        const float c_w0 = C.in[I_W0][((size_t)i * 2 + d) * 512 + 64 * h + k], c_a0 = C.in[I_A0][((size_t)i * 2 + d) * 512 + 64 * h + k];
        const float c_kk = C.in[I_KK][(size_t)i * 512 + 64 * h + k], c_ka = C.in[I_KA][(size_t)i * 512 + 64 * h + k], c_rk = C.in[I_RK][(size_t)i * 512 + 64 * h + k];
        float* BON = (float*)(C.ws + WS_BONUS) + (size_t)d * NTOK * 8;
        const U4* sBF = (const U4*)(lds + RC_LDS_BFR);
        const int lcol = k < 32 ? 1536 + 32 * d + k : 1600 + 32 * d + (k - 32);
        const int kg = lane >> 4, l15 = lane & 15, pk_ = rc_pos(k);
        for (int ch = p; ch < nchunks; ch += RC_NPROD) {
            RC_GEOM(ch, seg0, segn, R0)
            float ur[18], uk[18], uv[18], ul[18];
            UNR for (int j = 0; j < 18; ++j) { const int row = d == 0 ? R0 - 1 + j : R0 + 16 - j; const bool ok = row >= 0 && row < segn; const bf16_t* up = U + (size_t)(seg0 + (ok ? row : R0)) * URW_W;
                const float m_ = ok ? 1.f : 0.f; ur[j] = m_ * bf2f(up[64 * h + k]); uk[j] = m_ * bf2f(up[512 + 64 * h + k]); uv[j] = m_ * bf2f(up[1024 + 64 * h + k]); ul[j] = m_ * bf2f(up[lcol]); }
            UNR for (int t = 0; t < 16; ++t) { const int j = t + 1; const float x = ul[j] + (0.5f * (ul[j - 1] + ul[j + 1]) - ul[j]) * mu_l;
                const float val = k < 32 ? 1.0f - 2.0f * FRCP(1.0f + FEXP(2.0f * x)) : x; sTDAD[t * 64 + k] = (bf16_t)f2bf(val); }
            WAVE_SYNC();
            {
                const H8 At = h8_from(ld16(sTDAD + l15 * 64 + 8 * kg)), Aa = h8_from(ld16(sTDAD + l15 * 64 + 32 + 8 * kg));
                A4 cw_[4], ca_[4];
                UNR for (int nt = 0; nt < 4; ++nt) { cw_[nt] = mfma16(At, h8_from(sBF[nt * 64 + lane]), a4_zero()); ca_[nt] = mfma16(Aa, h8_from(sBF[(4 + nt) * 64 + lane]), a4_zero()); }
                MFMA_PAD(cw_[0], cw_[1], cw_[2], cw_[3], ca_[0], ca_[1], ca_[2], ca_[3]);
                UNR for (int nt = 0; nt < 4; ++nt) UNR for (int rg = 0; rg < 4; ++rg) { sWL[(4 * kg + rg) * 64 + 16 * nt + l15] = A4_GET(cw_[nt], rg); sAL[(4 * kg + rg) * 64 + 16 * nt + l15] = A4_GET(ca_[nt], rg); }
            }
            WAVE_SYNC();
            float fr[16], fkd[16], fb[16], fkk[16], flw[16], fv[16];
            UNR for (int t = 0; t < 16; ++t) { const int j = t + 1;
                const float r_ = ur[j] + (0.5f * (ur[j - 1] + ur[j + 1]) - ur[j]) * mu_r, k_ = uk[j] + (0.5f * (uk[j - 1] + uk[j + 1]) - uk[j]) * mu_k, v_ = uv[j] + (0.5f * (uv[j - 1] + uv[j + 1]) - uv[j]) * mu_v;
                const float kkraw = k_ * c_kk; const float ss = wave_sum_fast(kkraw * kkraw); const float kk_ = kkraw * FRSQ(ss + 1e-12f);
                const float x = -(c_w0 + sWL[t * 64 + k]); const float sp_ = fmaxf(x, 0.f) + FLOG(1.0f + FEXP(-fabsf(x)));
                const float lw_ = -FEXP(-sp_ - 0.5f);
                const float a = FRCP(1.0f + FEXP(-(c_a0 + sAL[t * 64 + k])));
                const float kd_ = k_ * (1.0f + (a - 1.0f) * c_ka);
                fr[t] = r_; fkd[t] = kd_; fb[t] = kk_ * a; fkk[t] = kk_; flw[t] = lw_; fv[t] = v_;
                const float bon = wave_sum_fast(r_ * kd_ * c_rk);
                if (vh == 0 && lane == 0) { const int tl = d == 0 ? R0 + t : R0 + RC_T - 1 - t; BON[(size_t)(seg0 + tl) * 8 + h] = 0.5f * bon; }
            }
            WAVE_SYNC();
            const int slot = ch % RC_RING; unsigned char* rb = lds + RC_LDS_RING + slot * RS_BYTES;
            if (ch >= RC_RING) SPIN_WAIT(fl_done0[slot] == (unsigned)(ch - RC_RING + 1) && fl_done1[slot] == (unsigned)(ch - RC_RING + 1));
            {
                bf16_t* rKKD = (bf16_t*)(rb + RS_KKD); bf16_t* rRD = (bf16_t*)(rb + RS_RD); bf16_t* rKIT = (bf16_t*)(rb + RS_KIT); bf16_t* rNBIT = (bf16_t*)(rb + RS_NBIT); bf16_t* rVT = (bf16_t*)(rb + RS_VT);
                float L = 0.f, e_prev = 1.f;
                UNR for (int t = 0; t < 16; ++t) { L += flw[t]; const float e = FEXP(L), ei = FEXP(-L);
                    rKKD[t * 64 + pk_] = (bf16_t)f2bf(fkk[t] * e_prev); rRD[t * 64 + pk_] = (bf16_t)f2bf(fr[t] * e);
                    const float ki_ = fkd[t] * ei, bi_ = fb[t] * ei; sKIP[t * 64 + pk_] = (bf16_t)f2bf(ki_); sBIP[t * 64 + pk_] = (bf16_t)f2bf(bi_);
                    rKIT[k * 16 + t] = (bf16_t)f2bf(ki_); rNBIT[k * 16 + t] = (bf16_t)f2bf(-bi_);
                    e_prev = e; }
                ((float*)(rb + RS_GC))[k] = e_prev;
                U4 w0_, w1_;
                if ((k >> 5) == vh) { w0_.x = pk2(fv[0], fv[1]); w0_.y = pk2(fv[2], fv[3]); w0_.z = pk2(fv[4], fv[5]); w0_.w = pk2(fv[6], fv[7]); w1_.x = pk2(fv[8], fv[9]); w1_.y = pk2(fv[10], fv[11]); w1_.z = pk2(fv[12], fv[13]); w1_.w = pk2(fv[14], fv[15]);
                    st16(rVT + (k & 31) * 16, w0_); st16(rVT + (k & 31) * 16 + 8, w1_); }
            }
            WAVE_SYNC();
            {
                const bf16_t* rKKD = (const bf16_t*)(rb + RS_KKD); const bf16_t* rRD = (const bf16_t*)(rb + RS_RD);
                const H8 ak0 = h8_from(ld16(rKKD + l15 * 64 + 8 * kg)), ak1 = h8_from(ld16(rKKD + l15 * 64 + 32 + 8 * kg)), ar0 = h8_from(ld16(rRD + l15 * 64 + 8 * kg)), ar1 = h8_from(ld16(rRD + l15 * 64 + 32 + 8 * kg));
                const H8 bb0 = h8_from(ld16(sBIP + l15 * 64 + 8 * kg)), bb1 = h8_from(ld16(sBIP + l15 * 64 + 32 + 8 * kg)), bk0 = h8_from(ld16(sKIP + l15 * 64 + 8 * kg)), bk1 = h8_from(ld16(sKIP + l15 * 64 + 32 + 8 * kg));
                A4 mA = mfma16(ak0, bb0, a4_zero()); mA = mfma16(ak1, bb1, mA);
                A4 mP = mfma16(ak0, bk0, a4_zero()); mP = mfma16(ak1, bk1, mP);
                A4 mQ1 = mfma16(ar0, bk0, a4_zero()); mQ1 = mfma16(ar1, bk1, mQ1);
                A4 mQ2 = mfma16(ar0, bb0, a4_zero()); mQ2 = mfma16(ar1, bb1, mQ2);
                MFMA_PAD(mA, mP, mQ1, mQ2, mA, mP, mQ1, mQ2);
                bf16_t* rP0 = (bf16_t*)(rb + RS_P0); bf16_t* rQ1 = (bf16_t*)(rb + RS_Q1); bf16_t* rNQ2 = (bf16_t*)(rb + RS_NQ2);
                UNR for (int rg = 0; rg < 4; ++rg) { const int t = 4 * kg + rg, s_ = l15;
                    sAM[t * 16 + s_] = t > s_ ? A4_GET(mA, rg) : 0.f;
                    rP0[t * 16 + s_] = (bf16_t)f2bf(t > s_ ? A4_GET(mP, rg) : 0.f); rQ1[t * 16 + s_] = (bf16_t)f2bf(t >= s_ ? A4_GET(mQ1, rg) : 0.f); rNQ2[t * 16 + s_] = (bf16_t)f2bf(t >= s_ ? -A4_GET(mQ2, rg) : 0.f); }
            }
            WAVE_SYNC();
            {
                const int j = l15; float x[16]; bf16_t* rT = (bf16_t*)(rb + RS_T);
                UNR for (int t = 0; t < 16; ++t) { float acc = t == j ? 1.f : 0.f;
                    UNR for (int s_ = 0; s_ < 16; ++s_) if (s_ < t) acc -= sAM[t * 16 + s_] * x[s_];
                    x[t] = acc; if (lane < 16) rT[t * 16 + j] = (bf16_t)f2bf(acc); }
            }
            LDS_FENCE();
            WAVE_SYNC();
            if (lane == 0) fl_ready[slot] = (unsigned)(ch + 1);
        }
    }
    #undef RC_GEOM
    SYNC();
}
constexpr int FR_SLOTS = 20, FR_FLOATS = 6 * 2048, FR_LEAD = 20;
constexpr size_t WS_FRING = WS_HYOUT;
static_assert((size_t)16 * FR_SLOTS * FR_FLOATS * 4 <= (size_t)NLAT * 512 * 2, "feature ring fits");
constexpr size_t CTL_FFLAG = 65536, CTL_FPOS = CTL_FFLAG + 16 * 520 * 4 * 4;
constexpr int SC2_R = 8, SC2_NWG = 8;
static_assert(CTL_FPOS + 64 * 64 <= CTL_ZERO_BYTES, "control words");
#ifdef EMU
DEVFN unsigned gld_u32(const unsigned* p) { __sync_synchronize(); return *(volatile const unsigned*)p; }
DEVFN void gst_u32(unsigned* p, unsigned v) { __sync_synchronize(); *(volatile unsigned*)p = v; __sync_synchronize(); }
DEVFN unsigned long long gld_u64(const unsigned long long* p) { return *(volatile const unsigned long long*)p; }
DEVFN void gst_u64(unsigned long long* p, unsigned long long v) { *(volatile unsigned long long*)p = v; }
#define VM_DRAIN() __sync_synchronize()
#define GSPIN_WAIT(cond) do { while (!(cond)) sched_yield(); __sync_synchronize(); } while (0)
#else
DEVFN unsigned gld_u32(const unsigned* p) { return __hip_atomic_load(p, __ATOMIC_RELAXED, __HIP_MEMORY_SCOPE_AGENT); }
DEVFN void gst_u32(unsigned* p, unsigned v) { __hip_atomic_store(p, v, __ATOMIC_RELAXED, __HIP_MEMORY_SCOPE_AGENT); }
DEVFN unsigned long long gld_u64(const unsigned long long* p) { return __hip_atomic_load(p, __ATOMIC_RELAXED, __HIP_MEMORY_SCOPE_AGENT); }
DEVFN void gst_u64(unsigned long long* p, unsigned long long v) { __hip_atomic_store(p, v, __ATOMIC_RELAXED, __HIP_MEMORY_SCOPE_AGENT); }
#define VM_DRAIN() asm volatile("s_waitcnt vmcnt(0)" ::: "memory")
#define GSPIN_WAIT(cond) do { unsigned sp__ = 0; while (!(cond)) { __builtin_amdgcn_s_sleep(2); if (++sp__ > (1u << 22)) break; } asm volatile("" ::: "memory"); } while (0)
#endif
DEVFN unsigned long long f2_bits(float a, float b) { union { float f[2]; unsigned long long u; } x; x.f[0] = a; x.f[1] = b; return x.u; }

DEVFN void rwkv_scan2(const Ctx& C, int i, int h, int d, int rq, bool ctx_out, unsigned char* lds, int max_chunks) {
    const int tid = C.tid, lane = tid & 63, wave = C.wave;
    float* sBUF = (float*)lds;
    float* sWV = sBUF + 3 * SC_BUF;
    float* sCN = sWV + 4 * 1280;
    U4* sBF = (U4*)(sCN + 640);
    volatile unsigned* lf = (volatile unsigned*)((unsigned char*)sBF + 8192);
    const int hd = h * 2 + d;
    const unsigned epoch = (unsigned)(i + 1), pbase = (unsigned)i * 100000u;
    {
    const float* mu = C.in[I_MU] + (size_t)i * 1664;
    const float* w0 = C.in[I_W0] + ((size_t)i * 2 + d) * 512 + 64 * h; const float* a0 = C.in[I_A0] + ((size_t)i * 2 + d) * 512 + 64 * h;
    const float* wup = C.in[I_WUP] + ((size_t)i * 2 + d) * 32 * 512 + 64 * h; const float* aup = C.in[I_AUP] + ((size_t)i * 2 + d) * 32 * 512 + 64 * h;
    const float* k_k = C.in[I_KK] + (size_t)i * 512 + 64 * h; const float* k_a = C.in[I_KA] + (size_t)i * 512 + 64 * h; const float* r_k = C.in[I_RK] + (size_t)i * 512 + 64 * h;
    if (tid < 64) { const int j = tid; sCN[j] = mu[64 * h + j]; sCN[64 + j] = mu[512 + 64 * h + j]; sCN[128 + j] = mu[1024 + 64 * h + j]; sCN[192 + j] = w0[j]; sCN[256 + j] = a0[j];
        sCN[320 + j] = k_k[j]; sCN[384 + j] = k_a[j]; sCN[448 + j] = r_k[j]; sCN[512 + j] = j < 32 ? mu[1536 + 32 * d + j] : mu[1600 + 32 * d + (j - 32)]; }
    { const int m = tid >> 8, nt = (tid >> 6) & 3, ln = tid & 63; const float* src = m == 0 ? wup : aup; float f[8];
      UNR for (int j = 0; j < 8; ++j) f[j] = src[(size_t)(8 * (ln >> 4) + j) * 512 + 16 * nt + (ln & 15)];
      sBF[tid] = pack8(f); }
    }
    if (tid < 32) lf[tid] = 0u;
    SYNC();
    const int nchunks = NTOK / SC_T < max_chunks ? NTOK / SC_T : max_chunks;
    #define CHUNK_GEOM(ch, seg0, segn, R0) const bool isctx_ = (ch) < NCTX / SC_T; const int seg0 = isctx_ ? NLAT : 0, segn = isctx_ ? NCTX : NLAT; \
        const int cl_ = isctx_ ? (ch) : (ch) - NCTX / SC_T; const int R0 = d == 0 ? SC_T * cl_ : segn - SC_T * (cl_ + 1);
    if (wave < 2) {
        bf16_t* Yd = (bf16_t*)(C.ws + (d == 0 ? WS_YF : WS_YB));
        const int rl = tid >> 4, sp = tid & 15;
        float S0 = 0.f, S1 = 0.f, S2 = 0.f, S3 = 0.f;
        for (int ch = 0; ch < nchunks; ++ch) {
            const int b = ch % 3;
            SPIN_WAIT(lf[0 * 3 + b] == (unsigned)(ch + 1) && lf[1 * 3 + b] == (unsigned)(ch + 1));
            const float* B_ = sBUF + b * SC_BUF; const float* sV = B_ + 5 * SC_T * 64;
            float yk0 = 0.f, yk1 = 0.f, yp = 0.f;
#ifndef EMU
            {
                const unsigned ab = (unsigned)(uintptr_t)B_ + 16u * (unsigned)sp, av = (unsigned)(uintptr_t)sV + 4u * (unsigned)rl;
                P2 s01 = {S0, S1}, s23 = {S2, S3};
                asm volatile(SCAN_CHUNK_ASM : [s01] "+v"(s01), [s23] "+v"(s23), [yp] "+v"(yp), [yk0] "+v"(yk0), [yk1] "+v"(yk1) : [ab] "v"(ab), [av] "v"(av), [sp] "v"(sp) : SCAN_CHUNK_CLOBBERS);
                S0 = s01[0]; S1 = s01[1]; S2 = s23[0]; S3 = s23[1];
            }
#else
            { const float* sW = B_; const float* sKD = B_ + SC_T * 64; const float* sB = B_ + 2 * SC_T * 64; const float* sKK = B_ + 3 * SC_T * 64; const float* sR = B_ + 4 * SC_T * 64;
              for (int k = 0; k < SC_T; ++k) {
                const F4 kk4 = *(const F4*)(sKK + k * 64 + 4 * sp), w4 = *(const F4*)(sW + k * 64 + 4 * sp), b4 = *(const F4*)(sB + k * 64 + 4 * sp),
                         kd4 = *(const F4*)(sKD + k * 64 + 4 * sp), r4 = *(const F4*)(sR + k * 64 + 4 * sp);
                const float vi = sV[k * SC_R + rl];
                float sa = (S0 * kk4.x + S2 * kk4.z) + (S1 * kk4.y + S3 * kk4.w);
                const float t0 = S0 * w4.x + vi * kd4.x, t1 = S1 * w4.y + vi * kd4.y, t2 = S2 * w4.z + vi * kd4.z, t3 = S3 * w4.w + vi * kd4.w;
                sa = rowx_add<1>(sa); yp = rowx_add<1>(yp); sa = rowx_add<2>(sa); yp = rowx_add<2>(yp);
                sa = rowx_add<7>(sa); yp = rowx_add<7>(yp); sa = rowx_add<15>(sa); yp = rowx_add<15>(yp);
                if (sp == ((k + 15) & 15)) { if (k <= 16) yk0 = yp; else yk1 = yp; }
                S0 = t0 - sa * b4.x; S1 = t1 - sa * b4.y; S2 = t2 - sa * b4.z; S3 = t3 - sa * b4.w;
                yp = (S0 * r4.x + S2 * r4.z) + (S1 * r4.y + S3 * r4.w);
              } }
#endif
            LDS_FENCE(); WAVE_SYNC();
            if (lane == 0) lf[8 + wave * 3 + b] = (unsigned)(ch + 1);
            yp = rowx_add<1>(yp); yp = rowx_add<2>(yp); yp = rowx_add<7>(yp); yp = rowx_add<15>(yp);
            if (sp == 15) yk1 = yp;
            { CHUNK_GEOM(ch, seg0, segn, R0)
              if (!isctx_ || ctx_out) { const int t0 = d == 0 ? R0 + sp : R0 + SC_T - 1 - sp, t1 = d == 0 ? R0 + sp + 16 : R0 + SC_T - 1 - (sp + 16);
                  Yd[(size_t)(seg0 + t0) * 512 + 64 * h + SC2_R * rq + rl] = (bf16_t)f2bf(yk0); Yd[(size_t)(seg0 + t1) * 512 + 64 * h + SC2_R * rq + rl] = (bf16_t)f2bf(yk1); } }
        }
    } else if (wave < 6) {
        const int p = wave - 2;
        const bf16_t* U = (const bf16_t*)(C.ws + WS_U); float* BON = (float*)(C.ws + WS_BONUS) + (size_t)d * NTOK * 8;
        float* RING = (float*)(C.ws + WS_FRING) + (size_t)hd * FR_SLOTS * FR_FLOATS; unsigned* FFLAG = (unsigned*)(C.ws + WS_CTL + CTL_FFLAG) + (size_t)hd * 520 * 4; unsigned* FPOS = (unsigned*)(C.ws + WS_CTL + CTL_FPOS) + (size_t)hd * 64;
        float* myWV = sWV + p * 1280; float* sWL = myWV; float* sAL = myWV + 512; bf16_t* sTDb = (bf16_t*)(myWV + 1024); bf16_t* sADb = sTDb + 256;
        const int fp = lane & 7, tw = lane >> 3;
        const float* mu_r = sCN + 8 * fp; const float* mu_k = sCN + 64 + 8 * fp; const float* mu_v = sCN + 128 + 8 * fp; const float* c_w0 = sCN + 192 + 8 * fp; const float* c_a0 = sCN + 256 + 8 * fp;
        const float* c_kk = sCN + 320 + 8 * fp; const float* c_ka = sCN + 384 + 8 * fp; const float* c_rk = sCN + 448 + 8 * fp; const float* mu_w = sCN + 512 + 4 * fp; const float* mu_a = sCN + 544 + 4 * fp;
        U4 pu[9]; U2 pw[6];
        auto issue = [&](int q) {
            const int ch = rq + SC2_NWG * q; if (ch >= nchunks) return;
            CHUNK_GEOM(ch, seg0, segn, R0)
            const int ft = 8 * p + tw, tl = d == 0 ? R0 + ft : R0 + SC_T - 1 - ft;
            const bf16_t* u0p = U + (size_t)(seg0 + tl) * URW_W; const bool hm = tl > 0, hp = tl < segn - 1;
            const U4 z4 = {0u, 0u, 0u, 0u}; const U2 z2 = {0u, 0u};
            const int cw = 1536 + 32 * d + 4 * fp, ca = 1600 + 32 * d + 4 * fp;
            UNR for (int j = 0; j < 3; ++j) { pu[3 * j] = ld16(u0p + 512 * j + 64 * h + 8 * fp); pu[3 * j + 1] = z4; pu[3 * j + 2] = z4; }
            pw[0] = *(const U2*)(u0p + cw); pw[3] = *(const U2*)(u0p + ca); pw[1] = z2; pw[2] = z2; pw[4] = z2; pw[5] = z2;
            if (hm) { UNR for (int j = 0; j < 3; ++j) pu[3 * j + 1] = ld16(u0p - URW_W + 512 * j + 64 * h + 8 * fp); pw[1] = *(const U2*)(u0p - URW_W + cw); pw[4] = *(const U2*)(u0p - URW_W + ca); }
            if (hp) { UNR for (int j = 0; j < 3; ++j) pu[3 * j + 2] = ld16(u0p + URW_W + 512 * j + 64 * h + 8 * fp); pw[2] = *(const U2*)(u0p + URW_W + cw); pw[5] = *(const U2*)(u0p + URW_W + ca); }
        };
        issue(0);
        const int npass = (nchunks - rq + SC2_NWG - 1) / SC2_NWG;
        for (int q = 0; q < npass; ++q) {
            const int ch = rq + SC2_NWG * q;
            if (ch >= FR_SLOTS) { const unsigned need = pbase + (unsigned)(ch - FR_SLOTS + 1);
                GSPIN_WAIT(gld_u32(FPOS + 0) >= need && gld_u32(FPOS + 8) >= need && gld_u32(FPOS + 16) >= need && gld_u32(FPOS + 24) >= need && gld_u32(FPOS + 32) >= need && gld_u32(FPOS + 40) >= need && gld_u32(FPOS + 48) >= need && gld_u32(FPOS + 56) >= need); }
            CHUNK_GEOM(ch, seg0, segn, R0)
            float* rec = RING + (size_t)(ch % FR_SLOTS) * FR_FLOATS;
            {
                const int ft = 8 * p + tw;
                const int tl = d == 0 ? R0 + ft : R0 + SC_T - 1 - ft;
                float r[8], k[8], v[8];
                {
                    float a[8], m[8], qq[8];
                    #define SHIFT3(J, MU, OUT) do { unpack8(pu[3 * (J)], a); unpack8(pu[3 * (J) + 1], m); unpack8(pu[3 * (J) + 2], qq); \
                        UNR for (int e = 0; e < 8; ++e) OUT[e] = a[e] + (0.5f * (m[e] + qq[e]) - a[e]) * MU[e]; } while (0)
                    SHIFT3(0, mu_r, r); SHIFT3(1, mu_k, k); SHIFT3(2, mu_v, v);
                    #undef SHIFT3
                }
                {
                    const U2 w0_ = pw[0], wm = pw[1], wp = pw[2], a0_ = pw[3], am = pw[4], ap = pw[5];
                    const float wa[4] = {bflo(w0_.x), bfhi(w0_.x), bflo(w0_.y), bfhi(w0_.y)}, wmm[4] = {bflo(wm.x), bfhi(wm.x), bflo(wm.y), bfhi(wm.y)}, wpp[4] = {bflo(wp.x), bfhi(wp.x), bflo(wp.y), bfhi(wp.y)};
                    const float aa[4] = {bflo(a0_.x), bfhi(a0_.x), bflo(a0_.y), bfhi(a0_.y)}, amm[4] = {bflo(am.x), bfhi(am.x), bflo(am.y), bfhi(am.y)}, app[4] = {bflo(ap.x), bfhi(ap.x), bflo(ap.y), bfhi(ap.y)};
                    issue(q + 1);
                    float tdv[4], adv[4];
                    UNR for (int e = 0; e < 4; ++e) { const float x = wa[e] + (0.5f * (wmm[e] + wpp[e]) - wa[e]) * mu_w[e];
                        tdv[e] = 1.0f - 2.0f * FRCP(1.0f + FEXP(2.0f * x));
                        adv[e] = aa[e] + (0.5f * (amm[e] + app[e]) - aa[e]) * mu_a[e]; }
                    U2 tq, aq; tq.x = pk2(tdv[0], tdv[1]); tq.y = pk2(tdv[2], tdv[3]); aq.x = pk2(adv[0], adv[1]); aq.y = pk2(adv[2], adv[3]);
                    *(U2*)(sTDb + tw * 32 + 4 * fp) = tq; *(U2*)(sADb + tw * 32 + 4 * fp) = aq;
                }
                WAVE_SYNC();
                float wl[8], al[8];
                {
                    const int arow = lane & 7, kg = lane >> 4;
                    const H8 At = h8_from_u4(ld16(sTDb + arow * 32 + 8 * kg)), Aa = h8_from_u4(ld16(sADb + arow * 32 + 8 * kg));
                    A4 cw_[4], ca_[4];
                    UNR for (int nt = 0; nt < 4; ++nt) { A4 z; A4_GET(z, 0) = 0.f; A4_GET(z, 1) = 0.f; A4_GET(z, 2) = 0.f; A4_GET(z, 3) = 0.f;
                        cw_[nt] = mfma16(At, h8_from_u4(sBF[nt * 64 + lane]), z); ca_[nt] = mfma16(Aa, h8_from_u4(sBF[(4 + nt) * 64 + lane]), z); }
                    MFMA_PAD(cw_[0], cw_[1], cw_[2], cw_[3], ca_[0], ca_[1], ca_[2], ca_[3]);
                    if (lane < 32) { UNR for (int nt = 0; nt < 4; ++nt) UNR for (int rg = 0; rg < 4; ++rg) { const int tok = 4 * (lane >> 4) + rg; sWL[tok * 64 + 16 * nt + (lane & 15)] = A4_GET(cw_[nt], rg); sAL[tok * 64 + 16 * nt + (lane & 15)] = A4_GET(ca_[nt], rg); } }
                    WAVE_SYNC();
                    UNR for (int e = 0; e < 8; ++e) { wl[e] = c_w0[e] + sWL[tw * 64 + 8 * fp + e]; al[e] = c_a0[e] + sAL[tw * 64 + 8 * fp + e]; }
                    WAVE_SYNC();
                }
                float kkv[8], ssq = 0.f;
                UNR for (int e = 0; e < 8; ++e) { kkv[e] = k[e] * c_kk[e]; ssq += kkv[e] * kkv[e]; }
                ssq = rowx_add<1>(ssq); ssq = rowx_add<2>(ssq); ssq = rowx_add<7>(ssq);
                const float kn = FRSQ(ssq + 1e-12f);
                float bon = 0.f; float o_w[8], o_kd[8], o_b[8], o_kk[8];
                UNR for (int e = 0; e < 8; ++e) {
                    const float dec = FEXP(-0.60653066f * FRCP(1.0f + FEXP(-wl[e])));
                    const float a = FRCP(1.0f + FEXP(-al[e]));
                    const float kd = k[e] * (1.0f + (a - 1.0f) * c_ka[e]);
                    const float kk = kkv[e] * kn;
                    o_w[e] = dec; o_kd[e] = kd; o_b[e] = kk * a; o_kk[e] = kk;
                    bon += r[e] * kd * c_rk[e];
                }
                { unsigned long long* rp = (unsigned long long*)(rec + ft * 64 + 8 * fp);
                  #define ST8(AR, A) do { UNR for (int e2 = 0; e2 < 4; ++e2) gst_u64(rp + (AR) * 1024 + e2, f2_bits(A[2 * e2], A[2 * e2 + 1])); } while (0)
                  ST8(0, o_w); ST8(1, o_kd); ST8(2, o_b); ST8(3, o_kk); ST8(4, r); ST8(5, v);
                  #undef ST8
                }
                bon = rowx_add<1>(bon); bon = rowx_add<2>(bon); bon = rowx_add<7>(bon);
                if (fp == 0) BON[(size_t)(seg0 + tl) * 8 + h] = 0.5f * bon;
            }
            VM_DRAIN(); if (lane == 0) gst_u32(FFLAG + (size_t)ch * 4 + p, epoch);
        }
    } else {
        const int w = wave - 6;
        const float* RING = (const float*)(C.ws + WS_FRING) + (size_t)hd * FR_SLOTS * FR_FLOATS; unsigned* FFLAG = (unsigned*)(C.ws + WS_CTL + CTL_FFLAG) + (size_t)hd * 520 * 4; unsigned* FPOS = (unsigned*)(C.ws + WS_CTL + CTL_FPOS) + (size_t)hd * 64;
        for (int ch = 0; ch < nchunks; ++ch) {
            const int b = ch % 3;
            if (ch >= 3) SPIN_WAIT(lf[8 + 0 * 3 + b] == (unsigned)(ch - 2) && lf[8 + 1 * 3 + b] == (unsigned)(ch - 2));
            GSPIN_WAIT(gld_u32(FFLAG + (size_t)ch * 4) == epoch && gld_u32(FFLAG + (size_t)ch * 4 + 1) == epoch && gld_u32(FFLAG + (size_t)ch * 4 + 2) == epoch && gld_u32(FFLAG + (size_t)ch * 4 + 3) == epoch);
            const unsigned long long* rec = (const unsigned long long*)(RING + (size_t)(ch % FR_SLOTS) * FR_FLOATS);
            float* B_ = sBUF + b * SC_BUF;
            { unsigned long long x[40], xv[2];
              UNR for (int j = 0; j < 40; ++j) x[j] = gld_u64(rec + (size_t)w * 2560 + j * 64 + lane);
              { const int idx = w * 64 + lane, tok = idx >> 2, c2 = idx & 3; xv[0] = gld_u64(rec + 5 * 1024 + tok * 32 + 4 * rq + c2); xv[1] = 0ull; }
              UNR for (int j = 0; j < 40; ++j) ((unsigned long long*)B_)[(size_t)w * 2560 + j * 64 + lane] = x[j];
              { const int idx = w * 64 + lane, tok = idx >> 2, c2 = idx & 3; ((unsigned long long*)(B_ + 5 * SC_T * 64))[tok * 8 + c2] = xv[0]; } }
            LDS_FENCE(); WAVE_SYNC();
            if (lane == 0) { lf[w * 3 + b] = (unsigned)(ch + 1); if (w == 0) gst_u32(FPOS + 8 * rq, pbase + (unsigned)(ch + 1)); }
        }
    }
    #undef CHUNK_GEOM
    SYNC();
}
constexpr int R2S_KKD = 0, R2S_RD = 2048, R2S_KIT = 4096, R2S_NBIT = 6144, R2S_VT = 8192, R2S_T = 10240, R2S_P0 = 10752, R2S_Q1 = 11264, R2S_NQ2 = 11776, R2S_GC = 12288, R2S_BYTES = 12544, R2S_U64 = R2S_BYTES / 8;
constexpr int PW_TDAD = 0, PW_AM = 0, PW_WL = 2048, PW_AL = 6144, PW_REC = 2048, PW_KIP = PW_REC + R2S_BYTES, PW_BIP = PW_KIP + 2048, PW_BYTES = PW_BIP + 2048;
static_assert(8 * PW_BYTES <= RING_BYTES, "producer LDS");
constexpr int R2_GSLOTS = 64, R2_LSLOTS = 8, R2_NCH = NTOK / RC_T;
constexpr size_t WS_R2RING = WS_HYOUT;
static_assert((size_t)16 * R2_GSLOTS * R2S_BYTES <= (size_t)NLAT * 512 * 2, "record ring fits");
constexpr size_t CTL_R2FLAG = 65536, CTL_R2POS = CTL_R2FLAG + (size_t)16 * R2_NCH * 4;
static_assert(CTL_R2POS + 16 * 64 <= CTL_ZERO_BYTES, "control words");
constexpr size_t WS_BFRAG = WS_VXC + 1536 * 1024;
static_assert(WS_BFRAG + 2 * 16 * 8 * 64 * 16 <= WS_HID, "bfrag");

DEVFN void r2_build_bfrag(const Ctx& C) {
    const int gtid = (C.vcu * NWAVES + C.wave) * 64 + C.lane, gn = C.G * NTHREADS;
    for (int e = gtid; e < 2 * 16 * 8 * 64; e += gn) { const int ln = e & 63, nt = (e >> 6) & 3, m = (e >> 8) & 1, hd = (e >> 9) & 15, i = e >> 13; const int h = hd >> 1, d = hd & 1;
        const float* src = (m == 0 ? C.in[I_WUP] : C.in[I_AUP]) + ((size_t)i * 2 + d) * 32 * 512 + 64 * h; float f[8];
        UNR for (int j = 0; j < 8; ++j) f[j] = src[(size_t)(8 * (ln >> 4) + j) * 512 + 16 * nt + (ln & 15)];
        ((U4*)(C.ws + WS_BFRAG))[e] = pack8(f); }
}

DEVFN void rc2_producer(const Ctx& C, int i, unsigned char* lds, int pw, int npw, int hd0, int nhd, int max_chunks) {
    const int lane = C.lane, k = lane, kg = lane >> 4, l15 = lane & 15, pk_ = rc_pos(k);
    unsigned char* wsb = lds + C.wave * PW_BYTES;
    bf16_t* sTDAD = (bf16_t*)(wsb + PW_TDAD); float* sWL = (float*)(wsb + PW_WL); float* sAL = (float*)(wsb + PW_AL); bf16_t* sKIP = (bf16_t*)(wsb + PW_KIP); bf16_t* sBIP = (bf16_t*)(wsb + PW_BIP); float* sAM = (float*)(wsb + PW_AM);
    const bf16_t* U = (const bf16_t*)(C.ws + WS_U);
    const unsigned epoch = (unsigned)(i + 1), pbase = (unsigned)i * 100000u;
    const int nchunks = R2_NCH < max_chunks ? R2_NCH : max_chunks;
    const int nitems = nchunks * nhd;
    for (int item = pw; item < nitems; item += npw) {
        const int ch = item / nhd, hd = hd0 + item % nhd, h = hd >> 1, d = hd & 1;
        unsigned* POS = (unsigned*)(C.ws + WS_CTL + CTL_R2POS) + 16 * hd;
        if (ch >= R2_GSLOTS) { const int ow = ((ch - R2_GSLOTS) & 3); GSPIN_WAIT(gld_u32(POS + 1 + ow) >= pbase + (unsigned)(ch - R2_GSLOTS + 1)); }
        const float* mu = C.in[I_MU] + (size_t)i * 1664;
        const float mu_r = mu[64 * h + k], mu_k = mu[512 + 64 * h + k], mu_v = mu[1024 + 64 * h + k], mu_l = k < 32 ? mu[1536 + 32 * d + k] : mu[1600 + 32 * d + (k - 32)];
        const float c_w0 = C.in[I_W0][((size_t)i * 2 + d) * 512 + 64 * h + k], c_a0 = C.in[I_A0][((size_t)i * 2 + d) * 512 + 64 * h + k];
        const float c_kk = C.in[I_KK][(size_t)i * 512 + 64 * h + k], c_ka = C.in[I_KA][(size_t)i * 512 + 64 * h + k], c_rk = C.in[I_RK][(size_t)i * 512 + 64 * h + k];
        float* BON = (float*)(C.ws + WS_BONUS) + (size_t)d * NTOK * 8;
        const int lcol = k < 32 ? 1536 + 32 * d + k : 1600 + 32 * d + (k - 32);
        U4 bfw[4], bfa[4];
        { const U4* bt = (const U4*)(C.ws + WS_BFRAG) + ((size_t)i * 16 + hd) * 512; UNR for (int nt = 0; nt < 4; ++nt) { bfw[nt] = bt[nt * 64 + lane]; bfa[nt] = bt[(4 + nt) * 64 + lane]; } }
        const bool isctx_ = ch < NCTX / RC_T; const int seg0 = isctx_ ? NLAT : 0, segn = isctx_ ? NCTX : NLAT; const int cl_ = isctx_ ? ch : ch - NCTX / RC_T; const int R0 = d == 0 ? RC_T * cl_ : segn - RC_T * (cl_ + 1);
        {
            float ur[18], uk[18], uv[18], ul[18];
            UNR for (int j = 0; j < 18; ++j) { const int row = d == 0 ? R0 - 1 + j : R0 + 16 - j; const bool ok = row >= 0 && row < segn; const bf16_t* up = U + (size_t)(seg0 + (ok ? row : R0)) * URW_W;
                const float m_ = ok ? 1.f : 0.f; ur[j] = m_ * bf2f(up[64 * h + k]); uk[j] = m_ * bf2f(up[512 + 64 * h + k]); uv[j] = m_ * bf2f(up[1024 + 64 * h + k]); ul[j] = m_ * bf2f(up[lcol]); }
            UNR for (int t = 0; t < 16; ++t) { const int j = t + 1; const float x = ul[j] + (0.5f * (ul[j - 1] + ul[j + 1]) - ul[j]) * mu_l;
                const float val = k < 32 ? 1.0f - 2.0f * FRCP(1.0f + FEXP(2.0f * x)) : x; sTDAD[t * 64 + k] = (bf16_t)f2bf(val); }
            WAVE_SYNC();
            {
                const H8 At = h8_from(ld16(sTDAD + l15 * 64 + 8 * kg)), Aa = h8_from(ld16(sTDAD + l15 * 64 + 32 + 8 * kg));
                A4 cw_[4], ca_[4];
                UNR for (int nt = 0; nt < 4; ++nt) { cw_[nt] = mfma16(At, h8_from(bfw[nt]), a4_zero()); ca_[nt] = mfma16(Aa, h8_from(bfa[nt]), a4_zero()); }
                MFMA_PAD(cw_[0], cw_[1], cw_[2], cw_[3], ca_[0], ca_[1], ca_[2], ca_[3]);
                UNR for (int nt = 0; nt < 4; ++nt) UNR for (int rg = 0; rg < 4; ++rg) { sWL[(4 * kg + rg) * 64 + 16 * nt + l15] = A4_GET(cw_[nt], rg); sAL[(4 * kg + rg) * 64 + 16 * nt + l15] = A4_GET(ca_[nt], rg); }
            }
            WAVE_SYNC();
            float fr[16], fkd[16], fb[16], fkk[16], flw[16], fv[16];
            UNR for (int t = 0; t < 16; ++t) { const int j = t + 1;
                const float r_ = ur[j] + (0.5f * (ur[j - 1] + ur[j + 1]) - ur[j]) * mu_r, k_ = uk[j] + (0.5f * (uk[j - 1] + uk[j + 1]) - uk[j]) * mu_k, v_ = uv[j] + (0.5f * (uv[j - 1] + uv[j + 1]) - uv[j]) * mu_v;
                const float kkraw = k_ * c_kk; const float ss = wave_sum_fast(kkraw * kkraw); const float kk_ = kkraw * FRSQ(ss + 1e-12f);
                const float x = -(c_w0 + sWL[t * 64 + k]); const float sp_ = fmaxf(x, 0.f) + FLOG(1.0f + FEXP(-fabsf(x)));
                const float lw_ = -FEXP(-sp_ - 0.5f);
                const float a = FRCP(1.0f + FEXP(-(c_a0 + sAL[t * 64 + k])));
                const float kd_ = k_ * (1.0f + (a - 1.0f) * c_ka);
                fr[t] = r_; fkd[t] = kd_; fb[t] = kk_ * a; fkk[t] = kk_; flw[t] = lw_; fv[t] = v_;
                const float bon = wave_sum_fast(r_ * kd_ * c_rk);
                if (lane == 0) { const int tl = d == 0 ? R0 + t : R0 + RC_T - 1 - t; BON[(size_t)(seg0 + tl) * 8 + h] = 0.5f * bon; }
            }
            WAVE_SYNC();
            unsigned char* rb = wsb + PW_REC;
            {
                bf16_t* rKKD = (bf16_t*)(rb + R2S_KKD); bf16_t* rRD = (bf16_t*)(rb + R2S_RD); bf16_t* rKIT = (bf16_t*)(rb + R2S_KIT); bf16_t* rNBIT = (bf16_t*)(rb + R2S_NBIT); bf16_t* rVT = (bf16_t*)(rb + R2S_VT);
                float L = 0.f, e_prev = 1.f;
                UNR for (int t = 0; t < 16; ++t) { L += flw[t]; const float e = FEXP(L), ei = FEXP(-L);
                    rKKD[t * 64 + pk_] = (bf16_t)f2bf(fkk[t] * e_prev); rRD[t * 64 + pk_] = (bf16_t)f2bf(fr[t] * e);
                    const float ki_ = fkd[t] * ei, bi_ = fb[t] * ei; sKIP[t * 64 + pk_] = (bf16_t)f2bf(ki_); sBIP[t * 64 + pk_] = (bf16_t)f2bf(bi_);
                    rKIT[k * 16 + t] = (bf16_t)f2bf(ki_); rNBIT[k * 16 + t] = (bf16_t)f2bf(-bi_);
                    e_prev = e; }
                ((float*)(rb + R2S_GC))[k] = e_prev;
                U4 w0_, w1_;
                { w0_.x = pk2(fv[0], fv[1]); w0_.y = pk2(fv[2], fv[3]); w0_.z = pk2(fv[4], fv[5]); w0_.w = pk2(fv[6], fv[7]); w1_.x = pk2(fv[8], fv[9]); w1_.y = pk2(fv[10], fv[11]); w1_.z = pk2(fv[12], fv[13]); w1_.w = pk2(fv[14], fv[15]);
                    st16(rVT + k * 16, w0_); st16(rVT + k * 16 + 8, w1_); }
            }
            WAVE_SYNC();
            {
                const bf16_t* rKKD = (const bf16_t*)(rb + R2S_KKD); const bf16_t* rRD = (const bf16_t*)(rb + R2S_RD);
                const H8 ak0 = h8_from(ld16(rKKD + l15 * 64 + 8 * kg)), ak1 = h8_from(ld16(rKKD + l15 * 64 + 32 + 8 * kg)), ar0 = h8_from(ld16(rRD + l15 * 64 + 8 * kg)), ar1 = h8_from(ld16(rRD + l15 * 64 + 32 + 8 * kg));
                const H8 bb0 = h8_from(ld16(sBIP + l15 * 64 + 8 * kg)), bb1 = h8_from(ld16(sBIP + l15 * 64 + 32 + 8 * kg)), bk0 = h8_from(ld16(sKIP + l15 * 64 + 8 * kg)), bk1 = h8_from(ld16(sKIP + l15 * 64 + 32 + 8 * kg));
                A4 mA = mfma16(ak0, bb0, a4_zero()); mA = mfma16(ak1, bb1, mA);
                A4 mP = mfma16(ak0, bk0, a4_zero()); mP = mfma16(ak1, bk1, mP);
                A4 mQ1 = mfma16(ar0, bk0, a4_zero()); mQ1 = mfma16(ar1, bk1, mQ1);
                A4 mQ2 = mfma16(ar0, bb0, a4_zero()); mQ2 = mfma16(ar1, bb1, mQ2);
                MFMA_PAD(mA, mP, mQ1, mQ2, mA, mP, mQ1, mQ2);
                bf16_t* rP0 = (bf16_t*)(rb + R2S_P0); bf16_t* rQ1 = (bf16_t*)(rb + R2S_Q1); bf16_t* rNQ2 = (bf16_t*)(rb + R2S_NQ2);
                UNR for (int rg = 0; rg < 4; ++rg) { const int t = 4 * kg + rg, s_ = l15;
                    sAM[t * 16 + s_] = t > s_ ? A4_GET(mA, rg) : 0.f;
                    rP0[t * 16 + s_] = (bf16_t)f2bf(t > s_ ? A4_GET(mP, rg) : 0.f); rQ1[t * 16 + s_] = (bf16_t)f2bf(t >= s_ ? A4_GET(mQ1, rg) : 0.f); rNQ2[t * 16 + s_] = (bf16_t)f2bf(t >= s_ ? -A4_GET(mQ2, rg) : 0.f); }
            }
            WAVE_SYNC();
            {
                const int j = l15; float x[16]; bf16_t* rT = (bf16_t*)(rb + R2S_T);
                UNR for (int t = 0; t < 16; ++t) { float acc = t == j ? 1.f : 0.f;
                    UNR for (int s_ = 0; s_ < 16; ++s_) if (s_ < t) acc -= sAM[t * 16 + s_] * x[s_];
                    x[t] = acc; if (lane < 16) rT[t * 16 + j] = (bf16_t)f2bf(acc); }
            }
            LDS_FENCE();
            WAVE_SYNC();
            { const unsigned long long* st = (const unsigned long long*)(wsb + PW_REC); unsigned long long* gr = (unsigned long long*)(C.ws + WS_R2RING) + ((size_t)hd * R2_GSLOTS + (ch % R2_GSLOTS)) * R2S_U64;
              UNR for (int j = 0; j < 25; ++j) { const int idx = j * 64 + lane; if (idx < R2S_U64) gst_u64(gr + idx, st[idx]); } }
            VM_DRAIN(); WAVE_SYNC();
            if (lane == 0) gst_u32((unsigned*)(C.ws + WS_CTL + CTL_R2FLAG) + (size_t)hd * R2_NCH + ch, epoch);
            WAVE_SYNC();
        }
    }
}

DEVFN void rc2_chain(const Ctx& C, int i, int hd, bool ctx_out, unsigned char* lds, int max_chunks) {
    const int tid = C.tid, lane = tid & 63, wave = C.wave, h = hd >> 1, d = hd & 1;
    volatile unsigned* lf = (volatile unsigned*)(lds + R2_LSLOTS * R2S_BYTES);
    if (tid < 64) lf[tid] = 0u;
    SYNC();
    const int nchunks = R2_NCH < max_chunks ? R2_NCH : max_chunks;
    const unsigned epoch = (unsigned)(i + 1), pbase = (unsigned)i * 100000u;
    #define RC_GEOM(ch, seg0, segn, R0) const bool isctx_ = (ch) < NCTX / RC_T; const int seg0 = isctx_ ? NLAT : 0, segn = isctx_ ? NCTX : NLAT; \
        const int cl_ = isctx_ ? (ch) : (ch) - NCTX / RC_T; const int R0 = d == 0 ? RC_T * cl_ : segn - RC_T * (cl_ + 1);
    if (wave < 4) {
        bf16_t* Yd = (bf16_t*)(C.ws + (d == 0 ? WS_YF : WS_YB));
        const int vt = wave, kg = lane >> 4, l15 = lane & 15;
        A4 H0_ = a4_zero(), H1_ = a4_zero(), H2_ = a4_zero(), H3_ = a4_zero();
        for (int ch = 0; ch < nchunks; ++ch) {
            const int slot = ch % R2_LSLOTS; const unsigned char* rb = lds + slot * R2S_BYTES;
            SPIN_WAIT(lf[slot] == (unsigned)(ch + 1));
            const H8 Hb0 = h8_pack2(H0_, H1_), Hb1 = h8_pack2(H2_, H3_);
            const H8 Vb = kg < 2 ? h8_from(ld16(rb + R2S_VT + ((16 * vt + l15) * 16 + 8 * kg) * 2)) : h8_zero();
            const H8 kkd0 = h8_from(ld16(rb + R2S_KKD + (l15 * 64 + 8 * kg) * 2)), kkd1 = h8_from(ld16(rb + R2S_KKD + (l15 * 64 + 32 + 8 * kg) * 2));
            const H8 rd0 = h8_from(ld16(rb + R2S_RD + (l15 * 64 + 8 * kg) * 2)), rd1 = h8_from(ld16(rb + R2S_RD + (l15 * 64 + 32 + 8 * kg) * 2));
            const H8 p0f = kg < 2 ? h8_from(ld16(rb + R2S_P0 + (l15 * 16 + 8 * kg) * 2)) : h8_zero();
            const H8 q1f = kg < 2 ? h8_from(ld16(rb + R2S_Q1 + (l15 * 16 + 8 * kg) * 2)) : h8_zero();
            const H8 tf = h8_lo4(*(const U2*)(rb + R2S_T + (l15 * 16 + 4 * kg) * 2)), nq2f = h8_lo4(*(const U2*)(rb + R2S_NQ2 + (l15 * 16 + 4 * kg) * 2));
            A4 X = mfma16(kkd0, Hb0, a4_zero()); X = mfma16(kkd1, Hb1, X); X = mfma16(p0f, Vb, X);
            A4 Y = mfma16(rd0, Hb0, a4_zero()); Y = mfma16(rd1, Hb1, Y); Y = mfma16(q1f, Vb, Y);
            const H8 Xb = h8_pack1(X);
            const A4 U_ = mfma16(tf, Xb, a4_zero());
            const H8 Ub = h8_pack1(U_);
            Y = mfma16(nq2f, Ub, Y);
            #define HUPD(Hx, kt) do { const int kr = 16 * (kt) + l15; \
                const H8 kif = kg < 2 ? h8_from(ld16(rb + R2S_KIT + (kr * 16 + 8 * kg) * 2)) : h8_zero(); const H8 nbf = h8_lo4(*(const U2*)(rb + R2S_NBIT + (kr * 16 + 4 * kg) * 2)); \
                Hx = mfma16(kif, Vb, Hx); Hx = mfma16(nbf, Ub, Hx); const F4 g = *(const F4*)(rb + R2S_GC + (16 * (kt) + 4 * kg) * 4); \
                A4_GET(Hx, 0) *= g.x; A4_GET(Hx, 1) *= g.y; A4_GET(Hx, 2) *= g.z; A4_GET(Hx, 3) *= g.w; } while (0)
            HUPD(H0_, 0); HUPD(H1_, 1); HUPD(H2_, 2); HUPD(H3_, 3);
            #undef HUPD
            LDS_FENCE(); WAVE_SYNC();
            if (lane == 0) lf[32 + wave * 8 + slot] = (unsigned)(ch + 1);
            { RC_GEOM(ch, seg0, segn, R0)
              if (!isctx_ || ctx_out) { UNR for (int rg = 0; rg < 4; ++rg) { const int t = 4 * kg + rg, tl = d == 0 ? R0 + t : R0 + RC_T - 1 - t;
                  Yd[(size_t)(seg0 + tl) * 512 + 64 * h + 16 * vt + l15] = (bf16_t)f2bf(A4_GET(Y, rg)); } } }
        }
    } else {
        const int w = wave - 4;
        const unsigned* FLAG = (const unsigned*)(C.ws + WS_CTL + CTL_R2FLAG) + (size_t)hd * R2_NCH; unsigned* POS = (unsigned*)(C.ws + WS_CTL + CTL_R2POS) + 16 * hd;
        unsigned long long xa[25], xb[25];
        auto fetch = [&](int ch, unsigned long long* x) {
            GSPIN_WAIT(gld_u32(FLAG + ch) == epoch);
            const unsigned long long* gr = (const unsigned long long*)(C.ws + WS_R2RING) + ((size_t)hd * R2_GSLOTS + (ch % R2_GSLOTS)) * R2S_U64;
            UNR for (int j = 0; j < 25; ++j) { const int idx = j * 64 + lane; x[j] = idx < R2S_U64 ? gld_u64(gr + idx) : 0ull; }
        };
        auto commit = [&](int ch, const unsigned long long* x) {
            const int slot = ch % R2_LSLOTS;
            if (ch >= R2_LSLOTS) { const unsigned need = (unsigned)(ch - R2_LSLOTS + 1); SPIN_WAIT(lf[32 + 0 * 8 + slot] == need && lf[32 + 1 * 8 + slot] == need && lf[32 + 2 * 8 + slot] == need && lf[32 + 3 * 8 + slot] == need); }
            unsigned long long* dst = (unsigned long long*)(lds + slot * R2S_BYTES);
            UNR for (int j = 0; j < 25; ++j) { const int idx = j * 64 + lane; if (idx < R2S_U64) dst[idx] = x[j]; }
            LDS_FENCE(); WAVE_SYNC();
            if (lane == 0) { lf[slot] = (unsigned)(ch + 1); gst_u32(POS + 1 + w, pbase + (unsigned)(ch + 1)); }
        };
        if (w < nchunks) fetch(w, xa);
        for (int ch = w; ch < nchunks; ch += 8) {
            if (ch + 4 < nchunks) fetch(ch + 4, xb);
            commit(ch, xa);
            if (ch + 4 < nchunks) { if (ch + 8 < nchunks) fetch(ch + 8, xa); commit(ch + 4, xb); }
        }
    }
    #undef RC_GEOM
    SYNC();
}
DEVFN void ph_scan_hyena(const Ctx& C, int i, bool ctx_out, unsigned char* lds) {
    const int np = C.G >= 256 ? C.G - 16 - 171 : (C.G - 16) / 3, nscan = 16 + np;
    if (C.vcu < 16) { rc2_chain(C, i, C.vcu, ctx_out, lds, 1 << 30); XSTAMP(C, 40, C.vcu == 0); return; }
    if (C.vcu < nscan) { rc2_producer(C, i, lds, (C.vcu - 16) * NWAVES + C.wave, np * NWAVES, 0, 16, 1 << 30); XSTAMP(C, 43, C.vcu == 16); return; }
    const int nh = C.G - nscan;
    for (int c = C.vcu - nscan; c < 512; c += nh) { hyena_channel(C, i, c, lds); if (c == C.vcu - nscan) XSTAMP(C, 44, C.vcu == nscan); }
    XSTAMP(C, 41, C.vcu == nscan); XSTAMP(C, 42, C.vcu == C.G - 1);
    if (ctx_out) for (int c = C.vcu - nscan; c < 512; c += nh) { SYNC(); hyena_ctx_channel(C, i, c, lds); }
}

DEVFN void ctx_outproj(const Ctx& C, const bf16_t* A1, const bf16_t* A2, int lda, const bf16_t* Wt, const float* gate_c, const float* base, float* out) {
    const int row = C.tid & 255, cp = C.tid >> 8;
    for (int n0 = 4 * C.vcu; n0 < DM; n0 += 4 * C.G) {
        const int n = n0 + 2 * cp;
        const bf16_t* w0p = Wt + (size_t)n * DM; const bf16_t* w1p = w0p + DM;
        float acc0 = 0.f, acc1 = 0.f;
        for (int hf = 0; hf < 2; ++hf) {
            const bf16_t* ap = (hf == 0 ? A1 : A2) + (size_t)row * lda;
            for (int k0 = 0; k0 < 512; k0 += 8) {
                float a[8], w0[8], w1[8];
                unpack8(ld16(ap + k0), a); unpack8(ld16(w0p + 512 * hf + k0), w0); unpack8(ld16(w1p + 512 * hf + k0), w1);
                UNR for (int e = 0; e < 8; ++e) { acc0 += a[e] * w0[e]; acc1 += a[e] * w1[e]; }
            }
        }
        const size_t o = (size_t)row * DM + n;
        out[o] = base[o] + gate_c[n] * acc0; out[o + 1] = base[o + 1] + gate_c[n + 1] * acc1;
    }
}
namespace pg8 {
#define PG8_LAS __attribute__((address_space(3)))
typedef unsigned short bf16_t;
typedef short bf16x8 __attribute__((ext_vector_type(8)));
typedef float f32x4 __attribute__((ext_vector_type(4)));
typedef unsigned u32x4 __attribute__((ext_vector_type(4)));
constexpr int BM = 256, BK = 64, HALF = 128, HTB = HALF * BK * 2  , STAGE_BYTES = 8 * HTB, NXCD = 8, WGM = 8;

__host__ __device__ __forceinline__ int lds_byte(int r, int c) { const int st = (r >> 4) * 2 + (c >> 5), rr = r & 15, cc = c & 31, ob = rr * 64 + cc * 2; return st * 1024 + (ob ^ (((ob >> 9) & 1) << 5)); }
__host__ __device__ __forceinline__ void stage_rc(int b, int& R, int& C) { const int st = b / 1024, sb = b % 1024, swz = sb ^ (((sb >> 9) & 1) << 5); R = (st >> 1) * 16 + swz / 64; C = (st & 1) * 32 + (swz % 64) / 2; }
__host__ __device__ __forceinline__ int perm32(int rho) { const int n = rho >> 4, i = rho & 15; return 8 * (i >> 2) + 4 * n + (i & 3); }

struct Unit { int pm, pn; };
struct Gemm { const bf16_t* A; const bf16_t* A2; int lda; const bf16_t* Bt; int M, N, K; };

struct StaticOrder {
    int nM, nN, nwg, G, c;
    __host__ __device__ void init(int M, int N, int G_, int c_) { nM = M / BM; nN = N / BM; nwg = nM * nN; G = G_; c = c_; }
    __host__ __device__ bool next(int i, Unit& u) const {
        const long L = (long)i * G + c; if (L >= nwg) return false;
        int wgid = (int)L; { const int q = nwg / NXCD, r = nwg % NXCD, xcd = wgid % NXCD, off = wgid / NXCD; wgid = (xcd < r ? xcd * (q + 1) : r * (q + 1) + (xcd - r) * q) + off; }
        const int nig = WGM * nN, gid = wgid / nig, fm = gid * WGM, gsz = (nM - fm) < WGM ? (nM - fm) : WGM;
        u.pm = fm + ((wgid % nig) % gsz); u.pn = (wgid % nig) / gsz; return true;
    }
    __device__ __forceinline__ void a_ready(const Unit&) const {}
    __device__ __forceinline__ void done(const Unit&) const {}
};

__device__ __forceinline__ unsigned cvt_pk_bf16(float lo, float hi) { unsigned r; asm volatile("v_cvt_pk_bf16_f32 %0, %1, %2" : "=v"(r) : "v"(lo), "v"(hi)); return r; }
__device__ __forceinline__ float silu_fast(float v) { return v * __builtin_amdgcn_rcpf(1.0f + __expf(-v)); }

template <int LAYOUT> struct EpiIn {
    static constexpr bool PERM = true, AFTER_DRAIN = false;
    unsigned char* ws;
    __device__ __forceinline__ void operator()(const f32x4 (&acc)[2][2][4][2], const Unit& u, int wr, int wc, int fr, int fq) const {
        const int row0 = u.pm * BM + wr * 64 + fr;
#pragma unroll
        for (int bj = 0; bj < 2; ++bj) {
            const int cg = u.pn * BM + bj * HALF;
            bf16_t* base; int ldc, mode, col;
            if (LAYOUT == 0) { base = (bf16_t*)(ws + WS_U); ldc = AIN; col = cg; mode = cg < 512 ? 1 : ((cg >= 1536 && cg < 2048) || cg >= 2816) ? 2 : 0; }
            else {
                if (cg < URW_W) { base = (bf16_t*)(ws + WS_U); ldc = URW_W; col = cg; mode = cg >= 1664 ? 2 : 0; }
                else if (cg < URW_W + UHY_W) { base = (bf16_t*)(ws + WS_UHY); ldc = UHY_W; col = cg - URW_W; mode = 0; }
                else if (cg < RIN) { base = (bf16_t*)(ws + WS_GHY); ldc = 512; col = cg - URW_W - UHY_W; mode = 2; }
                else { base = nullptr; ldc = 0; col = 0; mode = 3; }
            }
            if (mode == 3) continue;
            const int col0 = col + wc * 32 + 8 * fq;
#pragma unroll
            for (int ai = 0; ai < 2; ++ai)
#pragma unroll
                for (int m = 0; m < 4; ++m) {
                    f32x4 v0 = acc[ai][bj][m][0], v1 = acc[ai][bj][m][1];
                    if (mode == 1) { v0 = v0 * C2; v1 = v1 * C2; }
                    if (mode == 2) { v0 = (f32x4){silu_fast(v0[0]), silu_fast(v0[1]), silu_fast(v0[2]), silu_fast(v0[3])}; v1 = (f32x4){silu_fast(v1[0]), silu_fast(v1[1]), silu_fast(v1[2]), silu_fast(v1[3])}; }
                    u32x4 w; w.x = cvt_pk_bf16(v0[0], v0[1]); w.y = cvt_pk_bf16(v0[2], v0[3]); w.z = cvt_pk_bf16(v1[0], v1[1]); w.w = cvt_pk_bf16(v1[2], v1[3]);
                    *(u32x4*)(base + (size_t)(row0 + ai * HALF + m * 16) * ldc + col0) = w;
                }
        }
    }
};

struct EpiRes {
    static constexpr bool PERM = false, AFTER_DRAIN = false;
    const float* blat; const float* bctx; float* olat; float* octx; const float* gate; const float* gate_c;
    __device__ __forceinline__ void operator()(const f32x4 (&acc)[2][2][4][2], const Unit& u, int wr, int wc, int fr, int fq) const {
        const bool isctx = u.pm * BM >= NLAT;
        const float* bs = isctx ? bctx - (size_t)NLAT * DM : blat; float* os = isctx ? octx - (size_t)NLAT * DM : olat; const float* gt = isctx ? gate_c : gate;
        const int col0 = u.pn * BM + wc * 32 + 4 * fq;
#pragma unroll
        for (int bj = 0; bj < 2; ++bj)
#pragma unroll
            for (int n = 0; n < 2; ++n) { const f32x4 g = *(const f32x4*)(gt + col0 + bj * HALF + n * 16);
#pragma unroll
                for (int ai = 0; ai < 2; ++ai)
#pragma unroll
                    for (int m = 0; m < 4; ++m) { const size_t off = (size_t)(u.pm * BM + ai * HALF + wr * 64 + m * 16 + fr) * DM + col0 + bj * HALF + n * 16;
                        const f32x4 b = *(const f32x4*)(bs + off); *(f32x4*)(os + off) = b + g * acc[ai][bj][m][n]; } }
    }
};
template <class Epi, class Sched, bool ALIGN_EPI = false, bool SP2 = false>
__device__ __forceinline__ void gemm_phase(PG8_LAS unsigned char* lds, const Gemm g, const Sched& S, const Epi& E) {
    int tid_ = threadIdx.x; asm volatile("" : "+v"(tid_));
    const int tid = tid_, wid = __builtin_amdgcn_readfirstlane(tid >> 6), lane = tid & 63, wr = wid >> 2, wc = wid & 3, fr = lane & 15, fq = lane >> 4;
    const int K = g.K, nt = K / BK;
    unsigned voffA[2], voffB[2];
#pragma unroll
    for (int i = 0; i < 2; ++i) { int R, C; stage_rc(tid * 16 + i * 8192, R, C); const int Rb = Epi::PERM ? ((R & ~31) + perm32(R & 31)) : R;
        voffA[i] = (unsigned)(R * g.lda + C) * 2u; voffB[i] = (unsigned)(Rb * K + C) * 2u; }
    const size_t kstep = (size_t)(BK * 2);
    const size_t hstepA = (size_t)HALF * g.lda * 2, hstepB = (size_t)HALF * K * 2;
    const size_t tstepA = 2 * hstepA, tstepB = 2 * hstepB;
    const int nh = nt / 2; const ptrdiff_t dlt = ((const char*)g.A2 - (const char*)g.A) - (ptrdiff_t)nh * (ptrdiff_t)kstep;
    const unsigned ldsw = (unsigned)wid * 1024u;
    const int aoff = lds_byte(wr * 64 + fr, fq * 8), boff = lds_byte(wc * 32 + fr, fq * 8);
#define PG8_SA(b, h) (((b) * 2 + (h)) * HTB)
#define PG8_SB(b, h) ((4 + (b) * 2 + (h)) * HTB)
#define PG8_STAGE(bufoff, gbase, voff) do { _Pragma("unroll") for (int _i = 0; _i < 2; ++_i) \
        __builtin_amdgcn_global_load_lds((const unsigned*)((const char*)(gbase) + (voff)[_i]), (PG8_LAS unsigned*)(lds + (bufoff) + ldsw + _i * 8192), 16, 0, 0); } while (0)
#define PG8_LDA(dst, b, h) do { _Pragma("unroll") for (int m = 0; m < 4; ++m) _Pragma("unroll") for (int k = 0; k < 2; ++k) dst[m][k] = *(const PG8_LAS bf16x8*)(lds + PG8_SA(b, h) + aoff + m * 2048 + k * 1024); } while (0)
#define PG8_LDB(dst, b, h) do { _Pragma("unroll") for (int n = 0; n < 2; ++n) _Pragma("unroll") for (int k = 0; k < 2; ++k) dst[n][k] = *(const PG8_LAS bf16x8*)(lds + PG8_SB(b, h) + boff + n * 2048 + k * 1024); } while (0)
#define PG8_MMA(ai, bj, At, Bt) do { __builtin_amdgcn_s_setprio(1); _Pragma("unroll") for (int m = 0; m < 4; ++m) _Pragma("unroll") for (int n = 0; n < 2; ++n) _Pragma("unroll") for (int k = 0; k < 2; ++k) \
        acc[ai][bj][m][n] = __builtin_amdgcn_mfma_f32_16x16x32_bf16(Bt[n][k], At[m][k], acc[ai][bj][m][n], 0, 0, 0); __builtin_amdgcn_s_setprio(0); } while (0)
#define PG8_WAIT_V(n) asm volatile("s_waitcnt vmcnt(" #n ")" ::: "memory")
#define PG8_WAIT_L(n) asm volatile("s_waitcnt lgkmcnt(" #n ")" ::: "memory")
#define PG8_BAR __builtin_amdgcn_s_barrier()
#define PG8_SCHED __builtin_amdgcn_sched_barrier(0)
    Unit cur, nxt; int ui = 0;
    if (!S.next(0, cur)) return;
    f32x4 acc[2][2][4][2];
#pragma unroll
    for (int a = 0; a < 2; ++a)
#pragma unroll
        for (int b = 0; b < 2; ++b)
#pragma unroll
            for (int m = 0; m < 4; ++m)
#pragma unroll
                for (int n = 0; n < 2; ++n) acc[a][b][m][n] = (f32x4){0.f, 0.f, 0.f, 0.f};
    bf16x8 At[4][2], B0[2][2], B1[2][2];
    const char* cA = (const char*)g.A + (size_t)cur.pm * tstepA; const char* cB = (const char*)g.Bt + (size_t)cur.pn * tstepB;
    S.a_ready(cur);
    if constexpr (SP2) {
        PG8_STAGE(PG8_SB(0, 0), cB, voffB); PG8_STAGE(PG8_SB(0, 1), cB + hstepB, voffB); PG8_STAGE(PG8_SA(0, 0), cA, voffA); PG8_STAGE(PG8_SA(0, 1), cA + hstepA, voffA);
        if (wr == 1) PG8_BAR;
        PG8_WAIT_V(2); PG8_BAR;
        PG8_STAGE(PG8_SB(1, 0), cB + kstep, voffB); PG8_STAGE(PG8_SA(1, 0), cA + kstep, voffA); PG8_STAGE(PG8_SB(1, 1), cB + hstepB + kstep, voffB);
        PG8_WAIT_V(6); PG8_BAR;
    } else {
        PG8_STAGE(PG8_SB(0, 0), cB, voffB); PG8_STAGE(PG8_SA(0, 0), cA, voffA); PG8_STAGE(PG8_SB(0, 1), cB + hstepB, voffB); PG8_STAGE(PG8_SA(0, 1), cA + hstepA, voffA);
        if (wr == 1) PG8_BAR;
        PG8_WAIT_V(4); PG8_BAR;
        PG8_STAGE(PG8_SB(1, 0), cB + kstep, voffB); PG8_STAGE(PG8_SA(1, 0), cA + kstep, voffA); PG8_STAGE(PG8_SB(1, 1), cB + hstepB + kstep, voffB);
        PG8_WAIT_V(6); PG8_BAR;
    }
    for (;;) {
        const bool has_next = S.next(ui + 1, nxt);
        const char* nA = has_next ? (const char*)g.A + (size_t)nxt.pm * tstepA : cA; const char* nB = has_next ? (const char*)g.Bt + (size_t)nxt.pn * tstepB : cB;
        for (int t = 0; t < nt; t += 2) {
            const bool last = (t == nt - 2);
            const char* a1 = cA + (size_t)(t + 1) * kstep + ((t + 1) >= nh ? dlt : 0);
            const char* a2 = last ? nA : cA + (size_t)(t + 2) * kstep + ((t + 2) >= nh ? dlt : 0); const char* b2 = last ? nB : cB + (size_t)(t + 2) * kstep;
            const char* a3 = a2 + kstep; const char* b3 = b2 + kstep;
            if (last && has_next) S.a_ready(nxt);
            if constexpr (SP2) {
            PG8_LDB(B0, 0, 0); PG8_LDB(B1, 0, 1); PG8_SCHED; PG8_LDA(At, 0, 0); PG8_STAGE(PG8_SA(1, 1), a1 + hstepA, voffA);
            PG8_WAIT_V(8); PG8_WAIT_L(0); PG8_BAR; PG8_MMA(0, 0, At, B0); PG8_MMA(0, 1, At, B1); PG8_BAR; PG8_SCHED;
            PG8_LDA(At, 0, 1); PG8_STAGE(PG8_SB(0, 0), b2, voffB); PG8_STAGE(PG8_SB(0, 1), b2 + hstepB, voffB); PG8_STAGE(PG8_SA(0, 0), a2, voffA);
            PG8_WAIT_V(8); PG8_WAIT_L(0); PG8_BAR; PG8_MMA(1, 0, At, B0); PG8_MMA(1, 1, At, B1); PG8_BAR; PG8_SCHED;
            PG8_LDB(B0, 1, 0); PG8_LDB(B1, 1, 1); PG8_SCHED; PG8_LDA(At, 1, 0); PG8_STAGE(PG8_SA(0, 1), a2 + hstepA, voffA);
            PG8_WAIT_V(8); PG8_WAIT_L(0); PG8_BAR; PG8_MMA(0, 0, At, B0); PG8_MMA(0, 1, At, B1); PG8_BAR; PG8_SCHED;
            PG8_LDA(At, 1, 1); PG8_STAGE(PG8_SB(1, 0), b3, voffB); PG8_STAGE(PG8_SB(1, 1), b3 + hstepB, voffB); PG8_STAGE(PG8_SA(1, 0), a3, voffA);
            PG8_WAIT_V(8); PG8_WAIT_L(0); PG8_BAR; PG8_MMA(1, 0, At, B0); PG8_MMA(1, 1, At, B1); PG8_BAR; PG8_SCHED;
            } else {
            PG8_LDB(B0, 0, 0); PG8_SCHED; PG8_LDA(At, 0, 0); PG8_STAGE(PG8_SA(1, 1), a1 + hstepA, voffA);
            PG8_WAIT_L(8); PG8_BAR; PG8_WAIT_L(0); PG8_MMA(0, 0, At, B0); PG8_BAR; PG8_SCHED;
            PG8_LDB(B1, 0, 1); PG8_STAGE(PG8_SB(0, 0), b2, voffB);
            PG8_BAR; PG8_WAIT_L(0); PG8_MMA(0, 1, At, B1); PG8_BAR;
            PG8_LDA(At, 0, 1); PG8_STAGE(PG8_SA(0, 0), a2, voffA);
            PG8_BAR; PG8_WAIT_L(0); PG8_MMA(1, 0, At, B0); PG8_BAR; PG8_SCHED;
            PG8_STAGE(PG8_SB(0, 1), b2 + hstepB, voffB);
            PG8_WAIT_V(6); PG8_BAR; PG8_MMA(1, 1, At, B1); PG8_BAR;
            PG8_LDB(B0, 1, 0); PG8_SCHED; PG8_LDA(At, 1, 0); PG8_STAGE(PG8_SA(0, 1), a2 + hstepA, voffA);
            PG8_WAIT_L(8); PG8_BAR; PG8_WAIT_L(0); PG8_MMA(0, 0, At, B0); PG8_BAR; PG8_SCHED;
            PG8_LDB(B1, 1, 1); PG8_STAGE(PG8_SB(1, 0), b3, voffB);
            PG8_BAR; PG8_WAIT_L(0); PG8_MMA(0, 1, At, B1); PG8_BAR;
            PG8_LDA(At, 1, 1); PG8_STAGE(PG8_SA(1, 0), a3, voffA);
            PG8_BAR; PG8_WAIT_L(0); PG8_MMA(1, 0, At, B0); PG8_BAR; PG8_SCHED;
            PG8_STAGE(PG8_SB(1, 1), b3 + hstepB, voffB);
            PG8_WAIT_V(6); PG8_BAR; PG8_MMA(1, 1, At, B1); PG8_BAR;
            }
        }
        if constexpr (ALIGN_EPI) { if (wr == 0) PG8_BAR; }
        if constexpr (!Epi::AFTER_DRAIN) { E(acc, cur, wr, wc, fr, fq); S.done(cur); }
        if (!has_next) break;
#pragma unroll
        for (int a = 0; a < 2; ++a)
#pragma unroll
            for (int b = 0; b < 2; ++b)
#pragma unroll
                for (int m = 0; m < 4; ++m)
#pragma unroll
                    for (int n = 0; n < 2; ++n) acc[a][b][m][n] = (f32x4){0.f, 0.f, 0.f, 0.f};
        cur = nxt; cA = nA; cB = nB; ++ui;
        if constexpr (ALIGN_EPI) { if (wr == 1) PG8_BAR; }
    }
    PG8_WAIT_V(0);
    if constexpr (!ALIGN_EPI) { if (wr == 0) PG8_BAR; }
    PG8_BAR;
    if constexpr (Epi::AFTER_DRAIN) { E.fused(acc, cur, wr, wc, fr, fq, lds, wid, lane); S.done(cur); }
#undef PG8_SA
#undef PG8_SB
#undef PG8_STAGE
#undef PG8_LDA
#undef PG8_LDB
#undef PG8_MMA
#undef PG8_WAIT_V
#undef PG8_WAIT_L
#undef PG8_BAR
#undef PG8_SCHED
}
}
#include <hip/hip_bf16.h>
#include <cmath>
namespace attn_body {
using bf16=__hip_bfloat16;
using bf16x8=__attribute__((ext_vector_type(8)))short;
using s16x4=__attribute__((ext_vector_type(4)))short;
using f32x16=__attribute__((ext_vector_type(16)))float;
using u32x4=__attribute__((ext_vector_type(4)))unsigned;
constexpr int D=64;
constexpr int NW=8,QBLK=32,QB=QBLK*NW,KVBLK=64;
__device__ __forceinline__ int crow(int r,int hi){return (r&3)+8*(r>>2)+4*hi;}
#define SBAR() __builtin_amdgcn_sched_barrier(0)
typedef __attribute__((address_space(3))) const float* lds_fptr;
struct NaCtx { lds_fptr tab; int rmin, qr, qc, row0, col0; };
__device__ __forceinline__ void namask(f32x16&p0,f32x16&p1,int t,const NaCtx&n,int hi){
  if(t<4)return;
  const float NEG=-INFINITY; const int kr=n.rmin+(t-4);
  if(kr<n.row0||kr>=n.row0+8){
    #pragma unroll
    for(int r=0;r<16;++r){p0[r]=NEG;p1[r]=NEG;}
    return; }
  const lds_fptr bt=n.tab+((kr-n.qr+7)*31+15-n.qc+4*hi); const int d0=4*hi-n.col0;
  #pragma unroll
  for(int r=0;r<16;++r){const int e=(r&3)+8*(r>>2);
    p0[r]=((unsigned)(e+d0)<16u)?p0[r]+bt[e]:NEG; p1[r]=((unsigned)(e+32+d0)<16u)?p1[r]+bt[e+32]:NEG;}
}

constexpr int NSLOT=3, SLOTB=8192;
constexpr int LDS_K=0, LDS_V=NSLOT*SLOTB, LDS_WS=2*NSLOT*SLOTB, LDS_OST=LDS_WS+NW*64*4, LDS_BIAS=LDS_OST+NW*4096, LDS_BYTES=LDS_BIAS+640*4;
constexpr float C2=0.125f*1.4426950408889634f;
__device__ __forceinline__ void glds16(const void*gsrc,unsigned lds_dst){unsigned keep;
  asm volatile("s_mov_b32 %0, m0\n\ts_mov_b32 m0, %2\n\ts_nop 0\n\tglobal_load_lds_dwordx4 %1, off\n\ts_mov_b32 m0, %0":"=&s"(keep):"v"(gsrc),"s"(lds_dst):"memory");}
__device__ __forceinline__ float max3f(float a,float b,float c){float r;asm("v_max3_f32 %0, %1, %2, %3":"=v"(r):"v"(a),"v"(b),"v"(c));return r;}
__device__ __forceinline__ float max2f(float a,float b){float r;asm("v_max_f32_e32 %0, %1, %2":"=v"(r):"v"(a),"v"(b));return r;}
__device__ __forceinline__ float fadd_s(float a,float b){float r;asm("v_add_f32_e32 %0, %1, %2":"=v"(r):"v"(a),"v"(b));return r;}
__device__ __forceinline__ float fsub_s(float a,float b){float r;asm("v_sub_f32_e32 %0, %1, %2":"=v"(r):"v"(a),"v"(b));return r;}
typedef float f32x2_t __attribute__((ext_vector_type(2))); typedef __bf16 bf16x2_t __attribute__((ext_vector_type(2)));
__device__ __forceinline__ unsigned cvtpk_s(float lo,float hi){f32x2_t v={lo,hi};bf16x2_t b=__builtin_convertvector(v,bf16x2_t);return __builtin_bit_cast(unsigned,b);}
#define WAIT_BAR(N) asm volatile("s_waitcnt vmcnt(" #N ") lgkmcnt(0)\n\ts_barrier":::"memory")

__device__ __forceinline__ void qkt(f32x16&p0,f32x16&p1,const char*Kslot,const bf16x8*qr,const f32x16&negm,int r32,int hi){
  const char*kb=Kslot+hi*1024+r32*16;
  #pragma unroll
  for(int d0=0;d0<4;++d0){
    const bf16x8 b0=*reinterpret_cast<const bf16x8*>(kb+d0*2048);
    const bf16x8 b1=*reinterpret_cast<const bf16x8*>(kb+d0*2048+512);
    if(d0==0){p0=__builtin_amdgcn_mfma_f32_32x32x16_bf16(b0,qr[0],negm,0,0,0);p1=__builtin_amdgcn_mfma_f32_32x32x16_bf16(b1,qr[0],negm,0,0,0);}
    else{p0=__builtin_amdgcn_mfma_f32_32x32x16_bf16(b0,qr[d0],p0,0,0,0);p1=__builtin_amdgcn_mfma_f32_32x32x16_bf16(b1,qr[d0],p1,0,0,0);}}
}
typedef __attribute__((address_space(3))) const char* lds_cptr;
typedef short v4i16_t __attribute__((ext_vector_type(4)));
__device__ __forceinline__ void kload8(bf16x8*kf,lds_cptr kp){
  kf[0]=*(const __attribute__((address_space(3))) bf16x8*)(kp);      kf[1]=*(const __attribute__((address_space(3))) bf16x8*)(kp+512);
  kf[2]=*(const __attribute__((address_space(3))) bf16x8*)(kp+2048); kf[3]=*(const __attribute__((address_space(3))) bf16x8*)(kp+2560);
  kf[4]=*(const __attribute__((address_space(3))) bf16x8*)(kp+4096); kf[5]=*(const __attribute__((address_space(3))) bf16x8*)(kp+4608);
  kf[6]=*(const __attribute__((address_space(3))) bf16x8*)(kp+6144); kf[7]=*(const __attribute__((address_space(3))) bf16x8*)(kp+6656);
}
__device__ __forceinline__ void kload2(bf16x8*kf,lds_cptr kp,int j){ kf[2*j]=*(const __attribute__((address_space(3))) bf16x8*)(kp+j*2048); kf[2*j+1]=*(const __attribute__((address_space(3))) bf16x8*)(kp+j*2048+512); }
__device__ __forceinline__ s16x4 vtr(lds_cptr p){ return __builtin_bit_cast(s16x4,__builtin_amdgcn_ds_read_tr16_b64_v4i16((__attribute__((address_space(3))) v4i16_t*)p)); }
__device__ __forceinline__ float rowmax(const f32x16&p0,const f32x16&p1){
  float a=max3f(p0[0],p0[1],p1[0]),b=max3f(p0[2],p0[3],p1[1]);a=max3f(a,p1[2],p1[3]);
  #pragma unroll
  for(int r=4;r<16;r+=4){a=max3f(a,p0[r],p0[r+1]);b=max3f(b,p0[r+2],p0[r+3]);a=max3f(a,p1[r],p1[r+1]);b=max3f(b,p1[r+2],p1[r+3]);}
  const float m=max2f(a,b);
  auto rr=__builtin_amdgcn_permlane32_swap(__float_as_uint(m),__float_as_uint(m),false,false);
  return max2f(__uint_as_float(rr[0]),__uint_as_float(rr[1]));
}
__device__ __forceinline__ void pv(f32x16*o,int vb,bf16x8 pa0,bf16x8 pa1,bf16x8 pa2,bf16x8 pa3){
  #pragma unroll
  for(int d0=0;d0<2;++d0){s16x4 lo[4],hi[4];
    #pragma unroll
    for(int ks=0;ks<4;++ks){
      asm volatile("ds_read_b64_tr_b16 %0,%1 offset:%c2":"=&v"(lo[ks]):"v"(vb),"i"(d0*4096+ks*1024):"memory");
      asm volatile("ds_read_b64_tr_b16 %0,%1 offset:%c2":"=&v"(hi[ks]):"v"(vb),"i"(d0*4096+ks*1024+512):"memory");}
    asm volatile("s_waitcnt lgkmcnt(0)":::"memory");SBAR();
    #define PK(k) (bf16x8){lo[k][0],lo[k][1],lo[k][2],lo[k][3],hi[k][0],hi[k][1],hi[k][2],hi[k][3]}
    o[d0]=__builtin_amdgcn_mfma_f32_32x32x16_bf16(pa0,PK(0),o[d0],0,0,0);
    o[d0]=__builtin_amdgcn_mfma_f32_32x32x16_bf16(pa1,PK(1),o[d0],0,0,0);
    o[d0]=__builtin_amdgcn_mfma_f32_32x32x16_bf16(pa2,PK(2),o[d0],0,0,0);
    o[d0]=__builtin_amdgcn_mfma_f32_32x32x16_bf16(pa3,PK(3),o[d0],0,0,0);
    #undef PK
  }
}

#define ATTN_STORE16(p,v) (*(u32x4*)(p)=(v))
template<bool NA> __device__ __forceinline__ f32x16 cinit(const f32x16&negm){ if constexpr(NA){ f32x16 z=f32x16{}; return z; } else return negm; }
constexpr int UP=3328, OP=1024;
struct AJob { const bf16*U; bf16*MX; unsigned qo, ko, vo, go, oo; int NT, tile0a, na, tile0b; int qr0, rmin; const float*rpb; };
__device__ __forceinline__ u32x4 gate8(u32x4 v,u32x4 g);
template<int THRL,bool NA> __device__ __forceinline__ void attn_unit(const AJob&J,char*shm){
  int tid_=threadIdx.x; asm volatile("":"+v"(tid_));
  const int tid=tid_,lane=tid&63,r32=lane&31,hi=lane>>5; const int wid=__builtin_amdgcn_readfirstlane(tid>>6);
  const bf16*Qw=J.U+J.qo+(long)(wid*QBLK)*UP;
  const bf16*Kh=J.U+J.ko,*Vh=J.U+J.vo;
  const unsigned lds0=(unsigned)(uintptr_t)shm;
  float*wsf=(float*)(shm+LDS_WS)+wid*64;
  const bf16*ksrc=Kh+(long)lane*UP+wid*8;
  const bf16*vsrc=Vh+(long)(16*(wid&3)+(lane>>2))*UP+(wid>>2)*32+(lane&3)*8;
  const unsigned kdst=lds0+LDS_K+wid*1024, vdst=lds0+LDS_V+wid*1024;
  #define TROW(t) (64L*(long)(((t)<J.na)?(J.tile0a+(t)):(J.tile0b+((t)-J.na))))
  #define DMA_K(t,slot) glds16(ksrc+TROW(t)*UP,(unsigned)__builtin_amdgcn_readfirstlane(kdst+(slot)))
  #define DMA_V(t,slot) glds16(vsrc+TROW(t)*UP,(unsigned)__builtin_amdgcn_readfirstlane(vdst+(slot)))
  const int vb0=(int)(lds0+LDS_V)+((lane>>4)&1)*32+(lane&3)*8+(4*hi+((lane&15)>>2))*64;
  const char*Kbase=shm+LDS_K; bf16x8 kf[8];
  const lds_cptr shm3=(lds_cptr)shm; const lds_cptr kp0=shm3+LDS_K+hi*1024+r32*16; const lds_cptr vp0=shm3+LDS_V+((lane>>4)&1)*32+(lane&3)*8+(4*hi+((lane&15)>>2))*64;
  const int NT=J.NT;
  NaCtx nac; nac.tab=(lds_fptr)(shm+LDS_BIAS)+64; nac.rmin=J.rmin; nac.qr=J.qr0+(wid>>1); nac.qc=32*(wid&1)+r32;
  { int a=nac.qr-4; a=a<0?0:(a>248?248:a); nac.row0=a; int b=nac.qc-8; b=b<0?0:(b>48?48:b); nac.col0=b; }
  if(NA){ if(J.rpb){ for(int e=tid;e<465;e+=512)((__attribute__((address_space(3))) float*)(shm+LDS_BIAS))[64+e]=J.rpb[e]*1.4426950408889634f; } }
  DMA_K(0,0);DMA_V(0,0);DMA_K(1,SLOTB);
  bf16x8 qr[4];
  #pragma unroll
  for(int d0=0;d0<4;++d0)qr[d0]=*reinterpret_cast<const bf16x8*>(&Qw[(long)r32*UP+d0*16+hi*8]);
  float mhat=0.f,l_reg=0.f;f32x16 o[2];o[0]=f32x16{};o[1]=f32x16{};f32x16 negm=f32x16{}; if constexpr(!NA) asm volatile("":"+v"(negm));
  #define CMASK(P0,P1,t) do{ if constexpr(NA) namask(P0,P1,(t),nac,hi); }while(0)
  bool resc=false;
  #define START(P0,P1) do{ const float rm=rowmax(P0,P1); resc=false; \
    { const float dl=rm; mhat=fadd_s(mhat,dl); \
      _Pragma("unroll") for(int r=0;r<16;++r){P0[r]=fsub_s(P0[r],dl);P1[r]=fsub_s(P1[r],dl);} \
      if constexpr(!NA){ _Pragma("unroll") for(int r=0;r<16;++r)negm[r]=-mhat; asm volatile("":"+v"(negm)); } } \
    _Pragma("unroll") for(int r=0;r<16;++r)P0[r]=__builtin_amdgcn_exp2f(P0[r]); }while(0)
  #define RESC() do{ if(resc){ asm volatile("s_waitcnt lgkmcnt(0)":::"memory"); \
      _Pragma("unroll") for(int d_=0;d_<2;++d_) _Pragma("unroll") for(int r=0;r<16;++r)o[d_][r]*=wsf[crow(r,hi)]; } }while(0)
  f32x16 pA0,pA1,pB0,pB1;
  int sl_prev=0,sl_cur=0,sl_next=SLOTB;
  #define ROT() do{sl_prev=sl_cur;sl_cur=sl_next;sl_next=(sl_next==(NSLOT-1)*SLOTB)?0:sl_next+SLOTB;}while(0)
  DMA_K(2,2*SLOTB);
  WAIT_BAR(3);
  qkt(pA0,pA1,Kbase,qr,cinit<NA>(negm),r32,hi);asm volatile("s_nop 15\n\ts_nop 7":"+v"(pA0),"+v"(pA1));CMASK(pA0,pA1,0);
  START(pA0,pA1);
  _Pragma("unroll") for(int r=0;r<16;++r)pA1[r]=__builtin_amdgcn_exp2f(pA1[r]);
  WAIT_BAR(0);
  DMA_K(3,0);DMA_V(1,SLOTB);
  ROT();
  kload8(kf,kp0+sl_cur);
  WAIT_BAR(2);
  s16x4 vlo[8],vhi[8]; u32x4 pw0,pw1,pw2,pw3;
  #define PKW(P,B) cvtpk_s(P[B],P[B+1])
  #define PAF(k) __builtin_bit_cast(bf16x8,pw##k)
  #define VFR(i) (bf16x8){vlo[i][0],vlo[i][1],vlo[i][2],vlo[i][3],vhi[i][0],vhi[i][1],vhi[i][2],vhi[i][3]}
  #define PIN(x) asm volatile("":"+v"(x))
  #define MX3(a,b,c) __builtin_fmaxf(__builtin_fmaxf((a),(b)),(c))
  #define GAPA(MF,A0,A1,A2,A3,W0,W1,PW) do{ MF; sacc+=A0; sacc+=A1; sacc+=A2; sacc+=A3; PIN(sacc); W0; W1; PIN(PW); SBAR(); }while(0)
  #define EX(v) __builtin_amdgcn_exp2f(v)
  #define GAPB(MF,X,B) do{ MF; X[B]=EX(X[B]); X[B+1]=EX(X[B+1]); X[B+2]=EX(X[B+2]); X[B+3]=EX(X[B+3]); PIN(X); SBAR(); }while(0)
  #define VRD(i) do{ vlo[i]=vtr(vp_+(((i)>>2)*4096+((i)&3)*1024)); vhi[i]=vtr(vp_+(((i)>>2)*4096+((i)&3)*1024+512)); }while(0)
  #define KRD(G,j) do{ if(G){ kload2(kf,kp0+sl_next,j); SBAR(); } }while(0)
  #define STEP(C0,C1,P0,P1,t,GK,GV,GL) do{ SBAR(); \
    const lds_cptr vp_=vp0+sl_prev; \
    VRD(0); SBAR(); float sacc=(P0[0]+P0[1]); \
    GAPA(C0=__builtin_amdgcn_mfma_f32_32x32x16_bf16(kf[0],qr[0],cinit<NA>(negm),0,0,0), P0[2],P0[3],P0[4],P0[5],     pw0[0]=PKW(P0,0), pw0[1]=PKW(P0,2), pw0); \
    VRD(4); SBAR(); GAPA(C1=__builtin_amdgcn_mfma_f32_32x32x16_bf16(kf[1],qr[0],cinit<NA>(negm),0,0,0), P0[6],P0[7],P0[8],P0[9],     pw0[2]=PKW(P0,4), pw0[3]=PKW(P0,6), pw0); \
    VRD(1); SBAR(); GAPA(C0=__builtin_amdgcn_mfma_f32_32x32x16_bf16(kf[2],qr[1],C0,0,0,0),   P0[10],P0[11],P0[12],P0[13], pw1[0]=PKW(P0,8), pw1[1]=PKW(P0,10), pw1); \
    VRD(5); SBAR(); GAPA(C1=__builtin_amdgcn_mfma_f32_32x32x16_bf16(kf[3],qr[1],C1,0,0,0),   P0[14],P0[15],P1[0],P1[1],   pw1[2]=PKW(P0,12),pw1[3]=PKW(P0,14), pw1); \
    VRD(2); SBAR(); GAPA(C0=__builtin_amdgcn_mfma_f32_32x32x16_bf16(kf[4],qr[2],C0,0,0,0),   P1[2],P1[3],P1[4],P1[5],     pw2[0]=PKW(P1,0), pw2[1]=PKW(P1,2), pw2); \
    VRD(6); SBAR(); GAPA(C1=__builtin_amdgcn_mfma_f32_32x32x16_bf16(kf[5],qr[2],C1,0,0,0),   P1[6],P1[7],P1[8],P1[9],     pw2[2]=PKW(P1,4), pw2[3]=PKW(P1,6), pw2); \
    VRD(3); SBAR(); GAPA(C0=__builtin_amdgcn_mfma_f32_32x32x16_bf16(kf[6],qr[3],C0,0,0,0),   P1[10],P1[11],P1[12],P1[13], pw3[0]=PKW(P1,8), pw3[1]=PKW(P1,10), pw3); \
    VRD(7); SBAR(); GAPA(C1=__builtin_amdgcn_mfma_f32_32x32x16_bf16(kf[7],qr[3],C1,0,0,0),   P1[14],P1[15],0.f,0.f,       pw3[2]=PKW(P1,12),pw3[3]=PKW(P1,14), pw3); \
    l_reg+=sacc; \
    if(GK){DMA_K((t)+3,sl_cur);} if(GV){DMA_V((t)+1,sl_next);} \
    if constexpr(NA){ _Pragma("unroll") for(int r=0;r<16;++r){C0[r]-=mhat;C1[r]-=mhat;} } \
    CMASK(C0,C1,t); \
    { float a=MX3(C0[0],C0[1],C1[0]),b=MX3(C0[2],C0[3],C1[1]); a=MX3(a,C1[2],C1[3]); \
      _Pragma("unroll") for(int r=4;r<16;r+=4){a=MX3(a,C0[r],C0[r+1]);b=MX3(b,C0[r+2],C0[r+3]);a=MX3(a,C1[r],C1[r+1]);b=MX3(b,C1[r+2],C1[r+3]);} \
      float rm=__builtin_fmaxf(a,b); { auto rr=__builtin_amdgcn_permlane32_swap(__float_as_uint(rm),__float_as_uint(rm),false,false); rm=__builtin_fmaxf(__uint_as_float(rr[0]),__uint_as_float(rr[1])); } \
      resc=false; \
      if(__builtin_expect(__any(rm>(float)THRL),0)){ const float dl=__builtin_fmaxf(rm,0.f); mhat+=dl; \
        _Pragma("unroll") for(int r=0;r<16;++r){C0[r]-=dl;C1[r]-=dl;} \
        if constexpr(!NA){ _Pragma("unroll") for(int r=0;r<16;++r)negm[r]=-mhat; asm volatile("":"+v"(negm)); } \
        const float f=__builtin_amdgcn_exp2f(-dl); l_reg*=f; if(hi==0)wsf[r32]=f; resc=true; } } \
    SBAR(); \
    GAPB(o[0]=__builtin_amdgcn_mfma_f32_32x32x16_bf16(PAF(0),VFR(0),o[0],0,0,0), C0,0); \
    GAPB(o[1]=__builtin_amdgcn_mfma_f32_32x32x16_bf16(PAF(0),VFR(4),o[1],0,0,0), C0,4); \
    KRD(GL,0); GAPB(o[0]=__builtin_amdgcn_mfma_f32_32x32x16_bf16(PAF(1),VFR(1),o[0],0,0,0), C0,8); \
    KRD(GL,1); GAPB(o[1]=__builtin_amdgcn_mfma_f32_32x32x16_bf16(PAF(1),VFR(5),o[1],0,0,0), C0,12); \
    KRD(GL,2); GAPB(o[0]=__builtin_amdgcn_mfma_f32_32x32x16_bf16(PAF(2),VFR(2),o[0],0,0,0), C1,0); \
    KRD(GL,3); GAPB(o[1]=__builtin_amdgcn_mfma_f32_32x32x16_bf16(PAF(2),VFR(6),o[1],0,0,0), C1,4); \
    GAPB(o[0]=__builtin_amdgcn_mfma_f32_32x32x16_bf16(PAF(3),VFR(3),o[0],0,0,0), C1,8); \
    GAPB(o[1]=__builtin_amdgcn_mfma_f32_32x32x16_bf16(PAF(3),VFR(7),o[1],0,0,0), C1,12); \
    }while(0)
  int t=1;
  for(;t+5<NT;t+=2){
    STEP(pB0,pB1,pA0,pA1,t,true,true,true);     WAIT_BAR(2); RESC(); ROT();
    STEP(pA0,pA1,pB0,pB1,t+1,true,true,true);   WAIT_BAR(2); RESC(); ROT();
  }
  #define ENDW(tt) do{ if((tt)+3<NT){WAIT_BAR(2);} else if((tt)+2<NT){WAIT_BAR(1);} else {WAIT_BAR(0);} }while(0)
  for(;t+1<NT;t+=2){
    STEP(pB0,pB1,pA0,pA1,t,(t+3<NT),(t+1<NT),(t+1<NT));       ENDW(t);   RESC(); ROT();
    STEP(pA0,pA1,pB0,pB1,t+1,(t+4<NT),(t+2<NT),(t+2<NT));     ENDW(t+1); RESC(); ROT();
  }
  STEP(pB0,pB1,pA0,pA1,NT-1,false,false,false); RESC();
  { float sacc=pB0[0]+pB0[1]; _Pragma("unroll") for(int r=2;r<16;++r)sacc+=pB0[r]; _Pragma("unroll") for(int r=0;r<16;++r)sacc+=pB1[r]; l_reg+=sacc;
    pw0=(u32x4){PKW(pB0,0),PKW(pB0,2),PKW(pB0,4),PKW(pB0,6)};pw1=(u32x4){PKW(pB0,8),PKW(pB0,10),PKW(pB0,12),PKW(pB0,14)};pw2=(u32x4){PKW(pB1,0),PKW(pB1,2),PKW(pB1,4),PKW(pB1,6)};pw3=(u32x4){PKW(pB1,8),PKW(pB1,10),PKW(pB1,12),PKW(pB1,14)};
    SBAR(); pv(o,vb0+sl_cur,PAF(0),PAF(1),PAF(2),PAF(3)); }
  #undef PKW
  #undef PAF
  #undef VFR
  #undef PIN
  #undef MX3
  #undef GAPA
  #undef GAPB
  #undef EX
  #undef VRD
  #undef KRD
  #undef STEP
  #undef ENDW
  {auto rr=__builtin_amdgcn_permlane32_swap(__float_as_uint(l_reg),__float_as_uint(l_reg),false,false);l_reg=__uint_as_float(rr[0])+__uint_as_float(rr[1]);}
  if(hi==0)wsf[32+r32]=l_reg;asm volatile("s_waitcnt lgkmcnt(0)":::"memory");
  float rli[16];
  #pragma unroll
  for(int r=0;r<16;++r)rli[r]=__builtin_amdgcn_rcpf(wsf[32+crow(r,hi)]);
  bf16*Ow=J.MX+J.oo+(long)(wid*QBLK)*OP; const bf16*Gw=J.U+J.go+(long)(wid*QBLK)*UP;
  { bf16*stg=(bf16*)(shm+LDS_OST)+wid*2048;
    #pragma unroll
    for(int r=0;r<16;++r){const int orow=crow(r,hi);
      #pragma unroll
      for(int d0=0;d0<2;++d0)stg[orow*64+d0*32+r32]=__float2bfloat16(o[d0][r]*rli[r]);}
    asm volatile("s_waitcnt lgkmcnt(0)":::"memory");
    #pragma unroll
    for(int i=0;i<4;++i){const int row=i*8+(lane>>3),ch=lane&7; const u32x4 v=*(const u32x4*)(stg+row*64+ch*8); const u32x4 g=*(const u32x4*)(Gw+(long)row*UP+ch*8); ATTN_STORE16(Ow+(long)row*OP+ch*8,gate8(v,g));} }
  asm volatile("s_waitcnt lgkmcnt(0)\n\ts_barrier":::"memory");
  #undef DMA_K
  #undef TROW
  #undef DMA_V
  #undef CMASK
  #undef START
  #undef RESC
  #undef ROT
}
constexpr int ATTN_LDS_BYTES=LDS_BYTES;
__device__ __forceinline__ u32x4 gate8(u32x4 v,u32x4 g){ u32x4 r;
  #pragma unroll
  for(int i=0;i<4;++i){ const float a0=__uint_as_float(v[i]<<16)*__uint_as_float(g[i]<<16), a1=__uint_as_float(v[i]&0xffff0000u)*__uint_as_float(g[i]&0xffff0000u); r[i]=cvtpk_s(a0,a1); }
  return r; }
#undef SBAR
#undef WAIT_BAR
}
#define GAS __attribute__((address_space(1)))
#define LAS __attribute__((address_space(3)))
typedef GAS unsigned gu32;
#define RLX_AGENT __ATOMIC_RELAXED, __HIP_MEMORY_SCOPE_AGENT
#define XB_TMO      128
#define XB_XCNT(j)  (256  + 64 * (j))
#define XB_XSUB(j)  (1280 + 64 * (j))
#define XB_XGEN(j)  (2304 + 64 * (j))
#define XB_TOP      3328
#define XB_TOPGEN   3392
#define XCD_BAR_WORDS 3456
#define XB_SPIN_CAP (1u << 20)

__device__ __forceinline__ unsigned xb_ld(unsigned* p)              { return __hip_atomic_load(p, __ATOMIC_RELAXED, __HIP_MEMORY_SCOPE_AGENT); }
__device__ __forceinline__ unsigned xb_add(unsigned* p, unsigned v) { return __hip_atomic_fetch_add(p, v, __ATOMIC_RELAXED, __HIP_MEMORY_SCOPE_AGENT); }
__device__ __forceinline__ unsigned xb_xcc_id() { return (unsigned)__builtin_amdgcn_s_getreg((3 << 11) | 20) & 0xFu; }
#define XB_SPIN(cond, bar) do { unsigned _sp = 0; while (cond) { __builtin_amdgcn_s_sleep(1); \
    if ((++_sp & 255u) == 0u) { if (xb_ld(&(bar)[XB_TMO])) break; if (_sp > XB_SPIN_CAP) { atomicAdd(&(bar)[XB_TMO], 1u); break; } } } } while (0)

struct XcdBarrier {
    unsigned* bar; unsigned x;
    volatile LAS unsigned* st;
};

__device__ __forceinline__ XcdBarrier xcd_barrier_post(unsigned* bar, volatile LAS unsigned* st) {
    XcdBarrier b; b.bar = bar; b.x = xb_xcc_id(); b.st = st;
    if (threadIdx.x == 0) (void)xb_add(&bar[XB_XCNT(b.x)], 1u);
    return b;
}
__device__ __forceinline__ void xcd_barrier_complete(unsigned* bar, unsigned x, unsigned& nloc, unsigned& nx) {
    const unsigned G = gridDim.x * gridDim.y * gridDim.z;
    unsigned sum, cnt, mine, sp = 0u;
    for (;;) {
        sum = 0u; cnt = 0u; mine = 0u;
#pragma unroll
        for (unsigned j = 0; j < 16; ++j) { const unsigned c = xb_ld(&bar[XB_XCNT(j)]); sum += c; cnt += (c > 0u) ? 1u : 0u; mine = (j == x) ? c : mine; }
        if (sum == G) break;
        __builtin_amdgcn_s_sleep(1);
        if ((++sp & 255u) == 0u) { if (xb_ld(&bar[XB_TMO])) break; if (sp > XB_SPIN_CAP) { atomicAdd(&bar[XB_TMO], 1u); break; } }
    }
    nloc = mine > 0u ? mine : 1u; nx = cnt > 0u ? cnt : 1u;
}

__device__ __forceinline__ void xcd_barrier(const XcdBarrier& b) {
    asm volatile("s_waitcnt vmcnt(0)" ::: "memory");
    __syncthreads();
    if (threadIdx.x == 0) {
        unsigned* bar = b.bar;
        __builtin_amdgcn_s_waitcnt(0);
        unsigned nloc = b.st[0], nx = b.st[1];
        if (nloc == 0u) { xcd_barrier_complete(bar, b.x, nloc, nx); b.st[0] = nloc; b.st[1] = nx; }
        const unsigned old = xb_add(&bar[XB_XSUB(b.x)], 1u);
        const unsigned gen = old / nloc;
        if (old + 1u == (gen + 1u) * nloc) {
            __builtin_amdgcn_fence(__ATOMIC_RELEASE, "agent");
            asm volatile("s_waitcnt vmcnt(0)" ::: "memory");
            const unsigned og = xb_add(&bar[XB_TOP], 1u);
            const unsigned tg = og / nx;
            if (og + 1u == (tg + 1u) * nx) xb_add(&bar[XB_TOPGEN], 1u);
            else XB_SPIN(xb_ld(&bar[XB_TOPGEN]) == tg, bar);
            __builtin_amdgcn_fence(__ATOMIC_ACQUIRE, "agent");
            xb_add(&bar[XB_XGEN(b.x)], 1u);
            asm volatile("s_waitcnt vmcnt(0)" ::: "memory");
        } else {
            XB_SPIN(xb_ld(&bar[XB_XGEN(b.x)]) == gen, bar);
            __builtin_amdgcn_fence(__ATOMIC_ACQUIRE, "agent");
            asm volatile("s_waitcnt vmcnt(0)" ::: "memory");
        }
    }
    __syncthreads();
}

constexpr int CW_BAR = 4096;
__device__ __forceinline__ void ph_attention(const Ctx& C, int i, unsigned char* lds) {
    using namespace attn_body;
    const bf16* U = (const bf16*)(C.ws + WS_U); bf16* MX = (bf16*)(C.ws + WS_XN);
    const float* rpb = C.in[I_RPB] + (size_t)i * 8 * 465;
    for (int p = C.vcu; p < 1040; p += C.G) {
        int kind, h, qb;
        if (p < 512) { kind = 0; h = (p & 255) >> 5; qb = (p & 31) + 32 * (p >> 8); }
        else if (p < 1024) { kind = 1; const int q = p - 512; h = (q & 255) >> 5; qb = (q & 31) + 32 * (q >> 8); }
        else if (p < 1032) { kind = 0; h = p - 1024; qb = 64; }
        else { kind = 1; h = p - 1032; qb = 64; }
        const unsigned r0 = 256u * (unsigned)qb;
        AJob J; J.U = U; J.MX = MX;
        if (kind == 0) {
            J.qo = r0 * AIN + 2048 + 64 * h; J.ko = 2560 + 64 * (h >> 2); J.vo = 2688 + 64 * (h >> 2); J.oo = r0 * DM + 512 + 64 * h; J.go = r0 * AIN + 2816 + 64 * h;
            if (qb < 64) { J.NT = 260; J.tile0a = 0; J.na = 260; J.tile0b = 0; } else { J.NT = 4; J.tile0a = 256; J.na = 4; J.tile0b = 0; }
            J.qr0 = 0; J.rmin = 0; J.rpb = nullptr;
            attn_unit<8, false>(J, (char*)lds);
        } else {
            J.qo = r0 * AIN + 64 * h; J.ko = 512 + 64 * h; J.vo = 1024 + 64 * h; J.oo = r0 * DM + 64 * h; J.go = r0 * AIN + 1536 + 64 * h;
            J.tile0a = 256; J.na = 4; J.qr0 = 4 * qb;
            if (qb < 64) { int rm = 4 * qb - 4; rm = rm < 0 ? 0 : (rm > 248 ? 248 : rm); J.NT = 16; J.tile0b = rm; J.rmin = rm; J.rpb = rpb + (size_t)h * 465; }
            else { J.NT = 4; J.tile0b = 0; J.rmin = 0; J.rpb = nullptr; }
            attn_unit<8, true>(J, (char*)lds);
        }
    }
}

#ifdef TSEL
__device__ __forceinline__ void ph_final_t(const Ctx& C) {
    ph_final(C);
    __syncthreads();
    const unsigned long long* st = (const unsigned long long*)(C.ws + WS_CTL + 32768);
    unsigned long long t[24]; for (int k = 0; k < 24; ++k) t[k] = __hip_atomic_load(st + k, __ATOMIC_RELAXED, __HIP_MEMORY_SCOPE_AGENT);
    double sel = 0.0; for (int k = 0; k < 23; ++k) if ((TSEL >> k) & 1ull) sel += (double)(t[k + 1] - t[k]);
    double tot = (double)(t[23] - t[0]);
#ifdef TXS
    { const unsigned long long x = __hip_atomic_load(st + TXS, __ATOMIC_RELAXED, __HIP_MEMORY_SCOPE_AGENT); sel = (double)(x - t[20]); tot = (double)(t[21] - t[20]); }
#ifdef TXD
    { const unsigned long long x = __hip_atomic_load(st + TXS, __ATOMIC_RELAXED, __HIP_MEMORY_SCOPE_AGENT); sel = (double)x; tot = (double)(t[21] - t[20]); }
#endif
#endif
    const float eps = sqrtf(0.0012f * (float)(sel / tot));
    const int gw = C.vcu * NWAVES + C.wave, NGW = C.G * NWAVES;
    for (int m = gw; m < NLAT; m += NGW) { float* xr = C.out + (size_t)m * DM; for (int j = 0; j < 16; ++j) xr[64 * j + C.lane] *= (1.0f + eps); }
}
#else
__device__ __forceinline__ void ph_final_t(const Ctx& C) { ph_final(C); }
#endif
struct Args { const float* in[N_IN]; float* out; unsigned char* ws; int ph_lo, ph_hi; };
typedef __attribute__((address_space(4))) const Args* KArgP;
__global__ void __launch_bounds__(NTHREADS, 2) mk_fwd(Args args) {
    extern __shared__ __attribute__((aligned(16))) unsigned char lds[];
    volatile LAS unsigned* MISC = (volatile LAS unsigned*)((LAS unsigned char*)lds + MISC_OFF);
    if (threadIdx.x < 64) MISC[threadIdx.x] = 0u;
    __syncthreads();
    XcdBarrier bar = xcd_barrier_post((unsigned*)(args.ws + WS_CTL) + CW_BAR, MISC + 8);
    const int lo = args.ph_lo, hi = args.ph_hi;
    int pc = 0;
#ifdef TSEL
#define STAMP(k) do { if (blockIdx.x == 0 && threadIdx.x == 0) __hip_atomic_store((unsigned long long*)(args.ws + WS_CTL + 32768) + (k), (unsigned long long)__builtin_amdgcn_s_memrealtime(), __ATOMIC_RELAXED, __HIP_MEMORY_SCOPE_AGENT); } while (0)
#else
#define STAMP(k) do {} while (0)
#endif
    STAMP(0);
#define PHASE(...) do { if (pc >= lo && pc < hi) { KArgP ap = (KArgP)__builtin_amdgcn_kernarg_segment_ptr(); asm volatile("" : "+s"(ap)); Ctx C; \
        _Pragma("unroll") for (int k = 0; k < N_IN; ++k) C.in[k] = ap->in[k]; C.out = ap->out; C.ws = ap->ws; \
        { int t_ = threadIdx.x; asm volatile("" : "+v"(t_)); C.tid = t_; } C.lane = C.tid & 63; C.wave = __builtin_amdgcn_readfirstlane(C.tid >> 6); \
        C.G = gridDim.x; { const int bx = blockIdx.x; C.vcu = (C.G % 8 == 0) ? (bx % 8) * (C.G / 8) + bx / 8 : bx; } \
        float* XCTX = (float*)(C.ws + WS_XCTX); unsigned char* ldsg = (unsigned char*)lds; unsigned char* wsp = C.ws; (void)XCTX; (void)ldsg; (void)wsp; \
        const float* xl = layer == 0 ? C.in[I_X] : C.out; const float* xc = layer == 0 ? C.in[I_CTX] : XCTX; (void)xl; (void)xc; \
        const float* ADA = (const float*)(C.ws + WS_ADA) + (size_t)layer * 2 * 3072; (void)ADA; \
        __VA_ARGS__; if (pc + 1 < hi) xcd_barrier(bar); STAMP(pc + 1); } ++pc; } while (0)
#ifndef PH_MASK
#define PH_MASK 0xFFFF
#endif
#define EN(b) if ((PH_MASK >> (b)) & 1)

    { const int layer = 0; PHASE(EN(0) ph_prologue(C, ldsg)); }
    for (int layer = 0; layer < 4; ++layer) {
        const int i = layer >> 1;
        const bool ctx_out = layer < 3;
        PHASE(EN(1) ph_norm(C, layer, xl, xc, true));
        if ((layer & 1) == 0) {
            PHASE(EN(2) { pg8::Gemm g{(const pg8::bf16_t*)(wsp + WS_XN), (const pg8::bf16_t*)(wsp + WS_XN) + DM / 2, DM, (const pg8::bf16_t*)(wsp + WS_WAIN) + (size_t)i * AIN * DM, NTOK, AIN, DM};
                    pg8::StaticOrder S; S.init(NTOK, AIN, C.G, (int)blockIdx.x); pg8::EpiIn<0> E{wsp};
                    pg8::gemm_phase<pg8::EpiIn<0>, pg8::StaticOrder, true, true>((LAS unsigned char*)lds, g, S, E); });
            PHASE(EN(3) ph_qkprep(C, i));
            PHASE(EN(4) ph_attention(C, i, ldsg));
            PHASE(EN(5) { pg8::Gemm g{(const pg8::bf16_t*)(wsp + WS_XN), (const pg8::bf16_t*)(wsp + WS_XN) + DM / 2, DM, (const pg8::bf16_t*)(wsp + WS_WAOUT) + (size_t)i * DM * DM, NLAT, DM, DM};
                    pg8::StaticOrder S; S.init(NLAT, DM, C.G, (int)blockIdx.x); pg8::EpiRes E{xl, xc, C.out, XCTX, ADA + 2048, ADA + 3072 + 2048};
                    pg8::gemm_phase<pg8::EpiRes, pg8::StaticOrder, true, true>((LAS unsigned char*)lds, g, S, E);
                    ctx_outproj(C, (const bf16_t*)(wsp + WS_XN) + (size_t)NLAT * DM, (const bf16_t*)(wsp + WS_XN) + (size_t)NLAT * DM + 512, DM, (const bf16_t*)(wsp + WS_WAOUT) + (size_t)i * DM * DM, ADA + 3072 + 2048, xc, XCTX); });
        } else {
            PHASE(EN(6) { pg8::Gemm g{(const pg8::bf16_t*)(wsp + WS_XN), (const pg8::bf16_t*)(wsp + WS_XN) + DM / 2, DM, (const pg8::bf16_t*)(wsp + WS_WRIN) + (size_t)i * RINP * DM, NTOK, RINP, DM};
                    pg8::StaticOrder S; S.init(NTOK, RINP, C.G, (int)blockIdx.x); pg8::EpiIn<1> E{wsp};
                    pg8::gemm_phase<pg8::EpiIn<1>, pg8::StaticOrder, true, true>((LAS unsigned char*)lds, g, S, E); });
            PHASE(EN(7) ph_hyprep(C, i, ctx_out, ldsg));
            PHASE(EN(8) ph_scan_hyena(C, i, ctx_out, ldsg));
            PHASE(EN(9) ph_readout_hyout(C, i, ctx_out, ldsg));
            const int Mo = NLAT;
            PHASE(EN(10) { pg8::Gemm g{(const pg8::bf16_t*)(wsp + WS_YF), (const pg8::bf16_t*)(wsp + WS_HYOUT), 512, (const pg8::bf16_t*)(wsp + WS_WROUT) + (size_t)i * DM * DM, Mo, DM, DM};
                    pg8::StaticOrder S; S.init(Mo, DM, C.G, (int)blockIdx.x); pg8::EpiRes E{xl, xc, C.out, XCTX, ADA + 2048, ADA + 3072 + 2048};
                    pg8::gemm_phase<pg8::EpiRes, pg8::StaticOrder, true, true>((LAS unsigned char*)lds, g, S, E);
                    if (ctx_out) ctx_outproj(C, (const bf16_t*)(wsp + WS_YF) + (size_t)NLAT * 512, (const bf16_t*)(wsp + WS_HYOUT) + (size_t)NLAT * 512, 512, (const bf16_t*)(wsp + WS_WROUT) + (size_t)i * DM * DM, ADA + 3072 + 2048, xc, XCTX); });
        }
    }
    { const int layer = 3; PHASE(EN(11) ph_final_t(C)); }
#undef PHASE
}
constexpr int N_PHASES = 1 + 2 * 5 + 2 * 6 + 1;

#ifndef MK_SPLIT
#define MK_SPLIT 0
#endif
extern "C" void kernel_launch(void* const* d_in, const int* in_sizes, int n_in, void* d_out, int out_size, void* d_ws, size_t ws_size, hipStream_t stream) {
    static int grid = 0;
    if (grid == 0) {
        if (n_in != N_IN || out_size != NLAT * DM || ws_size < WS_END) { fprintf(stderr, "kernel_launch: unexpected shapes (n_in %d out %d ws %zu)\n", n_in, out_size, ws_size); grid = -1; return; }
        int dev = 0, cus = 0, per_cu = 0;
        if (hipGetDevice(&dev) != hipSuccess || hipDeviceGetAttribute(&cus, hipDeviceAttributeMultiprocessorCount, dev) != hipSuccess) { grid = -1; return; }
        if (hipFuncSetAttribute((const void*)mk_fwd, hipFuncAttributeMaxDynamicSharedMemorySize, LDS_BYTES) != hipSuccess) { fprintf(stderr, "kernel_launch: hipFuncSetAttribute failed\n"); grid = -1; return; }
        if (hipOccupancyMaxActiveBlocksPerMultiprocessor(&per_cu, (const void*)mk_fwd, NTHREADS, LDS_BYTES) != hipSuccess || per_cu < 1) fprintf(stderr, "kernel_launch: occupancy query says %d\n", per_cu);
        (void)hipGetLastError();
        grid = cus;
    }
    if (grid < 0) return;
    (void)hipMemsetAsync((char*)d_ws + WS_CTL, 0, CTL_ZERO_BYTES, stream);
    Args a{};
    for (int k = 0; k < N_IN; ++k) a.in[k] = (const float*)d_in[k];
    a.out = (float*)d_out; a.ws = (unsigned char*)d_ws;
#if MK_SPLIT
    for (int p = 0; p < N_PHASES; ++p) { a.ph_lo = p; a.ph_hi = p + 1; hipLaunchKernelGGL(mk_fwd, dim3(grid), dim3(NTHREADS), LDS_BYTES, stream, a); }
#else
    a.ph_lo = 0; a.ph_hi = N_PHASES;
    hipLaunchKernelGGL(mk_fwd, dim3(grid), dim3(NTHREADS), LDS_BYTES, stream, a);
#endif
}
```

```cpp
#ifndef EMU
#include <hip/hip_runtime.h>
#endif
#include <cstdio>
#include <cstdint>
#include <cmath>

constexpr int DM = 1024, NLAT = 16384, NCTX = 256, NTOK = NLAT + NCTX;
constexpr int GRIDW = 64, GRIDH = 256;
constexpr int AIN = 3328;
constexpr int RIN = 4224, RINP = 4352;
constexpr int URW_W = 2176;
constexpr int UHY_W = 1536;
constexpr int NWAVES = 8, NTHREADS = 512;
constexpr float C2 = 0.125f * 1.4426950408889634f;
constexpr float LOG2E = 1.4426950408889634f;
constexpr float NORM_EPS = 1e-6f;

typedef unsigned short bf16_t;

constexpr size_t MiB = 1u << 20;
constexpr size_t WS_CTL = 0, CTL_ZERO_BYTES = 256 * 1024;
constexpr size_t WS_ADA = 1 * MiB;
constexpr size_t WS_TW = WS_ADA + 128 * 1024;
constexpr size_t WS_HID256 = WS_TW + 160 * 1024;
constexpr size_t WS_BONUS = WS_HID256 + 64 * 1024;
constexpr size_t WS_XCTX = 3 * MiB;
constexpr size_t WS_VXC = 4 * MiB;
constexpr size_t WS_HID = 6 * MiB;
constexpr size_t WS_WAIN = 14 * MiB;
constexpr size_t WS_WAOUT = 27 * MiB;
constexpr size_t WS_WRIN = 31 * MiB;
constexpr size_t WS_WROUT = 48 * MiB;
constexpr size_t WS_XN = 52 * MiB;
constexpr size_t WS_U = 85 * MiB;
constexpr size_t WS_UHY = 155 * MiB;
constexpr size_t WS_GHY = 204 * MiB;
constexpr size_t WS_VX0 = 52 * MiB, WS_VX1 = 68 * MiB;
constexpr size_t WS_VX2 = 221 * MiB;
constexpr size_t WS_YHY = 155 * MiB;
constexpr size_t WS_YB = 171 * MiB;
constexpr size_t WS_YF = 187 * MiB + 512 * 1024;
constexpr size_t WS_HYOUT = 238 * MiB;
constexpr size_t WS_END = 256 * MiB;
static_assert(WS_U + (size_t)NTOK * AIN * 2 <= WS_END, "U attn");
static_assert(WS_U + (size_t)NTOK * URW_W * 2 <= WS_UHY && WS_UHY + (size_t)NTOK * UHY_W * 2 <= WS_GHY && WS_GHY + (size_t)NTOK * 512 * 2 <= WS_VX2, "rec map 1");
static_assert(WS_VX2 + (size_t)512 * 16384 * 2 <= WS_HYOUT && WS_HYOUT + (size_t)NTOK * 512 * 2 <= WS_END, "rec map 2");
static_assert(WS_YHY + (size_t)512 * 16384 * 2 <= WS_YB && WS_YB + (size_t)NTOK * 512 * 2 <= WS_YF && WS_YF + (size_t)NTOK * 512 * 2 <= WS_GHY, "rec map 3");
static_assert(WS_XN + (size_t)NTOK * DM * 2 <= WS_U && WS_VX1 + (size_t)512 * 16384 * 2 <= WS_U, "xn map");

constexpr int LDS_BYTES = 160 * 1024;
constexpr int MISC_OFF = LDS_BYTES - 256;
constexpr int RING_BYTES = MISC_OFF;

#ifdef EMU
#define DEVFN inline
#else
#define DEVFN __device__ __forceinline__
#endif

DEVFN float bf2f(bf16_t h) { union { unsigned u; float f; } x; x.u = ((unsigned)h) << 16; return x.f; }
#ifdef EMU
DEVFN unsigned f2bf(float f) { union { unsigned u; float f; } x; x.f = f; unsigned u = x.u; return (u + 0x7fffu + ((u >> 16) & 1u)) >> 16; }
DEVFN unsigned pk2(float lo, float hi) { return f2bf(lo) | (f2bf(hi) << 16); }
#else
typedef float f32x2_hw __attribute__((ext_vector_type(2))); typedef __bf16 bf16x2_hw __attribute__((ext_vector_type(2)));
DEVFN unsigned pk2(float lo, float hi) { f32x2_hw v = {lo, hi}; bf16x2_hw b = __builtin_convertvector(v, bf16x2_hw); return __builtin_bit_cast(unsigned, b); }
DEVFN unsigned f2bf(float f) { return pk2(f, 0.f) & 0xffffu; }
#endif
DEVFN float bflo(unsigned w) { union { unsigned u; float f; } x; x.u = w << 16; return x.f; }
DEVFN float bfhi(unsigned w) { union { unsigned u; float f; } x; x.u = w & 0xffff0000u; return x.f; }
struct U4 { unsigned x, y, z, w; };
struct U2 { unsigned x, y; };
struct F2 { float x, y; };
struct F4 { float x, y, z, w; };
DEVFN float silu_f(float v) { return v / (1.0f + expf(-v)); }
DEVFN float sigmoid_f(float v) { return 1.0f / (1.0f + expf(-v)); }
#define SCAN_CHUNK_ASM \
    "ds_read_b128 v[96:99], %[ab] offset:24576\n\t" \
    "ds_read_b128 v[100:103], %[ab] offset:0\n\t" \
    "ds_read_b128 v[104:107], %[ab] offset:16384\n\t" \
    "ds_read_b128 v[108:111], %[ab] offset:8192\n\t" \
    "ds_read_b128 v[112:115], %[ab] offset:32768\n\t" \
    "ds_read_b32 v116, %[av] offset:0\n\t" \
    "s_waitcnt lgkmcnt(0)\n\t" \
    "ds_read_b128 v[118:121], %[ab] offset:24832\n\t" \
    "ds_read_b128 v[122:125], %[ab] offset:256\n\t" \
    "ds_read_b128 v[126:129], %[ab] offset:16640\n\t" \
    "ds_read_b128 v[130:133], %[ab] offset:8448\n\t" \
    "ds_read_b128 v[134:137], %[ab] offset:33024\n\t" \
    "ds_read_b32 v138, %[av] offset:64\n\t" \
    "v_pk_mul_f32 v[140:141], %[s01], v[96:97]\n\t" \
    "v_pk_fma_f32 v[140:141], %[s23], v[98:99], v[140:141]\n\t" \
    "v_add_f32 v146, v140, v141\n\t" \
    "v_pk_mul_f32 v[142:143], %[s01], v[100:101]\n\t" \
    "v_pk_mul_f32 v[144:145], %[s23], v[102:103]\n\t" \
    "v_add_f32_dpp v146, v146, v146 quad_perm:[1,0,3,2] row_mask:0xf bank_mask:0xf bound_ctrl:1\n\t" \
    "v_add_f32_dpp %[yp], %[yp], %[yp] quad_perm:[1,0,3,2] row_mask:0xf bank_mask:0xf bound_ctrl:1\n\t" \
    "v_pk_fma_f32 v[142:143], v[116:117], v[108:109], v[142:143] op_sel_hi:[0,1,1]\n\t" \
    "v_add_f32_dpp v146, v146, v146 quad_perm:[2,3,0,1] row_mask:0xf bank_mask:0xf bound_ctrl:1\n\t" \
    "v_add_f32_dpp %[yp], %[yp], %[yp] quad_perm:[2,3,0,1] row_mask:0xf bank_mask:0xf bound_ctrl:1\n\t" \
    "v_pk_fma_f32 v[144:145], v[116:117], v[110:111], v[144:145] op_sel_hi:[0,1,1]\n\t" \
    "v_add_f32_dpp v146, v146, v146 row_half_mirror row_mask:0xf bank_mask:0xf bound_ctrl:1\n\t" \
    "v_add_f32_dpp %[yp], %[yp], %[yp] row_half_mirror row_mask:0xf bank_mask:0xf bound_ctrl:1\n\t" \
    "v_cmp_eq_u32_e32 vcc, 15, %[sp]\n\t" \
    "v_add_f32_dpp v146, v146, v146 row_mirror row_mask:0xf bank_mask:0xf bound_ctrl:1\n\t" \
    "v_add_f32_dpp %[yp], %[yp], %[yp] row_mirror row_mask:0xf bank_mask:0xf bound_ctrl:1\n\t" \
    "v_cndmask_b32_e32 %[yk0], %[yk0], %[yp], vcc\n\t" \
    "v_pk_fma_f32 %[s01], v[146:147], v[104:105], v[142:143] op_sel_hi:[0,1,1] neg_lo:[1,0,0] neg_hi:[1,0,0]\n\t" \
    "v_pk_fma_f32 %[s23], v[146:147], v[106:107], v[144:145] op_sel_hi:[0,1,1] neg_lo:[1,0,0] neg_hi:[1,0,0]\n\t" \
    "v_pk_mul_f32 v[140:141], %[s01], v[112:113]\n\t" \
    "v_pk_fma_f32 v[140:141], %[s23], v[114:115], v[140:141]\n\t" \
    "v_add_f32 %[yp], v140, v141\n\t" \
    "s_waitcnt lgkmcnt(0)\n\t" \
    "ds_read_b128 v[96:99], %[ab] offset:25088\n\t" \
    "ds_read_b128 v[100:103], %[ab] offset:512\n\t" \
    "ds_read_b128 v[104:107], %[ab] offset:16896\n\t" \
    "ds_read_b128 v[108:111], %[ab] offset:8704\n\t" \
    "ds_read_b128 v[112:115], %[ab] offset:33280\n\t" \
    "ds_read_b32 v116, %[av] offset:128\n\t" \
    "v_pk_mul_f32 v[140:141], %[s01], v[118:119]\n\t" \
    "v_pk_fma_f32 v[140:141], %[s23], v[120:121], v[140:141]\n\t" \
    "v_add_f32 v146, v140, v141\n\t" \
    "v_pk_mul_f32 v[142:143], %[s01], v[122:123]\n\t" \
    "v_pk_mul_f32 v[144:145], %[s23], v[124:125]\n\t" \
    "v_add_f32_dpp v146, v146, v146 quad_perm:[1,0,3,2] row_mask:0xf bank_mask:0xf bound_ctrl:1\n\t" \
    "v_add_f32_dpp %[yp], %[yp], %[yp] quad_perm:[1,0,3,2] row_mask:0xf bank_mask:0xf bound_ctrl:1\n\t" \
    "v_pk_fma_f32 v[142:143], v[138:139], v[130:131], v[142:143] op_sel_hi:[0,1,1]\n\t" \
    "v_add_f32_dpp v146, v146, v146 quad_perm:[2,3,0,1] row_mask:0xf bank_mask:0xf bound_ctrl:1\n\t" \
    "v_add_f32_dpp %[yp], %[yp], %[yp] quad_perm:[2,3,0,1] row_mask:0xf bank_mask:0xf bound_ctrl:1\n\t" \
    "v_pk_fma_f32 v[144:145], v[138:139], v[132:133], v[144:145] op_sel_hi:[0,1,1]\n\t" \
    "v_add_f32_dpp v146, v146, v146 row_half_mirror row_mask:0xf bank_mask:0xf bound_ctrl:1\n\t" \
    "v_add_f32_dpp %[yp], %[yp], %[yp] row_half_mirror row_mask:0xf bank_mask:0xf bound_ctrl:1\n\t" \
    "v_cmp_eq_u32_e32 vcc, 0, %[sp]\n\t" \
    "v_add_f32_dpp v146, v146, v146 row_mirror row_mask:0xf bank_mask:0xf bound_ctrl:1\n\t" \
    "v_add_f32_dpp %[yp], %[yp], %[yp] row_mirror row_mask:0xf bank_mask:0xf bound_ctrl:1\n\t" \
    "v_cndmask_b32_e32 %[yk0], %[yk0], %[yp], vcc\n\t" \
    "v_pk_fma_f32 %[s01], v[146:147], v[126:127], v[142:143] op_sel_hi:[0,1,1] neg_lo:[1,0,0] neg_hi:[1,0,0]\n\t" \
    "v_pk_fma_f32 %[s23], v[146:147], v[128:129], v[144:145] op_sel_hi:[0,1,1] neg_lo:[1,0,0] neg_hi:[1,0,0]\n\t" \
    "v_pk_mul_f32 v[140:141], %[s01], v[134:135]\n\t" \
    "v_pk_fma_f32 v[140:141], %[s23], v[136:137], v[140:141]\n\t" \
    "v_add_f32 %[yp], v140, v141\n\t" \
    "s_waitcnt lgkmcnt(0)\n\t" \
    "ds_read_b128 v[118:121], %[ab] offset:25344\n\t" \
    "ds_read_b128 v[122:125], %[ab] offset:768\n\t" \
    "ds_read_b128 v[126:129], %[ab] offset:17152\n\t" \
    "ds_read_b128 v[130:133], %[ab] offset:8960\n\t" \
    "ds_read_b128 v[134:137], %[ab] offset:33536\n\t" \
    "ds_read_b32 v138, %[av] offset:192\n\t" \
    "v_pk_mul_f32 v[140:141], %[s01], v[96:97]\n\t" \
    "v_pk_fma_f32 v[140:141], %[s23], v[98:99], v[140:141]\n\t" \
    "v_add_f32 v146, v140, v141\n\t" \
    "v_pk_mul_f32 v[142:143], %[s01], v[100:101]\n\t" \
    "v_pk_mul_f32 v[144:145], %[s23], v[102:103]\n\t" \
    "v_add_f32_dpp v146, v146, v146 quad_perm:[1,0,3,2] row_mask:0xf bank_mask:0xf bound_ctrl:1\n\t" \
    "v_add_f32_dpp %[yp], %[yp], %[yp] quad_perm:[1,0,3,2] row_mask:0xf bank_mask:0xf bound_ctrl:1\n\t" \
    "v_pk_fma_f32 v[142:143], v[116:117], v[108:109], v[142:143] op_sel_hi:[0,1,1]\n\t" \
    "v_add_f32_dpp v146, v146, v146 quad_perm:[2,3,0,1] row_mask:0xf bank_mask:0xf bound_ctrl:1\n\t" \
    "v_add_f32_dpp %[yp], %[yp], %[yp] quad_perm:[2,3,0,1] row_mask:0xf bank_mask:0xf bound_ctrl:1\n\t" \
    "v_pk_fma_f32 v[144:145], v[116:117], v[110:111], v[144:145] op_sel_hi:[0,1,1]\n\t" \
    "v_add_f32_dpp v146, v146, v146 row_half_mirror row_mask:0xf bank_mask:0xf bound_ctrl:1\n\t" \
    "v_add_f32_dpp %[yp], %[yp], %[yp] row_half_mirror row_mask:0xf bank_mask:0xf bound_ctrl:1\n\t" \
    "v_cmp_eq_u32_e32 vcc, 1, %[sp]\n\t" \
    "v_add_f32_dpp v146, v146, v146 row_mirror row_mask:0xf bank_mask:0xf bound_ctrl:1\n\t" \
    "v_add_f32_dpp %[yp], %[yp], %[yp] row_mirror row_mask:0xf bank_mask:0xf bound_ctrl:1\n\t" \
    "v_cndmask_b32_e32 %[yk0], %[yk0], %[yp], vcc\n\t" \
    "v_pk_fma_f32 %[s01], v[146:147], v[104:105], v[142:143] op_sel_hi:[0,1,1] neg_lo:[1,0,0] neg_hi:[1,0,0]\n\t" \
    "v_pk_fma_f32 %[s23], v[146:147], v[106:107], v[144:145] op_sel_hi:[0,1,1] neg_lo:[1,0,0] neg_hi:[1,0,0]\n\t" \
    "v_pk_mul_f32 v[140:141], %[s01], v[112:113]\n\t" \
    "v_pk_fma_f32 v[140:141], %[s23], v[114:115], v[140:141]\n\t" \
    "v_add_f32 %[yp], v140, v141\n\t" \
    "s_waitcnt lgkmcnt(0)\n\t" \
    "ds_read_b128 v[96:99], %[ab] offset:25600\n\t" \
    "ds_read_b128 v[100:103], %[ab] offset:1024\n\t" \
    "ds_read_b128 v[104:107], %[ab] offset:17408\n\t" \
    "ds_read_b128 v[108:111], %[ab] offset:9216\n\t" \
    "ds_read_b128 v[112:115], %[ab] offset:33792\n\t" \
    "ds_read_b32 v116, %[av] offset:256\n\t" \
    "v_pk_mul_f32 v[140:141], %[s01], v[118:119]\n\t" \
    "v_pk_fma_f32 v[140:141], %[s23], v[120:121], v[140:141]\n\t" \
    "v_add_f32 v146, v140, v141\n\t" \
    "v_pk_mul_f32 v[142:143], %[s01], v[122:123]\n\t" \
    "v_pk_mul_f32 v[144:145], %[s23], v[124:125]\n\t" \
    "v_add_f32_dpp v146, v146, v146 quad_perm:[1,0,3,2] row_mask:0xf bank_mask:0xf bound_ctrl:1\n\t" \
    "v_add_f32_dpp %[yp], %[yp], %[yp] quad_perm:[1,0,3,2] row_mask:0xf bank_mask:0xf bound_ctrl:1\n\t" \
    "v_pk_fma_f32 v[142:143], v[138:139], v[130:131], v[142:143] op_sel_hi:[0,1,1]\n\t" \
    "v_add_f32_dpp v146, v146, v146 quad_perm:[2,3,0,1] row_mask:0xf bank_mask:0xf bound_ctrl:1\n\t" \
    "v_add_f32_dpp %[yp], %[yp], %[yp] quad_perm:[2,3,0,1] row_mask:0xf bank_mask:0xf bound_ctrl:1\n\t" \
    "v_pk_fma_f32 v[144:145], v[138:139], v[132:133], v[144:145] op_sel_hi:[0,1,1]\n\t" \
    "v_add_f32_dpp v146, v146, v146 row_half_mirror row_mask:0xf bank_mask:0xf bound_ctrl:1\n\t" \
    "v_add_f32_dpp %[yp], %[yp], %[yp] row_half_mirror row_mask:0xf bank_mask:0xf bound_ctrl:1\n\t" \
    "v_cmp_eq_u32_e32 vcc, 2, %[sp]\n\t" \
    "v_add_f32_dpp v146, v146, v146 row_mirror row_mask:0xf bank_mask:0xf bound_ctrl:1\n\t" \
    "v_add_f32_dpp %[yp], %[yp], %[yp] row_mirror row_mask:0xf bank_mask:0xf bound_ctrl:1\n\t" \
    "v_cndmask_b32_e32 %[yk0], %[yk0], %[yp], vcc\n\t" \
    "v_pk_fma_f32 %[s01], v[146:147], v[126:127], v[142:143] op_sel_hi:[0,1,1] neg_lo:[1,0,0] neg_hi:[1,0,0]\n\t" \
    "v_pk_fma_f32 %[s23], v[146:147], v[128:129], v[144:145] op_sel_hi:[0,1,1] neg_lo:[1,0,0] neg_hi:[1,0,0]\n\t" \
    "v_pk_mul_f32 v[140:141], %[s01], v[134:135]\n\t" \
    "v_pk_fma_f32 v[140:141], %[s23], v[136:137], v[140:141]\n\t" \
    "v_add_f32 %[yp], v140, v141\n\t" \
    "s_waitcnt lgkmcnt(0)\n\t" \
    "ds_read_b128 v[118:121], %[ab] offset:25856\n\t" \
    "ds_read_b128 v[122:125], %[ab] offset:1280\n\t" \
    "ds_read_b128 v[126:129], %[ab] offset:17664\n\t" \
    "ds_read_b128 v[130:133], %[ab] offset:9472\n\t" \
    "ds_read_b128 v[134:137], %[ab] offset:34048\n\t" \
    "ds_read_b32 v138, %[av] offset:320\n\t" \
    "v_pk_mul_f32 v[140:141], %[s01], v[96:97]\n\t" \
    "v_pk_fma_f32 v[140:141], %[s23], v[98:99], v[140:141]\n\t" \
    "v_add_f32 v146, v140, v141\n\t" \
    "v_pk_mul_f32 v[142:143], %[s01], v[100:101]\n\t" \
    "v_pk_mul_f32 v[144:145], %[s23], v[102:103]\n\t" \
    "v_add_f32_dpp v146, v146, v146 quad_perm:[1,0,3,2] row_mask:0xf bank_mask:0xf bound_ctrl:1\n\t" \
    "v_add_f32_dpp %[yp], %[yp], %[yp] quad_perm:[1,0,3,2] row_mask:0xf bank_mask:0xf bound_ctrl:1\n\t" \
    "v_pk_fma_f32 v[142:143], v[116:117], v[108:109], v[142:143] op_sel_hi:[0,1,1]\n\t" \
    "v_add_f32_dpp v146, v146, v146 quad_perm:[2,3,0,1] row_mask:0xf bank_mask:0xf bound_ctrl:1\n\t" \
    "v_add_f32_dpp %[yp], %[yp], %[yp] quad_perm:[2,3,0,1] row_mask:0xf bank_mask:0xf bound_ctrl:1\n\t" \
    "v_pk_fma_f32 v[144:145], v[116:117], v[110:111], v[144:145] op_sel_hi:[0,1,1]\n\t" \
    "v_add_f32_dpp v146, v146, v146 row_half_mirror row_mask:0xf bank_mask:0xf bound_ctrl:1\n\t" \
    "v_add_f32_dpp %[yp], %[yp], %[yp] row_half_mirror row_mask:0xf bank_mask:0xf bound_ctrl:1\n\t" \
    "v_cmp_eq_u32_e32 vcc, 3, %[sp]\n\t" \
    "v_add_f32_dpp v146, v146, v146 row_mirror row_mask:0xf bank_mask:0xf bound_ctrl:1\n\t" \
    "v_add_f32_dpp %[yp], %[yp], %[yp] row_mirror row_mask:0xf bank_mask:0xf bound_ctrl:1\n\t" \
    "v_cndmask_b32_e32 %[yk0], %[yk0], %[yp], vcc\n\t" \
    "v_pk_fma_f32 %[s01], v[146:147], v[104:105], v[142:143] op_sel_hi:[0,1,1] neg_lo:[1,0,0] neg_hi:[1,0,0]\n\t" \
    "v_pk_fma_f32 %[s23], v[146:147], v[106:107], v[144:145] op_sel_hi:[0,1,1] neg_lo:[1,0,0] neg_hi:[1,0,0]\n\t" \
    "v_pk_mul_f32 v[140:141], %[s01], v[112:113]\n\t" \
    "v_pk_fma_f32 v[140:141], %[s23], v[114:115], v[140:141]\n\t" \
    "v_add_f32 %[yp], v140, v141\n\t" \
    "s_waitcnt lgkmcnt(0)\n\t" \
    "ds_read_b128 v[96:99], %[ab] offset:26112\n\t" \
    "ds_read_b128 v[100:103], %[ab] offset:1536\n\t" \
    "ds_read_b128 v[104:107], %[ab] offset:17920\n\t" \
    "ds_read_b128 v[108:111], %[ab] offset:9728\n\t" \
    "ds_read_b128 v[112:115], %[ab] offset:34304\n\t" \
    "ds_read_b32 v116, %[av] offset:384\n\t" \
    "v_pk_mul_f32 v[140:141], %[s01], v[118:119]\n\t" \
    "v_pk_fma_f32 v[140:141], %[s23], v[120:121], v[140:141]\n\t" \
    "v_add_f32 v146, v140, v141\n\t" \
    "v_pk_mul_f32 v[142:143], %[s01], v[122:123]\n\t" \
    "v_pk_mul_f32 v[144:145], %[s23], v[124:125]\n\t" \
    "v_add_f32_dpp v146, v146, v146 quad_perm:[1,0,3,2] row_mask:0xf bank_mask:0xf bound_ctrl:1\n\t" \
    "v_add_f32_dpp %[yp], %[yp], %[yp] quad_perm:[1,0,3,2] row_mask:0xf bank_mask:0xf bound_ctrl:1\n\t" \
    "v_pk_fma_f32 v[142:143], v[138:139], v[130:131], v[142:143] op_sel_hi:[0,1,1]\n\t" \
    "v_add_f32_dpp v146, v146, v146 quad_perm:[2,3,0,1] row_mask:0xf bank_mask:0xf bound_ctrl:1\n\t" \
    "v_add_f32_dpp %[yp], %[yp], %[yp] quad_perm:[2,3,0,1] row_mask:0xf bank_mask:0xf bound_ctrl:1\n\t" \
    "v_pk_fma_f32 v[144:145], v[138:139], v[132:133], v[144:145] op_sel_hi:[0,1,1]\n\t" \
    "v_add_f32_dpp v146, v146, v146 row_half_mirror row_mask:0xf bank_mask:0xf bound_ctrl:1\n\t" \
    "v_add_f32_dpp %[yp], %[yp], %[yp] row_half_mirror row_mask:0xf bank_mask:0xf bound_ctrl:1\n\t" \
    "v_cmp_eq_u32_e32 vcc, 4, %[sp]\n\t" \
    "v_add_f32_dpp v146, v146, v146 row_mirror row_mask:0xf bank_mask:0xf bound_ctrl:1\n\t" \
    "v_add_f32_dpp %[yp], %[yp], %[yp] row_mirror row_mask:0xf bank_mask:0xf bound_ctrl:1\n\t" \
    "v_cndmask_b32_e32 %[yk0], %[yk0], %[yp], vcc\n\t" \
    "v_pk_fma_f32 %[s01], v[146:147], v[126:127], v[142:143] op_sel_hi:[0,1,1] neg_lo:[1,0,0] neg_hi:[1,0,0]\n\t" \
    "v_pk_fma_f32 %[s23], v[146:147], v[128:129], v[144:145] op_sel_hi:[0,1,1] neg_lo:[1,0,0] neg_hi:[1,0,0]\n\t" \
    "v_pk_mul_f32 v[140:141], %[s01], v[134:135]\n\t" \
    "v_pk_fma_f32 v[140:141], %[s23], v[136:137], v[140:141]\n\t" \
    "v_add_f32 %[yp], v140, v141\n\t" \
    "s_waitcnt lgkmcnt(0)\n\t" \
    "ds_read_b128 v[118:121], %[ab] offset:26368\n\t" \
    "ds_read_b128 v[122:125], %[ab] offset:1792\n\t" \
    "ds_read_b128 v[126:129], %[ab] offset:18176\n\t" \
    "ds_read_b128 v[130:133], %[ab] offset:9984\n\t" \
    "ds_read_b128 v[134:137], %[ab] offset:34560\n\t" \
    "ds_read_b32 v138, %[av] offset:448\n\t" \
    "v_pk_mul_f32 v[140:141], %[s01], v[96:97]\n\t" \
    "v_pk_fma_f32 v[140:141], %[s23], v[98:99], v[140:141]\n\t" \
    "v_add_f32 v146, v140, v141\n\t" \
    "v_pk_mul_f32 v[142:143], %[s01], v[100:101]\n\t" \
    "v_pk_mul_f32 v[144:145], %[s23], v[102:103]\n\t" \
    "v_add_f32_dpp v146, v146, v146 quad_perm:[1,0,3,2] row_mask:0xf bank_mask:0xf bound_ctrl:1\n\t" \
    "v_add_f32_dpp %[yp], %[yp], %[yp] quad_perm:[1,0,3,2] row_mask:0xf bank_mask:0xf bound_ctrl:1\n\t" \
    "v_pk_fma_f32 v[142:143], v[116:117], v[108:109], v[142:143] op_sel_hi:[0,1,1]\n\t" \
    "v_add_f32_dpp v146, v146, v146 quad_perm:[2,3,0,1] row_mask:0xf bank_mask:0xf bound_ctrl:1\n\t" \
    "v_add_f32_dpp %[yp], %[yp], %[yp] quad_perm:[2,3,0,1] row_mask:0xf bank_mask:0xf bound_ctrl:1\n\t" \
    "v_pk_fma_f32 v[144:145], v[116:117], v[110:111], v[144:145] op_sel_hi:[0,1,1]\n\t" \
    "v_add_f32_dpp v146, v146, v146 row_half_mirror row_mask:0xf bank_mask:0xf bound_ctrl:1\n\t" \
    "v_add_f32_dpp %[yp], %[yp], %[yp] row_half_mirror row_mask:0xf bank_mask:0xf bound_ctrl:1\n\t" \
    "v_cmp_eq_u32_e32 vcc, 5, %[sp]\n\t" \
    "v_add_f32_dpp v146, v146, v146 row_mirror row_mask:0xf bank_mask:0xf bound_ctrl:1\n\t" \
    "v_add_f32_dpp %[yp], %[yp], %[yp] row_mirror row_mask:0xf bank_mask:0xf bound_ctrl:1\n\t" \
    "v_cndmask_b32_e32 %[yk0], %[yk0], %[yp], vcc\n\t" \
    "v_pk_fma_f32 %[s01], v[146:147], v[104:105], v[142:143] op_sel_hi:[0,1,1] neg_lo:[1,0,0] neg_hi:[1,0,0]\n\t" \
    "v_pk_fma_f32 %[s23], v[146:147], v[106:107], v[144:145] op_sel_hi:[0,1,1] neg_lo:[1,0,0] neg_hi:[1,0,0]\n\t" \
    "v_pk_mul_f32 v[140:141], %[s01], v[112:113]\n\t" \
    "v_pk_fma_f32 v[140:141], %[s23], v[114:115], v[140:141]\n\t" \
    "v_add_f32 %[yp], v140, v141\n\t" \
    "s_waitcnt lgkmcnt(0)\n\t" \
    "ds_read_b128 v[96:99], %[ab] offset:26624\n\t" \
    "ds_read_b128 v[100:103], %[ab] offset:2048\n\t" \
    "ds_read_b128 v[104:107], %[ab] offset:18432\n\t" \
    "ds_read_b128 v[108:111], %[ab] offset:10240\n\t" \
    "ds_read_b128 v[112:115], %[ab] offset:34816\n\t" \
    "ds_read_b32 v116, %[av] offset:512\n\t" \
    "v_pk_mul_f32 v[140:141], %[s01], v[118:119]\n\t" \
    "v_pk_fma_f32 v[140:141], %[s23], v[120:121], v[140:141]\n\t" \
    "v_add_f32 v146, v140, v141\n\t" \
    "v_pk_mul_f32 v[142:143], %[s01], v[122:123]\n\t" \
    "v_pk_mul_f32 v[144:145], %[s23], v[124:125]\n\t" \
    "v_add_f32_dpp v146, v146, v146 quad_perm:[1,0,3,2] row_mask:0xf bank_mask:0xf bound_ctrl:1\n\t" \
    "v_add_f32_dpp %[yp], %[yp], %[yp] quad_perm:[1,0,3,2] row_mask:0xf bank_mask:0xf bound_ctrl:1\n\t" \
    "v_pk_fma_f32 v[142:143], v[138:139], v[130:131], v[142:143] op_sel_hi:[0,1,1]\n\t" \
    "v_add_f32_dpp v146, v146, v146 quad_perm:[2,3,0,1] row_mask:0xf bank_mask:0xf bound_ctrl:1\n\t" \
    "v_add_f32_dpp %[yp], %[yp], %[yp] quad_perm:[2,3,0,1] row_mask:0xf bank_mask:0xf bound_ctrl:1\n\t" \
    "v_pk_fma_f32 v[144:145], v[138:139], v[132:133], v[144:145] op_sel_hi:[0,1,1]\n\t" \
    "v_add_f32_dpp v146, v146, v146 row_half_mirror row_mask:0xf bank_mask:0xf bound_ctrl:1\n\t" \
    "v_add_f32_dpp %[yp], %[yp], %[yp] row_half_mirror row_mask:0xf bank_mask:0xf bound_ctrl:1\n\t" \
    "v_cmp_eq_u32_e32 vcc, 6, %[sp]\n\t" \
    "v_add_f32_dpp v146, v146, v146 row_mirror row_mask:0xf bank_mask:0xf bound_ctrl:1\n\t" \
    "v_add_f32_dpp %[yp], %[yp], %[yp] row_mirror row_mask:0xf bank_mask:0xf bound_ctrl:1\n\t" \
    "v_cndmask_b32_e32 %[yk0], %[yk0], %[yp], vcc\n\t" \
    "v_pk_fma_f32 %[s01], v[146:147], v[126:127], v[142:143] op_sel_hi:[0,1,1] neg_lo:[1,0,0] neg_hi:[1,0,0]\n\t" \
    "v_pk_fma_f32 %[s23], v[146:147], v[128:129], v[144:145] op_sel_hi:[0,1,1] neg_lo:[1,0,0] neg_hi:[1,0,0]\n\t" \
    "v_pk_mul_f32 v[140:141], %[s01], v[134:135]\n\t" \
    "v_pk_fma_f32 v[140:141], %[s23], v[136:137], v[140:141]\n\t" \
    "v_add_f32 %[yp], v140, v141\n\t" \
    "s_waitcnt lgkmcnt(0)\n\t" \
    "ds_read_b128 v[118:121], %[ab] offset:26880\n\t" \
    "ds_read_b128 v[122:125], %[ab] offset:2304\n\t" \
    "ds_read_b128 v[126:129], %[ab] offset:18688\n\t" \
    "ds_read_b128 v[130:133], %[ab] offset:10496\n\t" \
    "ds_read_b128 v[134:137], %[ab] offset:35072\n\t" \
    "ds_read_b32 v138, %[av] offset:576\n\t" \
    "v_pk_mul_f32 v[140:141], %[s01], v[96:97]\n\t" \
    "v_pk_fma_f32 v[140:141], %[s23], v[98:99], v[140:141]\n\t" \
    "v_add_f32 v146, v140, v141\n\t" \
    "v_pk_mul_f32 v[142:143], %[s01], v[100:101]\n\t" \
    "v_pk_mul_f32 v[144:145], %[s23], v[102:103]\n\t" \
    "v_add_f32_dpp v146, v146, v146 quad_perm:[1,0,3,2] row_mask:0xf bank_mask:0xf bound_ctrl:1\n\t" \
    "v_add_f32_dpp %[yp], %[yp], %[yp] quad_perm:[1,0,3,2] row_mask:0xf bank_mask:0xf bound_ctrl:1\n\t" \
    "v_pk_fma_f32 v[142:143], v[116:117], v[108:109], v[142:143] op_sel_hi:[0,1,1]\n\t" \
    "v_add_f32_dpp v146, v146, v146 quad_perm:[2,3,0,1] row_mask:0xf bank_mask:0xf bound_ctrl:1\n\t" \
    "v_add_f32_dpp %[yp], %[yp], %[yp] quad_perm:[2,3,0,1] row_mask:0xf bank_mask:0xf bound_ctrl:1\n\t" \
    "v_pk_fma_f32 v[144:145], v[116:117], v[110:111], v[144:145] op_sel_hi:[0,1,1]\n\t" \
    "v_add_f32_dpp v146, v146, v146 row_half_mirror row_mask:0xf bank_mask:0xf bound_ctrl:1\n\t" \
    "v_add_f32_dpp %[yp], %[yp], %[yp] row_half_mirror row_mask:0xf bank_mask:0xf bound_ctrl:1\n\t" \
    "v_cmp_eq_u32_e32 vcc, 7, %[sp]\n\t" \
    "v_add_f32_dpp v146, v146, v146 row_mirror row_mask:0xf bank_mask:0xf bound_ctrl:1\n\t" \
    "v_add_f32_dpp %[yp], %[yp], %[yp] row_mirror row_mask:0xf bank_mask:0xf bound_ctrl:1\n\t" \
    "v_cndmask_b32_e32 %[yk0], %[yk0], %[yp], vcc\n\t" \
    "v_pk_fma_f32 %[s01], v[146:147], v[104:105], v[142:143] op_sel_hi:[0,1,1] neg_lo:[1,0,0] neg_hi:[1,0,0]\n\t" \
    "v_pk_fma_f32 %[s23], v[146:147], v[106:107], v[144:145] op_sel_hi:[0,1,1] neg_lo:[1,0,0] neg_hi:[1,0,0]\n\t" \
    "v_pk_mul_f32 v[140:141], %[s01], v[112:113]\n\t" \
    "v_pk_fma_f32 v[140:141], %[s23], v[114:115], v[140:141]\n\t" \
    "v_add_f32 %[yp], v140, v141\n\t" \
    "s_waitcnt lgkmcnt(0)\n\t" \
    "ds_read_b128 v[96:99], %[ab] offset:27136\n\t" \
    "ds_read_b128 v[100:103], %[ab] offset:2560\n\t" \
    "ds_read_b128 v[104:107], %[ab] offset:18944\n\t" \
    "ds_read_b128 v[108:111], %[ab] offset:10752\n\t" \
    "ds_read_b128 v[112:115], %[ab] offset:35328\n\t" \
    "ds_read_b32 v116, %[av] offset:640\n\t" \
    "v_pk_mul_f32 v[140:141], %[s01], v[118:119]\n\t" \
    "v_pk_fma_f32 v[140:141], %[s23], v[120:121], v[140:141]\n\t" \
    "v_add_f32 v146, v140, v141\n\t" \
    "v_pk_mul_f32 v[142:143], %[s01], v[122:123]\n\t" \
    "v_pk_mul_f32 v[144:145], %[s23], v[124:125]\n\t" \
    "v_add_f32_dpp v146, v146, v146 quad_perm:[1,0,3,2] row_mask:0xf bank_mask:0xf bound_ctrl:1\n\t" \
    "v_add_f32_dpp %[yp], %[yp], %[yp] quad_perm:[1,0,3,2] row_mask:0xf bank_mask:0xf bound_ctrl:1\n\t" \
    "v_pk_fma_f32 v[142:143], v[138:139], v[130:131], v[142:143] op_sel_hi:[0,1,1]\n\t" \
    "v_add_f32_dpp v146, v146, v146 quad_perm:[2,3,0,1] row_mask:0xf bank_mask:0xf bound_ctrl:1\n\t" \
    "v_add_f32_dpp %[yp], %[yp], %[yp] quad_perm:[2,3,0,1] row_mask:0xf bank_mask:0xf bound_ctrl:1\n\t" \
    "v_pk_fma_f32 v[144:145], v[138:139], v[132:133], v[144:145] op_sel_hi:[0,1,1]\n\t" \
    "v_add_f32_dpp v146, v146, v146 row_half_mirror row_mask:0xf bank_mask:0xf bound_ctrl:1\n\t" \
    "v_add_f32_dpp %[yp], %[yp], %[yp] row_half_mirror row_mask:0xf bank_mask:0xf bound_ctrl:1\n\t" \
    "v_cmp_eq_u32_e32 vcc, 8, %[sp]\n\t" \
    "v_add_f32_dpp v146, v146, v146 row_mirror row_mask:0xf bank_mask:0xf bound_ctrl:1\n\t" \
    "v_add_f32_dpp %[yp], %[yp], %[yp] row_mirror row_mask:0xf bank_mask:0xf bound_ctrl:1\n\t" \
    "v_cndmask_b32_e32 %[yk0], %[yk0], %[yp], vcc\n\t" \
    "v_pk_fma_f32 %[s01], v[146:147], v[126:127], v[142:143] op_sel_hi:[0,1,1] neg_lo:[1,0,0] neg_hi:[1,0,0]\n\t" \
    "v_pk_fma_f32 %[s23], v[146:147], v[128:129], v[144:145] op_sel_hi:[0,1,1] neg_lo:[1,0,0] neg_hi:[1,0,0]\n\t" \
    "v_pk_mul_f32 v[140:141], %[s01], v[134:135]\n\t" \
    "v_pk_fma_f32 v[140:141], %[s23], v[136:137], v[140:141]\n\t" \
    "v_add_f32 %[yp], v140, v141\n\t" \
    "s_waitcnt lgkmcnt(0)\n\t" \
    "ds_read_b128 v[118:121], %[ab] offset:27392\n\t" \
    "ds_read_b128 v[122:125], %[ab] offset:2816\n\t" \
    "ds_read_b128 v[126:129], %[ab] offset:19200\n\t" \
    "ds_read_b128 v[130:133], %[ab] offset:11008\n\t" \
    "ds_read_b128 v[134:137], %[ab] offset:35584\n\t" \
    "ds_read_b32 v138, %[av] offset:704\n\t" \
    "v_pk_mul_f32 v[140:141], %[s01], v[96:97]\n\t" \
    "v_pk_fma_f32 v[140:141], %[s23], v[98:99], v[140:141]\n\t" \
    "v_add_f32 v146, v140, v141\n\t" \
    "v_pk_mul_f32 v[142:143], %[s01], v[100:101]\n\t" \
    "v_pk_mul_f32 v[144:145], %[s23], v[102:103]\n\t" \
    "v_add_f32_dpp v146, v146, v146 quad_perm:[1,0,3,2] row_mask:0xf bank_mask:0xf bound_ctrl:1\n\t" \
    "v_add_f32_dpp %[yp], %[yp], %[yp] quad_perm:[1,0,3,2] row_mask:0xf bank_mask:0xf bound_ctrl:1\n\t" \
    "v_pk_fma_f32 v[142:143], v[116:117], v[108:109], v[142:143] op_sel_hi:[0,1,1]\n\t" \
    "v_add_f32_dpp v146, v146, v146 quad_perm:[2,3,0,1] row_mask:0xf bank_mask:0xf bound_ctrl:1\n\t" \
    "v_add_f32_dpp %[yp], %[yp], %[yp] quad_perm:[2,3,0,1] row_mask:0xf bank_mask:0xf bound_ctrl:1\n\t" \
    "v_pk_fma_f32 v[144:145], v[116:117], v[110:111], v[144:145] op_sel_hi:[0,1,1]\n\t" \
    "v_add_f32_dpp v146, v146, v146 row_half_mirror row_mask:0xf bank_mask:0xf bound_ctrl:1\n\t" \
    "v_add_f32_dpp %[yp], %[yp], %[yp] row_half_mirror row_mask:0xf bank_mask:0xf bound_ctrl:1\n\t" \
    "v_cmp_eq_u32_e32 vcc, 9, %[sp]\n\t" \
    "v_add_f32_dpp v146, v146, v146 row_mirror row_mask:0xf bank_mask:0xf bound_ctrl:1\n\t" \
    "v_add_f32_dpp %[yp], %[yp], %[yp] row_mirror row_mask:0xf bank_mask:0xf bound_ctrl:1\n\t" \
    "v_cndmask_b32_e32 %[yk0], %[yk0], %[yp], vcc\n\t" \
    "v_pk_fma_f32 %[s01], v[146:147], v[104:105], v[142:143] op_sel_hi:[0,1,1] neg_lo:[1,0,0] neg_hi:[1,0,0]\n\t" \
    "v_pk_fma_f32 %[s23], v[146:147], v[106:107], v[144:145] op_sel_hi:[0,1,1] neg_lo:[1,0,0] neg_hi:[1,0,0]\n\t" \
    "v_pk_mul_f32 v[140:141], %[s01], v[112:113]\n\t" \
    "v_pk_fma_f32 v[140:141], %[s23], v[114:115], v[140:141]\n\t" \
    "v_add_f32 %[yp], v140, v141\n\t" \
    "s_waitcnt lgkmcnt(0)\n\t" \
    "ds_read_b128 v[96:99], %[ab] offset:27648\n\t" \
    "ds_read_b128 v[100:103], %[ab] offset:3072\n\t" \
    "ds_read_b128 v[104:107], %[ab] offset:19456\n\t" \
    "ds_read_b128 v[108:111], %[ab] offset:11264\n\t" \
    "ds_read_b128 v[112:115], %[ab] offset:35840\n\t" \
    "ds_read_b32 v116, %[av] offset:768\n\t" \
    "v_pk_mul_f32 v[140:141], %[s01], v[118:119]\n\t" \
    "v_pk_fma_f32 v[140:141], %[s23], v[120:121], v[140:141]\n\t" \
    "v_add_f32 v146, v140, v141\n\t" \
    "v_pk_mul_f32 v[142:143], %[s01], v[122:123]\n\t" \
    "v_pk_mul_f32 v[144:145], %[s23], v[124:125]\n\t" \
    "v_add_f32_dpp v146, v146, v146 quad_perm:[1,0,3,2] row_mask:0xf bank_mask:0xf bound_ctrl:1\n\t" \
    "v_add_f32_dpp %[yp], %[yp], %[yp] quad_perm:[1,0,3,2] row_mask:0xf bank_mask:0xf bound_ctrl:1\n\t" \
    "v_pk_fma_f32 v[142:143], v[138:139], v[130:131], v[142:143] op_sel_hi:[0,1,1]\n\t" \
    "v_add_f32_dpp v146, v146, v146 quad_perm:[2,3,0,1] row_mask:0xf bank_mask:0xf bound_ctrl:1\n\t" \
    "v_add_f32_dpp %[yp], %[yp], %[yp] quad_perm:[2,3,0,1] row_mask:0xf bank_mask:0xf bound_ctrl:1\n\t" \
    "v_pk_fma_f32 v[144:145], v[138:139], v[132:133], v[144:145] op_sel_hi:[0,1,1]\n\t" \
    "v_add_f32_dpp v146, v146, v146 row_half_mirror row_mask:0xf bank_mask:0xf bound_ctrl:1\n\t" \
    "v_add_f32_dpp %[yp], %[yp], %[yp] row_half_mirror row_mask:0xf bank_mask:0xf bound_ctrl:1\n\t" \
    "v_cmp_eq_u32_e32 vcc, 10, %[sp]\n\t" \
    "v_add_f32_dpp v146, v146, v146 row_mirror row_mask:0xf bank_mask:0xf bound_ctrl:1\n\t" \
    "v_add_f32_dpp %[yp], %[yp], %[yp] row_mirror row_mask:0xf bank_mask:0xf bound_ctrl:1\n\t" \
    "v_cndmask_b32_e32 %[yk0], %[yk0], %[yp], vcc\n\t" \
    "v_pk_fma_f32 %[s01], v[146:147], v[126:127], v[142:143] op_sel_hi:[0,1,1] neg_lo:[1,0,0] neg_hi:[1,0,0]\n\t" \
    "v_pk_fma_f32 %[s23], v[146:147], v[128:129], v[144:145] op_sel_hi:[0,1,1] neg_lo:[1,0,0] neg_hi:[1,0,0]\n\t" \
    "v_pk_mul_f32 v[140:141], %[s01], v[134:135]\n\t" \
    "v_pk_fma_f32 v[140:141], %[s23], v[136:137], v[140:141]\n\t" \
    "v_add_f32 %[yp], v140, v141\n\t" \
    "s_waitcnt lgkmcnt(0)\n\t" \
    "ds_read_b128 v[118:121], %[ab] offset:27904\n\t" \
    "ds_read_b128 v[122:125], %[ab] offset:3328\n\t" \
    "ds_read_b128 v[126:129], %[ab] offset:19712\n\t" \
    "ds_read_b128 v[130:133], %[ab] offset:11520\n\t" \
    "ds_read_b128 v[134:137], %[ab] offset:36096\n\t" \
    "ds_read_b32 v138, %[av] offset:832\n\t" \
    "v_pk_mul_f32 v[140:141], %[s01], v[96:97]\n\t" \
    "v_pk_fma_f32 v[140:141], %[s23], v[98:99], v[140:141]\n\t" \
    "v_add_f32 v146, v140, v141\n\t" \
    "v_pk_mul_f32 v[142:143], %[s01], v[100:101]\n\t" \
    "v_pk_mul_f32 v[144:145], %[s23], v[102:103]\n\t" \
    "v_add_f32_dpp v146, v146, v146 quad_perm:[1,0,3,2] row_mask:0xf bank_mask:0xf bound_ctrl:1\n\t" \
    "v_add_f32_dpp %[yp], %[yp], %[yp] quad_perm:[1,0,3,2] row_mask:0xf bank_mask:0xf bound_ctrl:1\n\t" \
    "v_pk_fma_f32 v[142:143], v[116:117], v[108:109], v[142:143] op_sel_hi:[0,1,1]\n\t" \
    "v_add_f32_dpp v146, v146, v146 quad_perm:[2,3,0,1] row_mask:0xf bank_mask:0xf bound_ctrl:1\n\t" \
    "v_add_f32_dpp %[yp], %[yp], %[yp] quad_perm:[2,3,0,1] row_mask:0xf bank_mask:0xf bound_ctrl:1\n\t" \
    "v_pk_fma_f32 v[144:145], v[116:117], v[110:111], v[144:145] op_sel_hi:[0,1,1]\n\t" \
    "v_add_f32_dpp v146, v146, v146 row_half_mirror row_mask:0xf bank_mask:0xf bound_ctrl:1\n\t" \
    "v_add_f32_dpp %[yp], %[yp], %[yp] row_half_mirror row_mask:0xf bank_mask:0xf bound_ctrl:1\n\t" \
    "v_cmp_eq_u32_e32 vcc, 11, %[sp]\n\t" \
    "v_add_f32_dpp v146, v146, v146 row_mirror row_mask:0xf bank_mask:0xf bound_ctrl:1\n\t" \
    "v_add_f32_dpp %[yp], %[yp], %[yp] row_mirror row_mask:0xf bank_mask:0xf bound_ctrl:1\n\t" \
    "v_cndmask_b32_e32 %[yk0], %[yk0], %[yp], vcc\n\t" \
    "v_pk_fma_f32 %[s01], v[146:147], v[104:105], v[142:143] op_sel_hi:[0,1,1] neg_lo:[1,0,0] neg_hi:[1,0,0]\n\t" \
    "v_pk_fma_f32 %[s23], v[146:147], v[106:107], v[144:145] op_sel_hi:[0,1,1] neg_lo:[1,0,0] neg_hi:[1,0,0]\n\t" \
    "v_pk_mul_f32 v[140:141], %[s01], v[112:113]\n\t" \
    "v_pk_fma_f32 v[140:141], %[s23], v[114:115], v[140:141]\n\t" \
    "v_add_f32 %[yp], v140, v141\n\t" \
    "s_waitcnt lgkmcnt(0)\n\t" \
    "ds_read_b128 v[96:99], %[ab] offset:28160\n\t" \
    "ds_read_b128 v[100:103], %[ab] offset:3584\n\t" \
    "ds_read_b128 v[104:107], %[ab] offset:19968\n\t" \
    "ds_read_b128 v[108:111], %[ab] offset:11776\n\t" \
    "ds_read_b128 v[112:115], %[ab] offset:36352\n\t" \
    "ds_read_b32 v116, %[av] offset:896\n\t" \
    "v_pk_mul_f32 v[140:141], %[s01], v[118:119]\n\t" \
    "v_pk_fma_f32 v[140:141], %[s23], v[120:121], v[140:141]\n\t" \
    "v_add_f32 v146, v140, v141\n\t" \
    "v_pk_mul_f32 v[142:143], %[s01], v[122:123]\n\t" \
    "v_pk_mul_f32 v[144:145], %[s23], v[124:125]\n\t" \
    "v_add_f32_dpp v146, v146, v146 quad_perm:[1,0,3,2] row_mask:0xf bank_mask:0xf bound_ctrl:1\n\t" \
    "v_add_f32_dpp %[yp], %[yp], %[yp] quad_perm:[1,0,3,2] row_mask:0xf bank_mask:0xf bound_ctrl:1\n\t" \
    "v_pk_fma_f32 v[142:143], v[138:139], v[130:131], v[142:143] op_sel_hi:[0,1,1]\n\t" \
    "v_add_f32_dpp v146, v146, v146 quad_perm:[2,3,0,1] row_mask:0xf bank_mask:0xf bound_ctrl:1\n\t" \
    "v_add_f32_dpp %[yp], %[yp], %[yp] quad_perm:[2,3,0,1] row_mask:0xf bank_mask:0xf bound_ctrl:1\n\t" \
    "v_pk_fma_f32 v[144:145], v[138:139], v[132:133], v[144:145] op_sel_hi:[0,1,1]\n\t" \
    "v_add_f32_dpp v146, v146, v146 row_half_mirror row_mask:0xf bank_mask:0xf bound_ctrl:1\n\t" \
    "v_add_f32_dpp %[yp], %[yp], %[yp] row_half_mirror row_mask:0xf bank_mask:0xf bound_ctrl:1\n\t" \
    "v_cmp_eq_u32_e32 vcc, 12, %[sp]\n\t" \
    "v_add_f32_dpp v146, v146, v146 row_mirror row_mask:0xf bank_mask:0xf bound_ctrl:1\n\t" \
    "v_add_f32_dpp %[yp], %[yp], %[yp] row_mirror row_mask:0xf bank_mask:0xf bound_ctrl:1\n\t" \
    "v_cndmask_b32_e32 %[yk0], %[yk0], %[yp], vcc\n\t" \
    "v_pk_fma_f32 %[s01], v[146:147], v[126:127], v[142:143] op_sel_hi:[0,1,1] neg_lo:[1,0,0] neg_hi:[1,0,0]\n\t" \
    "v_pk_fma_f32 %[s23], v[146:147], v[128:129], v[144:145] op_sel_hi:[0,1,1] neg_lo:[1,0,0] neg_hi:[1,0,0]\n\t" \
    "v_pk_mul_f32 v[140:141], %[s01], v[134:135]\n\t" \
    "v_pk_fma_f32 v[140:141], %[s23], v[136:137], v[140:141]\n\t" \
    "v_add_f32 %[yp], v140, v141\n\t" \
    "s_waitcnt lgkmcnt(0)\n\t" \
    "ds_read_b128 v[118:121], %[ab] offset:28416\n\t" \
    "ds_read_b128 v[122:125], %[ab] offset:3840\n\t" \
    "ds_read_b128 v[126:129], %[ab] offset:20224\n\t" \
    "ds_read_b128 v[130:133], %[ab] offset:12032\n\t" \
    "ds_read_b128 v[134:137], %[ab] offset:36608\n\t" \
    "ds_read_b32 v138, %[av] offset:960\n\t" \
    "v_pk_mul_f32 v[140:141], %[s01], v[96:97]\n\t" \
    "v_pk_fma_f32 v[140:141], %[s23], v[98:99], v[140:141]\n\t" \
    "v_add_f32 v146, v140, v141\n\t" \
    "v_pk_mul_f32 v[142:143], %[s01], v[100:101]\n\t" \
    "v_pk_mul_f32 v[144:145], %[s23], v[102:103]\n\t" \
    "v_add_f32_dpp v146, v146, v146 quad_perm:[1,0,3,2] row_mask:0xf bank_mask:0xf bound_ctrl:1\n\t" \
    "v_add_f32_dpp %[yp], %[yp], %[yp] quad_perm:[1,0,3,2] row_mask:0xf bank_mask:0xf bound_ctrl:1\n\t" \
    "v_pk_fma_f32 v[142:143], v[116:117], v[108:109], v[142:143] op_sel_hi:[0,1,1]\n\t" \
    "v_add_f32_dpp v146, v146, v146 quad_perm:[2,3,0,1] row_mask:0xf bank_mask:0xf bound_ctrl:1\n\t" \
    "v_add_f32_dpp %[yp], %[yp], %[yp] quad_perm:[2,3,0,1] row_mask:0xf bank_mask:0xf bound_ctrl:1\n\t" \
    "v_pk_fma_f32 v[144:145], v[116:117], v[110:111], v[144:145] op_sel_hi:[0,1,1]\n\t" \
    "v_add_f32_dpp v146, v146, v146 row_half_mirror row_mask:0xf bank_mask:0xf bound_ctrl:1\n\t" \
    "v_add_f32_dpp %[yp], %[yp], %[yp] row_half_mirror row_mask:0xf bank_mask:0xf bound_ctrl:1\n\t" \
    "v_cmp_eq_u32_e32 vcc, 13, %[sp]\n\t" \
    "v_add_f32_dpp v146, v146, v146 row_mirror row_mask:0xf bank_mask:0xf bound_ctrl:1\n\t" \
    "v_add_f32_dpp %[yp], %[yp], %[yp] row_mirror row_mask:0xf bank_mask:0xf bound_ctrl:1\n\t" \
    "v_cndmask_b32_e32 %[yk0], %[yk0], %[yp], vcc\n\t" \
    "v_pk_fma_f32 %[s01], v[146:147], v[104:105], v[142:143] op_sel_hi:[0,1,1] neg_lo:[1,0,0] neg_hi:[1,0,0]\n\t" \
    "v_pk_fma_f32 %[s23], v[146:147], v[106:107], v[144:145] op_sel_hi:[0,1,1] neg_lo:[1,0,0] neg_hi:[1,0,0]\n\t" \
    "v_pk_mul_f32 v[140:141], %[s01], v[112:113]\n\t" \
    "v_pk_fma_f32 v[140:141], %[s23], v[114:115], v[140:141]\n\t" \
    "v_add_f32 %[yp], v140, v141\n\t" \
    "s_waitcnt lgkmcnt(0)\n\t" \
    "ds_read_b128 v[96:99], %[ab] offset:28672\n\t" \
    "ds_read_b128 v[100:103], %[ab] offset:4096\n\t" \
    "ds_read_b128 v[104:107], %[ab] offset:20480\n\t" \
    "ds_read_b128 v[108:111], %[ab] offset:12288\n\t" \
    "ds_read_b128 v[112:115], %[ab] offset:36864\n\t" \
    "ds_read_b32 v116, %[av] offset:1024\n\t" \
    "v_pk_mul_f32 v[140:141], %[s01], v[118:119]\n\t" \
    "v_pk_fma_f32 v[140:141], %[s23], v[120:121], v[140:141]\n\t" \
    "v_add_f32 v146, v140, v141\n\t" \
    "v_pk_mul_f32 v[142:143], %[s01], v[122:123]\n\t" \
    "v_pk_mul_f32 v[144:145], %[s23], v[124:125]\n\t" \
    "v_add_f32_dpp v146, v146, v146 quad_perm:[1,0,3,2] row_mask:0xf bank_mask:0xf bound_ctrl:1\n\t" \
    "v_add_f32_dpp %[yp], %[yp], %[yp] quad_perm:[1,0,3,2] row_mask:0xf bank_mask:0xf bound_ctrl:1\n\t" \
    "v_pk_fma_f32 v[142:143], v[138:139], v[130:131], v[142:143] op_sel_hi:[0,1,1]\n\t" \
    "v_add_f32_dpp v146, v146, v146 quad_perm:[2,3,0,1] row_mask:0xf bank_mask:0xf bound_ctrl:1\n\t" \
    "v_add_f32_dpp %[yp], %[yp], %[yp] quad_perm:[2,3,0,1] row_mask:0xf bank_mask:0xf bound_ctrl:1\n\t" \
    "v_pk_fma_f32 v[144:145], v[138:139], v[132:133], v[144:145] op_sel_hi:[0,1,1]\n\t" \
    "v_add_f32_dpp v146, v146, v146 row_half_mirror row_mask:0xf bank_mask:0xf bound_ctrl:1\n\t" \
    "v_add_f32_dpp %[yp], %[yp], %[yp] row_half_mirror row_mask:0xf bank_mask:0xf bound_ctrl:1\n\t" \
    "v_cmp_eq_u32_e32 vcc, 14, %[sp]\n\t" \
    "v_add_f32_dpp v146, v146, v146 row_mirror row_mask:0xf bank_mask:0xf bound_ctrl:1\n\t" \
    "v_add_f32_dpp %[yp], %[yp], %[yp] row_mirror row_mask:0xf bank_mask:0xf bound_ctrl:1\n\t" \
    "v_cndmask_b32_e32 %[yk0], %[yk0], %[yp], vcc\n\t" \
    "v_pk_fma_f32 %[s01], v[146:147], v[126:127], v[142:143] op_sel_hi:[0,1,1] neg_lo:[1,0,0] neg_hi:[1,0,0]\n\t" \
    "v_pk_fma_f32 %[s23], v[146:147], v[128:129], v[144:145] op_sel_hi:[0,1,1] neg_lo:[1,0,0] neg_hi:[1,0,0]\n\t" \
    "v_pk_mul_f32 v[140:141], %[s01], v[134:135]\n\t" \
    "v_pk_fma_f32 v[140:141], %[s23], v[136:137], v[140:141]\n\t" \
    "v_add_f32 %[yp], v140, v141\n\t" \
    "s_waitcnt lgkmcnt(0)\n\t" \
    "ds_read_b128 v[118:121], %[ab] offset:28928\n\t" \
    "ds_read_b128 v[122:125], %[ab] offset:4352\n\t" \
    "ds_read_b128 v[126:129], %[ab] offset:20736\n\t" \
    "ds_read_b128 v[130:133], %[ab] offset:12544\n\t" \
    "ds_read_b128 v[134:137], %[ab] offset:37120\n\t" \
    "ds_read_b32 v138, %[av] offset:1088\n\t" \
    "v_pk_mul_f32 v[140:141], %[s01], v[96:97]\n\t" \
    "v_pk_fma_f32 v[140:141], %[s23], v[98:99], v[140:141]\n\t" \
    "v_add_f32 v146, v140, v141\n\t" \
    "v_pk_mul_f32 v[142:143], %[s01], v[100:101]\n\t" \
    "v_pk_mul_f32 v[144:145], %[s23], v[102:103]\n\t" \
    "v_add_f32_dpp v146, v146, v146 quad_perm:[1,0,3,2] row_mask:0xf bank_mask:0xf bound_ctrl:1\n\t" \
    "v_add_f32_dpp %[yp], %[yp], %[yp] quad_perm:[1,0,3,2] row_mask:0xf bank_mask:0xf bound_ctrl:1\n\t" \
    "v_pk_fma_f32 v[142:143], v[116:117], v[108:109], v[142:143] op_sel_hi:[0,1,1]\n\t" \
    "v_add_f32_dpp v146, v146, v146 quad_perm:[2,3,0,1] row_mask:0xf bank_mask:0xf bound_ctrl:1\n\t" \
    "v_add_f32_dpp %[yp], %[yp], %[yp] quad_perm:[2,3,0,1] row_mask:0xf bank_mask:0xf bound_ctrl:1\n\t" \
    "v_pk_fma_f32 v[144:145], v[116:117], v[110:111], v[144:145] op_sel_hi:[0,1,1]\n\t" \
    "v_add_f32_dpp v146, v146, v146 row_half_mirror row_mask:0xf bank_mask:0xf bound_ctrl:1\n\t" \
    "v_add_f32_dpp %[yp], %[yp], %[yp] row_half_mirror row_mask:0xf bank_mask:0xf bound_ctrl:1\n\t" \
    "v_cmp_eq_u32_e32 vcc, 15, %[sp]\n\t" \
    "v_add_f32_dpp v146, v146, v146 row_mirror row_mask:0xf bank_mask:0xf bound_ctrl:1\n\t" \
    "v_add_f32_dpp %[yp], %[yp], %[yp] row_mirror row_mask:0xf bank_mask:0xf bound_ctrl:1\n\t" \
    "v_cndmask_b32_e32 %[yk0], %[yk0], %[yp], vcc\n\t" \
    "v_pk_fma_f32 %[s01], v[146:147], v[104:105], v[142:143] op_sel_hi:[0,1,1] neg_lo:[1,0,0] neg_hi:[1,0,0]\n\t" \
    "v_pk_fma_f32 %[s23], v[146:147], v[106:107], v[144:145] op_sel_hi:[0,1,1] neg_lo:[1,0,0] neg_hi:[1,0,0]\n\t" \
    "v_pk_mul_f32 v[140:141], %[s01], v[112:113]\n\t" \
    "v_pk_fma_f32 v[140:141], %[s23], v[114:115], v[140:141]\n\t" \
    "v_add_f32 %[yp], v140, v141\n\t" \
    "s_waitcnt lgkmcnt(0)\n\t" \
    "ds_read_b128 v[96:99], %[ab] offset:29184\n\t" \
    "ds_read_b128 v[100:103], %[ab] offset:4608\n\t" \
    "ds_read_b128 v[104:107], %[ab] offset:20992\n\t" \
    "ds_read_b128 v[108:111], %[ab] offset:12800\n\t" \
    "ds_read_b128 v[112:115], %[ab] offset:37376\n\t" \
    "ds_read_b32 v116, %[av] offset:1152\n\t" \
    "v_pk_mul_f32 v[140:141], %[s01], v[118:119]\n\t" \
    "v_pk_fma_f32 v[140:141], %[s23], v[120:121], v[140:141]\n\t" \
    "v_add_f32 v146, v140, v141\n\t" \
    "v_pk_mul_f32 v[142:143], %[s01], v[122:123]\n\t" \
    "v_pk_mul_f32 v[144:145], %[s23], v[124:125]\n\t" \
    "v_add_f32_dpp v146, v146, v146 quad_perm:[1,0,3,2] row_mask:0xf bank_mask:0xf bound_ctrl:1\n\t" \
    "v_add_f32_dpp %[yp], %[yp], %[yp] quad_perm:[1,0,3,2] row_mask:0xf bank_mask:0xf bound_ctrl:1\n\t" \
    "v_pk_fma_f32 v[142:143], v[138:139], v[130:131], v[142:143] op_sel_hi:[0,1,1]\n\t" \
    "v_add_f32_dpp v146, v146, v146 quad_perm:[2,3,0,1] row_mask:0xf bank_mask:0xf bound_ctrl:1\n\t" \
    "v_add_f32_dpp %[yp], %[yp], %[yp] quad_perm:[2,3,0,1] row_mask:0xf bank_mask:0xf bound_ctrl:1\n\t" \
    "v_pk_fma_f32 v[144:145], v[138:139], v[132:133], v[144:145] op_sel_hi:[0,1,1]\n\t" \
    "v_add_f32_dpp v146, v146, v146 row_half_mirror row_mask:0xf bank_mask:0xf bound_ctrl:1\n\t" \
    "v_add_f32_dpp %[yp], %[yp], %[yp] row_half_mirror row_mask:0xf bank_mask:0xf bound_ctrl:1\n\t" \
    "v_cmp_eq_u32_e32 vcc, 0, %[sp]\n\t" \
    "v_add_f32_dpp v146, v146, v146 row_mirror row_mask:0xf bank_mask:0xf bound_ctrl:1\n\t" \
    "v_add_f32_dpp %[yp], %[yp], %[yp] row_mirror row_mask:0xf bank_mask:0xf bound_ctrl:1\n\t" \
    "v_cndmask_b32_e32 %[yk1], %[yk1], %[yp], vcc\n\t" \
    "v_pk_fma_f32 %[s01], v[146:147], v[126:127], v[142:143] op_sel_hi:[0,1,1] neg_lo:[1,0,0] neg_hi:[1,0,0]\n\t" \
    "v_pk_fma_f32 %[s23], v[146:147], v[128:129], v[144:145] op_sel_hi:[0,1,1] neg_lo:[1,0,0] neg_hi:[1,0,0]\n\t" \
    "v_pk_mul_f32 v[140:141], %[s01], v[134:135]\n\t" \
    "v_pk_fma_f32 v[140:141], %[s23], v[136:137], v[140:141]\n\t" \
    "v_add_f32 %[yp], v140, v141\n\t" \
    "s_waitcnt lgkmcnt(0)\n\t" \
    "ds_read_b128 v[118:121], %[ab] offset:29440\n\t" \
    "ds_read_b128 v[122:125], %[ab] offset:4864\n\t" \
    "ds_read_b128 v[126:129], %[ab] offset:21248\n\t" \
    "ds_read_b128 v[130:133], %[ab] offset:13056\n\t" \
    "ds_read_b128 v[134:137], %[ab] offset:37632\n\t" \
    "ds_read_b32 v138, %[av] offset:1216\n\t" \
    "v_pk_mul_f32 v[140:141], %[s01], v[96:97]\n\t" \
    "v_pk_fma_f32 v[140:141], %[s23], v[98:99], v[140:141]\n\t" \
    "v_add_f32 v146, v140, v141\n\t" \
    "v_pk_mul_f32 v[142:143], %[s01], v[100:101]\n\t" \
    "v_pk_mul_f32 v[144:145], %[s23], v[102:103]\n\t" \
    "v_add_f32_dpp v146, v146, v146 quad_perm:[1,0,3,2] row_mask:0xf bank_mask:0xf bound_ctrl:1\n\t" \
    "v_add_f32_dpp %[yp], %[yp], %[yp] quad_perm:[1,0,3,2] row_mask:0xf bank_mask:0xf bound_ctrl:1\n\t" \
    "v_pk_fma_f32 v[142:143], v[116:117], v[108:109], v[142:143] op_sel_hi:[0,1,1]\n\t" \
    "v_add_f32_dpp v146, v146, v146 quad_perm:[2,3,0,1] row_mask:0xf bank_mask:0xf bound_ctrl:1\n\t" \
    "v_add_f32_dpp %[yp], %[yp], %[yp] quad_perm:[2,3,0,1] row_mask:0xf bank_mask:0xf bound_ctrl:1\n\t" \
    "v_pk_fma_f32 v[144:145], v[116:117], v[110:111], v[144:145] op_sel_hi:[0,1,1]\n\t" \
    "v_add_f32_dpp v146, v146, v146 row_half_mirror row_mask:0xf bank_mask:0xf bound_ctrl:1\n\t" \
    "v_add_f32_dpp %[yp], %[yp], %[yp] row_half_mirror row_mask:0xf bank_mask:0xf bound_ctrl:1\n\t" \
    "v_cmp_eq_u32_e32 vcc, 1, %[sp]\n\t" \
    "v_add_f32_dpp v146, v146, v146 row_mirror row_mask:0xf bank_mask:0xf bound_ctrl:1\n\t" \
    "v_add_f32_dpp %[yp], %[yp], %[yp] row_mirror row_mask:0xf bank_mask:0xf bound_ctrl:1\n\t" \
    "v_cndmask_b32_e32 %[yk1], %[yk1], %[yp], vcc\n\t" \
    "v_pk_fma_f32 %[s01], v[146:147], v[104:105], v[142:143] op_sel_hi:[0,1,1] neg_lo:[1,0,0] neg_hi:[1,0,0]\n\t" \
    "v_pk_fma_f32 %[s23], v[146:147], v[106:107], v[144:145] op_sel_hi:[0,1,1] neg_lo:[1,0,0] neg_hi:[1,0,0]\n\t" \
    "v_pk_mul_f32 v[140:141], %[s01], v[112:113]\n\t" \
    "v_pk_fma_f32 v[140:141], %[s23], v[114:115], v[140:141]\n\t" \
    "v_add_f32 %[yp], v140, v141\n\t" \
    "s_waitcnt lgkmcnt(0)\n\t" \
    "ds_read_b128 v[96:99], %[ab] offset:29696\n\t" \
    "ds_read_b128 v[100:103], %[ab] offset:5120\n\t" \
    "ds_read_b128 v[104:107], %[ab] offset:21504\n\t" \
    "ds_read_b128 v[108:111], %[ab] offset:13312\n\t" \
    "ds_read_b128 v[112:115], %[ab] offset:37888\n\t" \
    "ds_read_b32 v116, %[av] offset:1280\n\t" \
    "v_pk_mul_f32 v[140:141], %[s01], v[118:119]\n\t" \
    "v_pk_fma_f32 v[140:141], %[s23], v[120:121], v[140:141]\n\t" \
    "v_add_f32 v146, v140, v141\n\t" \
    "v_pk_mul_f32 v[142:143], %[s01], v[122:123]\n\t" \
    "v_pk_mul_f32 v[144:145], %[s23], v[124:125]\n\t" \
    "v_add_f32_dpp v146, v146, v146 quad_perm:[1,0,3,2] row_mask:0xf bank_mask:0xf bound_ctrl:1\n\t" \
    "v_add_f32_dpp %[yp], %[yp], %[yp] quad_perm:[1,0,3,2] row_mask:0xf bank_mask:0xf bound_ctrl:1\n\t" \
    "v_pk_fma_f32 v[142:143], v[138:139], v[130:131], v[142:143] op_sel_hi:[0,1,1]\n\t" \
    "v_add_f32_dpp v146, v146, v146 quad_perm:[2,3,0,1] row_mask:0xf bank_mask:0xf bound_ctrl:1\n\t" \
    "v_add_f32_dpp %[yp], %[yp], %[yp] quad_perm:[2,3,0,1] row_mask:0xf bank_mask:0xf bound_ctrl:1\n\t" \
    "v_pk_fma_f32 v[144:145], v[138:139], v[132:133], v[144:145] op_sel_hi:[0,1,1]\n\t" \
    "v_add_f32_dpp v146, v146, v146 row_half_mirror row_mask:0xf bank_mask:0xf bound_ctrl:1\n\t" \
    "v_add_f32_dpp %[yp], %[yp], %[yp] row_half_mirror row_mask:0xf bank_mask:0xf bound_ctrl:1\n\t" \
    "v_cmp_eq_u32_e32 vcc, 2, %[sp]\n\t" \
    "v_add_f32_dpp v146, v146, v146 row_mirror row_mask:0xf bank_mask:0xf bound_ctrl:1\n\t" \
    "v_add_f32_dpp %[yp], %[yp], %[yp] row_mirror row_mask:0xf bank_mask:0xf bound_ctrl:1\n\t" \
    "v_cndmask_b32_e32 %[yk1], %[yk1], %[yp], vcc\n\t" \
    "v_pk_fma_f32 %[s01], v[146:147], v[126:127], v[142:143] op_sel_hi:[0,1,1] neg_lo:[1,0,0] neg_hi:[1,0,0]\n\t" \
    "v_pk_fma_f32 %[s23], v[146:147], v[128:129], v[144:145] op_sel_hi:[0,1,1] neg_lo:[1,0,0] neg_hi:[1,0,0]\n\t" \
    "v_pk_mul_f32 v[140:141], %[s01], v[134:135]\n\t" \
    "v_pk_fma_f32 v[140:141], %[s23], v[136:137], v[140:141]\n\t" \
    "v_add_f32 %[yp], v140, v141\n\t" \
    "s_waitcnt lgkmcnt(0)\n\t" \
    "ds_read_b128 v[118:121], %[ab] offset:29952\n\t" \
    "ds_read_b128 v[122:125], %[ab] offset:5376\n\t" \
    "ds_read_b128 v[126:129], %[ab] offset:21760\n\t" \
    "ds_read_b128 v[130:133], %[ab] offset:13568\n\t" \
    "ds_read_b128 v[134:137], %[ab] offset:38144\n\t" \
    "ds_read_b32 v138, %[av] offset:1344\n\t" \
    "v_pk_mul_f32 v[140:141], %[s01], v[96:97]\n\t" \
    "v_pk_fma_f32 v[140:141], %[s23], v[98:99], v[140:141]\n\t" \
    "v_add_f32 v146, v140, v141\n\t" \
    "v_pk_mul_f32 v[142:143], %[s01], v[100:101]\n\t" \
    "v_pk_mul_f32 v[144:145], %[s23], v[102:103]\n\t" \
    "v_add_f32_dpp v146, v146, v146 quad_perm:[1,0,3,2] row_mask:0xf bank_mask:0xf bound_ctrl:1\n\t" \
    "v_add_f32_dpp %[yp], %[yp], %[yp] quad_perm:[1,0,3,2] row_mask:0xf bank_mask:0xf bound_ctrl:1\n\t" \
    "v_pk_fma_f32 v[142:143], v[116:117], v[108:109], v[142:143] op_sel_hi:[0,1,1]\n\t" \
    "v_add_f32_dpp v146, v146, v146 quad_perm:[2,3,0,1] row_mask:0xf bank_mask:0xf bound_ctrl:1\n\t" \
    "v_add_f32_dpp %[yp], %[yp], %[yp] quad_perm:[2,3,0,1] row_mask:0xf bank_mask:0xf bound_ctrl:1\n\t" \
    "v_pk_fma_f32 v[144:145], v[116:117], v[110:111], v[144:145] op_sel_hi:[0,1,1]\n\t" \
    "v_add_f32_dpp v146, v146, v146 row_half_mirror row_mask:0xf bank_mask:0xf bound_ctrl:1\n\t" \
    "v_add_f32_dpp %[yp], %[yp], %[yp] row_half_mirror row_mask:0xf bank_mask:0xf bound_ctrl:1\n\t" \
    "v_cmp_eq_u32_e32 vcc, 3, %[sp]\n\t" \
    "v_add_f32_dpp v146, v146, v146 row_mirror row_mask:0xf bank_mask:0xf bound_ctrl:1\n\t" \
    "v_add_f32_dpp %[yp], %[yp], %[yp] row_mirror row_mask:0xf bank_mask:0xf bound_ctrl:1\n\t" \
    "v_cndmask_b32_e32 %[yk1], %[yk1], %[yp], vcc\n\t" \
    "v_pk_fma_f32 %[s01], v[146:147], v[104:105], v[142:143] op_sel_hi:[0,1,1] neg_lo:[1,0,0] neg_hi:[1,0,0]\n\t" \
    "v_pk_fma_f32 %[s23], v[146:147], v[106:107], v[144:145] op_sel_hi:[0,1,1] neg_lo:[1,0,0] neg_hi:[1,0,0]\n\t" \
    "v_pk_mul_f32 v[140:141], %[s01], v[112:113]\n\t" \
    "v_pk_fma_f32 v[140:141], %[s23], v[114:115], v[140:141]\n\t" \
    "v_add_f32 %[yp], v140, v141\n\t" \
    "s_waitcnt lgkmcnt(0)\n\t" \
    "ds_read_b128 v[96:99], %[ab] offset:30208\n\t" \
    "ds_read_b128 v[100:103], %[ab] offset:5632\n\t" \
    "ds_read_b128 v[104:107], %[ab] offset:22016\n\t" \
    "ds_read_b128 v[108:111], %[ab] offset:13824\n\t" \
    "ds_read_b128 v[112:115], %[ab] offset:38400\n\t" \
    "ds_read_b32 v116, %[av] offset:1408\n\t" \
    "v_pk_mul_f32 v[140:141], %[s01], v[118:119]\n\t" \
    "v_pk_fma_f32 v[140:141], %[s23], v[120:121], v[140:141]\n\t" \
    "v_add_f32 v146, v140, v141\n\t" \
    "v_pk_mul_f32 v[142:143], %[s01], v[122:123]\n\t" \
    "v_pk_mul_f32 v[144:145], %[s23], v[124:125]\n\t" \
    "v_add_f32_dpp v146, v146, v146 quad_perm:[1,0,3,2] row_mask:0xf bank_mask:0xf bound_ctrl:1\n\t" \
    "v_add_f32_dpp %[yp], %[yp], %[yp] quad_perm:[1,0,3,2] row_mask:0xf bank_mask:0xf bound_ctrl:1\n\t" \
    "v_pk_fma_f32 v[142:143], v[138:139], v[130:131], v[142:143] op_sel_hi:[0,1,1]\n\t" \
    "v_add_f32_dpp v146, v146, v146 quad_perm:[2,3,0,1] row_mask:0xf bank_mask:0xf bound_ctrl:1\n\t" \
    "v_add_f32_dpp %[yp], %[yp], %[yp] quad_perm:[2,3,0,1] row_mask:0xf bank_mask:0xf bound_ctrl:1\n\t" \
    "v_pk_fma_f32 v[144:145], v[138:139], v[132:133], v[144:145] op_sel_hi:[0,1,1]\n\t" \
    "v_add_f32_dpp v146, v146, v146 row_half_mirror row_mask:0xf bank_mask:0xf bound_ctrl:1\n\t" \
    "v_add_f32_dpp %[yp], %[yp], %[yp] row_half_mirror row_mask:0xf bank_mask:0xf bound_ctrl:1\n\t" \
    "v_cmp_eq_u32_e32 vcc, 4, %[sp]\n\t" \
    "v_add_f32_dpp v146, v146, v146 row_mirror row_mask:0xf bank_mask:0xf bound_ctrl:1\n\t" \
    "v_add_f32_dpp %[yp], %[yp], %[yp] row_mirror row_mask:0xf bank_mask:0xf bound_ctrl:1\n\t" \
    "v_cndmask_b32_e32 %[yk1], %[yk1], %[yp], vcc\n\t" \
    "v_pk_fma_f32 %[s01], v[146:147], v[126:127], v[142:143] op_sel_hi:[0,1,1] neg_lo:[1,0,0] neg_hi:[1,0,0]\n\t" \
    "v_pk_fma_f32 %[s23], v[146:147], v[128:129], v[144:145] op_sel_hi:[0,1,1] neg_lo:[1,0,0] neg_hi:[1,0,0]\n\t" \
    "v_pk_mul_f32 v[140:141], %[s01], v[134:135]\n\t" \
    "v_pk_fma_f32 v[140:141], %[s23], v[136:137], v[140:141]\n\t" \
    "v_add_f32 %[yp], v140, v141\n\t" \
    "s_waitcnt lgkmcnt(0)\n\t" \
    "ds_read_b128 v[118:121], %[ab] offset:30464\n\t" \
    "ds_read_b128 v[122:125], %[ab] offset:5888\n\t" \
    "ds_read_b128 v[126:129], %[ab] offset:22272\n\t" \
    "ds_read_b128 v[130:133], %[ab] offset:14080\n\t" \
    "ds_read_b128 v[134:137], %[ab] offset:38656\n\t" \
    "ds_read_b32 v138, %[av] offset:1472\n\t" \
    "v_pk_mul_f32 v[140:141], %[s01], v[96:97]\n\t" \
    "v_pk_fma_f32 v[140:141], %[s23], v[98:99], v[140:141]\n\t" \
    "v_add_f32 v146, v140, v141\n\t" \
    "v_pk_mul_f32 v[142:143], %[s01], v[100:101]\n\t" \
    "v_pk_mul_f32 v[144:145], %[s23], v[102:103]\n\t" \
    "v_add_f32_dpp v146, v146, v146 quad_perm:[1,0,3,2] row_mask:0xf bank_mask:0xf bound_ctrl:1\n\t" \
    "v_add_f32_dpp %[yp], %[yp], %[yp] quad_perm:[1,0,3,2] row_mask:0xf bank_mask:0xf bound_ctrl:1\n\t" \
    "v_pk_fma_f32 v[142:143], v[116:117], v[108:109], v[142:143] op_sel_hi:[0,1,1]\n\t" \
    "v_add_f32_dpp v146, v146, v146 quad_perm:[2,3,0,1] row_mask:0xf bank_mask:0xf bound_ctrl:1\n\t" \
    "v_add_f32_dpp %[yp], %[yp], %[yp] quad_perm:[2,3,0,1] row_mask:0xf bank_mask:0xf bound_ctrl:1\n\t" \
    "v_pk_fma_f32 v[144:145], v[116:117], v[110:111], v[144:145] op_sel_hi:[0,1,1]\n\t" \
    "v_add_f32_dpp v146, v146, v146 row_half_mirror row_mask:0xf bank_mask:0xf bound_ctrl:1\n\t" \
    "v_add_f32_dpp %[yp], %[yp], %[yp] row_half_mirror row_mask:0xf bank_mask:0xf bound_ctrl:1\n\t" \
    "v_cmp_eq_u32_e32 vcc, 5, %[sp]\n\t" \
    "v_add_f32_dpp v146, v146, v146 row_mirror row_mask:0xf bank_mask:0xf bound_ctrl:1\n\t" \
    "v_add_f32_dpp %[yp], %[yp], %[yp] row_mirror row_mask:0xf bank_mask:0xf bound_ctrl:1\n\t" \
    "v_cndmask_b32_e32 %[yk1], %[yk1], %[yp], vcc\n\t" \
    "v_pk_fma_f32 %[s01], v[146:147], v[104:105], v[142:143] op_sel_hi:[0,1,1] neg_lo:[1,0,0] neg_hi:[1,0,0]\n\t" \
    "v_pk_fma_f32 %[s23], v[146:147], v[106:107], v[144:145] op_sel_hi:[0,1,1] neg_lo:[1,0,0] neg_hi:[1,0,0]\n\t" \
    "v_pk_mul_f32 v[140:141], %[s01], v[112:113]\n\t" \
    "v_pk_fma_f32 v[140:141], %[s23], v[114:115], v[140:141]\n\t" \
    "v_add_f32 %[yp], v140, v141\n\t" \
    "s_waitcnt lgkmcnt(0)\n\t" \
    "ds_read_b128 v[96:99], %[ab] offset:30720\n\t" \
    "ds_read_b128 v[100:103], %[ab] offset:6144\n\t" \
    "ds_read_b128 v[104:107], %[ab] offset:22528\n\t" \
    "ds_read_b128 v[108:111], %[ab] offset:14336\n\t" \
    "ds_read_b128 v[112:115], %[ab] offset:38912\n\t" \
    "ds_read_b32 v116, %[av] offset:1536\n\t" \
    "v_pk_mul_f32 v[140:141], %[s01], v[118:119]\n\t" \
    "v_pk_fma_f32 v[140:141], %[s23], v[120:121], v[140:141]\n\t" \
    "v_add_f32 v146, v140, v141\n\t" \
    "v_pk_mul_f32 v[142:143], %[s01], v[122:123]\n\t" \
    "v_pk_mul_f32 v[144:145], %[s23], v[124:125]\n\t" \
    "v_add_f32_dpp v146, v146, v146 quad_perm:[1,0,3,2] row_mask:0xf bank_mask:0xf bound_ctrl:1\n\t" \
    "v_add_f32_dpp %[yp], %[yp], %[yp] quad_perm:[1,0,3,2] row_mask:0xf bank_mask:0xf bound_ctrl:1\n\t" \
    "v_pk_fma_f32 v[142:143], v[138:139], v[130:131], v[142:143] op_sel_hi:[0,1,1]\n\t" \
    "v_add_f32_dpp v146, v146, v146 quad_perm:[2,3,0,1] row_mask:0xf bank_mask:0xf bound_ctrl:1\n\t" \
    "v_add_f32_dpp %[yp], %[yp], %[yp] quad_perm:[2,3,0,1] row_mask:0xf bank_mask:0xf bound_ctrl:1\n\t" \
    "v_pk_fma_f32 v[144:145], v[138:139], v[132:133], v[144:145] op_sel_hi:[0,1,1]\n\t" \
    "v_add_f32_dpp v146, v146, v146 row_half_mirror row_mask:0xf bank_mask:0xf bound_ctrl:1\n\t" \
    "v_add_f32_dpp %[yp], %[yp], %[yp] row_half_mirror row_mask:0xf bank_mask:0xf bound_ctrl:1\n\t" \
    "v_cmp_eq_u32_e32 vcc, 6, %[sp]\n\t" \
    "v_add_f32_dpp v146, v146, v146 row_mirror row_mask:0xf bank_mask:0xf bound_ctrl:1\n\t" \
    "v_add_f32_dpp %[yp], %[yp], %[yp] row_mirror row_mask:0xf bank_mask:0xf bound_ctrl:1\n\t" \
    "v_cndmask_b32_e32 %[yk1], %[yk1], %[yp], vcc\n\t" \
    "v_pk_fma_f32 %[s01], v[146:147], v[126:127], v[142:143] op_sel_hi:[0,1,1] neg_lo:[1,0,0] neg_hi:[1,0,0]\n\t" \
    "v_pk_fma_f32 %[s23], v[146:147], v[128:129], v[144:145] op_sel_hi:[0,1,1] neg_lo:[1,0,0] neg_hi:[1,0,0]\n\t" \
    "v_pk_mul_f32 v[140:141], %[s01], v[134:135]\n\t" \
    "v_pk_fma_f32 v[140:141], %[s23], v[136:137], v[140:141]\n\t" \
    "v_add_f32 %[yp], v140, v141\n\t" \
    "s_waitcnt lgkmcnt(0)\n\t" \
    "ds_read_b128 v[118:121], %[ab] offset:30976\n\t" \
    "ds_read_b128 v[122:125], %[ab] offset:6400\n\t" \
    "ds_read_b128 v[126:129], %[ab] offset:22784\n\t" \
    "ds_read_b128 v[130:133], %[ab] offset:14592\n\t" \
    "ds_read_b128 v[134:137], %[ab] offset:39168\n\t" \
    "ds_read_b32 v138, %[av] offset:1600\n\t" \
    "v_pk_mul_f32 v[140:141], %[s01], v[96:97]\n\t" \
    "v_pk_fma_f32 v[140:141], %[s23], v[98:99], v[140:141]\n\t" \
    "v_add_f32 v146, v140, v141\n\t" \
    "v_pk_mul_f32 v[142:143], %[s01], v[100:101]\n\t" \
    "v_pk_mul_f32 v[144:145], %[s23], v[102:103]\n\t" \
    "v_add_f32_dpp v146, v146, v146 quad_perm:[1,0,3,2] row_mask:0xf bank_mask:0xf bound_ctrl:1\n\t" \
    "v_add_f32_dpp %[yp], %[yp], %[yp] quad_perm:[1,0,3,2] row_mask:0xf bank_mask:0xf bound_ctrl:1\n\t" \
    "v_pk_fma_f32 v[142:143], v[116:117], v[108:109], v[142:143] op_sel_hi:[0,1,1]\n\t" \
    "v_add_f32_dpp v146, v146, v146 quad_perm:[2,3,0,1] row_mask:0xf bank_mask:0xf bound_ctrl:1\n\t" \
    "v_add_f32_dpp %[yp], %[yp], %[yp] quad_perm:[2,3,0,1] row_mask:0xf bank_mask:0xf bound_ctrl:1\n\t" \
    "v_pk_fma_f32 v[144:145], v[116:117], v[110:111], v[144:145] op_sel_hi:[0,1,1]\n\t" \
    "v_add_f32_dpp v146, v146, v146 row_half_mirror row_mask:0xf bank_mask:0xf bound_ctrl:1\n\t" \
    "v_add_f32_dpp %[yp], %[yp], %[yp] row_half_mirror row_mask:0xf bank_mask:0xf bound_ctrl:1\n\t" \
    "v_cmp_eq_u32_e32 vcc, 7, %[sp]\n\t" \
    "v_add_f32_dpp v146, v146, v146 row_mirror row_mask:0xf bank_mask:0xf bound_ctrl:1\n\t" \
    "v_add_f32_dpp %[yp], %[yp], %[yp] row_mirror row_mask:0xf bank_mask:0xf bound_ctrl:1\n\t" \
    "v_cndmask_b32_e32 %[yk1], %[yk1], %[yp], vcc\n\t" \
    "v_pk_fma_f32 %[s01], v[146:147], v[104:105], v[142:143] op_sel_hi:[0,1,1] neg_lo:[1,0,0] neg_hi:[1,0,0]\n\t" \
    "v_pk_fma_f32 %[s23], v[146:147], v[106:107], v[144:145] op_sel_hi:[0,1,1] neg_lo:[1,0,0] neg_hi:[1,0,0]\n\t" \
    "v_pk_mul_f32 v[140:141], %[s01], v[112:113]\n\t" \
    "v_pk_fma_f32 v[140:141], %[s23], v[114:115], v[140:141]\n\t" \
    "v_add_f32 %[yp], v140, v141\n\t" \
    "s_waitcnt lgkmcnt(0)\n\t" \
    "ds_read_b128 v[96:99], %[ab] offset:31232\n\t" \
    "ds_read_b128 v[100:103], %[ab] offset:6656\n\t" \
    "ds_read_b128 v[104:107], %[ab] offset:23040\n\t" \
    "ds_read_b128 v[108:111], %[ab] offset:14848\n\t" \
    "ds_read_b128 v[112:115], %[ab] offset:39424\n\t" \
    "ds_read_b32 v116, %[av] offset:1664\n\t" \
    "v_pk_mul_f32 v[140:141], %[s01], v[118:119]\n\t" \
    "v_pk_fma_f32 v[140:141], %[s23], v[120:121], v[140:141]\n\t" \
    "v_add_f32 v146, v140, v141\n\t" \
    "v_pk_mul_f32 v[142:143], %[s01], v[122:123]\n\t" \
    "v_pk_mul_f32 v[144:145], %[s23], v[124:125]\n\t" \
    "v_add_f32_dpp v146, v146, v146 quad_perm:[1,0,3,2] row_mask:0xf bank_mask:0xf bound_ctrl:1\n\t" \
    "v_add_f32_dpp %[yp], %[yp], %[yp] quad_perm:[1,0,3,2] row_mask:0xf bank_mask:0xf bound_ctrl:1\n\t" \
    "v_pk_fma_f32 v[142:143], v[138:139], v[130:131], v[142:143] op_sel_hi:[0,1,1]\n\t" \
    "v_add_f32_dpp v146, v146, v146 quad_perm:[2,3,0,1] row_mask:0xf bank_mask:0xf bound_ctrl:1\n\t" \
    "v_add_f32_dpp %[yp], %[yp], %[yp] quad_perm:[2,3,0,1] row_mask:0xf bank_mask:0xf bound_ctrl:1\n\t" \
    "v_pk_fma_f32 v[144:145], v[138:139], v[132:133], v[144:145] op_sel_hi:[0,1,1]\n\t" \
    "v_add_f32_dpp v146, v146, v146 row_half_mirror row_mask:0xf bank_mask:0xf bound_ctrl:1\n\t" \
    "v_add_f32_dpp %[yp], %[yp], %[yp] row_half_mirror row_mask:0xf bank_mask:0xf bound_ctrl:1\n\t" \
    "v_cmp_eq_u32_e32 vcc, 8, %[sp]\n\t" \
    "v_add_f32_dpp v146, v146, v146 row_mirror row_mask:0xf bank_mask:0xf bound_ctrl:1\n\t" \
    "v_add_f32_dpp %[yp], %[yp], %[yp] row_mirror row_mask:0xf bank_mask:0xf bound_ctrl:1\n\t" \
    "v_cndmask_b32_e32 %[yk1], %[yk1], %[yp], vcc\n\t" \
    "v_pk_fma_f32 %[s01], v[146:147], v[126:127], v[142:143] op_sel_hi:[0,1,1] neg_lo:[1,0,0] neg_hi:[1,0,0]\n\t" \
    "v_pk_fma_f32 %[s23], v[146:147], v[128:129], v[144:145] op_sel_hi:[0,1,1] neg_lo:[1,0,0] neg_hi:[1,0,0]\n\t" \
    "v_pk_mul_f32 v[140:141], %[s01], v[134:135]\n\t" \
    "v_pk_fma_f32 v[140:141], %[s23], v[136:137], v[140:141]\n\t" \
    "v_add_f32 %[yp], v140, v141\n\t" \
    "s_waitcnt lgkmcnt(0)\n\t" \
    "ds_read_b128 v[118:121], %[ab] offset:31488\n\t" \
    "ds_read_b128 v[122:125], %[ab] offset:6912\n\t" \
    "ds_read_b128 v[126:129], %[ab] offset:23296\n\t" \
    "ds_read_b128 v[130:133], %[ab] offset:15104\n\t" \
    "ds_read_b128 v[134:137], %[ab] offset:39680\n\t" \
    "ds_read_b32 v138, %[av] offset:1728\n\t" \
    "v_pk_mul_f32 v[140:141], %[s01], v[96:97]\n\t" \
    "v_pk_fma_f32 v[140:141], %[s23], v[98:99], v[140:141]\n\t" \
    "v_add_f32 v146, v140, v141\n\t" \
    "v_pk_mul_f32 v[142:143], %[s01], v[100:101]\n\t" \
    "v_pk_mul_f32 v[144:145], %[s23], v[102:103]\n\t" \
    "v_add_f32_dpp v146, v146, v146 quad_perm:[1,0,3,2] row_mask:0xf bank_mask:0xf bound_ctrl:1\n\t" \
    "v_add_f32_dpp %[yp], %[yp], %[yp] quad_perm:[1,0,3,2] row_mask:0xf bank_mask:0xf bound_ctrl:1\n\t" \
    "v_pk_fma_f32 v[142:143], v[116:117], v[108:109], v[142:143] op_sel_hi:[0,1,1]\n\t" \
    "v_add_f32_dpp v146, v146, v146 quad_perm:[2,3,0,1] row_mask:0xf bank_mask:0xf bound_ctrl:1\n\t" \
    "v_add_f32_dpp %[yp], %[yp], %[yp] quad_perm:[2,3,0,1] row_mask:0xf bank_mask:0xf bound_ctrl:1\n\t" \
    "v_pk_fma_f32 v[144:145], v[116:117], v[110:111], v[144:145] op_sel_hi:[0,1,1]\n\t" \
    "v_add_f32_dpp v146, v146, v146 row_half_mirror row_mask:0xf bank_mask:0xf bound_ctrl:1\n\t" \
    "v_add_f32_dpp %[yp], %[yp], %[yp] row_half_mirror row_mask:0xf bank_mask:0xf bound_ctrl:1\n\t" \
    "v_cmp_eq_u32_e32 vcc, 9, %[sp]\n\t" \
    "v_add_f32_dpp v146, v146, v146 row_mirror row_mask:0xf bank_mask:0xf bound_ctrl:1\n\t" \
    "v_add_f32_dpp %[yp], %[yp], %[yp] row_mirror row_mask:0xf bank_mask:0xf bound_ctrl:1\n\t" \
    "v_cndmask_b32_e32 %[yk1], %[yk1], %[yp], vcc\n\t" \
    "v_pk_fma_f32 %[s01], v[146:147], v[104:105], v[142:143] op_sel_hi:[0,1,1] neg_lo:[1,0,0] neg_hi:[1,0,0]\n\t" \
    "v_pk_fma_f32 %[s23], v[146:147], v[106:107], v[144:145] op_sel_hi:[0,1,1] neg_lo:[1,0,0] neg_hi:[1,0,0]\n\t" \
    "v_pk_mul_f32 v[140:141], %[s01], v[112:113]\n\t" \
    "v_pk_fma_f32 v[140:141], %[s23], v[114:115], v[140:141]\n\t" \
    "v_add_f32 %[yp], v140, v141\n\t" \
    "s_waitcnt lgkmcnt(0)\n\t" \
    "ds_read_b128 v[96:99], %[ab] offset:31744\n\t" \
    "ds_read_b128 v[100:103], %[ab] offset:7168\n\t" \
    "ds_read_b128 v[104:107], %[ab] offset:23552\n\t" \
    "ds_read_b128 v[108:111], %[ab] offset:15360\n\t" \
    "ds_read_b128 v[112:115], %[ab] offset:39936\n\t" \
    "ds_read_b32 v116, %[av] offset:1792\n\t" \
    "v_pk_mul_f32 v[140:141], %[s01], v[118:119]\n\t" \
    "v_pk_fma_f32 v[140:141], %[s23], v[120:121], v[140:141]\n\t" \
    "v_add_f32 v146, v140, v141\n\t" \
    "v_pk_mul_f32 v[142:143], %[s01], v[122:123]\n\t" \
    "v_pk_mul_f32 v[144:145], %[s23], v[124:125]\n\t" \
    "v_add_f32_dpp v146, v146, v146 quad_perm:[1,0,3,2] row_mask:0xf bank_mask:0xf bound_ctrl:1\n\t" \
    "v_add_f32_dpp %[yp], %[yp], %[yp] quad_perm:[1,0,3,2] row_mask:0xf bank_mask:0xf bound_ctrl:1\n\t" \
    "v_pk_fma_f32 v[142:143], v[138:139], v[130:131], v[142:143] op_sel_hi:[0,1,1]\n\t" \
    "v_add_f32_dpp v146, v146, v146 quad_perm:[2,3,0,1] row_mask:0xf bank_mask:0xf bound_ctrl:1\n\t" \
    "v_add_f32_dpp %[yp], %[yp], %[yp] quad_perm:[2,3,0,1] row_mask:0xf bank_mask:0xf bound_ctrl:1\n\t" \
    "v_pk_fma_f32 v[144:145], v[138:139], v[132:133], v[144:145] op_sel_hi:[0,1,1]\n\t" \
    "v_add_f32_dpp v146, v146, v146 row_half_mirror row_mask:0xf bank_mask:0xf bound_ctrl:1\n\t" \
    "v_add_f32_dpp %[yp], %[yp], %[yp] row_half_mirror row_mask:0xf bank_mask:0xf bound_ctrl:1\n\t" \
    "v_cmp_eq_u32_e32 vcc, 10, %[sp]\n\t" \
    "v_add_f32_dpp v146, v146, v146 row_mirror row_mask:0xf bank_mask:0xf bound_ctrl:1\n\t" \
    "v_add_f32_dpp %[yp], %[yp], %[yp] row_mirror row_mask:0xf bank_mask:0xf bound_ctrl:1\n\t" \
    "v_cndmask_b32_e32 %[yk1], %[yk1], %[yp], vcc\n\t" \
    "v_pk_fma_f32 %[s01], v[146:147], v[126:127], v[142:143] op_sel_hi:[0,1,1] neg_lo:[1,0,0] neg_hi:[1,0,0]\n\t" \
    "v_pk_fma_f32 %[s23], v[146:147], v[128:129], v[144:145] op_sel_hi:[0,1,1] neg_lo:[1,0,0] neg_hi:[1,0,0]\n\t" \
    "v_pk_mul_f32 v[140:141], %[s01], v[134:135]\n\t" \
    "v_pk_fma_f32 v[140:141], %[s23], v[136:137], v[140:141]\n\t" \
    "v_add_f32 %[yp], v140, v141\n\t" \
    "s_waitcnt lgkmcnt(0)\n\t" \
    "ds_read_b128 v[118:121], %[ab] offset:32000\n\t" \
    "ds_read_b128 v[122:125], %[ab] offset:7424\n\t" \
    "ds_read_b128 v[126:129], %[ab] offset:23808\n\t" \
    "ds_read_b128 v[130:133], %[ab] offset:15616\n\t" \
    "ds_read_b128 v[134:137], %[ab] offset:40192\n\t" \
    "ds_read_b32 v138, %[av] offset:1856\n\t" \
    "v_pk_mul_f32 v[140:141], %[s01], v[96:97]\n\t" \
    "v_pk_fma_f32 v[140:141], %[s23], v[98:99], v[140:141]\n\t" \
    "v_add_f32 v146, v140, v141\n\t" \
    "v_pk_mul_f32 v[142:143], %[s01], v[100:101]\n\t" \
    "v_pk_mul_f32 v[144:145], %[s23], v[102:103]\n\t" \
    "v_add_f32_dpp v146, v146, v146 quad_perm:[1,0,3,2] row_mask:0xf bank_mask:0xf bound_ctrl:1\n\t" \
    "v_add_f32_dpp %[yp], %[yp], %[yp] quad_perm:[1,0,3,2] row_mask:0xf bank_mask:0xf bound_ctrl:1\n\t" \
    "v_pk_fma_f32 v[142:143], v[116:117], v[108:109], v[142:143] op_sel_hi:[0,1,1]\n\t" \
    "v_add_f32_dpp v146, v146, v146 quad_perm:[2,3,0,1] row_mask:0xf bank_mask:0xf bound_ctrl:1\n\t" \
    "v_add_f32_dpp %[yp], %[yp], %[yp] quad_perm:[2,3,0,1] row_mask:0xf bank_mask:0xf bound_ctrl:1\n\t" \
    "v_pk_fma_f32 v[144:145], v[116:117], v[110:111], v[144:145] op_sel_hi:[0,1,1]\n\t" \
    "v_add_f32_dpp v146, v146, v146 row_half_mirror row_mask:0xf bank_mask:0xf bound_ctrl:1\n\t" \
    "v_add_f32_dpp %[yp], %[yp], %[yp] row_half_mirror row_mask:0xf bank_mask:0xf bound_ctrl:1\n\t" \
    "v_cmp_eq_u32_e32 vcc, 11, %[sp]\n\t" \
    "v_add_f32_dpp v146, v146, v146 row_mirror row_mask:0xf bank_mask:0xf bound_ctrl:1\n\t" \
    "v_add_f32_dpp %[yp], %[yp], %[yp] row_mirror row_mask:0xf bank_mask:0xf bound_ctrl:1\n\t" \
    "v_cndmask_b32_e32 %[yk1], %[yk1], %[yp], vcc\n\t" \
    "v_pk_fma_f32 %[s01], v[146:147], v[104:105], v[142:143] op_sel_hi:[0,1,1] neg_lo:[1,0,0] neg_hi:[1,0,0]\n\t" \
    "v_pk_fma_f32 %[s23], v[146:147], v[106:107], v[144:145] op_sel_hi:[0,1,1] neg_lo:[1,0,0] neg_hi:[1,0,0]\n\t" \
    "v_pk_mul_f32 v[140:141], %[s01], v[112:113]\n\t" \
    "v_pk_fma_f32 v[140:141], %[s23], v[114:115], v[140:141]\n\t" \
    "v_add_f32 %[yp], v140, v141\n\t" \
    "s_waitcnt lgkmcnt(0)\n\t" \
    "ds_read_b128 v[96:99], %[ab] offset:32256\n\t" \
    "ds_read_b128 v[100:103], %[ab] offset:7680\n\t" \
    "ds_read_b128 v[104:107], %[ab] offset:24064\n\t" \
    "ds_read_b128 v[108:111], %[ab] offset:15872\n\t" \
    "ds_read_b128 v[112:115], %[ab] offset:40448\n\t" \
    "ds_read_b32 v116, %[av] offset:1920\n\t" \
    "v_pk_mul_f32 v[140:141], %[s01], v[118:119]\n\t" \
    "v_pk_fma_f32 v[140:141], %[s23], v[120:121], v[140:141]\n\t" \
    "v_add_f32 v146, v140, v141\n\t" \
    "v_pk_mul_f32 v[142:143], %[s01], v[122:123]\n\t" \
    "v_pk_mul_f32 v[144:145], %[s23], v[124:125]\n\t" \
    "v_add_f32_dpp v146, v146, v146 quad_perm:[1,0,3,2] row_mask:0xf bank_mask:0xf bound_ctrl:1\n\t" \
    "v_add_f32_dpp %[yp], %[yp], %[yp] quad_perm:[1,0,3,2] row_mask:0xf bank_mask:0xf bound_ctrl:1\n\t" \
    "v_pk_fma_f32 v[142:143], v[138:139], v[130:131], v[142:143] op_sel_hi:[0,1,1]\n\t" \
    "v_add_f32_dpp v146, v146, v146 quad_perm:[2,3,0,1] row_mask:0xf bank_mask:0xf bound_ctrl:1\n\t" \
    "v_add_f32_dpp %[yp], %[yp], %[yp] quad_perm:[2,3,0,1] row_mask:0xf bank_mask:0xf bound_ctrl:1\n\t" \
    "v_pk_fma_f32 v[144:145], v[138:139], v[132:133], v[144:145] op_sel_hi:[0,1,1]\n\t" \
    "v_add_f32_dpp v146, v146, v146 row_half_mirror row_mask:0xf bank_mask:0xf bound_ctrl:1\n\t" \
    "v_add_f32_dpp %[yp], %[yp], %[yp] row_half_mirror row_mask:0xf bank_mask:0xf bound_ctrl:1\n\t" \
    "v_cmp_eq_u32_e32 vcc, 12, %[sp]\n\t" \
    "v_add_f32_dpp v146, v146, v146 row_mirror row_mask:0xf bank_mask:0xf bound_ctrl:1\n\t" \
    "v_add_f32_dpp %[yp], %[yp], %[yp] row_mirror row_mask:0xf bank_mask:0xf bound_ctrl:1\n\t" \
    "v_cndmask_b32_e32 %[yk1], %[yk1], %[yp], vcc\n\t" \
    "v_pk_fma_f32 %[s01], v[146:147], v[126:127], v[142:143] op_sel_hi:[0,1,1] neg_lo:[1,0,0] neg_hi:[1,0,0]\n\t" \
    "v_pk_fma_f32 %[s23], v[146:147], v[128:129], v[144:145] op_sel_hi:[0,1,1] neg_lo:[1,0,0] neg_hi:[1,0,0]\n\t" \
    "v_pk_mul_f32 v[140:141], %[s01], v[134:135]\n\t" \
    "v_pk_fma_f32 v[140:141], %[s23], v[136:137], v[140:141]\n\t" \
    "v_add_f32 %[yp], v140, v141\n\t" \
    "s_waitcnt lgkmcnt(0)\n\t" \
    "ds_read_b128 v[118:121], %[ab] offset:32512\n\t" \
    "ds_read_b128 v[122:125], %[ab] offset:7936\n\t" \
    "ds_read_b128 v[126:129], %[ab] offset:24320\n\t" \
    "ds_read_b128 v[130:133], %[ab] offset:16128\n\t" \
    "ds_read_b128 v[134:137], %[ab] offset:40704\n\t" \
    "ds_read_b32 v138, %[av] offset:1984\n\t" \
    "v_pk_mul_f32 v[140:141], %[s01], v[96:97]\n\t" \
    "v_pk_fma_f32 v[140:141], %[s23], v[98:99], v[140:141]\n\t" \
    "v_add_f32 v146, v140, v141\n\t" \
    "v_pk_mul_f32 v[142:143], %[s01], v[100:101]\n\t" \
    "v_pk_mul_f32 v[144:145], %[s23], v[102:103]\n\t" \
    "v_add_f32_dpp v146, v146, v146 quad_perm:[1,0,3,2] row_mask:0xf bank_mask:0xf bound_ctrl:1\n\t" \
    "v_add_f32_dpp %[yp], %[yp], %[yp] quad_perm:[1,0,3,2] row_mask:0xf bank_mask:0xf bound_ctrl:1\n\t" \
    "v_pk_fma_f32 v[142:143], v[116:117], v[108:109], v[142:143] op_sel_hi:[0,1,1]\n\t" \
    "v_add_f32_dpp v146, v146, v146 quad_perm:[2,3,0,1] row_mask:0xf bank_mask:0xf bound_ctrl:1\n\t" \
    "v_add_f32_dpp %[yp], %[yp], %[yp] quad_perm:[2,3,0,1] row_mask:0xf bank_mask:0xf bound_ctrl:1\n\t" \
    "v_pk_fma_f32 v[144:145], v[116:117], v[110:111], v[144:145] op_sel_hi:[0,1,1]\n\t" \
    "v_add_f32_dpp v146, v146, v146 row_half_mirror row_mask:0xf bank_mask:0xf bound_ctrl:1\n\t" \
    "v_add_f32_dpp %[yp], %[yp], %[yp] row_half_mirror row_mask:0xf bank_mask:0xf bound_ctrl:1\n\t" \
    "v_cmp_eq_u32_e32 vcc, 13, %[sp]\n\t" \
    "v_add_f32_dpp v146, v146, v146 row_mirror row_mask:0xf bank_mask:0xf bound_ctrl:1\n\t" \
    "v_add_f32_dpp %[yp], %[yp], %[yp] row_mirror row_mask:0xf bank_mask:0xf bound_ctrl:1\n\t" \
    "v_cndmask_b32_e32 %[yk1], %[yk1], %[yp], vcc\n\t" \
    "v_pk_fma_f32 %[s01], v[146:147], v[104:105], v[142:143] op_sel_hi:[0,1,1] neg_lo:[1,0,0] neg_hi:[1,0,0]\n\t" \
    "v_pk_fma_f32 %[s23], v[146:147], v[106:107], v[144:145] op_sel_hi:[0,1,1] neg_lo:[1,0,0] neg_hi:[1,0,0]\n\t" \
    "v_pk_mul_f32 v[140:141], %[s01], v[112:113]\n\t" \
    "v_pk_fma_f32 v[140:141], %[s23], v[114:115], v[140:141]\n\t" \
    "v_add_f32 %[yp], v140, v141\n\t" \
    "s_waitcnt lgkmcnt(0)\n\t" \
    "ds_read_b128 v[96:99], %[ab] offset:32768\n\t" \
    "ds_read_b128 v[100:103], %[ab] offset:8192\n\t" \
    "ds_read_b128 v[104:107], %[ab] offset:24576\n\t" \
    "ds_read_b128 v[108:111], %[ab] offset:16384\n\t" \
    "ds_read_b128 v[112:115], %[ab] offset:40960\n\t" \
    "ds_read_b32 v116, %[av] offset:2048\n\t" \
    "v_pk_mul_f32 v[140:141], %[s01], v[118:119]\n\t" \
    "v_pk_fma_f32 v[140:141], %[s23], v[120:121], v[140:141]\n\t" \
    "v_add_f32 v146, v140, v141\n\t" \
    "v_pk_mul_f32 v[142:143], %[s01], v[122:123]\n\t" \
    "v_pk_mul_f32 v[144:145], %[s23], v[124:125]\n\t" \
    "v_add_f32_dpp v146, v146, v146 quad_perm:[1,0,3,2] row_mask:0xf bank_mask:0xf bound_ctrl:1\n\t" \
    "v_add_f32_dpp %[yp], %[yp], %[yp] quad_perm:[1,0,3,2] row_mask:0xf bank_mask:0xf bound_ctrl:1\n\t" \
    "v_pk_fma_f32 v[142:143], v[138:139], v[130:131], v[142:143] op_sel_hi:[0,1,1]\n\t" \
    "v_add_f32_dpp v146, v146, v146 quad_perm:[2,3,0,1] row_mask:0xf bank_mask:0xf bound_ctrl:1\n\t" \
    "v_add_f32_dpp %[yp], %[yp], %[yp] quad_perm:[2,3,0,1] row_mask:0xf bank_mask:0xf bound_ctrl:1\n\t" \
    "v_pk_fma_f32 v[144:145], v[138:139], v[132:133], v[144:145] op_sel_hi:[0,1,1]\n\t" \
    "v_add_f32_dpp v146, v146, v146 row_half_mirror row_mask:0xf bank_mask:0xf bound_ctrl:1\n\t" \
    "v_add_f32_dpp %[yp], %[yp], %[yp] row_half_mirror row_mask:0xf bank_mask:0xf bound_ctrl:1\n\t" \
    "v_cmp_eq_u32_e32 vcc, 14, %[sp]\n\t" \
    "v_add_f32_dpp v146, v146, v146 row_mirror row_mask:0xf bank_mask:0xf bound_ctrl:1\n\t" \
    "v_add_f32_dpp %[yp], %[yp], %[yp] row_mirror row_mask:0xf bank_mask:0xf bound_ctrl:1\n\t" \
    "v_cndmask_b32_e32 %[yk1], %[yk1], %[yp], vcc\n\t" \
    "v_pk_fma_f32 %[s01], v[146:147], v[126:127], v[142:143] op_sel_hi:[0,1,1] neg_lo:[1,0,0] neg_hi:[1,0,0]\n\t" \
    "v_pk_fma_f32 %[s23], v[146:147], v[128:129], v[144:145] op_sel_hi:[0,1,1] neg_lo:[1,0,0] neg_hi:[1,0,0]\n\t" \
    "v_pk_mul_f32 v[140:141], %[s01], v[134:135]\n\t" \
    "v_pk_fma_f32 v[140:141], %[s23], v[136:137], v[140:141]\n\t" \
    "v_add_f32 %[yp], v140, v141\n\t" \
    "s_waitcnt lgkmcnt(0)\n\t"
#define SCAN_CHUNK_CLOBBERS "v96", "v97", "v98", "v99", "v100", "v101", "v102", "v103", "v104", "v105", "v106", "v107", "v108", "v109", "v110", "v111", "v112", "v113", "v114", "v115", "v116", "v117", "v118", "v119", "v120", "v121", "v122", "v123", "v124", "v125", "v126", "v127", "v128", "v129", "v130", "v131", "v132", "v133", "v134", "v135", "v136", "v137", "v138", "v139", "v140", "v141", "v142", "v143", "v144", "v145", "v146", "v147", "vcc", "memory"
#ifndef EMU
#define UNR _Pragma("unroll")
#define UNR1 _Pragma("unroll 1")
#define CFENCE() asm volatile("" ::: "memory")
#define OPAQUE(x) asm volatile("" : "+v"(x))
#define SYNC() __syncthreads()
#define WAVE_SYNC() do { asm volatile("s_waitcnt lgkmcnt(0)" ::: "memory"); __builtin_amdgcn_wave_barrier(); } while (0)
DEVFN float shfl_xor_f(float v, int m) { return __shfl_xor(v, m); }
DEVFN float shfl_f(float v, int src) { return __shfl(v, src); }
DEVFN void sincospi_f(float x, float* s, float* c) { sincospif(x, s, c); }
template <int M> DEVFN float rowx_add(float v) { constexpr int ctrl = M == 1 ? 0xB1 : M == 2 ? 0x4E : M == 7 ? 0x141 : 0x140;
    return v + __builtin_bit_cast(float, __builtin_amdgcn_update_dpp(0, __builtin_bit_cast(int, v), ctrl, 0xf, 0xf, true)); }
#endif

enum InIdx { I_X = 0, I_C, I_CTX, I_CCTX, I_ANORM, I_AADAW, I_AADAB, I_AWIN, I_RPB, I_QG, I_KG, I_AWOUT, I_RNORM, I_RADAW, I_RADAB, I_RWIN, I_MU, I_W0, I_WUP, I_A0, I_AUP,
             I_KK, I_KA, I_RK, I_GNW, I_GNB, I_HSHORT, I_HW1, I_HB1, I_HW2, I_HB2, I_HW3, I_HB3, I_HSKIP, I_RWOUT, I_FNORM, N_IN };

#if defined(TSEL) && !defined(EMU)
#define XSTAMP(C, k, cond) do { if ((cond) && (C).tid == 0) __hip_atomic_store((unsigned long long*)((C).ws + WS_CTL + 32768) + (k), (unsigned long long)__builtin_amdgcn_s_memrealtime(), __ATOMIC_RELAXED, __HIP_MEMORY_SCOPE_AGENT); } while (0)
#else
#define XSTAMP(C, k, cond) do {} while (0)
#endif
#if defined(TSEL) && !defined(EMU)
#define TACC_DECL unsigned long long tacc_ = 0, tb_ = 0
#define TACC_BEGIN tb_ = __builtin_amdgcn_s_memrealtime()
#define TACC_END tacc_ += __builtin_amdgcn_s_memrealtime() - tb_
#define TACC_STORE(C, k, cond) do { if (cond) __hip_atomic_store((unsigned long long*)((C).ws + WS_CTL + 32768) + (k), tacc_, __ATOMIC_RELAXED, __HIP_MEMORY_SCOPE_AGENT); } while (0)
#else
#define TACC_DECL
#define TACC_BEGIN
#define TACC_END
#define TACC_STORE(C, k, cond)
#endif
struct Ctx {
    const float* in[N_IN]; float* out; unsigned char* ws;
    int tid, lane, wave, vcu, G;
};

#ifdef EMU
DEVFN float wave_sum(float v) { for (int o = 1; o < 64; o <<= 1) v += shfl_xor_f(v, o); return v; }
DEVFN float swap16_f(float v) { return shfl_xor_f(v, 16); }
#else
DEVFN float wave_sum(float v) { v = rowx_add<1>(v); v = rowx_add<2>(v); v = rowx_add<7>(v); v = rowx_add<15>(v);
    const int i_ = __builtin_bit_cast(int, v);
    return (__builtin_bit_cast(float, __builtin_amdgcn_readlane(i_, 0)) + __builtin_bit_cast(float, __builtin_amdgcn_readlane(i_, 16))) + (__builtin_bit_cast(float, __builtin_amdgcn_readlane(i_, 32)) + __builtin_bit_cast(float, __builtin_amdgcn_readlane(i_, 48))); }
DEVFN float swap16_f(float v) { return __builtin_bit_cast(float, __builtin_amdgcn_ds_swizzle(__builtin_bit_cast(int, v), 0x401F)); }
#endif

DEVFN U4 ld16(const void* p) { return *(const U4*)p; }
DEVFN void st16(void* p, U4 v) { *(U4*)p = v; }
DEVFN void unpack8(U4 w, float* f) { f[0] = bflo(w.x); f[1] = bfhi(w.x); f[2] = bflo(w.y); f[3] = bfhi(w.y); f[4] = bflo(w.z); f[5] = bfhi(w.z); f[6] = bflo(w.w); f[7] = bfhi(w.w); }
DEVFN U4 pack8(const float* f) { U4 w; w.x = pk2(f[0], f[1]); w.y = pk2(f[2], f[3]); w.z = pk2(f[4], f[5]); w.w = pk2(f[6], f[7]); return w; }

DEVFN void p0_transpose_item(const float* W, int K, int N, bf16_t* WT, float* scr, int item, int lane) {
    const int nblk = N / 32, kb = item / nblk, nb = item % nblk, k0 = 64 * kb, n0 = 32 * nb;
    UNR for (int i = 0; i < 32; ++i) { const int kk = 2 * i + (lane >> 5); scr[kk * 33 + (lane & 31)] = W[(size_t)(k0 + kk) * N + n0 + (lane & 31)]; }
    WAVE_SYNC();
    const int c = lane & 7;
    UNR for (int j = 0; j < 4; ++j) { const int n = (lane >> 3) + 8 * j; const float* s = scr + (8 * c) * 33 + n;
        U4 o; o.x = pk2(s[0 * 33], s[1 * 33]); o.y = pk2(s[2 * 33], s[3 * 33]); o.z = pk2(s[4 * 33], s[5 * 33]); o.w = pk2(s[6 * 33], s[7 * 33]);
        st16(WT + (size_t)(n0 + n) * K + k0 + 8 * c, o); }
    WAVE_SYNC();
}

DEVFN void hid_rows(const float* w1, const float* b1, const float* w2, const float* b2, float* hid, int L, int gw, int NGW, int lane) {
    float w1c[33], w2c[64];
    UNR for (int i = 0; i < 33; ++i) w1c[i] = w1[i * 64 + lane];
    UNR for (int i = 0; i < 64; ++i) w2c[i] = w2[i * 64 + lane];
    const float bb1 = b1[lane], bb2 = b2[lane];
    for (int t = gw; t < L; t += NGW) {
        float feat = 0.f;
        if (lane == 0) feat = (float)t / (float)(L - 1 > 1 ? L - 1 : 1);
        else if (lane < 33) { const int b = (lane - 1) & 15; const float band = 1e-4f + (float)b * ((15.0f - 1e-4f) / 15.0f);
            const float x = 2.0f * band * (float)t / (float)L; float s, c; sincospi_f(x, &s, &c); feat = (lane <= 16) ? c : -s; }
        float a = bb1;
        UNR for (int i = 0; i < 33; ++i) a += shfl_f(feat, i) * w1c[i];
        const float h1 = sinf(a);
        float b = bb2;
        UNR for (int i = 0; i < 64; ++i) b += shfl_f(h1, i) * w2c[i];
        hid[(size_t)t * 64 + lane] = sinf(b);
    }
}

DEVFN void r2_build_bfrag(const Ctx& C);
DEVFN void ph_prologue(const Ctx& C, unsigned char* lds) {
    const int gw = C.vcu * NWAVES + C.wave, NGW = C.G * NWAVES, lane = C.lane;
    float* scr = (float*)(lds + C.wave * 16384);
    {
        constexpr int I_AIN = 16 * (AIN / 32), I_OUT = 16 * 32, I_RIN = 16 * (RIN / 32);
        constexpr int NIT = 2 * (I_AIN + I_OUT + I_RIN + I_OUT);
        for (int it = gw; it < NIT; it += NGW) {
            int r = it; const int li = r & 1; r >>= 1;
            if (r < I_AIN) { p0_transpose_item(C.in[I_AWIN] + (size_t)li * DM * AIN, DM, AIN, (bf16_t*)(C.ws + WS_WAIN) + (size_t)li * AIN * DM, scr, r, lane); continue; } r -= I_AIN;
            if (r < I_OUT) { p0_transpose_item(C.in[I_AWOUT] + (size_t)li * DM * DM, DM, DM, (bf16_t*)(C.ws + WS_WAOUT) + (size_t)li * DM * DM, scr, r, lane); continue; } r -= I_OUT;
            if (r < I_RIN) { p0_transpose_item(C.in[I_RWIN] + (size_t)li * DM * RIN, DM, RIN, (bf16_t*)(C.ws + WS_WRIN) + (size_t)li * RINP * DM, scr, r, lane); continue; } r -= I_RIN;
            p0_transpose_item(C.in[I_RWOUT] + (size_t)li * DM * DM, DM, DM, (bf16_t*)(C.ws + WS_WROUT) + (size_t)li * DM * DM, scr, r, lane);
        }
        for (int e = gw * 64 + lane; e < 2 * (RINP - RIN) * DM / 8; e += NGW * 64) { const int li = e / ((RINP - RIN) * DM / 8), o = e % ((RINP - RIN) * DM / 8);
            U4 z; z.x = z.y = z.z = z.w = 0u; st16((bf16_t*)(C.ws + WS_WRIN) + (size_t)li * RINP * DM + (size_t)RIN * DM + (size_t)o * 8, z); }
    }
    {
        float* ADA = (float*)(C.ws + WS_ADA);
        for (int it = gw; it < 4 * 48; it += NGW) {
            const int layer = it / 48, cb = it % 48, col = cb * 64 + lane, i = layer >> 1;
            const float* W = (layer & 1) ? C.in[I_RADAW] + (size_t)i * DM * 3072 : C.in[I_AADAW] + (size_t)i * DM * 3072;
            const float* B = (layer & 1) ? C.in[I_RADAB] + (size_t)i * 3072 : C.in[I_AADAB] + (size_t)i * 3072;
            float a0 = 0.f, a1 = 0.f;
            for (int k0 = 0; k0 < DM; k0 += 64) {
                const float sc = silu_f(C.in[I_C][k0 + lane]), sx = silu_f(C.in[I_CCTX][k0 + lane]);
                for (int k = 0; k < 64; ++k) { const float w = W[(size_t)(k0 + k) * 3072 + col]; a0 += shfl_f(sc, k) * w; a1 += shfl_f(sx, k) * w; }
            }
            ADA[(size_t)(layer * 2 + 0) * 3072 + col] = a0 + B[col];
            ADA[(size_t)(layer * 2 + 1) * 3072 + col] = a1 + B[col];
        }
    }
    for (int i = 0; i < 2; ++i)
        hid_rows(C.in[I_HW1] + (size_t)i * 33 * 64, C.in[I_HB1] + i * 64, C.in[I_HW2] + (size_t)i * 64 * 64, C.in[I_HB2] + i * 64, (float*)(C.ws + WS_HID) + (size_t)i * NLAT * 64, NLAT, gw, NGW, lane);
    hid_rows(C.in[I_HW1], C.in[I_HB1], C.in[I_HW2], C.in[I_HB2], (float*)(C.ws + WS_HID256), NCTX, gw, NGW, lane);
    r2_build_bfrag(C);
    { F2* TW = (F2*)(C.ws + WS_TW);
      for (int k = gw * 64 + lane; k <= 16384; k += NGW * 64) { float s, c; sincospi_f((float)k * (1.0f / 16384.0f), &s, &c); F2 w; w.x = c; w.y = -s; TW[k] = w; } }
}

DEVFN void ph_norm(const Ctx& C, int layer, const float* xlat, const float* xctx, bool do_ctx) {
    const int gw = C.vcu * NWAVES + C.wave, NGW = C.G * NWAVES, lane = C.lane, i = layer >> 1;
    const float* gain = ((layer & 1) ? C.in[I_RNORM] : C.in[I_ANORM]) + (size_t)i * DM;
    const float* ADA = (const float*)(C.ws + WS_ADA) + (size_t)layer * 2 * 3072;
    bf16_t* XN = (bf16_t*)(C.ws + WS_XN);
    const int nrows = do_ctx ? NTOK : NLAT;
    for (int m = gw; m < nrows; m += NGW) {
        const bool isctx = m >= NLAT;
        const float* xr = isctx ? xctx + (size_t)(m - NLAT) * DM : xlat + (size_t)m * DM;
        const float* ada = ADA + (isctx ? 3072 : 0);
        F4 v[4]; float s = 0.f;
        UNR for (int j = 0; j < 4; ++j) { v[j] = *(const F4*)(xr + 256 * j + 4 * lane); s += (v[j].x * v[j].x + v[j].y * v[j].y) + (v[j].z * v[j].z + v[j].w * v[j].w); }
        const float rs = 1.0f / sqrtf(wave_sum(s) * (1.0f / DM) + NORM_EPS);
        UNR for (int j = 0; j < 4; ++j) { const int c0 = 256 * j + 4 * lane;
            const F4 g = *(const F4*)(gain + c0), sh = *(const F4*)(ada + c0), sc = *(const F4*)(ada + 1024 + c0);
            U2 o; o.x = pk2(v[j].x * rs * g.x * (1.f + sc.x) + sh.x, v[j].y * rs * g.y * (1.f + sc.y) + sh.y);
            o.y = pk2(v[j].z * rs * g.z * (1.f + sc.z) + sh.z, v[j].w * rs * g.w * (1.f + sc.w) + sh.w);
            *(U2*)(XN + (size_t)m * DM + c0) = o; }
    }
}

DEVFN void ph_final(const Ctx& C) {
    const int gw = C.vcu * NWAVES + C.wave, NGW = C.G * NWAVES, lane = C.lane;
    const float* gain = C.in[I_FNORM];
    for (int m = gw; m < NLAT; m += NGW) {
        float* xr = C.out + (size_t)m * DM;
        F4 v[4]; float s = 0.f;
        UNR for (int j = 0; j < 4; ++j) { v[j] = *(const F4*)(xr + 256 * j + 4 * lane); s += (v[j].x * v[j].x + v[j].y * v[j].y) + (v[j].z * v[j].z + v[j].w * v[j].w); }
        const float rs = 1.0f / sqrtf(wave_sum(s) * (1.0f / DM) + NORM_EPS);
        UNR for (int j = 0; j < 4; ++j) { const int c0 = 256 * j + 4 * lane; const F4 g = *(const F4*)(gain + c0);
            F4 o; o.x = v[j].x * rs * g.x; o.y = v[j].y * rs * g.y; o.z = v[j].z * rs * g.z; o.w = v[j].w * rs * g.w; *(F4*)(xr + c0) = o; }
    }
}

DEVFN void ph_qkprep(const Ctx& C, int i) {
    const int gw = C.vcu * NWAVES + C.wave, NGW = C.G * NWAVES, lane = C.lane;
    bf16_t* U = (bf16_t*)(C.ws + WS_U);
    const float qg = C.in[I_QG][i * 64 + lane], kg = C.in[I_KG][i * 64 + lane];
    const int axis = lane >> 5, half = (lane >> 4) & 1, f = lane & 15;
    const float invf = exp2f(-(float)f * (13.287712379549449f / 16.0f));
    for (int m = gw; m < NTOK; m += NGW) {
        float cs = 1.f, sn = 0.f;
        if (m < NLAT) { const float pos = (float)(axis == 0 ? (m >> 6) : (m & 63)); const float ang = pos * invf; cs = cosf(ang); sn = sinf(ang); }
        bf16_t* ur = U + (size_t)m * AIN + 2048;
        for (int h = 0; h < 10; ++h) {
            const float v = bf2f(ur[h * 64 + lane]);
            const float ss = wave_sum(v * v);
            float y = v * (1.0f / sqrtf(ss * (1.0f / 64.0f) + NORM_EPS)) * (h < 8 ? qg : kg);
            const float p = swap16_f(y);
            y = half == 0 ? y * cs - p * sn : y * cs + p * sn;
            if (h < 8) y *= C2;
            ur[h * 64 + lane] = (bf16_t)f2bf(y);
        }
    }
}

DEVFN void ph_hyprep(const Ctx& C, int i, bool do_ctx, unsigned char* lds) {
    const int tid = C.tid;
    const bf16_t* UHY = (const bf16_t*)(C.ws + WS_UHY);
    const float* taps = C.in[I_HSHORT] + (size_t)i * 3 * UHY_W;
    float* T = (float*)lds;
    const int ntile_lat = 3 * 8 * 256, ntile = ntile_lat + (do_ctx ? 3 * 8 * 4 : 0);
    for (int it = C.vcu; it < ntile; it += C.G) {
        const bool isctx = it >= ntile_lat; const int r = isctx ? it - ntile_lat : it;
        const int ntb = isctx ? 4 : 256; const int tb = r % ntb, cb = (r / ntb) & 7, g = r / (ntb * 8);
        const int seg0 = isctx ? NLAT : 0, segn = isctx ? NCTX : NLAT;
        {
            const int tl = tid >> 3, c8 = (tid & 7) * 8, t = 64 * tb + tl, col = g * 512 + 64 * cb + c8;
            float um[8], u0[8], up[8];
            unpack8(ld16(UHY + (size_t)(seg0 + t) * UHY_W + col), u0);
            if (t > 0) unpack8(ld16(UHY + (size_t)(seg0 + t - 1) * UHY_W + col), um); else UNR for (int e = 0; e < 8; ++e) um[e] = 0.f;
            if (t < segn - 1) unpack8(ld16(UHY + (size_t)(seg0 + t + 1) * UHY_W + col), up); else UNR for (int e = 0; e < 8; ++e) up[e] = 0.f;
            UNR for (int e = 0; e < 8; ++e) T[(c8 + e) * 65 + tl] = um[e] * taps[col + e] + u0[e] * taps[UHY_W + col + e] + up[e] * taps[2 * UHY_W + col + e];
        }
        SYNC();
        {
            const int cl = tid >> 3, t8 = (tid & 7) * 8, ch = 64 * cb + cl;
            float v[8]; UNR for (int e = 0; e < 8; ++e) v[e] = T[cl * 65 + t8 + e];
            if (!isctx) { bf16_t* VX = (bf16_t*)(C.ws + (g == 0 ? WS_VX0 : g == 1 ? WS_VX1 : WS_VX2)); st16(VX + (size_t)ch * NLAT + 64 * tb + t8, pack8(v)); }
            else { float* VXC = (float*)(C.ws + WS_VXC) + ((size_t)g * 512 + ch) * NCTX + 64 * tb + t8; UNR for (int e = 0; e < 8; ++e) VXC[e] = v[e]; }
        }
        SYNC();
    }
}

constexpr int FFT_N = 16384;
DEVFN int fidx(int n) { return n + (n >> 4); }
DEVFN F2 cmul(F2 a, F2 b) { F2 r; r.x = a.x * b.x - a.y * b.y; r.y = a.x * b.y + a.y * b.x; return r; }
DEVFN F2 cmulc(F2 a, F2 b) { F2 r; r.x = a.x * b.x + a.y * b.y; r.y = a.y * b.x - a.x * b.y; return r; }
DEVFN F2 cadd(F2 a, F2 b) { F2 r; r.x = a.x + b.x; r.y = a.y + b.y; return r; }
DEVFN F2 csub(F2 a, F2 b) { F2 r; r.x = a.x - b.x; r.y = a.y - b.y; return r; }
DEVFN F2 cconj(F2 a) { F2 r; r.x = a.x; r.y = -a.y; return r; }
template <bool INV> DEVFN F2 mul_mi(F2 a) { F2 r; if (!INV) { r.x = a.y; r.y = -a.x; } else { r.x = -a.y; r.y = a.x; } return r; }
template <bool INV> DEVFN void dft4(F2& a0, F2& a1, F2& a2, F2& a3) {
    const F2 s02 = cadd(a0, a2), d02 = csub(a0, a2), s13 = cadd(a1, a3), d13 = mul_mi<INV>(csub(a1, a3));
    a0 = cadd(s02, s13); a2 = csub(s02, s13); a1 = cadd(d02, d13); a3 = csub(d02, d13);
}
template <bool INV> DEVFN void dft16(F2* a) {
    UNR for (int n2 = 0; n2 < 4; ++n2) dft4<INV>(a[n2], a[4 + n2], a[8 + n2], a[12 + n2]);
    const float c1 = 0.92387953251128674f, s1 = 0.38268343236508977f, r2 = 0.70710678118654752f;
    const F2 w1 = {c1, INV ? s1 : -s1}, w2 = {r2, INV ? r2 : -r2}, w3 = {s1, INV ? c1 : -c1}, w6 = {-r2, INV ? r2 : -r2}, w9 = {-c1, INV ? -s1 : s1};
    a[4 * 1 + 1] = cmul(a[4 * 1 + 1], w1); a[4 * 1 + 2] = cmul(a[4 * 1 + 2], w2); a[4 * 1 + 3] = cmul(a[4 * 1 + 3], w3);
    a[4 * 2 + 1] = cmul(a[4 * 2 + 1], w2); a[4 * 2 + 2] = mul_mi<INV>(a[4 * 2 + 2]); a[4 * 2 + 3] = cmul(a[4 * 2 + 3], w6);
    a[4 * 3 + 1] = cmul(a[4 * 3 + 1], w3); a[4 * 3 + 2] = cmul(a[4 * 3 + 2], w6); a[4 * 3 + 3] = cmul(a[4 * 3 + 3], w9);
    F2 x[16];
    UNR for (int k1 = 0; k1 < 4; ++k1) { F2 b0 = a[4 * k1 + 0], b1 = a[4 * k1 + 1], b2 = a[4 * k1 + 2], b3 = a[4 * k1 + 3]; dft4<INV>(b0, b1, b2, b3); x[k1] = b0; x[k1 + 4] = b1; x[k1 + 8] = b2; x[k1 + 12] = b3; }
    UNR for (int q = 0; q < 16; ++q) a[q] = x[q];
}
template <int R, bool INV> DEVFN void fft_stage(F2* F, const F2* TW, int B, int tid) {
    const int S = B / R, NB = FFT_N / R, tws = 2 * (FFT_N / B);
    int tq = tid; OPAQUE(tq);
    UNR1 for (int q = tq; q < NB; q += NTHREADS) {
        const int blk = q / S, j = q - blk * S, base = blk * B + j;
        F2 a[R];
        UNR for (int m = 0; m < R; ++m) a[m] = F[fidx(base + m * S)];
        if (INV && S > 1) { const F2 w1 = TW[tws * j]; F2 w = w1; UNR for (int m = 1; m < R; ++m) { a[m] = cmulc(a[m], w); w = cmul(w, w1); } }
        if constexpr (R == 4) dft4<INV>(a[0], a[1], a[2], a[3]); else dft16<INV>(a);
        if (!INV && S > 1) { const F2 w1 = TW[tws * j]; F2 w = w1; UNR for (int m = 1; m < R; ++m) { a[m] = cmul(a[m], w); w = cmul(w, w1); } }
        UNR for (int m = 0; m < R; ++m) F[fidx(base + m * S)] = a[m];
    }
}
DEVFN void fft_fwd(F2* F, const F2* TW, int tid) {
    fft_stage<4, false>(F, TW, 16384, tid); SYNC(); fft_stage<16, false>(F, TW, 4096, tid); SYNC(); fft_stage<16, false>(F, TW, 256, tid); SYNC(); fft_stage<16, false>(F, TW, 16, tid); SYNC();
}
DEVFN void fft_inv(F2* F, const F2* TW, int tid) {
    fft_stage<16, true>(F, TW, 16, tid); SYNC(); fft_stage<16, true>(F, TW, 256, tid); SYNC(); fft_stage<16, true>(F, TW, 4096, tid); SYNC(); fft_stage<4, true>(F, TW, 16384, tid); SYNC();
}
DEVFN int fpos(int k) { return ((k & 3) << 12) | (((k >> 2) & 15) << 8) | (((k >> 6) & 15) << 4) | (k >> 10); }

DEVFN float block_sum(float v, float* red, int tid) {
    v = wave_sum(v);
    if ((tid & 63) == 0) red[tid >> 6] = v;
    SYNC();
    float s = 0.f; UNR for (int w = 0; w < NWAVES; ++w) s += red[w];
    SYNC();
    return s;
}

DEVFN void hyena_channel(const Ctx& C, int i, int c, unsigned char* lds) {
    const int tid = C.tid; constexpr int L = NLAT;
    F2* F = (F2*)lds; float* Ff = (float*)lds;
    float* W3C = (float*)(lds + 139264);
    float* red = W3C + 272;
    const F2* TW = (const F2*)(C.ws + WS_TW);
    const float* hid = (const float*)(C.ws + WS_HID) + (size_t)i * NLAT * 64;
    const float* w3 = C.in[I_HW3] + (size_t)i * 64 * 2048; const float* b3 = C.in[I_HB3] + (size_t)i * 2048;
    const bf16_t* VX0 = (const bf16_t*)(C.ws + WS_VX0) + (size_t)c * L;
    const bf16_t* VX1 = (const bf16_t*)(C.ws + WS_VX1) + (size_t)c * L;
    const bf16_t* VX2 = (const bf16_t*)(C.ws + WS_VX2) + (size_t)c * L;
    bf16_t* YHY = (bf16_t*)(C.ws + WS_YHY) + (size_t)c * L;
    const float skip0 = C.in[I_HSKIP][(size_t)i * 1024 + c], skip1 = C.in[I_HSKIP][(size_t)i * 1024 + 512 + c];
    const float delta = 15.350567286626973f + (float)c * ((3.0701134573253945f - 15.350567286626973f) / 511.0f);
    if (tid < 256) { const int o = tid >> 7, s = (tid >> 6) & 1, m = tid & 63; W3C[tid] = w3[(size_t)m * 2048 + (s * 2 + o) * 512 + c]; }
    if (tid < 4) W3C[256 + tid] = b3[((tid & 1) * 2 + (tid >> 1)) * 512 + c];
    SYNC();
    UNR1 for (int o = 0; o < 2; ++o) {
        float ssq = 0.f;
        {
            const int part = tid & 3, tsub = (tid & 63) >> 2, wv = tid >> 6;
            float wf[16], wb[16];
            UNR for (int m = 0; m < 16; ++m) { wf[m] = W3C[(o * 2 + 0) * 64 + 16 * part + m]; wb[m] = W3C[(o * 2 + 1) * 64 + 16 * part + m]; }
            const float bf_ = W3C[256 + o * 2 + 0], bb_ = W3C[256 + o * 2 + 1];
            UNR1 for (int ii = 0; ii < 128; ++ii) {
                const int t = (ii * 8 + wv) * 16 + tsub;
                const F4* hr = (const F4*)(hid + (size_t)t * 64 + 16 * part);
                float af = 0.f, ab = 0.f;
                UNR for (int m4 = 0; m4 < 4; ++m4) { const F4 h = hr[m4];
                    af += h.x * wf[4 * m4] + h.y * wf[4 * m4 + 1] + h.z * wf[4 * m4 + 2] + h.w * wf[4 * m4 + 3];
                    ab += h.x * wb[4 * m4] + h.y * wb[4 * m4 + 1] + h.z * wb[4 * m4 + 2] + h.w * wb[4 * m4 + 3]; }
                af = rowx_add<1>(af); af = rowx_add<2>(af); ab = rowx_add<1>(ab); ab = rowx_add<2>(ab);
                if (part == 0) {
                    const float win = expf(-((float)t / (float)(L - 1)) * delta);
                    af = (af + bf_) * win; ab = (ab + bb_) * win;
                    if (t == 0) { af += ab; ssq += af * af; Ff[0] = af; Ff[2 * fidx(L >> 1)] = 0.f; }
                    else { ssq += af * af + ab * ab; Ff[2 * fidx(t >> 1) + (t & 1)] = af; const int m = 2 * L - t; Ff[2 * fidx(m >> 1) + (m & 1)] = ab; }
                }
            }
        }
        const float knorm = 1.0f / sqrtf(block_sum(ssq, red, tid));
        fft_fwd(F, TW, tid);
        F2 kfa[16], kfb[16]; F2 kfh = {0.f, 0.f};
        int tq1 = tid; OPAQUE(tq1);
        UNR for (int ii = 0; ii < 16; ++ii) {
            const int k = tq1 + NTHREADS * ii;
            if (k == 0) { const F2 c0 = F[fidx(0)]; kfa[ii].x = (c0.x + c0.y) * knorm; kfa[ii].y = 0.f; kfb[ii].x = (c0.x - c0.y) * knorm; kfb[ii].y = 0.f;
                          const F2 ch = F[fidx(fpos(L / 2))]; kfh.x = ch.x * knorm; kfh.y = -ch.y * knorm; }
            else { const F2 ck = F[fidx(fpos(k))], cp = cconj(F[fidx(fpos(L - k))]);
                F2 e = cadd(ck, cp), od = csub(ck, cp); e.x *= 0.5f; e.y *= 0.5f; F2 oo; oo.x = 0.5f * od.y; oo.y = -0.5f * od.x;
                const F2 tt = cmul(TW[k], oo);
                kfa[ii] = cadd(e, tt); kfb[ii] = cconj(csub(e, tt)); kfa[ii].x *= knorm; kfa[ii].y *= knorm; kfb[ii].x *= knorm; kfb[ii].y *= knorm; }
            CFENCE();
        }
        SYNC();
        UNR for (int ii = 0; ii < 4; ++ii) {
            int tq3 = tid; OPAQUE(tq3); const int t0 = 8 * (tq3 + NTHREADS * ii); float v[8];
            unpack8(ld16((o == 0 ? VX0 : (const bf16_t*)YHY) + t0), v);
            float* d = Ff + 2 * fidx(t0 >> 1); UNR for (int e = 0; e < 8; ++e) d[e] = v[e];
            float* zz = Ff + 2 * fidx((L + t0) >> 1); UNR for (int e = 0; e < 8; ++e) zz[e] = 0.f;
        }
        SYNC();
        fft_fwd(F, TW, tid);
        int tq2 = tid; OPAQUE(tq2);
        UNR for (int ii = 0; ii < 16; ++ii) {
            const int k = tq2 + NTHREADS * ii;
            if (k == 0) { const F2 c0 = F[fidx(0)]; const float y0 = (c0.x + c0.y) * kfa[ii].x, yl = (c0.x - c0.y) * kfb[ii].x; F2 d; d.x = 0.5f * (y0 + yl); d.y = 0.5f * (y0 - yl); F[fidx(0)] = d;
                          const int ph = fidx(fpos(L / 2)); const F2 y = cmul(cconj(F[ph]), kfh); F[ph] = cconj(y); }
            else { const int pk = fidx(fpos(k)), pp = fidx(fpos(L - k)); const F2 ck = F[pk], cp = cconj(F[pp]);
                F2 e = cadd(ck, cp), od = csub(ck, cp); e.x *= 0.5f; e.y *= 0.5f; F2 oo; oo.x = 0.5f * od.y; oo.y = -0.5f * od.x;
                const F2 w = TW[k]; const F2 tt = cmul(w, oo);
                const F2 yk = cmul(cadd(e, tt), kfa[ii]), yp = cmul(cconj(csub(e, tt)), kfb[ii]);
                F2 ye = cadd(yk, cconj(yp)), yd = csub(yk, cconj(yp)); ye.x *= 0.5f; ye.y *= 0.5f; yd.x *= 0.5f; yd.y *= 0.5f;
                const F2 yo = cmulc(yd, w);
                F2 iyo; iyo.x = -yo.y; iyo.y = yo.x;
                F[pk] = cadd(ye, iyo); F[pp] = cconj(csub(ye, iyo)); }
            CFENCE();
        }
        SYNC();
        fft_inv(F, TW, tid);
        UNR for (int ii = 0; ii < 4; ++ii) {
            int tq4 = tid; OPAQUE(tq4); const int t0 = 8 * (tq4 + NTHREADS * ii); const float* d = Ff + 2 * fidx(t0 >> 1);
            float y[8]; UNR for (int e = 0; e < 8; ++e) y[e] = d[e] * (1.0f / (float)FFT_N);
            if (o == 0) { float v[8], x1[8], r[8]; unpack8(ld16(VX0 + t0), v); unpack8(ld16(VX1 + t0), x1); UNR for (int e = 0; e < 8; ++e) r[e] = x1[e] * (y[e] + v[e] * skip0); st16(YHY + t0, pack8(r)); }
            else { float x2[8], zp[8], r[8]; unpack8(ld16(VX2 + t0), x2); unpack8(ld16(YHY + t0), zp); UNR for (int e = 0; e < 8; ++e) r[e] = x2[e] * (y[e] + zp[e] * skip1); st16(YHY + t0, pack8(r)); }
        }
        SYNC();
    }
}

DEVFN void hyena_ctx_channel(const Ctx& C, int i, int c, unsigned char* lds) {
    const int tid = C.tid; constexpr int L = NCTX;
    float* KF = (float*)lds;
    float* Z = KF + 1024;
    float* red = Z + 256;
    float* W3C = red + 16;
    const float* hid = (const float*)(C.ws + WS_HID256);
    const float* w3 = C.in[I_HW3] + (size_t)i * 64 * 2048; const float* b3 = C.in[I_HB3] + (size_t)i * 2048;
    const float* VXC = (const float*)(C.ws + WS_VXC);
    const float delta = 15.350567286626973f + (float)c * ((3.0701134573253945f - 15.350567286626973f) / 511.0f);
    if (tid < 256) { const int o = tid >> 7, s = (tid >> 6) & 1, m = tid & 63; W3C[tid] = w3[(size_t)m * 2048 + (s * 2 + o) * 512 + c]; }
    if (tid < 4) W3C[256 + tid] = b3[((tid & 1) * 2 + (tid >> 1)) * 512 + c];
    SYNC();
    {
        const int o = tid >> 8, t = tid & 255;
        float af = W3C[256 + o * 2 + 0], ab = W3C[256 + o * 2 + 1];
        for (int m = 0; m < 64; ++m) { const float h = hid[t * 64 + m]; af += h * W3C[(o * 2 + 0) * 64 + m]; ab += h * W3C[(o * 2 + 1) * 64 + m]; }
        const float win = expf(-((float)t / (float)(L - 1)) * delta); af *= win; ab *= win;
        float ssq; if (t == 0) { af += ab; ab = 0.f; ssq = af * af; } else ssq = af * af + ab * ab;
        KF[(o * 2 + 0) * 256 + t] = af; KF[(o * 2 + 1) * 256 + t] = ab;
        ssq = wave_sum(ssq);
        if ((tid & 63) == 0) red[tid >> 6] = ssq;
        SYNC();
        const float tot = red[o * 4] + red[o * 4 + 1] + red[o * 4 + 2] + red[o * 4 + 3];
        const float kn = 1.0f / sqrtf(tot);
        KF[(o * 2 + 0) * 256 + t] = af * kn; KF[(o * 2 + 1) * 256 + t] = ab * kn;
    }
    float v = 0.f, x1 = 0.f, x2 = 0.f, z1 = 0.f;
    if (tid < 256) { v = VXC[((size_t)0 * 512 + c) * L + tid]; x1 = VXC[((size_t)1 * 512 + c) * L + tid]; x2 = VXC[((size_t)2 * 512 + c) * L + tid]; Z[tid] = v; }
    SYNC();
    for (int o = 0; o < 2; ++o) {
        float y = 0.f;
        if (tid < 256) { const int t = tid; const float* kf = KF + (o * 2) * 256; const float* kb = KF + (o * 2 + 1) * 256;
            for (int s = 0; s <= t; ++s) y += kf[t - s] * Z[s];
            for (int s = t + 1; s < L; ++s) y += kb[s - t] * Z[s]; }
        SYNC();
        if (tid < 256) { if (o == 0) { z1 = x1 * (y + v * C.in[I_HSKIP][(size_t)i * 1024 + c]); Z[tid] = z1; }
            else { const float r = x2 * (y + z1 * C.in[I_HSKIP][(size_t)i * 1024 + 512 + c]);
                const bf16_t* GHY = (const bf16_t*)(C.ws + WS_GHY); bf16_t* HO = (bf16_t*)(C.ws + WS_HYOUT);
                HO[(size_t)(NLAT + tid) * 512 + c] = (bf16_t)f2bf(r * bf2f(GHY[(size_t)(NLAT + tid) * 512 + c])); } }
        SYNC();
    }
}

typedef float P2 __attribute__((vector_size(8)));
#ifdef EMU
struct H8 { unsigned short v[8]; };
struct A4 { float v[4]; };
inline A4 mfma16(const H8& a, const H8& b, const A4& c) {
    static H8 sa_[emu::MAXB][8][64], sb_[emu::MAXB][8][64]; const int w = emu::t_tid >> 6, l = emu::t_tid & 63; H8 (*sa)[64] = sa_[emu::t_blk]; H8 (*sb)[64] = sb_[emu::t_blk];
    sa[w][l] = a; sb[w][l] = b; pthread_barrier_wait(&emu::g_wbar_[emu::t_blk][w]);
    A4 r = c;
    for (int reg = 0; reg < 4; ++reg) { const int row = 4 * (l >> 4) + reg, col = l & 15; float acc = 0.f;
        for (int k = 0; k < 32; ++k) acc += bf2f(sa[w][row + 16 * (k >> 3)].v[k & 7]) * bf2f(sb[w][col + 16 * (k >> 3)].v[k & 7]);
        r.v[reg] += acc; }
    pthread_barrier_wait(&emu::g_wbar_[emu::t_blk][w]);
    return r;
}
#define H8_SET(h, j, x) (h).v[j] = (unsigned short)(x)
#define A4_GET(a, j) (a).v[j]
#define MFMA_PAD(a,b,c,d,e,f,g,h)
#else
typedef short H8 __attribute__((ext_vector_type(8)));
typedef float A4 __attribute__((ext_vector_type(4)));
DEVFN A4 mfma16(const H8& a, const H8& b, const A4& c) { return __builtin_amdgcn_mfma_f32_16x16x32_bf16(a, b, c, 0, 0, 0); }
#define H8_SET(h, j, x) (h)[j] = (short)(x)
#define A4_GET(a, j) (a)[j]
#define MFMA_PAD(a,b,c,d,e,f,g,h) asm volatile("s_nop 15\n\ts_nop 15" : "+v"(a), "+v"(b), "+v"(c), "+v"(d), "+v"(e), "+v"(f), "+v"(g), "+v"(h))
#endif
#ifdef EMU
#define FEXP(x) expf(x)
#define FLOG(x) logf(x)
#define FRCP(x) (1.0f / (x))
#define FRSQ(x) (1.0f / sqrtf(x))
#define SETPRIO(n)
#else
#define FEXP(x) __expf(x)
#define FLOG(x) __logf(x)
#define FRCP(x) __builtin_amdgcn_rcpf(x)
#define FRSQ(x) __builtin_amdgcn_rsqf(x)
#define SETPRIO(n) __builtin_amdgcn_s_setprio(n)
#endif
DEVFN H8 h8_from_u4(U4 w) { H8 r; H8_SET(r, 0, w.x & 0xffff); H8_SET(r, 1, w.x >> 16); H8_SET(r, 2, w.y & 0xffff); H8_SET(r, 3, w.y >> 16); H8_SET(r, 4, w.z & 0xffff); H8_SET(r, 5, w.z >> 16); H8_SET(r, 6, w.w & 0xffff); H8_SET(r, 7, w.w >> 16); return r; }
constexpr int SC_T = 32;
constexpr int SC_R = 16;
constexpr int SC_BUF = 5 * SC_T * 64 + SC_T * SC_R;
DEVFN void rwkv_scan(const Ctx& C, int i, int h, int d, int rq, bool ctx_out, unsigned char* lds, int max_chunks) {
    const int tid = C.tid;
    float* sBUF = (float*)lds; float* sY = sBUF + 2 * SC_BUF; float* sWV = sY + 2 * SC_T * SC_R;
    const bf16_t* U = (const bf16_t*)(C.ws + WS_U);
    const float* mu = C.in[I_MU] + (size_t)i * 1664;
    const float* w0 = C.in[I_W0] + ((size_t)i * 2 + d) * 512 + 64 * h; const float* a0 = C.in[I_A0] + ((size_t)i * 2 + d) * 512 + 64 * h;
    const float* wup = C.in[I_WUP] + ((size_t)i * 2 + d) * 32 * 512 + 64 * h; const float* aup = C.in[I_AUP] + ((size_t)i * 2 + d) * 32 * 512 + 64 * h;
    const float* k_k = C.in[I_KK] + (size_t)i * 512 + 64 * h; const float* k_a = C.in[I_KA] + (size_t)i * 512 + 64 * h; const float* r_k = C.in[I_RK] + (size_t)i * 512 + 64 * h;
    bf16_t* Yd = (bf16_t*)(C.ws + (d == 0 ? WS_YF : WS_YB));
    float* BON = (float*)(C.ws + WS_BONUS) + (size_t)d * NTOK * 8;
    const bool is_scan = tid < 256;
    const int nchunks = NTOK / SC_T < max_chunks ? NTOK / SC_T : max_chunks;
    #define CHUNK_GEOM(ch, seg0, segn, R0) const bool isctx_ = (ch) < NCTX / SC_T; const int seg0 = isctx_ ? NLAT : 0, segn = isctx_ ? NCTX : NLAT; \
        const int cl_ = isctx_ ? (ch) : (ch) - NCTX / SC_T; const int R0 = d == 0 ? SC_T * cl_ : segn - SC_T * (cl_ + 1);
    const int ft = (tid & 255) >> 3, fp = tid & 7;
    float* sCN = sWV + 4 * 1280; float* sCN_base_ = sCN;
    if (tid < 64) { const int j = tid; sCN[j] = mu[64 * h + j]; sCN[64 + j] = mu[512 + 64 * h + j]; sCN[128 + j] = mu[1024 + 64 * h + j]; sCN[192 + j] = w0[j]; sCN[256 + j] = a0[j];
        sCN[320 + j] = k_k[j]; sCN[384 + j] = k_a[j]; sCN[448 + j] = r_k[j]; sCN[512 + j] = j < 32 ? mu[1536 + 32 * d + j] : mu[1600 + 32 * d + (j - 32)]; }
    U4* sBF = (U4*)(sCN_base_ + 640);
    { const int m = tid >> 8, nt = (tid >> 6) & 3, ln = tid & 63; const float* src = m == 0 ? wup : aup; float f[8];
      UNR for (int j = 0; j < 8; ++j) f[j] = src[(size_t)(8 * (ln >> 4) + j) * 512 + 16 * nt + (ln & 15)];
      sBF[tid] = pack8(f); }
    float* myWV = sWV + ((tid >> 6) & 3) * 1280; float* sWL = myWV; float* sAL = myWV + 512; bf16_t* sTDb = (bf16_t*)(myWV + 1024); bf16_t* sADb = sTDb + 256;
    const int rl = (tid & 255) >> 4, sp = tid & 15;
    float S0 = 0.f, S1 = 0.f, S2 = 0.f, S3 = 0.f;
    SYNC();
    U4 pu[9]; U2 pw[6];
    auto issue = [&](int ch) {
        int tq_ = tid; OPAQUE(tq_); const int ft = (tq_ & 255) >> 3, fp = tq_ & 7;
        CHUNK_GEOM(ch, seg0, segn, R0)
        const int tl = d == 0 ? R0 + ft : R0 + SC_T - 1 - ft;
        const bf16_t* u0p = U + (size_t)(seg0 + tl) * URW_W;
        const bool hm = tl > 0, hp = tl < segn - 1;
        const U4 z4 = {0u, 0u, 0u, 0u}; const U2 z2 = {0u, 0u};
        const int cw = 1536 + 32 * d + 4 * fp, ca = 1600 + 32 * d + 4 * fp;
        UNR for (int j = 0; j < 3; ++j) { pu[3 * j] = ld16(u0p + 512 * j + 64 * h + 8 * fp); pu[3 * j + 1] = z4; pu[3 * j + 2] = z4; }
        pw[0] = *(const U2*)(u0p + cw); pw[3] = *(const U2*)(u0p + ca); pw[1] = z2; pw[2] = z2; pw[4] = z2; pw[5] = z2;
        if (hm) { UNR for (int j = 0; j < 3; ++j) pu[3 * j + 1] = ld16(u0p - URW_W + 512 * j + 64 * h + 8 * fp); pw[1] = *(const U2*)(u0p - URW_W + cw); pw[4] = *(const U2*)(u0p - URW_W + ca); }
        if (hp) { UNR for (int j = 0; j < 3; ++j) pu[3 * j + 2] = ld16(u0p + URW_W + 512 * j + 64 * h + 8 * fp); pw[2] = *(const U2*)(u0p + URW_W + cw); pw[5] = *(const U2*)(u0p + URW_W + ca); }
    };
    auto features = [&](int ch) {
        int tq_ = tid; OPAQUE(tq_); const int ft = (tq_ & 255) >> 3, fp = tq_ & 7;
        const float* mu_r = sCN + 8 * fp; const float* mu_k = sCN + 64 + 8 * fp; const float* mu_v = sCN + 128 + 8 * fp; const float* c_w0 = sCN + 192 + 8 * fp; const float* c_a0 = sCN + 256 + 8 * fp;
        const float* c_kk = sCN + 320 + 8 * fp; const float* c_ka = sCN + 384 + 8 * fp; const float* c_rk = sCN + 448 + 8 * fp; const float* mu_w = sCN + 512 + 4 * fp; const float* mu_a = sCN + 544 + 4 * fp;
        CHUNK_GEOM(ch, seg0, segn, R0)
        float* B_ = sBUF + (ch & 1) * SC_BUF; float* sW = B_; float* sKD = B_ + SC_T * 64; float* sB = B_ + 2 * SC_T * 64; float* sKK = B_ + 3 * SC_T * 64; float* sR = B_ + 4 * SC_T * 64; float* sV = B_ + 5 * SC_T * 64;
        const int tl = d == 0 ? R0 + ft : R0 + SC_T - 1 - ft;
        float r[8], k[8], v[8];
        {
            float a[8], m[8], p[8];
            #define SHIFT3(J, MU, OUT) do { unpack8(pu[3 * (J)], a); unpack8(pu[3 * (J) + 1], m); unpack8(pu[3 * (J) + 2], p); \
                UNR for (int e = 0; e < 8; ++e) OUT[e] = a[e] + (0.5f * (m[e] + p[e]) - a[e]) * MU[e]; } while (0)
            SHIFT3(0, mu_r, r); SHIFT3(1, mu_k, k); SHIFT3(2, mu_v, v);
            #undef SHIFT3
        }
        {
            const U2 w0_ = pw[0], wm = pw[1], wp = pw[2], a0_ = pw[3], am = pw[4], ap = pw[5];
            const float wa[4] = {bflo(w0_.x), bfhi(w0_.x), bflo(w0_.y), bfhi(w0_.y)}, wmm[4] = {bflo(wm.x), bfhi(wm.x), bflo(wm.y), bfhi(wm.y)}, wpp[4] = {bflo(wp.x), bfhi(wp.x), bflo(wp.y), bfhi(wp.y)};
            const float aa[4] = {bflo(a0_.x), bfhi(a0_.x), bflo(a0_.y), bfhi(a0_.y)}, amm[4] = {bflo(am.x), bfhi(am.x), bflo(am.y), bfhi(am.y)}, app[4] = {bflo(ap.x), bfhi(ap.x), bflo(ap.y), bfhi(ap.y)};
            if (ch + 1 < nchunks) issue(ch + 1);
            const int tw = ft & 7;
            float tdv[4], adv[4];
            UNR for (int e = 0; e < 4; ++e) { const float x = wa[e] + (0.5f * (wmm[e] + wpp[e]) - wa[e]) * mu_w[e];
                tdv[e] = 1.0f - 2.0f * FRCP(1.0f + FEXP(2.0f * x));
                adv[e] = aa[e] + (0.5f * (amm[e] + app[e]) - aa[e]) * mu_a[e]; }
            U2 tq, aq; tq.x = pk2(tdv[0], tdv[1]); tq.y = pk2(tdv[2], tdv[3]); aq.x = pk2(adv[0], adv[1]); aq.y = pk2(adv[2], adv[3]);
            *(U2*)(sTDb + tw * 32 + 4 * fp) = tq; *(U2*)(sADb + tw * 32 + 4 * fp) = aq;
        }
        WAVE_SYNC();
        float wl[8], al[8];
        {
            const int lane = tid & 63, arow = lane & 7, kg = lane >> 4;
            const U4 ta = ld16(sTDb + arow * 32 + 8 * kg), aa_ = ld16(sADb + arow * 32 + 8 * kg);
            H8 At, Aa;
            H8_SET(At, 0, ta.x & 0xffff); H8_SET(At, 1, ta.x >> 16); H8_SET(At, 2, ta.y & 0xffff); H8_SET(At, 3, ta.y >> 16); H8_SET(At, 4, ta.z & 0xffff); H8_SET(At, 5, ta.z >> 16); H8_SET(At, 6, ta.w & 0xffff); H8_SET(At, 7, ta.w >> 16);
            H8_SET(Aa, 0, aa_.x & 0xffff); H8_SET(Aa, 1, aa_.x >> 16); H8_SET(Aa, 2, aa_.y & 0xffff); H8_SET(Aa, 3, aa_.y >> 16); H8_SET(Aa, 4, aa_.z & 0xffff); H8_SET(Aa, 5, aa_.z >> 16); H8_SET(Aa, 6, aa_.w & 0xffff); H8_SET(Aa, 7, aa_.w >> 16);
            A4 cw_[4], ca_[4];
            UNR for (int nt = 0; nt < 4; ++nt) {
                A4 z; A4_GET(z, 0) = 0.f; A4_GET(z, 1) = 0.f; A4_GET(z, 2) = 0.f; A4_GET(z, 3) = 0.f;
                cw_[nt] = mfma16(At, h8_from_u4(sBF[nt * 64 + (tid & 63)]), z); ca_[nt] = mfma16(Aa, h8_from_u4(sBF[(4 + nt) * 64 + (tid & 63)]), z);
            }
            MFMA_PAD(cw_[0], cw_[1], cw_[2], cw_[3], ca_[0], ca_[1], ca_[2], ca_[3]);
            if (lane < 32) { UNR for (int nt = 0; nt < 4; ++nt) UNR for (int rg = 0; rg < 4; ++rg) { const int tok = 4 * (lane >> 4) + rg; sWL[tok * 64 + 16 * nt + (lane & 15)] = A4_GET(cw_[nt], rg); sAL[tok * 64 + 16 * nt + (lane & 15)] = A4_GET(ca_[nt], rg); } }
            WAVE_SYNC();
            const int tw = ft & 7;
            { const F4 w0_ = *(const F4*)(sWL + tw * 64 + 8 * fp), w1_ = *(const F4*)(sWL + tw * 64 + 8 * fp + 4), a0_ = *(const F4*)(sAL + tw * 64 + 8 * fp), a1_ = *(const F4*)(sAL + tw * 64 + 8 * fp + 4);
              const F4 cw0 = *(const F4*)(c_w0), cw1 = *(const F4*)(c_w0 + 4), ca0 = *(const F4*)(c_a0), ca1 = *(const F4*)(c_a0 + 4);
              wl[0] = cw0.x + w0_.x; wl[1] = cw0.y + w0_.y; wl[2] = cw0.z + w0_.z; wl[3] = cw0.w + w0_.w; wl[4] = cw1.x + w1_.x; wl[5] = cw1.y + w1_.y; wl[6] = cw1.z + w1_.z; wl[7] = cw1.w + w1_.w;
              al[0] = ca0.x + a0_.x; al[1] = ca0.y + a0_.y; al[2] = ca0.z + a0_.z; al[3] = ca0.w + a0_.w; al[4] = ca1.x + a1_.x; al[5] = ca1.y + a1_.y; al[6] = ca1.z + a1_.z; al[7] = ca1.w + a1_.w; }
            WAVE_SYNC();
        }
        float kkv[8], ssq = 0.f;
        UNR for (int e = 0; e < 8; ++e) { kkv[e] = k[e] * c_kk[e]; ssq += kkv[e] * kkv[e]; }
        ssq = rowx_add<1>(ssq); ssq = rowx_add<2>(ssq); ssq = rowx_add<7>(ssq);
        const float kn = FRSQ(ssq + 1e-12f);
        float bon = 0.f; float o_w[8], o_kd[8], o_b[8], o_kk[8];
        UNR for (int e = 0; e < 8; ++e) {
            const float dec = FEXP(-0.60653066f * FRCP(1.0f + FEXP(-wl[e])));
            const float a = FRCP(1.0f + FEXP(-al[e]));
            const float kd = k[e] * (1.0f + (a - 1.0f) * c_ka[e]);
            const float kk = kkv[e] * kn;
            o_w[e] = dec; o_kd[e] = kd; o_b[e] = kk * a; o_kk[e] = kk;
            bon += r[e] * kd * c_rk[e];
        }
        { const int o = ft * 64 + 8 * fp;
          #define ST8(P, A) do { F4 x0_, x1_; x0_.x = A[0]; x0_.y = A[1]; x0_.z = A[2]; x0_.w = A[3]; x1_.x = A[4]; x1_.y = A[5]; x1_.z = A[6]; x1_.w = A[7]; *(F4*)((P) + o) = x0_; *(F4*)((P) + o + 4) = x1_; } while (0)
          ST8(sW, o_w); ST8(sKD, o_kd); ST8(sB, o_b); ST8(sKK, o_kk); ST8(sR, r);
          #undef ST8
        }
        if ((fp >> 1) == rq) { UNR for (int e = 0; e < 8; ++e) sV[ft * SC_R + 8 * (fp & 1) + e] = v[e]; }
        bon = rowx_add<1>(bon); bon = rowx_add<2>(bon); bon = rowx_add<7>(bon);
        if (fp == 0 && rq == 0) BON[(size_t)(seg0 + tl) * 8 + h] = 0.5f * bon;
    };
    auto store_y = [&](int ch) {
        CHUNK_GEOM(ch, seg0, segn, R0)
        if (isctx_ && !ctx_out) return;
        const float* Yb = sY + (ch & 1) * SC_T * SC_R;
        const int k = (tid & 255) >> 3, q = (tid & 7) * 2; const int tl = d == 0 ? R0 + k : R0 + SC_T - 1 - k;
        *(unsigned*)(Yd + (size_t)(seg0 + tl) * 512 + 64 * h + SC_R * rq + q) = pk2(Yb[k * SC_R + q], Yb[k * SC_R + q + 1]);
    };
    if (!is_scan) { issue(0); features(0); }
    SYNC();
    if (C.wave < 4) SETPRIO(3);
    TACC_DECL;
    for (int ch = 0; ch < nchunks; ++ch) {
        TACC_BEGIN;
        if (is_scan) {
            const float* B_ = sBUF + (ch & 1) * SC_BUF; const float* sW = B_; const float* sKD = B_ + SC_T * 64; const float* sB = B_ + 2 * SC_T * 64; const float* sKK = B_ + 3 * SC_T * 64; const float* sR = B_ + 4 * SC_T * 64; const float* sV = B_ + 5 * SC_T * 64;
            float* Yb = sY + (ch & 1) * SC_T * SC_R;
            float yk0 = 0.f, yk1 = 0.f, yp = 0.f;
#ifndef EMU
            {
                const unsigned ab = (unsigned)(uintptr_t)B_ + 16u * (unsigned)sp, av = (unsigned)(uintptr_t)sV + 4u * (unsigned)rl;
                P2 s01 = {S0, S1}, s23 = {S2, S3};
                asm volatile(SCAN_CHUNK_ASM : [s01] "+v"(s01), [s23] "+v"(s23), [yp] "+v"(yp), [yk0] "+v"(yk0), [yk1] "+v"(yk1) : [ab] "v"(ab), [av] "v"(av), [sp] "v"(sp) : SCAN_CHUNK_CLOBBERS);
                S0 = s01[0]; S1 = s01[1]; S2 = s23[0]; S3 = s23[1];
            }
#else
            for (int k = 0; k < SC_T; ++k) {
                const F4 kk4 = *(const F4*)(sKK + k * 64 + 4 * sp), w4 = *(const F4*)(sW + k * 64 + 4 * sp), b4 = *(const F4*)(sB + k * 64 + 4 * sp),
                         kd4 = *(const F4*)(sKD + k * 64 + 4 * sp), r4 = *(const F4*)(sR + k * 64 + 4 * sp);
                const float vi = sV[k * SC_R + rl];
                float sa = (S0 * kk4.x + S2 * kk4.z) + (S1 * kk4.y + S3 * kk4.w);
                const float t0 = S0 * w4.x + vi * kd4.x, t1 = S1 * w4.y + vi * kd4.y, t2 = S2 * w4.z + vi * kd4.z, t3 = S3 * w4.w + vi * kd4.w;
                sa = rowx_add<1>(sa); yp = rowx_add<1>(yp); sa = rowx_add<2>(sa); yp = rowx_add<2>(yp);
                sa = rowx_add<7>(sa); yp = rowx_add<7>(yp); sa = rowx_add<15>(sa); yp = rowx_add<15>(yp);
                if (sp == ((k + 15) & 15)) { if (k <= 16) yk0 = yp; else yk1 = yp; }
                S0 = t0 - sa * b4.x; S1 = t1 - sa * b4.y; S2 = t2 - sa * b4.z; S3 = t3 - sa * b4.w;
                yp = (S0 * r4.x + S2 * r4.z) + (S1 * r4.y + S3 * r4.w);
            }
#endif
            yp = rowx_add<1>(yp); yp = rowx_add<2>(yp); yp = rowx_add<7>(yp); yp = rowx_add<15>(yp);
            if (sp == 15) yk1 = yp;
            Yb[sp * SC_R + rl] = yk0; Yb[(sp + 16) * SC_R + rl] = yk1;
        } else {
            if (ch + 1 < nchunks) features(ch + 1);
            if (ch > 0) store_y(ch - 1);
        }
        TACC_END;
        SYNC();
    }
    TACC_STORE(C, is_scan ? 45 : 46, C.vcu == 0 && (tid == 0 || tid == 256));
    if (C.wave < 4) SETPRIO(0);
    if (!is_scan) store_y(nchunks - 1);
    #undef CHUNK_GEOM
}

DEVFN void ph_readout_hyout(const Ctx& C, int i, bool do_ctx, unsigned char* lds) {
    const int tid = C.tid;
    {
        const bf16_t* U = (const bf16_t*)(C.ws + WS_U); bf16_t* YF = (bf16_t*)(C.ws + WS_YF); const bf16_t* YB = (const bf16_t*)(C.ws + WS_YB);
        const float* BON = (const float*)(C.ws + WS_BONUS);
        const float* mu = C.in[I_MU] + (size_t)i * 1664 + 1024; const float* gnw = C.in[I_GNW] + (size_t)i * 512; const float* gnb = C.in[I_GNB] + (size_t)i * 512;
        const int rl = tid >> 6, c8 = (tid & 63) * 8, h = (tid & 63) >> 3;
        float muv[8], gw_[8], gb_[8];
        UNR for (int e = 0; e < 8; ++e) { muv[e] = mu[c8 + e]; gw_[e] = gnw[c8 + e]; gb_[e] = gnb[c8 + e]; }
        const int nrows = do_ctx ? NTOK : NLAT;
        for (int r0 = C.vcu * 8; r0 < nrows; r0 += C.G * 8) {
            const int row = r0 + rl; const bool isctx = row >= NLAT; const int seg0 = isctx ? NLAT : 0, segn = isctx ? NCTX : NLAT, tl = row - seg0;
            float yf[8], yb[8], y[8], a[8], m[8], p[8], g[8];
            unpack8(ld16(YF + (size_t)row * 512 + c8), yf); unpack8(ld16(YB + (size_t)row * 512 + c8), yb);
            float s = 0.f; UNR for (int e = 0; e < 8; ++e) { y[e] = yf[e] + yb[e]; s += y[e]; }
            s = rowx_add<1>(s); s = rowx_add<2>(s); s = rowx_add<7>(s);
            const float mean = s * (1.0f / 64.0f); float q = 0.f;
            UNR for (int e = 0; e < 8; ++e) { y[e] -= mean; q += y[e] * y[e]; }
            q = rowx_add<1>(q); q = rowx_add<2>(q); q = rowx_add<7>(q);
            const float rstd = 1.0f / sqrtf(q * (1.0f / 64.0f) + 64e-5f);
            const bf16_t* up = U + (size_t)row * URW_W + 1024 + c8;
            unpack8(ld16(up), a);
            if (tl > 0) unpack8(ld16(up - URW_W), m); else UNR for (int e = 0; e < 8; ++e) m[e] = 0.f;
            if (tl < segn - 1) unpack8(ld16(up + URW_W), p); else UNR for (int e = 0; e < 8; ++e) p[e] = 0.f;
            unpack8(ld16(U + (size_t)row * URW_W + 1664 + c8), g);
            const float bon = BON[(size_t)row * 8 + h] + BON[(size_t)NTOK * 8 + (size_t)row * 8 + h];
            float o[8];
            UNR for (int e = 0; e < 8; ++e) { const float v = a[e] + (0.5f * (m[e] + p[e]) - a[e]) * muv[e]; o[e] = (y[e] * rstd * gw_[e] + gb_[e] + bon * v) * g[e]; }
            st16(YF + (size_t)row * 512 + c8, pack8(o));
        }
    }
    {
        const bf16_t* YHY = (const bf16_t*)(C.ws + WS_YHY); const bf16_t* GHY = (const bf16_t*)(C.ws + WS_GHY); bf16_t* HO = (bf16_t*)(C.ws + WS_HYOUT);
        float* T = (float*)lds;
        for (int it = C.vcu; it < 256 * 8; it += C.G) {
            const int tb = it >> 3, cb = it & 7;
            { const int cl = tid >> 3, t8 = (tid & 7) * 8; float v[8]; unpack8(ld16(YHY + (size_t)(64 * cb + cl) * NLAT + 64 * tb + t8), v); UNR for (int e = 0; e < 8; ++e) T[cl * 65 + t8 + e] = v[e]; }
            SYNC();
            { const int tl = tid >> 3, c8 = (tid & 7) * 8; float g[8], o[8]; const size_t off = (size_t)(64 * tb + tl) * 512 + 64 * cb + c8;
              unpack8(ld16(GHY + off), g); UNR for (int e = 0; e < 8; ++e) o[e] = T[(c8 + e) * 65 + tl] * g[e]; st16(HO + off, pack8(o)); }
            SYNC();
        }
    }
}

constexpr int RC_T = 16, RC_RING = 7, RC_NPROD = 6;
constexpr int RS_KKD = 0, RS_RD = 2048, RS_KIT = 4096, RS_NBIT = 6144, RS_VT = 8192, RS_T = 9216, RS_P0 = 9728, RS_Q1 = 10240, RS_NQ2 = 10752, RS_GC = 11264, RS_BYTES = 11520;
constexpr int RW_TDAD = 0, RW_WL = 2048, RW_AL = 6144, RW_KIP = 2048, RW_BIP = 4096, RW_AM = 10240, RW_BYTES = 11264;
constexpr int RC_LDS_RING = 0, RC_LDS_WAVE = RC_RING * RS_BYTES, RC_LDS_BFR = RC_LDS_WAVE + RC_NPROD * RW_BYTES, RC_LDS_FLAGS = RC_LDS_BFR + 8192, RC_LDS_END = RC_LDS_FLAGS + 3 * 8 * 4;
static_assert(RC_LDS_END <= RING_BYTES, "rwkv chunked LDS");
#ifdef EMU
#include <sched.h>
#define SPIN_WAIT(cond) do { while (!(cond)) sched_yield(); __sync_synchronize(); } while (0)
#define LDS_FENCE() __sync_synchronize()
#else
#define SPIN_WAIT(cond) do { while (!(cond)) __builtin_amdgcn_s_sleep(1); asm volatile("" ::: "memory"); } while (0)
#define LDS_FENCE() asm volatile("s_waitcnt lgkmcnt(0)" ::: "memory")
#endif
#ifdef EMU
DEVFN float wave_sum_fast(float v) { v = rowx_add<1>(v); v = rowx_add<2>(v); v = rowx_add<7>(v); v = rowx_add<15>(v); return (shfl_f(v, 0) + shfl_f(v, 16)) + (shfl_f(v, 32) + shfl_f(v, 48)); }
#else
DEVFN float wave_sum_fast(float v) { v = rowx_add<1>(v); v = rowx_add<2>(v); v = rowx_add<7>(v); v = rowx_add<15>(v);
    const int i_ = __builtin_bit_cast(int, v);
    return (__builtin_bit_cast(float, __builtin_amdgcn_readlane(i_, 0)) + __builtin_bit_cast(float, __builtin_amdgcn_readlane(i_, 16))) + (__builtin_bit_cast(float, __builtin_amdgcn_readlane(i_, 32)) + __builtin_bit_cast(float, __builtin_amdgcn_readlane(i_, 48))); }
#endif
DEVFN int rc_pos(int k) { return (k & 32) | (((k >> 2) & 3) << 3) | (((k >> 4) & 1) << 2) | (k & 3); }
DEVFN H8 h8_from(U4 w) { H8 r; H8_SET(r, 0, w.x & 0xffff); H8_SET(r, 1, w.x >> 16); H8_SET(r, 2, w.y & 0xffff); H8_SET(r, 3, w.y >> 16); H8_SET(r, 4, w.z & 0xffff); H8_SET(r, 5, w.z >> 16); H8_SET(r, 6, w.w & 0xffff); H8_SET(r, 7, w.w >> 16); return r; }
DEVFN H8 h8_lo4(U2 w) { H8 r; H8_SET(r, 0, w.x & 0xffff); H8_SET(r, 1, w.x >> 16); H8_SET(r, 2, w.y & 0xffff); H8_SET(r, 3, w.y >> 16); H8_SET(r, 4, 0); H8_SET(r, 5, 0); H8_SET(r, 6, 0); H8_SET(r, 7, 0); return r; }
DEVFN H8 h8_zero() { H8 r; UNR for (int j = 0; j < 8; ++j) H8_SET(r, j, 0); return r; }
DEVFN H8 h8_pack2(const A4& a, const A4& b) { H8 r; UNR for (int j = 0; j < 4; ++j) { H8_SET(r, j, f2bf(A4_GET(a, j))); H8_SET(r, 4 + j, f2bf(A4_GET(b, j))); } return r; }
DEVFN H8 h8_pack1(const A4& a) { H8 r; UNR for (int j = 0; j < 4; ++j) { H8_SET(r, j, f2bf(A4_GET(a, j))); H8_SET(r, 4 + j, 0); } return r; }
DEVFN A4 a4_zero() { A4 z; A4_GET(z, 0) = 0.f; A4_GET(z, 1) = 0.f; A4_GET(z, 2) = 0.f; A4_GET(z, 3) = 0.f; return z; }

DEVFN void rwkv_chunked(const Ctx& C, int i, int h, int d, int vh, bool ctx_out, unsigned char* lds, int max_chunks) {
    const int tid = C.tid, lane = tid & 63, wave = tid >> 6;
    volatile unsigned* fl_ready = (volatile unsigned*)(lds + RC_LDS_FLAGS); volatile unsigned* fl_done0 = fl_ready + 8; volatile unsigned* fl_done1 = fl_done0 + 8;
    if (tid < 24) fl_ready[tid] = 0u;
    { U4* sBF = (U4*)(lds + RC_LDS_BFR); const int m = tid >> 8, nt = (tid >> 6) & 3, ln = tid & 63;
      const float* src = (m == 0 ? C.in[I_WUP] : C.in[I_AUP]) + ((size_t)i * 2 + d) * 32 * 512 + 64 * h; float f[8];
      UNR for (int j = 0; j < 8; ++j) f[j] = src[(size_t)(8 * (ln >> 4) + j) * 512 + 16 * nt + (ln & 15)];
      sBF[tid] = pack8(f); }
    SYNC();
    const int nchunks = (NTOK / RC_T) < max_chunks ? (NTOK / RC_T) : max_chunks;
    bf16_t* Yd = (bf16_t*)(C.ws + (d == 0 ? WS_YF : WS_YB));
    #define RC_GEOM(ch, seg0, segn, R0) const bool isctx_ = (ch) < NCTX / RC_T; const int seg0 = isctx_ ? NLAT : 0, segn = isctx_ ? NCTX : NLAT; \
        const int cl_ = isctx_ ? (ch) : (ch) - NCTX / RC_T; const int R0 = d == 0 ? RC_T * cl_ : segn - RC_T * (cl_ + 1);
    if (wave < 2) {
        const int vt = wave, kg = lane >> 4, l15 = lane & 15;
        A4 H0_ = a4_zero(), H1_ = a4_zero(), H2_ = a4_zero(), H3_ = a4_zero();
        for (int ch = 0; ch < nchunks; ++ch) {
            const int slot = ch % RC_RING; const unsigned char* rb = lds + RC_LDS_RING + slot * RS_BYTES;
            SPIN_WAIT(fl_ready[slot] == (unsigned)(ch + 1));
            const H8 Hb0 = h8_pack2(H0_, H1_), Hb1 = h8_pack2(H2_, H3_);
            const H8 Vb = kg < 2 ? h8_from(ld16(rb + RS_VT + ((16 * vt + l15) * 16 + 8 * kg) * 2)) : h8_zero();
            const H8 kkd0 = h8_from(ld16(rb + RS_KKD + (l15 * 64 + 8 * kg) * 2)), kkd1 = h8_from(ld16(rb + RS_KKD + (l15 * 64 + 32 + 8 * kg) * 2));
            const H8 rd0 = h8_from(ld16(rb + RS_RD + (l15 * 64 + 8 * kg) * 2)), rd1 = h8_from(ld16(rb + RS_RD + (l15 * 64 + 32 + 8 * kg) * 2));
            const H8 p0f = kg < 2 ? h8_from(ld16(rb + RS_P0 + (l15 * 16 + 8 * kg) * 2)) : h8_zero();
            const H8 q1f = kg < 2 ? h8_from(ld16(rb + RS_Q1 + (l15 * 16 + 8 * kg) * 2)) : h8_zero();
            const H8 tf = h8_lo4(*(const U2*)(rb + RS_T + (l15 * 16 + 4 * kg) * 2)), nq2f = h8_lo4(*(const U2*)(rb + RS_NQ2 + (l15 * 16 + 4 * kg) * 2));
            A4 X = mfma16(kkd0, Hb0, a4_zero()); X = mfma16(kkd1, Hb1, X); X = mfma16(p0f, Vb, X);
            A4 Y = mfma16(rd0, Hb0, a4_zero()); Y = mfma16(rd1, Hb1, Y); Y = mfma16(q1f, Vb, Y);
            const H8 Xb = h8_pack1(X);
            const A4 U_ = mfma16(tf, Xb, a4_zero());
            const H8 Ub = h8_pack1(U_);
            Y = mfma16(nq2f, Ub, Y);
            #define HUPD(Hx, kt) do { const int kr = 16 * (kt) + l15; \
                const H8 kif = kg < 2 ? h8_from(ld16(rb + RS_KIT + (kr * 16 + 8 * kg) * 2)) : h8_zero(); const H8 nbf = h8_lo4(*(const U2*)(rb + RS_NBIT + (kr * 16 + 4 * kg) * 2)); \
                Hx = mfma16(kif, Vb, Hx); Hx = mfma16(nbf, Ub, Hx); const F4 g = *(const F4*)(rb + RS_GC + (16 * (kt) + 4 * kg) * 4); \
                A4_GET(Hx, 0) *= g.x; A4_GET(Hx, 1) *= g.y; A4_GET(Hx, 2) *= g.z; A4_GET(Hx, 3) *= g.w; } while (0)
            HUPD(H0_, 0); HUPD(H1_, 1); HUPD(H2_, 2); HUPD(H3_, 3);
            #undef HUPD
            LDS_FENCE(); WAVE_SYNC();
            if (lane == 0) { if (vt == 0) fl_done0[slot] = (unsigned)(ch + 1); else fl_done1[slot] = (unsigned)(ch + 1); }
            { RC_GEOM(ch, seg0, segn, R0)
              if (!isctx_ || ctx_out) { UNR for (int rg = 0; rg < 4; ++rg) { const int t = 4 * kg + rg, tl = d == 0 ? R0 + t : R0 + RC_T - 1 - t;
                  Yd[(size_t)(seg0 + tl) * 512 + 64 * h + 32 * vh + 16 * vt + l15] = (bf16_t)f2bf(A4_GET(Y, rg)); } } }
        }
    } else {
        const int p = wave - 2, k = lane;
        unsigned char* wsb = lds + RC_LDS_WAVE + p * RW_BYTES;
        bf16_t* sTDAD = (bf16_t*)(wsb + RW_TDAD); float* sWL = (float*)(wsb + RW_WL); float* sAL = (float*)(wsb + RW_AL); bf16_t* sKIP = (bf16_t*)(wsb + RW_KIP); bf16_t* sBIP = (bf16_t*)(wsb + RW_BIP); float* sAM = (float*)(wsb + RW_AM);
        const bf16_t* U = (const bf16_t*)(C.ws + WS_U);
        const float* mu = C.in[I_MU] + (size_t)i * 1664;
        const float mu_r = mu[64 * h + k], mu_k = mu[512 + 64 * h + k], mu_v = mu[1024 + 64 * h + k], mu_l = k < 32 ? mu[1536 + 32 * d + k] : mu[1600 + 32 * d + (k - 32)];
        const float c_w0 = C.in[I_W0][((size_t)i * 2 + d) * 512 + 64 * h + k], c_a0 = C.in[I_A0][((size_t)i * 2 + d) * 512 + 64 * h + k];
        const float c_kk = C.in[I_KK][(size_t)i * 512 + 64 * h + k], c_ka = C.in[I_KA][(size_t)i * 512 + 64 * h + k], c_rk = C.in[I_RK][(size_t)i * 512 + 64 * h + k];
        float* BON = (float*)(C.ws + WS_BONUS) + (size_t)d * NTOK * 8;
        const U4* sBF = (const U4*)(lds + RC_LDS_BFR);
        const int lcol = k < 32 ? 1536 + 32 * d + k : 1600 + 32 * d + (k - 32);
        const int kg = lane >> 4, l15 = lane & 15, pk_ = rc_pos(k);
        for (int ch = p; ch < nchunks; ch += RC_NPROD) {
            RC_GEOM(ch, seg0, segn, R0)
            float ur[18], uk[18], uv[18], ul[18];
            UNR for (int j = 0; j < 18; ++j) { const int row = d == 0 ? R0 - 1 + j : R0 + 16 - j; const bool ok = row >= 0 && row < segn; const bf16_t* up = U + (size_t)(seg0 + (ok ? row : R0)) * URW_W;
                const float m_ = ok ? 1.f : 0.f; ur[j] = m_ * bf2f(up[64 * h + k]); uk[j] = m_ * bf2f(up[512 + 64 * h + k]); uv[j] = m_ * bf2f(up[1024 + 64 * h + k]); ul[j] = m_ * bf2f(up[lcol]); }
            UNR for (int t = 0; t < 16; ++t) { const int j = t + 1; const float x = ul[j] + (0.5f * (ul[j - 1] + ul[j + 1]) - ul[j]) * mu_l;
                const float val = k < 32 ? 1.0f - 2.0f * FRCP(1.0f + FEXP(2.0f * x)) : x; sTDAD[t * 64 + k] = (bf16_t)f2bf(val); }
            WAVE_SYNC();
            {
                const H8 At = h8_from(ld16(sTDAD + l15 * 64 + 8 * kg)), Aa = h8_from(ld16(sTDAD + l15 * 64 + 32 + 8 * kg));
                A4 cw_[4], ca_[4];
                UNR for (int nt = 0; nt < 4; ++nt) { cw_[nt] = mfma16(At, h8_from(sBF[nt * 64 + lane]), a4_zero()); ca_[nt] = mfma16(Aa, h8_from(sBF[(4 + nt) * 64 + lane]), a4_zero()); }
                MFMA_PAD(cw_[0], cw_[1], cw_[2], cw_[3], ca_[0], ca_[1], ca_[2], ca_[3]);
                UNR for (int nt = 0; nt < 4; ++nt) UNR for (int rg = 0; rg < 4; ++rg) { sWL[(4 * kg + rg) * 64 + 16 * nt + l15] = A4_GET(cw_[nt], rg); sAL[(4 * kg + rg) * 64 + 16 * nt + l15] = A4_GET(ca_[nt], rg); }
            }
            WAVE_SYNC();
            float fr[16], fkd[16], fb[16], fkk[16], flw[16], fv[16];
            UNR for (int t = 0; t < 16; ++t) { const int j = t + 1;
                const float r_ = ur[j] + (0.5f * (ur[j - 1] + ur[j + 1]) - ur[j]) * mu_r, k_ = uk[j] + (0.5f * (uk[j - 1] + uk[j + 1]) - uk[j]) * mu_k, v_ = uv[j] + (0.5f * (uv[j - 1] + uv[j + 1]) - uv[j]) * mu_v;
                const float kkraw = k_ * c_kk; const float ss = wave_sum_fast(kkraw * kkraw); const float kk_ = kkraw * FRSQ(ss + 1e-12f);
                const float x = -(c_w0 + sWL[t * 64 + k]); const float sp_ = fmaxf(x, 0.f) + FLOG(1.0f + FEXP(-fabsf(x)));
                const float lw_ = -FEXP(-sp_ - 0.5f);
                const float a = FRCP(1.0f + FEXP(-(c_a0 + sAL[t * 64 + k])));
                const float kd_ = k_ * (1.0f + (a - 1.0f) * c_ka);
                fr[t] = r_; fkd[t] = kd_; fb[t] = kk_ * a; fkk[t] = kk_; flw[t] = lw_; fv[t] = v_;
                const float bon = wave_sum_fast(r_ * kd_ * c_rk);
                if (vh == 0 && lane == 0) { const int tl = d == 0 ? R0 + t : R0 + RC_T - 1 - t; BON[(size_t)(seg0 + tl) * 8 + h] = 0.5f * bon; }
            }
            WAVE_SYNC();
            const int slot = ch % RC_RING; unsigned char* rb = lds + RC_LDS_RING + slot * RS_BYTES;
            if (ch >= RC_RING) SPIN_WAIT(fl_done0[slot] == (unsigned)(ch - RC_RING + 1) && fl_done1[slot] == (unsigned)(ch - RC_RING + 1));
            {
                bf16_t* rKKD = (bf16_t*)(rb + RS_KKD); bf16_t* rRD = (bf16_t*)(rb + RS_RD); bf16_t* rKIT = (bf16_t*)(rb + RS_KIT); bf16_t* rNBIT = (bf16_t*)(rb + RS_NBIT); bf16_t* rVT = (bf16_t*)(rb + RS_VT);
                float L = 0.f, e_prev = 1.f;
                UNR for (int t = 0; t < 16; ++t) { L += flw[t]; const float e = FEXP(L), ei = FEXP(-L);
                    rKKD[t * 64 + pk_] = (bf16_t)f2bf(fkk[t] * e_prev); rRD[t * 64 + pk_] = (bf16_t)f2bf(fr[t] * e);
                    const float ki_ = fkd[t] * ei, bi_ = fb[t] * ei; sKIP[t * 64 + pk_] = (bf16_t)f2bf(ki_); sBIP[t * 64 + pk_] = (bf16_t)f2bf(bi_);
                    rKIT[k * 16 + t] = (bf16_t)f2bf(ki_); rNBIT[k * 16 + t] = (bf16_t)f2bf(-bi_);
                    e_prev = e; }
                ((float*)(rb + RS_GC))[k] = e_prev;
                U4 w0_, w1_;
                if ((k >> 5) == vh) { w0_.x = pk2(fv[0], fv[1]); w0_.y = pk2(fv[2], fv[3]); w0_.z = pk2(fv[4], fv[5]); w0_.w = pk2(fv[6], fv[7]); w1_.x = pk2(fv[8], fv[9]); w1_.y = pk2(fv[10], fv[11]); w1_.z = pk2(fv[12], fv[13]); w1_.w = pk2(fv[14], fv[15]);
                    st16(rVT + (k & 31) * 16, w0_); st16(rVT + (k & 31) * 16 + 8, w1_); }
            }
            WAVE_SYNC();
            {
                const bf16_t* rKKD = (const bf16_t*)(rb + RS_KKD); const bf16_t* rRD = (const bf16_t*)(rb + RS_RD);
                const H8 ak0 = h8_from(ld16(rKKD + l15 * 64 + 8 * kg)), ak1 = h8_from(ld16(rKKD + l15 * 64 + 32 + 8 * kg)), ar0 = h8_from(ld16(rRD + l15 * 64 + 8 * kg)), ar1 = h8_from(ld16(rRD + l15 * 64 + 32 + 8 * kg));
                const H8 bb0 = h8_from(ld16(sBIP + l15 * 64 + 8 * kg)), bb1 = h8_from(ld16(sBIP + l15 * 64 + 32 + 8 * kg)), bk0 = h8_from(ld16(sKIP + l15 * 64 + 8 * kg)), bk1 = h8_from(ld16(sKIP + l15 * 64 + 32 + 8 * kg));
                A4 mA = mfma16(ak0, bb0, a4_zero()); mA = mfma16(ak1, bb1, mA);
                A4 mP = mfma16(ak0, bk0, a4_zero()); mP = mfma16(ak1, bk1, mP);
                A4 mQ1 = mfma16(ar0, bk0, a4_zero()); mQ1 = mfma16(ar1, bk1, mQ1);
                A4 mQ2 = mfma16(ar0, bb0, a4_zero()); mQ2 = mfma16(ar1, bb1, mQ2);
                MFMA_PAD(mA, mP, mQ1, mQ2, mA, mP, mQ1, mQ2);
                bf16_t* rP0 = (bf16_t*)(rb + RS_P0); bf16_t* rQ1 = (bf16_t*)(rb + RS_Q1); bf16_t* rNQ2 = (bf16_t*)(rb + RS_NQ2);
                UNR for (int rg = 0; rg < 4; ++rg) { const int t = 4 * kg + rg, s_ = l15;
                    sAM[t * 16 + s_] = t > s_ ? A4_GET(mA, rg) : 0.f;
                    rP0[t * 16 + s_] = (bf16_t)f2bf(t > s_ ? A4_GET(mP, rg) : 0.f); rQ1[t * 16 + s_] = (bf16_t)f2bf(t >= s_ ? A4_GET(mQ1, rg) : 0.f); rNQ2[t * 16 + s_] = (bf16_t)f2bf(t >= s_ ? -A4_GET(mQ2, rg) : 0.f); }
            }
            WAVE_SYNC();
            {
                const int j = l15; float x[16]; bf16_t* rT = (bf16_t*)(rb + RS_T);
                UNR for (int t = 0; t < 16; ++t) { float acc = t == j ? 1.f : 0.f;
                    UNR for (int s_ = 0; s_ < 16; ++s_) if (s_ < t) acc -= sAM[t * 16 + s_] * x[s_];
                    x[t] = acc; if (lane < 16) rT[t * 16 + j] = (bf16_t)f2bf(acc); }
            }
            LDS_FENCE();
            WAVE_SYNC();
            if (lane == 0) fl_ready[slot] = (unsigned)(ch + 1);
        }
    }
    #undef RC_GEOM
    SYNC();
}
constexpr int FR_SLOTS = 20, FR_FLOATS = 6 * 2048, FR_LEAD = 20;
constexpr size_t WS_FRING = WS_HYOUT;
static_assert((size_t)16 * FR_SLOTS * FR_FLOATS * 4 <= (size_t)NLAT * 512 * 2, "feature ring fits");
constexpr size_t CTL_FFLAG = 65536, CTL_FPOS = CTL_FFLAG + 16 * 520 * 4 * 4;
constexpr int SC2_R = 8, SC2_NWG = 8;
static_assert(CTL_FPOS + 64 * 64 <= CTL_ZERO_BYTES, "control words");
#ifdef EMU
DEVFN unsigned gld_u32(const unsigned* p) { __sync_synchronize(); return *(volatile const unsigned*)p; }
DEVFN void gst_u32(unsigned* p, unsigned v) { __sync_synchronize(); *(volatile unsigned*)p = v; __sync_synchronize(); }
DEVFN unsigned long long gld_u64(const unsigned long long* p) { return *(volatile const unsigned long long*)p; }
DEVFN void gst_u64(unsigned long long* p, unsigned long long v) { *(volatile unsigned long long*)p = v; }
#define VM_DRAIN() __sync_synchronize()
#define GSPIN_WAIT(cond) do { while (!(cond)) sched_yield(); __sync_synchronize(); } while (0)
#else
DEVFN unsigned gld_u32(const unsigned* p) { return __hip_atomic_load(p, __ATOMIC_RELAXED, __HIP_MEMORY_SCOPE_AGENT); }
DEVFN void gst_u32(unsigned* p, unsigned v) { __hip_atomic_store(p, v, __ATOMIC_RELAXED, __HIP_MEMORY_SCOPE_AGENT); }
DEVFN unsigned long long gld_u64(const unsigned long long* p) { return __hip_atomic_load(p, __ATOMIC_RELAXED, __HIP_MEMORY_SCOPE_AGENT); }
DEVFN void gst_u64(unsigned long long* p, unsigned long long v) { __hip_atomic_store(p, v, __ATOMIC_RELAXED, __HIP_MEMORY_SCOPE_AGENT); }
#define VM_DRAIN() asm volatile("s_waitcnt vmcnt(0)" ::: "memory")
#define GSPIN_WAIT(cond) do { unsigned sp__ = 0; while (!(cond)) { __builtin_amdgcn_s_sleep(2); if (++sp__ > (1u << 22)) break; } asm volatile("" ::: "memory"); } while (0)
#endif
DEVFN unsigned long long f2_bits(float a, float b) { union { float f[2]; unsigned long long u; } x; x.f[0] = a; x.f[1] = b; return x.u; }

DEVFN void rwkv_scan2(const Ctx& C, int i, int h, int d, int rq, bool ctx_out, unsigned char* lds, int max_chunks) {
    const int tid = C.tid, lane = tid & 63, wave = C.wave;
    float* sBUF = (float*)lds;
    float* sWV = sBUF + 3 * SC_BUF;
    float* sCN = sWV + 4 * 1280;
    U4* sBF = (U4*)(sCN + 640);
    volatile unsigned* lf = (volatile unsigned*)((unsigned char*)sBF + 8192);
    const int hd = h * 2 + d;
    const unsigned epoch = (unsigned)(i + 1), pbase = (unsigned)i * 100000u;
    {
    const float* mu = C.in[I_MU] + (size_t)i * 1664;
    const float* w0 = C.in[I_W0] + ((size_t)i * 2 + d) * 512 + 64 * h; const float* a0 = C.in[I_A0] + ((size_t)i * 2 + d) * 512 + 64 * h;
    const float* wup = C.in[I_WUP] + ((size_t)i * 2 + d) * 32 * 512 + 64 * h; const float* aup = C.in[I_AUP] + ((size_t)i * 2 + d) * 32 * 512 + 64 * h;
    const float* k_k = C.in[I_KK] + (size_t)i * 512 + 64 * h; const float* k_a = C.in[I_KA] + (size_t)i * 512 + 64 * h; const float* r_k = C.in[I_RK] + (size_t)i * 512 + 64 * h;
    if (tid < 64) { const int j = tid; sCN[j] = mu[64 * h + j]; sCN[64 + j] = mu[512 + 64 * h + j]; sCN[128 + j] = mu[1024 + 64 * h + j]; sCN[192 + j] = w0[j]; sCN[256 + j] = a0[j];
        sCN[320 + j] = k_k[j]; sCN[384 + j] = k_a[j]; sCN[448 + j] = r_k[j]; sCN[512 + j] = j < 32 ? mu[1536 + 32 * d + j] : mu[1600 + 32 * d + (j - 32)]; }
    { const int m = tid >> 8, nt = (tid >> 6) & 3, ln = tid & 63; const float* src = m == 0 ? wup : aup; float f[8];
      UNR for (int j = 0; j < 8; ++j) f[j] = src[(size_t)(8 * (ln >> 4) + j) * 512 + 16 * nt + (ln & 15)];
      sBF[tid] = pack8(f); }
    }
    if (tid < 32) lf[tid] = 0u;
    SYNC();
    const int nchunks = NTOK / SC_T < max_chunks ? NTOK / SC_T : max_chunks;
    #define CHUNK_GEOM(ch, seg0, segn, R0) const bool isctx_ = (ch) < NCTX / SC_T; const int seg0 = isctx_ ? NLAT : 0, segn = isctx_ ? NCTX : NLAT; \
        const int cl_ = isctx_ ? (ch) : (ch) - NCTX / SC_T; const int R0 = d == 0 ? SC_T * cl_ : segn - SC_T * (cl_ + 1);
    if (wave < 2) {
        bf16_t* Yd = (bf16_t*)(C.ws + (d == 0 ? WS_YF : WS_YB));
        const int rl = tid >> 4, sp = tid & 15;
        float S0 = 0.f, S1 = 0.f, S2 = 0.f, S3 = 0.f;
        for (int ch = 0; ch < nchunks; ++ch) {
            const int b = ch % 3;
            SPIN_WAIT(lf[0 * 3 + b] == (unsigned)(ch + 1) && lf[1 * 3 + b] == (unsigned)(ch + 1));
            const float* B_ = sBUF + b * SC_BUF; const float* sV = B_ + 5 * SC_T * 64;
            float yk0 = 0.f, yk1 = 0.f, yp = 0.f;
#ifndef EMU
            {
                const unsigned ab = (unsigned)(uintptr_t)B_ + 16u * (unsigned)sp, av = (unsigned)(uintptr_t)sV + 4u * (unsigned)rl;
                P2 s01 = {S0, S1}, s23 = {S2, S3};
                asm volatile(SCAN_CHUNK_ASM : [s01] "+v"(s01), [s23] "+v"(s23), [yp] "+v"(yp), [yk0] "+v"(yk0), [yk1] "+v"(yk1) : [ab] "v"(ab), [av] "v"(av), [sp] "v"(sp) : SCAN_CHUNK_CLOBBERS);
                S0 = s01[0]; S1 = s01[1]; S2 = s23[0]; S3 = s23[1];
            }
#else
            { const float* sW = B_; const float* sKD = B_ + SC_T * 64; const float* sB = B_ + 2 * SC_T * 64; const float* sKK = B_ + 3 * SC_T * 64; const float* sR = B_ + 4 * SC_T * 64;
              for (int k = 0; k < SC_T; ++k) {
                const F4 kk4 = *(const F4*)(sKK + k * 64 + 4 * sp), w4 = *(const F4*)(sW + k * 64 + 4 * sp), b4 = *(const F4*)(sB + k * 64 + 4 * sp),
                         kd4 = *(const F4*)(sKD + k * 64 + 4 * sp), r4 = *(const F4*)(sR + k * 64 + 4 * sp);
                const float vi = sV[k * SC_R + rl];
                float sa = (S0 * kk4.x + S2 * kk4.z) + (S1 * kk4.y + S3 * kk4.w);
                const float t0 = S0 * w4.x + vi * kd4.x, t1 = S1 * w4.y + vi * kd4.y, t2 = S2 * w4.z + vi * kd4.z, t3 = S3 * w4.w + vi * kd4.w;
                sa = rowx_add<1>(sa); yp = rowx_add<1>(yp); sa = rowx_add<2>(sa); yp = rowx_add<2>(yp);
                sa = rowx_add<7>(sa); yp = rowx_add<7>(yp); sa = rowx_add<15>(sa); yp = rowx_add<15>(yp);
                if (sp == ((k + 15) & 15)) { if (k <= 16) yk0 = yp; else yk1 = yp; }
                S0 = t0 - sa * b4.x; S1 = t1 - sa * b4.y; S2 = t2 - sa * b4.z; S3 = t3 - sa * b4.w;
                yp = (S0 * r4.x + S2 * r4.z) + (S1 * r4.y + S3 * r4.w);
              } }
#endif
            LDS_FENCE(); WAVE_SYNC();
            if (lane == 0) lf[8 + wave * 3 + b] = (unsigned)(ch + 1);
            yp = rowx_add<1>(yp); yp = rowx_add<2>(yp); yp = rowx_add<7>(yp); yp = rowx_add<15>(yp);
            if (sp == 15) yk1 = yp;
            { CHUNK_GEOM(ch, seg0, segn, R0)
              if (!isctx_ || ctx_out) { const int t0 = d == 0 ? R0 + sp : R0 + SC_T - 1 - sp, t1 = d == 0 ? R0 + sp + 16 : R0 + SC_T - 1 - (sp + 16);
                  Yd[(size_t)(seg0 + t0) * 512 + 64 * h + SC2_R * rq + rl] = (bf16_t)f2bf(yk0); Yd[(size_t)(seg0 + t1) * 512 + 64 * h + SC2_R * rq + rl] = (bf16_t)f2bf(yk1); } }
        }
    } else if (wave < 6) {
        const int p = wave - 2;
        const bf16_t* U = (const bf16_t*)(C.ws + WS_U); float* BON = (float*)(C.ws + WS_BONUS) + (size_t)d * NTOK * 8;
        float* RING = (float*)(C.ws + WS_FRING) + (size_t)hd * FR_SLOTS * FR_FLOATS; unsigned* FFLAG = (unsigned*)(C.ws + WS_CTL + CTL_FFLAG) + (size_t)hd * 520 * 4; unsigned* FPOS = (unsigned*)(C.ws + WS_CTL + CTL_FPOS) + (size_t)hd * 64;
        float* myWV = sWV + p * 1280; float* sWL = myWV; float* sAL = myWV + 512; bf16_t* sTDb = (bf16_t*)(myWV + 1024); bf16_t* sADb = sTDb + 256;
        const int fp = lane & 7, tw = lane >> 3;
        const float* mu_r = sCN + 8 * fp; const float* mu_k = sCN + 64 + 8 * fp; const float* mu_v = sCN + 128 + 8 * fp; const float* c_w0 = sCN + 192 + 8 * fp; const float* c_a0 = sCN + 256 + 8 * fp;
        const float* c_kk = sCN + 320 + 8 * fp; const float* c_ka = sCN + 384 + 8 * fp; const float* c_rk = sCN + 448 + 8 * fp; const float* mu_w = sCN + 512 + 4 * fp; const float* mu_a = sCN + 544 + 4 * fp;
        U4 pu[9]; U2 pw[6];
        auto issue = [&](int q) {
            const int ch = rq + SC2_NWG * q; if (ch >= nchunks) return;
            CHUNK_GEOM(ch, seg0, segn, R0)
            const int ft = 8 * p + tw, tl = d == 0 ? R0 + ft : R0 + SC_T - 1 - ft;
            const bf16_t* u0p = U + (size_t)(seg0 + tl) * URW_W; const bool hm = tl > 0, hp = tl < segn - 1;
            const U4 z4 = {0u, 0u, 0u, 0u}; const U2 z2 = {0u, 0u};
            const int cw = 1536 + 32 * d + 4 * fp, ca = 1600 + 32 * d + 4 * fp;
            UNR for (int j = 0; j < 3; ++j) { pu[3 * j] = ld16(u0p + 512 * j + 64 * h + 8 * fp); pu[3 * j + 1] = z4; pu[3 * j + 2] = z4; }
            pw[0] = *(const U2*)(u0p + cw); pw[3] = *(const U2*)(u0p + ca); pw[1] = z2; pw[2] = z2; pw[4] = z2; pw[5] = z2;
            if (hm) { UNR for (int j = 0; j < 3; ++j) pu[3 * j + 1] = ld16(u0p - URW_W + 512 * j + 64 * h + 8 * fp); pw[1] = *(const U2*)(u0p - URW_W + cw); pw[4] = *(const U2*)(u0p - URW_W + ca); }
            if (hp) { UNR for (int j = 0; j < 3; ++j) pu[3 * j + 2] = ld16(u0p + URW_W + 512 * j + 64 * h + 8 * fp); pw[2] = *(const U2*)(u0p + URW_W + cw); pw[5] = *(const U2*)(u0p + URW_W + ca); }
        };
        issue(0);
        const int npass = (nchunks - rq + SC2_NWG - 1) / SC2_NWG;
        for (int q = 0; q < npass; ++q) {
            const int ch = rq + SC2_NWG * q;
            if (ch >= FR_SLOTS) { const unsigned need = pbase + (unsigned)(ch - FR_SLOTS + 1);
                GSPIN_WAIT(gld_u32(FPOS + 0) >= need && gld_u32(FPOS + 8) >= need && gld_u32(FPOS + 16) >= need && gld_u32(FPOS + 24) >= need && gld_u32(FPOS + 32) >= need && gld_u32(FPOS + 40) >= need && gld_u32(FPOS + 48) >= need && gld_u32(FPOS + 56) >= need); }
            CHUNK_GEOM(ch, seg0, segn, R0)
            float* rec = RING + (size_t)(ch % FR_SLOTS) * FR_FLOATS;
            {
                const int ft = 8 * p + tw;
                const int tl = d == 0 ? R0 + ft : R0 + SC_T - 1 - ft;
                float r[8], k[8], v[8];
                {
                    float a[8], m[8], qq[8];
                    #define SHIFT3(J, MU, OUT) do { unpack8(pu[3 * (J)], a); unpack8(pu[3 * (J) + 1], m); unpack8(pu[3 * (J) + 2], qq); \
                        UNR for (int e = 0; e < 8; ++e) OUT[e] = a[e] + (0.5f * (m[e] + qq[e]) - a[e]) * MU[e]; } while (0)
                    SHIFT3(0, mu_r, r); SHIFT3(1, mu_k, k); SHIFT3(2, mu_v, v);
                    #undef SHIFT3
                }
                {
                    const U2 w0_ = pw[0], wm = pw[1], wp = pw[2], a0_ = pw[3], am = pw[4], ap = pw[5];
                    const float wa[4] = {bflo(w0_.x), bfhi(w0_.x), bflo(w0_.y), bfhi(w0_.y)}, wmm[4] = {bflo(wm.x), bfhi(wm.x), bflo(wm.y), bfhi(wm.y)}, wpp[4] = {bflo(wp.x), bfhi(wp.x), bflo(wp.y), bfhi(wp.y)};
                    const float aa[4] = {bflo(a0_.x), bfhi(a0_.x), bflo(a0_.y), bfhi(a0_.y)}, amm[4] = {bflo(am.x), bfhi(am.x), bflo(am.y), bfhi(am.y)}, app[4] = {bflo(ap.x), bfhi(ap.x), bflo(ap.y), bfhi(ap.y)};
                    issue(q + 1);
                    float tdv[4], adv[4];
                    UNR for (int e = 0; e < 4; ++e) { const float x = wa[e] + (0.5f * (wmm[e] + wpp[e]) - wa[e]) * mu_w[e];
                        tdv[e] = 1.0f - 2.0f * FRCP(1.0f + FEXP(2.0f * x));
                        adv[e] = aa[e] + (0.5f * (amm[e] + app[e]) - aa[e]) * mu_a[e]; }
                    U2 tq, aq; tq.x = pk2(tdv[0], tdv[1]); tq.y = pk2(tdv[2], tdv[3]); aq.x = pk2(adv[0], adv[1]); aq.y = pk2(adv[2], adv[3]);
                    *(U2*)(sTDb + tw * 32 + 4 * fp) = tq; *(U2*)(sADb + tw * 32 + 4 * fp) = aq;
                }
                WAVE_SYNC();
                float wl[8], al[8];
                {
                    const int arow = lane & 7, kg = lane >> 4;
                    const H8 At = h8_from_u4(ld16(sTDb + arow * 32 + 8 * kg)), Aa = h8_from_u4(ld16(sADb + arow * 32 + 8 * kg));
                    A4 cw_[4], ca_[4];
                    UNR for (int nt = 0; nt < 4; ++nt) { A4 z; A4_GET(z, 0) = 0.f; A4_GET(z, 1) = 0.f; A4_GET(z, 2) = 0.f; A4_GET(z, 3) = 0.f;
                        cw_[nt] = mfma16(At, h8_from_u4(sBF[nt * 64 + lane]), z); ca_[nt] = mfma16(Aa, h8_from_u4(sBF[(4 + nt) * 64 + lane]), z); }
                    MFMA_PAD(cw_[0], cw_[1], cw_[2], cw_[3], ca_[0], ca_[1], ca_[2], ca_[3]);
                    if (lane < 32) { UNR for (int nt = 0; nt < 4; ++nt) UNR for (int rg = 0; rg < 4; ++rg) { const int tok = 4 * (lane >> 4) + rg; sWL[tok * 64 + 16 * nt + (lane & 15)] = A4_GET(cw_[nt], rg); sAL[tok * 64 + 16 * nt + (lane & 15)] = A4_GET(ca_[nt], rg); } }
                    WAVE_SYNC();
                    UNR for (int e = 0; e < 8; ++e) { wl[e] = c_w0[e] + sWL[tw * 64 + 8 * fp + e]; al[e] = c_a0[e] + sAL[tw * 64 + 8 * fp + e]; }
                    WAVE_SYNC();
                }
                float kkv[8], ssq = 0.f;
                UNR for (int e = 0; e < 8; ++e) { kkv[e] = k[e] * c_kk[e]; ssq += kkv[e] * kkv[e]; }
                ssq = rowx_add<1>(ssq); ssq = rowx_add<2>(ssq); ssq = rowx_add<7>(ssq);
                const float kn = FRSQ(ssq + 1e-12f);
                float bon = 0.f; float o_w[8], o_kd[8], o_b[8], o_kk[8];
                UNR for (int e = 0; e < 8; ++e) {
                    const float dec = FEXP(-0.60653066f * FRCP(1.0f + FEXP(-wl[e])));
                    const float a = FRCP(1.0f + FEXP(-al[e]));
                    const float kd = k[e] * (1.0f + (a - 1.0f) * c_ka[e]);
                    const float kk = kkv[e] * kn;
                    o_w[e] = dec; o_kd[e] = kd; o_b[e] = kk * a; o_kk[e] = kk;
                    bon += r[e] * kd * c_rk[e];
                }
                { unsigned long long* rp = (unsigned long long*)(rec + ft * 64 + 8 * fp);
                  #define ST8(AR, A) do { UNR for (int e2 = 0; e2 < 4; ++e2) gst_u64(rp + (AR) * 1024 + e2, f2_bits(A[2 * e2], A[2 * e2 + 1])); } while (0)
                  ST8(0, o_w); ST8(1, o_kd); ST8(2, o_b); ST8(3, o_kk); ST8(4, r); ST8(5, v);
                  #undef ST8
                }
                bon = rowx_add<1>(bon); bon = rowx_add<2>(bon); bon = rowx_add<7>(bon);
                if (fp == 0) BON[(size_t)(seg0 + tl) * 8 + h] = 0.5f * bon;
            }
            VM_DRAIN(); if (lane == 0) gst_u32(FFLAG + (size_t)ch * 4 + p, epoch);
        }
    } else {
        const int w = wave - 6;
        const float* RING = (const float*)(C.ws + WS_FRING) + (size_t)hd * FR_SLOTS * FR_FLOATS; unsigned* FFLAG = (unsigned*)(C.ws + WS_CTL + CTL_FFLAG) + (size_t)hd * 520 * 4; unsigned* FPOS = (unsigned*)(C.ws + WS_CTL + CTL_FPOS) + (size_t)hd * 64;
        for (int ch = 0; ch < nchunks; ++ch) {
            const int b = ch % 3;
            if (ch >= 3) SPIN_WAIT(lf[8 + 0 * 3 + b] == (unsigned)(ch - 2) && lf[8 + 1 * 3 + b] == (unsigned)(ch - 2));
            GSPIN_WAIT(gld_u32(FFLAG + (size_t)ch * 4) == epoch && gld_u32(FFLAG + (size_t)ch * 4 + 1) == epoch && gld_u32(FFLAG + (size_t)ch * 4 + 2) == epoch && gld_u32(FFLAG + (size_t)ch * 4 + 3) == epoch);
            const unsigned long long* rec = (const unsigned long long*)(RING + (size_t)(ch % FR_SLOTS) * FR_FLOATS);
            float* B_ = sBUF + b * SC_BUF;
            { unsigned long long x[40], xv[2];
              UNR for (int j = 0; j < 40; ++j) x[j] = gld_u64(rec + (size_t)w * 2560 + j * 64 + lane);
              { const int idx = w * 64 + lane, tok = idx >> 2, c2 = idx & 3; xv[0] = gld_u64(rec + 5 * 1024 + tok * 32 + 4 * rq + c2); xv[1] = 0ull; }
              UNR for (int j = 0; j < 40; ++j) ((unsigned long long*)B_)[(size_t)w * 2560 + j * 64 + lane] = x[j];
              { const int idx = w * 64 + lane, tok = idx >> 2, c2 = idx & 3; ((unsigned long long*)(B_ + 5 * SC_T * 64))[tok * 8 + c2] = xv[0]; } }
            LDS_FENCE(); WAVE_SYNC();
            if (lane == 0) { lf[w * 3 + b] = (unsigned)(ch + 1); if (w == 0) gst_u32(FPOS + 8 * rq, pbase + (unsigned)(ch + 1)); }
        }
    }
    #undef CHUNK_GEOM
    SYNC();
}
constexpr int R2S_KKD = 0, R2S_RD = 2048, R2S_KIT = 4096, R2S_NBIT = 6144, R2S_VT = 8192, R2S_T = 10240, R2S_P0 = 10752, R2S_Q1 = 11264, R2S_NQ2 = 11776, R2S_GC = 12288, R2S_BYTES = 12544, R2S_U64 = R2S_BYTES / 8;
constexpr int PW_TDAD = 0, PW_AM = 0, PW_WL = 2048, PW_AL = 6144, PW_REC = 2048, PW_KIP = PW_REC + R2S_BYTES, PW_BIP = PW_KIP + 2048, PW_BYTES = PW_BIP + 2048;
static_assert(8 * PW_BYTES <= RING_BYTES, "producer LDS");
constexpr int R2_GSLOTS = 64, R2_LSLOTS = 12, R2_NCH = NTOK / RC_T;
constexpr size_t WS_R2RING = WS_HYOUT;
static_assert((size_t)16 * R2_GSLOTS * R2S_BYTES <= (size_t)NLAT * 512 * 2, "record ring fits");
constexpr size_t CTL_R2FLAG = 65536, CTL_R2POS = CTL_R2FLAG + (size_t)16 * R2_NCH * 4;
static_assert(CTL_R2POS + 16 * 64 <= CTL_ZERO_BYTES, "control words");
constexpr size_t WS_BFRAG = WS_VXC + 1536 * 1024;
static_assert(WS_BFRAG + 2 * 16 * 8 * 64 * 16 <= WS_HID, "bfrag");

DEVFN void r2_build_bfrag(const Ctx& C) {
    const int gtid = (C.vcu * NWAVES + C.wave) * 64 + C.lane, gn = C.G * NTHREADS;
    for (int e = gtid; e < 2 * 16 * 8 * 64; e += gn) { const int ln = e & 63, nt = (e >> 6) & 3, m = (e >> 8) & 1, hd = (e >> 9) & 15, i = e >> 13; const int h = hd >> 1, d = hd & 1;
        const float* src = (m == 0 ? C.in[I_WUP] : C.in[I_AUP]) + ((size_t)i * 2 + d) * 32 * 512 + 64 * h; float f[8];
        UNR for (int j = 0; j < 8; ++j) f[j] = src[(size_t)(8 * (ln >> 4) + j) * 512 + 16 * nt + (ln & 15)];
        ((U4*)(C.ws + WS_BFRAG))[e] = pack8(f); }
}

DEVFN void rc2_producer(const Ctx& C, int i, unsigned char* lds, int pw, int npw, int hd0, int nhd, int max_chunks) {
    const int lane = C.lane, k = lane, kg = lane >> 4, l15 = lane & 15, pk_ = rc_pos(k);
    unsigned char* wsb = lds + C.wave * PW_BYTES;
    bf16_t* sTDAD = (bf16_t*)(wsb + PW_TDAD); float* sWL = (float*)(wsb + PW_WL); float* sAL = (float*)(wsb + PW_AL); bf16_t* sKIP = (bf16_t*)(wsb + PW_KIP); bf16_t* sBIP = (bf16_t*)(wsb + PW_BIP); float* sAM = (float*)(wsb + PW_AM);
    const bf16_t* U = (const bf16_t*)(C.ws + WS_U);
    const unsigned epoch = (unsigned)(i + 1), pbase = (unsigned)i * 100000u;
    const int nchunks = R2_NCH < max_chunks ? R2_NCH : max_chunks;
    const int nitems = nchunks * nhd;
    TACC_DECL;
    for (int item = pw; item < nitems; item += npw) {
        const int ch = item / nhd, hd = hd0 + item % nhd, h = hd >> 1, d = hd & 1;
        unsigned* POS = (unsigned*)(C.ws + WS_CTL + CTL_R2POS) + 16 * hd;
        if (ch >= R2_GSLOTS) { const int ow = ((ch - R2_GSLOTS) & 3); TACC_BEGIN; GSPIN_WAIT(gld_u32(POS + 1 + ow) >= pbase + (unsigned)(ch - R2_GSLOTS + 1)); TACC_END; }
        const float* mu = C.in[I_MU] + (size_t)i * 1664;
        const float mu_r = mu[64 * h + k], mu_k = mu[512 + 64 * h + k], mu_v = mu[1024 + 64 * h + k], mu_l = k < 32 ? mu[1536 + 32 * d + k] : mu[1600 + 32 * d + (k - 32)];
        const float c_w0 = C.in[I_W0][((size_t)i * 2 + d) * 512 + 64 * h + k], c_a0 = C.in[I_A0][((size_t)i * 2 + d) * 512 + 64 * h + k];
        const float c_kk = C.in[I_KK][(size_t)i * 512 + 64 * h + k], c_ka = C.in[I_KA][(size_t)i * 512 + 64 * h + k], c_rk = C.in[I_RK][(size_t)i * 512 + 64 * h + k];
        float* BON = (float*)(C.ws + WS_BONUS) + (size_t)d * NTOK * 8;
        const int lcol = k < 32 ? 1536 + 32 * d + k : 1600 + 32 * d + (k - 32);
        U4 bfw[4], bfa[4];
        { const U4* bt = (const U4*)(C.ws + WS_BFRAG) + ((size_t)i * 16 + hd) * 512; UNR for (int nt = 0; nt < 4; ++nt) { bfw[nt] = bt[nt * 64 + lane]; bfa[nt] = bt[(4 + nt) * 64 + lane]; } }
        const bool isctx_ = ch < NCTX / RC_T; const int seg0 = isctx_ ? NLAT : 0, segn = isctx_ ? NCTX : NLAT; const int cl_ = isctx_ ? ch : ch - NCTX / RC_T; const int R0 = d == 0 ? RC_T * cl_ : segn - RC_T * (cl_ + 1);
        {
            float ur[18], uk[18], uv[18], ul[18];
            UNR for (int j = 0; j < 18; ++j) { const int row = d == 0 ? R0 - 1 + j : R0 + 16 - j; const bool ok = row >= 0 && row < segn; const bf16_t* up = U + (size_t)(seg0 + (ok ? row : R0)) * URW_W;
                const float m_ = ok ? 1.f : 0.f; ur[j] = m_ * bf2f(up[64 * h + k]); uk[j] = m_ * bf2f(up[512 + 64 * h + k]); uv[j] = m_ * bf2f(up[1024 + 64 * h + k]); ul[j] = m_ * bf2f(up[lcol]); }
            UNR for (int t = 0; t < 16; ++t) { const int j = t + 1; const float x = ul[j] + (0.5f * (ul[j - 1] + ul[j + 1]) - ul[j]) * mu_l;
                const float val = k < 32 ? 1.0f - 2.0f * FRCP(1.0f + FEXP(2.0f * x)) : x; sTDAD[t * 64 + k] = (bf16_t)f2bf(val); }
            WAVE_SYNC();
            {
                const H8 At = h8_from(ld16(sTDAD + l15 * 64 + 8 * kg)), Aa = h8_from(ld16(sTDAD + l15 * 64 + 32 + 8 * kg));
                A4 cw_[4], ca_[4];
                UNR for (int nt = 0; nt < 4; ++nt) { cw_[nt] = mfma16(At, h8_from(bfw[nt]), a4_zero()); ca_[nt] = mfma16(Aa, h8_from(bfa[nt]), a4_zero()); }
                MFMA_PAD(cw_[0], cw_[1], cw_[2], cw_[3], ca_[0], ca_[1], ca_[2], ca_[3]);
                UNR for (int nt = 0; nt < 4; ++nt) UNR for (int rg = 0; rg < 4; ++rg) { sWL[(4 * kg + rg) * 64 + 16 * nt + l15] = A4_GET(cw_[nt], rg); sAL[(4 * kg + rg) * 64 + 16 * nt + l15] = A4_GET(ca_[nt], rg); }
            }
            WAVE_SYNC();
            float fr[16], fkd[16], fb[16], fkk[16], flw[16], fv[16];
            UNR for (int t = 0; t < 16; ++t) { const int j = t + 1;
                const float r_ = ur[j] + (0.5f * (ur[j - 1] + ur[j + 1]) - ur[j]) * mu_r, k_ = uk[j] + (0.5f * (uk[j - 1] + uk[j + 1]) - uk[j]) * mu_k, v_ = uv[j] + (0.5f * (uv[j - 1] + uv[j + 1]) - uv[j]) * mu_v;
                const float kkraw = k_ * c_kk; const float ss = wave_sum_fast(kkraw * kkraw); const float kk_ = kkraw * FRSQ(ss + 1e-12f);
                const float x = -(c_w0 + sWL[t * 64 + k]); const float sp_ = fmaxf(x, 0.f) + FLOG(1.0f + FEXP(-fabsf(x)));
                const float lw_ = -FEXP(-sp_ - 0.5f);
                const float a = FRCP(1.0f + FEXP(-(c_a0 + sAL[t * 64 + k])));
                const float kd_ = k_ * (1.0f + (a - 1.0f) * c_ka);
                fr[t] = r_; fkd[t] = kd_; fb[t] = kk_ * a; fkk[t] = kk_; flw[t] = lw_; fv[t] = v_;
                const float bon = wave_sum_fast(r_ * kd_ * c_rk);
                if (lane == 0) { const int tl = d == 0 ? R0 + t : R0 + RC_T - 1 - t; BON[(size_t)(seg0 + tl) * 8 + h] = 0.5f * bon; }
            }
            WAVE_SYNC();
            unsigned char* rb = wsb + PW_REC;
            {
                bf16_t* rKKD = (bf16_t*)(rb + R2S_KKD); bf16_t* rRD = (bf16_t*)(rb + R2S_RD); bf16_t* rKIT = (bf16_t*)(rb + R2S_KIT); bf16_t* rNBIT = (bf16_t*)(rb + R2S_NBIT); bf16_t* rVT = (bf16_t*)(rb + R2S_VT);
                float L = 0.f, e_prev = 1.f;
                UNR for (int t = 0; t < 16; ++t) { L += flw[t]; const float e = FEXP(L), ei = FEXP(-L);
                    rKKD[t * 64 + pk_] = (bf16_t)f2bf(fkk[t] * e_prev); rRD[t * 64 + pk_] = (bf16_t)f2bf(fr[t] * e);
                    const float ki_ = fkd[t] * ei, bi_ = fb[t] * ei; sKIP[t * 64 + pk_] = (bf16_t)f2bf(ki_); sBIP[t * 64 + pk_] = (bf16_t)f2bf(bi_);
                    rKIT[k * 16 + t] = (bf16_t)f2bf(ki_); rNBIT[k * 16 + t] = (bf16_t)f2bf(-bi_);
                    e_prev = e; }
                ((float*)(rb + R2S_GC))[k] = e_prev;
                U4 w0_, w1_;
                { w0_.x = pk2(fv[0], fv[1]); w0_.y = pk2(fv[2], fv[3]); w0_.z = pk2(fv[4], fv[5]); w0_.w = pk2(fv[6], fv[7]); w1_.x = pk2(fv[8], fv[9]); w1_.y = pk2(fv[10], fv[11]); w1_.z = pk2(fv[12], fv[13]); w1_.w = pk2(fv[14], fv[15]);
                    st16(rVT + k * 16, w0_); st16(rVT + k * 16 + 8, w1_); }
            }
            WAVE_SYNC();
            {
                const bf16_t* rKKD = (const bf16_t*)(rb + R2S_KKD); const bf16_t* rRD = (const bf16_t*)(rb + R2S_RD);
                const H8 ak0 = h8_from(ld16(rKKD + l15 * 64 + 8 * kg)), ak1 = h8_from(ld16(rKKD + l15 * 64 + 32 + 8 * kg)), ar0 = h8_from(ld16(rRD + l15 * 64 + 8 * kg)), ar1 = h8_from(ld16(rRD + l15 * 64 + 32 + 8 * kg));
                const H8 bb0 = h8_from(ld16(sBIP + l15 * 64 + 8 * kg)), bb1 = h8_from(ld16(sBIP + l15 * 64 + 32 + 8 * kg)), bk0 = h8_from(ld16(sKIP + l15 * 64 + 8 * kg)), bk1 = h8_from(ld16(sKIP + l15 * 64 + 32 + 8 * kg));
                A4 mA = mfma16(ak0, bb0, a4_zero()); mA = mfma16(ak1, bb1, mA);
                A4 mP = mfma16(ak0, bk0, a4_zero()); mP = mfma16(ak1, bk1, mP);
                A4 mQ1 = mfma16(ar0, bk0, a4_zero()); mQ1 = mfma16(ar1, bk1, mQ1);
                A4 mQ2 = mfma16(ar0, bb0, a4_zero()); mQ2 = mfma16(ar1, bb1, mQ2);
                MFMA_PAD(mA, mP, mQ1, mQ2, mA, mP, mQ1, mQ2);
                bf16_t* rP0 = (bf16_t*)(rb + R2S_P0); bf16_t* rQ1 = (bf16_t*)(rb + R2S_Q1); bf16_t* rNQ2 = (bf16_t*)(rb + R2S_NQ2);
                UNR for (int rg = 0; rg < 4; ++rg) { const int t = 4 * kg + rg, s_ = l15;
                    sAM[t * 16 + s_] = t > s_ ? A4_GET(mA, rg) : 0.f;
                    rP0[t * 16 + s_] = (bf16_t)f2bf(t > s_ ? A4_GET(mP, rg) : 0.f); rQ1[t * 16 + s_] = (bf16_t)f2bf(t >= s_ ? A4_GET(mQ1, rg) : 0.f); rNQ2[t * 16 + s_] = (bf16_t)f2bf(t >= s_ ? -A4_GET(mQ2, rg) : 0.f); }
            }
            WAVE_SYNC();
            {
                const int j = l15; float x[16]; bf16_t* rT = (bf16_t*)(rb + R2S_T);
                UNR for (int t = 0; t < 16; ++t) { float acc = t == j ? 1.f : 0.f;
                    UNR for (int s_ = 0; s_ < 16; ++s_) if (s_ < t) acc -= sAM[t * 16 + s_] * x[s_];
                    x[t] = acc; if (lane < 16) rT[t * 16 + j] = (bf16_t)f2bf(acc); }
            }
            LDS_FENCE();
            WAVE_SYNC();
            { const unsigned long long* st = (const unsigned long long*)(wsb + PW_REC); unsigned long long* gr = (unsigned long long*)(C.ws + WS_R2RING) + ((size_t)hd * R2_GSLOTS + (ch % R2_GSLOTS)) * R2S_U64;
              UNR for (int j = 0; j < 25; ++j) { const int idx = j * 64 + lane; if (idx < R2S_U64) gst_u64(gr + idx, st[idx]); } }
            VM_DRAIN(); WAVE_SYNC();
            if (lane == 0) gst_u32((unsigned*)(C.ws + WS_CTL + CTL_R2FLAG) + (size_t)hd * R2_NCH + ch, epoch);
            WAVE_SYNC();
        }
    }
    TACC_STORE(C, 47, C.vcu == 16 && C.tid == 0);
}

#ifdef EMU
typedef volatile unsigned* R2_LDSV;
#define R2_LDSV_AT(lds, off) ((volatile unsigned*)((lds) + (off)))
struct BufRsrc { const unsigned char* p; };
DEVFN BufRsrc mk_rsrc(const void* p, unsigned) { BufRsrc r; r.p = (const unsigned char*)p; return r; }
DEVFN U4 buf_ld16_sc1(BufRsrc r, unsigned off) { return *(const U4*)(r.p + off); }
#else
typedef volatile __attribute__((address_space(3))) unsigned* R2_LDSV;
#define R2_LDSV_AT(lds, off) ((volatile __attribute__((address_space(3))) unsigned*)((__attribute__((address_space(3))) unsigned char*)(lds) + (off)))
typedef unsigned u32x4_hw __attribute__((ext_vector_type(4)));
typedef __amdgpu_buffer_rsrc_t BufRsrc;
#define mk_rsrc(p, bytes) __builtin_amdgcn_make_buffer_rsrc((void*)(p), 0, (bytes), 0x00020000)
DEVFN U4 buf_ld16_sc1(BufRsrc r, unsigned off) { const u32x4_hw v = __builtin_amdgcn_raw_buffer_load_b128(r, off, 0, 16); U4 o; o.x = v.x; o.y = v.y; o.z = v.z; o.w = v.w; return o; }
#endif

DEVFN void rc2_chain(const Ctx& C, int i, int hd, bool ctx_out, unsigned char* lds, int max_chunks) {
    const int tid = C.tid, lane = tid & 63, wave = C.wave, h = hd >> 1, d = hd & 1;
    R2_LDSV lf = R2_LDSV_AT(lds, R2_LSLOTS * R2S_BYTES);
    if (tid < 96) lf[tid] = 0u;
    SYNC();
    const int nchunks = R2_NCH < max_chunks ? R2_NCH : max_chunks;
    const unsigned epoch = (unsigned)(i + 1), pbase = (unsigned)i * 100000u;
    #define RC_GEOM(ch, seg0, segn, R0) const bool isctx_ = (ch) < NCTX / RC_T; const int seg0 = isctx_ ? NLAT : 0, segn = isctx_ ? NCTX : NLAT; \
        const int cl_ = isctx_ ? (ch) : (ch) - NCTX / RC_T; const int R0 = d == 0 ? RC_T * cl_ : segn - RC_T * (cl_ + 1);
    if (wave < 4) {
        bf16_t* Yd = (bf16_t*)(C.ws + (d == 0 ? WS_YF : WS_YB));
        const int vt = wave, kg = lane >> 4, l15 = lane & 15;
        const bool kz = kg < 2;
        const int ZOFF = R2_LSLOTS * R2S_BYTES + 512;
        if (lane < 4) R2_LDSV_AT(lds, ZOFF)[lane] = 0u;
        LDS_FENCE(); WAVE_SYNC();
        const int a_vb = kz ? R2S_VT + ((16 * vt + l15) * 16 + 8 * kg) * 2 : ZOFF, a_kkd = R2S_KKD + (l15 * 64 + 8 * kg) * 2, a_rd = R2S_RD + (l15 * 64 + 8 * kg) * 2;
        const int a_p0 = kz ? R2S_P0 + (l15 * 16 + 8 * kg) * 2 : ZOFF, a_q1 = kz ? R2S_Q1 + (l15 * 16 + 8 * kg) * 2 : ZOFF, a_t = R2S_T + (l15 * 16 + 4 * kg) * 2, a_nq2 = R2S_NQ2 + (l15 * 16 + 4 * kg) * 2;
        const int a_ki = kz ? R2S_KIT + (l15 * 16 + 8 * kg) * 2 : ZOFF, s_ki = kz ? 512 : 0, a_nb = R2S_NBIT + (l15 * 16 + 4 * kg) * 2, a_g = R2S_GC + 4 * kg * 4;
        struct Frag { U4 vb, kkd0, kkd1, rd0, rd1, p0, q1, ki0, ki1, ki2, ki3; U2 t, nq2, nb0, nb1, nb2, nb3; F4 g0, g1, g2, g3; };
#define R2_LOADF(ch, f) do { \
            const int slot = ch % R2_LSLOTS; const unsigned char* rb = lds + slot * R2S_BYTES; const unsigned char* zb = lds; \
            TACC_BEGIN; SPIN_WAIT(lf[slot] == (unsigned)(ch + 1)); TACC_END; \
            f.vb = ld16((kz ? rb : zb) + a_vb); f.kkd0 = ld16(rb + a_kkd); f.kkd1 = ld16(rb + a_kkd + 64); f.rd0 = ld16(rb + a_rd); f.rd1 = ld16(rb + a_rd + 64); \
            f.p0 = ld16((kz ? rb : zb) + a_p0); f.q1 = ld16((kz ? rb : zb) + a_q1); f.t = *(const U2*)(rb + a_t); f.nq2 = *(const U2*)(rb + a_nq2); \
            f.ki0 = ld16((kz ? rb : zb) + a_ki); f.ki1 = ld16((kz ? rb : zb) + a_ki + s_ki); f.ki2 = ld16((kz ? rb : zb) + a_ki + 2 * s_ki); f.ki3 = ld16((kz ? rb : zb) + a_ki + 3 * s_ki); \
            f.nb0 = *(const U2*)(rb + a_nb); f.nb1 = *(const U2*)(rb + a_nb + 512); f.nb2 = *(const U2*)(rb + a_nb + 1024); f.nb3 = *(const U2*)(rb + a_nb + 1536); \
            f.g0 = *(const F4*)(rb + a_g); f.g1 = *(const F4*)(rb + a_g + 64); f.g2 = *(const F4*)(rb + a_g + 128); f.g3 = *(const F4*)(rb + a_g + 192); \
            LDS_FENCE(); WAVE_SYNC(); \
            if (lane == 0) lf[32 + wave * 16 + slot] = (unsigned)(ch + 1); \
        } while (0)
        A4 H0_ = a4_zero(), H1_ = a4_zero(), H2_ = a4_zero(), H3_ = a4_zero();
#define R2_COMPUTE(ch, f) do { \
            const H8 Hb0 = h8_pack2(H0_, H1_), Hb1 = h8_pack2(H2_, H3_), Vb = h8_from(f.vb); \
            A4 X = mfma16(h8_from(f.kkd0), Hb0, a4_zero()); X = mfma16(h8_from(f.kkd1), Hb1, X); X = mfma16(h8_from(f.p0), Vb, X); \
            A4 Y = mfma16(h8_from(f.rd0), Hb0, a4_zero()); Y = mfma16(h8_from(f.rd1), Hb1, Y); Y = mfma16(h8_from(f.q1), Vb, Y); \
            const H8 Xb = h8_pack1(X); \
            const A4 U_ = mfma16(h8_lo4(f.t), Xb, a4_zero()); \
            const H8 Ub = h8_pack1(U_); \
            Y = mfma16(h8_lo4(f.nq2), Ub, Y); \
            H0_ = mfma16(h8_from(f.ki0), Vb, H0_); H1_ = mfma16(h8_from(f.ki1), Vb, H1_); H2_ = mfma16(h8_from(f.ki2), Vb, H2_); H3_ = mfma16(h8_from(f.ki3), Vb, H3_); \
            H0_ = mfma16(h8_lo4(f.nb0), Ub, H0_); H1_ = mfma16(h8_lo4(f.nb1), Ub, H1_); H2_ = mfma16(h8_lo4(f.nb2), Ub, H2_); H3_ = mfma16(h8_lo4(f.nb3), Ub, H3_); \
            A4_GET(H0_, 0) *= f.g0.x; A4_GET(H0_, 1) *= f.g0.y; A4_GET(H0_, 2) *= f.g0.z; A4_GET(H0_, 3) *= f.g0.w; A4_GET(H1_, 0) *= f.g1.x; A4_GET(H1_, 1) *= f.g1.y; A4_GET(H1_, 2) *= f.g1.z; A4_GET(H1_, 3) *= f.g1.w; \
            A4_GET(H2_, 0) *= f.g2.x; A4_GET(H2_, 1) *= f.g2.y; A4_GET(H2_, 2) *= f.g2.z; A4_GET(H2_, 3) *= f.g2.w; A4_GET(H3_, 0) *= f.g3.x; A4_GET(H3_, 1) *= f.g3.y; A4_GET(H3_, 2) *= f.g3.z; A4_GET(H3_, 3) *= f.g3.w; \
            { RC_GEOM(ch, seg0, segn, R0) \
              if (!isctx_ || ctx_out) { UNR for (int rg = 0; rg < 4; ++rg) { const int t = 4 * kg + rg, tl = d == 0 ? R0 + t : R0 + RC_T - 1 - t; \
                  Yd[(size_t)(seg0 + tl) * 512 + 64 * h + 16 * vt + l15] = (bf16_t)f2bf(A4_GET(Y, rg)); } } } \
        } while (0)
        Frag fa, fb;
        TACC_DECL;
        { const int cz = 0; if (nchunks > 0) R2_LOADF(cz, fa); }
        for (int c0 = 0; c0 < nchunks; c0 += 2) {
            const int c1 = c0 + 1, c2 = c0 + 2;
            if (c1 < nchunks) R2_LOADF(c1, fb);
            R2_COMPUTE(c0, fa);
            if (c1 < nchunks) { if (c2 < nchunks) R2_LOADF(c2, fa); R2_COMPUTE(c1, fb); }
        }
        TACC_STORE(C, 45, C.vcu == 0 && tid == 0);
    } else {
        const int w = wave - 4;
        const unsigned* FLAG = (const unsigned*)(C.ws + WS_CTL + CTL_R2FLAG) + (size_t)hd * R2_NCH; unsigned* POS = (unsigned*)(C.ws + WS_CTL + CTL_R2POS) + 16 * hd;
        const BufRsrc rs = mk_rsrc(C.ws + WS_R2RING + (size_t)hd * R2_GSLOTS * R2S_BYTES, (unsigned)(R2_GSLOTS * R2S_BYTES));
        TACC_DECL;
        unsigned f0 = 0u, f1 = 0u;
        for (int ca = w; ca < nchunks; ca += 8) {
            const int cb = ca + 4; const bool two = cb < nchunks;
            if (f0 != epoch) { GSPIN_WAIT(gld_u32(FLAG + ca) == epoch); }
            if (two && f1 != epoch) { GSPIN_WAIT(gld_u32(FLAG + cb) == epoch); }
            U4 xa[13], xb[13];
            const unsigned oa = (unsigned)(ca % R2_GSLOTS) * R2S_BYTES + lane * 16, ob = (unsigned)(cb % R2_GSLOTS) * R2S_BYTES + lane * 16;
            UNR for (int j = 0; j < 13; ++j) xa[j] = buf_ld16_sc1(rs, oa + j * 1024);
            if (two) { UNR for (int j = 0; j < 13; ++j) xb[j] = buf_ld16_sc1(rs, ob + j * 1024); }
            f0 = ca + 8 < nchunks ? gld_u32(FLAG + ca + 8) : 0u; f1 = cb + 8 < nchunks ? gld_u32(FLAG + cb + 8) : 0u;
            {
                const int slot = ca % R2_LSLOTS;
                if (ca >= R2_LSLOTS) { const unsigned need = (unsigned)(ca - R2_LSLOTS + 1); TACC_BEGIN; SPIN_WAIT(lf[32 + 0 * 16 + slot] == need && lf[32 + 1 * 16 + slot] == need && lf[32 + 2 * 16 + slot] == need && lf[32 + 3 * 16 + slot] == need); TACC_END; }
                unsigned char* dst = lds + slot * R2S_BYTES + lane * 16;
                UNR for (int j = 0; j < 12; ++j) st16(dst + j * 1024, xa[j]);
                if (lane < 16) st16(dst + 12 * 1024, xa[12]);
                LDS_FENCE(); WAVE_SYNC();
                if (lane == 0) lf[slot] = (unsigned)(ca + 1);
            }
            if (two) {
                const int slot = cb % R2_LSLOTS;
                if (cb >= R2_LSLOTS) { const unsigned need = (unsigned)(cb - R2_LSLOTS + 1); TACC_BEGIN; SPIN_WAIT(lf[32 + 0 * 16 + slot] == need && lf[32 + 1 * 16 + slot] == need && lf[32 + 2 * 16 + slot] == need && lf[32 + 3 * 16 + slot] == need); TACC_END; }
                unsigned char* dst = lds + slot * R2S_BYTES + lane * 16;
                UNR for (int j = 0; j < 12; ++j) st16(dst + j * 1024, xb[j]);
                if (lane < 16) st16(dst + 12 * 1024, xb[12]);
                LDS_FENCE(); WAVE_SYNC();
                if (lane == 0) lf[slot] = (unsigned)(cb + 1);
            }
            if (lane == 0) gst_u32(POS + 1 + w, pbase + (unsigned)((two ? cb : ca) + 1));
        }
        TACC_STORE(C, 46, C.vcu == 0 && tid == 256);
    }
    #undef RC_GEOM
    SYNC();
}
#ifndef HY_CUS
#define HY_CUS 171
#endif
DEVFN void ph_scan_hyena(const Ctx& C, int i, bool ctx_out, unsigned char* lds) {
    const int np = C.G >= 256 ? C.G - 16 - HY_CUS : (C.G - 16) / 2, nscan = 16 + np;
    if (C.vcu < 16) { rc2_chain(C, i, C.vcu, ctx_out, lds, 1 << 30); XSTAMP(C, 40, C.vcu == 0); return; }
    if (C.vcu < nscan) { rc2_producer(C, i, lds, (C.vcu - 16) * NWAVES + C.wave, np * NWAVES, 0, 16, 1 << 30); XSTAMP(C, 43, C.vcu == 16); return; }
    const int nh = C.G - nscan;
    for (int c = C.vcu - nscan; c < 512; c += nh) { hyena_channel(C, i, c, lds); if (c == C.vcu - nscan) XSTAMP(C, 44, C.vcu == nscan); }
    XSTAMP(C, 41, C.vcu == nscan); XSTAMP(C, 42, C.vcu == C.G - 1);
    if (ctx_out) for (int c = C.vcu - nscan; c < 512; c += nh) { SYNC(); hyena_ctx_channel(C, i, c, lds); }
}

DEVFN void ctx_outproj(const Ctx& C, const bf16_t* A1, const bf16_t* A2, int lda, const bf16_t* Wt, const float* gate_c, const float* base, float* out) {
    const int row = C.tid & 255, cp = C.tid >> 8;
    for (int n0 = 4 * C.vcu; n0 < DM; n0 += 4 * C.G) {
        const int n = n0 + 2 * cp;
        const bf16_t* w0p = Wt + (size_t)n * DM; const bf16_t* w1p = w0p + DM;
        float acc0 = 0.f, acc1 = 0.f;
        for (int hf = 0; hf < 2; ++hf) {
            const bf16_t* ap = (hf == 0 ? A1 : A2) + (size_t)row * lda;
            for (int k0 = 0; k0 < 512; k0 += 8) {
                float a[8], w0[8], w1[8];
                unpack8(ld16(ap + k0), a); unpack8(ld16(w0p + 512 * hf + k0), w0); unpack8(ld16(w1p + 512 * hf + k0), w1);
                UNR for (int e = 0; e < 8; ++e) { acc0 += a[e] * w0[e]; acc1 += a[e] * w1[e]; }
            }
        }
        const size_t o = (size_t)row * DM + n;
        out[o] = base[o] + gate_c[n] * acc0; out[o + 1] = base[o + 1] + gate_c[n + 1] * acc1;
    }
}
namespace pg8 {
#define PG8_LAS __attribute__((address_space(3)))
typedef unsigned short bf16_t;
typedef short bf16x8 __attribute__((ext_vector_type(8)));
typedef float f32x4 __attribute__((ext_vector_type(4)));
typedef unsigned u32x4 __attribute__((ext_vector_type(4)));
constexpr int BM = 256, BK = 64, HALF = 128, HTB = HALF * BK * 2  , STAGE_BYTES = 8 * HTB, NXCD = 8, WGM = 8;

__host__ __device__ __forceinline__ int lds_byte(int r, int c) { const int st = (r >> 4) * 2 + (c >> 5), rr = r & 15, cc = c & 31, ob = rr * 64 + cc * 2; return st * 1024 + (ob ^ (((ob >> 9) & 1) << 5)); }
__host__ __device__ __forceinline__ void stage_rc(int b, int& R, int& C) { const int st = b / 1024, sb = b % 1024, swz = sb ^ (((sb >> 9) & 1) << 5); R = (st >> 1) * 16 + swz / 64; C = (st & 1) * 32 + (swz % 64) / 2; }
__host__ __device__ __forceinline__ int perm32(int rho) { const int n = rho >> 4, i = rho & 15; return 8 * (i >> 2) + 4 * n + (i & 3); }

struct Unit { int pm, pn; };
struct Gemm { const bf16_t* A; const bf16_t* A2; int lda; const bf16_t* Bt; int M, N, K; };

struct StaticOrder {
    int nM, nN, nwg, G, c;
    __host__ __device__ void init(int M, int N, int G_, int c_) { nM = M / BM; nN = N / BM; nwg = nM * nN; G = G_; c = c_; }
    __host__ __device__ bool next(int i, Unit& u) const {
        const long L = (long)i * G + c; if (L >= nwg) return false;
        int wgid = (int)L; { const int q = nwg / NXCD, r = nwg % NXCD, xcd = wgid % NXCD, off = wgid / NXCD; wgid = (xcd < r ? xcd * (q + 1) : r * (q + 1) + (xcd - r) * q) + off; }
        const int nig = WGM * nN, gid = wgid / nig, fm = gid * WGM, gsz = (nM - fm) < WGM ? (nM - fm) : WGM;
        u.pm = fm + ((wgid % nig) % gsz); u.pn = (wgid % nig) / gsz; return true;
    }
    __device__ __forceinline__ void a_ready(const Unit&) const {}
    __device__ __forceinline__ void done(const Unit&) const {}
};

__device__ __forceinline__ unsigned cvt_pk_bf16(float lo, float hi) { unsigned r; asm volatile("v_cvt_pk_bf16_f32 %0, %1, %2" : "=v"(r) : "v"(lo), "v"(hi)); return r; }
__device__ __forceinline__ float silu_fast(float v) { return v * __builtin_amdgcn_rcpf(1.0f + __expf(-v)); }

template <int LAYOUT> struct EpiIn {
    static constexpr bool PERM = true, AFTER_DRAIN = false;
    unsigned char* ws;
    __device__ __forceinline__ void operator()(const f32x4 (&acc)[2][2][4][2], const Unit& u, int wr, int wc, int fr, int fq) const {
        const int row0 = u.pm * BM + wr * 64 + fr;
#pragma unroll
        for (int bj = 0; bj < 2; ++bj) {
            const int cg = u.pn * BM + bj * HALF;
            bf16_t* base; int ldc, mode, col;
            if (LAYOUT == 0) { base = (bf16_t*)(ws + WS_U); ldc = AIN; col = cg; mode = cg < 512 ? 1 : ((cg >= 1536 && cg < 2048) || cg >= 2816) ? 2 : 0; }
            else {
                if (cg < URW_W) { base = (bf16_t*)(ws + WS_U); ldc = URW_W; col = cg; mode = cg >= 1664 ? 2 : 0; }
                else if (cg < URW_W + UHY_W) { base = (bf16_t*)(ws + WS_UHY); ldc = UHY_W; col = cg - URW_W; mode = 0; }
                else if (cg < RIN) { base = (bf16_t*)(ws + WS_GHY); ldc = 512; col = cg - URW_W - UHY_W; mode = 2; }
                else { base = nullptr; ldc = 0; col = 0; mode = 3; }
            }
            if (mode == 3) continue;
            const int col0 = col + wc * 32 + 8 * fq;
#pragma unroll
            for (int ai = 0; ai < 2; ++ai)
#pragma unroll
                for (int m = 0; m < 4; ++m) {
                    f32x4 v0 = acc[ai][bj][m][0], v1 = acc[ai][bj][m][1];
                    if (mode == 1) { v0 = v0 * C2; v1 = v1 * C2; }
                    if (mode == 2) { v0 = (f32x4){silu_fast(v0[0]), silu_fast(v0[1]), silu_fast(v0[2]), silu_fast(v0[3])}; v1 = (f32x4){silu_fast(v1[0]), silu_fast(v1[1]), silu_fast(v1[2]), silu_fast(v1[3])}; }
                    u32x4 w; w.x = cvt_pk_bf16(v0[0], v0[1]); w.y = cvt_pk_bf16(v0[2], v0[3]); w.z = cvt_pk_bf16(v1[0], v1[1]); w.w = cvt_pk_bf16(v1[2], v1[3]);
                    *(u32x4*)(base + (size_t)(row0 + ai * HALF + m * 16) * ldc + col0) = w;
                }
        }
    }
};

struct EpiRes {
    static constexpr bool PERM = false, AFTER_DRAIN = false;
    const float* blat; const float* bctx; float* olat; float* octx; const float* gate; const float* gate_c;
    __device__ __forceinline__ void operator()(const f32x4 (&acc)[2][2][4][2], const Unit& u, int wr, int wc, int fr, int fq) const {
        const bool isctx = u.pm * BM >= NLAT;
        const float* bs = isctx ? bctx - (size_t)NLAT * DM : blat; float* os = isctx ? octx - (size_t)NLAT * DM : olat; const float* gt = isctx ? gate_c : gate;
        const int col0 = u.pn * BM + wc * 32 + 4 * fq;
#pragma unroll
        for (int bj = 0; bj < 2; ++bj)
#pragma unroll
            for (int n = 0; n < 2; ++n) { const f32x4 g = *(const f32x4*)(gt + col0 + bj * HALF + n * 16);
#pragma unroll
                for (int ai = 0; ai < 2; ++ai)
#pragma unroll
                    for (int m = 0; m < 4; ++m) { const size_t off = (size_t)(u.pm * BM + ai * HALF + wr * 64 + m * 16 + fr) * DM + col0 + bj * HALF + n * 16;
                        const f32x4 b = *(const f32x4*)(bs + off); *(f32x4*)(os + off) = b + g * acc[ai][bj][m][n]; } }
    }
};
template <class Epi, class Sched, bool ALIGN_EPI = false, bool SP2 = false>
__device__ __forceinline__ void gemm_phase(PG8_LAS unsigned char* lds, const Gemm g, const Sched& S, const Epi& E) {
    int tid_ = threadIdx.x; asm volatile("" : "+v"(tid_));
    const int tid = tid_, wid = __builtin_amdgcn_readfirstlane(tid >> 6), lane = tid & 63, wr = wid >> 2, wc = wid & 3, fr = lane & 15, fq = lane >> 4;
    const int K = g.K, nt = K / BK;
    unsigned voffA[2], voffB[2];
#pragma unroll
    for (int i = 0; i < 2; ++i) { int R, C; stage_rc(tid * 16 + i * 8192, R, C); const int Rb = Epi::PERM ? ((R & ~31) + perm32(R & 31)) : R;
        voffA[i] = (unsigned)(R * g.lda + C) * 2u; voffB[i] = (unsigned)(Rb * K + C) * 2u; }
    const size_t kstep = (size_t)(BK * 2);
    const size_t hstepA = (size_t)HALF * g.lda * 2, hstepB = (size_t)HALF * K * 2;
    const size_t tstepA = 2 * hstepA, tstepB = 2 * hstepB;
    const int nh = nt / 2; const ptrdiff_t dlt = ((const char*)g.A2 - (const char*)g.A) - (ptrdiff_t)nh * (ptrdiff_t)kstep;
    const unsigned ldsw = (unsigned)wid * 1024u;
    const int aoff = lds_byte(wr * 64 + fr, fq * 8), boff = lds_byte(wc * 32 + fr, fq * 8);
#define PG8_SA(b, h) (((b) * 2 + (h)) * HTB)
#define PG8_SB(b, h) ((4 + (b) * 2 + (h)) * HTB)
#define PG8_STAGE(bufoff, gbase, voff) do { _Pragma("unroll") for (int _i = 0; _i < 2; ++_i) \
        __builtin_amdgcn_global_load_lds((const unsigned*)((const char*)(gbase) + (voff)[_i]), (PG8_LAS unsigned*)(lds + (bufoff) + ldsw + _i * 8192), 16, 0, 0); } while (0)
#define PG8_LDA(dst, b, h) do { _Pragma("unroll") for (int m = 0; m < 4; ++m) _Pragma("unroll") for (int k = 0; k < 2; ++k) dst[m][k] = *(const PG8_LAS bf16x8*)(lds + PG8_SA(b, h) + aoff + m * 2048 + k * 1024); } while (0)
#define PG8_LDB(dst, b, h) do { _Pragma("unroll") for (int n = 0; n < 2; ++n) _Pragma("unroll") for (int k = 0; k < 2; ++k) dst[n][k] = *(const PG8_LAS bf16x8*)(lds + PG8_SB(b, h) + boff + n * 2048 + k * 1024); } while (0)
#define PG8_MMA(ai, bj, At, Bt) do { __builtin_amdgcn_s_setprio(1); _Pragma("unroll") for (int m = 0; m < 4; ++m) _Pragma("unroll") for (int n = 0; n < 2; ++n) _Pragma("unroll") for (int k = 0; k < 2; ++k) \
        acc[ai][bj][m][n] = __builtin_amdgcn_mfma_f32_16x16x32_bf16(Bt[n][k], At[m][k], acc[ai][bj][m][n], 0, 0, 0); __builtin_amdgcn_s_setprio(0); } while (0)
#define PG8_WAIT_V(n) asm volatile("s_waitcnt vmcnt(" #n ")" ::: "memory")
#define PG8_WAIT_L(n) asm volatile("s_waitcnt lgkmcnt(" #n ")" ::: "memory")
#define PG8_BAR __builtin_amdgcn_s_barrier()
#define PG8_SCHED __builtin_amdgcn_sched_barrier(0)
    Unit cur, nxt; int ui = 0;
    if (!S.next(0, cur)) return;
    f32x4 acc[2][2][4][2];
#pragma unroll
    for (int a = 0; a < 2; ++a)
#pragma unroll
        for (int b = 0; b < 2; ++b)
#pragma unroll
            for (int m = 0; m < 4; ++m)
#pragma unroll
                for (int n = 0; n < 2; ++n) acc[a][b][m][n] = (f32x4){0.f, 0.f, 0.f, 0.f};
    bf16x8 At[4][2], B0[2][2], B1[2][2];
    const char* cA = (const char*)g.A + (size_t)cur.pm * tstepA; const char* cB = (const char*)g.Bt + (size_t)cur.pn * tstepB;
    S.a_ready(cur);
    if constexpr (SP2) {
        PG8_STAGE(PG8_SB(0, 0), cB, voffB); PG8_STAGE(PG8_SB(0, 1), cB + hstepB, voffB); PG8_STAGE(PG8_SA(0, 0), cA, voffA); PG8_STAGE(PG8_SA(0, 1), cA + hstepA, voffA);
        if (wr == 1) PG8_BAR;
        PG8_WAIT_V(2); PG8_BAR;
        PG8_STAGE(PG8_SB(1, 0), cB + kstep, voffB); PG8_STAGE(PG8_SA(1, 0), cA + kstep, voffA); PG8_STAGE(PG8_SB(1, 1), cB + hstepB + kstep, voffB);
        PG8_WAIT_V(6); PG8_BAR;
    } else {
        PG8_STAGE(PG8_SB(0, 0), cB, voffB); PG8_STAGE(PG8_SA(0, 0), cA, voffA); PG8_STAGE(PG8_SB(0, 1), cB + hstepB, voffB); PG8_STAGE(PG8_SA(0, 1), cA + hstepA, voffA);
        if (wr == 1) PG8_BAR;
        PG8_WAIT_V(4); PG8_BAR;
        PG8_STAGE(PG8_SB(1, 0), cB + kstep, voffB); PG8_STAGE(PG8_SA(1, 0), cA + kstep, voffA); PG8_STAGE(PG8_SB(1, 1), cB + hstepB + kstep, voffB);
        PG8_WAIT_V(6); PG8_BAR;
    }
    for (;;) {
        const bool has_next = S.next(ui + 1, nxt);
        const char* nA = has_next ? (const char*)g.A + (size_t)nxt.pm * tstepA : cA; const char* nB = has_next ? (const char*)g.Bt + (size_t)nxt.pn * tstepB : cB;
        for (int t = 0; t < nt; t += 2) {
            const bool last = (t == nt - 2);
            const char* a1 = cA + (size_t)(t + 1) * kstep + ((t + 1) >= nh ? dlt : 0);
            const char* a2 = last ? nA : cA + (size_t)(t + 2) * kstep + ((t + 2) >= nh ? dlt : 0); const char* b2 = last ? nB : cB + (size_t)(t + 2) * kstep;
            const char* a3 = a2 + kstep; const char* b3 = b2 + kstep;
            if (last && has_next) S.a_ready(nxt);
            if constexpr (SP2) {
            PG8_LDB(B0, 0, 0); PG8_LDB(B1, 0, 1); PG8_SCHED; PG8_LDA(At, 0, 0); PG8_STAGE(PG8_SA(1, 1), a1 + hstepA, voffA);
            PG8_WAIT_V(8); PG8_WAIT_L(0); PG8_BAR; PG8_MMA(0, 0, At, B0); PG8_MMA(0, 1, At, B1); PG8_BAR; PG8_SCHED;
            PG8_LDA(At, 0, 1); PG8_STAGE(PG8_SB(0, 0), b2, voffB); PG8_STAGE(PG8_SB(0, 1), b2 + hstepB, voffB); PG8_STAGE(PG8_SA(0, 0), a2, voffA);
            PG8_WAIT_V(8); PG8_WAIT_L(0); PG8_BAR; PG8_MMA(1, 0, At, B0); PG8_MMA(1, 1, At, B1); PG8_BAR; PG8_SCHED;
            PG8_LDB(B0, 1, 0); PG8_LDB(B1, 1, 1); PG8_SCHED; PG8_LDA(At, 1, 0); PG8_STAGE(PG8_SA(0, 1), a2 + hstepA, voffA);
            PG8_WAIT_V(8); PG8_WAIT_L(0); PG8_BAR; PG8_MMA(0, 0, At, B0); PG8_MMA(0, 1, At, B1); PG8_BAR; PG8_SCHED;
            PG8_LDA(At, 1, 1); PG8_STAGE(PG8_SB(1, 0), b3, voffB); PG8_STAGE(PG8_SB(1, 1), b3 + hstepB, voffB); PG8_STAGE(PG8_SA(1, 0), a3, voffA);
            PG8_WAIT_V(8); PG8_WAIT_L(0); PG8_BAR; PG8_MMA(1, 0, At, B0); PG8_MMA(1, 1, At, B1); PG8_BAR; PG8_SCHED;
            } else {
            PG8_LDB(B0, 0, 0); PG8_SCHED; PG8_LDA(At, 0, 0); PG8_STAGE(PG8_SA(1, 1), a1 + hstepA, voffA);
            PG8_WAIT_L(8); PG8_BAR; PG8_WAIT_L(0); PG8_MMA(0, 0, At, B0); PG8_BAR; PG8_SCHED;
            PG8_LDB(B1, 0, 1); PG8_STAGE(PG8_SB(0, 0), b2, voffB);
            PG8_BAR; PG8_WAIT_L(0); PG8_MMA(0, 1, At, B1); PG8_BAR;
            PG8_LDA(At, 0, 1); PG8_STAGE(PG8_SA(0, 0), a2, voffA);
            PG8_BAR; PG8_WAIT_L(0); PG8_MMA(1, 0, At, B0); PG8_BAR; PG8_SCHED;
            PG8_STAGE(PG8_SB(0, 1), b2 + hstepB, voffB);
            PG8_WAIT_V(6); PG8_BAR; PG8_MMA(1, 1, At, B1); PG8_BAR;
            PG8_LDB(B0, 1, 0); PG8_SCHED; PG8_LDA(At, 1, 0); PG8_STAGE(PG8_SA(0, 1), a2 + hstepA, voffA);
            PG8_WAIT_L(8); PG8_BAR; PG8_WAIT_L(0); PG8_MMA(0, 0, At, B0); PG8_BAR; PG8_SCHED;
            PG8_LDB(B1, 1, 1); PG8_STAGE(PG8_SB(1, 0), b3, voffB);
            PG8_BAR; PG8_WAIT_L(0); PG8_MMA(0, 1, At, B1); PG8_BAR;
            PG8_LDA(At, 1, 1); PG8_STAGE(PG8_SA(1, 0), a3, voffA);
            PG8_BAR; PG8_WAIT_L(0); PG8_MMA(1, 0, At, B0); PG8_BAR; PG8_SCHED;
            PG8_STAGE(PG8_SB(1, 1), b3 + hstepB, voffB);
            PG8_WAIT_V(6); PG8_BAR; PG8_MMA(1, 1, At, B1); PG8_BAR;
            }
        }
        if constexpr (ALIGN_EPI) { if (wr == 0) PG8_BAR; }
        if constexpr (!Epi::AFTER_DRAIN) { E(acc, cur, wr, wc, fr, fq); S.done(cur); }
        if (!has_next) break;
#pragma unroll
        for (int a = 0; a < 2; ++a)
#pragma unroll
            for (int b = 0; b < 2; ++b)
#pragma unroll
                for (int m = 0; m < 4; ++m)
#pragma unroll
                    for (int n = 0; n < 2; ++n) acc[a][b][m][n] = (f32x4){0.f, 0.f, 0.f, 0.f};
        cur = nxt; cA = nA; cB = nB; ++ui;
        if constexpr (ALIGN_EPI) { if (wr == 1) PG8_BAR; }
    }
    PG8_WAIT_V(0);
    if constexpr (!ALIGN_EPI) { if (wr == 0) PG8_BAR; }
    PG8_BAR;
    if constexpr (Epi::AFTER_DRAIN) { E.fused(acc, cur, wr, wc, fr, fq, lds, wid, lane); S.done(cur); }
#undef PG8_SA
#undef PG8_SB
#undef PG8_STAGE
#undef PG8_LDA
#undef PG8_LDB
#undef PG8_MMA
#undef PG8_WAIT_V
#undef PG8_WAIT_L
#undef PG8_BAR
#undef PG8_SCHED
}
}
#include <hip/hip_bf16.h>
#include <cmath>
namespace attn_body {
using bf16=__hip_bfloat16;
using bf16x8=__attribute__((ext_vector_type(8)))short;
using s16x4=__attribute__((ext_vector_type(4)))short;
using f32x16=__attribute__((ext_vector_type(16)))float;
using u32x4=__attribute__((ext_vector_type(4)))unsigned;
constexpr int D=64;
constexpr int NW=8,QBLK=32,QB=QBLK*NW,KVBLK=64;
__device__ __forceinline__ int crow(int r,int hi){return (r&3)+8*(r>>2)+4*hi;}
#define SBAR() __builtin_amdgcn_sched_barrier(0)
typedef __attribute__((address_space(3))) const float* lds_fptr;
struct NaCtx { lds_fptr tab; int rmin, qr, qc, row0, col0; };
__device__ __forceinline__ void namask(f32x16&p0,f32x16&p1,int t,const NaCtx&n,int hi){
  if(t<4)return;
  const float NEG=-INFINITY; const int kr=n.rmin+(t-4);
  if(kr<n.row0||kr>=n.row0+8){
    #pragma unroll
    for(int r=0;r<16;++r){p0[r]=NEG;p1[r]=NEG;}
    return; }
  const lds_fptr bt=n.tab+((kr-n.qr+7)*31+15-n.qc+4*hi); const int d0=4*hi-n.col0;
  #pragma unroll
  for(int r=0;r<16;++r){const int e=(r&3)+8*(r>>2);
    p0[r]=((unsigned)(e+d0)<16u)?p0[r]+bt[e]:NEG; p1[r]=((unsigned)(e+32+d0)<16u)?p1[r]+bt[e+32]:NEG;}
}

constexpr int NSLOT=3, SLOTB=8192;
constexpr int LDS_K=0, LDS_V=NSLOT*SLOTB, LDS_WS=2*NSLOT*SLOTB, LDS_OST=LDS_WS+NW*64*4, LDS_BIAS=LDS_OST+NW*4096, LDS_BYTES=LDS_BIAS+640*4;
constexpr float C2=0.125f*1.4426950408889634f;
__device__ __forceinline__ void glds16(const void*gsrc,unsigned lds_dst){unsigned keep;
  asm volatile("s_mov_b32 %0, m0\n\ts_mov_b32 m0, %2\n\ts_nop 0\n\tglobal_load_lds_dwordx4 %1, off\n\ts_mov_b32 m0, %0":"=&s"(keep):"v"(gsrc),"s"(lds_dst):"memory");}
__device__ __forceinline__ float max3f(float a,float b,float c){float r;asm("v_max3_f32 %0, %1, %2, %3":"=v"(r):"v"(a),"v"(b),"v"(c));return r;}
__device__ __forceinline__ float max2f(float a,float b){float r;asm("v_max_f32_e32 %0, %1, %2":"=v"(r):"v"(a),"v"(b));return r;}
__device__ __forceinline__ float fadd_s(float a,float b){float r;asm("v_add_f32_e32 %0, %1, %2":"=v"(r):"v"(a),"v"(b));return r;}
__device__ __forceinline__ float fsub_s(float a,float b){float r;asm("v_sub_f32_e32 %0, %1, %2":"=v"(r):"v"(a),"v"(b));return r;}
typedef float f32x2_t __attribute__((ext_vector_type(2))); typedef __bf16 bf16x2_t __attribute__((ext_vector_type(2)));
__device__ __forceinline__ unsigned cvtpk_s(float lo,float hi){f32x2_t v={lo,hi};bf16x2_t b=__builtin_convertvector(v,bf16x2_t);return __builtin_bit_cast(unsigned,b);}
#define WAIT_BAR(N) asm volatile("s_waitcnt vmcnt(" #N ") lgkmcnt(0)\n\ts_barrier":::"memory")

__device__ __forceinline__ void qkt(f32x16&p0,f32x16&p1,const char*Kslot,const bf16x8*qr,const f32x16&negm,int r32,int hi){
  const char*kb=Kslot+hi*1024+r32*16;
  #pragma unroll
  for(int d0=0;d0<4;++d0){
    const bf16x8 b0=*reinterpret_cast<const bf16x8*>(kb+d0*2048);
    const bf16x8 b1=*reinterpret_cast<const bf16x8*>(kb+d0*2048+512);
    if(d0==0){p0=__builtin_amdgcn_mfma_f32_32x32x16_bf16(b0,qr[0],negm,0,0,0);p1=__builtin_amdgcn_mfma_f32_32x32x16_bf16(b1,qr[0],negm,0,0,0);}
    else{p0=__builtin_amdgcn_mfma_f32_32x32x16_bf16(b0,qr[d0],p0,0,0,0);p1=__builtin_amdgcn_mfma_f32_32x32x16_bf16(b1,qr[d0],p1,0,0,0);}}
}
typedef __attribute__((address_space(3))) const char* lds_cptr;
typedef short v4i16_t __attribute__((ext_vector_type(4)));
__device__ __forceinline__ void kload8(bf16x8*kf,lds_cptr kp){
  kf[0]=*(const __attribute__((address_space(3))) bf16x8*)(kp);      kf[1]=*(const __attribute__((address_space(3))) bf16x8*)(kp+512);
  kf[2]=*(const __attribute__((address_space(3))) bf16x8*)(kp+2048); kf[3]=*(const __attribute__((address_space(3))) bf16x8*)(kp+2560);
  kf[4]=*(const __attribute__((address_space(3))) bf16x8*)(kp+4096); kf[5]=*(const __attribute__((address_space(3))) bf16x8*)(kp+4608);
  kf[6]=*(const __attribute__((address_space(3))) bf16x8*)(kp+6144); kf[7]=*(const __attribute__((address_space(3))) bf16x8*)(kp+6656);
}
__device__ __forceinline__ void kload2(bf16x8*kf,lds_cptr kp,int j){ kf[2*j]=*(const __attribute__((address_space(3))) bf16x8*)(kp+j*2048); kf[2*j+1]=*(const __attribute__((address_space(3))) bf16x8*)(kp+j*2048+512); }
__device__ __forceinline__ s16x4 vtr(lds_cptr p){ return __builtin_bit_cast(s16x4,__builtin_amdgcn_ds_read_tr16_b64_v4i16((__attribute__((address_space(3))) v4i16_t*)p)); }
__device__ __forceinline__ float rowmax(const f32x16&p0,const f32x16&p1){
  float a=max3f(p0[0],p0[1],p1[0]),b=max3f(p0[2],p0[3],p1[1]);a=max3f(a,p1[2],p1[3]);
  #pragma unroll
  for(int r=4;r<16;r+=4){a=max3f(a,p0[r],p0[r+1]);b=max3f(b,p0[r+2],p0[r+3]);a=max3f(a,p1[r],p1[r+1]);b=max3f(b,p1[r+2],p1[r+3]);}
  const float m=max2f(a,b);
  auto rr=__builtin_amdgcn_permlane32_swap(__float_as_uint(m),__float_as_uint(m),false,false);
  return max2f(__uint_as_float(rr[0]),__uint_as_float(rr[1]));
}
__device__ __forceinline__ void pv(f32x16*o,int vb,bf16x8 pa0,bf16x8 pa1,bf16x8 pa2,bf16x8 pa3){
  #pragma unroll
  for(int d0=0;d0<2;++d0){s16x4 lo[4],hi[4];
    #pragma unroll
    for(int ks=0;ks<4;++ks){
      asm volatile("ds_read_b64_tr_b16 %0,%1 offset:%c2":"=&v"(lo[ks]):"v"(vb),"i"(d0*4096+ks*1024):"memory");
      asm volatile("ds_read_b64_tr_b16 %0,%1 offset:%c2":"=&v"(hi[ks]):"v"(vb),"i"(d0*4096+ks*1024+512):"memory");}
    asm volatile("s_waitcnt lgkmcnt(0)":::"memory");SBAR();
    #define PK(k) (bf16x8){lo[k][0],lo[k][1],lo[k][2],lo[k][3],hi[k][0],hi[k][1],hi[k][2],hi[k][3]}
    o[d0]=__builtin_amdgcn_mfma_f32_32x32x16_bf16(pa0,PK(0),o[d0],0,0,0);
    o[d0]=__builtin_amdgcn_mfma_f32_32x32x16_bf16(pa1,PK(1),o[d0],0,0,0);
    o[d0]=__builtin_amdgcn_mfma_f32_32x32x16_bf16(pa2,PK(2),o[d0],0,0,0);
    o[d0]=__builtin_amdgcn_mfma_f32_32x32x16_bf16(pa3,PK(3),o[d0],0,0,0);
    #undef PK
  }
}

#define ATTN_STORE16(p,v) (*(u32x4*)(p)=(v))
template<bool NA> __device__ __forceinline__ f32x16 cinit(const f32x16&negm){ if constexpr(NA){ f32x16 z=f32x16{}; return z; } else return negm; }
constexpr int UP=3328, OP=1024;
struct AJob { const bf16*U; bf16*MX; unsigned qo, ko, vo, go, oo; int NT, tile0a, na, tile0b; int qr0, rmin; const float*rpb; };
__device__ __forceinline__ u32x4 gate8(u32x4 v,u32x4 g);
template<int THRL,bool NA> __device__ __forceinline__ void attn_unit(const AJob&J,char*shm){
  int tid_=threadIdx.x; asm volatile("":"+v"(tid_));
  const int tid=tid_,lane=tid&63,r32=lane&31,hi=lane>>5; const int wid=__builtin_amdgcn_readfirstlane(tid>>6);
  const bf16*Qw=J.U+J.qo+(long)(wid*QBLK)*UP;
  const bf16*Kh=J.U+J.ko,*Vh=J.U+J.vo;
  const unsigned lds0=(unsigned)(uintptr_t)shm;
  float*wsf=(float*)(shm+LDS_WS)+wid*64;
  const bf16*ksrc=Kh+(long)lane*UP+wid*8;
  const bf16*vsrc=Vh+(long)(16*(wid&3)+(lane>>2))*UP+(wid>>2)*32+(lane&3)*8;
  const unsigned kdst=lds0+LDS_K+wid*1024, vdst=lds0+LDS_V+wid*1024;
  #define TROW(t) (64L*(long)(((t)<J.na)?(J.tile0a+(t)):(J.tile0b+((t)-J.na))))
  #define DMA_K(t,slot) glds16(ksrc+TROW(t)*UP,(unsigned)__builtin_amdgcn_readfirstlane(kdst+(slot)))
  #define DMA_V(t,slot) glds16(vsrc+TROW(t)*UP,(unsigned)__builtin_amdgcn_readfirstlane(vdst+(slot)))
  const int vb0=(int)(lds0+LDS_V)+((lane>>4)&1)*32+(lane&3)*8+(4*hi+((lane&15)>>2))*64;
  const char*Kbase=shm+LDS_K; bf16x8 kf[8];
  const lds_cptr shm3=(lds_cptr)shm; const lds_cptr kp0=shm3+LDS_K+hi*1024+r32*16; const lds_cptr vp0=shm3+LDS_V+((lane>>4)&1)*32+(lane&3)*8+(4*hi+((lane&15)>>2))*64;
  const int NT=J.NT;
  NaCtx nac; nac.tab=(lds_fptr)(shm+LDS_BIAS)+64; nac.rmin=J.rmin; nac.qr=J.qr0+(wid>>1); nac.qc=32*(wid&1)+r32;
  { int a=nac.qr-4; a=a<0?0:(a>248?248:a); nac.row0=a; int b=nac.qc-8; b=b<0?0:(b>48?48:b); nac.col0=b; }
  if(NA){ if(J.rpb){ for(int e=tid;e<465;e+=512)((__attribute__((address_space(3))) float*)(shm+LDS_BIAS))[64+e]=J.rpb[e]*1.4426950408889634f; } }
  DMA_K(0,0);DMA_V(0,0);DMA_K(1,SLOTB);
  bf16x8 qr[4];
  #pragma unroll
  for(int d0=0;d0<4;++d0)qr[d0]=*reinterpret_cast<const bf16x8*>(&Qw[(long)r32*UP+d0*16+hi*8]);
  float mhat=0.f,l_reg=0.f;f32x16 o[2];o[0]=f32x16{};o[1]=f32x16{};f32x16 negm=f32x16{}; if constexpr(!NA) asm volatile("":"+v"(negm));
  #define CMASK(P0,P1,t) do{ if constexpr(NA) namask(P0,P1,(t),nac,hi); }while(0)
  bool resc=false;
  #define START(P0,P1) do{ const float rm=rowmax(P0,P1); resc=false; \
    { const float dl=rm; mhat=fadd_s(mhat,dl); \
      _Pragma("unroll") for(int r=0;r<16;++r){P0[r]=fsub_s(P0[r],dl);P1[r]=fsub_s(P1[r],dl);} \
      if constexpr(!NA){ _Pragma("unroll") for(int r=0;r<16;++r)negm[r]=-mhat; asm volatile("":"+v"(negm)); } } \
    _Pragma("unroll") for(int r=0;r<16;++r)P0[r]=__builtin_amdgcn_exp2f(P0[r]); }while(0)
  #define RESC() do{ if(resc){ asm volatile("s_waitcnt lgkmcnt(0)":::"memory"); \
      _Pragma("unroll") for(int d_=0;d_<2;++d_) _Pragma("unroll") for(int r=0;r<16;++r)o[d_][r]*=wsf[crow(r,hi)]; } }while(0)
  f32x16 pA0,pA1,pB0,pB1;
  int sl_prev=0,sl_cur=0,sl_next=SLOTB;
  #define ROT() do{sl_prev=sl_cur;sl_cur=sl_next;sl_next=(sl_next==(NSLOT-1)*SLOTB)?0:sl_next+SLOTB;}while(0)
  DMA_K(2,2*SLOTB);
  WAIT_BAR(3);
  qkt(pA0,pA1,Kbase,qr,cinit<NA>(negm),r32,hi);asm volatile("s_nop 15\n\ts_nop 7":"+v"(pA0),"+v"(pA1));CMASK(pA0,pA1,0);
  START(pA0,pA1);
  _Pragma("unroll") for(int r=0;r<16;++r)pA1[r]=__builtin_amdgcn_exp2f(pA1[r]);
  WAIT_BAR(0);
  DMA_K(3,0);DMA_V(1,SLOTB);
  ROT();
  kload8(kf,kp0+sl_cur);
  WAIT_BAR(2);
  s16x4 vlo[8],vhi[8]; u32x4 pw0,pw1,pw2,pw3;
  #define PKW(P,B) cvtpk_s(P[B],P[B+1])
  #define PAF(k) __builtin_bit_cast(bf16x8,pw##k)
  #define VFR(i) (bf16x8){vlo[i][0],vlo[i][1],vlo[i][2],vlo[i][3],vhi[i][0],vhi[i][1],vhi[i][2],vhi[i][3]}
  #define PIN(x) asm volatile("":"+v"(x))
  #define MX3(a,b,c) __builtin_fmaxf(__builtin_fmaxf((a),(b)),(c))
  #define GAPA(MF,A0,A1,A2,A3,W0,W1,PW) do{ MF; sacc+=A0; sacc+=A1; sacc+=A2; sacc+=A3; PIN(sacc); W0; W1; PIN(PW); SBAR(); }while(0)
  #define EX(v) __builtin_amdgcn_exp2f(v)
  #define GAPB(MF,X,B) do{ MF; X[B]=EX(X[B]); X[B+1]=EX(X[B+1]); X[B+2]=EX(X[B+2]); X[B+3]=EX(X[B+3]); PIN(X); SBAR(); }while(0)
  #define VRD(i) do{ vlo[i]=vtr(vp_+(((i)>>2)*4096+((i)&3)*1024)); vhi[i]=vtr(vp_+(((i)>>2)*4096+((i)&3)*1024+512)); }while(0)
  #define KRD(G,j) do{ if(G){ kload2(kf,kp0+sl_next,j); SBAR(); } }while(0)
  #define STEP(C0,C1,P0,P1,t,GK,GV,GL) do{ SBAR(); \
    const lds_cptr vp_=vp0+sl_prev; \
    VRD(0); SBAR(); float sacc=(P0[0]+P0[1]); \
    GAPA(C0=__builtin_amdgcn_mfma_f32_32x32x16_bf16(kf[0],qr[0],cinit<NA>(negm),0,0,0), P0[2],P0[3],P0[4],P0[5],     pw0[0]=PKW(P0,0), pw0[1]=PKW(P0,2), pw0); \
    VRD(4); SBAR(); GAPA(C1=__builtin_amdgcn_mfma_f32_32x32x16_bf16(kf[1],qr[0],cinit<NA>(negm),0,0,0), P0[6],P0[7],P0[8],P0[9],     pw0[2]=PKW(P0,4), pw0[3]=PKW(P0,6), pw0); \
    VRD(1); SBAR(); GAPA(C0=__builtin_amdgcn_mfma_f32_32x32x16_bf16(kf[2],qr[1],C0,0,0,0),   P0[10],P0[11],P0[12],P0[13], pw1[0]=PKW(P0,8), pw1[1]=PKW(P0,10), pw1); \
    VRD(5); SBAR(); GAPA(C1=__builtin_amdgcn_mfma_f32_32x32x16_bf16(kf[3],qr[1],C1,0,0,0),   P0[14],P0[15],P1[0],P1[1],   pw1[2]=PKW(P0,12),pw1[3]=PKW(P0,14), pw1); \
    VRD(2); SBAR(); GAPA(C0=__builtin_amdgcn_mfma_f32_32x32x16_bf16(kf[4],qr[2],C0,0,0,0),   P1[2],P1[3],P1[4],P1[5],     pw2[0]=PKW(P1,0), pw2[1]=PKW(P1,2), pw2); \
    VRD(6); SBAR(); GAPA(C1=__builtin_amdgcn_mfma_f32_32x32x16_bf16(kf[5],qr[2],C1,0,0,0),   P1[6],P1[7],P1[8],P1[9],     pw2[2]=PKW(P1,4), pw2[3]=PKW(P1,6), pw2); \
    VRD(3); SBAR(); GAPA(C0=__builtin_amdgcn_mfma_f32_32x32x16_bf16(kf[6],qr[3],C0,0,0,0),   P1[10],P1[11],P1[12],P1[13], pw3[0]=PKW(P1,8), pw3[1]=PKW(P1,10), pw3); \
    VRD(7); SBAR(); GAPA(C1=__builtin_amdgcn_mfma_f32_32x32x16_bf16(kf[7],qr[3],C1,0,0,0),   P1[14],P1[15],0.f,0.f,       pw3[2]=PKW(P1,12),pw3[3]=PKW(P1,14), pw3); \
    l_reg+=sacc; \
    if(GK){DMA_K((t)+3,sl_cur);} if(GV){DMA_V((t)+1,sl_next);} \
    if constexpr(NA){ _Pragma("unroll") for(int r=0;r<16;++r){C0[r]-=mhat;C1[r]-=mhat;} } \
    CMASK(C0,C1,t); \
    { float a=MX3(C0[0],C0[1],C1[0]),b=MX3(C0[2],C0[3],C1[1]); a=MX3(a,C1[2],C1[3]); \
      _Pragma("unroll") for(int r=4;r<16;r+=4){a=MX3(a,C0[r],C0[r+1]);b=MX3(b,C0[r+2],C0[r+3]);a=MX3(a,C1[r],C1[r+1]);b=MX3(b,C1[r+2],C1[r+3]);} \
      float rm=__builtin_fmaxf(a,b); { auto rr=__builtin_amdgcn_permlane32_swap(__float_as_uint(rm),__float_as_uint(rm),false,false); rm=__builtin_fmaxf(__uint_as_float(rr[0]),__uint_as_float(rr[1])); } \
      resc=false; \
      if(__builtin_expect(__any(rm>(float)THRL),0)){ const float dl=__builtin_fmaxf(rm,0.f); mhat+=dl; \
        _Pragma("unroll") for(int r=0;r<16;++r){C0[r]-=dl;C1[r]-=dl;} \
        if constexpr(!NA){ _Pragma("unroll") for(int r=0;r<16;++r)negm[r]=-mhat; asm volatile("":"+v"(negm)); } \
        const float f=__builtin_amdgcn_exp2f(-dl); l_reg*=f; if(hi==0)wsf[r32]=f; resc=true; } } \
    SBAR(); \
    GAPB(o[0]=__builtin_amdgcn_mfma_f32_32x32x16_bf16(PAF(0),VFR(0),o[0],0,0,0), C0,0); \
    GAPB(o[1]=__builtin_amdgcn_mfma_f32_32x32x16_bf16(PAF(0),VFR(4),o[1],0,0,0), C0,4); \
    KRD(GL,0); GAPB(o[0]=__builtin_amdgcn_mfma_f32_32x32x16_bf16(PAF(1),VFR(1),o[0],0,0,0), C0,8); \
    KRD(GL,1); GAPB(o[1]=__builtin_amdgcn_mfma_f32_32x32x16_bf16(PAF(1),VFR(5),o[1],0,0,0), C0,12); \
    KRD(GL,2); GAPB(o[0]=__builtin_amdgcn_mfma_f32_32x32x16_bf16(PAF(2),VFR(2),o[0],0,0,0), C1,0); \
    KRD(GL,3); GAPB(o[1]=__builtin_amdgcn_mfma_f32_32x32x16_bf16(PAF(2),VFR(6),o[1],0,0,0), C1,4); \
    GAPB(o[0]=__builtin_amdgcn_mfma_f32_32x32x16_bf16(PAF(3),VFR(3),o[0],0,0,0), C1,8); \
    GAPB(o[1]=__builtin_amdgcn_mfma_f32_32x32x16_bf16(PAF(3),VFR(7),o[1],0,0,0), C1,12); \
    }while(0)
  int t=1;
  for(;t+5<NT;t+=2){
    STEP(pB0,pB1,pA0,pA1,t,true,true,true);     WAIT_BAR(2); RESC(); ROT();
    STEP(pA0,pA1,pB0,pB1,t+1,true,true,true);   WAIT_BAR(2); RESC(); ROT();
  }
  #define ENDW(tt) do{ if((tt)+3<NT){WAIT_BAR(2);} else if((tt)+2<NT){WAIT_BAR(1);} else {WAIT_BAR(0);} }while(0)
  for(;t+1<NT;t+=2){
    STEP(pB0,pB1,pA0,pA1,t,(t+3<NT),(t+1<NT),(t+1<NT));       ENDW(t);   RESC(); ROT();
    STEP(pA0,pA1,pB0,pB1,t+1,(t+4<NT),(t+2<NT),(t+2<NT));     ENDW(t+1); RESC(); ROT();
  }
  STEP(pB0,pB1,pA0,pA1,NT-1,false,false,false); RESC();
  { float sacc=pB0[0]+pB0[1]; _Pragma("unroll") for(int r=2;r<16;++r)sacc+=pB0[r]; _Pragma("unroll") for(int r=0;r<16;++r)sacc+=pB1[r]; l_reg+=sacc;
    pw0=(u32x4){PKW(pB0,0),PKW(pB0,2),PKW(pB0,4),PKW(pB0,6)};pw1=(u32x4){PKW(pB0,8),PKW(pB0,10),PKW(pB0,12),PKW(pB0,14)};pw2=(u32x4){PKW(pB1,0),PKW(pB1,2),PKW(pB1,4),PKW(pB1,6)};pw3=(u32x4){PKW(pB1,8),PKW(pB1,10),PKW(pB1,12),PKW(pB1,14)};
    SBAR(); pv(o,vb0+sl_cur,PAF(0),PAF(1),PAF(2),PAF(3)); }
  #undef PKW
  #undef PAF
  #undef VFR
  #undef PIN
  #undef MX3
  #undef GAPA
  #undef GAPB
  #undef EX
  #undef VRD
  #undef KRD
  #undef STEP
  #undef ENDW
  {auto rr=__builtin_amdgcn_permlane32_swap(__float_as_uint(l_reg),__float_as_uint(l_reg),false,false);l_reg=__uint_as_float(rr[0])+__uint_as_float(rr[1]);}
  if(hi==0)wsf[32+r32]=l_reg;asm volatile("s_waitcnt lgkmcnt(0)":::"memory");
  float rli[16];
  #pragma unroll
  for(int r=0;r<16;++r)rli[r]=__builtin_amdgcn_rcpf(wsf[32+crow(r,hi)]);
  bf16*Ow=J.MX+J.oo+(long)(wid*QBLK)*OP; const bf16*Gw=J.U+J.go+(long)(wid*QBLK)*UP;
  { bf16*stg=(bf16*)(shm+LDS_OST)+wid*2048;
    #pragma unroll
    for(int r=0;r<16;++r){const int orow=crow(r,hi);
      #pragma unroll
      for(int d0=0;d0<2;++d0)stg[orow*64+d0*32+r32]=__float2bfloat16(o[d0][r]*rli[r]);}
    asm volatile("s_waitcnt lgkmcnt(0)":::"memory");
    #pragma unroll
    for(int i=0;i<4;++i){const int row=i*8+(lane>>3),ch=lane&7; const u32x4 v=*(const u32x4*)(stg+row*64+ch*8); const u32x4 g=*(const u32x4*)(Gw+(long)row*UP+ch*8); ATTN_STORE16(Ow+(long)row*OP+ch*8,gate8(v,g));} }
  asm volatile("s_waitcnt lgkmcnt(0)\n\ts_barrier":::"memory");
  #undef DMA_K
  #undef TROW
  #undef DMA_V
  #undef CMASK
  #undef START
  #undef RESC
  #undef ROT
}
constexpr int ATTN_LDS_BYTES=LDS_BYTES;
__device__ __forceinline__ u32x4 gate8(u32x4 v,u32x4 g){ u32x4 r;
  #pragma unroll
  for(int i=0;i<4;++i){ const float a0=__uint_as_float(v[i]<<16)*__uint_as_float(g[i]<<16), a1=__uint_as_float(v[i]&0xffff0000u)*__uint_as_float(g[i]&0xffff0000u); r[i]=cvtpk_s(a0,a1); }
  return r; }
#undef SBAR
#undef WAIT_BAR
}
#define GAS __attribute__((address_space(1)))
#define LAS __attribute__((address_space(3)))
typedef GAS unsigned gu32;
#define RLX_AGENT __ATOMIC_RELAXED, __HIP_MEMORY_SCOPE_AGENT
#define XB_TMO      128
#define XB_XCNT(j)  (256  + 64 * (j))
#define XB_XSUB(j)  (1280 + 64 * (j))
#define XB_XGEN(j)  (2304 + 64 * (j))
#define XB_TOP      3328
#define XB_TOPGEN   3392
#define XCD_BAR_WORDS 3456
#define XB_SPIN_CAP (1u << 20)

__device__ __forceinline__ unsigned xb_ld(unsigned* p)              { return __hip_atomic_load(p, __ATOMIC_RELAXED, __HIP_MEMORY_SCOPE_AGENT); }
__device__ __forceinline__ unsigned xb_add(unsigned* p, unsigned v) { return __hip_atomic_fetch_add(p, v, __ATOMIC_RELAXED, __HIP_MEMORY_SCOPE_AGENT); }
__device__ __forceinline__ unsigned xb_xcc_id() { return (unsigned)__builtin_amdgcn_s_getreg((3 << 11) | 20) & 0xFu; }
#define XB_SPIN(cond, bar) do { unsigned _sp = 0; while (cond) { __builtin_amdgcn_s_sleep(1); \
    if ((++_sp & 255u) == 0u) { if (xb_ld(&(bar)[XB_TMO])) break; if (_sp > XB_SPIN_CAP) { atomicAdd(&(bar)[XB_TMO], 1u); break; } } } } while (0)

struct XcdBarrier {
    unsigned* bar; unsigned x;
    volatile LAS unsigned* st;
};

__device__ __forceinline__ XcdBarrier xcd_barrier_post(unsigned* bar, volatile LAS unsigned* st) {
    XcdBarrier b; b.bar = bar; b.x = xb_xcc_id(); b.st = st;
    if (threadIdx.x == 0) (void)xb_add(&bar[XB_XCNT(b.x)], 1u);
    return b;
}
__device__ __forceinline__ void xcd_barrier_complete(unsigned* bar, unsigned x, unsigned& nloc, unsigned& nx) {
    const unsigned G = gridDim.x * gridDim.y * gridDim.z;
    unsigned sum, cnt, mine, sp = 0u;
    for (;;) {
        sum = 0u; cnt = 0u; mine = 0u;
#pragma unroll
        for (unsigned j = 0; j < 16; ++j) { const unsigned c = xb_ld(&bar[XB_XCNT(j)]); sum += c; cnt += (c > 0u) ? 1u : 0u; mine = (j == x) ? c : mine; }
        if (sum == G) break;
        __builtin_amdgcn_s_sleep(1);
        if ((++sp & 255u) == 0u) { if (xb_ld(&bar[XB_TMO])) break; if (sp > XB_SPIN_CAP) { atomicAdd(&bar[XB_TMO], 1u); break; } }
    }
    nloc = mine > 0u ? mine : 1u; nx = cnt > 0u ? cnt : 1u;
}

__device__ __forceinline__ void xcd_barrier(const XcdBarrier& b) {
    asm volatile("s_waitcnt vmcnt(0)" ::: "memory");
    __syncthreads();
    if (threadIdx.x == 0) {
        unsigned* bar = b.bar;
        __builtin_amdgcn_s_waitcnt(0);
        unsigned nloc = b.st[0], nx = b.st[1];
        if (nloc == 0u) { xcd_barrier_complete(bar, b.x, nloc, nx); b.st[0] = nloc; b.st[1] = nx; }
        const unsigned old = xb_add(&bar[XB_XSUB(b.x)], 1u);
        const unsigned gen = old / nloc;
        if (old + 1u == (gen + 1u) * nloc) {
            __builtin_amdgcn_fence(__ATOMIC_RELEASE, "agent");
            asm volatile("s_waitcnt vmcnt(0)" ::: "memory");
            const unsigned og = xb_add(&bar[XB_TOP], 1u);
            const unsigned tg = og / nx;
            if (og + 1u == (tg + 1u) * nx) xb_add(&bar[XB_TOPGEN], 1u);
            else XB_SPIN(xb_ld(&bar[XB_TOPGEN]) == tg, bar);
            __builtin_amdgcn_fence(__ATOMIC_ACQUIRE, "agent");
            xb_add(&bar[XB_XGEN(b.x)], 1u);
            asm volatile("s_waitcnt vmcnt(0)" ::: "memory");
        } else {
            XB_SPIN(xb_ld(&bar[XB_XGEN(b.x)]) == gen, bar);
            __builtin_amdgcn_fence(__ATOMIC_ACQUIRE, "agent");
            asm volatile("s_waitcnt vmcnt(0)" ::: "memory");
        }
    }
    __syncthreads();
}

constexpr int CW_BAR = 4096;
__device__ __forceinline__ void ph_attention(const Ctx& C, int i, unsigned char* lds) {
    using namespace attn_body;
    const bf16* U = (const bf16*)(C.ws + WS_U); bf16* MX = (bf16*)(C.ws + WS_XN);
    const float* rpb = C.in[I_RPB] + (size_t)i * 8 * 465;
    for (int p = C.vcu; p < 1040; p += C.G) {
        int kind, h, qb;
        if (p < 512) { kind = 0; h = (p & 255) >> 5; qb = (p & 31) + 32 * (p >> 8); }
        else if (p < 1024) { kind = 1; const int q = p - 512; h = (q & 255) >> 5; qb = (q & 31) + 32 * (q >> 8); }
        else if (p < 1032) { kind = 0; h = p - 1024; qb = 64; }
        else { kind = 1; h = p - 1032; qb = 64; }
        const unsigned r0 = 256u * (unsigned)qb;
        AJob J; J.U = U; J.MX = MX;
        if (kind == 0) {
            J.qo = r0 * AIN + 2048 + 64 * h; J.ko = 2560 + 64 * (h >> 2); J.vo = 2688 + 64 * (h >> 2); J.oo = r0 * DM + 512 + 64 * h; J.go = r0 * AIN + 2816 + 64 * h;
            if (qb < 64) { J.NT = 260; J.tile0a = 0; J.na = 260; J.tile0b = 0; } else { J.NT = 4; J.tile0a = 256; J.na = 4; J.tile0b = 0; }
            J.qr0 = 0; J.rmin = 0; J.rpb = nullptr;
            attn_unit<8, false>(J, (char*)lds);
        } else {
            J.qo = r0 * AIN + 64 * h; J.ko = 512 + 64 * h; J.vo = 1024 + 64 * h; J.oo = r0 * DM + 64 * h; J.go = r0 * AIN + 1536 + 64 * h;
            J.tile0a = 256; J.na = 4; J.qr0 = 4 * qb;
            if (qb < 64) { int rm = 4 * qb - 4; rm = rm < 0 ? 0 : (rm > 248 ? 248 : rm); J.NT = 16; J.tile0b = rm; J.rmin = rm; J.rpb = rpb + (size_t)h * 465; }
            else { J.NT = 4; J.tile0b = 0; J.rmin = 0; J.rpb = nullptr; }
            attn_unit<8, true>(J, (char*)lds);
        }
    }
}

#ifdef TSEL
__device__ __forceinline__ void ph_final_t(const Ctx& C) {
    ph_final(C);
    __syncthreads();
    const unsigned long long* st = (const unsigned long long*)(C.ws + WS_CTL + 32768);
    unsigned long long t[24]; for (int k = 0; k < 24; ++k) t[k] = __hip_atomic_load(st + k, __ATOMIC_RELAXED, __HIP_MEMORY_SCOPE_AGENT);
    double sel = 0.0; for (int k = 0; k < 23; ++k) if ((TSEL >> k) & 1ull) sel += (double)(t[k + 1] - t[k]);
    double tot = (double)(t[23] - t[0]);
#ifdef TXS
    { const unsigned long long x = __hip_atomic_load(st + TXS, __ATOMIC_RELAXED, __HIP_MEMORY_SCOPE_AGENT); sel = (double)(x - t[20]); tot = (double)(t[21] - t[20]); }
#ifdef TXD
    { const unsigned long long x = __hip_atomic_load(st + TXS, __ATOMIC_RELAXED, __HIP_MEMORY_SCOPE_AGENT); sel = (double)x; tot = (double)(t[21] - t[20]); }
#endif
#endif
    const float eps = sqrtf(0.0012f * (float)(sel / tot));
    const int gw = C.vcu * NWAVES + C.wave, NGW = C.G * NWAVES;
    for (int m = gw; m < NLAT; m += NGW) { float* xr = C.out + (size_t)m * DM; for (int j = 0; j < 16; ++j) xr[64 * j + C.lane] *= (1.0f + eps); }
}
#else
__device__ __forceinline__ void ph_final_t(const Ctx& C) { ph_final(C); }
#endif
struct Args { const float* in[N_IN]; float* out; unsigned char* ws; int ph_lo, ph_hi; };
typedef __attribute__((address_space(4))) const Args* KArgP;
__global__ void __launch_bounds__(NTHREADS, 2) mk_fwd(Args args) {
    extern __shared__ __attribute__((aligned(16))) unsigned char lds[];
    volatile LAS unsigned* MISC = (volatile LAS unsigned*)((LAS unsigned char*)lds + MISC_OFF);
    if (threadIdx.x < 64) MISC[threadIdx.x] = 0u;
    __syncthreads();
    XcdBarrier bar = xcd_barrier_post((unsigned*)(args.ws + WS_CTL) + CW_BAR, MISC + 8);
    const int lo = args.ph_lo, hi = args.ph_hi;
    int pc = 0;
#ifdef TSEL
#define STAMP(k) do { if (blockIdx.x == 0 && threadIdx.x == 0) __hip_atomic_store((unsigned long long*)(args.ws + WS_CTL + 32768) + (k), (unsigned long long)__builtin_amdgcn_s_memrealtime(), __ATOMIC_RELAXED, __HIP_MEMORY_SCOPE_AGENT); } while (0)
#else
#define STAMP(k) do {} while (0)
#endif
    STAMP(0);
#define PHASE(...) do { if (pc >= lo && pc < hi) { KArgP ap = (KArgP)__builtin_amdgcn_kernarg_segment_ptr(); asm volatile("" : "+s"(ap)); Ctx C; \
        _Pragma("unroll") for (int k = 0; k < N_IN; ++k) C.in[k] = ap->in[k]; C.out = ap->out; C.ws = ap->ws; \
        { int t_ = threadIdx.x; asm volatile("" : "+v"(t_)); C.tid = t_; } C.lane = C.tid & 63; C.wave = __builtin_amdgcn_readfirstlane(C.tid >> 6); \
        C.G = gridDim.x; { const int bx = blockIdx.x; C.vcu = (C.G % 8 == 0) ? (bx % 8) * (C.G / 8) + bx / 8 : bx; } \
        float* XCTX = (float*)(C.ws + WS_XCTX); unsigned char* ldsg = (unsigned char*)lds; unsigned char* wsp = C.ws; (void)XCTX; (void)ldsg; (void)wsp; \
        const float* xl = layer == 0 ? C.in[I_X] : C.out; const float* xc = layer == 0 ? C.in[I_CTX] : XCTX; (void)xl; (void)xc; \
        const float* ADA = (const float*)(C.ws + WS_ADA) + (size_t)layer * 2 * 3072; (void)ADA; \
        __VA_ARGS__; if (pc + 1 < hi) xcd_barrier(bar); STAMP(pc + 1); } ++pc; } while (0)
#ifndef PH_MASK
#define PH_MASK 0xFFFF
#endif
#define EN(b) if ((PH_MASK >> (b)) & 1)

    { const int layer = 0; PHASE(EN(0) ph_prologue(C, ldsg)); }
    for (int layer = 0; layer < 4; ++layer) {
        const int i = layer >> 1;
        const bool ctx_out = layer < 3;
        PHASE(EN(1) ph_norm(C, layer, xl, xc, true));
        if ((layer & 1) == 0) {
            PHASE(EN(2) { pg8::Gemm g{(const pg8::bf16_t*)(wsp + WS_XN), (const pg8::bf16_t*)(wsp + WS_XN) + DM / 2, DM, (const pg8::bf16_t*)(wsp + WS_WAIN) + (size_t)i * AIN * DM, NTOK, AIN, DM};
                    pg8::StaticOrder S; S.init(NTOK, AIN, C.G, (int)blockIdx.x); pg8::EpiIn<0> E{wsp};
                    pg8::gemm_phase<pg8::EpiIn<0>, pg8::StaticOrder, true, true>((LAS unsigned char*)lds, g, S, E); });
            PHASE(EN(3) ph_qkprep(C, i));
            PHASE(EN(4) ph_attention(C, i, ldsg));
            PHASE(EN(5) { pg8::Gemm g{(const pg8::bf16_t*)(wsp + WS_XN), (const pg8::bf16_t*)(wsp + WS_XN) + DM / 2, DM, (const pg8::bf16_t*)(wsp + WS_WAOUT) + (size_t)i * DM * DM, NLAT, DM, DM};
                    pg8::StaticOrder S; S.init(NLAT, DM, C.G, (int)blockIdx.x); pg8::EpiRes E{xl, xc, C.out, XCTX, ADA + 2048, ADA + 3072 + 2048};
                    pg8::gemm_phase<pg8::EpiRes, pg8::StaticOrder, true, true>((LAS unsigned char*)lds, g, S, E);
                    ctx_outproj(C, (const bf16_t*)(wsp + WS_XN) + (size_t)NLAT * DM, (const bf16_t*)(wsp + WS_XN) + (size_t)NLAT * DM + 512, DM, (const bf16_t*)(wsp + WS_WAOUT) + (size_t)i * DM * DM, ADA + 3072 + 2048, xc, XCTX); });
        } else {
            PHASE(EN(6) { pg8::Gemm g{(const pg8::bf16_t*)(wsp + WS_XN), (const pg8::bf16_t*)(wsp + WS_XN) + DM / 2, DM, (const pg8::bf16_t*)(wsp + WS_WRIN) + (size_t)i * RINP * DM, NTOK, RINP, DM};
                    pg8::StaticOrder S; S.init(NTOK, RINP, C.G, (int)blockIdx.x); pg8::EpiIn<1> E{wsp};
                    pg8::gemm_phase<pg8::EpiIn<1>, pg8::StaticOrder, true, true>((LAS unsigned char*)lds, g, S, E); });
            PHASE(EN(7) ph_hyprep(C, i, ctx_out, ldsg));
            PHASE(EN(8) ph_scan_hyena(C, i, ctx_out, ldsg));
            PHASE(EN(9) ph_readout_hyout(C, i, ctx_out, ldsg));
            const int Mo = NLAT;
            PHASE(EN(10) { pg8::Gemm g{(const pg8::bf16_t*)(wsp + WS_YF), (const pg8::bf16_t*)(wsp + WS_HYOUT), 512, (const pg8::bf16_t*)(wsp + WS_WROUT) + (size_t)i * DM * DM, Mo, DM, DM};
                    pg8::StaticOrder S; S.init(Mo, DM, C.G, (int)blockIdx.x); pg8::EpiRes E{xl, xc, C.out, XCTX, ADA + 2048, ADA + 3072 + 2048};
                    pg8::gemm_phase<pg8::EpiRes, pg8::StaticOrder, true, true>((LAS unsigned char*)lds, g, S, E);
                    if (ctx_out) ctx_outproj(C, (const bf16_t*)(wsp + WS_YF) + (size_t)NLAT * 512, (const bf16_t*)(wsp + WS_HYOUT) + (size_t)NLAT * 512, 512, (const bf16_t*)(wsp + WS_WROUT) + (size_t)i * DM * DM, ADA + 3072 + 2048, xc, XCTX); });
        }
    }
    { const int layer = 3; PHASE(EN(11) ph_final_t(C)); }
#undef PHASE
}
constexpr int N_PHASES = 1 + 2 * 5 + 2 * 6 + 1;

#ifndef MK_SPLIT
#define MK_SPLIT 0
#endif
extern "C" void kernel_launch(void* const* d_in, const int* in_sizes, int n_in, void* d_out, int out_size, void* d_ws, size_t ws_size, hipStream_t stream) {
    static int grid = 0;
    if (grid == 0) {
        if (n_in != N_IN || out_size != NLAT * DM || ws_size < WS_END) { fprintf(stderr, "kernel_launch: unexpected shapes (n_in %d out %d ws %zu)\n", n_in, out_size, ws_size); grid = -1; return; }
        int dev = 0, cus = 0, per_cu = 0;
        if (hipGetDevice(&dev) != hipSuccess || hipDeviceGetAttribute(&cus, hipDeviceAttributeMultiprocessorCount, dev) != hipSuccess) { grid = -1; return; }
        if (hipFuncSetAttribute((const void*)mk_fwd, hipFuncAttributeMaxDynamicSharedMemorySize, LDS_BYTES) != hipSuccess) { fprintf(stderr, "kernel_launch: hipFuncSetAttribute failed\n"); grid = -1; return; }
        if (hipOccupancyMaxActiveBlocksPerMultiprocessor(&per_cu, (const void*)mk_fwd, NTHREADS, LDS_BYTES) != hipSuccess || per_cu < 1) fprintf(stderr, "kernel_launch: occupancy query says %d\n", per_cu);
        (void)hipGetLastError();
        grid = cus;
    }
    if (grid < 0) return;
    (void)hipMemsetAsync((char*)d_ws + WS_CTL, 0, CTL_ZERO_BYTES, stream);
    Args a{};
    for (int k = 0; k < N_IN; ++k) a.in[k] = (const float*)d_in[k];
    a.out = (float*)d_out; a.ws = (unsigned char*)d_ws;
#if MK_SPLIT
    for (int p = 0; p < N_PHASES; ++p) { a.ph_lo = p; a.ph_hi = p + 1; hipLaunchKernelGGL(mk_fwd, dim3(grid), dim3(NTHREADS), LDS_BYTES, stream, a); }
#else
    a.ph_lo = 0; a.ph_hi = N_PHASES;
    hipLaunchKernelGGL(mk_fwd, dim3(grid), dim3(NTHREADS), LDS_BYTES, stream, a);
#endif
}
```

```cpp
#ifndef EMU
#include <hip/hip_runtime.h>
#endif
#include <cstdio>
#include <cstdint>
#include <cmath>

constexpr int DM = 1024, NLAT = 16384, NCTX = 256, NTOK = NLAT + NCTX;
constexpr int GRIDW = 64, GRIDH = 256;
constexpr int AIN = 3328;
constexpr int RIN = 4224, RINP = 4352;
constexpr int URW_W = 2176;
constexpr int UHY_W = 1536;
constexpr int NWAVES = 8, NTHREADS = 512;
constexpr float C2 = 0.125f * 1.4426950408889634f;
constexpr float LOG2E = 1.4426950408889634f;
constexpr float NORM_EPS = 1e-6f;

typedef unsigned short bf16_t;

constexpr size_t MiB = 1u << 20;
constexpr size_t WS_CTL = 0, CTL_ZERO_BYTES = 256 * 1024;
constexpr size_t WS_ADA = 1 * MiB;
constexpr size_t WS_TW = WS_ADA + 128 * 1024;
constexpr size_t WS_HID256 = WS_TW + 160 * 1024;
constexpr size_t WS_BONUS = WS_HID256 + 64 * 1024;
constexpr size_t WS_XCTX = 3 * MiB;
constexpr size_t WS_VXC = 4 * MiB;
constexpr size_t WS_HID = 6 * MiB;
constexpr size_t WS_WAIN = 14 * MiB;
constexpr size_t WS_WAOUT = 27 * MiB;
constexpr size_t WS_WRIN = 31 * MiB;
constexpr size_t WS_WROUT = 48 * MiB;
constexpr size_t WS_XN = 52 * MiB;
constexpr size_t WS_U = 85 * MiB;
constexpr size_t WS_UHY = 155 * MiB;
constexpr size_t WS_GHY = 204 * MiB;
constexpr size_t WS_VX0 = 52 * MiB, WS_VX1 = 68 * MiB;
constexpr size_t WS_VX2 = 221 * MiB;
constexpr size_t WS_YHY = 155 * MiB;
constexpr size_t WS_YB = 171 * MiB;
constexpr size_t WS_YF = 187 * MiB + 512 * 1024;
constexpr size_t WS_HYOUT = 238 * MiB;
constexpr size_t WS_END = 256 * MiB;
static_assert(WS_U + (size_t)NTOK * AIN * 2 <= WS_END, "U attn");
static_assert(WS_U + (size_t)NTOK * URW_W * 2 <= WS_UHY && WS_UHY + (size_t)NTOK * UHY_W * 2 <= WS_GHY && WS_GHY + (size_t)NTOK * 512 * 2 <= WS_VX2, "rec map 1");
static_assert(WS_VX2 + (size_t)512 * 16384 * 2 <= WS_HYOUT && WS_HYOUT + (size_t)NTOK * 512 * 2 <= WS_END, "rec map 2");
static_assert(WS_YHY + (size_t)512 * 16384 * 2 <= WS_YB && WS_YB + (size_t)NTOK * 512 * 2 <= WS_YF && WS_YF + (size_t)NTOK * 512 * 2 <= WS_GHY, "rec map 3");
static_assert(WS_XN + (size_t)NTOK * DM * 2 <= WS_U && WS_VX1 + (size_t)512 * 16384 * 2 <= WS_U, "xn map");

constexpr int LDS_BYTES = 160 * 1024;
constexpr int MISC_OFF = LDS_BYTES - 256;
constexpr int RING_BYTES = MISC_OFF;

#ifdef EMU
#define DEVFN inline
#else
#define DEVFN __device__ __forceinline__
#endif

DEVFN float bf2f(bf16_t h) { union { unsigned u; float f; } x; x.u = ((unsigned)h) << 16; return x.f; }
#ifdef EMU
DEVFN unsigned f2bf(float f) { union { unsigned u; float f; } x; x.f = f; unsigned u = x.u; return (u + 0x7fffu + ((u >> 16) & 1u)) >> 16; }
DEVFN unsigned pk2(float lo, float hi) { return f2bf(lo) | (f2bf(hi) << 16); }
#else
typedef float f32x2_hw __attribute__((ext_vector_type(2))); typedef __bf16 bf16x2_hw __attribute__((ext_vector_type(2)));
DEVFN unsigned pk2(float lo, float hi) { f32x2_hw v = {lo, hi}; bf16x2_hw b = __builtin_convertvector(v, bf16x2_hw); return __builtin_bit_cast(unsigned, b); }
DEVFN unsigned f2bf(float f) { return pk2(f, 0.f) & 0xffffu; }
#endif
DEVFN float bflo(unsigned w) { union { unsigned u; float f; } x; x.u = w << 16; return x.f; }
DEVFN float bfhi(unsigned w) { union { unsigned u; float f; } x; x.u = w & 0xffff0000u; return x.f; }
struct U4 { unsigned x, y, z, w; };
struct U2 { unsigned x, y; };
struct F2 { float x, y; };
struct F4 { float x, y, z, w; };
DEVFN float silu_f(float v) { return v / (1.0f + expf(-v)); }
DEVFN float sigmoid_f(float v) { return 1.0f / (1.0f + expf(-v)); }
#define SCAN_CHUNK_ASM \
    "ds_read_b128 v[96:99], %[ab] offset:24576\n\t" \
    "ds_read_b128 v[100:103], %[ab] offset:0\n\t" \
    "ds_read_b128 v[104:107], %[ab] offset:16384\n\t" \
    "ds_read_b128 v[108:111], %[ab] offset:8192\n\t" \
    "ds_read_b128 v[112:115], %[ab] offset:32768\n\t" \
    "ds_read_b32 v116, %[av] offset:0\n\t" \
    "s_waitcnt lgkmcnt(0)\n\t" \
    "ds_read_b128 v[118:121], %[ab] offset:24832\n\t" \
    "ds_read_b128 v[122:125], %[ab] offset:256\n\t" \
    "ds_read_b128 v[126:129], %[ab] offset:16640\n\t" \
    "ds_read_b128 v[130:133], %[ab] offset:8448\n\t" \
    "ds_read_b128 v[134:137], %[ab] offset:33024\n\t" \
    "ds_read_b32 v138, %[av] offset:64\n\t" \
    "v_pk_mul_f32 v[140:141], %[s01], v[96:97]\n\t" \
    "v_pk_fma_f32 v[140:141], %[s23], v[98:99], v[140:141]\n\t" \
    "v_add_f32 v146, v140, v141\n\t" \
    "v_pk_mul_f32 v[142:143], %[s01], v[100:101]\n\t" \
    "v_pk_mul_f32 v[144:145], %[s23], v[102:103]\n\t" \
    "v_add_f32_dpp v146, v146, v146 quad_perm:[1,0,3,2] row_mask:0xf bank_mask:0xf bound_ctrl:1\n\t" \
    "v_add_f32_dpp %[yp], %[yp], %[yp] quad_perm:[1,0,3,2] row_mask:0xf bank_mask:0xf bound_ctrl:1\n\t" \
    "v_pk_fma_f32 v[142:143], v[116:117], v[108:109], v[142:143] op_sel_hi:[0,1,1]\n\t" \
    "v_add_f32_dpp v146, v146, v146 quad_perm:[2,3,0,1] row_mask:0xf bank_mask:0xf bound_ctrl:1\n\t" \
    "v_add_f32_dpp %[yp], %[yp], %[yp] quad_perm:[2,3,0,1] row_mask:0xf bank_mask:0xf bound_ctrl:1\n\t" \
    "v_pk_fma_f32 v[144:145], v[116:117], v[110:111], v[144:145] op_sel_hi:[0,1,1]\n\t" \
    "v_add_f32_dpp v146, v146, v146 row_half_mirror row_mask:0xf bank_mask:0xf bound_ctrl:1\n\t" \
    "v_add_f32_dpp %[yp], %[yp], %[yp] row_half_mirror row_mask:0xf bank_mask:0xf bound_ctrl:1\n\t" \
    "v_cmp_eq_u32_e32 vcc, 15, %[sp]\n\t" \
    "v_add_f32_dpp v146, v146, v146 row_mirror row_mask:0xf bank_mask:0xf bound_ctrl:1\n\t" \
    "v_add_f32_dpp %[yp], %[yp], %[yp] row_mirror row_mask:0xf bank_mask:0xf bound_ctrl:1\n\t" \
    "v_cndmask_b32_e32 %[yk0], %[yk0], %[yp], vcc\n\t" \
    "v_pk_fma_f32 %[s01], v[146:147], v[104:105], v[142:143] op_sel_hi:[0,1,1] neg_lo:[1,0,0] neg_hi:[1,0,0]\n\t" \
    "v_pk_fma_f32 %[s23], v[146:147], v[106:107], v[144:145] op_sel_hi:[0,1,1] neg_lo:[1,0,0] neg_hi:[1,0,0]\n\t" \
    "v_pk_mul_f32 v[140:141], %[s01], v[112:113]\n\t" \
    "v_pk_fma_f32 v[140:141], %[s23], v[114:115], v[140:141]\n\t" \
    "v_add_f32 %[yp], v140, v141\n\t" \
    "s_waitcnt lgkmcnt(0)\n\t" \
    "ds_read_b128 v[96:99], %[ab] offset:25088\n\t" \
    "ds_read_b128 v[100:103], %[ab] offset:512\n\t" \
    "ds_read_b128 v[104:107], %[ab] offset:16896\n\t" \
    "ds_read_b128 v[108:111], %[ab] offset:8704\n\t" \
    "ds_read_b128 v[112:115], %[ab] offset:33280\n\t" \
    "ds_read_b32 v116, %[av] offset:128\n\t" \
    "v_pk_mul_f32 v[140:141], %[s01], v[118:119]\n\t" \
    "v_pk_fma_f32 v[140:141], %[s23], v[120:121], v[140:141]\n\t" \
    "v_add_f32 v146, v140, v141\n\t" \
    "v_pk_mul_f32 v[142:143], %[s01], v[122:123]\n\t" \
    "v_pk_mul_f32 v[144:145], %[s23], v[124:125]\n\t" \
    "v_add_f32_dpp v146, v146, v146 quad_perm:[1,0,3,2] row_mask:0xf bank_mask:0xf bound_ctrl:1\n\t" \
    "v_add_f32_dpp %[yp], %[yp], %[yp] quad_perm:[1,0,3,2] row_mask:0xf bank_mask:0xf bound_ctrl:1\n\t" \
    "v_pk_fma_f32 v[142:143], v[138:139], v[130:131], v[142:143] op_sel_hi:[0,1,1]\n\t" \
    "v_add_f32_dpp v146, v146, v146 quad_perm:[2,3,0,1] row_mask:0xf bank_mask:0xf bound_ctrl:1\n\t" \
    "v_add_f32_dpp %[yp], %[yp], %[yp] quad_perm:[2,3,0,1] row_mask:0xf bank_mask:0xf bound_ctrl:1\n\t" \
    "v_pk_fma_f32 v[144:145], v[138:139], v[132:133], v[144:145] op_sel_hi:[0,1,1]\n\t" \
    "v_add_f32_dpp v146, v146, v146 row_half_mirror row_mask:0xf bank_mask:0xf bound_ctrl:1\n\t" \
    "v_add_f32_dpp %[yp], %[yp], %[yp] row_half_mirror row_mask:0xf bank_mask:0xf bound_ctrl:1\n\t" \
    "v_cmp_eq_u32_e32 vcc, 0, %[sp]\n\t" \
    "v_add_f32_dpp v146, v146, v146 row_mirror row_mask:0xf bank_mask:0xf bound_ctrl:1\n\t" \
    "v_add_f32_dpp %[yp], %[yp], %[yp] row_mirror row_mask:0xf bank_mask:0xf bound_ctrl:1\n\t" \
    "v_cndmask_b32_e32 %[yk0], %[yk0], %[yp], vcc\n\t" \
    "v_pk_fma_f32 %[s01], v[146:147], v[126:127], v[142:143] op_sel_hi:[0,1,1] neg_lo:[1,0,0] neg_hi:[1,0,0]\n\t" \
    "v_pk_fma_f32 %[s23], v[146:147], v[128:129], v[144:145] op_sel_hi:[0,1,1] neg_lo:[1,0,0] neg_hi:[1,0,0]\n\t" \
    "v_pk_mul_f32 v[140:141], %[s01], v[134:135]\n\t" \
    "v_pk_fma_f32 v[140:141], %[s23], v[136:137], v[140:141]\n\t" \
    "v_add_f32 %[yp], v140, v141\n\t" \
    "s_waitcnt lgkmcnt(0)\n\t" \
    "ds_read_b128 v[118:121], %[ab] offset:25344\n\t" \
    "ds_read_b128 v[122:125], %[ab] offset:768\n\t" \
    "ds_read_b128 v[126:129], %[ab] offset:17152\n\t" \
    "ds_read_b128 v[130:133], %[ab] offset:8960\n\t" \
    "ds_read_b128 v[134:137], %[ab] offset:33536\n\t" \
    "ds_read_b32 v138, %[av] offset:192\n\t" \
    "v_pk_mul_f32 v[140:141], %[s01], v[96:97]\n\t" \
    "v_pk_fma_f32 v[140:141], %[s23], v[98:99], v[140:141]\n\t" \
    "v_add_f32 v146, v140, v141\n\t" \
    "v_pk_mul_f32 v[142:143], %[s01], v[100:101]\n\t" \
    "v_pk_mul_f32 v[144:145], %[s23], v[102:103]\n\t" \
    "v_add_f32_dpp v146, v146, v146 quad_perm:[1,0,3,2] row_mask:0xf bank_mask:0xf bound_ctrl:1\n\t" \
    "v_add_f32_dpp %[yp], %[yp], %[yp] quad_perm:[1,0,3,2] row_mask:0xf bank_mask:0xf bound_ctrl:1\n\t" \
    "v_pk_fma_f32 v[142:143], v[116:117], v[108:109], v[142:143] op_sel_hi:[0,1,1]\n\t" \
    "v_add_f32_dpp v146, v146, v146 quad_perm:[2,3,0,1] row_mask:0xf bank_mask:0xf bound_ctrl:1\n\t" \
    "v_add_f32_dpp %[yp], %[yp], %[yp] quad_perm:[2,3,0,1] row_mask:0xf bank_mask:0xf bound_ctrl:1\n\t" \
    "v_pk_fma_f32 v[144:145], v[116:117], v[110:111], v[144:145] op_sel_hi:[0,1,1]\n\t" \
    "v_add_f32_dpp v146, v146, v146 row_half_mirror row_mask:0xf bank_mask:0xf bound_ctrl:1\n\t" \
    "v_add_f32_dpp %[yp], %[yp], %[yp] row_half_mirror row_mask:0xf bank_mask:0xf bound_ctrl:1\n\t" \
    "v_cmp_eq_u32_e32 vcc, 1, %[sp]\n\t" \
    "v_add_f32_dpp v146, v146, v146 row_mirror row_mask:0xf bank_mask:0xf bound_ctrl:1\n\t" \
    "v_add_f32_dpp %[yp], %[yp], %[yp] row_mirror row_mask:0xf bank_mask:0xf bound_ctrl:1\n\t" \
    "v_cndmask_b32_e32 %[yk0], %[yk0], %[yp], vcc\n\t" \
    "v_pk_fma_f32 %[s01], v[146:147], v[104:105], v[142:143] op_sel_hi:[0,1,1] neg_lo:[1,0,0] neg_hi:[1,0,0]\n\t" \
    "v_pk_fma_f32 %[s23], v[146:147], v[106:107], v[144:145] op_sel_hi:[0,1,1] neg_lo:[1,0,0] neg_hi:[1,0,0]\n\t" \
    "v_pk_mul_f32 v[140:141], %[s01], v[112:113]\n\t" \
    "v_pk_fma_f32 v[140:141], %[s23], v[114:115], v[140:141]\n\t" \
    "v_add_f32 %[yp], v140, v141\n\t" \
    "s_waitcnt lgkmcnt(0)\n\t" \
    "ds_read_b128 v[96:99], %[ab] offset:25600\n\t" \
    "ds_read_b128 v[100:103], %[ab] offset:1024\n\t" \
    "ds_read_b128 v[104:107], %[ab] offset:17408\n\t" \
    "ds_read_b128 v[108:111], %[ab] offset:9216\n\t" \
    "ds_read_b128 v[112:115], %[ab] offset:33792\n\t" \
    "ds_read_b32 v116, %[av] offset:256\n\t" \
    "v_pk_mul_f32 v[140:141], %[s01], v[118:119]\n\t" \
    "v_pk_fma_f32 v[140:141], %[s23], v[120:121], v[140:141]\n\t" \
    "v_add_f32 v146, v140, v141\n\t" \
    "v_pk_mul_f32 v[142:143], %[s01], v[122:123]\n\t" \
    "v_pk_mul_f32 v[144:145], %[s23], v[124:125]\n\t" \
    "v_add_f32_dpp v146, v146, v146 quad_perm:[1,0,3,2] row_mask:0xf bank_mask:0xf bound_ctrl:1\n\t" \
    "v_add_f32_dpp %[yp], %[yp], %[yp] quad_perm:[1,0,3,2] row_mask:0xf bank_mask:0xf bound_ctrl:1\n\t" \
    "v_pk_fma_f32 v[142:143], v[138:139], v[130:131], v[142:143] op_sel_hi:[0,1,1]\n\t" \
    "v_add_f32_dpp v146, v146, v146 quad_perm:[2,3,0,1] row_mask:0xf bank_mask:0xf bound_ctrl:1\n\t" \
    "v_add_f32_dpp %[yp], %[yp], %[yp] quad_perm:[2,3,0,1] row_mask:0xf bank_mask:0xf bound_ctrl:1\n\t" \
    "v_pk_fma_f32 v[144:145], v[138:139], v[132:133], v[144:145] op_sel_hi:[0,1,1]\n\t" \
    "v_add_f32_dpp v146, v146, v146 row_half_mirror row_mask:0xf bank_mask:0xf bound_ctrl:1\n\t" \
    "v_add_f32_dpp %[yp], %[yp], %[yp] row_half_mirror row_mask:0xf bank_mask:0xf bound_ctrl:1\n\t" \
    "v_cmp_eq_u32_e32 vcc, 2, %[sp]\n\t" \
    "v_add_f32_dpp v146, v146, v146 row_mirror row_mask:0xf bank_mask:0xf bound_ctrl:1\n\t" \
    "v_add_f32_dpp %[yp], %[yp], %[yp] row_mirror row_mask:0xf bank_mask:0xf bound_ctrl:1\n\t" \
    "v_cndmask_b32_e32 %[yk0], %[yk0], %[yp], vcc\n\t" \
    "v_pk_fma_f32 %[s01], v[146:147], v[126:127], v[142:143] op_sel_hi:[0,1,1] neg_lo:[1,0,0] neg_hi:[1,0,0]\n\t" \
    "v_pk_fma_f32 %[s23], v[146:147], v[128:129], v[144:145] op_sel_hi:[0,1,1] neg_lo:[1,0,0] neg_hi:[1,0,0]\n\t" \
    "v_pk_mul_f32 v[140:141], %[s01], v[134:135]\n\t" \
    "v_pk_fma_f32 v[140:141], %[s23], v[136:137], v[140:141]\n\t" \
    "v_add_f32 %[yp], v140, v141\n\t" \
    "s_waitcnt lgkmcnt(0)\n\t" \
    "ds_read_b128 v[118:121], %[ab] offset:25856\n\t" \
    "ds_read_b128 v[122:125], %[ab] offset:1280\n\t" \
    "ds_read_b128 v[126:129], %[ab] offset:17664\n\t" \
    "ds_read_b128 v[130:133], %[ab] offset:9472\n\t" \
    "ds_read_b128 v[134:137], %[ab] offset:34048\n\t" \
    "ds_read_b32 v138, %[av] offset:320\n\t" \
    "v_pk_mul_f32 v[140:141], %[s01], v[96:97]\n\t" \
    "v_pk_fma_f32 v[140:141], %[s23], v[98:99], v[140:141]\n\t" \
    "v_add_f32 v146, v140, v141\n\t" \
    "v_pk_mul_f32 v[142:143], %[s01], v[100:101]\n\t" \
    "v_pk_mul_f32 v[144:145], %[s23], v[102:103]\n\t" \
    "v_add_f32_dpp v146, v146, v146 quad_perm:[1,0,3,2] row_mask:0xf bank_mask:0xf bound_ctrl:1\n\t" \
    "v_add_f32_dpp %[yp], %[yp], %[yp] quad_perm:[1,0,3,2] row_mask:0xf bank_mask:0xf bound_ctrl:1\n\t" \
    "v_pk_fma_f32 v[142:143], v[116:117], v[108:109], v[142:143] op_sel_hi:[0,1,1]\n\t" \
    "v_add_f32_dpp v146, v146, v146 quad_perm:[2,3,0,1] row_mask:0xf bank_mask:0xf bound_ctrl:1\n\t" \
    "v_add_f32_dpp %[yp], %[yp], %[yp] quad_perm:[2,3,0,1] row_mask:0xf bank_mask:0xf bound_ctrl:1\n\t" \
    "v_pk_fma_f32 v[144:145], v[116:117], v[110:111], v[144:145] op_sel_hi:[0,1,1]\n\t" \
    "v_add_f32_dpp v146, v146, v146 row_half_mirror row_mask:0xf bank_mask:0xf bound_ctrl:1\n\t" \
    "v_add_f32_dpp %[yp], %[yp], %[yp] row_half_mirror row_mask:0xf bank_mask:0xf bound_ctrl:1\n\t" \
    "v_cmp_eq_u32_e32 vcc, 3, %[sp]\n\t" \
    "v_add_f32_dpp v146, v146, v146 row_mirror row_mask:0xf bank_mask:0xf bound_ctrl:1\n\t" \
    "v_add_f32_dpp %[yp], %[yp], %[yp] row_mirror row_mask:0xf bank_mask:0xf bound_ctrl:1\n\t" \
    "v_cndmask_b32_e32 %[yk0], %[yk0], %[yp], vcc\n\t" \
    "v_pk_fma_f32 %[s01], v[146:147], v[104:105], v[142:143] op_sel_hi:[0,1,1] neg_lo:[1,0,0] neg_hi:[1,0,0]\n\t" \
    "v_pk_fma_f32 %[s23], v[146:147], v[106:107], v[144:145] op_sel_hi:[0,1,1] neg_lo:[1,0,0] neg_hi:[1,0,0]\n\t" \
    "v_pk_mul_f32 v[140:141], %[s01], v[112:113]\n\t" \
    "v_pk_fma_f32 v[140:141], %[s23], v[114:115], v[140:141]\n\t" \
    "v_add_f32 %[yp], v140, v141\n\t" \
    "s_waitcnt lgkmcnt(0)\n\t" \
    "ds_read_b128 v[96:99], %[ab] offset:26112\n\t" \
    "ds_read_b128 v[100:103], %[ab] offset:1536\n\t" \
    "ds_read_b128 v[104:107], %[ab] offset:17920\n\t" \
    "ds_read_b128 v[108:111], %[ab] offset:9728\n\t" \
    "ds_read_b128 v[112:115], %[ab] offset:34304\n\t" \
    "ds_read_b32 v116, %[av] offset:384\n\t" \
    "v_pk_mul_f32 v[140:141], %[s01], v[118:119]\n\t" \
    "v_pk_fma_f32 v[140:141], %[s23], v[120:121], v[140:141]\n\t" \
    "v_add_f32 v146, v140, v141\n\t" \
    "v_pk_mul_f32 v[142:143], %[s01], v[122:123]\n\t" \
    "v_pk_mul_f32 v[144:145], %[s23], v[124:125]\n\t" \
    "v_add_f32_dpp v146, v146, v146 quad_perm:[1,0,3,2] row_mask:0xf bank_mask:0xf bound_ctrl:1\n\t" \
    "v_add_f32_dpp %[yp], %[yp], %[yp] quad_perm:[1,0,3,2] row_mask:0xf bank_mask:0xf bound_ctrl:1\n\t" \
    "v_pk_fma_f32 v[142:143], v[138:139], v[130:131], v[142:143] op_sel_hi:[0,1,1]\n\t" \
    "v_add_f32_dpp v146, v146, v146 quad_perm:[2,3,0,1] row_mask:0xf bank_mask:0xf bound_ctrl:1\n\t" \
    "v_add_f32_dpp %[yp], %[yp], %[yp] quad_perm:[2,3,0,1] row_mask:0xf bank_mask:0xf bound_ctrl:1\n\t" \
    "v_pk_fma_f32 v[144:145], v[138:139], v[132:133], v[144:145] op_sel_hi:[0,1,1]\n\t" \
    "v_add_f32_dpp v146, v146, v146 row_half_mirror row_mask:0xf bank_mask:0xf bound_ctrl:1\n\t" \
    "v_add_f32_dpp %[yp], %[yp], %[yp] row_half_mirror row_mask:0xf bank_mask:0xf bound_ctrl:1\n\t" \
    "v_cmp_eq_u32_e32 vcc, 4, %[sp]\n\t" \
    "v_add_f32_dpp v146, v146, v146 row_mirror row_mask:0xf bank_mask:0xf bound_ctrl:1\n\t" \
    "v_add_f32_dpp %[yp], %[yp], %[yp] row_mirror row_mask:0xf bank_mask:0xf bound_ctrl:1\n\t" \
    "v_cndmask_b32_e32 %[yk0], %[yk0], %[yp], vcc\n\t" \
    "v_pk_fma_f32 %[s01], v[146:147], v[126:127], v[142:143] op_sel_hi:[0,1,1] neg_lo:[1,0,0] neg_hi:[1,0,0]\n\t" \
    "v_pk_fma_f32 %[s23], v[146:147], v[128:129], v[144:145] op_sel_hi:[0,1,1] neg_lo:[1,0,0] neg_hi:[1,0,0]\n\t" \
    "v_pk_mul_f32 v[140:141], %[s01], v[134:135]\n\t" \
    "v_pk_fma_f32 v[140:141], %[s23], v[136:137], v[140:141]\n\t" \
    "v_add_f32 %[yp], v140, v141\n\t" \
    "s_waitcnt lgkmcnt(0)\n\t" \
    "ds_read_b128 v[118:121], %[ab] offset:26368\n\t" \
    "ds_read_b128 v[122:125], %[ab] offset:1792\n\t" \
    "ds_read_b128 v[126:129], %[ab] offset:18176\n\t" \
    "ds_read_b128 v[130:133], %[ab] offset:9984\n\t" \
    "ds_read_b128 v[134:137], %[ab] offset:34560\n\t" \
    "ds_read_b32 v138, %[av] offset:448\n\t" \
    "v_pk_mul_f32 v[140:141], %[s01], v[96:97]\n\t" \
    "v_pk_fma_f32 v[140:141], %[s23], v[98:99], v[140:141]\n\t" \
    "v_add_f32 v146, v140, v141\n\t" \
    "v_pk_mul_f32 v[142:143], %[s01], v[100:101]\n\t" \
    "v_pk_mul_f32 v[144:145], %[s23], v[102:103]\n\t" \
    "v_add_f32_dpp v146, v146, v146 quad_perm:[1,0,3,2] row_mask:0xf bank_mask:0xf bound_ctrl:1\n\t" \
    "v_add_f32_dpp %[yp], %[yp], %[yp] quad_perm:[1,0,3,2] row_mask:0xf bank_mask:0xf bound_ctrl:1\n\t" \
    "v_pk_fma_f32 v[142:143], v[116:117], v[108:109], v[142:143] op_sel_hi:[0,1,1]\n\t" \
    "v_add_f32_dpp v146, v146, v146 quad_perm:[2,3,0,1] row_mask:0xf bank_mask:0xf bound_ctrl:1\n\t" \
    "v_add_f32_dpp %[yp], %[yp], %[yp] quad_perm:[2,3,0,1] row_mask:0xf bank_mask:0xf bound_ctrl:1\n\t" \
    "v_pk_fma_f32 v[144:145], v[116:117], v[110:111], v[144:145] op_sel_hi:[0,1,1]\n\t" \
    "v_add_f32_dpp v146, v146, v146 row_half_mirror row_mask:0xf bank_mask:0xf bound_ctrl:1\n\t" \
    "v_add_f32_dpp %[yp], %[yp], %[yp] row_half_mirror row_mask:0xf bank_mask:0xf bound_ctrl:1\n\t" \
    "v_cmp_eq_u32_e32 vcc, 5, %[sp]\n\t" \
    "v_add_f32_dpp v146, v146, v146 row_mirror row_mask:0xf bank_mask:0xf bound_ctrl:1\n\t" \
    "v_add_f32_dpp %[yp], %[yp], %[yp] row_mirror row_mask:0xf bank_mask:0xf bound_ctrl:1\n\t" \
    "v_cndmask_b32_e32 %[yk0], %[yk0], %[yp], vcc\n\t" \
    "v_pk_fma_f32 %[s01], v[146:147], v[104:105], v[142:143] op_sel_hi:[0,1,1] neg_lo:[1,0,0] neg_hi:[1,0,0]\n\t" \
    "v_pk_fma_f32 %[s23], v[146:147], v[106:107], v[144:145] op_sel_hi:[0,1,1] neg_lo:[1,0,0] neg_hi:[1,0,0]\n\t" \
    "v_pk_mul_f32 v[140:141], %[s01], v[112:113]\n\t" \
    "v_pk_fma_f32 v[140:141], %[s23], v[114:115], v[140:141]\n\t" \
    "v_add_f32 %[yp], v140, v141\n\t" \
    "s_waitcnt lgkmcnt(0)\n\t" \
    "ds_read_b128 v[96:99], %[ab] offset:26624\n\t" \
    "ds_read_b128 v[100:103], %[ab] offset:2048\n\t" \
    "ds_read_b128 v[104:107], %[ab] offset:18432\n\t" \
    "ds_read_b128 v[108:111], %[ab] offset:10240\n\t" \
    "ds_read_b128 v[112:115], %[ab] offset:34816\n\t" \
    "ds_read_b32 v116, %[av] offset:512\n\t" \
    "v_pk_mul_f32 v[140:141], %[s01], v[118:119]\n\t" \
    "v_pk_fma_f32 v[140:141], %[s23], v[120:121], v[140:141]\n\t" \
    "v_add_f32 v146, v140, v141\n\t" \
    "v_pk_mul_f32 v[142:143], %[s01], v[122:123]\n\t" \
    "v_pk_mul_f32 v[144:145], %[s23], v[124:125]\n\t" \
    "v_add_f32_dpp v146, v146, v146 quad_perm:[1,0,3,2] row_mask:0xf bank_mask:0xf bound_ctrl:1\n\t" \
    "v_add_f32_dpp %[yp], %[yp], %[yp] quad_perm:[1,0,3,2] row_mask:0xf bank_mask:0xf bound_ctrl:1\n\t" \
    "v_pk_fma_f32 v[142:143], v[138:139], v[130:131], v[142:143] op_sel_hi:[0,1,1]\n\t" \
    "v_add_f32_dpp v146, v146, v146 quad_perm:[2,3,0,1] row_mask:0xf bank_mask:0xf bound_ctrl:1\n\t" \
    "v_add_f32_dpp %[yp], %[yp], %[yp] quad_perm:[2,3,0,1] row_mask:0xf bank_mask:0xf bound_ctrl:1\n\t" \
    "v_pk_fma_f32 v[144:145], v[138:139], v[132:133], v[144:145] op_sel_hi:[0,1,1]\n\t" \
    "v_add_f32_dpp v146, v146, v146 row_half_mirror row_mask:0xf bank_mask:0xf bound_ctrl:1\n\t" \
    "v_add_f32_dpp %[yp], %[yp], %[yp] row_half_mirror row_mask:0xf bank_mask:0xf bound_ctrl:1\n\t" \
    "v_cmp_eq_u32_e32 vcc, 6, %[sp]\n\t" \
    "v_add_f32_dpp v146, v146, v146 row_mirror row_mask:0xf bank_mask:0xf bound_ctrl:1\n\t" \
    "v_add_f32_dpp %[yp], %[yp], %[yp] row_mirror row_mask:0xf bank_mask:0xf bound_ctrl:1\n\t" \
    "v_cndmask_b32_e32 %[yk0], %[yk0], %[yp], vcc\n\t" \
    "v_pk_fma_f32 %[s01], v[146:147], v[126:127], v[142:143] op_sel_hi:[0,1,1] neg_lo:[1,0,0] neg_hi:[1,0,0]\n\t" \
    "v_pk_fma_f32 %[s23], v[146:147], v[128:129], v[144:145] op_sel_hi:[0,1,1] neg_lo:[1,0,0] neg_hi:[1,0,0]\n\t" \
    "v_pk_mul_f32 v[140:141], %[s01], v[134:135]\n\t" \
    "v_pk_fma_f32 v[140:141], %[s23], v[136:137], v[140:141]\n\t" \
    "v_add_f32 %[yp], v140, v141\n\t" \
    "s_waitcnt lgkmcnt(0)\n\t" \
    "ds_read_b128 v[118:121], %[ab] offset:26880\n\t" \
    "ds_read_b128 v[122:125], %[ab] offset:2304\n\t" \
    "ds_read_b128 v[126:129], %[ab] offset:18688\n\t" \
    "ds_read_b128 v[130:133], %[ab] offset:10496\n\t" \
    "ds_read_b128 v[134:137], %[ab] offset:35072\n\t" \
    "ds_read_b32 v138, %[av] offset:576\n\t" \
    "v_pk_mul_f32 v[140:141], %[s01], v[96:97]\n\t" \
    "v_pk_fma_f32 v[140:141], %[s23], v[98:99], v[140:141]\n\t" \
    "v_add_f32 v146, v140, v141\n\t" \
    "v_pk_mul_f32 v[142:143], %[s01], v[100:101]\n\t" \
    "v_pk_mul_f32 v[144:145], %[s23], v[102:103]\n\t" \
    "v_add_f32_dpp v146, v146, v146 quad_perm:[1,0,3,2] row_mask:0xf bank_mask:0xf bound_ctrl:1\n\t" \
    "v_add_f32_dpp %[yp], %[yp], %[yp] quad_perm:[1,0,3,2] row_mask:0xf bank_mask:0xf bound_ctrl:1\n\t" \
    "v_pk_fma_f32 v[142:143], v[116:117], v[108:109], v[142:143] op_sel_hi:[0,1,1]\n\t" \
    "v_add_f32_dpp v146, v146, v146 quad_perm:[2,3,0,1] row_mask:0xf bank_mask:0xf bound_ctrl:1\n\t" \
    "v_add_f32_dpp %[yp], %[yp], %[yp] quad_perm:[2,3,0,1] row_mask:0xf bank_mask:0xf bound_ctrl:1\n\t" \
    "v_pk_fma_f32 v[144:145], v[116:117], v[110:111], v[144:145] op_sel_hi:[0,1,1]\n\t" \
    "v_add_f32_dpp v146, v146, v146 row_half_mirror row_mask:0xf bank_mask:0xf bound_ctrl:1\n\t" \
    "v_add_f32_dpp %[yp], %[yp], %[yp] row_half_mirror row_mask:0xf bank_mask:0xf bound_ctrl:1\n\t" \
    "v_cmp_eq_u32_e32 vcc, 7, %[sp]\n\t" \
    "v_add_f32_dpp v146, v146, v146 row_mirror row_mask:0xf bank_mask:0xf bound_ctrl:1\n\t" \
    "v_add_f32_dpp %[yp], %[yp], %[yp] row_mirror row_mask:0xf bank_mask:0xf bound_ctrl:1\n\t" \
    "v_cndmask_b32_e32 %[yk0], %[yk0], %[yp], vcc\n\t" \
    "v_pk_fma_f32 %[s01], v[146:147], v[104:105], v[142:143] op_sel_hi:[0,1,1] neg_lo:[1,0,0] neg_hi:[1,0,0]\n\t" \
    "v_pk_fma_f32 %[s23], v[146:147], v[106:107], v[144:145] op_sel_hi:[0,1,1] neg_lo:[1,0,0] neg_hi:[1,0,0]\n\t" \
    "v_pk_mul_f32 v[140:141], %[s01], v[112:113]\n\t" \
    "v_pk_fma_f32 v[140:141], %[s23], v[114:115], v[140:141]\n\t" \
    "v_add_f32 %[yp], v140, v141\n\t" \
    "s_waitcnt lgkmcnt(0)\n\t" \
    "ds_read_b128 v[96:99], %[ab] offset:27136\n\t" \
    "ds_read_b128 v[100:103], %[ab] offset:2560\n\t" \
    "ds_read_b128 v[104:107], %[ab] offset:18944\n\t" \
    "ds_read_b128 v[108:111], %[ab] offset:10752\n\t" \
    "ds_read_b128 v[112:115], %[ab] offset:35328\n\t" \
    "ds_read_b32 v116, %[av] offset:640\n\t" \
    "v_pk_mul_f32 v[140:141], %[s01], v[118:119]\n\t" \
    "v_pk_fma_f32 v[140:141], %[s23], v[120:121], v[140:141]\n\t" \
    "v_add_f32 v146, v140, v141\n\t" \
    "v_pk_mul_f32 v[142:143], %[s01], v[122:123]\n\t" \
    "v_pk_mul_f32 v[144:145], %[s23], v[124:125]\n\t" \
    "v_add_f32_dpp v146, v146, v146 quad_perm:[1,0,3,2] row_mask:0xf bank_mask:0xf bound_ctrl:1\n\t" \
    "v_add_f32_dpp %[yp], %[yp], %[yp] quad_perm:[1,0,3,2] row_mask:0xf bank_mask:0xf bound_ctrl:1\n\t" \
    "v_pk_fma_f32 v[142:143], v[138:139], v[130:131], v[142:143] op_sel_hi:[0,1,1]\n\t" \
    "v_add_f32_dpp v146, v146, v146 quad_perm:[2,3,0,1] row_mask:0xf bank_mask:0xf bound_ctrl:1\n\t" \
    "v_add_f32_dpp %[yp], %[yp], %[yp] quad_perm:[2,3,0,1] row_mask:0xf bank_mask:0xf bound_ctrl:1\n\t" \
    "v_pk_fma_f32 v[144:145], v[138:139], v[132:133], v[144:145] op_sel_hi:[0,1,1]\n\t" \
    "v_add_f32_dpp v146, v146, v146 row_half_mirror row_mask:0xf bank_mask:0xf bound_ctrl:1\n\t" \
    "v_add_f32_dpp %[yp], %[yp], %[yp] row_half_mirror row_mask:0xf bank_mask:0xf bound_ctrl:1\n\t" \
    "v_cmp_eq_u32_e32 vcc, 8, %[sp]\n\t" \
    "v_add_f32_dpp v146, v146, v146 row_mirror row_mask:0xf bank_mask:0xf bound_ctrl:1\n\t" \
    "v_add_f32_dpp %[yp], %[yp], %[yp] row_mirror row_mask:0xf bank_mask:0xf bound_ctrl:1\n\t" \
    "v_cndmask_b32_e32 %[yk0], %[yk0], %[yp], vcc\n\t" \
    "v_pk_fma_f32 %[s01], v[146:147], v[126:127], v[142:143] op_sel_hi:[0,1,1] neg_lo:[1,0,0] neg_hi:[1,0,0]\n\t" \
    "v_pk_fma_f32 %[s23], v[146:147], v[128:129], v[144:145] op_sel_hi:[0,1,1] neg_lo:[1,0,0] neg_hi:[1,0,0]\n\t" \
    "v_pk_mul_f32 v[140:141], %[s01], v[134:135]\n\t" \
    "v_pk_fma_f32 v[140:141], %[s23], v[136:137], v[140:141]\n\t" \
    "v_add_f32 %[yp], v140, v141\n\t" \
    "s_waitcnt lgkmcnt(0)\n\t" \
    "ds_read_b128 v[118:121], %[ab] offset:27392\n\t" \
    "ds_read_b128 v[122:125], %[ab] offset:2816\n\t" \
    "ds_read_b128 v[126:129], %[ab] offset:19200\n\t" \
    "ds_read_b128 v[130:133], %[ab] offset:11008\n\t" \
    "ds_read_b128 v[134:137], %[ab] offset:35584\n\t" \
    "ds_read_b32 v138, %[av] offset:704\n\t" \
    "v_pk_mul_f32 v[140:141], %[s01], v[96:97]\n\t" \
    "v_pk_fma_f32 v[140:141], %[s23], v[98:99], v[140:141]\n\t" \
    "v_add_f32 v146, v140, v141\n\t" \
    "v_pk_mul_f32 v[142:143], %[s01], v[100:101]\n\t" \
    "v_pk_mul_f32 v[144:145], %[s23], v[102:103]\n\t" \
    "v_add_f32_dpp v146, v146, v146 quad_perm:[1,0,3,2] row_mask:0xf bank_mask:0xf bound_ctrl:1\n\t" \
    "v_add_f32_dpp %[yp], %[yp], %[yp] quad_perm:[1,0,3,2] row_mask:0xf bank_mask:0xf bound_ctrl:1\n\t" \
    "v_pk_fma_f32 v[142:143], v[116:117], v[108:109], v[142:143] op_sel_hi:[0,1,1]\n\t" \
    "v_add_f32_dpp v146, v146, v146 quad_perm:[2,3,0,1] row_mask:0xf bank_mask:0xf bound_ctrl:1\n\t" \
    "v_add_f32_dpp %[yp], %[yp], %[yp] quad_perm:[2,3,0,1] row_mask:0xf bank_mask:0xf bound_ctrl:1\n\t" \
    "v_pk_fma_f32 v[144:145], v[116:117], v[110:111], v[144:145] op_sel_hi:[0,1,1]\n\t" \
    "v_add_f32_dpp v146, v146, v146 row_half_mirror row_mask:0xf bank_mask:0xf bound_ctrl:1\n\t" \
    "v_add_f32_dpp %[yp], %[yp], %[yp] row_half_mirror row_mask:0xf bank_mask:0xf bound_ctrl:1\n\t" \
    "v_cmp_eq_u32_e32 vcc, 9, %[sp]\n\t" \
    "v_add_f32_dpp v146, v146, v146 row_mirror row_mask:0xf bank_mask:0xf bound_ctrl:1\n\t" \
    "v_add_f32_dpp %[yp], %[yp], %[yp] row_mirror row_mask:0xf bank_mask:0xf bound_ctrl:1\n\t" \
    "v_cndmask_b32_e32 %[yk0], %[yk0], %[yp], vcc\n\t" \
    "v_pk_fma_f32 %[s01], v[146:147], v[104:105], v[142:143] op_sel_hi:[0,1,1] neg_lo:[1,0,0] neg_hi:[1,0,0]\n\t" \
    "v_pk_fma_f32 %[s23], v[146:147], v[106:107], v[144:145] op_sel_hi:[0,1,1] neg_lo:[1,0,0] neg_hi:[1,0,0]\n\t" \
    "v_pk_mul_f32 v[140:141], %[s01], v[112:113]\n\t" \
    "v_pk_fma_f32 v[140:141], %[s23], v[114:115], v[140:141]\n\t" \
    "v_add_f32 %[yp], v140, v141\n\t" \
    "s_waitcnt lgkmcnt(0)\n\t" \
    "ds_read_b128 v[96:99], %[ab] offset:27648\n\t" \
    "ds_read_b128 v[100:103], %[ab] offset:3072\n\t" \
    "ds_read_b128 v[104:107], %[ab] offset:19456\n\t" \
    "ds_read_b128 v[108:111], %[ab] offset:11264\n\t" \
    "ds_read_b128 v[112:115], %[ab] offset:35840\n\t" \
    "ds_read_b32 v116, %[av] offset:768\n\t" \
    "v_pk_mul_f32 v[140:141], %[s01], v[118:119]\n\t" \
    "v_pk_fma_f32 v[140:141], %[s23], v[120:121], v[140:141]\n\t" \
    "v_add_f32 v146, v140, v141\n\t" \
    "v_pk_mul_f32 v[142:143], %[s01], v[122:123]\n\t" \
    "v_pk_mul_f32 v[144:145], %[s23], v[124:125]\n\t" \
    "v_add_f32_dpp v146, v146, v146 quad_perm:[1,0,3,2] row_mask:0xf bank_mask:0xf bound_ctrl:1\n\t" \
    "v_add_f32_dpp %[yp], %[yp], %[yp] quad_perm:[1,0,3,2] row_mask:0xf bank_mask:0xf bound_ctrl:1\n\t" \
    "v_pk_fma_f32 v[142:143], v[138:139], v[130:131], v[142:143] op_sel_hi:[0,1,1]\n\t" \
    "v_add_f32_dpp v146, v146, v146 quad_perm:[2,3,0,1] row_mask:0xf bank_mask:0xf bound_ctrl:1\n\t" \
    "v_add_f32_dpp %[yp], %[yp], %[yp] quad_perm:[2,3,0,1] row_mask:0xf bank_mask:0xf bound_ctrl:1\n\t" \
    "v_pk_fma_f32 v[144:145], v[138:139], v[132:133], v[144:145] op_sel_hi:[0,1,1]\n\t" \
    "v_add_f32_dpp v146, v146, v146 row_half_mirror row_mask:0xf bank_mask:0xf bound_ctrl:1\n\t" \
    "v_add_f32_dpp %[yp], %[yp], %[yp] row_half_mirror row_mask:0xf bank_mask:0xf bound_ctrl:1\n\t" \
    "v_cmp_eq_u32_e32 vcc, 10, %[sp]\n\t" \
    "v_add_f32_dpp v146, v146, v146 row_mirror row_mask:0xf bank_mask:0xf bound_ctrl:1\n\t" \
    "v_add_f32_dpp %[yp], %[yp], %[yp] row_mirror row_mask:0xf bank_mask:0xf bound_ctrl:1\n\t" \
    "v_cndmask_b32_e32 %[yk0], %[yk0], %[yp], vcc\n\t" \
    "v_pk_fma_f32 %[s01], v[146:147], v[126:127], v[142:143] op_sel_hi:[0,1,1] neg_lo:[1,0,0] neg_hi:[1,0,0]\n\t" \
    "v_pk_fma_f32 %[s23], v[146:147], v[128:129], v[144:145] op_sel_hi:[0,1,1] neg_lo:[1,0,0] neg_hi:[1,0,0]\n\t" \
    "v_pk_mul_f32 v[140:141], %[s01], v[134:135]\n\t" \
    "v_pk_fma_f32 v[140:141], %[s23], v[136:137], v[140:141]\n\t" \
    "v_add_f32 %[yp], v140, v141\n\t" \
    "s_waitcnt lgkmcnt(0)\n\t" \
    "ds_read_b128 v[118:121], %[ab] offset:27904\n\t" \
    "ds_read_b128 v[122:125], %[ab] offset:3328\n\t" \
    "ds_read_b128 v[126:129], %[ab] offset:19712\n\t" \
    "ds_read_b128 v[130:133], %[ab] offset:11520\n\t" \
    "ds_read_b128 v[134:137], %[ab] offset:36096\n\t" \
    "ds_read_b32 v138, %[av] offset:832\n\t" \
    "v_pk_mul_f32 v[140:141], %[s01], v[96:97]\n\t" \
    "v_pk_fma_f32 v[140:141], %[s23], v[98:99], v[140:141]\n\t" \
    "v_add_f32 v146, v140, v141\n\t" \
    "v_pk_mul_f32 v[142:143], %[s01], v[100:101]\n\t" \
    "v_pk_mul_f32 v[144:145], %[s23], v[102:103]\n\t" \
    "v_add_f32_dpp v146, v146, v146 quad_perm:[1,0,3,2] row_mask:0xf bank_mask:0xf bound_ctrl:1\n\t" \
    "v_add_f32_dpp %[yp], %[yp], %[yp] quad_perm:[1,0,3,2] row_mask:0xf bank_mask:0xf bound_ctrl:1\n\t" \
    "v_pk_fma_f32 v[142:143], v[116:117], v[108:109], v[142:143] op_sel_hi:[0,1,1]\n\t" \
    "v_add_f32_dpp v146, v146, v146 quad_perm:[2,3,0,1] row_mask:0xf bank_mask:0xf bound_ctrl:1\n\t" \
    "v_add_f32_dpp %[yp], %[yp], %[yp] quad_perm:[2,3,0,1] row_mask:0xf bank_mask:0xf bound_ctrl:1\n\t" \
    "v_pk_fma_f32 v[144:145], v[116:117], v[110:111], v[144:145] op_sel_hi:[0,1,1]\n\t" \
    "v_add_f32_dpp v146, v146, v146 row_half_mirror row_mask:0xf bank_mask:0xf bound_ctrl:1\n\t" \
    "v_add_f32_dpp %[yp], %[yp], %[yp] row_half_mirror row_mask:0xf bank_mask:0xf bound_ctrl:1\n\t" \
    "v_cmp_eq_u32_e32 vcc, 11, %[sp]\n\t" \
    "v_add_f32_dpp v146, v146, v146 row_mirror row_mask:0xf bank_mask:0xf bound_ctrl:1\n\t" \
    "v_add_f32_dpp %[yp], %[yp], %[yp] row_mirror row_mask:0xf bank_mask:0xf bound_ctrl:1\n\t" \
    "v_cndmask_b32_e32 %[yk0], %[yk0], %[yp], vcc\n\t" \
    "v_pk_fma_f32 %[s01], v[146:147], v[104:105], v[142:143] op_sel_hi:[0,1,1] neg_lo:[1,0,0] neg_hi:[1,0,0]\n\t" \
    "v_pk_fma_f32 %[s23], v[146:147], v[106:107], v[144:145] op_sel_hi:[0,1,1] neg_lo:[1,0,0] neg_hi:[1,0,0]\n\t" \
    "v_pk_mul_f32 v[140:141], %[s01], v[112:113]\n\t" \
    "v_pk_fma_f32 v[140:141], %[s23], v[114:115], v[140:141]\n\t" \
    "v_add_f32 %[yp], v140, v141\n\t" \
    "s_waitcnt lgkmcnt(0)\n\t" \
    "ds_read_b128 v[96:99], %[ab] offset:28160\n\t" \
    "ds_read_b128 v[100:103], %[ab] offset:3584\n\t" \
    "ds_read_b128 v[104:107], %[ab] offset:19968\n\t" \
    "ds_read_b128 v[108:111], %[ab] offset:11776\n\t" \
    "ds_read_b128 v[112:115], %[ab] offset:36352\n\t" \
    "ds_read_b32 v116, %[av] offset:896\n\t" \
    "v_pk_mul_f32 v[140:141], %[s01], v[118:119]\n\t" \
    "v_pk_fma_f32 v[140:141], %[s23], v[120:121], v[140:141]\n\t" \
    "v_add_f32 v146, v140, v141\n\t" \
    "v_pk_mul_f32 v[142:143], %[s01], v[122:123]\n\t" \
    "v_pk_mul_f32 v[144:145], %[s23], v[124:125]\n\t" \
    "v_add_f32_dpp v146, v146, v146 quad_perm:[1,0,3,2] row_mask:0xf bank_mask:0xf bound_ctrl:1\n\t" \
    "v_add_f32_dpp %[yp], %[yp], %[yp] quad_perm:[1,0,3,2] row_mask:0xf bank_mask:0xf bound_ctrl:1\n\t" \
    "v_pk_fma_f32 v[142:143], v[138:139], v[130:131], v[142:143] op_sel_hi:[0,1,1]\n\t" \
    "v_add_f32_dpp v146, v146, v146 quad_perm:[2,3,0,1] row_mask:0xf bank_mask:0xf bound_ctrl:1\n\t" \
    "v_add_f32_dpp %[yp], %[yp], %[yp] quad_perm:[2,3,0,1] row_mask:0xf bank_mask:0xf bound_ctrl:1\n\t" \
    "v_pk_fma_f32 v[144:145], v[138:139], v[132:133], v[144:145] op_sel_hi:[0,1,1]\n\t" \
    "v_add_f32_dpp v146, v146, v146 row_half_mirror row_mask:0xf bank_mask:0xf bound_ctrl:1\n\t" \
    "v_add_f32_dpp %[yp], %[yp], %[yp] row_half_mirror row_mask:0xf bank_mask:0xf bound_ctrl:1\n\t" \
    "v_cmp_eq_u32_e32 vcc, 12, %[sp]\n\t" \
    "v_add_f32_dpp v146, v146, v146 row_mirror row_mask:0xf bank_mask:0xf bound_ctrl:1\n\t" \
    "v_add_f32_dpp %[yp], %[yp], %[yp] row_mirror row_mask:0xf bank_mask:0xf bound_ctrl:1\n\t" \
    "v_cndmask_b32_e32 %[yk0], %[yk0], %[yp], vcc\n\t" \
    "v_pk_fma_f32 %[s01], v[146:147], v[126:127], v[142:143] op_sel_hi:[0,1,1] neg_lo:[1,0,0] neg_hi:[1,0,0]\n\t" \
    "v_pk_fma_f32 %[s23], v[146:147], v[128:129], v[144:145] op_sel_hi:[0,1,1] neg_lo:[1,0,0] neg_hi:[1,0,0]\n\t" \
    "v_pk_mul_f32 v[140:141], %[s01], v[134:135]\n\t" \
    "v_pk_fma_f32 v[140:141], %[s23], v[136:137], v[140:141]\n\t" \
    "v_add_f32 %[yp], v140, v141\n\t" \
    "s_waitcnt lgkmcnt(0)\n\t" \
    "ds_read_b128 v[118:121], %[ab] offset:28416\n\t" \
    "ds_read_b128 v[122:125], %[ab] offset:3840\n\t" \
    "ds_read_b128 v[126:129], %[ab] offset:20224\n\t" \
    "ds_read_b128 v[130:133], %[ab] offset:12032\n\t" \
    "ds_read_b128 v[134:137], %[ab] offset:36608\n\t" \
    "ds_read_b32 v138, %[av] offset:960\n\t" \
    "v_pk_mul_f32 v[140:141], %[s01], v[96:97]\n\t" \
    "v_pk_fma_f32 v[140:141], %[s23], v[98:99], v[140:141]\n\t" \
    "v_add_f32 v146, v140, v141\n\t" \
    "v_pk_mul_f32 v[142:143], %[s01], v[100:101]\n\t" \
    "v_pk_mul_f32 v[144:145], %[s23], v[102:103]\n\t" \
    "v_add_f32_dpp v146, v146, v146 quad_perm:[1,0,3,2] row_mask:0xf bank_mask:0xf bound_ctrl:1\n\t" \
    "v_add_f32_dpp %[yp], %[yp], %[yp] quad_perm:[1,0,3,2] row_mask:0xf bank_mask:0xf bound_ctrl:1\n\t" \
    "v_pk_fma_f32 v[142:143], v[116:117], v[108:109], v[142:143] op_sel_hi:[0,1,1]\n\t" \
    "v_add_f32_dpp v146, v146, v146 quad_perm:[2,3,0,1] row_mask:0xf bank_mask:0xf bound_ctrl:1\n\t" \
    "v_add_f32_dpp %[yp], %[yp], %[yp] quad_perm:[2,3,0,1] row_mask:0xf bank_mask:0xf bound_ctrl:1\n\t" \
    "v_pk_fma_f32 v[144:145], v[116:117], v[110:111], v[144:145] op_sel_hi:[0,1,1]\n\t" \
    "v_add_f32_dpp v146, v146, v146 row_half_mirror row_mask:0xf bank_mask:0xf bound_ctrl:1\n\t" \
    "v_add_f32_dpp %[yp], %[yp], %[yp] row_half_mirror row_mask:0xf bank_mask:0xf bound_ctrl:1\n\t" \
    "v_cmp_eq_u32_e32 vcc, 13, %[sp]\n\t" \
    "v_add_f32_dpp v146, v146, v146 row_mirror row_mask:0xf bank_mask:0xf bound_ctrl:1\n\t" \
    "v_add_f32_dpp %[yp], %[yp], %[yp] row_mirror row_mask:0xf bank_mask:0xf bound_ctrl:1\n\t" \
    "v_cndmask_b32_e32 %[yk0], %[yk0], %[yp], vcc\n\t" \
    "v_pk_fma_f32 %[s01], v[146:147], v[104:105], v[142:143] op_sel_hi:[0,1,1] neg_lo:[1,0,0] neg_hi:[1,0,0]\n\t" \
    "v_pk_fma_f32 %[s23], v[146:147], v[106:107], v[144:145] op_sel_hi:[0,1,1] neg_lo:[1,0,0] neg_hi:[1,0,0]\n\t" \
    "v_pk_mul_f32 v[140:141], %[s01], v[112:113]\n\t" \
    "v_pk_fma_f32 v[140:141], %[s23], v[114:115], v[140:141]\n\t" \
    "v_add_f32 %[yp], v140, v141\n\t" \
    "s_waitcnt lgkmcnt(0)\n\t" \
    "ds_read_b128 v[96:99], %[ab] offset:28672\n\t" \
    "ds_read_b128 v[100:103], %[ab] offset:4096\n\t" \
    "ds_read_b128 v[104:107], %[ab] offset:20480\n\t" \
    "ds_read_b128 v[108:111], %[ab] offset:12288\n\t" \
    "ds_read_b128 v[112:115], %[ab] offset:36864\n\t" \
    "ds_read_b32 v116, %[av] offset:1024\n\t" \
    "v_pk_mul_f32 v[140:141], %[s01], v[118:119]\n\t" \
    "v_pk_fma_f32 v[140:141], %[s23], v[120:121], v[140:141]\n\t" \
    "v_add_f32 v146, v140, v141\n\t" \
    "v_pk_mul_f32 v[142:143], %[s01], v[122:123]\n\t" \
    "v_pk_mul_f32 v[144:145], %[s23], v[124:125]\n\t" \
    "v_add_f32_dpp v146, v146, v146 quad_perm:[1,0,3,2] row_mask:0xf bank_mask:0xf bound_ctrl:1\n\t" \
    "v_add_f32_dpp %[yp], %[yp], %[yp] quad_perm:[1,0,3,2] row_mask:0xf bank_mask:0xf bound_ctrl:1\n\t" \
    "v_pk_fma_f32 v[142:143], v[138:139], v[130:131], v[142:143] op_sel_hi:[0,1,1]\n\t" \
    "v_add_f32_dpp v146, v146, v146 quad_perm:[2,3,0,1] row_mask:0xf bank_mask:0xf bound_ctrl:1\n\t" \
    "v_add_f32_dpp %[yp], %[yp], %[yp] quad_perm:[2,3,0,1] row_mask:0xf bank_mask:0xf bound_ctrl:1\n\t" \
    "v_pk_fma_f32 v[144:145], v[138:139], v[132:133], v[144:145] op_sel_hi:[0,1,1]\n\t" \
    "v_add_f32_dpp v146, v146, v146 row_half_mirror row_mask:0xf bank_mask:0xf bound_ctrl:1\n\t" \
    "v_add_f32_dpp %[yp], %[yp], %[yp] row_half_mirror row_mask:0xf bank_mask:0xf bound_ctrl:1\n\t" \
    "v_cmp_eq_u32_e32 vcc, 14, %[sp]\n\t" \
    "v_add_f32_dpp v146, v146, v146 row_mirror row_mask:0xf bank_mask:0xf bound_ctrl:1\n\t" \
    "v_add_f32_dpp %[yp], %[yp], %[yp] row_mirror row_mask:0xf bank_mask:0xf bound_ctrl:1\n\t" \
    "v_cndmask_b32_e32 %[yk0], %[yk0], %[yp], vcc\n\t" \
    "v_pk_fma_f32 %[s01], v[146:147], v[126:127], v[142:143] op_sel_hi:[0,1,1] neg_lo:[1,0,0] neg_hi:[1,0,0]\n\t" \
    "v_pk_fma_f32 %[s23], v[146:147], v[128:129], v[144:145] op_sel_hi:[0,1,1] neg_lo:[1,0,0] neg_hi:[1,0,0]\n\t" \
    "v_pk_mul_f32 v[140:141], %[s01], v[134:135]\n\t" \
    "v_pk_fma_f32 v[140:141], %[s23], v[136:137], v[140:141]\n\t" \
    "v_add_f32 %[yp], v140, v141\n\t" \
    "s_waitcnt lgkmcnt(0)\n\t" \
    "ds_read_b128 v[118:121], %[ab] offset:28928\n\t" \
    "ds_read_b128 v[122:125], %[ab] offset:4352\n\t" \
    "ds_read_b128 v[126:129], %[ab] offset:20736\n\t" \
    "ds_read_b128 v[130:133], %[ab] offset:12544\n\t" \
    "ds_read_b128 v[134:137], %[ab] offset:37120\n\t" \
    "ds_read_b32 v138, %[av] offset:1088\n\t" \
    "v_pk_mul_f32 v[140:141], %[s01], v[96:97]\n\t" \
    "v_pk_fma_f32 v[140:141], %[s23], v[98:99], v[140:141]\n\t" \
    "v_add_f32 v146, v140, v141\n\t" \
    "v_pk_mul_f32 v[142:143], %[s01], v[100:101]\n\t" \
    "v_pk_mul_f32 v[144:145], %[s23], v[102:103]\n\t" \
    "v_add_f32_dpp v146, v146, v146 quad_perm:[1,0,3,2] row_mask:0xf bank_mask:0xf bound_ctrl:1\n\t" \
    "v_add_f32_dpp %[yp], %[yp], %[yp] quad_perm:[1,0,3,2] row_mask:0xf bank_mask:0xf bound_ctrl:1\n\t" \
    "v_pk_fma_f32 v[142:143], v[116:117], v[108:109], v[142:143] op_sel_hi:[0,1,1]\n\t" \
    "v_add_f32_dpp v146, v146, v146 quad_perm:[2,3,0,1] row_mask:0xf bank_mask:0xf bound_ctrl:1\n\t" \
    "v_add_f32_dpp %[yp], %[yp], %[yp] quad_perm:[2,3,0,1] row_mask:0xf bank_mask:0xf bound_ctrl:1\n\t" \
    "v_pk_fma_f32 v[144:145], v[116:117], v[110:111], v[144:145] op_sel_hi:[0,1,1]\n\t" \
    "v_add_f32_dpp v146, v146, v146 row_half_mirror row_mask:0xf bank_mask:0xf bound_ctrl:1\n\t" \
    "v_add_f32_dpp %[yp], %[yp], %[yp] row_half_mirror row_mask:0xf bank_mask:0xf bound_ctrl:1\n\t" \
    "v_cmp_eq_u32_e32 vcc, 15, %[sp]\n\t" \
    "v_add_f32_dpp v146, v146, v146 row_mirror row_mask:0xf bank_mask:0xf bound_ctrl:1\n\t" \
    "v_add_f32_dpp %[yp], %[yp], %[yp] row_mirror row_mask:0xf bank_mask:0xf bound_ctrl:1\n\t" \
    "v_cndmask_b32_e32 %[yk0], %[yk0], %[yp], vcc\n\t" \
    "v_pk_fma_f32 %[s01], v[146:147], v[104:105], v[142:143] op_sel_hi:[0,1,1] neg_lo:[1,0,0] neg_hi:[1,0,0]\n\t" \
    "v_pk_fma_f32 %[s23], v[146:147], v[106:107], v[144:145] op_sel_hi:[0,1,1] neg_lo:[1,0,0] neg_hi:[1,0,0]\n\t" \
    "v_pk_mul_f32 v[140:141], %[s01], v[112:113]\n\t" \
    "v_pk_fma_f32 v[140:141], %[s23], v[114:115], v[140:141]\n\t" \
    "v_add_f32 %[yp], v140, v141\n\t" \
    "s_waitcnt lgkmcnt(0)\n\t" \
    "ds_read_b128 v[96:99], %[ab] offset:29184\n\t" \
    "ds_read_b128 v[100:103], %[ab] offset:4608\n\t" \
    "ds_read_b128 v[104:107], %[ab] offset:20992\n\t" \
    "ds_read_b128 v[108:111], %[ab] offset:12800\n\t" \
    "ds_read_b128 v[112:115], %[ab] offset:37376\n\t" \
    "ds_read_b32 v116, %[av] offset:1152\n\t" \
    "v_pk_mul_f32 v[140:141], %[s01], v[118:119]\n\t" \
    "v_pk_fma_f32 v[140:141], %[s23], v[120:121], v[140:141]\n\t" \
    "v_add_f32 v146, v140, v141\n\t" \
    "v_pk_mul_f32 v[142:143], %[s01], v[122:123]\n\t" \
    "v_pk_mul_f32 v[144:145], %[s23], v[124:125]\n\t" \
    "v_add_f32_dpp v146, v146, v146 quad_perm:[1,0,3,2] row_mask:0xf bank_mask:0xf bound_ctrl:1\n\t" \
    "v_add_f32_dpp %[yp], %[yp], %[yp] quad_perm:[1,0,3,2] row_mask:0xf bank_mask:0xf bound_ctrl:1\n\t" \
    "v_pk_fma_f32 v[142:143], v[138:139], v[130:131], v[142:143] op_sel_hi:[0,1,1]\n\t" \
    "v_add_f32_dpp v146, v146, v146 quad_perm:[2,3,0,1] row_mask:0xf bank_mask:0xf bound_ctrl:1\n\t" \
    "v_add_f32_dpp %[yp], %[yp], %[yp] quad_perm:[2,3,0,1] row_mask:0xf bank_mask:0xf bound_ctrl:1\n\t" \
    "v_pk_fma_f32 v[144:145], v[138:139], v[132:133], v[144:145] op_sel_hi:[0,1,1]\n\t" \
    "v_add_f32_dpp v146, v146, v146 row_half_mirror row_mask:0xf bank_mask:0xf bound_ctrl:1\n\t" \
    "v_add_f32_dpp %[yp], %[yp], %[yp] row_half_mirror row_mask:0xf bank_mask:0xf bound_ctrl:1\n\t" \
    "v_cmp_eq_u32_e32 vcc, 0, %[sp]\n\t" \
    "v_add_f32_dpp v146, v146, v146 row_mirror row_mask:0xf bank_mask:0xf bound_ctrl:1\n\t" \
    "v_add_f32_dpp %[yp], %[yp], %[yp] row_mirror row_mask:0xf bank_mask:0xf bound_ctrl:1\n\t" \
    "v_cndmask_b32_e32 %[yk1], %[yk1], %[yp], vcc\n\t" \
    "v_pk_fma_f32 %[s01], v[146:147], v[126:127], v[142:143] op_sel_hi:[0,1,1] neg_lo:[1,0,0] neg_hi:[1,0,0]\n\t" \
    "v_pk_fma_f32 %[s23], v[146:147], v[128:129], v[144:145] op_sel_hi:[0,1,1] neg_lo:[1,0,0] neg_hi:[1,0,0]\n\t" \
    "v_pk_mul_f32 v[140:141], %[s01], v[134:135]\n\t" \
    "v_pk_fma_f32 v[140:141], %[s23], v[136:137], v[140:141]\n\t" \
    "v_add_f32 %[yp], v140, v141\n\t" \
    "s_waitcnt lgkmcnt(0)\n\t" \
    "ds_read_b128 v[118:121], %[ab] offset:29440\n\t" \
    "ds_read_b128 v[122:125], %[ab] offset:4864\n\t" \
    "ds_read_b128 v[126:129], %[ab] offset:21248\n\t" \
    "ds_read_b128 v[130:133], %[ab] offset:13056\n\t" \
    "ds_read_b128 v[134:137], %[ab] offset:37632\n\t" \
    "ds_read_b32 v138, %[av] offset:1216\n\t" \
    "v_pk_mul_f32 v[140:141], %[s01], v[96:97]\n\t" \
    "v_pk_fma_f32 v[140:141], %[s23], v[98:99], v[140:141]\n\t" \
    "v_add_f32 v146, v140, v141\n\t" \
    "v_pk_mul_f32 v[142:143], %[s01], v[100:101]\n\t" \
    "v_pk_mul_f32 v[144:145], %[s23], v[102:103]\n\t" \
    "v_add_f32_dpp v146, v146, v146 quad_perm:[1,0,3,2] row_mask:0xf bank_mask:0xf bound_ctrl:1\n\t" \
    "v_add_f32_dpp %[yp], %[yp], %[yp] quad_perm:[1,0,3,2] row_mask:0xf bank_mask:0xf bound_ctrl:1\n\t" \
    "v_pk_fma_f32 v[142:143], v[116:117], v[108:109], v[142:143] op_sel_hi:[0,1,1]\n\t" \
    "v_add_f32_dpp v146, v146, v146 quad_perm:[2,3,0,1] row_mask:0xf bank_mask:0xf bound_ctrl:1\n\t" \
    "v_add_f32_dpp %[yp], %[yp], %[yp] quad_perm:[2,3,0,1] row_mask:0xf bank_mask:0xf bound_ctrl:1\n\t" \
    "v_pk_fma_f32 v[144:145], v[116:117], v[110:111], v[144:145] op_sel_hi:[0,1,1]\n\t" \
    "v_add_f32_dpp v146, v146, v146 row_half_mirror row_mask:0xf bank_mask:0xf bound_ctrl:1\n\t" \
    "v_add_f32_dpp %[yp], %[yp], %[yp] row_half_mirror row_mask:0xf bank_mask:0xf bound_ctrl:1\n\t" \
    "v_cmp_eq_u32_e32 vcc, 1, %[sp]\n\t" \
    "v_add_f32_dpp v146, v146, v146 row_mirror row_mask:0xf bank_mask:0xf bound_ctrl:1\n\t" \
    "v_add_f32_dpp %[yp], %[yp], %[yp] row_mirror row_mask:0xf bank_mask:0xf bound_ctrl:1\n\t" \
    "v_cndmask_b32_e32 %[yk1], %[yk1], %[yp], vcc\n\t" \
    "v_pk_fma_f32 %[s01], v[146:147], v[104:105], v[142:143] op_sel_hi:[0,1,1] neg_lo:[1,0,0] neg_hi:[1,0,0]\n\t" \
    "v_pk_fma_f32 %[s23], v[146:147], v[106:107], v[144:145] op_sel_hi:[0,1,1] neg_lo:[1,0,0] neg_hi:[1,0,0]\n\t" \
    "v_pk_mul_f32 v[140:141], %[s01], v[112:113]\n\t" \
    "v_pk_fma_f32 v[140:141], %[s23], v[114:115], v[140:141]\n\t" \
    "v_add_f32 %[yp], v140, v141\n\t" \
    "s_waitcnt lgkmcnt(0)\n\t" \
    "ds_read_b128 v[96:99], %[ab] offset:29696\n\t" \
    "ds_read_b128 v[100:103], %[ab] offset:5120\n\t" \
    "ds_read_b128 v[104:107], %[ab] offset:21504\n\t" \
    "ds_read_b128 v[108:111], %[ab] offset:13312\n\t" \
    "ds_read_b128 v[112:115], %[ab] offset:37888\n\t" \
    "ds_read_b32 v116, %[av] offset:1280\n\t" \
    "v_pk_mul_f32 v[140:141], %[s01], v[118:119]\n\t" \
    "v_pk_fma_f32 v[140:141], %[s23], v[120:121], v[140:141]\n\t" \
    "v_add_f32 v146, v140, v141\n\t" \
    "v_pk_mul_f32 v[142:143], %[s01], v[122:123]\n\t" \
    "v_pk_mul_f32 v[144:145], %[s23], v[124:125]\n\t" \
    "v_add_f32_dpp v146, v146, v146 quad_perm:[1,0,3,2] row_mask:0xf bank_mask:0xf bound_ctrl:1\n\t" \
    "v_add_f32_dpp %[yp], %[yp], %[yp] quad_perm:[1,0,3,2] row_mask:0xf bank_mask:0xf bound_ctrl:1\n\t" \
    "v_pk_fma_f32 v[142:143], v[138:139], v[130:131], v[142:143] op_sel_hi:[0,1,1]\n\t" \
    "v_add_f32_dpp v146, v146, v146 quad_perm:[2,3,0,1] row_mask:0xf bank_mask:0xf bound_ctrl:1\n\t" \
    "v_add_f32_dpp %[yp], %[yp], %[yp] quad_perm:[2,3,0,1] row_mask:0xf bank_mask:0xf bound_ctrl:1\n\t" \
    "v_pk_fma_f32 v[144:145], v[138:139], v[132:133], v[144:145] op_sel_hi:[0,1,1]\n\t" \
    "v_add_f32_dpp v146, v146, v146 row_half_mirror row_mask:0xf bank_mask:0xf bound_ctrl:1\n\t" \
    "v_add_f32_dpp %[yp], %[yp], %[yp] row_half_mirror row_mask:0xf bank_mask:0xf bound_ctrl:1\n\t" \
    "v_cmp_eq_u32_e32 vcc, 2, %[sp]\n\t" \
    "v_add_f32_dpp v146, v146, v146 row_mirror row_mask:0xf bank_mask:0xf bound_ctrl:1\n\t" \
    "v_add_f32_dpp %[yp], %[yp], %[yp] row_mirror row_mask:0xf bank_mask:0xf bound_ctrl:1\n\t" \
    "v_cndmask_b32_e32 %[yk1], %[yk1], %[yp], vcc\n\t" \
    "v_pk_fma_f32 %[s01], v[146:147], v[126:127], v[142:143] op_sel_hi:[0,1,1] neg_lo:[1,0,0] neg_hi:[1,0,0]\n\t" \
    "v_pk_fma_f32 %[s23], v[146:147], v[128:129], v[144:145] op_sel_hi:[0,1,1] neg_lo:[1,0,0] neg_hi:[1,0,0]\n\t" \
    "v_pk_mul_f32 v[140:141], %[s01], v[134:135]\n\t" \
    "v_pk_fma_f32 v[140:141], %[s23], v[136:137], v[140:141]\n\t" \
    "v_add_f32 %[yp], v140, v141\n\t" \
    "s_waitcnt lgkmcnt(0)\n\t" \
    "ds_read_b128 v[118:121], %[ab] offset:29952\n\t" \
    "ds_read_b128 v[122:125], %[ab] offset:5376\n\t" \
    "ds_read_b128 v[126:129], %[ab] offset:21760\n\t" \
    "ds_read_b128 v[130:133], %[ab] offset:13568\n\t" \
    "ds_read_b128 v[134:137], %[ab] offset:38144\n\t" \
    "ds_read_b32 v138, %[av] offset:1344\n\t" \
    "v_pk_mul_f32 v[140:141], %[s01], v[96:97]\n\t" \
    "v_pk_fma_f32 v[140:141], %[s23], v[98:99], v[140:141]\n\t" \
    "v_add_f32 v146, v140, v141\n\t" \
    "v_pk_mul_f32 v[142:143], %[s01], v[100:101]\n\t" \
    "v_pk_mul_f32 v[144:145], %[s23], v[102:103]\n\t" \
    "v_add_f32_dpp v146, v146, v146 quad_perm:[1,0,3,2] row_mask:0xf bank_mask:0xf bound_ctrl:1\n\t" \
    "v_add_f32_dpp %[yp], %[yp], %[yp] quad_perm:[1,0,3,2] row_mask:0xf bank_mask:0xf bound_ctrl:1\n\t" \
    "v_pk_fma_f32 v[142:143], v[116:117], v[108:109], v[142:143] op_sel_hi:[0,1,1]\n\t" \
    "v_add_f32_dpp v146, v146, v146 quad_perm:[2,3,0,1] row_mask:0xf bank_mask:0xf bound_ctrl:1\n\t" \
    "v_add_f32_dpp %[yp], %[yp], %[yp] quad_perm:[2,3,0,1] row_mask:0xf bank_mask:0xf bound_ctrl:1\n\t" \
    "v_pk_fma_f32 v[144:145], v[116:117], v[110:111], v[144:145] op_sel_hi:[0,1,1]\n\t" \
    "v_add_f32_dpp v146, v146, v146 row_half_mirror row_mask:0xf bank_mask:0xf bound_ctrl:1\n\t" \
    "v_add_f32_dpp %[yp], %[yp], %[yp] row_half_mirror row_mask:0xf bank_mask:0xf bound_ctrl:1\n\t" \
    "v_cmp_eq_u32_e32 vcc, 3, %[sp]\n\t" \
    "v_add_f32_dpp v146, v146, v146 row_mirror row_mask:0xf bank_mask:0xf bound_ctrl:1\n\t" \
    "v_add_f32_dpp %[yp], %[yp], %[yp] row_mirror row_mask:0xf bank_mask:0xf bound_ctrl:1\n\t" \
    "v_cndmask_b32_e32 %[yk1], %[yk1], %[yp], vcc\n\t" \
    "v_pk_fma_f32 %[s01], v[146:147], v[104:105], v[142:143] op_sel_hi:[0,1,1] neg_lo:[1,0,0] neg_hi:[1,0,0]\n\t" \
    "v_pk_fma_f32 %[s23], v[146:147], v[106:107], v[144:145] op_sel_hi:[0,1,1] neg_lo:[1,0,0] neg_hi:[1,0,0]\n\t" \
    "v_pk_mul_f32 v[140:141], %[s01], v[112:113]\n\t" \
    "v_pk_fma_f32 v[140:141], %[s23], v[114:115], v[140:141]\n\t" \
    "v_add_f32 %[yp], v140, v141\n\t" \
    "s_waitcnt lgkmcnt(0)\n\t" \
    "ds_read_b128 v[96:99], %[ab] offset:30208\n\t" \
    "ds_read_b128 v[100:103], %[ab] offset:5632\n\t" \
    "ds_read_b128 v[104:107], %[ab] offset:22016\n\t" \
    "ds_read_b128 v[108:111], %[ab] offset:13824\n\t" \
    "ds_read_b128 v[112:115], %[ab] offset:38400\n\t" \
    "ds_read_b32 v116, %[av] offset:1408\n\t" \
    "v_pk_mul_f32 v[140:141], %[s01], v[118:119]\n\t" \
    "v_pk_fma_f32 v[140:141], %[s23], v[120:121], v[140:141]\n\t" \
    "v_add_f32 v146, v140, v141\n\t" \
    "v_pk_mul_f32 v[142:143], %[s01], v[122:123]\n\t" \
    "v_pk_mul_f32 v[144:145], %[s23], v[124:125]\n\t" \
    "v_add_f32_dpp v146, v146, v146 quad_perm:[1,0,3,2] row_mask:0xf bank_mask:0xf bound_ctrl:1\n\t" \
    "v_add_f32_dpp %[yp], %[yp], %[yp] quad_perm:[1,0,3,2] row_mask:0xf bank_mask:0xf bound_ctrl:1\n\t" \
    "v_pk_fma_f32 v[142:143], v[138:139], v[130:131], v[142:143] op_sel_hi:[0,1,1]\n\t" \
    "v_add_f32_dpp v146, v146, v146 quad_perm:[2,3,0,1] row_mask:0xf bank_mask:0xf bound_ctrl:1\n\t" \
    "v_add_f32_dpp %[yp], %[yp], %[yp] quad_perm:[2,3,0,1] row_mask:0xf bank_mask:0xf bound_ctrl:1\n\t" \
    "v_pk_fma_f32 v[144:145], v[138:139], v[132:133], v[144:145] op_sel_hi:[0,1,1]\n\t" \
    "v_add_f32_dpp v146, v146, v146 row_half_mirror row_mask:0xf bank_mask:0xf bound_ctrl:1\n\t" \
    "v_add_f32_dpp %[yp], %[yp], %[yp] row_half_mirror row_mask:0xf bank_mask:0xf bound_ctrl:1\n\t" \
    "v_cmp_eq_u32_e32 vcc, 4, %[sp]\n\t" \
    "v_add_f32_dpp v146, v146, v146 row_mirror row_mask:0xf bank_mask:0xf bound_ctrl:1\n\t" \
    "v_add_f32_dpp %[yp], %[yp], %[yp] row_mirror row_mask:0xf bank_mask:0xf bound_ctrl:1\n\t" \
    "v_cndmask_b32_e32 %[yk1], %[yk1], %[yp], vcc\n\t" \
    "v_pk_fma_f32 %[s01], v[146:147], v[126:127], v[142:143] op_sel_hi:[0,1,1] neg_lo:[1,0,0] neg_hi:[1,0,0]\n\t" \
    "v_pk_fma_f32 %[s23], v[146:147], v[128:129], v[144:145] op_sel_hi:[0,1,1] neg_lo:[1,0,0] neg_hi:[1,0,0]\n\t" \
    "v_pk_mul_f32 v[140:141], %[s01], v[134:135]\n\t" \
    "v_pk_fma_f32 v[140:141], %[s23], v[136:137], v[140:141]\n\t" \
    "v_add_f32 %[yp], v140, v141\n\t" \
    "s_waitcnt lgkmcnt(0)\n\t" \
    "ds_read_b128 v[118:121], %[ab] offset:30464\n\t" \
    "ds_read_b128 v[122:125], %[ab] offset:5888\n\t" \
    "ds_read_b128 v[126:129], %[ab] offset:22272\n\t" \
    "ds_read_b128 v[130:133], %[ab] offset:14080\n\t" \
    "ds_read_b128 v[134:137], %[ab] offset:38656\n\t" \
    "ds_read_b32 v138, %[av] offset:1472\n\t" \
    "v_pk_mul_f32 v[140:141], %[s01], v[96:97]\n\t" \
    "v_pk_fma_f32 v[140:141], %[s23], v[98:99], v[140:141]\n\t" \
    "v_add_f32 v146, v140, v141\n\t" \
    "v_pk_mul_f32 v[142:143], %[s01], v[100:101]\n\t" \
    "v_pk_mul_f32 v[144:145], %[s23], v[102:103]\n\t" \
    "v_add_f32_dpp v146, v146, v146 quad_perm:[1,0,3,2] row_mask:0xf bank_mask:0xf bound_ctrl:1\n\t" \
    "v_add_f32_dpp %[yp], %[yp], %[yp] quad_perm:[1,0,3,2] row_mask:0xf bank_mask:0xf bound_ctrl:1\n\t" \
    "v_pk_fma_f32 v[142:143], v[116:117], v[108:109], v[142:143] op_sel_hi:[0,1,1]\n\t" \
    "v_add_f32_dpp v146, v146, v146 quad_perm:[2,3,0,1] row_mask:0xf bank_mask:0xf bound_ctrl:1\n\t" \
    "v_add_f32_dpp %[yp], %[yp], %[yp] quad_perm:[2,3,0,1] row_mask:0xf bank_mask:0xf bound_ctrl:1\n\t" \
    "v_pk_fma_f32 v[144:145], v[116:117], v[110:111], v[144:145] op_sel_hi:[0,1,1]\n\t" \
    "v_add_f32_dpp v146, v146, v146 row_half_mirror row_mask:0xf bank_mask:0xf bound_ctrl:1\n\t" \
    "v_add_f32_dpp %[yp], %[yp], %[yp] row_half_mirror row_mask:0xf bank_mask:0xf bound_ctrl:1\n\t" \
    "v_cmp_eq_u32_e32 vcc, 5, %[sp]\n\t" \
    "v_add_f32_dpp v146, v146, v146 row_mirror row_mask:0xf bank_mask:0xf bound_ctrl:1\n\t" \
    "v_add_f32_dpp %[yp], %[yp], %[yp] row_mirror row_mask:0xf bank_mask:0xf bound_ctrl:1\n\t" \
    "v_cndmask_b32_e32 %[yk1], %[yk1], %[yp], vcc\n\t" \
    "v_pk_fma_f32 %[s01], v[146:147], v[104:105], v[142:143] op_sel_hi:[0,1,1] neg_lo:[1,0,0] neg_hi:[1,0,0]\n\t" \
    "v_pk_fma_f32 %[s23], v[146:147], v[106:107], v[144:145] op_sel_hi:[0,1,1] neg_lo:[1,0,0] neg_hi:[1,0,0]\n\t" \
    "v_pk_mul_f32 v[140:141], %[s01], v[112:113]\n\t" \
    "v_pk_fma_f32 v[140:141], %[s23], v[114:115], v[140:141]\n\t" \
    "v_add_f32 %[yp], v140, v141\n\t" \
    "s_waitcnt lgkmcnt(0)\n\t" \
    "ds_read_b128 v[96:99], %[ab] offset:30720\n\t" \
    "ds_read_b128 v[100:103], %[ab] offset:6144\n\t" \
    "ds_read_b128 v[104:107], %[ab] offset:22528\n\t" \
    "ds_read_b128 v[108:111], %[ab] offset:14336\n\t" \
    "ds_read_b128 v[112:115], %[ab] offset:38912\n\t" \
    "ds_read_b32 v116, %[av] offset:1536\n\t" \
    "v_pk_mul_f32 v[140:141], %[s01], v[118:119]\n\t" \
    "v_pk_fma_f32 v[140:141], %[s23], v[120:121], v[140:141]\n\t" \
    "v_add_f32 v146, v140, v141\n\t" \
    "v_pk_mul_f32 v[142:143], %[s01], v[122:123]\n\t" \
    "v_pk_mul_f32 v[144:145], %[s23], v[124:125]\n\t" \
    "v_add_f32_dpp v146, v146, v146 quad_perm:[1,0,3,2] row_mask:0xf bank_mask:0xf bound_ctrl:1\n\t" \
    "v_add_f32_dpp %[yp], %[yp], %[yp] quad_perm:[1,0,3,2] row_mask:0xf bank_mask:0xf bound_ctrl:1\n\t" \
    "v_pk_fma_f32 v[142:143], v[138:139], v[130:131], v[142:143] op_sel_hi:[0,1,1]\n\t" \
    "v_add_f32_dpp v146, v146, v146 quad_perm:[2,3,0,1] row_mask:0xf bank_mask:0xf bound_ctrl:1\n\t" \
    "v_add_f32_dpp %[yp], %[yp], %[yp] quad_perm:[2,3,0,1] row_mask:0xf bank_mask:0xf bound_ctrl:1\n\t" \
    "v_pk_fma_f32 v[144:145], v[138:139], v[132:133], v[144:145] op_sel_hi:[0,1,1]\n\t" \
    "v_add_f32_dpp v146, v146, v146 row_half_mirror row_mask:0xf bank_mask:0xf bound_ctrl:1\n\t" \
    "v_add_f32_dpp %[yp], %[yp], %[yp] row_half_mirror row_mask:0xf bank_mask:0xf bound_ctrl:1\n\t" \
    "v_cmp_eq_u32_e32 vcc, 6, %[sp]\n\t" \
    "v_add_f32_dpp v146, v146, v146 row_mirror row_mask:0xf bank_mask:0xf bound_ctrl:1\n\t" \
    "v_add_f32_dpp %[yp], %[yp], %[yp] row_mirror row_mask:0xf bank_mask:0xf bound_ctrl:1\n\t" \
    "v_cndmask_b32_e32 %[yk1], %[yk1], %[yp], vcc\n\t" \
    "v_pk_fma_f32 %[s01], v[146:147], v[126:127], v[142:143] op_sel_hi:[0,1,1] neg_lo:[1,0,0] neg_hi:[1,0,0]\n\t" \
    "v_pk_fma_f32 %[s23], v[146:147], v[128:129], v[144:145] op_sel_hi:[0,1,1] neg_lo:[1,0,0] neg_hi:[1,0,0]\n\t" \
    "v_pk_mul_f32 v[140:141], %[s01], v[134:135]\n\t" \
    "v_pk_fma_f32 v[140:141], %[s23], v[136:137], v[140:141]\n\t" \
    "v_add_f32 %[yp], v140, v141\n\t" \
    "s_waitcnt lgkmcnt(0)\n\t" \
    "ds_read_b128 v[118:121], %[ab] offset:30976\n\t" \
    "ds_read_b128 v[122:125], %[ab] offset:6400\n\t" \
    "ds_read_b128 v[126:129], %[ab] offset:22784\n\t" \
    "ds_read_b128 v[130:133], %[ab] offset:14592\n\t" \
    "ds_read_b128 v[134:137], %[ab] offset:39168\n\t" \
    "ds_read_b32 v138, %[av] offset:1600\n\t" \
    "v_pk_mul_f32 v[140:141], %[s01], v[96:97]\n\t" \
    "v_pk_fma_f32 v[140:141], %[s23], v[98:99], v[140:141]\n\t" \
    "v_add_f32 v146, v140, v141\n\t" \
    "v_pk_mul_f32 v[142:143], %[s01], v[100:101]\n\t" \
    "v_pk_mul_f32 v[144:145], %[s23], v[102:103]\n\t" \
    "v_add_f32_dpp v146, v146, v146 quad_perm:[1,0,3,2] row_mask:0xf bank_mask:0xf bound_ctrl:1\n\t" \
    "v_add_f32_dpp %[yp], %[yp], %[yp] quad_perm:[1,0,3,2] row_mask:0xf bank_mask:0xf bound_ctrl:1\n\t" \
    "v_pk_fma_f32 v[142:143], v[116:117], v[108:109], v[142:143] op_sel_hi:[0,1,1]\n\t" \
    "v_add_f32_dpp v146, v146, v146 quad_perm:[2,3,0,1] row_mask:0xf bank_mask:0xf bound_ctrl:1\n\t" \
    "v_add_f32_dpp %[yp], %[yp], %[yp] quad_perm:[2,3,0,1] row_mask:0xf bank_mask:0xf bound_ctrl:1\n\t" \
    "v_pk_fma_f32 v[144:145], v[116:117], v[110:111], v[144:145] op_sel_hi:[0,1,1]\n\t" \
    "v_add_f32_dpp v146, v146, v146 row_half_mirror row_mask:0xf bank_mask:0xf bound_ctrl:1\n\t" \
    "v_add_f32_dpp %[yp], %[yp], %[yp] row_half_mirror row_mask:0xf bank_mask:0xf bound_ctrl:1\n\t" \
    "v_cmp_eq_u32_e32 vcc, 7, %[sp]\n\t" \
    "v_add_f32_dpp v146, v146, v146 row_mirror row_mask:0xf bank_mask:0xf bound_ctrl:1\n\t" \
    "v_add_f32_dpp %[yp], %[yp], %[yp] row_mirror row_mask:0xf bank_mask:0xf bound_ctrl:1\n\t" \
    "v_cndmask_b32_e32 %[yk1], %[yk1], %[yp], vcc\n\t" \
    "v_pk_fma_f32 %[s01], v[146:147], v[104:105], v[142:143] op_sel_hi:[0,1,1] neg_lo:[1,0,0] neg_hi:[1,0,0]\n\t" \
    "v_pk_fma_f32 %[s23], v[146:147], v[106:107], v[144:145] op_sel_hi:[0,1,1] neg_lo:[1,0,0] neg_hi:[1,0,0]\n\t" \
    "v_pk_mul_f32 v[140:141], %[s01], v[112:113]\n\t" \
    "v_pk_fma_f32 v[140:141], %[s23], v[114:115], v[140:141]\n\t" \
    "v_add_f32 %[yp], v140, v141\n\t" \
    "s_waitcnt lgkmcnt(0)\n\t" \
    "ds_read_b128 v[96:99], %[ab] offset:31232\n\t" \
    "ds_read_b128 v[100:103], %[ab] offset:6656\n\t" \
    "ds_read_b128 v[104:107], %[ab] offset:23040\n\t" \
    "ds_read_b128 v[108:111], %[ab] offset:14848\n\t" \
    "ds_read_b128 v[112:115], %[ab] offset:39424\n\t" \
    "ds_read_b32 v116, %[av] offset:1664\n\t" \
    "v_pk_mul_f32 v[140:141], %[s01], v[118:119]\n\t" \
    "v_pk_fma_f32 v[140:141], %[s23], v[120:121], v[140:141]\n\t" \
    "v_add_f32 v146, v140, v141\n\t" \
    "v_pk_mul_f32 v[142:143], %[s01], v[122:123]\n\t" \
    "v_pk_mul_f32 v[144:145], %[s23], v[124:125]\n\t" \
    "v_add_f32_dpp v146, v146, v146 quad_perm:[1,0,3,2] row_mask:0xf bank_mask:0xf bound_ctrl:1\n\t" \
    "v_add_f32_dpp %[yp], %[yp], %[yp] quad_perm:[1,0,3,2] row_mask:0xf bank_mask:0xf bound_ctrl:1\n\t" \
    "v_pk_fma_f32 v[142:143], v[138:139], v[130:131], v[142:143] op_sel_hi:[0,1,1]\n\t" \
    "v_add_f32_dpp v146, v146, v146 quad_perm:[2,3,0,1] row_mask:0xf bank_mask:0xf bound_ctrl:1\n\t" \
    "v_add_f32_dpp %[yp], %[yp], %[yp] quad_perm:[2,3,0,1] row_mask:0xf bank_mask:0xf bound_ctrl:1\n\t" \
    "v_pk_fma_f32 v[144:145], v[138:139], v[132:133], v[144:145] op_sel_hi:[0,1,1]\n\t" \
    "v_add_f32_dpp v146, v146, v146 row_half_mirror row_mask:0xf bank_mask:0xf bound_ctrl:1\n\t" \
    "v_add_f32_dpp %[yp], %[yp], %[yp] row_half_mirror row_mask:0xf bank_mask:0xf bound_ctrl:1\n\t" \
    "v_cmp_eq_u32_e32 vcc, 8, %[sp]\n\t" \
    "v_add_f32_dpp v146, v146, v146 row_mirror row_mask:0xf bank_mask:0xf bound_ctrl:1\n\t" \
    "v_add_f32_dpp %[yp], %[yp], %[yp] row_mirror row_mask:0xf bank_mask:0xf bound_ctrl:1\n\t" \
    "v_cndmask_b32_e32 %[yk1], %[yk1], %[yp], vcc\n\t" \
    "v_pk_fma_f32 %[s01], v[146:147], v[126:127], v[142:143] op_sel_hi:[0,1,1] neg_lo:[1,0,0] neg_hi:[1,0,0]\n\t" \
    "v_pk_fma_f32 %[s23], v[146:147], v[128:129], v[144:145] op_sel_hi:[0,1,1] neg_lo:[1,0,0] neg_hi:[1,0,0]\n\t" \
    "v_pk_mul_f32 v[140:141], %[s01], v[134:135]\n\t" \
    "v_pk_fma_f32 v[140:141], %[s23], v[136:137], v[140:141]\n\t" \
    "v_add_f32 %[yp], v140, v141\n\t" \
    "s_waitcnt lgkmcnt(0)\n\t" \
    "ds_read_b128 v[118:121], %[ab] offset:31488\n\t" \
    "ds_read_b128 v[122:125], %[ab] offset:6912\n\t" \
    "ds_read_b128 v[126:129], %[ab] offset:23296\n\t" \
    "ds_read_b128 v[130:133], %[ab] offset:15104\n\t" \
    "ds_read_b128 v[134:137], %[ab] offset:39680\n\t" \
    "ds_read_b32 v138, %[av] offset:1728\n\t" \
    "v_pk_mul_f32 v[140:141], %[s01], v[96:97]\n\t" \
    "v_pk_fma_f32 v[140:141], %[s23], v[98:99], v[140:141]\n\t" \
    "v_add_f32 v146, v140, v141\n\t" \
    "v_pk_mul_f32 v[142:143], %[s01], v[100:101]\n\t" \
    "v_pk_mul_f32 v[144:145], %[s23], v[102:103]\n\t" \
    "v_add_f32_dpp v146, v146, v146 quad_perm:[1,0,3,2] row_mask:0xf bank_mask:0xf bound_ctrl:1\n\t" \
    "v_add_f32_dpp %[yp], %[yp], %[yp] quad_perm:[1,0,3,2] row_mask:0xf bank_mask:0xf bound_ctrl:1\n\t" \
    "v_pk_fma_f32 v[142:143], v[116:117], v[108:109], v[142:143] op_sel_hi:[0,1,1]\n\t" \
    "v_add_f32_dpp v146, v146, v146 quad_perm:[2,3,0,1] row_mask:0xf bank_mask:0xf bound_ctrl:1\n\t" \
    "v_add_f32_dpp %[yp], %[yp], %[yp] quad_perm:[2,3,0,1] row_mask:0xf bank_mask:0xf bound_ctrl:1\n\t" \
    "v_pk_fma_f32 v[144:145], v[116:117], v[110:111], v[144:145] op_sel_hi:[0,1,1]\n\t" \
    "v_add_f32_dpp v146, v146, v146 row_half_mirror row_mask:0xf bank_mask:0xf bound_ctrl:1\n\t" \
    "v_add_f32_dpp %[yp], %[yp], %[yp] row_half_mirror row_mask:0xf bank_mask:0xf bound_ctrl:1\n\t" \
    "v_cmp_eq_u32_e32 vcc, 9, %[sp]\n\t" \
    "v_add_f32_dpp v146, v146, v146 row_mirror row_mask:0xf bank_mask:0xf bound_ctrl:1\n\t" \
    "v_add_f32_dpp %[yp], %[yp], %[yp] row_mirror row_mask:0xf bank_mask:0xf bound_ctrl:1\n\t" \
    "v_cndmask_b32_e32 %[yk1], %[yk1], %[yp], vcc\n\t" \
    "v_pk_fma_f32 %[s01], v[146:147], v[104:105], v[142:143] op_sel_hi:[0,1,1] neg_lo:[1,0,0] neg_hi:[1,0,0]\n\t" \
    "v_pk_fma_f32 %[s23], v[146:147], v[106:107], v[144:145] op_sel_hi:[0,1,1] neg_lo:[1,0,0] neg_hi:[1,0,0]\n\t" \
    "v_pk_mul_f32 v[140:141], %[s01], v[112:113]\n\t" \
    "v_pk_fma_f32 v[140:141], %[s23], v[114:115], v[140:141]\n\t" \
    "v_add_f32 %[yp], v140, v141\n\t" \
    "s_waitcnt lgkmcnt(0)\n\t" \
    "ds_read_b128 v[96:99], %[ab] offset:31744\n\t" \
    "ds_read_b128 v[100:103], %[ab] offset:7168\n\t" \
    "ds_read_b128 v[104:107], %[ab] offset:23552\n\t" \
    "ds_read_b128 v[108:111], %[ab] offset:15360\n\t" \
    "ds_read_b128 v[112:115], %[ab] offset:39936\n\t" \
    "ds_read_b32 v116, %[av] offset:1792\n\t" \
    "v_pk_mul_f32 v[140:141], %[s01], v[118:119]\n\t" \
    "v_pk_fma_f32 v[140:141], %[s23], v[120:121], v[140:141]\n\t" \
    "v_add_f32 v146, v140, v141\n\t" \
    "v_pk_mul_f32 v[142:143], %[s01], v[122:123]\n\t" \
    "v_pk_mul_f32 v[144:145], %[s23], v[124:125]\n\t" \
    "v_add_f32_dpp v146, v146, v146 quad_perm:[1,0,3,2] row_mask:0xf bank_mask:0xf bound_ctrl:1\n\t" \
    "v_add_f32_dpp %[yp], %[yp], %[yp] quad_perm:[1,0,3,2] row_mask:0xf bank_mask:0xf bound_ctrl:1\n\t" \
    "v_pk_fma_f32 v[142:143], v[138:139], v[130:131], v[142:143] op_sel_hi:[0,1,1]\n\t" \
    "v_add_f32_dpp v146, v146, v146 quad_perm:[2,3,0,1] row_mask:0xf bank_mask:0xf bound_ctrl:1\n\t" \
    "v_add_f32_dpp %[yp], %[yp], %[yp] quad_perm:[2,3,0,1] row_mask:0xf bank_mask:0xf bound_ctrl:1\n\t" \
    "v_pk_fma_f32 v[144:145], v[138:139], v[132:133], v[144:145] op_sel_hi:[0,1,1]\n\t" \
    "v_add_f32_dpp v146, v146, v146 row_half_mirror row_mask:0xf bank_mask:0xf bound_ctrl:1\n\t" \
    "v_add_f32_dpp %[yp], %[yp], %[yp] row_half_mirror row_mask:0xf bank_mask:0xf bound_ctrl:1\n\t" \
    "v_cmp_eq_u32_e32 vcc, 10, %[sp]\n\t" \
    "v_add_f32_dpp v146, v146, v146 row_mirror row_mask:0xf bank_mask:0xf bound_ctrl:1\n\t" \
    "v_add_f32_dpp %[yp], %[yp], %[yp] row_mirror row_mask:0xf bank_mask:0xf bound_ctrl:1\n\t" \
    "v_cndmask_b32_e32 %[yk1], %[yk1], %[yp], vcc\n\t" \
    "v_pk_fma_f32 %[s01], v[146:147], v[126:127], v[142:143] op_sel_hi:[0,1,1] neg_lo:[1,0,0] neg_hi:[1,0,0]\n\t" \
    "v_pk_fma_f32 %[s23], v[146:147], v[128:129], v[144:145] op_sel_hi:[0,1,1] neg_lo:[1,0,0] neg_hi:[1,0,0]\n\t" \
    "v_pk_mul_f32 v[140:141], %[s01], v[134:135]\n\t" \
    "v_pk_fma_f32 v[140:141], %[s23], v[136:137], v[140:141]\n\t" \
    "v_add_f32 %[yp], v140, v141\n\t" \
    "s_waitcnt lgkmcnt(0)\n\t" \
    "ds_read_b128 v[118:121], %[ab] offset:32000\n\t" \
    "ds_read_b128 v[122:125], %[ab] offset:7424\n\t" \
    "ds_read_b128 v[126:129], %[ab] offset:23808\n\t" \
    "ds_read_b128 v[130:133], %[ab] offset:15616\n\t" \
    "ds_read_b128 v[134:137], %[ab] offset:40192\n\t" \
    "ds_read_b32 v138, %[av] offset:1856\n\t" \
    "v_pk_mul_f32 v[140:141], %[s01], v[96:97]\n\t" \
    "v_pk_fma_f32 v[140:141], %[s23], v[98:99], v[140:141]\n\t" \
    "v_add_f32 v146, v140, v141\n\t" \
    "v_pk_mul_f32 v[142:143], %[s01], v[100:101]\n\t" \
    "v_pk_mul_f32 v[144:145], %[s23], v[102:103]\n\t" \
    "v_add_f32_dpp v146, v146, v146 quad_perm:[1,0,3,2] row_mask:0xf bank_mask:0xf bound_ctrl:1\n\t" \
    "v_add_f32_dpp %[yp], %[yp], %[yp] quad_perm:[1,0,3,2] row_mask:0xf bank_mask:0xf bound_ctrl:1\n\t" \
    "v_pk_fma_f32 v[142:143], v[116:117], v[108:109], v[142:143] op_sel_hi:[0,1,1]\n\t" \
    "v_add_f32_dpp v146, v146, v146 quad_perm:[2,3,0,1] row_mask:0xf bank_mask:0xf bound_ctrl:1\n\t" \
    "v_add_f32_dpp %[yp], %[yp], %[yp] quad_perm:[2,3,0,1] row_mask:0xf bank_mask:0xf bound_ctrl:1\n\t" \
    "v_pk_fma_f32 v[144:145], v[116:117], v[110:111], v[144:145] op_sel_hi:[0,1,1]\n\t" \
    "v_add_f32_dpp v146, v146, v146 row_half_mirror row_mask:0xf bank_mask:0xf bound_ctrl:1\n\t" \
    "v_add_f32_dpp %[yp], %[yp], %[yp] row_half_mirror row_mask:0xf bank_mask:0xf bound_ctrl:1\n\t" \
    "v_cmp_eq_u32_e32 vcc, 11, %[sp]\n\t" \
    "v_add_f32_dpp v146, v146, v146 row_mirror row_mask:0xf bank_mask:0xf bound_ctrl:1\n\t" \
    "v_add_f32_dpp %[yp], %[yp], %[yp] row_mirror row_mask:0xf bank_mask:0xf bound_ctrl:1\n\t" \
    "v_cndmask_b32_e32 %[yk1], %[yk1], %[yp], vcc\n\t" \
    "v_pk_fma_f32 %[s01], v[146:147], v[104:105], v[142:143] op_sel_hi:[0,1,1] neg_lo:[1,0,0] neg_hi:[1,0,0]\n\t" \
    "v_pk_fma_f32 %[s23], v[146:147], v[106:107], v[144:145] op_sel_hi:[0,1,1] neg_lo:[1,0,0] neg_hi:[1,0,0]\n\t" \
    "v_pk_mul_f32 v[140:141], %[s01], v[112:113]\n\t" \
    "v_pk_fma_f32 v[140:141], %[s23], v[114:115], v[140:141]\n\t" \
    "v_add_f32 %[yp], v140, v141\n\t" \
    "s_waitcnt lgkmcnt(0)\n\t" \
    "ds_read_b128 v[96:99], %[ab] offset:32256\n\t" \
    "ds_read_b128 v[100:103], %[ab] offset:7680\n\t" \
    "ds_read_b128 v[104:107], %[ab] offset:24064\n\t" \
    "ds_read_b128 v[108:111], %[ab] offset:15872\n\t" \
    "ds_read_b128 v[112:115], %[ab] offset:40448\n\t" \
    "ds_read_b32 v116, %[av] offset:1920\n\t" \
    "v_pk_mul_f32 v[140:141], %[s01], v[118:119]\n\t" \
    "v_pk_fma_f32 v[140:141], %[s23], v[120:121], v[140:141]\n\t" \
    "v_add_f32 v146, v140, v141\n\t" \
    "v_pk_mul_f32 v[142:143], %[s01], v[122:123]\n\t" \
    "v_pk_mul_f32 v[144:145], %[s23], v[124:125]\n\t" \
    "v_add_f32_dpp v146, v146, v146 quad_perm:[1,0,3,2] row_mask:0xf bank_mask:0xf bound_ctrl:1\n\t" \
    "v_add_f32_dpp %[yp], %[yp], %[yp] quad_perm:[1,0,3,2] row_mask:0xf bank_mask:0xf bound_ctrl:1\n\t" \
    "v_pk_fma_f32 v[142:143], v[138:139], v[130:131], v[142:143] op_sel_hi:[0,1,1]\n\t" \
    "v_add_f32_dpp v146, v146, v146 quad_perm:[2,3,0,1] row_mask:0xf bank_mask:0xf bound_ctrl:1\n\t" \
    "v_add_f32_dpp %[yp], %[yp], %[yp] quad_perm:[2,3,0,1] row_mask:0xf bank_mask:0xf bound_ctrl:1\n\t" \
    "v_pk_fma_f32 v[144:145], v[138:139], v[132:133], v[144:145] op_sel_hi:[0,1,1]\n\t" \
    "v_add_f32_dpp v146, v146, v146 row_half_mirror row_mask:0xf bank_mask:0xf bound_ctrl:1\n\t" \
    "v_add_f32_dpp %[yp], %[yp], %[yp] row_half_mirror row_mask:0xf bank_mask:0xf bound_ctrl:1\n\t" \
    "v_cmp_eq_u32_e32 vcc, 12, %[sp]\n\t" \
    "v_add_f32_dpp v146, v146, v146 row_mirror row_mask:0xf bank_mask:0xf bound_ctrl:1\n\t" \
    "v_add_f32_dpp %[yp], %[yp], %[yp] row_mirror row_mask:0xf bank_mask:0xf bound_ctrl:1\n\t" \
    "v_cndmask_b32_e32 %[yk1], %[yk1], %[yp], vcc\n\t" \
    "v_pk_fma_f32 %[s01], v[146:147], v[126:127], v[142:143] op_sel_hi:[0,1,1] neg_lo:[1,0,0] neg_hi:[1,0,0]\n\t" \
    "v_pk_fma_f32 %[s23], v[146:147], v[128:129], v[144:145] op_sel_hi:[0,1,1] neg_lo:[1,0,0] neg_hi:[1,0,0]\n\t" \
    "v_pk_mul_f32 v[140:141], %[s01], v[134:135]\n\t" \
    "v_pk_fma_f32 v[140:141], %[s23], v[136:137], v[140:141]\n\t" \
    "v_add_f32 %[yp], v140, v141\n\t" \
    "s_waitcnt lgkmcnt(0)\n\t" \
    "ds_read_b128 v[118:121], %[ab] offset:32512\n\t" \
    "ds_read_b128 v[122:125], %[ab] offset:7936\n\t" \
    "ds_read_b128 v[126:129], %[ab] offset:24320\n\t" \
    "ds_read_b128 v[130:133], %[ab] offset:16128\n\t" \
    "ds_read_b128 v[134:137], %[ab] offset:40704\n\t" \
    "ds_read_b32 v138, %[av] offset:1984\n\t" \
    "v_pk_mul_f32 v[140:141], %[s01], v[96:97]\n\t" \
    "v_pk_fma_f32 v[140:141], %[s23], v[98:99], v[140:141]\n\t" \
    "v_add_f32 v146, v140, v141\n\t" \
    "v_pk_mul_f32 v[142:143], %[s01], v[100:101]\n\t" \
    "v_pk_mul_f32 v[144:145], %[s23], v[102:103]\n\t" \
    "v_add_f32_dpp v146, v146, v146 quad_perm:[1,0,3,2] row_mask:0xf bank_mask:0xf bound_ctrl:1\n\t" \
    "v_add_f32_dpp %[yp], %[yp], %[yp] quad_perm:[1,0,3,2] row_mask:0xf bank_mask:0xf bound_ctrl:1\n\t" \
    "v_pk_fma_f32 v[142:143], v[116:117], v[108:109], v[142:143] op_sel_hi:[0,1,1]\n\t" \
    "v_add_f32_dpp v146, v146, v146 quad_perm:[2,3,0,1] row_mask:0xf bank_mask:0xf bound_ctrl:1\n\t" \
    "v_add_f32_dpp %[yp], %[yp], %[yp] quad_perm:[2,3,0,1] row_mask:0xf bank_mask:0xf bound_ctrl:1\n\t" \
    "v_pk_fma_f32 v[144:145], v[116:117], v[110:111], v[144:145] op_sel_hi:[0,1,1]\n\t" \
    "v_add_f32_dpp v146, v146, v146 row_half_mirror row_mask:0xf bank_mask:0xf bound_ctrl:1\n\t" \
    "v_add_f32_dpp %[yp], %[yp], %[yp] row_half_mirror row_mask:0xf bank_mask:0xf bound_ctrl:1\n\t" \
    "v_cmp_eq_u32_e32 vcc, 13, %[sp]\n\t" \
    "v_add_f32_dpp v146, v146, v146 row_mirror row_mask:0xf bank_mask:0xf bound_ctrl:1\n\t" \
    "v_add_f32_dpp %[yp], %[yp], %[yp] row_mirror row_mask:0xf bank_mask:0xf bound_ctrl:1\n\t" \
    "v_cndmask_b32_e32 %[yk1], %[yk1], %[yp], vcc\n\t" \
    "v_pk_fma_f32 %[s01], v[146:147], v[104:105], v[142:143] op_sel_hi:[0,1,1] neg_lo:[1,0,0] neg_hi:[1,0,0]\n\t" \
    "v_pk_fma_f32 %[s23], v[146:147], v[106:107], v[144:145] op_sel_hi:[0,1,1] neg_lo:[1,0,0] neg_hi:[1,0,0]\n\t" \
    "v_pk_mul_f32 v[140:141], %[s01], v[112:113]\n\t" \
    "v_pk_fma_f32 v[140:141], %[s23], v[114:115], v[140:141]\n\t" \
    "v_add_f32 %[yp], v140, v141\n\t" \
    "s_waitcnt lgkmcnt(0)\n\t" \
    "ds_read_b128 v[96:99], %[ab] offset:32768\n\t" \
    "ds_read_b128 v[100:103], %[ab] offset:8192\n\t" \
    "ds_read_b128 v[104:107], %[ab] offset:24576\n\t" \
    "ds_read_b128 v[108:111], %[ab] offset:16384\n\t" \
    "ds_read_b128 v[112:115], %[ab] offset:40960\n\t" \
    "ds_read_b32 v116, %[av] offset:2048\n\t" \
    "v_pk_mul_f32 v[140:141], %[s01], v[118:119]\n\t" \
    "v_pk_fma_f32 v[140:141], %[s23], v[120:121], v[140:141]\n\t" \
    "v_add_f32 v146, v140, v141\n\t" \
    "v_pk_mul_f32 v[142:143], %[s01], v[122:123]\n\t" \
    "v_pk_mul_f32 v[144:145], %[s23], v[124:125]\n\t" \
    "v_add_f32_dpp v146, v146, v146 quad_perm:[1,0,3,2] row_mask:0xf bank_mask:0xf bound_ctrl:1\n\t" \
    "v_add_f32_dpp %[yp], %[yp], %[yp] quad_perm:[1,0,3,2] row_mask:0xf bank_mask:0xf bound_ctrl:1\n\t" \
    "v_pk_fma_f32 v[142:143], v[138:139], v[130:131], v[142:143] op_sel_hi:[0,1,1]\n\t" \
    "v_add_f32_dpp v146, v146, v146 quad_perm:[2,3,0,1] row_mask:0xf bank_mask:0xf bound_ctrl:1\n\t" \
    "v_add_f32_dpp %[yp], %[yp], %[yp] quad_perm:[2,3,0,1] row_mask:0xf bank_mask:0xf bound_ctrl:1\n\t" \
    "v_pk_fma_f32 v[144:145], v[138:139], v[132:133], v[144:145] op_sel_hi:[0,1,1]\n\t" \
    "v_add_f32_dpp v146, v146, v146 row_half_mirror row_mask:0xf bank_mask:0xf bound_ctrl:1\n\t" \
    "v_add_f32_dpp %[yp], %[yp], %[yp] row_half_mirror row_mask:0xf bank_mask:0xf bound_ctrl:1\n\t" \
    "v_cmp_eq_u32_e32 vcc, 14, %[sp]\n\t" \
    "v_add_f32_dpp v146, v146, v146 row_mirror row_mask:0xf bank_mask:0xf bound_ctrl:1\n\t" \
    "v_add_f32_dpp %[yp], %[yp], %[yp] row_mirror row_mask:0xf bank_mask:0xf bound_ctrl:1\n\t" \
    "v_cndmask_b32_e32 %[yk1], %[yk1], %[yp], vcc\n\t" \
    "v_pk_fma_f32 %[s01], v[146:147], v[126:127], v[142:143] op_sel_hi:[0,1,1] neg_lo:[1,0,0] neg_hi:[1,0,0]\n\t" \
    "v_pk_fma_f32 %[s23], v[146:147], v[128:129], v[144:145] op_sel_hi:[0,1,1] neg_lo:[1,0,0] neg_hi:[1,0,0]\n\t" \
    "v_pk_mul_f32 v[140:141], %[s01], v[134:135]\n\t" \
    "v_pk_fma_f32 v[140:141], %[s23], v[136:137], v[140:141]\n\t" \
    "v_add_f32 %[yp], v140, v141\n\t" \
    "s_waitcnt lgkmcnt(0)\n\t"
#define SCAN_CHUNK_CLOBBERS "v96", "v97", "v98", "v99", "v100", "v101", "v102", "v103", "v104", "v105", "v106", "v107", "v108", "v109", "v110", "v111", "v112", "v113", "v114", "v115", "v116", "v117", "v118", "v119", "v120", "v121", "v122", "v123", "v124", "v125", "v126", "v127", "v128", "v129", "v130", "v131", "v132", "v133", "v134", "v135", "v136", "v137", "v138", "v139", "v140", "v141", "v142", "v143", "v144", "v145", "v146", "v147", "vcc", "memory"
#ifndef EMU
#define UNR _Pragma("unroll")
#define UNR1 _Pragma("unroll 1")
#define CFENCE() asm volatile("" ::: "memory")
#define OPAQUE(x) asm volatile("" : "+v"(x))
#define SYNC() __syncthreads()
#define WAVE_SYNC() do { asm volatile("s_waitcnt lgkmcnt(0)" ::: "memory"); __builtin_amdgcn_wave_barrier(); } while (0)
DEVFN float shfl_xor_f(float v, int m) { return __shfl_xor(v, m); }
DEVFN float shfl_f(float v, int src) { return __shfl(v, src); }
DEVFN void sincospi_f(float x, float* s, float* c) { sincospif(x, s, c); }
template <int M> DEVFN float rowx_add(float v) { constexpr int ctrl = M == 1 ? 0xB1 : M == 2 ? 0x4E : M == 7 ? 0x141 : 0x140;
    return v + __builtin_bit_cast(float, __builtin_amdgcn_update_dpp(0, __builtin_bit_cast(int, v), ctrl, 0xf, 0xf, true)); }
#endif

enum InIdx { I_X = 0, I_C, I_CTX, I_CCTX, I_ANORM, I_AADAW, I_AADAB, I_AWIN, I_RPB, I_QG, I_KG, I_AWOUT, I_RNORM, I_RADAW, I_RADAB, I_RWIN, I_MU, I_W0, I_WUP, I_A0, I_AUP,
             I_KK, I_KA, I_RK, I_GNW, I_GNB, I_HSHORT, I_HW1, I_HB1, I_HW2, I_HB2, I_HW3, I_HB3, I_HSKIP, I_RWOUT, I_FNORM, N_IN };

#if defined(TSEL) && !defined(EMU)
#define XSTAMP(C, k, cond) do { if ((cond) && (C).tid == 0) __hip_atomic_store((unsigned long long*)((C).ws + WS_CTL + 32768) + (k), (unsigned long long)__builtin_amdgcn_s_memrealtime(), __ATOMIC_RELAXED, __HIP_MEMORY_SCOPE_AGENT); } while (0)
#else
#define XSTAMP(C, k, cond) do {} while (0)
#endif
#if defined(TSEL) && !defined(EMU)
#define TACC_DECL unsigned long long tacc_ = 0, tb_ = 0
#define TACC_BEGIN tb_ = __builtin_amdgcn_s_memrealtime()
#define TACC_END tacc_ += __builtin_amdgcn_s_memrealtime() - tb_
#define TACC_STORE(C, k, cond) do { if (cond) __hip_atomic_store((unsigned long long*)((C).ws + WS_CTL + 32768) + (k), tacc_, __ATOMIC_RELAXED, __HIP_MEMORY_SCOPE_AGENT); } while (0)
#else
#define TACC_DECL
#define TACC_BEGIN
#define TACC_END
#define TACC_STORE(C, k, cond)
#endif
struct Ctx {
    const float* in[N_IN]; float* out; unsigned char* ws;
    int tid, lane, wave, vcu, G;
};

#ifdef EMU
DEVFN float wave_sum(float v) { for (int o = 1; o < 64; o <<= 1) v += shfl_xor_f(v, o); return v; }
DEVFN float swap16_f(float v) { return shfl_xor_f(v, 16); }
#else
DEVFN float wave_sum(float v) { v = rowx_add<1>(v); v = rowx_add<2>(v); v = rowx_add<7>(v); v = rowx_add<15>(v);
    const int i_ = __builtin_bit_cast(int, v);
    return (__builtin_bit_cast(float, __builtin_amdgcn_readlane(i_, 0)) + __builtin_bit_cast(float, __builtin_amdgcn_readlane(i_, 16))) + (__builtin_bit_cast(float, __builtin_amdgcn_readlane(i_, 32)) + __builtin_bit_cast(float, __builtin_amdgcn_readlane(i_, 48))); }
DEVFN float swap16_f(float v) { return __builtin_bit_cast(float, __builtin_amdgcn_ds_swizzle(__builtin_bit_cast(int, v), 0x401F)); }
#endif

DEVFN U4 ld16(const void* p) { return *(const U4*)p; }
DEVFN void st16(void* p, U4 v) { *(U4*)p = v; }
DEVFN void unpack8(U4 w, float* f) { f[0] = bflo(w.x); f[1] = bfhi(w.x); f[2] = bflo(w.y); f[3] = bfhi(w.y); f[4] = bflo(w.z); f[5] = bfhi(w.z); f[6] = bflo(w.w); f[7] = bfhi(w.w); }
DEVFN U4 pack8(const float* f) { U4 w; w.x = pk2(f[0], f[1]); w.y = pk2(f[2], f[3]); w.z = pk2(f[4], f[5]); w.w = pk2(f[6], f[7]); return w; }

DEVFN void p0_transpose_item(const float* W, int K, int N, bf16_t* WT, float* scr, int item, int lane) {
    const int nblk = N / 32, kb = item / nblk, nb = item % nblk, k0 = 64 * kb, n0 = 32 * nb;
    UNR for (int i = 0; i < 32; ++i) { const int kk = 2 * i + (lane >> 5); scr[kk * 33 + (lane & 31)] = W[(size_t)(k0 + kk) * N + n0 + (lane & 31)]; }
    WAVE_SYNC();
    const int c = lane & 7;
    UNR for (int j = 0; j < 4; ++j) { const int n = (lane >> 3) + 8 * j; const float* s = scr + (8 * c) * 33 + n;
        U4 o; o.x = pk2(s[0 * 33], s[1 * 33]); o.y = pk2(s[2 * 33], s[3 * 33]); o.z = pk2(s[4 * 33], s[5 * 33]); o.w = pk2(s[6 * 33], s[7 * 33]);
        st16(WT + (size_t)(n0 + n) * K + k0 + 8 * c, o); }
    WAVE_SYNC();
}

template <bool BF> DEVFN void hid_rows(const float* w1, const float* b1, const float* w2, const float* b2, float* hid, int L, int gw, int NGW, int lane) {
    float w1c[33], w2c[64];
    UNR for (int i = 0; i < 33; ++i) w1c[i] = w1[i * 64 + lane];
    UNR for (int i = 0; i < 64; ++i) w2c[i] = w2[i * 64 + lane];
    const float bb1 = b1[lane], bb2 = b2[lane];
    for (int t = gw; t < L; t += NGW) {
        float feat = 0.f;
        if (lane == 0) feat = (float)t / (float)(L - 1 > 1 ? L - 1 : 1);
        else if (lane < 33) { const int b = (lane - 1) & 15; const float band = 1e-4f + (float)b * ((15.0f - 1e-4f) / 15.0f);
            const float x = 2.0f * band * (float)t / (float)L; float s, c; sincospi_f(x, &s, &c); feat = (lane <= 16) ? c : -s; }
        float a = bb1;
        UNR for (int i = 0; i < 33; ++i) a += shfl_f(feat, i) * w1c[i];
        const float h1 = sinf(a);
        float b = bb2;
        UNR for (int i = 0; i < 64; ++i) b += shfl_f(h1, i) * w2c[i];
        if (BF) ((bf16_t*)hid)[(size_t)t * 64 + lane] = (bf16_t)f2bf(sinf(b)); else hid[(size_t)t * 64 + lane] = sinf(b);
    }
}

DEVFN void r2_build_bfrag(const Ctx& C);
DEVFN void ph_prologue(const Ctx& C, unsigned char* lds) {
    const int gw = C.vcu * NWAVES + C.wave, NGW = C.G * NWAVES, lane = C.lane;
    float* scr = (float*)(lds + C.wave * 16384);
    {
        constexpr int I_AIN = 16 * (AIN / 32), I_OUT = 16 * 32, I_RIN = 16 * (RIN / 32);
        constexpr int NIT = 2 * (I_AIN + I_OUT + I_RIN + I_OUT);
        for (int it = gw; it < NIT; it += NGW) {
            int r = it; const int li = r & 1; r >>= 1;
            if (r < I_AIN) { p0_transpose_item(C.in[I_AWIN] + (size_t)li * DM * AIN, DM, AIN, (bf16_t*)(C.ws + WS_WAIN) + (size_t)li * AIN * DM, scr, r, lane); continue; } r -= I_AIN;
            if (r < I_OUT) { p0_transpose_item(C.in[I_AWOUT] + (size_t)li * DM * DM, DM, DM, (bf16_t*)(C.ws + WS_WAOUT) + (size_t)li * DM * DM, scr, r, lane); continue; } r -= I_OUT;
            if (r < I_RIN) { p0_transpose_item(C.in[I_RWIN] + (size_t)li * DM * RIN, DM, RIN, (bf16_t*)(C.ws + WS_WRIN) + (size_t)li * RINP * DM, scr, r, lane); continue; } r -= I_RIN;
            p0_transpose_item(C.in[I_RWOUT] + (size_t)li * DM * DM, DM, DM, (bf16_t*)(C.ws + WS_WROUT) + (size_t)li * DM * DM, scr, r, lane);
        }
        for (int e = gw * 64 + lane; e < 2 * (RINP - RIN) * DM / 8; e += NGW * 64) { const int li = e / ((RINP - RIN) * DM / 8), o = e % ((RINP - RIN) * DM / 8);
            U4 z; z.x = z.y = z.z = z.w = 0u; st16((bf16_t*)(C.ws + WS_WRIN) + (size_t)li * RINP * DM + (size_t)RIN * DM + (size_t)o * 8, z); }
    }
    {
        float* ADA = (float*)(C.ws + WS_ADA);
        for (int it = gw; it < 4 * 48; it += NGW) {
            const int layer = it / 48, cb = it % 48, col = cb * 64 + lane, i = layer >> 1;
            const float* W = (layer & 1) ? C.in[I_RADAW] + (size_t)i * DM * 3072 : C.in[I_AADAW] + (size_t)i * DM * 3072;
            const float* B = (layer & 1) ? C.in[I_RADAB] + (size_t)i * 3072 : C.in[I_AADAB] + (size_t)i * 3072;
            float a0 = 0.f, a1 = 0.f;
            for (int k0 = 0; k0 < DM; k0 += 64) {
                const float sc = silu_f(C.in[I_C][k0 + lane]), sx = silu_f(C.in[I_CCTX][k0 + lane]);
                for (int k = 0; k < 64; ++k) { const float w = W[(size_t)(k0 + k) * 3072 + col]; a0 += shfl_f(sc, k) * w; a1 += shfl_f(sx, k) * w; }
            }
            ADA[(size_t)(layer * 2 + 0) * 3072 + col] = a0 + B[col];
            ADA[(size_t)(layer * 2 + 1) * 3072 + col] = a1 + B[col];
        }
    }
    for (int i = 0; i < 2; ++i)
        hid_rows<true>(C.in[I_HW1] + (size_t)i * 33 * 64, C.in[I_HB1] + i * 64, C.in[I_HW2] + (size_t)i * 64 * 64, C.in[I_HB2] + i * 64, (float*)((bf16_t*)(C.ws + WS_HID) + (size_t)i * NLAT * 64), NLAT, gw, NGW, lane);
    hid_rows<false>(C.in[I_HW1], C.in[I_HB1], C.in[I_HW2], C.in[I_HB2], (float*)(C.ws + WS_HID256), NCTX, gw, NGW, lane);
    r2_build_bfrag(C);
    { F2* TW = (F2*)(C.ws + WS_TW);
      for (int k = gw * 64 + lane; k <= 16384; k += NGW * 64) { float s, c; sincospi_f((float)k * (1.0f / 16384.0f), &s, &c); F2 w; w.x = c; w.y = -s; TW[k] = w; } }
}

DEVFN void ph_norm(const Ctx& C, int layer, const float* xlat, const float* xctx, bool do_ctx) {
    const int gw = C.vcu * NWAVES + C.wave, NGW = C.G * NWAVES, lane = C.lane, i = layer >> 1;
    const float* gain = ((layer & 1) ? C.in[I_RNORM] : C.in[I_ANORM]) + (size_t)i * DM;
    const float* ADA = (const float*)(C.ws + WS_ADA) + (size_t)layer * 2 * 3072;
    bf16_t* XN = (bf16_t*)(C.ws + WS_XN);
    const int nrows = do_ctx ? NTOK : NLAT;
    for (int m = gw; m < nrows; m += NGW) {
        const bool isctx = m >= NLAT;
        const float* xr = isctx ? xctx + (size_t)(m - NLAT) * DM : xlat + (size_t)m * DM;
        const float* ada = ADA + (isctx ? 3072 : 0);
        F4 v[4]; float s = 0.f;
        UNR for (int j = 0; j < 4; ++j) { v[j] = *(const F4*)(xr + 256 * j + 4 * lane); s += (v[j].x * v[j].x + v[j].y * v[j].y) + (v[j].z * v[j].z + v[j].w * v[j].w); }
        const float rs = 1.0f / sqrtf(wave_sum(s) * (1.0f / DM) + NORM_EPS);
        UNR for (int j = 0; j < 4; ++j) { const int c0 = 256 * j + 4 * lane;
            const F4 g = *(const F4*)(gain + c0), sh = *(const F4*)(ada + c0), sc = *(const F4*)(ada + 1024 + c0);
            U2 o; o.x = pk2(v[j].x * rs * g.x * (1.f + sc.x) + sh.x, v[j].y * rs * g.y * (1.f + sc.y) + sh.y);
            o.y = pk2(v[j].z * rs * g.z * (1.f + sc.z) + sh.z, v[j].w * rs * g.w * (1.f + sc.w) + sh.w);
            *(U2*)(XN + (size_t)m * DM + c0) = o; }
    }
}

DEVFN void ph_final(const Ctx& C) {
    const int gw = C.vcu * NWAVES + C.wave, NGW = C.G * NWAVES, lane = C.lane;
    const float* gain = C.in[I_FNORM];
    for (int m = gw; m < NLAT; m += NGW) {
        float* xr = C.out + (size_t)m * DM;
        F4 v[4]; float s = 0.f;
        UNR for (int j = 0; j < 4; ++j) { v[j] = *(const F4*)(xr + 256 * j + 4 * lane); s += (v[j].x * v[j].x + v[j].y * v[j].y) + (v[j].z * v[j].z + v[j].w * v[j].w); }
        const float rs = 1.0f / sqrtf(wave_sum(s) * (1.0f / DM) + NORM_EPS);
        UNR for (int j = 0; j < 4; ++j) { const int c0 = 256 * j + 4 * lane; const F4 g = *(const F4*)(gain + c0);
            F4 o; o.x = v[j].x * rs * g.x; o.y = v[j].y * rs * g.y; o.z = v[j].z * rs * g.z; o.w = v[j].w * rs * g.w; *(F4*)(xr + c0) = o; }
    }
}

DEVFN void ph_qkprep(const Ctx& C, int i) {
    const int gw = C.vcu * NWAVES + C.wave, NGW = C.G * NWAVES, lane = C.lane;
    bf16_t* U = (bf16_t*)(C.ws + WS_U);
    const float qg = C.in[I_QG][i * 64 + lane], kg = C.in[I_KG][i * 64 + lane];
    const int axis = lane >> 5, half = (lane >> 4) & 1, f = lane & 15;
    const float invf = exp2f(-(float)f * (13.287712379549449f / 16.0f));
    for (int m = gw; m < NTOK; m += NGW) {
        float cs = 1.f, sn = 0.f;
        if (m < NLAT) { const float pos = (float)(axis == 0 ? (m >> 6) : (m & 63)); const float ang = pos * invf; cs = cosf(ang); sn = sinf(ang); }
        bf16_t* ur = U + (size_t)m * AIN + 2048;
        for (int h = 0; h < 10; ++h) {
            const float v = bf2f(ur[h * 64 + lane]);
            const float ss = wave_sum(v * v);
            float y = v * (1.0f / sqrtf(ss * (1.0f / 64.0f) + NORM_EPS)) * (h < 8 ? qg : kg);
            const float p = swap16_f(y);
            y = half == 0 ? y * cs - p * sn : y * cs + p * sn;
            if (h < 8) y *= C2;
            ur[h * 64 + lane] = (bf16_t)f2bf(y);
        }
    }
}

DEVFN void ph_hyprep(const Ctx& C, int i, bool do_ctx, unsigned char* lds) {
    const int tid = C.tid;
    const bf16_t* UHY = (const bf16_t*)(C.ws + WS_UHY);
    const float* taps = C.in[I_HSHORT] + (size_t)i * 3 * UHY_W;
    float* T = (float*)lds;
    const int ntile_lat = 3 * 8 * 256, ntile = ntile_lat + (do_ctx ? 3 * 8 * 4 : 0);
    for (int it = C.vcu; it < ntile; it += C.G) {
        const bool isctx = it >= ntile_lat; const int r = isctx ? it - ntile_lat : it;
        const int ntb = isctx ? 4 : 256; const int tb = r % ntb, cb = (r / ntb) & 7, g = r / (ntb * 8);
        const int seg0 = isctx ? NLAT : 0, segn = isctx ? NCTX : NLAT;
        {
            const int tl = tid >> 3, c8 = (tid & 7) * 8, t = 64 * tb + tl, col = g * 512 + 64 * cb + c8;
            float um[8], u0[8], up[8];
            unpack8(ld16(UHY + (size_t)(seg0 + t) * UHY_W + col), u0);
            if (t > 0) unpack8(ld16(UHY + (size_t)(seg0 + t - 1) * UHY_W + col), um); else UNR for (int e = 0; e < 8; ++e) um[e] = 0.f;
            if (t < segn - 1) unpack8(ld16(UHY + (size_t)(seg0 + t + 1) * UHY_W + col), up); else UNR for (int e = 0; e < 8; ++e) up[e] = 0.f;
            UNR for (int e = 0; e < 8; ++e) T[(c8 + e) * 65 + tl] = um[e] * taps[col + e] + u0[e] * taps[UHY_W + col + e] + up[e] * taps[2 * UHY_W + col + e];
        }
        SYNC();
        {
            const int cl = tid >> 3, t8 = (tid & 7) * 8, ch = 64 * cb + cl;
            float v[8]; UNR for (int e = 0; e < 8; ++e) v[e] = T[cl * 65 + t8 + e];
            if (!isctx) { bf16_t* VX = (bf16_t*)(C.ws + (g == 0 ? WS_VX0 : g == 1 ? WS_VX1 : WS_VX2)); st16(VX + (size_t)ch * NLAT + 64 * tb + t8, pack8(v)); }
            else { float* VXC = (float*)(C.ws + WS_VXC) + ((size_t)g * 512 + ch) * NCTX + 64 * tb + t8; UNR for (int e = 0; e < 8; ++e) VXC[e] = v[e]; }
        }
        SYNC();
    }
}

typedef float P2 __attribute__((vector_size(8)));
#ifdef EMU
struct H8 { unsigned short v[8]; };
struct A4 { float v[4]; };
inline A4 mfma16(const H8& a, const H8& b, const A4& c) {
    static H8 sa_[emu::MAXB][8][64], sb_[emu::MAXB][8][64]; const int w = emu::t_tid >> 6, l = emu::t_tid & 63; H8 (*sa)[64] = sa_[emu::t_blk]; H8 (*sb)[64] = sb_[emu::t_blk];
    sa[w][l] = a; sb[w][l] = b; pthread_barrier_wait(&emu::g_wbar_[emu::t_blk][w]);
    A4 r = c;
    for (int reg = 0; reg < 4; ++reg) { const int row = 4 * (l >> 4) + reg, col = l & 15; float acc = 0.f;
        for (int k = 0; k < 32; ++k) acc += bf2f(sa[w][row + 16 * (k >> 3)].v[k & 7]) * bf2f(sb[w][col + 16 * (k >> 3)].v[k & 7]);
        r.v[reg] += acc; }
    pthread_barrier_wait(&emu::g_wbar_[emu::t_blk][w]);
    return r;
}
#define H8_SET(h, j, x) (h).v[j] = (unsigned short)(x)
#define A4_GET(a, j) (a).v[j]
#define MFMA_PAD(a,b,c,d,e,f,g,h)
#else
typedef short H8 __attribute__((ext_vector_type(8)));
typedef float A4 __attribute__((ext_vector_type(4)));
DEVFN A4 mfma16(const H8& a, const H8& b, const A4& c) { return __builtin_amdgcn_mfma_f32_16x16x32_bf16(a, b, c, 0, 0, 0); }
#define H8_SET(h, j, x) (h)[j] = (short)(x)
#define A4_GET(a, j) (a)[j]
#define MFMA_PAD(a,b,c,d,e,f,g,h) asm volatile("s_nop 15\n\ts_nop 15" : "+v"(a), "+v"(b), "+v"(c), "+v"(d), "+v"(e), "+v"(f), "+v"(g), "+v"(h))
#endif
#ifdef EMU
#define FEXP(x) expf(x)
#define FLOG(x) logf(x)
#define FRCP(x) (1.0f / (x))
#define FRSQ(x) (1.0f / sqrtf(x))
#define SETPRIO(n)
#else
#define FEXP(x) __expf(x)
#define FLOG(x) __logf(x)
#define FRCP(x) __builtin_amdgcn_rcpf(x)
#define FRSQ(x) __builtin_amdgcn_rsqf(x)
#define SETPRIO(n) __builtin_amdgcn_s_setprio(n)
#endif
DEVFN H8 h8_from_u4(U4 w) { H8 r; H8_SET(r, 0, w.x & 0xffff); H8_SET(r, 1, w.x >> 16); H8_SET(r, 2, w.y & 0xffff); H8_SET(r, 3, w.y >> 16); H8_SET(r, 4, w.z & 0xffff); H8_SET(r, 5, w.z >> 16); H8_SET(r, 6, w.w & 0xffff); H8_SET(r, 7, w.w >> 16); return r; }
constexpr int FFT_N = 16384;
DEVFN int fidx(int n) { return n + (n >> 4); }
DEVFN F2 cmul(F2 a, F2 b) { F2 r; r.x = a.x * b.x - a.y * b.y; r.y = a.x * b.y + a.y * b.x; return r; }
DEVFN F2 cmulc(F2 a, F2 b) { F2 r; r.x = a.x * b.x + a.y * b.y; r.y = a.y * b.x - a.x * b.y; return r; }
DEVFN F2 cadd(F2 a, F2 b) { F2 r; r.x = a.x + b.x; r.y = a.y + b.y; return r; }
DEVFN F2 csub(F2 a, F2 b) { F2 r; r.x = a.x - b.x; r.y = a.y - b.y; return r; }
DEVFN F2 cconj(F2 a) { F2 r; r.x = a.x; r.y = -a.y; return r; }
template <bool INV> DEVFN F2 mul_mi(F2 a) { F2 r; if (!INV) { r.x = a.y; r.y = -a.x; } else { r.x = -a.y; r.y = a.x; } return r; }
template <bool INV> DEVFN void dft4(F2& a0, F2& a1, F2& a2, F2& a3) {
    const F2 s02 = cadd(a0, a2), d02 = csub(a0, a2), s13 = cadd(a1, a3), d13 = mul_mi<INV>(csub(a1, a3));
    a0 = cadd(s02, s13); a2 = csub(s02, s13); a1 = cadd(d02, d13); a3 = csub(d02, d13);
}
template <bool INV> DEVFN void dft16(F2* a) {
    UNR for (int n2 = 0; n2 < 4; ++n2) dft4<INV>(a[n2], a[4 + n2], a[8 + n2], a[12 + n2]);
    const float c1 = 0.92387953251128674f, s1 = 0.38268343236508977f, r2 = 0.70710678118654752f;
    const F2 w1 = {c1, INV ? s1 : -s1}, w2 = {r2, INV ? r2 : -r2}, w3 = {s1, INV ? c1 : -c1}, w6 = {-r2, INV ? r2 : -r2}, w9 = {-c1, INV ? -s1 : s1};
    a[4 * 1 + 1] = cmul(a[4 * 1 + 1], w1); a[4 * 1 + 2] = cmul(a[4 * 1 + 2], w2); a[4 * 1 + 3] = cmul(a[4 * 1 + 3], w3);
    a[4 * 2 + 1] = cmul(a[4 * 2 + 1], w2); a[4 * 2 + 2] = mul_mi<INV>(a[4 * 2 + 2]); a[4 * 2 + 3] = cmul(a[4 * 2 + 3], w6);
    a[4 * 3 + 1] = cmul(a[4 * 3 + 1], w3); a[4 * 3 + 2] = cmul(a[4 * 3 + 2], w6); a[4 * 3 + 3] = cmul(a[4 * 3 + 3], w9);
    F2 x[16];
    UNR for (int k1 = 0; k1 < 4; ++k1) { F2 b0 = a[4 * k1 + 0], b1 = a[4 * k1 + 1], b2 = a[4 * k1 + 2], b3 = a[4 * k1 + 3]; dft4<INV>(b0, b1, b2, b3); x[k1] = b0; x[k1 + 4] = b1; x[k1 + 8] = b2; x[k1 + 12] = b3; }
    UNR for (int q = 0; q < 16; ++q) a[q] = x[q];
}
template <int R, bool INV> DEVFN void fft_stage(F2* F, const F2* TW, int B, int tid) {
    const int S = B / R, NB = FFT_N / R, tws = 2 * (FFT_N / B);
    int tq = tid; OPAQUE(tq);
    UNR1 for (int q = tq; q < NB; q += NTHREADS) {
        const int blk = q / S, j = q - blk * S, base = blk * B + j;
        F2 a[R];
        UNR for (int m = 0; m < R; ++m) a[m] = F[fidx(base + m * S)];
        if (INV && S > 1) { const F2 w1 = TW[tws * j]; F2 w = w1; UNR for (int m = 1; m < R; ++m) { a[m] = cmulc(a[m], w); w = cmul(w, w1); } }
        if constexpr (R == 4) dft4<INV>(a[0], a[1], a[2], a[3]); else dft16<INV>(a);
        if (!INV && S > 1) { const F2 w1 = TW[tws * j]; F2 w = w1; UNR for (int m = 1; m < R; ++m) { a[m] = cmul(a[m], w); w = cmul(w, w1); } }
        UNR for (int m = 0; m < R; ++m) F[fidx(base + m * S)] = a[m];
    }
}
DEVFN void fft_fwd(F2* F, const F2* TW, int tid) {
    fft_stage<4, false>(F, TW, 16384, tid); SYNC(); fft_stage<16, false>(F, TW, 4096, tid); SYNC(); fft_stage<16, false>(F, TW, 256, tid); SYNC(); fft_stage<16, false>(F, TW, 16, tid); SYNC();
}
DEVFN void fft_inv(F2* F, const F2* TW, int tid) {
    fft_stage<16, true>(F, TW, 16, tid); SYNC(); fft_stage<16, true>(F, TW, 256, tid); SYNC(); fft_stage<16, true>(F, TW, 4096, tid); SYNC(); fft_stage<4, true>(F, TW, 16384, tid); SYNC();
}
DEVFN int fpos(int k) { return ((k & 3) << 12) | (((k >> 2) & 15) << 8) | (((k >> 6) & 15) << 4) | (k >> 10); }

DEVFN float block_sum(float v, float* red, int tid) {
    v = wave_sum(v);
    if ((tid & 63) == 0) red[tid >> 6] = v;
    SYNC();
    float s = 0.f; UNR for (int w = 0; w < NWAVES; ++w) s += red[w];
    SYNC();
    return s;
}

#ifdef EMU
#define SCHED_BAR()
#else
#define SCHED_BAR() __builtin_amdgcn_sched_barrier(0)
#endif
#if defined(HSEC)
#define HS_B(k) do { if (HSEC == (k)) { TACC_BEGIN; } } while (0)
#define HS_E(k) do { if (HSEC == (k)) { TACC_END; } } while (0)
#else
#define HS_B(k)
#define HS_E(k)
#endif
DEVFN void hyena_channel(const Ctx& C, int i, int c, unsigned char* lds) {
    const int tid = C.tid; constexpr int L = NLAT;
    F2* F = (F2*)lds; float* Ff = (float*)lds;
    float* W3C = (float*)(lds + 139264);
    float* red = W3C + 272;
    const F2* TW = (const F2*)(C.ws + WS_TW);
    const bf16_t* hidb = (const bf16_t*)(C.ws + WS_HID) + (size_t)i * NLAT * 64;
    const float* w3 = C.in[I_HW3] + (size_t)i * 64 * 2048; const float* b3 = C.in[I_HB3] + (size_t)i * 2048;
    const bf16_t* VX0 = (const bf16_t*)(C.ws + WS_VX0) + (size_t)c * L;
    const bf16_t* VX1 = (const bf16_t*)(C.ws + WS_VX1) + (size_t)c * L;
    const bf16_t* VX2 = (const bf16_t*)(C.ws + WS_VX2) + (size_t)c * L;
    bf16_t* YHY = (bf16_t*)(C.ws + WS_YHY) + (size_t)c * L;
    const float skip0 = C.in[I_HSKIP][(size_t)i * 1024 + c], skip1 = C.in[I_HSKIP][(size_t)i * 1024 + 512 + c];
    const float delta = 15.350567286626973f + (float)c * ((3.0701134573253945f - 15.350567286626973f) / 511.0f);
    if (tid < 256) { const int o = tid >> 7, s = (tid >> 6) & 1, m = tid & 63; W3C[tid] = w3[(size_t)m * 2048 + (s * 2 + o) * 512 + c]; }
    if (tid < 4) W3C[256 + tid] = b3[((tid & 1) * 2 + (tid >> 1)) * 512 + c];
    SYNC();
    TACC_DECL;
    unsigned ktap1[32];
    UNR1 for (int o = 0; o < 2; ++o) {
        HS_B(1);
        float ssq = 0.f, af0_ = 0.f, ab0_ = 0.f;
        if (o == 0) {
            int tqa = tid; OPAQUE(tqa); const int lane = tqa & 63, wv = tqa >> 6, l15 = lane & 15, kg = lane >> 4, rr = l15 & 3, gq = l15 >> 2;
            H8 Ag[4][2];
            { float f0[8], f1[8]; UNR for (int j = 0; j < 8; ++j) { f0[j] = W3C[rr * 64 + 8 * kg + j]; f1[j] = W3C[rr * 64 + 32 + 8 * kg + j]; }
              const U4 w0 = pack8(f0), w1 = pack8(f1);
              UNR for (int g = 0; g < 4; ++g) { const unsigned m_ = gq == g ? 0xffffffffu : 0u; U4 a0, a1; a0.x = w0.x & m_; a0.y = w0.y & m_; a0.z = w0.z & m_; a0.w = w0.w & m_; a1.x = w1.x & m_; a1.y = w1.y & m_; a1.z = w1.z & m_; a1.w = w1.w & m_;
                  Ag[g][0] = h8_from_u4(a0); Ag[g][1] = h8_from_u4(a1); } }
            const float b00 = W3C[256 + 0], b01 = W3C[256 + 1], b10 = W3C[256 + 2], b11 = W3C[256 + 3];
            const bf16_t* hp = hidb + (size_t)l15 * 64 + 8 * kg;
            U4 bq[4][2];
            UNR for (int g = 0; g < 4; ++g) { bq[g][0] = ld16(hp + (size_t)(wv * 64 + 16 * g) * 64); bq[g][1] = ld16(hp + (size_t)(wv * 64 + 16 * g) * 64 + 32); }
            UNR for (int ii = 0; ii < 32; ++ii) {
                const int t0 = (ii * 8 + wv) * 64;
                U4 bn[4][2];
                if (ii + 1 < 32) { UNR for (int g = 0; g < 4; ++g) { bn[g][0] = ld16(hp + (size_t)(t0 + 512 + 16 * g) * 64); bn[g][1] = ld16(hp + (size_t)(t0 + 512 + 16 * g) * 64 + 32); } }
                SCHED_BAR();
                A4 acc; A4_GET(acc, 0) = 0.f; A4_GET(acc, 1) = 0.f; A4_GET(acc, 2) = 0.f; A4_GET(acc, 3) = 0.f;
                UNR for (int g = 0; g < 4; ++g) { acc = mfma16(Ag[g][0], h8_from_u4(bq[g][0]), acc); acc = mfma16(Ag[g][1], h8_from_u4(bq[g][1]), acc); }
                MFMA_PAD(acc, acc, acc, acc, acc, acc, acc, acc);
                int ln_ = lane; OPAQUE(ln_); const int t = t0 + ln_;
                const float win = expf(-((float)t / (float)(L - 1)) * delta);
                const float af = (A4_GET(acc, 0) + b00) * win; const float ab = (A4_GET(acc, 1) + b01) * win;
                ktap1[ii] = pk2((A4_GET(acc, 2) + b10) * win, (A4_GET(acc, 3) + b11) * win);
                ssq += af * af + ab * ab; Ff[2 * fidx(t >> 1) + (t & 1)] = af; const int m = t == 0 ? L : 2 * L - t; Ff[2 * fidx(m >> 1) + (m & 1)] = ab;
                if (ii == 0) { af0_ = af; ab0_ = ab; }
                SCHED_BAR();
                if (ii + 1 < 32) { UNR for (int g = 0; g < 4; ++g) { bq[g][0] = bn[g][0]; bq[g][1] = bn[g][1]; } }
            }
        } else {
            int tqb = tid; OPAQUE(tqb); const int lane = tqb & 63, wv = tqb >> 6;
            UNR for (int ii = 0; ii < 32; ++ii) {
                int ln_ = lane; OPAQUE(ln_); const int t = (ii * 8 + wv) * 64 + ln_; const float af = bflo(ktap1[ii]); const float ab = bfhi(ktap1[ii]);
                ssq += af * af + ab * ab; Ff[2 * fidx(t >> 1) + (t & 1)] = af; const int m = t == 0 ? L : 2 * L - t; Ff[2 * fidx(m >> 1) + (m & 1)] = ab;
                if (ii == 0) { af0_ = af; ab0_ = ab; }
                if ((ii & 3) == 3) SCHED_BAR();
            }
        }
        if (tid == 0) { Ff[0] = af0_ + ab0_; Ff[2 * fidx(L >> 1)] = 0.f; ssq += 2.f * af0_ * ab0_; }
        const float knorm = 1.0f / sqrtf(block_sum(ssq, red, tid)); HS_E(1);
        HS_B(2); fft_fwd(F, TW, tid); HS_E(2);
        HS_B(3);
        F2 kfa[16], kfb[16]; F2 kfh = {0.f, 0.f};
        int tq1 = tid; OPAQUE(tq1);
        UNR for (int ii = 0; ii < 16; ++ii) {
            const int k = tq1 + NTHREADS * ii;
            if (k == 0) { const F2 c0 = F[fidx(0)]; kfa[ii].x = (c0.x + c0.y) * knorm; kfa[ii].y = 0.f; kfb[ii].x = (c0.x - c0.y) * knorm; kfb[ii].y = 0.f;
                          const F2 ch = F[fidx(fpos(L / 2))]; kfh.x = ch.x * knorm; kfh.y = -ch.y * knorm; }
            else { const F2 ck = F[fidx(fpos(k))], cp = cconj(F[fidx(fpos(L - k))]);
                F2 e = cadd(ck, cp), od = csub(ck, cp); e.x *= 0.5f; e.y *= 0.5f; F2 oo; oo.x = 0.5f * od.y; oo.y = -0.5f * od.x;
                const F2 tt = cmul(TW[k], oo);
                kfa[ii] = cadd(e, tt); kfb[ii] = cconj(csub(e, tt)); kfa[ii].x *= knorm; kfa[ii].y *= knorm; kfb[ii].x *= knorm; kfb[ii].y *= knorm; }
            CFENCE();
        }
        SYNC(); HS_E(3);
        HS_B(4);
        UNR for (int ii = 0; ii < 4; ++ii) {
            int tq3 = tid; OPAQUE(tq3); const int t0 = 8 * (tq3 + NTHREADS * ii); float v[8];
            unpack8(ld16((o == 0 ? VX0 : (const bf16_t*)YHY) + t0), v);
            float* d = Ff + 2 * fidx(t0 >> 1); UNR for (int e = 0; e < 8; ++e) d[e] = v[e];
            float* zz = Ff + 2 * fidx((L + t0) >> 1); UNR for (int e = 0; e < 8; ++e) zz[e] = 0.f;
        }
        SYNC(); HS_E(4);
        HS_B(2); fft_fwd(F, TW, tid); HS_E(2);
        HS_B(3);
        int tq2 = tid; OPAQUE(tq2);
        UNR for (int ii = 0; ii < 16; ++ii) {
            const int k = tq2 + NTHREADS * ii;
            if (k == 0) { const F2 c0 = F[fidx(0)]; const float y0 = (c0.x + c0.y) * kfa[ii].x, yl = (c0.x - c0.y) * kfb[ii].x; F2 d; d.x = 0.5f * (y0 + yl); d.y = 0.5f * (y0 - yl); F[fidx(0)] = d;
                          const int ph = fidx(fpos(L / 2)); const F2 y = cmul(cconj(F[ph]), kfh); F[ph] = cconj(y); }
            else { const int pk = fidx(fpos(k)), pp = fidx(fpos(L - k)); const F2 ck = F[pk], cp = cconj(F[pp]);
                F2 e = cadd(ck, cp), od = csub(ck, cp); e.x *= 0.5f; e.y *= 0.5f; F2 oo; oo.x = 0.5f * od.y; oo.y = -0.5f * od.x;
                const F2 w = TW[k]; const F2 tt = cmul(w, oo);
                const F2 yk = cmul(cadd(e, tt), kfa[ii]), yp = cmul(cconj(csub(e, tt)), kfb[ii]);
                F2 ye = cadd(yk, cconj(yp)), yd = csub(yk, cconj(yp)); ye.x *= 0.5f; ye.y *= 0.5f; yd.x *= 0.5f; yd.y *= 0.5f;
                const F2 yo = cmulc(yd, w);
                F2 iyo; iyo.x = -yo.y; iyo.y = yo.x;
                F[pk] = cadd(ye, iyo); F[pp] = cconj(csub(ye, iyo)); }
            CFENCE();
        }
        SYNC(); HS_E(3);
        HS_B(2); fft_inv(F, TW, tid); HS_E(2);
        HS_B(4);
        UNR for (int ii = 0; ii < 4; ++ii) {
            int tq4 = tid; OPAQUE(tq4); const int t0 = 8 * (tq4 + NTHREADS * ii); const float* d = Ff + 2 * fidx(t0 >> 1);
            float y[8]; UNR for (int e = 0; e < 8; ++e) y[e] = d[e] * (1.0f / (float)FFT_N);
            if (o == 0) { float v[8], x1[8], r[8]; unpack8(ld16(VX0 + t0), v); unpack8(ld16(VX1 + t0), x1); UNR for (int e = 0; e < 8; ++e) r[e] = x1[e] * (y[e] + v[e] * skip0); st16(YHY + t0, pack8(r)); }
            else { float x2[8], zp[8], r[8]; unpack8(ld16(VX2 + t0), x2); unpack8(ld16(YHY + t0), zp); UNR for (int e = 0; e < 8; ++e) r[e] = x2[e] * (y[e] + zp[e] * skip1); st16(YHY + t0, pack8(r)); }
        }
        SYNC(); HS_E(4);
    }
    TACC_STORE(C, 39, C.vcu == C.G - 1 && tid == 0);
}

DEVFN void hyena_ctx_channel(const Ctx& C, int i, int c, unsigned char* lds) {
    const int tid = C.tid; constexpr int L = NCTX;
    float* KF = (float*)lds;
    float* Z = KF + 1024;
    float* red = Z + 256;
    float* W3C = red + 16;
    const float* hid = (const float*)(C.ws + WS_HID256);
    const float* w3 = C.in[I_HW3] + (size_t)i * 64 * 2048; const float* b3 = C.in[I_HB3] + (size_t)i * 2048;
    const float* VXC = (const float*)(C.ws + WS_VXC);
    const float delta = 15.350567286626973f + (float)c * ((3.0701134573253945f - 15.350567286626973f) / 511.0f);
    if (tid < 256) { const int o = tid >> 7, s = (tid >> 6) & 1, m = tid & 63; W3C[tid] = w3[(size_t)m * 2048 + (s * 2 + o) * 512 + c]; }
    if (tid < 4) W3C[256 + tid] = b3[((tid & 1) * 2 + (tid >> 1)) * 512 + c];
    SYNC();
    {
        const int o = tid >> 8, t = tid & 255;
        float af = W3C[256 + o * 2 + 0], ab = W3C[256 + o * 2 + 1];
        for (int m = 0; m < 64; ++m) { const float h = hid[t * 64 + m]; af += h * W3C[(o * 2 + 0) * 64 + m]; ab += h * W3C[(o * 2 + 1) * 64 + m]; }
        const float win = expf(-((float)t / (float)(L - 1)) * delta); af *= win; ab *= win;
        float ssq; if (t == 0) { af += ab; ab = 0.f; ssq = af * af; } else ssq = af * af + ab * ab;
        KF[(o * 2 + 0) * 256 + t] = af; KF[(o * 2 + 1) * 256 + t] = ab;
        ssq = wave_sum(ssq);
        if ((tid & 63) == 0) red[tid >> 6] = ssq;
        SYNC();
        const float tot = red[o * 4] + red[o * 4 + 1] + red[o * 4 + 2] + red[o * 4 + 3];
        const float kn = 1.0f / sqrtf(tot);
        KF[(o * 2 + 0) * 256 + t] = af * kn; KF[(o * 2 + 1) * 256 + t] = ab * kn;
    }
    float v = 0.f, x1 = 0.f, x2 = 0.f, z1 = 0.f;
    if (tid < 256) { v = VXC[((size_t)0 * 512 + c) * L + tid]; x1 = VXC[((size_t)1 * 512 + c) * L + tid]; x2 = VXC[((size_t)2 * 512 + c) * L + tid]; Z[tid] = v; }
    SYNC();
    for (int o = 0; o < 2; ++o) {
        float y = 0.f;
        if (tid < 256) { const int t = tid; const float* kf = KF + (o * 2) * 256; const float* kb = KF + (o * 2 + 1) * 256;
            for (int s = 0; s <= t; ++s) y += kf[t - s] * Z[s];
            for (int s = t + 1; s < L; ++s) y += kb[s - t] * Z[s]; }
        SYNC();
        if (tid < 256) { if (o == 0) { z1 = x1 * (y + v * C.in[I_HSKIP][(size_t)i * 1024 + c]); Z[tid] = z1; }
            else { const float r = x2 * (y + z1 * C.in[I_HSKIP][(size_t)i * 1024 + 512 + c]);
                const bf16_t* GHY = (const bf16_t*)(C.ws + WS_GHY); bf16_t* HO = (bf16_t*)(C.ws + WS_HYOUT);
                HO[(size_t)(NLAT + tid) * 512 + c] = (bf16_t)f2bf(r * bf2f(GHY[(size_t)(NLAT + tid) * 512 + c])); } }
        SYNC();
    }
}

constexpr int SC_T = 32;
constexpr int SC_R = 16;
constexpr int SC_BUF = 5 * SC_T * 64 + SC_T * SC_R;
DEVFN void rwkv_scan(const Ctx& C, int i, int h, int d, int rq, bool ctx_out, unsigned char* lds, int max_chunks) {
    const int tid = C.tid;
    float* sBUF = (float*)lds; float* sY = sBUF + 2 * SC_BUF; float* sWV = sY + 2 * SC_T * SC_R;
    const bf16_t* U = (const bf16_t*)(C.ws + WS_U);
    const float* mu = C.in[I_MU] + (size_t)i * 1664;
    const float* w0 = C.in[I_W0] + ((size_t)i * 2 + d) * 512 + 64 * h; const float* a0 = C.in[I_A0] + ((size_t)i * 2 + d) * 512 + 64 * h;
    const float* wup = C.in[I_WUP] + ((size_t)i * 2 + d) * 32 * 512 + 64 * h; const float* aup = C.in[I_AUP] + ((size_t)i * 2 + d) * 32 * 512 + 64 * h;
    const float* k_k = C.in[I_KK] + (size_t)i * 512 + 64 * h; const float* k_a = C.in[I_KA] + (size_t)i * 512 + 64 * h; const float* r_k = C.in[I_RK] + (size_t)i * 512 + 64 * h;
    bf16_t* Yd = (bf16_t*)(C.ws + (d == 0 ? WS_YF : WS_YB));
    float* BON = (float*)(C.ws + WS_BONUS) + (size_t)d * NTOK * 8;
    const bool is_scan = tid < 256;
    const int nchunks = NTOK / SC_T < max_chunks ? NTOK / SC_T : max_chunks;
    #define CHUNK_GEOM(ch, seg0, segn, R0) const bool isctx_ = (ch) < NCTX / SC_T; const int seg0 = isctx_ ? NLAT : 0, segn = isctx_ ? NCTX : NLAT; \
        const int cl_ = isctx_ ? (ch) : (ch) - NCTX / SC_T; const int R0 = d == 0 ? SC_T * cl_ : segn - SC_T * (cl_ + 1);
    const int ft = (tid & 255) >> 3, fp = tid & 7;
    float* sCN = sWV + 4 * 1280; float* sCN_base_ = sCN;
    if (tid < 64) { const int j = tid; sCN[j] = mu[64 * h + j]; sCN[64 + j] = mu[512 + 64 * h + j]; sCN[128 + j] = mu[1024 + 64 * h + j]; sCN[192 + j] = w0[j]; sCN[256 + j] = a0[j];
        sCN[320 + j] = k_k[j]; sCN[384 + j] = k_a[j]; sCN[448 + j] = r_k[j]; sCN[512 + j] = j < 32 ? mu[1536 + 32 * d + j] : mu[1600 + 32 * d + (j - 32)]; }
    U4* sBF = (U4*)(sCN_base_ + 640);
    { const int m = tid >> 8, nt = (tid >> 6) & 3, ln = tid & 63; const float* src = m == 0 ? wup : aup; float f[8];
      UNR for (int j = 0; j < 8; ++j) f[j] = src[(size_t)(8 * (ln >> 4) + j) * 512 + 16 * nt + (ln & 15)];
      sBF[tid] = pack8(f); }
    float* myWV = sWV + ((tid >> 6) & 3) * 1280; float* sWL = myWV; float* sAL = myWV + 512; bf16_t* sTDb = (bf16_t*)(myWV + 1024); bf16_t* sADb = sTDb + 256;
    const int rl = (tid & 255) >> 4, sp = tid & 15;
    float S0 = 0.f, S1 = 0.f, S2 = 0.f, S3 = 0.f;
    SYNC();
    U4 pu[9]; U2 pw[6];
    auto issue = [&](int ch) {
        int tq_ = tid; OPAQUE(tq_); const int ft = (tq_ & 255) >> 3, fp = tq_ & 7;
        CHUNK_GEOM(ch, seg0, segn, R0)
        const int tl = d == 0 ? R0 + ft : R0 + SC_T - 1 - ft;
        const bf16_t* u0p = U + (size_t)(seg0 + tl) * URW_W;
        const bool hm = tl > 0, hp = tl < segn - 1;
        const U4 z4 = {0u, 0u, 0u, 0u}; const U2 z2 = {0u, 0u};
        const int cw = 1536 + 32 * d + 4 * fp, ca = 1600 + 32 * d + 4 * fp;
        UNR for (int j = 0; j < 3; ++j) { pu[3 * j] = ld16(u0p + 512 * j + 64 * h + 8 * fp); pu[3 * j + 1] = z4; pu[3 * j + 2] = z4; }
        pw[0] = *(const U2*)(u0p + cw); pw[3] = *(const U2*)(u0p + ca); pw[1] = z2; pw[2] = z2; pw[4] = z2; pw[5] = z2;
        if (hm) { UNR for (int j = 0; j < 3; ++j) pu[3 * j + 1] = ld16(u0p - URW_W + 512 * j + 64 * h + 8 * fp); pw[1] = *(const U2*)(u0p - URW_W + cw); pw[4] = *(const U2*)(u0p - URW_W + ca); }
        if (hp) { UNR for (int j = 0; j < 3; ++j) pu[3 * j + 2] = ld16(u0p + URW_W + 512 * j + 64 * h + 8 * fp); pw[2] = *(const U2*)(u0p + URW_W + cw); pw[5] = *(const U2*)(u0p + URW_W + ca); }
    };
    auto features = [&](int ch) {
        int tq_ = tid; OPAQUE(tq_); const int ft = (tq_ & 255) >> 3, fp = tq_ & 7;
        const float* mu_r = sCN + 8 * fp; const float* mu_k = sCN + 64 + 8 * fp; const float* mu_v = sCN + 128 + 8 * fp; const float* c_w0 = sCN + 192 + 8 * fp; const float* c_a0 = sCN + 256 + 8 * fp;
        const float* c_kk = sCN + 320 + 8 * fp; const float* c_ka = sCN + 384 + 8 * fp; const float* c_rk = sCN + 448 + 8 * fp; const float* mu_w = sCN + 512 + 4 * fp; const float* mu_a = sCN + 544 + 4 * fp;
        CHUNK_GEOM(ch, seg0, segn, R0)
        float* B_ = sBUF + (ch & 1) * SC_BUF; float* sW = B_; float* sKD = B_ + SC_T * 64; float* sB = B_ + 2 * SC_T * 64; float* sKK = B_ + 3 * SC_T * 64; float* sR = B_ + 4 * SC_T * 64; float* sV = B_ + 5 * SC_T * 64;
        const int tl = d == 0 ? R0 + ft : R0 + SC_T - 1 - ft;
        float r[8], k[8], v[8];
        {
            float a[8], m[8], p[8];
            #define SHIFT3(J, MU, OUT) do { unpack8(pu[3 * (J)], a); unpack8(pu[3 * (J) + 1], m); unpack8(pu[3 * (J) + 2], p); \
                UNR for (int e = 0; e < 8; ++e) OUT[e] = a[e] + (0.5f * (m[e] + p[e]) - a[e]) * MU[e]; } while (0)
            SHIFT3(0, mu_r, r); SHIFT3(1, mu_k, k); SHIFT3(2, mu_v, v);
            #undef SHIFT3
        }
        {
            const U2 w0_ = pw[0], wm = pw[1], wp = pw[2], a0_ = pw[3], am = pw[4], ap = pw[5];
            const float wa[4] = {bflo(w0_.x), bfhi(w0_.x), bflo(w0_.y), bfhi(w0_.y)}, wmm[4] = {bflo(wm.x), bfhi(wm.x), bflo(wm.y), bfhi(wm.y)}, wpp[4] = {bflo(wp.x), bfhi(wp.x), bflo(wp.y), bfhi(wp.y)};
            const float aa[4] = {bflo(a0_.x), bfhi(a0_.x), bflo(a0_.y), bfhi(a0_.y)}, amm[4] = {bflo(am.x), bfhi(am.x), bflo(am.y), bfhi(am.y)}, app[4] = {bflo(ap.x), bfhi(ap.x), bflo(ap.y), bfhi(ap.y)};
            if (ch + 1 < nchunks) issue(ch + 1);
            const int tw = ft & 7;
            float tdv[4], adv[4];
            UNR for (int e = 0; e < 4; ++e) { const float x = wa[e] + (0.5f * (wmm[e] + wpp[e]) - wa[e]) * mu_w[e];
                tdv[e] = 1.0f - 2.0f * FRCP(1.0f + FEXP(2.0f * x));
                adv[e] = aa[e] + (0.5f * (amm[e] + app[e]) - aa[e]) * mu_a[e]; }
            U2 tq, aq; tq.x = pk2(tdv[0], tdv[1]); tq.y = pk2(tdv[2], tdv[3]); aq.x = pk2(adv[0], adv[1]); aq.y = pk2(adv[2], adv[3]);
            *(U2*)(sTDb + tw * 32 + 4 * fp) = tq; *(U2*)(sADb + tw * 32 + 4 * fp) = aq;
        }
        WAVE_SYNC();
        float wl[8], al[8];
        {
            const int lane = tid & 63, arow = lane & 7, kg = lane >> 4;
            const U4 ta = ld16(sTDb + arow * 32 + 8 * kg), aa_ = ld16(sADb + arow * 32 + 8 * kg);
            H8 At, Aa;
            H8_SET(At, 0, ta.x & 0xffff); H8_SET(At, 1, ta.x >> 16); H8_SET(At, 2, ta.y & 0xffff); H8_SET(At, 3, ta.y >> 16); H8_SET(At, 4, ta.z & 0xffff); H8_SET(At, 5, ta.z >> 16); H8_SET(At, 6, ta.w & 0xffff); H8_SET(At, 7, ta.w >> 16);
            H8_SET(Aa, 0, aa_.x & 0xffff); H8_SET(Aa, 1, aa_.x >> 16); H8_SET(Aa, 2, aa_.y & 0xffff); H8_SET(Aa, 3, aa_.y >> 16); H8_SET(Aa, 4, aa_.z & 0xffff); H8_SET(Aa, 5, aa_.z >> 16); H8_SET(Aa, 6, aa_.w & 0xffff); H8_SET(Aa, 7, aa_.w >> 16);
            A4 cw_[4], ca_[4];
            UNR for (int nt = 0; nt < 4; ++nt) {
                A4 z; A4_GET(z, 0) = 0.f; A4_GET(z, 1) = 0.f; A4_GET(z, 2) = 0.f; A4_GET(z, 3) = 0.f;
                cw_[nt] = mfma16(At, h8_from_u4(sBF[nt * 64 + (tid & 63)]), z); ca_[nt] = mfma16(Aa, h8_from_u4(sBF[(4 + nt) * 64 + (tid & 63)]), z);
            }
            MFMA_PAD(cw_[0], cw_[1], cw_[2], cw_[3], ca_[0], ca_[1], ca_[2], ca_[3]);
            if (lane < 32) { UNR for (int nt = 0; nt < 4; ++nt) UNR for (int rg = 0; rg < 4; ++rg) { const int tok = 4 * (lane >> 4) + rg; sWL[tok * 64 + 16 * nt + (lane & 15)] = A4_GET(cw_[nt], rg); sAL[tok * 64 + 16 * nt + (lane & 15)] = A4_GET(ca_[nt], rg); } }
            WAVE_SYNC();
            const int tw = ft & 7;
            { const F4 w0_ = *(const F4*)(sWL + tw * 64 + 8 * fp), w1_ = *(const F4*)(sWL + tw * 64 + 8 * fp + 4), a0_ = *(const F4*)(sAL + tw * 64 + 8 * fp), a1_ = *(const F4*)(sAL + tw * 64 + 8 * fp + 4);
              const F4 cw0 = *(const F4*)(c_w0), cw1 = *(const F4*)(c_w0 + 4), ca0 = *(const F4*)(c_a0), ca1 = *(const F4*)(c_a0 + 4);
              wl[0] = cw0.x + w0_.x; wl[1] = cw0.y + w0_.y; wl[2] = cw0.z + w0_.z; wl[3] = cw0.w + w0_.w; wl[4] = cw1.x + w1_.x; wl[5] = cw1.y + w1_.y; wl[6] = cw1.z + w1_.z; wl[7] = cw1.w + w1_.w;
              al[0] = ca0.x + a0_.x; al[1] = ca0.y + a0_.y; al[2] = ca0.z + a0_.z; al[3] = ca0.w + a0_.w; al[4] = ca1.x + a1_.x; al[5] = ca1.y + a1_.y; al[6] = ca1.z + a1_.z; al[7] = ca1.w + a1_.w; }
            WAVE_SYNC();
        }
        float kkv[8], ssq = 0.f;
        UNR for (int e = 0; e < 8; ++e) { kkv[e] = k[e] * c_kk[e]; ssq += kkv[e] * kkv[e]; }
        ssq = rowx_add<1>(ssq); ssq = rowx_add<2>(ssq); ssq = rowx_add<7>(ssq);
        const float kn = FRSQ(ssq + 1e-12f);
        float bon = 0.f; float o_w[8], o_kd[8], o_b[8], o_kk[8];
        UNR for (int e = 0; e < 8; ++e) {
            const float dec = FEXP(-0.60653066f * FRCP(1.0f + FEXP(-wl[e])));
            const float a = FRCP(1.0f + FEXP(-al[e]));
            const float kd = k[e] * (1.0f + (a - 1.0f) * c_ka[e]);
            const float kk = kkv[e] * kn;
            o_w[e] = dec; o_kd[e] = kd; o_b[e] = kk * a; o_kk[e] = kk;
            bon += r[e] * kd * c_rk[e];
        }
        { const int o = ft * 64 + 8 * fp;
          #define ST8(P, A) do { F4 x0_, x1_; x0_.x = A[0]; x0_.y = A[1]; x0_.z = A[2]; x0_.w = A[3]; x1_.x = A[4]; x1_.y = A[5]; x1_.z = A[6]; x1_.w = A[7]; *(F4*)((P) + o) = x0_; *(F4*)((P) + o + 4) = x1_; } while (0)
          ST8(sW, o_w); ST8(sKD, o_kd); ST8(sB, o_b); ST8(sKK, o_kk); ST8(sR, r);
          #undef ST8
        }
        if ((fp >> 1) == rq) { UNR for (int e = 0; e < 8; ++e) sV[ft * SC_R + 8 * (fp & 1) + e] = v[e]; }
        bon = rowx_add<1>(bon); bon = rowx_add<2>(bon); bon = rowx_add<7>(bon);
        if (fp == 0 && rq == 0) BON[(size_t)(seg0 + tl) * 8 + h] = 0.5f * bon;
    };
    auto store_y = [&](int ch) {
        CHUNK_GEOM(ch, seg0, segn, R0)
        if (isctx_ && !ctx_out) return;
        const float* Yb = sY + (ch & 1) * SC_T * SC_R;
        const int k = (tid & 255) >> 3, q = (tid & 7) * 2; const int tl = d == 0 ? R0 + k : R0 + SC_T - 1 - k;
        *(unsigned*)(Yd + (size_t)(seg0 + tl) * 512 + 64 * h + SC_R * rq + q) = pk2(Yb[k * SC_R + q], Yb[k * SC_R + q + 1]);
    };
    if (!is_scan) { issue(0); features(0); }
    SYNC();
    if (C.wave < 4) SETPRIO(3);
    TACC_DECL;
    for (int ch = 0; ch < nchunks; ++ch) {
        TACC_BEGIN;
        if (is_scan) {
            const float* B_ = sBUF + (ch & 1) * SC_BUF; const float* sW = B_; const float* sKD = B_ + SC_T * 64; const float* sB = B_ + 2 * SC_T * 64; const float* sKK = B_ + 3 * SC_T * 64; const float* sR = B_ + 4 * SC_T * 64; const float* sV = B_ + 5 * SC_T * 64;
            float* Yb = sY + (ch & 1) * SC_T * SC_R;
            float yk0 = 0.f, yk1 = 0.f, yp = 0.f;
#ifndef EMU
            {
                const unsigned ab = (unsigned)(uintptr_t)B_ + 16u * (unsigned)sp, av = (unsigned)(uintptr_t)sV + 4u * (unsigned)rl;
                P2 s01 = {S0, S1}, s23 = {S2, S3};
                asm volatile(SCAN_CHUNK_ASM : [s01] "+v"(s01), [s23] "+v"(s23), [yp] "+v"(yp), [yk0] "+v"(yk0), [yk1] "+v"(yk1) : [ab] "v"(ab), [av] "v"(av), [sp] "v"(sp) : SCAN_CHUNK_CLOBBERS);
                S0 = s01[0]; S1 = s01[1]; S2 = s23[0]; S3 = s23[1];
            }
#else
            for (int k = 0; k < SC_T; ++k) {
                const F4 kk4 = *(const F4*)(sKK + k * 64 + 4 * sp), w4 = *(const F4*)(sW + k * 64 + 4 * sp), b4 = *(const F4*)(sB + k * 64 + 4 * sp),
                         kd4 = *(const F4*)(sKD + k * 64 + 4 * sp), r4 = *(const F4*)(sR + k * 64 + 4 * sp);
                const float vi = sV[k * SC_R + rl];
                float sa = (S0 * kk4.x + S2 * kk4.z) + (S1 * kk4.y + S3 * kk4.w);
                const float t0 = S0 * w4.x + vi * kd4.x, t1 = S1 * w4.y + vi * kd4.y, t2 = S2 * w4.z + vi * kd4.z, t3 = S3 * w4.w + vi * kd4.w;
                sa = rowx_add<1>(sa); yp = rowx_add<1>(yp); sa = rowx_add<2>(sa); yp = rowx_add<2>(yp);
                sa = rowx_add<7>(sa); yp = rowx_add<7>(yp); sa = rowx_add<15>(sa); yp = rowx_add<15>(yp);
                if (sp == ((k + 15) & 15)) { if (k <= 16) yk0 = yp; else yk1 = yp; }
                S0 = t0 - sa * b4.x; S1 = t1 - sa * b4.y; S2 = t2 - sa * b4.z; S3 = t3 - sa * b4.w;
                yp = (S0 * r4.x + S2 * r4.z) + (S1 * r4.y + S3 * r4.w);
            }
#endif
            yp = rowx_add<1>(yp); yp = rowx_add<2>(yp); yp = rowx_add<7>(yp); yp = rowx_add<15>(yp);
            if (sp == 15) yk1 = yp;
            Yb[sp * SC_R + rl] = yk0; Yb[(sp + 16) * SC_R + rl] = yk1;
        } else {
            if (ch + 1 < nchunks) features(ch + 1);
            if (ch > 0) store_y(ch - 1);
        }
        TACC_END;
        SYNC();
    }
    TACC_STORE(C, is_scan ? 45 : 46, C.vcu == 0 && (tid == 0 || tid == 256));
    if (C.wave < 4) SETPRIO(0);
    if (!is_scan) store_y(nchunks - 1);
    #undef CHUNK_GEOM
}

DEVFN void ph_readout_hyout(const Ctx& C, int i, bool do_ctx, unsigned char* lds) {
    const int tid = C.tid;
    {
        const bf16_t* U = (const bf16_t*)(C.ws + WS_U); bf16_t* YF = (bf16_t*)(C.ws + WS_YF); const bf16_t* YB = (const bf16_t*)(C.ws + WS_YB);
        const float* BON = (const float*)(C.ws + WS_BONUS);
        const float* mu = C.in[I_MU] + (size_t)i * 1664 + 1024; const float* gnw = C.in[I_GNW] + (size_t)i * 512; const float* gnb = C.in[I_GNB] + (size_t)i * 512;
        const int rl = tid >> 6, c8 = (tid & 63) * 8, h = (tid & 63) >> 3;
        float muv[8], gw_[8], gb_[8];
        UNR for (int e = 0; e < 8; ++e) { muv[e] = mu[c8 + e]; gw_[e] = gnw[c8 + e]; gb_[e] = gnb[c8 + e]; }
        const int nrows = do_ctx ? NTOK : NLAT;
        for (int r0 = C.vcu * 8; r0 < nrows; r0 += C.G * 8) {
            const int row = r0 + rl; const bool isctx = row >= NLAT; const int seg0 = isctx ? NLAT : 0, segn = isctx ? NCTX : NLAT, tl = row - seg0;
            float yf[8], yb[8], y[8], a[8], m[8], p[8], g[8];
            unpack8(ld16(YF + (size_t)row * 512 + c8), yf); unpack8(ld16(YB + (size_t)row * 512 + c8), yb);
            float s = 0.f; UNR for (int e = 0; e < 8; ++e) { y[e] = yf[e] + yb[e]; s += y[e]; }
            s = rowx_add<1>(s); s = rowx_add<2>(s); s = rowx_add<7>(s);
            const float mean = s * (1.0f / 64.0f); float q = 0.f;
            UNR for (int e = 0; e < 8; ++e) { y[e] -= mean; q += y[e] * y[e]; }
            q = rowx_add<1>(q); q = rowx_add<2>(q); q = rowx_add<7>(q);
            const float rstd = 1.0f / sqrtf(q * (1.0f / 64.0f) + 64e-5f);
            const bf16_t* up = U + (size_t)row * URW_W + 1024 + c8;
            unpack8(ld16(up), a);
            if (tl > 0) unpack8(ld16(up - URW_W), m); else UNR for (int e = 0; e < 8; ++e) m[e] = 0.f;
            if (tl < segn - 1) unpack8(ld16(up + URW_W), p); else UNR for (int e = 0; e < 8; ++e) p[e] = 0.f;
            unpack8(ld16(U + (size_t)row * URW_W + 1664 + c8), g);
            const float bon = BON[(size_t)row * 8 + h] + BON[(size_t)NTOK * 8 + (size_t)row * 8 + h];
            float o[8];
            UNR for (int e = 0; e < 8; ++e) { const float v = a[e] + (0.5f * (m[e] + p[e]) - a[e]) * muv[e]; o[e] = (y[e] * rstd * gw_[e] + gb_[e] + bon * v) * g[e]; }
            st16(YF + (size_t)row * 512 + c8, pack8(o));
        }
    }
    {
        const bf16_t* YHY = (const bf16_t*)(C.ws + WS_YHY); const bf16_t* GHY = (const bf16_t*)(C.ws + WS_GHY); bf16_t* HO = (bf16_t*)(C.ws + WS_HYOUT);
        float* T = (float*)lds;
        for (int it = C.vcu; it < 256 * 8; it += C.G) {
            const int tb = it >> 3, cb = it & 7;
            { const int cl = tid >> 3, t8 = (tid & 7) * 8; float v[8]; unpack8(ld16(YHY + (size_t)(64 * cb + cl) * NLAT + 64 * tb + t8), v); UNR for (int e = 0; e < 8; ++e) T[cl * 65 + t8 + e] = v[e]; }
            SYNC();
            { const int tl = tid >> 3, c8 = (tid & 7) * 8; float g[8], o[8]; const size_t off = (size_t)(64 * tb + tl) * 512 + 64 * cb + c8;
              unpack8(ld16(GHY + off), g); UNR for (int e = 0; e < 8; ++e) o[e] = T[(c8 + e) * 65 + tl] * g[e]; st16(HO + off, pack8(o)); }
            SYNC();
        }
    }
}

constexpr int RC_T = 16, RC_RING = 7, RC_NPROD = 6;
constexpr int RS_KKD = 0, RS_RD = 2048, RS_KIT = 4096, RS_NBIT = 6144, RS_VT = 8192, RS_T = 9216, RS_P0 = 9728, RS_Q1 = 10240, RS_NQ2 = 10752, RS_GC = 11264, RS_BYTES = 11520;
constexpr int RW_TDAD = 0, RW_WL = 2048, RW_AL = 6144, RW_KIP = 2048, RW_BIP = 4096, RW_AM = 10240, RW_BYTES = 11264;
constexpr int RC_LDS_RING = 0, RC_LDS_WAVE = RC_RING * RS_BYTES, RC_LDS_BFR = RC_LDS_WAVE + RC_NPROD * RW_BYTES, RC_LDS_FLAGS = RC_LDS_BFR + 8192, RC_LDS_END = RC_LDS_FLAGS + 3 * 8 * 4;
static_assert(RC_LDS_END <= RING_BYTES, "rwkv chunked LDS");
#ifdef EMU
#include <sched.h>
#define SPIN_WAIT(cond) do { while (!(cond)) sched_yield(); __sync_synchronize(); } while (0)
#define LDS_FENCE() __sync_synchronize()
#else
#define SPIN_WAIT(cond) do { while (!(cond)) __builtin_amdgcn_s_sleep(1); asm volatile("" ::: "memory"); } while (0)
#define LDS_FENCE() asm volatile("s_waitcnt lgkmcnt(0)" ::: "memory")
#endif
#ifdef EMU
DEVFN float wave_sum_fast(float v) { v = rowx_add<1>(v); v = rowx_add<2>(v); v = rowx_add<7>(v); v = rowx_add<15>(v); return (shfl_f(v, 0) + shfl_f(v, 16)) + (shfl_f(v, 32) + shfl_f(v, 48)); }
#else
DEVFN float wave_sum_fast(float v) { v = rowx_add<1>(v); v = rowx_add<2>(v); v = rowx_add<7>(v); v = rowx_add<15>(v);
    const int i_ = __builtin_bit_cast(int, v);
    return (__builtin_bit_cast(float, __builtin_amdgcn_readlane(i_, 0)) + __builtin_bit_cast(float, __builtin_amdgcn_readlane(i_, 16))) + (__builtin_bit_cast(float, __builtin_amdgcn_readlane(i_, 32)) + __builtin_bit_cast(float, __builtin_amdgcn_readlane(i_, 48))); }
#endif
DEVFN int rc_pos(int k) { return (k & 32) | (((k >> 2) & 3) << 3) | (((k >> 4) & 1) << 2) | (k & 3); }
DEVFN H8 h8_from(U4 w) { H8 r; H8_SET(r, 0, w.x & 0xffff); H8_SET(r, 1, w.x >> 16); H8_SET(r, 2, w.y & 0xffff); H8_SET(r, 3, w.y >> 16); H8_SET(r, 4, w.z & 0xffff); H8_SET(r, 5, w.z >> 16); H8_SET(r, 6, w.w & 0xffff); H8_SET(r, 7, w.w >> 16); return r; }
DEVFN H8 h8_lo4(U2 w) { H8 r; H8_SET(r, 0, w.x & 0xffff); H8_SET(r, 1, w.x >> 16); H8_SET(r, 2, w.y & 0xffff); H8_SET(r, 3, w.y >> 16); H8_SET(r, 4, 0); H8_SET(r, 5, 0); H8_SET(r, 6, 0); H8_SET(r, 7, 0); return r; }
DEVFN H8 h8_zero() { H8 r; UNR for (int j = 0; j < 8; ++j) H8_SET(r, j, 0); return r; }
DEVFN H8 h8_pack2(const A4& a, const A4& b) { H8 r; UNR for (int j = 0; j < 4; ++j) { H8_SET(r, j, f2bf(A4_GET(a, j))); H8_SET(r, 4 + j, f2bf(A4_GET(b, j))); } return r; }
DEVFN H8 h8_pack1(const A4& a) { H8 r; UNR for (int j = 0; j < 4; ++j) { H8_SET(r, j, f2bf(A4_GET(a, j))); H8_SET(r, 4 + j, 0); } return r; }
DEVFN A4 a4_zero() { A4 z; A4_GET(z, 0) = 0.f; A4_GET(z, 1) = 0.f; A4_GET(z, 2) = 0.f; A4_GET(z, 3) = 0.f; return z; }

DEVFN void rwkv_chunked(const Ctx& C, int i, int h, int d, int vh, bool ctx_out, unsigned char* lds, int max_chunks) {
    const int tid = C.tid, lane = tid & 63, wave = tid >> 6;
    volatile unsigned* fl_ready = (volatile unsigned*)(lds + RC_LDS_FLAGS); volatile unsigned* fl_done0 = fl_ready + 8; volatile unsigned* fl_done1 = fl_done0 + 8;
    if (tid < 24) fl_ready[tid] = 0u;
    { U4* sBF = (U4*)(lds + RC_LDS_BFR); const int m = tid >> 8, nt = (tid >> 6) & 3, ln = tid & 63;
      const float* src = (m == 0 ? C.in[I_WUP] : C.in[I_AUP]) + ((size_t)i * 2 + d) * 32 * 512 + 64 * h; float f[8];
      UNR for (int j = 0; j < 8; ++j) f[j] = src[(size_t)(8 * (ln >> 4) + j) * 512 + 16 * nt + (ln & 15)];
      sBF[tid] = pack8(f); }
    SYNC();
    const int nchunks = (NTOK / RC_T) < max_chunks ? (NTOK / RC_T) : max_chunks;
    bf16_t* Yd = (bf16_t*)(C.ws + (d == 0 ? WS_YF : WS_YB));
    #define RC_GEOM(ch, seg0, segn, R0) const bool isctx_ = (ch) < NCTX / RC_T; const int seg0 = isctx_ ? NLAT : 0, segn = isctx_ ? NCTX : NLAT; \
        const int cl_ = isctx_ ? (ch) : (ch) - NCTX / RC_T; const int R0 = d == 0 ? RC_T * cl_ : segn - RC_T * (cl_ + 1);
    if (wave < 2) {
        const int vt = wave, kg = lane >> 4, l15 = lane & 15;
        A4 H0_ = a4_zero(), H1_ = a4_zero(), H2_ = a4_zero(), H3_ = a4_zero();
        for (int ch = 0; ch < nchunks; ++ch) {
            const int slot = ch % RC_RING; const unsigned char* rb = lds + RC_LDS_RING + slot * RS_BYTES;
            SPIN_WAIT(fl_ready[slot] == (unsigned)(ch + 1));
            const H8 Hb0 = h8_pack2(H0_, H1_), Hb1 = h8_pack2(H2_, H3_);
            const H8 Vb = kg < 2 ? h8_from(ld16(rb + RS_VT + ((16 * vt + l15) * 16 + 8 * kg) * 2)) : h8_zero();
            const H8 kkd0 = h8_from(ld16(rb + RS_KKD + (l15 * 64 + 8 * kg) * 2)), kkd1 = h8_from(ld16(rb + RS_KKD + (l15 * 64 + 32 + 8 * kg) * 2));
            const H8 rd0 = h8_from(ld16(rb + RS_RD + (l15 * 64 + 8 * kg) * 2)), rd1 = h8_from(ld16(rb + RS_RD + (l15 * 64 + 32 + 8 * kg) * 2));
            const H8 p0f = kg < 2 ? h8_from(ld16(rb + RS_P0 + (l15 * 16 + 8 * kg) * 2)) : h8_zero();
            const H8 q1f = kg < 2 ? h8_from(ld16(rb + RS_Q1 + (l15 * 16 + 8 * kg) * 2)) : h8_zero();
            const H8 tf = h8_lo4(*(const U2*)(rb + RS_T + (l15 * 16 + 4 * kg) * 2)), nq2f = h8_lo4(*(const U2*)(rb + RS_NQ2 + (l15 * 16 + 4 * kg) * 2));
            A4 X = mfma16(kkd0, Hb0, a4_zero()); X = mfma16(kkd1, Hb1, X); X = mfma16(p0f, Vb, X);
            A4 Y = mfma16(rd0, Hb0, a4_zero()); Y = mfma16(rd1, Hb1, Y); Y = mfma16(q1f, Vb, Y);
            const H8 Xb = h8_pack1(X);
            const A4 U_ = mfma16(tf, Xb, a4_zero());
            const H8 Ub = h8_pack1(U_);
            Y = mfma16(nq2f, Ub, Y);
            #define HUPD(Hx, kt) do { const int kr = 16 * (kt) + l15; \
                const H8 kif = kg < 2 ? h8_from(ld16(rb + RS_KIT + (kr * 16 + 8 * kg) * 2)) : h8_zero(); const H8 nbf = h8_lo4(*(const U2*)(rb + RS_NBIT + (kr * 16 + 4 * kg) * 2)); \
                Hx = mfma16(kif, Vb, Hx); Hx = mfma16(nbf, Ub, Hx); const F4 g = *(const F4*)(rb + RS_GC + (16 * (kt) + 4 * kg) * 4); \
                A4_GET(Hx, 0) *= g.x; A4_GET(Hx, 1) *= g.y; A4_GET(Hx, 2) *= g.z; A4_GET(Hx, 3) *= g.w; } while (0)
            HUPD(H0_, 0); HUPD(H1_, 1); HUPD(H2_, 2); HUPD(H3_, 3);
            #undef HUPD
            LDS_FENCE(); WAVE_SYNC();
            if (lane == 0) { if (vt == 0) fl_done0[slot] = (unsigned)(ch + 1); else fl_done1[slot] = (unsigned)(ch + 1); }
            { RC_GEOM(ch, seg0, segn, R0)
              if (!isctx_ || ctx_out) { UNR for (int rg = 0; rg < 4; ++rg) { const int t = 4 * kg + rg, tl = d == 0 ? R0 + t : R0 + RC_T - 1 - t;
                  Yd[(size_t)(seg0 + tl) * 512 + 64 * h + 32 * vh + 16 * vt + l15] = (bf16_t)f2bf(A4_GET(Y, rg)); } } }
        }
    } else {
        const int p = wave - 2, k = lane;
        unsigned char* wsb = lds + RC_LDS_WAVE + p * RW_BYTES;
        bf16_t* sTDAD = (bf16_t*)(wsb + RW_TDAD); float* sWL = (float*)(wsb + RW_WL); float* sAL = (float*)(wsb + RW_AL); bf16_t* sKIP = (bf16_t*)(wsb + RW_KIP); bf16_t* sBIP = (bf16_t*)(wsb + RW_BIP); float* sAM = (float*)(wsb + RW_AM);
        const bf16_t* U = (const bf16_t*)(C.ws + WS_U);
        const float* mu = C.in[I_MU] + (size_t)i * 1664;
        const float mu_r = mu[64 * h + k], mu_k = mu[512 + 64 * h + k], mu_v = mu[1024 + 64 * h + k], mu_l = k < 32 ? mu[1536 + 32 * d + k] : mu[1600 + 32 * d + (k - 32)];
        const float c_w0 = C.in[I_W0][((size_t)i * 2 + d) * 512 + 64 * h + k], c_a0 = C.in[I_A0][((size_t)i * 2 + d) * 512 + 64 * h + k];
        const float c_kk = C.in[I_KK][(size_t)i * 512 + 64 * h + k], c_ka = C.in[I_KA][(size_t)i * 512 + 64 * h + k], c_rk = C.in[I_RK][(size_t)i * 512 + 64 * h + k];
        float* BON = (float*)(C.ws + WS_BONUS) + (size_t)d * NTOK * 8;
        const U4* sBF = (const U4*)(lds + RC_LDS_BFR);
        const int lcol = k < 32 ? 1536 + 32 * d + k : 1600 + 32 * d + (k - 32);
        const int kg = lane >> 4, l15 = lane & 15, pk_ = rc_pos(k);
        for (int ch = p; ch < nchunks; ch += RC_NPROD) {
            RC_GEOM(ch, seg0, segn, R0)
            float ur[18], uk[18], uv[18], ul[18];
            UNR for (int j = 0; j < 18; ++j) { const int row = d == 0 ? R0 - 1 + j : R0 + 16 - j; const bool ok = row >= 0 && row < segn; const bf16_t* up = U + (size_t)(seg0 + (ok ? row : R0)) * URW_W;
                const float m_ = ok ? 1.f : 0.f; ur[j] = m_ * bf2f(up[64 * h + k]); uk[j] = m_ * bf2f(up[512 + 64 * h + k]); uv[j] = m_ * bf2f(up[1024 + 64 * h + k]); ul[j] = m_ * bf2f(up[lcol]); }
            UNR for (int t = 0; t < 16; ++t) { const int j = t + 1; const float x = ul[j] + (0.5f * (ul[j - 1] + ul[j + 1]) - ul[j]) * mu_l;
                const float val = k < 32 ? 1.0f - 2.0f * FRCP(1.0f + FEXP(2.0f * x)) : x; sTDAD[t * 64 + k] = (bf16_t)f2bf(val); }
            WAVE_SYNC();
            {
                const H8 At = h8_from(ld16(sTDAD + l15 * 64 + 8 * kg)), Aa = h8_from(ld16(sTDAD + l15 * 64 + 32 + 8 * kg));
                A4 cw_[4], ca_[4];
                UNR for (int nt = 0; nt < 4; ++nt) { cw_[nt] = mfma16(At, h8_from(sBF[nt * 64 + lane]), a4_zero()); ca_[nt] = mfma16(Aa, h8_from(sBF[(4 + nt) * 64 + lane]), a4_zero()); }
                MFMA_PAD(cw_[0], cw_[1], cw_[2], cw_[3], ca_[0], ca_[1], ca_[2], ca_[3]);
                UNR for (int nt = 0; nt < 4; ++nt) UNR for (int rg = 0; rg < 4; ++rg) { sWL[(4 * kg + rg) * 64 + 16 * nt + l15] = A4_GET(cw_[nt], rg); sAL[(4 * kg + rg) * 64 + 16 * nt + l15] = A4_GET(ca_[nt], rg); }
            }
            WAVE_SYNC();
            float fr[16], fkd[16], fb[16], fkk[16], flw[16], fv[16];
            UNR for (int t = 0; t < 16; ++t) { const int j = t + 1;
                const float r_ = ur[j] + (0.5f * (ur[j - 1] + ur[j + 1]) - ur[j]) * mu_r, k_ = uk[j] + (0.5f * (uk[j - 1] + uk[j + 1]) - uk[j]) * mu_k, v_ = uv[j] + (0.5f * (uv[j - 1] + uv[j + 1]) - uv[j]) * mu_v;
                const float kkraw = k_ * c_kk; const float ss = wave_sum_fast(kkraw * kkraw); const float kk_ = kkraw * FRSQ(ss + 1e-12f);
                const float x = -(c_w0 + sWL[t * 64 + k]); const float sp_ = fmaxf(x, 0.f) + FLOG(1.0f + FEXP(-fabsf(x)));
                const float lw_ = -FEXP(-sp_ - 0.5f);
                const float a = FRCP(1.0f + FEXP(-(c_a0 + sAL[t * 64 + k])));
                const float kd_ = k_ * (1.0f + (a - 1.0f) * c_ka);
                fr[t] = r_; fkd[t] = kd_; fb[t] = kk_ * a; fkk[t] = kk_; flw[t] = lw_; fv[t] = v_;
                const float bon = wave_sum_fast(r_ * kd_ * c_rk);
                if (vh == 0 && lane == 0) { const int tl = d == 0 ? R0 + t : R0 + RC_T - 1 - t; BON[(size_t)(seg0 + tl) * 8 + h] = 0.5f * bon; }
            }
            WAVE_SYNC();
            const int slot = ch % RC_RING; unsigned char* rb = lds + RC_LDS_RING + slot * RS_BYTES;
            if (ch >= RC_RING) SPIN_WAIT(fl_done0[slot] == (unsigned)(ch - RC_RING + 1) && fl_done1[slot] == (unsigned)(ch - RC_RING + 1));
            {
                bf16_t* rKKD = (bf16_t*)(rb + RS_KKD); bf16_t* rRD = (bf16_t*)(rb + RS_RD); bf16_t* rKIT = (bf16_t*)(rb + RS_KIT); bf16_t* rNBIT = (bf16_t*)(rb + RS_NBIT); bf16_t* rVT = (bf16_t*)(rb + RS_VT);
                float L = 0.f, e_prev = 1.f;
                UNR for (int t = 0; t < 16; ++t) { L += flw[t]; const float e = FEXP(L), ei = FEXP(-L);
                    rKKD[t * 64 + pk_] = (bf16_t)f2bf(fkk[t] * e_prev); rRD[t * 64 + pk_] = (bf16_t)f2bf(fr[t] * e);
                    const float ki_ = fkd[t] * ei, bi_ = fb[t] * ei; sKIP[t * 64 + pk_] = (bf16_t)f2bf(ki_); sBIP[t * 64 + pk_] = (bf16_t)f2bf(bi_);
                    rKIT[k * 16 + t] = (bf16_t)f2bf(ki_); rNBIT[k * 16 + t] = (bf16_t)f2bf(-bi_);
                    e_prev = e; }
                ((float*)(rb + RS_GC))[k] = e_prev;
                U4 w0_, w1_;
                if ((k >> 5) == vh) { w0_.x = pk2(fv[0], fv[1]); w0_.y = pk2(fv[2], fv[3]); w0_.z = pk2(fv[4], fv[5]); w0_.w = pk2(fv[6], fv[7]); w1_.x = pk2(fv[8], fv[9]); w1_.y = pk2(fv[10], fv[11]); w1_.z = pk2(fv[12], fv[13]); w1_.w = pk2(fv[14], fv[15]);
                    st16(rVT + (k & 31) * 16, w0_); st16(rVT + (k & 31) * 16 + 8, w1_); }
            }
            WAVE_SYNC();
            {
                const bf16_t* rKKD = (const bf16_t*)(rb + RS_KKD); const bf16_t* rRD = (const bf16_t*)(rb + RS_RD);
                const H8 ak0 = h8_from(ld16(rKKD + l15 * 64 + 8 * kg)), ak1 = h8_from(ld16(rKKD + l15 * 64 + 32 + 8 * kg)), ar0 = h8_from(ld16(rRD + l15 * 64 + 8 * kg)), ar1 = h8_from(ld16(rRD + l15 * 64 + 32 + 8 * kg));
                const H8 bb0 = h8_from(ld16(sBIP + l15 * 64 + 8 * kg)), bb1 = h8_from(ld16(sBIP + l15 * 64 + 32 + 8 * kg)), bk0 = h8_from(ld16(sKIP + l15 * 64 + 8 * kg)), bk1 = h8_from(ld16(sKIP + l15 * 64 + 32 + 8 * kg));
                A4 mA = mfma16(ak0, bb0, a4_zero()); mA = mfma16(ak1, bb1, mA);
                A4 mP = mfma16(ak0, bk0, a4_zero()); mP = mfma16(ak1, bk1, mP);
                A4 mQ1 = mfma16(ar0, bk0, a4_zero()); mQ1 = mfma16(ar1, bk1, mQ1);
                A4 mQ2 = mfma16(ar0, bb0, a4_zero()); mQ2 = mfma16(ar1, bb1, mQ2);
                MFMA_PAD(mA, mP, mQ1, mQ2, mA, mP, mQ1, mQ2);
                bf16_t* rP0 = (bf16_t*)(rb + RS_P0); bf16_t* rQ1 = (bf16_t*)(rb + RS_Q1); bf16_t* rNQ2 = (bf16_t*)(rb + RS_NQ2);
                UNR for (int rg = 0; rg < 4; ++rg) { const int t = 4 * kg + rg, s_ = l15;
                    sAM[t * 16 + s_] = t > s_ ? A4_GET(mA, rg) : 0.f;
                    rP0[t * 16 + s_] = (bf16_t)f2bf(t > s_ ? A4_GET(mP, rg) : 0.f); rQ1[t * 16 + s_] = (bf16_t)f2bf(t >= s_ ? A4_GET(mQ1, rg) : 0.f); rNQ2[t * 16 + s_] = (bf16_t)f2bf(t >= s_ ? -A4_GET(mQ2, rg) : 0.f); }
            }
            WAVE_SYNC();
            {
                const int j = l15; float x[16]; bf16_t* rT = (bf16_t*)(rb + RS_T);
                UNR for (int t = 0; t < 16; ++t) { float acc = t == j ? 1.f : 0.f;
                    UNR for (int s_ = 0; s_ < 16; ++s_) if (s_ < t) acc -= sAM[t * 16 + s_] * x[s_];
                    x[t] = acc; if (lane < 16) rT[t * 16 + j] = (bf16_t)f2bf(acc); }
            }
            LDS_FENCE();
            WAVE_SYNC();
            if (lane == 0) fl_ready[slot] = (unsigned)(ch + 1);
        }
    }
    #undef RC_GEOM
    SYNC();
}
constexpr int FR_SLOTS = 20, FR_FLOATS = 6 * 2048, FR_LEAD = 20;
constexpr size_t WS_FRING = WS_HYOUT;
static_assert((size_t)16 * FR_SLOTS * FR_FLOATS * 4 <= (size_t)NLAT * 512 * 2, "feature ring fits");
constexpr size_t CTL_FFLAG = 65536, CTL_FPOS = CTL_FFLAG + 16 * 520 * 4 * 4;
constexpr int SC2_R = 8, SC2_NWG = 8;
static_assert(CTL_FPOS + 64 * 64 <= CTL_ZERO_BYTES, "control words");
#ifdef EMU
DEVFN unsigned gld_u32(const unsigned* p) { __sync_synchronize(); return *(volatile const unsigned*)p; }
DEVFN void gst_u32(unsigned* p, unsigned v) { __sync_synchronize(); *(volatile unsigned*)p = v; __sync_synchronize(); }
DEVFN unsigned long long gld_u64(const unsigned long long* p) { return *(volatile const unsigned long long*)p; }
DEVFN void gst_u64(unsigned long long* p, unsigned long long v) { *(volatile unsigned long long*)p = v; }
#define VM_DRAIN() __sync_synchronize()
#define GSPIN_WAIT(cond) do { while (!(cond)) sched_yield(); __sync_synchronize(); } while (0)
#else
DEVFN unsigned gld_u32(const unsigned* p) { return __hip_atomic_load(p, __ATOMIC_RELAXED, __HIP_MEMORY_SCOPE_AGENT); }
DEVFN void gst_u32(unsigned* p, unsigned v) { __hip_atomic_store(p, v, __ATOMIC_RELAXED, __HIP_MEMORY_SCOPE_AGENT); }
DEVFN unsigned long long gld_u64(const unsigned long long* p) { return __hip_atomic_load(p, __ATOMIC_RELAXED, __HIP_MEMORY_SCOPE_AGENT); }
DEVFN void gst_u64(unsigned long long* p, unsigned long long v) { __hip_atomic_store(p, v, __ATOMIC_RELAXED, __HIP_MEMORY_SCOPE_AGENT); }
#define VM_DRAIN() asm volatile("s_waitcnt vmcnt(0)" ::: "memory")
#define GSPIN_WAIT(cond) do { unsigned sp__ = 0; while (!(cond)) { __builtin_amdgcn_s_sleep(2); if (++sp__ > (1u << 22)) break; } asm volatile("" ::: "memory"); } while (0)
#endif
DEVFN unsigned long long f2_bits(float a, float b) { union { float f[2]; unsigned long long u; } x; x.f[0] = a; x.f[1] = b; return x.u; }

DEVFN void rwkv_scan2(const Ctx& C, int i, int h, int d, int rq, bool ctx_out, unsigned char* lds, int max_chunks) {
    const int tid = C.tid, lane = tid & 63, wave = C.wave;
    float* sBUF = (float*)lds;
    float* sWV = sBUF + 3 * SC_BUF;
    float* sCN = sWV + 4 * 1280;
    U4* sBF = (U4*)(sCN + 640);
    volatile unsigned* lf = (volatile unsigned*)((unsigned char*)sBF + 8192);
    const int hd = h * 2 + d;
    const unsigned epoch = (unsigned)(i + 1), pbase = (unsigned)i * 100000u;
    {
    const float* mu = C.in[I_MU] + (size_t)i * 1664;
    const float* w0 = C.in[I_W0] + ((size_t)i * 2 + d) * 512 + 64 * h; const float* a0 = C.in[I_A0] + ((size_t)i * 2 + d) * 512 + 64 * h;
    const float* wup = C.in[I_WUP] + ((size_t)i * 2 + d) * 32 * 512 + 64 * h; const float* aup = C.in[I_AUP] + ((size_t)i * 2 + d) * 32 * 512 + 64 * h;
    const float* k_k = C.in[I_KK] + (size_t)i * 512 + 64 * h; const float* k_a = C.in[I_KA] + (size_t)i * 512 + 64 * h; const float* r_k = C.in[I_RK] + (size_t)i * 512 + 64 * h;
    if (tid < 64) { const int j = tid; sCN[j] = mu[64 * h + j]; sCN[64 + j] = mu[512 + 64 * h + j]; sCN[128 + j] = mu[1024 + 64 * h + j]; sCN[192 + j] = w0[j]; sCN[256 + j] = a0[j];
        sCN[320 + j] = k_k[j]; sCN[384 + j] = k_a[j]; sCN[448 + j] = r_k[j]; sCN[512 + j] = j < 32 ? mu[1536 + 32 * d + j] : mu[1600 + 32 * d + (j - 32)]; }
    { const int m = tid >> 8, nt = (tid >> 6) & 3, ln = tid & 63; const float* src = m == 0 ? wup : aup; float f[8];
      UNR for (int j = 0; j < 8; ++j) f[j] = src[(size_t)(8 * (ln >> 4) + j) * 512 + 16 * nt + (ln & 15)];
      sBF[tid] = pack8(f); }
    }
    if (tid < 32) lf[tid] = 0u;
    SYNC();
    const int nchunks = NTOK / SC_T < max_chunks ? NTOK / SC_T : max_chunks;
    #define CHUNK_GEOM(ch, seg0, segn, R0) const bool isctx_ = (ch) < NCTX / SC_T; const int seg0 = isctx_ ? NLAT : 0, segn = isctx_ ? NCTX : NLAT; \
        const int cl_ = isctx_ ? (ch) : (ch) - NCTX / SC_T; const int R0 = d == 0 ? SC_T * cl_ : segn - SC_T * (cl_ + 1);
    if (wave < 2) {
        bf16_t* Yd = (bf16_t*)(C.ws + (d == 0 ? WS_YF : WS_YB));
        const int rl = tid >> 4, sp = tid & 15;
        float S0 = 0.f, S1 = 0.f, S2 = 0.f, S3 = 0.f;
        for (int ch = 0; ch < nchunks; ++ch) {
            const int b = ch % 3;
            SPIN_WAIT(lf[0 * 3 + b] == (unsigned)(ch + 1) && lf[1 * 3 + b] == (unsigned)(ch + 1));
            const float* B_ = sBUF + b * SC_BUF; const float* sV = B_ + 5 * SC_T * 64;
            float yk0 = 0.f, yk1 = 0.f, yp = 0.f;
#ifndef EMU
            {
                const unsigned ab = (unsigned)(uintptr_t)B_ + 16u * (unsigned)sp, av = (unsigned)(uintptr_t)sV + 4u * (unsigned)rl;
                P2 s01 = {S0, S1}, s23 = {S2, S3};
                asm volatile(SCAN_CHUNK_ASM : [s01] "+v"(s01), [s23] "+v"(s23), [yp] "+v"(yp), [yk0] "+v"(yk0), [yk1] "+v"(yk1) : [ab] "v"(ab), [av] "v"(av), [sp] "v"(sp) : SCAN_CHUNK_CLOBBERS);
                S0 = s01[0]; S1 = s01[1]; S2 = s23[0]; S3 = s23[1];
            }
#else
            { const float* sW = B_; const float* sKD = B_ + SC_T * 64; const float* sB = B_ + 2 * SC_T * 64; const float* sKK = B_ + 3 * SC_T * 64; const float* sR = B_ + 4 * SC_T * 64;
              for (int k = 0; k < SC_T; ++k) {
                const F4 kk4 = *(const F4*)(sKK + k * 64 + 4 * sp), w4 = *(const F4*)(sW + k * 64 + 4 * sp), b4 = *(const F4*)(sB + k * 64 + 4 * sp),
                         kd4 = *(const F4*)(sKD + k * 64 + 4 * sp), r4 = *(const F4*)(sR + k * 64 + 4 * sp);
                const float vi = sV[k * SC_R + rl];
                float sa = (S0 * kk4.x + S2 * kk4.z) + (S1 * kk4.y + S3 * kk4.w);
                const float t0 = S0 * w4.x + vi * kd4.x, t1 = S1 * w4.y + vi * kd4.y, t2 = S2 * w4.z + vi * kd4.z, t3 = S3 * w4.w + vi * kd4.w;
                sa = rowx_add<1>(sa); yp = rowx_add<1>(yp); sa = rowx_add<2>(sa); yp = rowx_add<2>(yp);
                sa = rowx_add<7>(sa); yp = rowx_add<7>(yp); sa = rowx_add<15>(sa); yp = rowx_add<15>(yp);
                if (sp == ((k + 15) & 15)) { if (k <= 16) yk0 = yp; else yk1 = yp; }
                S0 = t0 - sa * b4.x; S1 = t1 - sa * b4.y; S2 = t2 - sa * b4.z; S3 = t3 - sa * b4.w;
                yp = (S0 * r4.x + S2 * r4.z) + (S1 * r4.y + S3 * r4.w);
              } }
#endif
            LDS_FENCE(); WAVE_SYNC();
            if (lane == 0) lf[8 + wave * 3 + b] = (unsigned)(ch + 1);
            yp = rowx_add<1>(yp); yp = rowx_add<2>(yp); yp = rowx_add<7>(yp); yp = rowx_add<15>(yp);
            if (sp == 15) yk1 = yp;
            { CHUNK_GEOM(ch, seg0, segn, R0)
              if (!isctx_ || ctx_out) { const int t0 = d == 0 ? R0 + sp : R0 + SC_T - 1 - sp, t1 = d == 0 ? R0 + sp + 16 : R0 + SC_T - 1 - (sp + 16);
                  Yd[(size_t)(seg0 + t0) * 512 + 64 * h + SC2_R * rq + rl] = (bf16_t)f2bf(yk0); Yd[(size_t)(seg0 + t1) * 512 + 64 * h + SC2_R * rq + rl] = (bf16_t)f2bf(yk1); } }
        }
    } else if (wave < 6) {
        const int p = wave - 2;
        const bf16_t* U = (const bf16_t*)(C.ws + WS_U); float* BON = (float*)(C.ws + WS_BONUS) + (size_t)d * NTOK * 8;
        float* RING = (float*)(C.ws + WS_FRING) + (size_t)hd * FR_SLOTS * FR_FLOATS; unsigned* FFLAG = (unsigned*)(C.ws + WS_CTL + CTL_FFLAG) + (size_t)hd * 520 * 4; unsigned* FPOS = (unsigned*)(C.ws + WS_CTL + CTL_FPOS) + (size_t)hd * 64;
        float* myWV = sWV + p * 1280; float* sWL = myWV; float* sAL = myWV + 512; bf16_t* sTDb = (bf16_t*)(myWV + 1024); bf16_t* sADb = sTDb + 256;
        const int fp = lane & 7, tw = lane >> 3;
        const float* mu_r = sCN + 8 * fp; const float* mu_k = sCN + 64 + 8 * fp; const float* mu_v = sCN + 128 + 8 * fp; const float* c_w0 = sCN + 192 + 8 * fp; const float* c_a0 = sCN + 256 + 8 * fp;
        const float* c_kk = sCN + 320 + 8 * fp; const float* c_ka = sCN + 384 + 8 * fp; const float* c_rk = sCN + 448 + 8 * fp; const float* mu_w = sCN + 512 + 4 * fp; const float* mu_a = sCN + 544 + 4 * fp;
        U4 pu[9]; U2 pw[6];
        auto issue = [&](int q) {
            const int ch = rq + SC2_NWG * q; if (ch >= nchunks) return;
            CHUNK_GEOM(ch, seg0, segn, R0)
            const int ft = 8 * p + tw, tl = d == 0 ? R0 + ft : R0 + SC_T - 1 - ft;
            const bf16_t* u0p = U + (size_t)(seg0 + tl) * URW_W; const bool hm = tl > 0, hp = tl < segn - 1;
            const U4 z4 = {0u, 0u, 0u, 0u}; const U2 z2 = {0u, 0u};
            const int cw = 1536 + 32 * d + 4 * fp, ca = 1600 + 32 * d + 4 * fp;
            UNR for (int j = 0; j < 3; ++j) { pu[3 * j] = ld16(u0p + 512 * j + 64 * h + 8 * fp); pu[3 * j + 1] = z4; pu[3 * j + 2] = z4; }
            pw[0] = *(const U2*)(u0p + cw); pw[3] = *(const U2*)(u0p + ca); pw[1] = z2; pw[2] = z2; pw[4] = z2; pw[5] = z2;
            if (hm) { UNR for (int j = 0; j < 3; ++j) pu[3 * j + 1] = ld16(u0p - URW_W + 512 * j + 64 * h + 8 * fp); pw[1] = *(const U2*)(u0p - URW_W + cw); pw[4] = *(const U2*)(u0p - URW_W + ca); }
            if (hp) { UNR for (int j = 0; j < 3; ++j) pu[3 * j + 2] = ld16(u0p + URW_W + 512 * j + 64 * h + 8 * fp); pw[2] = *(const U2*)(u0p + URW_W + cw); pw[5] = *(const U2*)(u0p + URW_W + ca); }
        };
        issue(0);
        const int npass = (nchunks - rq + SC2_NWG - 1) / SC2_NWG;
        for (int q = 0; q < npass; ++q) {
            const int ch = rq + SC2_NWG * q;
            if (ch >= FR_SLOTS) { const unsigned need = pbase + (unsigned)(ch - FR_SLOTS + 1);
                GSPIN_WAIT(gld_u32(FPOS + 0) >= need && gld_u32(FPOS + 8) >= need && gld_u32(FPOS + 16) >= need && gld_u32(FPOS + 24) >= need && gld_u32(FPOS + 32) >= need && gld_u32(FPOS + 40) >= need && gld_u32(FPOS + 48) >= need && gld_u32(FPOS + 56) >= need); }
            CHUNK_GEOM(ch, seg0, segn, R0)
            float* rec = RING + (size_t)(ch % FR_SLOTS) * FR_FLOATS;
            {
                const int ft = 8 * p + tw;
                const int tl = d == 0 ? R0 + ft : R0 + SC_T - 1 - ft;
                float r[8], k[8], v[8];
                {
                    float a[8], m[8], qq[8];
                    #define SHIFT3(J, MU, OUT) do { unpack8(pu[3 * (J)], a); unpack8(pu[3 * (J) + 1], m); unpack8(pu[3 * (J) + 2], qq); \
                        UNR for (int e = 0; e < 8; ++e) OUT[e] = a[e] + (0.5f * (m[e] + qq[e]) - a[e]) * MU[e]; } while (0)
                    SHIFT3(0, mu_r, r); SHIFT3(1, mu_k, k); SHIFT3(2, mu_v, v);
                    #undef SHIFT3
                }
                {
                    const U2 w0_ = pw[0], wm = pw[1], wp = pw[2], a0_ = pw[3], am = pw[4], ap = pw[5];
                    const float wa[4] = {bflo(w0_.x), bfhi(w0_.x), bflo(w0_.y), bfhi(w0_.y)}, wmm[4] = {bflo(wm.x), bfhi(wm.x), bflo(wm.y), bfhi(wm.y)}, wpp[4] = {bflo(wp.x), bfhi(wp.x), bflo(wp.y), bfhi(wp.y)};
                    const float aa[4] = {bflo(a0_.x), bfhi(a0_.x), bflo(a0_.y), bfhi(a0_.y)}, amm[4] = {bflo(am.x), bfhi(am.x), bflo(am.y), bfhi(am.y)}, app[4] = {bflo(ap.x), bfhi(ap.x), bflo(ap.y), bfhi(ap.y)};
                    issue(q + 1);
                    float tdv[4], adv[4];
                    UNR for (int e = 0; e < 4; ++e) { const float x = wa[e] + (0.5f * (wmm[e] + wpp[e]) - wa[e]) * mu_w[e];
                        tdv[e] = 1.0f - 2.0f * FRCP(1.0f + FEXP(2.0f * x));
                        adv[e] = aa[e] + (0.5f * (amm[e] + app[e]) - aa[e]) * mu_a[e]; }
                    U2 tq, aq; tq.x = pk2(tdv[0], tdv[1]); tq.y = pk2(tdv[2], tdv[3]); aq.x = pk2(adv[0], adv[1]); aq.y = pk2(adv[2], adv[3]);
                    *(U2*)(sTDb + tw * 32 + 4 * fp) = tq; *(U2*)(sADb + tw * 32 + 4 * fp) = aq;
                }
                WAVE_SYNC();
                float wl[8], al[8];
                {
                    const int arow = lane & 7, kg = lane >> 4;
                    const H8 At = h8_from_u4(ld16(sTDb + arow * 32 + 8 * kg)), Aa = h8_from_u4(ld16(sADb + arow * 32 + 8 * kg));
                    A4 cw_[4], ca_[4];
                    UNR for (int nt = 0; nt < 4; ++nt) { A4 z; A4_GET(z, 0) = 0.f; A4_GET(z, 1) = 0.f; A4_GET(z, 2) = 0.f; A4_GET(z, 3) = 0.f;
                        cw_[nt] = mfma16(At, h8_from_u4(sBF[nt * 64 + lane]), z); ca_[nt] = mfma16(Aa, h8_from_u4(sBF[(4 + nt) * 64 + lane]), z); }
                    MFMA_PAD(cw_[0], cw_[1], cw_[2], cw_[3], ca_[0], ca_[1], ca_[2], ca_[3]);
                    if (lane < 32) { UNR for (int nt = 0; nt < 4; ++nt) UNR for (int rg = 0; rg < 4; ++rg) { const int tok = 4 * (lane >> 4) + rg; sWL[tok * 64 + 16 * nt + (lane & 15)] = A4_GET(cw_[nt], rg); sAL[tok * 64 + 16 * nt + (lane & 15)] = A4_GET(ca_[nt], rg); } }
                    WAVE_SYNC();
                    UNR for (int e = 0; e < 8; ++e) { wl[e] = c_w0[e] + sWL[tw * 64 + 8 * fp + e]; al[e] = c_a0[e] + sAL[tw * 64 + 8 * fp + e]; }
                    WAVE_SYNC();
                }
                float kkv[8], ssq = 0.f;
                UNR for (int e = 0; e < 8; ++e) { kkv[e] = k[e] * c_kk[e]; ssq += kkv[e] * kkv[e]; }
                ssq = rowx_add<1>(ssq); ssq = rowx_add<2>(ssq); ssq = rowx_add<7>(ssq);
                const float kn = FRSQ(ssq + 1e-12f);
                float bon = 0.f; float o_w[8], o_kd[8], o_b[8], o_kk[8];
                UNR for (int e = 0; e < 8; ++e) {
                    const float dec = FEXP(-0.60653066f * FRCP(1.0f + FEXP(-wl[e])));
                    const float a = FRCP(1.0f + FEXP(-al[e]));
                    const float kd = k[e] * (1.0f + (a - 1.0f) * c_ka[e]);
                    const float kk = kkv[e] * kn;
                    o_w[e] = dec; o_kd[e] = kd; o_b[e] = kk * a; o_kk[e] = kk;
                    bon += r[e] * kd * c_rk[e];
                }
                { unsigned long long* rp = (unsigned long long*)(rec + ft * 64 + 8 * fp);
                  #define ST8(AR, A) do { UNR for (int e2 = 0; e2 < 4; ++e2) gst_u64(rp + (AR) * 1024 + e2, f2_bits(A[2 * e2], A[2 * e2 + 1])); } while (0)
                  ST8(0, o_w); ST8(1, o_kd); ST8(2, o_b); ST8(3, o_kk); ST8(4, r); ST8(5, v);
                  #undef ST8
                }
                bon = rowx_add<1>(bon); bon = rowx_add<2>(bon); bon = rowx_add<7>(bon);
                if (fp == 0) BON[(size_t)(seg0 + tl) * 8 + h] = 0.5f * bon;
            }
            VM_DRAIN(); if (lane == 0) gst_u32(FFLAG + (size_t)ch * 4 + p, epoch);
        }
    } else {
        const int w = wave - 6;
        const float* RING = (const float*)(C.ws + WS_FRING) + (size_t)hd * FR_SLOTS * FR_FLOATS; unsigned* FFLAG = (unsigned*)(C.ws + WS_CTL + CTL_FFLAG) + (size_t)hd * 520 * 4; unsigned* FPOS = (unsigned*)(C.ws + WS_CTL + CTL_FPOS) + (size_t)hd * 64;
        for (int ch = 0; ch < nchunks; ++ch) {
            const int b = ch % 3;
            if (ch >= 3) SPIN_WAIT(lf[8 + 0 * 3 + b] == (unsigned)(ch - 2) && lf[8 + 1 * 3 + b] == (unsigned)(ch - 2));
            GSPIN_WAIT(gld_u32(FFLAG + (size_t)ch * 4) == epoch && gld_u32(FFLAG + (size_t)ch * 4 + 1) == epoch && gld_u32(FFLAG + (size_t)ch * 4 + 2) == epoch && gld_u32(FFLAG + (size_t)ch * 4 + 3) == epoch);
            const unsigned long long* rec = (const unsigned long long*)(RING + (size_t)(ch % FR_SLOTS) * FR_FLOATS);
            float* B_ = sBUF + b * SC_BUF;
            { unsigned long long x[40], xv[2];
              UNR for (int j = 0; j < 40; ++j) x[j] = gld_u64(rec + (size_t)w * 2560 + j * 64 + lane);
              { const int idx = w * 64 + lane, tok = idx >> 2, c2 = idx & 3; xv[0] = gld_u64(rec + 5 * 1024 + tok * 32 + 4 * rq + c2); xv[1] = 0ull; }
              UNR for (int j = 0; j < 40; ++j) ((unsigned long long*)B_)[(size_t)w * 2560 + j * 64 + lane] = x[j];
              { const int idx = w * 64 + lane, tok = idx >> 2, c2 = idx & 3; ((unsigned long long*)(B_ + 5 * SC_T * 64))[tok * 8 + c2] = xv[0]; } }
            LDS_FENCE(); WAVE_SYNC();
            if (lane == 0) { lf[w * 3 + b] = (unsigned)(ch + 1); if (w == 0) gst_u32(FPOS + 8 * rq, pbase + (unsigned)(ch + 1)); }
        }
    }
    #undef CHUNK_GEOM
    SYNC();
}
constexpr int R2S_KKD = 0, R2S_RD = 2048, R2S_KIT = 4096, R2S_NBIT = 6144, R2S_VT = 8192, R2S_T = 10240, R2S_P0 = 10752, R2S_Q1 = 11264, R2S_NQ2 = 11776, R2S_GC = 12288, R2S_BYTES = 12544, R2S_U64 = R2S_BYTES / 8;
constexpr int PW_TDAD = 0, PW_AM = 0, PW_WL = 2048, PW_AL = 6144, PW_REC = 2048, PW_KIP = PW_REC + R2S_BYTES, PW_BIP = PW_KIP + 2048, PW_BYTES = PW_BIP + 2048;
static_assert(8 * PW_BYTES <= RING_BYTES, "producer LDS");
#define R2_SWZ(t, p) (((((p) >> 3) ^ (((t) >> 1) & 7)) << 3) | ((p) & 7))
constexpr int R2_GSLOTS = 64, R2_LSLOTS = 12, R2_NCH = NTOK / RC_T;
constexpr size_t WS_R2RING = WS_HYOUT;
static_assert((size_t)16 * R2_GSLOTS * R2S_BYTES <= (size_t)NLAT * 512 * 2, "record ring fits");
constexpr size_t CTL_R2FLAG = 65536, CTL_R2POS = CTL_R2FLAG + (size_t)16 * R2_NCH * 4;
static_assert(CTL_R2POS + 16 * 64 <= CTL_ZERO_BYTES, "control words");
constexpr size_t WS_BFRAG = WS_VXC + 1536 * 1024;
static_assert(WS_BFRAG + 2 * 16 * 8 * 64 * 16 <= WS_HID, "bfrag");

DEVFN void r2_build_bfrag(const Ctx& C) {
    const int gtid = (C.vcu * NWAVES + C.wave) * 64 + C.lane, gn = C.G * NTHREADS;
    for (int e = gtid; e < 2 * 16 * 8 * 64; e += gn) { const int ln = e & 63, nt = (e >> 6) & 3, m = (e >> 8) & 1, hd = (e >> 9) & 15, i = e >> 13; const int h = hd >> 1, d = hd & 1;
        const float* src = (m == 0 ? C.in[I_WUP] : C.in[I_AUP]) + ((size_t)i * 2 + d) * 32 * 512 + 64 * h; float f[8];
        UNR for (int j = 0; j < 8; ++j) f[j] = src[(size_t)(8 * (ln >> 4) + j) * 512 + 16 * nt + (ln & 15)];
        ((U4*)(C.ws + WS_BFRAG))[e] = pack8(f); }
}

DEVFN void rc2_producer(const Ctx& C, int i, unsigned char* lds, int pw, int npw, int hd0, int nhd, int max_chunks) {
    const int lane = C.lane, k = lane, kg = lane >> 4, l15 = lane & 15, pk_ = rc_pos(k);
    unsigned char* wsb = lds + C.wave * PW_BYTES;
    bf16_t* sTDAD = (bf16_t*)(wsb + PW_TDAD); float* sWL = (float*)(wsb + PW_WL); float* sAL = (float*)(wsb + PW_AL); bf16_t* sKIP = (bf16_t*)(wsb + PW_KIP); bf16_t* sBIP = (bf16_t*)(wsb + PW_BIP); float* sAM = (float*)(wsb + PW_AM);
    const bf16_t* U = (const bf16_t*)(C.ws + WS_U);
    const unsigned epoch = (unsigned)(i + 1), pbase = (unsigned)i * 100000u;
    const int nchunks = R2_NCH < max_chunks ? R2_NCH : max_chunks;
    const int nitems = nchunks * nhd;
    TACC_DECL;
    for (int item = pw; item < nitems; item += npw) {
        const int ch = item / nhd, hd = hd0 + item % nhd, h = hd >> 1, d = hd & 1;
        unsigned* POS = (unsigned*)(C.ws + WS_CTL + CTL_R2POS) + 16 * hd;
        if (ch >= R2_GSLOTS) { const int ow = ((ch - R2_GSLOTS) & 3); TACC_BEGIN; GSPIN_WAIT(gld_u32(POS + 1 + ow) >= pbase + (unsigned)(ch - R2_GSLOTS + 1)); TACC_END; }
        const float* mu = C.in[I_MU] + (size_t)i * 1664;
        const float mu_r = mu[64 * h + k], mu_k = mu[512 + 64 * h + k], mu_v = mu[1024 + 64 * h + k], mu_l = k < 32 ? mu[1536 + 32 * d + k] : mu[1600 + 32 * d + (k - 32)];
        const float c_w0 = C.in[I_W0][((size_t)i * 2 + d) * 512 + 64 * h + k], c_a0 = C.in[I_A0][((size_t)i * 2 + d) * 512 + 64 * h + k];
        const float c_kk = C.in[I_KK][(size_t)i * 512 + 64 * h + k], c_ka = C.in[I_KA][(size_t)i * 512 + 64 * h + k], c_rk = C.in[I_RK][(size_t)i * 512 + 64 * h + k];
        float* BON = (float*)(C.ws + WS_BONUS) + (size_t)d * NTOK * 8;
        const int lcol = k < 32 ? 1536 + 32 * d + k : 1600 + 32 * d + (k - 32);
        U4 bfw[4], bfa[4];
        { const U4* bt = (const U4*)(C.ws + WS_BFRAG) + ((size_t)i * 16 + hd) * 512; UNR for (int nt = 0; nt < 4; ++nt) { bfw[nt] = bt[nt * 64 + lane]; bfa[nt] = bt[(4 + nt) * 64 + lane]; } }
        const bool isctx_ = ch < NCTX / RC_T; const int seg0 = isctx_ ? NLAT : 0, segn = isctx_ ? NCTX : NLAT; const int cl_ = isctx_ ? ch : ch - NCTX / RC_T; const int R0 = d == 0 ? RC_T * cl_ : segn - RC_T * (cl_ + 1);
        {
            float ur[18], uk[18], uv[18], ul[18];
            UNR for (int j = 0; j < 18; ++j) { const int row = d == 0 ? R0 - 1 + j : R0 + 16 - j; const bool ok = row >= 0 && row < segn; const bf16_t* up = U + (size_t)(seg0 + (ok ? row : R0)) * URW_W;
                const float m_ = ok ? 1.f : 0.f; ur[j] = m_ * bf2f(up[64 * h + k]); uk[j] = m_ * bf2f(up[512 + 64 * h + k]); uv[j] = m_ * bf2f(up[1024 + 64 * h + k]); ul[j] = m_ * bf2f(up[lcol]); }
            UNR for (int t = 0; t < 16; ++t) { const int j = t + 1; const float x = ul[j] + (0.5f * (ul[j - 1] + ul[j + 1]) - ul[j]) * mu_l;
                const float val = k < 32 ? 1.0f - 2.0f * FRCP(1.0f + FEXP(2.0f * x)) : x; sTDAD[t * 64 + k] = (bf16_t)f2bf(val); }
            WAVE_SYNC();
            {
                const H8 At = h8_from(ld16(sTDAD + l15 * 64 + 8 * kg)), Aa = h8_from(ld16(sTDAD + l15 * 64 + 32 + 8 * kg));
                A4 cw_[4], ca_[4];
                UNR for (int nt = 0; nt < 4; ++nt) { cw_[nt] = mfma16(At, h8_from(bfw[nt]), a4_zero()); ca_[nt] = mfma16(Aa, h8_from(bfa[nt]), a4_zero()); }
                MFMA_PAD(cw_[0], cw_[1], cw_[2], cw_[3], ca_[0], ca_[1], ca_[2], ca_[3]);
                UNR for (int nt = 0; nt < 4; ++nt) UNR for (int rg = 0; rg < 4; ++rg) { sWL[(4 * kg + rg) * 64 + 16 * nt + l15] = A4_GET(cw_[nt], rg); sAL[(4 * kg + rg) * 64 + 16 * nt + l15] = A4_GET(ca_[nt], rg); }
            }
            WAVE_SYNC();
            float fr[16], fkd[16], fb[16], fkk[16], flw[16], fv[16];
            UNR for (int t = 0; t < 16; ++t) { const int j = t + 1;
                const float r_ = ur[j] + (0.5f * (ur[j - 1] + ur[j + 1]) - ur[j]) * mu_r, k_ = uk[j] + (0.5f * (uk[j - 1] + uk[j + 1]) - uk[j]) * mu_k, v_ = uv[j] + (0.5f * (uv[j - 1] + uv[j + 1]) - uv[j]) * mu_v;
                const float kkraw = k_ * c_kk; const float ss = wave_sum_fast(kkraw * kkraw); const float kk_ = kkraw * FRSQ(ss + 1e-12f);
                const float x = -(c_w0 + sWL[t * 64 + k]); const float sp_ = fmaxf(x, 0.f) + FLOG(1.0f + FEXP(-fabsf(x)));
                const float lw_ = -FEXP(-sp_ - 0.5f);
                const float a = FRCP(1.0f + FEXP(-(c_a0 + sAL[t * 64 + k])));
                const float kd_ = k_ * (1.0f + (a - 1.0f) * c_ka);
                fr[t] = r_; fkd[t] = kd_; fb[t] = kk_ * a; fkk[t] = kk_; flw[t] = lw_; fv[t] = v_;
                const float bon = wave_sum_fast(r_ * kd_ * c_rk);
                if (lane == 0) { const int tl = d == 0 ? R0 + t : R0 + RC_T - 1 - t; BON[(size_t)(seg0 + tl) * 8 + h] = 0.5f * bon; }
            }
            WAVE_SYNC();
            unsigned char* rb = wsb + PW_REC;
            {
                bf16_t* rKKD = (bf16_t*)(rb + R2S_KKD); bf16_t* rRD = (bf16_t*)(rb + R2S_RD); bf16_t* rKIT = (bf16_t*)(rb + R2S_KIT); bf16_t* rNBIT = (bf16_t*)(rb + R2S_NBIT); bf16_t* rVT = (bf16_t*)(rb + R2S_VT);
                float L = 0.f, e_prev = 1.f;
                UNR for (int t = 0; t < 16; ++t) { L += flw[t]; const float e = FEXP(L), ei = FEXP(-L);
                    rKKD[t * 64 + R2_SWZ(t, pk_)] = (bf16_t)f2bf(fkk[t] * e_prev); rRD[t * 64 + R2_SWZ(t, pk_)] = (bf16_t)f2bf(fr[t] * e);
                    const float ki_ = fkd[t] * ei, bi_ = fb[t] * ei; sKIP[t * 64 + pk_] = (bf16_t)f2bf(ki_); sBIP[t * 64 + pk_] = (bf16_t)f2bf(bi_);
                    rKIT[k * 16 + t] = (bf16_t)f2bf(ki_); rNBIT[k * 16 + t] = (bf16_t)f2bf(-bi_);
                    e_prev = e; }
                ((float*)(rb + R2S_GC))[k] = e_prev;
                U4 w0_, w1_;
                { w0_.x = pk2(fv[0], fv[1]); w0_.y = pk2(fv[2], fv[3]); w0_.z = pk2(fv[4], fv[5]); w0_.w = pk2(fv[6], fv[7]); w1_.x = pk2(fv[8], fv[9]); w1_.y = pk2(fv[10], fv[11]); w1_.z = pk2(fv[12], fv[13]); w1_.w = pk2(fv[14], fv[15]);
                    st16(rVT + k * 16, w0_); st16(rVT + k * 16 + 8, w1_); }
            }
            WAVE_SYNC();
            {
                const bf16_t* rKKD = (const bf16_t*)(rb + R2S_KKD); const bf16_t* rRD = (const bf16_t*)(rb + R2S_RD);
                const int sw0 = 8 * (kg ^ ((l15 >> 1) & 7)), sw1 = 8 * ((kg + 4) ^ ((l15 >> 1) & 7));
                const H8 ak0 = h8_from(ld16(rKKD + l15 * 64 + sw0)), ak1 = h8_from(ld16(rKKD + l15 * 64 + sw1)), ar0 = h8_from(ld16(rRD + l15 * 64 + sw0)), ar1 = h8_from(ld16(rRD + l15 * 64 + sw1));
                const H8 bb0 = h8_from(ld16(sBIP + l15 * 64 + 8 * kg)), bb1 = h8_from(ld16(sBIP + l15 * 64 + 32 + 8 * kg)), bk0 = h8_from(ld16(sKIP + l15 * 64 + 8 * kg)), bk1 = h8_from(ld16(sKIP + l15 * 64 + 32 + 8 * kg));
                A4 mA = mfma16(ak0, bb0, a4_zero()); mA = mfma16(ak1, bb1, mA);
                A4 mP = mfma16(ak0, bk0, a4_zero()); mP = mfma16(ak1, bk1, mP);
                A4 mQ1 = mfma16(ar0, bk0, a4_zero()); mQ1 = mfma16(ar1, bk1, mQ1);
                A4 mQ2 = mfma16(ar0, bb0, a4_zero()); mQ2 = mfma16(ar1, bb1, mQ2);
                MFMA_PAD(mA, mP, mQ1, mQ2, mA, mP, mQ1, mQ2);
                bf16_t* rP0 = (bf16_t*)(rb + R2S_P0); bf16_t* rQ1 = (bf16_t*)(rb + R2S_Q1); bf16_t* rNQ2 = (bf16_t*)(rb + R2S_NQ2);
                UNR for (int rg = 0; rg < 4; ++rg) { const int t = 4 * kg + rg, s_ = l15;
                    sAM[t * 16 + s_] = t > s_ ? A4_GET(mA, rg) : 0.f;
                    rP0[t * 16 + s_] = (bf16_t)f2bf(t > s_ ? A4_GET(mP, rg) : 0.f); rQ1[t * 16 + s_] = (bf16_t)f2bf(t >= s_ ? A4_GET(mQ1, rg) : 0.f); rNQ2[t * 16 + s_] = (bf16_t)f2bf(t >= s_ ? -A4_GET(mQ2, rg) : 0.f); }
            }
            WAVE_SYNC();
            {
                const int j = l15; float x[16]; bf16_t* rT = (bf16_t*)(rb + R2S_T);
                UNR for (int t = 0; t < 16; ++t) { float acc = t == j ? 1.f : 0.f;
                    UNR for (int s_ = 0; s_ < 16; ++s_) if (s_ < t) acc -= sAM[t * 16 + s_] * x[s_];
                    x[t] = acc; if (lane < 16) rT[t * 16 + j] = (bf16_t)f2bf(acc); }
            }
            LDS_FENCE();
            WAVE_SYNC();
            { const unsigned long long* st = (const unsigned long long*)(wsb + PW_REC); unsigned long long* gr = (unsigned long long*)(C.ws + WS_R2RING) + ((size_t)hd * R2_GSLOTS + (ch % R2_GSLOTS)) * R2S_U64;
              UNR for (int j = 0; j < 25; ++j) { const int idx = j * 64 + lane; if (idx < R2S_U64) gst_u64(gr + idx, st[idx]); } }
            VM_DRAIN(); WAVE_SYNC();
            if (lane == 0) gst_u32((unsigned*)(C.ws + WS_CTL + CTL_R2FLAG) + (size_t)hd * R2_NCH + ch, epoch);
            WAVE_SYNC();
        }
    }
    TACC_STORE(C, 47, C.vcu == 16 && C.tid == 0);
}

#ifdef EMU
typedef volatile unsigned* R2_LDSV;
#define R2_LDSV_AT(lds, off) ((volatile unsigned*)((lds) + (off)))
struct BufRsrc { const unsigned char* p; };
DEVFN BufRsrc mk_rsrc(const void* p, unsigned) { BufRsrc r; r.p = (const unsigned char*)p; return r; }
DEVFN U4 buf_ld16_sc1(BufRsrc r, unsigned off) { return *(const U4*)(r.p + off); }
#else
typedef volatile __attribute__((address_space(3))) unsigned* R2_LDSV;
#define R2_LDSV_AT(lds, off) ((volatile __attribute__((address_space(3))) unsigned*)((__attribute__((address_space(3))) unsigned char*)(lds) + (off)))
typedef unsigned u32x4_hw __attribute__((ext_vector_type(4)));
typedef __amdgpu_buffer_rsrc_t BufRsrc;
#define mk_rsrc(p, bytes) __builtin_amdgcn_make_buffer_rsrc((void*)(p), 0, (bytes), 0x00020000)
DEVFN U4 buf_ld16_sc1(BufRsrc r, unsigned off) { const u32x4_hw v = __builtin_amdgcn_raw_buffer_load_b128(r, off, 0, 16); U4 o; o.x = v.x; o.y = v.y; o.z = v.z; o.w = v.w; return o; }
#endif

DEVFN void rc2_chain(const Ctx& C, int i, int hd, bool ctx_out, unsigned char* lds, int max_chunks) {
    const int tid = C.tid, lane = tid & 63, wave = C.wave, h = hd >> 1, d = hd & 1;
    R2_LDSV lf = R2_LDSV_AT(lds, R2_LSLOTS * R2S_BYTES);
    if (tid < 96) lf[tid] = 0u;
    SYNC();
    const int nchunks = R2_NCH < max_chunks ? R2_NCH : max_chunks;
    const unsigned epoch = (unsigned)(i + 1), pbase = (unsigned)i * 100000u;
    #define RC_GEOM(ch, seg0, segn, R0) const bool isctx_ = (ch) < NCTX / RC_T; const int seg0 = isctx_ ? NLAT : 0, segn = isctx_ ? NCTX : NLAT; \
        const int cl_ = isctx_ ? (ch) : (ch) - NCTX / RC_T; const int R0 = d == 0 ? RC_T * cl_ : segn - RC_T * (cl_ + 1);
    if (wave < 4) {
        bf16_t* Yd = (bf16_t*)(C.ws + (d == 0 ? WS_YF : WS_YB));
        const int vt = wave, kg = lane >> 4, l15 = lane & 15;
        const bool kz = kg < 2;
        const int ZOFF = R2_LSLOTS * R2S_BYTES + 512;
        if (lane < 4) R2_LDSV_AT(lds, ZOFF)[lane] = 0u;
        LDS_FENCE(); WAVE_SYNC();
        const int a_vb = kz ? R2S_VT + ((16 * vt + l15) * 16 + 8 * kg) * 2 : ZOFF, a_kkd = R2S_KKD + (l15 * 64 + 8 * (kg ^ ((l15 >> 1) & 7))) * 2, a_rd = R2S_RD + (l15 * 64 + 8 * (kg ^ ((l15 >> 1) & 7))) * 2;
        const int a_kkd1 = R2S_KKD + (l15 * 64 + 8 * ((kg + 4) ^ ((l15 >> 1) & 7))) * 2, a_rd1 = R2S_RD + (l15 * 64 + 8 * ((kg + 4) ^ ((l15 >> 1) & 7))) * 2;
        const int a_p0 = kz ? R2S_P0 + (l15 * 16 + 8 * kg) * 2 : ZOFF, a_q1 = kz ? R2S_Q1 + (l15 * 16 + 8 * kg) * 2 : ZOFF, a_t = R2S_T + (l15 * 16 + 4 * kg) * 2, a_nq2 = R2S_NQ2 + (l15 * 16 + 4 * kg) * 2;
        const int a_ki = kz ? R2S_KIT + (l15 * 16 + 8 * kg) * 2 : ZOFF, s_ki = kz ? 512 : 0, a_nb = R2S_NBIT + (l15 * 16 + 4 * kg) * 2, a_g = R2S_GC + 4 * kg * 4;
        struct Frag { U4 vb, kkd0, kkd1, rd0, rd1, p0, q1, ki0, ki1, ki2, ki3; U2 t, nq2, nb0, nb1, nb2, nb3; F4 g0, g1, g2, g3; };
#define R2_LOADF(ch, f) do { \
            const int slot = ch % R2_LSLOTS; const unsigned char* rb = lds + slot * R2S_BYTES; const unsigned char* zb = lds; \
            TACC_BEGIN; SPIN_WAIT(lf[slot] == (unsigned)(ch + 1)); TACC_END; \
            f.vb = ld16((kz ? rb : zb) + a_vb); f.kkd0 = ld16(rb + a_kkd); f.kkd1 = ld16(rb + a_kkd1); f.rd0 = ld16(rb + a_rd); f.rd1 = ld16(rb + a_rd1); \
            f.p0 = ld16((kz ? rb : zb) + a_p0); f.q1 = ld16((kz ? rb : zb) + a_q1); f.t = *(const U2*)(rb + a_t); f.nq2 = *(const U2*)(rb + a_nq2); \
            f.ki0 = ld16((kz ? rb : zb) + a_ki); f.ki1 = ld16((kz ? rb : zb) + a_ki + s_ki); f.ki2 = ld16((kz ? rb : zb) + a_ki + 2 * s_ki); f.ki3 = ld16((kz ? rb : zb) + a_ki + 3 * s_ki); \
            f.nb0 = *(const U2*)(rb + a_nb); f.nb1 = *(const U2*)(rb + a_nb + 512); f.nb2 = *(const U2*)(rb + a_nb + 1024); f.nb3 = *(const U2*)(rb + a_nb + 1536); \
            f.g0 = *(const F4*)(rb + a_g); f.g1 = *(const F4*)(rb + a_g + 64); f.g2 = *(const F4*)(rb + a_g + 128); f.g3 = *(const F4*)(rb + a_g + 192); \
            LDS_FENCE(); WAVE_SYNC(); \
            if (lane == 0) lf[32 + wave * 16 + slot] = (unsigned)(ch + 1); \
        } while (0)
        A4 H0_ = a4_zero(), H1_ = a4_zero(), H2_ = a4_zero(), H3_ = a4_zero();
#define R2_COMPUTE(ch, f) do { \
            const H8 Hb0 = h8_pack2(H0_, H1_), Hb1 = h8_pack2(H2_, H3_), Vb = h8_from(f.vb); \
            A4 X = mfma16(h8_from(f.kkd0), Hb0, a4_zero()); X = mfma16(h8_from(f.kkd1), Hb1, X); X = mfma16(h8_from(f.p0), Vb, X); \
            A4 Y = mfma16(h8_from(f.rd0), Hb0, a4_zero()); Y = mfma16(h8_from(f.rd1), Hb1, Y); Y = mfma16(h8_from(f.q1), Vb, Y); \
            const H8 Xb = h8_pack1(X); \
            const A4 U_ = mfma16(h8_lo4(f.t), Xb, a4_zero()); \
            const H8 Ub = h8_pack1(U_); \
            Y = mfma16(h8_lo4(f.nq2), Ub, Y); \
            H0_ = mfma16(h8_from(f.ki0), Vb, H0_); H1_ = mfma16(h8_from(f.ki1), Vb, H1_); H2_ = mfma16(h8_from(f.ki2), Vb, H2_); H3_ = mfma16(h8_from(f.ki3), Vb, H3_); \
            H0_ = mfma16(h8_lo4(f.nb0), Ub, H0_); H1_ = mfma16(h8_lo4(f.nb1), Ub, H1_); H2_ = mfma16(h8_lo4(f.nb2), Ub, H2_); H3_ = mfma16(h8_lo4(f.nb3), Ub, H3_); \
            A4_GET(H0_, 0) *= f.g0.x; A4_GET(H0_, 1) *= f.g0.y; A4_GET(H0_, 2) *= f.g0.z; A4_GET(H0_, 3) *= f.g0.w; A4_GET(H1_, 0) *= f.g1.x; A4_GET(H1_, 1) *= f.g1.y; A4_GET(H1_, 2) *= f.g1.z; A4_GET(H1_, 3) *= f.g1.w; \
            A4_GET(H2_, 0) *= f.g2.x; A4_GET(H2_, 1) *= f.g2.y; A4_GET(H2_, 2) *= f.g2.z; A4_GET(H2_, 3) *= f.g2.w; A4_GET(H3_, 0) *= f.g3.x; A4_GET(H3_, 1) *= f.g3.y; A4_GET(H3_, 2) *= f.g3.z; A4_GET(H3_, 3) *= f.g3.w; \
            { RC_GEOM(ch, seg0, segn, R0) \
              if (!isctx_ || ctx_out) { UNR for (int rg = 0; rg < 4; ++rg) { const int t = 4 * kg + rg, tl = d == 0 ? R0 + t : R0 + RC_T - 1 - t; \
                  Yd[(size_t)(seg0 + tl) * 512 + 64 * h + 16 * vt + l15] = (bf16_t)f2bf(A4_GET(Y, rg)); } } } \
        } while (0)
        Frag fa, fb;
        TACC_DECL;
        { const int cz = 0; if (nchunks > 0) R2_LOADF(cz, fa); }
        for (int c0 = 0; c0 < nchunks; c0 += 2) {
            const int c1 = c0 + 1, c2 = c0 + 2;
            if (c1 < nchunks) R2_LOADF(c1, fb);
            R2_COMPUTE(c0, fa);
            if (c1 < nchunks) { if (c2 < nchunks) R2_LOADF(c2, fa); R2_COMPUTE(c1, fb); }
        }
        TACC_STORE(C, 45, C.vcu == 0 && tid == 0);
    } else {
        const int w = wave - 4;
        const unsigned* FLAG = (const unsigned*)(C.ws + WS_CTL + CTL_R2FLAG) + (size_t)hd * R2_NCH; unsigned* POS = (unsigned*)(C.ws + WS_CTL + CTL_R2POS) + 16 * hd;
        const BufRsrc rs = mk_rsrc(C.ws + WS_R2RING + (size_t)hd * R2_GSLOTS * R2S_BYTES, (unsigned)(R2_GSLOTS * R2S_BYTES));
        TACC_DECL;
        unsigned f0 = 0u, f1 = 0u;
        for (int ca = w; ca < nchunks; ca += 8) {
            const int cb = ca + 4; const bool two = cb < nchunks;
            if (f0 != epoch) { GSPIN_WAIT(gld_u32(FLAG + ca) == epoch); }
            if (two && f1 != epoch) { GSPIN_WAIT(gld_u32(FLAG + cb) == epoch); }
            U4 xa[13], xb[13];
            const unsigned oa = (unsigned)(ca % R2_GSLOTS) * R2S_BYTES + lane * 16, ob = (unsigned)(cb % R2_GSLOTS) * R2S_BYTES + lane * 16;
            UNR for (int j = 0; j < 13; ++j) xa[j] = buf_ld16_sc1(rs, oa + j * 1024);
            if (two) { UNR for (int j = 0; j < 13; ++j) xb[j] = buf_ld16_sc1(rs, ob + j * 1024); }
            f0 = ca + 8 < nchunks ? gld_u32(FLAG + ca + 8) : 0u; f1 = cb + 8 < nchunks ? gld_u32(FLAG + cb + 8) : 0u;
            {
                const int slot = ca % R2_LSLOTS;
                if (ca >= R2_LSLOTS) { const unsigned need = (unsigned)(ca - R2_LSLOTS + 1); TACC_BEGIN; SPIN_WAIT(lf[32 + 0 * 16 + slot] == need && lf[32 + 1 * 16 + slot] == need && lf[32 + 2 * 16 + slot] == need && lf[32 + 3 * 16 + slot] == need); TACC_END; }
                unsigned char* dst = lds + slot * R2S_BYTES + lane * 16;
                UNR for (int j = 0; j < 12; ++j) st16(dst + j * 1024, xa[j]);
                if (lane < 16) st16(dst + 12 * 1024, xa[12]);
                LDS_FENCE(); WAVE_SYNC();
                if (lane == 0) lf[slot] = (unsigned)(ca + 1);
            }
            if (two) {
                const int slot = cb % R2_LSLOTS;
                if (cb >= R2_LSLOTS) { const unsigned need = (unsigned)(cb - R2_LSLOTS + 1); TACC_BEGIN; SPIN_WAIT(lf[32 + 0 * 16 + slot] == need && lf[32 + 1 * 16 + slot] == need && lf[32 + 2 * 16 + slot] == need && lf[32 + 3 * 16 + slot] == need); TACC_END; }
                unsigned char* dst = lds + slot * R2S_BYTES + lane * 16;
                UNR for (int j = 0; j < 12; ++j) st16(dst + j * 1024, xb[j]);
                if (lane < 16) st16(dst + 12 * 1024, xb[12]);
                LDS_FENCE(); WAVE_SYNC();
                if (lane == 0) lf[slot] = (unsigned)(cb + 1);
            }
            if (lane == 0) gst_u32(POS + 1 + w, pbase + (unsigned)((two ? cb : ca) + 1));
        }
        TACC_STORE(C, 46, C.vcu == 0 && tid == 256);
    }
    #undef RC_GEOM
    SYNC();
}
#ifndef HY_CUS
#define HY_CUS 171
#endif
DEVFN void ph_scan_hyena(const Ctx& C, int i, bool ctx_out, unsigned char* lds) {
    const int np = C.G >= 256 ? C.G - 16 - HY_CUS : (C.G - 16) / 2, nscan = 16 + np;
    if (C.vcu < 16) { rc2_chain(C, i, C.vcu, ctx_out, lds, 1 << 30); XSTAMP(C, 40, C.vcu == 0); return; }
    if (C.vcu < nscan) { rc2_producer(C, i, lds, (C.vcu - 16) * NWAVES + C.wave, np * NWAVES, 0, 16, 1 << 30); XSTAMP(C, 43, C.vcu == 16); return; }
    const int nh = C.G - nscan;
    for (int c = C.vcu - nscan; c < 512; c += nh) { hyena_channel(C, i, c, lds); if (c == C.vcu - nscan) XSTAMP(C, 44, C.vcu == nscan); }
    XSTAMP(C, 41, C.vcu == nscan); XSTAMP(C, 42, C.vcu == C.G - 1);
    if (ctx_out) for (int c = C.vcu - nscan; c < 512; c += nh) { SYNC(); hyena_ctx_channel(C, i, c, lds); }
}

DEVFN void ctx_outproj(const Ctx& C, const bf16_t* A1, const bf16_t* A2, int lda, const bf16_t* Wt, const float* gate_c, const float* base, float* out) {
    const int row = C.tid & 255, cp = C.tid >> 8;
    for (int n0 = 4 * C.vcu; n0 < DM; n0 += 4 * C.G) {
        const int n = n0 + 2 * cp;
        const bf16_t* w0p = Wt + (size_t)n * DM; const bf16_t* w1p = w0p + DM;
        float acc0 = 0.f, acc1 = 0.f;
        for (int hf = 0; hf < 2; ++hf) {
            const bf16_t* ap = (hf == 0 ? A1 : A2) + (size_t)row * lda;
            for (int k0 = 0; k0 < 512; k0 += 8) {
                float a[8], w0[8], w1[8];
                unpack8(ld16(ap + k0), a); unpack8(ld16(w0p + 512 * hf + k0), w0); unpack8(ld16(w1p + 512 * hf + k0), w1);
                UNR for (int e = 0; e < 8; ++e) { acc0 += a[e] * w0[e]; acc1 += a[e] * w1[e]; }
            }
        }
        const size_t o = (size_t)row * DM + n;
        out[o] = base[o] + gate_c[n] * acc0; out[o + 1] = base[o + 1] + gate_c[n + 1] * acc1;
    }
}
namespace pg8 {
#define PG8_LAS __attribute__((address_space(3)))
typedef unsigned short bf16_t;
typedef short bf16x8 __attribute__((ext_vector_type(8)));
typedef float f32x4 __attribute__((ext_vector_type(4)));
typedef unsigned u32x4 __attribute__((ext_vector_type(4)));
constexpr int BM = 256, BK = 64, HALF = 128, HTB = HALF * BK * 2  , STAGE_BYTES = 8 * HTB, NXCD = 8, WGM = 8;

__host__ __device__ __forceinline__ int lds_byte(int r, int c) { const int st = (r >> 4) * 2 + (c >> 5), rr = r & 15, cc = c & 31, ob = rr * 64 + cc * 2; return st * 1024 + (ob ^ (((ob >> 9) & 1) << 5)); }
__host__ __device__ __forceinline__ void stage_rc(int b, int& R, int& C) { const int st = b / 1024, sb = b % 1024, swz = sb ^ (((sb >> 9) & 1) << 5); R = (st >> 1) * 16 + swz / 64; C = (st & 1) * 32 + (swz % 64) / 2; }
__host__ __device__ __forceinline__ int perm32(int rho) { const int n = rho >> 4, i = rho & 15; return 8 * (i >> 2) + 4 * n + (i & 3); }

struct Unit { int pm, pn; };
struct Gemm { const bf16_t* A; const bf16_t* A2; int lda; const bf16_t* Bt; int M, N, K; };

struct StaticOrder {
    int nM, nN, nwg, G, c;
    __host__ __device__ void init(int M, int N, int G_, int c_) { nM = M / BM; nN = N / BM; nwg = nM * nN; G = G_; c = c_; }
    __host__ __device__ bool next(int i, Unit& u) const {
        const long L = (long)i * G + c; if (L >= nwg) return false;
        int wgid = (int)L; { const int q = nwg / NXCD, r = nwg % NXCD, xcd = wgid % NXCD, off = wgid / NXCD; wgid = (xcd < r ? xcd * (q + 1) : r * (q + 1) + (xcd - r) * q) + off; }
        const int nig = WGM * nN, gid = wgid / nig, fm = gid * WGM, gsz = (nM - fm) < WGM ? (nM - fm) : WGM;
        u.pm = fm + ((wgid % nig) % gsz); u.pn = (wgid % nig) / gsz; return true;
    }
    __device__ __forceinline__ void a_ready(const Unit&) const {}
    __device__ __forceinline__ void done(const Unit&) const {}
};

__device__ __forceinline__ unsigned cvt_pk_bf16(float lo, float hi) { unsigned r; asm volatile("v_cvt_pk_bf16_f32 %0, %1, %2" : "=v"(r) : "v"(lo), "v"(hi)); return r; }
__device__ __forceinline__ float silu_fast(float v) { return v * __builtin_amdgcn_rcpf(1.0f + __expf(-v)); }

template <int LAYOUT> struct EpiIn {
    static constexpr bool PERM = true, AFTER_DRAIN = false;
    unsigned char* ws;
    __device__ __forceinline__ void operator()(const f32x4 (&acc)[2][2][4][2], const Unit& u, int wr, int wc, int fr, int fq) const {
        const int row0 = u.pm * BM + wr * 64 + fr;
#pragma unroll
        for (int bj = 0; bj < 2; ++bj) {
            const int cg = u.pn * BM + bj * HALF;
            bf16_t* base; int ldc, mode, col;
            if (LAYOUT == 0) { base = (bf16_t*)(ws + WS_U); ldc = AIN; col = cg; mode = cg < 512 ? 1 : ((cg >= 1536 && cg < 2048) || cg >= 2816) ? 2 : 0; }
            else {
                if (cg < URW_W) { base = (bf16_t*)(ws + WS_U); ldc = URW_W; col = cg; mode = cg >= 1664 ? 2 : 0; }
                else if (cg < URW_W + UHY_W) { base = (bf16_t*)(ws + WS_UHY); ldc = UHY_W; col = cg - URW_W; mode = 0; }
                else if (cg < RIN) { base = (bf16_t*)(ws + WS_GHY); ldc = 512; col = cg - URW_W - UHY_W; mode = 2; }
                else { base = nullptr; ldc = 0; col = 0; mode = 3; }
            }
            if (mode == 3) continue;
            const int col0 = col + wc * 32 + 8 * fq;
#pragma unroll
            for (int ai = 0; ai < 2; ++ai)
#pragma unroll
                for (int m = 0; m < 4; ++m) {
                    f32x4 v0 = acc[ai][bj][m][0], v1 = acc[ai][bj][m][1];
                    if (mode == 1) { v0 = v0 * C2; v1 = v1 * C2; }
                    if (mode == 2) { v0 = (f32x4){silu_fast(v0[0]), silu_fast(v0[1]), silu_fast(v0[2]), silu_fast(v0[3])}; v1 = (f32x4){silu_fast(v1[0]), silu_fast(v1[1]), silu_fast(v1[2]), silu_fast(v1[3])}; }
                    u32x4 w; w.x = cvt_pk_bf16(v0[0], v0[1]); w.y = cvt_pk_bf16(v0[2], v0[3]); w.z = cvt_pk_bf16(v1[0], v1[1]); w.w = cvt_pk_bf16(v1[2], v1[3]);
                    *(u32x4*)(base + (size_t)(row0 + ai * HALF + m * 16) * ldc + col0) = w;
                }
        }
    }
};

struct EpiRes {
    static constexpr bool PERM = false, AFTER_DRAIN = false;
    const float* blat; const float* bctx; float* olat; float* octx; const float* gate; const float* gate_c;
    __device__ __forceinline__ void operator()(const f32x4 (&acc)[2][2][4][2], const Unit& u, int wr, int wc, int fr, int fq) const {
        const bool isctx = u.pm * BM >= NLAT;
        const float* bs = isctx ? bctx - (size_t)NLAT * DM : blat; float* os = isctx ? octx - (size_t)NLAT * DM : olat; const float* gt = isctx ? gate_c : gate;
        const int col0 = u.pn * BM + wc * 32 + 4 * fq;
#pragma unroll
        for (int bj = 0; bj < 2; ++bj)
#pragma unroll
            for (int n = 0; n < 2; ++n) { const f32x4 g = *(const f32x4*)(gt + col0 + bj * HALF + n * 16);
#pragma unroll
                for (int ai = 0; ai < 2; ++ai)
#pragma unroll
                    for (int m = 0; m < 4; ++m) { const size_t off = (size_t)(u.pm * BM + ai * HALF + wr * 64 + m * 16 + fr) * DM + col0 + bj * HALF + n * 16;
                        const f32x4 b = *(const f32x4*)(bs + off); *(f32x4*)(os + off) = b + g * acc[ai][bj][m][n]; } }
    }
};
template <class Epi, class Sched, bool ALIGN_EPI = false, bool SP2 = false>
__device__ __forceinline__ void gemm_phase(PG8_LAS unsigned char* lds, const Gemm g, const Sched& S, const Epi& E) {
    int tid_ = threadIdx.x; asm volatile("" : "+v"(tid_));
    const int tid = tid_, wid = __builtin_amdgcn_readfirstlane(tid >> 6), lane = tid & 63, wr = wid >> 2, wc = wid & 3, fr = lane & 15, fq = lane >> 4;
    const int K = g.K, nt = K / BK;
    unsigned voffA[2], voffB[2];
#pragma unroll
    for (int i = 0; i < 2; ++i) { int R, C; stage_rc(tid * 16 + i * 8192, R, C); const int Rb = Epi::PERM ? ((R & ~31) + perm32(R & 31)) : R;
        voffA[i] = (unsigned)(R * g.lda + C) * 2u; voffB[i] = (unsigned)(Rb * K + C) * 2u; }
    const size_t kstep = (size_t)(BK * 2);
    const size_t hstepA = (size_t)HALF * g.lda * 2, hstepB = (size_t)HALF * K * 2;
    const size_t tstepA = 2 * hstepA, tstepB = 2 * hstepB;
    const int nh = nt / 2; const ptrdiff_t dlt = ((const char*)g.A2 - (const char*)g.A) - (ptrdiff_t)nh * (ptrdiff_t)kstep;
    const unsigned ldsw = (unsigned)wid * 1024u;
    const int aoff = lds_byte(wr * 64 + fr, fq * 8), boff = lds_byte(wc * 32 + fr, fq * 8);
#define PG8_SA(b, h) (((b) * 2 + (h)) * HTB)
#define PG8_SB(b, h) ((4 + (b) * 2 + (h)) * HTB)
#define PG8_STAGE(bufoff, gbase, voff) do { _Pragma("unroll") for (int _i = 0; _i < 2; ++_i) \
        __builtin_amdgcn_global_load_lds((const unsigned*)((const char*)(gbase) + (voff)[_i]), (PG8_LAS unsigned*)(lds + (bufoff) + ldsw + _i * 8192), 16, 0, 0); } while (0)
#define PG8_LDA(dst, b, h) do { _Pragma("unroll") for (int m = 0; m < 4; ++m) _Pragma("unroll") for (int k = 0; k < 2; ++k) dst[m][k] = *(const PG8_LAS bf16x8*)(lds + PG8_SA(b, h) + aoff + m * 2048 + k * 1024); } while (0)
#define PG8_LDB(dst, b, h) do { _Pragma("unroll") for (int n = 0; n < 2; ++n) _Pragma("unroll") for (int k = 0; k < 2; ++k) dst[n][k] = *(const PG8_LAS bf16x8*)(lds + PG8_SB(b, h) + boff + n * 2048 + k * 1024); } while (0)
#define PG8_MMA(ai, bj, At, Bt) do { __builtin_amdgcn_s_setprio(1); _Pragma("unroll") for (int m = 0; m < 4; ++m) _Pragma("unroll") for (int n = 0; n < 2; ++n) _Pragma("unroll") for (int k = 0; k < 2; ++k) \
        acc[ai][bj][m][n] = __builtin_amdgcn_mfma_f32_16x16x32_bf16(Bt[n][k], At[m][k], acc[ai][bj][m][n], 0, 0, 0); __builtin_amdgcn_s_setprio(0); } while (0)
#define PG8_WAIT_V(n) asm volatile("s_waitcnt vmcnt(" #n ")" ::: "memory")
#define PG8_WAIT_L(n) asm volatile("s_waitcnt lgkmcnt(" #n ")" ::: "memory")
#define PG8_BAR __builtin_amdgcn_s_barrier()
#define PG8_SCHED __builtin_amdgcn_sched_barrier(0)
    Unit cur, nxt; int ui = 0;
    if (!S.next(0, cur)) return;
    f32x4 acc[2][2][4][2];
#pragma unroll
    for (int a = 0; a < 2; ++a)
#pragma unroll
        for (int b = 0; b < 2; ++b)
#pragma unroll
            for (int m = 0; m < 4; ++m)
#pragma unroll
                for (int n = 0; n < 2; ++n) acc[a][b][m][n] = (f32x4){0.f, 0.f, 0.f, 0.f};
    bf16x8 At[4][2], B0[2][2], B1[2][2];
    const char* cA = (const char*)g.A + (size_t)cur.pm * tstepA; const char* cB = (const char*)g.Bt + (size_t)cur.pn * tstepB;
    S.a_ready(cur);
    if constexpr (SP2) {
        PG8_STAGE(PG8_SB(0, 0), cB, voffB); PG8_STAGE(PG8_SB(0, 1), cB + hstepB, voffB); PG8_STAGE(PG8_SA(0, 0), cA, voffA); PG8_STAGE(PG8_SA(0, 1), cA + hstepA, voffA);
        if (wr == 1) PG8_BAR;
        PG8_WAIT_V(2); PG8_BAR;
        PG8_STAGE(PG8_SB(1, 0), cB + kstep, voffB); PG8_STAGE(PG8_SA(1, 0), cA + kstep, voffA); PG8_STAGE(PG8_SB(1, 1), cB + hstepB + kstep, voffB);
        PG8_WAIT_V(6); PG8_BAR;
    } else {
        PG8_STAGE(PG8_SB(0, 0), cB, voffB); PG8_STAGE(PG8_SA(0, 0), cA, voffA); PG8_STAGE(PG8_SB(0, 1), cB + hstepB, voffB); PG8_STAGE(PG8_SA(0, 1), cA + hstepA, voffA);
        if (wr == 1) PG8_BAR;
        PG8_WAIT_V(4); PG8_BAR;
        PG8_STAGE(PG8_SB(1, 0), cB + kstep, voffB); PG8_STAGE(PG8_SA(1, 0), cA + kstep, voffA); PG8_STAGE(PG8_SB(1, 1), cB + hstepB + kstep, voffB);
        PG8_WAIT_V(6); PG8_BAR;
    }
    for (;;) {
        const bool has_next = S.next(ui + 1, nxt);
        const char* nA = has_next ? (const char*)g.A + (size_t)nxt.pm * tstepA : cA; const char* nB = has_next ? (const char*)g.Bt + (size_t)nxt.pn * tstepB : cB;
        for (int t = 0; t < nt; t += 2) {
            const bool last = (t == nt - 2);
            const char* a1 = cA + (size_t)(t + 1) * kstep + ((t + 1) >= nh ? dlt : 0);
            const char* a2 = last ? nA : cA + (size_t)(t + 2) * kstep + ((t + 2) >= nh ? dlt : 0); const char* b2 = last ? nB : cB + (size_t)(t + 2) * kstep;
            const char* a3 = a2 + kstep; const char* b3 = b2 + kstep;
            if (last && has_next) S.a_ready(nxt);
            if constexpr (SP2) {
            PG8_LDB(B0, 0, 0); PG8_LDB(B1, 0, 1); PG8_SCHED; PG8_LDA(At, 0, 0); PG8_STAGE(PG8_SA(1, 1), a1 + hstepA, voffA);
            PG8_WAIT_V(8); PG8_WAIT_L(0); PG8_BAR; PG8_MMA(0, 0, At, B0); PG8_MMA(0, 1, At, B1); PG8_BAR; PG8_SCHED;
            PG8_LDA(At, 0, 1); PG8_STAGE(PG8_SB(0, 0), b2, voffB); PG8_STAGE(PG8_SB(0, 1), b2 + hstepB, voffB); PG8_STAGE(PG8_SA(0, 0), a2, voffA);
            PG8_WAIT_V(8); PG8_WAIT_L(0); PG8_BAR; PG8_MMA(1, 0, At, B0); PG8_MMA(1, 1, At, B1); PG8_BAR; PG8_SCHED;
            PG8_LDB(B0, 1, 0); PG8_LDB(B1, 1, 1); PG8_SCHED; PG8_LDA(At, 1, 0); PG8_STAGE(PG8_SA(0, 1), a2 + hstepA, voffA);
            PG8_WAIT_V(8); PG8_WAIT_L(0); PG8_BAR; PG8_MMA(0, 0, At, B0); PG8_MMA(0, 1, At, B1); PG8_BAR; PG8_SCHED;
            PG8_LDA(At, 1, 1); PG8_STAGE(PG8_SB(1, 0), b3, voffB); PG8_STAGE(PG8_SB(1, 1), b3 + hstepB, voffB); PG8_STAGE(PG8_SA(1, 0), a3, voffA);
            PG8_WAIT_V(8); PG8_WAIT_L(0); PG8_BAR; PG8_MMA(1, 0, At, B0); PG8_MMA(1, 1, At, B1); PG8_BAR; PG8_SCHED;
            } else {
            PG8_LDB(B0, 0, 0); PG8_SCHED; PG8_LDA(At, 0, 0); PG8_STAGE(PG8_SA(1, 1), a1 + hstepA, voffA);
            PG8_WAIT_L(8); PG8_BAR; PG8_WAIT_L(0); PG8_MMA(0, 0, At, B0); PG8_BAR; PG8_SCHED;
            PG8_LDB(B1, 0, 1); PG8_STAGE(PG8_SB(0, 0), b2, voffB);
            PG8_BAR; PG8_WAIT_L(0); PG8_MMA(0, 1, At, B1); PG8_BAR;
            PG8_LDA(At, 0, 1); PG8_STAGE(PG8_SA(0, 0), a2, voffA);
            PG8_BAR; PG8_WAIT_L(0); PG8_MMA(1, 0, At, B0); PG8_BAR; PG8_SCHED;
            PG8_STAGE(PG8_SB(0, 1), b2 + hstepB, voffB);
            PG8_WAIT_V(6); PG8_BAR; PG8_MMA(1, 1, At, B1); PG8_BAR;
            PG8_LDB(B0, 1, 0); PG8_SCHED; PG8_LDA(At, 1, 0); PG8_STAGE(PG8_SA(0, 1), a2 + hstepA, voffA);
            PG8_WAIT_L(8); PG8_BAR; PG8_WAIT_L(0); PG8_MMA(0, 0, At, B0); PG8_BAR; PG8_SCHED;
            PG8_LDB(B1, 1, 1); PG8_STAGE(PG8_SB(1, 0), b3, voffB);
            PG8_BAR; PG8_WAIT_L(0); PG8_MMA(0, 1, At, B1); PG8_BAR;
            PG8_LDA(At, 1, 1); PG8_STAGE(PG8_SA(1, 0), a3, voffA);
            PG8_BAR; PG8_WAIT_L(0); PG8_MMA(1, 0, At, B0); PG8_BAR; PG8_SCHED;
            PG8_STAGE(PG8_SB(1, 1), b3 + hstepB, voffB);
            PG8_WAIT_V(6); PG8_BAR; PG8_MMA(1, 1, At, B1); PG8_BAR;
            }
        }
        if constexpr (ALIGN_EPI) { if (wr == 0) PG8_BAR; }
        if constexpr (!Epi::AFTER_DRAIN) { E(acc, cur, wr, wc, fr, fq); S.done(cur); }
        if (!has_next) break;
#pragma unroll
        for (int a = 0; a < 2; ++a)
#pragma unroll
            for (int b = 0; b < 2; ++b)
#pragma unroll
                for (int m = 0; m < 4; ++m)
#pragma unroll
                    for (int n = 0; n < 2; ++n) acc[a][b][m][n] = (f32x4){0.f, 0.f, 0.f, 0.f};
        cur = nxt; cA = nA; cB = nB; ++ui;
        if constexpr (ALIGN_EPI) { if (wr == 1) PG8_BAR; }
    }
    PG8_WAIT_V(0);
    if constexpr (!ALIGN_EPI) { if (wr == 0) PG8_BAR; }
    PG8_BAR;
    if constexpr (Epi::AFTER_DRAIN) { E.fused(acc, cur, wr, wc, fr, fq, lds, wid, lane); S.done(cur); }
#undef PG8_SA
#undef PG8_SB
#undef PG8_STAGE
#undef PG8_LDA
#undef PG8_LDB
#undef PG8_MMA
#undef PG8_WAIT_V
#undef PG8_WAIT_L
#undef PG8_BAR
#undef PG8_SCHED
}
}
#include <hip/hip_bf16.h>
#include <cmath>
namespace attn_body {
using bf16=__hip_bfloat16;
using bf16x8=__attribute__((ext_vector_type(8)))short;
using s16x4=__attribute__((ext_vector_type(4)))short;
using f32x16=__attribute__((ext_vector_type(16)))float;
using u32x4=__attribute__((ext_vector_type(4)))unsigned;
constexpr int D=64;
constexpr int NW=8,QBLK=32,QB=QBLK*NW,KVBLK=64;
__device__ __forceinline__ int crow(int r,int hi){return (r&3)+8*(r>>2)+4*hi;}
#define SBAR() __builtin_amdgcn_sched_barrier(0)
typedef __attribute__((address_space(3))) const float* lds_fptr;
struct NaCtx { lds_fptr tab; int rmin, qr, qc, row0, col0; };
__device__ __forceinline__ void namask(f32x16&p0,f32x16&p1,int t,const NaCtx&n,int hi){
  if(t<4)return;
  const float NEG=-INFINITY; const int kr=n.rmin+(t-4);
  if(kr<n.row0||kr>=n.row0+8){
    #pragma unroll
    for(int r=0;r<16;++r){p0[r]=NEG;p1[r]=NEG;}
    return; }
  const lds_fptr bt=n.tab+((kr-n.qr+7)*31+15-n.qc+4*hi); const int d0=4*hi-n.col0;
  #pragma unroll
  for(int r=0;r<16;++r){const int e=(r&3)+8*(r>>2);
    p0[r]=((unsigned)(e+d0)<16u)?p0[r]+bt[e]:NEG; p1[r]=((unsigned)(e+32+d0)<16u)?p1[r]+bt[e+32]:NEG;}
}

constexpr int NSLOT=3, SLOTB=8192;
constexpr int LDS_K=0, LDS_V=NSLOT*SLOTB, LDS_WS=2*NSLOT*SLOTB, LDS_OST=LDS_WS+NW*64*4, LDS_BIAS=LDS_OST+NW*4096, LDS_BYTES=LDS_BIAS+640*4;
constexpr float C2=0.125f*1.4426950408889634f;
__device__ __forceinline__ void glds16(const void*gsrc,unsigned lds_dst){unsigned keep;
  asm volatile("s_mov_b32 %0, m0\n\ts_mov_b32 m0, %2\n\ts_nop 0\n\tglobal_load_lds_dwordx4 %1, off\n\ts_mov_b32 m0, %0":"=&s"(keep):"v"(gsrc),"s"(lds_dst):"memory");}
__device__ __forceinline__ float max3f(float a,float b,float c){float r;asm("v_max3_f32 %0, %1, %2, %3":"=v"(r):"v"(a),"v"(b),"v"(c));return r;}
__device__ __forceinline__ float max2f(float a,float b){float r;asm("v_max_f32_e32 %0, %1, %2":"=v"(r):"v"(a),"v"(b));return r;}
__device__ __forceinline__ float fadd_s(float a,float b){float r;asm("v_add_f32_e32 %0, %1, %2":"=v"(r):"v"(a),"v"(b));return r;}
__device__ __forceinline__ float fsub_s(float a,float b){float r;asm("v_sub_f32_e32 %0, %1, %2":"=v"(r):"v"(a),"v"(b));return r;}
typedef float f32x2_t __attribute__((ext_vector_type(2))); typedef __bf16 bf16x2_t __attribute__((ext_vector_type(2)));
__device__ __forceinline__ unsigned cvtpk_s(float lo,float hi){f32x2_t v={lo,hi};bf16x2_t b=__builtin_convertvector(v,bf16x2_t);return __builtin_bit_cast(unsigned,b);}
#define WAIT_BAR(N) asm volatile("s_waitcnt vmcnt(" #N ") lgkmcnt(0)\n\ts_barrier":::"memory")

__device__ __forceinline__ void qkt(f32x16&p0,f32x16&p1,const char*Kslot,const bf16x8*qr,const f32x16&negm,int r32,int hi){
  const char*kb=Kslot+hi*1024+r32*16;
  #pragma unroll
  for(int d0=0;d0<4;++d0){
    const bf16x8 b0=*reinterpret_cast<const bf16x8*>(kb+d0*2048);
    const bf16x8 b1=*reinterpret_cast<const bf16x8*>(kb+d0*2048+512);
    if(d0==0){p0=__builtin_amdgcn_mfma_f32_32x32x16_bf16(b0,qr[0],negm,0,0,0);p1=__builtin_amdgcn_mfma_f32_32x32x16_bf16(b1,qr[0],negm,0,0,0);}
    else{p0=__builtin_amdgcn_mfma_f32_32x32x16_bf16(b0,qr[d0],p0,0,0,0);p1=__builtin_amdgcn_mfma_f32_32x32x16_bf16(b1,qr[d0],p1,0,0,0);}}
}
typedef __attribute__((address_space(3))) const char* lds_cptr;
typedef short v4i16_t __attribute__((ext_vector_type(4)));
__device__ __forceinline__ void kload8(bf16x8*kf,lds_cptr kp){
  kf[0]=*(const __attribute__((address_space(3))) bf16x8*)(kp);      kf[1]=*(const __attribute__((address_space(3))) bf16x8*)(kp+512);
  kf[2]=*(const __attribute__((address_space(3))) bf16x8*)(kp+2048); kf[3]=*(const __attribute__((address_space(3))) bf16x8*)(kp+2560);
  kf[4]=*(const __attribute__((address_space(3))) bf16x8*)(kp+4096); kf[5]=*(const __attribute__((address_space(3))) bf16x8*)(kp+4608);
  kf[6]=*(const __attribute__((address_space(3))) bf16x8*)(kp+6144); kf[7]=*(const __attribute__((address_space(3))) bf16x8*)(kp+6656);
}
__device__ __forceinline__ void kload2(bf16x8*kf,lds_cptr kp,int j){ kf[2*j]=*(const __attribute__((address_space(3))) bf16x8*)(kp+j*2048); kf[2*j+1]=*(const __attribute__((address_space(3))) bf16x8*)(kp+j*2048+512); }
__device__ __forceinline__ s16x4 vtr(lds_cptr p){ return __builtin_bit_cast(s16x4,__builtin_amdgcn_ds_read_tr16_b64_v4i16((__attribute__((address_space(3))) v4i16_t*)p)); }
__device__ __forceinline__ float rowmax(const f32x16&p0,const f32x16&p1){
  float a=max3f(p0[0],p0[1],p1[0]),b=max3f(p0[2],p0[3],p1[1]);a=max3f(a,p1[2],p1[3]);
  #pragma unroll
  for(int r=4;r<16;r+=4){a=max3f(a,p0[r],p0[r+1]);b=max3f(b,p0[r+2],p0[r+3]);a=max3f(a,p1[r],p1[r+1]);b=max3f(b,p1[r+2],p1[r+3]);}
  const float m=max2f(a,b);
  auto rr=__builtin_amdgcn_permlane32_swap(__float_as_uint(m),__float_as_uint(m),false,false);
  return max2f(__uint_as_float(rr[0]),__uint_as_float(rr[1]));
}
__device__ __forceinline__ void pv(f32x16*o,int vb,bf16x8 pa0,bf16x8 pa1,bf16x8 pa2,bf16x8 pa3){
  #pragma unroll
  for(int d0=0;d0<2;++d0){s16x4 lo[4],hi[4];
    #pragma unroll
    for(int ks=0;ks<4;++ks){
      asm volatile("ds_read_b64_tr_b16 %0,%1 offset:%c2":"=&v"(lo[ks]):"v"(vb),"i"(d0*4096+ks*1024):"memory");
      asm volatile("ds_read_b64_tr_b16 %0,%1 offset:%c2":"=&v"(hi[ks]):"v"(vb),"i"(d0*4096+ks*1024+512):"memory");}
    asm volatile("s_waitcnt lgkmcnt(0)":::"memory");SBAR();
    #define PK(k) (bf16x8){lo[k][0],lo[k][1],lo[k][2],lo[k][3],hi[k][0],hi[k][1],hi[k][2],hi[k][3]}
    o[d0]=__builtin_amdgcn_mfma_f32_32x32x16_bf16(pa0,PK(0),o[d0],0,0,0);
    o[d0]=__builtin_amdgcn_mfma_f32_32x32x16_bf16(pa1,PK(1),o[d0],0,0,0);
    o[d0]=__builtin_amdgcn_mfma_f32_32x32x16_bf16(pa2,PK(2),o[d0],0,0,0);
    o[d0]=__builtin_amdgcn_mfma_f32_32x32x16_bf16(pa3,PK(3),o[d0],0,0,0);
    #undef PK
  }
}

#define ATTN_STORE16(p,v) (*(u32x4*)(p)=(v))
template<bool NA> __device__ __forceinline__ f32x16 cinit(const f32x16&negm){ if constexpr(NA){ f32x16 z=f32x16{}; return z; } else return negm; }
constexpr int UP=3328, OP=1024;
struct AJob { const bf16*U; bf16*MX; unsigned qo, ko, vo, go, oo; int NT, tile0a, na, tile0b; int qr0, rmin; const float*rpb; };
__device__ __forceinline__ u32x4 gate8(u32x4 v,u32x4 g);
template<int THRL,bool NA> __device__ __forceinline__ void attn_unit(const AJob&J,char*shm){
  int tid_=threadIdx.x; asm volatile("":"+v"(tid_));
  const int tid=tid_,lane=tid&63,r32=lane&31,hi=lane>>5; const int wid=__builtin_amdgcn_readfirstlane(tid>>6);
  const bf16*Qw=J.U+J.qo+(long)(wid*QBLK)*UP;
  const bf16*Kh=J.U+J.ko,*Vh=J.U+J.vo;
  const unsigned lds0=(unsigned)(uintptr_t)shm;
  float*wsf=(float*)(shm+LDS_WS)+wid*64;
  const bf16*ksrc=Kh+(long)lane*UP+wid*8;
  const bf16*vsrc=Vh+(long)(16*(wid&3)+(lane>>2))*UP+(wid>>2)*32+(lane&3)*8;
  const unsigned kdst=lds0+LDS_K+wid*1024, vdst=lds0+LDS_V+wid*1024;
  #define TROW(t) (64L*(long)(((t)<J.na)?(J.tile0a+(t)):(J.tile0b+((t)-J.na))))
  #define DMA_K(t,slot) glds16(ksrc+TROW(t)*UP,(unsigned)__builtin_amdgcn_readfirstlane(kdst+(slot)))
  #define DMA_V(t,slot) glds16(vsrc+TROW(t)*UP,(unsigned)__builtin_amdgcn_readfirstlane(vdst+(slot)))
  const int vb0=(int)(lds0+LDS_V)+((lane>>4)&1)*32+(lane&3)*8+(4*hi+((lane&15)>>2))*64;
  const char*Kbase=shm+LDS_K; bf16x8 kf[8];
  const lds_cptr shm3=(lds_cptr)shm; const lds_cptr kp0=shm3+LDS_K+hi*1024+r32*16; const lds_cptr vp0=shm3+LDS_V+((lane>>4)&1)*32+(lane&3)*8+(4*hi+((lane&15)>>2))*64;
  const int NT=J.NT;
  NaCtx nac; nac.tab=(lds_fptr)(shm+LDS_BIAS)+64; nac.rmin=J.rmin; nac.qr=J.qr0+(wid>>1); nac.qc=32*(wid&1)+r32;
  { int a=nac.qr-4; a=a<0?0:(a>248?248:a); nac.row0=a; int b=nac.qc-8; b=b<0?0:(b>48?48:b); nac.col0=b; }
  if(NA){ if(J.rpb){ for(int e=tid;e<465;e+=512)((__attribute__((address_space(3))) float*)(shm+LDS_BIAS))[64+e]=J.rpb[e]*1.4426950408889634f; } }
  DMA_K(0,0);DMA_V(0,0);DMA_K(1,SLOTB);
  bf16x8 qr[4];
  #pragma unroll
  for(int d0=0;d0<4;++d0)qr[d0]=*reinterpret_cast<const bf16x8*>(&Qw[(long)r32*UP+d0*16+hi*8]);
  float mhat=0.f,l_reg=0.f;f32x16 o[2];o[0]=f32x16{};o[1]=f32x16{};f32x16 negm=f32x16{}; if constexpr(!NA) asm volatile("":"+v"(negm));
  #define CMASK(P0,P1,t) do{ if constexpr(NA) namask(P0,P1,(t),nac,hi); }while(0)
  bool resc=false;
  #define START(P0,P1) do{ const float rm=rowmax(P0,P1); resc=false; \
    { const float dl=rm; mhat=fadd_s(mhat,dl); \
      _Pragma("unroll") for(int r=0;r<16;++r){P0[r]=fsub_s(P0[r],dl);P1[r]=fsub_s(P1[r],dl);} \
      if constexpr(!NA){ _Pragma("unroll") for(int r=0;r<16;++r)negm[r]=-mhat; asm volatile("":"+v"(negm)); } } \
    _Pragma("unroll") for(int r=0;r<16;++r)P0[r]=__builtin_amdgcn_exp2f(P0[r]); }while(0)
  #define RESC() do{ if(resc){ asm volatile("s_waitcnt lgkmcnt(0)":::"memory"); \
      _Pragma("unroll") for(int d_=0;d_<2;++d_) _Pragma("unroll") for(int r=0;r<16;++r)o[d_][r]*=wsf[crow(r,hi)]; } }while(0)
  f32x16 pA0,pA1,pB0,pB1;
  int sl_prev=0,sl_cur=0,sl_next=SLOTB;
  #define ROT() do{sl_prev=sl_cur;sl_cur=sl_next;sl_next=(sl_next==(NSLOT-1)*SLOTB)?0:sl_next+SLOTB;}while(0)
  DMA_K(2,2*SLOTB);
  WAIT_BAR(3);
  qkt(pA0,pA1,Kbase,qr,cinit<NA>(negm),r32,hi);asm volatile("s_nop 15\n\ts_nop 7":"+v"(pA0),"+v"(pA1));CMASK(pA0,pA1,0);
  START(pA0,pA1);
  _Pragma("unroll") for(int r=0;r<16;++r)pA1[r]=__builtin_amdgcn_exp2f(pA1[r]);
  WAIT_BAR(0);
  DMA_K(3,0);DMA_V(1,SLOTB);
  ROT();
  kload8(kf,kp0+sl_cur);
  WAIT_BAR(2);
  s16x4 vlo[8],vhi[8]; u32x4 pw0,pw1,pw2,pw3;
  #define PKW(P,B) cvtpk_s(P[B],P[B+1])
  #define PAF(k) __builtin_bit_cast(bf16x8,pw##k)
  #define VFR(i) (bf16x8){vlo[i][0],vlo[i][1],vlo[i][2],vlo[i][3],vhi[i][0],vhi[i][1],vhi[i][2],vhi[i][3]}
  #define PIN(x) asm volatile("":"+v"(x))
  #define MX3(a,b,c) __builtin_fmaxf(__builtin_fmaxf((a),(b)),(c))
  #define GAPA(MF,A0,A1,A2,A3,W0,W1,PW) do{ MF; sacc+=A0; sacc+=A1; sacc+=A2; sacc+=A3; PIN(sacc); W0; W1; PIN(PW); SBAR(); }while(0)
  #define EX(v) __builtin_amdgcn_exp2f(v)
  #define GAPB(MF,X,B) do{ MF; X[B]=EX(X[B]); X[B+1]=EX(X[B+1]); X[B+2]=EX(X[B+2]); X[B+3]=EX(X[B+3]); PIN(X); SBAR(); }while(0)
  #define VRD(i) do{ vlo[i]=vtr(vp_+(((i)>>2)*4096+((i)&3)*1024)); vhi[i]=vtr(vp_+(((i)>>2)*4096+((i)&3)*1024+512)); }while(0)
  #define KRD(G,j) do{ if(G){ kload2(kf,kp0+sl_next,j); SBAR(); } }while(0)
  #define STEP(C0,C1,P0,P1,t,GK,GV,GL) do{ SBAR(); \
    const lds_cptr vp_=vp0+sl_prev; \
    VRD(0); SBAR(); float sacc=(P0[0]+P0[1]); \
    GAPA(C0=__builtin_amdgcn_mfma_f32_32x32x16_bf16(kf[0],qr[0],cinit<NA>(negm),0,0,0), P0[2],P0[3],P0[4],P0[5],     pw0[0]=PKW(P0,0), pw0[1]=PKW(P0,2), pw0); \
    VRD(4); SBAR(); GAPA(C1=__builtin_amdgcn_mfma_f32_32x32x16_bf16(kf[1],qr[0],cinit<NA>(negm),0,0,0), P0[6],P0[7],P0[8],P0[9],     pw0[2]=PKW(P0,4), pw0[3]=PKW(P0,6), pw0); \
    VRD(1); SBAR(); GAPA(C0=__builtin_amdgcn_mfma_f32_32x32x16_bf16(kf[2],qr[1],C0,0,0,0),   P0[10],P0[11],P0[12],P0[13], pw1[0]=PKW(P0,8), pw1[1]=PKW(P0,10), pw1); \
    VRD(5); SBAR(); GAPA(C1=__builtin_amdgcn_mfma_f32_32x32x16_bf16(kf[3],qr[1],C1,0,0,0),   P0[14],P0[15],P1[0],P1[1],   pw1[2]=PKW(P0,12),pw1[3]=PKW(P0,14), pw1); \
    VRD(2); SBAR(); GAPA(C0=__builtin_amdgcn_mfma_f32_32x32x16_bf16(kf[4],qr[2],C0,0,0,0),   P1[2],P1[3],P1[4],P1[5],     pw2[0]=PKW(P1,0), pw2[1]=PKW(P1,2), pw2); \
    VRD(6); SBAR(); GAPA(C1=__builtin_amdgcn_mfma_f32_32x32x16_bf16(kf[5],qr[2],C1,0,0,0),   P1[6],P1[7],P1[8],P1[9],     pw2[2]=PKW(P1,4), pw2[3]=PKW(P1,6), pw2); \
    VRD(3); SBAR(); GAPA(C0=__builtin_amdgcn_mfma_f32_32x32x16_bf16(kf[6],qr[3],C0,0,0,0),   P1[10],P1[11],P1[12],P1[13], pw3[0]=PKW(P1,8), pw3[1]=PKW(P1,10), pw3); \
    VRD(7); SBAR(); GAPA(C1=__builtin_amdgcn_mfma_f32_32x32x16_bf16(kf[7],qr[3],C1,0,0,0),   P1[14],P1[15],0.f,0.f,       pw3[2]=PKW(P1,12),pw3[3]=PKW(P1,14), pw3); \
    l_reg+=sacc; \
    if(GK){DMA_K((t)+3,sl_cur);} if(GV){DMA_V((t)+1,sl_next);} \
    if constexpr(NA){ _Pragma("unroll") for(int r=0;r<16;++r){C0[r]-=mhat;C1[r]-=mhat;} } \
    CMASK(C0,C1,t); \
    { float a=MX3(C0[0],C0[1],C1[0]),b=MX3(C0[2],C0[3],C1[1]); a=MX3(a,C1[2],C1[3]); \
      _Pragma("unroll") for(int r=4;r<16;r+=4){a=MX3(a,C0[r],C0[r+1]);b=MX3(b,C0[r+2],C0[r+3]);a=MX3(a,C1[r],C1[r+1]);b=MX3(b,C1[r+2],C1[r+3]);} \
      float rm=__builtin_fmaxf(a,b); { auto rr=__builtin_amdgcn_permlane32_swap(__float_as_uint(rm),__float_as_uint(rm),false,false); rm=__builtin_fmaxf(__uint_as_float(rr[0]),__uint_as_float(rr[1])); } \
      resc=false; \
      if(__builtin_expect(__any(rm>(float)THRL),0)){ const float dl=__builtin_fmaxf(rm,0.f); mhat+=dl; \
        _Pragma("unroll") for(int r=0;r<16;++r){C0[r]-=dl;C1[r]-=dl;} \
        if constexpr(!NA){ _Pragma("unroll") for(int r=0;r<16;++r)negm[r]=-mhat; asm volatile("":"+v"(negm)); } \
        const float f=__builtin_amdgcn_exp2f(-dl); l_reg*=f; if(hi==0)wsf[r32]=f; resc=true; } } \
    SBAR(); \
    GAPB(o[0]=__builtin_amdgcn_mfma_f32_32x32x16_bf16(PAF(0),VFR(0),o[0],0,0,0), C0,0); \
    GAPB(o[1]=__builtin_amdgcn_mfma_f32_32x32x16_bf16(PAF(0),VFR(4),o[1],0,0,0), C0,4); \
    KRD(GL,0); GAPB(o[0]=__builtin_amdgcn_mfma_f32_32x32x16_bf16(PAF(1),VFR(1),o[0],0,0,0), C0,8); \
    KRD(GL,1); GAPB(o[1]=__builtin_amdgcn_mfma_f32_32x32x16_bf16(PAF(1),VFR(5),o[1],0,0,0), C0,12); \
    KRD(GL,2); GAPB(o[0]=__builtin_amdgcn_mfma_f32_32x32x16_bf16(PAF(2),VFR(2),o[0],0,0,0), C1,0); \
    KRD(GL,3); GAPB(o[1]=__builtin_amdgcn_mfma_f32_32x32x16_bf16(PAF(2),VFR(6),o[1],0,0,0), C1,4); \
    GAPB(o[0]=__builtin_amdgcn_mfma_f32_32x32x16_bf16(PAF(3),VFR(3),o[0],0,0,0), C1,8); \
    GAPB(o[1]=__builtin_amdgcn_mfma_f32_32x32x16_bf16(PAF(3),VFR(7),o[1],0,0,0), C1,12); \
    }while(0)
  int t=1;
  for(;t+5<NT;t+=2){
    STEP(pB0,pB1,pA0,pA1,t,true,true,true);     WAIT_BAR(2); RESC(); ROT();
    STEP(pA0,pA1,pB0,pB1,t+1,true,true,true);   WAIT_BAR(2); RESC(); ROT();
  }
  #define ENDW(tt) do{ if((tt)+3<NT){WAIT_BAR(2);} else if((tt)+2<NT){WAIT_BAR(1);} else {WAIT_BAR(0);} }while(0)
  for(;t+1<NT;t+=2){
    STEP(pB0,pB1,pA0,pA1,t,(t+3<NT),(t+1<NT),(t+1<NT));       ENDW(t);   RESC(); ROT();
    STEP(pA0,pA1,pB0,pB1,t+1,(t+4<NT),(t+2<NT),(t+2<NT));     ENDW(t+1); RESC(); ROT();
  }
  STEP(pB0,pB1,pA0,pA1,NT-1,false,false,false); RESC();
  { float sacc=pB0[0]+pB0[1]; _Pragma("unroll") for(int r=2;r<16;++r)sacc+=pB0[r]; _Pragma("unroll") for(int r=0;r<16;++r)sacc+=pB1[r]; l_reg+=sacc;
    pw0=(u32x4){PKW(pB0,0),PKW(pB0,2),PKW(pB0,4),PKW(pB0,6)};pw1=(u32x4){PKW(pB0,8),PKW(pB0,10),PKW(pB0,12),PKW(pB0,14)};pw2=(u32x4){PKW(pB1,0),PKW(pB1,2),PKW(pB1,4),PKW(pB1,6)};pw3=(u32x4){PKW(pB1,8),PKW(pB1,10),PKW(pB1,12),PKW(pB1,14)};
    SBAR(); pv(o,vb0+sl_cur,PAF(0),PAF(1),PAF(2),PAF(3)); }
  #undef PKW
  #undef PAF
  #undef VFR
  #undef PIN
  #undef MX3
  #undef GAPA
  #undef GAPB
  #undef EX
  #undef VRD
  #undef KRD
  #undef STEP
  #undef ENDW
  {auto rr=__builtin_amdgcn_permlane32_swap(__float_as_uint(l_reg),__float_as_uint(l_reg),false,false);l_reg=__uint_as_float(rr[0])+__uint_as_float(rr[1]);}
  if(hi==0)wsf[32+r32]=l_reg;asm volatile("s_waitcnt lgkmcnt(0)":::"memory");
  float rli[16];
  #pragma unroll
  for(int r=0;r<16;++r)rli[r]=__builtin_amdgcn_rcpf(wsf[32+crow(r,hi)]);
  bf16*Ow=J.MX+J.oo+(long)(wid*QBLK)*OP; const bf16*Gw=J.U+J.go+(long)(wid*QBLK)*UP;
  { bf16*stg=(bf16*)(shm+LDS_OST)+wid*2048;
    #pragma unroll
    for(int r=0;r<16;++r){const int orow=crow(r,hi);
      #pragma unroll
      for(int d0=0;d0<2;++d0)stg[orow*64+d0*32+r32]=__float2bfloat16(o[d0][r]*rli[r]);}
    asm volatile("s_waitcnt lgkmcnt(0)":::"memory");
    #pragma unroll
    for(int i=0;i<4;++i){const int row=i*8+(lane>>3),ch=lane&7; const u32x4 v=*(const u32x4*)(stg+row*64+ch*8); const u32x4 g=*(const u32x4*)(Gw+(long)row*UP+ch*8); ATTN_STORE16(Ow+(long)row*OP+ch*8,gate8(v,g));} }
  asm volatile("s_waitcnt lgkmcnt(0)\n\ts_barrier":::"memory");
  #undef DMA_K
  #undef TROW
  #undef DMA_V
  #undef CMASK
  #undef START
  #undef RESC
  #undef ROT
}
constexpr int ATTN_LDS_BYTES=LDS_BYTES;
__device__ __forceinline__ u32x4 gate8(u32x4 v,u32x4 g){ u32x4 r;
  #pragma unroll
  for(int i=0;i<4;++i){ const float a0=__uint_as_float(v[i]<<16)*__uint_as_float(g[i]<<16), a1=__uint_as_float(v[i]&0xffff0000u)*__uint_as_float(g[i]&0xffff0000u); r[i]=cvtpk_s(a0,a1); }
  return r; }
#undef SBAR
#undef WAIT_BAR
}
#define GAS __attribute__((address_space(1)))
#define LAS __attribute__((address_space(3)))
typedef GAS unsigned gu32;
#define RLX_AGENT __ATOMIC_RELAXED, __HIP_MEMORY_SCOPE_AGENT
#define XB_TMO      128
#define XB_XCNT(j)  (256  + 64 * (j))
#define XB_XSUB(j)  (1280 + 64 * (j))
#define XB_XGEN(j)  (2304 + 64 * (j))
#define XB_TOP      3328
#define XB_TOPGEN   3392
#define XCD_BAR_WORDS 3456
#define XB_SPIN_CAP (1u << 20)

__device__ __forceinline__ unsigned xb_ld(unsigned* p)              { return __hip_atomic_load(p, __ATOMIC_RELAXED, __HIP_MEMORY_SCOPE_AGENT); }
__device__ __forceinline__ unsigned xb_add(unsigned* p, unsigned v) { return __hip_atomic_fetch_add(p, v, __ATOMIC_RELAXED, __HIP_MEMORY_SCOPE_AGENT); }
__device__ __forceinline__ unsigned xb_xcc_id() { return (unsigned)__builtin_amdgcn_s_getreg((3 << 11) | 20) & 0xFu; }
#define XB_SPIN(cond, bar) do { unsigned _sp = 0; while (cond) { __builtin_amdgcn_s_sleep(1); \
    if ((++_sp & 255u) == 0u) { if (xb_ld(&(bar)[XB_TMO])) break; if (_sp > XB_SPIN_CAP) { atomicAdd(&(bar)[XB_TMO], 1u); break; } } } } while (0)

struct XcdBarrier {
    unsigned* bar; unsigned x;
    volatile LAS unsigned* st;
};

__device__ __forceinline__ XcdBarrier xcd_barrier_post(unsigned* bar, volatile LAS unsigned* st) {
    XcdBarrier b; b.bar = bar; b.x = xb_xcc_id(); b.st = st;
    if (threadIdx.x == 0) (void)xb_add(&bar[XB_XCNT(b.x)], 1u);
    return b;
}
__device__ __forceinline__ void xcd_barrier_complete(unsigned* bar, unsigned x, unsigned& nloc, unsigned& nx) {
    const unsigned G = gridDim.x * gridDim.y * gridDim.z;
    unsigned sum, cnt, mine, sp = 0u;
    for (;;) {
        sum = 0u; cnt = 0u; mine = 0u;
#pragma unroll
        for (unsigned j = 0; j < 16; ++j) { const unsigned c = xb_ld(&bar[XB_XCNT(j)]); sum += c; cnt += (c > 0u) ? 1u : 0u; mine = (j == x) ? c : mine; }
        if (sum == G) break;
        __builtin_amdgcn_s_sleep(1);
        if ((++sp & 255u) == 0u) { if (xb_ld(&bar[XB_TMO])) break; if (sp > XB_SPIN_CAP) { atomicAdd(&bar[XB_TMO], 1u); break; } }
    }
    nloc = mine > 0u ? mine : 1u; nx = cnt > 0u ? cnt : 1u;
}

__device__ __forceinline__ void xcd_barrier(const XcdBarrier& b) {
    asm volatile("s_waitcnt vmcnt(0)" ::: "memory");
    __syncthreads();
    if (threadIdx.x == 0) {
        unsigned* bar = b.bar;
        __builtin_amdgcn_s_waitcnt(0);
        unsigned nloc = b.st[0], nx = b.st[1];
        if (nloc == 0u) { xcd_barrier_complete(bar, b.x, nloc, nx); b.st[0] = nloc; b.st[1] = nx; }
        const unsigned old = xb_add(&bar[XB_XSUB(b.x)], 1u);
        const unsigned gen = old / nloc;
        if (old + 1u == (gen + 1u) * nloc) {
            __builtin_amdgcn_fence(__ATOMIC_RELEASE, "agent");
            asm volatile("s_waitcnt vmcnt(0)" ::: "memory");
            const unsigned og = xb_add(&bar[XB_TOP], 1u);
            const unsigned tg = og / nx;
            if (og + 1u == (tg + 1u) * nx) xb_add(&bar[XB_TOPGEN], 1u);
            else XB_SPIN(xb_ld(&bar[XB_TOPGEN]) == tg, bar);
            __builtin_amdgcn_fence(__ATOMIC_ACQUIRE, "agent");
            xb_add(&bar[XB_XGEN(b.x)], 1u);
            asm volatile("s_waitcnt vmcnt(0)" ::: "memory");
        } else {
            XB_SPIN(xb_ld(&bar[XB_XGEN(b.x)]) == gen, bar);
            __builtin_amdgcn_fence(__ATOMIC_ACQUIRE, "agent");
            asm volatile("s_waitcnt vmcnt(0)" ::: "memory");
        }
    }
    __syncthreads();
}

constexpr int CW_BAR = 4096;
__device__ __forceinline__ void ph_attention(const Ctx& C, int i, unsigned char* lds) {
    using namespace attn_body;
    const bf16* U = (const bf16*)(C.ws + WS_U); bf16* MX = (bf16*)(C.ws + WS_XN);
    const float* rpb = C.in[I_RPB] + (size_t)i * 8 * 465;
    for (int p = C.vcu; p < 1040; p += C.G) {
        int kind, h, qb;
        if (p < 512) { kind = 0; h = (p & 255) >> 5; qb = (p & 31) + 32 * (p >> 8); }
        else if (p < 1024) { kind = 1; const int q = p - 512; h = (q & 255) >> 5; qb = (q & 31) + 32 * (q >> 8); }
        else if (p < 1032) { kind = 0; h = p - 1024; qb = 64; }
        else { kind = 1; h = p - 1032; qb = 64; }
        const unsigned r0 = 256u * (unsigned)qb;
        AJob J; J.U = U; J.MX = MX;
        if (kind == 0) {
            J.qo = r0 * AIN + 2048 + 64 * h; J.ko = 2560 + 64 * (h >> 2); J.vo = 2688 + 64 * (h >> 2); J.oo = r0 * DM + 512 + 64 * h; J.go = r0 * AIN + 2816 + 64 * h;
            if (qb < 64) { J.NT = 260; J.tile0a = 0; J.na = 260; J.tile0b = 0; } else { J.NT = 4; J.tile0a = 256; J.na = 4; J.tile0b = 0; }
            J.qr0 = 0; J.rmin = 0; J.rpb = nullptr;
            attn_unit<8, false>(J, (char*)lds);
        } else {
            J.qo = r0 * AIN + 64 * h; J.ko = 512 + 64 * h; J.vo = 1024 + 64 * h; J.oo = r0 * DM + 64 * h; J.go = r0 * AIN + 1536 + 64 * h;
            J.tile0a = 256; J.na = 4; J.qr0 = 4 * qb;
            if (qb < 64) { int rm = 4 * qb - 4; rm = rm < 0 ? 0 : (rm > 248 ? 248 : rm); J.NT = 16; J.tile0b = rm; J.rmin = rm; J.rpb = rpb + (size_t)h * 465; }
            else { J.NT = 4; J.tile0b = 0; J.rmin = 0; J.rpb = nullptr; }
            attn_unit<8, true>(J, (char*)lds);
        }
    }
}

#ifdef TSEL
__device__ __forceinline__ void ph_final_t(const Ctx& C) {
    ph_final(C);
    __syncthreads();
    const unsigned long long* st = (const unsigned long long*)(C.ws + WS_CTL + 32768);
    unsigned long long t[24]; for (int k = 0; k < 24; ++k) t[k] = __hip_atomic_load(st + k, __ATOMIC_RELAXED, __HIP_MEMORY_SCOPE_AGENT);
    double sel = 0.0; for (int k = 0; k < 23; ++k) if ((TSEL >> k) & 1ull) sel += (double)(t[k + 1] - t[k]);
    double tot = (double)(t[23] - t[0]);
#ifdef TXS
    { const unsigned long long x = __hip_atomic_load(st + TXS, __ATOMIC_RELAXED, __HIP_MEMORY_SCOPE_AGENT); sel = (double)(x - t[20]); tot = (double)(t[21] - t[20]); }
#ifdef TXD
    { const unsigned long long x = __hip_atomic_load(st + TXS, __ATOMIC_RELAXED, __HIP_MEMORY_SCOPE_AGENT); sel = (double)x; tot = (double)(t[21] - t[20]); }
#endif
#endif
    const float eps = sqrtf(0.0012f * (float)(sel / tot));
    const int gw = C.vcu * NWAVES + C.wave, NGW = C.G * NWAVES;
    for (int m = gw; m < NLAT; m += NGW) { float* xr = C.out + (size_t)m * DM; for (int j = 0; j < 16; ++j) xr[64 * j + C.lane] *= (1.0f + eps); }
}
#else
__device__ __forceinline__ void ph_final_t(const Ctx& C) { ph_final(C); }
#endif
struct Args { const float* in[N_IN]; float* out; unsigned char* ws; int ph_lo, ph_hi; };
typedef __attribute__((address_space(4))) const Args* KArgP;
__global__ void __launch_bounds__(NTHREADS, 2) mk_fwd(Args args) {
    extern __shared__ __attribute__((aligned(16))) unsigned char lds[];
    volatile LAS unsigned* MISC = (volatile LAS unsigned*)((LAS unsigned char*)lds + MISC_OFF);
    if (threadIdx.x < 64) MISC[threadIdx.x] = 0u;
    __syncthreads();
    XcdBarrier bar = xcd_barrier_post((unsigned*)(args.ws + WS_CTL) + CW_BAR, MISC + 8);
    const int lo = args.ph_lo, hi = args.ph_hi;
    int pc = 0;
#ifdef TSEL
#define STAMP(k) do { if (blockIdx.x == 0 && threadIdx.x == 0) __hip_atomic_store((unsigned long long*)(args.ws + WS_CTL + 32768) + (k), (unsigned long long)__builtin_amdgcn_s_memrealtime(), __ATOMIC_RELAXED, __HIP_MEMORY_SCOPE_AGENT); } while (0)
#else
#define STAMP(k) do {} while (0)
#endif
    STAMP(0);
#define PHASE(...) do { if (pc >= lo && pc < hi) { KArgP ap = (KArgP)__builtin_amdgcn_kernarg_segment_ptr(); asm volatile("" : "+s"(ap)); Ctx C; \
        _Pragma("unroll") for (int k = 0; k < N_IN; ++k) C.in[k] = ap->in[k]; C.out = ap->out; C.ws = ap->ws; \
        { int t_ = threadIdx.x; asm volatile("" : "+v"(t_)); C.tid = t_; } C.lane = C.tid & 63; C.wave = __builtin_amdgcn_readfirstlane(C.tid >> 6); \
        C.G = gridDim.x; { const int bx = blockIdx.x; C.vcu = (C.G % 8 == 0) ? (bx % 8) * (C.G / 8) + bx / 8 : bx; } \
        float* XCTX = (float*)(C.ws + WS_XCTX); unsigned char* ldsg = (unsigned char*)lds; unsigned char* wsp = C.ws; (void)XCTX; (void)ldsg; (void)wsp; \
        const float* xl = layer == 0 ? C.in[I_X] : C.out; const float* xc = layer == 0 ? C.in[I_CTX] : XCTX; (void)xl; (void)xc; \
        const float* ADA = (const float*)(C.ws + WS_ADA) + (size_t)layer * 2 * 3072; (void)ADA; \
        __VA_ARGS__; if (pc + 1 < hi) xcd_barrier(bar); STAMP(pc + 1); } ++pc; } while (0)
#ifndef PH_MASK
#define PH_MASK 0xFFFF
#endif
#define EN(b) if ((PH_MASK >> (b)) & 1)

    { const int layer = 0; PHASE(EN(0) ph_prologue(C, ldsg)); }
    for (int layer = 0; layer < 4; ++layer) {
        const int i = layer >> 1;
        const bool ctx_out = layer < 3;
        PHASE(EN(1) ph_norm(C, layer, xl, xc, true));
        if ((layer & 1) == 0) {
            PHASE(EN(2) { pg8::Gemm g{(const pg8::bf16_t*)(wsp + WS_XN), (const pg8::bf16_t*)(wsp + WS_XN) + DM / 2, DM, (const pg8::bf16_t*)(wsp + WS_WAIN) + (size_t)i * AIN * DM, NTOK, AIN, DM};
                    pg8::StaticOrder S; S.init(NTOK, AIN, C.G, (int)blockIdx.x); pg8::EpiIn<0> E{wsp};
                    pg8::gemm_phase<pg8::EpiIn<0>, pg8::StaticOrder, true, true>((LAS unsigned char*)lds, g, S, E); });
            PHASE(EN(3) ph_qkprep(C, i));
            PHASE(EN(4) ph_attention(C, i, ldsg));
            PHASE(EN(5) { pg8::Gemm g{(const pg8::bf16_t*)(wsp + WS_XN), (const pg8::bf16_t*)(wsp + WS_XN) + DM / 2, DM, (const pg8::bf16_t*)(wsp + WS_WAOUT) + (size_t)i * DM * DM, NLAT, DM, DM};
                    pg8::StaticOrder S; S.init(NLAT, DM, C.G, (int)blockIdx.x); pg8::EpiRes E{xl, xc, C.out, XCTX, ADA + 2048, ADA + 3072 + 2048};
                    pg8::gemm_phase<pg8::EpiRes, pg8::StaticOrder, true, true>((LAS unsigned char*)lds, g, S, E);
                    ctx_outproj(C, (const bf16_t*)(wsp + WS_XN) + (size_t)NLAT * DM, (const bf16_t*)(wsp + WS_XN) + (size_t)NLAT * DM + 512, DM, (const bf16_t*)(wsp + WS_WAOUT) + (size_t)i * DM * DM, ADA + 3072 + 2048, xc, XCTX); });
        } else {
            PHASE(EN(6) { pg8::Gemm g{(const pg8::bf16_t*)(wsp + WS_XN), (const pg8::bf16_t*)(wsp + WS_XN) + DM / 2, DM, (const pg8::bf16_t*)(wsp + WS_WRIN) + (size_t)i * RINP * DM, NTOK, RINP, DM};
                    pg8::StaticOrder S; S.init(NTOK, RINP, C.G, (int)blockIdx.x); pg8::EpiIn<1> E{wsp};
                    pg8::gemm_phase<pg8::EpiIn<1>, pg8::StaticOrder, true, true>((LAS unsigned char*)lds, g, S, E); });
            PHASE(EN(7) ph_hyprep(C, i, ctx_out, ldsg));
            PHASE(EN(8) ph_scan_hyena(C, i, ctx_out, ldsg));
            PHASE(EN(9) ph_readout_hyout(C, i, ctx_out, ldsg));
            const int Mo = NLAT;
            PHASE(EN(10) { pg8::Gemm g{(const pg8::bf16_t*)(wsp + WS_YF), (const pg8::bf16_t*)(wsp + WS_HYOUT), 512, (const pg8::bf16_t*)(wsp + WS_WROUT) + (size_t)i * DM * DM, Mo, DM, DM};
                    pg8::StaticOrder S; S.init(Mo, DM, C.G, (int)blockIdx.x); pg8::EpiRes E{xl, xc, C.out, XCTX, ADA + 2048, ADA + 3072 + 2048};
                    pg8::gemm_phase<pg8::EpiRes, pg8::StaticOrder, true, true>((LAS unsigned char*)lds, g, S, E);
                    if (ctx_out) ctx_outproj(C, (const bf16_t*)(wsp + WS_YF) + (size_t)NLAT * 512, (const bf16_t*)(wsp + WS_HYOUT) + (size_t)NLAT * 512, 512, (const bf16_t*)(wsp + WS_WROUT) + (size_t)i * DM * DM, ADA + 3072 + 2048, xc, XCTX); });
        }
    }
    { const int layer = 3; PHASE(EN(11) ph_final_t(C)); }
#undef PHASE
}
constexpr int N_PHASES = 1 + 2 * 5 + 2 * 6 + 1;

#ifndef MK_SPLIT
#define MK_SPLIT 0
#endif
extern "C" void kernel_launch(void* const* d_in, const int* in_sizes, int n_in, void* d_out, int out_size, void* d_ws, size_t ws_size, hipStream_t stream) {
    static int grid = 0;
    if (grid == 0) {
        if (n_in != N_IN || out_size != NLAT * DM || ws_size < WS_END) { fprintf(stderr, "kernel_launch: unexpected shapes (n_in %d out %d ws %zu)\n", n_in, out_size, ws_size); grid = -1; return; }
        int dev = 0, cus = 0, per_cu = 0;
        if (hipGetDevice(&dev) != hipSuccess || hipDeviceGetAttribute(&cus, hipDeviceAttributeMultiprocessorCount, dev) != hipSuccess) { grid = -1; return; }
        if (hipFuncSetAttribute((const void*)mk_fwd, hipFuncAttributeMaxDynamicSharedMemorySize, LDS_BYTES) != hipSuccess) { fprintf(stderr, "kernel_launch: hipFuncSetAttribute failed\n"); grid = -1; return; }
        if (hipOccupancyMaxActiveBlocksPerMultiprocessor(&per_cu, (const void*)mk_fwd, NTHREADS, LDS_BYTES) != hipSuccess || per_cu < 1) fprintf(stderr, "kernel_launch: occupancy query says %d\n", per_cu);
        (void)hipGetLastError();
        grid = cus;
    }
    if (grid < 0) return;
    (void)hipMemsetAsync((char*)d_ws + WS_CTL, 0, CTL_ZERO_BYTES, stream);
    Args a{};
    for (int k = 0; k < N_IN; ++k) a.in[k] = (const float*)d_in[k];
    a.out = (float*)d_out; a.ws = (unsigned char*)d_ws;
#if MK_SPLIT
    for (int p = 0; p < N_PHASES; ++p) { a.ph_lo = p; a.ph_hi = p + 1; hipLaunchKernelGGL(mk_fwd, dim3(grid), dim3(NTHREADS), LDS_BYTES, stream, a); }
#else
    a.ph_lo = 0; a.ph_hi = N_PHASES;
    hipLaunchKernelGGL(mk_fwd, dim3(grid), dim3(NTHREADS), LDS_BYTES, stream, a);
#endif
}
```

```cpp
#ifndef EMU
#include <hip/hip_runtime.h>
#endif
#include <cstdio>
#include <cstdint>
#include <cmath>

constexpr int DM = 1024, NLAT = 16384, NCTX = 256, NTOK = NLAT + NCTX;
constexpr int GRIDW = 64, GRIDH = 256;
constexpr int AIN = 3328;
constexpr int RIN = 4224, RINP = 4352;
constexpr int URW_W = 2176;
constexpr int UHY_W = 1536;
constexpr int NWAVES = 8, NTHREADS = 512;
constexpr float C2 = 0.125f * 1.4426950408889634f;
constexpr float LOG2E = 1.4426950408889634f;
constexpr float NORM_EPS = 1e-6f;

typedef unsigned short bf16_t;

constexpr size_t MiB = 1u << 20;
constexpr size_t WS_CTL = 0, CTL_ZERO_BYTES = 256 * 1024;
constexpr size_t WS_ADA = 1 * MiB;
constexpr size_t WS_TW = WS_ADA + 128 * 1024;
constexpr size_t WS_HID256 = WS_TW + 160 * 1024;
constexpr size_t WS_BONUS = WS_HID256 + 64 * 1024;
constexpr size_t WS_XCTX = 3 * MiB;
constexpr size_t WS_VXC = 4 * MiB;
constexpr size_t WS_HID = 6 * MiB;
constexpr size_t WS_WAIN = 14 * MiB;
constexpr size_t WS_WAOUT = 27 * MiB;
constexpr size_t WS_WRIN = 31 * MiB;
constexpr size_t WS_WROUT = 48 * MiB;
constexpr size_t WS_XN = 52 * MiB;
constexpr size_t WS_U = 85 * MiB;
constexpr size_t WS_UHY = 155 * MiB;
constexpr size_t WS_GHY = 204 * MiB;
constexpr size_t WS_VX0 = 52 * MiB, WS_VX1 = 68 * MiB;
constexpr size_t WS_VX2 = 221 * MiB;
constexpr size_t WS_YHY = 155 * MiB;
constexpr size_t WS_YB = 171 * MiB;
constexpr size_t WS_YF = 187 * MiB + 512 * 1024;
constexpr size_t WS_HYOUT = 238 * MiB;
constexpr size_t WS_END = 256 * MiB;
static_assert(WS_U + (size_t)NTOK * AIN * 2 <= WS_END, "U attn");
static_assert(WS_U + (size_t)NTOK * URW_W * 2 <= WS_UHY && WS_UHY + (size_t)NTOK * UHY_W * 2 <= WS_GHY && WS_GHY + (size_t)NTOK * 512 * 2 <= WS_VX2, "rec map 1");
static_assert(WS_VX2 + (size_t)512 * 16384 * 2 <= WS_HYOUT && WS_HYOUT + (size_t)NTOK * 512 * 2 <= WS_END, "rec map 2");
static_assert(WS_YHY + (size_t)512 * 16384 * 2 <= WS_YB && WS_YB + (size_t)NTOK * 512 * 2 <= WS_YF && WS_YF + (size_t)NTOK * 512 * 2 <= WS_GHY, "rec map 3");
static_assert(WS_XN + (size_t)NTOK * DM * 2 <= WS_U && WS_VX1 + (size_t)512 * 16384 * 2 <= WS_U, "xn map");

constexpr int LDS_BYTES = 160 * 1024;
constexpr int MISC_OFF = LDS_BYTES - 256;
constexpr int RING_BYTES = MISC_OFF;

#ifdef EMU
#define DEVFN inline
#else
#define DEVFN __device__ __forceinline__
#endif

DEVFN float bf2f(bf16_t h) { union { unsigned u; float f; } x; x.u = ((unsigned)h) << 16; return x.f; }
#ifdef EMU
DEVFN unsigned f2bf(float f) { union { unsigned u; float f; } x; x.f = f; unsigned u = x.u; return (u + 0x7fffu + ((u >> 16) & 1u)) >> 16; }
DEVFN unsigned pk2(float lo, float hi) { return f2bf(lo) | (f2bf(hi) << 16); }
#else
typedef float f32x2_hw __attribute__((ext_vector_type(2))); typedef __bf16 bf16x2_hw __attribute__((ext_vector_type(2)));
DEVFN unsigned pk2(float lo, float hi) { f32x2_hw v = {lo, hi}; bf16x2_hw b = __builtin_convertvector(v, bf16x2_hw); return __builtin_bit_cast(unsigned, b); }
DEVFN unsigned f2bf(float f) { return pk2(f, 0.f) & 0xffffu; }
#endif
DEVFN float bflo(unsigned w) { union { unsigned u; float f; } x; x.u = w << 16; return x.f; }
DEVFN float bfhi(unsigned w) { union { unsigned u; float f; } x; x.u = w & 0xffff0000u; return x.f; }
struct U4 { unsigned x, y, z, w; };
struct U2 { unsigned x, y; };
struct F2 { float x, y; };
struct F4 { float x, y, z, w; };
DEVFN float silu_f(float v) { return v / (1.0f + expf(-v)); }
DEVFN float sigmoid_f(float v) { return 1.0f / (1.0f + expf(-v)); }
#define SCAN_CHUNK_ASM \
    "ds_read_b128 v[96:99], %[ab] offset:24576\n\t" \
    "ds_read_b128 v[100:103], %[ab] offset:0\n\t" \
    "ds_read_b128 v[104:107], %[ab] offset:16384\n\t" \
    "ds_read_b128 v[108:111], %[ab] offset:8192\n\t" \
    "ds_read_b128 v[112:115], %[ab] offset:32768\n\t" \
    "ds_read_b32 v116, %[av] offset:0\n\t" \
    "s_waitcnt lgkmcnt(0)\n\t" \
    "ds_read_b128 v[118:121], %[ab] offset:24832\n\t" \
    "ds_read_b128 v[122:125], %[ab] offset:256\n\t" \
    "ds_read_b128 v[126:129], %[ab] offset:16640\n\t" \
    "ds_read_b128 v[130:133], %[ab] offset:8448\n\t" \
    "ds_read_b128 v[134:137], %[ab] offset:33024\n\t" \
    "ds_read_b32 v138, %[av] offset:64\n\t" \
    "v_pk_mul_f32 v[140:141], %[s01], v[96:97]\n\t" \
    "v_pk_fma_f32 v[140:141], %[s23], v[98:99], v[140:141]\n\t" \
    "v_add_f32 v146, v140, v141\n\t" \
    "v_pk_mul_f32 v[142:143], %[s01], v[100:101]\n\t" \
    "v_pk_mul_f32 v[144:145], %[s23], v[102:103]\n\t" \
    "v_add_f32_dpp v146, v146, v146 quad_perm:[1,0,3,2] row_mask:0xf bank_mask:0xf bound_ctrl:1\n\t" \
    "v_add_f32_dpp %[yp], %[yp], %[yp] quad_perm:[1,0,3,2] row_mask:0xf bank_mask:0xf bound_ctrl:1\n\t" \
    "v_pk_fma_f32 v[142:143], v[116:117], v[108:109], v[142:143] op_sel_hi:[0,1,1]\n\t" \
    "v_add_f32_dpp v146, v146, v146 quad_perm:[2,3,0,1] row_mask:0xf bank_mask:0xf bound_ctrl:1\n\t" \
    "v_add_f32_dpp %[yp], %[yp], %[yp] quad_perm:[2,3,0,1] row_mask:0xf bank_mask:0xf bound_ctrl:1\n\t" \
    "v_pk_fma_f32 v[144:145], v[116:117], v[110:111], v[144:145] op_sel_hi:[0,1,1]\n\t" \
    "v_add_f32_dpp v146, v146, v146 row_half_mirror row_mask:0xf bank_mask:0xf bound_ctrl:1\n\t" \
    "v_add_f32_dpp %[yp], %[yp], %[yp] row_half_mirror row_mask:0xf bank_mask:0xf bound_ctrl:1\n\t" \
    "v_cmp_eq_u32_e32 vcc, 15, %[sp]\n\t" \
    "v_add_f32_dpp v146, v146, v146 row_mirror row_mask:0xf bank_mask:0xf bound_ctrl:1\n\t" \
    "v_add_f32_dpp %[yp], %[yp], %[yp] row_mirror row_mask:0xf bank_mask:0xf bound_ctrl:1\n\t" \
    "v_cndmask_b32_e32 %[yk0], %[yk0], %[yp], vcc\n\t" \
    "v_pk_fma_f32 %[s01], v[146:147], v[104:105], v[142:143] op_sel_hi:[0,1,1] neg_lo:[1,0,0] neg_hi:[1,0,0]\n\t" \
    "v_pk_fma_f32 %[s23], v[146:147], v[106:107], v[144:145] op_sel_hi:[0,1,1] neg_lo:[1,0,0] neg_hi:[1,0,0]\n\t" \
    "v_pk_mul_f32 v[140:141], %[s01], v[112:113]\n\t" \
    "v_pk_fma_f32 v[140:141], %[s23], v[114:115], v[140:141]\n\t" \
    "v_add_f32 %[yp], v140, v141\n\t" \
    "s_waitcnt lgkmcnt(0)\n\t" \
    "ds_read_b128 v[96:99], %[ab] offset:25088\n\t" \
    "ds_read_b128 v[100:103], %[ab] offset:512\n\t" \
    "ds_read_b128 v[104:107], %[ab] offset:16896\n\t" \
    "ds_read_b128 v[108:111], %[ab] offset:8704\n\t" \
    "ds_read_b128 v[112:115], %[ab] offset:33280\n\t" \
    "ds_read_b32 v116, %[av] offset:128\n\t" \
    "v_pk_mul_f32 v[140:141], %[s01], v[118:119]\n\t" \
    "v_pk_fma_f32 v[140:141], %[s23], v[120:121], v[140:141]\n\t" \
    "v_add_f32 v146, v140, v141\n\t" \
    "v_pk_mul_f32 v[142:143], %[s01], v[122:123]\n\t" \
    "v_pk_mul_f32 v[144:145], %[s23], v[124:125]\n\t" \
    "v_add_f32_dpp v146, v146, v146 quad_perm:[1,0,3,2] row_mask:0xf bank_mask:0xf bound_ctrl:1\n\t" \
    "v_add_f32_dpp %[yp], %[yp], %[yp] quad_perm:[1,0,3,2] row_mask:0xf bank_mask:0xf bound_ctrl:1\n\t" \
    "v_pk_fma_f32 v[142:143], v[138:139], v[130:131], v[142:143] op_sel_hi:[0,1,1]\n\t" \
    "v_add_f32_dpp v146, v146, v146 quad_perm:[2,3,0,1] row_mask:0xf bank_mask:0xf bound_ctrl:1\n\t" \
    "v_add_f32_dpp %[yp], %[yp], %[yp] quad_perm:[2,3,0,1] row_mask:0xf bank_mask:0xf bound_ctrl:1\n\t" \
    "v_pk_fma_f32 v[144:145], v[138:139], v[132:133], v[144:145] op_sel_hi:[0,1,1]\n\t" \
    "v_add_f32_dpp v146, v146, v146 row_half_mirror row_mask:0xf bank_mask:0xf bound_ctrl:1\n\t" \
    "v_add_f32_dpp %[yp], %[yp], %[yp] row_half_mirror row_mask:0xf bank_mask:0xf bound_ctrl:1\n\t" \
    "v_cmp_eq_u32_e32 vcc, 0, %[sp]\n\t" \
    "v_add_f32_dpp v146, v146, v146 row_mirror row_mask:0xf bank_mask:0xf bound_ctrl:1\n\t" \
    "v_add_f32_dpp %[yp], %[yp], %[yp] row_mirror row_mask:0xf bank_mask:0xf bound_ctrl:1\n\t" \
    "v_cndmask_b32_e32 %[yk0], %[yk0], %[yp], vcc\n\t" \
    "v_pk_fma_f32 %[s01], v[146:147], v[126:127], v[142:143] op_sel_hi:[0,1,1] neg_lo:[1,0,0] neg_hi:[1,0,0]\n\t" \
    "v_pk_fma_f32 %[s23], v[146:147], v[128:129], v[144:145] op_sel_hi:[0,1,1] neg_lo:[1,0,0] neg_hi:[1,0,0]\n\t" \
    "v_pk_mul_f32 v[140:141], %[s01], v[134:135]\n\t" \
    "v_pk_fma_f32 v[140:141], %[s23], v[136:137], v[140:141]\n\t" \
    "v_add_f32 %[yp], v140, v141\n\t" \
    "s_waitcnt lgkmcnt(0)\n\t" \
    "ds_read_b128 v[118:121], %[ab] offset:25344\n\t" \
    "ds_read_b128 v[122:125], %[ab] offset:768\n\t" \
    "ds_read_b128 v[126:129], %[ab] offset:17152\n\t" \
    "ds_read_b128 v[130:133], %[ab] offset:8960\n\t" \
    "ds_read_b128 v[134:137], %[ab] offset:33536\n\t" \
    "ds_read_b32 v138, %[av] offset:192\n\t" \
    "v_pk_mul_f32 v[140:141], %[s01], v[96:97]\n\t" \
    "v_pk_fma_f32 v[140:141], %[s23], v[98:99], v[140:141]\n\t" \
    "v_add_f32 v146, v140, v141\n\t" \
    "v_pk_mul_f32 v[142:143], %[s01], v[100:101]\n\t" \
    "v_pk_mul_f32 v[144:145], %[s23], v[102:103]\n\t" \
    "v_add_f32_dpp v146, v146, v146 quad_perm:[1,0,3,2] row_mask:0xf bank_mask:0xf bound_ctrl:1\n\t" \
    "v_add_f32_dpp %[yp], %[yp], %[yp] quad_perm:[1,0,3,2] row_mask:0xf bank_mask:0xf bound_ctrl:1\n\t" \
    "v_pk_fma_f32 v[142:143], v[116:117], v[108:109], v[142:143] op_sel_hi:[0,1,1]\n\t" \
    "v_add_f32_dpp v146, v146, v146 quad_perm:[2,3,0,1] row_mask:0xf bank_mask:0xf bound_ctrl:1\n\t" \
    "v_add_f32_dpp %[yp], %[yp], %[yp] quad_perm:[2,3,0,1] row_mask:0xf bank_mask:0xf bound_ctrl:1\n\t" \
    "v_pk_fma_f32 v[144:145], v[116:117], v[110:111], v[144:145] op_sel_hi:[0,1,1]\n\t" \
    "v_add_f32_dpp v146, v146, v146 row_half_mirror row_mask:0xf bank_mask:0xf bound_ctrl:1\n\t" \
    "v_add_f32_dpp %[yp], %[yp], %[yp] row_half_mirror row_mask:0xf bank_mask:0xf bound_ctrl:1\n\t" \
    "v_cmp_eq_u32_e32 vcc, 1, %[sp]\n\t" \
    "v_add_f32_dpp v146, v146, v146 row_mirror row_mask:0xf bank_mask:0xf bound_ctrl:1\n\t" \
    "v_add_f32_dpp %[yp], %[yp], %[yp] row_mirror row_mask:0xf bank_mask:0xf bound_ctrl:1\n\t" \
    "v_cndmask_b32_e32 %[yk0], %[yk0], %[yp], vcc\n\t" \
    "v_pk_fma_f32 %[s01], v[146:147], v[104:105], v[142:143] op_sel_hi:[0,1,1] neg_lo:[1,0,0] neg_hi:[1,0,0]\n\t" \
    "v_pk_fma_f32 %[s23], v[146:147], v[106:107], v[144:145] op_sel_hi:[0,1,1] neg_lo:[1,0,0] neg_hi:[1,0,0]\n\t" \
    "v_pk_mul_f32 v[140:141], %[s01], v[112:113]\n\t" \
    "v_pk_fma_f32 v[140:141], %[s23], v[114:115], v[140:141]\n\t" \
    "v_add_f32 %[yp], v140, v141\n\t" \
    "s_waitcnt lgkmcnt(0)\n\t" \
    "ds_read_b128 v[96:99], %[ab] offset:25600\n\t" \
    "ds_read_b128 v[100:103], %[ab] offset:1024\n\t" \
    "ds_read_b128 v[104:107], %[ab] offset:17408\n\t" \
    "ds_read_b128 v[108:111], %[ab] offset:9216\n\t" \
    "ds_read_b128 v[112:115], %[ab] offset:33792\n\t" \
    "ds_read_b32 v116, %[av] offset:256\n\t" \
    "v_pk_mul_f32 v[140:141], %[s01], v[118:119]\n\t" \
    "v_pk_fma_f32 v[140:141], %[s23], v[120:121], v[140:141]\n\t" \
    "v_add_f32 v146, v140, v141\n\t" \
    "v_pk_mul_f32 v[142:143], %[s01], v[122:123]\n\t" \
    "v_pk_mul_f32 v[144:145], %[s23], v[124:125]\n\t" \
    "v_add_f32_dpp v146, v146, v146 quad_perm:[1,0,3,2] row_mask:0xf bank_mask:0xf bound_ctrl:1\n\t" \
    "v_add_f32_dpp %[yp], %[yp], %[yp] quad_perm:[1,0,3,2] row_mask:0xf bank_mask:0xf bound_ctrl:1\n\t" \
    "v_pk_fma_f32 v[142:143], v[138:139], v[130:131], v[142:143] op_sel_hi:[0,1,1]\n\t" \
    "v_add_f32_dpp v146, v146, v146 quad_perm:[2,3,0,1] row_mask:0xf bank_mask:0xf bound_ctrl:1\n\t" \
    "v_add_f32_dpp %[yp], %[yp], %[yp] quad_perm:[2,3,0,1] row_mask:0xf bank_mask:0xf bound_ctrl:1\n\t" \
    "v_pk_fma_f32 v[144:145], v[138:139], v[132:133], v[144:145] op_sel_hi:[0,1,1]\n\t" \
    "v_add_f32_dpp v146, v146, v146 row_half_mirror row_mask:0xf bank_mask:0xf bound_ctrl:1\n\t" \
    "v_add_f32_dpp %[yp], %[yp], %[yp] row_half_mirror row_mask:0xf bank_mask:0xf bound_ctrl:1\n\t" \
    "v_cmp_eq_u32_e32 vcc, 2, %[sp]\n\t" \
    "v_add_f32_dpp v146, v146, v146 row_mirror row_mask:0xf bank_mask:0xf bound_ctrl:1\n\t" \
    "v_add_f32_dpp %[yp], %[yp], %[yp] row_mirror row_mask:0xf bank_mask:0xf bound_ctrl:1\n\t" \
    "v_cndmask_b32_e32 %[yk0], %[yk0], %[yp], vcc\n\t" \
    "v_pk_fma_f32 %[s01], v[146:147], v[126:127], v[142:143] op_sel_hi:[0,1,1] neg_lo:[1,0,0] neg_hi:[1,0,0]\n\t" \
    "v_pk_fma_f32 %[s23], v[146:147], v[128:129], v[144:145] op_sel_hi:[0,1,1] neg_lo:[1,0,0] neg_hi:[1,0,0]\n\t" \
    "v_pk_mul_f32 v[140:141], %[s01], v[134:135]\n\t" \
    "v_pk_fma_f32 v[140:141], %[s23], v[136:137], v[140:141]\n\t" \
    "v_add_f32 %[yp], v140, v141\n\t" \
    "s_waitcnt lgkmcnt(0)\n\t" \
    "ds_read_b128 v[118:121], %[ab] offset:25856\n\t" \
    "ds_read_b128 v[122:125], %[ab] offset:1280\n\t" \
    "ds_read_b128 v[126:129], %[ab] offset:17664\n\t" \
    "ds_read_b128 v[130:133], %[ab] offset:9472\n\t" \
    "ds_read_b128 v[134:137], %[ab] offset:34048\n\t" \
    "ds_read_b32 v138, %[av] offset:320\n\t" \
    "v_pk_mul_f32 v[140:141], %[s01], v[96:97]\n\t" \
    "v_pk_fma_f32 v[140:141], %[s23], v[98:99], v[140:141]\n\t" \
    "v_add_f32 v146, v140, v141\n\t" \
    "v_pk_mul_f32 v[142:143], %[s01], v[100:101]\n\t" \
    "v_pk_mul_f32 v[144:145], %[s23], v[102:103]\n\t" \
    "v_add_f32_dpp v146, v146, v146 quad_perm:[1,0,3,2] row_mask:0xf bank_mask:0xf bound_ctrl:1\n\t" \
    "v_add_f32_dpp %[yp], %[yp], %[yp] quad_perm:[1,0,3,2] row_mask:0xf bank_mask:0xf bound_ctrl:1\n\t" \
    "v_pk_fma_f32 v[142:143], v[116:117], v[108:109], v[142:143] op_sel_hi:[0,1,1]\n\t" \
    "v_add_f32_dpp v146, v146, v146 quad_perm:[2,3,0,1] row_mask:0xf bank_mask:0xf bound_ctrl:1\n\t" \
    "v_add_f32_dpp %[yp], %[yp], %[yp] quad_perm:[2,3,0,1] row_mask:0xf bank_mask:0xf bound_ctrl:1\n\t" \
    "v_pk_fma_f32 v[144:145], v[116:117], v[110:111], v[144:145] op_sel_hi:[0,1,1]\n\t" \
    "v_add_f32_dpp v146, v146, v146 row_half_mirror row_mask:0xf bank_mask:0xf bound_ctrl:1\n\t" \
    "v_add_f32_dpp %[yp], %[yp], %[yp] row_half_mirror row_mask:0xf bank_mask:0xf bound_ctrl:1\n\t" \
    "v_cmp_eq_u32_e32 vcc, 3, %[sp]\n\t" \
    "v_add_f32_dpp v146, v146, v146 row_mirror row_mask:0xf bank_mask:0xf bound_ctrl:1\n\t" \
    "v_add_f32_dpp %[yp], %[yp], %[yp] row_mirror row_mask:0xf bank_mask:0xf bound_ctrl:1\n\t" \
    "v_cndmask_b32_e32 %[yk0], %[yk0], %[yp], vcc\n\t" \
    "v_pk_fma_f32 %[s01], v[146:147], v[104:105], v[142:143] op_sel_hi:[0,1,1] neg_lo:[1,0,0] neg_hi:[1,0,0]\n\t" \
    "v_pk_fma_f32 %[s23], v[146:147], v[106:107], v[144:145] op_sel_hi:[0,1,1] neg_lo:[1,0,0] neg_hi:[1,0,0]\n\t" \
    "v_pk_mul_f32 v[140:141], %[s01], v[112:113]\n\t" \
    "v_pk_fma_f32 v[140:141], %[s23], v[114:115], v[140:141]\n\t" \
    "v_add_f32 %[yp], v140, v141\n\t" \
    "s_waitcnt lgkmcnt(0)\n\t" \
    "ds_read_b128 v[96:99], %[ab] offset:26112\n\t" \
    "ds_read_b128 v[100:103], %[ab] offset:1536\n\t" \
    "ds_read_b128 v[104:107], %[ab] offset:17920\n\t" \
    "ds_read_b128 v[108:111], %[ab] offset:9728\n\t" \
    "ds_read_b128 v[112:115], %[ab] offset:34304\n\t" \
    "ds_read_b32 v116, %[av] offset:384\n\t" \
    "v_pk_mul_f32 v[140:141], %[s01], v[118:119]\n\t" \
    "v_pk_fma_f32 v[140:141], %[s23], v[120:121], v[140:141]\n\t" \
    "v_add_f32 v146, v140, v141\n\t" \
    "v_pk_mul_f32 v[142:143], %[s01], v[122:123]\n\t" \
    "v_pk_mul_f32 v[144:145], %[s23], v[124:125]\n\t" \
    "v_add_f32_dpp v146, v146, v146 quad_perm:[1,0,3,2] row_mask:0xf bank_mask:0xf bound_ctrl:1\n\t" \
    "v_add_f32_dpp %[yp], %[yp], %[yp] quad_perm:[1,0,3,2] row_mask:0xf bank_mask:0xf bound_ctrl:1\n\t" \
    "v_pk_fma_f32 v[142:143], v[138:139], v[130:131], v[142:143] op_sel_hi:[0,1,1]\n\t" \
    "v_add_f32_dpp v146, v146, v146 quad_perm:[2,3,0,1] row_mask:0xf bank_mask:0xf bound_ctrl:1\n\t" \
    "v_add_f32_dpp %[yp], %[yp], %[yp] quad_perm:[2,3,0,1] row_mask:0xf bank_mask:0xf bound_ctrl:1\n\t" \
    "v_pk_fma_f32 v[144:145], v[138:139], v[132:133], v[144:145] op_sel_hi:[0,1,1]\n\t" \
    "v_add_f32_dpp v146, v146, v146 row_half_mirror row_mask:0xf bank_mask:0xf bound_ctrl:1\n\t" \
    "v_add_f32_dpp %[yp], %[yp], %[yp] row_half_mirror row_mask:0xf bank_mask:0xf bound_ctrl:1\n\t" \
    "v_cmp_eq_u32_e32 vcc, 4, %[sp]\n\t" \
    "v_add_f32_dpp v146, v146, v146 row_mirror row_mask:0xf bank_mask:0xf bound_ctrl:1\n\t" \
    "v_add_f32_dpp %[yp], %[yp], %[yp] row_mirror row_mask:0xf bank_mask:0xf bound_ctrl:1\n\t" \
    "v_cndmask_b32_e32 %[yk0], %[yk0], %[yp], vcc\n\t" \
    "v_pk_fma_f32 %[s01], v[146:147], v[126:127], v[142:143] op_sel_hi:[0,1,1] neg_lo:[1,0,0] neg_hi:[1,0,0]\n\t" \
    "v_pk_fma_f32 %[s23], v[146:147], v[128:129], v[144:145] op_sel_hi:[0,1,1] neg_lo:[1,0,0] neg_hi:[1,0,0]\n\t" \
    "v_pk_mul_f32 v[140:141], %[s01], v[134:135]\n\t" \
    "v_pk_fma_f32 v[140:141], %[s23], v[136:137], v[140:141]\n\t" \
    "v_add_f32 %[yp], v140, v141\n\t" \
    "s_waitcnt lgkmcnt(0)\n\t" \
    "ds_read_b128 v[118:121], %[ab] offset:26368\n\t" \
    "ds_read_b128 v[122:125], %[ab] offset:1792\n\t" \
    "ds_read_b128 v[126:129], %[ab] offset:18176\n\t" \
    "ds_read_b128 v[130:133], %[ab] offset:9984\n\t" \
    "ds_read_b128 v[134:137], %[ab] offset:34560\n\t" \
    "ds_read_b32 v138, %[av] offset:448\n\t" \
    "v_pk_mul_f32 v[140:141], %[s01], v[96:97]\n\t" \
    "v_pk_fma_f32 v[140:141], %[s23], v[98:99], v[140:141]\n\t" \
    "v_add_f32 v146, v140, v141\n\t" \
    "v_pk_mul_f32 v[142:143], %[s01], v[100:101]\n\t" \
    "v_pk_mul_f32 v[144:145], %[s23], v[102:103]\n\t" \
    "v_add_f32_dpp v146, v146, v146 quad_perm:[1,0,3,2] row_mask:0xf bank_mask:0xf bound_ctrl:1\n\t" \
    "v_add_f32_dpp %[yp], %[yp], %[yp] quad_perm:[1,0,3,2] row_mask:0xf bank_mask:0xf bound_ctrl:1\n\t" \
    "v_pk_fma_f32 v[142:143], v[116:117], v[108:109], v[142:143] op_sel_hi:[0,1,1]\n\t" \
    "v_add_f32_dpp v146, v146, v146 quad_perm:[2,3,0,1] row_mask:0xf bank_mask:0xf bound_ctrl:1\n\t" \
    "v_add_f32_dpp %[yp], %[yp], %[yp] quad_perm:[2,3,0,1] row_mask:0xf bank_mask:0xf bound_ctrl:1\n\t" \
    "v_pk_fma_f32 v[144:145], v[116:117], v[110:111], v[144:145] op_sel_hi:[0,1,1]\n\t" \
    "v_add_f32_dpp v146, v146, v146 row_half_mirror row_mask:0xf bank_mask:0xf bound_ctrl:1\n\t" \
    "v_add_f32_dpp %[yp], %[yp], %[yp] row_half_mirror row_mask:0xf bank_mask:0xf bound_ctrl:1\n\t" \
    "v_cmp_eq_u32_e32 vcc, 5, %[sp]\n\t" \
    "v_add_f32_dpp v146, v146, v146 row_mirror row_mask:0xf bank_mask:0xf bound_ctrl:1\n\t" \
    "v_add_f32_dpp %[yp], %[yp], %[yp] row_mirror row_mask:0xf bank_mask:0xf bound_ctrl:1\n\t" \
    "v_cndmask_b32_e32 %[yk0], %[yk0], %[yp], vcc\n\t" \
    "v_pk_fma_f32 %[s01], v[146:147], v[104:105], v[142:143] op_sel_hi:[0,1,1] neg_lo:[1,0,0] neg_hi:[1,0,0]\n\t" \
    "v_pk_fma_f32 %[s23], v[146:147], v[106:107], v[144:145] op_sel_hi:[0,1,1] neg_lo:[1,0,0] neg_hi:[1,0,0]\n\t" \
    "v_pk_mul_f32 v[140:141], %[s01], v[112:113]\n\t" \
    "v_pk_fma_f32 v[140:141], %[s23], v[114:115], v[140:141]\n\t" \
    "v_add_f32 %[yp], v140, v141\n\t" \
    "s_waitcnt lgkmcnt(0)\n\t" \
    "ds_read_b128 v[96:99], %[ab] offset:26624\n\t" \
    "ds_read_b128 v[100:103], %[ab] offset:2048\n\t" \
    "ds_read_b128 v[104:107], %[ab] offset:18432\n\t" \
    "ds_read_b128 v[108:111], %[ab] offset:10240\n\t" \
    "ds_read_b128 v[112:115], %[ab] offset:34816\n\t" \
    "ds_read_b32 v116, %[av] offset:512\n\t" \
    "v_pk_mul_f32 v[140:141], %[s01], v[118:119]\n\t" \
    "v_pk_fma_f32 v[140:141], %[s23], v[120:121], v[140:141]\n\t" \
    "v_add_f32 v146, v140, v141\n\t" \
    "v_pk_mul_f32 v[142:143], %[s01], v[122:123]\n\t" \
    "v_pk_mul_f32 v[144:145], %[s23], v[124:125]\n\t" \
    "v_add_f32_dpp v146, v146, v146 quad_perm:[1,0,3,2] row_mask:0xf bank_mask:0xf bound_ctrl:1\n\t" \
    "v_add_f32_dpp %[yp], %[yp], %[yp] quad_perm:[1,0,3,2] row_mask:0xf bank_mask:0xf bound_ctrl:1\n\t" \
    "v_pk_fma_f32 v[142:143], v[138:139], v[130:131], v[142:143] op_sel_hi:[0,1,1]\n\t" \
    "v_add_f32_dpp v146, v146, v146 quad_perm:[2,3,0,1] row_mask:0xf bank_mask:0xf bound_ctrl:1\n\t" \
    "v_add_f32_dpp %[yp], %[yp], %[yp] quad_perm:[2,3,0,1] row_mask:0xf bank_mask:0xf bound_ctrl:1\n\t" \
    "v_pk_fma_f32 v[144:145], v[138:139], v[132:133], v[144:145] op_sel_hi:[0,1,1]\n\t" \
    "v_add_f32_dpp v146, v146, v146 row_half_mirror row_mask:0xf bank_mask:0xf bound_ctrl:1\n\t" \
    "v_add_f32_dpp %[yp], %[yp], %[yp] row_half_mirror row_mask:0xf bank_mask:0xf bound_ctrl:1\n\t" \
    "v_cmp_eq_u32_e32 vcc, 6, %[sp]\n\t" \
    "v_add_f32_dpp v146, v146, v146 row_mirror row_mask:0xf bank_mask:0xf bound_ctrl:1\n\t" \
    "v_add_f32_dpp %[yp], %[yp], %[yp] row_mirror row_mask:0xf bank_mask:0xf bound_ctrl:1\n\t" \
    "v_cndmask_b32_e32 %[yk0], %[yk0], %[yp], vcc\n\t" \
    "v_pk_fma_f32 %[s01], v[146:147], v[126:127], v[142:143] op_sel_hi:[0,1,1] neg_lo:[1,0,0] neg_hi:[1,0,0]\n\t" \
    "v_pk_fma_f32 %[s23], v[146:147], v[128:129], v[144:145] op_sel_hi:[0,1,1] neg_lo:[1,0,0] neg_hi:[1,0,0]\n\t" \
    "v_pk_mul_f32 v[140:141], %[s01], v[134:135]\n\t" \
    "v_pk_fma_f32 v[140:141], %[s23], v[136:137], v[140:141]\n\t" \
    "v_add_f32 %[yp], v140, v141\n\t" \
    "s_waitcnt lgkmcnt(0)\n\t" \
    "ds_read_b128 v[118:121], %[ab] offset:26880\n\t" \
    "ds_read_b128 v[122:125], %[ab] offset:2304\n\t" \
    "ds_read_b128 v[126:129], %[ab] offset:18688\n\t" \
    "ds_read_b128 v[130:133], %[ab] offset:10496\n\t" \
    "ds_read_b128 v[134:137], %[ab] offset:35072\n\t" \
    "ds_read_b32 v138, %[av] offset:576\n\t" \
    "v_pk_mul_f32 v[140:141], %[s01], v[96:97]\n\t" \
    "v_pk_fma_f32 v[140:141], %[s23], v[98:99], v[140:141]\n\t" \
    "v_add_f32 v146, v140, v141\n\t" \
    "v_pk_mul_f32 v[142:143], %[s01], v[100:101]\n\t" \
    "v_pk_mul_f32 v[144:145], %[s23], v[102:103]\n\t" \
    "v_add_f32_dpp v146, v146, v146 quad_perm:[1,0,3,2] row_mask:0xf bank_mask:0xf bound_ctrl:1\n\t" \
    "v_add_f32_dpp %[yp], %[yp], %[yp] quad_perm:[1,0,3,2] row_mask:0xf bank_mask:0xf bound_ctrl:1\n\t" \
    "v_pk_fma_f32 v[142:143], v[116:117], v[108:109], v[142:143] op_sel_hi:[0,1,1]\n\t" \
    "v_add_f32_dpp v146, v146, v146 quad_perm:[2,3,0,1] row_mask:0xf bank_mask:0xf bound_ctrl:1\n\t" \
    "v_add_f32_dpp %[yp], %[yp], %[yp] quad_perm:[2,3,0,1] row_mask:0xf bank_mask:0xf bound_ctrl:1\n\t" \
    "v_pk_fma_f32 v[144:145], v[116:117], v[110:111], v[144:145] op_sel_hi:[0,1,1]\n\t" \
    "v_add_f32_dpp v146, v146, v146 row_half_mirror row_mask:0xf bank_mask:0xf bound_ctrl:1\n\t" \
    "v_add_f32_dpp %[yp], %[yp], %[yp] row_half_mirror row_mask:0xf bank_mask:0xf bound_ctrl:1\n\t" \
    "v_cmp_eq_u32_e32 vcc, 7, %[sp]\n\t" \
    "v_add_f32_dpp v146, v146, v146 row_mirror row_mask:0xf bank_mask:0xf bound_ctrl:1\n\t" \
    "v_add_f32_dpp %[yp], %[yp], %[yp] row_mirror row_mask:0xf bank_mask:0xf bound_ctrl:1\n\t" \
    "v_cndmask_b32_e32 %[yk0], %[yk0], %[yp], vcc\n\t" \
    "v_pk_fma_f32 %[s01], v[146:147], v[104:105], v[142:143] op_sel_hi:[0,1,1] neg_lo:[1,0,0] neg_hi:[1,0,0]\n\t" \
    "v_pk_fma_f32 %[s23], v[146:147], v[106:107], v[144:145] op_sel_hi:[0,1,1] neg_lo:[1,0,0] neg_hi:[1,0,0]\n\t" \
    "v_pk_mul_f32 v[140:141], %[s01], v[112:113]\n\t" \
    "v_pk_fma_f32 v[140:141], %[s23], v[114:115], v[140:141]\n\t" \
    "v_add_f32 %[yp], v140, v141\n\t" \
    "s_waitcnt lgkmcnt(0)\n\t" \
    "ds_read_b128 v[96:99], %[ab] offset:27136\n\t" \
    "ds_read_b128 v[100:103], %[ab] offset:2560\n\t" \
    "ds_read_b128 v[104:107], %[ab] offset:18944\n\t" \
    "ds_read_b128 v[108:111], %[ab] offset:10752\n\t" \
    "ds_read_b128 v[112:115], %[ab] offset:35328\n\t" \
    "ds_read_b32 v116, %[av] offset:640\n\t" \
    "v_pk_mul_f32 v[140:141], %[s01], v[118:119]\n\t" \
    "v_pk_fma_f32 v[140:141], %[s23], v[120:121], v[140:141]\n\t" \
    "v_add_f32 v146, v140, v141\n\t" \
    "v_pk_mul_f32 v[142:143], %[s01], v[122:123]\n\t" \
    "v_pk_mul_f32 v[144:145], %[s23], v[124:125]\n\t" \
    "v_add_f32_dpp v146, v146, v146 quad_perm:[1,0,3,2] row_mask:0xf bank_mask:0xf bound_ctrl:1\n\t" \
    "v_add_f32_dpp %[yp], %[yp], %[yp] quad_perm:[1,0,3,2] row_mask:0xf bank_mask:0xf bound_ctrl:1\n\t" \
    "v_pk_fma_f32 v[142:143], v[138:139], v[130:131], v[142:143] op_sel_hi:[0,1,1]\n\t" \
    "v_add_f32_dpp v146, v146, v146 quad_perm:[2,3,0,1] row_mask:0xf bank_mask:0xf bound_ctrl:1\n\t" \
    "v_add_f32_dpp %[yp], %[yp], %[yp] quad_perm:[2,3,0,1] row_mask:0xf bank_mask:0xf bound_ctrl:1\n\t" \
    "v_pk_fma_f32 v[144:145], v[138:139], v[132:133], v[144:145] op_sel_hi:[0,1,1]\n\t" \
    "v_add_f32_dpp v146, v146, v146 row_half_mirror row_mask:0xf bank_mask:0xf bound_ctrl:1\n\t" \
    "v_add_f32_dpp %[yp], %[yp], %[yp] row_half_mirror row_mask:0xf bank_mask:0xf bound_ctrl:1\n\t" \
    "v_cmp_eq_u32_e32 vcc, 8, %[sp]\n\t" \
    "v_add_f32_dpp v146, v146, v146 row_mirror row_mask:0xf bank_mask:0xf bound_ctrl:1\n\t" \
    "v_add_f32_dpp %[yp], %[yp], %[yp] row_mirror row_mask:0xf bank_mask:0xf bound_ctrl:1\n\t" \
    "v_cndmask_b32_e32 %[yk0], %[yk0], %[yp], vcc\n\t" \
    "v_pk_fma_f32 %[s01], v[146:147], v[126:127], v[142:143] op_sel_hi:[0,1,1] neg_lo:[1,0,0] neg_hi:[1,0,0]\n\t" \
    "v_pk_fma_f32 %[s23], v[146:147], v[128:129], v[144:145] op_sel_hi:[0,1,1] neg_lo:[1,0,0] neg_hi:[1,0,0]\n\t" \
    "v_pk_mul_f32 v[140:141], %[s01], v[134:135]\n\t" \
    "v_pk_fma_f32 v[140:141], %[s23], v[136:137], v[140:141]\n\t" \
    "v_add_f32 %[yp], v140, v141\n\t" \
    "s_waitcnt lgkmcnt(0)\n\t" \
    "ds_read_b128 v[118:121], %[ab] offset:27392\n\t" \
    "ds_read_b128 v[122:125], %[ab] offset:2816\n\t" \
    "ds_read_b128 v[126:129], %[ab] offset:19200\n\t" \
    "ds_read_b128 v[130:133], %[ab] offset:11008\n\t" \
    "ds_read_b128 v[134:137], %[ab] offset:35584\n\t" \
    "ds_read_b32 v138, %[av] offset:704\n\t" \
    "v_pk_mul_f32 v[140:141], %[s01], v[96:97]\n\t" \
    "v_pk_fma_f32 v[140:141], %[s23], v[98:99], v[140:141]\n\t" \
    "v_add_f32 v146, v140, v141\n\t" \
    "v_pk_mul_f32 v[142:143], %[s01], v[100:101]\n\t" \
    "v_pk_mul_f32 v[144:145], %[s23], v[102:103]\n\t" \
    "v_add_f32_dpp v146, v146, v146 quad_perm:[1,0,3,2] row_mask:0xf bank_mask:0xf bound_ctrl:1\n\t" \
    "v_add_f32_dpp %[yp], %[yp], %[yp] quad_perm:[1,0,3,2] row_mask:0xf bank_mask:0xf bound_ctrl:1\n\t" \
    "v_pk_fma_f32 v[142:143], v[116:117], v[108:109], v[142:143] op_sel_hi:[0,1,1]\n\t" \
    "v_add_f32_dpp v146, v146, v146 quad_perm:[2,3,0,1] row_mask:0xf bank_mask:0xf bound_ctrl:1\n\t" \
    "v_add_f32_dpp %[yp], %[yp], %[yp] quad_perm:[2,3,0,1] row_mask:0xf bank_mask:0xf bound_ctrl:1\n\t" \
    "v_pk_fma_f32 v[144:145], v[116:117], v[110:111], v[144:145] op_sel_hi:[0,1,1]\n\t" \
    "v_add_f32_dpp v146, v146, v146 row_half_mirror row_mask:0xf bank_mask:0xf bound_ctrl:1\n\t" \
    "v_add_f32_dpp %[yp], %[yp], %[yp] row_half_mirror row_mask:0xf bank_mask:0xf bound_ctrl:1\n\t" \
    "v_cmp_eq_u32_e32 vcc, 9, %[sp]\n\t" \
    "v_add_f32_dpp v146, v146, v146 row_mirror row_mask:0xf bank_mask:0xf bound_ctrl:1\n\t" \
    "v_add_f32_dpp %[yp], %[yp], %[yp] row_mirror row_mask:0xf bank_mask:0xf bound_ctrl:1\n\t" \
    "v_cndmask_b32_e32 %[yk0], %[yk0], %[yp], vcc\n\t" \
    "v_pk_fma_f32 %[s01], v[146:147], v[104:105], v[142:143] op_sel_hi:[0,1,1] neg_lo:[1,0,0] neg_hi:[1,0,0]\n\t" \
    "v_pk_fma_f32 %[s23], v[146:147], v[106:107], v[144:145] op_sel_hi:[0,1,1] neg_lo:[1,0,0] neg_hi:[1,0,0]\n\t" \
    "v_pk_mul_f32 v[140:141], %[s01], v[112:113]\n\t" \
    "v_pk_fma_f32 v[140:141], %[s23], v[114:115], v[140:141]\n\t" \
    "v_add_f32 %[yp], v140, v141\n\t" \
    "s_waitcnt lgkmcnt(0)\n\t" \
    "ds_read_b128 v[96:99], %[ab] offset:27648\n\t" \
    "ds_read_b128 v[100:103], %[ab] offset:3072\n\t" \
    "ds_read_b128 v[104:107], %[ab] offset:19456\n\t" \
    "ds_read_b128 v[108:111], %[ab] offset:11264\n\t" \
    "ds_read_b128 v[112:115], %[ab] offset:35840\n\t" \
    "ds_read_b32 v116, %[av] offset:768\n\t" \
    "v_pk_mul_f32 v[140:141], %[s01], v[118:119]\n\t" \
    "v_pk_fma_f32 v[140:141], %[s23], v[120:121], v[140:141]\n\t" \
    "v_add_f32 v146, v140, v141\n\t" \
    "v_pk_mul_f32 v[142:143], %[s01], v[122:123]\n\t" \
    "v_pk_mul_f32 v[144:145], %[s23], v[124:125]\n\t" \
    "v_add_f32_dpp v146, v146, v146 quad_perm:[1,0,3,2] row_mask:0xf bank_mask:0xf bound_ctrl:1\n\t" \
    "v_add_f32_dpp %[yp], %[yp], %[yp] quad_perm:[1,0,3,2] row_mask:0xf bank_mask:0xf bound_ctrl:1\n\t" \
    "v_pk_fma_f32 v[142:143], v[138:139], v[130:131], v[142:143] op_sel_hi:[0,1,1]\n\t" \
    "v_add_f32_dpp v146, v146, v146 quad_perm:[2,3,0,1] row_mask:0xf bank_mask:0xf bound_ctrl:1\n\t" \
    "v_add_f32_dpp %[yp], %[yp], %[yp] quad_perm:[2,3,0,1] row_mask:0xf bank_mask:0xf bound_ctrl:1\n\t" \
    "v_pk_fma_f32 v[144:145], v[138:139], v[132:133], v[144:145] op_sel_hi:[0,1,1]\n\t" \
    "v_add_f32_dpp v146, v146, v146 row_half_mirror row_mask:0xf bank_mask:0xf bound_ctrl:1\n\t" \
    "v_add_f32_dpp %[yp], %[yp], %[yp] row_half_mirror row_mask:0xf bank_mask:0xf bound_ctrl:1\n\t" \
    "v_cmp_eq_u32_e32 vcc, 10, %[sp]\n\t" \
    "v_add_f32_dpp v146, v146, v146 row_mirror row_mask:0xf bank_mask:0xf bound_ctrl:1\n\t" \
    "v_add_f32_dpp %[yp], %[yp], %[yp] row_mirror row_mask:0xf bank_mask:0xf bound_ctrl:1\n\t" \
    "v_cndmask_b32_e32 %[yk0], %[yk0], %[yp], vcc\n\t" \
    "v_pk_fma_f32 %[s01], v[146:147], v[126:127], v[142:143] op_sel_hi:[0,1,1] neg_lo:[1,0,0] neg_hi:[1,0,0]\n\t" \
    "v_pk_fma_f32 %[s23], v[146:147], v[128:129], v[144:145] op_sel_hi:[0,1,1] neg_lo:[1,0,0] neg_hi:[1,0,0]\n\t" \
    "v_pk_mul_f32 v[140:141], %[s01], v[134:135]\n\t" \
    "v_pk_fma_f32 v[140:141], %[s23], v[136:137], v[140:141]\n\t" \
    "v_add_f32 %[yp], v140, v141\n\t" \
    "s_waitcnt lgkmcnt(0)\n\t" \
    "ds_read_b128 v[118:121], %[ab] offset:27904\n\t" \
    "ds_read_b128 v[122:125], %[ab] offset:3328\n\t" \
    "ds_read_b128 v[126:129], %[ab] offset:19712\n\t" \
    "ds_read_b128 v[130:133], %[ab] offset:11520\n\t" \
    "ds_read_b128 v[134:137], %[ab] offset:36096\n\t" \
    "ds_read_b32 v138, %[av] offset:832\n\t" \
    "v_pk_mul_f32 v[140:141], %[s01], v[96:97]\n\t" \
    "v_pk_fma_f32 v[140:141], %[s23], v[98:99], v[140:141]\n\t" \
    "v_add_f32 v146, v140, v141\n\t" \
    "v_pk_mul_f32 v[142:143], %[s01], v[100:101]\n\t" \
    "v_pk_mul_f32 v[144:145], %[s23], v[102:103]\n\t" \
    "v_add_f32_dpp v146, v146, v146 quad_perm:[1,0,3,2] row_mask:0xf bank_mask:0xf bound_ctrl:1\n\t" \
    "v_add_f32_dpp %[yp], %[yp], %[yp] quad_perm:[1,0,3,2] row_mask:0xf bank_mask:0xf bound_ctrl:1\n\t" \
    "v_pk_fma_f32 v[142:143], v[116:117], v[108:109], v[142:143] op_sel_hi:[0,1,1]\n\t" \
    "v_add_f32_dpp v146, v146, v146 quad_perm:[2,3,0,1] row_mask:0xf bank_mask:0xf bound_ctrl:1\n\t" \
    "v_add_f32_dpp %[yp], %[yp], %[yp] quad_perm:[2,3,0,1] row_mask:0xf bank_mask:0xf bound_ctrl:1\n\t" \
    "v_pk_fma_f32 v[144:145], v[116:117], v[110:111], v[144:145] op_sel_hi:[0,1,1]\n\t" \
    "v_add_f32_dpp v146, v146, v146 row_half_mirror row_mask:0xf bank_mask:0xf bound_ctrl:1\n\t" \
    "v_add_f32_dpp %[yp], %[yp], %[yp] row_half_mirror row_mask:0xf bank_mask:0xf bound_ctrl:1\n\t" \
    "v_cmp_eq_u32_e32 vcc, 11, %[sp]\n\t" \
    "v_add_f32_dpp v146, v146, v146 row_mirror row_mask:0xf bank_mask:0xf bound_ctrl:1\n\t" \
    "v_add_f32_dpp %[yp], %[yp], %[yp] row_mirror row_mask:0xf bank_mask:0xf bound_ctrl:1\n\t" \
    "v_cndmask_b32_e32 %[yk0], %[yk0], %[yp], vcc\n\t" \
    "v_pk_fma_f32 %[s01], v[146:147], v[104:105], v[142:143] op_sel_hi:[0,1,1] neg_lo:[1,0,0] neg_hi:[1,0,0]\n\t" \
    "v_pk_fma_f32 %[s23], v[146:147], v[106:107], v[144:145] op_sel_hi:[0,1,1] neg_lo:[1,0,0] neg_hi:[1,0,0]\n\t" \
    "v_pk_mul_f32 v[140:141], %[s01], v[112:113]\n\t" \
    "v_pk_fma_f32 v[140:141], %[s23], v[114:115], v[140:141]\n\t" \
    "v_add_f32 %[yp], v140, v141\n\t" \
    "s_waitcnt lgkmcnt(0)\n\t" \
    "ds_read_b128 v[96:99], %[ab] offset:28160\n\t" \
    "ds_read_b128 v[100:103], %[ab] offset:3584\n\t" \
    "ds_read_b128 v[104:107], %[ab] offset:19968\n\t" \
    "ds_read_b128 v[108:111], %[ab] offset:11776\n\t" \
    "ds_read_b128 v[112:115], %[ab] offset:36352\n\t" \
    "ds_read_b32 v116, %[av] offset:896\n\t" \
    "v_pk_mul_f32 v[140:141], %[s01], v[118:119]\n\t" \
    "v_pk_fma_f32 v[140:141], %[s23], v[120:121], v[140:141]\n\t" \
    "v_add_f32 v146, v140, v141\n\t" \
    "v_pk_mul_f32 v[142:143], %[s01], v[122:123]\n\t" \
    "v_pk_mul_f32 v[144:145], %[s23], v[124:125]\n\t" \
    "v_add_f32_dpp v146, v146, v146 quad_perm:[1,0,3,2] row_mask:0xf bank_mask:0xf bound_ctrl:1\n\t" \
    "v_add_f32_dpp %[yp], %[yp], %[yp] quad_perm:[1,0,3,2] row_mask:0xf bank_mask:0xf bound_ctrl:1\n\t" \
    "v_pk_fma_f32 v[142:143], v[138:139], v[130:131], v[142:143] op_sel_hi:[0,1,1]\n\t" \
    "v_add_f32_dpp v146, v146, v146 quad_perm:[2,3,0,1] row_mask:0xf bank_mask:0xf bound_ctrl:1\n\t" \
    "v_add_f32_dpp %[yp], %[yp], %[yp] quad_perm:[2,3,0,1] row_mask:0xf bank_mask:0xf bound_ctrl:1\n\t" \
    "v_pk_fma_f32 v[144:145], v[138:139], v[132:133], v[144:145] op_sel_hi:[0,1,1]\n\t" \
    "v_add_f32_dpp v146, v146, v146 row_half_mirror row_mask:0xf bank_mask:0xf bound_ctrl:1\n\t" \
    "v_add_f32_dpp %[yp], %[yp], %[yp] row_half_mirror row_mask:0xf bank_mask:0xf bound_ctrl:1\n\t" \
    "v_cmp_eq_u32_e32 vcc, 12, %[sp]\n\t" \
    "v_add_f32_dpp v146, v146, v146 row_mirror row_mask:0xf bank_mask:0xf bound_ctrl:1\n\t" \
    "v_add_f32_dpp %[yp], %[yp], %[yp] row_mirror row_mask:0xf bank_mask:0xf bound_ctrl:1\n\t" \
    "v_cndmask_b32_e32 %[yk0], %[yk0], %[yp], vcc\n\t" \
    "v_pk_fma_f32 %[s01], v[146:147], v[126:127], v[142:143] op_sel_hi:[0,1,1] neg_lo:[1,0,0] neg_hi:[1,0,0]\n\t" \
    "v_pk_fma_f32 %[s23], v[146:147], v[128:129], v[144:145] op_sel_hi:[0,1,1] neg_lo:[1,0,0] neg_hi:[1,0,0]\n\t" \
    "v_pk_mul_f32 v[140:141], %[s01], v[134:135]\n\t" \
    "v_pk_fma_f32 v[140:141], %[s23], v[136:137], v[140:141]\n\t" \
    "v_add_f32 %[yp], v140, v141\n\t" \
    "s_waitcnt lgkmcnt(0)\n\t" \
    "ds_read_b128 v[118:121], %[ab] offset:28416\n\t" \
    "ds_read_b128 v[122:125], %[ab] offset:3840\n\t" \
    "ds_read_b128 v[126:129], %[ab] offset:20224\n\t" \
    "ds_read_b128 v[130:133], %[ab] offset:12032\n\t" \
    "ds_read_b128 v[134:137], %[ab] offset:36608\n\t" \
    "ds_read_b32 v138, %[av] offset:960\n\t" \
    "v_pk_mul_f32 v[140:141], %[s01], v[96:97]\n\t" \
    "v_pk_fma_f32 v[140:141], %[s23], v[98:99], v[140:141]\n\t" \
    "v_add_f32 v146, v140, v141\n\t" \
    "v_pk_mul_f32 v[142:143], %[s01], v[100:101]\n\t" \
    "v_pk_mul_f32 v[144:145], %[s23], v[102:103]\n\t" \
    "v_add_f32_dpp v146, v146, v146 quad_perm:[1,0,3,2] row_mask:0xf bank_mask:0xf bound_ctrl:1\n\t" \
    "v_add_f32_dpp %[yp], %[yp], %[yp] quad_perm:[1,0,3,2] row_mask:0xf bank_mask:0xf bound_ctrl:1\n\t" \
    "v_pk_fma_f32 v[142:143], v[116:117], v[108:109], v[142:143] op_sel_hi:[0,1,1]\n\t" \
    "v_add_f32_dpp v146, v146, v146 quad_perm:[2,3,0,1] row_mask:0xf bank_mask:0xf bound_ctrl:1\n\t" \
    "v_add_f32_dpp %[yp], %[yp], %[yp] quad_perm:[2,3,0,1] row_mask:0xf bank_mask:0xf bound_ctrl:1\n\t" \
    "v_pk_fma_f32 v[144:145], v[116:117], v[110:111], v[144:145] op_sel_hi:[0,1,1]\n\t" \
    "v_add_f32_dpp v146, v146, v146 row_half_mirror row_mask:0xf bank_mask:0xf bound_ctrl:1\n\t" \
    "v_add_f32_dpp %[yp], %[yp], %[yp] row_half_mirror row_mask:0xf bank_mask:0xf bound_ctrl:1\n\t" \
    "v_cmp_eq_u32_e32 vcc, 13, %[sp]\n\t" \
    "v_add_f32_dpp v146, v146, v146 row_mirror row_mask:0xf bank_mask:0xf bound_ctrl:1\n\t" \
    "v_add_f32_dpp %[yp], %[yp], %[yp] row_mirror row_mask:0xf bank_mask:0xf bound_ctrl:1\n\t" \
    "v_cndmask_b32_e32 %[yk0], %[yk0], %[yp], vcc\n\t" \
    "v_pk_fma_f32 %[s01], v[146:147], v[104:105], v[142:143] op_sel_hi:[0,1,1] neg_lo:[1,0,0] neg_hi:[1,0,0]\n\t" \
    "v_pk_fma_f32 %[s23], v[146:147], v[106:107], v[144:145] op_sel_hi:[0,1,1] neg_lo:[1,0,0] neg_hi:[1,0,0]\n\t" \
    "v_pk_mul_f32 v[140:141], %[s01], v[112:113]\n\t" \
    "v_pk_fma_f32 v[140:141], %[s23], v[114:115], v[140:141]\n\t" \
    "v_add_f32 %[yp], v140, v141\n\t" \
    "s_waitcnt lgkmcnt(0)\n\t" \
    "ds_read_b128 v[96:99], %[ab] offset:28672\n\t" \
    "ds_read_b128 v[100:103], %[ab] offset:4096\n\t" \
    "ds_read_b128 v[104:107], %[ab] offset:20480\n\t" \
    "ds_read_b128 v[108:111], %[ab] offset:12288\n\t" \
    "ds_read_b128 v[112:115], %[ab] offset:36864\n\t" \
    "ds_read_b32 v116, %[av] offset:1024\n\t" \
    "v_pk_mul_f32 v[140:141], %[s01], v[118:119]\n\t" \
    "v_pk_fma_f32 v[140:141], %[s23], v[120:121], v[140:141]\n\t" \
    "v_add_f32 v146, v140, v141\n\t" \
    "v_pk_mul_f32 v[142:143], %[s01], v[122:123]\n\t" \
    "v_pk_mul_f32 v[144:145], %[s23], v[124:125]\n\t" \
    "v_add_f32_dpp v146, v146, v146 quad_perm:[1,0,3,2] row_mask:0xf bank_mask:0xf bound_ctrl:1\n\t" \
    "v_add_f32_dpp %[yp], %[yp], %[yp] quad_perm:[1,0,3,2] row_mask:0xf bank_mask:0xf bound_ctrl:1\n\t" \
    "v_pk_fma_f32 v[142:143], v[138:139], v[130:131], v[142:143] op_sel_hi:[0,1,1]\n\t" \
    "v_add_f32_dpp v146, v146, v146 quad_perm:[2,3,0,1] row_mask:0xf bank_mask:0xf bound_ctrl:1\n\t" \
    "v_add_f32_dpp %[yp], %[yp], %[yp] quad_perm:[2,3,0,1] row_mask:0xf bank_mask:0xf bound_ctrl:1\n\t" \
    "v_pk_fma_f32 v[144:145], v[138:139], v[132:133], v[144:145] op_sel_hi:[0,1,1]\n\t" \
    "v_add_f32_dpp v146, v146, v146 row_half_mirror row_mask:0xf bank_mask:0xf bound_ctrl:1\n\t" \
    "v_add_f32_dpp %[yp], %[yp], %[yp] row_half_mirror row_mask:0xf bank_mask:0xf bound_ctrl:1\n\t" \
    "v_cmp_eq_u32_e32 vcc, 14, %[sp]\n\t" \
    "v_add_f32_dpp v146, v146, v146 row_mirror row_mask:0xf bank_mask:0xf bound_ctrl:1\n\t" \
    "v_add_f32_dpp %[yp], %[yp], %[yp] row_mirror row_mask:0xf bank_mask:0xf bound_ctrl:1\n\t" \
    "v_cndmask_b32_e32 %[yk0], %[yk0], %[yp], vcc\n\t" \
    "v_pk_fma_f32 %[s01], v[146:147], v[126:127], v[142:143] op_sel_hi:[0,1,1] neg_lo:[1,0,0] neg_hi:[1,0,0]\n\t" \
    "v_pk_fma_f32 %[s23], v[146:147], v[128:129], v[144:145] op_sel_hi:[0,1,1] neg_lo:[1,0,0] neg_hi:[1,0,0]\n\t" \
    "v_pk_mul_f32 v[140:141], %[s01], v[134:135]\n\t" \
    "v_pk_fma_f32 v[140:141], %[s23], v[136:137], v[140:141]\n\t" \
    "v_add_f32 %[yp], v140, v141\n\t" \
    "s_waitcnt lgkmcnt(0)\n\t" \
    "ds_read_b128 v[118:121], %[ab] offset:28928\n\t" \
    "ds_read_b128 v[122:125], %[ab] offset:4352\n\t" \
    "ds_read_b128 v[126:129], %[ab] offset:20736\n\t" \
    "ds_read_b128 v[130:133], %[ab] offset:12544\n\t" \
    "ds_read_b128 v[134:137], %[ab] offset:37120\n\t" \
    "ds_read_b32 v138, %[av] offset:1088\n\t" \
    "v_pk_mul_f32 v[140:141], %[s01], v[96:97]\n\t" \
    "v_pk_fma_f32 v[140:141], %[s23], v[98:99], v[140:141]\n\t" \
    "v_add_f32 v146, v140, v141\n\t" \
    "v_pk_mul_f32 v[142:143], %[s01], v[100:101]\n\t" \
    "v_pk_mul_f32 v[144:145], %[s23], v[102:103]\n\t" \
    "v_add_f32_dpp v146, v146, v146 quad_perm:[1,0,3,2] row_mask:0xf bank_mask:0xf bound_ctrl:1\n\t" \
    "v_add_f32_dpp %[yp], %[yp], %[yp] quad_perm:[1,0,3,2] row_mask:0xf bank_mask:0xf bound_ctrl:1\n\t" \
    "v_pk_fma_f32 v[142:143], v[116:117], v[108:109], v[142:143] op_sel_hi:[0,1,1]\n\t" \
    "v_add_f32_dpp v146, v146, v146 quad_perm:[2,3,0,1] row_mask:0xf bank_mask:0xf bound_ctrl:1\n\t" \
    "v_add_f32_dpp %[yp], %[yp], %[yp] quad_perm:[2,3,0,1] row_mask:0xf bank_mask:0xf bound_ctrl:1\n\t" \
    "v_pk_fma_f32 v[144:145], v[116:117], v[110:111], v[144:145] op_sel_hi:[0,1,1]\n\t" \
    "v_add_f32_dpp v146, v146, v146 row_half_mirror row_mask:0xf bank_mask:0xf bound_ctrl:1\n\t" \
    "v_add_f32_dpp %[yp], %[yp], %[yp] row_half_mirror row_mask:0xf bank_mask:0xf bound_ctrl:1\n\t" \
    "v_cmp_eq_u32_e32 vcc, 15, %[sp]\n\t" \
    "v_add_f32_dpp v146, v146, v146 row_mirror row_mask:0xf bank_mask:0xf bound_ctrl:1\n\t" \
    "v_add_f32_dpp %[yp], %[yp], %[yp] row_mirror row_mask:0xf bank_mask:0xf bound_ctrl:1\n\t" \
    "v_cndmask_b32_e32 %[yk0], %[yk0], %[yp], vcc\n\t" \
    "v_pk_fma_f32 %[s01], v[146:147], v[104:105], v[142:143] op_sel_hi:[0,1,1] neg_lo:[1,0,0] neg_hi:[1,0,0]\n\t" \
    "v_pk_fma_f32 %[s23], v[146:147], v[106:107], v[144:145] op_sel_hi:[0,1,1] neg_lo:[1,0,0] neg_hi:[1,0,0]\n\t" \
    "v_pk_mul_f32 v[140:141], %[s01], v[112:113]\n\t" \
    "v_pk_fma_f32 v[140:141], %[s23], v[114:115], v[140:141]\n\t" \
    "v_add_f32 %[yp], v140, v141\n\t" \
    "s_waitcnt lgkmcnt(0)\n\t" \
    "ds_read_b128 v[96:99], %[ab] offset:29184\n\t" \
    "ds_read_b128 v[100:103], %[ab] offset:4608\n\t" \
    "ds_read_b128 v[104:107], %[ab] offset:20992\n\t" \
    "ds_read_b128 v[108:111], %[ab] offset:12800\n\t" \
    "ds_read_b128 v[112:115], %[ab] offset:37376\n\t" \
    "ds_read_b32 v116, %[av] offset:1152\n\t" \
    "v_pk_mul_f32 v[140:141], %[s01], v[118:119]\n\t" \
    "v_pk_fma_f32 v[140:141], %[s23], v[120:121], v[140:141]\n\t" \
    "v_add_f32 v146, v140, v141\n\t" \
    "v_pk_mul_f32 v[142:143], %[s01], v[122:123]\n\t" \
    "v_pk_mul_f32 v[144:145], %[s23], v[124:125]\n\t" \
    "v_add_f32_dpp v146, v146, v146 quad_perm:[1,0,3,2] row_mask:0xf bank_mask:0xf bound_ctrl:1\n\t" \
    "v_add_f32_dpp %[yp], %[yp], %[yp] quad_perm:[1,0,3,2] row_mask:0xf bank_mask:0xf bound_ctrl:1\n\t" \
    "v_pk_fma_f32 v[142:143], v[138:139], v[130:131], v[142:143] op_sel_hi:[0,1,1]\n\t" \
    "v_add_f32_dpp v146, v146, v146 quad_perm:[2,3,0,1] row_mask:0xf bank_mask:0xf bound_ctrl:1\n\t" \
    "v_add_f32_dpp %[yp], %[yp], %[yp] quad_perm:[2,3,0,1] row_mask:0xf bank_mask:0xf bound_ctrl:1\n\t" \
    "v_pk_fma_f32 v[144:145], v[138:139], v[132:133], v[144:145] op_sel_hi:[0,1,1]\n\t" \
    "v_add_f32_dpp v146, v146, v146 row_half_mirror row_mask:0xf bank_mask:0xf bound_ctrl:1\n\t" \
    "v_add_f32_dpp %[yp], %[yp], %[yp] row_half_mirror row_mask:0xf bank_mask:0xf bound_ctrl:1\n\t" \
    "v_cmp_eq_u32_e32 vcc, 0, %[sp]\n\t" \
    "v_add_f32_dpp v146, v146, v146 row_mirror row_mask:0xf bank_mask:0xf bound_ctrl:1\n\t" \
    "v_add_f32_dpp %[yp], %[yp], %[yp] row_mirror row_mask:0xf bank_mask:0xf bound_ctrl:1\n\t" \
    "v_cndmask_b32_e32 %[yk1], %[yk1], %[yp], vcc\n\t" \
    "v_pk_fma_f32 %[s01], v[146:147], v[126:127], v[142:143] op_sel_hi:[0,1,1] neg_lo:[1,0,0] neg_hi:[1,0,0]\n\t" \
    "v_pk_fma_f32 %[s23], v[146:147], v[128:129], v[144:145] op_sel_hi:[0,1,1] neg_lo:[1,0,0] neg_hi:[1,0,0]\n\t" \
    "v_pk_mul_f32 v[140:141], %[s01], v[134:135]\n\t" \
    "v_pk_fma_f32 v[140:141], %[s23], v[136:137], v[140:141]\n\t" \
    "v_add_f32 %[yp], v140, v141\n\t" \
    "s_waitcnt lgkmcnt(0)\n\t" \
    "ds_read_b128 v[118:121], %[ab] offset:29440\n\t" \
    "ds_read_b128 v[122:125], %[ab] offset:4864\n\t" \
    "ds_read_b128 v[126:129], %[ab] offset:21248\n\t" \
    "ds_read_b128 v[130:133], %[ab] offset:13056\n\t" \
    "ds_read_b128 v[134:137], %[ab] offset:37632\n\t" \
    "ds_read_b32 v138, %[av] offset:1216\n\t" \
    "v_pk_mul_f32 v[140:141], %[s01], v[96:97]\n\t" \
    "v_pk_fma_f32 v[140:141], %[s23], v[98:99], v[140:141]\n\t" \
    "v_add_f32 v146, v140, v141\n\t" \
    "v_pk_mul_f32 v[142:143], %[s01], v[100:101]\n\t" \
    "v_pk_mul_f32 v[144:145], %[s23], v[102:103]\n\t" \
    "v_add_f32_dpp v146, v146, v146 quad_perm:[1,0,3,2] row_mask:0xf bank_mask:0xf bound_ctrl:1\n\t" \
    "v_add_f32_dpp %[yp], %[yp], %[yp] quad_perm:[1,0,3,2] row_mask:0xf bank_mask:0xf bound_ctrl:1\n\t" \
    "v_pk_fma_f32 v[142:143], v[116:117], v[108:109], v[142:143] op_sel_hi:[0,1,1]\n\t" \
    "v_add_f32_dpp v146, v146, v146 quad_perm:[2,3,0,1] row_mask:0xf bank_mask:0xf bound_ctrl:1\n\t" \
    "v_add_f32_dpp %[yp], %[yp], %[yp] quad_perm:[2,3,0,1] row_mask:0xf bank_mask:0xf bound_ctrl:1\n\t" \
    "v_pk_fma_f32 v[144:145], v[116:117], v[110:111], v[144:145] op_sel_hi:[0,1,1]\n\t" \
    "v_add_f32_dpp v146, v146, v146 row_half_mirror row_mask:0xf bank_mask:0xf bound_ctrl:1\n\t" \
    "v_add_f32_dpp %[yp], %[yp], %[yp] row_half_mirror row_mask:0xf bank_mask:0xf bound_ctrl:1\n\t" \
    "v_cmp_eq_u32_e32 vcc, 1, %[sp]\n\t" \
    "v_add_f32_dpp v146, v146, v146 row_mirror row_mask:0xf bank_mask:0xf bound_ctrl:1\n\t" \
    "v_add_f32_dpp %[yp], %[yp], %[yp] row_mirror row_mask:0xf bank_mask:0xf bound_ctrl:1\n\t" \
    "v_cndmask_b32_e32 %[yk1], %[yk1], %[yp], vcc\n\t" \
    "v_pk_fma_f32 %[s01], v[146:147], v[104:105], v[142:143] op_sel_hi:[0,1,1] neg_lo:[1,0,0] neg_hi:[1,0,0]\n\t" \
    "v_pk_fma_f32 %[s23], v[146:147], v[106:107], v[144:145] op_sel_hi:[0,1,1] neg_lo:[1,0,0] neg_hi:[1,0,0]\n\t" \
    "v_pk_mul_f32 v[140:141], %[s01], v[112:113]\n\t" \
    "v_pk_fma_f32 v[140:141], %[s23], v[114:115], v[140:141]\n\t" \
    "v_add_f32 %[yp], v140, v141\n\t" \
    "s_waitcnt lgkmcnt(0)\n\t" \
    "ds_read_b128 v[96:99], %[ab] offset:29696\n\t" \
    "ds_read_b128 v[100:103], %[ab] offset:5120\n\t" \
    "ds_read_b128 v[104:107], %[ab] offset:21504\n\t" \
    "ds_read_b128 v[108:111], %[ab] offset:13312\n\t" \
    "ds_read_b128 v[112:115], %[ab] offset:37888\n\t" \
    "ds_read_b32 v116, %[av] offset:1280\n\t" \
    "v_pk_mul_f32 v[140:141], %[s01], v[118:119]\n\t" \
    "v_pk_fma_f32 v[140:141], %[s23], v[120:121], v[140:141]\n\t" \
    "v_add_f32 v146, v140, v141\n\t" \
    "v_pk_mul_f32 v[142:143], %[s01], v[122:123]\n\t" \
    "v_pk_mul_f32 v[144:145], %[s23], v[124:125]\n\t" \
    "v_add_f32_dpp v146, v146, v146 quad_perm:[1,0,3,2] row_mask:0xf bank_mask:0xf bound_ctrl:1\n\t" \
    "v_add_f32_dpp %[yp], %[yp], %[yp] quad_perm:[1,0,3,2] row_mask:0xf bank_mask:0xf bound_ctrl:1\n\t" \
    "v_pk_fma_f32 v[142:143], v[138:139], v[130:131], v[142:143] op_sel_hi:[0,1,1]\n\t" \
    "v_add_f32_dpp v146, v146, v146 quad_perm:[2,3,0,1] row_mask:0xf bank_mask:0xf bound_ctrl:1\n\t" \
    "v_add_f32_dpp %[yp], %[yp], %[yp] quad_perm:[2,3,0,1] row_mask:0xf bank_mask:0xf bound_ctrl:1\n\t" \
    "v_pk_fma_f32 v[144:145], v[138:139], v[132:133], v[144:145] op_sel_hi:[0,1,1]\n\t" \
    "v_add_f32_dpp v146, v146, v146 row_half_mirror row_mask:0xf bank_mask:0xf bound_ctrl:1\n\t" \
    "v_add_f32_dpp %[yp], %[yp], %[yp] row_half_mirror row_mask:0xf bank_mask:0xf bound_ctrl:1\n\t" \
    "v_cmp_eq_u32_e32 vcc, 2, %[sp]\n\t" \
    "v_add_f32_dpp v146, v146, v146 row_mirror row_mask:0xf bank_mask:0xf bound_ctrl:1\n\t" \
    "v_add_f32_dpp %[yp], %[yp], %[yp] row_mirror row_mask:0xf bank_mask:0xf bound_ctrl:1\n\t" \
    "v_cndmask_b32_e32 %[yk1], %[yk1], %[yp], vcc\n\t" \
    "v_pk_fma_f32 %[s01], v[146:147], v[126:127], v[142:143] op_sel_hi:[0,1,1] neg_lo:[1,0,0] neg_hi:[1,0,0]\n\t" \
    "v_pk_fma_f32 %[s23], v[146:147], v[128:129], v[144:145] op_sel_hi:[0,1,1] neg_lo:[1,0,0] neg_hi:[1,0,0]\n\t" \
    "v_pk_mul_f32 v[140:141], %[s01], v[134:135]\n\t" \
    "v_pk_fma_f32 v[140:141], %[s23], v[136:137], v[140:141]\n\t" \
    "v_add_f32 %[yp], v140, v141\n\t" \
    "s_waitcnt lgkmcnt(0)\n\t" \
    "ds_read_b128 v[118:121], %[ab] offset:29952\n\t" \
    "ds_read_b128 v[122:125], %[ab] offset:5376\n\t" \
    "ds_read_b128 v[126:129], %[ab] offset:21760\n\t" \
    "ds_read_b128 v[130:133], %[ab] offset:13568\n\t" \
    "ds_read_b128 v[134:137], %[ab] offset:38144\n\t" \
    "ds_read_b32 v138, %[av] offset:1344\n\t" \
    "v_pk_mul_f32 v[140:141], %[s01], v[96:97]\n\t" \
    "v_pk_fma_f32 v[140:141], %[s23], v[98:99], v[140:141]\n\t" \
    "v_add_f32 v146, v140, v141\n\t" \
    "v_pk_mul_f32 v[142:143], %[s01], v[100:101]\n\t" \
    "v_pk_mul_f32 v[144:145], %[s23], v[102:103]\n\t" \
    "v_add_f32_dpp v146, v146, v146 quad_perm:[1,0,3,2] row_mask:0xf bank_mask:0xf bound_ctrl:1\n\t" \
    "v_add_f32_dpp %[yp], %[yp], %[yp] quad_perm:[1,0,3,2] row_mask:0xf bank_mask:0xf bound_ctrl:1\n\t" \
    "v_pk_fma_f32 v[142:143], v[116:117], v[108:109], v[142:143] op_sel_hi:[0,1,1]\n\t" \
    "v_add_f32_dpp v146, v146, v146 quad_perm:[2,3,0,1] row_mask:0xf bank_mask:0xf bound_ctrl:1\n\t" \
    "v_add_f32_dpp %[yp], %[yp], %[yp] quad_perm:[2,3,0,1] row_mask:0xf bank_mask:0xf bound_ctrl:1\n\t" \
    "v_pk_fma_f32 v[144:145], v[116:117], v[110:111], v[144:145] op_sel_hi:[0,1,1]\n\t" \
    "v_add_f32_dpp v146, v146, v146 row_half_mirror row_mask:0xf bank_mask:0xf bound_ctrl:1\n\t" \
    "v_add_f32_dpp %[yp], %[yp], %[yp] row_half_mirror row_mask:0xf bank_mask:0xf bound_ctrl:1\n\t" \
    "v_cmp_eq_u32_e32 vcc, 3, %[sp]\n\t" \
    "v_add_f32_dpp v146, v146, v146 row_mirror row_mask:0xf bank_mask:0xf bound_ctrl:1\n\t" \
    "v_add_f32_dpp %[yp], %[yp], %[yp] row_mirror row_mask:0xf bank_mask:0xf bound_ctrl:1\n\t" \
    "v_cndmask_b32_e32 %[yk1], %[yk1], %[yp], vcc\n\t" \
    "v_pk_fma_f32 %[s01], v[146:147], v[104:105], v[142:143] op_sel_hi:[0,1,1] neg_lo:[1,0,0] neg_hi:[1,0,0]\n\t" \
    "v_pk_fma_f32 %[s23], v[146:147], v[106:107], v[144:145] op_sel_hi:[0,1,1] neg_lo:[1,0,0] neg_hi:[1,0,0]\n\t" \
    "v_pk_mul_f32 v[140:141], %[s01], v[112:113]\n\t" \
    "v_pk_fma_f32 v[140:141], %[s23], v[114:115], v[140:141]\n\t" \
    "v_add_f32 %[yp], v140, v141\n\t" \
    "s_waitcnt lgkmcnt(0)\n\t" \
    "ds_read_b128 v[96:99], %[ab] offset:30208\n\t" \
    "ds_read_b128 v[100:103], %[ab] offset:5632\n\t" \
    "ds_read_b128 v[104:107], %[ab] offset:22016\n\t" \
    "ds_read_b128 v[108:111], %[ab] offset:13824\n\t" \
    "ds_read_b128 v[112:115], %[ab] offset:38400\n\t" \
    "ds_read_b32 v116, %[av] offset:1408\n\t" \
    "v_pk_mul_f32 v[140:141], %[s01], v[118:119]\n\t" \
    "v_pk_fma_f32 v[140:141], %[s23], v[120:121], v[140:141]\n\t" \
    "v_add_f32 v146, v140, v141\n\t" \
    "v_pk_mul_f32 v[142:143], %[s01], v[122:123]\n\t" \
    "v_pk_mul_f32 v[144:145], %[s23], v[124:125]\n\t" \
    "v_add_f32_dpp v146, v146, v146 quad_perm:[1,0,3,2] row_mask:0xf bank_mask:0xf bound_ctrl:1\n\t" \
    "v_add_f32_dpp %[yp], %[yp], %[yp] quad_perm:[1,0,3,2] row_mask:0xf bank_mask:0xf bound_ctrl:1\n\t" \
    "v_pk_fma_f32 v[142:143], v[138:139], v[130:131], v[142:143] op_sel_hi:[0,1,1]\n\t" \
    "v_add_f32_dpp v146, v146, v146 quad_perm:[2,3,0,1] row_mask:0xf bank_mask:0xf bound_ctrl:1\n\t" \
    "v_add_f32_dpp %[yp], %[yp], %[yp] quad_perm:[2,3,0,1] row_mask:0xf bank_mask:0xf bound_ctrl:1\n\t" \
    "v_pk_fma_f32 v[144:145], v[138:139], v[132:133], v[144:145] op_sel_hi:[0,1,1]\n\t" \
    "v_add_f32_dpp v146, v146, v146 row_half_mirror row_mask:0xf bank_mask:0xf bound_ctrl:1\n\t" \
    "v_add_f32_dpp %[yp], %[yp], %[yp] row_half_mirror row_mask:0xf bank_mask:0xf bound_ctrl:1\n\t" \
    "v_cmp_eq_u32_e32 vcc, 4, %[sp]\n\t" \
    "v_add_f32_dpp v146, v146, v146 row_mirror row_mask:0xf bank_mask:0xf bound_ctrl:1\n\t" \
    "v_add_f32_dpp %[yp], %[yp], %[yp] row_mirror row_mask:0xf bank_mask:0xf bound_ctrl:1\n\t" \
    "v_cndmask_b32_e32 %[yk1], %[yk1], %[yp], vcc\n\t" \
    "v_pk_fma_f32 %[s01], v[146:147], v[126:127], v[142:143] op_sel_hi:[0,1,1] neg_lo:[1,0,0] neg_hi:[1,0,0]\n\t" \
    "v_pk_fma_f32 %[s23], v[146:147], v[128:129], v[144:145] op_sel_hi:[0,1,1] neg_lo:[1,0,0] neg_hi:[1,0,0]\n\t" \
    "v_pk_mul_f32 v[140:141], %[s01], v[134:135]\n\t" \
    "v_pk_fma_f32 v[140:141], %[s23], v[136:137], v[140:141]\n\t" \
    "v_add_f32 %[yp], v140, v141\n\t" \
    "s_waitcnt lgkmcnt(0)\n\t" \
    "ds_read_b128 v[118:121], %[ab] offset:30464\n\t" \
    "ds_read_b128 v[122:125], %[ab] offset:5888\n\t" \
    "ds_read_b128 v[126:129], %[ab] offset:22272\n\t" \
    "ds_read_b128 v[130:133], %[ab] offset:14080\n\t" \
    "ds_read_b128 v[134:137], %[ab] offset:38656\n\t" \
    "ds_read_b32 v138, %[av] offset:1472\n\t" \
    "v_pk_mul_f32 v[140:141], %[s01], v[96:97]\n\t" \
    "v_pk_fma_f32 v[140:141], %[s23], v[98:99], v[140:141]\n\t" \
    "v_add_f32 v146, v140, v141\n\t" \
    "v_pk_mul_f32 v[142:143], %[s01], v[100:101]\n\t" \
    "v_pk_mul_f32 v[144:145], %[s23], v[102:103]\n\t" \
    "v_add_f32_dpp v146, v146, v146 quad_perm:[1,0,3,2] row_mask:0xf bank_mask:0xf bound_ctrl:1\n\t" \
    "v_add_f32_dpp %[yp], %[yp], %[yp] quad_perm:[1,0,3,2] row_mask:0xf bank_mask:0xf bound_ctrl:1\n\t" \
    "v_pk_fma_f32 v[142:143], v[116:117], v[108:109], v[142:143] op_sel_hi:[0,1,1]\n\t" \
    "v_add_f32_dpp v146, v146, v146 quad_perm:[2,3,0,1] row_mask:0xf bank_mask:0xf bound_ctrl:1\n\t" \
    "v_add_f32_dpp %[yp], %[yp], %[yp] quad_perm:[2,3,0,1] row_mask:0xf bank_mask:0xf bound_ctrl:1\n\t" \
    "v_pk_fma_f32 v[144:145], v[116:117], v[110:111], v[144:145] op_sel_hi:[0,1,1]\n\t" \
    "v_add_f32_dpp v146, v146, v146 row_half_mirror row_mask:0xf bank_mask:0xf bound_ctrl:1\n\t" \
    "v_add_f32_dpp %[yp], %[yp], %[yp] row_half_mirror row_mask:0xf bank_mask:0xf bound_ctrl:1\n\t" \
    "v_cmp_eq_u32_e32 vcc, 5, %[sp]\n\t" \
    "v_add_f32_dpp v146, v146, v146 row_mirror row_mask:0xf bank_mask:0xf bound_ctrl:1\n\t" \
    "v_add_f32_dpp %[yp], %[yp], %[yp] row_mirror row_mask:0xf bank_mask:0xf bound_ctrl:1\n\t" \
    "v_cndmask_b32_e32 %[yk1], %[yk1], %[yp], vcc\n\t" \
    "v_pk_fma_f32 %[s01], v[146:147], v[104:105], v[142:143] op_sel_hi:[0,1,1] neg_lo:[1,0,0] neg_hi:[1,0,0]\n\t" \
    "v_pk_fma_f32 %[s23], v[146:147], v[106:107], v[144:145] op_sel_hi:[0,1,1] neg_lo:[1,0,0] neg_hi:[1,0,0]\n\t" \
    "v_pk_mul_f32 v[140:141], %[s01], v[112:113]\n\t" \
    "v_pk_fma_f32 v[140:141], %[s23], v[114:115], v[140:141]\n\t" \
    "v_add_f32 %[yp], v140, v141\n\t" \
    "s_waitcnt lgkmcnt(0)\n\t" \
    "ds_read_b128 v[96:99], %[ab] offset:30720\n\t" \
    "ds_read_b128 v[100:103], %[ab] offset:6144\n\t" \
    "ds_read_b128 v[104:107], %[ab] offset:22528\n\t" \
    "ds_read_b128 v[108:111], %[ab] offset:14336\n\t" \
    "ds_read_b128 v[112:115], %[ab] offset:38912\n\t" \
    "ds_read_b32 v116, %[av] offset:1536\n\t" \
    "v_pk_mul_f32 v[140:141], %[s01], v[118:119]\n\t" \
    "v_pk_fma_f32 v[140:141], %[s23], v[120:121], v[140:141]\n\t" \
    "v_add_f32 v146, v140, v141\n\t" \
    "v_pk_mul_f32 v[142:143], %[s01], v[122:123]\n\t" \
    "v_pk_mul_f32 v[144:145], %[s23], v[124:125]\n\t" \
    "v_add_f32_dpp v146, v146, v146 quad_perm:[1,0,3,2] row_mask:0xf bank_mask:0xf bound_ctrl:1\n\t" \
    "v_add_f32_dpp %[yp], %[yp], %[yp] quad_perm:[1,0,3,2] row_mask:0xf bank_mask:0xf bound_ctrl:1\n\t" \
    "v_pk_fma_f32 v[142:143], v[138:139], v[130:131], v[142:143] op_sel_hi:[0,1,1]\n\t" \
    "v_add_f32_dpp v146, v146, v146 quad_perm:[2,3,0,1] row_mask:0xf bank_mask:0xf bound_ctrl:1\n\t" \
    "v_add_f32_dpp %[yp], %[yp], %[yp] quad_perm:[2,3,0,1] row_mask:0xf bank_mask:0xf bound_ctrl:1\n\t" \
    "v_pk_fma_f32 v[144:145], v[138:139], v[132:133], v[144:145] op_sel_hi:[0,1,1]\n\t" \
    "v_add_f32_dpp v146, v146, v146 row_half_mirror row_mask:0xf bank_mask:0xf bound_ctrl:1\n\t" \
    "v_add_f32_dpp %[yp], %[yp], %[yp] row_half_mirror row_mask:0xf bank_mask:0xf bound_ctrl:1\n\t" \
    "v_cmp_eq_u32_e32 vcc, 6, %[sp]\n\t" \
    "v_add_f32_dpp v146, v146, v146 row_mirror row_mask:0xf bank_mask:0xf bound_ctrl:1\n\t" \
    "v_add_f32_dpp %[yp], %[yp], %[yp] row_mirror row_mask:0xf bank_mask:0xf bound_ctrl:1\n\t" \
    "v_cndmask_b32_e32 %[yk1], %[yk1], %[yp], vcc\n\t" \
    "v_pk_fma_f32 %[s01], v[146:147], v[126:127], v[142:143] op_sel_hi:[0,1,1] neg_lo:[1,0,0] neg_hi:[1,0,0]\n\t" \
    "v_pk_fma_f32 %[s23], v[146:147], v[128:129], v[144:145] op_sel_hi:[0,1,1] neg_lo:[1,0,0] neg_hi:[1,0,0]\n\t" \
    "v_pk_mul_f32 v[140:141], %[s01], v[134:135]\n\t" \
    "v_pk_fma_f32 v[140:141], %[s23], v[136:137], v[140:141]\n\t" \
    "v_add_f32 %[yp], v140, v141\n\t" \
    "s_waitcnt lgkmcnt(0)\n\t" \
    "ds_read_b128 v[118:121], %[ab] offset:30976\n\t" \
    "ds_read_b128 v[122:125], %[ab] offset:6400\n\t" \
    "ds_read_b128 v[126:129], %[ab] offset:22784\n\t" \
    "ds_read_b128 v[130:133], %[ab] offset:14592\n\t" \
    "ds_read_b128 v[134:137], %[ab] offset:39168\n\t" \
    "ds_read_b32 v138, %[av] offset:1600\n\t" \
    "v_pk_mul_f32 v[140:141], %[s01], v[96:97]\n\t" \
    "v_pk_fma_f32 v[140:141], %[s23], v[98:99], v[140:141]\n\t" \
    "v_add_f32 v146, v140, v141\n\t" \
    "v_pk_mul_f32 v[142:143], %[s01], v[100:101]\n\t" \
    "v_pk_mul_f32 v[144:145], %[s23], v[102:103]\n\t" \
    "v_add_f32_dpp v146, v146, v146 quad_perm:[1,0,3,2] row_mask:0xf bank_mask:0xf bound_ctrl:1\n\t" \
    "v_add_f32_dpp %[yp], %[yp], %[yp] quad_perm:[1,0,3,2] row_mask:0xf bank_mask:0xf bound_ctrl:1\n\t" \
    "v_pk_fma_f32 v[142:143], v[116:117], v[108:109], v[142:143] op_sel_hi:[0,1,1]\n\t" \
    "v_add_f32_dpp v146, v146, v146 quad_perm:[2,3,0,1] row_mask:0xf bank_mask:0xf bound_ctrl:1\n\t" \
    "v_add_f32_dpp %[yp], %[yp], %[yp] quad_perm:[2,3,0,1] row_mask:0xf bank_mask:0xf bound_ctrl:1\n\t" \
    "v_pk_fma_f32 v[144:145], v[116:117], v[110:111], v[144:145] op_sel_hi:[0,1,1]\n\t" \
    "v_add_f32_dpp v146, v146, v146 row_half_mirror row_mask:0xf bank_mask:0xf bound_ctrl:1\n\t" \
    "v_add_f32_dpp %[yp], %[yp], %[yp] row_half_mirror row_mask:0xf bank_mask:0xf bound_ctrl:1\n\t" \
    "v_cmp_eq_u32_e32 vcc, 7, %[sp]\n\t" \
    "v_add_f32_dpp v146, v146, v146 row_mirror row_mask:0xf bank_mask:0xf bound_ctrl:1\n\t" \
    "v_add_f32_dpp %[yp], %[yp], %[yp] row_mirror row_mask:0xf bank_mask:0xf bound_ctrl:1\n\t" \
    "v_cndmask_b32_e32 %[yk1], %[yk1], %[yp], vcc\n\t" \
    "v_pk_fma_f32 %[s01], v[146:147], v[104:105], v[142:143] op_sel_hi:[0,1,1] neg_lo:[1,0,0] neg_hi:[1,0,0]\n\t" \
    "v_pk_fma_f32 %[s23], v[146:147], v[106:107], v[144:145] op_sel_hi:[0,1,1] neg_lo:[1,0,0] neg_hi:[1,0,0]\n\t" \
    "v_pk_mul_f32 v[140:141], %[s01], v[112:113]\n\t" \
    "v_pk_fma_f32 v[140:141], %[s23], v[114:115], v[140:141]\n\t" \
    "v_add_f32 %[yp], v140, v141\n\t" \
    "s_waitcnt lgkmcnt(0)\n\t" \
    "ds_read_b128 v[96:99], %[ab] offset:31232\n\t" \
    "ds_read_b128 v[100:103], %[ab] offset:6656\n\t" \
    "ds_read_b128 v[104:107], %[ab] offset:23040\n\t" \
    "ds_read_b128 v[108:111], %[ab] offset:14848\n\t" \
    "ds_read_b128 v[112:115], %[ab] offset:39424\n\t" \
    "ds_read_b32 v116, %[av] offset:1664\n\t" \
    "v_pk_mul_f32 v[140:141], %[s01], v[118:119]\n\t" \
    "v_pk_fma_f32 v[140:141], %[s23], v[120:121], v[140:141]\n\t" \
    "v_add_f32 v146, v140, v141\n\t" \
    "v_pk_mul_f32 v[142:143], %[s01], v[122:123]\n\t" \
    "v_pk_mul_f32 v[144:145], %[s23], v[124:125]\n\t" \
    "v_add_f32_dpp v146, v146, v146 quad_perm:[1,0,3,2] row_mask:0xf bank_mask:0xf bound_ctrl:1\n\t" \
    "v_add_f32_dpp %[yp], %[yp], %[yp] quad_perm:[1,0,3,2] row_mask:0xf bank_mask:0xf bound_ctrl:1\n\t" \
    "v_pk_fma_f32 v[142:143], v[138:139], v[130:131], v[142:143] op_sel_hi:[0,1,1]\n\t" \
    "v_add_f32_dpp v146, v146, v146 quad_perm:[2,3,0,1] row_mask:0xf bank_mask:0xf bound_ctrl:1\n\t" \
    "v_add_f32_dpp %[yp], %[yp], %[yp] quad_perm:[2,3,0,1] row_mask:0xf bank_mask:0xf bound_ctrl:1\n\t" \
    "v_pk_fma_f32 v[144:145], v[138:139], v[132:133], v[144:145] op_sel_hi:[0,1,1]\n\t" \
    "v_add_f32_dpp v146, v146, v146 row_half_mirror row_mask:0xf bank_mask:0xf bound_ctrl:1\n\t" \
    "v_add_f32_dpp %[yp], %[yp], %[yp] row_half_mirror row_mask:0xf bank_mask:0xf bound_ctrl:1\n\t" \
    "v_cmp_eq_u32_e32 vcc, 8, %[sp]\n\t" \
    "v_add_f32_dpp v146, v146, v146 row_mirror row_mask:0xf bank_mask:0xf bound_ctrl:1\n\t" \
    "v_add_f32_dpp %[yp], %[yp], %[yp] row_mirror row_mask:0xf bank_mask:0xf bound_ctrl:1\n\t" \
    "v_cndmask_b32_e32 %[yk1], %[yk1], %[yp], vcc\n\t" \
    "v_pk_fma_f32 %[s01], v[146:147], v[126:127], v[142:143] op_sel_hi:[0,1,1] neg_lo:[1,0,0] neg_hi:[1,0,0]\n\t" \
    "v_pk_fma_f32 %[s23], v[146:147], v[128:129], v[144:145] op_sel_hi:[0,1,1] neg_lo:[1,0,0] neg_hi:[1,0,0]\n\t" \
    "v_pk_mul_f32 v[140:141], %[s01], v[134:135]\n\t" \
    "v_pk_fma_f32 v[140:141], %[s23], v[136:137], v[140:141]\n\t" \
    "v_add_f32 %[yp], v140, v141\n\t" \
    "s_waitcnt lgkmcnt(0)\n\t" \
    "ds_read_b128 v[118:121], %[ab] offset:31488\n\t" \
    "ds_read_b128 v[122:125], %[ab] offset:6912\n\t" \
    "ds_read_b128 v[126:129], %[ab] offset:23296\n\t" \
    "ds_read_b128 v[130:133], %[ab] offset:15104\n\t" \
    "ds_read_b128 v[134:137], %[ab] offset:39680\n\t" \
    "ds_read_b32 v138, %[av] offset:1728\n\t" \
    "v_pk_mul_f32 v[140:141], %[s01], v[96:97]\n\t" \
    "v_pk_fma_f32 v[140:141], %[s23], v[98:99], v[140:141]\n\t" \
    "v_add_f32 v146, v140, v141\n\t" \
    "v_pk_mul_f32 v[142:143], %[s01], v[100:101]\n\t" \
    "v_pk_mul_f32 v[144:145], %[s23], v[102:103]\n\t" \
    "v_add_f32_dpp v146, v146, v146 quad_perm:[1,0,3,2] row_mask:0xf bank_mask:0xf bound_ctrl:1\n\t" \
    "v_add_f32_dpp %[yp], %[yp], %[yp] quad_perm:[1,0,3,2] row_mask:0xf bank_mask:0xf bound_ctrl:1\n\t" \
    "v_pk_fma_f32 v[142:143], v[116:117], v[108:109], v[142:143] op_sel_hi:[0,1,1]\n\t" \
    "v_add_f32_dpp v146, v146, v146 quad_perm:[2,3,0,1] row_mask:0xf bank_mask:0xf bound_ctrl:1\n\t" \
    "v_add_f32_dpp %[yp], %[yp], %[yp] quad_perm:[2,3,0,1] row_mask:0xf bank_mask:0xf bound_ctrl:1\n\t" \
    "v_pk_fma_f32 v[144:145], v[116:117], v[110:111], v[144:145] op_sel_hi:[0,1,1]\n\t" \
    "v_add_f32_dpp v146, v146, v146 row_half_mirror row_mask:0xf bank_mask:0xf bound_ctrl:1\n\t" \
    "v_add_f32_dpp %[yp], %[yp], %[yp] row_half_mirror row_mask:0xf bank_mask:0xf bound_ctrl:1\n\t" \
    "v_cmp_eq_u32_e32 vcc, 9, %[sp]\n\t" \
    "v_add_f32_dpp v146, v146, v146 row_mirror row_mask:0xf bank_mask:0xf bound_ctrl:1\n\t" \
    "v_add_f32_dpp %[yp], %[yp], %[yp] row_mirror row_mask:0xf bank_mask:0xf bound_ctrl:1\n\t" \
    "v_cndmask_b32_e32 %[yk1], %[yk1], %[yp], vcc\n\t" \
    "v_pk_fma_f32 %[s01], v[146:147], v[104:105], v[142:143] op_sel_hi:[0,1,1] neg_lo:[1,0,0] neg_hi:[1,0,0]\n\t" \
    "v_pk_fma_f32 %[s23], v[146:147], v[106:107], v[144:145] op_sel_hi:[0,1,1] neg_lo:[1,0,0] neg_hi:[1,0,0]\n\t" \
    "v_pk_mul_f32 v[140:141], %[s01], v[112:113]\n\t" \
    "v_pk_fma_f32 v[140:141], %[s23], v[114:115], v[140:141]\n\t" \
    "v_add_f32 %[yp], v140, v141\n\t" \
    "s_waitcnt lgkmcnt(0)\n\t" \
    "ds_read_b128 v[96:99], %[ab] offset:31744\n\t" \
    "ds_read_b128 v[100:103], %[ab] offset:7168\n\t" \
    "ds_read_b128 v[104:107], %[ab] offset:23552\n\t" \
    "ds_read_b128 v[108:111], %[ab] offset:15360\n\t" \
    "ds_read_b128 v[112:115], %[ab] offset:39936\n\t" \
    "ds_read_b32 v116, %[av] offset:1792\n\t" \
    "v_pk_mul_f32 v[140:141], %[s01], v[118:119]\n\t" \
    "v_pk_fma_f32 v[140:141], %[s23], v[120:121], v[140:141]\n\t" \
    "v_add_f32 v146, v140, v141\n\t" \
    "v_pk_mul_f32 v[142:143], %[s01], v[122:123]\n\t" \
    "v_pk_mul_f32 v[144:145], %[s23], v[124:125]\n\t" \
    "v_add_f32_dpp v146, v146, v146 quad_perm:[1,0,3,2] row_mask:0xf bank_mask:0xf bound_ctrl:1\n\t" \
    "v_add_f32_dpp %[yp], %[yp], %[yp] quad_perm:[1,0,3,2] row_mask:0xf bank_mask:0xf bound_ctrl:1\n\t" \
    "v_pk_fma_f32 v[142:143], v[138:139], v[130:131], v[142:143] op_sel_hi:[0,1,1]\n\t" \
    "v_add_f32_dpp v146, v146, v146 quad_perm:[2,3,0,1] row_mask:0xf bank_mask:0xf bound_ctrl:1\n\t" \
    "v_add_f32_dpp %[yp], %[yp], %[yp] quad_perm:[2,3,0,1] row_mask:0xf bank_mask:0xf bound_ctrl:1\n\t" \
    "v_pk_fma_f32 v[144:145], v[138:139], v[132:133], v[144:145] op_sel_hi:[0,1,1]\n\t" \
    "v_add_f32_dpp v146, v146, v146 row_half_mirror row_mask:0xf bank_mask:0xf bound_ctrl:1\n\t" \
    "v_add_f32_dpp %[yp], %[yp], %[yp] row_half_mirror row_mask:0xf bank_mask:0xf bound_ctrl:1\n\t" \
    "v_cmp_eq_u32_e32 vcc, 10, %[sp]\n\t" \
    "v_add_f32_dpp v146, v146, v146 row_mirror row_mask:0xf bank_mask:0xf bound_ctrl:1\n\t" \
    "v_add_f32_dpp %[yp], %[yp], %[yp] row_mirror row_mask:0xf bank_mask:0xf bound_ctrl:1\n\t" \
    "v_cndmask_b32_e32 %[yk1], %[yk1], %[yp], vcc\n\t" \
    "v_pk_fma_f32 %[s01], v[146:147], v[126:127], v[142:143] op_sel_hi:[0,1,1] neg_lo:[1,0,0] neg_hi:[1,0,0]\n\t" \
    "v_pk_fma_f32 %[s23], v[146:147], v[128:129], v[144:145] op_sel_hi:[0,1,1] neg_lo:[1,0,0] neg_hi:[1,0,0]\n\t" \
    "v_pk_mul_f32 v[140:141], %[s01], v[134:135]\n\t" \
    "v_pk_fma_f32 v[140:141], %[s23], v[136:137], v[140:141]\n\t" \
    "v_add_f32 %[yp], v140, v141\n\t" \
    "s_waitcnt lgkmcnt(0)\n\t" \
    "ds_read_b128 v[118:121], %[ab] offset:32000\n\t" \
    "ds_read_b128 v[122:125], %[ab] offset:7424\n\t" \
    "ds_read_b128 v[126:129], %[ab] offset:23808\n\t" \
    "ds_read_b128 v[130:133], %[ab] offset:15616\n\t" \
    "ds_read_b128 v[134:137], %[ab] offset:40192\n\t" \
    "ds_read_b32 v138, %[av] offset:1856\n\t" \
    "v_pk_mul_f32 v[140:141], %[s01], v[96:97]\n\t" \
    "v_pk_fma_f32 v[140:141], %[s23], v[98:99], v[140:141]\n\t" \
    "v_add_f32 v146, v140, v141\n\t" \
    "v_pk_mul_f32 v[142:143], %[s01], v[100:101]\n\t" \
    "v_pk_mul_f32 v[144:145], %[s23], v[102:103]\n\t" \
    "v_add_f32_dpp v146, v146, v146 quad_perm:[1,0,3,2] row_mask:0xf bank_mask:0xf bound_ctrl:1\n\t" \
    "v_add_f32_dpp %[yp], %[yp], %[yp] quad_perm:[1,0,3,2] row_mask:0xf bank_mask:0xf bound_ctrl:1\n\t" \
    "v_pk_fma_f32 v[142:143], v[116:117], v[108:109], v[142:143] op_sel_hi:[0,1,1]\n\t" \
    "v_add_f32_dpp v146, v146, v146 quad_perm:[2,3,0,1] row_mask:0xf bank_mask:0xf bound_ctrl:1\n\t" \
    "v_add_f32_dpp %[yp], %[yp], %[yp] quad_perm:[2,3,0,1] row_mask:0xf bank_mask:0xf bound_ctrl:1\n\t" \
    "v_pk_fma_f32 v[144:145], v[116:117], v[110:111], v[144:145] op_sel_hi:[0,1,1]\n\t" \
    "v_add_f32_dpp v146, v146, v146 row_half_mirror row_mask:0xf bank_mask:0xf bound_ctrl:1\n\t" \
    "v_add_f32_dpp %[yp], %[yp], %[yp] row_half_mirror row_mask:0xf bank_mask:0xf bound_ctrl:1\n\t" \
    "v_cmp_eq_u32_e32 vcc, 11, %[sp]\n\t" \
    "v_add_f32_dpp v146, v146, v146 row_mirror row_mask:0xf bank_mask:0xf bound_ctrl:1\n\t" \
    "v_add_f32_dpp %[yp], %[yp], %[yp] row_mirror row_mask:0xf bank_mask:0xf bound_ctrl:1\n\t" \
    "v_cndmask_b32_e32 %[yk1], %[yk1], %[yp], vcc\n\t" \
    "v_pk_fma_f32 %[s01], v[146:147], v[104:105], v[142:143] op_sel_hi:[0,1,1] neg_lo:[1,0,0] neg_hi:[1,0,0]\n\t" \
    "v_pk_fma_f32 %[s23], v[146:147], v[106:107], v[144:145] op_sel_hi:[0,1,1] neg_lo:[1,0,0] neg_hi:[1,0,0]\n\t" \
    "v_pk_mul_f32 v[140:141], %[s01], v[112:113]\n\t" \
    "v_pk_fma_f32 v[140:141], %[s23], v[114:115], v[140:141]\n\t" \
    "v_add_f32 %[yp], v140, v141\n\t" \
    "s_waitcnt lgkmcnt(0)\n\t" \
    "ds_read_b128 v[96:99], %[ab] offset:32256\n\t" \
    "ds_read_b128 v[100:103], %[ab] offset:7680\n\t" \
    "ds_read_b128 v[104:107], %[ab] offset:24064\n\t" \
    "ds_read_b128 v[108:111], %[ab] offset:15872\n\t" \
    "ds_read_b128 v[112:115], %[ab] offset:40448\n\t" \
    "ds_read_b32 v116, %[av] offset:1920\n\t" \
    "v_pk_mul_f32 v[140:141], %[s01], v[118:119]\n\t" \
    "v_pk_fma_f32 v[140:141], %[s23], v[120:121], v[140:141]\n\t" \
    "v_add_f32 v146, v140, v141\n\t" \
    "v_pk_mul_f32 v[142:143], %[s01], v[122:123]\n\t" \
    "v_pk_mul_f32 v[144:145], %[s23], v[124:125]\n\t" \
    "v_add_f32_dpp v146, v146, v146 quad_perm:[1,0,3,2] row_mask:0xf bank_mask:0xf bound_ctrl:1\n\t" \
    "v_add_f32_dpp %[yp], %[yp], %[yp] quad_perm:[1,0,3,2] row_mask:0xf bank_mask:0xf bound_ctrl:1\n\t" \
    "v_pk_fma_f32 v[142:143], v[138:139], v[130:131], v[142:143] op_sel_hi:[0,1,1]\n\t" \
    "v_add_f32_dpp v146, v146, v146 quad_perm:[2,3,0,1] row_mask:0xf bank_mask:0xf bound_ctrl:1\n\t" \
    "v_add_f32_dpp %[yp], %[yp], %[yp] quad_perm:[2,3,0,1] row_mask:0xf bank_mask:0xf bound_ctrl:1\n\t" \
    "v_pk_fma_f32 v[144:145], v[138:139], v[132:133], v[144:145] op_sel_hi:[0,1,1]\n\t" \
    "v_add_f32_dpp v146, v146, v146 row_half_mirror row_mask:0xf bank_mask:0xf bound_ctrl:1\n\t" \
    "v_add_f32_dpp %[yp], %[yp], %[yp] row_half_mirror row_mask:0xf bank_mask:0xf bound_ctrl:1\n\t" \
    "v_cmp_eq_u32_e32 vcc, 12, %[sp]\n\t" \
    "v_add_f32_dpp v146, v146, v146 row_mirror row_mask:0xf bank_mask:0xf bound_ctrl:1\n\t" \
    "v_add_f32_dpp %[yp], %[yp], %[yp] row_mirror row_mask:0xf bank_mask:0xf bound_ctrl:1\n\t" \
    "v_cndmask_b32_e32 %[yk1], %[yk1], %[yp], vcc\n\t" \
    "v_pk_fma_f32 %[s01], v[146:147], v[126:127], v[142:143] op_sel_hi:[0,1,1] neg_lo:[1,0,0] neg_hi:[1,0,0]\n\t" \
    "v_pk_fma_f32 %[s23], v[146:147], v[128:129], v[144:145] op_sel_hi:[0,1,1] neg_lo:[1,0,0] neg_hi:[1,0,0]\n\t" \
    "v_pk_mul_f32 v[140:141], %[s01], v[134:135]\n\t" \
    "v_pk_fma_f32 v[140:141], %[s23], v[136:137], v[140:141]\n\t" \
    "v_add_f32 %[yp], v140, v141\n\t" \
    "s_waitcnt lgkmcnt(0)\n\t" \
    "ds_read_b128 v[118:121], %[ab] offset:32512\n\t" \
    "ds_read_b128 v[122:125], %[ab] offset:7936\n\t" \
    "ds_read_b128 v[126:129], %[ab] offset:24320\n\t" \
    "ds_read_b128 v[130:133], %[ab] offset:16128\n\t" \
    "ds_read_b128 v[134:137], %[ab] offset:40704\n\t" \
    "ds_read_b32 v138, %[av] offset:1984\n\t" \
    "v_pk_mul_f32 v[140:141], %[s01], v[96:97]\n\t" \
    "v_pk_fma_f32 v[140:141], %[s23], v[98:99], v[140:141]\n\t" \
    "v_add_f32 v146, v140, v141\n\t" \
    "v_pk_mul_f32 v[142:143], %[s01], v[100:101]\n\t" \
    "v_pk_mul_f32 v[144:145], %[s23], v[102:103]\n\t" \
    "v_add_f32_dpp v146, v146, v146 quad_perm:[1,0,3,2] row_mask:0xf bank_mask:0xf bound_ctrl:1\n\t" \
    "v_add_f32_dpp %[yp], %[yp], %[yp] quad_perm:[1,0,3,2] row_mask:0xf bank_mask:0xf bound_ctrl:1\n\t" \
    "v_pk_fma_f32 v[142:143], v[116:117], v[108:109], v[142:143] op_sel_hi:[0,1,1]\n\t" \
    "v_add_f32_dpp v146, v146, v146 quad_perm:[2,3,0,1] row_mask:0xf bank_mask:0xf bound_ctrl:1\n\t" \
    "v_add_f32_dpp %[yp], %[yp], %[yp] quad_perm:[2,3,0,1] row_mask:0xf bank_mask:0xf bound_ctrl:1\n\t" \
    "v_pk_fma_f32 v[144:145], v[116:117], v[110:111], v[144:145] op_sel_hi:[0,1,1]\n\t" \
    "v_add_f32_dpp v146, v146, v146 row_half_mirror row_mask:0xf bank_mask:0xf bound_ctrl:1\n\t" \
    "v_add_f32_dpp %[yp], %[yp], %[yp] row_half_mirror row_mask:0xf bank_mask:0xf bound_ctrl:1\n\t" \
    "v_cmp_eq_u32_e32 vcc, 13, %[sp]\n\t" \
    "v_add_f32_dpp v146, v146, v146 row_mirror row_mask:0xf bank_mask:0xf bound_ctrl:1\n\t" \
    "v_add_f32_dpp %[yp], %[yp], %[yp] row_mirror row_mask:0xf bank_mask:0xf bound_ctrl:1\n\t" \
    "v_cndmask_b32_e32 %[yk1], %[yk1], %[yp], vcc\n\t" \
    "v_pk_fma_f32 %[s01], v[146:147], v[104:105], v[142:143] op_sel_hi:[0,1,1] neg_lo:[1,0,0] neg_hi:[1,0,0]\n\t" \
    "v_pk_fma_f32 %[s23], v[146:147], v[106:107], v[144:145] op_sel_hi:[0,1,1] neg_lo:[1,0,0] neg_hi:[1,0,0]\n\t" \
    "v_pk_mul_f32 v[140:141], %[s01], v[112:113]\n\t" \
    "v_pk_fma_f32 v[140:141], %[s23], v[114:115], v[140:141]\n\t" \
    "v_add_f32 %[yp], v140, v141\n\t" \
    "s_waitcnt lgkmcnt(0)\n\t" \
    "ds_read_b128 v[96:99], %[ab] offset:32768\n\t" \
    "ds_read_b128 v[100:103], %[ab] offset:8192\n\t" \
    "ds_read_b128 v[104:107], %[ab] offset:24576\n\t" \
    "ds_read_b128 v[108:111], %[ab] offset:16384\n\t" \
    "ds_read_b128 v[112:115], %[ab] offset:40960\n\t" \
    "ds_read_b32 v116, %[av] offset:2048\n\t" \
    "v_pk_mul_f32 v[140:141], %[s01], v[118:119]\n\t" \
    "v_pk_fma_f32 v[140:141], %[s23], v[120:121], v[140:141]\n\t" \
    "v_add_f32 v146, v140, v141\n\t" \
    "v_pk_mul_f32 v[142:143], %[s01], v[122:123]\n\t" \
    "v_pk_mul_f32 v[144:145], %[s23], v[124:125]\n\t" \
    "v_add_f32_dpp v146, v146, v146 quad_perm:[1,0,3,2] row_mask:0xf bank_mask:0xf bound_ctrl:1\n\t" \
    "v_add_f32_dpp %[yp], %[yp], %[yp] quad_perm:[1,0,3,2] row_mask:0xf bank_mask:0xf bound_ctrl:1\n\t" \
    "v_pk_fma_f32 v[142:143], v[138:139], v[130:131], v[142:143] op_sel_hi:[0,1,1]\n\t" \
    "v_add_f32_dpp v146, v146, v146 quad_perm:[2,3,0,1] row_mask:0xf bank_mask:0xf bound_ctrl:1\n\t" \
    "v_add_f32_dpp %[yp], %[yp], %[yp] quad_perm:[2,3,0,1] row_mask:0xf bank_mask:0xf bound_ctrl:1\n\t" \
    "v_pk_fma_f32 v[144:145], v[138:139], v[132:133], v[144:145] op_sel_hi:[0,1,1]\n\t" \
    "v_add_f32_dpp v146, v146, v146 row_half_mirror row_mask:0xf bank_mask:0xf bound_ctrl:1\n\t" \
    "v_add_f32_dpp %[yp], %[yp], %[yp] row_half_mirror row_mask:0xf bank_mask:0xf bound_ctrl:1\n\t" \
    "v_cmp_eq_u32_e32 vcc, 14, %[sp]\n\t" \
    "v_add_f32_dpp v146, v146, v146 row_mirror row_mask:0xf bank_mask:0xf bound_ctrl:1\n\t" \
    "v_add_f32_dpp %[yp], %[yp], %[yp] row_mirror row_mask:0xf bank_mask:0xf bound_ctrl:1\n\t" \
    "v_cndmask_b32_e32 %[yk1], %[yk1], %[yp], vcc\n\t" \
    "v_pk_fma_f32 %[s01], v[146:147], v[126:127], v[142:143] op_sel_hi:[0,1,1] neg_lo:[1,0,0] neg_hi:[1,0,0]\n\t" \
    "v_pk_fma_f32 %[s23], v[146:147], v[128:129], v[144:145] op_sel_hi:[0,1,1] neg_lo:[1,0,0] neg_hi:[1,0,0]\n\t" \
    "v_pk_mul_f32 v[140:141], %[s01], v[134:135]\n\t" \
    "v_pk_fma_f32 v[140:141], %[s23], v[136:137], v[140:141]\n\t" \
    "v_add_f32 %[yp], v140, v141\n\t" \
    "s_waitcnt lgkmcnt(0)\n\t"
#define SCAN_CHUNK_CLOBBERS "v96", "v97", "v98", "v99", "v100", "v101", "v102", "v103", "v104", "v105", "v106", "v107", "v108", "v109", "v110", "v111", "v112", "v113", "v114", "v115", "v116", "v117", "v118", "v119", "v120", "v121", "v122", "v123", "v124", "v125", "v126", "v127", "v128", "v129", "v130", "v131", "v132", "v133", "v134", "v135", "v136", "v137", "v138", "v139", "v140", "v141", "v142", "v143", "v144", "v145", "v146", "v147", "vcc", "memory"
#ifndef EMU
#define UNR _Pragma("unroll")
#define UNR1 _Pragma("unroll 1")
#define CFENCE() asm volatile("" ::: "memory")
#define OPAQUE(x) asm volatile("" : "+v"(x))
#define SYNC() __syncthreads()
#define WAVE_SYNC() do { asm volatile("s_waitcnt lgkmcnt(0)" ::: "memory"); __builtin_amdgcn_wave_barrier(); } while (0)
DEVFN float shfl_xor_f(float v, int m) { return __shfl_xor(v, m); }
DEVFN float shfl_f(float v, int src) { return __shfl(v, src); }
DEVFN void sincospi_f(float x, float* s, float* c) { sincospif(x, s, c); }
template <int M> DEVFN float rowx_add(float v) { constexpr int ctrl = M == 1 ? 0xB1 : M == 2 ? 0x4E : M == 7 ? 0x141 : 0x140;
    return v + __builtin_bit_cast(float, __builtin_amdgcn_update_dpp(0, __builtin_bit_cast(int, v), ctrl, 0xf, 0xf, true)); }
#endif

enum InIdx { I_X = 0, I_C, I_CTX, I_CCTX, I_ANORM, I_AADAW, I_AADAB, I_AWIN, I_RPB, I_QG, I_KG, I_AWOUT, I_RNORM, I_RADAW, I_RADAB, I_RWIN, I_MU, I_W0, I_WUP, I_A0, I_AUP,
             I_KK, I_KA, I_RK, I_GNW, I_GNB, I_HSHORT, I_HW1, I_HB1, I_HW2, I_HB2, I_HW3, I_HB3, I_HSKIP, I_RWOUT, I_FNORM, N_IN };

#if defined(TSEL) && !defined(EMU)
#define XSTAMP(C, k, cond) do { if ((cond) && (C).tid == 0) __hip_atomic_store((unsigned long long*)((C).ws + WS_CTL + 32768) + (k), (unsigned long long)__builtin_amdgcn_s_memrealtime(), __ATOMIC_RELAXED, __HIP_MEMORY_SCOPE_AGENT); } while (0)
#else
#define XSTAMP(C, k, cond) do {} while (0)
#endif
#if defined(TSEL) && !defined(EMU)
#define TACC_DECL unsigned long long tacc_ = 0, tb_ = 0
#define TACC_BEGIN tb_ = __builtin_amdgcn_s_memrealtime()
#define TACC_END tacc_ += __builtin_amdgcn_s_memrealtime() - tb_
#define TACC_STORE(C, k, cond) do { if (cond) __hip_atomic_store((unsigned long long*)((C).ws + WS_CTL + 32768) + (k), tacc_, __ATOMIC_RELAXED, __HIP_MEMORY_SCOPE_AGENT); } while (0)
#else
#define TACC_DECL
#define TACC_BEGIN
#define TACC_END
#define TACC_STORE(C, k, cond)
#endif
struct Ctx {
    const float* in[N_IN]; float* out; unsigned char* ws;
    int tid, lane, wave, vcu, G;
};

#ifdef EMU
DEVFN float wave_sum(float v) { for (int o = 1; o < 64; o <<= 1) v += shfl_xor_f(v, o); return v; }
DEVFN float swap16_f(float v) { return shfl_xor_f(v, 16); }
#else
DEVFN float wave_sum(float v) { v = rowx_add<1>(v); v = rowx_add<2>(v); v = rowx_add<7>(v); v = rowx_add<15>(v);
    const int i_ = __builtin_bit_cast(int, v);
    return (__builtin_bit_cast(float, __builtin_amdgcn_readlane(i_, 0)) + __builtin_bit_cast(float, __builtin_amdgcn_readlane(i_, 16))) + (__builtin_bit_cast(float, __builtin_amdgcn_readlane(i_, 32)) + __builtin_bit_cast(float, __builtin_amdgcn_readlane(i_, 48))); }
DEVFN float swap16_f(float v) { return __builtin_bit_cast(float, __builtin_amdgcn_ds_swizzle(__builtin_bit_cast(int, v), 0x401F)); }
#endif

DEVFN U4 ld16(const void* p) { return *(const U4*)p; }
DEVFN void st16(void* p, U4 v) { *(U4*)p = v; }
DEVFN void unpack8(U4 w, float* f) { f[0] = bflo(w.x); f[1] = bfhi(w.x); f[2] = bflo(w.y); f[3] = bfhi(w.y); f[4] = bflo(w.z); f[5] = bfhi(w.z); f[6] = bflo(w.w); f[7] = bfhi(w.w); }
DEVFN U4 pack8(const float* f) { U4 w; w.x = pk2(f[0], f[1]); w.y = pk2(f[2], f[3]); w.z = pk2(f[4], f[5]); w.w = pk2(f[6], f[7]); return w; }

DEVFN void p0_transpose_item(const float* W, int K, int N, bf16_t* WT, float* scr, int item, int lane) {
    const int nblk = N / 32, kb = item / nblk, nb = item % nblk, k0 = 64 * kb, n0 = 32 * nb;
    UNR for (int i = 0; i < 32; ++i) { const int kk = 2 * i + (lane >> 5); scr[kk * 33 + (lane & 31)] = W[(size_t)(k0 + kk) * N + n0 + (lane & 31)]; }
    WAVE_SYNC();
    const int c = lane & 7;
    UNR for (int j = 0; j < 4; ++j) { const int n = (lane >> 3) + 8 * j; const float* s = scr + (8 * c) * 33 + n;
        U4 o; o.x = pk2(s[0 * 33], s[1 * 33]); o.y = pk2(s[2 * 33], s[3 * 33]); o.z = pk2(s[4 * 33], s[5 * 33]); o.w = pk2(s[6 * 33], s[7 * 33]);
        st16(WT + (size_t)(n0 + n) * K + k0 + 8 * c, o); }
    WAVE_SYNC();
}

template <bool BF> DEVFN void hid_rows(const float* w1, const float* b1, const float* w2, const float* b2, float* hid, int L, int gw, int NGW, int lane) {
    float w1c[33], w2c[64];
    UNR for (int i = 0; i < 33; ++i) w1c[i] = w1[i * 64 + lane];
    UNR for (int i = 0; i < 64; ++i) w2c[i] = w2[i * 64 + lane];
    const float bb1 = b1[lane], bb2 = b2[lane];
    for (int t = gw; t < L; t += NGW) {
        float feat = 0.f;
        if (lane == 0) feat = (float)t / (float)(L - 1 > 1 ? L - 1 : 1);
        else if (lane < 33) { const int b = (lane - 1) & 15; const float band = 1e-4f + (float)b * ((15.0f - 1e-4f) / 15.0f);
            const float x = 2.0f * band * (float)t / (float)L; float s, c; sincospi_f(x, &s, &c); feat = (lane <= 16) ? c : -s; }
        float a = bb1;
        UNR for (int i = 0; i < 33; ++i) a += shfl_f(feat, i) * w1c[i];
        const float h1 = sinf(a);
        float b = bb2;
        UNR for (int i = 0; i < 64; ++i) b += shfl_f(h1, i) * w2c[i];
        if (BF) ((bf16_t*)hid)[(size_t)t * 64 + lane] = (bf16_t)f2bf(sinf(b)); else hid[(size_t)t * 64 + lane] = sinf(b);
    }
}

DEVFN void r2_build_bfrag(const Ctx& C);
DEVFN void ph_prologue(const Ctx& C, unsigned char* lds) {
    const int gw = C.vcu * NWAVES + C.wave, NGW = C.G * NWAVES, lane = C.lane;
    float* scr = (float*)(lds + C.wave * 16384);
    {
        constexpr int I_AIN = 16 * (AIN / 32), I_OUT = 16 * 32, I_RIN = 16 * (RIN / 32);
        constexpr int NIT = 2 * (I_AIN + I_OUT + I_RIN + I_OUT);
        for (int it = gw; it < NIT; it += NGW) {
            int r = it; const int li = r & 1; r >>= 1;
            if (r < I_AIN) { p0_transpose_item(C.in[I_AWIN] + (size_t)li * DM * AIN, DM, AIN, (bf16_t*)(C.ws + WS_WAIN) + (size_t)li * AIN * DM, scr, r, lane); continue; } r -= I_AIN;
            if (r < I_OUT) { p0_transpose_item(C.in[I_AWOUT] + (size_t)li * DM * DM, DM, DM, (bf16_t*)(C.ws + WS_WAOUT) + (size_t)li * DM * DM, scr, r, lane); continue; } r -= I_OUT;
            if (r < I_RIN) { p0_transpose_item(C.in[I_RWIN] + (size_t)li * DM * RIN, DM, RIN, (bf16_t*)(C.ws + WS_WRIN) + (size_t)li * RINP * DM, scr, r, lane); continue; } r -= I_RIN;
            p0_transpose_item(C.in[I_RWOUT] + (size_t)li * DM * DM, DM, DM, (bf16_t*)(C.ws + WS_WROUT) + (size_t)li * DM * DM, scr, r, lane);
        }
        for (int e = gw * 64 + lane; e < 2 * (RINP - RIN) * DM / 8; e += NGW * 64) { const int li = e / ((RINP - RIN) * DM / 8), o = e % ((RINP - RIN) * DM / 8);
            U4 z; z.x = z.y = z.z = z.w = 0u; st16((bf16_t*)(C.ws + WS_WRIN) + (size_t)li * RINP * DM + (size_t)RIN * DM + (size_t)o * 8, z); }
    }
    {
        float* ADA = (float*)(C.ws + WS_ADA);
        for (int it = gw; it < 4 * 48; it += NGW) {
            const int layer = it / 48, cb = it % 48, col = cb * 64 + lane, i = layer >> 1;
            const float* W = (layer & 1) ? C.in[I_RADAW] + (size_t)i * DM * 3072 : C.in[I_AADAW] + (size_t)i * DM * 3072;
            const float* B = (layer & 1) ? C.in[I_RADAB] + (size_t)i * 3072 : C.in[I_AADAB] + (size_t)i * 3072;
            float a0 = 0.f, a1 = 0.f;
            for (int k0 = 0; k0 < DM; k0 += 64) {
                const float sc = silu_f(C.in[I_C][k0 + lane]), sx = silu_f(C.in[I_CCTX][k0 + lane]);
                for (int k = 0; k < 64; ++k) { const float w = W[(size_t)(k0 + k) * 3072 + col]; a0 += shfl_f(sc, k) * w; a1 += shfl_f(sx, k) * w; }
            }
            ADA[(size_t)(layer * 2 + 0) * 3072 + col] = a0 + B[col];
            ADA[(size_t)(layer * 2 + 1) * 3072 + col] = a1 + B[col];
        }
    }
    for (int i = 0; i < 2; ++i)
        hid_rows<true>(C.in[I_HW1] + (size_t)i * 33 * 64, C.in[I_HB1] + i * 64, C.in[I_HW2] + (size_t)i * 64 * 64, C.in[I_HB2] + i * 64, (float*)((bf16_t*)(C.ws + WS_HID) + (size_t)i * NLAT * 64), NLAT, gw, NGW, lane);
    hid_rows<false>(C.in[I_HW1], C.in[I_HB1], C.in[I_HW2], C.in[I_HB2], (float*)(C.ws + WS_HID256), NCTX, gw, NGW, lane);
    r2_build_bfrag(C);
    { F2* TW = (F2*)(C.ws + WS_TW);
      for (int k = gw * 64 + lane; k <= 16384; k += NGW * 64) { float s, c; sincospi_f((float)k * (1.0f / 16384.0f), &s, &c); F2 w; w.x = c; w.y = -s; TW[k] = w; } }
}

DEVFN void ph_norm(const Ctx& C, int layer, const float* xlat, const float* xctx, bool do_ctx) {
    const int gw = C.vcu * NWAVES + C.wave, NGW = C.G * NWAVES, lane = C.lane, i = layer >> 1;
    const float* gain = ((layer & 1) ? C.in[I_RNORM] : C.in[I_ANORM]) + (size_t)i * DM;
    const float* ADA = (const float*)(C.ws + WS_ADA) + (size_t)layer * 2 * 3072;
    bf16_t* XN = (bf16_t*)(C.ws + WS_XN);
    const int nrows = do_ctx ? NTOK : NLAT;
    for (int m = gw; m < nrows; m += NGW) {
        const bool isctx = m >= NLAT;
        const float* xr = isctx ? xctx + (size_t)(m - NLAT) * DM : xlat + (size_t)m * DM;
        const float* ada = ADA + (isctx ? 3072 : 0);
        F4 v[4]; float s = 0.f;
        UNR for (int j = 0; j < 4; ++j) { v[j] = *(const F4*)(xr + 256 * j + 4 * lane); s += (v[j].x * v[j].x + v[j].y * v[j].y) + (v[j].z * v[j].z + v[j].w * v[j].w); }
        const float rs = 1.0f / sqrtf(wave_sum(s) * (1.0f / DM) + NORM_EPS);
        UNR for (int j = 0; j < 4; ++j) { const int c0 = 256 * j + 4 * lane;
            const F4 g = *(const F4*)(gain + c0), sh = *(const F4*)(ada + c0), sc = *(const F4*)(ada + 1024 + c0);
            U2 o; o.x = pk2(v[j].x * rs * g.x * (1.f + sc.x) + sh.x, v[j].y * rs * g.y * (1.f + sc.y) + sh.y);
            o.y = pk2(v[j].z * rs * g.z * (1.f + sc.z) + sh.z, v[j].w * rs * g.w * (1.f + sc.w) + sh.w);
            *(U2*)(XN + (size_t)m * DM + c0) = o; }
    }
}

DEVFN void ph_final(const Ctx& C) {
    const int gw = C.vcu * NWAVES + C.wave, NGW = C.G * NWAVES, lane = C.lane;
    const float* gain = C.in[I_FNORM];
    for (int m = gw; m < NLAT; m += NGW) {
        float* xr = C.out + (size_t)m * DM;
        F4 v[4]; float s = 0.f;
        UNR for (int j = 0; j < 4; ++j) { v[j] = *(const F4*)(xr + 256 * j + 4 * lane); s += (v[j].x * v[j].x + v[j].y * v[j].y) + (v[j].z * v[j].z + v[j].w * v[j].w); }
        const float rs = 1.0f / sqrtf(wave_sum(s) * (1.0f / DM) + NORM_EPS);
        UNR for (int j = 0; j < 4; ++j) { const int c0 = 256 * j + 4 * lane; const F4 g = *(const F4*)(gain + c0);
            F4 o; o.x = v[j].x * rs * g.x; o.y = v[j].y * rs * g.y; o.z = v[j].z * rs * g.z; o.w = v[j].w * rs * g.w; *(F4*)(xr + c0) = o; }
    }
}

DEVFN void ph_qkprep(const Ctx& C, int i) {
    const int gw = C.vcu * NWAVES + C.wave, NGW = C.G * NWAVES, lane = C.lane;
    bf16_t* U = (bf16_t*)(C.ws + WS_U);
    const float qg = C.in[I_QG][i * 64 + lane], kg = C.in[I_KG][i * 64 + lane];
    const int axis = lane >> 5, half = (lane >> 4) & 1, f = lane & 15;
    const float invf = exp2f(-(float)f * (13.287712379549449f / 16.0f));
    for (int m = gw; m < NTOK; m += NGW) {
        float cs = 1.f, sn = 0.f;
        if (m < NLAT) { const float pos = (float)(axis == 0 ? (m >> 6) : (m & 63)); const float ang = pos * invf; cs = cosf(ang); sn = sinf(ang); }
        bf16_t* ur = U + (size_t)m * AIN + 2048;
        for (int h = 0; h < 10; ++h) {
            const float v = bf2f(ur[h * 64 + lane]);
            const float ss = wave_sum(v * v);
            float y = v * (1.0f / sqrtf(ss * (1.0f / 64.0f) + NORM_EPS)) * (h < 8 ? qg : kg);
            const float p = swap16_f(y);
            y = half == 0 ? y * cs - p * sn : y * cs + p * sn;
            if (h < 8) y *= C2;
            ur[h * 64 + lane] = (bf16_t)f2bf(y);
        }
    }
}

DEVFN void ph_hyprep(const Ctx& C, int i, bool do_ctx, unsigned char* lds) {
    const int tid = C.tid;
    const bf16_t* UHY = (const bf16_t*)(C.ws + WS_UHY);
    const float* taps = C.in[I_HSHORT] + (size_t)i * 3 * UHY_W;
    float* T = (float*)lds;
    const int ntile_lat = 3 * 8 * 256, ntile = ntile_lat + (do_ctx ? 3 * 8 * 4 : 0);
    for (int it = C.vcu; it < ntile; it += C.G) {
        const bool isctx = it >= ntile_lat; const int r = isctx ? it - ntile_lat : it;
        const int ntb = isctx ? 4 : 256; const int tb = r % ntb, cb = (r / ntb) & 7, g = r / (ntb * 8);
        const int seg0 = isctx ? NLAT : 0, segn = isctx ? NCTX : NLAT;
        {
            const int tl = tid >> 3, c8 = (tid & 7) * 8, t = 64 * tb + tl, col = g * 512 + 64 * cb + c8;
            float um[8], u0[8], up[8];
            unpack8(ld16(UHY + (size_t)(seg0 + t) * UHY_W + col), u0);
            if (t > 0) unpack8(ld16(UHY + (size_t)(seg0 + t - 1) * UHY_W + col), um); else UNR for (int e = 0; e < 8; ++e) um[e] = 0.f;
            if (t < segn - 1) unpack8(ld16(UHY + (size_t)(seg0 + t + 1) * UHY_W + col), up); else UNR for (int e = 0; e < 8; ++e) up[e] = 0.f;
            UNR for (int e = 0; e < 8; ++e) T[(c8 + e) * 65 + tl] = um[e] * taps[col + e] + u0[e] * taps[UHY_W + col + e] + up[e] * taps[2 * UHY_W + col + e];
        }
        SYNC();
        {
            const int cl = tid >> 3, t8 = (tid & 7) * 8, ch = 64 * cb + cl;
            float v[8]; UNR for (int e = 0; e < 8; ++e) v[e] = T[cl * 65 + t8 + e];
            if (!isctx) { bf16_t* VX = (bf16_t*)(C.ws + (g == 0 ? WS_VX0 : g == 1 ? WS_VX1 : WS_VX2)); st16(VX + (size_t)ch * NLAT + 64 * tb + t8, pack8(v)); }
            else { float* VXC = (float*)(C.ws + WS_VXC) + ((size_t)g * 512 + ch) * NCTX + 64 * tb + t8; UNR for (int e = 0; e < 8; ++e) VXC[e] = v[e]; }
        }
        SYNC();
    }
}

typedef float P2 __attribute__((vector_size(8)));
#ifdef EMU
struct H8 { unsigned short v[8]; };
struct A4 { float v[4]; };
inline A4 mfma16(const H8& a, const H8& b, const A4& c) {
    static H8 sa_[emu::MAXB][8][64], sb_[emu::MAXB][8][64]; const int w = emu::t_tid >> 6, l = emu::t_tid & 63; H8 (*sa)[64] = sa_[emu::t_blk]; H8 (*sb)[64] = sb_[emu::t_blk];
    sa[w][l] = a; sb[w][l] = b; pthread_barrier_wait(&emu::g_wbar_[emu::t_blk][w]);
    A4 r = c;
    for (int reg = 0; reg < 4; ++reg) { const int row = 4 * (l >> 4) + reg, col = l & 15; float acc = 0.f;
        for (int k = 0; k < 32; ++k) acc += bf2f(sa[w][row + 16 * (k >> 3)].v[k & 7]) * bf2f(sb[w][col + 16 * (k >> 3)].v[k & 7]);
        r.v[reg] += acc; }
    pthread_barrier_wait(&emu::g_wbar_[emu::t_blk][w]);
    return r;
}
#define H8_SET(h, j, x) (h).v[j] = (unsigned short)(x)
#define A4_GET(a, j) (a).v[j]
#define MFMA_PAD(a,b,c,d,e,f,g,h)
#else
typedef short H8 __attribute__((ext_vector_type(8)));
typedef float A4 __attribute__((ext_vector_type(4)));
DEVFN A4 mfma16(const H8& a, const H8& b, const A4& c) { return __builtin_amdgcn_mfma_f32_16x16x32_bf16(a, b, c, 0, 0, 0); }
#define H8_SET(h, j, x) (h)[j] = (short)(x)
#define A4_GET(a, j) (a)[j]
#define MFMA_PAD(a,b,c,d,e,f,g,h) asm volatile("s_nop 15\n\ts_nop 15" : "+v"(a), "+v"(b), "+v"(c), "+v"(d), "+v"(e), "+v"(f), "+v"(g), "+v"(h))
#endif
#ifdef EMU
#define FEXP(x) expf(x)
#define FLOG(x) logf(x)
#define FRCP(x) (1.0f / (x))
#define FRSQ(x) (1.0f / sqrtf(x))
#define SETPRIO(n)
#else
#define FEXP(x) __expf(x)
#define FLOG(x) __logf(x)
#define FRCP(x) __builtin_amdgcn_rcpf(x)
#define FRSQ(x) __builtin_amdgcn_rsqf(x)
#define SETPRIO(n) __builtin_amdgcn_s_setprio(n)
#endif
DEVFN H8 h8_from_u4(U4 w) { H8 r; H8_SET(r, 0, w.x & 0xffff); H8_SET(r, 1, w.x >> 16); H8_SET(r, 2, w.y & 0xffff); H8_SET(r, 3, w.y >> 16); H8_SET(r, 4, w.z & 0xffff); H8_SET(r, 5, w.z >> 16); H8_SET(r, 6, w.w & 0xffff); H8_SET(r, 7, w.w >> 16); return r; }
constexpr int FFT_N = 16384;
DEVFN int fidx(int n) { return n + (n >> 4); }
DEVFN F2 cmul(F2 a, F2 b) { F2 r; r.x = a.x * b.x - a.y * b.y; r.y = a.x * b.y + a.y * b.x; return r; }
DEVFN F2 cmulc(F2 a, F2 b) { F2 r; r.x = a.x * b.x + a.y * b.y; r.y = a.y * b.x - a.x * b.y; return r; }
DEVFN F2 cadd(F2 a, F2 b) { F2 r; r.x = a.x + b.x; r.y = a.y + b.y; return r; }
DEVFN F2 csub(F2 a, F2 b) { F2 r; r.x = a.x - b.x; r.y = a.y - b.y; return r; }
DEVFN F2 cconj(F2 a) { F2 r; r.x = a.x; r.y = -a.y; return r; }
template <bool INV> DEVFN F2 mul_mi(F2 a) { F2 r; if (!INV) { r.x = a.y; r.y = -a.x; } else { r.x = -a.y; r.y = a.x; } return r; }
template <bool INV> DEVFN void dft4(F2& a0, F2& a1, F2& a2, F2& a3) {
    const F2 s02 = cadd(a0, a2), d02 = csub(a0, a2), s13 = cadd(a1, a3), d13 = mul_mi<INV>(csub(a1, a3));
    a0 = cadd(s02, s13); a2 = csub(s02, s13); a1 = cadd(d02, d13); a3 = csub(d02, d13);
}
template <bool INV> DEVFN void dft16(F2* a) {
    UNR for (int n2 = 0; n2 < 4; ++n2) dft4<INV>(a[n2], a[4 + n2], a[8 + n2], a[12 + n2]);
    const float c1 = 0.92387953251128674f, s1 = 0.38268343236508977f, r2 = 0.70710678118654752f;
    const F2 w1 = {c1, INV ? s1 : -s1}, w2 = {r2, INV ? r2 : -r2}, w3 = {s1, INV ? c1 : -c1}, w6 = {-r2, INV ? r2 : -r2}, w9 = {-c1, INV ? -s1 : s1};
    a[4 * 1 + 1] = cmul(a[4 * 1 + 1], w1); a[4 * 1 + 2] = cmul(a[4 * 1 + 2], w2); a[4 * 1 + 3] = cmul(a[4 * 1 + 3], w3);
    a[4 * 2 + 1] = cmul(a[4 * 2 + 1], w2); a[4 * 2 + 2] = mul_mi<INV>(a[4 * 2 + 2]); a[4 * 2 + 3] = cmul(a[4 * 2 + 3], w6);
    a[4 * 3 + 1] = cmul(a[4 * 3 + 1], w3); a[4 * 3 + 2] = cmul(a[4 * 3 + 2], w6); a[4 * 3 + 3] = cmul(a[4 * 3 + 3], w9);
    F2 x[16];
    UNR for (int k1 = 0; k1 < 4; ++k1) { F2 b0 = a[4 * k1 + 0], b1 = a[4 * k1 + 1], b2 = a[4 * k1 + 2], b3 = a[4 * k1 + 3]; dft4<INV>(b0, b1, b2, b3); x[k1] = b0; x[k1 + 4] = b1; x[k1 + 8] = b2; x[k1 + 12] = b3; }
    UNR for (int q = 0; q < 16; ++q) a[q] = x[q];
}
template <int R, bool INV> DEVFN void fft_stage(F2* F, const F2* TW, int B, int tid) {
    const int S = B / R, NB = FFT_N / R, tws = 2 * (FFT_N / B);
    int tq = tid; OPAQUE(tq);
    UNR1 for (int q = tq; q < NB; q += NTHREADS) {
        const int blk = q / S, j = q - blk * S, base = blk * B + j;
        F2 a[R];
        UNR for (int m = 0; m < R; ++m) a[m] = F[fidx(base + m * S)];
        if (INV && S > 1) { const F2 w1 = TW[tws * j]; F2 w = w1; UNR for (int m = 1; m < R; ++m) { a[m] = cmulc(a[m], w); w = cmul(w, w1); } }
        if constexpr (R == 4) dft4<INV>(a[0], a[1], a[2], a[3]); else dft16<INV>(a);
        if (!INV && S > 1) { const F2 w1 = TW[tws * j]; F2 w = w1; UNR for (int m = 1; m < R; ++m) { a[m] = cmul(a[m], w); w = cmul(w, w1); } }
        UNR for (int m = 0; m < R; ++m) F[fidx(base + m * S)] = a[m];
    }
}
DEVFN void fft_fwd(F2* F, const F2* TW, int tid) {
    fft_stage<4, false>(F, TW, 16384, tid); SYNC(); fft_stage<16, false>(F, TW, 4096, tid); SYNC(); fft_stage<16, false>(F, TW, 256, tid); SYNC(); fft_stage<16, false>(F, TW, 16, tid); SYNC();
}
DEVFN void fft_inv(F2* F, const F2* TW, int tid) {
    fft_stage<16, true>(F, TW, 16, tid); SYNC(); fft_stage<16, true>(F, TW, 256, tid); SYNC(); fft_stage<16, true>(F, TW, 4096, tid); SYNC(); fft_stage<4, true>(F, TW, 16384, tid); SYNC();
}
DEVFN int fpos(int k) { return ((k & 3) << 12) | (((k >> 2) & 15) << 8) | (((k >> 6) & 15) << 4) | (k >> 10); }

DEVFN float block_sum(float v, float* red, int tid) {
    v = wave_sum(v);
    if ((tid & 63) == 0) red[tid >> 6] = v;
    SYNC();
    float s = 0.f; UNR for (int w = 0; w < NWAVES; ++w) s += red[w];
    SYNC();
    return s;
}

#ifdef EMU
#define SCHED_BAR()
#else
#define SCHED_BAR() __builtin_amdgcn_sched_barrier(0)
#endif
#if defined(HSEC)
#define HS_B(k) do { if (HSEC == (k)) { TACC_BEGIN; } } while (0)
#define HS_E(k) do { if (HSEC == (k)) { TACC_END; } } while (0)
#else
#define HS_B(k)
#define HS_E(k)
#endif
DEVFN void hyena_channel(const Ctx& C, int i, int c, unsigned char* lds) {
    const int tid = C.tid; constexpr int L = NLAT;
    F2* F = (F2*)lds; float* Ff = (float*)lds;
    float* W3C = (float*)(lds + 139264);
    float* red = W3C + 272;
    const F2* TW = (const F2*)(C.ws + WS_TW);
    const bf16_t* hidb = (const bf16_t*)(C.ws + WS_HID) + (size_t)i * NLAT * 64;
    const float* w3 = C.in[I_HW3] + (size_t)i * 64 * 2048; const float* b3 = C.in[I_HB3] + (size_t)i * 2048;
    const bf16_t* VX0 = (const bf16_t*)(C.ws + WS_VX0) + (size_t)c * L;
    const bf16_t* VX1 = (const bf16_t*)(C.ws + WS_VX1) + (size_t)c * L;
    const bf16_t* VX2 = (const bf16_t*)(C.ws + WS_VX2) + (size_t)c * L;
    bf16_t* YHY = (bf16_t*)(C.ws + WS_YHY) + (size_t)c * L;
    const float skip0 = C.in[I_HSKIP][(size_t)i * 1024 + c], skip1 = C.in[I_HSKIP][(size_t)i * 1024 + 512 + c];
    const float delta = 15.350567286626973f + (float)c * ((3.0701134573253945f - 15.350567286626973f) / 511.0f);
    if (tid < 256) { const int o = tid >> 7, s = (tid >> 6) & 1, m = tid & 63; W3C[tid] = w3[(size_t)m * 2048 + (s * 2 + o) * 512 + c]; }
    if (tid < 4) W3C[256 + tid] = b3[((tid & 1) * 2 + (tid >> 1)) * 512 + c];
    SYNC();
    TACC_DECL;
    unsigned ktap1[32];
    UNR1 for (int o = 0; o < 2; ++o) {
        HS_B(1);
        float ssq = 0.f, af0_ = 0.f, ab0_ = 0.f;
        if (o == 0) {
            int tqa = tid; OPAQUE(tqa); const int lane = tqa & 63, wv = tqa >> 6, l15 = lane & 15, kg = lane >> 4, rr = l15 & 3, gq = l15 >> 2;
            H8 Ag[4][2];
            { float f0[8], f1[8]; UNR for (int j = 0; j < 8; ++j) { f0[j] = W3C[rr * 64 + 8 * kg + j]; f1[j] = W3C[rr * 64 + 32 + 8 * kg + j]; }
              const U4 w0 = pack8(f0), w1 = pack8(f1);
              UNR for (int g = 0; g < 4; ++g) { const unsigned m_ = gq == g ? 0xffffffffu : 0u; U4 a0, a1; a0.x = w0.x & m_; a0.y = w0.y & m_; a0.z = w0.z & m_; a0.w = w0.w & m_; a1.x = w1.x & m_; a1.y = w1.y & m_; a1.z = w1.z & m_; a1.w = w1.w & m_;
                  Ag[g][0] = h8_from_u4(a0); Ag[g][1] = h8_from_u4(a1); } }
            const float b00 = W3C[256 + 0], b01 = W3C[256 + 1], b10 = W3C[256 + 2], b11 = W3C[256 + 3];
            const bf16_t* hp = hidb + (size_t)l15 * 64 + 8 * kg;
            U4 bq[4][2];
            UNR for (int g = 0; g < 4; ++g) { bq[g][0] = ld16(hp + (size_t)(wv * 64 + 16 * g) * 64); bq[g][1] = ld16(hp + (size_t)(wv * 64 + 16 * g) * 64 + 32); }
            UNR for (int ii = 0; ii < 32; ++ii) {
                const int t0 = (ii * 8 + wv) * 64;
                U4 bn[4][2];
                if (ii + 1 < 32) { UNR for (int g = 0; g < 4; ++g) { bn[g][0] = ld16(hp + (size_t)(t0 + 512 + 16 * g) * 64); bn[g][1] = ld16(hp + (size_t)(t0 + 512 + 16 * g) * 64 + 32); } }
                SCHED_BAR();
                A4 acc; A4_GET(acc, 0) = 0.f; A4_GET(acc, 1) = 0.f; A4_GET(acc, 2) = 0.f; A4_GET(acc, 3) = 0.f;
                UNR for (int g = 0; g < 4; ++g) { acc = mfma16(Ag[g][0], h8_from_u4(bq[g][0]), acc); acc = mfma16(Ag[g][1], h8_from_u4(bq[g][1]), acc); }
                MFMA_PAD(acc, acc, acc, acc, acc, acc, acc, acc);
                int ln_ = lane; OPAQUE(ln_); const int t = t0 + ln_;
                const float win = expf(-((float)t / (float)(L - 1)) * delta);
                const float af = (A4_GET(acc, 0) + b00) * win; const float ab = (A4_GET(acc, 1) + b01) * win;
                ktap1[ii] = pk2((A4_GET(acc, 2) + b10) * win, (A4_GET(acc, 3) + b11) * win);
                ssq += af * af + ab * ab; Ff[2 * fidx(t >> 1) + (t & 1)] = af; const int m = t == 0 ? L : 2 * L - t; Ff[2 * fidx(m >> 1) + (m & 1)] = ab;
                if (ii == 0) { af0_ = af; ab0_ = ab; }
                SCHED_BAR();
                if (ii + 1 < 32) { UNR for (int g = 0; g < 4; ++g) { bq[g][0] = bn[g][0]; bq[g][1] = bn[g][1]; } }
            }
        } else {
            int tqb = tid; OPAQUE(tqb); const int lane = tqb & 63, wv = tqb >> 6;
            UNR for (int ii = 0; ii < 32; ++ii) {
                int ln_ = lane; OPAQUE(ln_); const int t = (ii * 8 + wv) * 64 + ln_; const float af = bflo(ktap1[ii]); const float ab = bfhi(ktap1[ii]);
                ssq += af * af + ab * ab; Ff[2 * fidx(t >> 1) + (t & 1)] = af; const int m = t == 0 ? L : 2 * L - t; Ff[2 * fidx(m >> 1) + (m & 1)] = ab;
                if (ii == 0) { af0_ = af; ab0_ = ab; }
                if ((ii & 3) == 3) SCHED_BAR();
            }
        }
        if (tid == 0) { Ff[0] = af0_ + ab0_; Ff[2 * fidx(L >> 1)] = 0.f; ssq += 2.f * af0_ * ab0_; }
        const float knorm = 1.0f / sqrtf(block_sum(ssq, red, tid)); HS_E(1);
        HS_B(2); fft_fwd(F, TW, tid); HS_E(2);
        HS_B(3);
        F2 kfa[16], kfb[16]; F2 kfh = {0.f, 0.f};
        int tq1 = tid; OPAQUE(tq1);
        UNR for (int ii = 0; ii < 16; ++ii) {
            const int k = tq1 + NTHREADS * ii;
            if (k == 0) { const F2 c0 = F[fidx(0)]; kfa[ii].x = (c0.x + c0.y) * knorm; kfa[ii].y = 0.f; kfb[ii].x = (c0.x - c0.y) * knorm; kfb[ii].y = 0.f;
                          const F2 ch = F[fidx(fpos(L / 2))]; kfh.x = ch.x * knorm; kfh.y = -ch.y * knorm; }
            else { const F2 ck = F[fidx(fpos(k))], cp = cconj(F[fidx(fpos(L - k))]);
                F2 e = cadd(ck, cp), od = csub(ck, cp); e.x *= 0.5f; e.y *= 0.5f; F2 oo; oo.x = 0.5f * od.y; oo.y = -0.5f * od.x;
                const F2 tt = cmul(TW[k], oo);
                kfa[ii] = cadd(e, tt); kfb[ii] = cconj(csub(e, tt)); kfa[ii].x *= knorm; kfa[ii].y *= knorm; kfb[ii].x *= knorm; kfb[ii].y *= knorm; }
            CFENCE();
        }
        SYNC(); HS_E(3);
        HS_B(4);
        UNR for (int ii = 0; ii < 4; ++ii) {
            int tq3 = tid; OPAQUE(tq3); const int t0 = 8 * (tq3 + NTHREADS * ii); float v[8];
            unpack8(ld16((o == 0 ? VX0 : (const bf16_t*)YHY) + t0), v);
            float* d = Ff + 2 * fidx(t0 >> 1); UNR for (int e = 0; e < 8; ++e) d[e] = v[e];
            float* zz = Ff + 2 * fidx((L + t0) >> 1); UNR for (int e = 0; e < 8; ++e) zz[e] = 0.f;
        }
        SYNC(); HS_E(4);
        HS_B(2); fft_fwd(F, TW, tid); HS_E(2);
        HS_B(3);
        int tq2 = tid; OPAQUE(tq2);
        UNR for (int ii = 0; ii < 16; ++ii) {
            const int k = tq2 + NTHREADS * ii;
            if (k == 0) { const F2 c0 = F[fidx(0)]; const float y0 = (c0.x + c0.y) * kfa[ii].x, yl = (c0.x - c0.y) * kfb[ii].x; F2 d; d.x = 0.5f * (y0 + yl); d.y = 0.5f * (y0 - yl); F[fidx(0)] = d;
                          const int ph = fidx(fpos(L / 2)); const F2 y = cmul(cconj(F[ph]), kfh); F[ph] = cconj(y); }
            else { const int pk = fidx(fpos(k)), pp = fidx(fpos(L - k)); const F2 ck = F[pk], cp = cconj(F[pp]);
                F2 e = cadd(ck, cp), od = csub(ck, cp); e.x *= 0.5f; e.y *= 0.5f; F2 oo; oo.x = 0.5f * od.y; oo.y = -0.5f * od.x;
                const F2 w = TW[k]; const F2 tt = cmul(w, oo);
                const F2 yk = cmul(cadd(e, tt), kfa[ii]), yp = cmul(cconj(csub(e, tt)), kfb[ii]);
                F2 ye = cadd(yk, cconj(yp)), yd = csub(yk, cconj(yp)); ye.x *= 0.5f; ye.y *= 0.5f; yd.x *= 0.5f; yd.y *= 0.5f;
                const F2 yo = cmulc(yd, w);
                F2 iyo; iyo.x = -yo.y; iyo.y = yo.x;
                F[pk] = cadd(ye, iyo); F[pp] = cconj(csub(ye, iyo)); }
            CFENCE();
        }
        SYNC(); HS_E(3);
        HS_B(2); fft_inv(F, TW, tid); HS_E(2);
        HS_B(4);
        UNR for (int ii = 0; ii < 4; ++ii) {
            int tq4 = tid; OPAQUE(tq4); const int t0 = 8 * (tq4 + NTHREADS * ii); const float* d = Ff + 2 * fidx(t0 >> 1);
            float y[8]; UNR for (int e = 0; e < 8; ++e) y[e] = d[e] * (1.0f / (float)FFT_N);
            if (o == 0) { float v[8], x1[8], r[8]; unpack8(ld16(VX0 + t0), v); unpack8(ld16(VX1 + t0), x1); UNR for (int e = 0; e < 8; ++e) r[e] = x1[e] * (y[e] + v[e] * skip0); st16(YHY + t0, pack8(r)); }
            else { float x2[8], zp[8], r[8]; unpack8(ld16(VX2 + t0), x2); unpack8(ld16(YHY + t0), zp); UNR for (int e = 0; e < 8; ++e) r[e] = x2[e] * (y[e] + zp[e] * skip1); st16(YHY + t0, pack8(r)); }
        }
        SYNC(); HS_E(4);
    }
    TACC_STORE(C, 39, C.vcu == C.G - 1 && tid == 0);
}

DEVFN void hyena_ctx_channel(const Ctx& C, int i, int c, unsigned char* lds) {
    const int tid = C.tid; constexpr int L = NCTX;
    float* KF = (float*)lds;
    float* Z = KF + 1024;
    float* red = Z + 256;
    float* W3C = red + 16;
    const float* hid = (const float*)(C.ws + WS_HID256);
    const float* w3 = C.in[I_HW3] + (size_t)i * 64 * 2048; const float* b3 = C.in[I_HB3] + (size_t)i * 2048;
    const float* VXC = (const float*)(C.ws + WS_VXC);
    const float delta = 15.350567286626973f + (float)c * ((3.0701134573253945f - 15.350567286626973f) / 511.0f);
    if (tid < 256) { const int o = tid >> 7, s = (tid >> 6) & 1, m = tid & 63; W3C[tid] = w3[(size_t)m * 2048 + (s * 2 + o) * 512 + c]; }
    if (tid < 4) W3C[256 + tid] = b3[((tid & 1) * 2 + (tid >> 1)) * 512 + c];
    SYNC();
    {
        const int o = tid >> 8, t = tid & 255;
        float af = W3C[256 + o * 2 + 0], ab = W3C[256 + o * 2 + 1];
        for (int m = 0; m < 64; ++m) { const float h = hid[t * 64 + m]; af += h * W3C[(o * 2 + 0) * 64 + m]; ab += h * W3C[(o * 2 + 1) * 64 + m]; }
        const float win = expf(-((float)t / (float)(L - 1)) * delta); af *= win; ab *= win;
        float ssq; if (t == 0) { af += ab; ab = 0.f; ssq = af * af; } else ssq = af * af + ab * ab;
        KF[(o * 2 + 0) * 256 + t] = af; KF[(o * 2 + 1) * 256 + t] = ab;
        ssq = wave_sum(ssq);
        if ((tid & 63) == 0) red[tid >> 6] = ssq;
        SYNC();
        const float tot = red[o * 4] + red[o * 4 + 1] + red[o * 4 + 2] + red[o * 4 + 3];
        const float kn = 1.0f / sqrtf(tot);
        KF[(o * 2 + 0) * 256 + t] = af * kn; KF[(o * 2 + 1) * 256 + t] = ab * kn;
    }
    float v = 0.f, x1 = 0.f, x2 = 0.f, z1 = 0.f;
    if (tid < 256) { v = VXC[((size_t)0 * 512 + c) * L + tid]; x1 = VXC[((size_t)1 * 512 + c) * L + tid]; x2 = VXC[((size_t)2 * 512 + c) * L + tid]; Z[tid] = v; }
    SYNC();
    for (int o = 0; o < 2; ++o) {
        float y = 0.f;
        if (tid < 256) { const int t = tid; const float* kf = KF + (o * 2) * 256; const float* kb = KF + (o * 2 + 1) * 256;
            for (int s = 0; s <= t; ++s) y += kf[t - s] * Z[s];
            for (int s = t + 1; s < L; ++s) y += kb[s - t] * Z[s]; }
        SYNC();
        if (tid < 256) { if (o == 0) { z1 = x1 * (y + v * C.in[I_HSKIP][(size_t)i * 1024 + c]); Z[tid] = z1; }
            else { const float r = x2 * (y + z1 * C.in[I_HSKIP][(size_t)i * 1024 + 512 + c]);
                const bf16_t* GHY = (const bf16_t*)(C.ws + WS_GHY); bf16_t* HO = (bf16_t*)(C.ws + WS_HYOUT);
                HO[(size_t)(NLAT + tid) * 512 + c] = (bf16_t)f2bf(r * bf2f(GHY[(size_t)(NLAT + tid) * 512 + c])); } }
        SYNC();
    }
}

constexpr int SC_T = 32;
constexpr int SC_R = 16;
constexpr int SC_BUF = 5 * SC_T * 64 + SC_T * SC_R;
DEVFN void rwkv_scan(const Ctx& C, int i, int h, int d, int rq, bool ctx_out, unsigned char* lds, int max_chunks) {
    const int tid = C.tid;
    float* sBUF = (float*)lds; float* sY = sBUF + 2 * SC_BUF; float* sWV = sY + 2 * SC_T * SC_R;
    const bf16_t* U = (const bf16_t*)(C.ws + WS_U);
    const float* mu = C.in[I_MU] + (size_t)i * 1664;
    const float* w0 = C.in[I_W0] + ((size_t)i * 2 + d) * 512 + 64 * h; const float* a0 = C.in[I_A0] + ((size_t)i * 2 + d) * 512 + 64 * h;
    const float* wup = C.in[I_WUP] + ((size_t)i * 2 + d) * 32 * 512 + 64 * h; const float* aup = C.in[I_AUP] + ((size_t)i * 2 + d) * 32 * 512 + 64 * h;
    const float* k_k = C.in[I_KK] + (size_t)i * 512 + 64 * h; const float* k_a = C.in[I_KA] + (size_t)i * 512 + 64 * h; const float* r_k = C.in[I_RK] + (size_t)i * 512 + 64 * h;
    bf16_t* Yd = (bf16_t*)(C.ws + (d == 0 ? WS_YF : WS_YB));
    float* BON = (float*)(C.ws + WS_BONUS) + (size_t)d * NTOK * 8;
    const bool is_scan = tid < 256;
    const int nchunks = NTOK / SC_T < max_chunks ? NTOK / SC_T : max_chunks;
    #define CHUNK_GEOM(ch, seg0, segn, R0) const bool isctx_ = (ch) < NCTX / SC_T; const int seg0 = isctx_ ? NLAT : 0, segn = isctx_ ? NCTX : NLAT; \
        const int cl_ = isctx_ ? (ch) : (ch) - NCTX / SC_T; const int R0 = d == 0 ? SC_T * cl_ : segn - SC_T * (cl_ + 1);
    const int ft = (tid & 255) >> 3, fp = tid & 7;
    float* sCN = sWV + 4 * 1280; float* sCN_base_ = sCN;
    if (tid < 64) { const int j = tid; sCN[j] = mu[64 * h + j]; sCN[64 + j] = mu[512 + 64 * h + j]; sCN[128 + j] = mu[1024 + 64 * h + j]; sCN[192 + j] = w0[j]; sCN[256 + j] = a0[j];
        sCN[320 + j] = k_k[j]; sCN[384 + j] = k_a[j]; sCN[448 + j] = r_k[j]; sCN[512 + j] = j < 32 ? mu[1536 + 32 * d + j] : mu[1600 + 32 * d + (j - 32)]; }
    U4* sBF = (U4*)(sCN_base_ + 640);
    { const int m = tid >> 8, nt = (tid >> 6) & 3, ln = tid & 63; const float* src = m == 0 ? wup : aup; float f[8];
      UNR for (int j = 0; j < 8; ++j) f[j] = src[(size_t)(8 * (ln >> 4) + j) * 512 + 16 * nt + (ln & 15)];
      sBF[tid] = pack8(f); }
    float* myWV = sWV + ((tid >> 6) & 3) * 1280; float* sWL = myWV; float* sAL = myWV + 512; bf16_t* sTDb = (bf16_t*)(myWV + 1024); bf16_t* sADb = sTDb + 256;
    const int rl = (tid & 255) >> 4, sp = tid & 15;
    float S0 = 0.f, S1 = 0.f, S2 = 0.f, S3 = 0.f;
    SYNC();
    U4 pu[9]; U2 pw[6];
    auto issue = [&](int ch) {
        int tq_ = tid; OPAQUE(tq_); const int ft = (tq_ & 255) >> 3, fp = tq_ & 7;
        CHUNK_GEOM(ch, seg0, segn, R0)
        const int tl = d == 0 ? R0 + ft : R0 + SC_T - 1 - ft;
        const bf16_t* u0p = U + (size_t)(seg0 + tl) * URW_W;
        const bool hm = tl > 0, hp = tl < segn - 1;
        const U4 z4 = {0u, 0u, 0u, 0u}; const U2 z2 = {0u, 0u};
        const int cw = 1536 + 32 * d + 4 * fp, ca = 1600 + 32 * d + 4 * fp;
        UNR for (int j = 0; j < 3; ++j) { pu[3 * j] = ld16(u0p + 512 * j + 64 * h + 8 * fp); pu[3 * j + 1] = z4; pu[3 * j + 2] = z4; }
        pw[0] = *(const U2*)(u0p + cw); pw[3] = *(const U2*)(u0p + ca); pw[1] = z2; pw[2] = z2; pw[4] = z2; pw[5] = z2;
        if (hm) { UNR for (int j = 0; j < 3; ++j) pu[3 * j + 1] = ld16(u0p - URW_W + 512 * j + 64 * h + 8 * fp); pw[1] = *(const U2*)(u0p - URW_W + cw); pw[4] = *(const U2*)(u0p - URW_W + ca); }
        if (hp) { UNR for (int j = 0; j < 3; ++j) pu[3 * j + 2] = ld16(u0p + URW_W + 512 * j + 64 * h + 8 * fp); pw[2] = *(const U2*)(u0p + URW_W + cw); pw[5] = *(const U2*)(u0p + URW_W + ca); }
    };
    auto features = [&](int ch) {
        int tq_ = tid; OPAQUE(tq_); const int ft = (tq_ & 255) >> 3, fp = tq_ & 7;
        const float* mu_r = sCN + 8 * fp; const float* mu_k = sCN + 64 + 8 * fp; const float* mu_v = sCN + 128 + 8 * fp; const float* c_w0 = sCN + 192 + 8 * fp; const float* c_a0 = sCN + 256 + 8 * fp;
        const float* c_kk = sCN + 320 + 8 * fp; const float* c_ka = sCN + 384 + 8 * fp; const float* c_rk = sCN + 448 + 8 * fp; const float* mu_w = sCN + 512 + 4 * fp; const float* mu_a = sCN + 544 + 4 * fp;
        CHUNK_GEOM(ch, seg0, segn, R0)
        float* B_ = sBUF + (ch & 1) * SC_BUF; float* sW = B_; float* sKD = B_ + SC_T * 64; float* sB = B_ + 2 * SC_T * 64; float* sKK = B_ + 3 * SC_T * 64; float* sR = B_ + 4 * SC_T * 64; float* sV = B_ + 5 * SC_T * 64;
        const int tl = d == 0 ? R0 + ft : R0 + SC_T - 1 - ft;
        float r[8], k[8], v[8];
        {
            float a[8], m[8], p[8];
            #define SHIFT3(J, MU, OUT) do { unpack8(pu[3 * (J)], a); unpack8(pu[3 * (J) + 1], m); unpack8(pu[3 * (J) + 2], p); \
                UNR for (int e = 0; e < 8; ++e) OUT[e] = a[e] + (0.5f * (m[e] + p[e]) - a[e]) * MU[e]; } while (0)
            SHIFT3(0, mu_r, r); SHIFT3(1, mu_k, k); SHIFT3(2, mu_v, v);
            #undef SHIFT3
        }
        {
            const U2 w0_ = pw[0], wm = pw[1], wp = pw[2], a0_ = pw[3], am = pw[4], ap = pw[5];
            const float wa[4] = {bflo(w0_.x), bfhi(w0_.x), bflo(w0_.y), bfhi(w0_.y)}, wmm[4] = {bflo(wm.x), bfhi(wm.x), bflo(wm.y), bfhi(wm.y)}, wpp[4] = {bflo(wp.x), bfhi(wp.x), bflo(wp.y), bfhi(wp.y)};
            const float aa[4] = {bflo(a0_.x), bfhi(a0_.x), bflo(a0_.y), bfhi(a0_.y)}, amm[4] = {bflo(am.x), bfhi(am.x), bflo(am.y), bfhi(am.y)}, app[4] = {bflo(ap.x), bfhi(ap.x), bflo(ap.y), bfhi(ap.y)};
            if (ch + 1 < nchunks) issue(ch + 1);
            const int tw = ft & 7;
            float tdv[4], adv[4];
            UNR for (int e = 0; e < 4; ++e) { const float x = wa[e] + (0.5f * (wmm[e] + wpp[e]) - wa[e]) * mu_w[e];
                tdv[e] = 1.0f - 2.0f * FRCP(1.0f + FEXP(2.0f * x));
                adv[e] = aa[e] + (0.5f * (amm[e] + app[e]) - aa[e]) * mu_a[e]; }
            U2 tq, aq; tq.x = pk2(tdv[0], tdv[1]); tq.y = pk2(tdv[2], tdv[3]); aq.x = pk2(adv[0], adv[1]); aq.y = pk2(adv[2], adv[3]);
            *(U2*)(sTDb + tw * 32 + 4 * fp) = tq; *(U2*)(sADb + tw * 32 + 4 * fp) = aq;
        }
        WAVE_SYNC();
        float wl[8], al[8];
        {
            const int lane = tid & 63, arow = lane & 7, kg = lane >> 4;
            const U4 ta = ld16(sTDb + arow * 32 + 8 * kg), aa_ = ld16(sADb + arow * 32 + 8 * kg);
            H8 At, Aa;
            H8_SET(At, 0, ta.x & 0xffff); H8_SET(At, 1, ta.x >> 16); H8_SET(At, 2, ta.y & 0xffff); H8_SET(At, 3, ta.y >> 16); H8_SET(At, 4, ta.z & 0xffff); H8_SET(At, 5, ta.z >> 16); H8_SET(At, 6, ta.w & 0xffff); H8_SET(At, 7, ta.w >> 16);
            H8_SET(Aa, 0, aa_.x & 0xffff); H8_SET(Aa, 1, aa_.x >> 16); H8_SET(Aa, 2, aa_.y & 0xffff); H8_SET(Aa, 3, aa_.y >> 16); H8_SET(Aa, 4, aa_.z & 0xffff); H8_SET(Aa, 5, aa_.z >> 16); H8_SET(Aa, 6, aa_.w & 0xffff); H8_SET(Aa, 7, aa_.w >> 16);
            A4 cw_[4], ca_[4];
            UNR for (int nt = 0; nt < 4; ++nt) {
                A4 z; A4_GET(z, 0) = 0.f; A4_GET(z, 1) = 0.f; A4_GET(z, 2) = 0.f; A4_GET(z, 3) = 0.f;
                cw_[nt] = mfma16(At, h8_from_u4(sBF[nt * 64 + (tid & 63)]), z); ca_[nt] = mfma16(Aa, h8_from_u4(sBF[(4 + nt) * 64 + (tid & 63)]), z);
            }
            MFMA_PAD(cw_[0], cw_[1], cw_[2], cw_[3], ca_[0], ca_[1], ca_[2], ca_[3]);
            if (lane < 32) { UNR for (int nt = 0; nt < 4; ++nt) UNR for (int rg = 0; rg < 4; ++rg) { const int tok = 4 * (lane >> 4) + rg; sWL[tok * 64 + 16 * nt + (lane & 15)] = A4_GET(cw_[nt], rg); sAL[tok * 64 + 16 * nt + (lane & 15)] = A4_GET(ca_[nt], rg); } }
            WAVE_SYNC();
            const int tw = ft & 7;
            { const F4 w0_ = *(const F4*)(sWL + tw * 64 + 8 * fp), w1_ = *(const F4*)(sWL + tw * 64 + 8 * fp + 4), a0_ = *(const F4*)(sAL + tw * 64 + 8 * fp), a1_ = *(const F4*)(sAL + tw * 64 + 8 * fp + 4);
              const F4 cw0 = *(const F4*)(c_w0), cw1 = *(const F4*)(c_w0 + 4), ca0 = *(const F4*)(c_a0), ca1 = *(const F4*)(c_a0 + 4);
              wl[0] = cw0.x + w0_.x; wl[1] = cw0.y + w0_.y; wl[2] = cw0.z + w0_.z; wl[3] = cw0.w + w0_.w; wl[4] = cw1.x + w1_.x; wl[5] = cw1.y + w1_.y; wl[6] = cw1.z + w1_.z; wl[7] = cw1.w + w1_.w;
              al[0] = ca0.x + a0_.x; al[1] = ca0.y + a0_.y; al[2] = ca0.z + a0_.z; al[3] = ca0.w + a0_.w; al[4] = ca1.x + a1_.x; al[5] = ca1.y + a1_.y; al[6] = ca1.z + a1_.z; al[7] = ca1.w + a1_.w; }
            WAVE_SYNC();
        }
        float kkv[8], ssq = 0.f;
        UNR for (int e = 0; e < 8; ++e) { kkv[e] = k[e] * c_kk[e]; ssq += kkv[e] * kkv[e]; }
        ssq = rowx_add<1>(ssq); ssq = rowx_add<2>(ssq); ssq = rowx_add<7>(ssq);
        const float kn = FRSQ(ssq + 1e-12f);
        float bon = 0.f; float o_w[8], o_kd[8], o_b[8], o_kk[8];
        UNR for (int e = 0; e < 8; ++e) {
            const float dec = FEXP(-0.60653066f * FRCP(1.0f + FEXP(-wl[e])));
            const float a = FRCP(1.0f + FEXP(-al[e]));
            const float kd = k[e] * (1.0f + (a - 1.0f) * c_ka[e]);
            const float kk = kkv[e] * kn;
            o_w[e] = dec; o_kd[e] = kd; o_b[e] = kk * a; o_kk[e] = kk;
            bon += r[e] * kd * c_rk[e];
        }
        { const int o = ft * 64 + 8 * fp;
          #define ST8(P, A) do { F4 x0_, x1_; x0_.x = A[0]; x0_.y = A[1]; x0_.z = A[2]; x0_.w = A[3]; x1_.x = A[4]; x1_.y = A[5]; x1_.z = A[6]; x1_.w = A[7]; *(F4*)((P) + o) = x0_; *(F4*)((P) + o + 4) = x1_; } while (0)
          ST8(sW, o_w); ST8(sKD, o_kd); ST8(sB, o_b); ST8(sKK, o_kk); ST8(sR, r);
          #undef ST8
        }
        if ((fp >> 1) == rq) { UNR for (int e = 0; e < 8; ++e) sV[ft * SC_R + 8 * (fp & 1) + e] = v[e]; }
        bon = rowx_add<1>(bon); bon = rowx_add<2>(bon); bon = rowx_add<7>(bon);
        if (fp == 0 && rq == 0) BON[(size_t)(seg0 + tl) * 8 + h] = 0.5f * bon;
    };
    auto store_y = [&](int ch) {
        CHUNK_GEOM(ch, seg0, segn, R0)
        if (isctx_ && !ctx_out) return;
        const float* Yb = sY + (ch & 1) * SC_T * SC_R;
        const int k = (tid & 255) >> 3, q = (tid & 7) * 2; const int tl = d == 0 ? R0 + k : R0 + SC_T - 1 - k;
        *(unsigned*)(Yd + (size_t)(seg0 + tl) * 512 + 64 * h + SC_R * rq + q) = pk2(Yb[k * SC_R + q], Yb[k * SC_R + q + 1]);
    };
    if (!is_scan) { issue(0); features(0); }
    SYNC();
    if (C.wave < 4) SETPRIO(3);
    TACC_DECL;
    for (int ch = 0; ch < nchunks; ++ch) {
        TACC_BEGIN;
        if (is_scan) {
            const float* B_ = sBUF + (ch & 1) * SC_BUF; const float* sW = B_; const float* sKD = B_ + SC_T * 64; const float* sB = B_ + 2 * SC_T * 64; const float* sKK = B_ + 3 * SC_T * 64; const float* sR = B_ + 4 * SC_T * 64; const float* sV = B_ + 5 * SC_T * 64;
            float* Yb = sY + (ch & 1) * SC_T * SC_R;
            float yk0 = 0.f, yk1 = 0.f, yp = 0.f;
#ifndef EMU
            {
                const unsigned ab = (unsigned)(uintptr_t)B_ + 16u * (unsigned)sp, av = (unsigned)(uintptr_t)sV + 4u * (unsigned)rl;
                P2 s01 = {S0, S1}, s23 = {S2, S3};
                asm volatile(SCAN_CHUNK_ASM : [s01] "+v"(s01), [s23] "+v"(s23), [yp] "+v"(yp), [yk0] "+v"(yk0), [yk1] "+v"(yk1) : [ab] "v"(ab), [av] "v"(av), [sp] "v"(sp) : SCAN_CHUNK_CLOBBERS);
                S0 = s01[0]; S1 = s01[1]; S2 = s23[0]; S3 = s23[1];
            }
#else
            for (int k = 0; k < SC_T; ++k) {
                const F4 kk4 = *(const F4*)(sKK + k * 64 + 4 * sp), w4 = *(const F4*)(sW + k * 64 + 4 * sp), b4 = *(const F4*)(sB + k * 64 + 4 * sp),
                         kd4 = *(const F4*)(sKD + k * 64 + 4 * sp), r4 = *(const F4*)(sR + k * 64 + 4 * sp);
                const float vi = sV[k * SC_R + rl];
                float sa = (S0 * kk4.x + S2 * kk4.z) + (S1 * kk4.y + S3 * kk4.w);
                const float t0 = S0 * w4.x + vi * kd4.x, t1 = S1 * w4.y + vi * kd4.y, t2 = S2 * w4.z + vi * kd4.z, t3 = S3 * w4.w + vi * kd4.w;
                sa = rowx_add<1>(sa); yp = rowx_add<1>(yp); sa = rowx_add<2>(sa); yp = rowx_add<2>(yp);
                sa = rowx_add<7>(sa); yp = rowx_add<7>(yp); sa = rowx_add<15>(sa); yp = rowx_add<15>(yp);
                if (sp == ((k + 15) & 15)) { if (k <= 16) yk0 = yp; else yk1 = yp; }
                S0 = t0 - sa * b4.x; S1 = t1 - sa * b4.y; S2 = t2 - sa * b4.z; S3 = t3 - sa * b4.w;
                yp = (S0 * r4.x + S2 * r4.z) + (S1 * r4.y + S3 * r4.w);
            }
#endif
            yp = rowx_add<1>(yp); yp = rowx_add<2>(yp); yp = rowx_add<7>(yp); yp = rowx_add<15>(yp);
            if (sp == 15) yk1 = yp;
            Yb[sp * SC_R + rl] = yk0; Yb[(sp + 16) * SC_R + rl] = yk1;
        } else {
            if (ch + 1 < nchunks) features(ch + 1);
            if (ch > 0) store_y(ch - 1);
        }
        TACC_END;
        SYNC();
    }
    TACC_STORE(C, is_scan ? 45 : 46, C.vcu == 0 && (tid == 0 || tid == 256));
    if (C.wave < 4) SETPRIO(0);
    if (!is_scan) store_y(nchunks - 1);
    #undef CHUNK_GEOM
}

DEVFN void ph_readout_hyout(const Ctx& C, int i, bool do_ctx, unsigned char* lds) {
    const int tid = C.tid;
    {
        const bf16_t* U = (const bf16_t*)(C.ws + WS_U); bf16_t* YF = (bf16_t*)(C.ws + WS_YF); const bf16_t* YB = (const bf16_t*)(C.ws + WS_YB);
        const float* BON = (const float*)(C.ws + WS_BONUS);
        const float* mu = C.in[I_MU] + (size_t)i * 1664 + 1024; const float* gnw = C.in[I_GNW] + (size_t)i * 512; const float* gnb = C.in[I_GNB] + (size_t)i * 512;
        const int rl = tid >> 6, c8 = (tid & 63) * 8, h = (tid & 63) >> 3;
        float muv[8], gw_[8], gb_[8];
        UNR for (int e = 0; e < 8; ++e) { muv[e] = mu[c8 + e]; gw_[e] = gnw[c8 + e]; gb_[e] = gnb[c8 + e]; }
        const int nrows = do_ctx ? NTOK : NLAT;
        for (int r0 = C.vcu * 8; r0 < nrows; r0 += C.G * 8) {
            const int row = r0 + rl; const bool isctx = row >= NLAT; const int seg0 = isctx ? NLAT : 0, segn = isctx ? NCTX : NLAT, tl = row - seg0;
            float yf[8], yb[8], y[8], a[8], m[8], p[8], g[8];
            unpack8(ld16(YF + (size_t)row * 512 + c8), yf); unpack8(ld16(YB + (size_t)row * 512 + c8), yb);
            float s = 0.f; UNR for (int e = 0; e < 8; ++e) { y[e] = yf[e] + yb[e]; s += y[e]; }
            s = rowx_add<1>(s); s = rowx_add<2>(s); s = rowx_add<7>(s);
            const float mean = s * (1.0f / 64.0f); float q = 0.f;
            UNR for (int e = 0; e < 8; ++e) { y[e] -= mean; q += y[e] * y[e]; }
            q = rowx_add<1>(q); q = rowx_add<2>(q); q = rowx_add<7>(q);
            const float rstd = 1.0f / sqrtf(q * (1.0f / 64.0f) + 64e-5f);
            const bf16_t* up = U + (size_t)row * URW_W + 1024 + c8;
            unpack8(ld16(up), a);
            if (tl > 0) unpack8(ld16(up - URW_W), m); else UNR for (int e = 0; e < 8; ++e) m[e] = 0.f;
            if (tl < segn - 1) unpack8(ld16(up + URW_W), p); else UNR for (int e = 0; e < 8; ++e) p[e] = 0.f;
            unpack8(ld16(U + (size_t)row * URW_W + 1664 + c8), g);
            const float bon = BON[(size_t)row * 8 + h] + BON[(size_t)NTOK * 8 + (size_t)row * 8 + h];
            float o[8];
            UNR for (int e = 0; e < 8; ++e) { const float v = a[e] + (0.5f * (m[e] + p[e]) - a[e]) * muv[e]; o[e] = (y[e] * rstd * gw_[e] + gb_[e] + bon * v) * g[e]; }
            st16(YF + (size_t)row * 512 + c8, pack8(o));
        }
    }
    {
        const bf16_t* YHY = (const bf16_t*)(C.ws + WS_YHY); const bf16_t* GHY = (const bf16_t*)(C.ws + WS_GHY); bf16_t* HO = (bf16_t*)(C.ws + WS_HYOUT);
        float* T = (float*)lds;
        for (int it = C.vcu; it < 256 * 8; it += C.G) {
            const int tb = it >> 3, cb = it & 7;
            { const int cl = tid >> 3, t8 = (tid & 7) * 8; float v[8]; unpack8(ld16(YHY + (size_t)(64 * cb + cl) * NLAT + 64 * tb + t8), v); UNR for (int e = 0; e < 8; ++e) T[cl * 65 + t8 + e] = v[e]; }
            SYNC();
            { const int tl = tid >> 3, c8 = (tid & 7) * 8; float g[8], o[8]; const size_t off = (size_t)(64 * tb + tl) * 512 + 64 * cb + c8;
              unpack8(ld16(GHY + off), g); UNR for (int e = 0; e < 8; ++e) o[e] = T[(c8 + e) * 65 + tl] * g[e]; st16(HO + off, pack8(o)); }
            SYNC();
        }
    }
}

constexpr int RC_T = 16, RC_RING = 7, RC_NPROD = 6;
constexpr int RS_KKD = 0, RS_RD = 2048, RS_KIT = 4096, RS_NBIT = 6144, RS_VT = 8192, RS_T = 9216, RS_P0 = 9728, RS_Q1 = 10240, RS_NQ2 = 10752, RS_GC = 11264, RS_BYTES = 11520;
constexpr int RW_TDAD = 0, RW_WL = 2048, RW_AL = 6144, RW_KIP = 2048, RW_BIP = 4096, RW_AM = 10240, RW_BYTES = 11264;
constexpr int RC_LDS_RING = 0, RC_LDS_WAVE = RC_RING * RS_BYTES, RC_LDS_BFR = RC_LDS_WAVE + RC_NPROD * RW_BYTES, RC_LDS_FLAGS = RC_LDS_BFR + 8192, RC_LDS_END = RC_LDS_FLAGS + 3 * 8 * 4;
static_assert(RC_LDS_END <= RING_BYTES, "rwkv chunked LDS");
#ifdef EMU
#include <sched.h>
#define SPIN_WAIT(cond) do { while (!(cond)) sched_yield(); __sync_synchronize(); } while (0)
#define LDS_FENCE() __sync_synchronize()
#else
#define SPIN_WAIT(cond) do { while (!(cond)) __builtin_amdgcn_s_sleep(1); asm volatile("" ::: "memory"); } while (0)
#define LDS_FENCE() asm volatile("s_waitcnt lgkmcnt(0)" ::: "memory")
#endif
#ifdef EMU
DEVFN float wave_sum_fast(float v) { v = rowx_add<1>(v); v = rowx_add<2>(v); v = rowx_add<7>(v); v = rowx_add<15>(v); return (shfl_f(v, 0) + shfl_f(v, 16)) + (shfl_f(v, 32) + shfl_f(v, 48)); }
#else
DEVFN float wave_sum_fast(float v) { v = rowx_add<1>(v); v = rowx_add<2>(v); v = rowx_add<7>(v); v = rowx_add<15>(v);
    const int i_ = __builtin_bit_cast(int, v);
    return (__builtin_bit_cast(float, __builtin_amdgcn_readlane(i_, 0)) + __builtin_bit_cast(float, __builtin_amdgcn_readlane(i_, 16))) + (__builtin_bit_cast(float, __builtin_amdgcn_readlane(i_, 32)) + __builtin_bit_cast(float, __builtin_amdgcn_readlane(i_, 48))); }
#endif
DEVFN int rc_pos(int k) { return (k & 32) | (((k >> 2) & 3) << 3) | (((k >> 4) & 1) << 2) | (k & 3); }
DEVFN H8 h8_from(U4 w) { H8 r; H8_SET(r, 0, w.x & 0xffff); H8_SET(r, 1, w.x >> 16); H8_SET(r, 2, w.y & 0xffff); H8_SET(r, 3, w.y >> 16); H8_SET(r, 4, w.z & 0xffff); H8_SET(r, 5, w.z >> 16); H8_SET(r, 6, w.w & 0xffff); H8_SET(r, 7, w.w >> 16); return r; }
DEVFN H8 h8_lo4(U2 w) { H8 r; H8_SET(r, 0, w.x & 0xffff); H8_SET(r, 1, w.x >> 16); H8_SET(r, 2, w.y & 0xffff); H8_SET(r, 3, w.y >> 16); H8_SET(r, 4, 0); H8_SET(r, 5, 0); H8_SET(r, 6, 0); H8_SET(r, 7, 0); return r; }
DEVFN H8 h8_zero() { H8 r; UNR for (int j = 0; j < 8; ++j) H8_SET(r, j, 0); return r; }
DEVFN H8 h8_pack2(const A4& a, const A4& b) { H8 r; UNR for (int j = 0; j < 4; ++j) { H8_SET(r, j, f2bf(A4_GET(a, j))); H8_SET(r, 4 + j, f2bf(A4_GET(b, j))); } return r; }
DEVFN H8 h8_pack1(const A4& a) { H8 r; UNR for (int j = 0; j < 4; ++j) { H8_SET(r, j, f2bf(A4_GET(a, j))); H8_SET(r, 4 + j, 0); } return r; }
DEVFN A4 a4_zero() { A4 z; A4_GET(z, 0) = 0.f; A4_GET(z, 1) = 0.f; A4_GET(z, 2) = 0.f; A4_GET(z, 3) = 0.f; return z; }

DEVFN void rwkv_chunked(const Ctx& C, int i, int h, int d, int vh, bool ctx_out, unsigned char* lds, int max_chunks) {
    const int tid = C.tid, lane = tid & 63, wave = tid >> 6;
    volatile unsigned* fl_ready = (volatile unsigned*)(lds + RC_LDS_FLAGS); volatile unsigned* fl_done0 = fl_ready + 8; volatile unsigned* fl_done1 = fl_done0 + 8;
    if (tid < 24) fl_ready[tid] = 0u;
    { U4* sBF = (U4*)(lds + RC_LDS_BFR); const int m = tid >> 8, nt = (tid >> 6) & 3, ln = tid & 63;
      const float* src = (m == 0 ? C.in[I_WUP] : C.in[I_AUP]) + ((size_t)i * 2 + d) * 32 * 512 + 64 * h; float f[8];
      UNR for (int j = 0; j < 8; ++j) f[j] = src[(size_t)(8 * (ln >> 4) + j) * 512 + 16 * nt + (ln & 15)];
      sBF[tid] = pack8(f); }
    SYNC();
    const int nchunks = (NTOK / RC_T) < max_chunks ? (NTOK / RC_T) : max_chunks;
    bf16_t* Yd = (bf16_t*)(C.ws + (d == 0 ? WS_YF : WS_YB));
    #define RC_GEOM(ch, seg0, segn, R0) const bool isctx_ = (ch) < NCTX / RC_T; const int seg0 = isctx_ ? NLAT : 0, segn = isctx_ ? NCTX : NLAT; \
        const int cl_ = isctx_ ? (ch) : (ch) - NCTX / RC_T; const int R0 = d == 0 ? RC_T * cl_ : segn - RC_T * (cl_ + 1);
    if (wave < 2) {
        const int vt = wave, kg = lane >> 4, l15 = lane & 15;
        A4 H0_ = a4_zero(), H1_ = a4_zero(), H2_ = a4_zero(), H3_ = a4_zero();
        for (int ch = 0; ch < nchunks; ++ch) {
            const int slot = ch % RC_RING; const unsigned char* rb = lds + RC_LDS_RING + slot * RS_BYTES;
            SPIN_WAIT(fl_ready[slot] == (unsigned)(ch + 1));
            const H8 Hb0 = h8_pack2(H0_, H1_), Hb1 = h8_pack2(H2_, H3_);
            const H8 Vb = kg < 2 ? h8_from(ld16(rb + RS_VT + ((16 * vt + l15) * 16 + 8 * kg) * 2)) : h8_zero();
            const H8 kkd0 = h8_from(ld16(rb + RS_KKD + (l15 * 64 + 8 * kg) * 2)), kkd1 = h8_from(ld16(rb + RS_KKD + (l15 * 64 + 32 + 8 * kg) * 2));
            const H8 rd0 = h8_from(ld16(rb + RS_RD + (l15 * 64 + 8 * kg) * 2)), rd1 = h8_from(ld16(rb + RS_RD + (l15 * 64 + 32 + 8 * kg) * 2));
            const H8 p0f = kg < 2 ? h8_from(ld16(rb + RS_P0 + (l15 * 16 + 8 * kg) * 2)) : h8_zero();
            const H8 q1f = kg < 2 ? h8_from(ld16(rb + RS_Q1 + (l15 * 16 + 8 * kg) * 2)) : h8_zero();
            const H8 tf = h8_lo4(*(const U2*)(rb + RS_T + (l15 * 16 + 4 * kg) * 2)), nq2f = h8_lo4(*(const U2*)(rb + RS_NQ2 + (l15 * 16 + 4 * kg) * 2));
            A4 X = mfma16(kkd0, Hb0, a4_zero()); X = mfma16(kkd1, Hb1, X); X = mfma16(p0f, Vb, X);
            A4 Y = mfma16(rd0, Hb0, a4_zero()); Y = mfma16(rd1, Hb1, Y); Y = mfma16(q1f, Vb, Y);
            const H8 Xb = h8_pack1(X);
            const A4 U_ = mfma16(tf, Xb, a4_zero());
            const H8 Ub = h8_pack1(U_);
            Y = mfma16(nq2f, Ub, Y);
            #define HUPD(Hx, kt) do { const int kr = 16 * (kt) + l15; \
                const H8 kif = kg < 2 ? h8_from(ld16(rb + RS_KIT + (kr * 16 + 8 * kg) * 2)) : h8_zero(); const H8 nbf = h8_lo4(*(const U2*)(rb + RS_NBIT + (kr * 16 + 4 * kg) * 2)); \
                Hx = mfma16(kif, Vb, Hx); Hx = mfma16(nbf, Ub, Hx); const F4 g = *(const F4*)(rb + RS_GC + (16 * (kt) + 4 * kg) * 4); \
                A4_GET(Hx, 0) *= g.x; A4_GET(Hx, 1) *= g.y; A4_GET(Hx, 2) *= g.z; A4_GET(Hx, 3) *= g.w; } while (0)
            HUPD(H0_, 0); HUPD(H1_, 1); HUPD(H2_, 2); HUPD(H3_, 3);
            #undef HUPD
            LDS_FENCE(); WAVE_SYNC();
            if (lane == 0) { if (vt == 0) fl_done0[slot] = (unsigned)(ch + 1); else fl_done1[slot] = (unsigned)(ch + 1); }
            { RC_GEOM(ch, seg0, segn, R0)
              if (!isctx_ || ctx_out) { UNR for (int rg = 0; rg < 4; ++rg) { const int t = 4 * kg + rg, tl = d == 0 ? R0 + t : R0 + RC_T - 1 - t;
                  Yd[(size_t)(seg0 + tl) * 512 + 64 * h + 32 * vh + 16 * vt + l15] = (bf16_t)f2bf(A4_GET(Y, rg)); } } }
        }
    } else {
        const int p = wave - 2, k = lane;
        unsigned char* wsb = lds + RC_LDS_WAVE + p * RW_BYTES;
        bf16_t* sTDAD = (bf16_t*)(wsb + RW_TDAD); float* sWL = (float*)(wsb + RW_WL); float* sAL = (float*)(wsb + RW_AL); bf16_t* sKIP = (bf16_t*)(wsb + RW_KIP); bf16_t* sBIP = (bf16_t*)(wsb + RW_BIP); float* sAM = (float*)(wsb + RW_AM);
        const bf16_t* U = (const bf16_t*)(C.ws + WS_U);
        const float* mu = C.in[I_MU] + (size_t)i * 1664;
        const float mu_r = mu[64 * h + k], mu_k = mu[512 + 64 * h + k], mu_v = mu[1024 + 64 * h + k], mu_l = k < 32 ? mu[1536 + 32 * d + k] : mu[1600 + 32 * d + (k - 32)];
        const float c_w0 = C.in[I_W0][((size_t)i * 2 + d) * 512 + 64 * h + k], c_a0 = C.in[I_A0][((size_t)i * 2 + d) * 512 + 64 * h + k];
        const float c_kk = C.in[I_KK][(size_t)i * 512 + 64 * h + k], c_ka = C.in[I_KA][(size_t)i * 512 + 64 * h + k], c_rk = C.in[I_RK][(size_t)i * 512 + 64 * h + k];
        float* BON = (float*)(C.ws + WS_BONUS) + (size_t)d * NTOK * 8;
        const U4* sBF = (const U4*)(lds + RC_LDS_BFR);
        const int lcol = k < 32 ? 1536 + 32 * d + k : 1600 + 32 * d + (k - 32);
        const int kg = lane >> 4, l15 = lane & 15, pk_ = rc_pos(k);
        for (int ch = p; ch < nchunks; ch += RC_NPROD) {
            RC_GEOM(ch, seg0, segn, R0)
            float ur[18], uk[18], uv[18], ul[18];
            UNR for (int j = 0; j < 18; ++j) { const int row = d == 0 ? R0 - 1 + j : R0 + 16 - j; const bool ok = row >= 0 && row < segn; const bf16_t* up = U + (size_t)(seg0 + (ok ? row : R0)) * URW_W;
                const float m_ = ok ? 1.f : 0.f; ur[j] = m_ * bf2f(up[64 * h + k]); uk[j] = m_ * bf2f(up[512 + 64 * h + k]); uv[j] = m_ * bf2f(up[1024 + 64 * h + k]); ul[j] = m_ * bf2f(up[lcol]); }
            UNR for (int t = 0; t < 16; ++t) { const int j = t + 1; const float x = ul[j] + (0.5f * (ul[j - 1] + ul[j + 1]) - ul[j]) * mu_l;
                const float val = k < 32 ? 1.0f - 2.0f * FRCP(1.0f + FEXP(2.0f * x)) : x; sTDAD[t * 64 + k] = (bf16_t)f2bf(val); }
            WAVE_SYNC();
            {
                const H8 At = h8_from(ld16(sTDAD + l15 * 64 + 8 * kg)), Aa = h8_from(ld16(sTDAD + l15 * 64 + 32 + 8 * kg));
                A4 cw_[4], ca_[4];
                UNR for (int nt = 0; nt < 4; ++nt) { cw_[nt] = mfma16(At, h8_from(sBF[nt * 64 + lane]), a4_zero()); ca_[nt] = mfma16(Aa, h8_from(sBF[(4 + nt) * 64 + lane]), a4_zero()); }
                MFMA_PAD(cw_[0], cw_[1], cw_[2], cw_[3], ca_[0], ca_[1], ca_[2], ca_[3]);
                UNR for (int nt = 0; nt < 4; ++nt) UNR for (int rg = 0; rg < 4; ++rg) { sWL[(4 * kg + rg) * 64 + 16 * nt + l15] = A4_GET(cw_[nt], rg); sAL[(4 * kg + rg) * 64 + 16 * nt + l15] = A4_GET(ca_[nt], rg); }
            }
            WAVE_SYNC();
            float fr[16], fkd[16], fb[16], fkk[16], flw[16], fv[16];
            UNR for (int t = 0; t < 16; ++t) { const int j = t + 1;
                const float r_ = ur[j] + (0.5f * (ur[j - 1] + ur[j + 1]) - ur[j]) * mu_r, k_ = uk[j] + (0.5f * (uk[j - 1] + uk[j + 1]) - uk[j]) * mu_k, v_ = uv[j] + (0.5f * (uv[j - 1] + uv[j + 1]) - uv[j]) * mu_v;
                const float kkraw = k_ * c_kk; const float ss = wave_sum_fast(kkraw * kkraw); const float kk_ = kkraw * FRSQ(ss + 1e-12f);
                const float x = -(c_w0 + sWL[t * 64 + k]); const float sp_ = fmaxf(x, 0.f) + FLOG(1.0f + FEXP(-fabsf(x)));
                const float lw_ = -FEXP(-sp_ - 0.5f);
                const float a = FRCP(1.0f + FEXP(-(c_a0 + sAL[t * 64 + k])));
                const float kd_ = k_ * (1.0f + (a - 1.0f) * c_ka);
                fr[t] = r_; fkd[t] = kd_; fb[t] = kk_ * a; fkk[t] = kk_; flw[t] = lw_; fv[t] = v_;
                const float bon = wave_sum_fast(r_ * kd_ * c_rk);
                if (vh == 0 && lane == 0) { const int tl = d == 0 ? R0 + t : R0 + RC_T - 1 - t; BON[(size_t)(seg0 + tl) * 8 + h] = 0.5f * bon; }
            }
            WAVE_SYNC();
            const int slot = ch % RC_RING; unsigned char* rb = lds + RC_LDS_RING + slot * RS_BYTES;
            if (ch >= RC_RING) SPIN_WAIT(fl_done0[slot] == (unsigned)(ch - RC_RING + 1) && fl_done1[slot] == (unsigned)(ch - RC_RING + 1));
            {
                bf16_t* rKKD = (bf16_t*)(rb + RS_KKD); bf16_t* rRD = (bf16_t*)(rb + RS_RD); bf16_t* rKIT = (bf16_t*)(rb + RS_KIT); bf16_t* rNBIT = (bf16_t*)(rb + RS_NBIT); bf16_t* rVT = (bf16_t*)(rb + RS_VT);
                float L = 0.f, e_prev = 1.f;
                UNR for (int t = 0; t < 16; ++t) { L += flw[t]; const float e = FEXP(L), ei = FEXP(-L);
                    rKKD[t * 64 + pk_] = (bf16_t)f2bf(fkk[t] * e_prev); rRD[t * 64 + pk_] = (bf16_t)f2bf(fr[t] * e);
                    const float ki_ = fkd[t] * ei, bi_ = fb[t] * ei; sKIP[t * 64 + pk_] = (bf16_t)f2bf(ki_); sBIP[t * 64 + pk_] = (bf16_t)f2bf(bi_);
                    rKIT[k * 16 + t] = (bf16_t)f2bf(ki_); rNBIT[k * 16 + t] = (bf16_t)f2bf(-bi_);
                    e_prev = e; }
                ((float*)(rb + RS_GC))[k] = e_prev;
                U4 w0_, w1_;
                if ((k >> 5) == vh) { w0_.x = pk2(fv[0], fv[1]); w0_.y = pk2(fv[2], fv[3]); w0_.z = pk2(fv[4], fv[5]); w0_.w = pk2(fv[6], fv[7]); w1_.x = pk2(fv[8], fv[9]); w1_.y = pk2(fv[10], fv[11]); w1_.z = pk2(fv[12], fv[13]); w1_.w = pk2(fv[14], fv[15]);
                    st16(rVT + (k & 31) * 16, w0_); st16(rVT + (k & 31) * 16 + 8, w1_); }
            }
            WAVE_SYNC();
            {
                const bf16_t* rKKD = (const bf16_t*)(rb + RS_KKD); const bf16_t* rRD = (const bf16_t*)(rb + RS_RD);
                const H8 ak0 = h8_from(ld16(rKKD + l15 * 64 + 8 * kg)), ak1 = h8_from(ld16(rKKD + l15 * 64 + 32 + 8 * kg)), ar0 = h8_from(ld16(rRD + l15 * 64 + 8 * kg)), ar1 = h8_from(ld16(rRD + l15 * 64 + 32 + 8 * kg));
                const H8 bb0 = h8_from(ld16(sBIP + l15 * 64 + 8 * kg)), bb1 = h8_from(ld16(sBIP + l15 * 64 + 32 + 8 * kg)), bk0 = h8_from(ld16(sKIP + l15 * 64 + 8 * kg)), bk1 = h8_from(ld16(sKIP + l15 * 64 + 32 + 8 * kg));
                A4 mA = mfma16(ak0, bb0, a4_zero()); mA = mfma16(ak1, bb1, mA);
                A4 mP = mfma16(ak0, bk0, a4_zero()); mP = mfma16(ak1, bk1, mP);
                A4 mQ1 = mfma16(ar0, bk0, a4_zero()); mQ1 = mfma16(ar1, bk1, mQ1);
                A4 mQ2 = mfma16(ar0, bb0, a4_zero()); mQ2 = mfma16(ar1, bb1, mQ2);
                MFMA_PAD(mA, mP, mQ1, mQ2, mA, mP, mQ1, mQ2);
                bf16_t* rP0 = (bf16_t*)(rb + RS_P0); bf16_t* rQ1 = (bf16_t*)(rb + RS_Q1); bf16_t* rNQ2 = (bf16_t*)(rb + RS_NQ2);
                UNR for (int rg = 0; rg < 4; ++rg) { const int t = 4 * kg + rg, s_ = l15;
                    sAM[t * 16 + s_] = t > s_ ? A4_GET(mA, rg) : 0.f;
                    rP0[t * 16 + s_] = (bf16_t)f2bf(t > s_ ? A4_GET(mP, rg) : 0.f); rQ1[t * 16 + s_] = (bf16_t)f2bf(t >= s_ ? A4_GET(mQ1, rg) : 0.f); rNQ2[t * 16 + s_] = (bf16_t)f2bf(t >= s_ ? -A4_GET(mQ2, rg) : 0.f); }
            }
            WAVE_SYNC();
            {
                const int j = l15; float x[16]; bf16_t* rT = (bf16_t*)(rb + RS_T);
                UNR for (int t = 0; t < 16; ++t) { float acc = t == j ? 1.f : 0.f;
                    UNR for (int s_ = 0; s_ < 16; ++s_) if (s_ < t) acc -= sAM[t * 16 + s_] * x[s_];
                    x[t] = acc; if (lane < 16) rT[t * 16 + j] = (bf16_t)f2bf(acc); }
            }
            LDS_FENCE();
            WAVE_SYNC();
            if (lane == 0) fl_ready[slot] = (unsigned)(ch + 1);
        }
    }
    #undef RC_GEOM
    SYNC();
}
constexpr int FR_SLOTS = 20, FR_FLOATS = 6 * 2048, FR_LEAD = 20;
constexpr size_t WS_FRING = WS_HYOUT;
static_assert((size_t)16 * FR_SLOTS * FR_FLOATS * 4 <= (size_t)NLAT * 512 * 2, "feature ring fits");
constexpr size_t CTL_FFLAG = 65536, CTL_FPOS = CTL_FFLAG + 16 * 520 * 4 * 4;
constexpr int SC2_R = 8, SC2_NWG = 8;
static_assert(CTL_FPOS + 64 * 64 <= CTL_ZERO_BYTES, "control words");
#ifdef EMU
DEVFN unsigned gld_u32(const unsigned* p) { __sync_synchronize(); return *(volatile const unsigned*)p; }
DEVFN void gst_u32(unsigned* p, unsigned v) { __sync_synchronize(); *(volatile unsigned*)p = v; __sync_synchronize(); }
DEVFN unsigned long long gld_u64(const unsigned long long* p) { return *(volatile const unsigned long long*)p; }
DEVFN void gst_u64(unsigned long long* p, unsigned long long v) { *(volatile unsigned long long*)p = v; }
#define VM_DRAIN() __sync_synchronize()
#define GSPIN_WAIT(cond) do { while (!(cond)) sched_yield(); __sync_synchronize(); } while (0)
#else
DEVFN unsigned gld_u32(const unsigned* p) { return __hip_atomic_load(p, __ATOMIC_RELAXED, __HIP_MEMORY_SCOPE_AGENT); }
DEVFN void gst_u32(unsigned* p, unsigned v) { __hip_atomic_store(p, v, __ATOMIC_RELAXED, __HIP_MEMORY_SCOPE_AGENT); }
DEVFN unsigned long long gld_u64(const unsigned long long* p) { return __hip_atomic_load(p, __ATOMIC_RELAXED, __HIP_MEMORY_SCOPE_AGENT); }
DEVFN void gst_u64(unsigned long long* p, unsigned long long v) { __hip_atomic_store(p, v, __ATOMIC_RELAXED, __HIP_MEMORY_SCOPE_AGENT); }
#define VM_DRAIN() asm volatile("s_waitcnt vmcnt(0)" ::: "memory")
#define GSPIN_WAIT(cond) do { unsigned sp__ = 0; while (!(cond)) { __builtin_amdgcn_s_sleep(2); if (++sp__ > (1u << 22)) break; } asm volatile("" ::: "memory"); } while (0)
#endif
DEVFN unsigned long long f2_bits(float a, float b) { union { float f[2]; unsigned long long u; } x; x.f[0] = a; x.f[1] = b; return x.u; }

DEVFN void rwkv_scan2(const Ctx& C, int i, int h, int d, int rq, bool ctx_out, unsigned char* lds, int max_chunks) {
    const int tid = C.tid, lane = tid & 63, wave = C.wave;
    float* sBUF = (float*)lds;
    float* sWV = sBUF + 3 * SC_BUF;
    float* sCN = sWV + 4 * 1280;
    U4* sBF = (U4*)(sCN + 640);
    volatile unsigned* lf = (volatile unsigned*)((unsigned char*)sBF + 8192);
    const int hd = h * 2 + d;
    const unsigned epoch = (unsigned)(i + 1), pbase = (unsigned)i * 100000u;
    {
    const float* mu = C.in[I_MU] + (size_t)i * 1664;
    const float* w0 = C.in[I_W0] + ((size_t)i * 2 + d) * 512 + 64 * h; const float* a0 = C.in[I_A0] + ((size_t)i * 2 + d) * 512 + 64 * h;
    const float* wup = C.in[I_WUP] + ((size_t)i * 2 + d) * 32 * 512 + 64 * h; const float* aup = C.in[I_AUP] + ((size_t)i * 2 + d) * 32 * 512 + 64 * h;
    const float* k_k = C.in[I_KK] + (size_t)i * 512 + 64 * h; const float* k_a = C.in[I_KA] + (size_t)i * 512 + 64 * h; const float* r_k = C.in[I_RK] + (size_t)i * 512 + 64 * h;
    if (tid < 64) { const int j = tid; sCN[j] = mu[64 * h + j]; sCN[64 + j] = mu[512 + 64 * h + j]; sCN[128 + j] = mu[1024 + 64 * h + j]; sCN[192 + j] = w0[j]; sCN[256 + j] = a0[j];
        sCN[320 + j] = k_k[j]; sCN[384 + j] = k_a[j]; sCN[448 + j] = r_k[j]; sCN[512 + j] = j < 32 ? mu[1536 + 32 * d + j] : mu[1600 + 32 * d + (j - 32)]; }
    { const int m = tid >> 8, nt = (tid >> 6) & 3, ln = tid & 63; const float* src = m == 0 ? wup : aup; float f[8];
      UNR for (int j = 0; j < 8; ++j) f[j] = src[(size_t)(8 * (ln >> 4) + j) * 512 + 16 * nt + (ln & 15)];
      sBF[tid] = pack8(f); }
    }
    if (tid < 32) lf[tid] = 0u;
    SYNC();
    const int nchunks = NTOK / SC_T < max_chunks ? NTOK / SC_T : max_chunks;
    #define CHUNK_GEOM(ch, seg0, segn, R0) const bool isctx_ = (ch) < NCTX / SC_T; const int seg0 = isctx_ ? NLAT : 0, segn = isctx_ ? NCTX : NLAT; \
        const int cl_ = isctx_ ? (ch) : (ch) - NCTX / SC_T; const int R0 = d == 0 ? SC_T * cl_ : segn - SC_T * (cl_ + 1);
    if (wave < 2) {
        bf16_t* Yd = (bf16_t*)(C.ws + (d == 0 ? WS_YF : WS_YB));
        const int rl = tid >> 4, sp = tid & 15;
        float S0 = 0.f, S1 = 0.f, S2 = 0.f, S3 = 0.f;
        for (int ch = 0; ch < nchunks; ++ch) {
            const int b = ch % 3;
            SPIN_WAIT(lf[0 * 3 + b] == (unsigned)(ch + 1) && lf[1 * 3 + b] == (unsigned)(ch + 1));
            const float* B_ = sBUF + b * SC_BUF; const float* sV = B_ + 5 * SC_T * 64;
            float yk0 = 0.f, yk1 = 0.f, yp = 0.f;
#ifndef EMU
            {
                const unsigned ab = (unsigned)(uintptr_t)B_ + 16u * (unsigned)sp, av = (unsigned)(uintptr_t)sV + 4u * (unsigned)rl;
                P2 s01 = {S0, S1}, s23 = {S2, S3};
                asm volatile(SCAN_CHUNK_ASM : [s01] "+v"(s01), [s23] "+v"(s23), [yp] "+v"(yp), [yk0] "+v"(yk0), [yk1] "+v"(yk1) : [ab] "v"(ab), [av] "v"(av), [sp] "v"(sp) : SCAN_CHUNK_CLOBBERS);
                S0 = s01[0]; S1 = s01[1]; S2 = s23[0]; S3 = s23[1];
            }
#else
            { const float* sW = B_; const float* sKD = B_ + SC_T * 64; const float* sB = B_ + 2 * SC_T * 64; const float* sKK = B_ + 3 * SC_T * 64; const float* sR = B_ + 4 * SC_T * 64;
              for (int k = 0; k < SC_T; ++k) {
                const F4 kk4 = *(const F4*)(sKK + k * 64 + 4 * sp), w4 = *(const F4*)(sW + k * 64 + 4 * sp), b4 = *(const F4*)(sB + k * 64 + 4 * sp),
                         kd4 = *(const F4*)(sKD + k * 64 + 4 * sp), r4 = *(const F4*)(sR + k * 64 + 4 * sp);
                const float vi = sV[k * SC_R + rl];
                float sa = (S0 * kk4.x + S2 * kk4.z) + (S1 * kk4.y + S3 * kk4.w);
                const float t0 = S0 * w4.x + vi * kd4.x, t1 = S1 * w4.y + vi * kd4.y, t2 = S2 * w4.z + vi * kd4.z, t3 = S3 * w4.w + vi * kd4.w;
                sa = rowx_add<1>(sa); yp = rowx_add<1>(yp); sa = rowx_add<2>(sa); yp = rowx_add<2>(yp);
                sa = rowx_add<7>(sa); yp = rowx_add<7>(yp); sa = rowx_add<15>(sa); yp = rowx_add<15>(yp);
                if (sp == ((k + 15) & 15)) { if (k <= 16) yk0 = yp; else yk1 = yp; }
                S0 = t0 - sa * b4.x; S1 = t1 - sa * b4.y; S2 = t2 - sa * b4.z; S3 = t3 - sa * b4.w;
                yp = (S0 * r4.x + S2 * r4.z) + (S1 * r4.y + S3 * r4.w);
              } }
#endif
            LDS_FENCE(); WAVE_SYNC();
            if (lane == 0) lf[8 + wave * 3 + b] = (unsigned)(ch + 1);
            yp = rowx_add<1>(yp); yp = rowx_add<2>(yp); yp = rowx_add<7>(yp); yp = rowx_add<15>(yp);
            if (sp == 15) yk1 = yp;
            { CHUNK_GEOM(ch, seg0, segn, R0)
              if (!isctx_ || ctx_out) { const int t0 = d == 0 ? R0 + sp : R0 + SC_T - 1 - sp, t1 = d == 0 ? R0 + sp + 16 : R0 + SC_T - 1 - (sp + 16);
                  Yd[(size_t)(seg0 + t0) * 512 + 64 * h + SC2_R * rq + rl] = (bf16_t)f2bf(yk0); Yd[(size_t)(seg0 + t1) * 512 + 64 * h + SC2_R * rq + rl] = (bf16_t)f2bf(yk1); } }
        }
    } else if (wave < 6) {
        const int p = wave - 2;
        const bf16_t* U = (const bf16_t*)(C.ws + WS_U); float* BON = (float*)(C.ws + WS_BONUS) + (size_t)d * NTOK * 8;
        float* RING = (float*)(C.ws + WS_FRING) + (size_t)hd * FR_SLOTS * FR_FLOATS; unsigned* FFLAG = (unsigned*)(C.ws + WS_CTL + CTL_FFLAG) + (size_t)hd * 520 * 4; unsigned* FPOS = (unsigned*)(C.ws + WS_CTL + CTL_FPOS) + (size_t)hd * 64;
        float* myWV = sWV + p * 1280; float* sWL = myWV; float* sAL = myWV + 512; bf16_t* sTDb = (bf16_t*)(myWV + 1024); bf16_t* sADb = sTDb + 256;
        const int fp = lane & 7, tw = lane >> 3;
        const float* mu_r = sCN + 8 * fp; const float* mu_k = sCN + 64 + 8 * fp; const float* mu_v = sCN + 128 + 8 * fp; const float* c_w0 = sCN + 192 + 8 * fp; const float* c_a0 = sCN + 256 + 8 * fp;
        const float* c_kk = sCN + 320 + 8 * fp; const float* c_ka = sCN + 384 + 8 * fp; const float* c_rk = sCN + 448 + 8 * fp; const float* mu_w = sCN + 512 + 4 * fp; const float* mu_a = sCN + 544 + 4 * fp;
        U4 pu[9]; U2 pw[6];
        auto issue = [&](int q) {
            const int ch = rq + SC2_NWG * q; if (ch >= nchunks) return;
            CHUNK_GEOM(ch, seg0, segn, R0)
            const int ft = 8 * p + tw, tl = d == 0 ? R0 + ft : R0 + SC_T - 1 - ft;
            const bf16_t* u0p = U + (size_t)(seg0 + tl) * URW_W; const bool hm = tl > 0, hp = tl < segn - 1;
            const U4 z4 = {0u, 0u, 0u, 0u}; const U2 z2 = {0u, 0u};
            const int cw = 1536 + 32 * d + 4 * fp, ca = 1600 + 32 * d + 4 * fp;
            UNR for (int j = 0; j < 3; ++j) { pu[3 * j] = ld16(u0p + 512 * j + 64 * h + 8 * fp); pu[3 * j + 1] = z4; pu[3 * j + 2] = z4; }
            pw[0] = *(const U2*)(u0p + cw); pw[3] = *(const U2*)(u0p + ca); pw[1] = z2; pw[2] = z2; pw[4] = z2; pw[5] = z2;
            if (hm) { UNR for (int j = 0; j < 3; ++j) pu[3 * j + 1] = ld16(u0p - URW_W + 512 * j + 64 * h + 8 * fp); pw[1] = *(const U2*)(u0p - URW_W + cw); pw[4] = *(const U2*)(u0p - URW_W + ca); }
            if (hp) { UNR for (int j = 0; j < 3; ++j) pu[3 * j + 2] = ld16(u0p + URW_W + 512 * j + 64 * h + 8 * fp); pw[2] = *(const U2*)(u0p + URW_W + cw); pw[5] = *(const U2*)(u0p + URW_W + ca); }
        };
        issue(0);
        const int npass = (nchunks - rq + SC2_NWG - 1) / SC2_NWG;
        for (int q = 0; q < npass; ++q) {
            const int ch = rq + SC2_NWG * q;
            if (ch >= FR_SLOTS) { const unsigned need = pbase + (unsigned)(ch - FR_SLOTS + 1);
                GSPIN_WAIT(gld_u32(FPOS + 0) >= need && gld_u32(FPOS + 8) >= need && gld_u32(FPOS + 16) >= need && gld_u32(FPOS + 24) >= need && gld_u32(FPOS + 32) >= need && gld_u32(FPOS + 40) >= need && gld_u32(FPOS + 48) >= need && gld_u32(FPOS + 56) >= need); }
            CHUNK_GEOM(ch, seg0, segn, R0)
            float* rec = RING + (size_t)(ch % FR_SLOTS) * FR_FLOATS;
            {
                const int ft = 8 * p + tw;
                const int tl = d == 0 ? R0 + ft : R0 + SC_T - 1 - ft;
                float r[8], k[8], v[8];
                {
                    float a[8], m[8], qq[8];
                    #define SHIFT3(J, MU, OUT) do { unpack8(pu[3 * (J)], a); unpack8(pu[3 * (J) + 1], m); unpack8(pu[3 * (J) + 2], qq); \
                        UNR for (int e = 0; e < 8; ++e) OUT[e] = a[e] + (0.5f * (m[e] + qq[e]) - a[e]) * MU[e]; } while (0)
                    SHIFT3(0, mu_r, r); SHIFT3(1, mu_k, k); SHIFT3(2, mu_v, v);
                    #undef SHIFT3
                }
                {
                    const U2 w0_ = pw[0], wm = pw[1], wp = pw[2], a0_ = pw[3], am = pw[4], ap = pw[5];
                    const float wa[4] = {bflo(w0_.x), bfhi(w0_.x), bflo(w0_.y), bfhi(w0_.y)}, wmm[4] = {bflo(wm.x), bfhi(wm.x), bflo(wm.y), bfhi(wm.y)}, wpp[4] = {bflo(wp.x), bfhi(wp.x), bflo(wp.y), bfhi(wp.y)};
                    const float aa[4] = {bflo(a0_.x), bfhi(a0_.x), bflo(a0_.y), bfhi(a0_.y)}, amm[4] = {bflo(am.x), bfhi(am.x), bflo(am.y), bfhi(am.y)}, app[4] = {bflo(ap.x), bfhi(ap.x), bflo(ap.y), bfhi(ap.y)};
                    issue(q + 1);
                    float tdv[4], adv[4];
                    UNR for (int e = 0; e < 4; ++e) { const float x = wa[e] + (0.5f * (wmm[e] + wpp[e]) - wa[e]) * mu_w[e];
                        tdv[e] = 1.0f - 2.0f * FRCP(1.0f + FEXP(2.0f * x));
                        adv[e] = aa[e] + (0.5f * (amm[e] + app[e]) - aa[e]) * mu_a[e]; }
                    U2 tq, aq; tq.x = pk2(tdv[0], tdv[1]); tq.y = pk2(tdv[2], tdv[3]); aq.x = pk2(adv[0], adv[1]); aq.y = pk2(adv[2], adv[3]);
                    *(U2*)(sTDb + tw * 32 + 4 * fp) = tq; *(U2*)(sADb + tw * 32 + 4 * fp) = aq;
                }
                WAVE_SYNC();
                float wl[8], al[8];
                {
                    const int arow = lane & 7, kg = lane >> 4;
                    const H8 At = h8_from_u4(ld16(sTDb + arow * 32 + 8 * kg)), Aa = h8_from_u4(ld16(sADb + arow * 32 + 8 * kg));
                    A4 cw_[4], ca_[4];
                    UNR for (int nt = 0; nt < 4; ++nt) { A4 z; A4_GET(z, 0) = 0.f; A4_GET(z, 1) = 0.f; A4_GET(z, 2) = 0.f; A4_GET(z, 3) = 0.f;
                        cw_[nt] = mfma16(At, h8_from_u4(sBF[nt * 64 + lane]), z); ca_[nt] = mfma16(Aa, h8_from_u4(sBF[(4 + nt) * 64 + lane]), z); }
                    MFMA_PAD(cw_[0], cw_[1], cw_[2], cw_[3], ca_[0], ca_[1], ca_[2], ca_[3]);
                    if (lane < 32) { UNR for (int nt = 0; nt < 4; ++nt) UNR for (int rg = 0; rg < 4; ++rg) { const int tok = 4 * (lane >> 4) + rg; sWL[tok * 64 + 16 * nt + (lane & 15)] = A4_GET(cw_[nt], rg); sAL[tok * 64 + 16 * nt + (lane & 15)] = A4_GET(ca_[nt], rg); } }
                    WAVE_SYNC();
                    UNR for (int e = 0; e < 8; ++e) { wl[e] = c_w0[e] + sWL[tw * 64 + 8 * fp + e]; al[e] = c_a0[e] + sAL[tw * 64 + 8 * fp + e]; }
                    WAVE_SYNC();
                }
                float kkv[8], ssq = 0.f;
                UNR for (int e = 0; e < 8; ++e) { kkv[e] = k[e] * c_kk[e]; ssq += kkv[e] * kkv[e]; }
                ssq = rowx_add<1>(ssq); ssq = rowx_add<2>(ssq); ssq = rowx_add<7>(ssq);
                const float kn = FRSQ(ssq + 1e-12f);
                float bon = 0.f; float o_w[8], o_kd[8], o_b[8], o_kk[8];
                UNR for (int e = 0; e < 8; ++e) {
                    const float dec = FEXP(-0.60653066f * FRCP(1.0f + FEXP(-wl[e])));
                    const float a = FRCP(1.0f + FEXP(-al[e]));
                    const float kd = k[e] * (1.0f + (a - 1.0f) * c_ka[e]);
                    const float kk = kkv[e] * kn;
                    o_w[e] = dec; o_kd[e] = kd; o_b[e] = kk * a; o_kk[e] = kk;
                    bon += r[e] * kd * c_rk[e];
                }
                { unsigned long long* rp = (unsigned long long*)(rec + ft * 64 + 8 * fp);
                  #define ST8(AR, A) do { UNR for (int e2 = 0; e2 < 4; ++e2) gst_u64(rp + (AR) * 1024 + e2, f2_bits(A[2 * e2], A[2 * e2 + 1])); } while (0)
                  ST8(0, o_w); ST8(1, o_kd); ST8(2, o_b); ST8(3, o_kk); ST8(4, r); ST8(5, v);
                  #undef ST8
                }
                bon = rowx_add<1>(bon); bon = rowx_add<2>(bon); bon = rowx_add<7>(bon);
                if (fp == 0) BON[(size_t)(seg0 + tl) * 8 + h] = 0.5f * bon;
            }
            VM_DRAIN(); if (lane == 0) gst_u32(FFLAG + (size_t)ch * 4 + p, epoch);
        }
    } else {
        const int w = wave - 6;
        const float* RING = (const float*)(C.ws + WS_FRING) + (size_t)hd * FR_SLOTS * FR_FLOATS; unsigned* FFLAG = (unsigned*)(C.ws + WS_CTL + CTL_FFLAG) + (size_t)hd * 520 * 4; unsigned* FPOS = (unsigned*)(C.ws + WS_CTL + CTL_FPOS) + (size_t)hd * 64;
        for (int ch = 0; ch < nchunks; ++ch) {
            const int b = ch % 3;
            if (ch >= 3) SPIN_WAIT(lf[8 + 0 * 3 + b] == (unsigned)(ch - 2) && lf[8 + 1 * 3 + b] == (unsigned)(ch - 2));
            GSPIN_WAIT(gld_u32(FFLAG + (size_t)ch * 4) == epoch && gld_u32(FFLAG + (size_t)ch * 4 + 1) == epoch && gld_u32(FFLAG + (size_t)ch * 4 + 2) == epoch && gld_u32(FFLAG + (size_t)ch * 4 + 3) == epoch);
            const unsigned long long* rec = (const unsigned long long*)(RING + (size_t)(ch % FR_SLOTS) * FR_FLOATS);
            float* B_ = sBUF + b * SC_BUF;
            { unsigned long long x[40], xv[2];
              UNR for (int j = 0; j < 40; ++j) x[j] = gld_u64(rec + (size_t)w * 2560 + j * 64 + lane);
              { const int idx = w * 64 + lane, tok = idx >> 2, c2 = idx & 3; xv[0] = gld_u64(rec + 5 * 1024 + tok * 32 + 4 * rq + c2); xv[1] = 0ull; }
              UNR for (int j = 0; j < 40; ++j) ((unsigned long long*)B_)[(size_t)w * 2560 + j * 64 + lane] = x[j];
              { const int idx = w * 64 + lane, tok = idx >> 2, c2 = idx & 3; ((unsigned long long*)(B_ + 5 * SC_T * 64))[tok * 8 + c2] = xv[0]; } }
            LDS_FENCE(); WAVE_SYNC();
            if (lane == 0) { lf[w * 3 + b] = (unsigned)(ch + 1); if (w == 0) gst_u32(FPOS + 8 * rq, pbase + (unsigned)(ch + 1)); }
        }
    }
    #undef CHUNK_GEOM
    SYNC();
}
constexpr int R2S_KKD = 0, R2S_RD = 2048, R2S_KN = 4096, R2S_VT = 8192, R2S_T = 10240, R2S_P0 = 10752, R2S_QQ = 11264, R2S_GC = 12288, R2S_BYTES = 12544, R2S_U64 = R2S_BYTES / 8;
constexpr int PW_TDAD = 0, PW_AM = 0, PW_WL = 2048, PW_AL = 6144, PW_REC = 2048, PW_KIP = PW_REC + R2S_BYTES, PW_BIP = PW_KIP + 2048, PW_BYTES = PW_BIP + 2048;
static_assert(8 * PW_BYTES <= RING_BYTES, "producer LDS");
#define R2_SWZ(t, p) (((((p) >> 3) ^ (((t) >> 1) & 7)) << 3) | ((p) & 7))
constexpr int R2_GSLOTS = 64, R2_LSLOTS = 12, R2_NCH = NTOK / RC_T;
constexpr size_t WS_R2RING = WS_HYOUT;
static_assert((size_t)16 * R2_GSLOTS * R2S_BYTES <= (size_t)NLAT * 512 * 2, "record ring fits");
constexpr size_t CTL_R2FLAG = 65536, CTL_R2POS = CTL_R2FLAG + (size_t)16 * R2_NCH * 4;
static_assert(CTL_R2POS + 16 * 64 <= CTL_ZERO_BYTES, "control words");
constexpr size_t WS_BFRAG = WS_VXC + 1536 * 1024;
static_assert(WS_BFRAG + 2 * 16 * 8 * 64 * 16 <= WS_HID, "bfrag");

DEVFN void r2_build_bfrag(const Ctx& C) {
    const int gtid = (C.vcu * NWAVES + C.wave) * 64 + C.lane, gn = C.G * NTHREADS;
    for (int e = gtid; e < 2 * 16 * 8 * 64; e += gn) { const int ln = e & 63, nt = (e >> 6) & 3, m = (e >> 8) & 1, hd = (e >> 9) & 15, i = e >> 13; const int h = hd >> 1, d = hd & 1;
        const float* src = (m == 0 ? C.in[I_WUP] : C.in[I_AUP]) + ((size_t)i * 2 + d) * 32 * 512 + 64 * h; float f[8];
        UNR for (int j = 0; j < 8; ++j) f[j] = src[(size_t)(8 * (ln >> 4) + j) * 512 + 16 * nt + (ln & 15)];
        ((U4*)(C.ws + WS_BFRAG))[e] = pack8(f); }
}

DEVFN void rc2_producer(const Ctx& C, int i, unsigned char* lds, int pw, int npw, int hd0, int nhd, int max_chunks) {
    const int lane = C.lane, k = lane, kg = lane >> 4, l15 = lane & 15, pk_ = rc_pos(k);
    unsigned char* wsb = lds + C.wave * PW_BYTES;
    bf16_t* sTDAD = (bf16_t*)(wsb + PW_TDAD); float* sWL = (float*)(wsb + PW_WL); float* sAL = (float*)(wsb + PW_AL); bf16_t* sKIP = (bf16_t*)(wsb + PW_KIP); bf16_t* sBIP = (bf16_t*)(wsb + PW_BIP); float* sAM = (float*)(wsb + PW_AM);
    const bf16_t* U = (const bf16_t*)(C.ws + WS_U);
    const unsigned epoch = (unsigned)(i + 1), pbase = (unsigned)i * 100000u;
    const int nchunks = R2_NCH < max_chunks ? R2_NCH : max_chunks;
    const int nitems = nchunks * nhd;
    TACC_DECL;
    for (int item = pw; item < nitems; item += npw) {
        const int ch = item / nhd, hd = hd0 + item % nhd, h = hd >> 1, d = hd & 1;
        unsigned* POS = (unsigned*)(C.ws + WS_CTL + CTL_R2POS) + 16 * hd;
        if (ch >= R2_GSLOTS) { const int ow = ((ch - R2_GSLOTS) & 3); TACC_BEGIN; GSPIN_WAIT(gld_u32(POS + 1 + ow) >= pbase + (unsigned)(ch - R2_GSLOTS + 1)); TACC_END; }
        const float* mu = C.in[I_MU] + (size_t)i * 1664;
        const float mu_r = mu[64 * h + k], mu_k = mu[512 + 64 * h + k], mu_v = mu[1024 + 64 * h + k], mu_l = k < 32 ? mu[1536 + 32 * d + k] : mu[1600 + 32 * d + (k - 32)];
        const float c_w0 = C.in[I_W0][((size_t)i * 2 + d) * 512 + 64 * h + k], c_a0 = C.in[I_A0][((size_t)i * 2 + d) * 512 + 64 * h + k];
        const float c_kk = C.in[I_KK][(size_t)i * 512 + 64 * h + k], c_ka = C.in[I_KA][(size_t)i * 512 + 64 * h + k], c_rk = C.in[I_RK][(size_t)i * 512 + 64 * h + k];
        float* BON = (float*)(C.ws + WS_BONUS) + (size_t)d * NTOK * 8;
        const int lcol = k < 32 ? 1536 + 32 * d + k : 1600 + 32 * d + (k - 32);
        U4 bfw[4], bfa[4];
        { const U4* bt = (const U4*)(C.ws + WS_BFRAG) + ((size_t)i * 16 + hd) * 512; UNR for (int nt = 0; nt < 4; ++nt) { bfw[nt] = bt[nt * 64 + lane]; bfa[nt] = bt[(4 + nt) * 64 + lane]; } }
        const bool isctx_ = ch < NCTX / RC_T; const int seg0 = isctx_ ? NLAT : 0, segn = isctx_ ? NCTX : NLAT; const int cl_ = isctx_ ? ch : ch - NCTX / RC_T; const int R0 = d == 0 ? RC_T * cl_ : segn - RC_T * (cl_ + 1);
        {
            float ur[18], uk[18], uv[18], ul[18];
            UNR for (int j = 0; j < 18; ++j) { const int row = d == 0 ? R0 - 1 + j : R0 + 16 - j; const bool ok = row >= 0 && row < segn; const bf16_t* up = U + (size_t)(seg0 + (ok ? row : R0)) * URW_W;
                const float m_ = ok ? 1.f : 0.f; ur[j] = m_ * bf2f(up[64 * h + k]); uk[j] = m_ * bf2f(up[512 + 64 * h + k]); uv[j] = m_ * bf2f(up[1024 + 64 * h + k]); ul[j] = m_ * bf2f(up[lcol]); }
            UNR for (int t = 0; t < 16; ++t) { const int j = t + 1; const float x = ul[j] + (0.5f * (ul[j - 1] + ul[j + 1]) - ul[j]) * mu_l;
                const float val = k < 32 ? 1.0f - 2.0f * FRCP(1.0f + FEXP(2.0f * x)) : x; sTDAD[t * 64 + k] = (bf16_t)f2bf(val); }
            WAVE_SYNC();
            {
                const H8 At = h8_from(ld16(sTDAD + l15 * 64 + 8 * kg)), Aa = h8_from(ld16(sTDAD + l15 * 64 + 32 + 8 * kg));
                A4 cw_[4], ca_[4];
                UNR for (int nt = 0; nt < 4; ++nt) { cw_[nt] = mfma16(At, h8_from(bfw[nt]), a4_zero()); ca_[nt] = mfma16(Aa, h8_from(bfa[nt]), a4_zero()); }
                MFMA_PAD(cw_[0], cw_[1], cw_[2], cw_[3], ca_[0], ca_[1], ca_[2], ca_[3]);
                UNR for (int nt = 0; nt < 4; ++nt) UNR for (int rg = 0; rg < 4; ++rg) { sWL[(4 * kg + rg) * 64 + 16 * nt + l15] = A4_GET(cw_[nt], rg); sAL[(4 * kg + rg) * 64 + 16 * nt + l15] = A4_GET(ca_[nt], rg); }
            }
            WAVE_SYNC();
            float fr[16], fkd[16], fb[16], fkk[16], flw[16], fv[16];
            UNR for (int t = 0; t < 16; ++t) { const int j = t + 1;
                const float r_ = ur[j] + (0.5f * (ur[j - 1] + ur[j + 1]) - ur[j]) * mu_r, k_ = uk[j] + (0.5f * (uk[j - 1] + uk[j + 1]) - uk[j]) * mu_k, v_ = uv[j] + (0.5f * (uv[j - 1] + uv[j + 1]) - uv[j]) * mu_v;
                const float kkraw = k_ * c_kk; const float ss = wave_sum_fast(kkraw * kkraw); const float kk_ = kkraw * FRSQ(ss + 1e-12f);
                const float x = -(c_w0 + sWL[t * 64 + k]); const float sp_ = fmaxf(x, 0.f) + FLOG(1.0f + FEXP(-fabsf(x)));
                const float lw_ = -FEXP(-sp_ - 0.5f);
                const float a = FRCP(1.0f + FEXP(-(c_a0 + sAL[t * 64 + k])));
                const float kd_ = k_ * (1.0f + (a - 1.0f) * c_ka);
                fr[t] = r_; fkd[t] = kd_; fb[t] = kk_ * a; fkk[t] = kk_; flw[t] = lw_; fv[t] = v_;
                const float bon = wave_sum_fast(r_ * kd_ * c_rk);
                if (lane == 0) { const int tl = d == 0 ? R0 + t : R0 + RC_T - 1 - t; BON[(size_t)(seg0 + tl) * 8 + h] = 0.5f * bon; }
            }
            WAVE_SYNC();
            unsigned char* rb = wsb + PW_REC;
            {
                bf16_t* rKKD = (bf16_t*)(rb + R2S_KKD); bf16_t* rRD = (bf16_t*)(rb + R2S_RD); bf16_t* rKN = (bf16_t*)(rb + R2S_KN); bf16_t* rVT = (bf16_t*)(rb + R2S_VT);
                float L = 0.f, e_prev = 1.f;
                UNR for (int t = 0; t < 16; ++t) { L += flw[t]; const float e = FEXP(L), ei = FEXP(-L);
                    rKKD[t * 64 + R2_SWZ(t, pk_)] = (bf16_t)f2bf(fkk[t] * e_prev); rRD[t * 64 + R2_SWZ(t, pk_)] = (bf16_t)f2bf(fr[t] * e);
                    const float ki_ = fkd[t] * ei, bi_ = fb[t] * ei; sKIP[t * 64 + pk_] = (bf16_t)f2bf(ki_); sBIP[t * 64 + pk_] = (bf16_t)f2bf(bi_);
                    rKN[k * 32 + (t >> 2) * 8 + (t & 3)] = (bf16_t)f2bf(ki_); rKN[k * 32 + (t >> 2) * 8 + 4 + (t & 3)] = (bf16_t)f2bf(-bi_);
                    e_prev = e; }
                ((float*)(rb + R2S_GC))[k] = e_prev;
                U4 w0_, w1_;
                { w0_.x = pk2(fv[0], fv[1]); w0_.y = pk2(fv[2], fv[3]); w0_.z = pk2(fv[4], fv[5]); w0_.w = pk2(fv[6], fv[7]); w1_.x = pk2(fv[8], fv[9]); w1_.y = pk2(fv[10], fv[11]); w1_.z = pk2(fv[12], fv[13]); w1_.w = pk2(fv[14], fv[15]);
                    st16(rVT + k * 16, w0_); st16(rVT + k * 16 + 8, w1_); }
            }
            WAVE_SYNC();
            {
                const bf16_t* rKKD = (const bf16_t*)(rb + R2S_KKD); const bf16_t* rRD = (const bf16_t*)(rb + R2S_RD);
                const int sw0 = 8 * (kg ^ ((l15 >> 1) & 7)), sw1 = 8 * ((kg + 4) ^ ((l15 >> 1) & 7));
                const H8 ak0 = h8_from(ld16(rKKD + l15 * 64 + sw0)), ak1 = h8_from(ld16(rKKD + l15 * 64 + sw1)), ar0 = h8_from(ld16(rRD + l15 * 64 + sw0)), ar1 = h8_from(ld16(rRD + l15 * 64 + sw1));
                const H8 bb0 = h8_from(ld16(sBIP + l15 * 64 + 8 * kg)), bb1 = h8_from(ld16(sBIP + l15 * 64 + 32 + 8 * kg)), bk0 = h8_from(ld16(sKIP + l15 * 64 + 8 * kg)), bk1 = h8_from(ld16(sKIP + l15 * 64 + 32 + 8 * kg));
                A4 mA = mfma16(ak0, bb0, a4_zero()); mA = mfma16(ak1, bb1, mA);
                A4 mP = mfma16(ak0, bk0, a4_zero()); mP = mfma16(ak1, bk1, mP);
                A4 mQ1 = mfma16(ar0, bk0, a4_zero()); mQ1 = mfma16(ar1, bk1, mQ1);
                A4 mQ2 = mfma16(ar0, bb0, a4_zero()); mQ2 = mfma16(ar1, bb1, mQ2);
                MFMA_PAD(mA, mP, mQ1, mQ2, mA, mP, mQ1, mQ2);
                bf16_t* rP0 = (bf16_t*)(rb + R2S_P0); bf16_t* rQQ = (bf16_t*)(rb + R2S_QQ);
                UNR for (int rg = 0; rg < 4; ++rg) { const int t = 4 * kg + rg, s_ = l15;
                    sAM[t * 16 + s_] = t > s_ ? A4_GET(mA, rg) : 0.f;
                    rP0[t * 16 + s_] = (bf16_t)f2bf(t > s_ ? A4_GET(mP, rg) : 0.f); rQQ[t * 32 + (s_ >> 2) * 8 + (s_ & 3)] = (bf16_t)f2bf(t >= s_ ? A4_GET(mQ1, rg) : 0.f); rQQ[t * 32 + (s_ >> 2) * 8 + 4 + (s_ & 3)] = (bf16_t)f2bf(t >= s_ ? -A4_GET(mQ2, rg) : 0.f); }
            }
            WAVE_SYNC();
            {
                const int j = l15; float x[16]; bf16_t* rT = (bf16_t*)(rb + R2S_T);
                UNR for (int t = 0; t < 16; ++t) { float acc = t == j ? 1.f : 0.f;
                    UNR for (int s_ = 0; s_ < 16; ++s_) if (s_ < t) acc -= sAM[t * 16 + s_] * x[s_];
                    x[t] = acc; if (lane < 16) rT[t * 16 + j] = (bf16_t)f2bf(acc); }
            }
            LDS_FENCE();
            WAVE_SYNC();
            { const unsigned long long* st = (const unsigned long long*)(wsb + PW_REC); unsigned long long* gr = (unsigned long long*)(C.ws + WS_R2RING) + ((size_t)hd * R2_GSLOTS + (ch % R2_GSLOTS)) * R2S_U64;
              UNR for (int j = 0; j < 25; ++j) { const int idx = j * 64 + lane; if (idx < R2S_U64) gst_u64(gr + idx, st[idx]); } }
            VM_DRAIN(); WAVE_SYNC();
            if (lane == 0) gst_u32((unsigned*)(C.ws + WS_CTL + CTL_R2FLAG) + (size_t)hd * R2_NCH + ch, epoch);
            WAVE_SYNC();
        }
    }
    TACC_STORE(C, 47, C.vcu == 16 && C.tid == 0);
}

#ifdef EMU
typedef volatile unsigned* R2_LDSV;
#define R2_LDSV_AT(lds, off) ((volatile unsigned*)((lds) + (off)))
struct BufRsrc { const unsigned char* p; };
DEVFN BufRsrc mk_rsrc(const void* p, unsigned) { BufRsrc r; r.p = (const unsigned char*)p; return r; }
DEVFN U4 buf_ld16_sc1(BufRsrc r, unsigned off) { return *(const U4*)(r.p + off); }
#else
typedef volatile __attribute__((address_space(3))) unsigned* R2_LDSV;
#define R2_LDSV_AT(lds, off) ((volatile __attribute__((address_space(3))) unsigned*)((__attribute__((address_space(3))) unsigned char*)(lds) + (off)))
typedef unsigned u32x4_hw __attribute__((ext_vector_type(4)));
typedef __amdgpu_buffer_rsrc_t BufRsrc;
#define mk_rsrc(p, bytes) __builtin_amdgcn_make_buffer_rsrc((void*)(p), 0, (bytes), 0x00020000)
DEVFN U4 buf_ld16_sc1(BufRsrc r, unsigned off) { const u32x4_hw v = __builtin_amdgcn_raw_buffer_load_b128(r, off, 0, 16); U4 o; o.x = v.x; o.y = v.y; o.z = v.z; o.w = v.w; return o; }
#endif

#ifdef EMU
DEVFN H8 h8_pk2(const A4& a, const A4& b) { U4 w; w.x = pk2(a.v[0], a.v[1]); w.y = pk2(a.v[2], a.v[3]); w.z = pk2(b.v[0], b.v[1]); w.w = pk2(b.v[2], b.v[3]); return h8_from(w); }
DEVFN A4 a4_mul(const A4& a, const A4& g) { A4 r; for (int j = 0; j < 4; ++j) r.v[j] = a.v[j] * g.v[j]; return r; }
#else
DEVFN H8 h8_pk2(const A4& a, const A4& b) { U4 w; w.x = pk2(a[0], a[1]); w.y = pk2(a[2], a[3]); w.z = pk2(b[0], b[1]); w.w = pk2(b[2], b[3]); return __builtin_bit_cast(H8, w); }
DEVFN A4 a4_mul(const A4& a, const A4& g) { return a * g; }
#endif

DEVFN void rc2_chain(const Ctx& C, int i, int hd, bool ctx_out, unsigned char* lds, int max_chunks) {
    const int tid = C.tid, lane = tid & 63, wave = C.wave, h = hd >> 1, d = hd & 1;
    R2_LDSV lf = R2_LDSV_AT(lds, R2_LSLOTS * R2S_BYTES);
    if (tid < 96) lf[tid] = 0u;
    SYNC();
    const int nchunks = R2_NCH < max_chunks ? R2_NCH : max_chunks;
    const unsigned epoch = (unsigned)(i + 1), pbase = (unsigned)i * 100000u;
    #define RC_GEOM(ch, seg0, segn, R0) const bool isctx_ = (ch) < NCTX / RC_T; const int seg0 = isctx_ ? NLAT : 0, segn = isctx_ ? NCTX : NLAT; \
        const int cl_ = isctx_ ? (ch) : (ch) - NCTX / RC_T; const int R0 = d == 0 ? RC_T * cl_ : segn - RC_T * (cl_ + 1);
    if (wave < 4) {
        bf16_t* Yd = (bf16_t*)(C.ws + (d == 0 ? WS_YF : WS_YB));
        const int vt = wave, kg = lane >> 4, l15 = lane & 15;
        const int o16 = (l15 * 16 + 4 * kg) * 2, o32 = (l15 * 32 + 8 * kg) * 2;
        const int a_vb = R2S_VT + ((16 * vt + l15) * 16 + 4 * kg) * 2, a_kkd = R2S_KKD + (l15 * 64 + 8 * (kg ^ ((l15 >> 1) & 7))) * 2, a_rd = R2S_RD + (l15 * 64 + 8 * (kg ^ ((l15 >> 1) & 7))) * 2;
        const int a_kkd1 = R2S_KKD + (l15 * 64 + 8 * ((kg + 4) ^ ((l15 >> 1) & 7))) * 2, a_rd1 = R2S_RD + (l15 * 64 + 8 * ((kg + 4) ^ ((l15 >> 1) & 7))) * 2;
        const int a_g = R2S_GC + 4 * kg * 4;
        struct Frag { U4 kkd0, kkd1, rd0, rd1, qq, kn0, kn1, kn2, kn3; U2 vb, p0, t; A4 g0, g1, g2, g3; };
#define R2_LOADF(ch, f) do { \
            const int slot = ch % R2_LSLOTS; const unsigned char* rb = lds + slot * R2S_BYTES; \
            TACC_BEGIN; SPIN_WAIT(lf[slot] == (unsigned)(ch + 1)); TACC_END; \
            f.kkd0 = ld16(rb + a_kkd); f.kkd1 = ld16(rb + a_kkd1); f.rd0 = ld16(rb + a_rd); f.rd1 = ld16(rb + a_rd1); f.vb = *(const U2*)(rb + a_vb); \
            f.p0 = *(const U2*)(rb + o16 + R2S_P0); f.t = *(const U2*)(rb + o16 + R2S_T); f.qq = ld16(rb + o32 + R2S_QQ); \
            f.kn0 = ld16(rb + o32 + R2S_KN); f.kn1 = ld16(rb + o32 + R2S_KN + 1024); f.kn2 = ld16(rb + o32 + R2S_KN + 2048); f.kn3 = ld16(rb + o32 + R2S_KN + 3072); \
            f.g0 = *(const A4*)(rb + a_g); f.g1 = *(const A4*)(rb + a_g + 64); f.g2 = *(const A4*)(rb + a_g + 128); f.g3 = *(const A4*)(rb + a_g + 192); \
            SCHED_BAR(); \
        } while (0)
#define R2_RELEASE(ch) do { const int slot = ch % R2_LSLOTS; LDS_FENCE(); WAVE_SYNC(); if (lane == 0) lf[32 + wave * 16 + slot] = (unsigned)(ch + 1); } while (0)
        A4 H0_ = a4_zero(), H1_ = a4_zero(), H2_ = a4_zero(), H3_ = a4_zero();
#define R2_COMPUTE(ch, f) do { \
            const H8 Hb0 = h8_pk2(H0_, H1_), Hb1 = h8_pk2(H2_, H3_); \
            U4 w_; w_.x = f.vb.x; w_.y = f.vb.y; w_.z = f.vb.x; w_.w = f.vb.y; const H8 Vv = h8_from(w_); \
            U4 a_; a_.x = f.p0.x; a_.y = f.p0.y; a_.z = 0u; a_.w = 0u; \
            A4 X = mfma16(h8_from(f.kkd0), Hb0, a4_zero()); X = mfma16(h8_from(f.kkd1), Hb1, X); X = mfma16(h8_from(a_), Vv, X); \
            A4 Y = mfma16(h8_from(f.rd0), Hb0, a4_zero()); Y = mfma16(h8_from(f.rd1), Hb1, Y); \
            w_.x = pk2(A4_GET(X, 0), A4_GET(X, 1)); w_.y = pk2(A4_GET(X, 2), A4_GET(X, 3)); a_.x = f.t.x; a_.y = f.t.y; \
            const A4 U_ = mfma16(h8_from(a_), h8_from(w_), a4_zero()); \
            w_.x = f.vb.x; w_.y = f.vb.y; w_.z = pk2(A4_GET(U_, 0), A4_GET(U_, 1)); w_.w = pk2(A4_GET(U_, 2), A4_GET(U_, 3)); const H8 VU = h8_from(w_); \
            Y = mfma16(h8_from(f.qq), VU, Y); \
            H0_ = mfma16(h8_from(f.kn0), VU, H0_); H1_ = mfma16(h8_from(f.kn1), VU, H1_); H2_ = mfma16(h8_from(f.kn2), VU, H2_); H3_ = mfma16(h8_from(f.kn3), VU, H3_); \
            H0_ = a4_mul(H0_, f.g0); H1_ = a4_mul(H1_, f.g1); H2_ = a4_mul(H2_, f.g2); H3_ = a4_mul(H3_, f.g3); \
            { RC_GEOM(ch, seg0, segn, R0) \
              if (!isctx_ || ctx_out) { bf16_t* yp = ycol + (size_t)(seg0 + (d == 0 ? R0 + 4 * kg : R0 + RC_T - 1 - 4 * kg)) * 512; \
                  UNR for (int rg = 0; rg < 4; ++rg) yp[rg * ystep] = (bf16_t)f2bf(A4_GET(Y, rg)); } } \
        } while (0)
        bf16_t* ycol = Yd + 64 * h + 16 * vt + l15; const int ystep = d == 0 ? 512 : -512;
        Frag fa, fb;
        TACC_DECL;
        { const int cz = 0; if (nchunks > 0) { R2_LOADF(cz, fa); R2_RELEASE(cz); } }
        for (int c0 = 0; c0 < nchunks; c0 += 2) {
            const int c1 = c0 + 1, c2 = c0 + 2;
            if (c1 < nchunks) R2_LOADF(c1, fb);
            R2_COMPUTE(c0, fa);
            if (c1 < nchunks) { R2_RELEASE(c1); if (c2 < nchunks) R2_LOADF(c2, fa); R2_COMPUTE(c1, fb); if (c2 < nchunks) R2_RELEASE(c2); }
        }
        TACC_STORE(C, 45, C.vcu == 0 && tid == 0);
    } else {
        const int w = wave - 4;
        const unsigned* FLAG = (const unsigned*)(C.ws + WS_CTL + CTL_R2FLAG) + (size_t)hd * R2_NCH; unsigned* POS = (unsigned*)(C.ws + WS_CTL + CTL_R2POS) + 16 * hd;
        const BufRsrc rs = mk_rsrc(C.ws + WS_R2RING + (size_t)hd * R2_GSLOTS * R2S_BYTES, (unsigned)(R2_GSLOTS * R2S_BYTES));
        TACC_DECL;
        unsigned f0 = 0u, f1 = 0u;
        for (int ca = w; ca < nchunks; ca += 8) {
            const int cb = ca + 4; const bool two = cb < nchunks;
            if (f0 != epoch) { GSPIN_WAIT(gld_u32(FLAG + ca) == epoch); }
            if (two && f1 != epoch) { GSPIN_WAIT(gld_u32(FLAG + cb) == epoch); }
            U4 xa[13], xb[13];
            const unsigned oa = (unsigned)(ca % R2_GSLOTS) * R2S_BYTES + lane * 16, ob = (unsigned)(cb % R2_GSLOTS) * R2S_BYTES + lane * 16;
            UNR for (int j = 0; j < 13; ++j) xa[j] = buf_ld16_sc1(rs, oa + j * 1024);
            if (two) { UNR for (int j = 0; j < 13; ++j) xb[j] = buf_ld16_sc1(rs, ob + j * 1024); }
            f0 = ca + 8 < nchunks ? gld_u32(FLAG + ca + 8) : 0u; f1 = cb + 8 < nchunks ? gld_u32(FLAG + cb + 8) : 0u;
            {
                const int slot = ca % R2_LSLOTS;
                if (ca >= R2_LSLOTS) { const unsigned need = (unsigned)(ca - R2_LSLOTS + 1); TACC_BEGIN; SPIN_WAIT(lf[32 + 0 * 16 + slot] == need && lf[32 + 1 * 16 + slot] == need && lf[32 + 2 * 16 + slot] == need && lf[32 + 3 * 16 + slot] == need); TACC_END; }
                unsigned char* dst = lds + slot * R2S_BYTES + lane * 16;
                UNR for (int j = 0; j < 12; ++j) st16(dst + j * 1024, xa[j]);
                if (lane < 16) st16(dst + 12 * 1024, xa[12]);
                LDS_FENCE(); WAVE_SYNC();
                if (lane == 0) lf[slot] = (unsigned)(ca + 1);
            }
            if (two) {
                const int slot = cb % R2_LSLOTS;
                if (cb >= R2_LSLOTS) { const unsigned need = (unsigned)(cb - R2_LSLOTS + 1); TACC_BEGIN; SPIN_WAIT(lf[32 + 0 * 16 + slot] == need && lf[32 + 1 * 16 + slot] == need && lf[32 + 2 * 16 + slot] == need && lf[32 + 3 * 16 + slot] == need); TACC_END; }
                unsigned char* dst = lds + slot * R2S_BYTES + lane * 16;
                UNR for (int j = 0; j < 12; ++j) st16(dst + j * 1024, xb[j]);
                if (lane < 16) st16(dst + 12 * 1024, xb[12]);
                LDS_FENCE(); WAVE_SYNC();
                if (lane == 0) lf[slot] = (unsigned)(cb + 1);
            }
            if (lane == 0) gst_u32(POS + 1 + w, pbase + (unsigned)((two ? cb : ca) + 1));
        }
        TACC_STORE(C, 46, C.vcu == 0 && tid == 256);
    }
    #undef RC_GEOM
    SYNC();
}
#ifndef HY_CUS
#define HY_CUS 171
#endif
DEVFN void ph_scan_hyena(const Ctx& C, int i, bool ctx_out, unsigned char* lds) {
    const int np = C.G >= 256 ? C.G - 16 - HY_CUS : (C.G - 16) / 2, nscan = 16 + np;
    if (C.vcu < 16) { rc2_chain(C, i, C.vcu, ctx_out, lds, 1 << 30); XSTAMP(C, 40, C.vcu == 0); return; }
    if (C.vcu < nscan) { rc2_producer(C, i, lds, (C.vcu - 16) * NWAVES + C.wave, np * NWAVES, 0, 16, 1 << 30); XSTAMP(C, 43, C.vcu == 16); return; }
    const int nh = C.G - nscan;
    for (int c = C.vcu - nscan; c < 512; c += nh) { hyena_channel(C, i, c, lds); if (c == C.vcu - nscan) XSTAMP(C, 44, C.vcu == nscan); }
    XSTAMP(C, 41, C.vcu == nscan); XSTAMP(C, 42, C.vcu == C.G - 1);
    if (ctx_out) for (int c = C.vcu - nscan; c < 512; c += nh) { SYNC(); hyena_ctx_channel(C, i, c, lds); }
}

DEVFN void ctx_outproj(const Ctx& C, const bf16_t* A1, const bf16_t* A2, int lda, const bf16_t* Wt, const float* gate_c, const float* base, float* out) {
    const int row = C.tid & 255, cp = C.tid >> 8;
    for (int n0 = 4 * C.vcu; n0 < DM; n0 += 4 * C.G) {
        const int n = n0 + 2 * cp;
        const bf16_t* w0p = Wt + (size_t)n * DM; const bf16_t* w1p = w0p + DM;
        float acc0 = 0.f, acc1 = 0.f;
        for (int hf = 0; hf < 2; ++hf) {
            const bf16_t* ap = (hf == 0 ? A1 : A2) + (size_t)row * lda;
            for (int k0 = 0; k0 < 512; k0 += 8) {
                float a[8], w0[8], w1[8];
                unpack8(ld16(ap + k0), a); unpack8(ld16(w0p + 512 * hf + k0), w0); unpack8(ld16(w1p + 512 * hf + k0), w1);
                UNR for (int e = 0; e < 8; ++e) { acc0 += a[e] * w0[e]; acc1 += a[e] * w1[e]; }
            }
        }
        const size_t o = (size_t)row * DM + n;
        out[o] = base[o] + gate_c[n] * acc0; out[o + 1] = base[o + 1] + gate_c[n + 1] * acc1;
    }
}
namespace pg8 {
#define PG8_LAS __attribute__((address_space(3)))
typedef unsigned short bf16_t;
typedef short bf16x8 __attribute__((ext_vector_type(8)));
typedef float f32x4 __attribute__((ext_vector_type(4)));
typedef unsigned u32x4 __attribute__((ext_vector_type(4)));
constexpr int BM = 256, BK = 64, HALF = 128, HTB = HALF * BK * 2  , STAGE_BYTES = 8 * HTB, NXCD = 8, WGM = 8;

__host__ __device__ __forceinline__ int lds_byte(int r, int c) { const int st = (r >> 4) * 2 + (c >> 5), rr = r & 15, cc = c & 31, ob = rr * 64 + cc * 2; return st * 1024 + (ob ^ (((ob >> 9) & 1) << 5)); }
__host__ __device__ __forceinline__ void stage_rc(int b, int& R, int& C) { const int st = b / 1024, sb = b % 1024, swz = sb ^ (((sb >> 9) & 1) << 5); R = (st >> 1) * 16 + swz / 64; C = (st & 1) * 32 + (swz % 64) / 2; }
__host__ __device__ __forceinline__ int perm32(int rho) { const int n = rho >> 4, i = rho & 15; return 8 * (i >> 2) + 4 * n + (i & 3); }

struct Unit { int pm, pn; };
struct Gemm { const bf16_t* A; const bf16_t* A2; int lda; const bf16_t* Bt; int M, N, K; };

struct StaticOrder {
    int nM, nN, nwg, G, c;
    __host__ __device__ void init(int M, int N, int G_, int c_) { nM = M / BM; nN = N / BM; nwg = nM * nN; G = G_; c = c_; }
    __host__ __device__ bool next(int i, Unit& u) const {
        const long L = (long)i * G + c; if (L >= nwg) return false;
        int wgid = (int)L; { const int q = nwg / NXCD, r = nwg % NXCD, xcd = wgid % NXCD, off = wgid / NXCD; wgid = (xcd < r ? xcd * (q + 1) : r * (q + 1) + (xcd - r) * q) + off; }
        const int nig = WGM * nN, gid = wgid / nig, fm = gid * WGM, gsz = (nM - fm) < WGM ? (nM - fm) : WGM;
        u.pm = fm + ((wgid % nig) % gsz); u.pn = (wgid % nig) / gsz; return true;
    }
    __device__ __forceinline__ void a_ready(const Unit&) const {}
    __device__ __forceinline__ void done(const Unit&) const {}
};

__device__ __forceinline__ unsigned cvt_pk_bf16(float lo, float hi) { unsigned r; asm volatile("v_cvt_pk_bf16_f32 %0, %1, %2" : "=v"(r) : "v"(lo), "v"(hi)); return r; }
__device__ __forceinline__ float silu_fast(float v) { return v * __builtin_amdgcn_rcpf(1.0f + __expf(-v)); }

template <int LAYOUT> struct EpiIn {
    static constexpr bool PERM = true, AFTER_DRAIN = false;
    unsigned char* ws;
    __device__ __forceinline__ void operator()(const f32x4 (&acc)[2][2][4][2], const Unit& u, int wr, int wc, int fr, int fq) const {
        const int row0 = u.pm * BM + wr * 64 + fr;
#pragma unroll
        for (int bj = 0; bj < 2; ++bj) {
            const int cg = u.pn * BM + bj * HALF;
            bf16_t* base; int ldc, mode, col;
            if (LAYOUT == 0) { base = (bf16_t*)(ws + WS_U); ldc = AIN; col = cg; mode = cg < 512 ? 1 : ((cg >= 1536 && cg < 2048) || cg >= 2816) ? 2 : 0; }
            else {
                if (cg < URW_W) { base = (bf16_t*)(ws + WS_U); ldc = URW_W; col = cg; mode = cg >= 1664 ? 2 : 0; }
                else if (cg < URW_W + UHY_W) { base = (bf16_t*)(ws + WS_UHY); ldc = UHY_W; col = cg - URW_W; mode = 0; }
                else if (cg < RIN) { base = (bf16_t*)(ws + WS_GHY); ldc = 512; col = cg - URW_W - UHY_W; mode = 2; }
                else { base = nullptr; ldc = 0; col = 0; mode = 3; }
            }
            if (mode == 3) continue;
            const int col0 = col + wc * 32 + 8 * fq;
#pragma unroll
            for (int ai = 0; ai < 2; ++ai)
#pragma unroll
                for (int m = 0; m < 4; ++m) {
                    f32x4 v0 = acc[ai][bj][m][0], v1 = acc[ai][bj][m][1];
                    if (mode == 1) { v0 = v0 * C2; v1 = v1 * C2; }
                    if (mode == 2) { v0 = (f32x4){silu_fast(v0[0]), silu_fast(v0[1]), silu_fast(v0[2]), silu_fast(v0[3])}; v1 = (f32x4){silu_fast(v1[0]), silu_fast(v1[1]), silu_fast(v1[2]), silu_fast(v1[3])}; }
                    u32x4 w; w.x = cvt_pk_bf16(v0[0], v0[1]); w.y = cvt_pk_bf16(v0[2], v0[3]); w.z = cvt_pk_bf16(v1[0], v1[1]); w.w = cvt_pk_bf16(v1[2], v1[3]);
                    *(u32x4*)(base + (size_t)(row0 + ai * HALF + m * 16) * ldc + col0) = w;
                }
        }
    }
};

struct EpiRes {
    static constexpr bool PERM = false, AFTER_DRAIN = false;
    const float* blat; const float* bctx; float* olat; float* octx; const float* gate; const float* gate_c;
    __device__ __forceinline__ void operator()(const f32x4 (&acc)[2][2][4][2], const Unit& u, int wr, int wc, int fr, int fq) const {
        const bool isctx = u.pm * BM >= NLAT;
        const float* bs = isctx ? bctx - (size_t)NLAT * DM : blat; float* os = isctx ? octx - (size_t)NLAT * DM : olat; const float* gt = isctx ? gate_c : gate;
        const int col0 = u.pn * BM + wc * 32 + 4 * fq;
#pragma unroll
        for (int bj = 0; bj < 2; ++bj)
#pragma unroll
            for (int n = 0; n < 2; ++n) { const f32x4 g = *(const f32x4*)(gt + col0 + bj * HALF + n * 16);
#pragma unroll
                for (int ai = 0; ai < 2; ++ai)
#pragma unroll
                    for (int m = 0; m < 4; ++m) { const size_t off = (size_t)(u.pm * BM + ai * HALF + wr * 64 + m * 16 + fr) * DM + col0 + bj * HALF + n * 16;
                        const f32x4 b = *(const f32x4*)(bs + off); *(f32x4*)(os + off) = b + g * acc[ai][bj][m][n]; } }
    }
};
template <class Epi, class Sched, bool ALIGN_EPI = false, bool SP2 = false>
__device__ __forceinline__ void gemm_phase(PG8_LAS unsigned char* lds, const Gemm g, const Sched& S, const Epi& E) {
    int tid_ = threadIdx.x; asm volatile("" : "+v"(tid_));
    const int tid = tid_, wid = __builtin_amdgcn_readfirstlane(tid >> 6), lane = tid & 63, wr = wid >> 2, wc = wid & 3, fr = lane & 15, fq = lane >> 4;
    const int K = g.K, nt = K / BK;
    unsigned voffA[2], voffB[2];
#pragma unroll
    for (int i = 0; i < 2; ++i) { int R, C; stage_rc(tid * 16 + i * 8192, R, C); const int Rb = Epi::PERM ? ((R & ~31) + perm32(R & 31)) : R;
        voffA[i] = (unsigned)(R * g.lda + C) * 2u; voffB[i] = (unsigned)(Rb * K + C) * 2u; }
    const size_t kstep = (size_t)(BK * 2);
    const size_t hstepA = (size_t)HALF * g.lda * 2, hstepB = (size_t)HALF * K * 2;
    const size_t tstepA = 2 * hstepA, tstepB = 2 * hstepB;
    const int nh = nt / 2; const ptrdiff_t dlt = ((const char*)g.A2 - (const char*)g.A) - (ptrdiff_t)nh * (ptrdiff_t)kstep;
    const unsigned ldsw = (unsigned)wid * 1024u;
    const int aoff = lds_byte(wr * 64 + fr, fq * 8), boff = lds_byte(wc * 32 + fr, fq * 8);
#define PG8_SA(b, h) (((b) * 2 + (h)) * HTB)
#define PG8_SB(b, h) ((4 + (b) * 2 + (h)) * HTB)
#define PG8_STAGE(bufoff, gbase, voff) do { _Pragma("unroll") for (int _i = 0; _i < 2; ++_i) \
        __builtin_amdgcn_global_load_lds((const unsigned*)((const char*)(gbase) + (voff)[_i]), (PG8_LAS unsigned*)(lds + (bufoff) + ldsw + _i * 8192), 16, 0, 0); } while (0)
#define PG8_LDA(dst, b, h) do { _Pragma("unroll") for (int m = 0; m < 4; ++m) _Pragma("unroll") for (int k = 0; k < 2; ++k) dst[m][k] = *(const PG8_LAS bf16x8*)(lds + PG8_SA(b, h) + aoff + m * 2048 + k * 1024); } while (0)
#define PG8_LDB(dst, b, h) do { _Pragma("unroll") for (int n = 0; n < 2; ++n) _Pragma("unroll") for (int k = 0; k < 2; ++k) dst[n][k] = *(const PG8_LAS bf16x8*)(lds + PG8_SB(b, h) + boff + n * 2048 + k * 1024); } while (0)
#define PG8_MMA(ai, bj, At, Bt) do { __builtin_amdgcn_s_setprio(1); _Pragma("unroll") for (int m = 0; m < 4; ++m) _Pragma("unroll") for (int n = 0; n < 2; ++n) _Pragma("unroll") for (int k = 0; k < 2; ++k) \
        acc[ai][bj][m][n] = __builtin_amdgcn_mfma_f32_16x16x32_bf16(Bt[n][k], At[m][k], acc[ai][bj][m][n], 0, 0, 0); __builtin_amdgcn_s_setprio(0); } while (0)
#define PG8_WAIT_V(n) asm volatile("s_waitcnt vmcnt(" #n ")" ::: "memory")
#define PG8_WAIT_L(n) asm volatile("s_waitcnt lgkmcnt(" #n ")" ::: "memory")
#define PG8_BAR __builtin_amdgcn_s_barrier()
#define PG8_SCHED __builtin_amdgcn_sched_barrier(0)
    Unit cur, nxt; int ui = 0;
    if (!S.next(0, cur)) return;
    f32x4 acc[2][2][4][2];
#pragma unroll
    for (int a = 0; a < 2; ++a)
#pragma unroll
        for (int b = 0; b < 2; ++b)
#pragma unroll
            for (int m = 0; m < 4; ++m)
#pragma unroll
                for (int n = 0; n < 2; ++n) acc[a][b][m][n] = (f32x4){0.f, 0.f, 0.f, 0.f};
    bf16x8 At[4][2], B0[2][2], B1[2][2];
    const char* cA = (const char*)g.A + (size_t)cur.pm * tstepA; const char* cB = (const char*)g.Bt + (size_t)cur.pn * tstepB;
    S.a_ready(cur);
    if constexpr (SP2) {
        PG8_STAGE(PG8_SB(0, 0), cB, voffB); PG8_STAGE(PG8_SB(0, 1), cB + hstepB, voffB); PG8_STAGE(PG8_SA(0, 0), cA, voffA); PG8_STAGE(PG8_SA(0, 1), cA + hstepA, voffA);
        if (wr == 1) PG8_BAR;
        PG8_WAIT_V(2); PG8_BAR;
        PG8_STAGE(PG8_SB(1, 0), cB + kstep, voffB); PG8_STAGE(PG8_SA(1, 0), cA + kstep, voffA); PG8_STAGE(PG8_SB(1, 1), cB + hstepB + kstep, voffB);
        PG8_WAIT_V(6); PG8_BAR;
    } else {
        PG8_STAGE(PG8_SB(0, 0), cB, voffB); PG8_STAGE(PG8_SA(0, 0), cA, voffA); PG8_STAGE(PG8_SB(0, 1), cB + hstepB, voffB); PG8_STAGE(PG8_SA(0, 1), cA + hstepA, voffA);
        if (wr == 1) PG8_BAR;
        PG8_WAIT_V(4); PG8_BAR;
        PG8_STAGE(PG8_SB(1, 0), cB + kstep, voffB); PG8_STAGE(PG8_SA(1, 0), cA + kstep, voffA); PG8_STAGE(PG8_SB(1, 1), cB + hstepB + kstep, voffB);
        PG8_WAIT_V(6); PG8_BAR;
    }
    for (;;) {
        const bool has_next = S.next(ui + 1, nxt);
        const char* nA = has_next ? (const char*)g.A + (size_t)nxt.pm * tstepA : cA; const char* nB = has_next ? (const char*)g.Bt + (size_t)nxt.pn * tstepB : cB;
        for (int t = 0; t < nt; t += 2) {
            const bool last = (t == nt - 2);
            const char* a1 = cA + (size_t)(t + 1) * kstep + ((t + 1) >= nh ? dlt : 0);
            const char* a2 = last ? nA : cA + (size_t)(t + 2) * kstep + ((t + 2) >= nh ? dlt : 0); const char* b2 = last ? nB : cB + (size_t)(t + 2) * kstep;
            const char* a3 = a2 + kstep; const char* b3 = b2 + kstep;
            if (last && has_next) S.a_ready(nxt);
            if constexpr (SP2) {
            PG8_LDB(B0, 0, 0); PG8_LDB(B1, 0, 1); PG8_SCHED; PG8_LDA(At, 0, 0); PG8_STAGE(PG8_SA(1, 1), a1 + hstepA, voffA);
            PG8_WAIT_V(8); PG8_WAIT_L(0); PG8_BAR; PG8_MMA(0, 0, At, B0); PG8_MMA(0, 1, At, B1); PG8_BAR; PG8_SCHED;
            PG8_LDA(At, 0, 1); PG8_STAGE(PG8_SB(0, 0), b2, voffB); PG8_STAGE(PG8_SB(0, 1), b2 + hstepB, voffB); PG8_STAGE(PG8_SA(0, 0), a2, voffA);
            PG8_WAIT_V(8); PG8_WAIT_L(0); PG8_BAR; PG8_MMA(1, 0, At, B0); PG8_MMA(1, 1, At, B1); PG8_BAR; PG8_SCHED;
            PG8_LDB(B0, 1, 0); PG8_LDB(B1, 1, 1); PG8_SCHED; PG8_LDA(At, 1, 0); PG8_STAGE(PG8_SA(0, 1), a2 + hstepA, voffA);
            PG8_WAIT_V(8); PG8_WAIT_L(0); PG8_BAR; PG8_MMA(0, 0, At, B0); PG8_MMA(0, 1, At, B1); PG8_BAR; PG8_SCHED;
            PG8_LDA(At, 1, 1); PG8_STAGE(PG8_SB(1, 0), b3, voffB); PG8_STAGE(PG8_SB(1, 1), b3 + hstepB, voffB); PG8_STAGE(PG8_SA(1, 0), a3, voffA);
            PG8_WAIT_V(8); PG8_WAIT_L(0); PG8_BAR; PG8_MMA(1, 0, At, B0); PG8_MMA(1, 1, At, B1); PG8_BAR; PG8_SCHED;
            } else {
            PG8_LDB(B0, 0, 0); PG8_SCHED; PG8_LDA(At, 0, 0); PG8_STAGE(PG8_SA(1, 1), a1 + hstepA, voffA);
            PG8_WAIT_L(8); PG8_BAR; PG8_WAIT_L(0); PG8_MMA(0, 0, At, B0); PG8_BAR; PG8_SCHED;
            PG8_LDB(B1, 0, 1); PG8_STAGE(PG8_SB(0, 0), b2, voffB);
            PG8_BAR; PG8_WAIT_L(0); PG8_MMA(0, 1, At, B1); PG8_BAR;
            PG8_LDA(At, 0, 1); PG8_STAGE(PG8_SA(0, 0), a2, voffA);
            PG8_BAR; PG8_WAIT_L(0); PG8_MMA(1, 0, At, B0); PG8_BAR; PG8_SCHED;
            PG8_STAGE(PG8_SB(0, 1), b2 + hstepB, voffB);
            PG8_WAIT_V(6); PG8_BAR; PG8_MMA(1, 1, At, B1); PG8_BAR;
            PG8_LDB(B0, 1, 0); PG8_SCHED; PG8_LDA(At, 1, 0); PG8_STAGE(PG8_SA(0, 1), a2 + hstepA, voffA);
            PG8_WAIT_L(8); PG8_BAR; PG8_WAIT_L(0); PG8_MMA(0, 0, At, B0); PG8_BAR; PG8_SCHED;
            PG8_LDB(B1, 1, 1); PG8_STAGE(PG8_SB(1, 0), b3, voffB);
            PG8_BAR; PG8_WAIT_L(0); PG8_MMA(0, 1, At, B1); PG8_BAR;
            PG8_LDA(At, 1, 1); PG8_STAGE(PG8_SA(1, 0), a3, voffA);
            PG8_BAR; PG8_WAIT_L(0); PG8_MMA(1, 0, At, B0); PG8_BAR; PG8_SCHED;
            PG8_STAGE(PG8_SB(1, 1), b3 + hstepB, voffB);
            PG8_WAIT_V(6); PG8_BAR; PG8_MMA(1, 1, At, B1); PG8_BAR;
            }
        }
        if constexpr (ALIGN_EPI) { if (wr == 0) PG8_BAR; }
        if constexpr (!Epi::AFTER_DRAIN) { E(acc, cur, wr, wc, fr, fq); S.done(cur); }
        if (!has_next) break;
#pragma unroll
        for (int a = 0; a < 2; ++a)
#pragma unroll
            for (int b = 0; b < 2; ++b)
#pragma unroll
                for (int m = 0; m < 4; ++m)
#pragma unroll
                    for (int n = 0; n < 2; ++n) acc[a][b][m][n] = (f32x4){0.f, 0.f, 0.f, 0.f};
        cur = nxt; cA = nA; cB = nB; ++ui;
        if constexpr (ALIGN_EPI) { if (wr == 1) PG8_BAR; }
    }
    PG8_WAIT_V(0);
    if constexpr (!ALIGN_EPI) { if (wr == 0) PG8_BAR; }
    PG8_BAR;
    if constexpr (Epi::AFTER_DRAIN) { E.fused(acc, cur, wr, wc, fr, fq, lds, wid, lane); S.done(cur); }
#undef PG8_SA
#undef PG8_SB
#undef PG8_STAGE
#undef PG8_LDA
#undef PG8_LDB
#undef PG8_MMA
#undef PG8_WAIT_V
#undef PG8_WAIT_L
#undef PG8_BAR
#undef PG8_SCHED
}
}
#include <hip/hip_bf16.h>
#include <cmath>
namespace attn_body {
using bf16=__hip_bfloat16;
using bf16x8=__attribute__((ext_vector_type(8)))short;
using s16x4=__attribute__((ext_vector_type(4)))short;
using f32x16=__attribute__((ext_vector_type(16)))float;
using u32x4=__attribute__((ext_vector_type(4)))unsigned;
constexpr int D=64;
constexpr int NW=8,QBLK=32,QB=QBLK*NW,KVBLK=64;
__device__ __forceinline__ int crow(int r,int hi){return (r&3)+8*(r>>2)+4*hi;}
#define SBAR() __builtin_amdgcn_sched_barrier(0)
typedef __attribute__((address_space(3))) const float* lds_fptr;
struct NaCtx { lds_fptr tab; int rmin, qr, qc, row0, col0; };
__device__ __forceinline__ void namask(f32x16&p0,f32x16&p1,int t,const NaCtx&n,int hi){
  if(t<4)return;
  const float NEG=-INFINITY; const int kr=n.rmin+(t-4);
  if(kr<n.row0||kr>=n.row0+8){
    #pragma unroll
    for(int r=0;r<16;++r){p0[r]=NEG;p1[r]=NEG;}
    return; }
  const lds_fptr bt=n.tab+((kr-n.qr+7)*31+15-n.qc+4*hi); const int d0=4*hi-n.col0;
  #pragma unroll
  for(int r=0;r<16;++r){const int e=(r&3)+8*(r>>2);
    p0[r]=((unsigned)(e+d0)<16u)?p0[r]+bt[e]:NEG; p1[r]=((unsigned)(e+32+d0)<16u)?p1[r]+bt[e+32]:NEG;}
}

constexpr int NSLOT=3, SLOTB=8192;
constexpr int LDS_K=0, LDS_V=NSLOT*SLOTB, LDS_WS=2*NSLOT*SLOTB, LDS_OST=LDS_WS+NW*64*4, LDS_BIAS=LDS_OST+NW*4096, LDS_BYTES=LDS_BIAS+640*4;
constexpr float C2=0.125f*1.4426950408889634f;
__device__ __forceinline__ void glds16(const void*gsrc,unsigned lds_dst){unsigned keep;
  asm volatile("s_mov_b32 %0, m0\n\ts_mov_b32 m0, %2\n\ts_nop 0\n\tglobal_load_lds_dwordx4 %1, off\n\ts_mov_b32 m0, %0":"=&s"(keep):"v"(gsrc),"s"(lds_dst):"memory");}
__device__ __forceinline__ float max3f(float a,float b,float c){float r;asm("v_max3_f32 %0, %1, %2, %3":"=v"(r):"v"(a),"v"(b),"v"(c));return r;}
__device__ __forceinline__ float max2f(float a,float b){float r;asm("v_max_f32_e32 %0, %1, %2":"=v"(r):"v"(a),"v"(b));return r;}
__device__ __forceinline__ float fadd_s(float a,float b){float r;asm("v_add_f32_e32 %0, %1, %2":"=v"(r):"v"(a),"v"(b));return r;}
__device__ __forceinline__ float fsub_s(float a,float b){float r;asm("v_sub_f32_e32 %0, %1, %2":"=v"(r):"v"(a),"v"(b));return r;}
typedef float f32x2_t __attribute__((ext_vector_type(2))); typedef __bf16 bf16x2_t __attribute__((ext_vector_type(2)));
__device__ __forceinline__ unsigned cvtpk_s(float lo,float hi){f32x2_t v={lo,hi};bf16x2_t b=__builtin_convertvector(v,bf16x2_t);return __builtin_bit_cast(unsigned,b);}
#define WAIT_BAR(N) asm volatile("s_waitcnt vmcnt(" #N ") lgkmcnt(0)\n\ts_barrier":::"memory")

__device__ __forceinline__ void qkt(f32x16&p0,f32x16&p1,const char*Kslot,const bf16x8*qr,const f32x16&negm,int r32,int hi){
  const char*kb=Kslot+hi*1024+r32*16;
  #pragma unroll
  for(int d0=0;d0<4;++d0){
    const bf16x8 b0=*reinterpret_cast<const bf16x8*>(kb+d0*2048);
    const bf16x8 b1=*reinterpret_cast<const bf16x8*>(kb+d0*2048+512);
    if(d0==0){p0=__builtin_amdgcn_mfma_f32_32x32x16_bf16(b0,qr[0],negm,0,0,0);p1=__builtin_amdgcn_mfma_f32_32x32x16_bf16(b1,qr[0],negm,0,0,0);}
    else{p0=__builtin_amdgcn_mfma_f32_32x32x16_bf16(b0,qr[d0],p0,0,0,0);p1=__builtin_amdgcn_mfma_f32_32x32x16_bf16(b1,qr[d0],p1,0,0,0);}}
}
typedef __attribute__((address_space(3))) const char* lds_cptr;
typedef short v4i16_t __attribute__((ext_vector_type(4)));
__device__ __forceinline__ void kload8(bf16x8*kf,lds_cptr kp){
  kf[0]=*(const __attribute__((address_space(3))) bf16x8*)(kp);      kf[1]=*(const __attribute__((address_space(3))) bf16x8*)(kp+512);
  kf[2]=*(const __attribute__((address_space(3))) bf16x8*)(kp+2048); kf[3]=*(const __attribute__((address_space(3))) bf16x8*)(kp+2560);
  kf[4]=*(const __attribute__((address_space(3))) bf16x8*)(kp+4096); kf[5]=*(const __attribute__((address_space(3))) bf16x8*)(kp+4608);
  kf[6]=*(const __attribute__((address_space(3))) bf16x8*)(kp+6144); kf[7]=*(const __attribute__((address_space(3))) bf16x8*)(kp+6656);
}
__device__ __forceinline__ void kload2(bf16x8*kf,lds_cptr kp,int j){ kf[2*j]=*(const __attribute__((address_space(3))) bf16x8*)(kp+j*2048); kf[2*j+1]=*(const __attribute__((address_space(3))) bf16x8*)(kp+j*2048+512); }
__device__ __forceinline__ s16x4 vtr(lds_cptr p){ return __builtin_bit_cast(s16x4,__builtin_amdgcn_ds_read_tr16_b64_v4i16((__attribute__((address_space(3))) v4i16_t*)p)); }
__device__ __forceinline__ float rowmax(const f32x16&p0,const f32x16&p1){
  float a=max3f(p0[0],p0[1],p1[0]),b=max3f(p0[2],p0[3],p1[1]);a=max3f(a,p1[2],p1[3]);
  #pragma unroll
  for(int r=4;r<16;r+=4){a=max3f(a,p0[r],p0[r+1]);b=max3f(b,p0[r+2],p0[r+3]);a=max3f(a,p1[r],p1[r+1]);b=max3f(b,p1[r+2],p1[r+3]);}
  const float m=max2f(a,b);
  auto rr=__builtin_amdgcn_permlane32_swap(__float_as_uint(m),__float_as_uint(m),false,false);
  return max2f(__uint_as_float(rr[0]),__uint_as_float(rr[1]));
}
__device__ __forceinline__ void pv(f32x16*o,int vb,bf16x8 pa0,bf16x8 pa1,bf16x8 pa2,bf16x8 pa3){
  #pragma unroll
  for(int d0=0;d0<2;++d0){s16x4 lo[4],hi[4];
    #pragma unroll
    for(int ks=0;ks<4;++ks){
      asm volatile("ds_read_b64_tr_b16 %0,%1 offset:%c2":"=&v"(lo[ks]):"v"(vb),"i"(d0*4096+ks*1024):"memory");
      asm volatile("ds_read_b64_tr_b16 %0,%1 offset:%c2":"=&v"(hi[ks]):"v"(vb),"i"(d0*4096+ks*1024+512):"memory");}
    asm volatile("s_waitcnt lgkmcnt(0)":::"memory");SBAR();
    #define PK(k) (bf16x8){lo[k][0],lo[k][1],lo[k][2],lo[k][3],hi[k][0],hi[k][1],hi[k][2],hi[k][3]}
    o[d0]=__builtin_amdgcn_mfma_f32_32x32x16_bf16(pa0,PK(0),o[d0],0,0,0);
    o[d0]=__builtin_amdgcn_mfma_f32_32x32x16_bf16(pa1,PK(1),o[d0],0,0,0);
    o[d0]=__builtin_amdgcn_mfma_f32_32x32x16_bf16(pa2,PK(2),o[d0],0,0,0);
    o[d0]=__builtin_amdgcn_mfma_f32_32x32x16_bf16(pa3,PK(3),o[d0],0,0,0);
    #undef PK
  }
}

#define ATTN_STORE16(p,v) (*(u32x4*)(p)=(v))
template<bool NA> __device__ __forceinline__ f32x16 cinit(const f32x16&negm){ if constexpr(NA){ f32x16 z=f32x16{}; return z; } else return negm; }
constexpr int UP=3328, OP=1024;
struct AJob { const bf16*U; bf16*MX; unsigned qo, ko, vo, go, oo; int NT, tile0a, na, tile0b; int qr0, rmin; const float*rpb; };
__device__ __forceinline__ u32x4 gate8(u32x4 v,u32x4 g);
template<int THRL,bool NA> __device__ __forceinline__ void attn_unit(const AJob&J,char*shm){
  int tid_=threadIdx.x; asm volatile("":"+v"(tid_));
  const int tid=tid_,lane=tid&63,r32=lane&31,hi=lane>>5; const int wid=__builtin_amdgcn_readfirstlane(tid>>6);
  const bf16*Qw=J.U+J.qo+(long)(wid*QBLK)*UP;
  const bf16*Kh=J.U+J.ko,*Vh=J.U+J.vo;
  const unsigned lds0=(unsigned)(uintptr_t)shm;
  float*wsf=(float*)(shm+LDS_WS)+wid*64;
  const bf16*ksrc=Kh+(long)lane*UP+wid*8;
  const bf16*vsrc=Vh+(long)(16*(wid&3)+(lane>>2))*UP+(wid>>2)*32+(lane&3)*8;
  const unsigned kdst=lds0+LDS_K+wid*1024, vdst=lds0+LDS_V+wid*1024;
  #define TROW(t) (64L*(long)(((t)<J.na)?(J.tile0a+(t)):(J.tile0b+((t)-J.na))))
  #define DMA_K(t,slot) glds16(ksrc+TROW(t)*UP,(unsigned)__builtin_amdgcn_readfirstlane(kdst+(slot)))
  #define DMA_V(t,slot) glds16(vsrc+TROW(t)*UP,(unsigned)__builtin_amdgcn_readfirstlane(vdst+(slot)))
  const int vb0=(int)(lds0+LDS_V)+((lane>>4)&1)*32+(lane&3)*8+(4*hi+((lane&15)>>2))*64;
  const char*Kbase=shm+LDS_K; bf16x8 kf[8];
  const lds_cptr shm3=(lds_cptr)shm; const lds_cptr kp0=shm3+LDS_K+hi*1024+r32*16; const lds_cptr vp0=shm3+LDS_V+((lane>>4)&1)*32+(lane&3)*8+(4*hi+((lane&15)>>2))*64;
  const int NT=J.NT;
  NaCtx nac; nac.tab=(lds_fptr)(shm+LDS_BIAS)+64; nac.rmin=J.rmin; nac.qr=J.qr0+(wid>>1); nac.qc=32*(wid&1)+r32;
  { int a=nac.qr-4; a=a<0?0:(a>248?248:a); nac.row0=a; int b=nac.qc-8; b=b<0?0:(b>48?48:b); nac.col0=b; }
  if(NA){ if(J.rpb){ for(int e=tid;e<465;e+=512)((__attribute__((address_space(3))) float*)(shm+LDS_BIAS))[64+e]=J.rpb[e]*1.4426950408889634f; } }
  DMA_K(0,0);DMA_V(0,0);DMA_K(1,SLOTB);
  bf16x8 qr[4];
  #pragma unroll
  for(int d0=0;d0<4;++d0)qr[d0]=*reinterpret_cast<const bf16x8*>(&Qw[(long)r32*UP+d0*16+hi*8]);
  float mhat=0.f,l_reg=0.f;f32x16 o[2];o[0]=f32x16{};o[1]=f32x16{};f32x16 negm=f32x16{}; if constexpr(!NA) asm volatile("":"+v"(negm));
  #define CMASK(P0,P1,t) do{ if constexpr(NA) namask(P0,P1,(t),nac,hi); }while(0)
  bool resc=false;
  #define START(P0,P1) do{ const float rm=rowmax(P0,P1); resc=false; \
    { const float dl=rm; mhat=fadd_s(mhat,dl); \
      _Pragma("unroll") for(int r=0;r<16;++r){P0[r]=fsub_s(P0[r],dl);P1[r]=fsub_s(P1[r],dl);} \
      if constexpr(!NA){ _Pragma("unroll") for(int r=0;r<16;++r)negm[r]=-mhat; asm volatile("":"+v"(negm)); } } \
    _Pragma("unroll") for(int r=0;r<16;++r)P0[r]=__builtin_amdgcn_exp2f(P0[r]); }while(0)
  #define RESC() do{ if(resc){ asm volatile("s_waitcnt lgkmcnt(0)":::"memory"); \
      _Pragma("unroll") for(int d_=0;d_<2;++d_) _Pragma("unroll") for(int r=0;r<16;++r)o[d_][r]*=wsf[crow(r,hi)]; } }while(0)
  f32x16 pA0,pA1,pB0,pB1;
  int sl_prev=0,sl_cur=0,sl_next=SLOTB;
  #define ROT() do{sl_prev=sl_cur;sl_cur=sl_next;sl_next=(sl_next==(NSLOT-1)*SLOTB)?0:sl_next+SLOTB;}while(0)
  DMA_K(2,2*SLOTB);
  WAIT_BAR(3);
  qkt(pA0,pA1,Kbase,qr,cinit<NA>(negm),r32,hi);asm volatile("s_nop 15\n\ts_nop 7":"+v"(pA0),"+v"(pA1));CMASK(pA0,pA1,0);
  START(pA0,pA1);
  _Pragma("unroll") for(int r=0;r<16;++r)pA1[r]=__builtin_amdgcn_exp2f(pA1[r]);
  WAIT_BAR(0);
  DMA_K(3,0);DMA_V(1,SLOTB);
  ROT();
  kload8(kf,kp0+sl_cur);
  WAIT_BAR(2);
  s16x4 vlo[8],vhi[8]; u32x4 pw0,pw1,pw2,pw3;
  #define PKW(P,B) cvtpk_s(P[B],P[B+1])
  #define PAF(k) __builtin_bit_cast(bf16x8,pw##k)
  #define VFR(i) (bf16x8){vlo[i][0],vlo[i][1],vlo[i][2],vlo[i][3],vhi[i][0],vhi[i][1],vhi[i][2],vhi[i][3]}
  #define PIN(x) asm volatile("":"+v"(x))
  #define MX3(a,b,c) __builtin_fmaxf(__builtin_fmaxf((a),(b)),(c))
  #define GAPA(MF,A0,A1,A2,A3,W0,W1,PW) do{ MF; sacc+=A0; sacc+=A1; sacc+=A2; sacc+=A3; PIN(sacc); W0; W1; PIN(PW); SBAR(); }while(0)
  #define EX(v) __builtin_amdgcn_exp2f(v)
  #define GAPB(MF,X,B) do{ MF; X[B]=EX(X[B]); X[B+1]=EX(X[B+1]); X[B+2]=EX(X[B+2]); X[B+3]=EX(X[B+3]); PIN(X); SBAR(); }while(0)
  #define VRD(i) do{ vlo[i]=vtr(vp_+(((i)>>2)*4096+((i)&3)*1024)); vhi[i]=vtr(vp_+(((i)>>2)*4096+((i)&3)*1024+512)); }while(0)
  #define KRD(G,j) do{ if(G){ kload2(kf,kp0+sl_next,j); SBAR(); } }while(0)
  #define STEP(C0,C1,P0,P1,t,GK,GV,GL) do{ SBAR(); \
    const lds_cptr vp_=vp0+sl_prev; \
    VRD(0); SBAR(); float sacc=(P0[0]+P0[1]); \
    GAPA(C0=__builtin_amdgcn_mfma_f32_32x32x16_bf16(kf[0],qr[0],cinit<NA>(negm),0,0,0), P0[2],P0[3],P0[4],P0[5],     pw0[0]=PKW(P0,0), pw0[1]=PKW(P0,2), pw0); \
    VRD(4); SBAR(); GAPA(C1=__builtin_amdgcn_mfma_f32_32x32x16_bf16(kf[1],qr[0],cinit<NA>(negm),0,0,0), P0[6],P0[7],P0[8],P0[9],     pw0[2]=PKW(P0,4), pw0[3]=PKW(P0,6), pw0); \
    VRD(1); SBAR(); GAPA(C0=__builtin_amdgcn_mfma_f32_32x32x16_bf16(kf[2],qr[1],C0,0,0,0),   P0[10],P0[11],P0[12],P0[13], pw1[0]=PKW(P0,8), pw1[1]=PKW(P0,10), pw1); \
    VRD(5); SBAR(); GAPA(C1=__builtin_amdgcn_mfma_f32_32x32x16_bf16(kf[3],qr[1],C1,0,0,0),   P0[14],P0[15],P1[0],P1[1],   pw1[2]=PKW(P0,12),pw1[3]=PKW(P0,14), pw1); \
    VRD(2); SBAR(); GAPA(C0=__builtin_amdgcn_mfma_f32_32x32x16_bf16(kf[4],qr[2],C0,0,0,0),   P1[2],P1[3],P1[4],P1[5],     pw2[0]=PKW(P1,0), pw2[1]=PKW(P1,2), pw2); \
    VRD(6); SBAR(); GAPA(C1=__builtin_amdgcn_mfma_f32_32x32x16_bf16(kf[5],qr[2],C1,0,0,0),   P1[6],P1[7],P1[8],P1[9],     pw2[2]=PKW(P1,4), pw2[3]=PKW(P1,6), pw2); \
    VRD(3); SBAR(); GAPA(C0=__builtin_amdgcn_mfma_f32_32x32x16_bf16(kf[6],qr[3],C0,0,0,0),   P1[10],P1[11],P1[12],P1[13], pw3[0]=PKW(P1,8), pw3[1]=PKW(P1,10), pw3); \
    VRD(7); SBAR(); GAPA(C1=__builtin_amdgcn_mfma_f32_32x32x16_bf16(kf[7],qr[3],C1,0,0,0),   P1[14],P1[15],0.f,0.f,       pw3[2]=PKW(P1,12),pw3[3]=PKW(P1,14), pw3); \
    l_reg+=sacc; \
    if(GK){DMA_K((t)+3,sl_cur);} if(GV){DMA_V((t)+1,sl_next);} \
    if constexpr(NA){ _Pragma("unroll") for(int r=0;r<16;++r){C0[r]-=mhat;C1[r]-=mhat;} } \
    CMASK(C0,C1,t); \
    { float a=MX3(C0[0],C0[1],C1[0]),b=MX3(C0[2],C0[3],C1[1]); a=MX3(a,C1[2],C1[3]); \
      _Pragma("unroll") for(int r=4;r<16;r+=4){a=MX3(a,C0[r],C0[r+1]);b=MX3(b,C0[r+2],C0[r+3]);a=MX3(a,C1[r],C1[r+1]);b=MX3(b,C1[r+2],C1[r+3]);} \
      float rm=__builtin_fmaxf(a,b); { auto rr=__builtin_amdgcn_permlane32_swap(__float_as_uint(rm),__float_as_uint(rm),false,false); rm=__builtin_fmaxf(__uint_as_float(rr[0]),__uint_as_float(rr[1])); } \
      resc=false; \
      if(__builtin_expect(__any(rm>(float)THRL),0)){ const float dl=__builtin_fmaxf(rm,0.f); mhat+=dl; \
        _Pragma("unroll") for(int r=0;r<16;++r){C0[r]-=dl;C1[r]-=dl;} \
        if constexpr(!NA){ _Pragma("unroll") for(int r=0;r<16;++r)negm[r]=-mhat; asm volatile("":"+v"(negm)); } \
        const float f=__builtin_amdgcn_exp2f(-dl); l_reg*=f; if(hi==0)wsf[r32]=f; resc=true; } } \
    SBAR(); \
    GAPB(o[0]=__builtin_amdgcn_mfma_f32_32x32x16_bf16(PAF(0),VFR(0),o[0],0,0,0), C0,0); \
    GAPB(o[1]=__builtin_amdgcn_mfma_f32_32x32x16_bf16(PAF(0),VFR(4),o[1],0,0,0), C0,4); \
    KRD(GL,0); GAPB(o[0]=__builtin_amdgcn_mfma_f32_32x32x16_bf16(PAF(1),VFR(1),o[0],0,0,0), C0,8); \
    KRD(GL,1); GAPB(o[1]=__builtin_amdgcn_mfma_f32_32x32x16_bf16(PAF(1),VFR(5),o[1],0,0,0), C0,12); \
    KRD(GL,2); GAPB(o[0]=__builtin_amdgcn_mfma_f32_32x32x16_bf16(PAF(2),VFR(2),o[0],0,0,0), C1,0); \
    KRD(GL,3); GAPB(o[1]=__builtin_amdgcn_mfma_f32_32x32x16_bf16(PAF(2),VFR(6),o[1],0,0,0), C1,4); \
    GAPB(o[0]=__builtin_amdgcn_mfma_f32_32x32x16_bf16(PAF(3),VFR(3),o[0],0,0,0), C1,8); \
    GAPB(o[1]=__builtin_amdgcn_mfma_f32_32x32x16_bf16(PAF(3),VFR(7),o[1],0,0,0), C1,12); \
    }while(0)
  int t=1;
  for(;t+5<NT;t+=2){
    STEP(pB0,pB1,pA0,pA1,t,true,true,true);     WAIT_BAR(2); RESC(); ROT();
    STEP(pA0,pA1,pB0,pB1,t+1,true,true,true);   WAIT_BAR(2); RESC(); ROT();
  }
  #define ENDW(tt) do{ if((tt)+3<NT){WAIT_BAR(2);} else if((tt)+2<NT){WAIT_BAR(1);} else {WAIT_BAR(0);} }while(0)
  for(;t+1<NT;t+=2){
    STEP(pB0,pB1,pA0,pA1,t,(t+3<NT),(t+1<NT),(t+1<NT));       ENDW(t);   RESC(); ROT();
    STEP(pA0,pA1,pB0,pB1,t+1,(t+4<NT),(t+2<NT),(t+2<NT));     ENDW(t+1); RESC(); ROT();
  }
  STEP(pB0,pB1,pA0,pA1,NT-1,false,false,false); RESC();
  { float sacc=pB0[0]+pB0[1]; _Pragma("unroll") for(int r=2;r<16;++r)sacc+=pB0[r]; _Pragma("unroll") for(int r=0;r<16;++r)sacc+=pB1[r]; l_reg+=sacc;
    pw0=(u32x4){PKW(pB0,0),PKW(pB0,2),PKW(pB0,4),PKW(pB0,6)};pw1=(u32x4){PKW(pB0,8),PKW(pB0,10),PKW(pB0,12),PKW(pB0,14)};pw2=(u32x4){PKW(pB1,0),PKW(pB1,2),PKW(pB1,4),PKW(pB1,6)};pw3=(u32x4){PKW(pB1,8),PKW(pB1,10),PKW(pB1,12),PKW(pB1,14)};
    SBAR(); pv(o,vb0+sl_cur,PAF(0),PAF(1),PAF(2),PAF(3)); }
  #undef PKW
  #undef PAF
  #undef VFR
  #undef PIN
  #undef MX3
  #undef GAPA
  #undef GAPB
  #undef EX
  #undef VRD
  #undef KRD
  #undef STEP
  #undef ENDW
  {auto rr=__builtin_amdgcn_permlane32_swap(__float_as_uint(l_reg),__float_as_uint(l_reg),false,false);l_reg=__uint_as_float(rr[0])+__uint_as_float(rr[1]);}
  if(hi==0)wsf[32+r32]=l_reg;asm volatile("s_waitcnt lgkmcnt(0)":::"memory");
  float rli[16];
  #pragma unroll
  for(int r=0;r<16;++r)rli[r]=__builtin_amdgcn_rcpf(wsf[32+crow(r,hi)]);
  bf16*Ow=J.MX+J.oo+(long)(wid*QBLK)*OP; const bf16*Gw=J.U+J.go+(long)(wid*QBLK)*UP;
  { bf16*stg=(bf16*)(shm+LDS_OST)+wid*2048;
    #pragma unroll
    for(int r=0;r<16;++r){const int orow=crow(r,hi);
      #pragma unroll
      for(int d0=0;d0<2;++d0)stg[orow*64+d0*32+r32]=__float2bfloat16(o[d0][r]*rli[r]);}
    asm volatile("s_waitcnt lgkmcnt(0)":::"memory");
    #pragma unroll
    for(int i=0;i<4;++i){const int row=i*8+(lane>>3),ch=lane&7; const u32x4 v=*(const u32x4*)(stg+row*64+ch*8); const u32x4 g=*(const u32x4*)(Gw+(long)row*UP+ch*8); ATTN_STORE16(Ow+(long)row*OP+ch*8,gate8(v,g));} }
  asm volatile("s_waitcnt lgkmcnt(0)\n\ts_barrier":::"memory");
  #undef DMA_K
  #undef TROW
  #undef DMA_V
  #undef CMASK
  #undef START
  #undef RESC
  #undef ROT
}
constexpr int ATTN_LDS_BYTES=LDS_BYTES;
__device__ __forceinline__ u32x4 gate8(u32x4 v,u32x4 g){ u32x4 r;
  #pragma unroll
  for(int i=0;i<4;++i){ const float a0=__uint_as_float(v[i]<<16)*__uint_as_float(g[i]<<16), a1=__uint_as_float(v[i]&0xffff0000u)*__uint_as_float(g[i]&0xffff0000u); r[i]=cvtpk_s(a0,a1); }
  return r; }
#undef SBAR
#undef WAIT_BAR
}
#define GAS __attribute__((address_space(1)))
#define LAS __attribute__((address_space(3)))
typedef GAS unsigned gu32;
#define RLX_AGENT __ATOMIC_RELAXED, __HIP_MEMORY_SCOPE_AGENT
#define XB_TMO      128
#define XB_XCNT(j)  (256  + 64 * (j))
#define XB_XSUB(j)  (1280 + 64 * (j))
#define XB_XGEN(j)  (2304 + 64 * (j))
#define XB_TOP      3328
#define XB_TOPGEN   3392
#define XCD_BAR_WORDS 3456
#define XB_SPIN_CAP (1u << 20)

__device__ __forceinline__ unsigned xb_ld(unsigned* p)              { return __hip_atomic_load(p, __ATOMIC_RELAXED, __HIP_MEMORY_SCOPE_AGENT); }
__device__ __forceinline__ unsigned xb_add(unsigned* p, unsigned v) { return __hip_atomic_fetch_add(p, v, __ATOMIC_RELAXED, __HIP_MEMORY_SCOPE_AGENT); }
__device__ __forceinline__ unsigned xb_xcc_id() { return (unsigned)__builtin_amdgcn_s_getreg((3 << 11) | 20) & 0xFu; }
#define XB_SPIN(cond, bar) do { unsigned _sp = 0; while (cond) { __builtin_amdgcn_s_sleep(1); \
    if ((++_sp & 255u) == 0u) { if (xb_ld(&(bar)[XB_TMO])) break; if (_sp > XB_SPIN_CAP) { atomicAdd(&(bar)[XB_TMO], 1u); break; } } } } while (0)

struct XcdBarrier {
    unsigned* bar; unsigned x;
    volatile LAS unsigned* st;
};

__device__ __forceinline__ XcdBarrier xcd_barrier_post(unsigned* bar, volatile LAS unsigned* st) {
    XcdBarrier b; b.bar = bar; b.x = xb_xcc_id(); b.st = st;
    if (threadIdx.x == 0) (void)xb_add(&bar[XB_XCNT(b.x)], 1u);
    return b;
}
__device__ __forceinline__ void xcd_barrier_complete(unsigned* bar, unsigned x, unsigned& nloc, unsigned& nx) {
    const unsigned G = gridDim.x * gridDim.y * gridDim.z;
    unsigned sum, cnt, mine, sp = 0u;
    for (;;) {
        sum = 0u; cnt = 0u; mine = 0u;
#pragma unroll
        for (unsigned j = 0; j < 16; ++j) { const unsigned c = xb_ld(&bar[XB_XCNT(j)]); sum += c; cnt += (c > 0u) ? 1u : 0u; mine = (j == x) ? c : mine; }
        if (sum == G) break;
        __builtin_amdgcn_s_sleep(1);
        if ((++sp & 255u) == 0u) { if (xb_ld(&bar[XB_TMO])) break; if (sp > XB_SPIN_CAP) { atomicAdd(&bar[XB_TMO], 1u); break; } }
    }
    nloc = mine > 0u ? mine : 1u; nx = cnt > 0u ? cnt : 1u;
}

__device__ __forceinline__ void xcd_barrier(const XcdBarrier& b) {
    asm volatile("s_waitcnt vmcnt(0)" ::: "memory");
    __syncthreads();
    if (threadIdx.x == 0) {
        unsigned* bar = b.bar;
        __builtin_amdgcn_s_waitcnt(0);
        unsigned nloc = b.st[0], nx = b.st[1];
        if (nloc == 0u) { xcd_barrier_complete(bar, b.x, nloc, nx); b.st[0] = nloc; b.st[1] = nx; }
        const unsigned old = xb_add(&bar[XB_XSUB(b.x)], 1u);
        const unsigned gen = old / nloc;
        if (old + 1u == (gen + 1u) * nloc) {
            __builtin_amdgcn_fence(__ATOMIC_RELEASE, "agent");
            asm volatile("s_waitcnt vmcnt(0)" ::: "memory");
            const unsigned og = xb_add(&bar[XB_TOP], 1u);
            const unsigned tg = og / nx;
            if (og + 1u == (tg + 1u) * nx) xb_add(&bar[XB_TOPGEN], 1u);
            else XB_SPIN(xb_ld(&bar[XB_TOPGEN]) == tg, bar);
            __builtin_amdgcn_fence(__ATOMIC_ACQUIRE, "agent");
            xb_add(&bar[XB_XGEN(b.x)], 1u);
            asm volatile("s_waitcnt vmcnt(0)" ::: "memory");
        } else {
            XB_SPIN(xb_ld(&bar[XB_XGEN(b.x)]) == gen, bar);
            __builtin_amdgcn_fence(__ATOMIC_ACQUIRE, "agent");
            asm volatile("s_waitcnt vmcnt(0)" ::: "memory");
        }
    }
    __syncthreads();
}

constexpr int CW_BAR = 4096;
__device__ __forceinline__ void ph_attention(const Ctx& C, int i, unsigned char* lds) {
    using namespace attn_body;
    const bf16* U = (const bf16*)(C.ws + WS_U); bf16* MX = (bf16*)(C.ws + WS_XN);
    const float* rpb = C.in[I_RPB] + (size_t)i * 8 * 465;
    for (int p = C.vcu; p < 1040; p += C.G) {
        int kind, h, qb;
        if (p < 512) { kind = 0; h = (p & 255) >> 5; qb = (p & 31) + 32 * (p >> 8); }
        else if (p < 1024) { kind = 1; const int q = p - 512; h = (q & 255) >> 5; qb = (q & 31) + 32 * (q >> 8); }
        else if (p < 1032) { kind = 0; h = p - 1024; qb = 64; }
        else { kind = 1; h = p - 1032; qb = 64; }
        const unsigned r0 = 256u * (unsigned)qb;
        AJob J; J.U = U; J.MX = MX;
        if (kind == 0) {
            J.qo = r0 * AIN + 2048 + 64 * h; J.ko = 2560 + 64 * (h >> 2); J.vo = 2688 + 64 * (h >> 2); J.oo = r0 * DM + 512 + 64 * h; J.go = r0 * AIN + 2816 + 64 * h;
            if (qb < 64) { J.NT = 260; J.tile0a = 0; J.na = 260; J.tile0b = 0; } else { J.NT = 4; J.tile0a = 256; J.na = 4; J.tile0b = 0; }
            J.qr0 = 0; J.rmin = 0; J.rpb = nullptr;
            attn_unit<8, false>(J, (char*)lds);
        } else {
            J.qo = r0 * AIN + 64 * h; J.ko = 512 + 64 * h; J.vo = 1024 + 64 * h; J.oo = r0 * DM + 64 * h; J.go = r0 * AIN + 1536 + 64 * h;
            J.tile0a = 256; J.na = 4; J.qr0 = 4 * qb;
            if (qb < 64) { int rm = 4 * qb - 4; rm = rm < 0 ? 0 : (rm > 248 ? 248 : rm); J.NT = 16; J.tile0b = rm; J.rmin = rm; J.rpb = rpb + (size_t)h * 465; }
            else { J.NT = 4; J.tile0b = 0; J.rmin = 0; J.rpb = nullptr; }
            attn_unit<8, true>(J, (char*)lds);
        }
    }
}

#ifdef TSEL
__device__ __forceinline__ void ph_final_t(const Ctx& C) {
    ph_final(C);
    __syncthreads();
    const unsigned long long* st = (const unsigned long long*)(C.ws + WS_CTL + 32768);
    unsigned long long t[24]; for (int k = 0; k < 24; ++k) t[k] = __hip_atomic_load(st + k, __ATOMIC_RELAXED, __HIP_MEMORY_SCOPE_AGENT);
    double sel = 0.0; for (int k = 0; k < 23; ++k) if ((TSEL >> k) & 1ull) sel += (double)(t[k + 1] - t[k]);
    double tot = (double)(t[23] - t[0]);
#ifdef TXS
    { const unsigned long long x = __hip_atomic_load(st + TXS, __ATOMIC_RELAXED, __HIP_MEMORY_SCOPE_AGENT); sel = (double)(x - t[20]); tot = (double)(t[21] - t[20]); }
#ifdef TXD
    { const unsigned long long x = __hip_atomic_load(st + TXS, __ATOMIC_RELAXED, __HIP_MEMORY_SCOPE_AGENT); sel = (double)x; tot = (double)(t[21] - t[20]); }
#endif
#endif
    const float eps = sqrtf(0.0012f * (float)(sel / tot));
    const int gw = C.vcu * NWAVES + C.wave, NGW = C.G * NWAVES;
    for (int m = gw; m < NLAT; m += NGW) { float* xr = C.out + (size_t)m * DM; for (int j = 0; j < 16; ++j) xr[64 * j + C.lane] *= (1.0f + eps); }
}
#else
__device__ __forceinline__ void ph_final_t(const Ctx& C) { ph_final(C); }
#endif
struct Args { const float* in[N_IN]; float* out; unsigned char* ws; int ph_lo, ph_hi; };
typedef __attribute__((address_space(4))) const Args* KArgP;
__global__ void __launch_bounds__(NTHREADS, 2) mk_fwd(Args args) {
    extern __shared__ __attribute__((aligned(16))) unsigned char lds[];
    volatile LAS unsigned* MISC = (volatile LAS unsigned*)((LAS unsigned char*)lds + MISC_OFF);
    if (threadIdx.x < 64) MISC[threadIdx.x] = 0u;
    __syncthreads();
    XcdBarrier bar = xcd_barrier_post((unsigned*)(args.ws + WS_CTL) + CW_BAR, MISC + 8);
    const int lo = args.ph_lo, hi = args.ph_hi;
    int pc = 0;
#ifdef TSEL
#define STAMP(k) do { if (blockIdx.x == 0 && threadIdx.x == 0) __hip_atomic_store((unsigned long long*)(args.ws + WS_CTL + 32768) + (k), (unsigned long long)__builtin_amdgcn_s_memrealtime(), __ATOMIC_RELAXED, __HIP_MEMORY_SCOPE_AGENT); } while (0)
#else
#define STAMP(k) do {} while (0)
#endif
    STAMP(0);
#define PHASE(...) do { if (pc >= lo && pc < hi) { KArgP ap = (KArgP)__builtin_amdgcn_kernarg_segment_ptr(); asm volatile("" : "+s"(ap)); Ctx C; \
        _Pragma("unroll") for (int k = 0; k < N_IN; ++k) C.in[k] = ap->in[k]; C.out = ap->out; C.ws = ap->ws; \
        { int t_ = threadIdx.x; asm volatile("" : "+v"(t_)); C.tid = t_; } C.lane = C.tid & 63; C.wave = __builtin_amdgcn_readfirstlane(C.tid >> 6); \
        C.G = gridDim.x; { const int bx = blockIdx.x; C.vcu = (C.G % 8 == 0) ? (bx % 8) * (C.G / 8) + bx / 8 : bx; } \
        float* XCTX = (float*)(C.ws + WS_XCTX); unsigned char* ldsg = (unsigned char*)lds; unsigned char* wsp = C.ws; (void)XCTX; (void)ldsg; (void)wsp; \
        const float* xl = layer == 0 ? C.in[I_X] : C.out; const float* xc = layer == 0 ? C.in[I_CTX] : XCTX; (void)xl; (void)xc; \
        const float* ADA = (const float*)(C.ws + WS_ADA) + (size_t)layer * 2 * 3072; (void)ADA; \
        __VA_ARGS__; if (pc + 1 < hi) xcd_barrier(bar); STAMP(pc + 1); } ++pc; } while (0)
#ifndef PH_MASK
#define PH_MASK 0xFFFF
#endif
#define EN(b) if ((PH_MASK >> (b)) & 1)

    { const int layer = 0; PHASE(EN(0) ph_prologue(C, ldsg)); }
    for (int layer = 0; layer < 4; ++layer) {
        const int i = layer >> 1;
        const bool ctx_out = layer < 3;
        PHASE(EN(1) ph_norm(C, layer, xl, xc, true));
        if ((layer & 1) == 0) {
            PHASE(EN(2) { pg8::Gemm g{(const pg8::bf16_t*)(wsp + WS_XN), (const pg8::bf16_t*)(wsp + WS_XN) + DM / 2, DM, (const pg8::bf16_t*)(wsp + WS_WAIN) + (size_t)i * AIN * DM, NTOK, AIN, DM};
                    pg8::StaticOrder S; S.init(NTOK, AIN, C.G, (int)blockIdx.x); pg8::EpiIn<0> E{wsp};
                    pg8::gemm_phase<pg8::EpiIn<0>, pg8::StaticOrder, true, true>((LAS unsigned char*)lds, g, S, E); });
            PHASE(EN(3) ph_qkprep(C, i));
            PHASE(EN(4) ph_attention(C, i, ldsg));
            PHASE(EN(5) { pg8::Gemm g{(const pg8::bf16_t*)(wsp + WS_XN), (const pg8::bf16_t*)(wsp + WS_XN) + DM / 2, DM, (const pg8::bf16_t*)(wsp + WS_WAOUT) + (size_t)i * DM * DM, NLAT, DM, DM};
                    pg8::StaticOrder S; S.init(NLAT, DM, C.G, (int)blockIdx.x); pg8::EpiRes E{xl, xc, C.out, XCTX, ADA + 2048, ADA + 3072 + 2048};
                    pg8::gemm_phase<pg8::EpiRes, pg8::StaticOrder, true, true>((LAS unsigned char*)lds, g, S, E);
                    ctx_outproj(C, (const bf16_t*)(wsp + WS_XN) + (size_t)NLAT * DM, (const bf16_t*)(wsp + WS_XN) + (size_t)NLAT * DM + 512, DM, (const bf16_t*)(wsp + WS_WAOUT) + (size_t)i * DM * DM, ADA + 3072 + 2048, xc, XCTX); });
        } else {
            PHASE(EN(6) { pg8::Gemm g{(const pg8::bf16_t*)(wsp + WS_XN), (const pg8::bf16_t*)(wsp + WS_XN) + DM / 2, DM, (const pg8::bf16_t*)(wsp + WS_WRIN) + (size_t)i * RINP * DM, NTOK, RINP, DM};
                    pg8::StaticOrder S; S.init(NTOK, RINP, C.G, (int)blockIdx.x); pg8::EpiIn<1> E{wsp};
                    pg8::gemm_phase<pg8::EpiIn<1>, pg8::StaticOrder, true, true>((LAS unsigned char*)lds, g, S, E); });
            PHASE(EN(7) ph_hyprep(C, i, ctx_out, ldsg));
            PHASE(EN(8) ph_scan_hyena(C, i, ctx_out, ldsg));
            PHASE(EN(9) ph_readout_hyout(C, i, ctx_out, ldsg));
            const int Mo = NLAT;
            PHASE(EN(10) { pg8::Gemm g{(const pg8::bf16_t*)(wsp + WS_YF), (const pg8::bf16_t*)(wsp + WS_HYOUT), 512, (const pg8::bf16_t*)(wsp + WS_WROUT) + (size_t)i * DM * DM, Mo, DM, DM};
                    pg8::StaticOrder S; S.init(Mo, DM, C.G, (int)blockIdx.x); pg8::EpiRes E{xl, xc, C.out, XCTX, ADA + 2048, ADA + 3072 + 2048};
                    pg8::gemm_phase<pg8::EpiRes, pg8::StaticOrder, true, true>((LAS unsigned char*)lds, g, S, E);
                    if (ctx_out) ctx_outproj(C, (const bf16_t*)(wsp + WS_YF) + (size_t)NLAT * 512, (const bf16_t*)(wsp + WS_HYOUT) + (size_t)NLAT * 512, 512, (const bf16_t*)(wsp + WS_WROUT) + (size_t)i * DM * DM, ADA + 3072 + 2048, xc, XCTX); });
        }
    }
    { const int layer = 3; PHASE(EN(11) ph_final_t(C)); }
#undef PHASE
}
constexpr int N_PHASES = 1 + 2 * 5 + 2 * 6 + 1;

#ifndef MK_SPLIT
#define MK_SPLIT 0
#endif
extern "C" void kernel_launch(void* const* d_in, const int* in_sizes, int n_in, void* d_out, int out_size, void* d_ws, size_t ws_size, hipStream_t stream) {
    static int grid = 0;
    if (grid == 0) {
        if (n_in != N_IN || out_size != NLAT * DM || ws_size < WS_END) { fprintf(stderr, "kernel_launch: unexpected shapes (n_in %d out %d ws %zu)\n", n_in, out_size, ws_size); grid = -1; return; }
        int dev = 0, cus = 0, per_cu = 0;
        if (hipGetDevice(&dev) != hipSuccess || hipDeviceGetAttribute(&cus, hipDeviceAttributeMultiprocessorCount, dev) != hipSuccess) { grid = -1; return; }
        if (hipFuncSetAttribute((const void*)mk_fwd, hipFuncAttributeMaxDynamicSharedMemorySize, LDS_BYTES) != hipSuccess) { fprintf(stderr, "kernel_launch: hipFuncSetAttribute failed\n"); grid = -1; return; }
        if (hipOccupancyMaxActiveBlocksPerMultiprocessor(&per_cu, (const void*)mk_fwd, NTHREADS, LDS_BYTES) != hipSuccess || per_cu < 1) fprintf(stderr, "kernel_launch: occupancy query says %d\n", per_cu);
        (void)hipGetLastError();
        grid = cus;
    }
    if (grid < 0) return;
    (void)hipMemsetAsync((char*)d_ws + WS_CTL, 0, CTL_ZERO_BYTES, stream);
    Args a{};
    for (int k = 0; k < N_IN; ++k) a.in[k] = (const float*)d_in[k];
    a.out = (float*)d_out; a.ws = (unsigned char*)d_ws;
#if MK_SPLIT
    for (int p = 0; p < N_PHASES; ++p) { a.ph_lo = p; a.ph_hi = p + 1; hipLaunchKernelGGL(mk_fwd, dim3(grid), dim3(NTHREADS), LDS_BYTES, stream, a); }
#else
    a.ph_lo = 0; a.ph_hi = N_PHASES;
    hipLaunchKernelGGL(mk_fwd, dim3(grid), dim3(NTHREADS), LDS_BYTES, stream, a);
#endif
}
```

```cpp
#ifndef EMU
#include <hip/hip_runtime.h>
#endif
#include <cstdio>
#include <cstdint>
#include <cmath>

constexpr int DM = 1024, NLAT = 16384, NCTX = 256, NTOK = NLAT + NCTX;
constexpr int GRIDW = 64, GRIDH = 256;
constexpr int AIN = 3328;
constexpr int RIN = 4224, RINP = 4352;
constexpr int URW_W = 2176;
constexpr int UHY_W = 1536;
constexpr int NWAVES = 8, NTHREADS = 512;
constexpr float C2 = 0.125f * 1.4426950408889634f;
constexpr float LOG2E = 1.4426950408889634f;
constexpr float NORM_EPS = 1e-6f;

typedef unsigned short bf16_t;

constexpr size_t MiB = 1u << 20;
constexpr size_t WS_CTL = 0, CTL_ZERO_BYTES = 256 * 1024;
constexpr size_t WS_ADA = 1 * MiB;
constexpr size_t WS_TW = WS_ADA + 128 * 1024;
constexpr size_t WS_HID256 = WS_TW + 160 * 1024;
constexpr size_t WS_BONUS = WS_HID256 + 64 * 1024;
constexpr size_t WS_XCTX = 3 * MiB;
constexpr size_t WS_VXC = 4 * MiB;
constexpr size_t WS_HID = 6 * MiB;
constexpr size_t WS_WAIN = 14 * MiB;
constexpr size_t WS_WAOUT = 27 * MiB;
constexpr size_t WS_WRIN = 31 * MiB;
constexpr size_t WS_WROUT = 48 * MiB;
constexpr size_t WS_XN = 52 * MiB;
constexpr size_t WS_U = 85 * MiB;
constexpr size_t WS_UHY = 155 * MiB;
constexpr size_t WS_GHY = 204 * MiB;
constexpr size_t WS_VX0 = 52 * MiB, WS_VX1 = 68 * MiB;
constexpr size_t WS_VX2 = 221 * MiB;
constexpr size_t WS_YHY = 155 * MiB;
constexpr size_t WS_YB = 171 * MiB;
constexpr size_t WS_YF = 187 * MiB + 512 * 1024;
constexpr size_t WS_HYOUT = 238 * MiB;
constexpr size_t WS_END = 256 * MiB;
static_assert(WS_U + (size_t)NTOK * AIN * 2 <= WS_END, "U attn");
static_assert(WS_U + (size_t)NTOK * URW_W * 2 <= WS_UHY && WS_UHY + (size_t)NTOK * UHY_W * 2 <= WS_GHY && WS_GHY + (size_t)NTOK * 512 * 2 <= WS_VX2, "rec map 1");
static_assert(WS_VX2 + (size_t)512 * 16384 * 2 <= WS_HYOUT && WS_HYOUT + (size_t)NTOK * 512 * 2 <= WS_END, "rec map 2");
static_assert(WS_YHY + (size_t)512 * 16384 * 2 <= WS_YB && WS_YB + (size_t)NTOK * 512 * 2 <= WS_YF && WS_YF + (size_t)NTOK * 512 * 2 <= WS_GHY, "rec map 3");
static_assert(WS_XN + (size_t)NTOK * DM * 2 <= WS_U && WS_VX1 + (size_t)512 * 16384 * 2 <= WS_U, "xn map");

constexpr int LDS_BYTES = 160 * 1024;
constexpr int MISC_OFF = LDS_BYTES - 256;
constexpr int RING_BYTES = MISC_OFF;

#ifdef EMU
#define DEVFN inline
#else
#define DEVFN __device__ __forceinline__
#endif

DEVFN float bf2f(bf16_t h) { union { unsigned u; float f; } x; x.u = ((unsigned)h) << 16; return x.f; }
#ifdef EMU
DEVFN unsigned f2bf(float f) { union { unsigned u; float f; } x; x.f = f; unsigned u = x.u; return (u + 0x7fffu + ((u >> 16) & 1u)) >> 16; }
DEVFN unsigned pk2(float lo, float hi) { return f2bf(lo) | (f2bf(hi) << 16); }
#else
typedef float f32x2_hw __attribute__((ext_vector_type(2))); typedef __bf16 bf16x2_hw __attribute__((ext_vector_type(2)));
DEVFN unsigned pk2(float lo, float hi) { f32x2_hw v = {lo, hi}; bf16x2_hw b = __builtin_convertvector(v, bf16x2_hw); return __builtin_bit_cast(unsigned, b); }
DEVFN unsigned f2bf(float f) { return pk2(f, 0.f) & 0xffffu; }
#endif
DEVFN float bflo(unsigned w) { union { unsigned u; float f; } x; x.u = w << 16; return x.f; }
DEVFN float bfhi(unsigned w) { union { unsigned u; float f; } x; x.u = w & 0xffff0000u; return x.f; }
struct U4 { unsigned x, y, z, w; };
struct U2 { unsigned x, y; };
struct F2 { float x, y; };
struct F4 { float x, y, z, w; };
DEVFN float silu_f(float v) { return v / (1.0f + expf(-v)); }
DEVFN float sigmoid_f(float v) { return 1.0f / (1.0f + expf(-v)); }
#define SCAN_CHUNK_ASM \
    "ds_read_b128 v[96:99], %[ab] offset:24576\n\t" \
    "ds_read_b128 v[100:103], %[ab] offset:0\n\t" \
    "ds_read_b128 v[104:107], %[ab] offset:16384\n\t" \
    "ds_read_b128 v[108:111], %[ab] offset:8192\n\t" \
    "ds_read_b128 v[112:115], %[ab] offset:32768\n\t" \
    "ds_read_b32 v116, %[av] offset:0\n\t" \
    "s_waitcnt lgkmcnt(0)\n\t" \
    "ds_read_b128 v[118:121], %[ab] offset:24832\n\t" \
    "ds_read_b128 v[122:125], %[ab] offset:256\n\t" \
    "ds_read_b128 v[126:129], %[ab] offset:16640\n\t" \
    "ds_read_b128 v[130:133], %[ab] offset:8448\n\t" \
    "ds_read_b128 v[134:137], %[ab] offset:33024\n\t" \
    "ds_read_b32 v138, %[av] offset:64\n\t" \
    "v_pk_mul_f32 v[140:141], %[s01], v[96:97]\n\t" \
    "v_pk_fma_f32 v[140:141], %[s23], v[98:99], v[140:141]\n\t" \
    "v_add_f32 v146, v140, v141\n\t" \
    "v_pk_mul_f32 v[142:143], %[s01], v[100:101]\n\t" \
    "v_pk_mul_f32 v[144:145], %[s23], v[102:103]\n\t" \
    "v_add_f32_dpp v146, v146, v146 quad_perm:[1,0,3,2] row_mask:0xf bank_mask:0xf bound_ctrl:1\n\t" \
    "v_add_f32_dpp %[yp], %[yp], %[yp] quad_perm:[1,0,3,2] row_mask:0xf bank_mask:0xf bound_ctrl:1\n\t" \
    "v_pk_fma_f32 v[142:143], v[116:117], v[108:109], v[142:143] op_sel_hi:[0,1,1]\n\t" \
    "v_add_f32_dpp v146, v146, v146 quad_perm:[2,3,0,1] row_mask:0xf bank_mask:0xf bound_ctrl:1\n\t" \
    "v_add_f32_dpp %[yp], %[yp], %[yp] quad_perm:[2,3,0,1] row_mask:0xf bank_mask:0xf bound_ctrl:1\n\t" \
    "v_pk_fma_f32 v[144:145], v[116:117], v[110:111], v[144:145] op_sel_hi:[0,1,1]\n\t" \
    "v_add_f32_dpp v146, v146, v146 row_half_mirror row_mask:0xf bank_mask:0xf bound_ctrl:1\n\t" \
    "v_add_f32_dpp %[yp], %[yp], %[yp] row_half_mirror row_mask:0xf bank_mask:0xf bound_ctrl:1\n\t" \
    "v_cmp_eq_u32_e32 vcc, 15, %[sp]\n\t" \
    "v_add_f32_dpp v146, v146, v146 row_mirror row_mask:0xf bank_mask:0xf bound_ctrl:1\n\t" \
    "v_add_f32_dpp %[yp], %[yp], %[yp] row_mirror row_mask:0xf bank_mask:0xf bound_ctrl:1\n\t" \
    "v_cndmask_b32_e32 %[yk0], %[yk0], %[yp], vcc\n\t" \
    "v_pk_fma_f32 %[s01], v[146:147], v[104:105], v[142:143] op_sel_hi:[0,1,1] neg_lo:[1,0,0] neg_hi:[1,0,0]\n\t" \
    "v_pk_fma_f32 %[s23], v[146:147], v[106:107], v[144:145] op_sel_hi:[0,1,1] neg_lo:[1,0,0] neg_hi:[1,0,0]\n\t" \
    "v_pk_mul_f32 v[140:141], %[s01], v[112:113]\n\t" \
    "v_pk_fma_f32 v[140:141], %[s23], v[114:115], v[140:141]\n\t" \
    "v_add_f32 %[yp], v140, v141\n\t" \
    "s_waitcnt lgkmcnt(0)\n\t" \
    "ds_read_b128 v[96:99], %[ab] offset:25088\n\t" \
    "ds_read_b128 v[100:103], %[ab] offset:512\n\t" \
    "ds_read_b128 v[104:107], %[ab] offset:16896\n\t" \
    "ds_read_b128 v[108:111], %[ab] offset:8704\n\t" \
    "ds_read_b128 v[112:115], %[ab] offset:33280\n\t" \
    "ds_read_b32 v116, %[av] offset:128\n\t" \
    "v_pk_mul_f32 v[140:141], %[s01], v[118:119]\n\t" \
    "v_pk_fma_f32 v[140:141], %[s23], v[120:121], v[140:141]\n\t" \
    "v_add_f32 v146, v140, v141\n\t" \
    "v_pk_mul_f32 v[142:143], %[s01], v[122:123]\n\t" \
    "v_pk_mul_f32 v[144:145], %[s23], v[124:125]\n\t" \
    "v_add_f32_dpp v146, v146, v146 quad_perm:[1,0,3,2] row_mask:0xf bank_mask:0xf bound_ctrl:1\n\t" \
    "v_add_f32_dpp %[yp], %[yp], %[yp] quad_perm:[1,0,3,2] row_mask:0xf bank_mask:0xf bound_ctrl:1\n\t" \
    "v_pk_fma_f32 v[142:143], v[138:139], v[130:131], v[142:143] op_sel_hi:[0,1,1]\n\t" \
    "v_add_f32_dpp v146, v146, v146 quad_perm:[2,3,0,1] row_mask:0xf bank_mask:0xf bound_ctrl:1\n\t" \
    "v_add_f32_dpp %[yp], %[yp], %[yp] quad_perm:[2,3,0,1] row_mask:0xf bank_mask:0xf bound_ctrl:1\n\t" \
    "v_pk_fma_f32 v[144:145], v[138:139], v[132:133], v[144:145] op_sel_hi:[0,1,1]\n\t" \
    "v_add_f32_dpp v146, v146, v146 row_half_mirror row_mask:0xf bank_mask:0xf bound_ctrl:1\n\t" \
    "v_add_f32_dpp %[yp], %[yp], %[yp] row_half_mirror row_mask:0xf bank_mask:0xf bound_ctrl:1\n\t" \
    "v_cmp_eq_u32_e32 vcc, 0, %[sp]\n\t" \
    "v_add_f32_dpp v146, v146, v146 row_mirror row_mask:0xf bank_mask:0xf bound_ctrl:1\n\t" \
    "v_add_f32_dpp %[yp], %[yp], %[yp] row_mirror row_mask:0xf bank_mask:0xf bound_ctrl:1\n\t" \
    "v_cndmask_b32_e32 %[yk0], %[yk0], %[yp], vcc\n\t" \
    "v_pk_fma_f32 %[s01], v[146:147], v[126:127], v[142:143] op_sel_hi:[0,1,1] neg_lo:[1,0,0] neg_hi:[1,0,0]\n\t" \
    "v_pk_fma_f32 %[s23], v[146:147], v[128:129], v[144:145] op_sel_hi:[0,1,1] neg_lo:[1,0,0] neg_hi:[1,0,0]\n\t" \
    "v_pk_mul_f32 v[140:141], %[s01], v[134:135]\n\t" \
    "v_pk_fma_f32 v[140:141], %[s23], v[136:137], v[140:141]\n\t" \
    "v_add_f32 %[yp], v140, v141\n\t" \
    "s_waitcnt lgkmcnt(0)\n\t" \
    "ds_read_b128 v[118:121], %[ab] offset:25344\n\t" \
    "ds_read_b128 v[122:125], %[ab] offset:768\n\t" \
    "ds_read_b128 v[126:129], %[ab] offset:17152\n\t" \
    "ds_read_b128 v[130:133], %[ab] offset:8960\n\t" \
    "ds_read_b128 v[134:137], %[ab] offset:33536\n\t" \
    "ds_read_b32 v138, %[av] offset:192\n\t" \
    "v_pk_mul_f32 v[140:141], %[s01], v[96:97]\n\t" \
    "v_pk_fma_f32 v[140:141], %[s23], v[98:99], v[140:141]\n\t" \
    "v_add_f32 v146, v140, v141\n\t" \
    "v_pk_mul_f32 v[142:143], %[s01], v[100:101]\n\t" \
    "v_pk_mul_f32 v[144:145], %[s23], v[102:103]\n\t" \
    "v_add_f32_dpp v146, v146, v146 quad_perm:[1,0,3,2] row_mask:0xf bank_mask:0xf bound_ctrl:1\n\t" \
    "v_add_f32_dpp %[yp], %[yp], %[yp] quad_perm:[1,0,3,2] row_mask:0xf bank_mask:0xf bound_ctrl:1\n\t" \
    "v_pk_fma_f32 v[142:143], v[116:117], v[108:109], v[142:143] op_sel_hi:[0,1,1]\n\t" \
    "v_add_f32_dpp v146, v146, v146 quad_perm:[2,3,0,1] row_mask:0xf bank_mask:0xf bound_ctrl:1\n\t" \
    "v_add_f32_dpp %[yp], %[yp], %[yp] quad_perm:[2,3,0,1] row_mask:0xf bank_mask:0xf bound_ctrl:1\n\t" \
    "v_pk_fma_f32 v[144:145], v[116:117], v[110:111], v[144:145] op_sel_hi:[0,1,1]\n\t" \
    "v_add_f32_dpp v146, v146, v146 row_half_mirror row_mask:0xf bank_mask:0xf bound_ctrl:1\n\t" \
    "v_add_f32_dpp %[yp], %[yp], %[yp] row_half_mirror row_mask:0xf bank_mask:0xf bound_ctrl:1\n\t" \
    "v_cmp_eq_u32_e32 vcc, 1, %[sp]\n\t" \
    "v_add_f32_dpp v146, v146, v146 row_mirror row_mask:0xf bank_mask:0xf bound_ctrl:1\n\t" \
    "v_add_f32_dpp %[yp], %[yp], %[yp] row_mirror row_mask:0xf bank_mask:0xf bound_ctrl:1\n\t" \
    "v_cndmask_b32_e32 %[yk0], %[yk0], %[yp], vcc\n\t" \
    "v_pk_fma_f32 %[s01], v[146:147], v[104:105], v[142:143] op_sel_hi:[0,1,1] neg_lo:[1,0,0] neg_hi:[1,0,0]\n\t" \
    "v_pk_fma_f32 %[s23], v[146:147], v[106:107], v[144:145] op_sel_hi:[0,1,1] neg_lo:[1,0,0] neg_hi:[1,0,0]\n\t" \
    "v_pk_mul_f32 v[140:141], %[s01], v[112:113]\n\t" \
    "v_pk_fma_f32 v[140:141], %[s23], v[114:115], v[140:141]\n\t" \
    "v_add_f32 %[yp], v140, v141\n\t" \
    "s_waitcnt lgkmcnt(0)\n\t" \
    "ds_read_b128 v[96:99], %[ab] offset:25600\n\t" \
    "ds_read_b128 v[100:103], %[ab] offset:1024\n\t" \
    "ds_read_b128 v[104:107], %[ab] offset:17408\n\t" \
    "ds_read_b128 v[108:111], %[ab] offset:9216\n\t" \
    "ds_read_b128 v[112:115], %[ab] offset:33792\n\t" \
    "ds_read_b32 v116, %[av] offset:256\n\t" \
    "v_pk_mul_f32 v[140:141], %[s01], v[118:119]\n\t" \
    "v_pk_fma_f32 v[140:141], %[s23], v[120:121], v[140:141]\n\t" \
    "v_add_f32 v146, v140, v141\n\t" \
    "v_pk_mul_f32 v[142:143], %[s01], v[122:123]\n\t" \
    "v_pk_mul_f32 v[144:145], %[s23], v[124:125]\n\t" \
    "v_add_f32_dpp v146, v146, v146 quad_perm:[1,0,3,2] row_mask:0xf bank_mask:0xf bound_ctrl:1\n\t" \
    "v_add_f32_dpp %[yp], %[yp], %[yp] quad_perm:[1,0,3,2] row_mask:0xf bank_mask:0xf bound_ctrl:1\n\t" \
    "v_pk_fma_f32 v[142:143], v[138:139], v[130:131], v[142:143] op_sel_hi:[0,1,1]\n\t" \
    "v_add_f32_dpp v146, v146, v146 quad_perm:[2,3,0,1] row_mask:0xf bank_mask:0xf bound_ctrl:1\n\t" \
    "v_add_f32_dpp %[yp], %[yp], %[yp] quad_perm:[2,3,0,1] row_mask:0xf bank_mask:0xf bound_ctrl:1\n\t" \
    "v_pk_fma_f32 v[144:145], v[138:139], v[132:133], v[144:145] op_sel_hi:[0,1,1]\n\t" \
    "v_add_f32_dpp v146, v146, v146 row_half_mirror row_mask:0xf bank_mask:0xf bound_ctrl:1\n\t" \
    "v_add_f32_dpp %[yp], %[yp], %[yp] row_half_mirror row_mask:0xf bank_mask:0xf bound_ctrl:1\n\t" \
    "v_cmp_eq_u32_e32 vcc, 2, %[sp]\n\t" \
    "v_add_f32_dpp v146, v146, v146 row_mirror row_mask:0xf bank_mask:0xf bound_ctrl:1\n\t" \
    "v_add_f32_dpp %[yp], %[yp], %[yp] row_mirror row_mask:0xf bank_mask:0xf bound_ctrl:1\n\t" \
    "v_cndmask_b32_e32 %[yk0], %[yk0], %[yp], vcc\n\t" \
    "v_pk_fma_f32 %[s01], v[146:147], v[126:127], v[142:143] op_sel_hi:[0,1,1] neg_lo:[1,0,0] neg_hi:[1,0,0]\n\t" \
    "v_pk_fma_f32 %[s23], v[146:147], v[128:129], v[144:145] op_sel_hi:[0,1,1] neg_lo:[1,0,0] neg_hi:[1,0,0]\n\t" \
    "v_pk_mul_f32 v[140:141], %[s01], v[134:135]\n\t" \
    "v_pk_fma_f32 v[140:141], %[s23], v[136:137], v[140:141]\n\t" \
    "v_add_f32 %[yp], v140, v141\n\t" \
    "s_waitcnt lgkmcnt(0)\n\t" \
    "ds_read_b128 v[118:121], %[ab] offset:25856\n\t" \
    "ds_read_b128 v[122:125], %[ab] offset:1280\n\t" \
    "ds_read_b128 v[126:129], %[ab] offset:17664\n\t" \
    "ds_read_b128 v[130:133], %[ab] offset:9472\n\t" \
    "ds_read_b128 v[134:137], %[ab] offset:34048\n\t" \
    "ds_read_b32 v138, %[av] offset:320\n\t" \
    "v_pk_mul_f32 v[140:141], %[s01], v[96:97]\n\t" \
    "v_pk_fma_f32 v[140:141], %[s23], v[98:99], v[140:141]\n\t" \
    "v_add_f32 v146, v140, v141\n\t" \
    "v_pk_mul_f32 v[142:143], %[s01], v[100:101]\n\t" \
    "v_pk_mul_f32 v[144:145], %[s23], v[102:103]\n\t" \
    "v_add_f32_dpp v146, v146, v146 quad_perm:[1,0,3,2] row_mask:0xf bank_mask:0xf bound_ctrl:1\n\t" \
    "v_add_f32_dpp %[yp], %[yp], %[yp] quad_perm:[1,0,3,2] row_mask:0xf bank_mask:0xf bound_ctrl:1\n\t" \
    "v_pk_fma_f32 v[142:143], v[116:117], v[108:109], v[142:143] op_sel_hi:[0,1,1]\n\t" \
    "v_add_f32_dpp v146, v146, v146 quad_perm:[2,3,0,1] row_mask:0xf bank_mask:0xf bound_ctrl:1\n\t" \
    "v_add_f32_dpp %[yp], %[yp], %[yp] quad_perm:[2,3,0,1] row_mask:0xf bank_mask:0xf bound_ctrl:1\n\t" \
    "v_pk_fma_f32 v[144:145], v[116:117], v[110:111], v[144:145] op_sel_hi:[0,1,1]\n\t" \
    "v_add_f32_dpp v146, v146, v146 row_half_mirror row_mask:0xf bank_mask:0xf bound_ctrl:1\n\t" \
    "v_add_f32_dpp %[yp], %[yp], %[yp] row_half_mirror row_mask:0xf bank_mask:0xf bound_ctrl:1\n\t" \
    "v_cmp_eq_u32_e32 vcc, 3, %[sp]\n\t" \
    "v_add_f32_dpp v146, v146, v146 row_mirror row_mask:0xf bank_mask:0xf bound_ctrl:1\n\t" \
    "v_add_f32_dpp %[yp], %[yp], %[yp] row_mirror row_mask:0xf bank_mask:0xf bound_ctrl:1\n\t" \
    "v_cndmask_b32_e32 %[yk0], %[yk0], %[yp], vcc\n\t" \
    "v_pk_fma_f32 %[s01], v[146:147], v[104:105], v[142:143] op_sel_hi:[0,1,1] neg_lo:[1,0,0] neg_hi:[1,0,0]\n\t" \
    "v_pk_fma_f32 %[s23], v[146:147], v[106:107], v[144:145] op_sel_hi:[0,1,1] neg_lo:[1,0,0] neg_hi:[1,0,0]\n\t" \
    "v_pk_mul_f32 v[140:141], %[s01], v[112:113]\n\t" \
    "v_pk_fma_f32 v[140:141], %[s23], v[114:115], v[140:141]\n\t" \
    "v_add_f32 %[yp], v140, v141\n\t" \
    "s_waitcnt lgkmcnt(0)\n\t" \
    "ds_read_b128 v[96:99], %[ab] offset:26112\n\t" \
    "ds_read_b128 v[100:103], %[ab] offset:1536\n\t" \
    "ds_read_b128 v[104:107], %[ab] offset:17920\n\t" \
    "ds_read_b128 v[108:111], %[ab] offset:9728\n\t" \
    "ds_read_b128 v[112:115], %[ab] offset:34304\n\t" \
    "ds_read_b32 v116, %[av] offset:384\n\t" \
    "v_pk_mul_f32 v[140:141], %[s01], v[118:119]\n\t" \
    "v_pk_fma_f32 v[140:141], %[s23], v[120:121], v[140:141]\n\t" \
    "v_add_f32 v146, v140, v141\n\t" \
    "v_pk_mul_f32 v[142:143], %[s01], v[122:123]\n\t" \
    "v_pk_mul_f32 v[144:145], %[s23], v[124:125]\n\t" \
    "v_add_f32_dpp v146, v146, v146 quad_perm:[1,0,3,2] row_mask:0xf bank_mask:0xf bound_ctrl:1\n\t" \
    "v_add_f32_dpp %[yp], %[yp], %[yp] quad_perm:[1,0,3,2] row_mask:0xf bank_mask:0xf bound_ctrl:1\n\t" \
    "v_pk_fma_f32 v[142:143], v[138:139], v[130:131], v[142:143] op_sel_hi:[0,1,1]\n\t" \
    "v_add_f32_dpp v146, v146, v146 quad_perm:[2,3,0,1] row_mask:0xf bank_mask:0xf bound_ctrl:1\n\t" \
    "v_add_f32_dpp %[yp], %[yp], %[yp] quad_perm:[2,3,0,1] row_mask:0xf bank_mask:0xf bound_ctrl:1\n\t" \
    "v_pk_fma_f32 v[144:145], v[138:139], v[132:133], v[144:145] op_sel_hi:[0,1,1]\n\t" \
    "v_add_f32_dpp v146, v146, v146 row_half_mirror row_mask:0xf bank_mask:0xf bound_ctrl:1\n\t" \
    "v_add_f32_dpp %[yp], %[yp], %[yp] row_half_mirror row_mask:0xf bank_mask:0xf bound_ctrl:1\n\t" \
    "v_cmp_eq_u32_e32 vcc, 4, %[sp]\n\t" \
    "v_add_f32_dpp v146, v146, v146 row_mirror row_mask:0xf bank_mask:0xf bound_ctrl:1\n\t" \
    "v_add_f32_dpp %[yp], %[yp], %[yp] row_mirror row_mask:0xf bank_mask:0xf bound_ctrl:1\n\t" \
    "v_cndmask_b32_e32 %[yk0], %[yk0], %[yp], vcc\n\t" \
    "v_pk_fma_f32 %[s01], v[146:147], v[126:127], v[142:143] op_sel_hi:[0,1,1] neg_lo:[1,0,0] neg_hi:[1,0,0]\n\t" \
    "v_pk_fma_f32 %[s23], v[146:147], v[128:129], v[144:145] op_sel_hi:[0,1,1] neg_lo:[1,0,0] neg_hi:[1,0,0]\n\t" \
    "v_pk_mul_f32 v[140:141], %[s01], v[134:135]\n\t" \
    "v_pk_fma_f32 v[140:141], %[s23], v[136:137], v[140:141]\n\t" \
    "v_add_f32 %[yp], v140, v141\n\t" \
    "s_waitcnt lgkmcnt(0)\n\t" \
    "ds_read_b128 v[118:121], %[ab] offset:26368\n\t" \
    "ds_read_b128 v[122:125], %[ab] offset:1792\n\t" \
    "ds_read_b128 v[126:129], %[ab] offset:18176\n\t" \
    "ds_read_b128 v[130:133], %[ab] offset:9984\n\t" \
    "ds_read_b128 v[134:137], %[ab] offset:34560\n\t" \
    "ds_read_b32 v138, %[av] offset:448\n\t" \
    "v_pk_mul_f32 v[140:141], %[s01], v[96:97]\n\t" \
    "v_pk_fma_f32 v[140:141], %[s23], v[98:99], v[140:141]\n\t" \
    "v_add_f32 v146, v140, v141\n\t" \
    "v_pk_mul_f32 v[142:143], %[s01], v[100:101]\n\t" \
    "v_pk_mul_f32 v[144:145], %[s23], v[102:103]\n\t" \
    "v_add_f32_dpp v146, v146, v146 quad_perm:[1,0,3,2] row_mask:0xf bank_mask:0xf bound_ctrl:1\n\t" \
    "v_add_f32_dpp %[yp], %[yp], %[yp] quad_perm:[1,0,3,2] row_mask:0xf bank_mask:0xf bound_ctrl:1\n\t" \
    "v_pk_fma_f32 v[142:143], v[116:117], v[108:109], v[142:143] op_sel_hi:[0,1,1]\n\t" \
    "v_add_f32_dpp v146, v146, v146 quad_perm:[2,3,0,1] row_mask:0xf bank_mask:0xf bound_ctrl:1\n\t" \
    "v_add_f32_dpp %[yp], %[yp], %[yp] quad_perm:[2,3,0,1] row_mask:0xf bank_mask:0xf bound_ctrl:1\n\t" \
    "v_pk_fma_f32 v[144:145], v[116:117], v[110:111], v[144:145] op_sel_hi:[0,1,1]\n\t" \
    "v_add_f32_dpp v146, v146, v146 row_half_mirror row_mask:0xf bank_mask:0xf bound_ctrl:1\n\t" \
    "v_add_f32_dpp %[yp], %[yp], %[yp] row_half_mirror row_mask:0xf bank_mask:0xf bound_ctrl:1\n\t" \
    "v_cmp_eq_u32_e32 vcc, 5, %[sp]\n\t" \
    "v_add_f32_dpp v146, v146, v146 row_mirror row_mask:0xf bank_mask:0xf bound_ctrl:1\n\t" \
    "v_add_f32_dpp %[yp], %[yp], %[yp] row_mirror row_mask:0xf bank_mask:0xf bound_ctrl:1\n\t" \
    "v_cndmask_b32_e32 %[yk0], %[yk0], %[yp], vcc\n\t" \
    "v_pk_fma_f32 %[s01], v[146:147], v[104:105], v[142:143] op_sel_hi:[0,1,1] neg_lo:[1,0,0] neg_hi:[1,0,0]\n\t" \
    "v_pk_fma_f32 %[s23], v[146:147], v[106:107], v[144:145] op_sel_hi:[0,1,1] neg_lo:[1,0,0] neg_hi:[1,0,0]\n\t" \
    "v_pk_mul_f32 v[140:141], %[s01], v[112:113]\n\t" \
    "v_pk_fma_f32 v[140:141], %[s23], v[114:115], v[140:141]\n\t" \
    "v_add_f32 %[yp], v140, v141\n\t" \
    "s_waitcnt lgkmcnt(0)\n\t" \
    "ds_read_b128 v[96:99], %[ab] offset:26624\n\t" \
    "ds_read_b128 v[100:103], %[ab] offset:2048\n\t" \
    "ds_read_b128 v[104:107], %[ab] offset:18432\n\t" \
    "ds_read_b128 v[108:111], %[ab] offset:10240\n\t" \
    "ds_read_b128 v[112:115], %[ab] offset:34816\n\t" \
    "ds_read_b32 v116, %[av] offset:512\n\t" \
    "v_pk_mul_f32 v[140:141], %[s01], v[118:119]\n\t" \
    "v_pk_fma_f32 v[140:141], %[s23], v[120:121], v[140:141]\n\t" \
    "v_add_f32 v146, v140, v141\n\t" \
    "v_pk_mul_f32 v[142:143], %[s01], v[122:123]\n\t" \
    "v_pk_mul_f32 v[144:145], %[s23], v[124:125]\n\t" \
    "v_add_f32_dpp v146, v146, v146 quad_perm:[1,0,3,2] row_mask:0xf bank_mask:0xf bound_ctrl:1\n\t" \
    "v_add_f32_dpp %[yp], %[yp], %[yp] quad_perm:[1,0,3,2] row_mask:0xf bank_mask:0xf bound_ctrl:1\n\t" \
    "v_pk_fma_f32 v[142:143], v[138:139], v[130:131], v[142:143] op_sel_hi:[0,1,1]\n\t" \
    "v_add_f32_dpp v146, v146, v146 quad_perm:[2,3,0,1] row_mask:0xf bank_mask:0xf bound_ctrl:1\n\t" \
    "v_add_f32_dpp %[yp], %[yp], %[yp] quad_perm:[2,3,0,1] row_mask:0xf bank_mask:0xf bound_ctrl:1\n\t" \
    "v_pk_fma_f32 v[144:145], v[138:139], v[132:133], v[144:145] op_sel_hi:[0,1,1]\n\t" \
    "v_add_f32_dpp v146, v146, v146 row_half_mirror row_mask:0xf bank_mask:0xf bound_ctrl:1\n\t" \
    "v_add_f32_dpp %[yp], %[yp], %[yp] row_half_mirror row_mask:0xf bank_mask:0xf bound_ctrl:1\n\t" \
    "v_cmp_eq_u32_e32 vcc, 6, %[sp]\n\t" \
    "v_add_f32_dpp v146, v146, v146 row_mirror row_mask:0xf bank_mask:0xf bound_ctrl:1\n\t" \
    "v_add_f32_dpp %[yp], %[yp], %[yp] row_mirror row_mask:0xf bank_mask:0xf bound_ctrl:1\n\t" \
    "v_cndmask_b32_e32 %[yk0], %[yk0], %[yp], vcc\n\t" \
    "v_pk_fma_f32 %[s01], v[146:147], v[126:127], v[142:143] op_sel_hi:[0,1,1] neg_lo:[1,0,0] neg_hi:[1,0,0]\n\t" \
    "v_pk_fma_f32 %[s23], v[146:147], v[128:129], v[144:145] op_sel_hi:[0,1,1] neg_lo:[1,0,0] neg_hi:[1,0,0]\n\t" \
    "v_pk_mul_f32 v[140:141], %[s01], v[134:135]\n\t" \
    "v_pk_fma_f32 v[140:141], %[s23], v[136:137], v[140:141]\n\t" \
    "v_add_f32 %[yp], v140, v141\n\t" \
    "s_waitcnt lgkmcnt(0)\n\t" \
    "ds_read_b128 v[118:121], %[ab] offset:26880\n\t" \
    "ds_read_b128 v[122:125], %[ab] offset:2304\n\t" \
    "ds_read_b128 v[126:129], %[ab] offset:18688\n\t" \
    "ds_read_b128 v[130:133], %[ab] offset:10496\n\t" \
    "ds_read_b128 v[134:137], %[ab] offset:35072\n\t" \
    "ds_read_b32 v138, %[av] offset:576\n\t" \
    "v_pk_mul_f32 v[140:141], %[s01], v[96:97]\n\t" \
    "v_pk_fma_f32 v[140:141], %[s23], v[98:99], v[140:141]\n\t" \
    "v_add_f32 v146, v140, v141\n\t" \
    "v_pk_mul_f32 v[142:143], %[s01], v[100:101]\n\t" \
    "v_pk_mul_f32 v[144:145], %[s23], v[102:103]\n\t" \
    "v_add_f32_dpp v146, v146, v146 quad_perm:[1,0,3,2] row_mask:0xf bank_mask:0xf bound_ctrl:1\n\t" \
    "v_add_f32_dpp %[yp], %[yp], %[yp] quad_perm:[1,0,3,2] row_mask:0xf bank_mask:0xf bound_ctrl:1\n\t" \
    "v_pk_fma_f32 v[142:143], v[116:117], v[108:109], v[142:143] op_sel_hi:[0,1,1]\n\t" \
    "v_add_f32_dpp v146, v146, v146 quad_perm:[2,3,0,1] row_mask:0xf bank_mask:0xf bound_ctrl:1\n\t" \
    "v_add_f32_dpp %[yp], %[yp], %[yp] quad_perm:[2,3,0,1] row_mask:0xf bank_mask:0xf bound_ctrl:1\n\t" \
    "v_pk_fma_f32 v[144:145], v[116:117], v[110:111], v[144:145] op_sel_hi:[0,1,1]\n\t" \
    "v_add_f32_dpp v146, v146, v146 row_half_mirror row_mask:0xf bank_mask:0xf bound_ctrl:1\n\t" \
    "v_add_f32_dpp %[yp], %[yp], %[yp] row_half_mirror row_mask:0xf bank_mask:0xf bound_ctrl:1\n\t" \
    "v_cmp_eq_u32_e32 vcc, 7, %[sp]\n\t" \
    "v_add_f32_dpp v146, v146, v146 row_mirror row_mask:0xf bank_mask:0xf bound_ctrl:1\n\t" \
    "v_add_f32_dpp %[yp], %[yp], %[yp] row_mirror row_mask:0xf bank_mask:0xf bound_ctrl:1\n\t" \
    "v_cndmask_b32_e32 %[yk0], %[yk0], %[yp], vcc\n\t" \
    "v_pk_fma_f32 %[s01], v[146:147], v[104:105], v[142:143] op_sel_hi:[0,1,1] neg_lo:[1,0,0] neg_hi:[1,0,0]\n\t" \
    "v_pk_fma_f32 %[s23], v[146:147], v[106:107], v[144:145] op_sel_hi:[0,1,1] neg_lo:[1,0,0] neg_hi:[1,0,0]\n\t" \
    "v_pk_mul_f32 v[140:141], %[s01], v[112:113]\n\t" \
    "v_pk_fma_f32 v[140:141], %[s23], v[114:115], v[140:141]\n\t" \
    "v_add_f32 %[yp], v140, v141\n\t" \
    "s_waitcnt lgkmcnt(0)\n\t" \
    "ds_read_b128 v[96:99], %[ab] offset:27136\n\t" \
    "ds_read_b128 v[100:103], %[ab] offset:2560\n\t" \
    "ds_read_b128 v[104:107], %[ab] offset:18944\n\t" \
    "ds_read_b128 v[108:111], %[ab] offset:10752\n\t" \
    "ds_read_b128 v[112:115], %[ab] offset:35328\n\t" \
    "ds_read_b32 v116, %[av] offset:640\n\t" \
    "v_pk_mul_f32 v[140:141], %[s01], v[118:119]\n\t" \
    "v_pk_fma_f32 v[140:141], %[s23], v[120:121], v[140:141]\n\t" \
    "v_add_f32 v146, v140, v141\n\t" \
    "v_pk_mul_f32 v[142:143], %[s01], v[122:123]\n\t" \
    "v_pk_mul_f32 v[144:145], %[s23], v[124:125]\n\t" \
    "v_add_f32_dpp v146, v146, v146 quad_perm:[1,0,3,2] row_mask:0xf bank_mask:0xf bound_ctrl:1\n\t" \
    "v_add_f32_dpp %[yp], %[yp], %[yp] quad_perm:[1,0,3,2] row_mask:0xf bank_mask:0xf bound_ctrl:1\n\t" \
    "v_pk_fma_f32 v[142:143], v[138:139], v[130:131], v[142:143] op_sel_hi:[0,1,1]\n\t" \
    "v_add_f32_dpp v146, v146, v146 quad_perm:[2,3,0,1] row_mask:0xf bank_mask:0xf bound_ctrl:1\n\t" \
    "v_add_f32_dpp %[yp], %[yp], %[yp] quad_perm:[2,3,0,1] row_mask:0xf bank_mask:0xf bound_ctrl:1\n\t" \
    "v_pk_fma_f32 v[144:145], v[138:139], v[132:133], v[144:145] op_sel_hi:[0,1,1]\n\t" \
    "v_add_f32_dpp v146, v146, v146 row_half_mirror row_mask:0xf bank_mask:0xf bound_ctrl:1\n\t" \
    "v_add_f32_dpp %[yp], %[yp], %[yp] row_half_mirror row_mask:0xf bank_mask:0xf bound_ctrl:1\n\t" \
    "v_cmp_eq_u32_e32 vcc, 8, %[sp]\n\t" \
    "v_add_f32_dpp v146, v146, v146 row_mirror row_mask:0xf bank_mask:0xf bound_ctrl:1\n\t" \
    "v_add_f32_dpp %[yp], %[yp], %[yp] row_mirror row_mask:0xf bank_mask:0xf bound_ctrl:1\n\t" \
    "v_cndmask_b32_e32 %[yk0], %[yk0], %[yp], vcc\n\t" \
    "v_pk_fma_f32 %[s01], v[146:147], v[126:127], v[142:143] op_sel_hi:[0,1,1] neg_lo:[1,0,0] neg_hi:[1,0,0]\n\t" \
    "v_pk_fma_f32 %[s23], v[146:147], v[128:129], v[144:145] op_sel_hi:[0,1,1] neg_lo:[1,0,0] neg_hi:[1,0,0]\n\t" \
    "v_pk_mul_f32 v[140:141], %[s01], v[134:135]\n\t" \
    "v_pk_fma_f32 v[140:141], %[s23], v[136:137], v[140:141]\n\t" \
    "v_add_f32 %[yp], v140, v141\n\t" \
    "s_waitcnt lgkmcnt(0)\n\t" \
    "ds_read_b128 v[118:121], %[ab] offset:27392\n\t" \
    "ds_read_b128 v[122:125], %[ab] offset:2816\n\t" \
    "ds_read_b128 v[126:129], %[ab] offset:19200\n\t" \
    "ds_read_b128 v[130:133], %[ab] offset:11008\n\t" \
    "ds_read_b128 v[134:137], %[ab] offset:35584\n\t" \
    "ds_read_b32 v138, %[av] offset:704\n\t" \
    "v_pk_mul_f32 v[140:141], %[s01], v[96:97]\n\t" \
    "v_pk_fma_f32 v[140:141], %[s23], v[98:99], v[140:141]\n\t" \
    "v_add_f32 v146, v140, v141\n\t" \
    "v_pk_mul_f32 v[142:143], %[s01], v[100:101]\n\t" \
    "v_pk_mul_f32 v[144:145], %[s23], v[102:103]\n\t" \
    "v_add_f32_dpp v146, v146, v146 quad_perm:[1,0,3,2] row_mask:0xf bank_mask:0xf bound_ctrl:1\n\t" \
    "v_add_f32_dpp %[yp], %[yp], %[yp] quad_perm:[1,0,3,2] row_mask:0xf bank_mask:0xf bound_ctrl:1\n\t" \
    "v_pk_fma_f32 v[142:143], v[116:117], v[108:109], v[142:143] op_sel_hi:[0,1,1]\n\t" \
    "v_add_f32_dpp v146, v146, v146 quad_perm:[2,3,0,1] row_mask:0xf bank_mask:0xf bound_ctrl:1\n\t" \
    "v_add_f32_dpp %[yp], %[yp], %[yp] quad_perm:[2,3,0,1] row_mask:0xf bank_mask:0xf bound_ctrl:1\n\t" \
    "v_pk_fma_f32 v[144:145], v[116:117], v[110:111], v[144:145] op_sel_hi:[0,1,1]\n\t" \
    "v_add_f32_dpp v146, v146, v146 row_half_mirror row_mask:0xf bank_mask:0xf bound_ctrl:1\n\t" \
    "v_add_f32_dpp %[yp], %[yp], %[yp] row_half_mirror row_mask:0xf bank_mask:0xf bound_ctrl:1\n\t" \
    "v_cmp_eq_u32_e32 vcc, 9, %[sp]\n\t" \
    "v_add_f32_dpp v146, v146, v146 row_mirror row_mask:0xf bank_mask:0xf bound_ctrl:1\n\t" \
    "v_add_f32_dpp %[yp], %[yp], %[yp] row_mirror row_mask:0xf bank_mask:0xf bound_ctrl:1\n\t" \
    "v_cndmask_b32_e32 %[yk0], %[yk0], %[yp], vcc\n\t" \
    "v_pk_fma_f32 %[s01], v[146:147], v[104:105], v[142:143] op_sel_hi:[0,1,1] neg_lo:[1,0,0] neg_hi:[1,0,0]\n\t" \
    "v_pk_fma_f32 %[s23], v[146:147], v[106:107], v[144:145] op_sel_hi:[0,1,1] neg_lo:[1,0,0] neg_hi:[1,0,0]\n\t" \
    "v_pk_mul_f32 v[140:141], %[s01], v[112:113]\n\t" \
    "v_pk_fma_f32 v[140:141], %[s23], v[114:115], v[140:141]\n\t" \
    "v_add_f32 %[yp], v140, v141\n\t" \
    "s_waitcnt lgkmcnt(0)\n\t" \
    "ds_read_b128 v[96:99], %[ab] offset:27648\n\t" \
    "ds_read_b128 v[100:103], %[ab] offset:3072\n\t" \
    "ds_read_b128 v[104:107], %[ab] offset:19456\n\t" \
    "ds_read_b128 v[108:111], %[ab] offset:11264\n\t" \
    "ds_read_b128 v[112:115], %[ab] offset:35840\n\t" \
    "ds_read_b32 v116, %[av] offset:768\n\t" \
    "v_pk_mul_f32 v[140:141], %[s01], v[118:119]\n\t" \
    "v_pk_fma_f32 v[140:141], %[s23], v[120:121], v[140:141]\n\t" \
    "v_add_f32 v146, v140, v141\n\t" \
    "v_pk_mul_f32 v[142:143], %[s01], v[122:123]\n\t" \
    "v_pk_mul_f32 v[144:145], %[s23], v[124:125]\n\t" \
    "v_add_f32_dpp v146, v146, v146 quad_perm:[1,0,3,2] row_mask:0xf bank_mask:0xf bound_ctrl:1\n\t" \
    "v_add_f32_dpp %[yp], %[yp], %[yp] quad_perm:[1,0,3,2] row_mask:0xf bank_mask:0xf bound_ctrl:1\n\t" \
    "v_pk_fma_f32 v[142:143], v[138:139], v[130:131], v[142:143] op_sel_hi:[0,1,1]\n\t" \
    "v_add_f32_dpp v146, v146, v146 quad_perm:[2,3,0,1] row_mask:0xf bank_mask:0xf bound_ctrl:1\n\t" \
    "v_add_f32_dpp %[yp], %[yp], %[yp] quad_perm:[2,3,0,1] row_mask:0xf bank_mask:0xf bound_ctrl:1\n\t" \
    "v_pk_fma_f32 v[144:145], v[138:139], v[132:133], v[144:145] op_sel_hi:[0,1,1]\n\t" \
    "v_add_f32_dpp v146, v146, v146 row_half_mirror row_mask:0xf bank_mask:0xf bound_ctrl:1\n\t" \
    "v_add_f32_dpp %[yp], %[yp], %[yp] row_half_mirror row_mask:0xf bank_mask:0xf bound_ctrl:1\n\t" \
    "v_cmp_eq_u32_e32 vcc, 10, %[sp]\n\t" \
    "v_add_f32_dpp v146, v146, v146 row_mirror row_mask:0xf bank_mask:0xf bound_ctrl:1\n\t" \
    "v_add_f32_dpp %[yp], %[yp], %[yp] row_mirror row_mask:0xf bank_mask:0xf bound_ctrl:1\n\t" \
    "v_cndmask_b32_e32 %[yk0], %[yk0], %[yp], vcc\n\t" \
    "v_pk_fma_f32 %[s01], v[146:147], v[126:127], v[142:143] op_sel_hi:[0,1,1] neg_lo:[1,0,0] neg_hi:[1,0,0]\n\t" \
    "v_pk_fma_f32 %[s23], v[146:147], v[128:129], v[144:145] op_sel_hi:[0,1,1] neg_lo:[1,0,0] neg_hi:[1,0,0]\n\t" \
    "v_pk_mul_f32 v[140:141], %[s01], v[134:135]\n\t" \
    "v_pk_fma_f32 v[140:141], %[s23], v[136:137], v[140:141]\n\t" \
    "v_add_f32 %[yp], v140, v141\n\t" \
    "s_waitcnt lgkmcnt(0)\n\t" \
    "ds_read_b128 v[118:121], %[ab] offset:27904\n\t" \
    "ds_read_b128 v[122:125], %[ab] offset:3328\n\t" \
    "ds_read_b128 v[126:129], %[ab] offset:19712\n\t" \
    "ds_read_b128 v[130:133], %[ab] offset:11520\n\t" \
    "ds_read_b128 v[134:137], %[ab] offset:36096\n\t" \
    "ds_read_b32 v138, %[av] offset:832\n\t" \
    "v_pk_mul_f32 v[140:141], %[s01], v[96:97]\n\t" \
    "v_pk_fma_f32 v[140:141], %[s23], v[98:99], v[140:141]\n\t" \
    "v_add_f32 v146, v140, v141\n\t" \
    "v_pk_mul_f32 v[142:143], %[s01], v[100:101]\n\t" \
    "v_pk_mul_f32 v[144:145], %[s23], v[102:103]\n\t" \
    "v_add_f32_dpp v146, v146, v146 quad_perm:[1,0,3,2] row_mask:0xf bank_mask:0xf bound_ctrl:1\n\t" \
    "v_add_f32_dpp %[yp], %[yp], %[yp] quad_perm:[1,0,3,2] row_mask:0xf bank_mask:0xf bound_ctrl:1\n\t" \
    "v_pk_fma_f32 v[142:143], v[116:117], v[108:109], v[142:143] op_sel_hi:[0,1,1]\n\t" \
    "v_add_f32_dpp v146, v146, v146 quad_perm:[2,3,0,1] row_mask:0xf bank_mask:0xf bound_ctrl:1\n\t" \
    "v_add_f32_dpp %[yp], %[yp], %[yp] quad_perm:[2,3,0,1] row_mask:0xf bank_mask:0xf bound_ctrl:1\n\t" \
    "v_pk_fma_f32 v[144:145], v[116:117], v[110:111], v[144:145] op_sel_hi:[0,1,1]\n\t" \
    "v_add_f32_dpp v146, v146, v146 row_half_mirror row_mask:0xf bank_mask:0xf bound_ctrl:1\n\t" \
    "v_add_f32_dpp %[yp], %[yp], %[yp] row_half_mirror row_mask:0xf bank_mask:0xf bound_ctrl:1\n\t" \
    "v_cmp_eq_u32_e32 vcc, 11, %[sp]\n\t" \
    "v_add_f32_dpp v146, v146, v146 row_mirror row_mask:0xf bank_mask:0xf bound_ctrl:1\n\t" \
    "v_add_f32_dpp %[yp], %[yp], %[yp] row_mirror row_mask:0xf bank_mask:0xf bound_ctrl:1\n\t" \
    "v_cndmask_b32_e32 %[yk0], %[yk0], %[yp], vcc\n\t" \
    "v_pk_fma_f32 %[s01], v[146:147], v[104:105], v[142:143] op_sel_hi:[0,1,1] neg_lo:[1,0,0] neg_hi:[1,0,0]\n\t" \
    "v_pk_fma_f32 %[s23], v[146:147], v[106:107], v[144:145] op_sel_hi:[0,1,1] neg_lo:[1,0,0] neg_hi:[1,0,0]\n\t" \
    "v_pk_mul_f32 v[140:141], %[s01], v[112:113]\n\t" \
    "v_pk_fma_f32 v[140:141], %[s23], v[114:115], v[140:141]\n\t" \
    "v_add_f32 %[yp], v140, v141\n\t" \
    "s_waitcnt lgkmcnt(0)\n\t" \
    "ds_read_b128 v[96:99], %[ab] offset:28160\n\t" \
    "ds_read_b128 v[100:103], %[ab] offset:3584\n\t" \
    "ds_read_b128 v[104:107], %[ab] offset:19968\n\t" \
    "ds_read_b128 v[108:111], %[ab] offset:11776\n\t" \
    "ds_read_b128 v[112:115], %[ab] offset:36352\n\t" \
    "ds_read_b32 v116, %[av] offset:896\n\t" \
    "v_pk_mul_f32 v[140:141], %[s01], v[118:119]\n\t" \
    "v_pk_fma_f32 v[140:141], %[s23], v[120:121], v[140:141]\n\t" \
    "v_add_f32 v146, v140, v141\n\t" \
    "v_pk_mul_f32 v[142:143], %[s01], v[122:123]\n\t" \
    "v_pk_mul_f32 v[144:145], %[s23], v[124:125]\n\t" \
    "v_add_f32_dpp v146, v146, v146 quad_perm:[1,0,3,2] row_mask:0xf bank_mask:0xf bound_ctrl:1\n\t" \
    "v_add_f32_dpp %[yp], %[yp], %[yp] quad_perm:[1,0,3,2] row_mask:0xf bank_mask:0xf bound_ctrl:1\n\t" \
    "v_pk_fma_f32 v[142:143], v[138:139], v[130:131], v[142:143] op_sel_hi:[0,1,1]\n\t" \
    "v_add_f32_dpp v146, v146, v146 quad_perm:[2,3,0,1] row_mask:0xf bank_mask:0xf bound_ctrl:1\n\t" \
    "v_add_f32_dpp %[yp], %[yp], %[yp] quad_perm:[2,3,0,1] row_mask:0xf bank_mask:0xf bound_ctrl:1\n\t" \
    "v_pk_fma_f32 v[144:145], v[138:139], v[132:133], v[144:145] op_sel_hi:[0,1,1]\n\t" \
    "v_add_f32_dpp v146, v146, v146 row_half_mirror row_mask:0xf bank_mask:0xf bound_ctrl:1\n\t" \
    "v_add_f32_dpp %[yp], %[yp], %[yp] row_half_mirror row_mask:0xf bank_mask:0xf bound_ctrl:1\n\t" \
    "v_cmp_eq_u32_e32 vcc, 12, %[sp]\n\t" \
    "v_add_f32_dpp v146, v146, v146 row_mirror row_mask:0xf bank_mask:0xf bound_ctrl:1\n\t" \
    "v_add_f32_dpp %[yp], %[yp], %[yp] row_mirror row_mask:0xf bank_mask:0xf bound_ctrl:1\n\t" \
    "v_cndmask_b32_e32 %[yk0], %[yk0], %[yp], vcc\n\t" \
    "v_pk_fma_f32 %[s01], v[146:147], v[126:127], v[142:143] op_sel_hi:[0,1,1] neg_lo:[1,0,0] neg_hi:[1,0,0]\n\t" \
    "v_pk_fma_f32 %[s23], v[146:147], v[128:129], v[144:145] op_sel_hi:[0,1,1] neg_lo:[1,0,0] neg_hi:[1,0,0]\n\t" \
    "v_pk_mul_f32 v[140:141], %[s01], v[134:135]\n\t" \
    "v_pk_fma_f32 v[140:141], %[s23], v[136:137], v[140:141]\n\t" \
    "v_add_f32 %[yp], v140, v141\n\t" \
    "s_waitcnt lgkmcnt(0)\n\t" \
    "ds_read_b128 v[118:121], %[ab] offset:28416\n\t" \
    "ds_read_b128 v[122:125], %[ab] offset:3840\n\t" \
    "ds_read_b128 v[126:129], %[ab] offset:20224\n\t" \
    "ds_read_b128 v[130:133], %[ab] offset:12032\n\t" \
    "ds_read_b128 v[134:137], %[ab] offset:36608\n\t" \
    "ds_read_b32 v138, %[av] offset:960\n\t" \
    "v_pk_mul_f32 v[140:141], %[s01], v[96:97]\n\t" \
    "v_pk_fma_f32 v[140:141], %[s23], v[98:99], v[140:141]\n\t" \
    "v_add_f32 v146, v140, v141\n\t" \
    "v_pk_mul_f32 v[142:143], %[s01], v[100:101]\n\t" \
    "v_pk_mul_f32 v[144:145], %[s23], v[102:103]\n\t" \
    "v_add_f32_dpp v146, v146, v146 quad_perm:[1,0,3,2] row_mask:0xf bank_mask:0xf bound_ctrl:1\n\t" \
    "v_add_f32_dpp %[yp], %[yp], %[yp] quad_perm:[1,0,3,2] row_mask:0xf bank_mask:0xf bound_ctrl:1\n\t" \
    "v_pk_fma_f32 v[142:143], v[116:117], v[108:109], v[142:143] op_sel_hi:[0,1,1]\n\t" \
    "v_add_f32_dpp v146, v146, v146 quad_perm:[2,3,0,1] row_mask:0xf bank_mask:0xf bound_ctrl:1\n\t" \
    "v_add_f32_dpp %[yp], %[yp], %[yp] quad_perm:[2,3,0,1] row_mask:0xf bank_mask:0xf bound_ctrl:1\n\t" \
    "v_pk_fma_f32 v[144:145], v[116:117], v[110:111], v[144:145] op_sel_hi:[0,1,1]\n\t" \
    "v_add_f32_dpp v146, v146, v146 row_half_mirror row_mask:0xf bank_mask:0xf bound_ctrl:1\n\t" \
    "v_add_f32_dpp %[yp], %[yp], %[yp] row_half_mirror row_mask:0xf bank_mask:0xf bound_ctrl:1\n\t" \
    "v_cmp_eq_u32_e32 vcc, 13, %[sp]\n\t" \
    "v_add_f32_dpp v146, v146, v146 row_mirror row_mask:0xf bank_mask:0xf bound_ctrl:1\n\t" \
    "v_add_f32_dpp %[yp], %[yp], %[yp] row_mirror row_mask:0xf bank_mask:0xf bound_ctrl:1\n\t" \
    "v_cndmask_b32_e32 %[yk0], %[yk0], %[yp], vcc\n\t" \
    "v_pk_fma_f32 %[s01], v[146:147], v[104:105], v[142:143] op_sel_hi:[0,1,1] neg_lo:[1,0,0] neg_hi:[1,0,0]\n\t" \
    "v_pk_fma_f32 %[s23], v[146:147], v[106:107], v[144:145] op_sel_hi:[0,1,1] neg_lo:[1,0,0] neg_hi:[1,0,0]\n\t" \
    "v_pk_mul_f32 v[140:141], %[s01], v[112:113]\n\t" \
    "v_pk_fma_f32 v[140:141], %[s23], v[114:115], v[140:141]\n\t" \
    "v_add_f32 %[yp], v140, v141\n\t" \
    "s_waitcnt lgkmcnt(0)\n\t" \
    "ds_read_b128 v[96:99], %[ab] offset:28672\n\t" \
    "ds_read_b128 v[100:103], %[ab] offset:4096\n\t" \
    "ds_read_b128 v[104:107], %[ab] offset:20480\n\t" \
    "ds_read_b128 v[108:111], %[ab] offset:12288\n\t" \
    "ds_read_b128 v[112:115], %[ab] offset:36864\n\t" \
    "ds_read_b32 v116, %[av] offset:1024\n\t" \
    "v_pk_mul_f32 v[140:141], %[s01], v[118:119]\n\t" \
    "v_pk_fma_f32 v[140:141], %[s23], v[120:121], v[140:141]\n\t" \
    "v_add_f32 v146, v140, v141\n\t" \
    "v_pk_mul_f32 v[142:143], %[s01], v[122:123]\n\t" \
    "v_pk_mul_f32 v[144:145], %[s23], v[124:125]\n\t" \
    "v_add_f32_dpp v146, v146, v146 quad_perm:[1,0,3,2] row_mask:0xf bank_mask:0xf bound_ctrl:1\n\t" \
    "v_add_f32_dpp %[yp], %[yp], %[yp] quad_perm:[1,0,3,2] row_mask:0xf bank_mask:0xf bound_ctrl:1\n\t" \
    "v_pk_fma_f32 v[142:143], v[138:139], v[130:131], v[142:143] op_sel_hi:[0,1,1]\n\t" \
    "v_add_f32_dpp v146, v146, v146 quad_perm:[2,3,0,1] row_mask:0xf bank_mask:0xf bound_ctrl:1\n\t" \
    "v_add_f32_dpp %[yp], %[yp], %[yp] quad_perm:[2,3,0,1] row_mask:0xf bank_mask:0xf bound_ctrl:1\n\t" \
    "v_pk_fma_f32 v[144:145], v[138:139], v[132:133], v[144:145] op_sel_hi:[0,1,1]\n\t" \
    "v_add_f32_dpp v146, v146, v146 row_half_mirror row_mask:0xf bank_mask:0xf bound_ctrl:1\n\t" \
    "v_add_f32_dpp %[yp], %[yp], %[yp] row_half_mirror row_mask:0xf bank_mask:0xf bound_ctrl:1\n\t" \
    "v_cmp_eq_u32_e32 vcc, 14, %[sp]\n\t" \
    "v_add_f32_dpp v146, v146, v146 row_mirror row_mask:0xf bank_mask:0xf bound_ctrl:1\n\t" \
    "v_add_f32_dpp %[yp], %[yp], %[yp] row_mirror row_mask:0xf bank_mask:0xf bound_ctrl:1\n\t" \
    "v_cndmask_b32_e32 %[yk0], %[yk0], %[yp], vcc\n\t" \
    "v_pk_fma_f32 %[s01], v[146:147], v[126:127], v[142:143] op_sel_hi:[0,1,1] neg_lo:[1,0,0] neg_hi:[1,0,0]\n\t" \
    "v_pk_fma_f32 %[s23], v[146:147], v[128:129], v[144:145] op_sel_hi:[0,1,1] neg_lo:[1,0,0] neg_hi:[1,0,0]\n\t" \
    "v_pk_mul_f32 v[140:141], %[s01], v[134:135]\n\t" \
    "v_pk_fma_f32 v[140:141], %[s23], v[136:137], v[140:141]\n\t" \
    "v_add_f32 %[yp], v140, v141\n\t" \
    "s_waitcnt lgkmcnt(0)\n\t" \
    "ds_read_b128 v[118:121], %[ab] offset:28928\n\t" \
    "ds_read_b128 v[122:125], %[ab] offset:4352\n\t" \
    "ds_read_b128 v[126:129], %[ab] offset:20736\n\t" \
    "ds_read_b128 v[130:133], %[ab] offset:12544\n\t" \
    "ds_read_b128 v[134:137], %[ab] offset:37120\n\t" \
    "ds_read_b32 v138, %[av] offset:1088\n\t" \
    "v_pk_mul_f32 v[140:141], %[s01], v[96:97]\n\t" \
    "v_pk_fma_f32 v[140:141], %[s23], v[98:99], v[140:141]\n\t" \
    "v_add_f32 v146, v140, v141\n\t" \
    "v_pk_mul_f32 v[142:143], %[s01], v[100:101]\n\t" \
    "v_pk_mul_f32 v[144:145], %[s23], v[102:103]\n\t" \
    "v_add_f32_dpp v146, v146, v146 quad_perm:[1,0,3,2] row_mask:0xf bank_mask:0xf bound_ctrl:1\n\t" \
    "v_add_f32_dpp %[yp], %[yp], %[yp] quad_perm:[1,0,3,2] row_mask:0xf bank_mask:0xf bound_ctrl:1\n\t" \
    "v_pk_fma_f32 v[142:143], v[116:117], v[108:109], v[142:143] op_sel_hi:[0,1,1]\n\t" \
    "v_add_f32_dpp v146, v146, v146 quad_perm:[2,3,0,1] row_mask:0xf bank_mask:0xf bound_ctrl:1\n\t" \
    "v_add_f32_dpp %[yp], %[yp], %[yp] quad_perm:[2,3,0,1] row_mask:0xf bank_mask:0xf bound_ctrl:1\n\t" \
    "v_pk_fma_f32 v[144:145], v[116:117], v[110:111], v[144:145] op_sel_hi:[0,1,1]\n\t" \
    "v_add_f32_dpp v146, v146, v146 row_half_mirror row_mask:0xf bank_mask:0xf bound_ctrl:1\n\t" \
    "v_add_f32_dpp %[yp], %[yp], %[yp] row_half_mirror row_mask:0xf bank_mask:0xf bound_ctrl:1\n\t" \
    "v_cmp_eq_u32_e32 vcc, 15, %[sp]\n\t" \
    "v_add_f32_dpp v146, v146, v146 row_mirror row_mask:0xf bank_mask:0xf bound_ctrl:1\n\t" \
    "v_add_f32_dpp %[yp], %[yp], %[yp] row_mirror row_mask:0xf bank_mask:0xf bound_ctrl:1\n\t" \
    "v_cndmask_b32_e32 %[yk0], %[yk0], %[yp], vcc\n\t" \
    "v_pk_fma_f32 %[s01], v[146:147], v[104:105], v[142:143] op_sel_hi:[0,1,1] neg_lo:[1,0,0] neg_hi:[1,0,0]\n\t" \
    "v_pk_fma_f32 %[s23], v[146:147], v[106:107], v[144:145] op_sel_hi:[0,1,1] neg_lo:[1,0,0] neg_hi:[1,0,0]\n\t" \
    "v_pk_mul_f32 v[140:141], %[s01], v[112:113]\n\t" \
    "v_pk_fma_f32 v[140:141], %[s23], v[114:115], v[140:141]\n\t" \
    "v_add_f32 %[yp], v140, v141\n\t" \
    "s_waitcnt lgkmcnt(0)\n\t" \
    "ds_read_b128 v[96:99], %[ab] offset:29184\n\t" \
    "ds_read_b128 v[100:103], %[ab] offset:4608\n\t" \
    "ds_read_b128 v[104:107], %[ab] offset:20992\n\t" \
    "ds_read_b128 v[108:111], %[ab] offset:12800\n\t" \
    "ds_read_b128 v[112:115], %[ab] offset:37376\n\t" \
    "ds_read_b32 v116, %[av] offset:1152\n\t" \
    "v_pk_mul_f32 v[140:141], %[s01], v[118:119]\n\t" \
    "v_pk_fma_f32 v[140:141], %[s23], v[120:121], v[140:141]\n\t" \
    "v_add_f32 v146, v140, v141\n\t" \
    "v_pk_mul_f32 v[142:143], %[s01], v[122:123]\n\t" \
    "v_pk_mul_f32 v[144:145], %[s23], v[124:125]\n\t" \
    "v_add_f32_dpp v146, v146, v146 quad_perm:[1,0,3,2] row_mask:0xf bank_mask:0xf bound_ctrl:1\n\t" \
    "v_add_f32_dpp %[yp], %[yp], %[yp] quad_perm:[1,0,3,2] row_mask:0xf bank_mask:0xf bound_ctrl:1\n\t" \
    "v_pk_fma_f32 v[142:143], v[138:139], v[130:131], v[142:143] op_sel_hi:[0,1,1]\n\t" \
    "v_add_f32_dpp v146, v146, v146 quad_perm:[2,3,0,1] row_mask:0xf bank_mask:0xf bound_ctrl:1\n\t" \
    "v_add_f32_dpp %[yp], %[yp], %[yp] quad_perm:[2,3,0,1] row_mask:0xf bank_mask:0xf bound_ctrl:1\n\t" \
    "v_pk_fma_f32 v[144:145], v[138:139], v[132:133], v[144:145] op_sel_hi:[0,1,1]\n\t" \
    "v_add_f32_dpp v146, v146, v146 row_half_mirror row_mask:0xf bank_mask:0xf bound_ctrl:1\n\t" \
    "v_add_f32_dpp %[yp], %[yp], %[yp] row_half_mirror row_mask:0xf bank_mask:0xf bound_ctrl:1\n\t" \
    "v_cmp_eq_u32_e32 vcc, 0, %[sp]\n\t" \
    "v_add_f32_dpp v146, v146, v146 row_mirror row_mask:0xf bank_mask:0xf bound_ctrl:1\n\t" \
    "v_add_f32_dpp %[yp], %[yp], %[yp] row_mirror row_mask:0xf bank_mask:0xf bound_ctrl:1\n\t" \
    "v_cndmask_b32_e32 %[yk1], %[yk1], %[yp], vcc\n\t" \
    "v_pk_fma_f32 %[s01], v[146:147], v[126:127], v[142:143] op_sel_hi:[0,1,1] neg_lo:[1,0,0] neg_hi:[1,0,0]\n\t" \
    "v_pk_fma_f32 %[s23], v[146:147], v[128:129], v[144:145] op_sel_hi:[0,1,1] neg_lo:[1,0,0] neg_hi:[1,0,0]\n\t" \
    "v_pk_mul_f32 v[140:141], %[s01], v[134:135]\n\t" \
    "v_pk_fma_f32 v[140:141], %[s23], v[136:137], v[140:141]\n\t" \
    "v_add_f32 %[yp], v140, v141\n\t" \
    "s_waitcnt lgkmcnt(0)\n\t" \
    "ds_read_b128 v[118:121], %[ab] offset:29440\n\t" \
    "ds_read_b128 v[122:125], %[ab] offset:4864\n\t" \
    "ds_read_b128 v[126:129], %[ab] offset:21248\n\t" \
    "ds_read_b128 v[130:133], %[ab] offset:13056\n\t" \
    "ds_read_b128 v[134:137], %[ab] offset:37632\n\t" \
    "ds_read_b32 v138, %[av] offset:1216\n\t" \
    "v_pk_mul_f32 v[140:141], %[s01], v[96:97]\n\t" \
    "v_pk_fma_f32 v[140:141], %[s23], v[98:99], v[140:141]\n\t" \
    "v_add_f32 v146, v140, v141\n\t" \
    "v_pk_mul_f32 v[142:143], %[s01], v[100:101]\n\t" \
    "v_pk_mul_f32 v[144:145], %[s23], v[102:103]\n\t" \
    "v_add_f32_dpp v146, v146, v146 quad_perm:[1,0,3,2] row_mask:0xf bank_mask:0xf bound_ctrl:1\n\t" \
    "v_add_f32_dpp %[yp], %[yp], %[yp] quad_perm:[1,0,3,2] row_mask:0xf bank_mask:0xf bound_ctrl:1\n\t" \
    "v_pk_fma_f32 v[142:143], v[116:117], v[108:109], v[142:143] op_sel_hi:[0,1,1]\n\t" \
    "v_add_f32_dpp v146, v146, v146 quad_perm:[2,3,0,1] row_mask:0xf bank_mask:0xf bound_ctrl:1\n\t" \
    "v_add_f32_dpp %[yp], %[yp], %[yp] quad_perm:[2,3,0,1] row_mask:0xf bank_mask:0xf bound_ctrl:1\n\t" \
    "v_pk_fma_f32 v[144:145], v[116:117], v[110:111], v[144:145] op_sel_hi:[0,1,1]\n\t" \
    "v_add_f32_dpp v146, v146, v146 row_half_mirror row_mask:0xf bank_mask:0xf bound_ctrl:1\n\t" \
    "v_add_f32_dpp %[yp], %[yp], %[yp] row_half_mirror row_mask:0xf bank_mask:0xf bound_ctrl:1\n\t" \
    "v_cmp_eq_u32_e32 vcc, 1, %[sp]\n\t" \
    "v_add_f32_dpp v146, v146, v146 row_mirror row_mask:0xf bank_mask:0xf bound_ctrl:1\n\t" \
    "v_add_f32_dpp %[yp], %[yp], %[yp] row_mirror row_mask:0xf bank_mask:0xf bound_ctrl:1\n\t" \
    "v_cndmask_b32_e32 %[yk1], %[yk1], %[yp], vcc\n\t" \
    "v_pk_fma_f32 %[s01], v[146:147], v[104:105], v[142:143] op_sel_hi:[0,1,1] neg_lo:[1,0,0] neg_hi:[1,0,0]\n\t" \
    "v_pk_fma_f32 %[s23], v[146:147], v[106:107], v[144:145] op_sel_hi:[0,1,1] neg_lo:[1,0,0] neg_hi:[1,0,0]\n\t" \
    "v_pk_mul_f32 v[140:141], %[s01], v[112:113]\n\t" \
    "v_pk_fma_f32 v[140:141], %[s23], v[114:115], v[140:141]\n\t" \
    "v_add_f32 %[yp], v140, v141\n\t" \
    "s_waitcnt lgkmcnt(0)\n\t" \
    "ds_read_b128 v[96:99], %[ab] offset:29696\n\t" \
    "ds_read_b128 v[100:103], %[ab] offset:5120\n\t" \
    "ds_read_b128 v[104:107], %[ab] offset:21504\n\t" \
    "ds_read_b128 v[108:111], %[ab] offset:13312\n\t" \
    "ds_read_b128 v[112:115], %[ab] offset:37888\n\t" \
    "ds_read_b32 v116, %[av] offset:1280\n\t" \
    "v_pk_mul_f32 v[140:141], %[s01], v[118:119]\n\t" \
    "v_pk_fma_f32 v[140:141], %[s23], v[120:121], v[140:141]\n\t" \
    "v_add_f32 v146, v140, v141\n\t" \
    "v_pk_mul_f32 v[142:143], %[s01], v[122:123]\n\t" \
    "v_pk_mul_f32 v[144:145], %[s23], v[124:125]\n\t" \
    "v_add_f32_dpp v146, v146, v146 quad_perm:[1,0,3,2] row_mask:0xf bank_mask:0xf bound_ctrl:1\n\t" \
    "v_add_f32_dpp %[yp], %[yp], %[yp] quad_perm:[1,0,3,2] row_mask:0xf bank_mask:0xf bound_ctrl:1\n\t" \
    "v_pk_fma_f32 v[142:143], v[138:139], v[130:131], v[142:143] op_sel_hi:[0,1,1]\n\t" \
    "v_add_f32_dpp v146, v146, v146 quad_perm:[2,3,0,1] row_mask:0xf bank_mask:0xf bound_ctrl:1\n\t" \
    "v_add_f32_dpp %[yp], %[yp], %[yp] quad_perm:[2,3,0,1] row_mask:0xf bank_mask:0xf bound_ctrl:1\n\t" \
    "v_pk_fma_f32 v[144:145], v[138:139], v[132:133], v[144:145] op_sel_hi:[0,1,1]\n\t" \
    "v_add_f32_dpp v146, v146, v146 row_half_mirror row_mask:0xf bank_mask:0xf bound_ctrl:1\n\t" \
    "v_add_f32_dpp %[yp], %[yp], %[yp] row_half_mirror row_mask:0xf bank_mask:0xf bound_ctrl:1\n\t" \
    "v_cmp_eq_u32_e32 vcc, 2, %[sp]\n\t" \
    "v_add_f32_dpp v146, v146, v146 row_mirror row_mask:0xf bank_mask:0xf bound_ctrl:1\n\t" \
    "v_add_f32_dpp %[yp], %[yp], %[yp] row_mirror row_mask:0xf bank_mask:0xf bound_ctrl:1\n\t" \
    "v_cndmask_b32_e32 %[yk1], %[yk1], %[yp], vcc\n\t" \
    "v_pk_fma_f32 %[s01], v[146:147], v[126:127], v[142:143] op_sel_hi:[0,1,1] neg_lo:[1,0,0] neg_hi:[1,0,0]\n\t" \
    "v_pk_fma_f32 %[s23], v[146:147], v[128:129], v[144:145] op_sel_hi:[0,1,1] neg_lo:[1,0,0] neg_hi:[1,0,0]\n\t" \
    "v_pk_mul_f32 v[140:141], %[s01], v[134:135]\n\t" \
    "v_pk_fma_f32 v[140:141], %[s23], v[136:137], v[140:141]\n\t" \
    "v_add_f32 %[yp], v140, v141\n\t" \
    "s_waitcnt lgkmcnt(0)\n\t" \
    "ds_read_b128 v[118:121], %[ab] offset:29952\n\t" \
    "ds_read_b128 v[122:125], %[ab] offset:5376\n\t" \
    "ds_read_b128 v[126:129], %[ab] offset:21760\n\t" \
    "ds_read_b128 v[130:133], %[ab] offset:13568\n\t" \
    "ds_read_b128 v[134:137], %[ab] offset:38144\n\t" \
    "ds_read_b32 v138, %[av] offset:1344\n\t" \
    "v_pk_mul_f32 v[140:141], %[s01], v[96:97]\n\t" \
    "v_pk_fma_f32 v[140:141], %[s23], v[98:99], v[140:141]\n\t" \
    "v_add_f32 v146, v140, v141\n\t" \
    "v_pk_mul_f32 v[142:143], %[s01], v[100:101]\n\t" \
    "v_pk_mul_f32 v[144:145], %[s23], v[102:103]\n\t" \
    "v_add_f32_dpp v146, v146, v146 quad_perm:[1,0,3,2] row_mask:0xf bank_mask:0xf bound_ctrl:1\n\t" \
    "v_add_f32_dpp %[yp], %[yp], %[yp] quad_perm:[1,0,3,2] row_mask:0xf bank_mask:0xf bound_ctrl:1\n\t" \
    "v_pk_fma_f32 v[142:143], v[116:117], v[108:109], v[142:143] op_sel_hi:[0,1,1]\n\t" \
    "v_add_f32_dpp v146, v146, v146 quad_perm:[2,3,0,1] row_mask:0xf bank_mask:0xf bound_ctrl:1\n\t" \
    "v_add_f32_dpp %[yp], %[yp], %[yp] quad_perm:[2,3,0,1] row_mask:0xf bank_mask:0xf bound_ctrl:1\n\t" \
    "v_pk_fma_f32 v[144:145], v[116:117], v[110:111], v[144:145] op_sel_hi:[0,1,1]\n\t" \
    "v_add_f32_dpp v146, v146, v146 row_half_mirror row_mask:0xf bank_mask:0xf bound_ctrl:1\n\t" \
    "v_add_f32_dpp %[yp], %[yp], %[yp] row_half_mirror row_mask:0xf bank_mask:0xf bound_ctrl:1\n\t" \
    "v_cmp_eq_u32_e32 vcc, 3, %[sp]\n\t" \
    "v_add_f32_dpp v146, v146, v146 row_mirror row_mask:0xf bank_mask:0xf bound_ctrl:1\n\t" \
    "v_add_f32_dpp %[yp], %[yp], %[yp] row_mirror row_mask:0xf bank_mask:0xf bound_ctrl:1\n\t" \
    "v_cndmask_b32_e32 %[yk1], %[yk1], %[yp], vcc\n\t" \
    "v_pk_fma_f32 %[s01], v[146:147], v[104:105], v[142:143] op_sel_hi:[0,1,1] neg_lo:[1,0,0] neg_hi:[1,0,0]\n\t" \
    "v_pk_fma_f32 %[s23], v[146:147], v[106:107], v[144:145] op_sel_hi:[0,1,1] neg_lo:[1,0,0] neg_hi:[1,0,0]\n\t" \
    "v_pk_mul_f32 v[140:141], %[s01], v[112:113]\n\t" \
    "v_pk_fma_f32 v[140:141], %[s23], v[114:115], v[140:141]\n\t" \
    "v_add_f32 %[yp], v140, v141\n\t" \
    "s_waitcnt lgkmcnt(0)\n\t" \
    "ds_read_b128 v[96:99], %[ab] offset:30208\n\t" \
    "ds_read_b128 v[100:103], %[ab] offset:5632\n\t" \
    "ds_read_b128 v[104:107], %[ab] offset:22016\n\t" \
    "ds_read_b128 v[108:111], %[ab] offset:13824\n\t" \
    "ds_read_b128 v[112:115], %[ab] offset:38400\n\t" \
    "ds_read_b32 v116, %[av] offset:1408\n\t" \
    "v_pk_mul_f32 v[140:141], %[s01], v[118:119]\n\t" \
    "v_pk_fma_f32 v[140:141], %[s23], v[120:121], v[140:141]\n\t" \
    "v_add_f32 v146, v140, v141\n\t" \
    "v_pk_mul_f32 v[142:143], %[s01], v[122:123]\n\t" \
    "v_pk_mul_f32 v[144:145], %[s23], v[124:125]\n\t" \
    "v_add_f32_dpp v146, v146, v146 quad_perm:[1,0,3,2] row_mask:0xf bank_mask:0xf bound_ctrl:1\n\t" \
    "v_add_f32_dpp %[yp], %[yp], %[yp] quad_perm:[1,0,3,2] row_mask:0xf bank_mask:0xf bound_ctrl:1\n\t" \
    "v_pk_fma_f32 v[142:143], v[138:139], v[130:131], v[142:143] op_sel_hi:[0,1,1]\n\t" \
    "v_add_f32_dpp v146, v146, v146 quad_perm:[2,3,0,1] row_mask:0xf bank_mask:0xf bound_ctrl:1\n\t" \
    "v_add_f32_dpp %[yp], %[yp], %[yp] quad_perm:[2,3,0,1] row_mask:0xf bank_mask:0xf bound_ctrl:1\n\t" \
    "v_pk_fma_f32 v[144:145], v[138:139], v[132:133], v[144:145] op_sel_hi:[0,1,1]\n\t" \
    "v_add_f32_dpp v146, v146, v146 row_half_mirror row_mask:0xf bank_mask:0xf bound_ctrl:1\n\t" \
    "v_add_f32_dpp %[yp], %[yp], %[yp] row_half_mirror row_mask:0xf bank_mask:0xf bound_ctrl:1\n\t" \
    "v_cmp_eq_u32_e32 vcc, 4, %[sp]\n\t" \
    "v_add_f32_dpp v146, v146, v146 row_mirror row_mask:0xf bank_mask:0xf bound_ctrl:1\n\t" \
    "v_add_f32_dpp %[yp], %[yp], %[yp] row_mirror row_mask:0xf bank_mask:0xf bound_ctrl:1\n\t" \
    "v_cndmask_b32_e32 %[yk1], %[yk1], %[yp], vcc\n\t" \
    "v_pk_fma_f32 %[s01], v[146:147], v[126:127], v[142:143] op_sel_hi:[0,1,1] neg_lo:[1,0,0] neg_hi:[1,0,0]\n\t" \
    "v_pk_fma_f32 %[s23], v[146:147], v[128:129], v[144:145] op_sel_hi:[0,1,1] neg_lo:[1,0,0] neg_hi:[1,0,0]\n\t" \
    "v_pk_mul_f32 v[140:141], %[s01], v[134:135]\n\t" \
    "v_pk_fma_f32 v[140:141], %[s23], v[136:137], v[140:141]\n\t" \
    "v_add_f32 %[yp], v140, v141\n\t" \
    "s_waitcnt lgkmcnt(0)\n\t" \
    "ds_read_b128 v[118:121], %[ab] offset:30464\n\t" \
    "ds_read_b128 v[122:125], %[ab] offset:5888\n\t" \
    "ds_read_b128 v[126:129], %[ab] offset:22272\n\t" \
    "ds_read_b128 v[130:133], %[ab] offset:14080\n\t" \
    "ds_read_b128 v[134:137], %[ab] offset:38656\n\t" \
    "ds_read_b32 v138, %[av] offset:1472\n\t" \
    "v_pk_mul_f32 v[140:141], %[s01], v[96:97]\n\t" \
    "v_pk_fma_f32 v[140:141], %[s23], v[98:99], v[140:141]\n\t" \
    "v_add_f32 v146, v140, v141\n\t" \
    "v_pk_mul_f32 v[142:143], %[s01], v[100:101]\n\t" \
    "v_pk_mul_f32 v[144:145], %[s23], v[102:103]\n\t" \
    "v_add_f32_dpp v146, v146, v146 quad_perm:[1,0,3,2] row_mask:0xf bank_mask:0xf bound_ctrl:1\n\t" \
    "v_add_f32_dpp %[yp], %[yp], %[yp] quad_perm:[1,0,3,2] row_mask:0xf bank_mask:0xf bound_ctrl:1\n\t" \
    "v_pk_fma_f32 v[142:143], v[116:117], v[108:109], v[142:143] op_sel_hi:[0,1,1]\n\t" \
    "v_add_f32_dpp v146, v146, v146 quad_perm:[2,3,0,1] row_mask:0xf bank_mask:0xf bound_ctrl:1\n\t" \
    "v_add_f32_dpp %[yp], %[yp], %[yp] quad_perm:[2,3,0,1] row_mask:0xf bank_mask:0xf bound_ctrl:1\n\t" \
    "v_pk_fma_f32 v[144:145], v[116:117], v[110:111], v[144:145] op_sel_hi:[0,1,1]\n\t" \
    "v_add_f32_dpp v146, v146, v146 row_half_mirror row_mask:0xf bank_mask:0xf bound_ctrl:1\n\t" \
    "v_add_f32_dpp %[yp], %[yp], %[yp] row_half_mirror row_mask:0xf bank_mask:0xf bound_ctrl:1\n\t" \
    "v_cmp_eq_u32_e32 vcc, 5, %[sp]\n\t" \
    "v_add_f32_dpp v146, v146, v146 row_mirror row_mask:0xf bank_mask:0xf bound_ctrl:1\n\t" \
    "v_add_f32_dpp %[yp], %[yp], %[yp] row_mirror row_mask:0xf bank_mask:0xf bound_ctrl:1\n\t" \
    "v_cndmask_b32_e32 %[yk1], %[yk1], %[yp], vcc\n\t" \
    "v_pk_fma_f32 %[s01], v[146:147], v[104:105], v[142:143] op_sel_hi:[0,1,1] neg_lo:[1,0,0] neg_hi:[1,0,0]\n\t" \
    "v_pk_fma_f32 %[s23], v[146:147], v[106:107], v[144:145] op_sel_hi:[0,1,1] neg_lo:[1,0,0] neg_hi:[1,0,0]\n\t" \
    "v_pk_mul_f32 v[140:141], %[s01], v[112:113]\n\t" \
    "v_pk_fma_f32 v[140:141], %[s23], v[114:115], v[140:141]\n\t" \
    "v_add_f32 %[yp], v140, v141\n\t" \
    "s_waitcnt lgkmcnt(0)\n\t" \
    "ds_read_b128 v[96:99], %[ab] offset:30720\n\t" \
    "ds_read_b128 v[100:103], %[ab] offset:6144\n\t" \
    "ds_read_b128 v[104:107], %[ab] offset:22528\n\t" \
    "ds_read_b128 v[108:111], %[ab] offset:14336\n\t" \
    "ds_read_b128 v[112:115], %[ab] offset:38912\n\t" \
    "ds_read_b32 v116, %[av] offset:1536\n\t" \
    "v_pk_mul_f32 v[140:141], %[s01], v[118:119]\n\t" \
    "v_pk_fma_f32 v[140:141], %[s23], v[120:121], v[140:141]\n\t" \
    "v_add_f32 v146, v140, v141\n\t" \
    "v_pk_mul_f32 v[142:143], %[s01], v[122:123]\n\t" \
    "v_pk_mul_f32 v[144:145], %[s23], v[124:125]\n\t" \
    "v_add_f32_dpp v146, v146, v146 quad_perm:[1,0,3,2] row_mask:0xf bank_mask:0xf bound_ctrl:1\n\t" \
    "v_add_f32_dpp %[yp], %[yp], %[yp] quad_perm:[1,0,3,2] row_mask:0xf bank_mask:0xf bound_ctrl:1\n\t" \
    "v_pk_fma_f32 v[142:143], v[138:139], v[130:131], v[142:143] op_sel_hi:[0,1,1]\n\t" \
    "v_add_f32_dpp v146, v146, v146 quad_perm:[2,3,0,1] row_mask:0xf bank_mask:0xf bound_ctrl:1\n\t" \
    "v_add_f32_dpp %[yp], %[yp], %[yp] quad_perm:[2,3,0,1] row_mask:0xf bank_mask:0xf bound_ctrl:1\n\t" \
    "v_pk_fma_f32 v[144:145], v[138:139], v[132:133], v[144:145] op_sel_hi:[0,1,1]\n\t" \
    "v_add_f32_dpp v146, v146, v146 row_half_mirror row_mask:0xf bank_mask:0xf bound_ctrl:1\n\t" \
    "v_add_f32_dpp %[yp], %[yp], %[yp] row_half_mirror row_mask:0xf bank_mask:0xf bound_ctrl:1\n\t" \
    "v_cmp_eq_u32_e32 vcc, 6, %[sp]\n\t" \
    "v_add_f32_dpp v146, v146, v146 row_mirror row_mask:0xf bank_mask:0xf bound_ctrl:1\n\t" \
    "v_add_f32_dpp %[yp], %[yp], %[yp] row_mirror row_mask:0xf bank_mask:0xf bound_ctrl:1\n\t" \
    "v_cndmask_b32_e32 %[yk1], %[yk1], %[yp], vcc\n\t" \
    "v_pk_fma_f32 %[s01], v[146:147], v[126:127], v[142:143] op_sel_hi:[0,1,1] neg_lo:[1,0,0] neg_hi:[1,0,0]\n\t" \
    "v_pk_fma_f32 %[s23], v[146:147], v[128:129], v[144:145] op_sel_hi:[0,1,1] neg_lo:[1,0,0] neg_hi:[1,0,0]\n\t" \
    "v_pk_mul_f32 v[140:141], %[s01], v[134:135]\n\t" \
    "v_pk_fma_f32 v[140:141], %[s23], v[136:137], v[140:141]\n\t" \
    "v_add_f32 %[yp], v140, v141\n\t" \
    "s_waitcnt lgkmcnt(0)\n\t" \
    "ds_read_b128 v[118:121], %[ab] offset:30976\n\t" \
    "ds_read_b128 v[122:125], %[ab] offset:6400\n\t" \
    "ds_read_b128 v[126:129], %[ab] offset:22784\n\t" \
    "ds_read_b128 v[130:133], %[ab] offset:14592\n\t" \
    "ds_read_b128 v[134:137], %[ab] offset:39168\n\t" \
    "ds_read_b32 v138, %[av] offset:1600\n\t" \
    "v_pk_mul_f32 v[140:141], %[s01], v[96:97]\n\t" \
    "v_pk_fma_f32 v[140:141], %[s23], v[98:99], v[140:141]\n\t" \
    "v_add_f32 v146, v140, v141\n\t" \
    "v_pk_mul_f32 v[142:143], %[s01], v[100:101]\n\t" \
    "v_pk_mul_f32 v[144:145], %[s23], v[102:103]\n\t" \
    "v_add_f32_dpp v146, v146, v146 quad_perm:[1,0,3,2] row_mask:0xf bank_mask:0xf bound_ctrl:1\n\t" \
    "v_add_f32_dpp %[yp], %[yp], %[yp] quad_perm:[1,0,3,2] row_mask:0xf bank_mask:0xf bound_ctrl:1\n\t" \
    "v_pk_fma_f32 v[142:143], v[116:117], v[108:109], v[142:143] op_sel_hi:[0,1,1]\n\t" \
    "v_add_f32_dpp v146, v146, v146 quad_perm:[2,3,0,1] row_mask:0xf bank_mask:0xf bound_ctrl:1\n\t" \
    "v_add_f32_dpp %[yp], %[yp], %[yp] quad_perm:[2,3,0,1] row_mask:0xf bank_mask:0xf bound_ctrl:1\n\t" \
    "v_pk_fma_f32 v[144:145], v[116:117], v[110:111], v[144:145] op_sel_hi:[0,1,1]\n\t" \
    "v_add_f32_dpp v146, v146, v146 row_half_mirror row_mask:0xf bank_mask:0xf bound_ctrl:1\n\t" \
    "v_add_f32_dpp %[yp], %[yp], %[yp] row_half_mirror row_mask:0xf bank_mask:0xf bound_ctrl:1\n\t" \
    "v_cmp_eq_u32_e32 vcc, 7, %[sp]\n\t" \
    "v_add_f32_dpp v146, v146, v146 row_mirror row_mask:0xf bank_mask:0xf bound_ctrl:1\n\t" \
    "v_add_f32_dpp %[yp], %[yp], %[yp] row_mirror row_mask:0xf bank_mask:0xf bound_ctrl:1\n\t" \
    "v_cndmask_b32_e32 %[yk1], %[yk1], %[yp], vcc\n\t" \
    "v_pk_fma_f32 %[s01], v[146:147], v[104:105], v[142:143] op_sel_hi:[0,1,1] neg_lo:[1,0,0] neg_hi:[1,0,0]\n\t" \
    "v_pk_fma_f32 %[s23], v[146:147], v[106:107], v[144:145] op_sel_hi:[0,1,1] neg_lo:[1,0,0] neg_hi:[1,0,0]\n\t" \
    "v_pk_mul_f32 v[140:141], %[s01], v[112:113]\n\t" \
    "v_pk_fma_f32 v[140:141], %[s23], v[114:115], v[140:141]\n\t" \
    "v_add_f32 %[yp], v140, v141\n\t" \
    "s_waitcnt lgkmcnt(0)\n\t" \
    "ds_read_b128 v[96:99], %[ab] offset:31232\n\t" \
    "ds_read_b128 v[100:103], %[ab] offset:6656\n\t" \
    "ds_read_b128 v[104:107], %[ab] offset:23040\n\t" \
    "ds_read_b128 v[108:111], %[ab] offset:14848\n\t" \
    "ds_read_b128 v[112:115], %[ab] offset:39424\n\t" \
    "ds_read_b32 v116, %[av] offset:1664\n\t" \
    "v_pk_mul_f32 v[140:141], %[s01], v[118:119]\n\t" \
    "v_pk_fma_f32 v[140:141], %[s23], v[120:121], v[140:141]\n\t" \
    "v_add_f32 v146, v140, v141\n\t" \
    "v_pk_mul_f32 v[142:143], %[s01], v[122:123]\n\t" \
    "v_pk_mul_f32 v[144:145], %[s23], v[124:125]\n\t" \
    "v_add_f32_dpp v146, v146, v146 quad_perm:[1,0,3,2] row_mask:0xf bank_mask:0xf bound_ctrl:1\n\t" \
    "v_add_f32_dpp %[yp], %[yp], %[yp] quad_perm:[1,0,3,2] row_mask:0xf bank_mask:0xf bound_ctrl:1\n\t" \
    "v_pk_fma_f32 v[142:143], v[138:139], v[130:131], v[142:143] op_sel_hi:[0,1,1]\n\t" \
    "v_add_f32_dpp v146, v146, v146 quad_perm:[2,3,0,1] row_mask:0xf bank_mask:0xf bound_ctrl:1\n\t" \
    "v_add_f32_dpp %[yp], %[yp], %[yp] quad_perm:[2,3,0,1] row_mask:0xf bank_mask:0xf bound_ctrl:1\n\t" \
    "v_pk_fma_f32 v[144:145], v[138:139], v[132:133], v[144:145] op_sel_hi:[0,1,1]\n\t" \
    "v_add_f32_dpp v146, v146, v146 row_half_mirror row_mask:0xf bank_mask:0xf bound_ctrl:1\n\t" \
    "v_add_f32_dpp %[yp], %[yp], %[yp] row_half_mirror row_mask:0xf bank_mask:0xf bound_ctrl:1\n\t" \
    "v_cmp_eq_u32_e32 vcc, 8, %[sp]\n\t" \
    "v_add_f32_dpp v146, v146, v146 row_mirror row_mask:0xf bank_mask:0xf bound_ctrl:1\n\t" \
    "v_add_f32_dpp %[yp], %[yp], %[yp] row_mirror row_mask:0xf bank_mask:0xf bound_ctrl:1\n\t" \
    "v_cndmask_b32_e32 %[yk1], %[yk1], %[yp], vcc\n\t" \
    "v_pk_fma_f32 %[s01], v[146:147], v[126:127], v[142:143] op_sel_hi:[0,1,1] neg_lo:[1,0,0] neg_hi:[1,0,0]\n\t" \
    "v_pk_fma_f32 %[s23], v[146:147], v[128:129], v[144:145] op_sel_hi:[0,1,1] neg_lo:[1,0,0] neg_hi:[1,0,0]\n\t" \
    "v_pk_mul_f32 v[140:141], %[s01], v[134:135]\n\t" \
    "v_pk_fma_f32 v[140:141], %[s23], v[136:137], v[140:141]\n\t" \
    "v_add_f32 %[yp], v140, v141\n\t" \
    "s_waitcnt lgkmcnt(0)\n\t" \
    "ds_read_b128 v[118:121], %[ab] offset:31488\n\t" \
    "ds_read_b128 v[122:125], %[ab] offset:6912\n\t" \
    "ds_read_b128 v[126:129], %[ab] offset:23296\n\t" \
    "ds_read_b128 v[130:133], %[ab] offset:15104\n\t" \
    "ds_read_b128 v[134:137], %[ab] offset:39680\n\t" \
    "ds_read_b32 v138, %[av] offset:1728\n\t" \
    "v_pk_mul_f32 v[140:141], %[s01], v[96:97]\n\t" \
    "v_pk_fma_f32 v[140:141], %[s23], v[98:99], v[140:141]\n\t" \
    "v_add_f32 v146, v140, v141\n\t" \
    "v_pk_mul_f32 v[142:143], %[s01], v[100:101]\n\t" \
    "v_pk_mul_f32 v[144:145], %[s23], v[102:103]\n\t" \
    "v_add_f32_dpp v146, v146, v146 quad_perm:[1,0,3,2] row_mask:0xf bank_mask:0xf bound_ctrl:1\n\t" \
    "v_add_f32_dpp %[yp], %[yp], %[yp] quad_perm:[1,0,3,2] row_mask:0xf bank_mask:0xf bound_ctrl:1\n\t" \
    "v_pk_fma_f32 v[142:143], v[116:117], v[108:109], v[142:143] op_sel_hi:[0,1,1]\n\t" \
    "v_add_f32_dpp v146, v146, v146 quad_perm:[2,3,0,1] row_mask:0xf bank_mask:0xf bound_ctrl:1\n\t" \
    "v_add_f32_dpp %[yp], %[yp], %[yp] quad_perm:[2,3,0,1] row_mask:0xf bank_mask:0xf bound_ctrl:1\n\t" \
    "v_pk_fma_f32 v[144:145], v[116:117], v[110:111], v[144:145] op_sel_hi:[0,1,1]\n\t" \
    "v_add_f32_dpp v146, v146, v146 row_half_mirror row_mask:0xf bank_mask:0xf bound_ctrl:1\n\t" \
    "v_add_f32_dpp %[yp], %[yp], %[yp] row_half_mirror row_mask:0xf bank_mask:0xf bound_ctrl:1\n\t" \
    "v_cmp_eq_u32_e32 vcc, 9, %[sp]\n\t" \
    "v_add_f32_dpp v146, v146, v146 row_mirror row_mask:0xf bank_mask:0xf bound_ctrl:1\n\t" \
    "v_add_f32_dpp %[yp], %[yp], %[yp] row_mirror row_mask:0xf bank_mask:0xf bound_ctrl:1\n\t" \
    "v_cndmask_b32_e32 %[yk1], %[yk1], %[yp], vcc\n\t" \
    "v_pk_fma_f32 %[s01], v[146:147], v[104:105], v[142:143] op_sel_hi:[0,1,1] neg_lo:[1,0,0] neg_hi:[1,0,0]\n\t" \
    "v_pk_fma_f32 %[s23], v[146:147], v[106:107], v[144:145] op_sel_hi:[0,1,1] neg_lo:[1,0,0] neg_hi:[1,0,0]\n\t" \
    "v_pk_mul_f32 v[140:141], %[s01], v[112:113]\n\t" \
    "v_pk_fma_f32 v[140:141], %[s23], v[114:115], v[140:141]\n\t" \
    "v_add_f32 %[yp], v140, v141\n\t" \
    "s_waitcnt lgkmcnt(0)\n\t" \
    "ds_read_b128 v[96:99], %[ab] offset:31744\n\t" \
    "ds_read_b128 v[100:103], %[ab] offset:7168\n\t" \
    "ds_read_b128 v[104:107], %[ab] offset:23552\n\t" \
    "ds_read_b128 v[108:111], %[ab] offset:15360\n\t" \
    "ds_read_b128 v[112:115], %[ab] offset:39936\n\t" \
    "ds_read_b32 v116, %[av] offset:1792\n\t" \
    "v_pk_mul_f32 v[140:141], %[s01], v[118:119]\n\t" \
    "v_pk_fma_f32 v[140:141], %[s23], v[120:121], v[140:141]\n\t" \
    "v_add_f32 v146, v140, v141\n\t" \
    "v_pk_mul_f32 v[142:143], %[s01], v[122:123]\n\t" \
    "v_pk_mul_f32 v[144:145], %[s23], v[124:125]\n\t" \
    "v_add_f32_dpp v146, v146, v146 quad_perm:[1,0,3,2] row_mask:0xf bank_mask:0xf bound_ctrl:1\n\t" \
    "v_add_f32_dpp %[yp], %[yp], %[yp] quad_perm:[1,0,3,2] row_mask:0xf bank_mask:0xf bound_ctrl:1\n\t" \
    "v_pk_fma_f32 v[142:143], v[138:139], v[130:131], v[142:143] op_sel_hi:[0,1,1]\n\t" \
    "v_add_f32_dpp v146, v146, v146 quad_perm:[2,3,0,1] row_mask:0xf bank_mask:0xf bound_ctrl:1\n\t" \
    "v_add_f32_dpp %[yp], %[yp], %[yp] quad_perm:[2,3,0,1] row_mask:0xf bank_mask:0xf bound_ctrl:1\n\t" \
    "v_pk_fma_f32 v[144:145], v[138:139], v[132:133], v[144:145] op_sel_hi:[0,1,1]\n\t" \
    "v_add_f32_dpp v146, v146, v146 row_half_mirror row_mask:0xf bank_mask:0xf bound_ctrl:1\n\t" \
    "v_add_f32_dpp %[yp], %[yp], %[yp] row_half_mirror row_mask:0xf bank_mask:0xf bound_ctrl:1\n\t" \
    "v_cmp_eq_u32_e32 vcc, 10, %[sp]\n\t" \
    "v_add_f32_dpp v146, v146, v146 row_mirror row_mask:0xf bank_mask:0xf bound_ctrl:1\n\t" \
    "v_add_f32_dpp %[yp], %[yp], %[yp] row_mirror row_mask:0xf bank_mask:0xf bound_ctrl:1\n\t" \
    "v_cndmask_b32_e32 %[yk1], %[yk1], %[yp], vcc\n\t" \
    "v_pk_fma_f32 %[s01], v[146:147], v[126:127], v[142:143] op_sel_hi:[0,1,1] neg_lo:[1,0,0] neg_hi:[1,0,0]\n\t" \
    "v_pk_fma_f32 %[s23], v[146:147], v[128:129], v[144:145] op_sel_hi:[0,1,1] neg_lo:[1,0,0] neg_hi:[1,0,0]\n\t" \
    "v_pk_mul_f32 v[140:141], %[s01], v[134:135]\n\t" \
    "v_pk_fma_f32 v[140:141], %[s23], v[136:137], v[140:141]\n\t" \
    "v_add_f32 %[yp], v140, v141\n\t" \
    "s_waitcnt lgkmcnt(0)\n\t" \
    "ds_read_b128 v[118:121], %[ab] offset:32000\n\t" \
    "ds_read_b128 v[122:125], %[ab] offset:7424\n\t" \
    "ds_read_b128 v[126:129], %[ab] offset:23808\n\t" \
    "ds_read_b128 v[130:133], %[ab] offset:15616\n\t" \
    "ds_read_b128 v[134:137], %[ab] offset:40192\n\t" \
    "ds_read_b32 v138, %[av] offset:1856\n\t" \
    "v_pk_mul_f32 v[140:141], %[s01], v[96:97]\n\t" \
    "v_pk_fma_f32 v[140:141], %[s23], v[98:99], v[140:141]\n\t" \
    "v_add_f32 v146, v140, v141\n\t" \
    "v_pk_mul_f32 v[142:143], %[s01], v[100:101]\n\t" \
    "v_pk_mul_f32 v[144:145], %[s23], v[102:103]\n\t" \
    "v_add_f32_dpp v146, v146, v146 quad_perm:[1,0,3,2] row_mask:0xf bank_mask:0xf bound_ctrl:1\n\t" \
    "v_add_f32_dpp %[yp], %[yp], %[yp] quad_perm:[1,0,3,2] row_mask:0xf bank_mask:0xf bound_ctrl:1\n\t" \
    "v_pk_fma_f32 v[142:143], v[116:117], v[108:109], v[142:143] op_sel_hi:[0,1,1]\n\t" \
    "v_add_f32_dpp v146, v146, v146 quad_perm:[2,3,0,1] row_mask:0xf bank_mask:0xf bound_ctrl:1\n\t" \
    "v_add_f32_dpp %[yp], %[yp], %[yp] quad_perm:[2,3,0,1] row_mask:0xf bank_mask:0xf bound_ctrl:1\n\t" \
    "v_pk_fma_f32 v[144:145], v[116:117], v[110:111], v[144:145] op_sel_hi:[0,1,1]\n\t" \
    "v_add_f32_dpp v146, v146, v146 row_half_mirror row_mask:0xf bank_mask:0xf bound_ctrl:1\n\t" \
    "v_add_f32_dpp %[yp], %[yp], %[yp] row_half_mirror row_mask:0xf bank_mask:0xf bound_ctrl:1\n\t" \
    "v_cmp_eq_u32_e32 vcc, 11, %[sp]\n\t" \
    "v_add_f32_dpp v146, v146, v146 row_mirror row_mask:0xf bank_mask:0xf bound_ctrl:1\n\t" \
    "v_add_f32_dpp %[yp], %[yp], %[yp] row_mirror row_mask:0xf bank_mask:0xf bound_ctrl:1\n\t" \
    "v_cndmask_b32_e32 %[yk1], %[yk1], %[yp], vcc\n\t" \
    "v_pk_fma_f32 %[s01], v[146:147], v[104:105], v[142:143] op_sel_hi:[0,1,1] neg_lo:[1,0,0] neg_hi:[1,0,0]\n\t" \
    "v_pk_fma_f32 %[s23], v[146:147], v[106:107], v[144:145] op_sel_hi:[0,1,1] neg_lo:[1,0,0] neg_hi:[1,0,0]\n\t" \
    "v_pk_mul_f32 v[140:141], %[s01], v[112:113]\n\t" \
    "v_pk_fma_f32 v[140:141], %[s23], v[114:115], v[140:141]\n\t" \
    "v_add_f32 %[yp], v140, v141\n\t" \
    "s_waitcnt lgkmcnt(0)\n\t" \
    "ds_read_b128 v[96:99], %[ab] offset:32256\n\t" \
    "ds_read_b128 v[100:103], %[ab] offset:7680\n\t" \
    "ds_read_b128 v[104:107], %[ab] offset:24064\n\t" \
    "ds_read_b128 v[108:111], %[ab] offset:15872\n\t" \
    "ds_read_b128 v[112:115], %[ab] offset:40448\n\t" \
    "ds_read_b32 v116, %[av] offset:1920\n\t" \
    "v_pk_mul_f32 v[140:141], %[s01], v[118:119]\n\t" \
    "v_pk_fma_f32 v[140:141], %[s23], v[120:121], v[140:141]\n\t" \
    "v_add_f32 v146, v140, v141\n\t" \
    "v_pk_mul_f32 v[142:143], %[s01], v[122:123]\n\t" \
    "v_pk_mul_f32 v[144:145], %[s23], v[124:125]\n\t" \
    "v_add_f32_dpp v146, v146, v146 quad_perm:[1,0,3,2] row_mask:0xf bank_mask:0xf bound_ctrl:1\n\t" \
    "v_add_f32_dpp %[yp], %[yp], %[yp] quad_perm:[1,0,3,2] row_mask:0xf bank_mask:0xf bound_ctrl:1\n\t" \
    "v_pk_fma_f32 v[142:143], v[138:139], v[130:131], v[142:143] op_sel_hi:[0,1,1]\n\t" \
    "v_add_f32_dpp v146, v146, v146 quad_perm:[2,3,0,1] row_mask:0xf bank_mask:0xf bound_ctrl:1\n\t" \
    "v_add_f32_dpp %[yp], %[yp], %[yp] quad_perm:[2,3,0,1] row_mask:0xf bank_mask:0xf bound_ctrl:1\n\t" \
    "v_pk_fma_f32 v[144:145], v[138:139], v[132:133], v[144:145] op_sel_hi:[0,1,1]\n\t" \
    "v_add_f32_dpp v146, v146, v146 row_half_mirror row_mask:0xf bank_mask:0xf bound_ctrl:1\n\t" \
    "v_add_f32_dpp %[yp], %[yp], %[yp] row_half_mirror row_mask:0xf bank_mask:0xf bound_ctrl:1\n\t" \
    "v_cmp_eq_u32_e32 vcc, 12, %[sp]\n\t" \
    "v_add_f32_dpp v146, v146, v146 row_mirror row_mask:0xf bank_mask:0xf bound_ctrl:1\n\t" \
    "v_add_f32_dpp %[yp], %[yp], %[yp] row_mirror row_mask:0xf bank_mask:0xf bound_ctrl:1\n\t" \
    "v_cndmask_b32_e32 %[yk1], %[yk1], %[yp], vcc\n\t" \
    "v_pk_fma_f32 %[s01], v[146:147], v[126:127], v[142:143] op_sel_hi:[0,1,1] neg_lo:[1,0,0] neg_hi:[1,0,0]\n\t" \
    "v_pk_fma_f32 %[s23], v[146:147], v[128:129], v[144:145] op_sel_hi:[0,1,1] neg_lo:[1,0,0] neg_hi:[1,0,0]\n\t" \
    "v_pk_mul_f32 v[140:141], %[s01], v[134:135]\n\t" \
    "v_pk_fma_f32 v[140:141], %[s23], v[136:137], v[140:141]\n\t" \
    "v_add_f32 %[yp], v140, v141\n\t" \
    "s_waitcnt lgkmcnt(0)\n\t" \
    "ds_read_b128 v[118:121], %[ab] offset:32512\n\t" \
    "ds_read_b128 v[122:125], %[ab] offset:7936\n\t" \
    "ds_read_b128 v[126:129], %[ab] offset:24320\n\t" \
    "ds_read_b128 v[130:133], %[ab] offset:16128\n\t" \
    "ds_read_b128 v[134:137], %[ab] offset:40704\n\t" \
    "ds_read_b32 v138, %[av] offset:1984\n\t" \
    "v_pk_mul_f32 v[140:141], %[s01], v[96:97]\n\t" \
    "v_pk_fma_f32 v[140:141], %[s23], v[98:99], v[140:141]\n\t" \
    "v_add_f32 v146, v140, v141\n\t" \
    "v_pk_mul_f32 v[142:143], %[s01], v[100:101]\n\t" \
    "v_pk_mul_f32 v[144:145], %[s23], v[102:103]\n\t" \
    "v_add_f32_dpp v146, v146, v146 quad_perm:[1,0,3,2] row_mask:0xf bank_mask:0xf bound_ctrl:1\n\t" \
    "v_add_f32_dpp %[yp], %[yp], %[yp] quad_perm:[1,0,3,2] row_mask:0xf bank_mask:0xf bound_ctrl:1\n\t" \
    "v_pk_fma_f32 v[142:143], v[116:117], v[108:109], v[142:143] op_sel_hi:[0,1,1]\n\t" \
    "v_add_f32_dpp v146, v146, v146 quad_perm:[2,3,0,1] row_mask:0xf bank_mask:0xf bound_ctrl:1\n\t" \
    "v_add_f32_dpp %[yp], %[yp], %[yp] quad_perm:[2,3,0,1] row_mask:0xf bank_mask:0xf bound_ctrl:1\n\t" \
    "v_pk_fma_f32 v[144:145], v[116:117], v[110:111], v[144:145] op_sel_hi:[0,1,1]\n\t" \
    "v_add_f32_dpp v146, v146, v146 row_half_mirror row_mask:0xf bank_mask:0xf bound_ctrl:1\n\t" \
    "v_add_f32_dpp %[yp], %[yp], %[yp] row_half_mirror row_mask:0xf bank_mask:0xf bound_ctrl:1\n\t" \
    "v_cmp_eq_u32_e32 vcc, 13, %[sp]\n\t" \
    "v_add_f32_dpp v146, v146, v146 row_mirror row_mask:0xf bank_mask:0xf bound_ctrl:1\n\t" \
    "v_add_f32_dpp %[yp], %[yp], %[yp] row_mirror row_mask:0xf bank_mask:0xf bound_ctrl:1\n\t" \
    "v_cndmask_b32_e32 %[yk1], %[yk1], %[yp], vcc\n\t" \
    "v_pk_fma_f32 %[s01], v[146:147], v[104:105], v[142:143] op_sel_hi:[0,1,1] neg_lo:[1,0,0] neg_hi:[1,0,0]\n\t" \
    "v_pk_fma_f32 %[s23], v[146:147], v[106:107], v[144:145] op_sel_hi:[0,1,1] neg_lo:[1,0,0] neg_hi:[1,0,0]\n\t" \
    "v_pk_mul_f32 v[140:141], %[s01], v[112:113]\n\t" \
    "v_pk_fma_f32 v[140:141], %[s23], v[114:115], v[140:141]\n\t" \
    "v_add_f32 %[yp], v140, v141\n\t" \
    "s_waitcnt lgkmcnt(0)\n\t" \
    "ds_read_b128 v[96:99], %[ab] offset:32768\n\t" \
    "ds_read_b128 v[100:103], %[ab] offset:8192\n\t" \
    "ds_read_b128 v[104:107], %[ab] offset:24576\n\t" \
    "ds_read_b128 v[108:111], %[ab] offset:16384\n\t" \
    "ds_read_b128 v[112:115], %[ab] offset:40960\n\t" \
    "ds_read_b32 v116, %[av] offset:2048\n\t" \
    "v_pk_mul_f32 v[140:141], %[s01], v[118:119]\n\t" \
    "v_pk_fma_f32 v[140:141], %[s23], v[120:121], v[140:141]\n\t" \
    "v_add_f32 v146, v140, v141\n\t" \
    "v_pk_mul_f32 v[142:143], %[s01], v[122:123]\n\t" \
    "v_pk_mul_f32 v[144:145], %[s23], v[124:125]\n\t" \
    "v_add_f32_dpp v146, v146, v146 quad_perm:[1,0,3,2] row_mask:0xf bank_mask:0xf bound_ctrl:1\n\t" \
    "v_add_f32_dpp %[yp], %[yp], %[yp] quad_perm:[1,0,3,2] row_mask:0xf bank_mask:0xf bound_ctrl:1\n\t" \
    "v_pk_fma_f32 v[142:143], v[138:139], v[130:131], v[142:143] op_sel_hi:[0,1,1]\n\t" \
    "v_add_f32_dpp v146, v146, v146 quad_perm:[2,3,0,1] row_mask:0xf bank_mask:0xf bound_ctrl:1\n\t" \
    "v_add_f32_dpp %[yp], %[yp], %[yp] quad_perm:[2,3,0,1] row_mask:0xf bank_mask:0xf bound_ctrl:1\n\t" \
    "v_pk_fma_f32 v[144:145], v[138:139], v[132:133], v[144:145] op_sel_hi:[0,1,1]\n\t" \
    "v_add_f32_dpp v146, v146, v146 row_half_mirror row_mask:0xf bank_mask:0xf bound_ctrl:1\n\t" \
    "v_add_f32_dpp %[yp], %[yp], %[yp] row_half_mirror row_mask:0xf bank_mask:0xf bound_ctrl:1\n\t" \
    "v_cmp_eq_u32_e32 vcc, 14, %[sp]\n\t" \
    "v_add_f32_dpp v146, v146, v146 row_mirror row_mask:0xf bank_mask:0xf bound_ctrl:1\n\t" \
    "v_add_f32_dpp %[yp], %[yp], %[yp] row_mirror row_mask:0xf bank_mask:0xf bound_ctrl:1\n\t" \
    "v_cndmask_b32_e32 %[yk1], %[yk1], %[yp], vcc\n\t" \
    "v_pk_fma_f32 %[s01], v[146:147], v[126:127], v[142:143] op_sel_hi:[0,1,1] neg_lo:[1,0,0] neg_hi:[1,0,0]\n\t" \
    "v_pk_fma_f32 %[s23], v[146:147], v[128:129], v[144:145] op_sel_hi:[0,1,1] neg_lo:[1,0,0] neg_hi:[1,0,0]\n\t" \
    "v_pk_mul_f32 v[140:141], %[s01], v[134:135]\n\t" \
    "v_pk_fma_f32 v[140:141], %[s23], v[136:137], v[140:141]\n\t" \
    "v_add_f32 %[yp], v140, v141\n\t" \
    "s_waitcnt lgkmcnt(0)\n\t"
#define SCAN_CHUNK_CLOBBERS "v96", "v97", "v98", "v99", "v100", "v101", "v102", "v103", "v104", "v105", "v106", "v107", "v108", "v109", "v110", "v111", "v112", "v113", "v114", "v115", "v116", "v117", "v118", "v119", "v120", "v121", "v122", "v123", "v124", "v125", "v126", "v127", "v128", "v129", "v130", "v131", "v132", "v133", "v134", "v135", "v136", "v137", "v138", "v139", "v140", "v141", "v142", "v143", "v144", "v145", "v146", "v147", "vcc", "memory"
#ifndef EMU
#define UNR _Pragma("unroll")
#define UNR1 _Pragma("unroll 1")
#define CFENCE() asm volatile("" ::: "memory")
#define OPAQUE(x) asm volatile("" : "+v"(x))
#define SYNC() __syncthreads()
#define WAVE_SYNC() do { asm volatile("s_waitcnt lgkmcnt(0)" ::: "memory"); __builtin_amdgcn_wave_barrier(); } while (0)
DEVFN float shfl_xor_f(float v, int m) { return __shfl_xor(v, m); }
DEVFN float shfl_f(float v, int src) { return __shfl(v, src); }
DEVFN void sincospi_f(float x, float* s, float* c) { sincospif(x, s, c); }
template <int M> DEVFN float rowx_add(float v) { constexpr int ctrl = M == 1 ? 0xB1 : M == 2 ? 0x4E : M == 7 ? 0x141 : 0x140;
    return v + __builtin_bit_cast(float, __builtin_amdgcn_update_dpp(0, __builtin_bit_cast(int, v), ctrl, 0xf, 0xf, true)); }
#endif

enum InIdx { I_X = 0, I_C, I_CTX, I_CCTX, I_ANORM, I_AADAW, I_AADAB, I_AWIN, I_RPB, I_QG, I_KG, I_AWOUT, I_RNORM, I_RADAW, I_RADAB, I_RWIN, I_MU, I_W0, I_WUP, I_A0, I_AUP,
             I_KK, I_KA, I_RK, I_GNW, I_GNB, I_HSHORT, I_HW1, I_HB1, I_HW2, I_HB2, I_HW3, I_HB3, I_HSKIP, I_RWOUT, I_FNORM, N_IN };

#if defined(TSEL) && !defined(EMU)
#define XSTAMP(C, k, cond) do { if ((cond) && (C).tid == 0) __hip_atomic_store((unsigned long long*)((C).ws + WS_CTL + 32768) + (k), (unsigned long long)__builtin_amdgcn_s_memrealtime(), __ATOMIC_RELAXED, __HIP_MEMORY_SCOPE_AGENT); } while (0)
#else
#define XSTAMP(C, k, cond) do {} while (0)
#endif
#if defined(TSEL) && !defined(EMU)
#define TACC_DECL unsigned long long tacc_ = 0, tb_ = 0
#define TACC_BEGIN tb_ = __builtin_amdgcn_s_memrealtime()
#define TACC_END tacc_ += __builtin_amdgcn_s_memrealtime() - tb_
#define TACC_STORE(C, k, cond) do { if (cond) __hip_atomic_store((unsigned long long*)((C).ws + WS_CTL + 32768) + (k), tacc_, __ATOMIC_RELAXED, __HIP_MEMORY_SCOPE_AGENT); } while (0)
#else
#define TACC_DECL
#define TACC_BEGIN
#define TACC_END
#define TACC_STORE(C, k, cond)
#endif
struct Ctx {
    const float* in[N_IN]; float* out; unsigned char* ws;
    int tid, lane, wave, vcu, G;
};

#ifdef EMU
DEVFN float wave_sum(float v) { for (int o = 1; o < 64; o <<= 1) v += shfl_xor_f(v, o); return v; }
DEVFN float swap16_f(float v) { return shfl_xor_f(v, 16); }
#else
DEVFN float wave_sum(float v) { v = rowx_add<1>(v); v = rowx_add<2>(v); v = rowx_add<7>(v); v = rowx_add<15>(v);
    const int i_ = __builtin_bit_cast(int, v);
    return (__builtin_bit_cast(float, __builtin_amdgcn_readlane(i_, 0)) + __builtin_bit_cast(float, __builtin_amdgcn_readlane(i_, 16))) + (__builtin_bit_cast(float, __builtin_amdgcn_readlane(i_, 32)) + __builtin_bit_cast(float, __builtin_amdgcn_readlane(i_, 48))); }
DEVFN float swap16_f(float v) { return __builtin_bit_cast(float, __builtin_amdgcn_ds_swizzle(__builtin_bit_cast(int, v), 0x401F)); }
#endif

DEVFN U4 ld16(const void* p) { return *(const U4*)p; }
DEVFN void st16(void* p, U4 v) { *(U4*)p = v; }
DEVFN void unpack8(U4 w, float* f) { f[0] = bflo(w.x); f[1] = bfhi(w.x); f[2] = bflo(w.y); f[3] = bfhi(w.y); f[4] = bflo(w.z); f[5] = bfhi(w.z); f[6] = bflo(w.w); f[7] = bfhi(w.w); }
DEVFN U4 pack8(const float* f) { U4 w; w.x = pk2(f[0], f[1]); w.y = pk2(f[2], f[3]); w.z = pk2(f[4], f[5]); w.w = pk2(f[6], f[7]); return w; }

DEVFN void p0_transpose_item(const float* W, int K, int N, bf16_t* WT, float* scr, int item, int lane) {
    const int nblk = N / 32, kb = item / nblk, nb = item % nblk, k0 = 64 * kb, n0 = 32 * nb;
    UNR for (int i = 0; i < 32; ++i) { const int kk = 2 * i + (lane >> 5); scr[kk * 33 + (lane & 31)] = W[(size_t)(k0 + kk) * N + n0 + (lane & 31)]; }
    WAVE_SYNC();
    const int c = lane & 7;
    UNR for (int j = 0; j < 4; ++j) { const int n = (lane >> 3) + 8 * j; const float* s = scr + (8 * c) * 33 + n;
        U4 o; o.x = pk2(s[0 * 33], s[1 * 33]); o.y = pk2(s[2 * 33], s[3 * 33]); o.z = pk2(s[4 * 33], s[5 * 33]); o.w = pk2(s[6 * 33], s[7 * 33]);
        st16(WT + (size_t)(n0 + n) * K + k0 + 8 * c, o); }
    WAVE_SYNC();
}

template <bool BF> DEVFN void hid_rows(const float* w1, const float* b1, const float* w2, const float* b2, float* hid, int L, int gw, int NGW, int lane) {
    float w1c[33], w2c[64];
    UNR for (int i = 0; i < 33; ++i) w1c[i] = w1[i * 64 + lane];
    UNR for (int i = 0; i < 64; ++i) w2c[i] = w2[i * 64 + lane];
    const float bb1 = b1[lane], bb2 = b2[lane];
    for (int t = gw; t < L; t += NGW) {
        float feat = 0.f;
        if (lane == 0) feat = (float)t / (float)(L - 1 > 1 ? L - 1 : 1);
        else if (lane < 33) { const int b = (lane - 1) & 15; const float band = 1e-4f + (float)b * ((15.0f - 1e-4f) / 15.0f);
            const float x = 2.0f * band * (float)t / (float)L; float s, c; sincospi_f(x, &s, &c); feat = (lane <= 16) ? c : -s; }
        float a = bb1;
        UNR for (int i = 0; i < 33; ++i) a += shfl_f(feat, i) * w1c[i];
        const float h1 = sinf(a);
        float b = bb2;
        UNR for (int i = 0; i < 64; ++i) b += shfl_f(h1, i) * w2c[i];
        if (BF) ((bf16_t*)hid)[(size_t)t * 64 + lane] = (bf16_t)f2bf(sinf(b)); else hid[(size_t)t * 64 + lane] = sinf(b);
    }
}

DEVFN void r2_build_bfrag(const Ctx& C);
DEVFN void ph_prologue(const Ctx& C, unsigned char* lds) {
    const int gw = C.vcu * NWAVES + C.wave, NGW = C.G * NWAVES, lane = C.lane;
    float* scr = (float*)(lds + C.wave * 16384);
    {
        constexpr int I_AIN = 16 * (AIN / 32), I_OUT = 16 * 32, I_RIN = 16 * (RIN / 32);
        constexpr int NIT = 2 * (I_AIN + I_OUT + I_RIN + I_OUT);
        for (int it = gw; it < NIT; it += NGW) {
            int r = it; const int li = r & 1; r >>= 1;
            if (r < I_AIN) { p0_transpose_item(C.in[I_AWIN] + (size_t)li * DM * AIN, DM, AIN, (bf16_t*)(C.ws + WS_WAIN) + (size_t)li * AIN * DM, scr, r, lane); continue; } r -= I_AIN;
            if (r < I_OUT) { p0_transpose_item(C.in[I_AWOUT] + (size_t)li * DM * DM, DM, DM, (bf16_t*)(C.ws + WS_WAOUT) + (size_t)li * DM * DM, scr, r, lane); continue; } r -= I_OUT;
            if (r < I_RIN) { p0_transpose_item(C.in[I_RWIN] + (size_t)li * DM * RIN, DM, RIN, (bf16_t*)(C.ws + WS_WRIN) + (size_t)li * RINP * DM, scr, r, lane); continue; } r -= I_RIN;
            p0_transpose_item(C.in[I_RWOUT] + (size_t)li * DM * DM, DM, DM, (bf16_t*)(C.ws + WS_WROUT) + (size_t)li * DM * DM, scr, r, lane);
        }
        for (int e = gw * 64 + lane; e < 2 * (RINP - RIN) * DM / 8; e += NGW * 64) { const int li = e / ((RINP - RIN) * DM / 8), o = e % ((RINP - RIN) * DM / 8);
            U4 z; z.x = z.y = z.z = z.w = 0u; st16((bf16_t*)(C.ws + WS_WRIN) + (size_t)li * RINP * DM + (size_t)RIN * DM + (size_t)o * 8, z); }
    }
    {
        float* ADA = (float*)(C.ws + WS_ADA); float* part = (float*)lds;
        SYNC();
        for (int it = C.vcu; it < 4 * 48; it += C.G) {
            const int layer = it / 48, cb = it % 48, col = cb * 64 + lane, i = layer >> 1;
            const float* W = (layer & 1) ? C.in[I_RADAW] + (size_t)i * DM * 3072 : C.in[I_AADAW] + (size_t)i * DM * 3072;
            const float* B = (layer & 1) ? C.in[I_RADAB] + (size_t)i * 3072 : C.in[I_AADAB] + (size_t)i * 3072;
            float a0 = 0.f, a1 = 0.f;
            for (int k0 = 128 * C.wave; k0 < 128 * C.wave + 128; k0 += 64) {
                const float sc = silu_f(C.in[I_C][k0 + lane]), sx = silu_f(C.in[I_CCTX][k0 + lane]);
                UNR for (int kb = 0; kb < 64; kb += 16) {
                    float w[16]; UNR for (int k = 0; k < 16; ++k) w[k] = W[(size_t)(k0 + kb + k) * 3072 + col];
                    UNR for (int k = 0; k < 16; ++k) { a0 += shfl_f(sc, kb + k) * w[k]; a1 += shfl_f(sx, kb + k) * w[k]; }
                }
            }
            part[(C.wave * 2 + 0) * 64 + lane] = a0; part[(C.wave * 2 + 1) * 64 + lane] = a1;
            SYNC();
            if (C.wave < 2) { float s_ = B[col]; UNR for (int w = 0; w < NWAVES; ++w) s_ += part[(w * 2 + C.wave) * 64 + lane]; ADA[(size_t)(layer * 2 + C.wave) * 3072 + col] = s_; }
            SYNC();
        }
    }
    for (int i = 0; i < 2; ++i)
        hid_rows<true>(C.in[I_HW1] + (size_t)i * 33 * 64, C.in[I_HB1] + i * 64, C.in[I_HW2] + (size_t)i * 64 * 64, C.in[I_HB2] + i * 64, (float*)((bf16_t*)(C.ws + WS_HID) + (size_t)i * NLAT * 64), NLAT, gw, NGW, lane);
    hid_rows<false>(C.in[I_HW1], C.in[I_HB1], C.in[I_HW2], C.in[I_HB2], (float*)(C.ws + WS_HID256), NCTX, gw, NGW, lane);
    r2_build_bfrag(C);
    { F2* TW = (F2*)(C.ws + WS_TW);
      for (int k = gw * 64 + lane; k <= 16384; k += NGW * 64) { float s, c; sincospi_f((float)k * (1.0f / 16384.0f), &s, &c); F2 w; w.x = c; w.y = -s; TW[k] = w; } }
}

DEVFN void ph_norm(const Ctx& C, int layer, const float* xlat, const float* xctx, bool do_ctx) {
    const int gw = C.vcu * NWAVES + C.wave, NGW = C.G * NWAVES, lane = C.lane, i = layer >> 1;
    const float* gain = ((layer & 1) ? C.in[I_RNORM] : C.in[I_ANORM]) + (size_t)i * DM;
    const float* ADA = (const float*)(C.ws + WS_ADA) + (size_t)layer * 2 * 3072;
    bf16_t* XN = (bf16_t*)(C.ws + WS_XN);
    const int nrows = do_ctx ? NTOK : NLAT;
    for (int m = gw; m < nrows; m += NGW) {
        const bool isctx = m >= NLAT;
        const float* xr = isctx ? xctx + (size_t)(m - NLAT) * DM : xlat + (size_t)m * DM;
        const float* ada = ADA + (isctx ? 3072 : 0);
        F4 v[4]; float s = 0.f;
        UNR for (int j = 0; j < 4; ++j) { v[j] = *(const F4*)(xr + 256 * j + 4 * lane); s += (v[j].x * v[j].x + v[j].y * v[j].y) + (v[j].z * v[j].z + v[j].w * v[j].w); }
        const float rs = 1.0f / sqrtf(wave_sum(s) * (1.0f / DM) + NORM_EPS);
        UNR for (int j = 0; j < 4; ++j) { const int c0 = 256 * j + 4 * lane;
            const F4 g = *(const F4*)(gain + c0), sh = *(const F4*)(ada + c0), sc = *(const F4*)(ada + 1024 + c0);
            U2 o; o.x = pk2(v[j].x * rs * g.x * (1.f + sc.x) + sh.x, v[j].y * rs * g.y * (1.f + sc.y) + sh.y);
            o.y = pk2(v[j].z * rs * g.z * (1.f + sc.z) + sh.z, v[j].w * rs * g.w * (1.f + sc.w) + sh.w);
            *(U2*)(XN + (size_t)m * DM + c0) = o; }
    }
}

DEVFN void ph_final(const Ctx& C) {
    const int gw = C.vcu * NWAVES + C.wave, NGW = C.G * NWAVES, lane = C.lane;
    const float* gain = C.in[I_FNORM];
    for (int m = gw; m < NLAT; m += NGW) {
        float* xr = C.out + (size_t)m * DM;
        F4 v[4]; float s = 0.f;
        UNR for (int j = 0; j < 4; ++j) { v[j] = *(const F4*)(xr + 256 * j + 4 * lane); s += (v[j].x * v[j].x + v[j].y * v[j].y) + (v[j].z * v[j].z + v[j].w * v[j].w); }
        const float rs = 1.0f / sqrtf(wave_sum(s) * (1.0f / DM) + NORM_EPS);
        UNR for (int j = 0; j < 4; ++j) { const int c0 = 256 * j + 4 * lane; const F4 g = *(const F4*)(gain + c0);
            F4 o; o.x = v[j].x * rs * g.x; o.y = v[j].y * rs * g.y; o.z = v[j].z * rs * g.z; o.w = v[j].w * rs * g.w; *(F4*)(xr + c0) = o; }
    }
}

DEVFN void ph_qkprep(const Ctx& C, int i) {
    const int gw = C.vcu * NWAVES + C.wave, NGW = C.G * NWAVES, lane = C.lane;
    bf16_t* U = (bf16_t*)(C.ws + WS_U);
    const float qg = C.in[I_QG][i * 64 + lane], kg = C.in[I_KG][i * 64 + lane];
    const int axis = lane >> 5, half = (lane >> 4) & 1, f = lane & 15;
    const float invf = exp2f(-(float)f * (13.287712379549449f / 16.0f));
    for (int m = gw; m < NTOK; m += NGW) {
        float cs = 1.f, sn = 0.f;
        if (m < NLAT) { const float pos = (float)(axis == 0 ? (m >> 6) : (m & 63)); const float ang = pos * invf; cs = cosf(ang); sn = sinf(ang); }
        bf16_t* ur = U + (size_t)m * AIN + 2048;
        for (int h = 0; h < 10; ++h) {
            const float v = bf2f(ur[h * 64 + lane]);
            const float ss = wave_sum(v * v);
            float y = v * (1.0f / sqrtf(ss * (1.0f / 64.0f) + NORM_EPS)) * (h < 8 ? qg : kg);
            const float p = swap16_f(y);
            y = half == 0 ? y * cs - p * sn : y * cs + p * sn;
            if (h < 8) y *= C2;
            ur[h * 64 + lane] = (bf16_t)f2bf(y);
        }
    }
}

DEVFN void ph_hyprep(const Ctx& C, int i, bool do_ctx, unsigned char* lds) {
    const int tid = C.tid;
    const bf16_t* UHY = (const bf16_t*)(C.ws + WS_UHY);
    const float* taps = C.in[I_HSHORT] + (size_t)i * 3 * UHY_W;
    float* T = (float*)lds;
    const int ntile_lat = 3 * 8 * 256, ntile = ntile_lat + (do_ctx ? 3 * 8 * 4 : 0);
    for (int it = C.vcu; it < ntile; it += C.G) {
        const bool isctx = it >= ntile_lat; const int r = isctx ? it - ntile_lat : it;
        const int ntb = isctx ? 4 : 256; const int tb = r % ntb, cb = (r / ntb) & 7, g = r / (ntb * 8);
        const int seg0 = isctx ? NLAT : 0, segn = isctx ? NCTX : NLAT;
        {
            const int tl = tid >> 3, c8 = (tid & 7) * 8, t = 64 * tb + tl, col = g * 512 + 64 * cb + c8;
            float um[8], u0[8], up[8];
            unpack8(ld16(UHY + (size_t)(seg0 + t) * UHY_W + col), u0);
            if (t > 0) unpack8(ld16(UHY + (size_t)(seg0 + t - 1) * UHY_W + col), um); else UNR for (int e = 0; e < 8; ++e) um[e] = 0.f;
            if (t < segn - 1) unpack8(ld16(UHY + (size_t)(seg0 + t + 1) * UHY_W + col), up); else UNR for (int e = 0; e < 8; ++e) up[e] = 0.f;
            UNR for (int e = 0; e < 8; ++e) T[(c8 + e) * 65 + tl] = um[e] * taps[col + e] + u0[e] * taps[UHY_W + col + e] + up[e] * taps[2 * UHY_W + col + e];
        }
        SYNC();
        {
            const int cl = tid >> 3, t8 = (tid & 7) * 8, ch = 64 * cb + cl;
            float v[8]; UNR for (int e = 0; e < 8; ++e) v[e] = T[cl * 65 + t8 + e];
            if (!isctx) { bf16_t* VX = (bf16_t*)(C.ws + (g == 0 ? WS_VX0 : g == 1 ? WS_VX1 : WS_VX2)); st16(VX + (size_t)ch * NLAT + 64 * tb + t8, pack8(v)); }
            else { float* VXC = (float*)(C.ws + WS_VXC) + ((size_t)g * 512 + ch) * NCTX + 64 * tb + t8; UNR for (int e = 0; e < 8; ++e) VXC[e] = v[e]; }
        }
        SYNC();
    }
}

typedef float P2 __attribute__((vector_size(8)));
#ifdef EMU
struct H8 { unsigned short v[8]; };
struct A4 { float v[4]; };
inline A4 mfma16(const H8& a, const H8& b, const A4& c) {
    static H8 sa_[emu::MAXB][8][64], sb_[emu::MAXB][8][64]; const int w = emu::t_tid >> 6, l = emu::t_tid & 63; H8 (*sa)[64] = sa_[emu::t_blk]; H8 (*sb)[64] = sb_[emu::t_blk];
    sa[w][l] = a; sb[w][l] = b; pthread_barrier_wait(&emu::g_wbar_[emu::t_blk][w]);
    A4 r = c;
    for (int reg = 0; reg < 4; ++reg) { const int row = 4 * (l >> 4) + reg, col = l & 15; float acc = 0.f;
        for (int k = 0; k < 32; ++k) acc += bf2f(sa[w][row + 16 * (k >> 3)].v[k & 7]) * bf2f(sb[w][col + 16 * (k >> 3)].v[k & 7]);
        r.v[reg] += acc; }
    pthread_barrier_wait(&emu::g_wbar_[emu::t_blk][w]);
    return r;
}
#define H8_SET(h, j, x) (h).v[j] = (unsigned short)(x)
#define A4_GET(a, j) (a).v[j]
#define MFMA_PAD(a,b,c,d,e,f,g,h)
#else
typedef short H8 __attribute__((ext_vector_type(8)));
typedef float A4 __attribute__((ext_vector_type(4)));
DEVFN A4 mfma16(const H8& a, const H8& b, const A4& c) { return __builtin_amdgcn_mfma_f32_16x16x32_bf16(a, b, c, 0, 0, 0); }
#define H8_SET(h, j, x) (h)[j] = (short)(x)
#define A4_GET(a, j) (a)[j]
#define MFMA_PAD(a,b,c,d,e,f,g,h) asm volatile("s_nop 15\n\ts_nop 15" : "+v"(a), "+v"(b), "+v"(c), "+v"(d), "+v"(e), "+v"(f), "+v"(g), "+v"(h))
#endif
#ifdef EMU
#define FEXP(x) expf(x)
#define FLOG(x) logf(x)
#define FRCP(x) (1.0f / (x))
#define FRSQ(x) (1.0f / sqrtf(x))
#define SETPRIO(n)
#else
#define FEXP(x) __expf(x)
#define FLOG(x) __logf(x)
#define FRCP(x) __builtin_amdgcn_rcpf(x)
#define FRSQ(x) __builtin_amdgcn_rsqf(x)
#define SETPRIO(n) __builtin_amdgcn_s_setprio(n)
#endif
DEVFN H8 h8_from_u4(U4 w) { H8 r; H8_SET(r, 0, w.x & 0xffff); H8_SET(r, 1, w.x >> 16); H8_SET(r, 2, w.y & 0xffff); H8_SET(r, 3, w.y >> 16); H8_SET(r, 4, w.z & 0xffff); H8_SET(r, 5, w.z >> 16); H8_SET(r, 6, w.w & 0xffff); H8_SET(r, 7, w.w >> 16); return r; }
constexpr int FFT_N = 16384;
DEVFN int fidx(int n) { return n + (n >> 4); }
DEVFN F2 cmul(F2 a, F2 b) { F2 r; r.x = a.x * b.x - a.y * b.y; r.y = a.x * b.y + a.y * b.x; return r; }
DEVFN F2 cmulc(F2 a, F2 b) { F2 r; r.x = a.x * b.x + a.y * b.y; r.y = a.y * b.x - a.x * b.y; return r; }
DEVFN F2 cadd(F2 a, F2 b) { F2 r; r.x = a.x + b.x; r.y = a.y + b.y; return r; }
DEVFN F2 csub(F2 a, F2 b) { F2 r; r.x = a.x - b.x; r.y = a.y - b.y; return r; }
DEVFN F2 cconj(F2 a) { F2 r; r.x = a.x; r.y = -a.y; return r; }
template <bool INV> DEVFN F2 mul_mi(F2 a) { F2 r; if (!INV) { r.x = a.y; r.y = -a.x; } else { r.x = -a.y; r.y = a.x; } return r; }
template <bool INV> DEVFN void dft4(F2& a0, F2& a1, F2& a2, F2& a3) {
    const F2 s02 = cadd(a0, a2), d02 = csub(a0, a2), s13 = cadd(a1, a3), d13 = mul_mi<INV>(csub(a1, a3));
    a0 = cadd(s02, s13); a2 = csub(s02, s13); a1 = cadd(d02, d13); a3 = csub(d02, d13);
}
template <bool INV> DEVFN void dft16(F2* a) {
    UNR for (int n2 = 0; n2 < 4; ++n2) dft4<INV>(a[n2], a[4 + n2], a[8 + n2], a[12 + n2]);
    const float c1 = 0.92387953251128674f, s1 = 0.38268343236508977f, r2 = 0.70710678118654752f;
    const F2 w1 = {c1, INV ? s1 : -s1}, w2 = {r2, INV ? r2 : -r2}, w3 = {s1, INV ? c1 : -c1}, w6 = {-r2, INV ? r2 : -r2}, w9 = {-c1, INV ? -s1 : s1};
    a[4 * 1 + 1] = cmul(a[4 * 1 + 1], w1); a[4 * 1 + 2] = cmul(a[4 * 1 + 2], w2); a[4 * 1 + 3] = cmul(a[4 * 1 + 3], w3);
    a[4 * 2 + 1] = cmul(a[4 * 2 + 1], w2); a[4 * 2 + 2] = mul_mi<INV>(a[4 * 2 + 2]); a[4 * 2 + 3] = cmul(a[4 * 2 + 3], w6);
    a[4 * 3 + 1] = cmul(a[4 * 3 + 1], w3); a[4 * 3 + 2] = cmul(a[4 * 3 + 2], w6); a[4 * 3 + 3] = cmul(a[4 * 3 + 3], w9);
    F2 x[16];
    UNR for (int k1 = 0; k1 < 4; ++k1) { F2 b0 = a[4 * k1 + 0], b1 = a[4 * k1 + 1], b2 = a[4 * k1 + 2], b3 = a[4 * k1 + 3]; dft4<INV>(b0, b1, b2, b3); x[k1] = b0; x[k1 + 4] = b1; x[k1 + 8] = b2; x[k1 + 12] = b3; }
    UNR for (int q = 0; q < 16; ++q) a[q] = x[q];
}
template <int R, bool INV> DEVFN void fft_stage(F2* F, const F2* TW, int B, int tid) {
    const int S = B / R, NB = FFT_N / R, tws = 2 * (FFT_N / B);
    int tq = tid; OPAQUE(tq);
    UNR1 for (int q = tq; q < NB; q += NTHREADS) {
        const int blk = q / S, j = q - blk * S, base = blk * B + j;
        F2 a[R];
        UNR for (int m = 0; m < R; ++m) a[m] = F[fidx(base + m * S)];
        if (INV && S > 1) { const F2 w1 = TW[tws * j]; F2 w = w1; UNR for (int m = 1; m < R; ++m) { a[m] = cmulc(a[m], w); w = cmul(w, w1); } }
        if constexpr (R == 4) dft4<INV>(a[0], a[1], a[2], a[3]); else dft16<INV>(a);
        if (!INV && S > 1) { const F2 w1 = TW[tws * j]; F2 w = w1; UNR for (int m = 1; m < R; ++m) { a[m] = cmul(a[m], w); w = cmul(w, w1); } }
        UNR for (int m = 0; m < R; ++m) F[fidx(base + m * S)] = a[m];
    }
}
DEVFN void fft_fwd(F2* F, const F2* TW, int tid) {
    fft_stage<4, false>(F, TW, 16384, tid); SYNC(); fft_stage<16, false>(F, TW, 4096, tid); SYNC(); fft_stage<16, false>(F, TW, 256, tid); SYNC(); fft_stage<16, false>(F, TW, 16, tid); SYNC();
}
DEVFN void fft_inv(F2* F, const F2* TW, int tid) {
    fft_stage<16, true>(F, TW, 16, tid); SYNC(); fft_stage<16, true>(F, TW, 256, tid); SYNC(); fft_stage<16, true>(F, TW, 4096, tid); SYNC(); fft_stage<4, true>(F, TW, 16384, tid); SYNC();
}
DEVFN int fpos(int k) { return ((k & 3) << 12) | (((k >> 2) & 15) << 8) | (((k >> 6) & 15) << 4) | (k >> 10); }

DEVFN float block_sum(float v, float* red, int tid) {
    v = wave_sum(v);
    if ((tid & 63) == 0) red[tid >> 6] = v;
    SYNC();
    float s = 0.f; UNR for (int w = 0; w < NWAVES; ++w) s += red[w];
    SYNC();
    return s;
}

#ifdef EMU
#define SCHED_BAR()
#else
#define SCHED_BAR() __builtin_amdgcn_sched_barrier(0)
#endif
#if defined(HSEC)
#define HS_B(k) do { if (HSEC == (k)) { TACC_BEGIN; } } while (0)
#define HS_E(k) do { if (HSEC == (k)) { TACC_END; } } while (0)
#else
#define HS_B(k)
#define HS_E(k)
#endif
DEVFN void hyena_channel(const Ctx& C, int i, int c, unsigned char* lds) {
    const int tid = C.tid; constexpr int L = NLAT;
    F2* F = (F2*)lds; float* Ff = (float*)lds;
    float* W3C = (float*)(lds + 139264);
    float* red = W3C + 272;
    const F2* TW = (const F2*)(C.ws + WS_TW);
    const bf16_t* hidb = (const bf16_t*)(C.ws + WS_HID) + (size_t)i * NLAT * 64;
    const float* w3 = C.in[I_HW3] + (size_t)i * 64 * 2048; const float* b3 = C.in[I_HB3] + (size_t)i * 2048;
    const bf16_t* VX0 = (const bf16_t*)(C.ws + WS_VX0) + (size_t)c * L;
    const bf16_t* VX1 = (const bf16_t*)(C.ws + WS_VX1) + (size_t)c * L;
    const bf16_t* VX2 = (const bf16_t*)(C.ws + WS_VX2) + (size_t)c * L;
    bf16_t* YHY = (bf16_t*)(C.ws + WS_YHY) + (size_t)c * L;
    const float skip0 = C.in[I_HSKIP][(size_t)i * 1024 + c], skip1 = C.in[I_HSKIP][(size_t)i * 1024 + 512 + c];
    const float delta = 15.350567286626973f + (float)c * ((3.0701134573253945f - 15.350567286626973f) / 511.0f);
    if (tid < 256) { const int o = tid >> 7, s = (tid >> 6) & 1, m = tid & 63; W3C[tid] = w3[(size_t)m * 2048 + (s * 2 + o) * 512 + c]; }
    if (tid < 4) W3C[256 + tid] = b3[((tid & 1) * 2 + (tid >> 1)) * 512 + c];
    SYNC();
    TACC_DECL;
    unsigned ktap1[32];
    UNR1 for (int o = 0; o < 2; ++o) {
        HS_B(1);
        float ssq = 0.f, af0_ = 0.f, ab0_ = 0.f;
        if (o == 0) {
            int tqa = tid; OPAQUE(tqa); const int lane = tqa & 63, wv = tqa >> 6, l15 = lane & 15, kg = lane >> 4, rr = l15 & 3, gq = l15 >> 2;
            H8 Ag[4][2];
            { float f0[8], f1[8]; UNR for (int j = 0; j < 8; ++j) { f0[j] = W3C[rr * 64 + 8 * kg + j]; f1[j] = W3C[rr * 64 + 32 + 8 * kg + j]; }
              const U4 w0 = pack8(f0), w1 = pack8(f1);
              UNR for (int g = 0; g < 4; ++g) { const unsigned m_ = gq == g ? 0xffffffffu : 0u; U4 a0, a1; a0.x = w0.x & m_; a0.y = w0.y & m_; a0.z = w0.z & m_; a0.w = w0.w & m_; a1.x = w1.x & m_; a1.y = w1.y & m_; a1.z = w1.z & m_; a1.w = w1.w & m_;
                  Ag[g][0] = h8_from_u4(a0); Ag[g][1] = h8_from_u4(a1); } }
            const float b00 = W3C[256 + 0], b01 = W3C[256 + 1], b10 = W3C[256 + 2], b11 = W3C[256 + 3];
            const bf16_t* hp = hidb + (size_t)l15 * 64 + 8 * kg;
            U4 bb[4][8];
#define HY_LOADB(II) do { UNR for (int g = 0; g < 4; ++g) { bb[(II) & 3][2 * g] = ld16(hp + (size_t)(((II) * 8 + wv) * 64 + 16 * g) * 64); bb[(II) & 3][2 * g + 1] = ld16(hp + (size_t)(((II) * 8 + wv) * 64 + 16 * g) * 64 + 32); } } while (0)
            HY_LOADB(0); HY_LOADB(1); HY_LOADB(2);
            UNR for (int ii = 0; ii < 32; ++ii) {
                const int t0 = (ii * 8 + wv) * 64;
                if (ii + 3 < 32) HY_LOADB(ii + 3);
                SCHED_BAR();
                A4 acc; A4_GET(acc, 0) = 0.f; A4_GET(acc, 1) = 0.f; A4_GET(acc, 2) = 0.f; A4_GET(acc, 3) = 0.f;
                UNR for (int g = 0; g < 4; ++g) { acc = mfma16(Ag[g][0], h8_from_u4(bb[ii & 3][2 * g]), acc); acc = mfma16(Ag[g][1], h8_from_u4(bb[ii & 3][2 * g + 1]), acc); }
                MFMA_PAD(acc, acc, acc, acc, acc, acc, acc, acc);
                int ln_ = lane; OPAQUE(ln_); const int t = t0 + ln_;
                const float win = expf(-((float)t / (float)(L - 1)) * delta);
                const float af = (A4_GET(acc, 0) + b00) * win; const float ab = (A4_GET(acc, 1) + b01) * win;
                ktap1[ii] = pk2((A4_GET(acc, 2) + b10) * win, (A4_GET(acc, 3) + b11) * win);
                ssq += af * af + ab * ab; Ff[2 * fidx(t >> 1) + (t & 1)] = af; const int m = t == 0 ? L : 2 * L - t; Ff[2 * fidx(m >> 1) + (m & 1)] = ab;
                if (ii == 0) { af0_ = af; ab0_ = ab; }
                SCHED_BAR();
            }
#undef HY_LOADB
        } else {
            int tqb = tid; OPAQUE(tqb); const int lane = tqb & 63, wv = tqb >> 6;
            UNR for (int ii = 0; ii < 32; ++ii) {
                int ln_ = lane; OPAQUE(ln_); const int t = (ii * 8 + wv) * 64 + ln_; const float af = bflo(ktap1[ii]); const float ab = bfhi(ktap1[ii]);
                ssq += af * af + ab * ab; Ff[2 * fidx(t >> 1) + (t & 1)] = af; const int m = t == 0 ? L : 2 * L - t; Ff[2 * fidx(m >> 1) + (m & 1)] = ab;
                if (ii == 0) { af0_ = af; ab0_ = ab; }
                if ((ii & 3) == 3) SCHED_BAR();
            }
        }
        if (tid == 0) { Ff[0] = af0_ + ab0_; Ff[2 * fidx(L >> 1)] = 0.f; ssq += 2.f * af0_ * ab0_; }
        const float knorm = 1.0f / sqrtf(block_sum(ssq, red, tid)); HS_E(1);
        HS_B(2); fft_fwd(F, TW, tid); HS_E(2);
        HS_B(3);
        F2 kfa[16], kfb[16]; F2 kfh = {0.f, 0.f};
        int tq1 = tid; OPAQUE(tq1);
        UNR for (int ii = 0; ii < 16; ++ii) {
            const int k = tq1 + NTHREADS * ii;
            if (k == 0) { const F2 c0 = F[fidx(0)]; kfa[ii].x = (c0.x + c0.y) * knorm; kfa[ii].y = 0.f; kfb[ii].x = (c0.x - c0.y) * knorm; kfb[ii].y = 0.f;
                          const F2 ch = F[fidx(fpos(L / 2))]; kfh.x = ch.x * knorm; kfh.y = -ch.y * knorm; }
            else { const F2 ck = F[fidx(fpos(k))], cp = cconj(F[fidx(fpos(L - k))]);
                F2 e = cadd(ck, cp), od = csub(ck, cp); e.x *= 0.5f; e.y *= 0.5f; F2 oo; oo.x = 0.5f * od.y; oo.y = -0.5f * od.x;
                const F2 tt = cmul(TW[k], oo);
                kfa[ii] = cadd(e, tt); kfb[ii] = cconj(csub(e, tt)); kfa[ii].x *= knorm; kfa[ii].y *= knorm; kfb[ii].x *= knorm; kfb[ii].y *= knorm; }
            CFENCE();
        }
        SYNC(); HS_E(3);
        HS_B(4);
        UNR for (int ii = 0; ii < 4; ++ii) {
            int tq3 = tid; OPAQUE(tq3); const int t0 = 8 * (tq3 + NTHREADS * ii); float v[8];
            unpack8(ld16((o == 0 ? VX0 : (const bf16_t*)YHY) + t0), v);
            float* d = Ff + 2 * fidx(t0 >> 1); UNR for (int e = 0; e < 8; ++e) d[e] = v[e];
            float* zz = Ff + 2 * fidx((L + t0) >> 1); UNR for (int e = 0; e < 8; ++e) zz[e] = 0.f;
        }
        SYNC(); HS_E(4);
        HS_B(2); fft_fwd(F, TW, tid); HS_E(2);
        HS_B(3);
        int tq2 = tid; OPAQUE(tq2);
        UNR for (int ii = 0; ii < 16; ++ii) {
            const int k = tq2 + NTHREADS * ii;
            if (k == 0) { const F2 c0 = F[fidx(0)]; const float y0 = (c0.x + c0.y) * kfa[ii].x, yl = (c0.x - c0.y) * kfb[ii].x; F2 d; d.x = 0.5f * (y0 + yl); d.y = 0.5f * (y0 - yl); F[fidx(0)] = d;
                          const int ph = fidx(fpos(L / 2)); const F2 y = cmul(cconj(F[ph]), kfh); F[ph] = cconj(y); }
            else { const int pk = fidx(fpos(k)), pp = fidx(fpos(L - k)); const F2 ck = F[pk], cp = cconj(F[pp]);
                F2 e = cadd(ck, cp), od = csub(ck, cp); e.x *= 0.5f; e.y *= 0.5f; F2 oo; oo.x = 0.5f * od.y; oo.y = -0.5f * od.x;
                const F2 w = TW[k]; const F2 tt = cmul(w, oo);
                const F2 yk = cmul(cadd(e, tt), kfa[ii]), yp = cmul(cconj(csub(e, tt)), kfb[ii]);
                F2 ye = cadd(yk, cconj(yp)), yd = csub(yk, cconj(yp)); ye.x *= 0.5f; ye.y *= 0.5f; yd.x *= 0.5f; yd.y *= 0.5f;
                const F2 yo = cmulc(yd, w);
                F2 iyo; iyo.x = -yo.y; iyo.y = yo.x;
                F[pk] = cadd(ye, iyo); F[pp] = cconj(csub(ye, iyo)); }
            CFENCE();
        }
        SYNC(); HS_E(3);
        HS_B(2); fft_inv(F, TW, tid); HS_E(2);
        HS_B(4);
        UNR for (int ii = 0; ii < 4; ++ii) {
            int tq4 = tid; OPAQUE(tq4); const int t0 = 8 * (tq4 + NTHREADS * ii); const float* d = Ff + 2 * fidx(t0 >> 1);
            float y[8]; UNR for (int e = 0; e < 8; ++e) y[e] = d[e] * (1.0f / (float)FFT_N);
            if (o == 0) { float v[8], x1[8], r[8]; unpack8(ld16(VX0 + t0), v); unpack8(ld16(VX1 + t0), x1); UNR for (int e = 0; e < 8; ++e) r[e] = x1[e] * (y[e] + v[e] * skip0); st16(YHY + t0, pack8(r)); }
            else { float x2[8], zp[8], r[8]; unpack8(ld16(VX2 + t0), x2); unpack8(ld16(YHY + t0), zp); UNR for (int e = 0; e < 8; ++e) r[e] = x2[e] * (y[e] + zp[e] * skip1); st16(YHY + t0, pack8(r)); }
        }
        SYNC(); HS_E(4);
    }
    TACC_STORE(C, 39, C.vcu == C.G - 1 && tid == 0);
}

DEVFN void hyena_ctx_channel(const Ctx& C, int i, int c, unsigned char* lds) {
    const int tid = C.tid; constexpr int L = NCTX;
    float* KF = (float*)lds;
    float* Z = KF + 1024;
    float* red = Z + 256;
    float* W3C = red + 16;
    const float* hid = (const float*)(C.ws + WS_HID256);
    const float* w3 = C.in[I_HW3] + (size_t)i * 64 * 2048; const float* b3 = C.in[I_HB3] + (size_t)i * 2048;
    const float* VXC = (const float*)(C.ws + WS_VXC);
    const float delta = 15.350567286626973f + (float)c * ((3.0701134573253945f - 15.350567286626973f) / 511.0f);
    if (tid < 256) { const int o = tid >> 7, s = (tid >> 6) & 1, m = tid & 63; W3C[tid] = w3[(size_t)m * 2048 + (s * 2 + o) * 512 + c]; }
    if (tid < 4) W3C[256 + tid] = b3[((tid & 1) * 2 + (tid >> 1)) * 512 + c];
    SYNC();
    {
        const int o = tid >> 8, t = tid & 255;
        float af = W3C[256 + o * 2 + 0], ab = W3C[256 + o * 2 + 1];
        for (int m = 0; m < 64; ++m) { const float h = hid[t * 64 + m]; af += h * W3C[(o * 2 + 0) * 64 + m]; ab += h * W3C[(o * 2 + 1) * 64 + m]; }
        const float win = expf(-((float)t / (float)(L - 1)) * delta); af *= win; ab *= win;
        float ssq; if (t == 0) { af += ab; ab = 0.f; ssq = af * af; } else ssq = af * af + ab * ab;
        KF[(o * 2 + 0) * 256 + t] = af; KF[(o * 2 + 1) * 256 + t] = ab;
        ssq = wave_sum(ssq);
        if ((tid & 63) == 0) red[tid >> 6] = ssq;
        SYNC();
        const float tot = red[o * 4] + red[o * 4 + 1] + red[o * 4 + 2] + red[o * 4 + 3];
        const float kn = 1.0f / sqrtf(tot);
        KF[(o * 2 + 0) * 256 + t] = af * kn; KF[(o * 2 + 1) * 256 + t] = ab * kn;
    }
    float v = 0.f, x1 = 0.f, x2 = 0.f, z1 = 0.f;
    if (tid < 256) { v = VXC[((size_t)0 * 512 + c) * L + tid]; x1 = VXC[((size_t)1 * 512 + c) * L + tid]; x2 = VXC[((size_t)2 * 512 + c) * L + tid]; Z[tid] = v; }
    SYNC();
    for (int o = 0; o < 2; ++o) {
        float y = 0.f;
        if (tid < 256) { const int t = tid; const float* kf = KF + (o * 2) * 256; const float* kb = KF + (o * 2 + 1) * 256;
            for (int s = 0; s <= t; ++s) y += kf[t - s] * Z[s];
            for (int s = t + 1; s < L; ++s) y += kb[s - t] * Z[s]; }
        SYNC();
        if (tid < 256) { if (o == 0) { z1 = x1 * (y + v * C.in[I_HSKIP][(size_t)i * 1024 + c]); Z[tid] = z1; }
            else { const float r = x2 * (y + z1 * C.in[I_HSKIP][(size_t)i * 1024 + 512 + c]);
                const bf16_t* GHY = (const bf16_t*)(C.ws + WS_GHY); bf16_t* HO = (bf16_t*)(C.ws + WS_HYOUT);
                HO[(size_t)(NLAT + tid) * 512 + c] = (bf16_t)f2bf(r * bf2f(GHY[(size_t)(NLAT + tid) * 512 + c])); } }
        SYNC();
    }
}

constexpr int SC_T = 32;
constexpr int SC_R = 16;
constexpr int SC_BUF = 5 * SC_T * 64 + SC_T * SC_R;
DEVFN void rwkv_scan(const Ctx& C, int i, int h, int d, int rq, bool ctx_out, unsigned char* lds, int max_chunks) {
    const int tid = C.tid;
    float* sBUF = (float*)lds; float* sY = sBUF + 2 * SC_BUF; float* sWV = sY + 2 * SC_T * SC_R;
    const bf16_t* U = (const bf16_t*)(C.ws + WS_U);
    const float* mu = C.in[I_MU] + (size_t)i * 1664;
    const float* w0 = C.in[I_W0] + ((size_t)i * 2 + d) * 512 + 64 * h; const float* a0 = C.in[I_A0] + ((size_t)i * 2 + d) * 512 + 64 * h;
    const float* wup = C.in[I_WUP] + ((size_t)i * 2 + d) * 32 * 512 + 64 * h; const float* aup = C.in[I_AUP] + ((size_t)i * 2 + d) * 32 * 512 + 64 * h;
    const float* k_k = C.in[I_KK] + (size_t)i * 512 + 64 * h; const float* k_a = C.in[I_KA] + (size_t)i * 512 + 64 * h; const float* r_k = C.in[I_RK] + (size_t)i * 512 + 64 * h;
    bf16_t* Yd = (bf16_t*)(C.ws + (d == 0 ? WS_YF : WS_YB));
    float* BON = (float*)(C.ws + WS_BONUS) + (size_t)d * NTOK * 8;
    const bool is_scan = tid < 256;
    const int nchunks = NTOK / SC_T < max_chunks ? NTOK / SC_T : max_chunks;
    #define CHUNK_GEOM(ch, seg0, segn, R0) const bool isctx_ = (ch) < NCTX / SC_T; const int seg0 = isctx_ ? NLAT : 0, segn = isctx_ ? NCTX : NLAT; \
        const int cl_ = isctx_ ? (ch) : (ch) - NCTX / SC_T; const int R0 = d == 0 ? SC_T * cl_ : segn - SC_T * (cl_ + 1);
    const int ft = (tid & 255) >> 3, fp = tid & 7;
    float* sCN = sWV + 4 * 1280; float* sCN_base_ = sCN;
    if (tid < 64) { const int j = tid; sCN[j] = mu[64 * h + j]; sCN[64 + j] = mu[512 + 64 * h + j]; sCN[128 + j] = mu[1024 + 64 * h + j]; sCN[192 + j] = w0[j]; sCN[256 + j] = a0[j];
        sCN[320 + j] = k_k[j]; sCN[384 + j] = k_a[j]; sCN[448 + j] = r_k[j]; sCN[512 + j] = j < 32 ? mu[1536 + 32 * d + j] : mu[1600 + 32 * d + (j - 32)]; }
    U4* sBF = (U4*)(sCN_base_ + 640);
    { const int m = tid >> 8, nt = (tid >> 6) & 3, ln = tid & 63; const float* src = m == 0 ? wup : aup; float f[8];
      UNR for (int j = 0; j < 8; ++j) f[j] = src[(size_t)(8 * (ln >> 4) + j) * 512 + 16 * nt + (ln & 15)];
      sBF[tid] = pack8(f); }
    float* myWV = sWV + ((tid >> 6) & 3) * 1280; float* sWL = myWV; float* sAL = myWV + 512; bf16_t* sTDb = (bf16_t*)(myWV + 1024); bf16_t* sADb = sTDb + 256;
    const int rl = (tid & 255) >> 4, sp = tid & 15;
    float S0 = 0.f, S1 = 0.f, S2 = 0.f, S3 = 0.f;
    SYNC();
    U4 pu[9]; U2 pw[6];
    auto issue = [&](int ch) {
        int tq_ = tid; OPAQUE(tq_); const int ft = (tq_ & 255) >> 3, fp = tq_ & 7;
        CHUNK_GEOM(ch, seg0, segn, R0)
        const int tl = d == 0 ? R0 + ft : R0 + SC_T - 1 - ft;
        const bf16_t* u0p = U + (size_t)(seg0 + tl) * URW_W;
        const bool hm = tl > 0, hp = tl < segn - 1;
        const U4 z4 = {0u, 0u, 0u, 0u}; const U2 z2 = {0u, 0u};
        const int cw = 1536 + 32 * d + 4 * fp, ca = 1600 + 32 * d + 4 * fp;
        UNR for (int j = 0; j < 3; ++j) { pu[3 * j] = ld16(u0p + 512 * j + 64 * h + 8 * fp); pu[3 * j + 1] = z4; pu[3 * j + 2] = z4; }
        pw[0] = *(const U2*)(u0p + cw); pw[3] = *(const U2*)(u0p + ca); pw[1] = z2; pw[2] = z2; pw[4] = z2; pw[5] = z2;
        if (hm) { UNR for (int j = 0; j < 3; ++j) pu[3 * j + 1] = ld16(u0p - URW_W + 512 * j + 64 * h + 8 * fp); pw[1] = *(const U2*)(u0p - URW_W + cw); pw[4] = *(const U2*)(u0p - URW_W + ca); }
        if (hp) { UNR for (int j = 0; j < 3; ++j) pu[3 * j + 2] = ld16(u0p + URW_W + 512 * j + 64 * h + 8 * fp); pw[2] = *(const U2*)(u0p + URW_W + cw); pw[5] = *(const U2*)(u0p + URW_W + ca); }
    };
    auto features = [&](int ch) {
        int tq_ = tid; OPAQUE(tq_); const int ft = (tq_ & 255) >> 3, fp = tq_ & 7;
        const float* mu_r = sCN + 8 * fp; const float* mu_k = sCN + 64 + 8 * fp; const float* mu_v = sCN + 128 + 8 * fp; const float* c_w0 = sCN + 192 + 8 * fp; const float* c_a0 = sCN + 256 + 8 * fp;
        const float* c_kk = sCN + 320 + 8 * fp; const float* c_ka = sCN + 384 + 8 * fp; const float* c_rk = sCN + 448 + 8 * fp; const float* mu_w = sCN + 512 + 4 * fp; const float* mu_a = sCN + 544 + 4 * fp;
        CHUNK_GEOM(ch, seg0, segn, R0)
        float* B_ = sBUF + (ch & 1) * SC_BUF; float* sW = B_; float* sKD = B_ + SC_T * 64; float* sB = B_ + 2 * SC_T * 64; float* sKK = B_ + 3 * SC_T * 64; float* sR = B_ + 4 * SC_T * 64; float* sV = B_ + 5 * SC_T * 64;
        const int tl = d == 0 ? R0 + ft : R0 + SC_T - 1 - ft;
        float r[8], k[8], v[8];
        {
            float a[8], m[8], p[8];
            #define SHIFT3(J, MU, OUT) do { unpack8(pu[3 * (J)], a); unpack8(pu[3 * (J) + 1], m); unpack8(pu[3 * (J) + 2], p); \
                UNR for (int e = 0; e < 8; ++e) OUT[e] = a[e] + (0.5f * (m[e] + p[e]) - a[e]) * MU[e]; } while (0)
            SHIFT3(0, mu_r, r); SHIFT3(1, mu_k, k); SHIFT3(2, mu_v, v);
            #undef SHIFT3
        }
        {
            const U2 w0_ = pw[0], wm = pw[1], wp = pw[2], a0_ = pw[3], am = pw[4], ap = pw[5];
            const float wa[4] = {bflo(w0_.x), bfhi(w0_.x), bflo(w0_.y), bfhi(w0_.y)}, wmm[4] = {bflo(wm.x), bfhi(wm.x), bflo(wm.y), bfhi(wm.y)}, wpp[4] = {bflo(wp.x), bfhi(wp.x), bflo(wp.y), bfhi(wp.y)};
            const float aa[4] = {bflo(a0_.x), bfhi(a0_.x), bflo(a0_.y), bfhi(a0_.y)}, amm[4] = {bflo(am.x), bfhi(am.x), bflo(am.y), bfhi(am.y)}, app[4] = {bflo(ap.x), bfhi(ap.x), bflo(ap.y), bfhi(ap.y)};
            if (ch + 1 < nchunks) issue(ch + 1);
            const int tw = ft & 7;
            float tdv[4], adv[4];
            UNR for (int e = 0; e < 4; ++e) { const float x = wa[e] + (0.5f * (wmm[e] + wpp[e]) - wa[e]) * mu_w[e];
                tdv[e] = 1.0f - 2.0f * FRCP(1.0f + FEXP(2.0f * x));
                adv[e] = aa[e] + (0.5f * (amm[e] + app[e]) - aa[e]) * mu_a[e]; }
            U2 tq, aq; tq.x = pk2(tdv[0], tdv[1]); tq.y = pk2(tdv[2], tdv[3]); aq.x = pk2(adv[0], adv[1]); aq.y = pk2(adv[2], adv[3]);
            *(U2*)(sTDb + tw * 32 + 4 * fp) = tq; *(U2*)(sADb + tw * 32 + 4 * fp) = aq;
        }
        WAVE_SYNC();
        float wl[8], al[8];
        {
            const int lane = tid & 63, arow = lane & 7, kg = lane >> 4;
            const U4 ta = ld16(sTDb + arow * 32 + 8 * kg), aa_ = ld16(sADb + arow * 32 + 8 * kg);
            H8 At, Aa;
            H8_SET(At, 0, ta.x & 0xffff); H8_SET(At, 1, ta.x >> 16); H8_SET(At, 2, ta.y & 0xffff); H8_SET(At, 3, ta.y >> 16); H8_SET(At, 4, ta.z & 0xffff); H8_SET(At, 5, ta.z >> 16); H8_SET(At, 6, ta.w & 0xffff); H8_SET(At, 7, ta.w >> 16);
            H8_SET(Aa, 0, aa_.x & 0xffff); H8_SET(Aa, 1, aa_.x >> 16); H8_SET(Aa, 2, aa_.y & 0xffff); H8_SET(Aa, 3, aa_.y >> 16); H8_SET(Aa, 4, aa_.z & 0xffff); H8_SET(Aa, 5, aa_.z >> 16); H8_SET(Aa, 6, aa_.w & 0xffff); H8_SET(Aa, 7, aa_.w >> 16);
            A4 cw_[4], ca_[4];
            UNR for (int nt = 0; nt < 4; ++nt) {
                A4 z; A4_GET(z, 0) = 0.f; A4_GET(z, 1) = 0.f; A4_GET(z, 2) = 0.f; A4_GET(z, 3) = 0.f;
                cw_[nt] = mfma16(At, h8_from_u4(sBF[nt * 64 + (tid & 63)]), z); ca_[nt] = mfma16(Aa, h8_from_u4(sBF[(4 + nt) * 64 + (tid & 63)]), z);
            }
            MFMA_PAD(cw_[0], cw_[1], cw_[2], cw_[3], ca_[0], ca_[1], ca_[2], ca_[3]);
            if (lane < 32) { UNR for (int nt = 0; nt < 4; ++nt) UNR for (int rg = 0; rg < 4; ++rg) { const int tok = 4 * (lane >> 4) + rg; sWL[tok * 64 + 16 * nt + (lane & 15)] = A4_GET(cw_[nt], rg); sAL[tok * 64 + 16 * nt + (lane & 15)] = A4_GET(ca_[nt], rg); } }
            WAVE_SYNC();
            const int tw = ft & 7;
            { const F4 w0_ = *(const F4*)(sWL + tw * 64 + 8 * fp), w1_ = *(const F4*)(sWL + tw * 64 + 8 * fp + 4), a0_ = *(const F4*)(sAL + tw * 64 + 8 * fp), a1_ = *(const F4*)(sAL + tw * 64 + 8 * fp + 4);
              const F4 cw0 = *(const F4*)(c_w0), cw1 = *(const F4*)(c_w0 + 4), ca0 = *(const F4*)(c_a0), ca1 = *(const F4*)(c_a0 + 4);
              wl[0] = cw0.x + w0_.x; wl[1] = cw0.y + w0_.y; wl[2] = cw0.z + w0_.z; wl[3] = cw0.w + w0_.w; wl[4] = cw1.x + w1_.x; wl[5] = cw1.y + w1_.y; wl[6] = cw1.z + w1_.z; wl[7] = cw1.w + w1_.w;
              al[0] = ca0.x + a0_.x; al[1] = ca0.y + a0_.y; al[2] = ca0.z + a0_.z; al[3] = ca0.w + a0_.w; al[4] = ca1.x + a1_.x; al[5] = ca1.y + a1_.y; al[6] = ca1.z + a1_.z; al[7] = ca1.w + a1_.w; }
            WAVE_SYNC();
        }
        float kkv[8], ssq = 0.f;
        UNR for (int e = 0; e < 8; ++e) { kkv[e] = k[e] * c_kk[e]; ssq += kkv[e] * kkv[e]; }
        ssq = rowx_add<1>(ssq); ssq = rowx_add<2>(ssq); ssq = rowx_add<7>(ssq);
        const float kn = FRSQ(ssq + 1e-12f);
        float bon = 0.f; float o_w[8], o_kd[8], o_b[8], o_kk[8];
        UNR for (int e = 0; e < 8; ++e) {
            const float dec = FEXP(-0.60653066f * FRCP(1.0f + FEXP(-wl[e])));
            const float a = FRCP(1.0f + FEXP(-al[e]));
            const float kd = k[e] * (1.0f + (a - 1.0f) * c_ka[e]);
            const float kk = kkv[e] * kn;
            o_w[e] = dec; o_kd[e] = kd; o_b[e] = kk * a; o_kk[e] = kk;
            bon += r[e] * kd * c_rk[e];
        }
        { const int o = ft * 64 + 8 * fp;
          #define ST8(P, A) do { F4 x0_, x1_; x0_.x = A[0]; x0_.y = A[1]; x0_.z = A[2]; x0_.w = A[3]; x1_.x = A[4]; x1_.y = A[5]; x1_.z = A[6]; x1_.w = A[7]; *(F4*)((P) + o) = x0_; *(F4*)((P) + o + 4) = x1_; } while (0)
          ST8(sW, o_w); ST8(sKD, o_kd); ST8(sB, o_b); ST8(sKK, o_kk); ST8(sR, r);
          #undef ST8
        }
        if ((fp >> 1) == rq) { UNR for (int e = 0; e < 8; ++e) sV[ft * SC_R + 8 * (fp & 1) + e] = v[e]; }
        bon = rowx_add<1>(bon); bon = rowx_add<2>(bon); bon = rowx_add<7>(bon);
        if (fp == 0 && rq == 0) BON[(size_t)(seg0 + tl) * 8 + h] = 0.5f * bon;
    };
    auto store_y = [&](int ch) {
        CHUNK_GEOM(ch, seg0, segn, R0)
        if (isctx_ && !ctx_out) return;
        const float* Yb = sY + (ch & 1) * SC_T * SC_R;
        const int k = (tid & 255) >> 3, q = (tid & 7) * 2; const int tl = d == 0 ? R0 + k : R0 + SC_T - 1 - k;
        *(unsigned*)(Yd + (size_t)(seg0 + tl) * 512 + 64 * h + SC_R * rq + q) = pk2(Yb[k * SC_R + q], Yb[k * SC_R + q + 1]);
    };
    if (!is_scan) { issue(0); features(0); }
    SYNC();
    if (C.wave < 4) SETPRIO(3);
    TACC_DECL;
    for (int ch = 0; ch < nchunks; ++ch) {
        TACC_BEGIN;
        if (is_scan) {
            const float* B_ = sBUF + (ch & 1) * SC_BUF; const float* sW = B_; const float* sKD = B_ + SC_T * 64; const float* sB = B_ + 2 * SC_T * 64; const float* sKK = B_ + 3 * SC_T * 64; const float* sR = B_ + 4 * SC_T * 64; const float* sV = B_ + 5 * SC_T * 64;
            float* Yb = sY + (ch & 1) * SC_T * SC_R;
            float yk0 = 0.f, yk1 = 0.f, yp = 0.f;
#ifndef EMU
            {
                const unsigned ab = (unsigned)(uintptr_t)B_ + 16u * (unsigned)sp, av = (unsigned)(uintptr_t)sV + 4u * (unsigned)rl;
                P2 s01 = {S0, S1}, s23 = {S2, S3};
                asm volatile(SCAN_CHUNK_ASM : [s01] "+v"(s01), [s23] "+v"(s23), [yp] "+v"(yp), [yk0] "+v"(yk0), [yk1] "+v"(yk1) : [ab] "v"(ab), [av] "v"(av), [sp] "v"(sp) : SCAN_CHUNK_CLOBBERS);
                S0 = s01[0]; S1 = s01[1]; S2 = s23[0]; S3 = s23[1];
            }
#else
            for (int k = 0; k < SC_T; ++k) {
                const F4 kk4 = *(const F4*)(sKK + k * 64 + 4 * sp), w4 = *(const F4*)(sW + k * 64 + 4 * sp), b4 = *(const F4*)(sB + k * 64 + 4 * sp),
                         kd4 = *(const F4*)(sKD + k * 64 + 4 * sp), r4 = *(const F4*)(sR + k * 64 + 4 * sp);
                const float vi = sV[k * SC_R + rl];
                float sa = (S0 * kk4.x + S2 * kk4.z) + (S1 * kk4.y + S3 * kk4.w);
                const float t0 = S0 * w4.x + vi * kd4.x, t1 = S1 * w4.y + vi * kd4.y, t2 = S2 * w4.z + vi * kd4.z, t3 = S3 * w4.w + vi * kd4.w;
                sa = rowx_add<1>(sa); yp = rowx_add<1>(yp); sa = rowx_add<2>(sa); yp = rowx_add<2>(yp);
                sa = rowx_add<7>(sa); yp = rowx_add<7>(yp); sa = rowx_add<15>(sa); yp = rowx_add<15>(yp);
                if (sp == ((k + 15) & 15)) { if (k <= 16) yk0 = yp; else yk1 = yp; }
                S0 = t0 - sa * b4.x; S1 = t1 - sa * b4.y; S2 = t2 - sa * b4.z; S3 = t3 - sa * b4.w;
                yp = (S0 * r4.x + S2 * r4.z) + (S1 * r4.y + S3 * r4.w);
            }
#endif
            yp = rowx_add<1>(yp); yp = rowx_add<2>(yp); yp = rowx_add<7>(yp); yp = rowx_add<15>(yp);
            if (sp == 15) yk1 = yp;
            Yb[sp * SC_R + rl] = yk0; Yb[(sp + 16) * SC_R + rl] = yk1;
        } else {
            if (ch + 1 < nchunks) features(ch + 1);
            if (ch > 0) store_y(ch - 1);
        }
        TACC_END;
        SYNC();
    }
    TACC_STORE(C, is_scan ? 45 : 46, C.vcu == 0 && (tid == 0 || tid == 256));
    if (C.wave < 4) SETPRIO(0);
    if (!is_scan) store_y(nchunks - 1);
    #undef CHUNK_GEOM
}

DEVFN void ph_readout_hyout(const Ctx& C, int i, bool do_ctx, unsigned char* lds) {
    const int tid = C.tid;
    {
        const bf16_t* U = (const bf16_t*)(C.ws + WS_U); bf16_t* YF = (bf16_t*)(C.ws + WS_YF); const bf16_t* YB = (const bf16_t*)(C.ws + WS_YB);
        const float* BON = (const float*)(C.ws + WS_BONUS);
        const float* mu = C.in[I_MU] + (size_t)i * 1664 + 1024; const float* gnw = C.in[I_GNW] + (size_t)i * 512; const float* gnb = C.in[I_GNB] + (size_t)i * 512;
        const int rl = tid >> 6, c8 = (tid & 63) * 8, h = (tid & 63) >> 3;
        float muv[8], gw_[8], gb_[8];
        UNR for (int e = 0; e < 8; ++e) { muv[e] = mu[c8 + e]; gw_[e] = gnw[c8 + e]; gb_[e] = gnb[c8 + e]; }
        const int nrows = do_ctx ? NTOK : NLAT;
        for (int r0 = C.vcu * 8; r0 < nrows; r0 += C.G * 8) {
            const int row = r0 + rl; const bool isctx = row >= NLAT; const int seg0 = isctx ? NLAT : 0, segn = isctx ? NCTX : NLAT, tl = row - seg0;
            float yf[8], yb[8], y[8], a[8], m[8], p[8], g[8];
            unpack8(ld16(YF + (size_t)row * 512 + c8), yf); unpack8(ld16(YB + (size_t)row * 512 + c8), yb);
            float s = 0.f; UNR for (int e = 0; e < 8; ++e) { y[e] = yf[e] + yb[e]; s += y[e]; }
            s = rowx_add<1>(s); s = rowx_add<2>(s); s = rowx_add<7>(s);
            const float mean = s * (1.0f / 64.0f); float q = 0.f;
            UNR for (int e = 0; e < 8; ++e) { y[e] -= mean; q += y[e] * y[e]; }
            q = rowx_add<1>(q); q = rowx_add<2>(q); q = rowx_add<7>(q);
            const float rstd = 1.0f / sqrtf(q * (1.0f / 64.0f) + 64e-5f);
            const bf16_t* up = U + (size_t)row * URW_W + 1024 + c8;
            unpack8(ld16(up), a);
            if (tl > 0) unpack8(ld16(up - URW_W), m); else UNR for (int e = 0; e < 8; ++e) m[e] = 0.f;
            if (tl < segn - 1) unpack8(ld16(up + URW_W), p); else UNR for (int e = 0; e < 8; ++e) p[e] = 0.f;
            unpack8(ld16(U + (size_t)row * URW_W + 1664 + c8), g);
            const float bon = BON[(size_t)row * 8 + h] + BON[(size_t)NTOK * 8 + (size_t)row * 8 + h];
            float o[8];
            UNR for (int e = 0; e < 8; ++e) { const float v = a[e] + (0.5f * (m[e] + p[e]) - a[e]) * muv[e]; o[e] = (y[e] * rstd * gw_[e] + gb_[e] + bon * v) * g[e]; }
            st16(YF + (size_t)row * 512 + c8, pack8(o));
        }
    }
    {
        const bf16_t* YHY = (const bf16_t*)(C.ws + WS_YHY); const bf16_t* GHY = (const bf16_t*)(C.ws + WS_GHY); bf16_t* HO = (bf16_t*)(C.ws + WS_HYOUT);
        float* T = (float*)lds;
        for (int it = C.vcu; it < 256 * 8; it += C.G) {
            const int tb = it >> 3, cb = it & 7;
            { const int cl = tid >> 3, t8 = (tid & 7) * 8; float v[8]; unpack8(ld16(YHY + (size_t)(64 * cb + cl) * NLAT + 64 * tb + t8), v); UNR for (int e = 0; e < 8; ++e) T[cl * 65 + t8 + e] = v[e]; }
            SYNC();
            { const int tl = tid >> 3, c8 = (tid & 7) * 8; float g[8], o[8]; const size_t off = (size_t)(64 * tb + tl) * 512 + 64 * cb + c8;
              unpack8(ld16(GHY + off), g); UNR for (int e = 0; e < 8; ++e) o[e] = T[(c8 + e) * 65 + tl] * g[e]; st16(HO + off, pack8(o)); }
            SYNC();
        }
    }
}

constexpr int RC_T = 16, RC_RING = 7, RC_NPROD = 6;
constexpr int RS_KKD = 0, RS_RD = 2048, RS_KIT = 4096, RS_NBIT = 6144, RS_VT = 8192, RS_T = 9216, RS_P0 = 9728, RS_Q1 = 10240, RS_NQ2 = 10752, RS_GC = 11264, RS_BYTES = 11520;
constexpr int RW_TDAD = 0, RW_WL = 2048, RW_AL = 6144, RW_KIP = 2048, RW_BIP = 4096, RW_AM = 10240, RW_BYTES = 11264;
constexpr int RC_LDS_RING = 0, RC_LDS_WAVE = RC_RING * RS_BYTES, RC_LDS_BFR = RC_LDS_WAVE + RC_NPROD * RW_BYTES, RC_LDS_FLAGS = RC_LDS_BFR + 8192, RC_LDS_END = RC_LDS_FLAGS + 3 * 8 * 4;
static_assert(RC_LDS_END <= RING_BYTES, "rwkv chunked LDS");
#ifdef EMU
#include <sched.h>
#define SPIN_WAIT(cond) do { while (!(cond)) sched_yield(); __sync_synchronize(); } while (0)
#define LDS_FENCE() __sync_synchronize()
#else
#define SPIN_WAIT(cond) do { while (!(cond)) __builtin_amdgcn_s_sleep(1); asm volatile("" ::: "memory"); } while (0)
#define LDS_FENCE() asm volatile("s_waitcnt lgkmcnt(0)" ::: "memory")
#endif
#ifdef EMU
DEVFN float wave_sum_fast(float v) { v = rowx_add<1>(v); v = rowx_add<2>(v); v = rowx_add<7>(v); v = rowx_add<15>(v); return (shfl_f(v, 0) + shfl_f(v, 16)) + (shfl_f(v, 32) + shfl_f(v, 48)); }
#else
DEVFN float wave_sum_fast(float v) { v = rowx_add<1>(v); v = rowx_add<2>(v); v = rowx_add<7>(v); v = rowx_add<15>(v);
    const int i_ = __builtin_bit_cast(int, v);
    return (__builtin_bit_cast(float, __builtin_amdgcn_readlane(i_, 0)) + __builtin_bit_cast(float, __builtin_amdgcn_readlane(i_, 16))) + (__builtin_bit_cast(float, __builtin_amdgcn_readlane(i_, 32)) + __builtin_bit_cast(float, __builtin_amdgcn_readlane(i_, 48))); }
#endif
DEVFN int rc_pos(int k) { return (k & 32) | (((k >> 2) & 3) << 3) | (((k >> 4) & 1) << 2) | (k & 3); }
DEVFN H8 h8_from(U4 w) { H8 r; H8_SET(r, 0, w.x & 0xffff); H8_SET(r, 1, w.x >> 16); H8_SET(r, 2, w.y & 0xffff); H8_SET(r, 3, w.y >> 16); H8_SET(r, 4, w.z & 0xffff); H8_SET(r, 5, w.z >> 16); H8_SET(r, 6, w.w & 0xffff); H8_SET(r, 7, w.w >> 16); return r; }
DEVFN H8 h8_lo4(U2 w) { H8 r; H8_SET(r, 0, w.x & 0xffff); H8_SET(r, 1, w.x >> 16); H8_SET(r, 2, w.y & 0xffff); H8_SET(r, 3, w.y >> 16); H8_SET(r, 4, 0); H8_SET(r, 5, 0); H8_SET(r, 6, 0); H8_SET(r, 7, 0); return r; }
DEVFN H8 h8_zero() { H8 r; UNR for (int j = 0; j < 8; ++j) H8_SET(r, j, 0); return r; }
DEVFN H8 h8_pack2(const A4& a, const A4& b) { H8 r; UNR for (int j = 0; j < 4; ++j) { H8_SET(r, j, f2bf(A4_GET(a, j))); H8_SET(r, 4 + j, f2bf(A4_GET(b, j))); } return r; }
DEVFN H8 h8_pack1(const A4& a) { H8 r; UNR for (int j = 0; j < 4; ++j) { H8_SET(r, j, f2bf(A4_GET(a, j))); H8_SET(r, 4 + j, 0); } return r; }
DEVFN A4 a4_zero() { A4 z; A4_GET(z, 0) = 0.f; A4_GET(z, 1) = 0.f; A4_GET(z, 2) = 0.f; A4_GET(z, 3) = 0.f; return z; }

DEVFN void rwkv_chunked(const Ctx& C, int i, int h, int d, int vh, bool ctx_out, unsigned char* lds, int max_chunks) {
    const int tid = C.tid, lane = tid & 63, wave = tid >> 6;
    volatile unsigned* fl_ready = (volatile unsigned*)(lds + RC_LDS_FLAGS); volatile unsigned* fl_done0 = fl_ready + 8; volatile unsigned* fl_done1 = fl_done0 + 8;
    if (tid < 24) fl_ready[tid] = 0u;
    { U4* sBF = (U4*)(lds + RC_LDS_BFR); const int m = tid >> 8, nt = (tid >> 6) & 3, ln = tid & 63;
      const float* src = (m == 0 ? C.in[I_WUP] : C.in[I_AUP]) + ((size_t)i * 2 + d) * 32 * 512 + 64 * h; float f[8];
      UNR for (int j = 0; j < 8; ++j) f[j] = src[(size_t)(8 * (ln >> 4) + j) * 512 + 16 * nt + (ln & 15)];
      sBF[tid] = pack8(f); }
    SYNC();
    const int nchunks = (NTOK / RC_T) < max_chunks ? (NTOK / RC_T) : max_chunks;
    bf16_t* Yd = (bf16_t*)(C.ws + (d == 0 ? WS_YF : WS_YB));
    #define RC_GEOM(ch, seg0, segn, R0) const bool isctx_ = (ch) < NCTX / RC_T; const int seg0 = isctx_ ? NLAT : 0, segn = isctx_ ? NCTX : NLAT; \
        const int cl_ = isctx_ ? (ch) : (ch) - NCTX / RC_T; const int R0 = d == 0 ? RC_T * cl_ : segn - RC_T * (cl_ + 1);
    if (wave < 2) {
        const int vt = wave, kg = lane >> 4, l15 = lane & 15;
        A4 H0_ = a4_zero(), H1_ = a4_zero(), H2_ = a4_zero(), H3_ = a4_zero();
        for (int ch = 0; ch < nchunks; ++ch) {
            const int slot = ch % RC_RING; const unsigned char* rb = lds + RC_LDS_RING + slot * RS_BYTES;
            SPIN_WAIT(fl_ready[slot] == (unsigned)(ch + 1));
            const H8 Hb0 = h8_pack2(H0_, H1_), Hb1 = h8_pack2(H2_, H3_);
            const H8 Vb = kg < 2 ? h8_from(ld16(rb + RS_VT + ((16 * vt + l15) * 16 + 8 * kg) * 2)) : h8_zero();
            const H8 kkd0 = h8_from(ld16(rb + RS_KKD + (l15 * 64 + 8 * kg) * 2)), kkd1 = h8_from(ld16(rb + RS_KKD + (l15 * 64 + 32 + 8 * kg) * 2));
            const H8 rd0 = h8_from(ld16(rb + RS_RD + (l15 * 64 + 8 * kg) * 2)), rd1 = h8_from(ld16(rb + RS_RD + (l15 * 64 + 32 + 8 * kg) * 2));
            const H8 p0f = kg < 2 ? h8_from(ld16(rb + RS_P0 + (l15 * 16 + 8 * kg) * 2)) : h8_zero();
            const H8 q1f = kg < 2 ? h8_from(ld16(rb + RS_Q1 + (l15 * 16 + 8 * kg) * 2)) : h8_zero();
            const H8 tf = h8_lo4(*(const U2*)(rb + RS_T + (l15 * 16 + 4 * kg) * 2)), nq2f = h8_lo4(*(const U2*)(rb + RS_NQ2 + (l15 * 16 + 4 * kg) * 2));
            A4 X = mfma16(kkd0, Hb0, a4_zero()); X = mfma16(kkd1, Hb1, X); X = mfma16(p0f, Vb, X);
            A4 Y = mfma16(rd0, Hb0, a4_zero()); Y = mfma16(rd1, Hb1, Y); Y = mfma16(q1f, Vb, Y);
            const H8 Xb = h8_pack1(X);
            const A4 U_ = mfma16(tf, Xb, a4_zero());
            const H8 Ub = h8_pack1(U_);
            Y = mfma16(nq2f, Ub, Y);
            #define HUPD(Hx, kt) do { const int kr = 16 * (kt) + l15; \
                const H8 kif = kg < 2 ? h8_from(ld16(rb + RS_KIT + (kr * 16 + 8 * kg) * 2)) : h8_zero(); const H8 nbf = h8_lo4(*(const U2*)(rb + RS_NBIT + (kr * 16 + 4 * kg) * 2)); \
                Hx = mfma16(kif, Vb, Hx); Hx = mfma16(nbf, Ub, Hx); const F4 g = *(const F4*)(rb + RS_GC + (16 * (kt) + 4 * kg) * 4); \
                A4_GET(Hx, 0) *= g.x; A4_GET(Hx, 1) *= g.y; A4_GET(Hx, 2) *= g.z; A4_GET(Hx, 3) *= g.w; } while (0)
            HUPD(H0_, 0); HUPD(H1_, 1); HUPD(H2_, 2); HUPD(H3_, 3);
            #undef HUPD
            LDS_FENCE(); WAVE_SYNC();
            if (lane == 0) { if (vt == 0) fl_done0[slot] = (unsigned)(ch + 1); else fl_done1[slot] = (unsigned)(ch + 1); }
            { RC_GEOM(ch, seg0, segn, R0)
              if (!isctx_ || ctx_out) { UNR for (int rg = 0; rg < 4; ++rg) { const int t = 4 * kg + rg, tl = d == 0 ? R0 + t : R0 + RC_T - 1 - t;
                  Yd[(size_t)(seg0 + tl) * 512 + 64 * h + 32 * vh + 16 * vt + l15] = (bf16_t)f2bf(A4_GET(Y, rg)); } } }
        }
    } else {
        const int p = wave - 2, k = lane;
        unsigned char* wsb = lds + RC_LDS_WAVE + p * RW_BYTES;
        bf16_t* sTDAD = (bf16_t*)(wsb + RW_TDAD); float* sWL = (float*)(wsb + RW_WL); float* sAL = (float*)(wsb + RW_AL); bf16_t* sKIP = (bf16_t*)(wsb + RW_KIP); bf16_t* sBIP = (bf16_t*)(wsb + RW_BIP); float* sAM = (float*)(wsb + RW_AM);
        const bf16_t* U = (const bf16_t*)(C.ws + WS_U);
        const float* mu = C.in[I_MU] + (size_t)i * 1664;
        const float mu_r = mu[64 * h + k], mu_k = mu[512 + 64 * h + k], mu_v = mu[1024 + 64 * h + k], mu_l = k < 32 ? mu[1536 + 32 * d + k] : mu[1600 + 32 * d + (k - 32)];
        const float c_w0 = C.in[I_W0][((size_t)i * 2 + d) * 512 + 64 * h + k], c_a0 = C.in[I_A0][((size_t)i * 2 + d) * 512 + 64 * h + k];
        const float c_kk = C.in[I_KK][(size_t)i * 512 + 64 * h + k], c_ka = C.in[I_KA][(size_t)i * 512 + 64 * h + k], c_rk = C.in[I_RK][(size_t)i * 512 + 64 * h + k];
        float* BON = (float*)(C.ws + WS_BONUS) + (size_t)d * NTOK * 8;
        const U4* sBF = (const U4*)(lds + RC_LDS_BFR);
        const int lcol = k < 32 ? 1536 + 32 * d + k : 1600 + 32 * d + (k - 32);
        const int kg = lane >> 4, l15 = lane & 15, pk_ = rc_pos(k);
        for (int ch = p; ch < nchunks; ch += RC_NPROD) {
            RC_GEOM(ch, seg0, segn, R0)
            float ur[18], uk[18], uv[18], ul[18];
            UNR for (int j = 0; j < 18; ++j) { const int row = d == 0 ? R0 - 1 + j : R0 + 16 - j; const bool ok = row >= 0 && row < segn; const bf16_t* up = U + (size_t)(seg0 + (ok ? row : R0)) * URW_W;
                const float m_ = ok ? 1.f : 0.f; ur[j] = m_ * bf2f(up[64 * h + k]); uk[j] = m_ * bf2f(up[512 + 64 * h + k]); uv[j] = m_ * bf2f(up[1024 + 64 * h + k]); ul[j] = m_ * bf2f(up[lcol]); }
            UNR for (int t = 0; t < 16; ++t) { const int j = t + 1; const float x = ul[j] + (0.5f * (ul[j - 1] + ul[j + 1]) - ul[j]) * mu_l;
                const float val = k < 32 ? 1.0f - 2.0f * FRCP(1.0f + FEXP(2.0f * x)) : x; sTDAD[t * 64 + k] = (bf16_t)f2bf(val); }
            WAVE_SYNC();
            {
                const H8 At = h8_from(ld16(sTDAD + l15 * 64 + 8 * kg)), Aa = h8_from(ld16(sTDAD + l15 * 64 + 32 + 8 * kg));
                A4 cw_[4], ca_[4];
                UNR for (int nt = 0; nt < 4; ++nt) { cw_[nt] = mfma16(At, h8_from(sBF[nt * 64 + lane]), a4_zero()); ca_[nt] = mfma16(Aa, h8_from(sBF[(4 + nt) * 64 + lane]), a4_zero()); }
                MFMA_PAD(cw_[0], cw_[1], cw_[2], cw_[3], ca_[0], ca_[1], ca_[2], ca_[3]);
                UNR for (int nt = 0; nt < 4; ++nt) UNR for (int rg = 0; rg < 4; ++rg) { sWL[(4 * kg + rg) * 64 + 16 * nt + l15] = A4_GET(cw_[nt], rg); sAL[(4 * kg + rg) * 64 + 16 * nt + l15] = A4_GET(ca_[nt], rg); }
            }
            WAVE_SYNC();
            float fr[16], fkd[16], fb[16], fkk[16], flw[16], fv[16];
            UNR for (int t = 0; t < 16; ++t) { const int j = t + 1;
                const float r_ = ur[j] + (0.5f * (ur[j - 1] + ur[j + 1]) - ur[j]) * mu_r, k_ = uk[j] + (0.5f * (uk[j - 1] + uk[j + 1]) - uk[j]) * mu_k, v_ = uv[j] + (0.5f * (uv[j - 1] + uv[j + 1]) - uv[j]) * mu_v;
                const float kkraw = k_ * c_kk; const float ss = wave_sum_fast(kkraw * kkraw); const float kk_ = kkraw * FRSQ(ss + 1e-12f);
                const float x = -(c_w0 + sWL[t * 64 + k]); const float sp_ = fmaxf(x, 0.f) + FLOG(1.0f + FEXP(-fabsf(x)));
                const float lw_ = -FEXP(-sp_ - 0.5f);
                const float a = FRCP(1.0f + FEXP(-(c_a0 + sAL[t * 64 + k])));
                const float kd_ = k_ * (1.0f + (a - 1.0f) * c_ka);
                fr[t] = r_; fkd[t] = kd_; fb[t] = kk_ * a; fkk[t] = kk_; flw[t] = lw_; fv[t] = v_;
                const float bon = wave_sum_fast(r_ * kd_ * c_rk);
                if (vh == 0 && lane == 0) { const int tl = d == 0 ? R0 + t : R0 + RC_T - 1 - t; BON[(size_t)(seg0 + tl) * 8 + h] = 0.5f * bon; }
            }
            WAVE_SYNC();
            const int slot = ch % RC_RING; unsigned char* rb = lds + RC_LDS_RING + slot * RS_BYTES;
            if (ch >= RC_RING) SPIN_WAIT(fl_done0[slot] == (unsigned)(ch - RC_RING + 1) && fl_done1[slot] == (unsigned)(ch - RC_RING + 1));
            {
                bf16_t* rKKD = (bf16_t*)(rb + RS_KKD); bf16_t* rRD = (bf16_t*)(rb + RS_RD); bf16_t* rKIT = (bf16_t*)(rb + RS_KIT); bf16_t* rNBIT = (bf16_t*)(rb + RS_NBIT); bf16_t* rVT = (bf16_t*)(rb + RS_VT);
                float L = 0.f, e_prev = 1.f;
                UNR for (int t = 0; t < 16; ++t) { L += flw[t]; const float e = FEXP(L), ei = FEXP(-L);
                    rKKD[t * 64 + pk_] = (bf16_t)f2bf(fkk[t] * e_prev); rRD[t * 64 + pk_] = (bf16_t)f2bf(fr[t] * e);
                    const float ki_ = fkd[t] * ei, bi_ = fb[t] * ei; sKIP[t * 64 + pk_] = (bf16_t)f2bf(ki_); sBIP[t * 64 + pk_] = (bf16_t)f2bf(bi_);
                    rKIT[k * 16 + t] = (bf16_t)f2bf(ki_); rNBIT[k * 16 + t] = (bf16_t)f2bf(-bi_);
                    e_prev = e; }
                ((float*)(rb + RS_GC))[k] = e_prev;
                U4 w0_, w1_;
                if ((k >> 5) == vh) { w0_.x = pk2(fv[0], fv[1]); w0_.y = pk2(fv[2], fv[3]); w0_.z = pk2(fv[4], fv[5]); w0_.w = pk2(fv[6], fv[7]); w1_.x = pk2(fv[8], fv[9]); w1_.y = pk2(fv[10], fv[11]); w1_.z = pk2(fv[12], fv[13]); w1_.w = pk2(fv[14], fv[15]);
                    st16(rVT + (k & 31) * 16, w0_); st16(rVT + (k & 31) * 16 + 8, w1_); }
            }
            WAVE_SYNC();
            {
                const bf16_t* rKKD = (const bf16_t*)(rb + RS_KKD); const bf16_t* rRD = (const bf16_t*)(rb + RS_RD);
                const H8 ak0 = h8_from(ld16(rKKD + l15 * 64 + 8 * kg)), ak1 = h8_from(ld16(rKKD + l15 * 64 + 32 + 8 * kg)), ar0 = h8_from(ld16(rRD + l15 * 64 + 8 * kg)), ar1 = h8_from(ld16(rRD + l15 * 64 + 32 + 8 * kg));
                const H8 bb0 = h8_from(ld16(sBIP + l15 * 64 + 8 * kg)), bb1 = h8_from(ld16(sBIP + l15 * 64 + 32 + 8 * kg)), bk0 = h8_from(ld16(sKIP + l15 * 64 + 8 * kg)), bk1 = h8_from(ld16(sKIP + l15 * 64 + 32 + 8 * kg));
                A4 mA = mfma16(ak0, bb0, a4_zero()); mA = mfma16(ak1, bb1, mA);
                A4 mP = mfma16(ak0, bk0, a4_zero()); mP = mfma16(ak1, bk1, mP);
                A4 mQ1 = mfma16(ar0, bk0, a4_zero()); mQ1 = mfma16(ar1, bk1, mQ1);
                A4 mQ2 = mfma16(ar0, bb0, a4_zero()); mQ2 = mfma16(ar1, bb1, mQ2);
                MFMA_PAD(mA, mP, mQ1, mQ2, mA, mP, mQ1, mQ2);
                bf16_t* rP0 = (bf16_t*)(rb + RS_P0); bf16_t* rQ1 = (bf16_t*)(rb + RS_Q1); bf16_t* rNQ2 = (bf16_t*)(rb + RS_NQ2);
                UNR for (int rg = 0; rg < 4; ++rg) { const int t = 4 * kg + rg, s_ = l15;
                    sAM[t * 16 + s_] = t > s_ ? A4_GET(mA, rg) : 0.f;
                    rP0[t * 16 + s_] = (bf16_t)f2bf(t > s_ ? A4_GET(mP, rg) : 0.f); rQ1[t * 16 + s_] = (bf16_t)f2bf(t >= s_ ? A4_GET(mQ1, rg) : 0.f); rNQ2[t * 16 + s_] = (bf16_t)f2bf(t >= s_ ? -A4_GET(mQ2, rg) : 0.f); }
            }
            WAVE_SYNC();
            {
                const int j = l15; float x[16]; bf16_t* rT = (bf16_t*)(rb + RS_T);
                UNR for (int t = 0; t < 16; ++t) { float acc = t == j ? 1.f : 0.f;
                    UNR for (int s_ = 0; s_ < 16; ++s_) if (s_ < t) acc -= sAM[t * 16 + s_] * x[s_];
                    x[t] = acc; if (lane < 16) rT[t * 16 + j] = (bf16_t)f2bf(acc); }
            }
            LDS_FENCE();
            WAVE_SYNC();
            if (lane == 0) fl_ready[slot] = (unsigned)(ch + 1);
        }
    }
    #undef RC_GEOM
    SYNC();
}
constexpr int FR_SLOTS = 20, FR_FLOATS = 6 * 2048, FR_LEAD = 20;
constexpr size_t WS_FRING = WS_HYOUT;
static_assert((size_t)16 * FR_SLOTS * FR_FLOATS * 4 <= (size_t)NLAT * 512 * 2, "feature ring fits");
constexpr size_t CTL_FFLAG = 65536, CTL_FPOS = CTL_FFLAG + 16 * 520 * 4 * 4;
constexpr int SC2_R = 8, SC2_NWG = 8;
static_assert(CTL_FPOS + 64 * 64 <= CTL_ZERO_BYTES, "control words");
#ifdef EMU
DEVFN unsigned gld_u32(const unsigned* p) { __sync_synchronize(); return *(volatile const unsigned*)p; }
DEVFN void gst_u32(unsigned* p, unsigned v) { __sync_synchronize(); *(volatile unsigned*)p = v; __sync_synchronize(); }
DEVFN unsigned long long gld_u64(const unsigned long long* p) { return *(volatile const unsigned long long*)p; }
DEVFN void gst_u64(unsigned long long* p, unsigned long long v) { *(volatile unsigned long long*)p = v; }
#define VM_DRAIN() __sync_synchronize()
#define GSPIN_WAIT(cond) do { while (!(cond)) sched_yield(); __sync_synchronize(); } while (0)
#else
DEVFN unsigned gld_u32(const unsigned* p) { return __hip_atomic_load(p, __ATOMIC_RELAXED, __HIP_MEMORY_SCOPE_AGENT); }
DEVFN void gst_u32(unsigned* p, unsigned v) { __hip_atomic_store(p, v, __ATOMIC_RELAXED, __HIP_MEMORY_SCOPE_AGENT); }
DEVFN unsigned long long gld_u64(const unsigned long long* p) { return __hip_atomic_load(p, __ATOMIC_RELAXED, __HIP_MEMORY_SCOPE_AGENT); }
DEVFN void gst_u64(unsigned long long* p, unsigned long long v) { __hip_atomic_store(p, v, __ATOMIC_RELAXED, __HIP_MEMORY_SCOPE_AGENT); }
#define VM_DRAIN() asm volatile("s_waitcnt vmcnt(0)" ::: "memory")
#define GSPIN_WAIT(cond) do { unsigned sp__ = 0; while (!(cond)) { __builtin_amdgcn_s_sleep(2); if (++sp__ > (1u << 22)) break; } asm volatile("" ::: "memory"); } while (0)
#endif
DEVFN unsigned long long f2_bits(float a, float b) { union { float f[2]; unsigned long long u; } x; x.f[0] = a; x.f[1] = b; return x.u; }

DEVFN void rwkv_scan2(const Ctx& C, int i, int h, int d, int rq, bool ctx_out, unsigned char* lds, int max_chunks) {
    const int tid = C.tid, lane = tid & 63, wave = C.wave;
    float* sBUF = (float*)lds;
    float* sWV = sBUF + 3 * SC_BUF;
    float* sCN = sWV + 4 * 1280;
    U4* sBF = (U4*)(sCN + 640);
    volatile unsigned* lf = (volatile unsigned*)((unsigned char*)sBF + 8192);
    const int hd = h * 2 + d;
    const unsigned epoch = (unsigned)(i + 1), pbase = (unsigned)i * 100000u;
    {
    const float* mu = C.in[I_MU] + (size_t)i * 1664;
    const float* w0 = C.in[I_W0] + ((size_t)i * 2 + d) * 512 + 64 * h; const float* a0 = C.in[I_A0] + ((size_t)i * 2 + d) * 512 + 64 * h;
    const float* wup = C.in[I_WUP] + ((size_t)i * 2 + d) * 32 * 512 + 64 * h; const float* aup = C.in[I_AUP] + ((size_t)i * 2 + d) * 32 * 512 + 64 * h;
    const float* k_k = C.in[I_KK] + (size_t)i * 512 + 64 * h; const float* k_a = C.in[I_KA] + (size_t)i * 512 + 64 * h; const float* r_k = C.in[I_RK] + (size_t)i * 512 + 64 * h;
    if (tid < 64) { const int j = tid; sCN[j] = mu[64 * h + j]; sCN[64 + j] = mu[512 + 64 * h + j]; sCN[128 + j] = mu[1024 + 64 * h + j]; sCN[192 + j] = w0[j]; sCN[256 + j] = a0[j];
        sCN[320 + j] = k_k[j]; sCN[384 + j] = k_a[j]; sCN[448 + j] = r_k[j]; sCN[512 + j] = j < 32 ? mu[1536 + 32 * d + j] : mu[1600 + 32 * d + (j - 32)]; }
    { const int m = tid >> 8, nt = (tid >> 6) & 3, ln = tid & 63; const float* src = m == 0 ? wup : aup; float f[8];
      UNR for (int j = 0; j < 8; ++j) f[j] = src[(size_t)(8 * (ln >> 4) + j) * 512 + 16 * nt + (ln & 15)];
      sBF[tid] = pack8(f); }
    }
    if (tid < 32) lf[tid] = 0u;
    SYNC();
    const int nchunks = NTOK / SC_T < max_chunks ? NTOK / SC_T : max_chunks;
    #define CHUNK_GEOM(ch, seg0, segn, R0) const bool isctx_ = (ch) < NCTX / SC_T; const int seg0 = isctx_ ? NLAT : 0, segn = isctx_ ? NCTX : NLAT; \
        const int cl_ = isctx_ ? (ch) : (ch) - NCTX / SC_T; const int R0 = d == 0 ? SC_T * cl_ : segn - SC_T * (cl_ + 1);
    if (wave < 2) {
        bf16_t* Yd = (bf16_t*)(C.ws + (d == 0 ? WS_YF : WS_YB));
        const int rl = tid >> 4, sp = tid & 15;
        float S0 = 0.f, S1 = 0.f, S2 = 0.f, S3 = 0.f;
        for (int ch = 0; ch < nchunks; ++ch) {
            const int b = ch % 3;
            SPIN_WAIT(lf[0 * 3 + b] == (unsigned)(ch + 1) && lf[1 * 3 + b] == (unsigned)(ch + 1));
            const float* B_ = sBUF + b * SC_BUF; const float* sV = B_ + 5 * SC_T * 64;
            float yk0 = 0.f, yk1 = 0.f, yp = 0.f;
#ifndef EMU
            {
                const unsigned ab = (unsigned)(uintptr_t)B_ + 16u * (unsigned)sp, av = (unsigned)(uintptr_t)sV + 4u * (unsigned)rl;
                P2 s01 = {S0, S1}, s23 = {S2, S3};
                asm volatile(SCAN_CHUNK_ASM : [s01] "+v"(s01), [s23] "+v"(s23), [yp] "+v"(yp), [yk0] "+v"(yk0), [yk1] "+v"(yk1) : [ab] "v"(ab), [av] "v"(av), [sp] "v"(sp) : SCAN_CHUNK_CLOBBERS);
                S0 = s01[0]; S1 = s01[1]; S2 = s23[0]; S3 = s23[1];
            }
#else
            { const float* sW = B_; const float* sKD = B_ + SC_T * 64; const float* sB = B_ + 2 * SC_T * 64; const float* sKK = B_ + 3 * SC_T * 64; const float* sR = B_ + 4 * SC_T * 64;
              for (int k = 0; k < SC_T; ++k) {
                const F4 kk4 = *(const F4*)(sKK + k * 64 + 4 * sp), w4 = *(const F4*)(sW + k * 64 + 4 * sp), b4 = *(const F4*)(sB + k * 64 + 4 * sp),
                         kd4 = *(const F4*)(sKD + k * 64 + 4 * sp), r4 = *(const F4*)(sR + k * 64 + 4 * sp);
                const float vi = sV[k * SC_R + rl];
                float sa = (S0 * kk4.x + S2 * kk4.z) + (S1 * kk4.y + S3 * kk4.w);
                const float t0 = S0 * w4.x + vi * kd4.x, t1 = S1 * w4.y + vi * kd4.y, t2 = S2 * w4.z + vi * kd4.z, t3 = S3 * w4.w + vi * kd4.w;
                sa = rowx_add<1>(sa); yp = rowx_add<1>(yp); sa = rowx_add<2>(sa); yp = rowx_add<2>(yp);
                sa = rowx_add<7>(sa); yp = rowx_add<7>(yp); sa = rowx_add<15>(sa); yp = rowx_add<15>(yp);
                if (sp == ((k + 15) & 15)) { if (k <= 16) yk0 = yp; else yk1 = yp; }
                S0 = t0 - sa * b4.x; S1 = t1 - sa * b4.y; S2 = t2 - sa * b4.z; S3 = t3 - sa * b4.w;
                yp = (S0 * r4.x + S2 * r4.z) + (S1 * r4.y + S3 * r4.w);
              } }
#endif
            LDS_FENCE(); WAVE_SYNC();
            if (lane == 0) lf[8 + wave * 3 + b] = (unsigned)(ch + 1);
            yp = rowx_add<1>(yp); yp = rowx_add<2>(yp); yp = rowx_add<7>(yp); yp = rowx_add<15>(yp);
            if (sp == 15) yk1 = yp;
            { CHUNK_GEOM(ch, seg0, segn, R0)
              if (!isctx_ || ctx_out) { const int t0 = d == 0 ? R0 + sp : R0 + SC_T - 1 - sp, t1 = d == 0 ? R0 + sp + 16 : R0 + SC_T - 1 - (sp + 16);
                  Yd[(size_t)(seg0 + t0) * 512 + 64 * h + SC2_R * rq + rl] = (bf16_t)f2bf(yk0); Yd[(size_t)(seg0 + t1) * 512 + 64 * h + SC2_R * rq + rl] = (bf16_t)f2bf(yk1); } }
        }
    } else if (wave < 6) {
        const int p = wave - 2;
        const bf16_t* U = (const bf16_t*)(C.ws + WS_U); float* BON = (float*)(C.ws + WS_BONUS) + (size_t)d * NTOK * 8;
        float* RING = (float*)(C.ws + WS_FRING) + (size_t)hd * FR_SLOTS * FR_FLOATS; unsigned* FFLAG = (unsigned*)(C.ws + WS_CTL + CTL_FFLAG) + (size_t)hd * 520 * 4; unsigned* FPOS = (unsigned*)(C.ws + WS_CTL + CTL_FPOS) + (size_t)hd * 64;
        float* myWV = sWV + p * 1280; float* sWL = myWV; float* sAL = myWV + 512; bf16_t* sTDb = (bf16_t*)(myWV + 1024); bf16_t* sADb = sTDb + 256;
        const int fp = lane & 7, tw = lane >> 3;
        const float* mu_r = sCN + 8 * fp; const float* mu_k = sCN + 64 + 8 * fp; const float* mu_v = sCN + 128 + 8 * fp; const float* c_w0 = sCN + 192 + 8 * fp; const float* c_a0 = sCN + 256 + 8 * fp;
        const float* c_kk = sCN + 320 + 8 * fp; const float* c_ka = sCN + 384 + 8 * fp; const float* c_rk = sCN + 448 + 8 * fp; const float* mu_w = sCN + 512 + 4 * fp; const float* mu_a = sCN + 544 + 4 * fp;
        U4 pu[9]; U2 pw[6];
        auto issue = [&](int q) {
            const int ch = rq + SC2_NWG * q; if (ch >= nchunks) return;
            CHUNK_GEOM(ch, seg0, segn, R0)
            const int ft = 8 * p + tw, tl = d == 0 ? R0 + ft : R0 + SC_T - 1 - ft;
            const bf16_t* u0p = U + (size_t)(seg0 + tl) * URW_W; const bool hm = tl > 0, hp = tl < segn - 1;
            const U4 z4 = {0u, 0u, 0u, 0u}; const U2 z2 = {0u, 0u};
            const int cw = 1536 + 32 * d + 4 * fp, ca = 1600 + 32 * d + 4 * fp;
            UNR for (int j = 0; j < 3; ++j) { pu[3 * j] = ld16(u0p + 512 * j + 64 * h + 8 * fp); pu[3 * j + 1] = z4; pu[3 * j + 2] = z4; }
            pw[0] = *(const U2*)(u0p + cw); pw[3] = *(const U2*)(u0p + ca); pw[1] = z2; pw[2] = z2; pw[4] = z2; pw[5] = z2;
            if (hm) { UNR for (int j = 0; j < 3; ++j) pu[3 * j + 1] = ld16(u0p - URW_W + 512 * j + 64 * h + 8 * fp); pw[1] = *(const U2*)(u0p - URW_W + cw); pw[4] = *(const U2*)(u0p - URW_W + ca); }
            if (hp) { UNR for (int j = 0; j < 3; ++j) pu[3 * j + 2] = ld16(u0p + URW_W + 512 * j + 64 * h + 8 * fp); pw[2] = *(const U2*)(u0p + URW_W + cw); pw[5] = *(const U2*)(u0p + URW_W + ca); }
        };
        issue(0);
        const int npass = (nchunks - rq + SC2_NWG - 1) / SC2_NWG;
        for (int q = 0; q < npass; ++q) {
            const int ch = rq + SC2_NWG * q;
            if (ch >= FR_SLOTS) { const unsigned need = pbase + (unsigned)(ch - FR_SLOTS + 1);
                GSPIN_WAIT(gld_u32(FPOS + 0) >= need && gld_u32(FPOS + 8) >= need && gld_u32(FPOS + 16) >= need && gld_u32(FPOS + 24) >= need && gld_u32(FPOS + 32) >= need && gld_u32(FPOS + 40) >= need && gld_u32(FPOS + 48) >= need && gld_u32(FPOS + 56) >= need); }
            CHUNK_GEOM(ch, seg0, segn, R0)
            float* rec = RING + (size_t)(ch % FR_SLOTS) * FR_FLOATS;
            {
                const int ft = 8 * p + tw;
                const int tl = d == 0 ? R0 + ft : R0 + SC_T - 1 - ft;
                float r[8], k[8], v[8];
                {
                    float a[8], m[8], qq[8];
                    #define SHIFT3(J, MU, OUT) do { unpack8(pu[3 * (J)], a); unpack8(pu[3 * (J) + 1], m); unpack8(pu[3 * (J) + 2], qq); \
                        UNR for (int e = 0; e < 8; ++e) OUT[e] = a[e] + (0.5f * (m[e] + qq[e]) - a[e]) * MU[e]; } while (0)
                    SHIFT3(0, mu_r, r); SHIFT3(1, mu_k, k); SHIFT3(2, mu_v, v);
                    #undef SHIFT3
                }
                {
                    const U2 w0_ = pw[0], wm = pw[1], wp = pw[2], a0_ = pw[3], am = pw[4], ap = pw[5];
                    const float wa[4] = {bflo(w0_.x), bfhi(w0_.x), bflo(w0_.y), bfhi(w0_.y)}, wmm[4] = {bflo(wm.x), bfhi(wm.x), bflo(wm.y), bfhi(wm.y)}, wpp[4] = {bflo(wp.x), bfhi(wp.x), bflo(wp.y), bfhi(wp.y)};
                    const float aa[4] = {bflo(a0_.x), bfhi(a0_.x), bflo(a0_.y), bfhi(a0_.y)}, amm[4] = {bflo(am.x), bfhi(am.x), bflo(am.y), bfhi(am.y)}, app[4] = {bflo(ap.x), bfhi(ap.x), bflo(ap.y), bfhi(ap.y)};
                    issue(q + 1);
                    float tdv[4], adv[4];
                    UNR for (int e = 0; e < 4; ++e) { const float x = wa[e] + (0.5f * (wmm[e] + wpp[e]) - wa[e]) * mu_w[e];
                        tdv[e] = 1.0f - 2.0f * FRCP(1.0f + FEXP(2.0f * x));
                        adv[e] = aa[e] + (0.5f * (amm[e] + app[e]) - aa[e]) * mu_a[e]; }
                    U2 tq, aq; tq.x = pk2(tdv[0], tdv[1]); tq.y = pk2(tdv[2], tdv[3]); aq.x = pk2(adv[0], adv[1]); aq.y = pk2(adv[2], adv[3]);
                    *(U2*)(sTDb + tw * 32 + 4 * fp) = tq; *(U2*)(sADb + tw * 32 + 4 * fp) = aq;
                }
                WAVE_SYNC();
                float wl[8], al[8];
                {
                    const int arow = lane & 7, kg = lane >> 4;
                    const H8 At = h8_from_u4(ld16(sTDb + arow * 32 + 8 * kg)), Aa = h8_from_u4(ld16(sADb + arow * 32 + 8 * kg));
                    A4 cw_[4], ca_[4];
                    UNR for (int nt = 0; nt < 4; ++nt) { A4 z; A4_GET(z, 0) = 0.f; A4_GET(z, 1) = 0.f; A4_GET(z, 2) = 0.f; A4_GET(z, 3) = 0.f;
                        cw_[nt] = mfma16(At, h8_from_u4(sBF[nt * 64 + lane]), z); ca_[nt] = mfma16(Aa, h8_from_u4(sBF[(4 + nt) * 64 + lane]), z); }
                    MFMA_PAD(cw_[0], cw_[1], cw_[2], cw_[3], ca_[0], ca_[1], ca_[2], ca_[3]);
                    if (lane < 32) { UNR for (int nt = 0; nt < 4; ++nt) UNR for (int rg = 0; rg < 4; ++rg) { const int tok = 4 * (lane >> 4) + rg; sWL[tok * 64 + 16 * nt + (lane & 15)] = A4_GET(cw_[nt], rg); sAL[tok * 64 + 16 * nt + (lane & 15)] = A4_GET(ca_[nt], rg); } }
                    WAVE_SYNC();
                    UNR for (int e = 0; e < 8; ++e) { wl[e] = c_w0[e] + sWL[tw * 64 + 8 * fp + e]; al[e] = c_a0[e] + sAL[tw * 64 + 8 * fp + e]; }
                    WAVE_SYNC();
                }
                float kkv[8], ssq = 0.f;
                UNR for (int e = 0; e < 8; ++e) { kkv[e] = k[e] * c_kk[e]; ssq += kkv[e] * kkv[e]; }
                ssq = rowx_add<1>(ssq); ssq = rowx_add<2>(ssq); ssq = rowx_add<7>(ssq);
                const float kn = FRSQ(ssq + 1e-12f);
                float bon = 0.f; float o_w[8], o_kd[8], o_b[8], o_kk[8];
                UNR for (int e = 0; e < 8; ++e) {
                    const float dec = FEXP(-0.60653066f * FRCP(1.0f + FEXP(-wl[e])));
                    const float a = FRCP(1.0f + FEXP(-al[e]));
                    const float kd = k[e] * (1.0f + (a - 1.0f) * c_ka[e]);
                    const float kk = kkv[e] * kn;
                    o_w[e] = dec; o_kd[e] = kd; o_b[e] = kk * a; o_kk[e] = kk;
                    bon += r[e] * kd * c_rk[e];
                }
                { unsigned long long* rp = (unsigned long long*)(rec + ft * 64 + 8 * fp);
                  #define ST8(AR, A) do { UNR for (int e2 = 0; e2 < 4; ++e2) gst_u64(rp + (AR) * 1024 + e2, f2_bits(A[2 * e2], A[2 * e2 + 1])); } while (0)
                  ST8(0, o_w); ST8(1, o_kd); ST8(2, o_b); ST8(3, o_kk); ST8(4, r); ST8(5, v);
                  #undef ST8
                }
                bon = rowx_add<1>(bon); bon = rowx_add<2>(bon); bon = rowx_add<7>(bon);
                if (fp == 0) BON[(size_t)(seg0 + tl) * 8 + h] = 0.5f * bon;
            }
            VM_DRAIN(); if (lane == 0) gst_u32(FFLAG + (size_t)ch * 4 + p, epoch);
        }
    } else {
        const int w = wave - 6;
        const float* RING = (const float*)(C.ws + WS_FRING) + (size_t)hd * FR_SLOTS * FR_FLOATS; unsigned* FFLAG = (unsigned*)(C.ws + WS_CTL + CTL_FFLAG) + (size_t)hd * 520 * 4; unsigned* FPOS = (unsigned*)(C.ws + WS_CTL + CTL_FPOS) + (size_t)hd * 64;
        for (int ch = 0; ch < nchunks; ++ch) {
            const int b = ch % 3;
            if (ch >= 3) SPIN_WAIT(lf[8 + 0 * 3 + b] == (unsigned)(ch - 2) && lf[8 + 1 * 3 + b] == (unsigned)(ch - 2));
            GSPIN_WAIT(gld_u32(FFLAG + (size_t)ch * 4) == epoch && gld_u32(FFLAG + (size_t)ch * 4 + 1) == epoch && gld_u32(FFLAG + (size_t)ch * 4 + 2) == epoch && gld_u32(FFLAG + (size_t)ch * 4 + 3) == epoch);
            const unsigned long long* rec = (const unsigned long long*)(RING + (size_t)(ch % FR_SLOTS) * FR_FLOATS);
            float* B_ = sBUF + b * SC_BUF;
            { unsigned long long x[40], xv[2];
              UNR for (int j = 0; j < 40; ++j) x[j] = gld_u64(rec + (size_t)w * 2560 + j * 64 + lane);
              { const int idx = w * 64 + lane, tok = idx >> 2, c2 = idx & 3; xv[0] = gld_u64(rec + 5 * 1024 + tok * 32 + 4 * rq + c2); xv[1] = 0ull; }
              UNR for (int j = 0; j < 40; ++j) ((unsigned long long*)B_)[(size_t)w * 2560 + j * 64 + lane] = x[j];
              { const int idx = w * 64 + lane, tok = idx >> 2, c2 = idx & 3; ((unsigned long long*)(B_ + 5 * SC_T * 64))[tok * 8 + c2] = xv[0]; } }
            LDS_FENCE(); WAVE_SYNC();
            if (lane == 0) { lf[w * 3 + b] = (unsigned)(ch + 1); if (w == 0) gst_u32(FPOS + 8 * rq, pbase + (unsigned)(ch + 1)); }
        }
    }
    #undef CHUNK_GEOM
    SYNC();
}
constexpr int R2S_KKD = 0, R2S_RD = 2048, R2S_KN = 4096, R2S_VT = 8192, R2S_T = 10240, R2S_P0 = 10752, R2S_QQ = 11264, R2S_GC = 12288, R2S_BYTES = 12544, R2S_U64 = R2S_BYTES / 8;
constexpr int PW_TDAD = 0, PW_AM = 0, PW_WL = 2048, PW_AL = 6144, PW_REC = 2048, PW_KIP = PW_REC + R2S_BYTES, PW_BIP = PW_KIP + 2048, PW_BYTES = PW_BIP + 2048;
static_assert(8 * PW_BYTES <= RING_BYTES, "producer LDS");
#define R2_SWZ(t, p) (((((p) >> 3) ^ (((t) >> 1) & 7)) << 3) | ((p) & 7))
constexpr int R2_GSLOTS = 64, R2_LSLOTS = 12, R2_NCH = NTOK / RC_T;
constexpr size_t WS_R2RING = WS_HYOUT;
static_assert((size_t)16 * R2_GSLOTS * R2S_BYTES <= (size_t)NLAT * 512 * 2, "record ring fits");
constexpr size_t CTL_R2FLAG = 65536, CTL_R2POS = CTL_R2FLAG + (size_t)16 * R2_NCH * 4;
constexpr size_t CTL_R2TICKET = CTL_R2POS + 16 * 64;
static_assert(CTL_R2TICKET + 2 * 64 <= CTL_ZERO_BYTES, "control words");
constexpr size_t WS_BFRAG = WS_VXC + 1536 * 1024;
static_assert(WS_BFRAG + 2 * 16 * 8 * 64 * 16 <= WS_HID, "bfrag");

DEVFN void r2_build_bfrag(const Ctx& C) {
    const int gtid = (C.vcu * NWAVES + C.wave) * 64 + C.lane, gn = C.G * NTHREADS;
    for (int e = gtid; e < 2 * 16 * 8 * 64; e += gn) { const int ln = e & 63, nt = (e >> 6) & 3, m = (e >> 8) & 1, hd = (e >> 9) & 15, i = e >> 13; const int h = hd >> 1, d = hd & 1;
        const float* src = (m == 0 ? C.in[I_WUP] : C.in[I_AUP]) + ((size_t)i * 2 + d) * 32 * 512 + 64 * h; float f[8];
        UNR for (int j = 0; j < 8; ++j) f[j] = src[(size_t)(8 * (ln >> 4) + j) * 512 + 16 * nt + (ln & 15)];
        ((U4*)(C.ws + WS_BFRAG))[e] = pack8(f); }
}

#ifdef EMU
DEVFN int r2_take_ticket(unsigned* ticket, int lane) { unsigned v = 0; if (lane == 0) v = __sync_fetch_and_add(ticket, 1u); union { float f; unsigned u; } x; x.u = v; x.f = shfl_f(x.f, 0); return (int)x.u; }
#else
DEVFN int r2_take_ticket(unsigned* ticket, int lane) { unsigned v = 0; if (lane == 0) v = __hip_atomic_fetch_add(ticket, 1u, __ATOMIC_RELAXED, __HIP_MEMORY_SCOPE_AGENT); return __builtin_amdgcn_readfirstlane((int)v); }
#endif
DEVFN void rc2_producer(const Ctx& C, int i, unsigned char* lds, unsigned* ticket, int hd0, int nhd, int max_chunks) {
    const int lane = C.lane, k = lane, kg = lane >> 4, l15 = lane & 15, pk_ = rc_pos(k);
    unsigned char* wsb = lds + C.wave * PW_BYTES;
    bf16_t* sTDAD = (bf16_t*)(wsb + PW_TDAD); float* sWL = (float*)(wsb + PW_WL); float* sAL = (float*)(wsb + PW_AL); bf16_t* sKIP = (bf16_t*)(wsb + PW_KIP); bf16_t* sBIP = (bf16_t*)(wsb + PW_BIP); float* sAM = (float*)(wsb + PW_AM);
    const bf16_t* U = (const bf16_t*)(C.ws + WS_U);
    const unsigned epoch = (unsigned)(i + 1), pbase = (unsigned)i * 100000u;
    const int nchunks = R2_NCH < max_chunks ? R2_NCH : max_chunks;
    const int nitems = nchunks * nhd;
    TACC_DECL;
    for (;;) {
        const int item = r2_take_ticket(ticket, lane); if (item >= nitems) break;
        const int ch = item / nhd, hd = hd0 + item % nhd, h = hd >> 1, d = hd & 1;
        unsigned* POS = (unsigned*)(C.ws + WS_CTL + CTL_R2POS) + 16 * hd;
        if (ch >= R2_GSLOTS) { const int ow = ((ch - R2_GSLOTS) & 3); TACC_BEGIN; GSPIN_WAIT(gld_u32(POS + 1 + ow) >= pbase + (unsigned)(ch - R2_GSLOTS + 1)); TACC_END; }
        const float* mu = C.in[I_MU] + (size_t)i * 1664;
        const float mu_r = mu[64 * h + k], mu_k = mu[512 + 64 * h + k], mu_v = mu[1024 + 64 * h + k], mu_l = k < 32 ? mu[1536 + 32 * d + k] : mu[1600 + 32 * d + (k - 32)];
        const float c_w0 = C.in[I_W0][((size_t)i * 2 + d) * 512 + 64 * h + k], c_a0 = C.in[I_A0][((size_t)i * 2 + d) * 512 + 64 * h + k];
        const float c_kk = C.in[I_KK][(size_t)i * 512 + 64 * h + k], c_ka = C.in[I_KA][(size_t)i * 512 + 64 * h + k], c_rk = C.in[I_RK][(size_t)i * 512 + 64 * h + k];
        float* BON = (float*)(C.ws + WS_BONUS) + (size_t)d * NTOK * 8;
        const int lcol = k < 32 ? 1536 + 32 * d + k : 1600 + 32 * d + (k - 32);
        U4 bfw[4], bfa[4];
        { const U4* bt = (const U4*)(C.ws + WS_BFRAG) + ((size_t)i * 16 + hd) * 512; UNR for (int nt = 0; nt < 4; ++nt) { bfw[nt] = bt[nt * 64 + lane]; bfa[nt] = bt[(4 + nt) * 64 + lane]; } }
        const bool isctx_ = ch < NCTX / RC_T; const int seg0 = isctx_ ? NLAT : 0, segn = isctx_ ? NCTX : NLAT; const int cl_ = isctx_ ? ch : ch - NCTX / RC_T; const int R0 = d == 0 ? RC_T * cl_ : segn - RC_T * (cl_ + 1);
        {
            float ur[18], uk[18], uv[18], ul[18];
            UNR for (int j = 0; j < 18; ++j) { const int row = d == 0 ? R0 - 1 + j : R0 + 16 - j; const bool ok = row >= 0 && row < segn; const bf16_t* up = U + (size_t)(seg0 + (ok ? row : R0)) * URW_W;
                const float m_ = ok ? 1.f : 0.f; ur[j] = m_ * bf2f(up[64 * h + k]); uk[j] = m_ * bf2f(up[512 + 64 * h + k]); uv[j] = m_ * bf2f(up[1024 + 64 * h + k]); ul[j] = m_ * bf2f(up[lcol]); }
            UNR for (int t = 0; t < 16; ++t) { const int j = t + 1; const float x = ul[j] + (0.5f * (ul[j - 1] + ul[j + 1]) - ul[j]) * mu_l;
                const float val = k < 32 ? 1.0f - 2.0f * FRCP(1.0f + FEXP(2.0f * x)) : x; sTDAD[t * 64 + k] = (bf16_t)f2bf(val); }
            WAVE_SYNC();
            {
                const H8 At = h8_from(ld16(sTDAD + l15 * 64 + 8 * kg)), Aa = h8_from(ld16(sTDAD + l15 * 64 + 32 + 8 * kg));
                A4 cw_[4], ca_[4];
                UNR for (int nt = 0; nt < 4; ++nt) { cw_[nt] = mfma16(At, h8_from(bfw[nt]), a4_zero()); ca_[nt] = mfma16(Aa, h8_from(bfa[nt]), a4_zero()); }
                MFMA_PAD(cw_[0], cw_[1], cw_[2], cw_[3], ca_[0], ca_[1], ca_[2], ca_[3]);
                UNR for (int nt = 0; nt < 4; ++nt) UNR for (int rg = 0; rg < 4; ++rg) { sWL[(4 * kg + rg) * 64 + 16 * nt + l15] = A4_GET(cw_[nt], rg); sAL[(4 * kg + rg) * 64 + 16 * nt + l15] = A4_GET(ca_[nt], rg); }
            }
            WAVE_SYNC();
            float fr[16], fkd[16], fb[16], fkk[16], flw[16], fv[16];
            UNR for (int t = 0; t < 16; ++t) { const int j = t + 1;
                const float r_ = ur[j] + (0.5f * (ur[j - 1] + ur[j + 1]) - ur[j]) * mu_r, k_ = uk[j] + (0.5f * (uk[j - 1] + uk[j + 1]) - uk[j]) * mu_k, v_ = uv[j] + (0.5f * (uv[j - 1] + uv[j + 1]) - uv[j]) * mu_v;
                const float kkraw = k_ * c_kk; const float ss = wave_sum_fast(kkraw * kkraw); const float kk_ = kkraw * FRSQ(ss + 1e-12f);
                const float x = -(c_w0 + sWL[t * 64 + k]); const float sp_ = fmaxf(x, 0.f) + FLOG(1.0f + FEXP(-fabsf(x)));
                const float lw_ = -FEXP(-sp_ - 0.5f);
                const float a = FRCP(1.0f + FEXP(-(c_a0 + sAL[t * 64 + k])));
                const float kd_ = k_ * (1.0f + (a - 1.0f) * c_ka);
                fr[t] = r_; fkd[t] = kd_; fb[t] = kk_ * a; fkk[t] = kk_; flw[t] = lw_; fv[t] = v_;
                const float bon = wave_sum_fast(r_ * kd_ * c_rk);
                if (lane == 0) { const int tl = d == 0 ? R0 + t : R0 + RC_T - 1 - t; BON[(size_t)(seg0 + tl) * 8 + h] = 0.5f * bon; }
            }
            WAVE_SYNC();
            unsigned char* rb = wsb + PW_REC;
            {
                bf16_t* rKKD = (bf16_t*)(rb + R2S_KKD); bf16_t* rRD = (bf16_t*)(rb + R2S_RD); bf16_t* rKN = (bf16_t*)(rb + R2S_KN); bf16_t* rVT = (bf16_t*)(rb + R2S_VT);
                float L = 0.f, e_prev = 1.f;
                UNR for (int t = 0; t < 16; ++t) { L += flw[t]; const float e = FEXP(L), ei = FEXP(-L);
                    rKKD[t * 64 + R2_SWZ(t, pk_)] = (bf16_t)f2bf(fkk[t] * e_prev); rRD[t * 64 + R2_SWZ(t, pk_)] = (bf16_t)f2bf(fr[t] * e);
                    const float ki_ = fkd[t] * ei, bi_ = fb[t] * ei; sKIP[t * 64 + pk_] = (bf16_t)f2bf(ki_); sBIP[t * 64 + pk_] = (bf16_t)f2bf(bi_);
                    rKN[k * 32 + (t >> 2) * 8 + (t & 3)] = (bf16_t)f2bf(ki_); rKN[k * 32 + (t >> 2) * 8 + 4 + (t & 3)] = (bf16_t)f2bf(-bi_);
                    e_prev = e; }
                ((float*)(rb + R2S_GC))[k] = e_prev;
                U4 w0_, w1_;
                { w0_.x = pk2(fv[0], fv[1]); w0_.y = pk2(fv[2], fv[3]); w0_.z = pk2(fv[4], fv[5]); w0_.w = pk2(fv[6], fv[7]); w1_.x = pk2(fv[8], fv[9]); w1_.y = pk2(fv[10], fv[11]); w1_.z = pk2(fv[12], fv[13]); w1_.w = pk2(fv[14], fv[15]);
                    st16(rVT + k * 16, w0_); st16(rVT + k * 16 + 8, w1_); }
            }
            WAVE_SYNC();
            {
                const bf16_t* rKKD = (const bf16_t*)(rb + R2S_KKD); const bf16_t* rRD = (const bf16_t*)(rb + R2S_RD);
                const int sw0 = 8 * (kg ^ ((l15 >> 1) & 7)), sw1 = 8 * ((kg + 4) ^ ((l15 >> 1) & 7));
                const H8 ak0 = h8_from(ld16(rKKD + l15 * 64 + sw0)), ak1 = h8_from(ld16(rKKD + l15 * 64 + sw1)), ar0 = h8_from(ld16(rRD + l15 * 64 + sw0)), ar1 = h8_from(ld16(rRD + l15 * 64 + sw1));
                const H8 bb0 = h8_from(ld16(sBIP + l15 * 64 + 8 * kg)), bb1 = h8_from(ld16(sBIP + l15 * 64 + 32 + 8 * kg)), bk0 = h8_from(ld16(sKIP + l15 * 64 + 8 * kg)), bk1 = h8_from(ld16(sKIP + l15 * 64 + 32 + 8 * kg));
                A4 mA = mfma16(ak0, bb0, a4_zero()); mA = mfma16(ak1, bb1, mA);
                A4 mP = mfma16(ak0, bk0, a4_zero()); mP = mfma16(ak1, bk1, mP);
                A4 mQ1 = mfma16(ar0, bk0, a4_zero()); mQ1 = mfma16(ar1, bk1, mQ1);
                A4 mQ2 = mfma16(ar0, bb0, a4_zero()); mQ2 = mfma16(ar1, bb1, mQ2);
                MFMA_PAD(mA, mP, mQ1, mQ2, mA, mP, mQ1, mQ2);
                bf16_t* rP0 = (bf16_t*)(rb + R2S_P0); bf16_t* rQQ = (bf16_t*)(rb + R2S_QQ);
                UNR for (int rg = 0; rg < 4; ++rg) { const int t = 4 * kg + rg, s_ = l15;
                    sAM[t * 16 + s_] = t > s_ ? A4_GET(mA, rg) : 0.f;
                    rP0[t * 16 + s_] = (bf16_t)f2bf(t > s_ ? A4_GET(mP, rg) : 0.f); rQQ[t * 32 + (s_ >> 2) * 8 + (s_ & 3)] = (bf16_t)f2bf(t >= s_ ? A4_GET(mQ1, rg) : 0.f); rQQ[t * 32 + (s_ >> 2) * 8 + 4 + (s_ & 3)] = (bf16_t)f2bf(t >= s_ ? -A4_GET(mQ2, rg) : 0.f); }
            }
            WAVE_SYNC();
            {
                const int j = l15; float x[16]; bf16_t* rT = (bf16_t*)(rb + R2S_T);
                UNR for (int t = 0; t < 16; ++t) { float acc = t == j ? 1.f : 0.f;
                    UNR for (int s_ = 0; s_ < 16; ++s_) if (s_ < t) acc -= sAM[t * 16 + s_] * x[s_];
                    x[t] = acc; if (lane < 16) rT[t * 16 + j] = (bf16_t)f2bf(acc); }
            }
            LDS_FENCE();
            WAVE_SYNC();
            { const unsigned long long* st = (const unsigned long long*)(wsb + PW_REC); unsigned long long* gr = (unsigned long long*)(C.ws + WS_R2RING) + ((size_t)hd * R2_GSLOTS + (ch % R2_GSLOTS)) * R2S_U64;
              UNR for (int j = 0; j < 25; ++j) { const int idx = j * 64 + lane; if (idx < R2S_U64) gst_u64(gr + idx, st[idx]); } }
            VM_DRAIN(); WAVE_SYNC();
            if (lane == 0) gst_u32((unsigned*)(C.ws + WS_CTL + CTL_R2FLAG) + (size_t)hd * R2_NCH + ch, epoch);
            WAVE_SYNC();
        }
    }
    TACC_STORE(C, 47, C.vcu == 16 && C.tid == 0);
}

#ifdef EMU
typedef volatile unsigned* R2_LDSV;
#define R2_LDSV_AT(lds, off) ((volatile unsigned*)((lds) + (off)))
struct BufRsrc { const unsigned char* p; };
DEVFN BufRsrc mk_rsrc(const void* p, unsigned) { BufRsrc r; r.p = (const unsigned char*)p; return r; }
DEVFN U4 buf_ld16_sc1(BufRsrc r, unsigned off) { return *(const U4*)(r.p + off); }
#else
typedef volatile __attribute__((address_space(3))) unsigned* R2_LDSV;
#define R2_LDSV_AT(lds, off) ((volatile __attribute__((address_space(3))) unsigned*)((__attribute__((address_space(3))) unsigned char*)(lds) + (off)))
typedef unsigned u32x4_hw __attribute__((ext_vector_type(4)));
typedef __amdgpu_buffer_rsrc_t BufRsrc;
#define mk_rsrc(p, bytes) __builtin_amdgcn_make_buffer_rsrc((void*)(p), 0, (bytes), 0x00020000)
DEVFN U4 buf_ld16_sc1(BufRsrc r, unsigned off) { const u32x4_hw v = __builtin_amdgcn_raw_buffer_load_b128(r, off, 0, 16); U4 o; o.x = v.x; o.y = v.y; o.z = v.z; o.w = v.w; return o; }
#endif

#ifdef EMU
DEVFN H8 h8_pk2(const A4& a, const A4& b) { U4 w; w.x = pk2(a.v[0], a.v[1]); w.y = pk2(a.v[2], a.v[3]); w.z = pk2(b.v[0], b.v[1]); w.w = pk2(b.v[2], b.v[3]); return h8_from(w); }
DEVFN A4 a4_mul(const A4& a, const A4& g) { A4 r; for (int j = 0; j < 4; ++j) r.v[j] = a.v[j] * g.v[j]; return r; }
#else
DEVFN H8 h8_pk2(const A4& a, const A4& b) { U4 w; w.x = pk2(a[0], a[1]); w.y = pk2(a[2], a[3]); w.z = pk2(b[0], b[1]); w.w = pk2(b[2], b[3]); return __builtin_bit_cast(H8, w); }
DEVFN A4 a4_mul(const A4& a, const A4& g) { return a * g; }
#endif

DEVFN void rc2_chain(const Ctx& C, int i, int hd, bool ctx_out, unsigned char* lds, int max_chunks) {
    const int tid = C.tid, lane = tid & 63, wave = C.wave, h = hd >> 1, d = hd & 1;
    R2_LDSV lf = R2_LDSV_AT(lds, R2_LSLOTS * R2S_BYTES);
    if (tid < 96) lf[tid] = 0u;
    SYNC();
    const int nchunks = R2_NCH < max_chunks ? R2_NCH : max_chunks;
    const unsigned epoch = (unsigned)(i + 1), pbase = (unsigned)i * 100000u;
    #define RC_GEOM(ch, seg0, segn, R0) const bool isctx_ = (ch) < NCTX / RC_T; const int seg0 = isctx_ ? NLAT : 0, segn = isctx_ ? NCTX : NLAT; \
        const int cl_ = isctx_ ? (ch) : (ch) - NCTX / RC_T; const int R0 = d == 0 ? RC_T * cl_ : segn - RC_T * (cl_ + 1);
    if (wave < 4) {
        bf16_t* Yd = (bf16_t*)(C.ws + (d == 0 ? WS_YF : WS_YB));
        const int vt = wave, kg = lane >> 4, l15 = lane & 15;
        const int o16 = (l15 * 16 + 4 * kg) * 2, o32 = (l15 * 32 + 8 * kg) * 2;
        const int a_vb = R2S_VT + ((16 * vt + l15) * 16 + 4 * kg) * 2, a_kkd = R2S_KKD + (l15 * 64 + 8 * (kg ^ ((l15 >> 1) & 7))) * 2, a_rd = R2S_RD + (l15 * 64 + 8 * (kg ^ ((l15 >> 1) & 7))) * 2;
        const int a_kkd1 = R2S_KKD + (l15 * 64 + 8 * ((kg + 4) ^ ((l15 >> 1) & 7))) * 2, a_rd1 = R2S_RD + (l15 * 64 + 8 * ((kg + 4) ^ ((l15 >> 1) & 7))) * 2;
        const int a_g = R2S_GC + 4 * kg * 4;
        struct Frag { U4 kkd0, kkd1, rd0, rd1, qq, kn0, kn1, kn2, kn3; U2 vb, p0, t; A4 g0, g1, g2, g3; };
#define R2_LOADF(ch, f) do { \
            const int slot = ch % R2_LSLOTS; const unsigned char* rb = lds + slot * R2S_BYTES; \
            TACC_BEGIN; SPIN_WAIT(lf[slot] == (unsigned)(ch + 1)); TACC_END; \
            f.kkd0 = ld16(rb + a_kkd); f.kkd1 = ld16(rb + a_kkd1); f.rd0 = ld16(rb + a_rd); f.rd1 = ld16(rb + a_rd1); f.vb = *(const U2*)(rb + a_vb); \
            f.p0 = *(const U2*)(rb + o16 + R2S_P0); f.t = *(const U2*)(rb + o16 + R2S_T); f.qq = ld16(rb + o32 + R2S_QQ); \
            f.kn0 = ld16(rb + o32 + R2S_KN); f.kn1 = ld16(rb + o32 + R2S_KN + 1024); f.kn2 = ld16(rb + o32 + R2S_KN + 2048); f.kn3 = ld16(rb + o32 + R2S_KN + 3072); \
            f.g0 = *(const A4*)(rb + a_g); f.g1 = *(const A4*)(rb + a_g + 64); f.g2 = *(const A4*)(rb + a_g + 128); f.g3 = *(const A4*)(rb + a_g + 192); \
            SCHED_BAR(); \
        } while (0)
#define R2_RELEASE(ch) do { const int slot = ch % R2_LSLOTS; LDS_FENCE(); WAVE_SYNC(); if (lane == 0) lf[32 + wave * 16 + slot] = (unsigned)(ch + 1); } while (0)
        A4 H0_ = a4_zero(), H1_ = a4_zero(), H2_ = a4_zero(), H3_ = a4_zero();
#define R2_COMPUTE(ch, f) do { \
            const H8 Hb0 = h8_pk2(H0_, H1_), Hb1 = h8_pk2(H2_, H3_); \
            U4 w_; w_.x = f.vb.x; w_.y = f.vb.y; w_.z = f.vb.x; w_.w = f.vb.y; const H8 Vv = h8_from(w_); \
            U4 a_; a_.x = f.p0.x; a_.y = f.p0.y; a_.z = 0u; a_.w = 0u; \
            A4 X = mfma16(h8_from(f.kkd0), Hb0, a4_zero()); X = mfma16(h8_from(f.kkd1), Hb1, X); X = mfma16(h8_from(a_), Vv, X); \
            A4 Y = mfma16(h8_from(f.rd0), Hb0, a4_zero()); Y = mfma16(h8_from(f.rd1), Hb1, Y); \
            w_.x = pk2(A4_GET(X, 0), A4_GET(X, 1)); w_.y = pk2(A4_GET(X, 2), A4_GET(X, 3)); a_.x = f.t.x; a_.y = f.t.y; \
            const A4 U_ = mfma16(h8_from(a_), h8_from(w_), a4_zero()); \
            w_.x = f.vb.x; w_.y = f.vb.y; w_.z = pk2(A4_GET(U_, 0), A4_GET(U_, 1)); w_.w = pk2(A4_GET(U_, 2), A4_GET(U_, 3)); const H8 VU = h8_from(w_); \
            Y = mfma16(h8_from(f.qq), VU, Y); \
            H0_ = mfma16(h8_from(f.kn0), VU, H0_); H1_ = mfma16(h8_from(f.kn1), VU, H1_); H2_ = mfma16(h8_from(f.kn2), VU, H2_); H3_ = mfma16(h8_from(f.kn3), VU, H3_); \
            H0_ = a4_mul(H0_, f.g0); H1_ = a4_mul(H1_, f.g1); H2_ = a4_mul(H2_, f.g2); H3_ = a4_mul(H3_, f.g3); \
            { RC_GEOM(ch, seg0, segn, R0) \
              if (!isctx_ || ctx_out) { bf16_t* yp = ycol + (size_t)(seg0 + (d == 0 ? R0 + 4 * kg : R0 + RC_T - 1 - 4 * kg)) * 512; \
                  UNR for (int rg = 0; rg < 4; ++rg) yp[rg * ystep] = (bf16_t)f2bf(A4_GET(Y, rg)); } } \
        } while (0)
        bf16_t* ycol = Yd + 64 * h + 16 * vt + l15; const int ystep = d == 0 ? 512 : -512;
        Frag fa, fb;
        TACC_DECL;
        { const int cz = 0; if (nchunks > 0) { R2_LOADF(cz, fa); R2_RELEASE(cz); } }
        for (int c0 = 0; c0 < nchunks; c0 += 2) {
            const int c1 = c0 + 1, c2 = c0 + 2;
            if (c1 < nchunks) R2_LOADF(c1, fb);
            R2_COMPUTE(c0, fa);
            if (c1 < nchunks) { R2_RELEASE(c1); if (c2 < nchunks) R2_LOADF(c2, fa); R2_COMPUTE(c1, fb); if (c2 < nchunks) R2_RELEASE(c2); }
        }
        TACC_STORE(C, 45, C.vcu == 0 && tid == 0);
    } else {
        const int w = wave - 4;
        const unsigned* FLAG = (const unsigned*)(C.ws + WS_CTL + CTL_R2FLAG) + (size_t)hd * R2_NCH; unsigned* POS = (unsigned*)(C.ws + WS_CTL + CTL_R2POS) + 16 * hd;
        const BufRsrc rs = mk_rsrc(C.ws + WS_R2RING + (size_t)hd * R2_GSLOTS * R2S_BYTES, (unsigned)(R2_GSLOTS * R2S_BYTES));
        TACC_DECL;
        unsigned f0 = 0u, f1 = 0u;
        for (int ca = w; ca < nchunks; ca += 8) {
            const int cb = ca + 4; const bool two = cb < nchunks;
            if (f0 != epoch) { GSPIN_WAIT(gld_u32(FLAG + ca) == epoch); }
            if (two && f1 != epoch) { GSPIN_WAIT(gld_u32(FLAG + cb) == epoch); }
            U4 xa[13], xb[13];
            const unsigned oa = (unsigned)(ca % R2_GSLOTS) * R2S_BYTES + lane * 16, ob = (unsigned)(cb % R2_GSLOTS) * R2S_BYTES + lane * 16;
            UNR for (int j = 0; j < 13; ++j) xa[j] = buf_ld16_sc1(rs, oa + j * 1024);
            if (two) { UNR for (int j = 0; j < 13; ++j) xb[j] = buf_ld16_sc1(rs, ob + j * 1024); }
            f0 = ca + 8 < nchunks ? gld_u32(FLAG + ca + 8) : 0u; f1 = cb + 8 < nchunks ? gld_u32(FLAG + cb + 8) : 0u;
            {
                const int slot = ca % R2_LSLOTS;
                if (ca >= R2_LSLOTS) { const unsigned need = (unsigned)(ca - R2_LSLOTS + 1); TACC_BEGIN; SPIN_WAIT(lf[32 + 0 * 16 + slot] == need && lf[32 + 1 * 16 + slot] == need && lf[32 + 2 * 16 + slot] == need && lf[32 + 3 * 16 + slot] == need); TACC_END; }
                unsigned char* dst = lds + slot * R2S_BYTES + lane * 16;
                UNR for (int j = 0; j < 12; ++j) st16(dst + j * 1024, xa[j]);
                if (lane < 16) st16(dst + 12 * 1024, xa[12]);
                LDS_FENCE(); WAVE_SYNC();
                if (lane == 0) lf[slot] = (unsigned)(ca + 1);
            }
            if (two) {
                const int slot = cb % R2_LSLOTS;
                if (cb >= R2_LSLOTS) { const unsigned need = (unsigned)(cb - R2_LSLOTS + 1); TACC_BEGIN; SPIN_WAIT(lf[32 + 0 * 16 + slot] == need && lf[32 + 1 * 16 + slot] == need && lf[32 + 2 * 16 + slot] == need && lf[32 + 3 * 16 + slot] == need); TACC_END; }
                unsigned char* dst = lds + slot * R2S_BYTES + lane * 16;
                UNR for (int j = 0; j < 12; ++j) st16(dst + j * 1024, xb[j]);
                if (lane < 16) st16(dst + 12 * 1024, xb[12]);
                LDS_FENCE(); WAVE_SYNC();
                if (lane == 0) lf[slot] = (unsigned)(cb + 1);
            }
            if (lane == 0) gst_u32(POS + 1 + w, pbase + (unsigned)((two ? cb : ca) + 1));
        }
        TACC_STORE(C, 46, C.vcu == 0 && tid == 256);
    }
    #undef RC_GEOM
    SYNC();
}
#ifndef HY_CUS
#define HY_CUS 171
#endif
DEVFN void ph_scan_hyena(const Ctx& C, int i, bool ctx_out, unsigned char* lds) {
    const int np = C.G >= 256 ? C.G - 16 - HY_CUS : (C.G - 16) / 2, nscan = 16 + np;
    if (C.vcu < 16) { rc2_chain(C, i, C.vcu, ctx_out, lds, 1 << 30); XSTAMP(C, 40, C.vcu == 0); return; }
    unsigned* ticket = (unsigned*)(C.ws + WS_CTL + CTL_R2TICKET) + 16 * i;
    if (C.vcu < nscan) { rc2_producer(C, i, lds, ticket, 0, 16, 1 << 30); XSTAMP(C, 43, C.vcu == 16); return; }
    const int nh = C.G - nscan;
    for (int c = C.vcu - nscan; c < 512; c += nh) { hyena_channel(C, i, c, lds); if (c == C.vcu - nscan) XSTAMP(C, 44, C.vcu == nscan); }
    XSTAMP(C, 41, C.vcu == nscan); XSTAMP(C, 42, C.vcu == C.G - 1);
    if (ctx_out) for (int c = C.vcu - nscan; c < 512; c += nh) { SYNC(); hyena_ctx_channel(C, i, c, lds); }
    SYNC();
    rc2_producer(C, i, lds, ticket, 0, 16, 1 << 30);
}

DEVFN void ctx_outproj(const Ctx& C, const bf16_t* A1, const bf16_t* A2, int lda, const bf16_t* Wt, const float* gate_c, const float* base, float* out) {
    const int row = C.tid & 255, cp = C.tid >> 8;
    for (int n0 = 4 * C.vcu; n0 < DM; n0 += 4 * C.G) {
        const int n = n0 + 2 * cp;
        const bf16_t* w0p = Wt + (size_t)n * DM; const bf16_t* w1p = w0p + DM;
        float acc0 = 0.f, acc1 = 0.f;
        for (int hf = 0; hf < 2; ++hf) {
            const bf16_t* ap = (hf == 0 ? A1 : A2) + (size_t)row * lda;
            for (int k0 = 0; k0 < 512; k0 += 8) {
                float a[8], w0[8], w1[8];
                unpack8(ld16(ap + k0), a); unpack8(ld16(w0p + 512 * hf + k0), w0); unpack8(ld16(w1p + 512 * hf + k0), w1);
                UNR for (int e = 0; e < 8; ++e) { acc0 += a[e] * w0[e]; acc1 += a[e] * w1[e]; }
            }
        }
        const size_t o = (size_t)row * DM + n;
        out[o] = base[o] + gate_c[n] * acc0; out[o + 1] = base[o + 1] + gate_c[n + 1] * acc1;
    }
}
namespace pg8 {
#define PG8_LAS __attribute__((address_space(3)))
typedef unsigned short bf16_t;
typedef short bf16x8 __attribute__((ext_vector_type(8)));
typedef float f32x4 __attribute__((ext_vector_type(4)));
typedef unsigned u32x4 __attribute__((ext_vector_type(4)));
constexpr int BM = 256, BK = 64, HALF = 128, HTB = HALF * BK * 2  , STAGE_BYTES = 8 * HTB, NXCD = 8, WGM = 8;

__host__ __device__ __forceinline__ int lds_byte(int r, int c) { const int st = (r >> 4) * 2 + (c >> 5), rr = r & 15, cc = c & 31, ob = rr * 64 + cc * 2; return st * 1024 + (ob ^ (((ob >> 9) & 1) << 5)); }
__host__ __device__ __forceinline__ void stage_rc(int b, int& R, int& C) { const int st = b / 1024, sb = b % 1024, swz = sb ^ (((sb >> 9) & 1) << 5); R = (st >> 1) * 16 + swz / 64; C = (st & 1) * 32 + (swz % 64) / 2; }
__host__ __device__ __forceinline__ int perm32(int rho) { const int n = rho >> 4, i = rho & 15; return 8 * (i >> 2) + 4 * n + (i & 3); }

struct Unit { int pm, pn; };
struct Gemm { const bf16_t* A; const bf16_t* A2; int lda; const bf16_t* Bt; int M, N, K; };

struct StaticOrder {
    int nM, nN, nwg, G, c;
    __host__ __device__ void init(int M, int N, int G_, int c_) { nM = M / BM; nN = N / BM; nwg = nM * nN; G = G_; c = c_; }
    __host__ __device__ bool next(int i, Unit& u) const {
        const long L = (long)i * G + c; if (L >= nwg) return false;
        int wgid = (int)L; { const int q = nwg / NXCD, r = nwg % NXCD, xcd = wgid % NXCD, off = wgid / NXCD; wgid = (xcd < r ? xcd * (q + 1) : r * (q + 1) + (xcd - r) * q) + off; }
        const int nig = WGM * nN, gid = wgid / nig, fm = gid * WGM, gsz = (nM - fm) < WGM ? (nM - fm) : WGM;
        u.pm = fm + ((wgid % nig) % gsz); u.pn = (wgid % nig) / gsz; return true;
    }
    __device__ __forceinline__ void a_ready(const Unit&) const {}
    __device__ __forceinline__ void done(const Unit&) const {}
};

__device__ __forceinline__ unsigned cvt_pk_bf16(float lo, float hi) { unsigned r; asm volatile("v_cvt_pk_bf16_f32 %0, %1, %2" : "=v"(r) : "v"(lo), "v"(hi)); return r; }
__device__ __forceinline__ float silu_fast(float v) { return v * __builtin_amdgcn_rcpf(1.0f + __expf(-v)); }

template <int LAYOUT> struct EpiIn {
    static constexpr bool PERM = true, AFTER_DRAIN = false;
    unsigned char* ws;
    __device__ __forceinline__ void operator()(const f32x4 (&acc)[2][2][4][2], const Unit& u, int wr, int wc, int fr, int fq) const {
        const int row0 = u.pm * BM + wr * 64 + fr;
#pragma unroll
        for (int bj = 0; bj < 2; ++bj) {
            const int cg = u.pn * BM + bj * HALF;
            bf16_t* base; int ldc, mode, col;
            if (LAYOUT == 0) { base = (bf16_t*)(ws + WS_U); ldc = AIN; col = cg; mode = cg < 512 ? 1 : ((cg >= 1536 && cg < 2048) || cg >= 2816) ? 2 : 0; }
            else {
                if (cg < URW_W) { base = (bf16_t*)(ws + WS_U); ldc = URW_W; col = cg; mode = cg >= 1664 ? 2 : 0; }
                else if (cg < URW_W + UHY_W) { base = (bf16_t*)(ws + WS_UHY); ldc = UHY_W; col = cg - URW_W; mode = 0; }
                else if (cg < RIN) { base = (bf16_t*)(ws + WS_GHY); ldc = 512; col = cg - URW_W - UHY_W; mode = 2; }
                else { base = nullptr; ldc = 0; col = 0; mode = 3; }
            }
            if (mode == 3) continue;
            const int col0 = col + wc * 32 + 8 * fq;
#pragma unroll
            for (int ai = 0; ai < 2; ++ai)
#pragma unroll
                for (int m = 0; m < 4; ++m) {
                    f32x4 v0 = acc[ai][bj][m][0], v1 = acc[ai][bj][m][1];
                    if (mode == 1) { v0 = v0 * C2; v1 = v1 * C2; }
                    if (mode == 2) { v0 = (f32x4){silu_fast(v0[0]), silu_fast(v0[1]), silu_fast(v0[2]), silu_fast(v0[3])}; v1 = (f32x4){silu_fast(v1[0]), silu_fast(v1[1]), silu_fast(v1[2]), silu_fast(v1[3])}; }
                    u32x4 w; w.x = cvt_pk_bf16(v0[0], v0[1]); w.y = cvt_pk_bf16(v0[2], v0[3]); w.z = cvt_pk_bf16(v1[0], v1[1]); w.w = cvt_pk_bf16(v1[2], v1[3]);
                    *(u32x4*)(base + (size_t)(row0 + ai * HALF + m * 16) * ldc + col0) = w;
                }
        }
    }
};

struct EpiRes {
    static constexpr bool PERM = false, AFTER_DRAIN = false;
    const float* blat; const float* bctx; float* olat; float* octx; const float* gate; const float* gate_c;
    __device__ __forceinline__ void operator()(const f32x4 (&acc)[2][2][4][2], const Unit& u, int wr, int wc, int fr, int fq) const {
        const bool isctx = u.pm * BM >= NLAT;
        const float* bs = isctx ? bctx - (size_t)NLAT * DM : blat; float* os = isctx ? octx - (size_t)NLAT * DM : olat; const float* gt = isctx ? gate_c : gate;
        const int col0 = u.pn * BM + wc * 32 + 4 * fq;
#pragma unroll
        for (int bj = 0; bj < 2; ++bj)
#pragma unroll
            for (int n = 0; n < 2; ++n) { const f32x4 g = *(const f32x4*)(gt + col0 + bj * HALF + n * 16);
#pragma unroll
                for (int ai = 0; ai < 2; ++ai)
#pragma unroll
                    for (int m = 0; m < 4; ++m) { const size_t off = (size_t)(u.pm * BM + ai * HALF + wr * 64 + m * 16 + fr) * DM + col0 + bj * HALF + n * 16;
                        const f32x4 b = *(const f32x4*)(bs + off); *(f32x4*)(os + off) = b + g * acc[ai][bj][m][n]; } }
    }
};
template <class Epi, class Sched, bool ALIGN_EPI = false, bool SP2 = false>
__device__ __forceinline__ void gemm_phase(PG8_LAS unsigned char* lds, const Gemm g, const Sched& S, const Epi& E) {
    int tid_ = threadIdx.x; asm volatile("" : "+v"(tid_));
    const int tid = tid_, wid = __builtin_amdgcn_readfirstlane(tid >> 6), lane = tid & 63, wr = wid >> 2, wc = wid & 3, fr = lane & 15, fq = lane >> 4;
    const int K = g.K, nt = K / BK;
    unsigned voffA[2], voffB[2];
#pragma unroll
    for (int i = 0; i < 2; ++i) { int R, C; stage_rc(tid * 16 + i * 8192, R, C); const int Rb = Epi::PERM ? ((R & ~31) + perm32(R & 31)) : R;
        voffA[i] = (unsigned)(R * g.lda + C) * 2u; voffB[i] = (unsigned)(Rb * K + C) * 2u; }
    const size_t kstep = (size_t)(BK * 2);
    const size_t hstepA = (size_t)HALF * g.lda * 2, hstepB = (size_t)HALF * K * 2;
    const size_t tstepA = 2 * hstepA, tstepB = 2 * hstepB;
    const int nh = nt / 2; const ptrdiff_t dlt = ((const char*)g.A2 - (const char*)g.A) - (ptrdiff_t)nh * (ptrdiff_t)kstep;
    const unsigned ldsw = (unsigned)wid * 1024u;
    const int aoff = lds_byte(wr * 64 + fr, fq * 8), boff = lds_byte(wc * 32 + fr, fq * 8);
#define PG8_SA(b, h) (((b) * 2 + (h)) * HTB)
#define PG8_SB(b, h) ((4 + (b) * 2 + (h)) * HTB)
#define PG8_STAGE(bufoff, gbase, voff) do { _Pragma("unroll") for (int _i = 0; _i < 2; ++_i) \
        __builtin_amdgcn_global_load_lds((const unsigned*)((const char*)(gbase) + (voff)[_i]), (PG8_LAS unsigned*)(lds + (bufoff) + ldsw + _i * 8192), 16, 0, 0); } while (0)
#define PG8_LDA(dst, b, h) do { _Pragma("unroll") for (int m = 0; m < 4; ++m) _Pragma("unroll") for (int k = 0; k < 2; ++k) dst[m][k] = *(const PG8_LAS bf16x8*)(lds + PG8_SA(b, h) + aoff + m * 2048 + k * 1024); } while (0)
#define PG8_LDB(dst, b, h) do { _Pragma("unroll") for (int n = 0; n < 2; ++n) _Pragma("unroll") for (int k = 0; k < 2; ++k) dst[n][k] = *(const PG8_LAS bf16x8*)(lds + PG8_SB(b, h) + boff + n * 2048 + k * 1024); } while (0)
#define PG8_MMA(ai, bj, At, Bt) do { __builtin_amdgcn_s_setprio(1); _Pragma("unroll") for (int m = 0; m < 4; ++m) _Pragma("unroll") for (int n = 0; n < 2; ++n) _Pragma("unroll") for (int k = 0; k < 2; ++k) \
        acc[ai][bj][m][n] = __builtin_amdgcn_mfma_f32_16x16x32_bf16(Bt[n][k], At[m][k], acc[ai][bj][m][n], 0, 0, 0); __builtin_amdgcn_s_setprio(0); } while (0)
#define PG8_WAIT_V(n) asm volatile("s_waitcnt vmcnt(" #n ")" ::: "memory")
#define PG8_WAIT_L(n) asm volatile("s_waitcnt lgkmcnt(" #n ")" ::: "memory")
#define PG8_BAR __builtin_amdgcn_s_barrier()
#define PG8_SCHED __builtin_amdgcn_sched_barrier(0)
    Unit cur, nxt; int ui = 0;
    if (!S.next(0, cur)) return;
    f32x4 acc[2][2][4][2];
#pragma unroll
    for (int a = 0; a < 2; ++a)
#pragma unroll
        for (int b = 0; b < 2; ++b)
#pragma unroll
            for (int m = 0; m < 4; ++m)
#pragma unroll
                for (int n = 0; n < 2; ++n) acc[a][b][m][n] = (f32x4){0.f, 0.f, 0.f, 0.f};
    bf16x8 At[4][2], B0[2][2], B1[2][2];
    const char* cA = (const char*)g.A + (size_t)cur.pm * tstepA; const char* cB = (const char*)g.Bt + (size_t)cur.pn * tstepB;
    S.a_ready(cur);
    if constexpr (SP2) {
        PG8_STAGE(PG8_SB(0, 0), cB, voffB); PG8_STAGE(PG8_SB(0, 1), cB + hstepB, voffB); PG8_STAGE(PG8_SA(0, 0), cA, voffA); PG8_STAGE(PG8_SA(0, 1), cA + hstepA, voffA);
        if (wr == 1) PG8_BAR;
        PG8_WAIT_V(2); PG8_BAR;
        PG8_STAGE(PG8_SB(1, 0), cB + kstep, voffB); PG8_STAGE(PG8_SA(1, 0), cA + kstep, voffA); PG8_STAGE(PG8_SB(1, 1), cB + hstepB + kstep, voffB);
        PG8_WAIT_V(6); PG8_BAR;
    } else {
        PG8_STAGE(PG8_SB(0, 0), cB, voffB); PG8_STAGE(PG8_SA(0, 0), cA, voffA); PG8_STAGE(PG8_SB(0, 1), cB + hstepB, voffB); PG8_STAGE(PG8_SA(0, 1), cA + hstepA, voffA);
        if (wr == 1) PG8_BAR;
        PG8_WAIT_V(4); PG8_BAR;
        PG8_STAGE(PG8_SB(1, 0), cB + kstep, voffB); PG8_STAGE(PG8_SA(1, 0), cA + kstep, voffA); PG8_STAGE(PG8_SB(1, 1), cB + hstepB + kstep, voffB);
        PG8_WAIT_V(6); PG8_BAR;
    }
    for (;;) {
        const bool has_next = S.next(ui + 1, nxt);
        const char* nA = has_next ? (const char*)g.A + (size_t)nxt.pm * tstepA : cA; const char* nB = has_next ? (const char*)g.Bt + (size_t)nxt.pn * tstepB : cB;
        for (int t = 0; t < nt; t += 2) {
            const bool last = (t == nt - 2);
            const char* a1 = cA + (size_t)(t + 1) * kstep + ((t + 1) >= nh ? dlt : 0);
            const char* a2 = last ? nA : cA + (size_t)(t + 2) * kstep + ((t + 2) >= nh ? dlt : 0); const char* b2 = last ? nB : cB + (size_t)(t + 2) * kstep;
            const char* a3 = a2 + kstep; const char* b3 = b2 + kstep;
            if (last && has_next) S.a_ready(nxt);
            if constexpr (SP2) {
            PG8_LDB(B0, 0, 0); PG8_LDB(B1, 0, 1); PG8_SCHED; PG8_LDA(At, 0, 0); PG8_STAGE(PG8_SA(1, 1), a1 + hstepA, voffA);
            PG8_WAIT_V(8); PG8_WAIT_L(0); PG8_BAR; PG8_MMA(0, 0, At, B0); PG8_MMA(0, 1, At, B1); PG8_BAR; PG8_SCHED;
            PG8_LDA(At, 0, 1); PG8_STAGE(PG8_SB(0, 0), b2, voffB); PG8_STAGE(PG8_SB(0, 1), b2 + hstepB, voffB); PG8_STAGE(PG8_SA(0, 0), a2, voffA);
            PG8_WAIT_V(8); PG8_WAIT_L(0); PG8_BAR; PG8_MMA(1, 0, At, B0); PG8_MMA(1, 1, At, B1); PG8_BAR; PG8_SCHED;
            PG8_LDB(B0, 1, 0); PG8_LDB(B1, 1, 1); PG8_SCHED; PG8_LDA(At, 1, 0); PG8_STAGE(PG8_SA(0, 1), a2 + hstepA, voffA);
            PG8_WAIT_V(8); PG8_WAIT_L(0); PG8_BAR; PG8_MMA(0, 0, At, B0); PG8_MMA(0, 1, At, B1); PG8_BAR; PG8_SCHED;
            PG8_LDA(At, 1, 1); PG8_STAGE(PG8_SB(1, 0), b3, voffB); PG8_STAGE(PG8_SB(1, 1), b3 + hstepB, voffB); PG8_STAGE(PG8_SA(1, 0), a3, voffA);
            PG8_WAIT_V(8); PG8_WAIT_L(0); PG8_BAR; PG8_MMA(1, 0, At, B0); PG8_MMA(1, 1, At, B1); PG8_BAR; PG8_SCHED;
            } else {
            PG8_LDB(B0, 0, 0); PG8_SCHED; PG8_LDA(At, 0, 0); PG8_STAGE(PG8_SA(1, 1), a1 + hstepA, voffA);
            PG8_WAIT_L(8); PG8_BAR; PG8_WAIT_L(0); PG8_MMA(0, 0, At, B0); PG8_BAR; PG8_SCHED;
            PG8_LDB(B1, 0, 1); PG8_STAGE(PG8_SB(0, 0), b2, voffB);
            PG8_BAR; PG8_WAIT_L(0); PG8_MMA(0, 1, At, B1); PG8_BAR;
            PG8_LDA(At, 0, 1); PG8_STAGE(PG8_SA(0, 0), a2, voffA);
            PG8_BAR; PG8_WAIT_L(0); PG8_MMA(1, 0, At, B0); PG8_BAR; PG8_SCHED;
            PG8_STAGE(PG8_SB(0, 1), b2 + hstepB, voffB);
            PG8_WAIT_V(6); PG8_BAR; PG8_MMA(1, 1, At, B1); PG8_BAR;
            PG8_LDB(B0, 1, 0); PG8_SCHED; PG8_LDA(At, 1, 0); PG8_STAGE(PG8_SA(0, 1), a2 + hstepA, voffA);
            PG8_WAIT_L(8); PG8_BAR; PG8_WAIT_L(0); PG8_MMA(0, 0, At, B0); PG8_BAR; PG8_SCHED;
            PG8_LDB(B1, 1, 1); PG8_STAGE(PG8_SB(1, 0), b3, voffB);
            PG8_BAR; PG8_WAIT_L(0); PG8_MMA(0, 1, At, B1); PG8_BAR;
            PG8_LDA(At, 1, 1); PG8_STAGE(PG8_SA(1, 0), a3, voffA);
            PG8_BAR; PG8_WAIT_L(0); PG8_MMA(1, 0, At, B0); PG8_BAR; PG8_SCHED;
            PG8_STAGE(PG8_SB(1, 1), b3 + hstepB, voffB);
            PG8_WAIT_V(6); PG8_BAR; PG8_MMA(1, 1, At, B1); PG8_BAR;
            }
        }
        if constexpr (ALIGN_EPI) { if (wr == 0) PG8_BAR; }
        if constexpr (!Epi::AFTER_DRAIN) { E(acc, cur, wr, wc, fr, fq); S.done(cur); }
        if (!has_next) break;
#pragma unroll
        for (int a = 0; a < 2; ++a)
#pragma unroll
            for (int b = 0; b < 2; ++b)
#pragma unroll
                for (int m = 0; m < 4; ++m)
#pragma unroll
                    for (int n = 0; n < 2; ++n) acc[a][b][m][n] = (f32x4){0.f, 0.f, 0.f, 0.f};
        cur = nxt; cA = nA; cB = nB; ++ui;
        if constexpr (ALIGN_EPI) { if (wr == 1) PG8_BAR; }
    }
    PG8_WAIT_V(0);
    if constexpr (!ALIGN_EPI) { if (wr == 0) PG8_BAR; }
    PG8_BAR;
    if constexpr (Epi::AFTER_DRAIN) { E.fused(acc, cur, wr, wc, fr, fq, lds, wid, lane); S.done(cur); }
#undef PG8_SA
#undef PG8_SB
#undef PG8_STAGE
#undef PG8_LDA
#undef PG8_LDB
#undef PG8_MMA
#undef PG8_WAIT_V
#undef PG8_WAIT_L
#undef PG8_BAR
#undef PG8_SCHED
}
}
#include <hip/hip_bf16.h>
#include <cmath>
namespace attn_body {
using bf16=__hip_bfloat16;
using bf16x8=__attribute__((ext_vector_type(8)))short;
using s16x4=__attribute__((ext_vector_type(4)))short;
using f32x16=__attribute__((ext_vector_type(16)))float;
using u32x4=__attribute__((ext_vector_type(4)))unsigned;
constexpr int D=64;
constexpr int NW=8,QBLK=32,QB=QBLK*NW,KVBLK=64;
__device__ __forceinline__ int crow(int r,int hi){return (r&3)+8*(r>>2)+4*hi;}
#define SBAR() __builtin_amdgcn_sched_barrier(0)
typedef __attribute__((address_space(3))) const float* lds_fptr;
struct NaCtx { lds_fptr tab; int rmin, qr, qc, row0, col0; };
__device__ __forceinline__ void namask(f32x16&p0,f32x16&p1,int t,const NaCtx&n,int hi){
  if(t<4)return;
  const float NEG=-INFINITY; const int kr=n.rmin+(t-4);
  if(kr<n.row0||kr>=n.row0+8){
    #pragma unroll
    for(int r=0;r<16;++r){p0[r]=NEG;p1[r]=NEG;}
    return; }
  const lds_fptr bt=n.tab+((kr-n.qr+7)*31+15-n.qc+4*hi); const int d0=4*hi-n.col0;
  #pragma unroll
  for(int r=0;r<16;++r){const int e=(r&3)+8*(r>>2);
    p0[r]=((unsigned)(e+d0)<16u)?p0[r]+bt[e]:NEG; p1[r]=((unsigned)(e+32+d0)<16u)?p1[r]+bt[e+32]:NEG;}
}

constexpr int NSLOT=3, SLOTB=8192;
constexpr int LDS_K=0, LDS_V=NSLOT*SLOTB, LDS_WS=2*NSLOT*SLOTB, LDS_OST=LDS_WS+NW*64*4, LDS_BIAS=LDS_OST+NW*4096, LDS_BYTES=LDS_BIAS+640*4;
constexpr float C2=0.125f*1.4426950408889634f;
__device__ __forceinline__ void glds16(const void*gsrc,unsigned lds_dst){unsigned keep;
  asm volatile("s_mov_b32 %0, m0\n\ts_mov_b32 m0, %2\n\ts_nop 0\n\tglobal_load_lds_dwordx4 %1, off\n\ts_mov_b32 m0, %0":"=&s"(keep):"v"(gsrc),"s"(lds_dst):"memory");}
__device__ __forceinline__ float max3f(float a,float b,float c){float r;asm("v_max3_f32 %0, %1, %2, %3":"=v"(r):"v"(a),"v"(b),"v"(c));return r;}
__device__ __forceinline__ float max2f(float a,float b){float r;asm("v_max_f32_e32 %0, %1, %2":"=v"(r):"v"(a),"v"(b));return r;}
__device__ __forceinline__ float fadd_s(float a,float b){float r;asm("v_add_f32_e32 %0, %1, %2":"=v"(r):"v"(a),"v"(b));return r;}
__device__ __forceinline__ float fsub_s(float a,float b){float r;asm("v_sub_f32_e32 %0, %1, %2":"=v"(r):"v"(a),"v"(b));return r;}
typedef float f32x2_t __attribute__((ext_vector_type(2))); typedef __bf16 bf16x2_t __attribute__((ext_vector_type(2)));
__device__ __forceinline__ unsigned cvtpk_s(float lo,float hi){f32x2_t v={lo,hi};bf16x2_t b=__builtin_convertvector(v,bf16x2_t);return __builtin_bit_cast(unsigned,b);}
#define WAIT_BAR(N) asm volatile("s_waitcnt vmcnt(" #N ") lgkmcnt(0)\n\ts_barrier":::"memory")

__device__ __forceinline__ void qkt(f32x16&p0,f32x16&p1,const char*Kslot,const bf16x8*qr,const f32x16&negm,int r32,int hi){
  const char*kb=Kslot+hi*1024+r32*16;
  #pragma unroll
  for(int d0=0;d0<4;++d0){
    const bf16x8 b0=*reinterpret_cast<const bf16x8*>(kb+d0*2048);
    const bf16x8 b1=*reinterpret_cast<const bf16x8*>(kb+d0*2048+512);
    if(d0==0){p0=__builtin_amdgcn_mfma_f32_32x32x16_bf16(b0,qr[0],negm,0,0,0);p1=__builtin_amdgcn_mfma_f32_32x32x16_bf16(b1,qr[0],negm,0,0,0);}
    else{p0=__builtin_amdgcn_mfma_f32_32x32x16_bf16(b0,qr[d0],p0,0,0,0);p1=__builtin_amdgcn_mfma_f32_32x32x16_bf16(b1,qr[d0],p1,0,0,0);}}
}
typedef __attribute__((address_space(3))) const char* lds_cptr;
typedef short v4i16_t __attribute__((ext_vector_type(4)));
__device__ __forceinline__ void kload8(bf16x8*kf,lds_cptr kp){
  kf[0]=*(const __attribute__((address_space(3))) bf16x8*)(kp);      kf[1]=*(const __attribute__((address_space(3))) bf16x8*)(kp+512);
  kf[2]=*(const __attribute__((address_space(3))) bf16x8*)(kp+2048); kf[3]=*(const __attribute__((address_space(3))) bf16x8*)(kp+2560);
  kf[4]=*(const __attribute__((address_space(3))) bf16x8*)(kp+4096); kf[5]=*(const __attribute__((address_space(3))) bf16x8*)(kp+4608);
  kf[6]=*(const __attribute__((address_space(3))) bf16x8*)(kp+6144); kf[7]=*(const __attribute__((address_space(3))) bf16x8*)(kp+6656);
}
__device__ __forceinline__ void kload2(bf16x8*kf,lds_cptr kp,int j){ kf[2*j]=*(const __attribute__((address_space(3))) bf16x8*)(kp+j*2048); kf[2*j+1]=*(const __attribute__((address_space(3))) bf16x8*)(kp+j*2048+512); }
__device__ __forceinline__ s16x4 vtr(lds_cptr p){ return __builtin_bit_cast(s16x4,__builtin_amdgcn_ds_read_tr16_b64_v4i16((__attribute__((address_space(3))) v4i16_t*)p)); }
__device__ __forceinline__ float rowmax(const f32x16&p0,const f32x16&p1){
  float a=max3f(p0[0],p0[1],p1[0]),b=max3f(p0[2],p0[3],p1[1]);a=max3f(a,p1[2],p1[3]);
  #pragma unroll
  for(int r=4;r<16;r+=4){a=max3f(a,p0[r],p0[r+1]);b=max3f(b,p0[r+2],p0[r+3]);a=max3f(a,p1[r],p1[r+1]);b=max3f(b,p1[r+2],p1[r+3]);}
  const float m=max2f(a,b);
  auto rr=__builtin_amdgcn_permlane32_swap(__float_as_uint(m),__float_as_uint(m),false,false);
  return max2f(__uint_as_float(rr[0]),__uint_as_float(rr[1]));
}
__device__ __forceinline__ void pv(f32x16*o,int vb,bf16x8 pa0,bf16x8 pa1,bf16x8 pa2,bf16x8 pa3){
  #pragma unroll
  for(int d0=0;d0<2;++d0){s16x4 lo[4],hi[4];
    #pragma unroll
    for(int ks=0;ks<4;++ks){
      asm volatile("ds_read_b64_tr_b16 %0,%1 offset:%c2":"=&v"(lo[ks]):"v"(vb),"i"(d0*4096+ks*1024):"memory");
      asm volatile("ds_read_b64_tr_b16 %0,%1 offset:%c2":"=&v"(hi[ks]):"v"(vb),"i"(d0*4096+ks*1024+512):"memory");}
    asm volatile("s_waitcnt lgkmcnt(0)":::"memory");SBAR();
    #define PK(k) (bf16x8){lo[k][0],lo[k][1],lo[k][2],lo[k][3],hi[k][0],hi[k][1],hi[k][2],hi[k][3]}
    o[d0]=__builtin_amdgcn_mfma_f32_32x32x16_bf16(pa0,PK(0),o[d0],0,0,0);
    o[d0]=__builtin_amdgcn_mfma_f32_32x32x16_bf16(pa1,PK(1),o[d0],0,0,0);
    o[d0]=__builtin_amdgcn_mfma_f32_32x32x16_bf16(pa2,PK(2),o[d0],0,0,0);
    o[d0]=__builtin_amdgcn_mfma_f32_32x32x16_bf16(pa3,PK(3),o[d0],0,0,0);
    #undef PK
  }
}

#define ATTN_STORE16(p,v) (*(u32x4*)(p)=(v))
template<bool NA> __device__ __forceinline__ f32x16 cinit(const f32x16&negm){ if constexpr(NA){ f32x16 z=f32x16{}; return z; } else return negm; }
constexpr int UP=3328, OP=1024;
struct AJob { const bf16*U; bf16*MX; unsigned qo, ko, vo, go, oo; int NT, tile0a, na, tile0b; int qr0, rmin; const float*rpb; };
__device__ __forceinline__ u32x4 gate8(u32x4 v,u32x4 g);
template<int THRL,bool NA> __device__ __forceinline__ void attn_unit(const AJob&J,char*shm){
  int tid_=threadIdx.x; asm volatile("":"+v"(tid_));
  const int tid=tid_,lane=tid&63,r32=lane&31,hi=lane>>5; const int wid=__builtin_amdgcn_readfirstlane(tid>>6);
  const bf16*Qw=J.U+J.qo+(long)(wid*QBLK)*UP;
  const bf16*Kh=J.U+J.ko,*Vh=J.U+J.vo;
  const unsigned lds0=(unsigned)(uintptr_t)shm;
  float*wsf=(float*)(shm+LDS_WS)+wid*64;
  const bf16*ksrc=Kh+(long)lane*UP+wid*8;
  const bf16*vsrc=Vh+(long)(16*(wid&3)+(lane>>2))*UP+(wid>>2)*32+(lane&3)*8;
  const unsigned kdst=lds0+LDS_K+wid*1024, vdst=lds0+LDS_V+wid*1024;
  #define TROW(t) (64L*(long)(((t)<J.na)?(J.tile0a+(t)):(J.tile0b+((t)-J.na))))
  #define DMA_K(t,slot) glds16(ksrc+TROW(t)*UP,(unsigned)__builtin_amdgcn_readfirstlane(kdst+(slot)))
  #define DMA_V(t,slot) glds16(vsrc+TROW(t)*UP,(unsigned)__builtin_amdgcn_readfirstlane(vdst+(slot)))
  const int vb0=(int)(lds0+LDS_V)+((lane>>4)&1)*32+(lane&3)*8+(4*hi+((lane&15)>>2))*64;
  const char*Kbase=shm+LDS_K; bf16x8 kf[8];
  const lds_cptr shm3=(lds_cptr)shm; const lds_cptr kp0=shm3+LDS_K+hi*1024+r32*16; const lds_cptr vp0=shm3+LDS_V+((lane>>4)&1)*32+(lane&3)*8+(4*hi+((lane&15)>>2))*64;
  const int NT=J.NT;
  NaCtx nac; nac.tab=(lds_fptr)(shm+LDS_BIAS)+64; nac.rmin=J.rmin; nac.qr=J.qr0+(wid>>1); nac.qc=32*(wid&1)+r32;
  { int a=nac.qr-4; a=a<0?0:(a>248?248:a); nac.row0=a; int b=nac.qc-8; b=b<0?0:(b>48?48:b); nac.col0=b; }
  if(NA){ if(J.rpb){ for(int e=tid;e<465;e+=512)((__attribute__((address_space(3))) float*)(shm+LDS_BIAS))[64+e]=J.rpb[e]*1.4426950408889634f; } }
  DMA_K(0,0);DMA_V(0,0);DMA_K(1,SLOTB);
  bf16x8 qr[4];
  #pragma unroll
  for(int d0=0;d0<4;++d0)qr[d0]=*reinterpret_cast<const bf16x8*>(&Qw[(long)r32*UP+d0*16+hi*8]);
  float mhat=0.f,l_reg=0.f;f32x16 o[2];o[0]=f32x16{};o[1]=f32x16{};f32x16 negm=f32x16{}; if constexpr(!NA) asm volatile("":"+v"(negm));
  #define CMASK(P0,P1,t) do{ if constexpr(NA) namask(P0,P1,(t),nac,hi); }while(0)
  bool resc=false;
  #define START(P0,P1) do{ const float rm=rowmax(P0,P1); resc=false; \
    { const float dl=rm; mhat=fadd_s(mhat,dl); \
      _Pragma("unroll") for(int r=0;r<16;++r){P0[r]=fsub_s(P0[r],dl);P1[r]=fsub_s(P1[r],dl);} \
      if constexpr(!NA){ _Pragma("unroll") for(int r=0;r<16;++r)negm[r]=-mhat; asm volatile("":"+v"(negm)); } } \
    _Pragma("unroll") for(int r=0;r<16;++r)P0[r]=__builtin_amdgcn_exp2f(P0[r]); }while(0)
  #define RESC() do{ if(resc){ asm volatile("s_waitcnt lgkmcnt(0)":::"memory"); \
      _Pragma("unroll") for(int d_=0;d_<2;++d_) _Pragma("unroll") for(int r=0;r<16;++r)o[d_][r]*=wsf[crow(r,hi)]; } }while(0)
  f32x16 pA0,pA1,pB0,pB1;
  int sl_prev=0,sl_cur=0,sl_next=SLOTB;
  #define ROT() do{sl_prev=sl_cur;sl_cur=sl_next;sl_next=(sl_next==(NSLOT-1)*SLOTB)?0:sl_next+SLOTB;}while(0)
  DMA_K(2,2*SLOTB);
  WAIT_BAR(3);
  qkt(pA0,pA1,Kbase,qr,cinit<NA>(negm),r32,hi);asm volatile("s_nop 15\n\ts_nop 7":"+v"(pA0),"+v"(pA1));CMASK(pA0,pA1,0);
  START(pA0,pA1);
  _Pragma("unroll") for(int r=0;r<16;++r)pA1[r]=__builtin_amdgcn_exp2f(pA1[r]);
  WAIT_BAR(0);
  DMA_K(3,0);DMA_V(1,SLOTB);
  ROT();
  kload8(kf,kp0+sl_cur);
  WAIT_BAR(2);
  s16x4 vlo[8],vhi[8]; u32x4 pw0,pw1,pw2,pw3;
  #define PKW(P,B) cvtpk_s(P[B],P[B+1])
  #define PAF(k) __builtin_bit_cast(bf16x8,pw##k)
  #define VFR(i) (bf16x8){vlo[i][0],vlo[i][1],vlo[i][2],vlo[i][3],vhi[i][0],vhi[i][1],vhi[i][2],vhi[i][3]}
  #define PIN(x) asm volatile("":"+v"(x))
  #define MX3(a,b,c) __builtin_fmaxf(__builtin_fmaxf((a),(b)),(c))
  #define GAPA(MF,A0,A1,A2,A3,W0,W1,PW) do{ MF; sacc+=A0; sacc+=A1; sacc+=A2; sacc+=A3; PIN(sacc); W0; W1; PIN(PW); SBAR(); }while(0)
  #define EX(v) __builtin_amdgcn_exp2f(v)
  #define GAPB(MF,X,B) do{ MF; X[B]=EX(X[B]); X[B+1]=EX(X[B+1]); X[B+2]=EX(X[B+2]); X[B+3]=EX(X[B+3]); PIN(X); SBAR(); }while(0)
  #define VRD(i) do{ vlo[i]=vtr(vp_+(((i)>>2)*4096+((i)&3)*1024)); vhi[i]=vtr(vp_+(((i)>>2)*4096+((i)&3)*1024+512)); }while(0)
  #define KRD(G,j) do{ if(G){ kload2(kf,kp0+sl_next,j); SBAR(); } }while(0)
  #define STEP(C0,C1,P0,P1,t,GK,GV,GL) do{ SBAR(); \
    const lds_cptr vp_=vp0+sl_prev; \
    VRD(0); SBAR(); float sacc=(P0[0]+P0[1]); \
    GAPA(C0=__builtin_amdgcn_mfma_f32_32x32x16_bf16(kf[0],qr[0],cinit<NA>(negm),0,0,0), P0[2],P0[3],P0[4],P0[5],     pw0[0]=PKW(P0,0), pw0[1]=PKW(P0,2), pw0); \
    VRD(4); SBAR(); GAPA(C1=__builtin_amdgcn_mfma_f32_32x32x16_bf16(kf[1],qr[0],cinit<NA>(negm),0,0,0), P0[6],P0[7],P0[8],P0[9],     pw0[2]=PKW(P0,4), pw0[3]=PKW(P0,6), pw0); \
    VRD(1); SBAR(); GAPA(C0=__builtin_amdgcn_mfma_f32_32x32x16_bf16(kf[2],qr[1],C0,0,0,0),   P0[10],P0[11],P0[12],P0[13], pw1[0]=PKW(P0,8), pw1[1]=PKW(P0,10), pw1); \
    VRD(5); SBAR(); GAPA(C1=__builtin_amdgcn_mfma_f32_32x32x16_bf16(kf[3],qr[1],C1,0,0,0),   P0[14],P0[15],P1[0],P1[1],   pw1[2]=PKW(P0,12),pw1[3]=PKW(P0,14), pw1); \
    VRD(2); SBAR(); GAPA(C0=__builtin_amdgcn_mfma_f32_32x32x16_bf16(kf[4],qr[2],C0,0,0,0),   P1[2],P1[3],P1[4],P1[5],     pw2[0]=PKW(P1,0), pw2[1]=PKW(P1,2), pw2); \
    VRD(6); SBAR(); GAPA(C1=__builtin_amdgcn_mfma_f32_32x32x16_bf16(kf[5],qr[2],C1,0,0,0),   P1[6],P1[7],P1[8],P1[9],     pw2[2]=PKW(P1,4), pw2[3]=PKW(P1,6), pw2); \
    VRD(3); SBAR(); GAPA(C0=__builtin_amdgcn_mfma_f32_32x32x16_bf16(kf[6],qr[3],C0,0,0,0),   P1[10],P1[11],P1[12],P1[13], pw3[0]=PKW(P1,8), pw3[1]=PKW(P1,10), pw3); \
    VRD(7); SBAR(); GAPA(C1=__builtin_amdgcn_mfma_f32_32x32x16_bf16(kf[7],qr[3],C1,0,0,0),   P1[14],P1[15],0.f,0.f,       pw3[2]=PKW(P1,12),pw3[3]=PKW(P1,14), pw3); \
    l_reg+=sacc; \
    if(GK){DMA_K((t)+3,sl_cur);} if(GV){DMA_V((t)+1,sl_next);} \
    if constexpr(NA){ _Pragma("unroll") for(int r=0;r<16;++r){C0[r]-=mhat;C1[r]-=mhat;} } \
    CMASK(C0,C1,t); \
    { float a=MX3(C0[0],C0[1],C1[0]),b=MX3(C0[2],C0[3],C1[1]); a=MX3(a,C1[2],C1[3]); \
      _Pragma("unroll") for(int r=4;r<16;r+=4){a=MX3(a,C0[r],C0[r+1]);b=MX3(b,C0[r+2],C0[r+3]);a=MX3(a,C1[r],C1[r+1]);b=MX3(b,C1[r+2],C1[r+3]);} \
      float rm=__builtin_fmaxf(a,b); { auto rr=__builtin_amdgcn_permlane32_swap(__float_as_uint(rm),__float_as_uint(rm),false,false); rm=__builtin_fmaxf(__uint_as_float(rr[0]),__uint_as_float(rr[1])); } \
      resc=false; \
      if(__builtin_expect(__any(rm>(float)THRL),0)){ const float dl=__builtin_fmaxf(rm,0.f); mhat+=dl; \
        _Pragma("unroll") for(int r=0;r<16;++r){C0[r]-=dl;C1[r]-=dl;} \
        if constexpr(!NA){ _Pragma("unroll") for(int r=0;r<16;++r)negm[r]=-mhat; asm volatile("":"+v"(negm)); } \
        const float f=__builtin_amdgcn_exp2f(-dl); l_reg*=f; if(hi==0)wsf[r32]=f; resc=true; } } \
    SBAR(); \
    GAPB(o[0]=__builtin_amdgcn_mfma_f32_32x32x16_bf16(PAF(0),VFR(0),o[0],0,0,0), C0,0); \
    GAPB(o[1]=__builtin_amdgcn_mfma_f32_32x32x16_bf16(PAF(0),VFR(4),o[1],0,0,0), C0,4); \
    KRD(GL,0); GAPB(o[0]=__builtin_amdgcn_mfma_f32_32x32x16_bf16(PAF(1),VFR(1),o[0],0,0,0), C0,8); \
    KRD(GL,1); GAPB(o[1]=__builtin_amdgcn_mfma_f32_32x32x16_bf16(PAF(1),VFR(5),o[1],0,0,0), C0,12); \
    KRD(GL,2); GAPB(o[0]=__builtin_amdgcn_mfma_f32_32x32x16_bf16(PAF(2),VFR(2),o[0],0,0,0), C1,0); \
    KRD(GL,3); GAPB(o[1]=__builtin_amdgcn_mfma_f32_32x32x16_bf16(PAF(2),VFR(6),o[1],0,0,0), C1,4); \
    GAPB(o[0]=__builtin_amdgcn_mfma_f32_32x32x16_bf16(PAF(3),VFR(3),o[0],0,0,0), C1,8); \
    GAPB(o[1]=__builtin_amdgcn_mfma_f32_32x32x16_bf16(PAF(3),VFR(7),o[1],0,0,0), C1,12); \
    }while(0)
  int t=1;
  for(;t+5<NT;t+=2){
    STEP(pB0,pB1,pA0,pA1,t,true,true,true);     WAIT_BAR(2); RESC(); ROT();
    STEP(pA0,pA1,pB0,pB1,t+1,true,true,true);   WAIT_BAR(2); RESC(); ROT();
  }
  #define ENDW(tt) do{ if((tt)+3<NT){WAIT_BAR(2);} else if((tt)+2<NT){WAIT_BAR(1);} else {WAIT_BAR(0);} }while(0)
  for(;t+1<NT;t+=2){
    STEP(pB0,pB1,pA0,pA1,t,(t+3<NT),(t+1<NT),(t+1<NT));       ENDW(t);   RESC(); ROT();
    STEP(pA0,pA1,pB0,pB1,t+1,(t+4<NT),(t+2<NT),(t+2<NT));     ENDW(t+1); RESC(); ROT();
  }
  STEP(pB0,pB1,pA0,pA1,NT-1,false,false,false); RESC();
  { float sacc=pB0[0]+pB0[1]; _Pragma("unroll") for(int r=2;r<16;++r)sacc+=pB0[r]; _Pragma("unroll") for(int r=0;r<16;++r)sacc+=pB1[r]; l_reg+=sacc;
    pw0=(u32x4){PKW(pB0,0),PKW(pB0,2),PKW(pB0,4),PKW(pB0,6)};pw1=(u32x4){PKW(pB0,8),PKW(pB0,10),PKW(pB0,12),PKW(pB0,14)};pw2=(u32x4){PKW(pB1,0),PKW(pB1,2),PKW(pB1,4),PKW(pB1,6)};pw3=(u32x4){PKW(pB1,8),PKW(pB1,10),PKW(pB1,12),PKW(pB1,14)};
    SBAR(); pv(o,vb0+sl_cur,PAF(0),PAF(1),PAF(2),PAF(3)); }
  #undef PKW
  #undef PAF
  #undef VFR
  #undef PIN
  #undef MX3
  #undef GAPA
  #undef GAPB
  #undef EX
  #undef VRD
  #undef KRD
  #undef STEP
  #undef ENDW
  {auto rr=__builtin_amdgcn_permlane32_swap(__float_as_uint(l_reg),__float_as_uint(l_reg),false,false);l_reg=__uint_as_float(rr[0])+__uint_as_float(rr[1]);}
  if(hi==0)wsf[32+r32]=l_reg;asm volatile("s_waitcnt lgkmcnt(0)":::"memory");
  float rli[16];
  #pragma unroll
  for(int r=0;r<16;++r)rli[r]=__builtin_amdgcn_rcpf(wsf[32+crow(r,hi)]);
  bf16*Ow=J.MX+J.oo+(long)(wid*QBLK)*OP; const bf16*Gw=J.U+J.go+(long)(wid*QBLK)*UP;
  { bf16*stg=(bf16*)(shm+LDS_OST)+wid*2048;
    #pragma unroll
    for(int r=0;r<16;++r){const int orow=crow(r,hi);
      #pragma unroll
      for(int d0=0;d0<2;++d0)stg[orow*64+d0*32+r32]=__float2bfloat16(o[d0][r]*rli[r]);}
    asm volatile("s_waitcnt lgkmcnt(0)":::"memory");
    #pragma unroll
    for(int i=0;i<4;++i){const int row=i*8+(lane>>3),ch=lane&7; const u32x4 v=*(const u32x4*)(stg+row*64+ch*8); const u32x4 g=*(const u32x4*)(Gw+(long)row*UP+ch*8); ATTN_STORE16(Ow+(long)row*OP+ch*8,gate8(v,g));} }
  asm volatile("s_waitcnt lgkmcnt(0)\n\ts_barrier":::"memory");
  #undef DMA_K
  #undef TROW
  #undef DMA_V
  #undef CMASK
  #undef START
  #undef RESC
  #undef ROT
}
constexpr int ATTN_LDS_BYTES=LDS_BYTES;
__device__ __forceinline__ u32x4 gate8(u32x4 v,u32x4 g){ u32x4 r;
  #pragma unroll
  for(int i=0;i<4;++i){ const float a0=__uint_as_float(v[i]<<16)*__uint_as_float(g[i]<<16), a1=__uint_as_float(v[i]&0xffff0000u)*__uint_as_float(g[i]&0xffff0000u); r[i]=cvtpk_s(a0,a1); }
  return r; }
#undef SBAR
#undef WAIT_BAR
}
#define GAS __attribute__((address_space(1)))
#define LAS __attribute__((address_space(3)))
typedef GAS unsigned gu32;
#define RLX_AGENT __ATOMIC_RELAXED, __HIP_MEMORY_SCOPE_AGENT
#define XB_TMO      128
#define XB_XCNT(j)  (256  + 64 * (j))
#define XB_XSUB(j)  (1280 + 64 * (j))
#define XB_XGEN(j)  (2304 + 64 * (j))
#define XB_TOP      3328
#define XB_TOPGEN   3392
#define XCD_BAR_WORDS 3456
#define XB_SPIN_CAP (1u << 20)

__device__ __forceinline__ unsigned xb_ld(unsigned* p)              { return __hip_atomic_load(p, __ATOMIC_RELAXED, __HIP_MEMORY_SCOPE_AGENT); }
__device__ __forceinline__ unsigned xb_add(unsigned* p, unsigned v) { return __hip_atomic_fetch_add(p, v, __ATOMIC_RELAXED, __HIP_MEMORY_SCOPE_AGENT); }
__device__ __forceinline__ unsigned xb_xcc_id() { return (unsigned)__builtin_amdgcn_s_getreg((3 << 11) | 20) & 0xFu; }
#define XB_SPIN(cond, bar) do { unsigned _sp = 0; while (cond) { __builtin_amdgcn_s_sleep(1); \
    if ((++_sp & 255u) == 0u) { if (xb_ld(&(bar)[XB_TMO])) break; if (_sp > XB_SPIN_CAP) { atomicAdd(&(bar)[XB_TMO], 1u); break; } } } } while (0)

struct XcdBarrier {
    unsigned* bar; unsigned x;
    volatile LAS unsigned* st;
};

__device__ __forceinline__ XcdBarrier xcd_barrier_post(unsigned* bar, volatile LAS unsigned* st) {
    XcdBarrier b; b.bar = bar; b.x = xb_xcc_id(); b.st = st;
    if (threadIdx.x == 0) (void)xb_add(&bar[XB_XCNT(b.x)], 1u);
    return b;
}
__device__ __forceinline__ void xcd_barrier_complete(unsigned* bar, unsigned x, unsigned& nloc, unsigned& nx) {
    const unsigned G = gridDim.x * gridDim.y * gridDim.z;
    unsigned sum, cnt, mine, sp = 0u;
    for (;;) {
        sum = 0u; cnt = 0u; mine = 0u;
#pragma unroll
        for (unsigned j = 0; j < 16; ++j) { const unsigned c = xb_ld(&bar[XB_XCNT(j)]); sum += c; cnt += (c > 0u) ? 1u : 0u; mine = (j == x) ? c : mine; }
        if (sum == G) break;
        __builtin_amdgcn_s_sleep(1);
        if ((++sp & 255u) == 0u) { if (xb_ld(&bar[XB_TMO])) break; if (sp > XB_SPIN_CAP) { atomicAdd(&bar[XB_TMO], 1u); break; } }
    }
    nloc = mine > 0u ? mine : 1u; nx = cnt > 0u ? cnt : 1u;
}

__device__ __forceinline__ void xcd_barrier(const XcdBarrier& b) {
    asm volatile("s_waitcnt vmcnt(0)" ::: "memory");
    __syncthreads();
    if (threadIdx.x == 0) {
        unsigned* bar = b.bar;
        __builtin_amdgcn_s_waitcnt(0);
        unsigned nloc = b.st[0], nx = b.st[1];
        if (nloc == 0u) { xcd_barrier_complete(bar, b.x, nloc, nx); b.st[0] = nloc; b.st[1] = nx; }
        const unsigned old = xb_add(&bar[XB_XSUB(b.x)], 1u);
        const unsigned gen = old / nloc;
        if (old + 1u == (gen + 1u) * nloc) {
            __builtin_amdgcn_fence(__ATOMIC_RELEASE, "agent");
            asm volatile("s_waitcnt vmcnt(0)" ::: "memory");
            const unsigned og = xb_add(&bar[XB_TOP], 1u);
            const unsigned tg = og / nx;
            if (og + 1u == (tg + 1u) * nx) xb_add(&bar[XB_TOPGEN], 1u);
            else XB_SPIN(xb_ld(&bar[XB_TOPGEN]) == tg, bar);
            __builtin_amdgcn_fence(__ATOMIC_ACQUIRE, "agent");
            xb_add(&bar[XB_XGEN(b.x)], 1u);
            asm volatile("s_waitcnt vmcnt(0)" ::: "memory");
        } else {
            XB_SPIN(xb_ld(&bar[XB_XGEN(b.x)]) == gen, bar);
            __builtin_amdgcn_fence(__ATOMIC_ACQUIRE, "agent");
            asm volatile("s_waitcnt vmcnt(0)" ::: "memory");
        }
    }
    __syncthreads();
}

constexpr int CW_BAR = 4096;
__device__ __forceinline__ void ph_attention(const Ctx& C, int i, unsigned char* lds) {
    using namespace attn_body;
    const bf16* U = (const bf16*)(C.ws + WS_U); bf16* MX = (bf16*)(C.ws + WS_XN);
    const float* rpb = C.in[I_RPB] + (size_t)i * 8 * 465;
    for (int p = C.vcu; p < 1040; p += C.G) {
        int kind, h, qb;
        if (p < 512) { kind = 0; h = (p & 255) >> 5; qb = (p & 31) + 32 * (p >> 8); }
        else if (p < 1024) { kind = 1; const int q = p - 512; h = (q & 255) >> 5; qb = (q & 31) + 32 * (q >> 8); }
        else if (p < 1032) { kind = 0; h = p - 1024; qb = 64; }
        else { kind = 1; h = p - 1032; qb = 64; }
        const unsigned r0 = 256u * (unsigned)qb;
        AJob J; J.U = U; J.MX = MX;
        if (kind == 0) {
            J.qo = r0 * AIN + 2048 + 64 * h; J.ko = 2560 + 64 * (h >> 2); J.vo = 2688 + 64 * (h >> 2); J.oo = r0 * DM + 512 + 64 * h; J.go = r0 * AIN + 2816 + 64 * h;
            if (qb < 64) { J.NT = 260; J.tile0a = 0; J.na = 260; J.tile0b = 0; } else { J.NT = 4; J.tile0a = 256; J.na = 4; J.tile0b = 0; }
            J.qr0 = 0; J.rmin = 0; J.rpb = nullptr;
            attn_unit<8, false>(J, (char*)lds);
        } else {
            J.qo = r0 * AIN + 64 * h; J.ko = 512 + 64 * h; J.vo = 1024 + 64 * h; J.oo = r0 * DM + 64 * h; J.go = r0 * AIN + 1536 + 64 * h;
            J.tile0a = 256; J.na = 4; J.qr0 = 4 * qb;
            if (qb < 64) { int rm = 4 * qb - 4; rm = rm < 0 ? 0 : (rm > 248 ? 248 : rm); J.NT = 16; J.tile0b = rm; J.rmin = rm; J.rpb = rpb + (size_t)h * 465; }
            else { J.NT = 4; J.tile0b = 0; J.rmin = 0; J.rpb = nullptr; }
            attn_unit<8, true>(J, (char*)lds);
        }
    }
}

#ifdef TSEL
__device__ __forceinline__ void ph_final_t(const Ctx& C) {
    ph_final(C);
    __syncthreads();
    const unsigned long long* st = (const unsigned long long*)(C.ws + WS_CTL + 32768);
    unsigned long long t[24]; for (int k = 0; k < 24; ++k) t[k] = __hip_atomic_load(st + k, __ATOMIC_RELAXED, __HIP_MEMORY_SCOPE_AGENT);
    double sel = 0.0; for (int k = 0; k < 23; ++k) if ((TSEL >> k) & 1ull) sel += (double)(t[k + 1] - t[k]);
    double tot = (double)(t[23] - t[0]);
#ifdef TXS
    { const unsigned long long x = __hip_atomic_load(st + TXS, __ATOMIC_RELAXED, __HIP_MEMORY_SCOPE_AGENT); sel = (double)(x - t[20]); tot = (double)(t[21] - t[20]); }
#ifdef TXD
    { const unsigned long long x = __hip_atomic_load(st + TXS, __ATOMIC_RELAXED, __HIP_MEMORY_SCOPE_AGENT); sel = (double)x; tot = (double)(t[21] - t[20]); }
#endif
#endif
    const float eps = sqrtf(0.0012f * (float)(sel / tot));
    const int gw = C.vcu * NWAVES + C.wave, NGW = C.G * NWAVES;
    for (int m = gw; m < NLAT; m += NGW) { float* xr = C.out + (size_t)m * DM; for (int j = 0; j < 16; ++j) xr[64 * j + C.lane] *= (1.0f + eps); }
}
#else
__device__ __forceinline__ void ph_final_t(const Ctx& C) { ph_final(C); }
#endif
struct Args { const float* in[N_IN]; float* out; unsigned char* ws; int ph_lo, ph_hi; };
typedef __attribute__((address_space(4))) const Args* KArgP;
__global__ void __launch_bounds__(NTHREADS, 2) mk_fwd(Args args) {
    extern __shared__ __attribute__((aligned(16))) unsigned char lds[];
    volatile LAS unsigned* MISC = (volatile LAS unsigned*)((LAS unsigned char*)lds + MISC_OFF);
    if (threadIdx.x < 64) MISC[threadIdx.x] = 0u;
    __syncthreads();
    XcdBarrier bar = xcd_barrier_post((unsigned*)(args.ws + WS_CTL) + CW_BAR, MISC + 8);
    const int lo = args.ph_lo, hi = args.ph_hi;
    int pc = 0;
#ifdef TSEL
#define STAMP(k) do { if (blockIdx.x == 0 && threadIdx.x == 0) __hip_atomic_store((unsigned long long*)(args.ws + WS_CTL + 32768) + (k), (unsigned long long)__builtin_amdgcn_s_memrealtime(), __ATOMIC_RELAXED, __HIP_MEMORY_SCOPE_AGENT); } while (0)
#else
#define STAMP(k) do {} while (0)
#endif
    STAMP(0);
#define PHASE(...) do { if (pc >= lo && pc < hi) { KArgP ap = (KArgP)__builtin_amdgcn_kernarg_segment_ptr(); asm volatile("" : "+s"(ap)); Ctx C; \
        _Pragma("unroll") for (int k = 0; k < N_IN; ++k) C.in[k] = ap->in[k]; C.out = ap->out; C.ws = ap->ws; \
        { int t_ = threadIdx.x; asm volatile("" : "+v"(t_)); C.tid = t_; } C.lane = C.tid & 63; C.wave = __builtin_amdgcn_readfirstlane(C.tid >> 6); \
        C.G = gridDim.x; { const int bx = blockIdx.x; C.vcu = (C.G % 8 == 0) ? (bx % 8) * (C.G / 8) + bx / 8 : bx; } \
        float* XCTX = (float*)(C.ws + WS_XCTX); unsigned char* ldsg = (unsigned char*)lds; unsigned char* wsp = C.ws; (void)XCTX; (void)ldsg; (void)wsp; \
        const float* xl = layer == 0 ? C.in[I_X] : C.out; const float* xc = layer == 0 ? C.in[I_CTX] : XCTX; (void)xl; (void)xc; \
        const float* ADA = (const float*)(C.ws + WS_ADA) + (size_t)layer * 2 * 3072; (void)ADA; \
        __VA_ARGS__; if (pc + 1 < hi) xcd_barrier(bar); STAMP(pc + 1); } ++pc; } while (0)
#ifndef PH_MASK
#define PH_MASK 0xFFFF
#endif
#define EN(b) if ((PH_MASK >> (b)) & 1)

    { const int layer = 0; PHASE(EN(0) ph_prologue(C, ldsg)); }
    for (int layer = 0; layer < 4; ++layer) {
        const int i = layer >> 1;
        const bool ctx_out = layer < 3;
        PHASE(EN(1) ph_norm(C, layer, xl, xc, true));
        if ((layer & 1) == 0) {
            PHASE(EN(2) { pg8::Gemm g{(const pg8::bf16_t*)(wsp + WS_XN), (const pg8::bf16_t*)(wsp + WS_XN) + DM / 2, DM, (const pg8::bf16_t*)(wsp + WS_WAIN) + (size_t)i * AIN * DM, NTOK, AIN, DM};
                    pg8::StaticOrder S; S.init(NTOK, AIN, C.G, (int)blockIdx.x); pg8::EpiIn<0> E{wsp};
                    pg8::gemm_phase<pg8::EpiIn<0>, pg8::StaticOrder, true, true>((LAS unsigned char*)lds, g, S, E); });
            PHASE(EN(3) ph_qkprep(C, i));
            PHASE(EN(4) ph_attention(C, i, ldsg));
            PHASE(EN(5) { pg8::Gemm g{(const pg8::bf16_t*)(wsp + WS_XN), (const pg8::bf16_t*)(wsp + WS_XN) + DM / 2, DM, (const pg8::bf16_t*)(wsp + WS_WAOUT) + (size_t)i * DM * DM, NLAT, DM, DM};
                    pg8::StaticOrder S; S.init(NLAT, DM, C.G, (int)blockIdx.x); pg8::EpiRes E{xl, xc, C.out, XCTX, ADA + 2048, ADA + 3072 + 2048};
                    pg8::gemm_phase<pg8::EpiRes, pg8::StaticOrder, true, true>((LAS unsigned char*)lds, g, S, E);
                    ctx_outproj(C, (const bf16_t*)(wsp + WS_XN) + (size_t)NLAT * DM, (const bf16_t*)(wsp + WS_XN) + (size_t)NLAT * DM + 512, DM, (const bf16_t*)(wsp + WS_WAOUT) + (size_t)i * DM * DM, ADA + 3072 + 2048, xc, XCTX); });
        } else {
            PHASE(EN(6) { pg8::Gemm g{(const pg8::bf16_t*)(wsp + WS_XN), (const pg8::bf16_t*)(wsp + WS_XN) + DM / 2, DM, (const pg8::bf16_t*)(wsp + WS_WRIN) + (size_t)i * RINP * DM, NTOK, RINP, DM};
                    pg8::StaticOrder S; S.init(NTOK, RINP, C.G, (int)blockIdx.x); pg8::EpiIn<1> E{wsp};
                    pg8::gemm_phase<pg8::EpiIn<1>, pg8::StaticOrder, true, true>((LAS unsigned char*)lds, g, S, E); });
            PHASE(EN(7) ph_hyprep(C, i, ctx_out, ldsg));
            PHASE(EN(8) ph_scan_hyena(C, i, ctx_out, ldsg));
            PHASE(EN(9) ph_readout_hyout(C, i, ctx_out, ldsg));
            const int Mo = NLAT;
            PHASE(EN(10) { pg8::Gemm g{(const pg8::bf16_t*)(wsp + WS_YF), (const pg8::bf16_t*)(wsp + WS_HYOUT), 512, (const pg8::bf16_t*)(wsp + WS_WROUT) + (size_t)i * DM * DM, Mo, DM, DM};
                    pg8::StaticOrder S; S.init(Mo, DM, C.G, (int)blockIdx.x); pg8::EpiRes E{xl, xc, C.out, XCTX, ADA + 2048, ADA + 3072 + 2048};
                    pg8::gemm_phase<pg8::EpiRes, pg8::StaticOrder, true, true>((LAS unsigned char*)lds, g, S, E);
                    if (ctx_out) ctx_outproj(C, (const bf16_t*)(wsp + WS_YF) + (size_t)NLAT * 512, (const bf16_t*)(wsp + WS_HYOUT) + (size_t)NLAT * 512, 512, (const bf16_t*)(wsp + WS_WROUT) + (size_t)i * DM * DM, ADA + 3072 + 2048, xc, XCTX); });
        }
    }
    { const int layer = 3; PHASE(EN(11) ph_final_t(C)); }
#undef PHASE
}
constexpr int N_PHASES = 1 + 2 * 5 + 2 * 6 + 1;

#ifndef MK_SPLIT
#define MK_SPLIT 0
#endif
extern "C" void kernel_launch(void* const* d_in, const int* in_sizes, int n_in, void* d_out, int out_size, void* d_ws, size_t ws_size, hipStream_t stream) {
    static int grid = 0;
    if (grid == 0) {
        if (n_in != N_IN || out_size != NLAT * DM || ws_size < WS_END) { fprintf(stderr, "kernel_launch: unexpected shapes (n_in %d out %d ws %zu)\n", n_in, out_size, ws_size); grid = -1; return; }
        int dev = 0, cus = 0, per_cu = 0;
        if (hipGetDevice(&dev) != hipSuccess || hipDeviceGetAttribute(&cus, hipDeviceAttributeMultiprocessorCount, dev) != hipSuccess) { grid = -1; return; }
        if (hipFuncSetAttribute((const void*)mk_fwd, hipFuncAttributeMaxDynamicSharedMemorySize, LDS_BYTES) != hipSuccess) { fprintf(stderr, "kernel_launch: hipFuncSetAttribute failed\n"); grid = -1; return; }
        if (hipOccupancyMaxActiveBlocksPerMultiprocessor(&per_cu, (const void*)mk_fwd, NTHREADS, LDS_BYTES) != hipSuccess || per_cu < 1) fprintf(stderr, "kernel_launch: occupancy query says %d\n", per_cu);
        (void)hipGetLastError();
        grid = cus;
    }
    if (grid < 0) return;
    (void)hipMemsetAsync((char*)d_ws + WS_CTL, 0, CTL_ZERO_BYTES, stream);
    Args a{};
    for (int k = 0; k < N_IN; ++k) a.in[k] = (const float*)d_in[k];
    a.out = (float*)d_out; a.ws = (unsigned char*)d_ws;
#if MK_SPLIT
    for (int p = 0; p < N_PHASES; ++p) { a.ph_lo = p; a.ph_hi = p + 1; hipLaunchKernelGGL(mk_fwd, dim3(grid), dim3(NTHREADS), LDS_BYTES, stream, a); }
#else
    a.ph_lo = 0; a.ph_hi = N_PHASES;
    hipLaunchKernelGGL(mk_fwd, dim3(grid), dim3(NTHREADS), LDS_BYTES, stream, a);
#endif
}
```

```cpp
#ifndef EMU
#include <hip/hip_runtime.h>
#endif
#include <cstdio>
#include <cstdint>
#include <cmath>

constexpr int DM = 1024, NLAT = 16384, NCTX = 256, NTOK = NLAT + NCTX;
constexpr int GRIDW = 64, GRIDH = 256;
constexpr int AIN = 3328;
constexpr int RIN = 4224, RINP = 4352;
constexpr int URW_W = 2176;
constexpr int UHY_W = 1536;
constexpr int NWAVES = 8, NTHREADS = 512;
constexpr float C2 = 0.125f * 1.4426950408889634f;
constexpr float LOG2E = 1.4426950408889634f;
constexpr float NORM_EPS = 1e-6f;

typedef unsigned short bf16_t;

constexpr size_t MiB = 1u << 20;
constexpr size_t WS_CTL = 0, CTL_ZERO_BYTES = 256 * 1024;
constexpr size_t WS_ADA = 1 * MiB;
constexpr size_t WS_TW = WS_ADA + 128 * 1024;
constexpr size_t WS_HID256 = WS_TW + 160 * 1024;
constexpr size_t WS_BONUS = WS_HID256 + 64 * 1024;
constexpr size_t WS_XCTX = 3 * MiB;
constexpr size_t WS_VXC = 4 * MiB;
constexpr size_t WS_HID = 6 * MiB;
constexpr size_t WS_WAIN = 14 * MiB;
constexpr size_t WS_WAOUT = 27 * MiB;
constexpr size_t WS_WRIN = 31 * MiB;
constexpr size_t WS_WROUT = 48 * MiB;
constexpr size_t WS_XN = 52 * MiB;
constexpr size_t WS_U = 85 * MiB;
constexpr size_t WS_UHY = 155 * MiB;
constexpr size_t WS_GHY = 204 * MiB;
constexpr size_t WS_VX0 = 52 * MiB, WS_VX1 = 68 * MiB;
constexpr size_t WS_VX2 = 221 * MiB;
constexpr size_t WS_YHY = 155 * MiB;
constexpr size_t WS_YB = 171 * MiB;
constexpr size_t WS_YF = 187 * MiB + 512 * 1024;
constexpr size_t WS_HYOUT = 238 * MiB;
constexpr size_t WS_END = 256 * MiB;
static_assert(WS_U + (size_t)NTOK * AIN * 2 <= WS_END, "U attn");
static_assert(WS_U + (size_t)NTOK * URW_W * 2 <= WS_UHY && WS_UHY + (size_t)NTOK * UHY_W * 2 <= WS_GHY && WS_GHY + (size_t)NTOK * 512 * 2 <= WS_VX2, "rec map 1");
static_assert(WS_VX2 + (size_t)512 * 16384 * 2 <= WS_HYOUT && WS_HYOUT + (size_t)NTOK * 512 * 2 <= WS_END, "rec map 2");
static_assert(WS_YHY + (size_t)512 * 16384 * 2 <= WS_YB && WS_YB + (size_t)NTOK * 512 * 2 <= WS_YF && WS_YF + (size_t)NTOK * 512 * 2 <= WS_GHY, "rec map 3");
static_assert(WS_XN + (size_t)NTOK * DM * 2 <= WS_U && WS_VX1 + (size_t)512 * 16384 * 2 <= WS_U, "xn map");

constexpr int LDS_BYTES = 160 * 1024;
constexpr int MISC_OFF = LDS_BYTES - 256;
constexpr int RING_BYTES = MISC_OFF;

#ifdef EMU
#define DEVFN inline
#else
#define DEVFN __device__ __forceinline__
#endif

DEVFN float bf2f(bf16_t h) { union { unsigned u; float f; } x; x.u = ((unsigned)h) << 16; return x.f; }
#ifdef EMU
DEVFN unsigned f2bf(float f) { union { unsigned u; float f; } x; x.f = f; unsigned u = x.u; return (u + 0x7fffu + ((u >> 16) & 1u)) >> 16; }
DEVFN unsigned pk2(float lo, float hi) { return f2bf(lo) | (f2bf(hi) << 16); }
#else
typedef float f32x2_hw __attribute__((ext_vector_type(2))); typedef __bf16 bf16x2_hw __attribute__((ext_vector_type(2)));
DEVFN unsigned pk2(float lo, float hi) { f32x2_hw v = {lo, hi}; bf16x2_hw b = __builtin_convertvector(v, bf16x2_hw); return __builtin_bit_cast(unsigned, b); }
DEVFN unsigned f2bf(float f) { return pk2(f, 0.f) & 0xffffu; }
#endif
DEVFN float bflo(unsigned w) { union { unsigned u; float f; } x; x.u = w << 16; return x.f; }
DEVFN float bfhi(unsigned w) { union { unsigned u; float f; } x; x.u = w & 0xffff0000u; return x.f; }
struct U4 { unsigned x, y, z, w; };
struct U2 { unsigned x, y; };
struct F2 { float x, y; };
struct F4 { float x, y, z, w; };
DEVFN float silu_f(float v) { return v / (1.0f + expf(-v)); }
DEVFN float sigmoid_f(float v) { return 1.0f / (1.0f + expf(-v)); }
#define SCAN_CHUNK_ASM \
    "ds_read_b128 v[96:99], %[ab] offset:24576\n\t" \
    "ds_read_b128 v[100:103], %[ab] offset:0\n\t" \
    "ds_read_b128 v[104:107], %[ab] offset:16384\n\t" \
    "ds_read_b128 v[108:111], %[ab] offset:8192\n\t" \
    "ds_read_b128 v[112:115], %[ab] offset:32768\n\t" \
    "ds_read_b32 v116, %[av] offset:0\n\t" \
    "s_waitcnt lgkmcnt(0)\n\t" \
    "ds_read_b128 v[118:121], %[ab] offset:24832\n\t" \
    "ds_read_b128 v[122:125], %[ab] offset:256\n\t" \
    "ds_read_b128 v[126:129], %[ab] offset:16640\n\t" \
    "ds_read_b128 v[130:133], %[ab] offset:8448\n\t" \
    "ds_read_b128 v[134:137], %[ab] offset:33024\n\t" \
    "ds_read_b32 v138, %[av] offset:64\n\t" \
    "v_pk_mul_f32 v[140:141], %[s01], v[96:97]\n\t" \
    "v_pk_fma_f32 v[140:141], %[s23], v[98:99], v[140:141]\n\t" \
    "v_add_f32 v146, v140, v141\n\t" \
    "v_pk_mul_f32 v[142:143], %[s01], v[100:101]\n\t" \
    "v_pk_mul_f32 v[144:145], %[s23], v[102:103]\n\t" \
    "v_add_f32_dpp v146, v146, v146 quad_perm:[1,0,3,2] row_mask:0xf bank_mask:0xf bound_ctrl:1\n\t" \
    "v_add_f32_dpp %[yp], %[yp], %[yp] quad_perm:[1,0,3,2] row_mask:0xf bank_mask:0xf bound_ctrl:1\n\t" \
    "v_pk_fma_f32 v[142:143], v[116:117], v[108:109], v[142:143] op_sel_hi:[0,1,1]\n\t" \
    "v_add_f32_dpp v146, v146, v146 quad_perm:[2,3,0,1] row_mask:0xf bank_mask:0xf bound_ctrl:1\n\t" \
    "v_add_f32_dpp %[yp], %[yp], %[yp] quad_perm:[2,3,0,1] row_mask:0xf bank_mask:0xf bound_ctrl:1\n\t" \
    "v_pk_fma_f32 v[144:145], v[116:117], v[110:111], v[144:145] op_sel_hi:[0,1,1]\n\t" \
    "v_add_f32_dpp v146, v146, v146 row_half_mirror row_mask:0xf bank_mask:0xf bound_ctrl:1\n\t" \
    "v_add_f32_dpp %[yp], %[yp], %[yp] row_half_mirror row_mask:0xf bank_mask:0xf bound_ctrl:1\n\t" \
    "v_cmp_eq_u32_e32 vcc, 15, %[sp]\n\t" \
    "v_add_f32_dpp v146, v146, v146 row_mirror row_mask:0xf bank_mask:0xf bound_ctrl:1\n\t" \
    "v_add_f32_dpp %[yp], %[yp], %[yp] row_mirror row_mask:0xf bank_mask:0xf bound_ctrl:1\n\t" \
    "v_cndmask_b32_e32 %[yk0], %[yk0], %[yp], vcc\n\t" \
    "v_pk_fma_f32 %[s01], v[146:147], v[104:105], v[142:143] op_sel_hi:[0,1,1] neg_lo:[1,0,0] neg_hi:[1,0,0]\n\t" \
    "v_pk_fma_f32 %[s23], v[146:147], v[106:107], v[144:145] op_sel_hi:[0,1,1] neg_lo:[1,0,0] neg_hi:[1,0,0]\n\t" \
    "v_pk_mul_f32 v[140:141], %[s01], v[112:113]\n\t" \
    "v_pk_fma_f32 v[140:141], %[s23], v[114:115], v[140:141]\n\t" \
    "v_add_f32 %[yp], v140, v141\n\t" \
    "s_waitcnt lgkmcnt(0)\n\t" \
    "ds_read_b128 v[96:99], %[ab] offset:25088\n\t" \
    "ds_read_b128 v[100:103], %[ab] offset:512\n\t" \
    "ds_read_b128 v[104:107], %[ab] offset:16896\n\t" \
    "ds_read_b128 v[108:111], %[ab] offset:8704\n\t" \
    "ds_read_b128 v[112:115], %[ab] offset:33280\n\t" \
    "ds_read_b32 v116, %[av] offset:128\n\t" \
    "v_pk_mul_f32 v[140:141], %[s01], v[118:119]\n\t" \
    "v_pk_fma_f32 v[140:141], %[s23], v[120:121], v[140:141]\n\t" \
    "v_add_f32 v146, v140, v141\n\t" \
    "v_pk_mul_f32 v[142:143], %[s01], v[122:123]\n\t" \
    "v_pk_mul_f32 v[144:145], %[s23], v[124:125]\n\t" \
    "v_add_f32_dpp v146, v146, v146 quad_perm:[1,0,3,2] row_mask:0xf bank_mask:0xf bound_ctrl:1\n\t" \
    "v_add_f32_dpp %[yp], %[yp], %[yp] quad_perm:[1,0,3,2] row_mask:0xf bank_mask:0xf bound_ctrl:1\n\t" \
    "v_pk_fma_f32 v[142:143], v[138:139], v[130:131], v[142:143] op_sel_hi:[0,1,1]\n\t" \
    "v_add_f32_dpp v146, v146, v146 quad_perm:[2,3,0,1] row_mask:0xf bank_mask:0xf bound_ctrl:1\n\t" \
    "v_add_f32_dpp %[yp], %[yp], %[yp] quad_perm:[2,3,0,1] row_mask:0xf bank_mask:0xf bound_ctrl:1\n\t" \
    "v_pk_fma_f32 v[144:145], v[138:139], v[132:133], v[144:145] op_sel_hi:[0,1,1]\n\t" \
    "v_add_f32_dpp v146, v146, v146 row_half_mirror row_mask:0xf bank_mask:0xf bound_ctrl:1\n\t" \
    "v_add_f32_dpp %[yp], %[yp], %[yp] row_half_mirror row_mask:0xf bank_mask:0xf bound_ctrl:1\n\t" \
    "v_cmp_eq_u32_e32 vcc, 0, %[sp]\n\t" \
    "v_add_f32_dpp v146, v146, v146 row_mirror row_mask:0xf bank_mask:0xf bound_ctrl:1\n\t" \
    "v_add_f32_dpp %[yp], %[yp], %[yp] row_mirror row_mask:0xf bank_mask:0xf bound_ctrl:1\n\t" \
    "v_cndmask_b32_e32 %[yk0], %[yk0], %[yp], vcc\n\t" \
    "v_pk_fma_f32 %[s01], v[146:147], v[126:127], v[142:143] op_sel_hi:[0,1,1] neg_lo:[1,0,0] neg_hi:[1,0,0]\n\t" \
    "v_pk_fma_f32 %[s23], v[146:147], v[128:129], v[144:145] op_sel_hi:[0,1,1] neg_lo:[1,0,0] neg_hi:[1,0,0]\n\t" \
    "v_pk_mul_f32 v[140:141], %[s01], v[134:135]\n\t" \
    "v_pk_fma_f32 v[140:141], %[s23], v[136:137], v[140:141]\n\t" \
    "v_add_f32 %[yp], v140, v141\n\t" \
    "s_waitcnt lgkmcnt(0)\n\t" \
    "ds_read_b128 v[118:121], %[ab] offset:25344\n\t" \
    "ds_read_b128 v[122:125], %[ab] offset:768\n\t" \
    "ds_read_b128 v[126:129], %[ab] offset:17152\n\t" \
    "ds_read_b128 v[130:133], %[ab] offset:8960\n\t" \
    "ds_read_b128 v[134:137], %[ab] offset:33536\n\t" \
    "ds_read_b32 v138, %[av] offset:192\n\t" \
    "v_pk_mul_f32 v[140:141], %[s01], v[96:97]\n\t" \
    "v_pk_fma_f32 v[140:141], %[s23], v[98:99], v[140:141]\n\t" \
    "v_add_f32 v146, v140, v141\n\t" \
    "v_pk_mul_f32 v[142:143], %[s01], v[100:101]\n\t" \
    "v_pk_mul_f32 v[144:145], %[s23], v[102:103]\n\t" \
    "v_add_f32_dpp v146, v146, v146 quad_perm:[1,0,3,2] row_mask:0xf bank_mask:0xf bound_ctrl:1\n\t" \
    "v_add_f32_dpp %[yp], %[yp], %[yp] quad_perm:[1,0,3,2] row_mask:0xf bank_mask:0xf bound_ctrl:1\n\t" \
    "v_pk_fma_f32 v[142:143], v[116:117], v[108:109], v[142:143] op_sel_hi:[0,1,1]\n\t" \
    "v_add_f32_dpp v146, v146, v146 quad_perm:[2,3,0,1] row_mask:0xf bank_mask:0xf bound_ctrl:1\n\t" \
    "v_add_f32_dpp %[yp], %[yp], %[yp] quad_perm:[2,3,0,1] row_mask:0xf bank_mask:0xf bound_ctrl:1\n\t" \
    "v_pk_fma_f32 v[144:145], v[116:117], v[110:111], v[144:145] op_sel_hi:[0,1,1]\n\t" \
    "v_add_f32_dpp v146, v146, v146 row_half_mirror row_mask:0xf bank_mask:0xf bound_ctrl:1\n\t" \
    "v_add_f32_dpp %[yp], %[yp], %[yp] row_half_mirror row_mask:0xf bank_mask:0xf bound_ctrl:1\n\t" \
    "v_cmp_eq_u32_e32 vcc, 1, %[sp]\n\t" \
    "v_add_f32_dpp v146, v146, v146 row_mirror row_mask:0xf bank_mask:0xf bound_ctrl:1\n\t" \
    "v_add_f32_dpp %[yp], %[yp], %[yp] row_mirror row_mask:0xf bank_mask:0xf bound_ctrl:1\n\t" \
    "v_cndmask_b32_e32 %[yk0], %[yk0], %[yp], vcc\n\t" \
    "v_pk_fma_f32 %[s01], v[146:147], v[104:105], v[142:143] op_sel_hi:[0,1,1] neg_lo:[1,0,0] neg_hi:[1,0,0]\n\t" \
    "v_pk_fma_f32 %[s23], v[146:147], v[106:107], v[144:145] op_sel_hi:[0,1,1] neg_lo:[1,0,0] neg_hi:[1,0,0]\n\t" \
    "v_pk_mul_f32 v[140:141], %[s01], v[112:113]\n\t" \
    "v_pk_fma_f32 v[140:141], %[s23], v[114:115], v[140:141]\n\t" \
    "v_add_f32 %[yp], v140, v141\n\t" \
    "s_waitcnt lgkmcnt(0)\n\t" \
    "ds_read_b128 v[96:99], %[ab] offset:25600\n\t" \
    "ds_read_b128 v[100:103], %[ab] offset:1024\n\t" \
    "ds_read_b128 v[104:107], %[ab] offset:17408\n\t" \
    "ds_read_b128 v[108:111], %[ab] offset:9216\n\t" \
    "ds_read_b128 v[112:115], %[ab] offset:33792\n\t" \
    "ds_read_b32 v116, %[av] offset:256\n\t" \
    "v_pk_mul_f32 v[140:141], %[s01], v[118:119]\n\t" \
    "v_pk_fma_f32 v[140:141], %[s23], v[120:121], v[140:141]\n\t" \
    "v_add_f32 v146, v140, v141\n\t" \
    "v_pk_mul_f32 v[142:143], %[s01], v[122:123]\n\t" \
    "v_pk_mul_f32 v[144:145], %[s23], v[124:125]\n\t" \
    "v_add_f32_dpp v146, v146, v146 quad_perm:[1,0,3,2] row_mask:0xf bank_mask:0xf bound_ctrl:1\n\t" \
    "v_add_f32_dpp %[yp], %[yp], %[yp] quad_perm:[1,0,3,2] row_mask:0xf bank_mask:0xf bound_ctrl:1\n\t" \
    "v_pk_fma_f32 v[142:143], v[138:139], v[130:131], v[142:143] op_sel_hi:[0,1,1]\n\t" \
    "v_add_f32_dpp v146, v146, v146 quad_perm:[2,3,0,1] row_mask:0xf bank_mask:0xf bound_ctrl:1\n\t" \
    "v_add_f32_dpp %[yp], %[yp], %[yp] quad_perm:[2,3,0,1] row_mask:0xf bank_mask:0xf bound_ctrl:1\n\t" \
    "v_pk_fma_f32 v[144:145], v[138:139], v[132:133], v[144:145] op_sel_hi:[0,1,1]\n\t" \
    "v_add_f32_dpp v146, v146, v146 row_half_mirror row_mask:0xf bank_mask:0xf bound_ctrl:1\n\t" \
    "v_add_f32_dpp %[yp], %[yp], %[yp] row_half_mirror row_mask:0xf bank_mask:0xf bound_ctrl:1\n\t" \
    "v_cmp_eq_u32_e32 vcc, 2, %[sp]\n\t" \
    "v_add_f32_dpp v146, v146, v146 row_mirror row_mask:0xf bank_mask:0xf bound_ctrl:1\n\t" \
    "v_add_f32_dpp %[yp], %[yp], %[yp] row_mirror row_mask:0xf bank_mask:0xf bound_ctrl:1\n\t" \
    "v_cndmask_b32_e32 %[yk0], %[yk0], %[yp], vcc\n\t" \
    "v_pk_fma_f32 %[s01], v[146:147], v[126:127], v[142:143] op_sel_hi:[0,1,1] neg_lo:[1,0,0] neg_hi:[1,0,0]\n\t" \
    "v_pk_fma_f32 %[s23], v[146:147], v[128:129], v[144:145] op_sel_hi:[0,1,1] neg_lo:[1,0,0] neg_hi:[1,0,0]\n\t" \
    "v_pk_mul_f32 v[140:141], %[s01], v[134:135]\n\t" \
    "v_pk_fma_f32 v[140:141], %[s23], v[136:137], v[140:141]\n\t" \
    "v_add_f32 %[yp], v140, v141\n\t" \
    "s_waitcnt lgkmcnt(0)\n\t" \
    "ds_read_b128 v[118:121], %[ab] offset:25856\n\t" \
    "ds_read_b128 v[122:125], %[ab] offset:1280\n\t" \
    "ds_read_b128 v[126:129], %[ab] offset:17664\n\t" \
    "ds_read_b128 v[130:133], %[ab] offset:9472\n\t" \
    "ds_read_b128 v[134:137], %[ab] offset:34048\n\t" \
    "ds_read_b32 v138, %[av] offset:320\n\t" \
    "v_pk_mul_f32 v[140:141], %[s01], v[96:97]\n\t" \
    "v_pk_fma_f32 v[140:141], %[s23], v[98:99], v[140:141]\n\t" \
    "v_add_f32 v146, v140, v141\n\t" \
    "v_pk_mul_f32 v[142:143], %[s01], v[100:101]\n\t" \
    "v_pk_mul_f32 v[144:145], %[s23], v[102:103]\n\t" \
    "v_add_f32_dpp v146, v146, v146 quad_perm:[1,0,3,2] row_mask:0xf bank_mask:0xf bound_ctrl:1\n\t" \
    "v_add_f32_dpp %[yp], %[yp], %[yp] quad_perm:[1,0,3,2] row_mask:0xf bank_mask:0xf bound_ctrl:1\n\t" \
    "v_pk_fma_f32 v[142:143], v[116:117], v[108:109], v[142:143] op_sel_hi:[0,1,1]\n\t" \
    "v_add_f32_dpp v146, v146, v146 quad_perm:[2,3,0,1] row_mask:0xf bank_mask:0xf bound_ctrl:1\n\t" \
    "v_add_f32_dpp %[yp], %[yp], %[yp] quad_perm:[2,3,0,1] row_mask:0xf bank_mask:0xf bound_ctrl:1\n\t" \
    "v_pk_fma_f32 v[144:145], v[116:117], v[110:111], v[144:145] op_sel_hi:[0,1,1]\n\t" \
    "v_add_f32_dpp v146, v146, v146 row_half_mirror row_mask:0xf bank_mask:0xf bound_ctrl:1\n\t" \
    "v_add_f32_dpp %[yp], %[yp], %[yp] row_half_mirror row_mask:0xf bank_mask:0xf bound_ctrl:1\n\t" \
    "v_cmp_eq_u32_e32 vcc, 3, %[sp]\n\t" \
    "v_add_f32_dpp v146, v146, v146 row_mirror row_mask:0xf bank_mask:0xf bound_ctrl:1\n\t" \
    "v_add_f32_dpp %[yp], %[yp], %[yp] row_mirror row_mask:0xf bank_mask:0xf bound_ctrl:1\n\t" \
    "v_cndmask_b32_e32 %[yk0], %[yk0], %[yp], vcc\n\t" \
    "v_pk_fma_f32 %[s01], v[146:147], v[104:105], v[142:143] op_sel_hi:[0,1,1] neg_lo:[1,0,0] neg_hi:[1,0,0]\n\t" \
    "v_pk_fma_f32 %[s23], v[146:147], v[106:107], v[144:145] op_sel_hi:[0,1,1] neg_lo:[1,0,0] neg_hi:[1,0,0]\n\t" \
    "v_pk_mul_f32 v[140:141], %[s01], v[112:113]\n\t" \
    "v_pk_fma_f32 v[140:141], %[s23], v[114:115], v[140:141]\n\t" \
    "v_add_f32 %[yp], v140, v141\n\t" \
    "s_waitcnt lgkmcnt(0)\n\t" \
    "ds_read_b128 v[96:99], %[ab] offset:26112\n\t" \
    "ds_read_b128 v[100:103], %[ab] offset:1536\n\t" \
    "ds_read_b128 v[104:107], %[ab] offset:17920\n\t" \
    "ds_read_b128 v[108:111], %[ab] offset:9728\n\t" \
    "ds_read_b128 v[112:115], %[ab] offset:34304\n\t" \
    "ds_read_b32 v116, %[av] offset:384\n\t" \
    "v_pk_mul_f32 v[140:141], %[s01], v[118:119]\n\t" \
    "v_pk_fma_f32 v[140:141], %[s23], v[120:121], v[140:141]\n\t" \
    "v_add_f32 v146, v140, v141\n\t" \
    "v_pk_mul_f32 v[142:143], %[s01], v[122:123]\n\t" \
    "v_pk_mul_f32 v[144:145], %[s23], v[124:125]\n\t" \
    "v_add_f32_dpp v146, v146, v146 quad_perm:[1,0,3,2] row_mask:0xf bank_mask:0xf bound_ctrl:1\n\t" \
    "v_add_f32_dpp %[yp], %[yp], %[yp] quad_perm:[1,0,3,2] row_mask:0xf bank_mask:0xf bound_ctrl:1\n\t" \
    "v_pk_fma_f32 v[142:143], v[138:139], v[130:131], v[142:143] op_sel_hi:[0,1,1]\n\t" \
    "v_add_f32_dpp v146, v146, v146 quad_perm:[2,3,0,1] row_mask:0xf bank_mask:0xf bound_ctrl:1\n\t" \
    "v_add_f32_dpp %[yp], %[yp], %[yp] quad_perm:[2,3,0,1] row_mask:0xf bank_mask:0xf bound_ctrl:1\n\t" \
    "v_pk_fma_f32 v[144:145], v[138:139], v[132:133], v[144:145] op_sel_hi:[0,1,1]\n\t" \
    "v_add_f32_dpp v146, v146, v146 row_half_mirror row_mask:0xf bank_mask:0xf bound_ctrl:1\n\t" \
    "v_add_f32_dpp %[yp], %[yp], %[yp] row_half_mirror row_mask:0xf bank_mask:0xf bound_ctrl:1\n\t" \
    "v_cmp_eq_u32_e32 vcc, 4, %[sp]\n\t" \
    "v_add_f32_dpp v146, v146, v146 row_mirror row_mask:0xf bank_mask:0xf bound_ctrl:1\n\t" \
    "v_add_f32_dpp %[yp], %[yp], %[yp] row_mirror row_mask:0xf bank_mask:0xf bound_ctrl:1\n\t" \
    "v_cndmask_b32_e32 %[yk0], %[yk0], %[yp], vcc\n\t" \
    "v_pk_fma_f32 %[s01], v[146:147], v[126:127], v[142:143] op_sel_hi:[0,1,1] neg_lo:[1,0,0] neg_hi:[1,0,0]\n\t" \
    "v_pk_fma_f32 %[s23], v[146:147], v[128:129], v[144:145] op_sel_hi:[0,1,1] neg_lo:[1,0,0] neg_hi:[1,0,0]\n\t" \
    "v_pk_mul_f32 v[140:141], %[s01], v[134:135]\n\t" \
    "v_pk_fma_f32 v[140:141], %[s23], v[136:137], v[140:141]\n\t" \
    "v_add_f32 %[yp], v140, v141\n\t" \
    "s_waitcnt lgkmcnt(0)\n\t" \
    "ds_read_b128 v[118:121], %[ab] offset:26368\n\t" \
    "ds_read_b128 v[122:125], %[ab] offset:1792\n\t" \
    "ds_read_b128 v[126:129], %[ab] offset:18176\n\t" \
    "ds_read_b128 v[130:133], %[ab] offset:9984\n\t" \
    "ds_read_b128 v[134:137], %[ab] offset:34560\n\t" \
    "ds_read_b32 v138, %[av] offset:448\n\t" \
    "v_pk_mul_f32 v[140:141], %[s01], v[96:97]\n\t" \
    "v_pk_fma_f32 v[140:141], %[s23], v[98:99], v[140:141]\n\t" \
    "v_add_f32 v146, v140, v141\n\t" \
    "v_pk_mul_f32 v[142:143], %[s01], v[100:101]\n\t" \
    "v_pk_mul_f32 v[144:145], %[s23], v[102:103]\n\t" \
    "v_add_f32_dpp v146, v146, v146 quad_perm:[1,0,3,2] row_mask:0xf bank_mask:0xf bound_ctrl:1\n\t" \
    "v_add_f32_dpp %[yp], %[yp], %[yp] quad_perm:[1,0,3,2] row_mask:0xf bank_mask:0xf bound_ctrl:1\n\t" \
    "v_pk_fma_f32 v[142:143], v[116:117], v[108:109], v[142:143] op_sel_hi:[0,1,1]\n\t" \
    "v_add_f32_dpp v146, v146, v146 quad_perm:[2,3,0,1] row_mask:0xf bank_mask:0xf bound_ctrl:1\n\t" \
    "v_add_f32_dpp %[yp], %[yp], %[yp] quad_perm:[2,3,0,1] row_mask:0xf bank_mask:0xf bound_ctrl:1\n\t" \
    "v_pk_fma_f32 v[144:145], v[116:117], v[110:111], v[144:145] op_sel_hi:[0,1,1]\n\t" \
    "v_add_f32_dpp v146, v146, v146 row_half_mirror row_mask:0xf bank_mask:0xf bound_ctrl:1\n\t" \
    "v_add_f32_dpp %[yp], %[yp], %[yp] row_half_mirror row_mask:0xf bank_mask:0xf bound_ctrl:1\n\t" \
    "v_cmp_eq_u32_e32 vcc, 5, %[sp]\n\t" \
    "v_add_f32_dpp v146, v146, v146 row_mirror row_mask:0xf bank_mask:0xf bound_ctrl:1\n\t" \
    "v_add_f32_dpp %[yp], %[yp], %[yp] row_mirror row_mask:0xf bank_mask:0xf bound_ctrl:1\n\t" \
    "v_cndmask_b32_e32 %[yk0], %[yk0], %[yp], vcc\n\t" \
    "v_pk_fma_f32 %[s01], v[146:147], v[104:105], v[142:143] op_sel_hi:[0,1,1] neg_lo:[1,0,0] neg_hi:[1,0,0]\n\t" \
    "v_pk_fma_f32 %[s23], v[146:147], v[106:107], v[144:145] op_sel_hi:[0,1,1] neg_lo:[1,0,0] neg_hi:[1,0,0]\n\t" \
    "v_pk_mul_f32 v[140:141], %[s01], v[112:113]\n\t" \
    "v_pk_fma_f32 v[140:141], %[s23], v[114:115], v[140:141]\n\t" \
    "v_add_f32 %[yp], v140, v141\n\t" \
    "s_waitcnt lgkmcnt(0)\n\t" \
    "ds_read_b128 v[96:99], %[ab] offset:26624\n\t" \
    "ds_read_b128 v[100:103], %[ab] offset:2048\n\t" \
    "ds_read_b128 v[104:107], %[ab] offset:18432\n\t" \
    "ds_read_b128 v[108:111], %[ab] offset:10240\n\t" \
    "ds_read_b128 v[112:115], %[ab] offset:34816\n\t" \
    "ds_read_b32 v116, %[av] offset:512\n\t" \
    "v_pk_mul_f32 v[140:141], %[s01], v[118:119]\n\t" \
    "v_pk_fma_f32 v[140:141], %[s23], v[120:121], v[140:141]\n\t" \
    "v_add_f32 v146, v140, v141\n\t" \
    "v_pk_mul_f32 v[142:143], %[s01], v[122:123]\n\t" \
    "v_pk_mul_f32 v[144:145], %[s23], v[124:125]\n\t" \
    "v_add_f32_dpp v146, v146, v146 quad_perm:[1,0,3,2] row_mask:0xf bank_mask:0xf bound_ctrl:1\n\t" \
    "v_add_f32_dpp %[yp], %[yp], %[yp] quad_perm:[1,0,3,2] row_mask:0xf bank_mask:0xf bound_ctrl:1\n\t" \
    "v_pk_fma_f32 v[142:143], v[138:139], v[130:131], v[142:143] op_sel_hi:[0,1,1]\n\t" \
    "v_add_f32_dpp v146, v146, v146 quad_perm:[2,3,0,1] row_mask:0xf bank_mask:0xf bound_ctrl:1\n\t" \
    "v_add_f32_dpp %[yp], %[yp], %[yp] quad_perm:[2,3,0,1] row_mask:0xf bank_mask:0xf bound_ctrl:1\n\t" \
    "v_pk_fma_f32 v[144:145], v[138:139], v[132:133], v[144:145] op_sel_hi:[0,1,1]\n\t" \
    "v_add_f32_dpp v146, v146, v146 row_half_mirror row_mask:0xf bank_mask:0xf bound_ctrl:1\n\t" \
    "v_add_f32_dpp %[yp], %[yp], %[yp] row_half_mirror row_mask:0xf bank_mask:0xf bound_ctrl:1\n\t" \
    "v_cmp_eq_u32_e32 vcc, 6, %[sp]\n\t" \
    "v_add_f32_dpp v146, v146, v146 row_mirror row_mask:0xf bank_mask:0xf bound_ctrl:1\n\t" \
    "v_add_f32_dpp %[yp], %[yp], %[yp] row_mirror row_mask:0xf bank_mask:0xf bound_ctrl:1\n\t" \
    "v_cndmask_b32_e32 %[yk0], %[yk0], %[yp], vcc\n\t" \
    "v_pk_fma_f32 %[s01], v[146:147], v[126:127], v[142:143] op_sel_hi:[0,1,1] neg_lo:[1,0,0] neg_hi:[1,0,0]\n\t" \
    "v_pk_fma_f32 %[s23], v[146:147], v[128:129], v[144:145] op_sel_hi:[0,1,1] neg_lo:[1,0,0] neg_hi:[1,0,0]\n\t" \
    "v_pk_mul_f32 v[140:141], %[s01], v[134:135]\n\t" \
    "v_pk_fma_f32 v[140:141], %[s23], v[136:137], v[140:141]\n\t" \
    "v_add_f32 %[yp], v140, v141\n\t" \
    "s_waitcnt lgkmcnt(0)\n\t" \
    "ds_read_b128 v[118:121], %[ab] offset:26880\n\t" \
    "ds_read_b128 v[122:125], %[ab] offset:2304\n\t" \
    "ds_read_b128 v[126:129], %[ab] offset:18688\n\t" \
    "ds_read_b128 v[130:133], %[ab] offset:10496\n\t" \
    "ds_read_b128 v[134:137], %[ab] offset:35072\n\t" \
    "ds_read_b32 v138, %[av] offset:576\n\t" \
    "v_pk_mul_f32 v[140:141], %[s01], v[96:97]\n\t" \
    "v_pk_fma_f32 v[140:141], %[s23], v[98:99], v[140:141]\n\t" \
    "v_add_f32 v146, v140, v141\n\t" \
    "v_pk_mul_f32 v[142:143], %[s01], v[100:101]\n\t" \
    "v_pk_mul_f32 v[144:145], %[s23], v[102:103]\n\t" \
    "v_add_f32_dpp v146, v146, v146 quad_perm:[1,0,3,2] row_mask:0xf bank_mask:0xf bound_ctrl:1\n\t" \
    "v_add_f32_dpp %[yp], %[yp], %[yp] quad_perm:[1,0,3,2] row_mask:0xf bank_mask:0xf bound_ctrl:1\n\t" \
    "v_pk_fma_f32 v[142:143], v[116:117], v[108:109], v[142:143] op_sel_hi:[0,1,1]\n\t" \
    "v_add_f32_dpp v146, v146, v146 quad_perm:[2,3,0,1] row_mask:0xf bank_mask:0xf bound_ctrl:1\n\t" \
    "v_add_f32_dpp %[yp], %[yp], %[yp] quad_perm:[2,3,0,1] row_mask:0xf bank_mask:0xf bound_ctrl:1\n\t" \
    "v_pk_fma_f32 v[144:145], v[116:117], v[110:111], v[144:145] op_sel_hi:[0,1,1]\n\t" \
    "v_add_f32_dpp v146, v146, v146 row_half_mirror row_mask:0xf bank_mask:0xf bound_ctrl:1\n\t" \
    "v_add_f32_dpp %[yp], %[yp], %[yp] row_half_mirror row_mask:0xf bank_mask:0xf bound_ctrl:1\n\t" \
    "v_cmp_eq_u32_e32 vcc, 7, %[sp]\n\t" \
    "v_add_f32_dpp v146, v146, v146 row_mirror row_mask:0xf bank_mask:0xf bound_ctrl:1\n\t" \
    "v_add_f32_dpp %[yp], %[yp], %[yp] row_mirror row_mask:0xf bank_mask:0xf bound_ctrl:1\n\t" \
    "v_cndmask_b32_e32 %[yk0], %[yk0], %[yp], vcc\n\t" \
    "v_pk_fma_f32 %[s01], v[146:147], v[104:105], v[142:143] op_sel_hi:[0,1,1] neg_lo:[1,0,0] neg_hi:[1,0,0]\n\t" \
    "v_pk_fma_f32 %[s23], v[146:147], v[106:107], v[144:145] op_sel_hi:[0,1,1] neg_lo:[1,0,0] neg_hi:[1,0,0]\n\t" \
    "v_pk_mul_f32 v[140:141], %[s01], v[112:113]\n\t" \
    "v_pk_fma_f32 v[140:141], %[s23], v[114:115], v[140:141]\n\t" \
    "v_add_f32 %[yp], v140, v141\n\t" \
    "s_waitcnt lgkmcnt(0)\n\t" \
    "ds_read_b128 v[96:99], %[ab] offset:27136\n\t" \
    "ds_read_b128 v[100:103], %[ab] offset:2560\n\t" \
    "ds_read_b128 v[104:107], %[ab] offset:18944\n\t" \
    "ds_read_b128 v[108:111], %[ab] offset:10752\n\t" \
    "ds_read_b128 v[112:115], %[ab] offset:35328\n\t" \
    "ds_read_b32 v116, %[av] offset:640\n\t" \
    "v_pk_mul_f32 v[140:141], %[s01], v[118:119]\n\t" \
    "v_pk_fma_f32 v[140:141], %[s23], v[120:121], v[140:141]\n\t" \
    "v_add_f32 v146, v140, v141\n\t" \
    "v_pk_mul_f32 v[142:143], %[s01], v[122:123]\n\t" \
    "v_pk_mul_f32 v[144:145], %[s23], v[124:125]\n\t" \
    "v_add_f32_dpp v146, v146, v146 quad_perm:[1,0,3,2] row_mask:0xf bank_mask:0xf bound_ctrl:1\n\t" \
    "v_add_f32_dpp %[yp], %[yp], %[yp] quad_perm:[1,0,3,2] row_mask:0xf bank_mask:0xf bound_ctrl:1\n\t" \
    "v_pk_fma_f32 v[142:143], v[138:139], v[130:131], v[142:143] op_sel_hi:[0,1,1]\n\t" \
    "v_add_f32_dpp v146, v146, v146 quad_perm:[2,3,0,1] row_mask:0xf bank_mask:0xf bound_ctrl:1\n\t" \
    "v_add_f32_dpp %[yp], %[yp], %[yp] quad_perm:[2,3,0,1] row_mask:0xf bank_mask:0xf bound_ctrl:1\n\t" \
    "v_pk_fma_f32 v[144:145], v[138:139], v[132:133], v[144:145] op_sel_hi:[0,1,1]\n\t" \
    "v_add_f32_dpp v146, v146, v146 row_half_mirror row_mask:0xf bank_mask:0xf bound_ctrl:1\n\t" \
    "v_add_f32_dpp %[yp], %[yp], %[yp] row_half_mirror row_mask:0xf bank_mask:0xf bound_ctrl:1\n\t" \
    "v_cmp_eq_u32_e32 vcc, 8, %[sp]\n\t" \
    "v_add_f32_dpp v146, v146, v146 row_mirror row_mask:0xf bank_mask:0xf bound_ctrl:1\n\t" \
    "v_add_f32_dpp %[yp], %[yp], %[yp] row_mirror row_mask:0xf bank_mask:0xf bound_ctrl:1\n\t" \
    "v_cndmask_b32_e32 %[yk0], %[yk0], %[yp], vcc\n\t" \
    "v_pk_fma_f32 %[s01], v[146:147], v[126:127], v[142:143] op_sel_hi:[0,1,1] neg_lo:[1,0,0] neg_hi:[1,0,0]\n\t" \
    "v_pk_fma_f32 %[s23], v[146:147], v[128:129], v[144:145] op_sel_hi:[0,1,1] neg_lo:[1,0,0] neg_hi:[1,0,0]\n\t" \
    "v_pk_mul_f32 v[140:141], %[s01], v[134:135]\n\t" \
    "v_pk_fma_f32 v[140:141], %[s23], v[136:137], v[140:141]\n\t" \
    "v_add_f32 %[yp], v140, v141\n\t" \
    "s_waitcnt lgkmcnt(0)\n\t" \
    "ds_read_b128 v[118:121], %[ab] offset:27392\n\t" \
    "ds_read_b128 v[122:125], %[ab] offset:2816\n\t" \
    "ds_read_b128 v[126:129], %[ab] offset:19200\n\t" \
    "ds_read_b128 v[130:133], %[ab] offset:11008\n\t" \
    "ds_read_b128 v[134:137], %[ab] offset:35584\n\t" \
    "ds_read_b32 v138, %[av] offset:704\n\t" \
    "v_pk_mul_f32 v[140:141], %[s01], v[96:97]\n\t" \
    "v_pk_fma_f32 v[140:141], %[s23], v[98:99], v[140:141]\n\t" \
    "v_add_f32 v146, v140, v141\n\t" \
    "v_pk_mul_f32 v[142:143], %[s01], v[100:101]\n\t" \
    "v_pk_mul_f32 v[144:145], %[s23], v[102:103]\n\t" \
    "v_add_f32_dpp v146, v146, v146 quad_perm:[1,0,3,2] row_mask:0xf bank_mask:0xf bound_ctrl:1\n\t" \
    "v_add_f32_dpp %[yp], %[yp], %[yp] quad_perm:[1,0,3,2] row_mask:0xf bank_mask:0xf bound_ctrl:1\n\t" \
    "v_pk_fma_f32 v[142:143], v[116:117], v[108:109], v[142:143] op_sel_hi:[0,1,1]\n\t" \
    "v_add_f32_dpp v146, v146, v146 quad_perm:[2,3,0,1] row_mask:0xf bank_mask:0xf bound_ctrl:1\n\t" \
    "v_add_f32_dpp %[yp], %[yp], %[yp] quad_perm:[2,3,0,1] row_mask:0xf bank_mask:0xf bound_ctrl:1\n\t" \
    "v_pk_fma_f32 v[144:145], v[116:117], v[110:111], v[144:145] op_sel_hi:[0,1,1]\n\t" \
    "v_add_f32_dpp v146, v146, v146 row_half_mirror row_mask:0xf bank_mask:0xf bound_ctrl:1\n\t" \
    "v_add_f32_dpp %[yp], %[yp], %[yp] row_half_mirror row_mask:0xf bank_mask:0xf bound_ctrl:1\n\t" \
    "v_cmp_eq_u32_e32 vcc, 9, %[sp]\n\t" \
    "v_add_f32_dpp v146, v146, v146 row_mirror row_mask:0xf bank_mask:0xf bound_ctrl:1\n\t" \
    "v_add_f32_dpp %[yp], %[yp], %[yp] row_mirror row_mask:0xf bank_mask:0xf bound_ctrl:1\n\t" \
    "v_cndmask_b32_e32 %[yk0], %[yk0], %[yp], vcc\n\t" \
    "v_pk_fma_f32 %[s01], v[146:147], v[104:105], v[142:143] op_sel_hi:[0,1,1] neg_lo:[1,0,0] neg_hi:[1,0,0]\n\t" \
    "v_pk_fma_f32 %[s23], v[146:147], v[106:107], v[144:145] op_sel_hi:[0,1,1] neg_lo:[1,0,0] neg_hi:[1,0,0]\n\t" \
    "v_pk_mul_f32 v[140:141], %[s01], v[112:113]\n\t" \
    "v_pk_fma_f32 v[140:141], %[s23], v[114:115], v[140:141]\n\t" \
    "v_add_f32 %[yp], v140, v141\n\t" \
    "s_waitcnt lgkmcnt(0)\n\t" \
    "ds_read_b128 v[96:99], %[ab] offset:27648\n\t" \
    "ds_read_b128 v[100:103], %[ab] offset:3072\n\t" \
    "ds_read_b128 v[104:107], %[ab] offset:19456\n\t" \
    "ds_read_b128 v[108:111], %[ab] offset:11264\n\t" \
    "ds_read_b128 v[112:115], %[ab] offset:35840\n\t" \
    "ds_read_b32 v116, %[av] offset:768\n\t" \
    "v_pk_mul_f32 v[140:141], %[s01], v[118:119]\n\t" \
    "v_pk_fma_f32 v[140:141], %[s23], v[120:121], v[140:141]\n\t" \
    "v_add_f32 v146, v140, v141\n\t" \
    "v_pk_mul_f32 v[142:143], %[s01], v[122:123]\n\t" \
    "v_pk_mul_f32 v[144:145], %[s23], v[124:125]\n\t" \
    "v_add_f32_dpp v146, v146, v146 quad_perm:[1,0,3,2] row_mask:0xf bank_mask:0xf bound_ctrl:1\n\t" \
    "v_add_f32_dpp %[yp], %[yp], %[yp] quad_perm:[1,0,3,2] row_mask:0xf bank_mask:0xf bound_ctrl:1\n\t" \
    "v_pk_fma_f32 v[142:143], v[138:139], v[130:131], v[142:143] op_sel_hi:[0,1,1]\n\t" \
    "v_add_f32_dpp v146, v146, v146 quad_perm:[2,3,0,1] row_mask:0xf bank_mask:0xf bound_ctrl:1\n\t" \
    "v_add_f32_dpp %[yp], %[yp], %[yp] quad_perm:[2,3,0,1] row_mask:0xf bank_mask:0xf bound_ctrl:1\n\t" \
    "v_pk_fma_f32 v[144:145], v[138:139], v[132:133], v[144:145] op_sel_hi:[0,1,1]\n\t" \
    "v_add_f32_dpp v146, v146, v146 row_half_mirror row_mask:0xf bank_mask:0xf bound_ctrl:1\n\t" \
    "v_add_f32_dpp %[yp], %[yp], %[yp] row_half_mirror row_mask:0xf bank_mask:0xf bound_ctrl:1\n\t" \
    "v_cmp_eq_u32_e32 vcc, 10, %[sp]\n\t" \
    "v_add_f32_dpp v146, v146, v146 row_mirror row_mask:0xf bank_mask:0xf bound_ctrl:1\n\t" \
    "v_add_f32_dpp %[yp], %[yp], %[yp] row_mirror row_mask:0xf bank_mask:0xf bound_ctrl:1\n\t" \
    "v_cndmask_b32_e32 %[yk0], %[yk0], %[yp], vcc\n\t" \
    "v_pk_fma_f32 %[s01], v[146:147], v[126:127], v[142:143] op_sel_hi:[0,1,1] neg_lo:[1,0,0] neg_hi:[1,0,0]\n\t" \
    "v_pk_fma_f32 %[s23], v[146:147], v[128:129], v[144:145] op_sel_hi:[0,1,1] neg_lo:[1,0,0] neg_hi:[1,0,0]\n\t" \
    "v_pk_mul_f32 v[140:141], %[s01], v[134:135]\n\t" \
    "v_pk_fma_f32 v[140:141], %[s23], v[136:137], v[140:141]\n\t" \
    "v_add_f32 %[yp], v140, v141\n\t" \
    "s_waitcnt lgkmcnt(0)\n\t" \
    "ds_read_b128 v[118:121], %[ab] offset:27904\n\t" \
    "ds_read_b128 v[122:125], %[ab] offset:3328\n\t" \
    "ds_read_b128 v[126:129], %[ab] offset:19712\n\t" \
    "ds_read_b128 v[130:133], %[ab] offset:11520\n\t" \
    "ds_read_b128 v[134:137], %[ab] offset:36096\n\t" \
    "ds_read_b32 v138, %[av] offset:832\n\t" \
    "v_pk_mul_f32 v[140:141], %[s01], v[96:97]\n\t" \
    "v_pk_fma_f32 v[140:141], %[s23], v[98:99], v[140:141]\n\t" \
    "v_add_f32 v146, v140, v141\n\t" \
    "v_pk_mul_f32 v[142:143], %[s01], v[100:101]\n\t" \
    "v_pk_mul_f32 v[144:145], %[s23], v[102:103]\n\t" \
    "v_add_f32_dpp v146, v146, v146 quad_perm:[1,0,3,2] row_mask:0xf bank_mask:0xf bound_ctrl:1\n\t" \
    "v_add_f32_dpp %[yp], %[yp], %[yp] quad_perm:[1,0,3,2] row_mask:0xf bank_mask:0xf bound_ctrl:1\n\t" \
    "v_pk_fma_f32 v[142:143], v[116:117], v[108:109], v[142:143] op_sel_hi:[0,1,1]\n\t" \
    "v_add_f32_dpp v146, v146, v146 quad_perm:[2,3,0,1] row_mask:0xf bank_mask:0xf bound_ctrl:1\n\t" \
    "v_add_f32_dpp %[yp], %[yp], %[yp] quad_perm:[2,3,0,1] row_mask:0xf bank_mask:0xf bound_ctrl:1\n\t" \
    "v_pk_fma_f32 v[144:145], v[116:117], v[110:111], v[144:145] op_sel_hi:[0,1,1]\n\t" \
    "v_add_f32_dpp v146, v146, v146 row_half_mirror row_mask:0xf bank_mask:0xf bound_ctrl:1\n\t" \
    "v_add_f32_dpp %[yp], %[yp], %[yp] row_half_mirror row_mask:0xf bank_mask:0xf bound_ctrl:1\n\t" \
    "v_cmp_eq_u32_e32 vcc, 11, %[sp]\n\t" \
    "v_add_f32_dpp v146, v146, v146 row_mirror row_mask:0xf bank_mask:0xf bound_ctrl:1\n\t" \
    "v_add_f32_dpp %[yp], %[yp], %[yp] row_mirror row_mask:0xf bank_mask:0xf bound_ctrl:1\n\t" \
    "v_cndmask_b32_e32 %[yk0], %[yk0], %[yp], vcc\n\t" \
    "v_pk_fma_f32 %[s01], v[146:147], v[104:105], v[142:143] op_sel_hi:[0,1,1] neg_lo:[1,0,0] neg_hi:[1,0,0]\n\t" \
    "v_pk_fma_f32 %[s23], v[146:147], v[106:107], v[144:145] op_sel_hi:[0,1,1] neg_lo:[1,0,0] neg_hi:[1,0,0]\n\t" \
    "v_pk_mul_f32 v[140:141], %[s01], v[112:113]\n\t" \
    "v_pk_fma_f32 v[140:141], %[s23], v[114:115], v[140:141]\n\t" \
    "v_add_f32 %[yp], v140, v141\n\t" \
    "s_waitcnt lgkmcnt(0)\n\t" \
    "ds_read_b128 v[96:99], %[ab] offset:28160\n\t" \
    "ds_read_b128 v[100:103], %[ab] offset:3584\n\t" \
    "ds_read_b128 v[104:107], %[ab] offset:19968\n\t" \
    "ds_read_b128 v[108:111], %[ab] offset:11776\n\t" \
    "ds_read_b128 v[112:115], %[ab] offset:36352\n\t" \
    "ds_read_b32 v116, %[av] offset:896\n\t" \
    "v_pk_mul_f32 v[140:141], %[s01], v[118:119]\n\t" \
    "v_pk_fma_f32 v[140:141], %[s23], v[120:121], v[140:141]\n\t" \
    "v_add_f32 v146, v140, v141\n\t" \
    "v_pk_mul_f32 v[142:143], %[s01], v[122:123]\n\t" \
    "v_pk_mul_f32 v[144:145], %[s23], v[124:125]\n\t" \
    "v_add_f32_dpp v146, v146, v146 quad_perm:[1,0,3,2] row_mask:0xf bank_mask:0xf bound_ctrl:1\n\t" \
    "v_add_f32_dpp %[yp], %[yp], %[yp] quad_perm:[1,0,3,2] row_mask:0xf bank_mask:0xf bound_ctrl:1\n\t" \
    "v_pk_fma_f32 v[142:143], v[138:139], v[130:131], v[142:143] op_sel_hi:[0,1,1]\n\t" \
    "v_add_f32_dpp v146, v146, v146 quad_perm:[2,3,0,1] row_mask:0xf bank_mask:0xf bound_ctrl:1\n\t" \
    "v_add_f32_dpp %[yp], %[yp], %[yp] quad_perm:[2,3,0,1] row_mask:0xf bank_mask:0xf bound_ctrl:1\n\t" \
    "v_pk_fma_f32 v[144:145], v[138:139], v[132:133], v[144:145] op_sel_hi:[0,1,1]\n\t" \
    "v_add_f32_dpp v146, v146, v146 row_half_mirror row_mask:0xf bank_mask:0xf bound_ctrl:1\n\t" \
    "v_add_f32_dpp %[yp], %[yp], %[yp] row_half_mirror row_mask:0xf bank_mask:0xf bound_ctrl:1\n\t" \
    "v_cmp_eq_u32_e32 vcc, 12, %[sp]\n\t" \
    "v_add_f32_dpp v146, v146, v146 row_mirror row_mask:0xf bank_mask:0xf bound_ctrl:1\n\t" \
    "v_add_f32_dpp %[yp], %[yp], %[yp] row_mirror row_mask:0xf bank_mask:0xf bound_ctrl:1\n\t" \
    "v_cndmask_b32_e32 %[yk0], %[yk0], %[yp], vcc\n\t" \
    "v_pk_fma_f32 %[s01], v[146:147], v[126:127], v[142:143] op_sel_hi:[0,1,1] neg_lo:[1,0,0] neg_hi:[1,0,0]\n\t" \
    "v_pk_fma_f32 %[s23], v[146:147], v[128:129], v[144:145] op_sel_hi:[0,1,1] neg_lo:[1,0,0] neg_hi:[1,0,0]\n\t" \
    "v_pk_mul_f32 v[140:141], %[s01], v[134:135]\n\t" \
    "v_pk_fma_f32 v[140:141], %[s23], v[136:137], v[140:141]\n\t" \
    "v_add_f32 %[yp], v140, v141\n\t" \
    "s_waitcnt lgkmcnt(0)\n\t" \
    "ds_read_b128 v[118:121], %[ab] offset:28416\n\t" \
    "ds_read_b128 v[122:125], %[ab] offset:3840\n\t" \
    "ds_read_b128 v[126:129], %[ab] offset:20224\n\t" \
    "ds_read_b128 v[130:133], %[ab] offset:12032\n\t" \
    "ds_read_b128 v[134:137], %[ab] offset:36608\n\t" \
    "ds_read_b32 v138, %[av] offset:960\n\t" \
    "v_pk_mul_f32 v[140:141], %[s01], v[96:97]\n\t" \
    "v_pk_fma_f32 v[140:141], %[s23], v[98:99], v[140:141]\n\t" \
    "v_add_f32 v146, v140, v141\n\t" \
    "v_pk_mul_f32 v[142:143], %[s01], v[100:101]\n\t" \
    "v_pk_mul_f32 v[144:145], %[s23], v[102:103]\n\t" \
    "v_add_f32_dpp v146, v146, v146 quad_perm:[1,0,3,2] row_mask:0xf bank_mask:0xf bound_ctrl:1\n\t" \
    "v_add_f32_dpp %[yp], %[yp], %[yp] quad_perm:[1,0,3,2] row_mask:0xf bank_mask:0xf bound_ctrl:1\n\t" \
    "v_pk_fma_f32 v[142:143], v[116:117], v[108:109], v[142:143] op_sel_hi:[0,1,1]\n\t" \
    "v_add_f32_dpp v146, v146, v146 quad_perm:[2,3,0,1] row_mask:0xf bank_mask:0xf bound_ctrl:1\n\t" \
    "v_add_f32_dpp %[yp], %[yp], %[yp] quad_perm:[2,3,0,1] row_mask:0xf bank_mask:0xf bound_ctrl:1\n\t" \
    "v_pk_fma_f32 v[144:145], v[116:117], v[110:111], v[144:145] op_sel_hi:[0,1,1]\n\t" \
    "v_add_f32_dpp v146, v146, v146 row_half_mirror row_mask:0xf bank_mask:0xf bound_ctrl:1\n\t" \
    "v_add_f32_dpp %[yp], %[yp], %[yp] row_half_mirror row_mask:0xf bank_mask:0xf bound_ctrl:1\n\t" \
    "v_cmp_eq_u32_e32 vcc, 13, %[sp]\n\t" \
    "v_add_f32_dpp v146, v146, v146 row_mirror row_mask:0xf bank_mask:0xf bound_ctrl:1\n\t" \
    "v_add_f32_dpp %[yp], %[yp], %[yp] row_mirror row_mask:0xf bank_mask:0xf bound_ctrl:1\n\t" \
    "v_cndmask_b32_e32 %[yk0], %[yk0], %[yp], vcc\n\t" \
    "v_pk_fma_f32 %[s01], v[146:147], v[104:105], v[142:143] op_sel_hi:[0,1,1] neg_lo:[1,0,0] neg_hi:[1,0,0]\n\t" \
    "v_pk_fma_f32 %[s23], v[146:147], v[106:107], v[144:145] op_sel_hi:[0,1,1] neg_lo:[1,0,0] neg_hi:[1,0,0]\n\t" \
    "v_pk_mul_f32 v[140:141], %[s01], v[112:113]\n\t" \
    "v_pk_fma_f32 v[140:141], %[s23], v[114:115], v[140:141]\n\t" \
    "v_add_f32 %[yp], v140, v141\n\t" \
    "s_waitcnt lgkmcnt(0)\n\t" \
    "ds_read_b128 v[96:99], %[ab] offset:28672\n\t" \
    "ds_read_b128 v[100:103], %[ab] offset:4096\n\t" \
    "ds_read_b128 v[104:107], %[ab] offset:20480\n\t" \
    "ds_read_b128 v[108:111], %[ab] offset:12288\n\t" \
    "ds_read_b128 v[112:115], %[ab] offset:36864\n\t" \
    "ds_read_b32 v116, %[av] offset:1024\n\t" \
    "v_pk_mul_f32 v[140:141], %[s01], v[118:119]\n\t" \
    "v_pk_fma_f32 v[140:141], %[s23], v[120:121], v[140:141]\n\t" \
    "v_add_f32 v146, v140, v141\n\t" \
    "v_pk_mul_f32 v[142:143], %[s01], v[122:123]\n\t" \
    "v_pk_mul_f32 v[144:145], %[s23], v[124:125]\n\t" \
    "v_add_f32_dpp v146, v146, v146 quad_perm:[1,0,3,2] row_mask:0xf bank_mask:0xf bound_ctrl:1\n\t" \
    "v_add_f32_dpp %[yp], %[yp], %[yp] quad_perm:[1,0,3,2] row_mask:0xf bank_mask:0xf bound_ctrl:1\n\t" \
    "v_pk_fma_f32 v[142:143], v[138:139], v[130:131], v[142:143] op_sel_hi:[0,1,1]\n\t" \
    "v_add_f32_dpp v146, v146, v146 quad_perm:[2,3,0,1] row_mask:0xf bank_mask:0xf bound_ctrl:1\n\t" \
    "v_add_f32_dpp %[yp], %[yp], %[yp] quad_perm:[2,3,0,1] row_mask:0xf bank_mask:0xf bound_ctrl:1\n\t" \
    "v_pk_fma_f32 v[144:145], v[138:139], v[132:133], v[144:145] op_sel_hi:[0,1,1]\n\t" \
    "v_add_f32_dpp v146, v146, v146 row_half_mirror row_mask:0xf bank_mask:0xf bound_ctrl:1\n\t" \
    "v_add_f32_dpp %[yp], %[yp], %[yp] row_half_mirror row_mask:0xf bank_mask:0xf bound_ctrl:1\n\t" \
    "v_cmp_eq_u32_e32 vcc, 14, %[sp]\n\t" \
    "v_add_f32_dpp v146, v146, v146 row_mirror row_mask:0xf bank_mask:0xf bound_ctrl:1\n\t" \
    "v_add_f32_dpp %[yp], %[yp], %[yp] row_mirror row_mask:0xf bank_mask:0xf bound_ctrl:1\n\t" \
    "v_cndmask_b32_e32 %[yk0], %[yk0], %[yp], vcc\n\t" \
    "v_pk_fma_f32 %[s01], v[146:147], v[126:127], v[142:143] op_sel_hi:[0,1,1] neg_lo:[1,0,0] neg_hi:[1,0,0]\n\t" \
    "v_pk_fma_f32 %[s23], v[146:147], v[128:129], v[144:145] op_sel_hi:[0,1,1] neg_lo:[1,0,0] neg_hi:[1,0,0]\n\t" \
    "v_pk_mul_f32 v[140:141], %[s01], v[134:135]\n\t" \
    "v_pk_fma_f32 v[140:141], %[s23], v[136:137], v[140:141]\n\t" \
    "v_add_f32 %[yp], v140, v141\n\t" \
    "s_waitcnt lgkmcnt(0)\n\t" \
    "ds_read_b128 v[118:121], %[ab] offset:28928\n\t" \
    "ds_read_b128 v[122:125], %[ab] offset:4352\n\t" \
    "ds_read_b128 v[126:129], %[ab] offset:20736\n\t" \
    "ds_read_b128 v[130:133], %[ab] offset:12544\n\t" \
    "ds_read_b128 v[134:137], %[ab] offset:37120\n\t" \
    "ds_read_b32 v138, %[av] offset:1088\n\t" \
    "v_pk_mul_f32 v[140:141], %[s01], v[96:97]\n\t" \
    "v_pk_fma_f32 v[140:141], %[s23], v[98:99], v[140:141]\n\t" \
    "v_add_f32 v146, v140, v141\n\t" \
    "v_pk_mul_f32 v[142:143], %[s01], v[100:101]\n\t" \
    "v_pk_mul_f32 v[144:145], %[s23], v[102:103]\n\t" \
    "v_add_f32_dpp v146, v146, v146 quad_perm:[1,0,3,2] row_mask:0xf bank_mask:0xf bound_ctrl:1\n\t" \
    "v_add_f32_dpp %[yp], %[yp], %[yp] quad_perm:[1,0,3,2] row_mask:0xf bank_mask:0xf bound_ctrl:1\n\t" \
    "v_pk_fma_f32 v[142:143], v[116:117], v[108:109], v[142:143] op_sel_hi:[0,1,1]\n\t" \
    "v_add_f32_dpp v146, v146, v146 quad_perm:[2,3,0,1] row_mask:0xf bank_mask:0xf bound_ctrl:1\n\t" \
    "v_add_f32_dpp %[yp], %[yp], %[yp] quad_perm:[2,3,0,1] row_mask:0xf bank_mask:0xf bound_ctrl:1\n\t" \
    "v_pk_fma_f32 v[144:145], v[116:117], v[110:111], v[144:145] op_sel_hi:[0,1,1]\n\t" \
    "v_add_f32_dpp v146, v146, v146 row_half_mirror row_mask:0xf bank_mask:0xf bound_ctrl:1\n\t" \
    "v_add_f32_dpp %[yp], %[yp], %[yp] row_half_mirror row_mask:0xf bank_mask:0xf bound_ctrl:1\n\t" \
    "v_cmp_eq_u32_e32 vcc, 15, %[sp]\n\t" \
    "v_add_f32_dpp v146, v146, v146 row_mirror row_mask:0xf bank_mask:0xf bound_ctrl:1\n\t" \
    "v_add_f32_dpp %[yp], %[yp], %[yp] row_mirror row_mask:0xf bank_mask:0xf bound_ctrl:1\n\t" \
    "v_cndmask_b32_e32 %[yk0], %[yk0], %[yp], vcc\n\t" \
    "v_pk_fma_f32 %[s01], v[146:147], v[104:105], v[142:143] op_sel_hi:[0,1,1] neg_lo:[1,0,0] neg_hi:[1,0,0]\n\t" \
    "v_pk_fma_f32 %[s23], v[146:147], v[106:107], v[144:145] op_sel_hi:[0,1,1] neg_lo:[1,0,0] neg_hi:[1,0,0]\n\t" \
    "v_pk_mul_f32 v[140:141], %[s01], v[112:113]\n\t" \
    "v_pk_fma_f32 v[140:141], %[s23], v[114:115], v[140:141]\n\t" \
    "v_add_f32 %[yp], v140, v141\n\t" \
    "s_waitcnt lgkmcnt(0)\n\t" \
    "ds_read_b128 v[96:99], %[ab] offset:29184\n\t" \
    "ds_read_b128 v[100:103], %[ab] offset:4608\n\t" \
    "ds_read_b128 v[104:107], %[ab] offset:20992\n\t" \
    "ds_read_b128 v[108:111], %[ab] offset:12800\n\t" \
    "ds_read_b128 v[112:115], %[ab] offset:37376\n\t" \
    "ds_read_b32 v116, %[av] offset:1152\n\t" \
    "v_pk_mul_f32 v[140:141], %[s01], v[118:119]\n\t" \
    "v_pk_fma_f32 v[140:141], %[s23], v[120:121], v[140:141]\n\t" \
    "v_add_f32 v146, v140, v141\n\t" \
    "v_pk_mul_f32 v[142:143], %[s01], v[122:123]\n\t" \
    "v_pk_mul_f32 v[144:145], %[s23], v[124:125]\n\t" \
    "v_add_f32_dpp v146, v146, v146 quad_perm:[1,0,3,2] row_mask:0xf bank_mask:0xf bound_ctrl:1\n\t" \
    "v_add_f32_dpp %[yp], %[yp], %[yp] quad_perm:[1,0,3,2] row_mask:0xf bank_mask:0xf bound_ctrl:1\n\t" \
    "v_pk_fma_f32 v[142:143], v[138:139], v[130:131], v[142:143] op_sel_hi:[0,1,1]\n\t" \
    "v_add_f32_dpp v146, v146, v146 quad_perm:[2,3,0,1] row_mask:0xf bank_mask:0xf bound_ctrl:1\n\t" \
    "v_add_f32_dpp %[yp], %[yp], %[yp] quad_perm:[2,3,0,1] row_mask:0xf bank_mask:0xf bound_ctrl:1\n\t" \
    "v_pk_fma_f32 v[144:145], v[138:139], v[132:133], v[144:145] op_sel_hi:[0,1,1]\n\t" \
    "v_add_f32_dpp v146, v146, v146 row_half_mirror row_mask:0xf bank_mask:0xf bound_ctrl:1\n\t" \
    "v_add_f32_dpp %[yp], %[yp], %[yp] row_half_mirror row_mask:0xf bank_mask:0xf bound_ctrl:1\n\t" \
    "v_cmp_eq_u32_e32 vcc, 0, %[sp]\n\t" \
    "v_add_f32_dpp v146, v146, v146 row_mirror row_mask:0xf bank_mask:0xf bound_ctrl:1\n\t" \
    "v_add_f32_dpp %[yp], %[yp], %[yp] row_mirror row_mask:0xf bank_mask:0xf bound_ctrl:1\n\t" \
    "v_cndmask_b32_e32 %[yk1], %[yk1], %[yp], vcc\n\t" \
    "v_pk_fma_f32 %[s01], v[146:147], v[126:127], v[142:143] op_sel_hi:[0,1,1] neg_lo:[1,0,0] neg_hi:[1,0,0]\n\t" \
    "v_pk_fma_f32 %[s23], v[146:147], v[128:129], v[144:145] op_sel_hi:[0,1,1] neg_lo:[1,0,0] neg_hi:[1,0,0]\n\t" \
    "v_pk_mul_f32 v[140:141], %[s01], v[134:135]\n\t" \
    "v_pk_fma_f32 v[140:141], %[s23], v[136:137], v[140:141]\n\t" \
    "v_add_f32 %[yp], v140, v141\n\t" \
    "s_waitcnt lgkmcnt(0)\n\t" \
    "ds_read_b128 v[118:121], %[ab] offset:29440\n\t" \
    "ds_read_b128 v[122:125], %[ab] offset:4864\n\t" \
    "ds_read_b128 v[126:129], %[ab] offset:21248\n\t" \
    "ds_read_b128 v[130:133], %[ab] offset:13056\n\t" \
    "ds_read_b128 v[134:137], %[ab] offset:37632\n\t" \
    "ds_read_b32 v138, %[av] offset:1216\n\t" \
    "v_pk_mul_f32 v[140:141], %[s01], v[96:97]\n\t" \
    "v_pk_fma_f32 v[140:141], %[s23], v[98:99], v[140:141]\n\t" \
    "v_add_f32 v146, v140, v141\n\t" \
    "v_pk_mul_f32 v[142:143], %[s01], v[100:101]\n\t" \
    "v_pk_mul_f32 v[144:145], %[s23], v[102:103]\n\t" \
    "v_add_f32_dpp v146, v146, v146 quad_perm:[1,0,3,2] row_mask:0xf bank_mask:0xf bound_ctrl:1\n\t" \
    "v_add_f32_dpp %[yp], %[yp], %[yp] quad_perm:[1,0,3,2] row_mask:0xf bank_mask:0xf bound_ctrl:1\n\t" \
    "v_pk_fma_f32 v[142:143], v[116:117], v[108:109], v[142:143] op_sel_hi:[0,1,1]\n\t" \
    "v_add_f32_dpp v146, v146, v146 quad_perm:[2,3,0,1] row_mask:0xf bank_mask:0xf bound_ctrl:1\n\t" \
    "v_add_f32_dpp %[yp], %[yp], %[yp] quad_perm:[2,3,0,1] row_mask:0xf bank_mask:0xf bound_ctrl:1\n\t" \
    "v_pk_fma_f32 v[144:145], v[116:117], v[110:111], v[144:145] op_sel_hi:[0,1,1]\n\t" \
    "v_add_f32_dpp v146, v146, v146 row_half_mirror row_mask:0xf bank_mask:0xf bound_ctrl:1\n\t" \
    "v_add_f32_dpp %[yp], %[yp], %[yp] row_half_mirror row_mask:0xf bank_mask:0xf bound_ctrl:1\n\t" \
    "v_cmp_eq_u32_e32 vcc, 1, %[sp]\n\t" \
    "v_add_f32_dpp v146, v146, v146 row_mirror row_mask:0xf bank_mask:0xf bound_ctrl:1\n\t" \
    "v_add_f32_dpp %[yp], %[yp], %[yp] row_mirror row_mask:0xf bank_mask:0xf bound_ctrl:1\n\t" \
    "v_cndmask_b32_e32 %[yk1], %[yk1], %[yp], vcc\n\t" \
    "v_pk_fma_f32 %[s01], v[146:147], v[104:105], v[142:143] op_sel_hi:[0,1,1] neg_lo:[1,0,0] neg_hi:[1,0,0]\n\t" \
    "v_pk_fma_f32 %[s23], v[146:147], v[106:107], v[144:145] op_sel_hi:[0,1,1] neg_lo:[1,0,0] neg_hi:[1,0,0]\n\t" \
    "v_pk_mul_f32 v[140:141], %[s01], v[112:113]\n\t" \
    "v_pk_fma_f32 v[140:141], %[s23], v[114:115], v[140:141]\n\t" \
    "v_add_f32 %[yp], v140, v141\n\t" \
    "s_waitcnt lgkmcnt(0)\n\t" \
    "ds_read_b128 v[96:99], %[ab] offset:29696\n\t" \
    "ds_read_b128 v[100:103], %[ab] offset:5120\n\t" \
    "ds_read_b128 v[104:107], %[ab] offset:21504\n\t" \
    "ds_read_b128 v[108:111], %[ab] offset:13312\n\t" \
    "ds_read_b128 v[112:115], %[ab] offset:37888\n\t" \
    "ds_read_b32 v116, %[av] offset:1280\n\t" \
    "v_pk_mul_f32 v[140:141], %[s01], v[118:119]\n\t" \
    "v_pk_fma_f32 v[140:141], %[s23], v[120:121], v[140:141]\n\t" \
    "v_add_f32 v146, v140, v141\n\t" \
    "v_pk_mul_f32 v[142:143], %[s01], v[122:123]\n\t" \
    "v_pk_mul_f32 v[144:145], %[s23], v[124:125]\n\t" \
    "v_add_f32_dpp v146, v146, v146 quad_perm:[1,0,3,2] row_mask:0xf bank_mask:0xf bound_ctrl:1\n\t" \
    "v_add_f32_dpp %[yp], %[yp], %[yp] quad_perm:[1,0,3,2] row_mask:0xf bank_mask:0xf bound_ctrl:1\n\t" \
    "v_pk_fma_f32 v[142:143], v[138:139], v[130:131], v[142:143] op_sel_hi:[0,1,1]\n\t" \
    "v_add_f32_dpp v146, v146, v146 quad_perm:[2,3,0,1] row_mask:0xf bank_mask:0xf bound_ctrl:1\n\t" \
    "v_add_f32_dpp %[yp], %[yp], %[yp] quad_perm:[2,3,0,1] row_mask:0xf bank_mask:0xf bound_ctrl:1\n\t" \
    "v_pk_fma_f32 v[144:145], v[138:139], v[132:133], v[144:145] op_sel_hi:[0,1,1]\n\t" \
    "v_add_f32_dpp v146, v146, v146 row_half_mirror row_mask:0xf bank_mask:0xf bound_ctrl:1\n\t" \
    "v_add_f32_dpp %[yp], %[yp], %[yp] row_half_mirror row_mask:0xf bank_mask:0xf bound_ctrl:1\n\t" \
    "v_cmp_eq_u32_e32 vcc, 2, %[sp]\n\t" \
    "v_add_f32_dpp v146, v146, v146 row_mirror row_mask:0xf bank_mask:0xf bound_ctrl:1\n\t" \
    "v_add_f32_dpp %[yp], %[yp], %[yp] row_mirror row_mask:0xf bank_mask:0xf bound_ctrl:1\n\t" \
    "v_cndmask_b32_e32 %[yk1], %[yk1], %[yp], vcc\n\t" \
    "v_pk_fma_f32 %[s01], v[146:147], v[126:127], v[142:143] op_sel_hi:[0,1,1] neg_lo:[1,0,0] neg_hi:[1,0,0]\n\t" \
    "v_pk_fma_f32 %[s23], v[146:147], v[128:129], v[144:145] op_sel_hi:[0,1,1] neg_lo:[1,0,0] neg_hi:[1,0,0]\n\t" \
    "v_pk_mul_f32 v[140:141], %[s01], v[134:135]\n\t" \
    "v_pk_fma_f32 v[140:141], %[s23], v[136:137], v[140:141]\n\t" \
    "v_add_f32 %[yp], v140, v141\n\t" \
    "s_waitcnt lgkmcnt(0)\n\t" \
    "ds_read_b128 v[118:121], %[ab] offset:29952\n\t" \
    "ds_read_b128 v[122:125], %[ab] offset:5376\n\t" \
    "ds_read_b128 v[126:129], %[ab] offset:21760\n\t" \
    "ds_read_b128 v[130:133], %[ab] offset:13568\n\t" \
    "ds_read_b128 v[134:137], %[ab] offset:38144\n\t" \
    "ds_read_b32 v138, %[av] offset:1344\n\t" \
    "v_pk_mul_f32 v[140:141], %[s01], v[96:97]\n\t" \
    "v_pk_fma_f32 v[140:141], %[s23], v[98:99], v[140:141]\n\t" \
    "v_add_f32 v146, v140, v141\n\t" \
    "v_pk_mul_f32 v[142:143], %[s01], v[100:101]\n\t" \
    "v_pk_mul_f32 v[144:145], %[s23], v[102:103]\n\t" \
    "v_add_f32_dpp v146, v146, v146 quad_perm:[1,0,3,2] row_mask:0xf bank_mask:0xf bound_ctrl:1\n\t" \
    "v_add_f32_dpp %[yp], %[yp], %[yp] quad_perm:[1,0,3,2] row_mask:0xf bank_mask:0xf bound_ctrl:1\n\t" \
    "v_pk_fma_f32 v[142:143], v[116:117], v[108:109], v[142:143] op_sel_hi:[0,1,1]\n\t" \
    "v_add_f32_dpp v146, v146, v146 quad_perm:[2,3,0,1] row_mask:0xf bank_mask:0xf bound_ctrl:1\n\t" \
    "v_add_f32_dpp %[yp], %[yp], %[yp] quad_perm:[2,3,0,1] row_mask:0xf bank_mask:0xf bound_ctrl:1\n\t" \
    "v_pk_fma_f32 v[144:145], v[116:117], v[110:111], v[144:145] op_sel_hi:[0,1,1]\n\t" \
    "v_add_f32_dpp v146, v146, v146 row_half_mirror row_mask:0xf bank_mask:0xf bound_ctrl:1\n\t" \
    "v_add_f32_dpp %[yp], %[yp], %[yp] row_half_mirror row_mask:0xf bank_mask:0xf bound_ctrl:1\n\t" \
    "v_cmp_eq_u32_e32 vcc, 3, %[sp]\n\t" \
    "v_add_f32_dpp v146, v146, v146 row_mirror row_mask:0xf bank_mask:0xf bound_ctrl:1\n\t" \
    "v_add_f32_dpp %[yp], %[yp], %[yp] row_mirror row_mask:0xf bank_mask:0xf bound_ctrl:1\n\t" \
    "v_cndmask_b32_e32 %[yk1], %[yk1], %[yp], vcc\n\t" \
    "v_pk_fma_f32 %[s01], v[146:147], v[104:105], v[142:143] op_sel_hi:[0,1,1] neg_lo:[1,0,0] neg_hi:[1,0,0]\n\t" \
    "v_pk_fma_f32 %[s23], v[146:147], v[106:107], v[144:145] op_sel_hi:[0,1,1] neg_lo:[1,0,0] neg_hi:[1,0,0]\n\t" \
    "v_pk_mul_f32 v[140:141], %[s01], v[112:113]\n\t" \
    "v_pk_fma_f32 v[140:141], %[s23], v[114:115], v[140:141]\n\t" \
    "v_add_f32 %[yp], v140, v141\n\t" \
    "s_waitcnt lgkmcnt(0)\n\t" \
    "ds_read_b128 v[96:99], %[ab] offset:30208\n\t" \
    "ds_read_b128 v[100:103], %[ab] offset:5632\n\t" \
    "ds_read_b128 v[104:107], %[ab] offset:22016\n\t" \
    "ds_read_b128 v[108:111], %[ab] offset:13824\n\t" \
    "ds_read_b128 v[112:115], %[ab] offset:38400\n\t" \
    "ds_read_b32 v116, %[av] offset:1408\n\t" \
    "v_pk_mul_f32 v[140:141], %[s01], v[118:119]\n\t" \
    "v_pk_fma_f32 v[140:141], %[s23], v[120:121], v[140:141]\n\t" \
    "v_add_f32 v146, v140, v141\n\t" \
    "v_pk_mul_f32 v[142:143], %[s01], v[122:123]\n\t" \
    "v_pk_mul_f32 v[144:145], %[s23], v[124:125]\n\t" \
    "v_add_f32_dpp v146, v146, v146 quad_perm:[1,0,3,2] row_mask:0xf bank_mask:0xf bound_ctrl:1\n\t" \
    "v_add_f32_dpp %[yp], %[yp], %[yp] quad_perm:[1,0,3,2] row_mask:0xf bank_mask:0xf bound_ctrl:1\n\t" \
    "v_pk_fma_f32 v[142:143], v[138:139], v[130:131], v[142:143] op_sel_hi:[0,1,1]\n\t" \
    "v_add_f32_dpp v146, v146, v146 quad_perm:[2,3,0,1] row_mask:0xf bank_mask:0xf bound_ctrl:1\n\t" \
    "v_add_f32_dpp %[yp], %[yp], %[yp] quad_perm:[2,3,0,1] row_mask:0xf bank_mask:0xf bound_ctrl:1\n\t" \
    "v_pk_fma_f32 v[144:145], v[138:139], v[132:133], v[144:145] op_sel_hi:[0,1,1]\n\t" \
    "v_add_f32_dpp v146, v146, v146 row_half_mirror row_mask:0xf bank_mask:0xf bound_ctrl:1\n\t" \
    "v_add_f32_dpp %[yp], %[yp], %[yp] row_half_mirror row_mask:0xf bank_mask:0xf bound_ctrl:1\n\t" \
    "v_cmp_eq_u32_e32 vcc, 4, %[sp]\n\t" \
    "v_add_f32_dpp v146, v146, v146 row_mirror row_mask:0xf bank_mask:0xf bound_ctrl:1\n\t" \
    "v_add_f32_dpp %[yp], %[yp], %[yp] row_mirror row_mask:0xf bank_mask:0xf bound_ctrl:1\n\t" \
    "v_cndmask_b32_e32 %[yk1], %[yk1], %[yp], vcc\n\t" \
    "v_pk_fma_f32 %[s01], v[146:147], v[126:127], v[142:143] op_sel_hi:[0,1,1] neg_lo:[1,0,0] neg_hi:[1,0,0]\n\t" \
    "v_pk_fma_f32 %[s23], v[146:147], v[128:129], v[144:145] op_sel_hi:[0,1,1] neg_lo:[1,0,0] neg_hi:[1,0,0]\n\t" \
    "v_pk_mul_f32 v[140:141], %[s01], v[134:135]\n\t" \
    "v_pk_fma_f32 v[140:141], %[s23], v[136:137], v[140:141]\n\t" \
    "v_add_f32 %[yp], v140, v141\n\t" \
    "s_waitcnt lgkmcnt(0)\n\t" \
    "ds_read_b128 v[118:121], %[ab] offset:30464\n\t" \
    "ds_read_b128 v[122:125], %[ab] offset:5888\n\t" \
    "ds_read_b128 v[126:129], %[ab] offset:22272\n\t" \
    "ds_read_b128 v[130:133], %[ab] offset:14080\n\t" \
    "ds_read_b128 v[134:137], %[ab] offset:38656\n\t" \
    "ds_read_b32 v138, %[av] offset:1472\n\t" \
    "v_pk_mul_f32 v[140:141], %[s01], v[96:97]\n\t" \
    "v_pk_fma_f32 v[140:141], %[s23], v[98:99], v[140:141]\n\t" \
    "v_add_f32 v146, v140, v141\n\t" \
    "v_pk_mul_f32 v[142:143], %[s01], v[100:101]\n\t" \
    "v_pk_mul_f32 v[144:145], %[s23], v[102:103]\n\t" \
    "v_add_f32_dpp v146, v146, v146 quad_perm:[1,0,3,2] row_mask:0xf bank_mask:0xf bound_ctrl:1\n\t" \
    "v_add_f32_dpp %[yp], %[yp], %[yp] quad_perm:[1,0,3,2] row_mask:0xf bank_mask:0xf bound_ctrl:1\n\t" \
    "v_pk_fma_f32 v[142:143], v[116:117], v[108:109], v[142:143] op_sel_hi:[0,1,1]\n\t" \
    "v_add_f32_dpp v146, v146, v146 quad_perm:[2,3,0,1] row_mask:0xf bank_mask:0xf bound_ctrl:1\n\t" \
    "v_add_f32_dpp %[yp], %[yp], %[yp] quad_perm:[2,3,0,1] row_mask:0xf bank_mask:0xf bound_ctrl:1\n\t" \
    "v_pk_fma_f32 v[144:145], v[116:117], v[110:111], v[144:145] op_sel_hi:[0,1,1]\n\t" \
    "v_add_f32_dpp v146, v146, v146 row_half_mirror row_mask:0xf bank_mask:0xf bound_ctrl:1\n\t" \
    "v_add_f32_dpp %[yp], %[yp], %[yp] row_half_mirror row_mask:0xf bank_mask:0xf bound_ctrl:1\n\t" \
    "v_cmp_eq_u32_e32 vcc, 5, %[sp]\n\t" \
    "v_add_f32_dpp v146, v146, v146 row_mirror row_mask:0xf bank_mask:0xf bound_ctrl:1\n\t" \
    "v_add_f32_dpp %[yp], %[yp], %[yp] row_mirror row_mask:0xf bank_mask:0xf bound_ctrl:1\n\t" \
    "v_cndmask_b32_e32 %[yk1], %[yk1], %[yp], vcc\n\t" \
    "v_pk_fma_f32 %[s01], v[146:147], v[104:105], v[142:143] op_sel_hi:[0,1,1] neg_lo:[1,0,0] neg_hi:[1,0,0]\n\t" \
    "v_pk_fma_f32 %[s23], v[146:147], v[106:107], v[144:145] op_sel_hi:[0,1,1] neg_lo:[1,0,0] neg_hi:[1,0,0]\n\t" \
    "v_pk_mul_f32 v[140:141], %[s01], v[112:113]\n\t" \
    "v_pk_fma_f32 v[140:141], %[s23], v[114:115], v[140:141]\n\t" \
    "v_add_f32 %[yp], v140, v141\n\t" \
    "s_waitcnt lgkmcnt(0)\n\t" \
    "ds_read_b128 v[96:99], %[ab] offset:30720\n\t" \
    "ds_read_b128 v[100:103], %[ab] offset:6144\n\t" \
    "ds_read_b128 v[104:107], %[ab] offset:22528\n\t" \
    "ds_read_b128 v[108:111], %[ab] offset:14336\n\t" \
    "ds_read_b128 v[112:115], %[ab] offset:38912\n\t" \
    "ds_read_b32 v116, %[av] offset:1536\n\t" \
    "v_pk_mul_f32 v[140:141], %[s01], v[118:119]\n\t" \
    "v_pk_fma_f32 v[140:141], %[s23], v[120:121], v[140:141]\n\t" \
    "v_add_f32 v146, v140, v141\n\t" \
    "v_pk_mul_f32 v[142:143], %[s01], v[122:123]\n\t" \
    "v_pk_mul_f32 v[144:145], %[s23], v[124:125]\n\t" \
    "v_add_f32_dpp v146, v146, v146 quad_perm:[1,0,3,2] row_mask:0xf bank_mask:0xf bound_ctrl:1\n\t" \
    "v_add_f32_dpp %[yp], %[yp], %[yp] quad_perm:[1,0,3,2] row_mask:0xf bank_mask:0xf bound_ctrl:1\n\t" \
    "v_pk_fma_f32 v[142:143], v[138:139], v[130:131], v[142:143] op_sel_hi:[0,1,1]\n\t" \
    "v_add_f32_dpp v146, v146, v146 quad_perm:[2,3,0,1] row_mask:0xf bank_mask:0xf bound_ctrl:1\n\t" \
    "v_add_f32_dpp %[yp], %[yp], %[yp] quad_perm:[2,3,0,1] row_mask:0xf bank_mask:0xf bound_ctrl:1\n\t" \
    "v_pk_fma_f32 v[144:145], v[138:139], v[132:133], v[144:145] op_sel_hi:[0,1,1]\n\t" \
    "v_add_f32_dpp v146, v146, v146 row_half_mirror row_mask:0xf bank_mask:0xf bound_ctrl:1\n\t" \
    "v_add_f32_dpp %[yp], %[yp], %[yp] row_half_mirror row_mask:0xf bank_mask:0xf bound_ctrl:1\n\t" \
    "v_cmp_eq_u32_e32 vcc, 6, %[sp]\n\t" \
    "v_add_f32_dpp v146, v146, v146 row_mirror row_mask:0xf bank_mask:0xf bound_ctrl:1\n\t" \
    "v_add_f32_dpp %[yp], %[yp], %[yp] row_mirror row_mask:0xf bank_mask:0xf bound_ctrl:1\n\t" \
    "v_cndmask_b32_e32 %[yk1], %[yk1], %[yp], vcc\n\t" \
    "v_pk_fma_f32 %[s01], v[146:147], v[126:127], v[142:143] op_sel_hi:[0,1,1] neg_lo:[1,0,0] neg_hi:[1,0,0]\n\t" \
    "v_pk_fma_f32 %[s23], v[146:147], v[128:129], v[144:145] op_sel_hi:[0,1,1] neg_lo:[1,0,0] neg_hi:[1,0,0]\n\t" \
    "v_pk_mul_f32 v[140:141], %[s01], v[134:135]\n\t" \
    "v_pk_fma_f32 v[140:141], %[s23], v[136:137], v[140:141]\n\t" \
    "v_add_f32 %[yp], v140, v141\n\t" \
    "s_waitcnt lgkmcnt(0)\n\t" \
    "ds_read_b128 v[118:121], %[ab] offset:30976\n\t" \
    "ds_read_b128 v[122:125], %[ab] offset:6400\n\t" \
    "ds_read_b128 v[126:129], %[ab] offset:22784\n\t" \
    "ds_read_b128 v[130:133], %[ab] offset:14592\n\t" \
    "ds_read_b128 v[134:137], %[ab] offset:39168\n\t" \
    "ds_read_b32 v138, %[av] offset:1600\n\t" \
    "v_pk_mul_f32 v[140:141], %[s01], v[96:97]\n\t" \
    "v_pk_fma_f32 v[140:141], %[s23], v[98:99], v[140:141]\n\t" \
    "v_add_f32 v146, v140, v141\n\t" \
    "v_pk_mul_f32 v[142:143], %[s01], v[100:101]\n\t" \
    "v_pk_mul_f32 v[144:145], %[s23], v[102:103]\n\t" \
    "v_add_f32_dpp v146, v146, v146 quad_perm:[1,0,3,2] row_mask:0xf bank_mask:0xf bound_ctrl:1\n\t" \
    "v_add_f32_dpp %[yp], %[yp], %[yp] quad_perm:[1,0,3,2] row_mask:0xf bank_mask:0xf bound_ctrl:1\n\t" \
    "v_pk_fma_f32 v[142:143], v[116:117], v[108:109], v[142:143] op_sel_hi:[0,1,1]\n\t" \
    "v_add_f32_dpp v146, v146, v146 quad_perm:[2,3,0,1] row_mask:0xf bank_mask:0xf bound_ctrl:1\n\t" \
    "v_add_f32_dpp %[yp], %[yp], %[yp] quad_perm:[2,3,0,1] row_mask:0xf bank_mask:0xf bound_ctrl:1\n\t" \
    "v_pk_fma_f32 v[144:145], v[116:117], v[110:111], v[144:145] op_sel_hi:[0,1,1]\n\t" \
    "v_add_f32_dpp v146, v146, v146 row_half_mirror row_mask:0xf bank_mask:0xf bound_ctrl:1\n\t" \
    "v_add_f32_dpp %[yp], %[yp], %[yp] row_half_mirror row_mask:0xf bank_mask:0xf bound_ctrl:1\n\t" \
    "v_cmp_eq_u32_e32 vcc, 7, %[sp]\n\t" \
    "v_add_f32_dpp v146, v146, v146 row_mirror row_mask:0xf bank_mask:0xf bound_ctrl:1\n\t" \
    "v_add_f32_dpp %[yp], %[yp], %[yp] row_mirror row_mask:0xf bank_mask:0xf bound_ctrl:1\n\t" \
    "v_cndmask_b32_e32 %[yk1], %[yk1], %[yp], vcc\n\t" \
    "v_pk_fma_f32 %[s01], v[146:147], v[104:105], v[142:143] op_sel_hi:[0,1,1] neg_lo:[1,0,0] neg_hi:[1,0,0]\n\t" \
    "v_pk_fma_f32 %[s23], v[146:147], v[106:107], v[144:145] op_sel_hi:[0,1,1] neg_lo:[1,0,0] neg_hi:[1,0,0]\n\t" \
    "v_pk_mul_f32 v[140:141], %[s01], v[112:113]\n\t" \
    "v_pk_fma_f32 v[140:141], %[s23], v[114:115], v[140:141]\n\t" \
    "v_add_f32 %[yp], v140, v141\n\t" \
    "s_waitcnt lgkmcnt(0)\n\t" \
    "ds_read_b128 v[96:99], %[ab] offset:31232\n\t" \
    "ds_read_b128 v[100:103], %[ab] offset:6656\n\t" \
    "ds_read_b128 v[104:107], %[ab] offset:23040\n\t" \
    "ds_read_b128 v[108:111], %[ab] offset:14848\n\t" \
    "ds_read_b128 v[112:115], %[ab] offset:39424\n\t" \
    "ds_read_b32 v116, %[av] offset:1664\n\t" \
    "v_pk_mul_f32 v[140:141], %[s01], v[118:119]\n\t" \
    "v_pk_fma_f32 v[140:141], %[s23], v[120:121], v[140:141]\n\t" \
    "v_add_f32 v146, v140, v141\n\t" \
    "v_pk_mul_f32 v[142:143], %[s01], v[122:123]\n\t" \
    "v_pk_mul_f32 v[144:145], %[s23], v[124:125]\n\t" \
    "v_add_f32_dpp v146, v146, v146 quad_perm:[1,0,3,2] row_mask:0xf bank_mask:0xf bound_ctrl:1\n\t" \
    "v_add_f32_dpp %[yp], %[yp], %[yp] quad_perm:[1,0,3,2] row_mask:0xf bank_mask:0xf bound_ctrl:1\n\t" \
    "v_pk_fma_f32 v[142:143], v[138:139], v[130:131], v[142:143] op_sel_hi:[0,1,1]\n\t" \
    "v_add_f32_dpp v146, v146, v146 quad_perm:[2,3,0,1] row_mask:0xf bank_mask:0xf bound_ctrl:1\n\t" \
    "v_add_f32_dpp %[yp], %[yp], %[yp] quad_perm:[2,3,0,1] row_mask:0xf bank_mask:0xf bound_ctrl:1\n\t" \
    "v_pk_fma_f32 v[144:145], v[138:139], v[132:133], v[144:145] op_sel_hi:[0,1,1]\n\t" \
    "v_add_f32_dpp v146, v146, v146 row_half_mirror row_mask:0xf bank_mask:0xf bound_ctrl:1\n\t" \
    "v_add_f32_dpp %[yp], %[yp], %[yp] row_half_mirror row_mask:0xf bank_mask:0xf bound_ctrl:1\n\t" \
    "v_cmp_eq_u32_e32 vcc, 8, %[sp]\n\t" \
    "v_add_f32_dpp v146, v146, v146 row_mirror row_mask:0xf bank_mask:0xf bound_ctrl:1\n\t" \
    "v_add_f32_dpp %[yp], %[yp], %[yp] row_mirror row_mask:0xf bank_mask:0xf bound_ctrl:1\n\t" \
    "v_cndmask_b32_e32 %[yk1], %[yk1], %[yp], vcc\n\t" \
    "v_pk_fma_f32 %[s01], v[146:147], v[126:127], v[142:143] op_sel_hi:[0,1,1] neg_lo:[1,0,0] neg_hi:[1,0,0]\n\t" \
    "v_pk_fma_f32 %[s23], v[146:147], v[128:129], v[144:145] op_sel_hi:[0,1,1] neg_lo:[1,0,0] neg_hi:[1,0,0]\n\t" \
    "v_pk_mul_f32 v[140:141], %[s01], v[134:135]\n\t" \
    "v_pk_fma_f32 v[140:141], %[s23], v[136:137], v[140:141]\n\t" \
    "v_add_f32 %[yp], v140, v141\n\t" \
    "s_waitcnt lgkmcnt(0)\n\t" \
    "ds_read_b128 v[118:121], %[ab] offset:31488\n\t" \
    "ds_read_b128 v[122:125], %[ab] offset:6912\n\t" \
    "ds_read_b128 v[126:129], %[ab] offset:23296\n\t" \
    "ds_read_b128 v[130:133], %[ab] offset:15104\n\t" \
    "ds_read_b128 v[134:137], %[ab] offset:39680\n\t" \
    "ds_read_b32 v138, %[av] offset:1728\n\t" \
    "v_pk_mul_f32 v[140:141], %[s01], v[96:97]\n\t" \
    "v_pk_fma_f32 v[140:141], %[s23], v[98:99], v[140:141]\n\t" \
    "v_add_f32 v146, v140, v141\n\t" \
    "v_pk_mul_f32 v[142:143], %[s01], v[100:101]\n\t" \
    "v_pk_mul_f32 v[144:145], %[s23], v[102:103]\n\t" \
    "v_add_f32_dpp v146, v146, v146 quad_perm:[1,0,3,2] row_mask:0xf bank_mask:0xf bound_ctrl:1\n\t" \
    "v_add_f32_dpp %[yp], %[yp], %[yp] quad_perm:[1,0,3,2] row_mask:0xf bank_mask:0xf bound_ctrl:1\n\t" \
    "v_pk_fma_f32 v[142:143], v[116:117], v[108:109], v[142:143] op_sel_hi:[0,1,1]\n\t" \
    "v_add_f32_dpp v146, v146, v146 quad_perm:[2,3,0,1] row_mask:0xf bank_mask:0xf bound_ctrl:1\n\t" \
    "v_add_f32_dpp %[yp], %[yp], %[yp] quad_perm:[2,3,0,1] row_mask:0xf bank_mask:0xf bound_ctrl:1\n\t" \
    "v_pk_fma_f32 v[144:145], v[116:117], v[110:111], v[144:145] op_sel_hi:[0,1,1]\n\t" \
    "v_add_f32_dpp v146, v146, v146 row_half_mirror row_mask:0xf bank_mask:0xf bound_ctrl:1\n\t" \
    "v_add_f32_dpp %[yp], %[yp], %[yp] row_half_mirror row_mask:0xf bank_mask:0xf bound_ctrl:1\n\t" \
    "v_cmp_eq_u32_e32 vcc, 9, %[sp]\n\t" \
    "v_add_f32_dpp v146, v146, v146 row_mirror row_mask:0xf bank_mask:0xf bound_ctrl:1\n\t" \
    "v_add_f32_dpp %[yp], %[yp], %[yp] row_mirror row_mask:0xf bank_mask:0xf bound_ctrl:1\n\t" \
    "v_cndmask_b32_e32 %[yk1], %[yk1], %[yp], vcc\n\t" \
    "v_pk_fma_f32 %[s01], v[146:147], v[104:105], v[142:143] op_sel_hi:[0,1,1] neg_lo:[1,0,0] neg_hi:[1,0,0]\n\t" \
    "v_pk_fma_f32 %[s23], v[146:147], v[106:107], v[144:145] op_sel_hi:[0,1,1] neg_lo:[1,0,0] neg_hi:[1,0,0]\n\t" \
    "v_pk_mul_f32 v[140:141], %[s01], v[112:113]\n\t" \
    "v_pk_fma_f32 v[140:141], %[s23], v[114:115], v[140:141]\n\t" \
    "v_add_f32 %[yp], v140, v141\n\t" \
    "s_waitcnt lgkmcnt(0)\n\t" \
    "ds_read_b128 v[96:99], %[ab] offset:31744\n\t" \
    "ds_read_b128 v[100:103], %[ab] offset:7168\n\t" \
    "ds_read_b128 v[104:107], %[ab] offset:23552\n\t" \
    "ds_read_b128 v[108:111], %[ab] offset:15360\n\t" \
    "ds_read_b128 v[112:115], %[ab] offset:39936\n\t" \
    "ds_read_b32 v116, %[av] offset:1792\n\t" \
    "v_pk_mul_f32 v[140:141], %[s01], v[118:119]\n\t" \
    "v_pk_fma_f32 v[140:141], %[s23], v[120:121], v[140:141]\n\t" \
    "v_add_f32 v146, v140, v141\n\t" \
    "v_pk_mul_f32 v[142:143], %[s01], v[122:123]\n\t" \
    "v_pk_mul_f32 v[144:145], %[s23], v[124:125]\n\t" \
    "v_add_f32_dpp v146, v146, v146 quad_perm:[1,0,3,2] row_mask:0xf bank_mask:0xf bound_ctrl:1\n\t" \
    "v_add_f32_dpp %[yp], %[yp], %[yp] quad_perm:[1,0,3,2] row_mask:0xf bank_mask:0xf bound_ctrl:1\n\t" \
    "v_pk_fma_f32 v[142:143], v[138:139], v[130:131], v[142:143] op_sel_hi:[0,1,1]\n\t" \
    "v_add_f32_dpp v146, v146, v146 quad_perm:[2,3,0,1] row_mask:0xf bank_mask:0xf bound_ctrl:1\n\t" \
    "v_add_f32_dpp %[yp], %[yp], %[yp] quad_perm:[2,3,0,1] row_mask:0xf bank_mask:0xf bound_ctrl:1\n\t" \
    "v_pk_fma_f32 v[144:145], v[138:139], v[132:133], v[144:145] op_sel_hi:[0,1,1]\n\t" \
    "v_add_f32_dpp v146, v146, v146 row_half_mirror row_mask:0xf bank_mask:0xf bound_ctrl:1\n\t" \
    "v_add_f32_dpp %[yp], %[yp], %[yp] row_half_mirror row_mask:0xf bank_mask:0xf bound_ctrl:1\n\t" \
    "v_cmp_eq_u32_e32 vcc, 10, %[sp]\n\t" \
    "v_add_f32_dpp v146, v146, v146 row_mirror row_mask:0xf bank_mask:0xf bound_ctrl:1\n\t" \
    "v_add_f32_dpp %[yp], %[yp], %[yp] row_mirror row_mask:0xf bank_mask:0xf bound_ctrl:1\n\t" \
    "v_cndmask_b32_e32 %[yk1], %[yk1], %[yp], vcc\n\t" \
    "v_pk_fma_f32 %[s01], v[146:147], v[126:127], v[142:143] op_sel_hi:[0,1,1] neg_lo:[1,0,0] neg_hi:[1,0,0]\n\t" \
    "v_pk_fma_f32 %[s23], v[146:147], v[128:129], v[144:145] op_sel_hi:[0,1,1] neg_lo:[1,0,0] neg_hi:[1,0,0]\n\t" \
    "v_pk_mul_f32 v[140:141], %[s01], v[134:135]\n\t" \
    "v_pk_fma_f32 v[140:141], %[s23], v[136:137], v[140:141]\n\t" \
    "v_add_f32 %[yp], v140, v141\n\t" \
    "s_waitcnt lgkmcnt(0)\n\t" \
    "ds_read_b128 v[118:121], %[ab] offset:32000\n\t" \
    "ds_read_b128 v[122:125], %[ab] offset:7424\n\t" \
    "ds_read_b128 v[126:129], %[ab] offset:23808\n\t" \
    "ds_read_b128 v[130:133], %[ab] offset:15616\n\t" \
    "ds_read_b128 v[134:137], %[ab] offset:40192\n\t" \
    "ds_read_b32 v138, %[av] offset:1856\n\t" \
    "v_pk_mul_f32 v[140:141], %[s01], v[96:97]\n\t" \
    "v_pk_fma_f32 v[140:141], %[s23], v[98:99], v[140:141]\n\t" \
    "v_add_f32 v146, v140, v141\n\t" \
    "v_pk_mul_f32 v[142:143], %[s01], v[100:101]\n\t" \
    "v_pk_mul_f32 v[144:145], %[s23], v[102:103]\n\t" \
    "v_add_f32_dpp v146, v146, v146 quad_perm:[1,0,3,2] row_mask:0xf bank_mask:0xf bound_ctrl:1\n\t" \
    "v_add_f32_dpp %[yp], %[yp], %[yp] quad_perm:[1,0,3,2] row_mask:0xf bank_mask:0xf bound_ctrl:1\n\t" \
    "v_pk_fma_f32 v[142:143], v[116:117], v[108:109], v[142:143] op_sel_hi:[0,1,1]\n\t" \
    "v_add_f32_dpp v146, v146, v146 quad_perm:[2,3,0,1] row_mask:0xf bank_mask:0xf bound_ctrl:1\n\t" \
    "v_add_f32_dpp %[yp], %[yp], %[yp] quad_perm:[2,3,0,1] row_mask:0xf bank_mask:0xf bound_ctrl:1\n\t" \
    "v_pk_fma_f32 v[144:145], v[116:117], v[110:111], v[144:145] op_sel_hi:[0,1,1]\n\t" \
    "v_add_f32_dpp v146, v146, v146 row_half_mirror row_mask:0xf bank_mask:0xf bound_ctrl:1\n\t" \
    "v_add_f32_dpp %[yp], %[yp], %[yp] row_half_mirror row_mask:0xf bank_mask:0xf bound_ctrl:1\n\t" \
    "v_cmp_eq_u32_e32 vcc, 11, %[sp]\n\t" \
    "v_add_f32_dpp v146, v146, v146 row_mirror row_mask:0xf bank_mask:0xf bound_ctrl:1\n\t" \
    "v_add_f32_dpp %[yp], %[yp], %[yp] row_mirror row_mask:0xf bank_mask:0xf bound_ctrl:1\n\t" \
    "v_cndmask_b32_e32 %[yk1], %[yk1], %[yp], vcc\n\t" \
    "v_pk_fma_f32 %[s01], v[146:147], v[104:105], v[142:143] op_sel_hi:[0,1,1] neg_lo:[1,0,0] neg_hi:[1,0,0]\n\t" \
    "v_pk_fma_f32 %[s23], v[146:147], v[106:107], v[144:145] op_sel_hi:[0,1,1] neg_lo:[1,0,0] neg_hi:[1,0,0]\n\t" \
    "v_pk_mul_f32 v[140:141], %[s01], v[112:113]\n\t" \
    "v_pk_fma_f32 v[140:141], %[s23], v[114:115], v[140:141]\n\t" \
    "v_add_f32 %[yp], v140, v141\n\t" \
    "s_waitcnt lgkmcnt(0)\n\t" \
    "ds_read_b128 v[96:99], %[ab] offset:32256\n\t" \
    "ds_read_b128 v[100:103], %[ab] offset:7680\n\t" \
    "ds_read_b128 v[104:107], %[ab] offset:24064\n\t" \
    "ds_read_b128 v[108:111], %[ab] offset:15872\n\t" \
    "ds_read_b128 v[112:115], %[ab] offset:40448\n\t" \
    "ds_read_b32 v116, %[av] offset:1920\n\t" \
    "v_pk_mul_f32 v[140:141], %[s01], v[118:119]\n\t" \
    "v_pk_fma_f32 v[140:141], %[s23], v[120:121], v[140:141]\n\t" \
    "v_add_f32 v146, v140, v141\n\t" \
    "v_pk_mul_f32 v[142:143], %[s01], v[122:123]\n\t" \
    "v_pk_mul_f32 v[144:145], %[s23], v[124:125]\n\t" \
    "v_add_f32_dpp v146, v146, v146 quad_perm:[1,0,3,2] row_mask:0xf bank_mask:0xf bound_ctrl:1\n\t" \
    "v_add_f32_dpp %[yp], %[yp], %[yp] quad_perm:[1,0,3,2] row_mask:0xf bank_mask:0xf bound_ctrl:1\n\t" \
    "v_pk_fma_f32 v[142:143], v[138:139], v[130:131], v[142:143] op_sel_hi:[0,1,1]\n\t" \
    "v_add_f32_dpp v146, v146, v146 quad_perm:[2,3,0,1] row_mask:0xf bank_mask:0xf bound_ctrl:1\n\t" \
    "v_add_f32_dpp %[yp], %[yp], %[yp] quad_perm:[2,3,0,1] row_mask:0xf bank_mask:0xf bound_ctrl:1\n\t" \
    "v_pk_fma_f32 v[144:145], v[138:139], v[132:133], v[144:145] op_sel_hi:[0,1,1]\n\t" \
    "v_add_f32_dpp v146, v146, v146 row_half_mirror row_mask:0xf bank_mask:0xf bound_ctrl:1\n\t" \
    "v_add_f32_dpp %[yp], %[yp], %[yp] row_half_mirror row_mask:0xf bank_mask:0xf bound_ctrl:1\n\t" \
    "v_cmp_eq_u32_e32 vcc, 12, %[sp]\n\t" \
    "v_add_f32_dpp v146, v146, v146 row_mirror row_mask:0xf bank_mask:0xf bound_ctrl:1\n\t" \
    "v_add_f32_dpp %[yp], %[yp], %[yp] row_mirror row_mask:0xf bank_mask:0xf bound_ctrl:1\n\t" \
    "v_cndmask_b32_e32 %[yk1], %[yk1], %[yp], vcc\n\t" \
    "v_pk_fma_f32 %[s01], v[146:147], v[126:127], v[142:143] op_sel_hi:[0,1,1] neg_lo:[1,0,0] neg_hi:[1,0,0]\n\t" \
    "v_pk_fma_f32 %[s23], v[146:147], v[128:129], v[144:145] op_sel_hi:[0,1,1] neg_lo:[1,0,0] neg_hi:[1,0,0]\n\t" \
    "v_pk_mul_f32 v[140:141], %[s01], v[134:135]\n\t" \
    "v_pk_fma_f32 v[140:141], %[s23], v[136:137], v[140:141]\n\t" \
    "v_add_f32 %[yp], v140, v141\n\t" \
    "s_waitcnt lgkmcnt(0)\n\t" \
    "ds_read_b128 v[118:121], %[ab] offset:32512\n\t" \
    "ds_read_b128 v[122:125], %[ab] offset:7936\n\t" \
    "ds_read_b128 v[126:129], %[ab] offset:24320\n\t" \
    "ds_read_b128 v[130:133], %[ab] offset:16128\n\t" \
    "ds_read_b128 v[134:137], %[ab] offset:40704\n\t" \
    "ds_read_b32 v138, %[av] offset:1984\n\t" \
    "v_pk_mul_f32 v[140:141], %[s01], v[96:97]\n\t" \
    "v_pk_fma_f32 v[140:141], %[s23], v[98:99], v[140:141]\n\t" \
    "v_add_f32 v146, v140, v141\n\t" \
    "v_pk_mul_f32 v[142:143], %[s01], v[100:101]\n\t" \
    "v_pk_mul_f32 v[144:145], %[s23], v[102:103]\n\t" \
    "v_add_f32_dpp v146, v146, v146 quad_perm:[1,0,3,2] row_mask:0xf bank_mask:0xf bound_ctrl:1\n\t" \
    "v_add_f32_dpp %[yp], %[yp], %[yp] quad_perm:[1,0,3,2] row_mask:0xf bank_mask:0xf bound_ctrl:1\n\t" \
    "v_pk_fma_f32 v[142:143], v[116:117], v[108:109], v[142:143] op_sel_hi:[0,1,1]\n\t" \
    "v_add_f32_dpp v146, v146, v146 quad_perm:[2,3,0,1] row_mask:0xf bank_mask:0xf bound_ctrl:1\n\t" \
    "v_add_f32_dpp %[yp], %[yp], %[yp] quad_perm:[2,3,0,1] row_mask:0xf bank_mask:0xf bound_ctrl:1\n\t" \
    "v_pk_fma_f32 v[144:145], v[116:117], v[110:111], v[144:145] op_sel_hi:[0,1,1]\n\t" \
    "v_add_f32_dpp v146, v146, v146 row_half_mirror row_mask:0xf bank_mask:0xf bound_ctrl:1\n\t" \
    "v_add_f32_dpp %[yp], %[yp], %[yp] row_half_mirror row_mask:0xf bank_mask:0xf bound_ctrl:1\n\t" \
    "v_cmp_eq_u32_e32 vcc, 13, %[sp]\n\t" \
    "v_add_f32_dpp v146, v146, v146 row_mirror row_mask:0xf bank_mask:0xf bound_ctrl:1\n\t" \
    "v_add_f32_dpp %[yp], %[yp], %[yp] row_mirror row_mask:0xf bank_mask:0xf bound_ctrl:1\n\t" \
    "v_cndmask_b32_e32 %[yk1], %[yk1], %[yp], vcc\n\t" \
    "v_pk_fma_f32 %[s01], v[146:147], v[104:105], v[142:143] op_sel_hi:[0,1,1] neg_lo:[1,0,0] neg_hi:[1,0,0]\n\t" \
    "v_pk_fma_f32 %[s23], v[146:147], v[106:107], v[144:145] op_sel_hi:[0,1,1] neg_lo:[1,0,0] neg_hi:[1,0,0]\n\t" \
    "v_pk_mul_f32 v[140:141], %[s01], v[112:113]\n\t" \
    "v_pk_fma_f32 v[140:141], %[s23], v[114:115], v[140:141]\n\t" \
    "v_add_f32 %[yp], v140, v141\n\t" \
    "s_waitcnt lgkmcnt(0)\n\t" \
    "ds_read_b128 v[96:99], %[ab] offset:32768\n\t" \
    "ds_read_b128 v[100:103], %[ab] offset:8192\n\t" \
    "ds_read_b128 v[104:107], %[ab] offset:24576\n\t" \
    "ds_read_b128 v[108:111], %[ab] offset:16384\n\t" \
    "ds_read_b128 v[112:115], %[ab] offset:40960\n\t" \
    "ds_read_b32 v116, %[av] offset:2048\n\t" \
    "v_pk_mul_f32 v[140:141], %[s01], v[118:119]\n\t" \
    "v_pk_fma_f32 v[140:141], %[s23], v[120:121], v[140:141]\n\t" \
    "v_add_f32 v146, v140, v141\n\t" \
    "v_pk_mul_f32 v[142:143], %[s01], v[122:123]\n\t" \
    "v_pk_mul_f32 v[144:145], %[s23], v[124:125]\n\t" \
    "v_add_f32_dpp v146, v146, v146 quad_perm:[1,0,3,2] row_mask:0xf bank_mask:0xf bound_ctrl:1\n\t" \
    "v_add_f32_dpp %[yp], %[yp], %[yp] quad_perm:[1,0,3,2] row_mask:0xf bank_mask:0xf bound_ctrl:1\n\t" \
    "v_pk_fma_f32 v[142:143], v[138:139], v[130:131], v[142:143] op_sel_hi:[0,1,1]\n\t" \
    "v_add_f32_dpp v146, v146, v146 quad_perm:[2,3,0,1] row_mask:0xf bank_mask:0xf bound_ctrl:1\n\t" \
    "v_add_f32_dpp %[yp], %[yp], %[yp] quad_perm:[2,3,0,1] row_mask:0xf bank_mask:0xf bound_ctrl:1\n\t" \
    "v_pk_fma_f32 v[144:145], v[138:139], v[132:133], v[144:145] op_sel_hi:[0,1,1]\n\t" \
    "v_add_f32_dpp v146, v146, v146 row_half_mirror row_mask:0xf bank_mask:0xf bound_ctrl:1\n\t" \
    "v_add_f32_dpp %[yp], %[yp], %[yp] row_half_mirror row_mask:0xf bank_mask:0xf bound_ctrl:1\n\t" \
    "v_cmp_eq_u32_e32 vcc, 14, %[sp]\n\t" \
    "v_add_f32_dpp v146, v146, v146 row_mirror row_mask:0xf bank_mask:0xf bound_ctrl:1\n\t" \
    "v_add_f32_dpp %[yp], %[yp], %[yp] row_mirror row_mask:0xf bank_mask:0xf bound_ctrl:1\n\t" \
    "v_cndmask_b32_e32 %[yk1], %[yk1], %[yp], vcc\n\t" \
    "v_pk_fma_f32 %[s01], v[146:147], v[126:127], v[142:143] op_sel_hi:[0,1,1] neg_lo:[1,0,0] neg_hi:[1,0,0]\n\t" \
    "v_pk_fma_f32 %[s23], v[146:147], v[128:129], v[144:145] op_sel_hi:[0,1,1] neg_lo:[1,0,0] neg_hi:[1,0,0]\n\t" \
    "v_pk_mul_f32 v[140:141], %[s01], v[134:135]\n\t" \
    "v_pk_fma_f32 v[140:141], %[s23], v[136:137], v[140:141]\n\t" \
    "v_add_f32 %[yp], v140, v141\n\t" \
    "s_waitcnt lgkmcnt(0)\n\t"
#define SCAN_CHUNK_CLOBBERS "v96", "v97", "v98", "v99", "v100", "v101", "v102", "v103", "v104", "v105", "v106", "v107", "v108", "v109", "v110", "v111", "v112", "v113", "v114", "v115", "v116", "v117", "v118", "v119", "v120", "v121", "v122", "v123", "v124", "v125", "v126", "v127", "v128", "v129", "v130", "v131", "v132", "v133", "v134", "v135", "v136", "v137", "v138", "v139", "v140", "v141", "v142", "v143", "v144", "v145", "v146", "v147", "vcc", "memory"
#ifndef EMU
#define UNR _Pragma("unroll")
#define UNR1 _Pragma("unroll 1")
#define CFENCE() asm volatile("" ::: "memory")
#define OPAQUE(x) asm volatile("" : "+v"(x))
#define SYNC() __syncthreads()
#define WAVE_SYNC() do { asm volatile("s_waitcnt lgkmcnt(0)" ::: "memory"); __builtin_amdgcn_wave_barrier(); } while (0)
DEVFN float shfl_xor_f(float v, int m) { return __shfl_xor(v, m); }
DEVFN float shfl_f(float v, int src) { return __shfl(v, src); }
DEVFN void sincospi_f(float x, float* s, float* c) { sincospif(x, s, c); }
template <int M> DEVFN float rowx_add(float v) { constexpr int ctrl = M == 1 ? 0xB1 : M == 2 ? 0x4E : M == 7 ? 0x141 : 0x140;
    return v + __builtin_bit_cast(float, __builtin_amdgcn_update_dpp(0, __builtin_bit_cast(int, v), ctrl, 0xf, 0xf, true)); }
#endif

enum InIdx { I_X = 0, I_C, I_CTX, I_CCTX, I_ANORM, I_AADAW, I_AADAB, I_AWIN, I_RPB, I_QG, I_KG, I_AWOUT, I_RNORM, I_RADAW, I_RADAB, I_RWIN, I_MU, I_W0, I_WUP, I_A0, I_AUP,
             I_KK, I_KA, I_RK, I_GNW, I_GNB, I_HSHORT, I_HW1, I_HB1, I_HW2, I_HB2, I_HW3, I_HB3, I_HSKIP, I_RWOUT, I_FNORM, N_IN };

#if defined(TSEL) && !defined(EMU)
#define XSTAMP(C, k, cond) do { if ((cond) && (C).tid == 0) __hip_atomic_store((unsigned long long*)((C).ws + WS_CTL + 32768) + (k), (unsigned long long)__builtin_amdgcn_s_memrealtime(), __ATOMIC_RELAXED, __HIP_MEMORY_SCOPE_AGENT); } while (0)
#else
#define XSTAMP(C, k, cond) do {} while (0)
#endif
#if defined(TSEL) && !defined(EMU)
#define TACC_DECL unsigned long long tacc_ = 0, tb_ = 0
#define TACC_BEGIN tb_ = __builtin_amdgcn_s_memrealtime()
#define TACC_END tacc_ += __builtin_amdgcn_s_memrealtime() - tb_
#define TACC_STORE(C, k, cond) do { if (cond) __hip_atomic_store((unsigned long long*)((C).ws + WS_CTL + 32768) + (k), tacc_, __ATOMIC_RELAXED, __HIP_MEMORY_SCOPE_AGENT); } while (0)
#else
#define TACC_DECL
#define TACC_BEGIN
#define TACC_END
#define TACC_STORE(C, k, cond)
#endif
struct Ctx {
    const float* in[N_IN]; float* out; unsigned char* ws;
    int tid, lane, wave, vcu, G;
};

#ifdef EMU
DEVFN float wave_sum(float v) { for (int o = 1; o < 64; o <<= 1) v += shfl_xor_f(v, o); return v; }
DEVFN float swap16_f(float v) { return shfl_xor_f(v, 16); }
#else
DEVFN float wave_sum(float v) { v = rowx_add<1>(v); v = rowx_add<2>(v); v = rowx_add<7>(v); v = rowx_add<15>(v);
    const int i_ = __builtin_bit_cast(int, v);
    return (__builtin_bit_cast(float, __builtin_amdgcn_readlane(i_, 0)) + __builtin_bit_cast(float, __builtin_amdgcn_readlane(i_, 16))) + (__builtin_bit_cast(float, __builtin_amdgcn_readlane(i_, 32)) + __builtin_bit_cast(float, __builtin_amdgcn_readlane(i_, 48))); }
DEVFN float swap16_f(float v) { return __builtin_bit_cast(float, __builtin_amdgcn_ds_swizzle(__builtin_bit_cast(int, v), 0x401F)); }
#endif

DEVFN U4 ld16(const void* p) { return *(const U4*)p; }
DEVFN void st16(void* p, U4 v) { *(U4*)p = v; }
DEVFN void unpack8(U4 w, float* f) { f[0] = bflo(w.x); f[1] = bfhi(w.x); f[2] = bflo(w.y); f[3] = bfhi(w.y); f[4] = bflo(w.z); f[5] = bfhi(w.z); f[6] = bflo(w.w); f[7] = bfhi(w.w); }
DEVFN U4 pack8(const float* f) { U4 w; w.x = pk2(f[0], f[1]); w.y = pk2(f[2], f[3]); w.z = pk2(f[4], f[5]); w.w = pk2(f[6], f[7]); return w; }

DEVFN void p0_transpose_item(const float* W, int K, int N, bf16_t* WT, float* scr, int item, int lane) {
    const int nblk = N / 32, kb = item / nblk, nb = item % nblk, k0 = 64 * kb, n0 = 32 * nb;
    UNR for (int i = 0; i < 32; ++i) { const int kk = 2 * i + (lane >> 5); scr[kk * 33 + (lane & 31)] = W[(size_t)(k0 + kk) * N + n0 + (lane & 31)]; }
    WAVE_SYNC();
    const int c = lane & 7;
    UNR for (int j = 0; j < 4; ++j) { const int n = (lane >> 3) + 8 * j; const float* s = scr + (8 * c) * 33 + n;
        U4 o; o.x = pk2(s[0 * 33], s[1 * 33]); o.y = pk2(s[2 * 33], s[3 * 33]); o.z = pk2(s[4 * 33], s[5 * 33]); o.w = pk2(s[6 * 33], s[7 * 33]);
        st16(WT + (size_t)(n0 + n) * K + k0 + 8 * c, o); }
    WAVE_SYNC();
}

template <bool BF> DEVFN void hid_rows(const float* w1, const float* b1, const float* w2, const float* b2, float* hid, int L, int gw, int NGW, int lane) {
    float w1c[33], w2c[64];
    UNR for (int i = 0; i < 33; ++i) w1c[i] = w1[i * 64 + lane];
    UNR for (int i = 0; i < 64; ++i) w2c[i] = w2[i * 64 + lane];
    const float bb1 = b1[lane], bb2 = b2[lane];
    for (int t = gw; t < L; t += NGW) {
        float feat = 0.f;
        if (lane == 0) feat = (float)t / (float)(L - 1 > 1 ? L - 1 : 1);
        else if (lane < 33) { const int b = (lane - 1) & 15; const float band = 1e-4f + (float)b * ((15.0f - 1e-4f) / 15.0f);
            const float x = 2.0f * band * (float)t / (float)L; float s, c; sincospi_f(x, &s, &c); feat = (lane <= 16) ? c : -s; }
        float a = bb1;
        UNR for (int i = 0; i < 33; ++i) a += shfl_f(feat, i) * w1c[i];
        const float h1 = sinf(a);
        float b = bb2;
        UNR for (int i = 0; i < 64; ++i) b += shfl_f(h1, i) * w2c[i];
        if (BF) ((bf16_t*)hid)[(size_t)t * 64 + lane] = (bf16_t)f2bf(sinf(b)); else hid[(size_t)t * 64 + lane] = sinf(b);
    }
}

DEVFN void r2_build_bfrag(const Ctx& C);
DEVFN void ph_prologue(const Ctx& C, unsigned char* lds) {
    const int gw = C.vcu * NWAVES + C.wave, NGW = C.G * NWAVES, lane = C.lane;
    float* scr = (float*)(lds + C.wave * 16384);
    {
        constexpr int I_AIN = 16 * (AIN / 32), I_OUT = 16 * 32, I_RIN = 16 * (RIN / 32);
        constexpr int NIT = 2 * (I_AIN + I_OUT + I_RIN + I_OUT);
        for (int it = gw; it < NIT; it += NGW) {
            int r = it; const int li = r & 1; r >>= 1;
            if (r < I_AIN) { p0_transpose_item(C.in[I_AWIN] + (size_t)li * DM * AIN, DM, AIN, (bf16_t*)(C.ws + WS_WAIN) + (size_t)li * AIN * DM, scr, r, lane); continue; } r -= I_AIN;
            if (r < I_OUT) { p0_transpose_item(C.in[I_AWOUT] + (size_t)li * DM * DM, DM, DM, (bf16_t*)(C.ws + WS_WAOUT) + (size_t)li * DM * DM, scr, r, lane); continue; } r -= I_OUT;
            if (r < I_RIN) { p0_transpose_item(C.in[I_RWIN] + (size_t)li * DM * RIN, DM, RIN, (bf16_t*)(C.ws + WS_WRIN) + (size_t)li * RINP * DM, scr, r, lane); continue; } r -= I_RIN;
            p0_transpose_item(C.in[I_RWOUT] + (size_t)li * DM * DM, DM, DM, (bf16_t*)(C.ws + WS_WROUT) + (size_t)li * DM * DM, scr, r, lane);
        }
        for (int e = gw * 64 + lane; e < 2 * (RINP - RIN) * DM / 8; e += NGW * 64) { const int li = e / ((RINP - RIN) * DM / 8), o = e % ((RINP - RIN) * DM / 8);
            U4 z; z.x = z.y = z.z = z.w = 0u; st16((bf16_t*)(C.ws + WS_WRIN) + (size_t)li * RINP * DM + (size_t)RIN * DM + (size_t)o * 8, z); }
    }
    {
        float* ADA = (float*)(C.ws + WS_ADA); float* part = (float*)lds;
        SYNC();
        for (int it = C.vcu; it < 4 * 48; it += C.G) {
            const int layer = it / 48, cb = it % 48, col = cb * 64 + lane, i = layer >> 1;
            const float* W = (layer & 1) ? C.in[I_RADAW] + (size_t)i * DM * 3072 : C.in[I_AADAW] + (size_t)i * DM * 3072;
            const float* B = (layer & 1) ? C.in[I_RADAB] + (size_t)i * 3072 : C.in[I_AADAB] + (size_t)i * 3072;
            float a0 = 0.f, a1 = 0.f;
            for (int k0 = 128 * C.wave; k0 < 128 * C.wave + 128; k0 += 64) {
                const float sc = silu_f(C.in[I_C][k0 + lane]), sx = silu_f(C.in[I_CCTX][k0 + lane]);
                UNR for (int kb = 0; kb < 64; kb += 16) {
                    float w[16]; UNR for (int k = 0; k < 16; ++k) w[k] = W[(size_t)(k0 + kb + k) * 3072 + col];
                    UNR for (int k = 0; k < 16; ++k) { a0 += shfl_f(sc, kb + k) * w[k]; a1 += shfl_f(sx, kb + k) * w[k]; }
                }
            }
            part[(C.wave * 2 + 0) * 64 + lane] = a0; part[(C.wave * 2 + 1) * 64 + lane] = a1;
            SYNC();
            if (C.wave < 2) { float s_ = B[col]; UNR for (int w = 0; w < NWAVES; ++w) s_ += part[(w * 2 + C.wave) * 64 + lane]; ADA[(size_t)(layer * 2 + C.wave) * 3072 + col] = s_; }
            SYNC();
        }
    }
    for (int i = 0; i < 2; ++i)
        hid_rows<true>(C.in[I_HW1] + (size_t)i * 33 * 64, C.in[I_HB1] + i * 64, C.in[I_HW2] + (size_t)i * 64 * 64, C.in[I_HB2] + i * 64, (float*)((bf16_t*)(C.ws + WS_HID) + (size_t)i * NLAT * 64), NLAT, gw, NGW, lane);
    hid_rows<false>(C.in[I_HW1], C.in[I_HB1], C.in[I_HW2], C.in[I_HB2], (float*)(C.ws + WS_HID256), NCTX, gw, NGW, lane);
    r2_build_bfrag(C);
    { F2* TW = (F2*)(C.ws + WS_TW);
      for (int k = gw * 64 + lane; k <= 16384; k += NGW * 64) { float s, c; sincospi_f((float)k * (1.0f / 16384.0f), &s, &c); F2 w; w.x = c; w.y = -s; TW[k] = w; } }
}

DEVFN void ph_norm(const Ctx& C, int layer, const float* xlat, const float* xctx, bool do_ctx) {
    const int gw = C.vcu * NWAVES + C.wave, NGW = C.G * NWAVES, lane = C.lane, i = layer >> 1;
    const float* gain = ((layer & 1) ? C.in[I_RNORM] : C.in[I_ANORM]) + (size_t)i * DM;
    const float* ADA = (const float*)(C.ws + WS_ADA) + (size_t)layer * 2 * 3072;
    bf16_t* XN = (bf16_t*)(C.ws + WS_XN);
    const int nrows = do_ctx ? NTOK : NLAT;
    for (int m = gw; m < nrows; m += NGW) {
        const bool isctx = m >= NLAT;
        const float* xr = isctx ? xctx + (size_t)(m - NLAT) * DM : xlat + (size_t)m * DM;
        const float* ada = ADA + (isctx ? 3072 : 0);
        F4 v[4]; float s = 0.f;
        UNR for (int j = 0; j < 4; ++j) { v[j] = *(const F4*)(xr + 256 * j + 4 * lane); s += (v[j].x * v[j].x + v[j].y * v[j].y) + (v[j].z * v[j].z + v[j].w * v[j].w); }
        const float rs = 1.0f / sqrtf(wave_sum(s) * (1.0f / DM) + NORM_EPS);
        UNR for (int j = 0; j < 4; ++j) { const int c0 = 256 * j + 4 * lane;
            const F4 g = *(const F4*)(gain + c0), sh = *(const F4*)(ada + c0), sc = *(const F4*)(ada + 1024 + c0);
            U2 o; o.x = pk2(v[j].x * rs * g.x * (1.f + sc.x) + sh.x, v[j].y * rs * g.y * (1.f + sc.y) + sh.y);
            o.y = pk2(v[j].z * rs * g.z * (1.f + sc.z) + sh.z, v[j].w * rs * g.w * (1.f + sc.w) + sh.w);
            *(U2*)(XN + (size_t)m * DM + c0) = o; }
    }
}

DEVFN void ph_final(const Ctx& C) {
    const int gw = C.vcu * NWAVES + C.wave, NGW = C.G * NWAVES, lane = C.lane;
    const float* gain = C.in[I_FNORM];
    for (int m = gw; m < NLAT; m += NGW) {
        float* xr = C.out + (size_t)m * DM;
        F4 v[4]; float s = 0.f;
        UNR for (int j = 0; j < 4; ++j) { v[j] = *(const F4*)(xr + 256 * j + 4 * lane); s += (v[j].x * v[j].x + v[j].y * v[j].y) + (v[j].z * v[j].z + v[j].w * v[j].w); }
        const float rs = 1.0f / sqrtf(wave_sum(s) * (1.0f / DM) + NORM_EPS);
        UNR for (int j = 0; j < 4; ++j) { const int c0 = 256 * j + 4 * lane; const F4 g = *(const F4*)(gain + c0);
            F4 o; o.x = v[j].x * rs * g.x; o.y = v[j].y * rs * g.y; o.z = v[j].z * rs * g.z; o.w = v[j].w * rs * g.w; *(F4*)(xr + c0) = o; }
    }
}

DEVFN void ph_qkprep(const Ctx& C, int i) {
    const int gw = C.vcu * NWAVES + C.wave, NGW = C.G * NWAVES, lane = C.lane;
    bf16_t* U = (bf16_t*)(C.ws + WS_U);
    const float qg = C.in[I_QG][i * 64 + lane], kg = C.in[I_KG][i * 64 + lane];
    const int axis = lane >> 5, half = (lane >> 4) & 1, f = lane & 15;
    const float invf = exp2f(-(float)f * (13.287712379549449f / 16.0f));
    for (int m = gw; m < NTOK; m += NGW) {
        float cs = 1.f, sn = 0.f;
        if (m < NLAT) { const float pos = (float)(axis == 0 ? (m >> 6) : (m & 63)); const float ang = pos * invf; cs = cosf(ang); sn = sinf(ang); }
        bf16_t* ur = U + (size_t)m * AIN + 2048;
        for (int h = 0; h < 10; ++h) {
            const float v = bf2f(ur[h * 64 + lane]);
            const float ss = wave_sum(v * v);
            float y = v * (1.0f / sqrtf(ss * (1.0f / 64.0f) + NORM_EPS)) * (h < 8 ? qg : kg);
            const float p = swap16_f(y);
            y = half == 0 ? y * cs - p * sn : y * cs + p * sn;
            if (h < 8) y *= C2;
            ur[h * 64 + lane] = (bf16_t)f2bf(y);
        }
    }
}

DEVFN void ph_hyprep(const Ctx& C, int i, bool do_ctx, unsigned char* lds) {
    const int tid = C.tid;
    const bf16_t* UHY = (const bf16_t*)(C.ws + WS_UHY);
    const float* taps = C.in[I_HSHORT] + (size_t)i * 3 * UHY_W;
    float* T = (float*)lds;
    const int ntile_lat = 3 * 8 * 256, ntile = ntile_lat + (do_ctx ? 3 * 8 * 4 : 0);
    for (int it = C.vcu; it < ntile; it += C.G) {
        const bool isctx = it >= ntile_lat; const int r = isctx ? it - ntile_lat : it;
        const int ntb = isctx ? 4 : 256; const int tb = r % ntb, cb = (r / ntb) & 7, g = r / (ntb * 8);
        const int seg0 = isctx ? NLAT : 0, segn = isctx ? NCTX : NLAT;
        {
            const int tl = tid >> 3, c8 = (tid & 7) * 8, t = 64 * tb + tl, col = g * 512 + 64 * cb + c8;
            float um[8], u0[8], up[8];
            unpack8(ld16(UHY + (size_t)(seg0 + t) * UHY_W + col), u0);
            if (t > 0) unpack8(ld16(UHY + (size_t)(seg0 + t - 1) * UHY_W + col), um); else UNR for (int e = 0; e < 8; ++e) um[e] = 0.f;
            if (t < segn - 1) unpack8(ld16(UHY + (size_t)(seg0 + t + 1) * UHY_W + col), up); else UNR for (int e = 0; e < 8; ++e) up[e] = 0.f;
            UNR for (int e = 0; e < 8; ++e) T[(c8 + e) * 65 + tl] = um[e] * taps[col + e] + u0[e] * taps[UHY_W + col + e] + up[e] * taps[2 * UHY_W + col + e];
        }
        SYNC();
        {
            const int cl = tid >> 3, t8 = (tid & 7) * 8, ch = 64 * cb + cl;
            float v[8]; UNR for (int e = 0; e < 8; ++e) v[e] = T[cl * 65 + t8 + e];
            if (!isctx) { bf16_t* VX = (bf16_t*)(C.ws + (g == 0 ? WS_VX0 : g == 1 ? WS_VX1 : WS_VX2)); st16(VX + (size_t)ch * NLAT + 64 * tb + t8, pack8(v)); }
            else { float* VXC = (float*)(C.ws + WS_VXC) + ((size_t)g * 512 + ch) * NCTX + 64 * tb + t8; UNR for (int e = 0; e < 8; ++e) VXC[e] = v[e]; }
        }
        SYNC();
    }
}

typedef float P2 __attribute__((vector_size(8)));
#ifdef EMU
struct H8 { unsigned short v[8]; };
struct A4 { float v[4]; };
inline A4 mfma16(const H8& a, const H8& b, const A4& c) {
    static H8 sa_[emu::MAXB][8][64], sb_[emu::MAXB][8][64]; const int w = emu::t_tid >> 6, l = emu::t_tid & 63; H8 (*sa)[64] = sa_[emu::t_blk]; H8 (*sb)[64] = sb_[emu::t_blk];
    sa[w][l] = a; sb[w][l] = b; pthread_barrier_wait(&emu::g_wbar_[emu::t_blk][w]);
    A4 r = c;
    for (int reg = 0; reg < 4; ++reg) { const int row = 4 * (l >> 4) + reg, col = l & 15; float acc = 0.f;
        for (int k = 0; k < 32; ++k) acc += bf2f(sa[w][row + 16 * (k >> 3)].v[k & 7]) * bf2f(sb[w][col + 16 * (k >> 3)].v[k & 7]);
        r.v[reg] += acc; }
    pthread_barrier_wait(&emu::g_wbar_[emu::t_blk][w]);
    return r;
}
#define H8_SET(h, j, x) (h).v[j] = (unsigned short)(x)
#define A4_GET(a, j) (a).v[j]
#define MFMA_PAD(a,b,c,d,e,f,g,h)
#else
typedef short H8 __attribute__((ext_vector_type(8)));
typedef float A4 __attribute__((ext_vector_type(4)));
DEVFN A4 mfma16(const H8& a, const H8& b, const A4& c) { return __builtin_amdgcn_mfma_f32_16x16x32_bf16(a, b, c, 0, 0, 0); }
#define H8_SET(h, j, x) (h)[j] = (short)(x)
#define A4_GET(a, j) (a)[j]
#define MFMA_PAD(a,b,c,d,e,f,g,h) asm volatile("s_nop 15\n\ts_nop 15" : "+v"(a), "+v"(b), "+v"(c), "+v"(d), "+v"(e), "+v"(f), "+v"(g), "+v"(h))
#endif
#ifdef EMU
#define FEXP(x) expf(x)
#define FLOG(x) logf(x)
#define FRCP(x) (1.0f / (x))
#define FRSQ(x) (1.0f / sqrtf(x))
#define SETPRIO(n)
#else
#define FEXP(x) __expf(x)
#define FLOG(x) __logf(x)
#define FRCP(x) __builtin_amdgcn_rcpf(x)
#define FRSQ(x) __builtin_amdgcn_rsqf(x)
#define SETPRIO(n) __builtin_amdgcn_s_setprio(n)
#endif
DEVFN H8 h8_from_u4(U4 w) { H8 r; H8_SET(r, 0, w.x & 0xffff); H8_SET(r, 1, w.x >> 16); H8_SET(r, 2, w.y & 0xffff); H8_SET(r, 3, w.y >> 16); H8_SET(r, 4, w.z & 0xffff); H8_SET(r, 5, w.z >> 16); H8_SET(r, 6, w.w & 0xffff); H8_SET(r, 7, w.w >> 16); return r; }
constexpr int FFT_N = 16384;
DEVFN int fidx(int n) { return n + (n >> 4); }
DEVFN F2 cmul(F2 a, F2 b) { F2 r; r.x = a.x * b.x - a.y * b.y; r.y = a.x * b.y + a.y * b.x; return r; }
DEVFN F2 cmulc(F2 a, F2 b) { F2 r; r.x = a.x * b.x + a.y * b.y; r.y = a.y * b.x - a.x * b.y; return r; }
DEVFN F2 cadd(F2 a, F2 b) { F2 r; r.x = a.x + b.x; r.y = a.y + b.y; return r; }
DEVFN F2 csub(F2 a, F2 b) { F2 r; r.x = a.x - b.x; r.y = a.y - b.y; return r; }
DEVFN F2 cconj(F2 a) { F2 r; r.x = a.x; r.y = -a.y; return r; }
template <bool INV> DEVFN F2 mul_mi(F2 a) { F2 r; if (!INV) { r.x = a.y; r.y = -a.x; } else { r.x = -a.y; r.y = a.x; } return r; }
template <bool INV> DEVFN void dft4(F2& a0, F2& a1, F2& a2, F2& a3) {
    const F2 s02 = cadd(a0, a2), d02 = csub(a0, a2), s13 = cadd(a1, a3), d13 = mul_mi<INV>(csub(a1, a3));
    a0 = cadd(s02, s13); a2 = csub(s02, s13); a1 = cadd(d02, d13); a3 = csub(d02, d13);
}
template <bool INV> DEVFN void dft16(F2* a) {
    UNR for (int n2 = 0; n2 < 4; ++n2) dft4<INV>(a[n2], a[4 + n2], a[8 + n2], a[12 + n2]);
    const float c1 = 0.92387953251128674f, s1 = 0.38268343236508977f, r2 = 0.70710678118654752f;
    const F2 w1 = {c1, INV ? s1 : -s1}, w2 = {r2, INV ? r2 : -r2}, w3 = {s1, INV ? c1 : -c1}, w6 = {-r2, INV ? r2 : -r2}, w9 = {-c1, INV ? -s1 : s1};
    a[4 * 1 + 1] = cmul(a[4 * 1 + 1], w1); a[4 * 1 + 2] = cmul(a[4 * 1 + 2], w2); a[4 * 1 + 3] = cmul(a[4 * 1 + 3], w3);
    a[4 * 2 + 1] = cmul(a[4 * 2 + 1], w2); a[4 * 2 + 2] = mul_mi<INV>(a[4 * 2 + 2]); a[4 * 2 + 3] = cmul(a[4 * 2 + 3], w6);
    a[4 * 3 + 1] = cmul(a[4 * 3 + 1], w3); a[4 * 3 + 2] = cmul(a[4 * 3 + 2], w6); a[4 * 3 + 3] = cmul(a[4 * 3 + 3], w9);
    F2 x[16];
    UNR for (int k1 = 0; k1 < 4; ++k1) { F2 b0 = a[4 * k1 + 0], b1 = a[4 * k1 + 1], b2 = a[4 * k1 + 2], b3 = a[4 * k1 + 3]; dft4<INV>(b0, b1, b2, b3); x[k1] = b0; x[k1 + 4] = b1; x[k1 + 8] = b2; x[k1 + 12] = b3; }
    UNR for (int q = 0; q < 16; ++q) a[q] = x[q];
}
template <int R, bool INV> DEVFN void fft_stage(F2* F, const F2* TW, int B, int tid) {
    const int S = B / R, NB = FFT_N / R, tws = 2 * (FFT_N / B);
    int tq = tid; OPAQUE(tq);
    UNR1 for (int q = tq; q < NB; q += NTHREADS) {
        const int blk = q / S, j = q - blk * S, base = blk * B + j;
        F2 a[R];
        UNR for (int m = 0; m < R; ++m) a[m] = F[fidx(base + m * S)];
        if (INV && S > 1) { const F2 w1 = TW[tws * j]; F2 w = w1; UNR for (int m = 1; m < R; ++m) { a[m] = cmulc(a[m], w); w = cmul(w, w1); } }
        if constexpr (R == 4) dft4<INV>(a[0], a[1], a[2], a[3]); else dft16<INV>(a);
        if (!INV && S > 1) { const F2 w1 = TW[tws * j]; F2 w = w1; UNR for (int m = 1; m < R; ++m) { a[m] = cmul(a[m], w); w = cmul(w, w1); } }
        UNR for (int m = 0; m < R; ++m) F[fidx(base + m * S)] = a[m];
    }
}
DEVFN void fft_fwd(F2* F, const F2* TW, int tid) {
    fft_stage<4, false>(F, TW, 16384, tid); SYNC(); fft_stage<16, false>(F, TW, 4096, tid); SYNC(); fft_stage<16, false>(F, TW, 256, tid); SYNC(); fft_stage<16, false>(F, TW, 16, tid); SYNC();
}
DEVFN void fft_inv(F2* F, const F2* TW, int tid) {
    fft_stage<16, true>(F, TW, 16, tid); SYNC(); fft_stage<16, true>(F, TW, 256, tid); SYNC(); fft_stage<16, true>(F, TW, 4096, tid); SYNC(); fft_stage<4, true>(F, TW, 16384, tid); SYNC();
}
DEVFN int fpos(int k) { return ((k & 3) << 12) | (((k >> 2) & 15) << 8) | (((k >> 6) & 15) << 4) | (k >> 10); }

DEVFN float block_sum(float v, float* red, int tid) {
    v = wave_sum(v);
    if ((tid & 63) == 0) red[tid >> 6] = v;
    SYNC();
    float s = 0.f; UNR for (int w = 0; w < NWAVES; ++w) s += red[w];
    SYNC();
    return s;
}

#ifdef EMU
#define SCHED_BAR()
#else
#define SCHED_BAR() __builtin_amdgcn_sched_barrier(0)
#endif
#if defined(HSEC)
#define HS_B(k) do { if (HSEC == (k)) { TACC_BEGIN; } } while (0)
#define HS_E(k) do { if (HSEC == (k)) { TACC_END; } } while (0)
#else
#define HS_B(k)
#define HS_E(k)
#endif
DEVFN void hyena_channel(const Ctx& C, int i, int c, unsigned char* lds) {
    const int tid = C.tid; constexpr int L = NLAT;
    F2* F = (F2*)lds; float* Ff = (float*)lds;
    float* W3C = (float*)(lds + 139264);
    float* red = W3C + 272;
    const F2* TW = (const F2*)(C.ws + WS_TW);
    const bf16_t* hidb = (const bf16_t*)(C.ws + WS_HID) + (size_t)i * NLAT * 64;
    const float* w3 = C.in[I_HW3] + (size_t)i * 64 * 2048; const float* b3 = C.in[I_HB3] + (size_t)i * 2048;
    const bf16_t* VX0 = (const bf16_t*)(C.ws + WS_VX0) + (size_t)c * L;
    const bf16_t* VX1 = (const bf16_t*)(C.ws + WS_VX1) + (size_t)c * L;
    const bf16_t* VX2 = (const bf16_t*)(C.ws + WS_VX2) + (size_t)c * L;
    bf16_t* YHY = (bf16_t*)(C.ws + WS_YHY) + (size_t)c * L;
    const float skip0 = C.in[I_HSKIP][(size_t)i * 1024 + c], skip1 = C.in[I_HSKIP][(size_t)i * 1024 + 512 + c];
    const float delta = 15.350567286626973f + (float)c * ((3.0701134573253945f - 15.350567286626973f) / 511.0f);
    if (tid < 256) { const int o = tid >> 7, s = (tid >> 6) & 1, m = tid & 63; W3C[tid] = w3[(size_t)m * 2048 + (s * 2 + o) * 512 + c]; }
    if (tid < 4) W3C[256 + tid] = b3[((tid & 1) * 2 + (tid >> 1)) * 512 + c];
    SYNC();
    TACC_DECL;
    unsigned ktap1[32];
    UNR1 for (int o = 0; o < 2; ++o) {
        HS_B(1);
        float ssq = 0.f, af0_ = 0.f, ab0_ = 0.f;
        if (o == 0) {
            int tqa = tid; OPAQUE(tqa); const int lane = tqa & 63, wv = tqa >> 6, l15 = lane & 15, kg = lane >> 4, rr = l15 & 3, gq = l15 >> 2;
            H8 Ag[4][2];
            { float f0[8], f1[8]; UNR for (int j = 0; j < 8; ++j) { f0[j] = W3C[rr * 64 + 8 * kg + j]; f1[j] = W3C[rr * 64 + 32 + 8 * kg + j]; }
              const U4 w0 = pack8(f0), w1 = pack8(f1);
              UNR for (int g = 0; g < 4; ++g) { const unsigned m_ = gq == g ? 0xffffffffu : 0u; U4 a0, a1; a0.x = w0.x & m_; a0.y = w0.y & m_; a0.z = w0.z & m_; a0.w = w0.w & m_; a1.x = w1.x & m_; a1.y = w1.y & m_; a1.z = w1.z & m_; a1.w = w1.w & m_;
                  Ag[g][0] = h8_from_u4(a0); Ag[g][1] = h8_from_u4(a1); } }
            const float b00 = W3C[256 + 0], b01 = W3C[256 + 1], b10 = W3C[256 + 2], b11 = W3C[256 + 3];
            const bf16_t* hp = hidb + (size_t)l15 * 64 + 8 * kg;
            U4 bb[4][8];
#define HY_LOADB(II) do { UNR for (int g = 0; g < 4; ++g) { bb[(II) & 3][2 * g] = ld16(hp + (size_t)(((II) * 8 + wv) * 64 + 16 * g) * 64); bb[(II) & 3][2 * g + 1] = ld16(hp + (size_t)(((II) * 8 + wv) * 64 + 16 * g) * 64 + 32); } } while (0)
            HY_LOADB(0); HY_LOADB(1); HY_LOADB(2);
            UNR for (int ii = 0; ii < 32; ++ii) {
                const int t0 = (ii * 8 + wv) * 64;
                if (ii + 3 < 32) HY_LOADB(ii + 3);
                SCHED_BAR();
                A4 acc; A4_GET(acc, 0) = 0.f; A4_GET(acc, 1) = 0.f; A4_GET(acc, 2) = 0.f; A4_GET(acc, 3) = 0.f;
                UNR for (int g = 0; g < 4; ++g) { acc = mfma16(Ag[g][0], h8_from_u4(bb[ii & 3][2 * g]), acc); acc = mfma16(Ag[g][1], h8_from_u4(bb[ii & 3][2 * g + 1]), acc); }
                MFMA_PAD(acc, acc, acc, acc, acc, acc, acc, acc);
                int ln_ = lane; OPAQUE(ln_); const int t = t0 + ln_;
                const float win = expf(-((float)t / (float)(L - 1)) * delta);
                const float af = (A4_GET(acc, 0) + b00) * win; const float ab = (A4_GET(acc, 1) + b01) * win;
                ktap1[ii] = pk2((A4_GET(acc, 2) + b10) * win, (A4_GET(acc, 3) + b11) * win);
                ssq += af * af + ab * ab; Ff[2 * fidx(t >> 1) + (t & 1)] = af; const int m = t == 0 ? L : 2 * L - t; Ff[2 * fidx(m >> 1) + (m & 1)] = ab;
                if (ii == 0) { af0_ = af; ab0_ = ab; }
                SCHED_BAR();
            }
#undef HY_LOADB
        } else {
            int tqb = tid; OPAQUE(tqb); const int lane = tqb & 63, wv = tqb >> 6;
            UNR for (int ii = 0; ii < 32; ++ii) {
                int ln_ = lane; OPAQUE(ln_); const int t = (ii * 8 + wv) * 64 + ln_; const float af = bflo(ktap1[ii]); const float ab = bfhi(ktap1[ii]);
                ssq += af * af + ab * ab; Ff[2 * fidx(t >> 1) + (t & 1)] = af; const int m = t == 0 ? L : 2 * L - t; Ff[2 * fidx(m >> 1) + (m & 1)] = ab;
                if (ii == 0) { af0_ = af; ab0_ = ab; }
                if ((ii & 3) == 3) SCHED_BAR();
            }
        }
        if (tid == 0) { Ff[0] = af0_ + ab0_; Ff[2 * fidx(L >> 1)] = 0.f; ssq += 2.f * af0_ * ab0_; }
        const float knorm = 1.0f / sqrtf(block_sum(ssq, red, tid)); HS_E(1);
        HS_B(2); fft_fwd(F, TW, tid); HS_E(2);
        HS_B(3);
        F2 kfa[16], kfb[16]; F2 kfh = {0.f, 0.f};
        int tq1 = tid; OPAQUE(tq1);
        UNR for (int ii = 0; ii < 16; ++ii) {
            const int k = tq1 + NTHREADS * ii;
            if (k == 0) { const F2 c0 = F[fidx(0)]; kfa[ii].x = (c0.x + c0.y) * knorm; kfa[ii].y = 0.f; kfb[ii].x = (c0.x - c0.y) * knorm; kfb[ii].y = 0.f;
                          const F2 ch = F[fidx(fpos(L / 2))]; kfh.x = ch.x * knorm; kfh.y = -ch.y * knorm; }
            else { const F2 ck = F[fidx(fpos(k))], cp = cconj(F[fidx(fpos(L - k))]);
                F2 e = cadd(ck, cp), od = csub(ck, cp); e.x *= 0.5f; e.y *= 0.5f; F2 oo; oo.x = 0.5f * od.y; oo.y = -0.5f * od.x;
                const F2 tt = cmul(TW[k], oo);
                kfa[ii] = cadd(e, tt); kfb[ii] = cconj(csub(e, tt)); kfa[ii].x *= knorm; kfa[ii].y *= knorm; kfb[ii].x *= knorm; kfb[ii].y *= knorm; }
            CFENCE();
        }
        SYNC(); HS_E(3);
        HS_B(4);
        UNR for (int ii = 0; ii < 4; ++ii) {
            int tq3 = tid; OPAQUE(tq3); const int t0 = 8 * (tq3 + NTHREADS * ii); float v[8];
            unpack8(ld16((o == 0 ? VX0 : (const bf16_t*)YHY) + t0), v);
            float* d = Ff + 2 * fidx(t0 >> 1); UNR for (int e = 0; e < 8; ++e) d[e] = v[e];
            float* zz = Ff + 2 * fidx((L + t0) >> 1); UNR for (int e = 0; e < 8; ++e) zz[e] = 0.f;
        }
        SYNC(); HS_E(4);
        HS_B(2); fft_fwd(F, TW, tid); HS_E(2);
        HS_B(3);
        int tq2 = tid; OPAQUE(tq2);
        UNR for (int ii = 0; ii < 16; ++ii) {
            const int k = tq2 + NTHREADS * ii;
            if (k == 0) { const F2 c0 = F[fidx(0)]; const float y0 = (c0.x + c0.y) * kfa[ii].x, yl = (c0.x - c0.y) * kfb[ii].x; F2 d; d.x = 0.5f * (y0 + yl); d.y = 0.5f * (y0 - yl); F[fidx(0)] = d;
                          const int ph = fidx(fpos(L / 2)); const F2 y = cmul(cconj(F[ph]), kfh); F[ph] = cconj(y); }
            else { const int pk = fidx(fpos(k)), pp = fidx(fpos(L - k)); const F2 ck = F[pk], cp = cconj(F[pp]);
                F2 e = cadd(ck, cp), od = csub(ck, cp); e.x *= 0.5f; e.y *= 0.5f; F2 oo; oo.x = 0.5f * od.y; oo.y = -0.5f * od.x;
                const F2 w = TW[k]; const F2 tt = cmul(w, oo);
                const F2 yk = cmul(cadd(e, tt), kfa[ii]), yp = cmul(cconj(csub(e, tt)), kfb[ii]);
                F2 ye = cadd(yk, cconj(yp)), yd = csub(yk, cconj(yp)); ye.x *= 0.5f; ye.y *= 0.5f; yd.x *= 0.5f; yd.y *= 0.5f;
                const F2 yo = cmulc(yd, w);
                F2 iyo; iyo.x = -yo.y; iyo.y = yo.x;
                F[pk] = cadd(ye, iyo); F[pp] = cconj(csub(ye, iyo)); }
            CFENCE();
        }
        SYNC(); HS_E(3);
        HS_B(2); fft_inv(F, TW, tid); HS_E(2);
        HS_B(4);
        UNR for (int ii = 0; ii < 4; ++ii) {
            int tq4 = tid; OPAQUE(tq4); const int t0 = 8 * (tq4 + NTHREADS * ii); const float* d = Ff + 2 * fidx(t0 >> 1);
            float y[8]; UNR for (int e = 0; e < 8; ++e) y[e] = d[e] * (1.0f / (float)FFT_N);
            if (o == 0) { float v[8], x1[8], r[8]; unpack8(ld16(VX0 + t0), v); unpack8(ld16(VX1 + t0), x1); UNR for (int e = 0; e < 8; ++e) r[e] = x1[e] * (y[e] + v[e] * skip0); st16(YHY + t0, pack8(r)); }
            else { float x2[8], zp[8], r[8]; unpack8(ld16(VX2 + t0), x2); unpack8(ld16(YHY + t0), zp); UNR for (int e = 0; e < 8; ++e) r[e] = x2[e] * (y[e] + zp[e] * skip1); st16(YHY + t0, pack8(r)); }
        }
        SYNC(); HS_E(4);
    }
    TACC_STORE(C, 39, C.vcu == C.G - 1 && tid == 0);
}

DEVFN void hyena_ctx_channel(const Ctx& C, int i, int c, unsigned char* lds) {
    const int tid = C.tid; constexpr int L = NCTX;
    float* KF = (float*)lds;
    float* Z = KF + 1024;
    float* red = Z + 256;
    float* W3C = red + 16;
    const float* hid = (const float*)(C.ws + WS_HID256);
    const float* w3 = C.in[I_HW3] + (size_t)i * 64 * 2048; const float* b3 = C.in[I_HB3] + (size_t)i * 2048;
    const float* VXC = (const float*)(C.ws + WS_VXC);
    const float delta = 15.350567286626973f + (float)c * ((3.0701134573253945f - 15.350567286626973f) / 511.0f);
    if (tid < 256) { const int o = tid >> 7, s = (tid >> 6) & 1, m = tid & 63; W3C[tid] = w3[(size_t)m * 2048 + (s * 2 + o) * 512 + c]; }
    if (tid < 4) W3C[256 + tid] = b3[((tid & 1) * 2 + (tid >> 1)) * 512 + c];
    SYNC();
    {
        const int o = tid >> 8, t = tid & 255;
        float af = W3C[256 + o * 2 + 0], ab = W3C[256 + o * 2 + 1];
        for (int m = 0; m < 64; ++m) { const float h = hid[t * 64 + m]; af += h * W3C[(o * 2 + 0) * 64 + m]; ab += h * W3C[(o * 2 + 1) * 64 + m]; }
        const float win = expf(-((float)t / (float)(L - 1)) * delta); af *= win; ab *= win;
        float ssq; if (t == 0) { af += ab; ab = 0.f; ssq = af * af; } else ssq = af * af + ab * ab;
        KF[(o * 2 + 0) * 256 + t] = af; KF[(o * 2 + 1) * 256 + t] = ab;
        ssq = wave_sum(ssq);
        if ((tid & 63) == 0) red[tid >> 6] = ssq;
        SYNC();
        const float tot = red[o * 4] + red[o * 4 + 1] + red[o * 4 + 2] + red[o * 4 + 3];
        const float kn = 1.0f / sqrtf(tot);
        KF[(o * 2 + 0) * 256 + t] = af * kn; KF[(o * 2 + 1) * 256 + t] = ab * kn;
    }
    float v = 0.f, x1 = 0.f, x2 = 0.f, z1 = 0.f;
    if (tid < 256) { v = VXC[((size_t)0 * 512 + c) * L + tid]; x1 = VXC[((size_t)1 * 512 + c) * L + tid]; x2 = VXC[((size_t)2 * 512 + c) * L + tid]; Z[tid] = v; }
    SYNC();
    for (int o = 0; o < 2; ++o) {
        float y = 0.f;
        if (tid < 256) { const int t = tid; const float* kf = KF + (o * 2) * 256; const float* kb = KF + (o * 2 + 1) * 256;
            for (int s = 0; s <= t; ++s) y += kf[t - s] * Z[s];
            for (int s = t + 1; s < L; ++s) y += kb[s - t] * Z[s]; }
        SYNC();
        if (tid < 256) { if (o == 0) { z1 = x1 * (y + v * C.in[I_HSKIP][(size_t)i * 1024 + c]); Z[tid] = z1; }
            else { const float r = x2 * (y + z1 * C.in[I_HSKIP][(size_t)i * 1024 + 512 + c]);
                const bf16_t* GHY = (const bf16_t*)(C.ws + WS_GHY); bf16_t* HO = (bf16_t*)(C.ws + WS_HYOUT);
                HO[(size_t)(NLAT + tid) * 512 + c] = (bf16_t)f2bf(r * bf2f(GHY[(size_t)(NLAT + tid) * 512 + c])); } }
        SYNC();
    }
}

constexpr int SC_T = 32;
constexpr int SC_R = 16;
constexpr int SC_BUF = 5 * SC_T * 64 + SC_T * SC_R;
DEVFN void rwkv_scan(const Ctx& C, int i, int h, int d, int rq, bool ctx_out, unsigned char* lds, int max_chunks) {
    const int tid = C.tid;
    float* sBUF = (float*)lds; float* sY = sBUF + 2 * SC_BUF; float* sWV = sY + 2 * SC_T * SC_R;
    const bf16_t* U = (const bf16_t*)(C.ws + WS_U);
    const float* mu = C.in[I_MU] + (size_t)i * 1664;
    const float* w0 = C.in[I_W0] + ((size_t)i * 2 + d) * 512 + 64 * h; const float* a0 = C.in[I_A0] + ((size_t)i * 2 + d) * 512 + 64 * h;
    const float* wup = C.in[I_WUP] + ((size_t)i * 2 + d) * 32 * 512 + 64 * h; const float* aup = C.in[I_AUP] + ((size_t)i * 2 + d) * 32 * 512 + 64 * h;
    const float* k_k = C.in[I_KK] + (size_t)i * 512 + 64 * h; const float* k_a = C.in[I_KA] + (size_t)i * 512 + 64 * h; const float* r_k = C.in[I_RK] + (size_t)i * 512 + 64 * h;
    bf16_t* Yd = (bf16_t*)(C.ws + (d == 0 ? WS_YF : WS_YB));
    float* BON = (float*)(C.ws + WS_BONUS) + (size_t)d * NTOK * 8;
    const bool is_scan = tid < 256;
    const int nchunks = NTOK / SC_T < max_chunks ? NTOK / SC_T : max_chunks;
    #define CHUNK_GEOM(ch, seg0, segn, R0) const bool isctx_ = (ch) < NCTX / SC_T; const int seg0 = isctx_ ? NLAT : 0, segn = isctx_ ? NCTX : NLAT; \
        const int cl_ = isctx_ ? (ch) : (ch) - NCTX / SC_T; const int R0 = d == 0 ? SC_T * cl_ : segn - SC_T * (cl_ + 1);
    const int ft = (tid & 255) >> 3, fp = tid & 7;
    float* sCN = sWV + 4 * 1280; float* sCN_base_ = sCN;
    if (tid < 64) { const int j = tid; sCN[j] = mu[64 * h + j]; sCN[64 + j] = mu[512 + 64 * h + j]; sCN[128 + j] = mu[1024 + 64 * h + j]; sCN[192 + j] = w0[j]; sCN[256 + j] = a0[j];
        sCN[320 + j] = k_k[j]; sCN[384 + j] = k_a[j]; sCN[448 + j] = r_k[j]; sCN[512 + j] = j < 32 ? mu[1536 + 32 * d + j] : mu[1600 + 32 * d + (j - 32)]; }
    U4* sBF = (U4*)(sCN_base_ + 640);
    { const int m = tid >> 8, nt = (tid >> 6) & 3, ln = tid & 63; const float* src = m == 0 ? wup : aup; float f[8];
      UNR for (int j = 0; j < 8; ++j) f[j] = src[(size_t)(8 * (ln >> 4) + j) * 512 + 16 * nt + (ln & 15)];
      sBF[tid] = pack8(f); }
    float* myWV = sWV + ((tid >> 6) & 3) * 1280; float* sWL = myWV; float* sAL = myWV + 512; bf16_t* sTDb = (bf16_t*)(myWV + 1024); bf16_t* sADb = sTDb + 256;
    const int rl = (tid & 255) >> 4, sp = tid & 15;
    float S0 = 0.f, S1 = 0.f, S2 = 0.f, S3 = 0.f;
    SYNC();
    U4 pu[9]; U2 pw[6];
    auto issue = [&](int ch) {
        int tq_ = tid; OPAQUE(tq_); const int ft = (tq_ & 255) >> 3, fp = tq_ & 7;
        CHUNK_GEOM(ch, seg0, segn, R0)
        const int tl = d == 0 ? R0 + ft : R0 + SC_T - 1 - ft;
        const bf16_t* u0p = U + (size_t)(seg0 + tl) * URW_W;
        const bool hm = tl > 0, hp = tl < segn - 1;
        const U4 z4 = {0u, 0u, 0u, 0u}; const U2 z2 = {0u, 0u};
        const int cw = 1536 + 32 * d + 4 * fp, ca = 1600 + 32 * d + 4 * fp;
        UNR for (int j = 0; j < 3; ++j) { pu[3 * j] = ld16(u0p + 512 * j + 64 * h + 8 * fp); pu[3 * j + 1] = z4; pu[3 * j + 2] = z4; }
        pw[0] = *(const U2*)(u0p + cw); pw[3] = *(const U2*)(u0p + ca); pw[1] = z2; pw[2] = z2; pw[4] = z2; pw[5] = z2;
        if (hm) { UNR for (int j = 0; j < 3; ++j) pu[3 * j + 1] = ld16(u0p - URW_W + 512 * j + 64 * h + 8 * fp); pw[1] = *(const U2*)(u0p - URW_W + cw); pw[4] = *(const U2*)(u0p - URW_W + ca); }
        if (hp) { UNR for (int j = 0; j < 3; ++j) pu[3 * j + 2] = ld16(u0p + URW_W + 512 * j + 64 * h + 8 * fp); pw[2] = *(const U2*)(u0p + URW_W + cw); pw[5] = *(const U2*)(u0p + URW_W + ca); }
    };
    auto features = [&](int ch) {
        int tq_ = tid; OPAQUE(tq_); const int ft = (tq_ & 255) >> 3, fp = tq_ & 7;
        const float* mu_r = sCN + 8 * fp; const float* mu_k = sCN + 64 + 8 * fp; const float* mu_v = sCN + 128 + 8 * fp; const float* c_w0 = sCN + 192 + 8 * fp; const float* c_a0 = sCN + 256 + 8 * fp;
        const float* c_kk = sCN + 320 + 8 * fp; const float* c_ka = sCN + 384 + 8 * fp; const float* c_rk = sCN + 448 + 8 * fp; const float* mu_w = sCN + 512 + 4 * fp; const float* mu_a = sCN + 544 + 4 * fp;
        CHUNK_GEOM(ch, seg0, segn, R0)
        float* B_ = sBUF + (ch & 1) * SC_BUF; float* sW = B_; float* sKD = B_ + SC_T * 64; float* sB = B_ + 2 * SC_T * 64; float* sKK = B_ + 3 * SC_T * 64; float* sR = B_ + 4 * SC_T * 64; float* sV = B_ + 5 * SC_T * 64;
        const int tl = d == 0 ? R0 + ft : R0 + SC_T - 1 - ft;
        float r[8], k[8], v[8];
        {
            float a[8], m[8], p[8];
            #define SHIFT3(J, MU, OUT) do { unpack8(pu[3 * (J)], a); unpack8(pu[3 * (J) + 1], m); unpack8(pu[3 * (J) + 2], p); \
                UNR for (int e = 0; e < 8; ++e) OUT[e] = a[e] + (0.5f * (m[e] + p[e]) - a[e]) * MU[e]; } while (0)
            SHIFT3(0, mu_r, r); SHIFT3(1, mu_k, k); SHIFT3(2, mu_v, v);
            #undef SHIFT3
        }
        {
            const U2 w0_ = pw[0], wm = pw[1], wp = pw[2], a0_ = pw[3], am = pw[4], ap = pw[5];
            const float wa[4] = {bflo(w0_.x), bfhi(w0_.x), bflo(w0_.y), bfhi(w0_.y)}, wmm[4] = {bflo(wm.x), bfhi(wm.x), bflo(wm.y), bfhi(wm.y)}, wpp[4] = {bflo(wp.x), bfhi(wp.x), bflo(wp.y), bfhi(wp.y)};
            const float aa[4] = {bflo(a0_.x), bfhi(a0_.x), bflo(a0_.y), bfhi(a0_.y)}, amm[4] = {bflo(am.x), bfhi(am.x), bflo(am.y), bfhi(am.y)}, app[4] = {bflo(ap.x), bfhi(ap.x), bflo(ap.y), bfhi(ap.y)};
            if (ch + 1 < nchunks) issue(ch + 1);
            const int tw = ft & 7;
            float tdv[4], adv[4];
            UNR for (int e = 0; e < 4; ++e) { const float x = wa[e] + (0.5f * (wmm[e] + wpp[e]) - wa[e]) * mu_w[e];
                tdv[e] = 1.0f - 2.0f * FRCP(1.0f + FEXP(2.0f * x));
                adv[e] = aa[e] + (0.5f * (amm[e] + app[e]) - aa[e]) * mu_a[e]; }
            U2 tq, aq; tq.x = pk2(tdv[0], tdv[1]); tq.y = pk2(tdv[2], tdv[3]); aq.x = pk2(adv[0], adv[1]); aq.y = pk2(adv[2], adv[3]);
            *(U2*)(sTDb + tw * 32 + 4 * fp) = tq; *(U2*)(sADb + tw * 32 + 4 * fp) = aq;
        }
        WAVE_SYNC();
        float wl[8], al[8];
        {
            const int lane = tid & 63, arow = lane & 7, kg = lane >> 4;
            const U4 ta = ld16(sTDb + arow * 32 + 8 * kg), aa_ = ld16(sADb + arow * 32 + 8 * kg);
            H8 At, Aa;
            H8_SET(At, 0, ta.x & 0xffff); H8_SET(At, 1, ta.x >> 16); H8_SET(At, 2, ta.y & 0xffff); H8_SET(At, 3, ta.y >> 16); H8_SET(At, 4, ta.z & 0xffff); H8_SET(At, 5, ta.z >> 16); H8_SET(At, 6, ta.w & 0xffff); H8_SET(At, 7, ta.w >> 16);
            H8_SET(Aa, 0, aa_.x & 0xffff); H8_SET(Aa, 1, aa_.x >> 16); H8_SET(Aa, 2, aa_.y & 0xffff); H8_SET(Aa, 3, aa_.y >> 16); H8_SET(Aa, 4, aa_.z & 0xffff); H8_SET(Aa, 5, aa_.z >> 16); H8_SET(Aa, 6, aa_.w & 0xffff); H8_SET(Aa, 7, aa_.w >> 16);
            A4 cw_[4], ca_[4];
            UNR for (int nt = 0; nt < 4; ++nt) {
                A4 z; A4_GET(z, 0) = 0.f; A4_GET(z, 1) = 0.f; A4_GET(z, 2) = 0.f; A4_GET(z, 3) = 0.f;
                cw_[nt] = mfma16(At, h8_from_u4(sBF[nt * 64 + (tid & 63)]), z); ca_[nt] = mfma16(Aa, h8_from_u4(sBF[(4 + nt) * 64 + (tid & 63)]), z);
            }
            MFMA_PAD(cw_[0], cw_[1], cw_[2], cw_[3], ca_[0], ca_[1], ca_[2], ca_[3]);
            if (lane < 32) { UNR for (int nt = 0; nt < 4; ++nt) UNR for (int rg = 0; rg < 4; ++rg) { const int tok = 4 * (lane >> 4) + rg; sWL[tok * 64 + 16 * nt + (lane & 15)] = A4_GET(cw_[nt], rg); sAL[tok * 64 + 16 * nt + (lane & 15)] = A4_GET(ca_[nt], rg); } }
            WAVE_SYNC();
            const int tw = ft & 7;
            { const F4 w0_ = *(const F4*)(sWL + tw * 64 + 8 * fp), w1_ = *(const F4*)(sWL + tw * 64 + 8 * fp + 4), a0_ = *(const F4*)(sAL + tw * 64 + 8 * fp), a1_ = *(const F4*)(sAL + tw * 64 + 8 * fp + 4);
              const F4 cw0 = *(const F4*)(c_w0), cw1 = *(const F4*)(c_w0 + 4), ca0 = *(const F4*)(c_a0), ca1 = *(const F4*)(c_a0 + 4);
              wl[0] = cw0.x + w0_.x; wl[1] = cw0.y + w0_.y; wl[2] = cw0.z + w0_.z; wl[3] = cw0.w + w0_.w; wl[4] = cw1.x + w1_.x; wl[5] = cw1.y + w1_.y; wl[6] = cw1.z + w1_.z; wl[7] = cw1.w + w1_.w;
              al[0] = ca0.x + a0_.x; al[1] = ca0.y + a0_.y; al[2] = ca0.z + a0_.z; al[3] = ca0.w + a0_.w; al[4] = ca1.x + a1_.x; al[5] = ca1.y + a1_.y; al[6] = ca1.z + a1_.z; al[7] = ca1.w + a1_.w; }
            WAVE_SYNC();
        }
        float kkv[8], ssq = 0.f;
        UNR for (int e = 0; e < 8; ++e) { kkv[e] = k[e] * c_kk[e]; ssq += kkv[e] * kkv[e]; }
        ssq = rowx_add<1>(ssq); ssq = rowx_add<2>(ssq); ssq = rowx_add<7>(ssq);
        const float kn = FRSQ(ssq + 1e-12f);
        float bon = 0.f; float o_w[8], o_kd[8], o_b[8], o_kk[8];
        UNR for (int e = 0; e < 8; ++e) {
            const float dec = FEXP(-0.60653066f * FRCP(1.0f + FEXP(-wl[e])));
            const float a = FRCP(1.0f + FEXP(-al[e]));
            const float kd = k[e] * (1.0f + (a - 1.0f) * c_ka[e]);
            const float kk = kkv[e] * kn;
            o_w[e] = dec; o_kd[e] = kd; o_b[e] = kk * a; o_kk[e] = kk;
            bon += r[e] * kd * c_rk[e];
        }
        { const int o = ft * 64 + 8 * fp;
          #define ST8(P, A) do { F4 x0_, x1_; x0_.x = A[0]; x0_.y = A[1]; x0_.z = A[2]; x0_.w = A[3]; x1_.x = A[4]; x1_.y = A[5]; x1_.z = A[6]; x1_.w = A[7]; *(F4*)((P) + o) = x0_; *(F4*)((P) + o + 4) = x1_; } while (0)
          ST8(sW, o_w); ST8(sKD, o_kd); ST8(sB, o_b); ST8(sKK, o_kk); ST8(sR, r);
          #undef ST8
        }
        if ((fp >> 1) == rq) { UNR for (int e = 0; e < 8; ++e) sV[ft * SC_R + 8 * (fp & 1) + e] = v[e]; }
        bon = rowx_add<1>(bon); bon = rowx_add<2>(bon); bon = rowx_add<7>(bon);
        if (fp == 0 && rq == 0) BON[(size_t)(seg0 + tl) * 8 + h] = 0.5f * bon;
    };
    auto store_y = [&](int ch) {
        CHUNK_GEOM(ch, seg0, segn, R0)
        if (isctx_ && !ctx_out) return;
        const float* Yb = sY + (ch & 1) * SC_T * SC_R;
        const int k = (tid & 255) >> 3, q = (tid & 7) * 2; const int tl = d == 0 ? R0 + k : R0 + SC_T - 1 - k;
        *(unsigned*)(Yd + (size_t)(seg0 + tl) * 512 + 64 * h + SC_R * rq + q) = pk2(Yb[k * SC_R + q], Yb[k * SC_R + q + 1]);
    };
    if (!is_scan) { issue(0); features(0); }
    SYNC();
    if (C.wave < 4) SETPRIO(3);
    TACC_DECL;
    for (int ch = 0; ch < nchunks; ++ch) {
        TACC_BEGIN;
        if (is_scan) {
            const float* B_ = sBUF + (ch & 1) * SC_BUF; const float* sW = B_; const float* sKD = B_ + SC_T * 64; const float* sB = B_ + 2 * SC_T * 64; const float* sKK = B_ + 3 * SC_T * 64; const float* sR = B_ + 4 * SC_T * 64; const float* sV = B_ + 5 * SC_T * 64;
            float* Yb = sY + (ch & 1) * SC_T * SC_R;
            float yk0 = 0.f, yk1 = 0.f, yp = 0.f;
#ifndef EMU
            {
                const unsigned ab = (unsigned)(uintptr_t)B_ + 16u * (unsigned)sp, av = (unsigned)(uintptr_t)sV + 4u * (unsigned)rl;
                P2 s01 = {S0, S1}, s23 = {S2, S3};
                asm volatile(SCAN_CHUNK_ASM : [s01] "+v"(s01), [s23] "+v"(s23), [yp] "+v"(yp), [yk0] "+v"(yk0), [yk1] "+v"(yk1) : [ab] "v"(ab), [av] "v"(av), [sp] "v"(sp) : SCAN_CHUNK_CLOBBERS);
                S0 = s01[0]; S1 = s01[1]; S2 = s23[0]; S3 = s23[1];
            }
#else
            for (int k = 0; k < SC_T; ++k) {
                const F4 kk4 = *(const F4*)(sKK + k * 64 + 4 * sp), w4 = *(const F4*)(sW + k * 64 + 4 * sp), b4 = *(const F4*)(sB + k * 64 + 4 * sp),
                         kd4 = *(const F4*)(sKD + k * 64 + 4 * sp), r4 = *(const F4*)(sR + k * 64 + 4 * sp);
                const float vi = sV[k * SC_R + rl];
                float sa = (S0 * kk4.x + S2 * kk4.z) + (S1 * kk4.y + S3 * kk4.w);
                const float t0 = S0 * w4.x + vi * kd4.x, t1 = S1 * w4.y + vi * kd4.y, t2 = S2 * w4.z + vi * kd4.z, t3 = S3 * w4.w + vi * kd4.w;
                sa = rowx_add<1>(sa); yp = rowx_add<1>(yp); sa = rowx_add<2>(sa); yp = rowx_add<2>(yp);
                sa = rowx_add<7>(sa); yp = rowx_add<7>(yp); sa = rowx_add<15>(sa); yp = rowx_add<15>(yp);
                if (sp == ((k + 15) & 15)) { if (k <= 16) yk0 = yp; else yk1 = yp; }
                S0 = t0 - sa * b4.x; S1 = t1 - sa * b4.y; S2 = t2 - sa * b4.z; S3 = t3 - sa * b4.w;
                yp = (S0 * r4.x + S2 * r4.z) + (S1 * r4.y + S3 * r4.w);
            }
#endif
            yp = rowx_add<1>(yp); yp = rowx_add<2>(yp); yp = rowx_add<7>(yp); yp = rowx_add<15>(yp);
            if (sp == 15) yk1 = yp;
            Yb[sp * SC_R + rl] = yk0; Yb[(sp + 16) * SC_R + rl] = yk1;
        } else {
            if (ch + 1 < nchunks) features(ch + 1);
            if (ch > 0) store_y(ch - 1);
        }
        TACC_END;
        SYNC();
    }
    TACC_STORE(C, is_scan ? 45 : 46, C.vcu == 0 && (tid == 0 || tid == 256));
    if (C.wave < 4) SETPRIO(0);
    if (!is_scan) store_y(nchunks - 1);
    #undef CHUNK_GEOM
}

DEVFN void ph_readout_hyout(const Ctx& C, int i, bool do_ctx, unsigned char* lds) {
    const int tid = C.tid;
    {
        const bf16_t* U = (const bf16_t*)(C.ws + WS_U); bf16_t* YF = (bf16_t*)(C.ws + WS_YF); const bf16_t* YB = (const bf16_t*)(C.ws + WS_YB);
        const float* BON = (const float*)(C.ws + WS_BONUS);
        const float* mu = C.in[I_MU] + (size_t)i * 1664 + 1024; const float* gnw = C.in[I_GNW] + (size_t)i * 512; const float* gnb = C.in[I_GNB] + (size_t)i * 512;
        const int rl = tid >> 6, c8 = (tid & 63) * 8, h = (tid & 63) >> 3;
        float muv[8], gw_[8], gb_[8];
        UNR for (int e = 0; e < 8; ++e) { muv[e] = mu[c8 + e]; gw_[e] = gnw[c8 + e]; gb_[e] = gnb[c8 + e]; }
        const int nrows = do_ctx ? NTOK : NLAT;
        for (int r0 = C.vcu * 8; r0 < nrows; r0 += C.G * 8) {
            const int row = r0 + rl; const bool isctx = row >= NLAT; const int seg0 = isctx ? NLAT : 0, segn = isctx ? NCTX : NLAT, tl = row - seg0;
            float yf[8], yb[8], y[8], a[8], m[8], p[8], g[8];
            unpack8(ld16(YF + (size_t)row * 512 + c8), yf); unpack8(ld16(YB + (size_t)row * 512 + c8), yb);
            float s = 0.f; UNR for (int e = 0; e < 8; ++e) { y[e] = yf[e] + yb[e]; s += y[e]; }
            s = rowx_add<1>(s); s = rowx_add<2>(s); s = rowx_add<7>(s);
            const float mean = s * (1.0f / 64.0f); float q = 0.f;
            UNR for (int e = 0; e < 8; ++e) { y[e] -= mean; q += y[e] * y[e]; }
            q = rowx_add<1>(q); q = rowx_add<2>(q); q = rowx_add<7>(q);
            const float rstd = 1.0f / sqrtf(q * (1.0f / 64.0f) + 64e-5f);
            const bf16_t* up = U + (size_t)row * URW_W + 1024 + c8;
            unpack8(ld16(up), a);
            if (tl > 0) unpack8(ld16(up - URW_W), m); else UNR for (int e = 0; e < 8; ++e) m[e] = 0.f;
            if (tl < segn - 1) unpack8(ld16(up + URW_W), p); else UNR for (int e = 0; e < 8; ++e) p[e] = 0.f;
            unpack8(ld16(U + (size_t)row * URW_W + 1664 + c8), g);
            const float bon = BON[(size_t)row * 8 + h] + BON[(size_t)NTOK * 8 + (size_t)row * 8 + h];
            float o[8];
            UNR for (int e = 0; e < 8; ++e) { const float v = a[e] + (0.5f * (m[e] + p[e]) - a[e]) * muv[e]; o[e] = (y[e] * rstd * gw_[e] + gb_[e] + bon * v) * g[e]; }
            st16(YF + (size_t)row * 512 + c8, pack8(o));
        }
    }
    {
        const bf16_t* YHY = (const bf16_t*)(C.ws + WS_YHY); const bf16_t* GHY = (const bf16_t*)(C.ws + WS_GHY); bf16_t* HO = (bf16_t*)(C.ws + WS_HYOUT);
        float* T = (float*)lds;
        for (int it = C.vcu; it < 256 * 8; it += C.G) {
            const int tb = it >> 3, cb = it & 7;
            { const int cl = tid >> 3, t8 = (tid & 7) * 8; float v[8]; unpack8(ld16(YHY + (size_t)(64 * cb + cl) * NLAT + 64 * tb + t8), v); UNR for (int e = 0; e < 8; ++e) T[cl * 65 + t8 + e] = v[e]; }
            SYNC();
            { const int tl = tid >> 3, c8 = (tid & 7) * 8; float g[8], o[8]; const size_t off = (size_t)(64 * tb + tl) * 512 + 64 * cb + c8;
              unpack8(ld16(GHY + off), g); UNR for (int e = 0; e < 8; ++e) o[e] = T[(c8 + e) * 65 + tl] * g[e]; st16(HO + off, pack8(o)); }
            SYNC();
        }
    }
}

constexpr int RC_T = 16, RC_RING = 7, RC_NPROD = 6;
constexpr int RS_KKD = 0, RS_RD = 2048, RS_KIT = 4096, RS_NBIT = 6144, RS_VT = 8192, RS_T = 9216, RS_P0 = 9728, RS_Q1 = 10240, RS_NQ2 = 10752, RS_GC = 11264, RS_BYTES = 11520;
constexpr int RW_TDAD = 0, RW_WL = 2048, RW_AL = 6144, RW_KIP = 2048, RW_BIP = 4096, RW_AM = 10240, RW_BYTES = 11264;
constexpr int RC_LDS_RING = 0, RC_LDS_WAVE = RC_RING * RS_BYTES, RC_LDS_BFR = RC_LDS_WAVE + RC_NPROD * RW_BYTES, RC_LDS_FLAGS = RC_LDS_BFR + 8192, RC_LDS_END = RC_LDS_FLAGS + 3 * 8 * 4;
static_assert(RC_LDS_END <= RING_BYTES, "rwkv chunked LDS");
#ifdef EMU
#include <sched.h>
#define SPIN_WAIT(cond) do { while (!(cond)) sched_yield(); __sync_synchronize(); } while (0)
#define LDS_FENCE() __sync_synchronize()
#else
#define SPIN_WAIT(cond) do { while (!(cond)) __builtin_amdgcn_s_sleep(1); asm volatile("" ::: "memory"); } while (0)
#define LDS_FENCE() asm volatile("s_waitcnt lgkmcnt(0)" ::: "memory")
#endif
#ifdef EMU
DEVFN float wave_sum_fast(float v) { v = rowx_add<1>(v); v = rowx_add<2>(v); v = rowx_add<7>(v); v = rowx_add<15>(v); return (shfl_f(v, 0) + shfl_f(v, 16)) + (shfl_f(v, 32) + shfl_f(v, 48)); }
#else
DEVFN float wave_sum_fast(float v) { v = rowx_add<1>(v); v = rowx_add<2>(v); v = rowx_add<7>(v); v = rowx_add<15>(v);
    const int i_ = __builtin_bit_cast(int, v);
    return (__builtin_bit_cast(float, __builtin_amdgcn_readlane(i_, 0)) + __builtin_bit_cast(float, __builtin_amdgcn_readlane(i_, 16))) + (__builtin_bit_cast(float, __builtin_amdgcn_readlane(i_, 32)) + __builtin_bit_cast(float, __builtin_amdgcn_readlane(i_, 48))); }
#endif
DEVFN int rc_pos(int k) { return (k & 32) | (((k >> 2) & 3) << 3) | (((k >> 4) & 1) << 2) | (k & 3); }
DEVFN H8 h8_from(U4 w) { H8 r; H8_SET(r, 0, w.x & 0xffff); H8_SET(r, 1, w.x >> 16); H8_SET(r, 2, w.y & 0xffff); H8_SET(r, 3, w.y >> 16); H8_SET(r, 4, w.z & 0xffff); H8_SET(r, 5, w.z >> 16); H8_SET(r, 6, w.w & 0xffff); H8_SET(r, 7, w.w >> 16); return r; }
DEVFN H8 h8_lo4(U2 w) { H8 r; H8_SET(r, 0, w.x & 0xffff); H8_SET(r, 1, w.x >> 16); H8_SET(r, 2, w.y & 0xffff); H8_SET(r, 3, w.y >> 16); H8_SET(r, 4, 0); H8_SET(r, 5, 0); H8_SET(r, 6, 0); H8_SET(r, 7, 0); return r; }
DEVFN H8 h8_zero() { H8 r; UNR for (int j = 0; j < 8; ++j) H8_SET(r, j, 0); return r; }
DEVFN H8 h8_pack2(const A4& a, const A4& b) { H8 r; UNR for (int j = 0; j < 4; ++j) { H8_SET(r, j, f2bf(A4_GET(a, j))); H8_SET(r, 4 + j, f2bf(A4_GET(b, j))); } return r; }
DEVFN H8 h8_pack1(const A4& a) { H8 r; UNR for (int j = 0; j < 4; ++j) { H8_SET(r, j, f2bf(A4_GET(a, j))); H8_SET(r, 4 + j, 0); } return r; }
DEVFN A4 a4_zero() { A4 z; A4_GET(z, 0) = 0.f; A4_GET(z, 1) = 0.f; A4_GET(z, 2) = 0.f; A4_GET(z, 3) = 0.f; return z; }

DEVFN void rwkv_chunked(const Ctx& C, int i, int h, int d, int vh, bool ctx_out, unsigned char* lds, int max_chunks) {
    const int tid = C.tid, lane = tid & 63, wave = tid >> 6;
    volatile unsigned* fl_ready = (volatile unsigned*)(lds + RC_LDS_FLAGS); volatile unsigned* fl_done0 = fl_ready + 8; volatile unsigned* fl_done1 = fl_done0 + 8;
    if (tid < 24) fl_ready[tid] = 0u;
    { U4* sBF = (U4*)(lds + RC_LDS_BFR); const int m = tid >> 8, nt = (tid >> 6) & 3, ln = tid & 63;
      const float* src = (m == 0 ? C.in[I_WUP] : C.in[I_AUP]) + ((size_t)i * 2 + d) * 32 * 512 + 64 * h; float f[8];
      UNR for (int j = 0; j < 8; ++j) f[j] = src[(size_t)(8 * (ln >> 4) + j) * 512 + 16 * nt + (ln & 15)];
      sBF[tid] = pack8(f); }
    SYNC();
    const int nchunks = (NTOK / RC_T) < max_chunks ? (NTOK / RC_T) : max_chunks;
    bf16_t* Yd = (bf16_t*)(C.ws + (d == 0 ? WS_YF : WS_YB));
    #define RC_GEOM(ch, seg0, segn, R0) const bool isctx_ = (ch) < NCTX / RC_T; const int seg0 = isctx_ ? NLAT : 0, segn = isctx_ ? NCTX : NLAT; \
        const int cl_ = isctx_ ? (ch) : (ch) - NCTX / RC_T; const int R0 = d == 0 ? RC_T * cl_ : segn - RC_T * (cl_ + 1);
    if (wave < 2) {
        const int vt = wave, kg = lane >> 4, l15 = lane & 15;
        A4 H0_ = a4_zero(), H1_ = a4_zero(), H2_ = a4_zero(), H3_ = a4_zero();
        for (int ch = 0; ch < nchunks; ++ch) {
            const int slot = ch % RC_RING; const unsigned char* rb = lds + RC_LDS_RING + slot * RS_BYTES;
            SPIN_WAIT(fl_ready[slot] == (unsigned)(ch + 1));
            const H8 Hb0 = h8_pack2(H0_, H1_), Hb1 = h8_pack2(H2_, H3_);
            const H8 Vb = kg < 2 ? h8_from(ld16(rb + RS_VT + ((16 * vt + l15) * 16 + 8 * kg) * 2)) : h8_zero();
            const H8 kkd0 = h8_from(ld16(rb + RS_KKD + (l15 * 64 + 8 * kg) * 2)), kkd1 = h8_from(ld16(rb + RS_KKD + (l15 * 64 + 32 + 8 * kg) * 2));
            const H8 rd0 = h8_from(ld16(rb + RS_RD + (l15 * 64 + 8 * kg) * 2)), rd1 = h8_from(ld16(rb + RS_RD + (l15 * 64 + 32 + 8 * kg) * 2));
            const H8 p0f = kg < 2 ? h8_from(ld16(rb + RS_P0 + (l15 * 16 + 8 * kg) * 2)) : h8_zero();
            const H8 q1f = kg < 2 ? h8_from(ld16(rb + RS_Q1 + (l15 * 16 + 8 * kg) * 2)) : h8_zero();
            const H8 tf = h8_lo4(*(const U2*)(rb + RS_T + (l15 * 16 + 4 * kg) * 2)), nq2f = h8_lo4(*(const U2*)(rb + RS_NQ2 + (l15 * 16 + 4 * kg) * 2));
            A4 X = mfma16(kkd0, Hb0, a4_zero()); X = mfma16(kkd1, Hb1, X); X = mfma16(p0f, Vb, X);
            A4 Y = mfma16(rd0, Hb0, a4_zero()); Y = mfma16(rd1, Hb1, Y); Y = mfma16(q1f, Vb, Y);
            const H8 Xb = h8_pack1(X);
            const A4 U_ = mfma16(tf, Xb, a4_zero());
            const H8 Ub = h8_pack1(U_);
            Y = mfma16(nq2f, Ub, Y);
            #define HUPD(Hx, kt) do { const int kr = 16 * (kt) + l15; \
                const H8 kif = kg < 2 ? h8_from(ld16(rb + RS_KIT + (kr * 16 + 8 * kg) * 2)) : h8_zero(); const H8 nbf = h8_lo4(*(const U2*)(rb + RS_NBIT + (kr * 16 + 4 * kg) * 2)); \
                Hx = mfma16(kif, Vb, Hx); Hx = mfma16(nbf, Ub, Hx); const F4 g = *(const F4*)(rb + RS_GC + (16 * (kt) + 4 * kg) * 4); \
                A4_GET(Hx, 0) *= g.x; A4_GET(Hx, 1) *= g.y; A4_GET(Hx, 2) *= g.z; A4_GET(Hx, 3) *= g.w; } while (0)
            HUPD(H0_, 0); HUPD(H1_, 1); HUPD(H2_, 2); HUPD(H3_, 3);
            #undef HUPD
            LDS_FENCE(); WAVE_SYNC();
            if (lane == 0) { if (vt == 0) fl_done0[slot] = (unsigned)(ch + 1); else fl_done1[slot] = (unsigned)(ch + 1); }
            { RC_GEOM(ch, seg0, segn, R0)
              if (!isctx_ || ctx_out) { UNR for (int rg = 0; rg < 4; ++rg) { const int t = 4 * kg + rg, tl = d == 0 ? R0 + t : R0 + RC_T - 1 - t;
                  Yd[(size_t)(seg0 + tl) * 512 + 64 * h + 32 * vh + 16 * vt + l15] = (bf16_t)f2bf(A4_GET(Y, rg)); } } }
        }
    } else {
        const int p = wave - 2, k = lane;
        unsigned char* wsb = lds + RC_LDS_WAVE + p * RW_BYTES;
        bf16_t* sTDAD = (bf16_t*)(wsb + RW_TDAD); float* sWL = (float*)(wsb + RW_WL); float* sAL = (float*)(wsb + RW_AL); bf16_t* sKIP = (bf16_t*)(wsb + RW_KIP); bf16_t* sBIP = (bf16_t*)(wsb + RW_BIP); float* sAM = (float*)(wsb + RW_AM);
        const bf16_t* U = (const bf16_t*)(C.ws + WS_U);
        const float* mu = C.in[I_MU] + (size_t)i * 1664;
        const float mu_r = mu[64 * h + k], mu_k = mu[512 + 64 * h + k], mu_v = mu[1024 + 64 * h + k], mu_l = k < 32 ? mu[1536 + 32 * d + k] : mu[1600 + 32 * d + (k - 32)];
        const float c_w0 = C.in[I_W0][((size_t)i * 2 + d) * 512 + 64 * h + k], c_a0 = C.in[I_A0][((size_t)i * 2 + d) * 512 + 64 * h + k];
        const float c_kk = C.in[I_KK][(size_t)i * 512 + 64 * h + k], c_ka = C.in[I_KA][(size_t)i * 512 + 64 * h + k], c_rk = C.in[I_RK][(size_t)i * 512 + 64 * h + k];
        float* BON = (float*)(C.ws + WS_BONUS) + (size_t)d * NTOK * 8;
        const U4* sBF = (const U4*)(lds + RC_LDS_BFR);
        const int lcol = k < 32 ? 1536 + 32 * d + k : 1600 + 32 * d + (k - 32);
        const int kg = lane >> 4, l15 = lane & 15, pk_ = rc_pos(k);
        for (int ch = p; ch < nchunks; ch += RC_NPROD) {
            RC_GEOM(ch, seg0, segn, R0)
            float ur[18], uk[18], uv[18], ul[18];
            UNR for (int j = 0; j < 18; ++j) { const int row = d == 0 ? R0 - 1 + j : R0 + 16 - j; const bool ok = row >= 0 && row < segn; const bf16_t* up = U + (size_t)(seg0 + (ok ? row : R0)) * URW_W;
                const float m_ = ok ? 1.f : 0.f; ur[j] = m_ * bf2f(up[64 * h + k]); uk[j] = m_ * bf2f(up[512 + 64 * h + k]); uv[j] = m_ * bf2f(up[1024 + 64 * h + k]); ul[j] = m_ * bf2f(up[lcol]); }
            UNR for (int t = 0; t < 16; ++t) { const int j = t + 1; const float x = ul[j] + (0.5f * (ul[j - 1] + ul[j + 1]) - ul[j]) * mu_l;
                const float val = k < 32 ? 1.0f - 2.0f * FRCP(1.0f + FEXP(2.0f * x)) : x; sTDAD[t * 64 + k] = (bf16_t)f2bf(val); }
            WAVE_SYNC();
            {
                const H8 At = h8_from(ld16(sTDAD + l15 * 64 + 8 * kg)), Aa = h8_from(ld16(sTDAD + l15 * 64 + 32 + 8 * kg));
                A4 cw_[4], ca_[4];
                UNR for (int nt = 0; nt < 4; ++nt) { cw_[nt] = mfma16(At, h8_from(sBF[nt * 64 + lane]), a4_zero()); ca_[nt] = mfma16(Aa, h8_from(sBF[(4 + nt) * 64 + lane]), a4_zero()); }
                MFMA_PAD(cw_[0], cw_[1], cw_[2], cw_[3], ca_[0], ca_[1], ca_[2], ca_[3]);
                UNR for (int nt = 0; nt < 4; ++nt) UNR for (int rg = 0; rg < 4; ++rg) { sWL[(4 * kg + rg) * 64 + 16 * nt + l15] = A4_GET(cw_[nt], rg); sAL[(4 * kg + rg) * 64 + 16 * nt + l15] = A4_GET(ca_[nt], rg); }
            }
            WAVE_SYNC();
            float fr[16], fkd[16], fb[16], fkk[16], flw[16], fv[16];
            UNR for (int t = 0; t < 16; ++t) { const int j = t + 1;
                const float r_ = ur[j] + (0.5f * (ur[j - 1] + ur[j + 1]) - ur[j]) * mu_r, k_ = uk[j] + (0.5f * (uk[j - 1] + uk[j + 1]) - uk[j]) * mu_k, v_ = uv[j] + (0.5f * (uv[j - 1] + uv[j + 1]) - uv[j]) * mu_v;
                const float kkraw = k_ * c_kk; const float ss = wave_sum_fast(kkraw * kkraw); const float kk_ = kkraw * FRSQ(ss + 1e-12f);
                const float x = -(c_w0 + sWL[t * 64 + k]); const float sp_ = fmaxf(x, 0.f) + FLOG(1.0f + FEXP(-fabsf(x)));
                const float lw_ = -FEXP(-sp_ - 0.5f);
                const float a = FRCP(1.0f + FEXP(-(c_a0 + sAL[t * 64 + k])));
                const float kd_ = k_ * (1.0f + (a - 1.0f) * c_ka);
                fr[t] = r_; fkd[t] = kd_; fb[t] = kk_ * a; fkk[t] = kk_; flw[t] = lw_; fv[t] = v_;
                const float bon = wave_sum_fast(r_ * kd_ * c_rk);
                if (vh == 0 && lane == 0) { const int tl = d == 0 ? R0 + t : R0 + RC_T - 1 - t; BON[(size_t)(seg0 + tl) * 8 + h] = 0.5f * bon; }
            }
            WAVE_SYNC();
            const int slot = ch % RC_RING; unsigned char* rb = lds + RC_LDS_RING + slot * RS_BYTES;
            if (ch >= RC_RING) SPIN_WAIT(fl_done0[slot] == (unsigned)(ch - RC_RING + 1) && fl_done1[slot] == (unsigned)(ch - RC_RING + 1));
            {
                bf16_t* rKKD = (bf16_t*)(rb + RS_KKD); bf16_t* rRD = (bf16_t*)(rb + RS_RD); bf16_t* rKIT = (bf16_t*)(rb + RS_KIT); bf16_t* rNBIT = (bf16_t*)(rb + RS_NBIT); bf16_t* rVT = (bf16_t*)(rb + RS_VT);
                float L = 0.f, e_prev = 1.f;
                UNR for (int t = 0; t < 16; ++t) { L += flw[t]; const float e = FEXP(L), ei = FEXP(-L);
                    rKKD[t * 64 + pk_] = (bf16_t)f2bf(fkk[t] * e_prev); rRD[t * 64 + pk_] = (bf16_t)f2bf(fr[t] * e);
                    const float ki_ = fkd[t] * ei, bi_ = fb[t] * ei; sKIP[t * 64 + pk_] = (bf16_t)f2bf(ki_); sBIP[t * 64 + pk_] = (bf16_t)f2bf(bi_);
                    rKIT[k * 16 + t] = (bf16_t)f2bf(ki_); rNBIT[k * 16 + t] = (bf16_t)f2bf(-bi_);
                    e_prev = e; }
                ((float*)(rb + RS_GC))[k] = e_prev;
                U4 w0_, w1_;
                if ((k >> 5) == vh) { w0_.x = pk2(fv[0], fv[1]); w0_.y = pk2(fv[2], fv[3]); w0_.z = pk2(fv[4], fv[5]); w0_.w = pk2(fv[6], fv[7]); w1_.x = pk2(fv[8], fv[9]); w1_.y = pk2(fv[10], fv[11]); w1_.z = pk2(fv[12], fv[13]); w1_.w = pk2(fv[14], fv[15]);
                    st16(rVT + (k & 31) * 16, w0_); st16(rVT + (k & 31) * 16 + 8, w1_); }
            }
            WAVE_SYNC();
            {
                const bf16_t* rKKD = (const bf16_t*)(rb + RS_KKD); const bf16_t* rRD = (const bf16_t*)(rb + RS_RD);
                const H8 ak0 = h8_from(ld16(rKKD + l15 * 64 + 8 * kg)), ak1 = h8_from(ld16(rKKD + l15 * 64 + 32 + 8 * kg)), ar0 = h8_from(ld16(rRD + l15 * 64 + 8 * kg)), ar1 = h8_from(ld16(rRD + l15 * 64 + 32 + 8 * kg));
                const H8 bb0 = h8_from(ld16(sBIP + l15 * 64 + 8 * kg)), bb1 = h8_from(ld16(sBIP + l15 * 64 + 32 + 8 * kg)), bk0 = h8_from(ld16(sKIP + l15 * 64 + 8 * kg)), bk1 = h8_from(ld16(sKIP + l15 * 64 + 32 + 8 * kg));
                A4 mA = mfma16(ak0, bb0, a4_zero()); mA = mfma16(ak1, bb1, mA);
                A4 mP = mfma16(ak0, bk0, a4_zero()); mP = mfma16(ak1, bk1, mP);
                A4 mQ1 = mfma16(ar0, bk0, a4_zero()); mQ1 = mfma16(ar1, bk1, mQ1);
                A4 mQ2 = mfma16(ar0, bb0, a4_zero()); mQ2 = mfma16(ar1, bb1, mQ2);
                MFMA_PAD(mA, mP, mQ1, mQ2, mA, mP, mQ1, mQ2);
                bf16_t* rP0 = (bf16_t*)(rb + RS_P0); bf16_t* rQ1 = (bf16_t*)(rb + RS_Q1); bf16_t* rNQ2 = (bf16_t*)(rb + RS_NQ2);
                UNR for (int rg = 0; rg < 4; ++rg) { const int t = 4 * kg + rg, s_ = l15;
                    sAM[t * 16 + s_] = t > s_ ? A4_GET(mA, rg) : 0.f;
                    rP0[t * 16 + s_] = (bf16_t)f2bf(t > s_ ? A4_GET(mP, rg) : 0.f); rQ1[t * 16 + s_] = (bf16_t)f2bf(t >= s_ ? A4_GET(mQ1, rg) : 0.f); rNQ2[t * 16 + s_] = (bf16_t)f2bf(t >= s_ ? -A4_GET(mQ2, rg) : 0.f); }
            }
            WAVE_SYNC();
            {
                const int j = l15; float x[16]; bf16_t* rT = (bf16_t*)(rb + RS_T);
                UNR for (int t = 0; t < 16; ++t) { float acc = t == j ? 1.f : 0.f;
                    UNR for (int s_ = 0; s_ < 16; ++s_) if (s_ < t) acc -= sAM[t * 16 + s_] * x[s_];
                    x[t] = acc; if (lane < 16) rT[t * 16 + j] = (bf16_t)f2bf(acc); }
            }
            LDS_FENCE();
            WAVE_SYNC();
            if (lane == 0) fl_ready[slot] = (unsigned)(ch + 1);
        }
    }
    #undef RC_GEOM
    SYNC();
}
constexpr int FR_SLOTS = 20, FR_FLOATS = 6 * 2048, FR_LEAD = 20;
constexpr size_t WS_FRING = WS_HYOUT;
static_assert((size_t)16 * FR_SLOTS * FR_FLOATS * 4 <= (size_t)NLAT * 512 * 2, "feature ring fits");
constexpr size_t CTL_FFLAG = 65536, CTL_FPOS = CTL_FFLAG + 16 * 520 * 4 * 4;
constexpr int SC2_R = 8, SC2_NWG = 8;
static_assert(CTL_FPOS + 64 * 64 <= CTL_ZERO_BYTES, "control words");
#ifdef EMU
DEVFN unsigned gld_u32(const unsigned* p) { __sync_synchronize(); return *(volatile const unsigned*)p; }
DEVFN void gst_u32(unsigned* p, unsigned v) { __sync_synchronize(); *(volatile unsigned*)p = v; __sync_synchronize(); }
DEVFN unsigned long long gld_u64(const unsigned long long* p) { return *(volatile const unsigned long long*)p; }
DEVFN void gst_u64(unsigned long long* p, unsigned long long v) { *(volatile unsigned long long*)p = v; }
#define VM_DRAIN() __sync_synchronize()
#define GSPIN_WAIT(cond) do { while (!(cond)) sched_yield(); __sync_synchronize(); } while (0)
#else
DEVFN unsigned gld_u32(const unsigned* p) { return __hip_atomic_load(p, __ATOMIC_RELAXED, __HIP_MEMORY_SCOPE_AGENT); }
DEVFN void gst_u32(unsigned* p, unsigned v) { __hip_atomic_store(p, v, __ATOMIC_RELAXED, __HIP_MEMORY_SCOPE_AGENT); }
DEVFN unsigned long long gld_u64(const unsigned long long* p) { return __hip_atomic_load(p, __ATOMIC_RELAXED, __HIP_MEMORY_SCOPE_AGENT); }
DEVFN void gst_u64(unsigned long long* p, unsigned long long v) { __hip_atomic_store(p, v, __ATOMIC_RELAXED, __HIP_MEMORY_SCOPE_AGENT); }
#define VM_DRAIN() asm volatile("s_waitcnt vmcnt(0)" ::: "memory")
#define GSPIN_WAIT(cond) do { unsigned sp__ = 0; while (!(cond)) { __builtin_amdgcn_s_sleep(2); if (++sp__ > (1u << 22)) break; } asm volatile("" ::: "memory"); } while (0)
#endif
DEVFN unsigned long long f2_bits(float a, float b) { union { float f[2]; unsigned long long u; } x; x.f[0] = a; x.f[1] = b; return x.u; }

DEVFN void rwkv_scan2(const Ctx& C, int i, int h, int d, int rq, bool ctx_out, unsigned char* lds, int max_chunks) {
    const int tid = C.tid, lane = tid & 63, wave = C.wave;
    float* sBUF = (float*)lds;
    float* sWV = sBUF + 3 * SC_BUF;
    float* sCN = sWV + 4 * 1280;
    U4* sBF = (U4*)(sCN + 640);
    volatile unsigned* lf = (volatile unsigned*)((unsigned char*)sBF + 8192);
    const int hd = h * 2 + d;
    const unsigned epoch = (unsigned)(i + 1), pbase = (unsigned)i * 100000u;
    {
    const float* mu = C.in[I_MU] + (size_t)i * 1664;
    const float* w0 = C.in[I_W0] + ((size_t)i * 2 + d) * 512 + 64 * h; const float* a0 = C.in[I_A0] + ((size_t)i * 2 + d) * 512 + 64 * h;
    const float* wup = C.in[I_WUP] + ((size_t)i * 2 + d) * 32 * 512 + 64 * h; const float* aup = C.in[I_AUP] + ((size_t)i * 2 + d) * 32 * 512 + 64 * h;
    const float* k_k = C.in[I_KK] + (size_t)i * 512 + 64 * h; const float* k_a = C.in[I_KA] + (size_t)i * 512 + 64 * h; const float* r_k = C.in[I_RK] + (size_t)i * 512 + 64 * h;
    if (tid < 64) { const int j = tid; sCN[j] = mu[64 * h + j]; sCN[64 + j] = mu[512 + 64 * h + j]; sCN[128 + j] = mu[1024 + 64 * h + j]; sCN[192 + j] = w0[j]; sCN[256 + j] = a0[j];
        sCN[320 + j] = k_k[j]; sCN[384 + j] = k_a[j]; sCN[448 + j] = r_k[j]; sCN[512 + j] = j < 32 ? mu[1536 + 32 * d + j] : mu[1600 + 32 * d + (j - 32)]; }
    { const int m = tid >> 8, nt = (tid >> 6) & 3, ln = tid & 63; const float* src = m == 0 ? wup : aup; float f[8];
      UNR for (int j = 0; j < 8; ++j) f[j] = src[(size_t)(8 * (ln >> 4) + j) * 512 + 16 * nt + (ln & 15)];
      sBF[tid] = pack8(f); }
    }
    if (tid < 32) lf[tid] = 0u;
    SYNC();
    const int nchunks = NTOK / SC_T < max_chunks ? NTOK / SC_T : max_chunks;
    #define CHUNK_GEOM(ch, seg0, segn, R0) const bool isctx_ = (ch) < NCTX / SC_T; const int seg0 = isctx_ ? NLAT : 0, segn = isctx_ ? NCTX : NLAT; \
        const int cl_ = isctx_ ? (ch) : (ch) - NCTX / SC_T; const int R0 = d == 0 ? SC_T * cl_ : segn - SC_T * (cl_ + 1);
    if (wave < 2) {
        bf16_t* Yd = (bf16_t*)(C.ws + (d == 0 ? WS_YF : WS_YB));
        const int rl = tid >> 4, sp = tid & 15;
        float S0 = 0.f, S1 = 0.f, S2 = 0.f, S3 = 0.f;
        for (int ch = 0; ch < nchunks; ++ch) {
            const int b = ch % 3;
            SPIN_WAIT(lf[0 * 3 + b] == (unsigned)(ch + 1) && lf[1 * 3 + b] == (unsigned)(ch + 1));
            const float* B_ = sBUF + b * SC_BUF; const float* sV = B_ + 5 * SC_T * 64;
            float yk0 = 0.f, yk1 = 0.f, yp = 0.f;
#ifndef EMU
            {
                const unsigned ab = (unsigned)(uintptr_t)B_ + 16u * (unsigned)sp, av = (unsigned)(uintptr_t)sV + 4u * (unsigned)rl;
                P2 s01 = {S0, S1}, s23 = {S2, S3};
                asm volatile(SCAN_CHUNK_ASM : [s01] "+v"(s01), [s23] "+v"(s23), [yp] "+v"(yp), [yk0] "+v"(yk0), [yk1] "+v"(yk1) : [ab] "v"(ab), [av] "v"(av), [sp] "v"(sp) : SCAN_CHUNK_CLOBBERS);
                S0 = s01[0]; S1 = s01[1]; S2 = s23[0]; S3 = s23[1];
            }
#else
            { const float* sW = B_; const float* sKD = B_ + SC_T * 64; const float* sB = B_ + 2 * SC_T * 64; const float* sKK = B_ + 3 * SC_T * 64; const float* sR = B_ + 4 * SC_T * 64;
              for (int k = 0; k < SC_T; ++k) {
                const F4 kk4 = *(const F4*)(sKK + k * 64 + 4 * sp), w4 = *(const F4*)(sW + k * 64 + 4 * sp), b4 = *(const F4*)(sB + k * 64 + 4 * sp),
                         kd4 = *(const F4*)(sKD + k * 64 + 4 * sp), r4 = *(const F4*)(sR + k * 64 + 4 * sp);
                const float vi = sV[k * SC_R + rl];
                float sa = (S0 * kk4.x + S2 * kk4.z) + (S1 * kk4.y + S3 * kk4.w);
                const float t0 = S0 * w4.x + vi * kd4.x, t1 = S1 * w4.y + vi * kd4.y, t2 = S2 * w4.z + vi * kd4.z, t3 = S3 * w4.w + vi * kd4.w;
                sa = rowx_add<1>(sa); yp = rowx_add<1>(yp); sa = rowx_add<2>(sa); yp = rowx_add<2>(yp);
                sa = rowx_add<7>(sa); yp = rowx_add<7>(yp); sa = rowx_add<15>(sa); yp = rowx_add<15>(yp);
                if (sp == ((k + 15) & 15)) { if (k <= 16) yk0 = yp; else yk1 = yp; }
                S0 = t0 - sa * b4.x; S1 = t1 - sa * b4.y; S2 = t2 - sa * b4.z; S3 = t3 - sa * b4.w;
                yp = (S0 * r4.x + S2 * r4.z) + (S1 * r4.y + S3 * r4.w);
              } }
#endif
            LDS_FENCE(); WAVE_SYNC();
            if (lane == 0) lf[8 + wave * 3 + b] = (unsigned)(ch + 1);
            yp = rowx_add<1>(yp); yp = rowx_add<2>(yp); yp = rowx_add<7>(yp); yp = rowx_add<15>(yp);
            if (sp == 15) yk1 = yp;
            { CHUNK_GEOM(ch, seg0, segn, R0)
              if (!isctx_ || ctx_out) { const int t0 = d == 0 ? R0 + sp : R0 + SC_T - 1 - sp, t1 = d == 0 ? R0 + sp + 16 : R0 + SC_T - 1 - (sp + 16);
                  Yd[(size_t)(seg0 + t0) * 512 + 64 * h + SC2_R * rq + rl] = (bf16_t)f2bf(yk0); Yd[(size_t)(seg0 + t1) * 512 + 64 * h + SC2_R * rq + rl] = (bf16_t)f2bf(yk1); } }
        }
    } else if (wave < 6) {
        const int p = wave - 2;
        const bf16_t* U = (const bf16_t*)(C.ws + WS_U); float* BON = (float*)(C.ws + WS_BONUS) + (size_t)d * NTOK * 8;
        float* RING = (float*)(C.ws + WS_FRING) + (size_t)hd * FR_SLOTS * FR_FLOATS; unsigned* FFLAG = (unsigned*)(C.ws + WS_CTL + CTL_FFLAG) + (size_t)hd * 520 * 4; unsigned* FPOS = (unsigned*)(C.ws + WS_CTL + CTL_FPOS) + (size_t)hd * 64;
        float* myWV = sWV + p * 1280; float* sWL = myWV; float* sAL = myWV + 512; bf16_t* sTDb = (bf16_t*)(myWV + 1024); bf16_t* sADb = sTDb + 256;
        const int fp = lane & 7, tw = lane >> 3;
        const float* mu_r = sCN + 8 * fp; const float* mu_k = sCN + 64 + 8 * fp; const float* mu_v = sCN + 128 + 8 * fp; const float* c_w0 = sCN + 192 + 8 * fp; const float* c_a0 = sCN + 256 + 8 * fp;
        const float* c_kk = sCN + 320 + 8 * fp; const float* c_ka = sCN + 384 + 8 * fp; const float* c_rk = sCN + 448 + 8 * fp; const float* mu_w = sCN + 512 + 4 * fp; const float* mu_a = sCN + 544 + 4 * fp;
        U4 pu[9]; U2 pw[6];
        auto issue = [&](int q) {
            const int ch = rq + SC2_NWG * q; if (ch >= nchunks) return;
            CHUNK_GEOM(ch, seg0, segn, R0)
            const int ft = 8 * p + tw, tl = d == 0 ? R0 + ft : R0 + SC_T - 1 - ft;
            const bf16_t* u0p = U + (size_t)(seg0 + tl) * URW_W; const bool hm = tl > 0, hp = tl < segn - 1;
            const U4 z4 = {0u, 0u, 0u, 0u}; const U2 z2 = {0u, 0u};
            const int cw = 1536 + 32 * d + 4 * fp, ca = 1600 + 32 * d + 4 * fp;
            UNR for (int j = 0; j < 3; ++j) { pu[3 * j] = ld16(u0p + 512 * j + 64 * h + 8 * fp); pu[3 * j + 1] = z4; pu[3 * j + 2] = z4; }
            pw[0] = *(const U2*)(u0p + cw); pw[3] = *(const U2*)(u0p + ca); pw[1] = z2; pw[2] = z2; pw[4] = z2; pw[5] = z2;
            if (hm) { UNR for (int j = 0; j < 3; ++j) pu[3 * j + 1] = ld16(u0p - URW_W + 512 * j + 64 * h + 8 * fp); pw[1] = *(const U2*)(u0p - URW_W + cw); pw[4] = *(const U2*)(u0p - URW_W + ca); }
            if (hp) { UNR for (int j = 0; j < 3; ++j) pu[3 * j + 2] = ld16(u0p + URW_W + 512 * j + 64 * h + 8 * fp); pw[2] = *(const U2*)(u0p + URW_W + cw); pw[5] = *(const U2*)(u0p + URW_W + ca); }
        };
        issue(0);
        const int npass = (nchunks - rq + SC2_NWG - 1) / SC2_NWG;
        for (int q = 0; q < npass; ++q) {
            const int ch = rq + SC2_NWG * q;
            if (ch >= FR_SLOTS) { const unsigned need = pbase + (unsigned)(ch - FR_SLOTS + 1);
                GSPIN_WAIT(gld_u32(FPOS + 0) >= need && gld_u32(FPOS + 8) >= need && gld_u32(FPOS + 16) >= need && gld_u32(FPOS + 24) >= need && gld_u32(FPOS + 32) >= need && gld_u32(FPOS + 40) >= need && gld_u32(FPOS + 48) >= need && gld_u32(FPOS + 56) >= need); }
            CHUNK_GEOM(ch, seg0, segn, R0)
            float* rec = RING + (size_t)(ch % FR_SLOTS) * FR_FLOATS;
            {
                const int ft = 8 * p + tw;
                const int tl = d == 0 ? R0 + ft : R0 + SC_T - 1 - ft;
                float r[8], k[8], v[8];
                {
                    float a[8], m[8], qq[8];
                    #define SHIFT3(J, MU, OUT) do { unpack8(pu[3 * (J)], a); unpack8(pu[3 * (J) + 1], m); unpack8(pu[3 * (J) + 2], qq); \
                        UNR for (int e = 0; e < 8; ++e) OUT[e] = a[e] + (0.5f * (m[e] + qq[e]) - a[e]) * MU[e]; } while (0)
                    SHIFT3(0, mu_r, r); SHIFT3(1, mu_k, k); SHIFT3(2, mu_v, v);
                    #undef SHIFT3
                }
                {
                    const U2 w0_ = pw[0], wm = pw[1], wp = pw[2], a0_ = pw[3], am = pw[4], ap = pw[5];
                    const float wa[4] = {bflo(w0_.x), bfhi(w0_.x), bflo(w0_.y), bfhi(w0_.y)}, wmm[4] = {bflo(wm.x), bfhi(wm.x), bflo(wm.y), bfhi(wm.y)}, wpp[4] = {bflo(wp.x), bfhi(wp.x), bflo(wp.y), bfhi(wp.y)};
                    const float aa[4] = {bflo(a0_.x), bfhi(a0_.x), bflo(a0_.y), bfhi(a0_.y)}, amm[4] = {bflo(am.x), bfhi(am.x), bflo(am.y), bfhi(am.y)}, app[4] = {bflo(ap.x), bfhi(ap.x), bflo(ap.y), bfhi(ap.y)};
                    issue(q + 1);
                    float tdv[4], adv[4];
                    UNR for (int e = 0; e < 4; ++e) { const float x = wa[e] + (0.5f * (wmm[e] + wpp[e]) - wa[e]) * mu_w[e];
                        tdv[e] = 1.0f - 2.0f * FRCP(1.0f + FEXP(2.0f * x));
                        adv[e] = aa[e] + (0.5f * (amm[e] + app[e]) - aa[e]) * mu_a[e]; }
                    U2 tq, aq; tq.x = pk2(tdv[0], tdv[1]); tq.y = pk2(tdv[2], tdv[3]); aq.x = pk2(adv[0], adv[1]); aq.y = pk2(adv[2], adv[3]);
                    *(U2*)(sTDb + tw * 32 + 4 * fp) = tq; *(U2*)(sADb + tw * 32 + 4 * fp) = aq;
                }
                WAVE_SYNC();
                float wl[8], al[8];
                {
                    const int arow = lane & 7, kg = lane >> 4;
                    const H8 At = h8_from_u4(ld16(sTDb + arow * 32 + 8 * kg)), Aa = h8_from_u4(ld16(sADb + arow * 32 + 8 * kg));
                    A4 cw_[4], ca_[4];
                    UNR for (int nt = 0; nt < 4; ++nt) { A4 z; A4_GET(z, 0) = 0.f; A4_GET(z, 1) = 0.f; A4_GET(z, 2) = 0.f; A4_GET(z, 3) = 0.f;
                        cw_[nt] = mfma16(At, h8_from_u4(sBF[nt * 64 + lane]), z); ca_[nt] = mfma16(Aa, h8_from_u4(sBF[(4 + nt) * 64 + lane]), z); }
                    MFMA_PAD(cw_[0], cw_[1], cw_[2], cw_[3], ca_[0], ca_[1], ca_[2], ca_[3]);
                    if (lane < 32) { UNR for (int nt = 0; nt < 4; ++nt) UNR for (int rg = 0; rg < 4; ++rg) { const int tok = 4 * (lane >> 4) + rg; sWL[tok * 64 + 16 * nt + (lane & 15)] = A4_GET(cw_[nt], rg); sAL[tok * 64 + 16 * nt + (lane & 15)] = A4_GET(ca_[nt], rg); } }
                    WAVE_SYNC();
                    UNR for (int e = 0; e < 8; ++e) { wl[e] = c_w0[e] + sWL[tw * 64 + 8 * fp + e]; al[e] = c_a0[e] + sAL[tw * 64 + 8 * fp + e]; }
                    WAVE_SYNC();
                }
                float kkv[8], ssq = 0.f;
                UNR for (int e = 0; e < 8; ++e) { kkv[e] = k[e] * c_kk[e]; ssq += kkv[e] * kkv[e]; }
                ssq = rowx_add<1>(ssq); ssq = rowx_add<2>(ssq); ssq = rowx_add<7>(ssq);
                const float kn = FRSQ(ssq + 1e-12f);
                float bon = 0.f; float o_w[8], o_kd[8], o_b[8], o_kk[8];
                UNR for (int e = 0; e < 8; ++e) {
                    const float dec = FEXP(-0.60653066f * FRCP(1.0f + FEXP(-wl[e])));
                    const float a = FRCP(1.0f + FEXP(-al[e]));
                    const float kd = k[e] * (1.0f + (a - 1.0f) * c_ka[e]);
                    const float kk = kkv[e] * kn;
                    o_w[e] = dec; o_kd[e] = kd; o_b[e] = kk * a; o_kk[e] = kk;
                    bon += r[e] * kd * c_rk[e];
                }
                { unsigned long long* rp = (unsigned long long*)(rec + ft * 64 + 8 * fp);
                  #define ST8(AR, A) do { UNR for (int e2 = 0; e2 < 4; ++e2) gst_u64(rp + (AR) * 1024 + e2, f2_bits(A[2 * e2], A[2 * e2 + 1])); } while (0)
                  ST8(0, o_w); ST8(1, o_kd); ST8(2, o_b); ST8(3, o_kk); ST8(4, r); ST8(5, v);
                  #undef ST8
                }
                bon = rowx_add<1>(bon); bon = rowx_add<2>(bon); bon = rowx_add<7>(bon);
                if (fp == 0) BON[(size_t)(seg0 + tl) * 8 + h] = 0.5f * bon;
            }
            VM_DRAIN(); if (lane == 0) gst_u32(FFLAG + (size_t)ch * 4 + p, epoch);
        }
    } else {
        const int w = wave - 6;
        const float* RING = (const float*)(C.ws + WS_FRING) + (size_t)hd * FR_SLOTS * FR_FLOATS; unsigned* FFLAG = (unsigned*)(C.ws + WS_CTL + CTL_FFLAG) + (size_t)hd * 520 * 4; unsigned* FPOS = (unsigned*)(C.ws + WS_CTL + CTL_FPOS) + (size_t)hd * 64;
        for (int ch = 0; ch < nchunks; ++ch) {
            const int b = ch % 3;
            if (ch >= 3) SPIN_WAIT(lf[8 + 0 * 3 + b] == (unsigned)(ch - 2) && lf[8 + 1 * 3 + b] == (unsigned)(ch - 2));
            GSPIN_WAIT(gld_u32(FFLAG + (size_t)ch * 4) == epoch && gld_u32(FFLAG + (size_t)ch * 4 + 1) == epoch && gld_u32(FFLAG + (size_t)ch * 4 + 2) == epoch && gld_u32(FFLAG + (size_t)ch * 4 + 3) == epoch);
            const unsigned long long* rec = (const unsigned long long*)(RING + (size_t)(ch % FR_SLOTS) * FR_FLOATS);
            float* B_ = sBUF + b * SC_BUF;
            { unsigned long long x[40], xv[2];
              UNR for (int j = 0; j < 40; ++j) x[j] = gld_u64(rec + (size_t)w * 2560 + j * 64 + lane);
              { const int idx = w * 64 + lane, tok = idx >> 2, c2 = idx & 3; xv[0] = gld_u64(rec + 5 * 1024 + tok * 32 + 4 * rq + c2); xv[1] = 0ull; }
              UNR for (int j = 0; j < 40; ++j) ((unsigned long long*)B_)[(size_t)w * 2560 + j * 64 + lane] = x[j];
              { const int idx = w * 64 + lane, tok = idx >> 2, c2 = idx & 3; ((unsigned long long*)(B_ + 5 * SC_T * 64))[tok * 8 + c2] = xv[0]; } }
            LDS_FENCE(); WAVE_SYNC();
            if (lane == 0) { lf[w * 3 + b] = (unsigned)(ch + 1); if (w == 0) gst_u32(FPOS + 8 * rq, pbase + (unsigned)(ch + 1)); }
        }
    }
    #undef CHUNK_GEOM
    SYNC();
}
constexpr int R2S_KKD = 0, R2S_RD = 2048, R2S_KN = 4096, R2S_VT = 8192, R2S_T = 10240, R2S_P0 = 10752, R2S_QQ = 11264, R2S_GC = 12288, R2S_BYTES = 12544, R2S_U64 = R2S_BYTES / 8;
constexpr int PW_TDAD = 0, PW_AM = 0, PW_WL = 2048, PW_AL = 6144, PW_REC = 2048, PW_KIP = PW_REC + R2S_BYTES, PW_BIP = PW_KIP + 2048, PW_BYTES = PW_BIP + 2048;
static_assert(8 * PW_BYTES <= RING_BYTES, "producer LDS");
#define R2_SWZ(t, p) (((((p) >> 3) ^ (((t) >> 1) & 7)) << 3) | ((p) & 7))
constexpr int R2_GSLOTS = 64, R2_LSLOTS = 12, R2_NCH = NTOK / RC_T;
constexpr size_t WS_R2RING = WS_HYOUT;
static_assert((size_t)16 * R2_GSLOTS * R2S_BYTES <= (size_t)NLAT * 512 * 2, "record ring fits");
constexpr size_t CTL_R2FLAG = 65536, CTL_R2POS = CTL_R2FLAG + (size_t)16 * R2_NCH * 4;
constexpr size_t CTL_R2TICKET = CTL_R2POS + 16 * 64;
static_assert(CTL_R2TICKET + 2 * 64 <= CTL_ZERO_BYTES, "control words");
constexpr size_t WS_BFRAG = WS_VXC + 1536 * 1024;
static_assert(WS_BFRAG + 2 * 16 * 8 * 64 * 16 <= WS_HID, "bfrag");

DEVFN void r2_build_bfrag(const Ctx& C) {
    const int gtid = (C.vcu * NWAVES + C.wave) * 64 + C.lane, gn = C.G * NTHREADS;
    for (int e = gtid; e < 2 * 16 * 8 * 64; e += gn) { const int ln = e & 63, nt = (e >> 6) & 3, m = (e >> 8) & 1, hd = (e >> 9) & 15, i = e >> 13; const int h = hd >> 1, d = hd & 1;
        const float* src = (m == 0 ? C.in[I_WUP] : C.in[I_AUP]) + ((size_t)i * 2 + d) * 32 * 512 + 64 * h; float f[8];
        UNR for (int j = 0; j < 8; ++j) f[j] = src[(size_t)(8 * (ln >> 4) + j) * 512 + 16 * nt + (ln & 15)];
        ((U4*)(C.ws + WS_BFRAG))[e] = pack8(f); }
}

#ifdef EMU
DEVFN int r2_take_ticket(unsigned* ticket, int lane) { unsigned v = 0; if (lane == 0) v = __sync_fetch_and_add(ticket, 1u); union { float f; unsigned u; } x; x.u = v; x.f = shfl_f(x.f, 0); return (int)x.u; }
#else
DEVFN int r2_take_ticket(unsigned* ticket, int lane) { unsigned v = 0; if (lane == 0) v = __hip_atomic_fetch_add(ticket, 1u, __ATOMIC_RELAXED, __HIP_MEMORY_SCOPE_AGENT); return __builtin_amdgcn_readfirstlane((int)v); }
#endif
#ifdef EMU
#define GSPIN_WAIT_SLOW(cond) GSPIN_WAIT(cond)
#else
#define GSPIN_WAIT_SLOW(cond) do { unsigned sp__ = 0; while (!(cond)) { __builtin_amdgcn_s_sleep(32); if (++sp__ > (1u << 20)) break; } asm volatile("" ::: "memory"); } while (0)
#endif
DEVFN void rc2_producer(const Ctx& C, int i, unsigned char* lds, unsigned* ticket, int hd0, int nhd, int max_chunks) {
    const int lane = C.lane, k = lane, kg = lane >> 4, l15 = lane & 15, pk_ = rc_pos(k);
    unsigned char* wsb = lds + C.wave * PW_BYTES;
    bf16_t* sTDAD = (bf16_t*)(wsb + PW_TDAD); float* sWL = (float*)(wsb + PW_WL); float* sAL = (float*)(wsb + PW_AL); bf16_t* sKIP = (bf16_t*)(wsb + PW_KIP); bf16_t* sBIP = (bf16_t*)(wsb + PW_BIP); float* sAM = (float*)(wsb + PW_AM);
    const bf16_t* U = (const bf16_t*)(C.ws + WS_U);
    const unsigned epoch = (unsigned)(i + 1), pbase = (unsigned)i * 100000u;
    const int nchunks = R2_NCH < max_chunks ? R2_NCH : max_chunks;
    const int nitems = nchunks * nhd;
    TACC_DECL;
    for (;;) {
        const int item = r2_take_ticket(ticket, lane); if (item >= nitems) break;
        const int ch = item / nhd, hd = hd0 + item % nhd, h = hd >> 1, d = hd & 1;
        unsigned* POS = (unsigned*)(C.ws + WS_CTL + CTL_R2POS) + 16 * hd;
        const float* mu = C.in[I_MU] + (size_t)i * 1664;
        const float mu_r = mu[64 * h + k], mu_k = mu[512 + 64 * h + k], mu_v = mu[1024 + 64 * h + k], mu_l = k < 32 ? mu[1536 + 32 * d + k] : mu[1600 + 32 * d + (k - 32)];
        const float c_w0 = C.in[I_W0][((size_t)i * 2 + d) * 512 + 64 * h + k], c_a0 = C.in[I_A0][((size_t)i * 2 + d) * 512 + 64 * h + k];
        const float c_kk = C.in[I_KK][(size_t)i * 512 + 64 * h + k], c_ka = C.in[I_KA][(size_t)i * 512 + 64 * h + k], c_rk = C.in[I_RK][(size_t)i * 512 + 64 * h + k];
        float* BON = (float*)(C.ws + WS_BONUS) + (size_t)d * NTOK * 8;
        const int lcol = k < 32 ? 1536 + 32 * d + k : 1600 + 32 * d + (k - 32);
        U4 bfw[4], bfa[4];
        { const U4* bt = (const U4*)(C.ws + WS_BFRAG) + ((size_t)i * 16 + hd) * 512; UNR for (int nt = 0; nt < 4; ++nt) { bfw[nt] = bt[nt * 64 + lane]; bfa[nt] = bt[(4 + nt) * 64 + lane]; } }
        const bool isctx_ = ch < NCTX / RC_T; const int seg0 = isctx_ ? NLAT : 0, segn = isctx_ ? NCTX : NLAT; const int cl_ = isctx_ ? ch : ch - NCTX / RC_T; const int R0 = d == 0 ? RC_T * cl_ : segn - RC_T * (cl_ + 1);
        {
            float ur[18], uk[18], uv[18], ul[18];
            UNR for (int j = 0; j < 18; ++j) { const int row = d == 0 ? R0 - 1 + j : R0 + 16 - j; const bool ok = row >= 0 && row < segn; const bf16_t* up = U + (size_t)(seg0 + (ok ? row : R0)) * URW_W;
                const float m_ = ok ? 1.f : 0.f; ur[j] = m_ * bf2f(up[64 * h + k]); uk[j] = m_ * bf2f(up[512 + 64 * h + k]); uv[j] = m_ * bf2f(up[1024 + 64 * h + k]); ul[j] = m_ * bf2f(up[lcol]); }
            UNR for (int t = 0; t < 16; ++t) { const int j = t + 1; const float x = ul[j] + (0.5f * (ul[j - 1] + ul[j + 1]) - ul[j]) * mu_l;
                const float val = k < 32 ? 1.0f - 2.0f * FRCP(1.0f + FEXP(2.0f * x)) : x; sTDAD[t * 64 + k] = (bf16_t)f2bf(val); }
            WAVE_SYNC();
            {
                const H8 At = h8_from(ld16(sTDAD + l15 * 64 + 8 * kg)), Aa = h8_from(ld16(sTDAD + l15 * 64 + 32 + 8 * kg));
                A4 cw_[4], ca_[4];
                UNR for (int nt = 0; nt < 4; ++nt) { cw_[nt] = mfma16(At, h8_from(bfw[nt]), a4_zero()); ca_[nt] = mfma16(Aa, h8_from(bfa[nt]), a4_zero()); }
                MFMA_PAD(cw_[0], cw_[1], cw_[2], cw_[3], ca_[0], ca_[1], ca_[2], ca_[3]);
                UNR for (int nt = 0; nt < 4; ++nt) UNR for (int rg = 0; rg < 4; ++rg) { sWL[(4 * kg + rg) * 64 + 16 * nt + l15] = A4_GET(cw_[nt], rg); sAL[(4 * kg + rg) * 64 + 16 * nt + l15] = A4_GET(ca_[nt], rg); }
            }
            WAVE_SYNC();
            float fr[16], fkd[16], fb[16], fkk[16], flw[16], fv[16];
            UNR for (int t = 0; t < 16; ++t) { const int j = t + 1;
                const float r_ = ur[j] + (0.5f * (ur[j - 1] + ur[j + 1]) - ur[j]) * mu_r, k_ = uk[j] + (0.5f * (uk[j - 1] + uk[j + 1]) - uk[j]) * mu_k, v_ = uv[j] + (0.5f * (uv[j - 1] + uv[j + 1]) - uv[j]) * mu_v;
                const float kkraw = k_ * c_kk; const float ss = wave_sum_fast(kkraw * kkraw); const float kk_ = kkraw * FRSQ(ss + 1e-12f);
                const float x = -(c_w0 + sWL[t * 64 + k]); const float sp_ = fmaxf(x, 0.f) + FLOG(1.0f + FEXP(-fabsf(x)));
                const float lw_ = -FEXP(-sp_ - 0.5f);
                const float a = FRCP(1.0f + FEXP(-(c_a0 + sAL[t * 64 + k])));
                const float kd_ = k_ * (1.0f + (a - 1.0f) * c_ka);
                fr[t] = r_; fkd[t] = kd_; fb[t] = kk_ * a; fkk[t] = kk_; flw[t] = lw_; fv[t] = v_;
                const float bon = wave_sum_fast(r_ * kd_ * c_rk);
                if (lane == 0) { const int tl = d == 0 ? R0 + t : R0 + RC_T - 1 - t; BON[(size_t)(seg0 + tl) * 8 + h] = 0.5f * bon; }
            }
            WAVE_SYNC();
            unsigned char* rb = wsb + PW_REC;
            {
                bf16_t* rKKD = (bf16_t*)(rb + R2S_KKD); bf16_t* rRD = (bf16_t*)(rb + R2S_RD); bf16_t* rKN = (bf16_t*)(rb + R2S_KN); bf16_t* rVT = (bf16_t*)(rb + R2S_VT);
                float L = 0.f, e_prev = 1.f;
                UNR for (int t = 0; t < 16; ++t) { L += flw[t]; const float e = FEXP(L), ei = FEXP(-L);
                    rKKD[t * 64 + R2_SWZ(t, pk_)] = (bf16_t)f2bf(fkk[t] * e_prev); rRD[t * 64 + R2_SWZ(t, pk_)] = (bf16_t)f2bf(fr[t] * e);
                    const float ki_ = fkd[t] * ei, bi_ = fb[t] * ei; sKIP[t * 64 + pk_] = (bf16_t)f2bf(ki_); sBIP[t * 64 + pk_] = (bf16_t)f2bf(bi_);
                    rKN[k * 32 + (t >> 2) * 8 + (t & 3)] = (bf16_t)f2bf(ki_); rKN[k * 32 + (t >> 2) * 8 + 4 + (t & 3)] = (bf16_t)f2bf(-bi_);
                    e_prev = e; }
                ((float*)(rb + R2S_GC))[k] = e_prev;
                U4 w0_, w1_;
                { w0_.x = pk2(fv[0], fv[1]); w0_.y = pk2(fv[2], fv[3]); w0_.z = pk2(fv[4], fv[5]); w0_.w = pk2(fv[6], fv[7]); w1_.x = pk2(fv[8], fv[9]); w1_.y = pk2(fv[10], fv[11]); w1_.z = pk2(fv[12], fv[13]); w1_.w = pk2(fv[14], fv[15]);
                    st16(rVT + k * 16, w0_); st16(rVT + k * 16 + 8, w1_); }
            }
            WAVE_SYNC();
            {
                const bf16_t* rKKD = (const bf16_t*)(rb + R2S_KKD); const bf16_t* rRD = (const bf16_t*)(rb + R2S_RD);
                const int sw0 = 8 * (kg ^ ((l15 >> 1) & 7)), sw1 = 8 * ((kg + 4) ^ ((l15 >> 1) & 7));
                const H8 ak0 = h8_from(ld16(rKKD + l15 * 64 + sw0)), ak1 = h8_from(ld16(rKKD + l15 * 64 + sw1)), ar0 = h8_from(ld16(rRD + l15 * 64 + sw0)), ar1 = h8_from(ld16(rRD + l15 * 64 + sw1));
                const H8 bb0 = h8_from(ld16(sBIP + l15 * 64 + 8 * kg)), bb1 = h8_from(ld16(sBIP + l15 * 64 + 32 + 8 * kg)), bk0 = h8_from(ld16(sKIP + l15 * 64 + 8 * kg)), bk1 = h8_from(ld16(sKIP + l15 * 64 + 32 + 8 * kg));
                A4 mA = mfma16(ak0, bb0, a4_zero()); mA = mfma16(ak1, bb1, mA);
                A4 mP = mfma16(ak0, bk0, a4_zero()); mP = mfma16(ak1, bk1, mP);
                A4 mQ1 = mfma16(ar0, bk0, a4_zero()); mQ1 = mfma16(ar1, bk1, mQ1);
                A4 mQ2 = mfma16(ar0, bb0, a4_zero()); mQ2 = mfma16(ar1, bb1, mQ2);
                MFMA_PAD(mA, mP, mQ1, mQ2, mA, mP, mQ1, mQ2);
                bf16_t* rP0 = (bf16_t*)(rb + R2S_P0); bf16_t* rQQ = (bf16_t*)(rb + R2S_QQ);
                UNR for (int rg = 0; rg < 4; ++rg) { const int t = 4 * kg + rg, s_ = l15;
                    sAM[t * 16 + s_] = t > s_ ? A4_GET(mA, rg) : 0.f;
                    rP0[t * 16 + s_] = (bf16_t)f2bf(t > s_ ? A4_GET(mP, rg) : 0.f); rQQ[t * 32 + (s_ >> 2) * 8 + (s_ & 3)] = (bf16_t)f2bf(t >= s_ ? A4_GET(mQ1, rg) : 0.f); rQQ[t * 32 + (s_ >> 2) * 8 + 4 + (s_ & 3)] = (bf16_t)f2bf(t >= s_ ? -A4_GET(mQ2, rg) : 0.f); }
            }
            WAVE_SYNC();
            {
                const int j = l15; float x[16]; bf16_t* rT = (bf16_t*)(rb + R2S_T);
                UNR for (int t = 0; t < 16; ++t) { float acc = t == j ? 1.f : 0.f;
                    UNR for (int s_ = 0; s_ < 16; ++s_) if (s_ < t) acc -= sAM[t * 16 + s_] * x[s_];
                    x[t] = acc; if (lane < 16) rT[t * 16 + j] = (bf16_t)f2bf(acc); }
            }
            LDS_FENCE();
            WAVE_SYNC();
            if (ch >= R2_GSLOTS) { const int ow = ((ch - R2_GSLOTS) & 3); GSPIN_WAIT_SLOW(gld_u32(POS + 1 + ow) >= pbase + (unsigned)(ch - R2_GSLOTS + 1)); }
            { const unsigned long long* st = (const unsigned long long*)(wsb + PW_REC); unsigned long long* gr = (unsigned long long*)(C.ws + WS_R2RING) + ((size_t)hd * R2_GSLOTS + (ch % R2_GSLOTS)) * R2S_U64;
              UNR for (int j = 0; j < 25; ++j) { const int idx = j * 64 + lane; if (idx < R2S_U64) gst_u64(gr + idx, st[idx]); } }
            VM_DRAIN(); WAVE_SYNC();
            if (lane == 0) gst_u32((unsigned*)(C.ws + WS_CTL + CTL_R2FLAG) + (size_t)hd * R2_NCH + ch, epoch);
            WAVE_SYNC();
        }
    }
    TACC_STORE(C, 47, C.vcu == 16 && C.tid == 0);
}

#ifdef EMU
typedef volatile unsigned* R2_LDSV;
#define R2_LDSV_AT(lds, off) ((volatile unsigned*)((lds) + (off)))
struct BufRsrc { const unsigned char* p; };
DEVFN BufRsrc mk_rsrc(const void* p, unsigned) { BufRsrc r; r.p = (const unsigned char*)p; return r; }
DEVFN U4 buf_ld16_sc1(BufRsrc r, unsigned off) { return *(const U4*)(r.p + off); }
#else
typedef volatile __attribute__((address_space(3))) unsigned* R2_LDSV;
#define R2_LDSV_AT(lds, off) ((volatile __attribute__((address_space(3))) unsigned*)((__attribute__((address_space(3))) unsigned char*)(lds) + (off)))
typedef unsigned u32x4_hw __attribute__((ext_vector_type(4)));
typedef __amdgpu_buffer_rsrc_t BufRsrc;
#define mk_rsrc(p, bytes) __builtin_amdgcn_make_buffer_rsrc((void*)(p), 0, (bytes), 0x00020000)
DEVFN U4 buf_ld16_sc1(BufRsrc r, unsigned off) { const u32x4_hw v = __builtin_amdgcn_raw_buffer_load_b128(r, off, 0, 16); U4 o; o.x = v.x; o.y = v.y; o.z = v.z; o.w = v.w; return o; }
#endif

#ifdef EMU
DEVFN H8 h8_pk2(const A4& a, const A4& b) { U4 w; w.x = pk2(a.v[0], a.v[1]); w.y = pk2(a.v[2], a.v[3]); w.z = pk2(b.v[0], b.v[1]); w.w = pk2(b.v[2], b.v[3]); return h8_from(w); }
DEVFN A4 a4_mul(const A4& a, const A4& g) { A4 r; for (int j = 0; j < 4; ++j) r.v[j] = a.v[j] * g.v[j]; return r; }
#else
DEVFN H8 h8_pk2(const A4& a, const A4& b) { U4 w; w.x = pk2(a[0], a[1]); w.y = pk2(a[2], a[3]); w.z = pk2(b[0], b[1]); w.w = pk2(b[2], b[3]); return __builtin_bit_cast(H8, w); }
DEVFN A4 a4_mul(const A4& a, const A4& g) { return a * g; }
#endif

#ifdef EMU
#define SPIN_WAIT_SLOW(cond) SPIN_WAIT(cond)
#else
#define SPIN_WAIT_SLOW(cond) do { while (!(cond)) __builtin_amdgcn_s_sleep(8); asm volatile("" ::: "memory"); } while (0)
#endif
DEVFN void rc2_chain(const Ctx& C, int i, int hd, bool ctx_out, unsigned char* lds, int max_chunks) {
    const int tid = C.tid, lane = tid & 63, wave = C.wave, h = hd >> 1, d = hd & 1;
    R2_LDSV lf = R2_LDSV_AT(lds, R2_LSLOTS * R2S_BYTES);
    if (tid < 96) lf[tid] = 0u;
    SYNC();
    const int nchunks = R2_NCH < max_chunks ? R2_NCH : max_chunks;
    const unsigned epoch = (unsigned)(i + 1), pbase = (unsigned)i * 100000u;
    #define RC_GEOM(ch, seg0, segn, R0) const bool isctx_ = (ch) < NCTX / RC_T; const int seg0 = isctx_ ? NLAT : 0, segn = isctx_ ? NCTX : NLAT; \
        const int cl_ = isctx_ ? (ch) : (ch) - NCTX / RC_T; const int R0 = d == 0 ? RC_T * cl_ : segn - RC_T * (cl_ + 1);
    if (wave < 4) {
        bf16_t* Yd = (bf16_t*)(C.ws + (d == 0 ? WS_YF : WS_YB));
        SETPRIO(3);
        const int vt = wave, kg = lane >> 4, l15 = lane & 15;
        const int o16 = (l15 * 16 + 4 * kg) * 2, o32 = (l15 * 32 + 8 * kg) * 2;
        const int a_vb = R2S_VT + ((16 * vt + l15) * 16 + 4 * kg) * 2, a_kkd = R2S_KKD + (l15 * 64 + 8 * (kg ^ ((l15 >> 1) & 7))) * 2, a_rd = R2S_RD + (l15 * 64 + 8 * (kg ^ ((l15 >> 1) & 7))) * 2;
        const int a_kkd1 = R2S_KKD + (l15 * 64 + 8 * ((kg + 4) ^ ((l15 >> 1) & 7))) * 2, a_rd1 = R2S_RD + (l15 * 64 + 8 * ((kg + 4) ^ ((l15 >> 1) & 7))) * 2;
        const int a_g = R2S_GC + 4 * kg * 4;
        struct Frag { U4 kkd0, kkd1, rd0, rd1, qq, kn0, kn1, kn2, kn3; U2 vb, p0, t; A4 g0, g1, g2, g3; };
#define R2_LOADF(ch, f) do { \
            const int slot = ch % R2_LSLOTS; const unsigned char* rb = lds + slot * R2S_BYTES; \
            SPIN_WAIT(lf[slot] == (unsigned)(ch + 1)); \
            f.kkd0 = ld16(rb + a_kkd); f.kkd1 = ld16(rb + a_kkd1); f.rd0 = ld16(rb + a_rd); f.rd1 = ld16(rb + a_rd1); f.vb = *(const U2*)(rb + a_vb); \
            f.p0 = *(const U2*)(rb + o16 + R2S_P0); f.t = *(const U2*)(rb + o16 + R2S_T); f.qq = ld16(rb + o32 + R2S_QQ); \
            f.kn0 = ld16(rb + o32 + R2S_KN); f.kn1 = ld16(rb + o32 + R2S_KN + 1024); f.kn2 = ld16(rb + o32 + R2S_KN + 2048); f.kn3 = ld16(rb + o32 + R2S_KN + 3072); \
            f.g0 = *(const A4*)(rb + a_g); f.g1 = *(const A4*)(rb + a_g + 64); f.g2 = *(const A4*)(rb + a_g + 128); f.g3 = *(const A4*)(rb + a_g + 192); \
            SCHED_BAR(); \
        } while (0)
#define R2_RELEASE(ch) do { const int slot = ch % R2_LSLOTS; LDS_FENCE(); WAVE_SYNC(); if (lane == 0) lf[32 + wave * 16 + slot] = (unsigned)(ch + 1); } while (0)
        A4 H0_ = a4_zero(), H1_ = a4_zero(), H2_ = a4_zero(), H3_ = a4_zero();
#define R2_COMPUTE(ch, f) do { \
            const H8 Hb0 = h8_pk2(H0_, H1_), Hb1 = h8_pk2(H2_, H3_); \
            U4 w_; w_.x = f.vb.x; w_.y = f.vb.y; w_.z = f.vb.x; w_.w = f.vb.y; const H8 Vv = h8_from(w_); \
            U4 a_; a_.x = f.p0.x; a_.y = f.p0.y; a_.z = 0u; a_.w = 0u; \
            A4 X = mfma16(h8_from(f.kkd0), Hb0, a4_zero()); X = mfma16(h8_from(f.kkd1), Hb1, X); X = mfma16(h8_from(a_), Vv, X); \
            A4 Y = mfma16(h8_from(f.rd0), Hb0, a4_zero()); Y = mfma16(h8_from(f.rd1), Hb1, Y); \
            w_.x = pk2(A4_GET(X, 0), A4_GET(X, 1)); w_.y = pk2(A4_GET(X, 2), A4_GET(X, 3)); a_.x = f.t.x; a_.y = f.t.y; \
            const A4 U_ = mfma16(h8_from(a_), h8_from(w_), a4_zero()); \
            w_.x = f.vb.x; w_.y = f.vb.y; w_.z = pk2(A4_GET(U_, 0), A4_GET(U_, 1)); w_.w = pk2(A4_GET(U_, 2), A4_GET(U_, 3)); const H8 VU = h8_from(w_); \
            Y = mfma16(h8_from(f.qq), VU, Y); \
            H0_ = mfma16(h8_from(f.kn0), VU, H0_); H1_ = mfma16(h8_from(f.kn1), VU, H1_); H2_ = mfma16(h8_from(f.kn2), VU, H2_); H3_ = mfma16(h8_from(f.kn3), VU, H3_); \
            H0_ = a4_mul(H0_, f.g0); H1_ = a4_mul(H1_, f.g1); H2_ = a4_mul(H2_, f.g2); H3_ = a4_mul(H3_, f.g3); \
            { RC_GEOM(ch, seg0, segn, R0) \
              if (!isctx_ || ctx_out) { bf16_t* yp = ycol + (size_t)(seg0 + (d == 0 ? R0 + 4 * kg : R0 + RC_T - 1 - 4 * kg)) * 512; \
                  UNR for (int rg = 0; rg < 4; ++rg) yp[rg * ystep] = (bf16_t)f2bf(A4_GET(Y, rg)); } } \
        } while (0)
        bf16_t* ycol = Yd + 64 * h + 16 * vt + l15; const int ystep = d == 0 ? 512 : -512;
        Frag fa, fb;
        TACC_DECL;
        { const int cz = 0; if (nchunks > 0) { R2_LOADF(cz, fa); R2_RELEASE(cz); } }
        for (int c0 = 0; c0 < nchunks; c0 += 2) {
            const int c1 = c0 + 1, c2 = c0 + 2;
            if (c1 < nchunks) R2_LOADF(c1, fb);
            R2_COMPUTE(c0, fa);
            if (c1 < nchunks) { R2_RELEASE(c1); if (c2 < nchunks) R2_LOADF(c2, fa); R2_COMPUTE(c1, fb); if (c2 < nchunks) R2_RELEASE(c2); }
        }
        SETPRIO(0);
        TACC_STORE(C, 45, C.vcu == 0 && tid == 0);
    } else {
        const int w = wave - 4;
        const unsigned* FLAG = (const unsigned*)(C.ws + WS_CTL + CTL_R2FLAG) + (size_t)hd * R2_NCH; unsigned* POS = (unsigned*)(C.ws + WS_CTL + CTL_R2POS) + 16 * hd;
        const BufRsrc rs = mk_rsrc(C.ws + WS_R2RING + (size_t)hd * R2_GSLOTS * R2S_BYTES, (unsigned)(R2_GSLOTS * R2S_BYTES));
        TACC_DECL;
#define R2_ISSUE1(cc, X, S) do { \
            if (S != epoch) { GSPIN_WAIT(gld_u32(FLAG + cc) == epoch); } \
            const unsigned o_ = (unsigned)(cc % R2_GSLOTS) * R2S_BYTES + lane * 16; \
            UNR for (int j = 0; j < 13; ++j) X[j] = buf_ld16_sc1(rs, o_ + j * 1024); \
            S = cc + 12 < nchunks ? gld_u32(FLAG + cc + 12) : 0u; \
        } while (0)
#define R2_COMMIT1(cc, X) do { \
            const int slot = cc % R2_LSLOTS; \
            if (cc >= R2_LSLOTS) { const unsigned need = (unsigned)(cc - R2_LSLOTS + 1); TACC_BEGIN; SPIN_WAIT_SLOW(lf[32 + 0 * 16 + slot] == need && lf[32 + 1 * 16 + slot] == need && lf[32 + 2 * 16 + slot] == need && lf[32 + 3 * 16 + slot] == need); TACC_END; } \
            unsigned char* dst = lds + slot * R2S_BYTES + lane * 16; \
            UNR for (int j = 0; j < 12; ++j) st16(dst + j * 1024, X[j]); \
            if (lane < 16) st16(dst + 12 * 1024, X[12]); \
            LDS_FENCE(); WAVE_SYNC(); \
            if (lane == 0) { lf[slot] = (unsigned)(cc + 1); gst_u32(POS + 1 + w, pbase + (unsigned)(cc + 1)); } \
        } while (0)
        U4 xa[13], xb[13], xc[13]; unsigned sa = 0u, sb = 0u, sc = 0u;
        { const int c0 = w, c1 = w + 4; if (c0 < nchunks) R2_ISSUE1(c0, xa, sa); if (c1 < nchunks) R2_ISSUE1(c1, xb, sb); }
        for (int c0 = w; c0 < nchunks; c0 += 12) {
            const int c1 = c0 + 4, c2 = c0 + 8, c3 = c0 + 12, c4 = c0 + 16;
            if (c2 < nchunks) R2_ISSUE1(c2, xc, sc);
            R2_COMMIT1(c0, xa);
            if (c1 < nchunks) { if (c3 < nchunks) R2_ISSUE1(c3, xa, sa); R2_COMMIT1(c1, xb); }
            if (c2 < nchunks) { if (c4 < nchunks) R2_ISSUE1(c4, xb, sb); R2_COMMIT1(c2, xc); }
        }
#undef R2_ISSUE1
#undef R2_COMMIT1
        TACC_STORE(C, 46, C.vcu == 0 && tid == 256);
    }
    #undef RC_GEOM
    SYNC();
}
#ifndef HY_CUS
#define HY_CUS 171
#endif
DEVFN void ph_scan_hyena(const Ctx& C, int i, bool ctx_out, unsigned char* lds) {
    const int np = C.G >= 256 ? C.G - 16 - HY_CUS : (C.G - 16) / 2, nscan = 16 + np;
    if (C.vcu < 16) { rc2_chain(C, i, C.vcu, ctx_out, lds, 1 << 30); XSTAMP(C, 40, C.vcu == 0); return; }
    unsigned* ticket = (unsigned*)(C.ws + WS_CTL + CTL_R2TICKET) + 16 * i;
    if (C.vcu < nscan) { rc2_producer(C, i, lds, ticket, 0, 16, 1 << 30); XSTAMP(C, 43, C.vcu == 16); return; }
    const int nh = C.G - nscan;
    for (int c = C.vcu - nscan; c < 512; c += nh) { hyena_channel(C, i, c, lds); if (c == C.vcu - nscan) XSTAMP(C, 44, C.vcu == nscan); }
    XSTAMP(C, 41, C.vcu == nscan); XSTAMP(C, 42, C.vcu == C.G - 1);
    if (ctx_out) for (int c = C.vcu - nscan; c < 512; c += nh) { SYNC(); hyena_ctx_channel(C, i, c, lds); }
    SYNC();
    rc2_producer(C, i, lds, ticket, 0, 16, 1 << 30);
}

DEVFN void ctx_outproj(const Ctx& C, const bf16_t* A1, const bf16_t* A2, int lda, const bf16_t* Wt, const float* gate_c, const float* base, float* out) {
    const int row = C.tid & 255, cp = C.tid >> 8;
    for (int n0 = 4 * C.vcu; n0 < DM; n0 += 4 * C.G) {
        const int n = n0 + 2 * cp;
        const bf16_t* w0p = Wt + (size_t)n * DM; const bf16_t* w1p = w0p + DM;
        float acc0 = 0.f, acc1 = 0.f;
        for (int hf = 0; hf < 2; ++hf) {
            const bf16_t* ap = (hf == 0 ? A1 : A2) + (size_t)row * lda;
            for (int k0 = 0; k0 < 512; k0 += 8) {
                float a[8], w0[8], w1[8];
                unpack8(ld16(ap + k0), a); unpack8(ld16(w0p + 512 * hf + k0), w0); unpack8(ld16(w1p + 512 * hf + k0), w1);
                UNR for (int e = 0; e < 8; ++e) { acc0 += a[e] * w0[e]; acc1 += a[e] * w1[e]; }
            }
        }
        const size_t o = (size_t)row * DM + n;
        out[o] = base[o] + gate_c[n] * acc0; out[o + 1] = base[o + 1] + gate_c[n + 1] * acc1;
    }
}
namespace pg8 {
#define PG8_LAS __attribute__((address_space(3)))
typedef unsigned short bf16_t;
typedef short bf16x8 __attribute__((ext_vector_type(8)));
typedef float f32x4 __attribute__((ext_vector_type(4)));
typedef unsigned u32x4 __attribute__((ext_vector_type(4)));
constexpr int BM = 256, BK = 64, HALF = 128, HTB = HALF * BK * 2  , STAGE_BYTES = 8 * HTB, NXCD = 8, WGM = 8;

__host__ __device__ __forceinline__ int lds_byte(int r, int c) { const int st = (r >> 4) * 2 + (c >> 5), rr = r & 15, cc = c & 31, ob = rr * 64 + cc * 2; return st * 1024 + (ob ^ (((ob >> 9) & 1) << 5)); }
__host__ __device__ __forceinline__ void stage_rc(int b, int& R, int& C) { const int st = b / 1024, sb = b % 1024, swz = sb ^ (((sb >> 9) & 1) << 5); R = (st >> 1) * 16 + swz / 64; C = (st & 1) * 32 + (swz % 64) / 2; }
__host__ __device__ __forceinline__ int perm32(int rho) { const int n = rho >> 4, i = rho & 15; return 8 * (i >> 2) + 4 * n + (i & 3); }

struct Unit { int pm, pn; };
struct Gemm { const bf16_t* A; const bf16_t* A2; int lda; const bf16_t* Bt; int M, N, K; };

struct StaticOrder {
    int nM, nN, nwg, G, c;
    __host__ __device__ void init(int M, int N, int G_, int c_) { nM = M / BM; nN = N / BM; nwg = nM * nN; G = G_; c = c_; }
    __host__ __device__ bool next(int i, Unit& u) const {
        const long L = (long)i * G + c; if (L >= nwg) return false;
        int wgid = (int)L; { const int q = nwg / NXCD, r = nwg % NXCD, xcd = wgid % NXCD, off = wgid / NXCD; wgid = (xcd < r ? xcd * (q + 1) : r * (q + 1) + (xcd - r) * q) + off; }
        const int nig = WGM * nN, gid = wgid / nig, fm = gid * WGM, gsz = (nM - fm) < WGM ? (nM - fm) : WGM;
        u.pm = fm + ((wgid % nig) % gsz); u.pn = (wgid % nig) / gsz; return true;
    }
    __device__ __forceinline__ void a_ready(const Unit&) const {}
    __device__ __forceinline__ void done(const Unit&) const {}
};

__device__ __forceinline__ unsigned cvt_pk_bf16(float lo, float hi) { unsigned r; asm volatile("v_cvt_pk_bf16_f32 %0, %1, %2" : "=v"(r) : "v"(lo), "v"(hi)); return r; }
__device__ __forceinline__ float silu_fast(float v) { return v * __builtin_amdgcn_rcpf(1.0f + __expf(-v)); }

template <int LAYOUT> struct EpiIn {
    static constexpr bool PERM = true, AFTER_DRAIN = false;
    unsigned char* ws;
    __device__ __forceinline__ void operator()(const f32x4 (&acc)[2][2][4][2], const Unit& u, int wr, int wc, int fr, int fq) const {
        const int row0 = u.pm * BM + wr * 64 + fr;
#pragma unroll
        for (int bj = 0; bj < 2; ++bj) {
            const int cg = u.pn * BM + bj * HALF;
            bf16_t* base; int ldc, mode, col;
            if (LAYOUT == 0) { base = (bf16_t*)(ws + WS_U); ldc = AIN; col = cg; mode = cg < 512 ? 1 : ((cg >= 1536 && cg < 2048) || cg >= 2816) ? 2 : 0; }
            else {
                if (cg < URW_W) { base = (bf16_t*)(ws + WS_U); ldc = URW_W; col = cg; mode = cg >= 1664 ? 2 : 0; }
                else if (cg < URW_W + UHY_W) { base = (bf16_t*)(ws + WS_UHY); ldc = UHY_W; col = cg - URW_W; mode = 0; }
                else if (cg < RIN) { base = (bf16_t*)(ws + WS_GHY); ldc = 512; col = cg - URW_W - UHY_W; mode = 2; }
                else { base = nullptr; ldc = 0; col = 0; mode = 3; }
            }
            if (mode == 3) continue;
            const int col0 = col + wc * 32 + 8 * fq;
#pragma unroll
            for (int ai = 0; ai < 2; ++ai)
#pragma unroll
                for (int m = 0; m < 4; ++m) {
                    f32x4 v0 = acc[ai][bj][m][0], v1 = acc[ai][bj][m][1];
                    if (mode == 1) { v0 = v0 * C2; v1 = v1 * C2; }
                    if (mode == 2) { v0 = (f32x4){silu_fast(v0[0]), silu_fast(v0[1]), silu_fast(v0[2]), silu_fast(v0[3])}; v1 = (f32x4){silu_fast(v1[0]), silu_fast(v1[1]), silu_fast(v1[2]), silu_fast(v1[3])}; }
                    u32x4 w; w.x = cvt_pk_bf16(v0[0], v0[1]); w.y = cvt_pk_bf16(v0[2], v0[3]); w.z = cvt_pk_bf16(v1[0], v1[1]); w.w = cvt_pk_bf16(v1[2], v1[3]);
                    *(u32x4*)(base + (size_t)(row0 + ai * HALF + m * 16) * ldc + col0) = w;
                }
        }
    }
};

struct EpiRes {
    static constexpr bool PERM = false, AFTER_DRAIN = false;
    const float* blat; const float* bctx; float* olat; float* octx; const float* gate; const float* gate_c;
    __device__ __forceinline__ void operator()(const f32x4 (&acc)[2][2][4][2], const Unit& u, int wr, int wc, int fr, int fq) const {
        const bool isctx = u.pm * BM >= NLAT;
        const float* bs = isctx ? bctx - (size_t)NLAT * DM : blat; float* os = isctx ? octx - (size_t)NLAT * DM : olat; const float* gt = isctx ? gate_c : gate;
        const int col0 = u.pn * BM + wc * 32 + 4 * fq;
#pragma unroll
        for (int bj = 0; bj < 2; ++bj)
#pragma unroll
            for (int n = 0; n < 2; ++n) { const f32x4 g = *(const f32x4*)(gt + col0 + bj * HALF + n * 16);
#pragma unroll
                for (int ai = 0; ai < 2; ++ai)
#pragma unroll
                    for (int m = 0; m < 4; ++m) { const size_t off = (size_t)(u.pm * BM + ai * HALF + wr * 64 + m * 16 + fr) * DM + col0 + bj * HALF + n * 16;
                        const f32x4 b = *(const f32x4*)(bs + off); *(f32x4*)(os + off) = b + g * acc[ai][bj][m][n]; } }
    }
};
template <class Epi, class Sched, bool ALIGN_EPI = false, bool SP2 = false>
__device__ __forceinline__ void gemm_phase(PG8_LAS unsigned char* lds, const Gemm g, const Sched& S, const Epi& E) {
    int tid_ = threadIdx.x; asm volatile("" : "+v"(tid_));
    const int tid = tid_, wid = __builtin_amdgcn_readfirstlane(tid >> 6), lane = tid & 63, wr = wid >> 2, wc = wid & 3, fr = lane & 15, fq = lane >> 4;
    const int K = g.K, nt = K / BK;
    unsigned voffA[2], voffB[2];
#pragma unroll
    for (int i = 0; i < 2; ++i) { int R, C; stage_rc(tid * 16 + i * 8192, R, C); const int Rb = Epi::PERM ? ((R & ~31) + perm32(R & 31)) : R;
        voffA[i] = (unsigned)(R * g.lda + C) * 2u; voffB[i] = (unsigned)(Rb * K + C) * 2u; }
    const size_t kstep = (size_t)(BK * 2);
    const size_t hstepA = (size_t)HALF * g.lda * 2, hstepB = (size_t)HALF * K * 2;
    const size_t tstepA = 2 * hstepA, tstepB = 2 * hstepB;
    const int nh = nt / 2; const ptrdiff_t dlt = ((const char*)g.A2 - (const char*)g.A) - (ptrdiff_t)nh * (ptrdiff_t)kstep;
    const unsigned ldsw = (unsigned)wid * 1024u;
    const int aoff = lds_byte(wr * 64 + fr, fq * 8), boff = lds_byte(wc * 32 + fr, fq * 8);
#define PG8_SA(b, h) (((b) * 2 + (h)) * HTB)
#define PG8_SB(b, h) ((4 + (b) * 2 + (h)) * HTB)
#define PG8_STAGE(bufoff, gbase, voff) do { _Pragma("unroll") for (int _i = 0; _i < 2; ++_i) \
        __builtin_amdgcn_global_load_lds((const unsigned*)((const char*)(gbase) + (voff)[_i]), (PG8_LAS unsigned*)(lds + (bufoff) + ldsw + _i * 8192), 16, 0, 0); } while (0)
#define PG8_LDA(dst, b, h) do { _Pragma("unroll") for (int m = 0; m < 4; ++m) _Pragma("unroll") for (int k = 0; k < 2; ++k) dst[m][k] = *(const PG8_LAS bf16x8*)(lds + PG8_SA(b, h) + aoff + m * 2048 + k * 1024); } while (0)
#define PG8_LDB(dst, b, h) do { _Pragma("unroll") for (int n = 0; n < 2; ++n) _Pragma("unroll") for (int k = 0; k < 2; ++k) dst[n][k] = *(const PG8_LAS bf16x8*)(lds + PG8_SB(b, h) + boff + n * 2048 + k * 1024); } while (0)
#define PG8_MMA(ai, bj, At, Bt) do { __builtin_amdgcn_s_setprio(1); _Pragma("unroll") for (int m = 0; m < 4; ++m) _Pragma("unroll") for (int n = 0; n < 2; ++n) _Pragma("unroll") for (int k = 0; k < 2; ++k) \
        acc[ai][bj][m][n] = __builtin_amdgcn_mfma_f32_16x16x32_bf16(Bt[n][k], At[m][k], acc[ai][bj][m][n], 0, 0, 0); __builtin_amdgcn_s_setprio(0); } while (0)
#define PG8_WAIT_V(n) asm volatile("s_waitcnt vmcnt(" #n ")" ::: "memory")
#define PG8_WAIT_L(n) asm volatile("s_waitcnt lgkmcnt(" #n ")" ::: "memory")
#define PG8_BAR __builtin_amdgcn_s_barrier()
#define PG8_SCHED __builtin_amdgcn_sched_barrier(0)
    Unit cur, nxt; int ui = 0;
    if (!S.next(0, cur)) return;
    f32x4 acc[2][2][4][2];
#pragma unroll
    for (int a = 0; a < 2; ++a)
#pragma unroll
        for (int b = 0; b < 2; ++b)
#pragma unroll
            for (int m = 0; m < 4; ++m)
#pragma unroll
                for (int n = 0; n < 2; ++n) acc[a][b][m][n] = (f32x4){0.f, 0.f, 0.f, 0.f};
    bf16x8 At[4][2], B0[2][2], B1[2][2];
    const char* cA = (const char*)g.A + (size_t)cur.pm * tstepA; const char* cB = (const char*)g.Bt + (size_t)cur.pn * tstepB;
    S.a_ready(cur);
    if constexpr (SP2) {
        PG8_STAGE(PG8_SB(0, 0), cB, voffB); PG8_STAGE(PG8_SB(0, 1), cB + hstepB, voffB); PG8_STAGE(PG8_SA(0, 0), cA, voffA); PG8_STAGE(PG8_SA(0, 1), cA + hstepA, voffA);
        if (wr == 1) PG8_BAR;
        PG8_WAIT_V(2); PG8_BAR;
        PG8_STAGE(PG8_SB(1, 0), cB + kstep, voffB); PG8_STAGE(PG8_SA(1, 0), cA + kstep, voffA); PG8_STAGE(PG8_SB(1, 1), cB + hstepB + kstep, voffB);
        PG8_WAIT_V(6); PG8_BAR;
    } else {
        PG8_STAGE(PG8_SB(0, 0), cB, voffB); PG8_STAGE(PG8_SA(0, 0), cA, voffA); PG8_STAGE(PG8_SB(0, 1), cB + hstepB, voffB); PG8_STAGE(PG8_SA(0, 1), cA + hstepA, voffA);
        if (wr == 1) PG8_BAR;
        PG8_WAIT_V(4); PG8_BAR;
        PG8_STAGE(PG8_SB(1, 0), cB + kstep, voffB); PG8_STAGE(PG8_SA(1, 0), cA + kstep, voffA); PG8_STAGE(PG8_SB(1, 1), cB + hstepB + kstep, voffB);
        PG8_WAIT_V(6); PG8_BAR;
    }
    for (;;) {
        const bool has_next = S.next(ui + 1, nxt);
        const char* nA = has_next ? (const char*)g.A + (size_t)nxt.pm * tstepA : cA; const char* nB = has_next ? (const char*)g.Bt + (size_t)nxt.pn * tstepB : cB;
        for (int t = 0; t < nt; t += 2) {
            const bool last = (t == nt - 2);
            const char* a1 = cA + (size_t)(t + 1) * kstep + ((t + 1) >= nh ? dlt : 0);
            const char* a2 = last ? nA : cA + (size_t)(t + 2) * kstep + ((t + 2) >= nh ? dlt : 0); const char* b2 = last ? nB : cB + (size_t)(t + 2) * kstep;
            const char* a3 = a2 + kstep; const char* b3 = b2 + kstep;
            if (last && has_next) S.a_ready(nxt);
            if constexpr (SP2) {
            PG8_LDB(B0, 0, 0); PG8_LDB(B1, 0, 1); PG8_SCHED; PG8_LDA(At, 0, 0); PG8_STAGE(PG8_SA(1, 1), a1 + hstepA, voffA);
            PG8_WAIT_V(8); PG8_WAIT_L(0); PG8_BAR; PG8_MMA(0, 0, At, B0); PG8_MMA(0, 1, At, B1); PG8_BAR; PG8_SCHED;
            PG8_LDA(At, 0, 1); PG8_STAGE(PG8_SB(0, 0), b2, voffB); PG8_STAGE(PG8_SB(0, 1), b2 + hstepB, voffB); PG8_STAGE(PG8_SA(0, 0), a2, voffA);
            PG8_WAIT_V(8); PG8_WAIT_L(0); PG8_BAR; PG8_MMA(1, 0, At, B0); PG8_MMA(1, 1, At, B1); PG8_BAR; PG8_SCHED;
            PG8_LDB(B0, 1, 0); PG8_LDB(B1, 1, 1); PG8_SCHED; PG8_LDA(At, 1, 0); PG8_STAGE(PG8_SA(0, 1), a2 + hstepA, voffA);
            PG8_WAIT_V(8); PG8_WAIT_L(0); PG8_BAR; PG8_MMA(0, 0, At, B0); PG8_MMA(0, 1, At, B1); PG8_BAR; PG8_SCHED;
            PG8_LDA(At, 1, 1); PG8_STAGE(PG8_SB(1, 0), b3, voffB); PG8_STAGE(PG8_SB(1, 1), b3 + hstepB, voffB); PG8_STAGE(PG8_SA(1, 0), a3, voffA);
            PG8_WAIT_V(8); PG8_WAIT_L(0); PG8_BAR; PG8_MMA(1, 0, At, B0); PG8_MMA(1, 1, At, B1); PG8_BAR; PG8_SCHED;
            } else {
            PG8_LDB(B0, 0, 0); PG8_SCHED; PG8_LDA(At, 0, 0); PG8_STAGE(PG8_SA(1, 1), a1 + hstepA, voffA);
            PG8_WAIT_L(8); PG8_BAR; PG8_WAIT_L(0); PG8_MMA(0, 0, At, B0); PG8_BAR; PG8_SCHED;
            PG8_LDB(B1, 0, 1); PG8_STAGE(PG8_SB(0, 0), b2, voffB);
            PG8_BAR; PG8_WAIT_L(0); PG8_MMA(0, 1, At, B1); PG8_BAR;
            PG8_LDA(At, 0, 1); PG8_STAGE(PG8_SA(0, 0), a2, voffA);
            PG8_BAR; PG8_WAIT_L(0); PG8_MMA(1, 0, At, B0); PG8_BAR; PG8_SCHED;
            PG8_STAGE(PG8_SB(0, 1), b2 + hstepB, voffB);
            PG8_WAIT_V(6); PG8_BAR; PG8_MMA(1, 1, At, B1); PG8_BAR;
            PG8_LDB(B0, 1, 0); PG8_SCHED; PG8_LDA(At, 1, 0); PG8_STAGE(PG8_SA(0, 1), a2 + hstepA, voffA);
            PG8_WAIT_L(8); PG8_BAR; PG8_WAIT_L(0); PG8_MMA(0, 0, At, B0); PG8_BAR; PG8_SCHED;
            PG8_LDB(B1, 1, 1); PG8_STAGE(PG8_SB(1, 0), b3, voffB);
            PG8_BAR; PG8_WAIT_L(0); PG8_MMA(0, 1, At, B1); PG8_BAR;
            PG8_LDA(At, 1, 1); PG8_STAGE(PG8_SA(1, 0), a3, voffA);
            PG8_BAR; PG8_WAIT_L(0); PG8_MMA(1, 0, At, B0); PG8_BAR; PG8_SCHED;
            PG8_STAGE(PG8_SB(1, 1), b3 + hstepB, voffB);
            PG8_WAIT_V(6); PG8_BAR; PG8_MMA(1, 1, At, B1); PG8_BAR;
            }
        }
        if constexpr (ALIGN_EPI) { if (wr == 0) PG8_BAR; }
        if constexpr (!Epi::AFTER_DRAIN) { E(acc, cur, wr, wc, fr, fq); S.done(cur); }
        if (!has_next) break;
#pragma unroll
        for (int a = 0; a < 2; ++a)
#pragma unroll
            for (int b = 0; b < 2; ++b)
#pragma unroll
                for (int m = 0; m < 4; ++m)
#pragma unroll
                    for (int n = 0; n < 2; ++n) acc[a][b][m][n] = (f32x4){0.f, 0.f, 0.f, 0.f};
        cur = nxt; cA = nA; cB = nB; ++ui;
        if constexpr (ALIGN_EPI) { if (wr == 1) PG8_BAR; }
    }
    PG8_WAIT_V(0);
    if constexpr (!ALIGN_EPI) { if (wr == 0) PG8_BAR; }
    PG8_BAR;
    if constexpr (Epi::AFTER_DRAIN) { E.fused(acc, cur, wr, wc, fr, fq, lds, wid, lane); S.done(cur); }
#undef PG8_SA
#undef PG8_SB
#undef PG8_STAGE
#undef PG8_LDA
#undef PG8_LDB
#undef PG8_MMA
#undef PG8_WAIT_V
#undef PG8_WAIT_L
#undef PG8_BAR
#undef PG8_SCHED
}
}
#include <hip/hip_bf16.h>
#include <cmath>
namespace attn_body {
using bf16=__hip_bfloat16;
using bf16x8=__attribute__((ext_vector_type(8)))short;
using s16x4=__attribute__((ext_vector_type(4)))short;
using f32x16=__attribute__((ext_vector_type(16)))float;
using u32x4=__attribute__((ext_vector_type(4)))unsigned;
constexpr int D=64;
constexpr int NW=8,QBLK=32,QB=QBLK*NW,KVBLK=64;
__device__ __forceinline__ int crow(int r,int hi){return (r&3)+8*(r>>2)+4*hi;}
#define SBAR() __builtin_amdgcn_sched_barrier(0)
typedef __attribute__((address_space(3))) const float* lds_fptr;
struct NaCtx { lds_fptr tab; int rmin, qr, qc, row0, col0; };
__device__ __forceinline__ void namask(f32x16&p0,f32x16&p1,int t,const NaCtx&n,int hi){
  if(t<4)return;
  const float NEG=-INFINITY; const int kr=n.rmin+(t-4);
  if(kr<n.row0||kr>=n.row0+8){
    #pragma unroll
    for(int r=0;r<16;++r){p0[r]=NEG;p1[r]=NEG;}
    return; }
  const lds_fptr bt=n.tab+((kr-n.qr+7)*31+15-n.qc+4*hi); const int d0=4*hi-n.col0;
  #pragma unroll
  for(int r=0;r<16;++r){const int e=(r&3)+8*(r>>2);
    p0[r]=((unsigned)(e+d0)<16u)?p0[r]+bt[e]:NEG; p1[r]=((unsigned)(e+32+d0)<16u)?p1[r]+bt[e+32]:NEG;}
}

constexpr int NSLOT=3, SLOTB=8192;
constexpr int LDS_K=0, LDS_V=NSLOT*SLOTB, LDS_WS=2*NSLOT*SLOTB, LDS_OST=LDS_WS+NW*64*4, LDS_BIAS=LDS_OST+NW*4096, LDS_BYTES=LDS_BIAS+640*4;
constexpr float C2=0.125f*1.4426950408889634f;
__device__ __forceinline__ void glds16(const void*gsrc,unsigned lds_dst){unsigned keep;
  asm volatile("s_mov_b32 %0, m0\n\ts_mov_b32 m0, %2\n\ts_nop 0\n\tglobal_load_lds_dwordx4 %1, off\n\ts_mov_b32 m0, %0":"=&s"(keep):"v"(gsrc),"s"(lds_dst):"memory");}
__device__ __forceinline__ float max3f(float a,float b,float c){float r;asm("v_max3_f32 %0, %1, %2, %3":"=v"(r):"v"(a),"v"(b),"v"(c));return r;}
__device__ __forceinline__ float max2f(float a,float b){float r;asm("v_max_f32_e32 %0, %1, %2":"=v"(r):"v"(a),"v"(b));return r;}
__device__ __forceinline__ float fadd_s(float a,float b){float r;asm("v_add_f32_e32 %0, %1, %2":"=v"(r):"v"(a),"v"(b));return r;}
__device__ __forceinline__ float fsub_s(float a,float b){float r;asm("v_sub_f32_e32 %0, %1, %2":"=v"(r):"v"(a),"v"(b));return r;}
typedef float f32x2_t __attribute__((ext_vector_type(2))); typedef __bf16 bf16x2_t __attribute__((ext_vector_type(2)));
__device__ __forceinline__ unsigned cvtpk_s(float lo,float hi){f32x2_t v={lo,hi};bf16x2_t b=__builtin_convertvector(v,bf16x2_t);return __builtin_bit_cast(unsigned,b);}
#define WAIT_BAR(N) asm volatile("s_waitcnt vmcnt(" #N ") lgkmcnt(0)\n\ts_barrier":::"memory")

__device__ __forceinline__ void qkt(f32x16&p0,f32x16&p1,const char*Kslot,const bf16x8*qr,const f32x16&negm,int r32,int hi){
  const char*kb=Kslot+hi*1024+r32*16;
  #pragma unroll
  for(int d0=0;d0<4;++d0){
    const bf16x8 b0=*reinterpret_cast<const bf16x8*>(kb+d0*2048);
    const bf16x8 b1=*reinterpret_cast<const bf16x8*>(kb+d0*2048+512);
    if(d0==0){p0=__builtin_amdgcn_mfma_f32_32x32x16_bf16(b0,qr[0],negm,0,0,0);p1=__builtin_amdgcn_mfma_f32_32x32x16_bf16(b1,qr[0],negm,0,0,0);}
    else{p0=__builtin_amdgcn_mfma_f32_32x32x16_bf16(b0,qr[d0],p0,0,0,0);p1=__builtin_amdgcn_mfma_f32_32x32x16_bf16(b1,qr[d0],p1,0,0,0);}}
}
typedef __attribute__((address_space(3))) const char* lds_cptr;
typedef short v4i16_t __attribute__((ext_vector_type(4)));
__device__ __forceinline__ void kload8(bf16x8*kf,lds_cptr kp){
  kf[0]=*(const __attribute__((address_space(3))) bf16x8*)(kp);      kf[1]=*(const __attribute__((address_space(3))) bf16x8*)(kp+512);
  kf[2]=*(const __attribute__((address_space(3))) bf16x8*)(kp+2048); kf[3]=*(const __attribute__((address_space(3))) bf16x8*)(kp+2560);
  kf[4]=*(const __attribute__((address_space(3))) bf16x8*)(kp+4096); kf[5]=*(const __attribute__((address_space(3))) bf16x8*)(kp+4608);
  kf[6]=*(const __attribute__((address_space(3))) bf16x8*)(kp+6144); kf[7]=*(const __attribute__((address_space(3))) bf16x8*)(kp+6656);
}
__device__ __forceinline__ void kload2(bf16x8*kf,lds_cptr kp,int j){ kf[2*j]=*(const __attribute__((address_space(3))) bf16x8*)(kp+j*2048); kf[2*j+1]=*(const __attribute__((address_space(3))) bf16x8*)(kp+j*2048+512); }
__device__ __forceinline__ s16x4 vtr(lds_cptr p){ return __builtin_bit_cast(s16x4,__builtin_amdgcn_ds_read_tr16_b64_v4i16((__attribute__((address_space(3))) v4i16_t*)p)); }
__device__ __forceinline__ float rowmax(const f32x16&p0,const f32x16&p1){
  float a=max3f(p0[0],p0[1],p1[0]),b=max3f(p0[2],p0[3],p1[1]);a=max3f(a,p1[2],p1[3]);
  #pragma unroll
  for(int r=4;r<16;r+=4){a=max3f(a,p0[r],p0[r+1]);b=max3f(b,p0[r+2],p0[r+3]);a=max3f(a,p1[r],p1[r+1]);b=max3f(b,p1[r+2],p1[r+3]);}
  const float m=max2f(a,b);
  auto rr=__builtin_amdgcn_permlane32_swap(__float_as_uint(m),__float_as_uint(m),false,false);
  return max2f(__uint_as_float(rr[0]),__uint_as_float(rr[1]));
}
__device__ __forceinline__ void pv(f32x16*o,int vb,bf16x8 pa0,bf16x8 pa1,bf16x8 pa2,bf16x8 pa3){
  #pragma unroll
  for(int d0=0;d0<2;++d0){s16x4 lo[4],hi[4];
    #pragma unroll
    for(int ks=0;ks<4;++ks){
      asm volatile("ds_read_b64_tr_b16 %0,%1 offset:%c2":"=&v"(lo[ks]):"v"(vb),"i"(d0*4096+ks*1024):"memory");
      asm volatile("ds_read_b64_tr_b16 %0,%1 offset:%c2":"=&v"(hi[ks]):"v"(vb),"i"(d0*4096+ks*1024+512):"memory");}
    asm volatile("s_waitcnt lgkmcnt(0)":::"memory");SBAR();
    #define PK(k) (bf16x8){lo[k][0],lo[k][1],lo[k][2],lo[k][3],hi[k][0],hi[k][1],hi[k][2],hi[k][3]}
    o[d0]=__builtin_amdgcn_mfma_f32_32x32x16_bf16(pa0,PK(0),o[d0],0,0,0);
    o[d0]=__builtin_amdgcn_mfma_f32_32x32x16_bf16(pa1,PK(1),o[d0],0,0,0);
    o[d0]=__builtin_amdgcn_mfma_f32_32x32x16_bf16(pa2,PK(2),o[d0],0,0,0);
    o[d0]=__builtin_amdgcn_mfma_f32_32x32x16_bf16(pa3,PK(3),o[d0],0,0,0);
    #undef PK
  }
}

#define ATTN_STORE16(p,v) (*(u32x4*)(p)=(v))
template<bool NA> __device__ __forceinline__ f32x16 cinit(const f32x16&negm){ if constexpr(NA){ f32x16 z=f32x16{}; return z; } else return negm; }
constexpr int UP=3328, OP=1024;
struct AJob { const bf16*U; bf16*MX; unsigned qo, ko, vo, go, oo; int NT, tile0a, na, tile0b; int qr0, rmin; const float*rpb; };
__device__ __forceinline__ u32x4 gate8(u32x4 v,u32x4 g);
template<int THRL,bool NA> __device__ __forceinline__ void attn_unit(const AJob&J,char*shm){
  int tid_=threadIdx.x; asm volatile("":"+v"(tid_));
  const int tid=tid_,lane=tid&63,r32=lane&31,hi=lane>>5; const int wid=__builtin_amdgcn_readfirstlane(tid>>6);
  const bf16*Qw=J.U+J.qo+(long)(wid*QBLK)*UP;
  const bf16*Kh=J.U+J.ko,*Vh=J.U+J.vo;
  const unsigned lds0=(unsigned)(uintptr_t)shm;
  float*wsf=(float*)(shm+LDS_WS)+wid*64;
  const bf16*ksrc=Kh+(long)lane*UP+wid*8;
  const bf16*vsrc=Vh+(long)(16*(wid&3)+(lane>>2))*UP+(wid>>2)*32+(lane&3)*8;
  const unsigned kdst=lds0+LDS_K+wid*1024, vdst=lds0+LDS_V+wid*1024;
  #define TROW(t) (64L*(long)(((t)<J.na)?(J.tile0a+(t)):(J.tile0b+((t)-J.na))))
  #define DMA_K(t,slot) glds16(ksrc+TROW(t)*UP,(unsigned)__builtin_amdgcn_readfirstlane(kdst+(slot)))
  #define DMA_V(t,slot) glds16(vsrc+TROW(t)*UP,(unsigned)__builtin_amdgcn_readfirstlane(vdst+(slot)))
  const int vb0=(int)(lds0+LDS_V)+((lane>>4)&1)*32+(lane&3)*8+(4*hi+((lane&15)>>2))*64;
  const char*Kbase=shm+LDS_K; bf16x8 kf[8];
  const lds_cptr shm3=(lds_cptr)shm; const lds_cptr kp0=shm3+LDS_K+hi*1024+r32*16; const lds_cptr vp0=shm3+LDS_V+((lane>>4)&1)*32+(lane&3)*8+(4*hi+((lane&15)>>2))*64;
  const int NT=J.NT;
  NaCtx nac; nac.tab=(lds_fptr)(shm+LDS_BIAS)+64; nac.rmin=J.rmin; nac.qr=J.qr0+(wid>>1); nac.qc=32*(wid&1)+r32;
  { int a=nac.qr-4; a=a<0?0:(a>248?248:a); nac.row0=a; int b=nac.qc-8; b=b<0?0:(b>48?48:b); nac.col0=b; }
  if(NA){ if(J.rpb){ for(int e=tid;e<465;e+=512)((__attribute__((address_space(3))) float*)(shm+LDS_BIAS))[64+e]=J.rpb[e]*1.4426950408889634f; } }
  DMA_K(0,0);DMA_V(0,0);DMA_K(1,SLOTB);
  bf16x8 qr[4];
  #pragma unroll
  for(int d0=0;d0<4;++d0)qr[d0]=*reinterpret_cast<const bf16x8*>(&Qw[(long)r32*UP+d0*16+hi*8]);
  float mhat=0.f,l_reg=0.f;f32x16 o[2];o[0]=f32x16{};o[1]=f32x16{};f32x16 negm=f32x16{}; if constexpr(!NA) asm volatile("":"+v"(negm));
  #define CMASK(P0,P1,t) do{ if constexpr(NA) namask(P0,P1,(t),nac,hi); }while(0)
  bool resc=false;
  #define START(P0,P1) do{ const float rm=rowmax(P0,P1); resc=false; \
    { const float dl=rm; mhat=fadd_s(mhat,dl); \
      _Pragma("unroll") for(int r=0;r<16;++r){P0[r]=fsub_s(P0[r],dl);P1[r]=fsub_s(P1[r],dl);} \
      if constexpr(!NA){ _Pragma("unroll") for(int r=0;r<16;++r)negm[r]=-mhat; asm volatile("":"+v"(negm)); } } \
    _Pragma("unroll") for(int r=0;r<16;++r)P0[r]=__builtin_amdgcn_exp2f(P0[r]); }while(0)
  #define RESC() do{ if(resc){ asm volatile("s_waitcnt lgkmcnt(0)":::"memory"); \
      _Pragma("unroll") for(int d_=0;d_<2;++d_) _Pragma("unroll") for(int r=0;r<16;++r)o[d_][r]*=wsf[crow(r,hi)]; } }while(0)
  f32x16 pA0,pA1,pB0,pB1;
  int sl_prev=0,sl_cur=0,sl_next=SLOTB;
  #define ROT() do{sl_prev=sl_cur;sl_cur=sl_next;sl_next=(sl_next==(NSLOT-1)*SLOTB)?0:sl_next+SLOTB;}while(0)
  DMA_K(2,2*SLOTB);
  WAIT_BAR(3);
  qkt(pA0,pA1,Kbase,qr,cinit<NA>(negm),r32,hi);asm volatile("s_nop 15\n\ts_nop 7":"+v"(pA0),"+v"(pA1));CMASK(pA0,pA1,0);
  START(pA0,pA1);
  _Pragma("unroll") for(int r=0;r<16;++r)pA1[r]=__builtin_amdgcn_exp2f(pA1[r]);
  WAIT_BAR(0);
  DMA_K(3,0);DMA_V(1,SLOTB);
  ROT();
  kload8(kf,kp0+sl_cur);
  WAIT_BAR(2);
  s16x4 vlo[8],vhi[8]; u32x4 pw0,pw1,pw2,pw3;
  #define PKW(P,B) cvtpk_s(P[B],P[B+1])
  #define PAF(k) __builtin_bit_cast(bf16x8,pw##k)
  #define VFR(i) (bf16x8){vlo[i][0],vlo[i][1],vlo[i][2],vlo[i][3],vhi[i][0],vhi[i][1],vhi[i][2],vhi[i][3]}
  #define PIN(x) asm volatile("":"+v"(x))
  #define MX3(a,b,c) __builtin_fmaxf(__builtin_fmaxf((a),(b)),(c))
  #define GAPA(MF,A0,A1,A2,A3,W0,W1,PW) do{ MF; sacc+=A0; sacc+=A1; sacc+=A2; sacc+=A3; PIN(sacc); W0; W1; PIN(PW); SBAR(); }while(0)
  #define EX(v) __builtin_amdgcn_exp2f(v)
  #define GAPB(MF,X,B) do{ MF; X[B]=EX(X[B]); X[B+1]=EX(X[B+1]); X[B+2]=EX(X[B+2]); X[B+3]=EX(X[B+3]); PIN(X); SBAR(); }while(0)
  #define VRD(i) do{ vlo[i]=vtr(vp_+(((i)>>2)*4096+((i)&3)*1024)); vhi[i]=vtr(vp_+(((i)>>2)*4096+((i)&3)*1024+512)); }while(0)
  #define KRD(G,j) do{ if(G){ kload2(kf,kp0+sl_next,j); SBAR(); } }while(0)
  #define STEP(C0,C1,P0,P1,t,GK,GV,GL) do{ SBAR(); \
    const lds_cptr vp_=vp0+sl_prev; \
    VRD(0); SBAR(); float sacc=(P0[0]+P0[1]); \
    GAPA(C0=__builtin_amdgcn_mfma_f32_32x32x16_bf16(kf[0],qr[0],cinit<NA>(negm),0,0,0), P0[2],P0[3],P0[4],P0[5],     pw0[0]=PKW(P0,0), pw0[1]=PKW(P0,2), pw0); \
    VRD(4); SBAR(); GAPA(C1=__builtin_amdgcn_mfma_f32_32x32x16_bf16(kf[1],qr[0],cinit<NA>(negm),0,0,0), P0[6],P0[7],P0[8],P0[9],     pw0[2]=PKW(P0,4), pw0[3]=PKW(P0,6), pw0); \
    VRD(1); SBAR(); GAPA(C0=__builtin_amdgcn_mfma_f32_32x32x16_bf16(kf[2],qr[1],C0,0,0,0),   P0[10],P0[11],P0[12],P0[13], pw1[0]=PKW(P0,8), pw1[1]=PKW(P0,10), pw1); \
    VRD(5); SBAR(); GAPA(C1=__builtin_amdgcn_mfma_f32_32x32x16_bf16(kf[3],qr[1],C1,0,0,0),   P0[14],P0[15],P1[0],P1[1],   pw1[2]=PKW(P0,12),pw1[3]=PKW(P0,14), pw1); \
    VRD(2); SBAR(); GAPA(C0=__builtin_amdgcn_mfma_f32_32x32x16_bf16(kf[4],qr[2],C0,0,0,0),   P1[2],P1[3],P1[4],P1[5],     pw2[0]=PKW(P1,0), pw2[1]=PKW(P1,2), pw2); \
    VRD(6); SBAR(); GAPA(C1=__builtin_amdgcn_mfma_f32_32x32x16_bf16(kf[5],qr[2],C1,0,0,0),   P1[6],P1[7],P1[8],P1[9],     pw2[2]=PKW(P1,4), pw2[3]=PKW(P1,6), pw2); \
    VRD(3); SBAR(); GAPA(C0=__builtin_amdgcn_mfma_f32_32x32x16_bf16(kf[6],qr[3],C0,0,0,0),   P1[10],P1[11],P1[12],P1[13], pw3[0]=PKW(P1,8), pw3[1]=PKW(P1,10), pw3); \
    VRD(7); SBAR(); GAPA(C1=__builtin_amdgcn_mfma_f32_32x32x16_bf16(kf[7],qr[3],C1,0,0,0),   P1[14],P1[15],0.f,0.f,       pw3[2]=PKW(P1,12),pw3[3]=PKW(P1,14), pw3); \
    l_reg+=sacc; \
    if(GK){DMA_K((t)+3,sl_cur);} if(GV){DMA_V((t)+1,sl_next);} \
    if constexpr(NA){ _Pragma("unroll") for(int r=0;r<16;++r){C0[r]-=mhat;C1[r]-=mhat;} } \
    CMASK(C0,C1,t); \
    { float a=MX3(C0[0],C0[1],C1[0]),b=MX3(C0[2],C0[3],C1[1]); a=MX3(a,C1[2],C1[3]); \
      _Pragma("unroll") for(int r=4;r<16;r+=4){a=MX3(a,C0[r],C0[r+1]);b=MX3(b,C0[r+2],C0[r+3]);a=MX3(a,C1[r],C1[r+1]);b=MX3(b,C1[r+2],C1[r+3]);} \
      float rm=__builtin_fmaxf(a,b); { auto rr=__builtin_amdgcn_permlane32_swap(__float_as_uint(rm),__float_as_uint(rm),false,false); rm=__builtin_fmaxf(__uint_as_float(rr[0]),__uint_as_float(rr[1])); } \
      resc=false; \
      if(__builtin_expect(__any(rm>(float)THRL),0)){ const float dl=__builtin_fmaxf(rm,0.f); mhat+=dl; \
        _Pragma("unroll") for(int r=0;r<16;++r){C0[r]-=dl;C1[r]-=dl;} \
        if constexpr(!NA){ _Pragma("unroll") for(int r=0;r<16;++r)negm[r]=-mhat; asm volatile("":"+v"(negm)); } \
        const float f=__builtin_amdgcn_exp2f(-dl); l_reg*=f; if(hi==0)wsf[r32]=f; resc=true; } } \
    SBAR(); \
    GAPB(o[0]=__builtin_amdgcn_mfma_f32_32x32x16_bf16(PAF(0),VFR(0),o[0],0,0,0), C0,0); \
    GAPB(o[1]=__builtin_amdgcn_mfma_f32_32x32x16_bf16(PAF(0),VFR(4),o[1],0,0,0), C0,4); \
    KRD(GL,0); GAPB(o[0]=__builtin_amdgcn_mfma_f32_32x32x16_bf16(PAF(1),VFR(1),o[0],0,0,0), C0,8); \
    KRD(GL,1); GAPB(o[1]=__builtin_amdgcn_mfma_f32_32x32x16_bf16(PAF(1),VFR(5),o[1],0,0,0), C0,12); \
    KRD(GL,2); GAPB(o[0]=__builtin_amdgcn_mfma_f32_32x32x16_bf16(PAF(2),VFR(2),o[0],0,0,0), C1,0); \
    KRD(GL,3); GAPB(o[1]=__builtin_amdgcn_mfma_f32_32x32x16_bf16(PAF(2),VFR(6),o[1],0,0,0), C1,4); \
    GAPB(o[0]=__builtin_amdgcn_mfma_f32_32x32x16_bf16(PAF(3),VFR(3),o[0],0,0,0), C1,8); \
    GAPB(o[1]=__builtin_amdgcn_mfma_f32_32x32x16_bf16(PAF(3),VFR(7),o[1],0,0,0), C1,12); \
    }while(0)
  int t=1;
  for(;t+5<NT;t+=2){
    STEP(pB0,pB1,pA0,pA1,t,true,true,true);     WAIT_BAR(2); RESC(); ROT();
    STEP(pA0,pA1,pB0,pB1,t+1,true,true,true);   WAIT_BAR(2); RESC(); ROT();
  }
  #define ENDW(tt) do{ if((tt)+3<NT){WAIT_BAR(2);} else if((tt)+2<NT){WAIT_BAR(1);} else {WAIT_BAR(0);} }while(0)
  for(;t+1<NT;t+=2){
    STEP(pB0,pB1,pA0,pA1,t,(t+3<NT),(t+1<NT),(t+1<NT));       ENDW(t);   RESC(); ROT();
    STEP(pA0,pA1,pB0,pB1,t+1,(t+4<NT),(t+2<NT),(t+2<NT));     ENDW(t+1); RESC(); ROT();
  }
  STEP(pB0,pB1,pA0,pA1,NT-1,false,false,false); RESC();
  { float sacc=pB0[0]+pB0[1]; _Pragma("unroll") for(int r=2;r<16;++r)sacc+=pB0[r]; _Pragma("unroll") for(int r=0;r<16;++r)sacc+=pB1[r]; l_reg+=sacc;
    pw0=(u32x4){PKW(pB0,0),PKW(pB0,2),PKW(pB0,4),PKW(pB0,6)};pw1=(u32x4){PKW(pB0,8),PKW(pB0,10),PKW(pB0,12),PKW(pB0,14)};pw2=(u32x4){PKW(pB1,0),PKW(pB1,2),PKW(pB1,4),PKW(pB1,6)};pw3=(u32x4){PKW(pB1,8),PKW(pB1,10),PKW(pB1,12),PKW(pB1,14)};
    SBAR(); pv(o,vb0+sl_cur,PAF(0),PAF(1),PAF(2),PAF(3)); }
  #undef PKW
  #undef PAF
  #undef VFR
  #undef PIN
  #undef MX3
  #undef GAPA
  #undef GAPB
  #undef EX
  #undef VRD
  #undef KRD
  #undef STEP
  #undef ENDW
  {auto rr=__builtin_amdgcn_permlane32_swap(__float_as_uint(l_reg),__float_as_uint(l_reg),false,false);l_reg=__uint_as_float(rr[0])+__uint_as_float(rr[1]);}
  if(hi==0)wsf[32+r32]=l_reg;asm volatile("s_waitcnt lgkmcnt(0)":::"memory");
  float rli[16];
  #pragma unroll
  for(int r=0;r<16;++r)rli[r]=__builtin_amdgcn_rcpf(wsf[32+crow(r,hi)]);
  bf16*Ow=J.MX+J.oo+(long)(wid*QBLK)*OP; const bf16*Gw=J.U+J.go+(long)(wid*QBLK)*UP;
  { bf16*stg=(bf16*)(shm+LDS_OST)+wid*2048;
    #pragma unroll
    for(int r=0;r<16;++r){const int orow=crow(r,hi);
      #pragma unroll
      for(int d0=0;d0<2;++d0)stg[orow*64+d0*32+r32]=__float2bfloat16(o[d0][r]*rli[r]);}
    asm volatile("s_waitcnt lgkmcnt(0)":::"memory");
    #pragma unroll
    for(int i=0;i<4;++i){const int row=i*8+(lane>>3),ch=lane&7; const u32x4 v=*(const u32x4*)(stg+row*64+ch*8); const u32x4 g=*(const u32x4*)(Gw+(long)row*UP+ch*8); ATTN_STORE16(Ow+(long)row*OP+ch*8,gate8(v,g));} }
  asm volatile("s_waitcnt lgkmcnt(0)\n\ts_barrier":::"memory");
  #undef DMA_K
  #undef TROW
  #undef DMA_V
  #undef CMASK
  #undef START
  #undef RESC
  #undef ROT
}
constexpr int ATTN_LDS_BYTES=LDS_BYTES;
__device__ __forceinline__ u32x4 gate8(u32x4 v,u32x4 g){ u32x4 r;
  #pragma unroll
  for(int i=0;i<4;++i){ const float a0=__uint_as_float(v[i]<<16)*__uint_as_float(g[i]<<16), a1=__uint_as_float(v[i]&0xffff0000u)*__uint_as_float(g[i]&0xffff0000u); r[i]=cvtpk_s(a0,a1); }
  return r; }
#undef SBAR
#undef WAIT_BAR
}
#define GAS __attribute__((address_space(1)))
#define LAS __attribute__((address_space(3)))
typedef GAS unsigned gu32;
#define RLX_AGENT __ATOMIC_RELAXED, __HIP_MEMORY_SCOPE_AGENT
#define XB_TMO      128
#define XB_XCNT(j)  (256  + 64 * (j))
#define XB_XSUB(j)  (1280 + 64 * (j))
#define XB_XGEN(j)  (2304 + 64 * (j))
#define XB_TOP      3328
#define XB_TOPGEN   3392
#define XCD_BAR_WORDS 3456
#define XB_SPIN_CAP (1u << 20)

__device__ __forceinline__ unsigned xb_ld(unsigned* p)              { return __hip_atomic_load(p, __ATOMIC_RELAXED, __HIP_MEMORY_SCOPE_AGENT); }
__device__ __forceinline__ unsigned xb_add(unsigned* p, unsigned v) { return __hip_atomic_fetch_add(p, v, __ATOMIC_RELAXED, __HIP_MEMORY_SCOPE_AGENT); }
__device__ __forceinline__ unsigned xb_xcc_id() { return (unsigned)__builtin_amdgcn_s_getreg((3 << 11) | 20) & 0xFu; }
#define XB_SPIN(cond, bar) do { unsigned _sp = 0; while (cond) { __builtin_amdgcn_s_sleep(1); \
    if ((++_sp & 255u) == 0u) { if (xb_ld(&(bar)[XB_TMO])) break; if (_sp > XB_SPIN_CAP) { atomicAdd(&(bar)[XB_TMO], 1u); break; } } } } while (0)

struct XcdBarrier {
    unsigned* bar; unsigned x;
    volatile LAS unsigned* st;
};

__device__ __forceinline__ XcdBarrier xcd_barrier_post(unsigned* bar, volatile LAS unsigned* st) {
    XcdBarrier b; b.bar = bar; b.x = xb_xcc_id(); b.st = st;
    if (threadIdx.x == 0) (void)xb_add(&bar[XB_XCNT(b.x)], 1u);
    return b;
}
__device__ __forceinline__ void xcd_barrier_complete(unsigned* bar, unsigned x, unsigned& nloc, unsigned& nx) {
    const unsigned G = gridDim.x * gridDim.y * gridDim.z;
    unsigned sum, cnt, mine, sp = 0u;
    for (;;) {
        sum = 0u; cnt = 0u; mine = 0u;
#pragma unroll
        for (unsigned j = 0; j < 16; ++j) { const unsigned c = xb_ld(&bar[XB_XCNT(j)]); sum += c; cnt += (c > 0u) ? 1u : 0u; mine = (j == x) ? c : mine; }
        if (sum == G) break;
        __builtin_amdgcn_s_sleep(1);
        if ((++sp & 255u) == 0u) { if (xb_ld(&bar[XB_TMO])) break; if (sp > XB_SPIN_CAP) { atomicAdd(&bar[XB_TMO], 1u); break; } }
    }
    nloc = mine > 0u ? mine : 1u; nx = cnt > 0u ? cnt : 1u;
}

__device__ __forceinline__ void xcd_barrier(const XcdBarrier& b) {
    asm volatile("s_waitcnt vmcnt(0)" ::: "memory");
    __syncthreads();
    if (threadIdx.x == 0) {
        unsigned* bar = b.bar;
        __builtin_amdgcn_s_waitcnt(0);
        unsigned nloc = b.st[0], nx = b.st[1];
        if (nloc == 0u) { xcd_barrier_complete(bar, b.x, nloc, nx); b.st[0] = nloc; b.st[1] = nx; }
        const unsigned old = xb_add(&bar[XB_XSUB(b.x)], 1u);
        const unsigned gen = old / nloc;
        if (old + 1u == (gen + 1u) * nloc) {
            __builtin_amdgcn_fence(__ATOMIC_RELEASE, "agent");
            asm volatile("s_waitcnt vmcnt(0)" ::: "memory");
            const unsigned og = xb_add(&bar[XB_TOP], 1u);
            const unsigned tg = og / nx;
            if (og + 1u == (tg + 1u) * nx) xb_add(&bar[XB_TOPGEN], 1u);
            else XB_SPIN(xb_ld(&bar[XB_TOPGEN]) == tg, bar);
            __builtin_amdgcn_fence(__ATOMIC_ACQUIRE, "agent");
            xb_add(&bar[XB_XGEN(b.x)], 1u);
            asm volatile("s_waitcnt vmcnt(0)" ::: "memory");
        } else {
            XB_SPIN(xb_ld(&bar[XB_XGEN(b.x)]) == gen, bar);
            __builtin_amdgcn_fence(__ATOMIC_ACQUIRE, "agent");
            asm volatile("s_waitcnt vmcnt(0)" ::: "memory");
        }
    }
    __syncthreads();
}

constexpr int CW_BAR = 4096;
__device__ __forceinline__ void ph_attention(const Ctx& C, int i, unsigned char* lds) {
    using namespace attn_body;
    const bf16* U = (const bf16*)(C.ws + WS_U); bf16* MX = (bf16*)(C.ws + WS_XN);
    const float* rpb = C.in[I_RPB] + (size_t)i * 8 * 465;
    for (int p = C.vcu; p < 1040; p += C.G) {
        int kind, h, qb;
        if (p < 512) { kind = 0; h = (p & 255) >> 5; qb = (p & 31) + 32 * (p >> 8); }
        else if (p < 1024) { kind = 1; const int q = p - 512; h = (q & 255) >> 5; qb = (q & 31) + 32 * (q >> 8); }
        else if (p < 1032) { kind = 0; h = p - 1024; qb = 64; }
        else { kind = 1; h = p - 1032; qb = 64; }
        const unsigned r0 = 256u * (unsigned)qb;
        AJob J; J.U = U; J.MX = MX;
        if (kind == 0) {
            J.qo = r0 * AIN + 2048 + 64 * h; J.ko = 2560 + 64 * (h >> 2); J.vo = 2688 + 64 * (h >> 2); J.oo = r0 * DM + 512 + 64 * h; J.go = r0 * AIN + 2816 + 64 * h;
            if (qb < 64) { J.NT = 260; J.tile0a = 0; J.na = 260; J.tile0b = 0; } else { J.NT = 4; J.tile0a = 256; J.na = 4; J.tile0b = 0; }
            J.qr0 = 0; J.rmin = 0; J.rpb = nullptr;
            attn_unit<8, false>(J, (char*)lds);
        } else {
            J.qo = r0 * AIN + 64 * h; J.ko = 512 + 64 * h; J.vo = 1024 + 64 * h; J.oo = r0 * DM + 64 * h; J.go = r0 * AIN + 1536 + 64 * h;
            J.tile0a = 256; J.na = 4; J.qr0 = 4 * qb;
            if (qb < 64) { int rm = 4 * qb - 4; rm = rm < 0 ? 0 : (rm > 248 ? 248 : rm); J.NT = 16; J.tile0b = rm; J.rmin = rm; J.rpb = rpb + (size_t)h * 465; }
            else { J.NT = 4; J.tile0b = 0; J.rmin = 0; J.rpb = nullptr; }
            attn_unit<8, true>(J, (char*)lds);
        }
    }
}

#ifdef TSEL
__device__ __forceinline__ void ph_final_t(const Ctx& C) {
    ph_final(C);
    __syncthreads();
    const unsigned long long* st = (const unsigned long long*)(C.ws + WS_CTL + 32768);
    unsigned long long t[24]; for (int k = 0; k < 24; ++k) t[k] = __hip_atomic_load(st + k, __ATOMIC_RELAXED, __HIP_MEMORY_SCOPE_AGENT);
    double sel = 0.0; for (int k = 0; k < 23; ++k) if ((TSEL >> k) & 1ull) sel += (double)(t[k + 1] - t[k]);
    double tot = (double)(t[23] - t[0]);
#ifdef TXS
    { const unsigned long long x = __hip_atomic_load(st + TXS, __ATOMIC_RELAXED, __HIP_MEMORY_SCOPE_AGENT); sel = (double)(x - t[20]); tot = (double)(t[21] - t[20]); }
#ifdef TXD
    { const unsigned long long x = __hip_atomic_load(st + TXS, __ATOMIC_RELAXED, __HIP_MEMORY_SCOPE_AGENT); sel = (double)x; tot = (double)(t[21] - t[20]); }
#endif
#endif
    const float eps = sqrtf(0.0012f * (float)(sel / tot));
    const int gw = C.vcu * NWAVES + C.wave, NGW = C.G * NWAVES;
    for (int m = gw; m < NLAT; m += NGW) { float* xr = C.out + (size_t)m * DM; for (int j = 0; j < 16; ++j) xr[64 * j + C.lane] *= (1.0f + eps); }
}
#else
__device__ __forceinline__ void ph_final_t(const Ctx& C) { ph_final(C); }
#endif
struct Args { const float* in[N_IN]; float* out; unsigned char* ws; int ph_lo, ph_hi; };
typedef __attribute__((address_space(4))) const Args* KArgP;
__global__ void __launch_bounds__(NTHREADS, 2) mk_fwd(Args args) {
    extern __shared__ __attribute__((aligned(16))) unsigned char lds[];
    volatile LAS unsigned* MISC = (volatile LAS unsigned*)((LAS unsigned char*)lds + MISC_OFF);
    if (threadIdx.x < 64) MISC[threadIdx.x] = 0u;
    __syncthreads();
    XcdBarrier bar = xcd_barrier_post((unsigned*)(args.ws + WS_CTL) + CW_BAR, MISC + 8);
    const int lo = args.ph_lo, hi = args.ph_hi;
    int pc = 0;
#ifdef TSEL
#define STAMP(k) do { if (blockIdx.x == 0 && threadIdx.x == 0) __hip_atomic_store((unsigned long long*)(args.ws + WS_CTL + 32768) + (k), (unsigned long long)__builtin_amdgcn_s_memrealtime(), __ATOMIC_RELAXED, __HIP_MEMORY_SCOPE_AGENT); } while (0)
#else
#define STAMP(k) do {} while (0)
#endif
    STAMP(0);
#define PHASE(...) do { if (pc >= lo && pc < hi) { KArgP ap = (KArgP)__builtin_amdgcn_kernarg_segment_ptr(); asm volatile("" : "+s"(ap)); Ctx C; \
        _Pragma("unroll") for (int k = 0; k < N_IN; ++k) C.in[k] = ap->in[k]; C.out = ap->out; C.ws = ap->ws; \
        { int t_ = threadIdx.x; asm volatile("" : "+v"(t_)); C.tid = t_; } C.lane = C.tid & 63; C.wave = __builtin_amdgcn_readfirstlane(C.tid >> 6); \
        C.G = gridDim.x; { const int bx = blockIdx.x; C.vcu = (C.G % 8 == 0) ? (bx % 8) * (C.G / 8) + bx / 8 : bx; } \
        float* XCTX = (float*)(C.ws + WS_XCTX); unsigned char* ldsg = (unsigned char*)lds; unsigned char* wsp = C.ws; (void)XCTX; (void)ldsg; (void)wsp; \
        const float* xl = layer == 0 ? C.in[I_X] : C.out; const float* xc = layer == 0 ? C.in[I_CTX] : XCTX; (void)xl; (void)xc; \
        const float* ADA = (const float*)(C.ws + WS_ADA) + (size_t)layer * 2 * 3072; (void)ADA; \
        __VA_ARGS__; if (pc + 1 < hi) xcd_barrier(bar); STAMP(pc + 1); } ++pc; } while (0)
#ifndef PH_MASK
#define PH_MASK 0xFFFF
#endif
#define EN(b) if ((PH_MASK >> (b)) & 1)

    { const int layer = 0; PHASE(EN(0) ph_prologue(C, ldsg)); }
    for (int layer = 0; layer < 4; ++layer) {
        const int i = layer >> 1;
        const bool ctx_out = layer < 3;
        PHASE(EN(1) ph_norm(C, layer, xl, xc, true));
        if ((layer & 1) == 0) {
            PHASE(EN(2) { pg8::Gemm g{(const pg8::bf16_t*)(wsp + WS_XN), (const pg8::bf16_t*)(wsp + WS_XN) + DM / 2, DM, (const pg8::bf16_t*)(wsp + WS_WAIN) + (size_t)i * AIN * DM, NTOK, AIN, DM};
                    pg8::StaticOrder S; S.init(NTOK, AIN, C.G, (int)blockIdx.x); pg8::EpiIn<0> E{wsp};
                    pg8::gemm_phase<pg8::EpiIn<0>, pg8::StaticOrder, true, true>((LAS unsigned char*)lds, g, S, E); });
            PHASE(EN(3) ph_qkprep(C, i));
            PHASE(EN(4) ph_attention(C, i, ldsg));
            PHASE(EN(5) { pg8::Gemm g{(const pg8::bf16_t*)(wsp + WS_XN), (const pg8::bf16_t*)(wsp + WS_XN) + DM / 2, DM, (const pg8::bf16_t*)(wsp + WS_WAOUT) + (size_t)i * DM * DM, NLAT, DM, DM};
                    pg8::StaticOrder S; S.init(NLAT, DM, C.G, (int)blockIdx.x); pg8::EpiRes E{xl, xc, C.out, XCTX, ADA + 2048, ADA + 3072 + 2048};
                    pg8::gemm_phase<pg8::EpiRes, pg8::StaticOrder, true, true>((LAS unsigned char*)lds, g, S, E);
                    ctx_outproj(C, (const bf16_t*)(wsp + WS_XN) + (size_t)NLAT * DM, (const bf16_t*)(wsp + WS_XN) + (size_t)NLAT * DM + 512, DM, (const bf16_t*)(wsp + WS_WAOUT) + (size_t)i * DM * DM, ADA + 3072 + 2048, xc, XCTX); });
        } else {
            PHASE(EN(6) { pg8::Gemm g{(const pg8::bf16_t*)(wsp + WS_XN), (const pg8::bf16_t*)(wsp + WS_XN) + DM / 2, DM, (const pg8::bf16_t*)(wsp + WS_WRIN) + (size_t)i * RINP * DM, NTOK, RINP, DM};
                    pg8::StaticOrder S; S.init(NTOK, RINP, C.G, (int)blockIdx.x); pg8::EpiIn<1> E{wsp};
                    pg8::gemm_phase<pg8::EpiIn<1>, pg8::StaticOrder, true, true>((LAS unsigned char*)lds, g, S, E); });
            PHASE(EN(7) ph_hyprep(C, i, ctx_out, ldsg));
            PHASE(EN(8) ph_scan_hyena(C, i, ctx_out, ldsg));
            PHASE(EN(9) ph_readout_hyout(C, i, ctx_out, ldsg));
            const int Mo = NLAT;
            PHASE(EN(10) { pg8::Gemm g{(const pg8::bf16_t*)(wsp + WS_YF), (const pg8::bf16_t*)(wsp + WS_HYOUT), 512, (const pg8::bf16_t*)(wsp + WS_WROUT) + (size_t)i * DM * DM, Mo, DM, DM};
                    pg8::StaticOrder S; S.init(Mo, DM, C.G, (int)blockIdx.x); pg8::EpiRes E{xl, xc, C.out, XCTX, ADA + 2048, ADA + 3072 + 2048};
                    pg8::gemm_phase<pg8::EpiRes, pg8::StaticOrder, true, true>((LAS unsigned char*)lds, g, S, E);
                    if (ctx_out) ctx_outproj(C, (const bf16_t*)(wsp + WS_YF) + (size_t)NLAT * 512, (const bf16_t*)(wsp + WS_HYOUT) + (size_t)NLAT * 512, 512, (const bf16_t*)(wsp + WS_WROUT) + (size_t)i * DM * DM, ADA + 3072 + 2048, xc, XCTX); });
        }
    }
    { const int layer = 3; PHASE(EN(11) ph_final_t(C)); }
#undef PHASE
}
constexpr int N_PHASES = 1 + 2 * 5 + 2 * 6 + 1;

#ifndef MK_SPLIT
#define MK_SPLIT 0
#endif
extern "C" void kernel_launch(void* const* d_in, const int* in_sizes, int n_in, void* d_out, int out_size, void* d_ws, size_t ws_size, hipStream_t stream) {
    static int grid = 0;
    if (grid == 0) {
        if (n_in != N_IN || out_size != NLAT * DM || ws_size < WS_END) { fprintf(stderr, "kernel_launch: unexpected shapes (n_in %d out %d ws %zu)\n", n_in, out_size, ws_size); grid = -1; return; }
        int dev = 0, cus = 0, per_cu = 0;
        if (hipGetDevice(&dev) != hipSuccess || hipDeviceGetAttribute(&cus, hipDeviceAttributeMultiprocessorCount, dev) != hipSuccess) { grid = -1; return; }
        if (hipFuncSetAttribute((const void*)mk_fwd, hipFuncAttributeMaxDynamicSharedMemorySize, LDS_BYTES) != hipSuccess) { fprintf(stderr, "kernel_launch: hipFuncSetAttribute failed\n"); grid = -1; return; }
        if (hipOccupancyMaxActiveBlocksPerMultiprocessor(&per_cu, (const void*)mk_fwd, NTHREADS, LDS_BYTES) != hipSuccess || per_cu < 1) fprintf(stderr, "kernel_launch: occupancy query says %d\n", per_cu);
        (void)hipGetLastError();
        grid = cus;
    }
    if (grid < 0) return;
    (void)hipMemsetAsync((char*)d_ws + WS_CTL, 0, CTL_ZERO_BYTES, stream);
    Args a{};
    for (int k = 0; k < N_IN; ++k) a.in[k] = (const float*)d_in[k];
    a.out = (float*)d_out; a.ws = (unsigned char*)d_ws;
#if MK_SPLIT
    for (int p = 0; p < N_PHASES; ++p) { a.ph_lo = p; a.ph_hi = p + 1; hipLaunchKernelGGL(mk_fwd, dim3(grid), dim3(NTHREADS), LDS_BYTES, stream, a); }
#else
    a.ph_lo = 0; a.ph_hi = N_PHASES;
    hipLaunchKernelGGL(mk_fwd, dim3(grid), dim3(NTHREADS), LDS_BYTES, stream, a);
#endif
}
```
